# Optimizing an MI355X kernel written in HIP

```python
import math
import jax, jax.numpy as jnp
from jax import lax
import numpy as np

D_MODEL = 1024
BATCH = 2
SEQ = 8192
DEPTH = 4
DEC_BATCH = 128
DEC_SEQ = 8
PAST_LEN = 8192
PAGE_SIZE = 128

N_A_LAYERS = DEPTH // 2
N_B_LAYERS = DEPTH - N_A_LAYERS
N_META = 16
SSM_EXPAND = 2
D_INNER = SSM_EXPAND * D_MODEL
SSM_HEAD_DIM = 64
N_SSM_HEADS = D_INNER // SSM_HEAD_DIM
N_GROUPS = 8
HEADS_PER_GROUP = N_SSM_HEADS // N_GROUPS
D_STATE = 128
CONV_K = 4
CONV_DIM = D_INNER + 2 * N_GROUPS * D_STATE
IN_PROJ_DIM = D_INNER + CONV_DIM + N_SSM_HEADS
SSD_CHUNK = 128
ATTN_HEAD_DIM = 64
N_Q_HEADS = D_MODEL // ATTN_HEAD_DIM
N_KV_HEADS = 4
Q_PER_KV = N_Q_HEADS // N_KV_HEADS
WINDOW = 128
ATTN_SCALE = ATTN_HEAD_DIM ** -0.5
D_FF = 4 * D_MODEL
EPS = 1e-5

kernel_name = 'yoco_mamba2_swa_sink_hybrid_step'


def rmsnorm(x, w):
    xf = x.astype(jnp.float32)
    xf = xf * lax.rsqrt(jnp.mean(xf * xf, axis=-1, keepdims=True) + EPS)
    return (xf * w.astype(jnp.float32)).astype(x.dtype)


def gated_group_rmsnorm(y, z, w):
    g = (y * jax.nn.silu(z)).astype(jnp.float32)
    shp = g.shape
    g = g.reshape(shp[:-1] + (N_GROUPS, shp[-1] // N_GROUPS))
    g = g * lax.rsqrt(jnp.mean(g * g, axis=-1, keepdims=True) + EPS)
    return (g.reshape(shp) * w.astype(jnp.float32)).astype(y.dtype)


def sq_relu_mlp(h, norm_w, w_up, w_down):
    return h + jnp.square(jax.nn.relu(rmsnorm(h, norm_w) @ w_up)) @ w_down


def _chunk_len(length):
    return SSD_CHUNK if length % SSD_CHUNK == 0 else length


def ssd_scan(x, dt, a_neg, bm, cm, h0):
    f32 = jnp.float32
    b, L, g, r, p = x.shape
    chunk = _chunk_len(L)
    nc = L // chunk

    def blocks(t):
        return t.astype(f32).reshape((b, nc, chunk) + t.shape[2:])

    xdt = blocks(x.astype(f32) * dt[..., None])
    acs = jnp.cumsum(blocks(dt * a_neg), axis=2)
    bb, cc = blocks(bm), blocks(cm)
    causal = jnp.tril(jnp.ones((chunk, chunk), bool))[:, :, None, None]
    seg = acs[:, :, :, None] - acs[:, :, None, :]
    decay = jnp.exp(jnp.where(causal, seg, -jnp.inf))
    cb = jnp.einsum('bclgn,bcsgn->bclsg', cc, bb)
    y_diag = jnp.einsum('bclsgr,bcsgrp->bclgrp', cb[..., None] * decay, xdt)
    decay_to_end = jnp.exp(acs[:, :, -1:] - acs)
    chunk_states = jnp.einsum('bclgn,bclgrp->bcgrpn', bb, decay_to_end[..., None] * xdt)
    chunk_decay = jnp.exp(acs[:, :, -1])

    def step(h, inp):
        s, d = inp
        return d[..., None, None] * h + s, h

    h_final, h_start = lax.scan(step, h0.astype(f32),
                                (jnp.moveaxis(chunk_states, 1, 0), jnp.moveaxis(chunk_decay, 1, 0)))
    h_start = jnp.moveaxis(h_start, 0, 1)
    y_off = jnp.einsum('bclgn,bcgrpn->bclgrp', cc, h_start) * jnp.exp(acs)[..., None]
    y = (y_diag + y_off).reshape(b, L, g, r, p)
    return y, h_final


def mamba_mixer(h, conv_state, ssm_state, norm_w, w_in, conv_w, conv_b, dt_bias, a_log, d_skip, gate_w, w_out):
    b, L, _ = h.shape
    zxbcdt = rmsnorm(h, norm_w) @ w_in
    z = zxbcdt[..., :D_INNER]
    xbc = zxbcdt[..., D_INNER:D_INNER + CONV_DIM]
    dt_raw = zxbcdt[..., D_INNER + CONV_DIM:]
    xpad = jnp.concatenate([conv_state.astype(xbc.dtype), xbc], axis=1)
    new_conv = xpad[:, L:]
    conv = conv_b
    for k in range(CONV_K):
        conv = conv + xpad[:, k:k + L] * conv_w[k]
    xbc = jax.nn.silu(conv)
    xs = xbc[..., :D_INNER].reshape(b, L, N_GROUPS, HEADS_PER_GROUP, SSM_HEAD_DIM)
    bm = xbc[..., D_INNER:D_INNER + N_GROUPS * D_STATE].reshape(b, L, N_GROUPS, D_STATE)
    cm = xbc[..., D_INNER + N_GROUPS * D_STATE:].reshape(b, L, N_GROUPS, D_STATE)
    dt = jax.nn.softplus(dt_raw.astype(jnp.float32) + dt_bias.astype(jnp.float32))
    dt = dt.reshape(b, L, N_GROUPS, HEADS_PER_GROUP)
    a_neg = -jnp.exp(a_log.astype(jnp.float32)).reshape(N_GROUPS, HEADS_PER_GROUP)
    h0 = ssm_state.reshape(b, N_GROUPS, HEADS_PER_GROUP, SSM_HEAD_DIM, D_STATE)
    y, h_new = ssd_scan(xs, dt, a_neg, bm, cm, h0)
    y = y + d_skip.astype(jnp.float32).reshape(N_GROUPS, HEADS_PER_GROUP)[:, :, None] * xs.astype(jnp.float32)
    y = y.reshape(b, L, D_INNER).astype(h.dtype)
    out = gated_group_rmsnorm(y, z, gate_w) @ w_out
    return out, new_conv, h_new.reshape(b, N_SSM_HEADS, SSM_HEAD_DIM, D_STATE).astype(ssm_state.dtype)


def shared_kv(h, kv_norm_w, w_kv):
    b, L, _ = h.shape
    kv = (rmsnorm(h, kv_norm_w) @ w_kv).reshape(b, L, 2, N_KV_HEADS, ATTN_HEAD_DIM)
    return kv[:, :, 0], kv[:, :, 1]


def queries(h, norm_w, w_q):
    b, L, _ = h.shape
    return (rmsnorm(h, norm_w) @ w_q).reshape(b, L, N_KV_HEADS, Q_PER_KV, ATTN_HEAD_DIM)


def sink_softmax(scores, mask, sinks):
    s = jnp.where(mask, scores, -jnp.inf)
    sink = jnp.broadcast_to(sinks.astype(jnp.float32).reshape(N_KV_HEADS, Q_PER_KV, 1, 1), s.shape[:-1] + (1,))
    return jax.nn.softmax(jnp.concatenate([s, sink], axis=-1), axis=-1)[..., :-1]


def swa_prompt(q, k, v, k_meta, v_meta, sinks):
    b, S = q.shape[:2]
    m = k_meta.shape[0]
    nb = S // WINDOW
    qb = q.reshape(b, nb, WINDOW, N_KV_HEADS, Q_PER_KV, ATTN_HEAD_DIM)

    def band(t, t_meta):
        tb = t.reshape(b, nb, WINDOW, N_KV_HEADS, ATTN_HEAD_DIM)
        prev = jnp.concatenate([jnp.zeros_like(tb[:, :1]), tb[:, :-1]], axis=1)
        meta = jnp.broadcast_to(t_meta, (b, nb) + t_meta.shape)
        return jnp.concatenate([meta, prev, tb], axis=2)

    keys, vals = band(k, k_meta), band(v, v_meta)
    scores = jnp.einsum('bnqkrd,bnskd->bnkrqs', qb, keys, preferred_element_type=jnp.float32) * ATTN_SCALE
    qi = jnp.arange(WINDOW)[:, None]
    ci = jnp.arange(WINDOW)[None, :]
    blk = jnp.arange(nb)[:, None, None]
    meta_m = jnp.ones((nb, WINDOW, m), bool)
    prev_m = (ci > qi)[None] & (blk > 0)
    cur_m = jnp.broadcast_to((ci <= qi)[None], (nb, WINDOW, WINDOW))
    mask = jnp.concatenate([meta_m, prev_m, cur_m], axis=-1)
    probs = sink_softmax(scores, mask[None, :, None, None], sinks)
    out = jnp.einsum('bnkrqs,bnskd->bnqkrd', probs.astype(vals.dtype), vals)
    return out.reshape(b, S, N_Q_HEADS * ATTN_HEAD_DIM)


def swa_sample(q, k_new, v_new, k_buf, v_buf, k_meta, v_meta, sinks):
    b, T = q.shape[:2]
    w_buf = k_buf.shape[1]
    m = k_meta.shape[0]
    keys = jnp.concatenate([jnp.broadcast_to(k_meta, (b,) + k_meta.shape), k_buf, k_new], axis=1)
    vals = jnp.concatenate([jnp.broadcast_to(v_meta, (b,) + v_meta.shape), v_buf, v_new], axis=1)
    scores = jnp.einsum('bqkrd,bskd->bkrqs', q, keys, preferred_element_type=jnp.float32) * ATTN_SCALE
    qi = jnp.arange(T)[:, None]
    pos_q = PAST_LEN + qi
    pos_buf = PAST_LEN - w_buf + jnp.arange(w_buf)[None, :]
    buf_m = (pos_q - pos_buf < WINDOW) & (pos_buf >= m)
    ci = jnp.arange(T)[None, :]
    new_m = (ci <= qi) & (qi - ci < WINDOW)
    mask = jnp.concatenate([jnp.ones((T, m), bool), buf_m, new_m], axis=-1)
    probs = sink_softmax(scores, mask[None, None, None], sinks)
    out = jnp.einsum('bkrqs,bskd->bqkrd', probs.astype(vals.dtype), vals)
    return out.reshape(b, T, N_Q_HEADS * ATTN_HEAD_DIM)


def setup_inputs(seed: int = 0) -> dict:
    key = jax.random.key(seed)
    ks = jax.random.split(key, 32)
    f32 = jnp.float32

    def nrm(k, shape, scale):
        return scale * jax.random.normal(k, shape, f32)

    w_buf = min(WINDOW, PAST_LEN)
    na, nb = N_A_LAYERS, N_B_LAYERS
    dt0 = jnp.exp(jax.random.uniform(ks[10], (na, N_SSM_HEADS), f32, math.log(1e-3), math.log(1e-1)))
    return {
        'x_prompt': nrm(ks[0], (BATCH, SEQ, D_MODEL), 1.0),
        'x_sample': nrm(ks[1], (DEC_BATCH, DEC_SEQ, D_MODEL), 1.0),
        'state_conv': nrm(ks[2], (na, DEC_BATCH, CONV_K - 1, CONV_DIM), 1.0),
        'state_ssm': nrm(ks[3], (na, DEC_BATCH, N_SSM_HEADS, SSM_HEAD_DIM, D_STATE), 0.1),
        'cache_k_win': nrm(ks[4], (DEC_BATCH, w_buf, N_KV_HEADS, ATTN_HEAD_DIM), 1.0),
        'cache_v_win': nrm(ks[5], (DEC_BATCH, w_buf, N_KV_HEADS, ATTN_HEAD_DIM), 1.0),
        'meta_tokens': nrm(ks[6], (N_META, D_MODEL), 1.0),
        'a_norm_w': 1.0 + nrm(ks[7], (na, D_MODEL), 0.02),
        'a_in_proj': nrm(ks[8], (na, D_MODEL, IN_PROJ_DIM), D_MODEL ** -0.5),
        'a_conv_w': nrm(ks[9], (na, CONV_K, CONV_DIM), CONV_K ** -0.5),
        'a_conv_b': nrm(ks[11], (na, CONV_DIM), 0.02),
        'a_dt_bias': dt0 + jnp.log(-jnp.expm1(-dt0)),
        'a_log': jnp.log(jax.random.uniform(ks[12], (na, N_SSM_HEADS), f32, 1.0, 16.0)),
        'a_d_skip': 1.0 + nrm(ks[13], (na, N_SSM_HEADS), 0.02),
        'a_gate_norm_w': 1.0 + nrm(ks[14], (na, D_INNER), 0.02),
        'a_out_proj': nrm(ks[15], (na, D_INNER, D_MODEL), D_INNER ** -0.5),
        'kv_norm_w': 1.0 + nrm(ks[16], (D_MODEL,), 0.02),
        'w_kv': nrm(ks[17], (D_MODEL, 2 * N_KV_HEADS * ATTN_HEAD_DIM), D_MODEL ** -0.5),
        'b_norm_w': 1.0 + nrm(ks[18], (nb, D_MODEL), 0.02),
        'w_q': nrm(ks[19], (nb, D_MODEL, N_Q_HEADS * ATTN_HEAD_DIM), D_MODEL ** -0.5),
        'attn_sinks': nrm(ks[20], (nb, N_Q_HEADS), 0.5),
        'w_o': nrm(ks[21], (nb, N_Q_HEADS * ATTN_HEAD_DIM, D_MODEL), (N_Q_HEADS * ATTN_HEAD_DIM) ** -0.5),
        'mlp_norm_w': 1.0 + nrm(ks[22], (DEPTH, D_MODEL), 0.02),
        'w_up': nrm(ks[23], (DEPTH, D_MODEL, D_FF), D_MODEL ** -0.5),
        'w_down': nrm(ks[24], (DEPTH, D_FF, D_MODEL), D_FF ** -0.5),
        'final_norm_w': 1.0 + nrm(ks[25], (D_MODEL,), 0.02),
    }


def reference(x_prompt, x_sample, state_conv, state_ssm, cache_k_win, cache_v_win, meta_tokens,
              a_norm_w, a_in_proj, a_conv_w, a_conv_b, a_dt_bias, a_log, a_d_skip, a_gate_norm_w, a_out_proj,
              kv_norm_w, w_kv, b_norm_w, w_q, attn_sinks, w_o, mlp_norm_w, w_up, w_down, final_norm_w):
    n_prompt = x_prompt.shape[0]
    w_buf = cache_k_win.shape[1]
    hm = meta_tokens[None].astype(x_prompt.dtype)
    hp = x_prompt
    hs = x_sample
    conv_p_list, ssm_p_list, conv_s_list, ssm_s_list = [], [], [], []
    k_meta = v_meta = k_p = v_p = k_s = v_s = None
    for layer in range(DEPTH):
        if layer < N_A_LAYERS:
            i = layer
            prm = (a_norm_w[i], a_in_proj[i], a_conv_w[i], a_conv_b[i], a_dt_bias[i], a_log[i],
                   a_d_skip[i], a_gate_norm_w[i], a_out_proj[i])
            zero_conv = jnp.zeros((1, CONV_K - 1, CONV_DIM), hm.dtype)
            zero_ssm = jnp.zeros((1, N_SSM_HEADS, SSM_HEAD_DIM, D_STATE), hm.dtype)
            ym, conv_m, ssm_m = mamba_mixer(hm, zero_conv, zero_ssm, *prm)
            yp, conv_p, ssm_p = mamba_mixer(hp, jnp.broadcast_to(conv_m, (n_prompt,) + conv_m.shape[1:]),
                                            jnp.broadcast_to(ssm_m, (n_prompt,) + ssm_m.shape[1:]), *prm)
            ys, conv_s, ssm_s = mamba_mixer(hs, state_conv[i], state_ssm[i], *prm)
            hm, hp, hs = hm + ym, hp + yp, hs + ys
            conv_p_list.append(conv_p)
            ssm_p_list.append(ssm_p)
            conv_s_list.append(conv_s)
            ssm_s_list.append(ssm_s)
            hm = sq_relu_mlp(hm, mlp_norm_w[layer], w_up[layer], w_down[layer])
        else:
            j = layer - N_A_LAYERS
            if j == 0:
                km, vm = shared_kv(hm, kv_norm_w, w_kv)
                k_meta, v_meta = km[0], vm[0]
                k_p, v_p = shared_kv(hp, kv_norm_w, w_kv)
                k_s, v_s = shared_kv(hs, kv_norm_w, w_kv)
            q_p = queries(hp, b_norm_w[j], w_q[j])
            q_s = queries(hs, b_norm_w[j], w_q[j])
            hp = hp + swa_prompt(q_p, k_p, v_p, k_meta, v_meta, attn_sinks[j]) @ w_o[j]
            hs = hs + swa_sample(q_s, k_s, v_s, cache_k_win, cache_v_win, k_meta, v_meta, attn_sinks[j]) @ w_o[j]
        hp = sq_relu_mlp(hp, mlp_norm_w[layer], w_up[layer], w_down[layer])
        hs = sq_relu_mlp(hs, mlp_norm_w[layer], w_up[layer], w_down[layer])
    y_prompt = rmsnorm(hp, final_norm_w)
    y_sample = rmsnorm(hs, final_norm_w)
    prompt_state_conv = jnp.stack(conv_p_list)
    prompt_state_ssm = jnp.stack(ssm_p_list)
    prompt_cache_k_win = k_p[:, -w_buf:]
    prompt_cache_v_win = v_p[:, -w_buf:]
    sample_state_conv = jnp.stack(conv_s_list)
    sample_state_ssm = jnp.stack(ssm_s_list)
    sample_cache_k_win = jnp.concatenate([cache_k_win, k_s], axis=1)[:, -w_buf:]
    sample_cache_v_win = jnp.concatenate([cache_v_win, v_s], axis=1)[:, -w_buf:]
    return (y_prompt, y_sample, prompt_state_conv, prompt_state_ssm, prompt_cache_k_win, prompt_cache_v_win,
            sample_state_conv, sample_state_ssm, sample_cache_k_win, sample_cache_v_win)
```

```cpp
#include <hip/hip_runtime.h>
#include <cstdio>
#include <cstdint>
#include <cmath>
namespace pg8 {
#define PG8_LAS __attribute__((address_space(3)))
typedef unsigned short bf16_t;
typedef short bf16x8 __attribute__((ext_vector_type(8)));
typedef float f32x4 __attribute__((ext_vector_type(4)));
typedef unsigned u32x4 __attribute__((ext_vector_type(4)));
constexpr int BM = 256, BK = 64, HALF = 128, HTB = HALF * BK * 2  , STAGE_BYTES = 8 * HTB, NXCD = 8, WGM = 8;

__host__ __device__ __forceinline__ int lds_byte(int r, int c) { const int st = (r >> 4) * 2 + (c >> 5), rr = r & 15, cc = c & 31, ob = rr * 64 + cc * 2; return st * 1024 + (ob ^ (((ob >> 9) & 1) << 5)); }
__host__ __device__ __forceinline__ void stage_rc(int b, int& R, int& C) { const int st = b / 1024, sb = b % 1024, swz = sb ^ (((sb >> 9) & 1) << 5); R = (st >> 1) * 16 + swz / 64; C = (st & 1) * 32 + (swz % 64) / 2; }
__host__ __device__ __forceinline__ int perm32(int rho) { const int n = rho >> 4, i = rho & 15; return 8 * (i >> 2) + 4 * n + (i & 3); }

struct Unit { int pm, pn; };
struct Gemm { const bf16_t* A; const bf16_t* Bt; int M, N, K; };

struct StaticOrder {
    int nM, nN, nwg, G, c;
    __host__ __device__ void init(int M, int N, int G_, int c_) { nM = M / BM; nN = N / BM; nwg = nM * nN; G = G_; c = c_; }
    __host__ __device__ bool next(int i, Unit& u) const {
        const long L = (long)i * G + c; if (L >= nwg) return false;
        int wgid = (int)L; { const int q = nwg / NXCD, r = nwg % NXCD, xcd = wgid % NXCD, off = wgid / NXCD; wgid = (xcd < r ? xcd * (q + 1) : r * (q + 1) + (xcd - r) * q) + off; }
        const int nig = WGM * nN, gid = wgid / nig, fm = gid * WGM, gsz = (nM - fm) < WGM ? (nM - fm) : WGM;
        u.pm = fm + ((wgid % nig) % gsz); u.pn = (wgid % nig) / gsz; return true;
    }
    __device__ __forceinline__ void a_ready(const Unit&) const {}
    __device__ __forceinline__ void done(const Unit&) const {}
};

__device__ __forceinline__ unsigned cvt_pk_bf16(float lo, float hi) { unsigned r; asm volatile("v_cvt_pk_bf16_f32 %0, %1, %2" : "=v"(r) : "v"(lo), "v"(hi)); return r; }
typedef float f32x2 __attribute__((ext_vector_type(2)));
typedef unsigned u32x2 __attribute__((ext_vector_type(2)));
__device__ __forceinline__ float softplus_f(float x) { return x > 20.f ? x : log1pf(__expf(x)); }
struct EpiInProj {
    static constexpr bool PERM = true, AFTER_DRAIN = false;
    bf16_t* ZX; float* DT; const float* dt_bias;
    __device__ __forceinline__ void operator()(const f32x4 (&acc)[2][2][4][2], const Unit& u, int wr, int wc, int fr, int fq) const {
        const int row0 = u.pm * BM + wr * 64 + fr;
        if (u.pn < 24) {
            const int col0 = u.pn * BM + wc * 32 + 8 * fq;
#pragma unroll
            for (int ai = 0; ai < 2; ++ai)
#pragma unroll
                for (int m = 0; m < 4; ++m) { bf16_t* rowp = ZX + (size_t)(row0 + ai * HALF + m * 16) * 6144 + col0;
#pragma unroll
                    for (int bj = 0; bj < 2; ++bj) { const f32x4 v0 = acc[ai][bj][m][0], v1 = acc[ai][bj][m][1];
                        u32x4 w; w.x = cvt_pk_bf16(v0[0], v0[1]); w.y = cvt_pk_bf16(v0[2], v0[3]); w.z = cvt_pk_bf16(v1[0], v1[1]); w.w = cvt_pk_bf16(v1[2], v1[3]);
                        *(u32x4*)(rowp + bj * HALF) = w; } }
        } else if (wc == 0) {
            const int c0 = 8 * fq;
            const f32x4 b0 = *(const f32x4*)(dt_bias + c0), b1 = *(const f32x4*)(dt_bias + c0 + 4);
#pragma unroll
            for (int ai = 0; ai < 2; ++ai)
#pragma unroll
                for (int m = 0; m < 4; ++m) { float* rowp = DT + (size_t)(row0 + ai * HALF + m * 16) * 32 + c0;
                    const f32x4 v0 = acc[ai][0][m][0] + b0, v1 = acc[ai][0][m][1] + b1;
                    f32x4 o0, o1;
#pragma unroll
                    for (int j = 0; j < 4; ++j) { o0[j] = softplus_f(v0[j]); o1[j] = softplus_f(v1[j]); }
                    *(f32x4*)(rowp) = o0; *(f32x4*)(rowp + 4) = o1; }
        }
    }
};
struct EpiRes {
    static constexpr bool PERM = false, AFTER_DRAIN = false;
    float* H;
    __device__ __forceinline__ void operator()(const f32x4 (&acc)[2][2][4][2], const Unit& u, int wr, int wc, int fr, int fq) const {
        const int row0 = u.pm * BM + wr * 64 + fr, col0 = u.pn * BM + wc * 32 + 4 * fq;
#pragma unroll
        for (int ai = 0; ai < 2; ++ai)
#pragma unroll
            for (int m = 0; m < 4; ++m) { float* rowp = H + (size_t)(row0 + ai * HALF + m * 16) * 1024 + col0;
#pragma unroll
                for (int bj = 0; bj < 2; ++bj)
#pragma unroll
                    for (int n = 0; n < 2; ++n) { f32x4* p = (f32x4*)(rowp + bj * HALF + n * 16); *p = *p + acc[ai][bj][m][n]; } }
    }
};
template <int ACT> struct EpiBf {
    static constexpr bool PERM = true, AFTER_DRAIN = false;
    bf16_t* O0; int ldc0; int nsplit; bf16_t* O1; int ldc1;
    __device__ __forceinline__ void operator()(const f32x4 (&acc)[2][2][4][2], const Unit& u, int wr, int wc, int fr, int fq) const {
        const int row0 = u.pm * BM + wr * 64 + fr;
        bf16_t* base; int ldc, colt;
        if (u.pn < nsplit) { base = O0; ldc = ldc0; colt = u.pn * BM; } else { base = O1; ldc = ldc1; colt = (u.pn - nsplit) * BM; }
        const int col0 = colt + wc * 32 + 8 * fq;
#pragma unroll
        for (int ai = 0; ai < 2; ++ai)
#pragma unroll
            for (int m = 0; m < 4; ++m) { bf16_t* rowp = base + (size_t)(row0 + ai * HALF + m * 16) * ldc + col0;
#pragma unroll
                for (int bj = 0; bj < 2; ++bj) { f32x4 v0 = acc[ai][bj][m][0], v1 = acc[ai][bj][m][1];
                    if (ACT == 1) {
#pragma unroll
                        for (int j = 0; j < 4; ++j) { const float a = fmaxf(v0[j], 0.f), b = fmaxf(v1[j], 0.f); v0[j] = a * a; v1[j] = b * b; } }
                    u32x4 w; w.x = cvt_pk_bf16(v0[0], v0[1]); w.y = cvt_pk_bf16(v0[2], v0[3]); w.z = cvt_pk_bf16(v1[0], v1[1]); w.w = cvt_pk_bf16(v1[2], v1[3]);
                    *(u32x4*)(rowp + bj * HALF) = w; } }
    }
};

template <class Epi, class Sched, bool ALIGN_EPI = false, bool SP2 = false>
__device__ __forceinline__ void gemm_phase(PG8_LAS unsigned char* lds, const Gemm g, const Sched& S, const Epi& E) {
    int tid_l = threadIdx.x; asm volatile("" : "+v"(tid_l));
    const int tid = tid_l, wid = __builtin_amdgcn_readfirstlane(tid >> 6), lane = tid & 63, wr = wid >> 2, wc = wid & 3, fr = lane & 15, fq = lane >> 4;
    const int K = g.K, nt = K / BK;
    unsigned voffA[2], voffB[2];
#pragma unroll
    for (int i = 0; i < 2; ++i) { int R, C; stage_rc(tid * 16 + i * 8192, R, C); const int Rb = Epi::PERM ? ((R & ~31) + perm32(R & 31)) : R;
        voffA[i] = (unsigned)(R * K + C) * 2u; voffB[i] = (unsigned)(Rb * K + C) * 2u; }
    const size_t kstep = (size_t)(BK * 2);
    const size_t hstep = (size_t)HALF * K * 2;
    const size_t tstep = 2 * hstep;
    const unsigned ldsw = (unsigned)wid * 1024u;
    const int aoff = lds_byte(wr * 64 + fr, fq * 8), boff = lds_byte(wc * 32 + fr, fq * 8);
#define PG8_SA(b, h) (((b) * 2 + (h)) * HTB)
#define PG8_SB(b, h) ((4 + (b) * 2 + (h)) * HTB)
#define PG8_STAGE(bufoff, gbase, voff) do { _Pragma("unroll") for (int _i = 0; _i < 2; ++_i) \
        __builtin_amdgcn_global_load_lds((const unsigned*)((const char*)(gbase) + (voff)[_i]), (PG8_LAS unsigned*)(lds + (bufoff) + ldsw + _i * 8192), 16, 0, 0); } while (0)
#define PG8_LDA(dst, b, h) do { _Pragma("unroll") for (int m = 0; m < 4; ++m) _Pragma("unroll") for (int k = 0; k < 2; ++k) dst[m][k] = *(const PG8_LAS bf16x8*)(lds + PG8_SA(b, h) + aoff + m * 2048 + k * 1024); } while (0)
#define PG8_LDB(dst, b, h) do { _Pragma("unroll") for (int n = 0; n < 2; ++n) _Pragma("unroll") for (int k = 0; k < 2; ++k) dst[n][k] = *(const PG8_LAS bf16x8*)(lds + PG8_SB(b, h) + boff + n * 2048 + k * 1024); } while (0)
#define PG8_MMA(ai, bj, At, Bt) do { __builtin_amdgcn_s_setprio(1); _Pragma("unroll") for (int m = 0; m < 4; ++m) _Pragma("unroll") for (int n = 0; n < 2; ++n) _Pragma("unroll") for (int k = 0; k < 2; ++k) \
        acc[ai][bj][m][n] = __builtin_amdgcn_mfma_f32_16x16x32_bf16(Bt[n][k], At[m][k], acc[ai][bj][m][n], 0, 0, 0); __builtin_amdgcn_s_setprio(0); } while (0)
#define PG8_WAIT_V(n) asm volatile("s_waitcnt vmcnt(" #n ")" ::: "memory")
#define PG8_WAIT_L(n) asm volatile("s_waitcnt lgkmcnt(" #n ")" ::: "memory")
#define PG8_BAR __builtin_amdgcn_s_barrier()
#define PG8_SCHED __builtin_amdgcn_sched_barrier(0)
    Unit cur, nxt; int ui = 0;
    if (!S.next(0, cur)) return;
    f32x4 acc[2][2][4][2];
#pragma unroll
    for (int a = 0; a < 2; ++a)
#pragma unroll
        for (int b = 0; b < 2; ++b)
#pragma unroll
            for (int m = 0; m < 4; ++m)
#pragma unroll
                for (int n = 0; n < 2; ++n) acc[a][b][m][n] = (f32x4){0.f, 0.f, 0.f, 0.f};
    bf16x8 At[4][2], B0[2][2], B1[2][2];
    const char* cA = (const char*)g.A + (size_t)cur.pm * tstep; const char* cB = (const char*)g.Bt + (size_t)cur.pn * tstep;
    S.a_ready(cur);
    if constexpr (SP2) {
        PG8_STAGE(PG8_SB(0, 0), cB, voffB); PG8_STAGE(PG8_SB(0, 1), cB + hstep, voffB); PG8_STAGE(PG8_SA(0, 0), cA, voffA); PG8_STAGE(PG8_SA(0, 1), cA + hstep, voffA);
        if (wr == 1) PG8_BAR;
        PG8_WAIT_V(2); PG8_BAR;
        PG8_STAGE(PG8_SB(1, 0), cB + kstep, voffB); PG8_STAGE(PG8_SA(1, 0), cA + kstep, voffA); PG8_STAGE(PG8_SB(1, 1), cB + hstep + kstep, voffB);
        PG8_WAIT_V(6); PG8_BAR;
    } else {
        PG8_STAGE(PG8_SB(0, 0), cB, voffB); PG8_STAGE(PG8_SA(0, 0), cA, voffA); PG8_STAGE(PG8_SB(0, 1), cB + hstep, voffB); PG8_STAGE(PG8_SA(0, 1), cA + hstep, voffA);
        if (wr == 1) PG8_BAR;
        PG8_WAIT_V(4); PG8_BAR;
        PG8_STAGE(PG8_SB(1, 0), cB + kstep, voffB); PG8_STAGE(PG8_SA(1, 0), cA + kstep, voffA); PG8_STAGE(PG8_SB(1, 1), cB + hstep + kstep, voffB);
        PG8_WAIT_V(6); PG8_BAR;
    }
    for (;;) {
        const bool has_next = S.next(ui + 1, nxt);
        const char* nA = has_next ? (const char*)g.A + (size_t)nxt.pm * tstep : cA; const char* nB = has_next ? (const char*)g.Bt + (size_t)nxt.pn * tstep : cB;
        for (int t = 0; t < nt; t += 2) {
            const bool last = (t == nt - 2);
            const char* a1 = cA + (size_t)(t + 1) * kstep;
            const char* a2 = last ? nA : cA + (size_t)(t + 2) * kstep; const char* b2 = last ? nB : cB + (size_t)(t + 2) * kstep;
            const char* a3 = a2 + kstep; const char* b3 = b2 + kstep;
            if (last && has_next) S.a_ready(nxt);
            if constexpr (SP2) {
            PG8_LDB(B0, 0, 0); PG8_LDB(B1, 0, 1); PG8_SCHED; PG8_LDA(At, 0, 0); PG8_STAGE(PG8_SA(1, 1), a1 + hstep, voffA);
            PG8_WAIT_V(8); PG8_WAIT_L(0); PG8_BAR; PG8_MMA(0, 0, At, B0); PG8_MMA(0, 1, At, B1); PG8_BAR; PG8_SCHED;
            PG8_LDA(At, 0, 1); PG8_STAGE(PG8_SB(0, 0), b2, voffB); PG8_STAGE(PG8_SB(0, 1), b2 + hstep, voffB); PG8_STAGE(PG8_SA(0, 0), a2, voffA);
            PG8_WAIT_V(8); PG8_WAIT_L(0); PG8_BAR; PG8_MMA(1, 0, At, B0); PG8_MMA(1, 1, At, B1); PG8_BAR; PG8_SCHED;
            PG8_LDB(B0, 1, 0); PG8_LDB(B1, 1, 1); PG8_SCHED; PG8_LDA(At, 1, 0); PG8_STAGE(PG8_SA(0, 1), a2 + hstep, voffA);
            PG8_WAIT_V(8); PG8_WAIT_L(0); PG8_BAR; PG8_MMA(0, 0, At, B0); PG8_MMA(0, 1, At, B1); PG8_BAR; PG8_SCHED;
            PG8_LDA(At, 1, 1); PG8_STAGE(PG8_SB(1, 0), b3, voffB); PG8_STAGE(PG8_SB(1, 1), b3 + hstep, voffB); PG8_STAGE(PG8_SA(1, 0), a3, voffA);
            PG8_WAIT_V(8); PG8_WAIT_L(0); PG8_BAR; PG8_MMA(1, 0, At, B0); PG8_MMA(1, 1, At, B1); PG8_BAR; PG8_SCHED;
            } else {
            PG8_LDB(B0, 0, 0); PG8_SCHED; PG8_LDA(At, 0, 0); PG8_STAGE(PG8_SA(1, 1), a1 + hstep, voffA);
            PG8_WAIT_L(8); PG8_BAR; PG8_WAIT_L(0); PG8_MMA(0, 0, At, B0); PG8_BAR; PG8_SCHED;
            PG8_LDB(B1, 0, 1); PG8_STAGE(PG8_SB(0, 0), b2, voffB);
            PG8_BAR; PG8_WAIT_L(0); PG8_MMA(0, 1, At, B1); PG8_BAR;
            PG8_LDA(At, 0, 1); PG8_STAGE(PG8_SA(0, 0), a2, voffA);
            PG8_BAR; PG8_WAIT_L(0); PG8_MMA(1, 0, At, B0); PG8_BAR; PG8_SCHED;
            PG8_STAGE(PG8_SB(0, 1), b2 + hstep, voffB);
            PG8_WAIT_V(6); PG8_BAR; PG8_MMA(1, 1, At, B1); PG8_BAR;
            PG8_LDB(B0, 1, 0); PG8_SCHED; PG8_LDA(At, 1, 0); PG8_STAGE(PG8_SA(0, 1), a2 + hstep, voffA);
            PG8_WAIT_L(8); PG8_BAR; PG8_WAIT_L(0); PG8_MMA(0, 0, At, B0); PG8_BAR; PG8_SCHED;
            PG8_LDB(B1, 1, 1); PG8_STAGE(PG8_SB(1, 0), b3, voffB);
            PG8_BAR; PG8_WAIT_L(0); PG8_MMA(0, 1, At, B1); PG8_BAR;
            PG8_LDA(At, 1, 1); PG8_STAGE(PG8_SA(1, 0), a3, voffA);
            PG8_BAR; PG8_WAIT_L(0); PG8_MMA(1, 0, At, B0); PG8_BAR; PG8_SCHED;
            PG8_STAGE(PG8_SB(1, 1), b3 + hstep, voffB);
            PG8_WAIT_V(6); PG8_BAR; PG8_MMA(1, 1, At, B1); PG8_BAR;
            }
        }
        if constexpr (ALIGN_EPI) { if (wr == 0) PG8_BAR; }
        if constexpr (!Epi::AFTER_DRAIN) { E(acc, cur, wr, wc, fr, fq); S.done(cur); }
        if (!has_next) break;
#pragma unroll
        for (int a = 0; a < 2; ++a)
#pragma unroll
            for (int b = 0; b < 2; ++b)
#pragma unroll
                for (int m = 0; m < 4; ++m)
#pragma unroll
                    for (int n = 0; n < 2; ++n) acc[a][b][m][n] = (f32x4){0.f, 0.f, 0.f, 0.f};
        cur = nxt; cA = nA; cB = nB; ++ui;
        if constexpr (ALIGN_EPI) { if (wr == 1) PG8_BAR; }
    }
    PG8_WAIT_V(0);
    if constexpr (!ALIGN_EPI) { if (wr == 0) PG8_BAR; }
    PG8_BAR;
    if constexpr (Epi::AFTER_DRAIN) { E.fused(acc, cur, wr, wc, fr, fq, lds, wid, lane); S.done(cur); }
#undef PG8_SA
#undef PG8_SB
#undef PG8_STAGE
#undef PG8_LDA
#undef PG8_LDB
#undef PG8_MMA
#undef PG8_WAIT_V
#undef PG8_WAIT_L
#undef PG8_BAR
#undef PG8_SCHED
}
}
#define GAS __attribute__((address_space(1)))
#define LAS __attribute__((address_space(3)))
typedef unsigned short bf16;
typedef unsigned v4u __attribute__((ext_vector_type(4)));
typedef float f32x4 __attribute__((ext_vector_type(4)));
typedef short bf16x8 __attribute__((ext_vector_type(8)));
typedef GAS unsigned gu32;
typedef GAS unsigned long long gu64;
#define RLX_AGENT __ATOMIC_RELAXED, __HIP_MEMORY_SCOPE_AGENT
#define LDS_WAIT() asm volatile("s_waitcnt lgkmcnt(0)" ::: "memory")
#define VM_WAIT() asm volatile("s_waitcnt vmcnt(0)" ::: "memory")
__device__ __forceinline__ unsigned long long rt() { return __builtin_amdgcn_s_memrealtime(); }
__device__ __forceinline__ unsigned f2bf(float f) { unsigned u = __builtin_bit_cast(unsigned, f); return (u + 0x7fffu + ((u >> 16) & 1u)) >> 16; }
__device__ __forceinline__ unsigned pk2(float lo, float hi) { return f2bf(lo) | (f2bf(hi) << 16); }

#define XB_TMO      128
#define XB_XCNT(j)  (256  + 64 * (j))
#define XB_XSUB(j)  (1280 + 64 * (j))
#define XB_XGEN(j)  (2304 + 64 * (j))
#define XB_TOP      3328
#define XB_TOPGEN   3392
#define XCD_BAR_WORDS 3456
#define XB_SPIN_CAP (1u << 18)

__device__ __forceinline__ unsigned xb_ld(unsigned* p)              { return __hip_atomic_load(p, __ATOMIC_RELAXED, __HIP_MEMORY_SCOPE_AGENT); }
__device__ __forceinline__ unsigned xb_add(unsigned* p, unsigned v) { return __hip_atomic_fetch_add(p, v, __ATOMIC_RELAXED, __HIP_MEMORY_SCOPE_AGENT); }
__device__ __forceinline__ unsigned xb_xcc_id() { return (unsigned)__builtin_amdgcn_s_getreg((3 << 11) | 20) & 0xFu; }
#define XB_SPIN(cond, bar) do { unsigned _sp = 0; while (cond) { __builtin_amdgcn_s_sleep(1); \
    if ((++_sp & 255u) == 0u) { if (xb_ld(&(bar)[XB_TMO])) break; if (_sp > XB_SPIN_CAP) { atomicAdd(&(bar)[XB_TMO], 1u); break; } } } } while (0)

struct XcdBarrier {
    unsigned* bar; unsigned x;
    volatile LAS unsigned* st;
};

__device__ __forceinline__ XcdBarrier xcd_barrier_post(unsigned* bar, volatile LAS unsigned* st) {
    XcdBarrier b; b.bar = bar; b.x = xb_xcc_id(); b.st = st;
    if (threadIdx.x == 0) (void)xb_add(&bar[XB_XCNT(b.x)], 1u);
    return b;
}
__device__ __forceinline__ void xcd_barrier_complete(unsigned* bar, unsigned x, unsigned& nloc, unsigned& nx) {
    const unsigned G = gridDim.x * gridDim.y * gridDim.z;
    unsigned sum, cnt, mine, sp = 0u;
    for (;;) {
        sum = 0u; cnt = 0u; mine = 0u;
#pragma unroll
        for (unsigned j = 0; j < 16; ++j) { const unsigned c = xb_ld(&bar[XB_XCNT(j)]); sum += c; cnt += (c > 0u) ? 1u : 0u; mine = (j == x) ? c : mine; }
        if (sum == G) break;
        __builtin_amdgcn_s_sleep(1);
        if ((++sp & 255u) == 0u) { if (xb_ld(&bar[XB_TMO])) break; if (sp > XB_SPIN_CAP) { atomicAdd(&bar[XB_TMO], 1u); break; } }
    }
    nloc = mine > 0u ? mine : 1u; nx = cnt > 0u ? cnt : 1u;
}

__device__ __forceinline__ void xcd_barrier(const XcdBarrier& b) {
    asm volatile("s_waitcnt vmcnt(0)" ::: "memory");
    __syncthreads();
    if (threadIdx.x == 0) {
        unsigned* bar = b.bar;
        __builtin_amdgcn_s_waitcnt(0);
        unsigned nloc = b.st[0], nx = b.st[1];
        if (nloc == 0u) { xcd_barrier_complete(bar, b.x, nloc, nx); b.st[0] = nloc; b.st[1] = nx; }
        const unsigned old = xb_add(&bar[XB_XSUB(b.x)], 1u);
        const unsigned gen = old / nloc;
        if (old + 1u == (gen + 1u) * nloc) {
            __builtin_amdgcn_fence(__ATOMIC_RELEASE, "agent");
            asm volatile("s_waitcnt vmcnt(0)" ::: "memory");
            const unsigned og = xb_add(&bar[XB_TOP], 1u);
            const unsigned tg = og / nx;
            if (og + 1u == (tg + 1u) * nx) xb_add(&bar[XB_TOPGEN], 1u);
            else XB_SPIN(xb_ld(&bar[XB_TOPGEN]) == tg, bar);
            __builtin_amdgcn_fence(__ATOMIC_ACQUIRE, "agent");
            xb_add(&bar[XB_XGEN(b.x)], 1u);
            asm volatile("s_waitcnt vmcnt(0)" ::: "memory");
        } else {
            XB_SPIN(xb_ld(&bar[XB_XGEN(b.x)]) == gen, bar);
            __builtin_amdgcn_fence(__ATOMIC_ACQUIRE, "agent");
            asm volatile("s_waitcnt vmcnt(0)" ::: "memory");
        }
    }
    __syncthreads();
}
constexpr int NWAVES = 8, NTHREADS = 512;
constexpr int DM = 1024, SEQ = 8192, NPROMPT = 2, NSAMP = 128, TSAMP = 8, NMETA = 16;
constexpr int ROW_S = NPROMPT * SEQ;
constexpr int ROW_M = ROW_S + NSAMP * TSAMP;
constexpr int NROWS = ROW_M + NMETA;
constexpr int MP = 17664;
constexpr int DINNER = 2048, NHEADS = 32, HD = 64, NGROUPS = 8, DSTATE = 128, CONVD = 4096, INPROJ = 6176, INPROJ_P = 6400, ZXW = 6144;
constexpr int DFF = 4096, NKV = 4, NQ = 16, KVW = 512;
constexpr float EPS = 1e-5f;
constexpr int LDX = 136;

constexpr size_t O_YP = 0, O_YS = O_YP + (size_t)NPROMPT * SEQ * DM, O_PCONV = O_YS + (size_t)NSAMP * TSAMP * DM, O_PSSM = O_PCONV + 2 * 2 * 3 * 4096,
    O_PCK = O_PSSM + (size_t)2 * 2 * 32 * 64 * 128, O_PCV = O_PCK + 2 * 128 * 256, O_SCONV = O_PCV + 2 * 128 * 256, O_SSSM = O_SCONV + (size_t)2 * 128 * 3 * 4096,
    O_SCK = O_SSSM + (size_t)2 * 128 * 32 * 64 * 128, O_SCV = O_SCK + (size_t)128 * 128 * 256, O_END = O_SCV + (size_t)128 * 128 * 256;

constexpr size_t MiB = 1u << 20;
constexpr size_t WS_CTL = 0, CTL_ZERO_BYTES = 1 * MiB;
constexpr size_t SZ_WIN = (size_t)INPROJ_P * 1024 * 2, SZ_WOUT = (size_t)1024 * 2048 * 2, SZ_WUP = (size_t)4096 * 1024 * 2, SZ_WDN = SZ_WUP, SZ_WQKV0 = (size_t)1536 * 1024 * 2, SZ_WQ1 = (size_t)1024 * 1024 * 2, SZ_WO = SZ_WQ1;
constexpr size_t WS_WIN = 1 * MiB, WS_WOUT = WS_WIN + 2 * SZ_WIN, WS_WUP = WS_WOUT + 2 * SZ_WOUT, WS_WDN = WS_WUP + 4 * SZ_WUP, WS_WQKV0 = WS_WDN + 4 * SZ_WDN, WS_WQ1 = WS_WQKV0 + SZ_WQKV0, WS_WO = WS_WQ1 + SZ_WQ1, WS_WEND = WS_WO + 2 * SZ_WO;
constexpr size_t al1m(size_t x) { return (x + MiB - 1) / MiB * MiB; }
constexpr size_t WS_H = al1m(WS_WEND), WS_HN = al1m(WS_H + (size_t)MP * 1024 * 4), WS_ZX = al1m(WS_HN + (size_t)MP * 1024 * 2), WS_DT = al1m(WS_ZX + (size_t)MP * ZXW * 2),
    WS_XC = al1m(WS_DT + (size_t)MP * 32 * 4), WS_YN = al1m(WS_XC + (size_t)MP * 4096 * 2), WS_CS = al1m(WS_YN + (size_t)MP * 2048 * 2), WS_CD = al1m(WS_CS + (size_t)129 * 32 * 8192 * 4), WS_END = al1m(WS_CD + 129 * 32 * 4);
constexpr size_t WS_U = WS_ZX;
constexpr size_t WS_Q = WS_XC, WS_KV = WS_Q + (size_t)MP * 1024 * 2, WS_AO = WS_KV + (size_t)MP * 512 * 2;
static_assert(WS_AO + (size_t)MP * 1024 * 2 <= WS_YN, "attention overlay");
constexpr int CW_BAR = 4096;

constexpr int RING_BYTES = 131072, LDSCTL_OFF = RING_BYTES, MISC_OFF = LDSCTL_OFF + 320, LDS_BYTES = 147456;

typedef unsigned u32x2 __attribute__((ext_vector_type(2)));
typedef unsigned u32x4 __attribute__((ext_vector_type(4)));
__device__ __forceinline__ int ltid() { int t = threadIdx.x; asm volatile("" : "+v"(t)); return t; }
__device__ __forceinline__ float bf2f(unsigned short b) { return __uint_as_float((unsigned)b << 16); }
__device__ __forceinline__ float bflo(unsigned w) { return __uint_as_float(w << 16); }
__device__ __forceinline__ float bfhi(unsigned w) { return __uint_as_float(w & 0xffff0000u); }
__device__ __forceinline__ unsigned pkbf(float lo, float hi) { return pg8::cvt_pk_bf16(lo, hi); }
__device__ __forceinline__ float wave_sum(float v) {
#pragma unroll
    for (int o = 1; o < 64; o <<= 1) v += __shfl_xor(v, o);
    return v;
}
__device__ __forceinline__ float sigmoid_f(float x) { return 1.f / (1.f + __expf(-x)); }
#define MFMA16(b, a, c) __builtin_amdgcn_mfma_f32_16x16x32_bf16((b), (a), (c), 0, 0, 0)

struct Args {
    const float* in[26]; float* out; unsigned char* ws; int ph_lo, ph_hi;
};
typedef const __attribute__((address_space(4))) Args* ArgsP;
enum { I_XP = 0, I_XS, I_SCONV, I_SSSM, I_CK, I_CV, I_META, I_ANORM, I_AIN, I_ACONVW, I_ACONVB, I_ADTB, I_ALOG, I_ADSKIP, I_AGATE, I_AOUT, I_KVNORM, I_WKV, I_BNORM, I_WQ, I_SINKS, I_WO, I_MLPNORM, I_WUP, I_WDOWN, I_FNORM };

__device__ __forceinline__ void transpose_item(const float* W, const float* scale, int K, int N, bf16* WT, int row_off, LAS float* scr, int item, int lane) {
    const int nblk = N / 32, kb = item / nblk, nb = item % nblk, k0 = 64 * kb, n0 = 32 * nb;
#pragma unroll 8
    for (int i = 0; i < 32; ++i) { const int kk = 2 * i + (lane >> 5); float v = W[(size_t)(k0 + kk) * N + n0 + (lane & 31)]; if (scale) v *= scale[k0 + kk]; scr[kk * 33 + (lane & 31)] = v; }
    LDS_WAIT(); asm volatile("" ::: "memory");
    const int c = lane & 7;
#pragma unroll
    for (int j = 0; j < 4; ++j) { const int n = (lane >> 3) + 8 * j; const LAS float* s = scr + (8 * c) * 33 + n;
        v4u o; o.x = pk2(s[0 * 33], s[1 * 33]); o.y = pk2(s[2 * 33], s[3 * 33]); o.z = pk2(s[4 * 33], s[5 * 33]); o.w = pk2(s[6 * 33], s[7 * 33]);
        *(GAS v4u*)(WT + (size_t)(row_off + n0 + n) * K + k0 + 8 * c) = o; }
    LDS_WAIT(); asm volatile("" ::: "memory");
}
struct WJob { const float* W; const float* scale; int K, N; bf16* WT; int row_off; int items; };

__device__ __forceinline__ void phase_prologue(ArgsP a, LAS unsigned char* lds, int wave, int lane) {
    LAS float* scr = (LAS float*)(lds + wave * 16384);
    const int gw = blockIdx.x * NWAVES + wave, NGW = gridDim.x * NWAVES;
    unsigned char* ws = a->ws;
    for (int jb = 0; jb < 21; ++jb) {
        WJob J;
        if (jb < 2)       { const int i = jb;      J = WJob{a->in[I_AIN] + (size_t)i * 1024 * INPROJ, a->in[I_ANORM] + i * 1024, 1024, INPROJ, (bf16*)(ws + WS_WIN + i * SZ_WIN), 0, 0}; }
        else if (jb < 4)  { const int i = jb - 2;  J = WJob{a->in[I_AOUT] + (size_t)i * 2048 * 1024, a->in[I_AGATE] + i * 2048, 2048, 1024, (bf16*)(ws + WS_WOUT + i * SZ_WOUT), 0, 0}; }
        else if (jb < 8)  { const int l = jb - 4;  J = WJob{a->in[I_WUP] + (size_t)l * 1024 * 4096, a->in[I_MLPNORM] + l * 1024, 1024, 4096, (bf16*)(ws + WS_WUP + l * SZ_WUP), 0, 0}; }
        else if (jb < 12) { const int l = jb - 8;  J = WJob{a->in[I_WDOWN] + (size_t)l * 4096 * 1024, nullptr, 4096, 1024, (bf16*)(ws + WS_WDN + l * SZ_WDN), 0, 0}; }
        else if (jb == 12) { J = WJob{a->in[I_WQ], a->in[I_BNORM], 1024, 1024, (bf16*)(ws + WS_WQKV0), 0, 0}; }
        else if (jb == 13) { J = WJob{a->in[I_WKV], a->in[I_KVNORM], 1024, 512, (bf16*)(ws + WS_WQKV0), 1024, 0}; }
        else if (jb == 14) { J = WJob{a->in[I_WQ] + (size_t)1024 * 1024, a->in[I_BNORM] + 1024, 1024, 1024, (bf16*)(ws + WS_WQ1), 0, 0}; }
        else if (jb < 17) { const int j = jb - 15; J = WJob{a->in[I_WO] + (size_t)j * 1024 * 1024, nullptr, 1024, 1024, (bf16*)(ws + WS_WO + j * SZ_WO), 0, 0}; }
        else break;
        const int items = (J.K / 64) * (J.N / 32);
        for (int it = gw; it < items; it += NGW) transpose_item(J.W, J.scale, J.K, J.N, J.WT, J.row_off, scr, it, lane);
    }
    {
        const int gt = blockIdx.x * NTHREADS + ltid(), NT = gridDim.x * NTHREADS;
        const int per = (INPROJ_P - INPROJ) * 1024 * 2 / 16;
        for (int e = gt; e < 2 * per; e += NT) { const int i = e / per, c = e % per;
            *(v4u*)(ws + WS_WIN + i * SZ_WIN + (size_t)INPROJ * 1024 * 2 + (size_t)c * 16) = (v4u){0u, 0u, 0u, 0u}; }
    }
}

__device__ __forceinline__ void phase_norm(ArgsP a, int from_inputs, int wave, int lane) {
    float* H = (float*)(a->ws + WS_H); bf16* HN = (bf16*)(a->ws + WS_HN);
    const int gw = blockIdx.x * NWAVES + wave, NGW = gridDim.x * NWAVES;
    for (int m = gw; m < MP; m += NGW) {
        unsigned long long* o8 = (unsigned long long*)(HN + (size_t)m * DM) + lane;
        if (m >= NROWS) {
#pragma unroll
            for (int j = 0; j < 4; ++j) o8[64 * j] = 0ull;
            continue;
        }
        const float* src;
        if (from_inputs) src = (m < ROW_S) ? a->in[I_XP] + (size_t)m * DM : (m < ROW_M) ? a->in[I_XS] + (size_t)(m - ROW_S) * DM : a->in[I_META] + (size_t)(m - ROW_M) * DM;
        else src = H + (size_t)m * DM;
        const f32x4* xr = (const f32x4*)src + lane;
        f32x4 v[4]; float s = 0.f;
#pragma unroll
        for (int j = 0; j < 4; ++j) { v[j] = xr[64 * j]; s += (v[j].x * v[j].x + v[j].y * v[j].y) + (v[j].z * v[j].z + v[j].w * v[j].w); }
        const float rs = rsqrtf(wave_sum(s) * (1.f / DM) + EPS);
        if (from_inputs) { f32x4* hr = (f32x4*)(H + (size_t)m * DM) + lane;
#pragma unroll
            for (int j = 0; j < 4; ++j) hr[64 * j] = v[j]; }
#pragma unroll
        for (int j = 0; j < 4; ++j) o8[64 * j] = (unsigned long long)pkbf(v[j].x * rs, v[j].y * rs) | ((unsigned long long)pkbf(v[j].z * rs, v[j].w * rs) << 32);
    }
}
__device__ __forceinline__ void phase_final(ArgsP a, int wave, int lane) {
    const float* H = (const float*)(a->ws + WS_H); const float* fw = a->in[I_FNORM];
    const int gw = blockIdx.x * NWAVES + wave, NGW = gridDim.x * NWAVES;
    f32x4 w[4];
#pragma unroll
    for (int j = 0; j < 4; ++j) w[j] = ((const f32x4*)fw)[lane + 64 * j];
    for (int m = gw; m < ROW_M; m += NGW) {
        const f32x4* xr = (const f32x4*)(H + (size_t)m * DM) + lane;
        f32x4 v[4]; float s = 0.f;
#pragma unroll
        for (int j = 0; j < 4; ++j) { v[j] = xr[64 * j]; s += (v[j].x * v[j].x + v[j].y * v[j].y) + (v[j].z * v[j].z + v[j].w * v[j].w); }
        const float rs = rsqrtf(wave_sum(s) * (1.f / DM) + EPS);
        f32x4* o = (f32x4*)(a->out + O_YP + (size_t)m * DM) + lane;
#pragma unroll
        for (int j = 0; j < 4; ++j) o[64 * j] = v[j] * rs * w[j];
    }
}

__device__ __forceinline__ void unpack8(const u32x4 w, float (&f)[8]) { f[0] = bflo(w.x); f[1] = bfhi(w.x); f[2] = bflo(w.y); f[3] = bfhi(w.y); f[4] = bflo(w.z); f[5] = bfhi(w.z); f[6] = bflo(w.w); f[7] = bfhi(w.w); }
__device__ __forceinline__ void phase_conv(ArgsP a, int li) {
    const bf16* ZX = (const bf16*)(a->ws + WS_ZX); bf16* XC = (bf16*)(a->ws + WS_XC);
    const float* cw = a->in[I_ACONVW] + (size_t)li * 4 * CONVD; const float* cb = a->in[I_ACONVB] + (size_t)li * CONVD;
    const float* sconv = a->in[I_SCONV] + (size_t)li * NSAMP * 3 * CONVD;
    constexpr int NRUNS = 2048 + 128 + 2;
    const int gt = blockIdx.x * NTHREADS + ltid(), NT = gridDim.x * NTHREADS;
    for (int item = gt; item < NRUNS * 512; item += NT) {
        const int run = item >> 9, c0 = (item & 511) * 8;
        int R0, kind, b = 0; bool last = false;
        if (run < 2048) { kind = 0; b = run >> 10; const int t0 = (run & 1023) * 8; R0 = b * SEQ + t0; last = (t0 == SEQ - 8); }
        else if (run < 2176) { kind = 1; b = run - 2048; R0 = ROW_S + b * 8; last = true; }
        else { kind = 2; R0 = ROW_M + (run - 2176) * 8; }
        float w0[8], w1[8], w2[8], w3[8], bs[8];
        { const f32x4* p = (const f32x4*)(cw + c0); f32x4 x0 = p[0], x1 = p[1]; w0[0]=x0.x;w0[1]=x0.y;w0[2]=x0.z;w0[3]=x0.w;w0[4]=x1.x;w0[5]=x1.y;w0[6]=x1.z;w0[7]=x1.w; }
        { const f32x4* p = (const f32x4*)(cw + CONVD + c0); f32x4 x0 = p[0], x1 = p[1]; w1[0]=x0.x;w1[1]=x0.y;w1[2]=x0.z;w1[3]=x0.w;w1[4]=x1.x;w1[5]=x1.y;w1[6]=x1.z;w1[7]=x1.w; }
        { const f32x4* p = (const f32x4*)(cw + 2 * CONVD + c0); f32x4 x0 = p[0], x1 = p[1]; w2[0]=x0.x;w2[1]=x0.y;w2[2]=x0.z;w2[3]=x0.w;w2[4]=x1.x;w2[5]=x1.y;w2[6]=x1.z;w2[7]=x1.w; }
        { const f32x4* p = (const f32x4*)(cw + 3 * CONVD + c0); f32x4 x0 = p[0], x1 = p[1]; w3[0]=x0.x;w3[1]=x0.y;w3[2]=x0.z;w3[3]=x0.w;w3[4]=x1.x;w3[5]=x1.y;w3[6]=x1.z;w3[7]=x1.w; }
        { const f32x4* p = (const f32x4*)(cb + c0); f32x4 x0 = p[0], x1 = p[1]; bs[0]=x0.x;bs[1]=x0.y;bs[2]=x0.z;bs[3]=x0.w;bs[4]=x1.x;bs[5]=x1.y;bs[6]=x1.z;bs[7]=x1.w; }
        float p0[8], p1[8], p2[8];
        const bool first = (kind == 0) ? ((run & 1023) == 0) : (kind == 1) ? true : (run == 2176);
        if (!first) {
            unpack8(*(const u32x4*)(ZX + (size_t)(R0 - 3) * ZXW + 2048 + c0), p0);
            unpack8(*(const u32x4*)(ZX + (size_t)(R0 - 2) * ZXW + 2048 + c0), p1);
            unpack8(*(const u32x4*)(ZX + (size_t)(R0 - 1) * ZXW + 2048 + c0), p2);
        } else if (kind == 0) {
            unpack8(*(const u32x4*)(ZX + (size_t)(ROW_M + 13) * ZXW + 2048 + c0), p0);
            unpack8(*(const u32x4*)(ZX + (size_t)(ROW_M + 14) * ZXW + 2048 + c0), p1);
            unpack8(*(const u32x4*)(ZX + (size_t)(ROW_M + 15) * ZXW + 2048 + c0), p2);
        } else if (kind == 1) {
            const float* s = sconv + (size_t)b * 3 * CONVD + c0;
            { f32x4 x0 = *(const f32x4*)(s), x1 = *(const f32x4*)(s + 4); p0[0]=x0.x;p0[1]=x0.y;p0[2]=x0.z;p0[3]=x0.w;p0[4]=x1.x;p0[5]=x1.y;p0[6]=x1.z;p0[7]=x1.w; }
            { f32x4 x0 = *(const f32x4*)(s + CONVD), x1 = *(const f32x4*)(s + CONVD + 4); p1[0]=x0.x;p1[1]=x0.y;p1[2]=x0.z;p1[3]=x0.w;p1[4]=x1.x;p1[5]=x1.y;p1[6]=x1.z;p1[7]=x1.w; }
            { f32x4 x0 = *(const f32x4*)(s + 2 * CONVD), x1 = *(const f32x4*)(s + 2 * CONVD + 4); p2[0]=x0.x;p2[1]=x0.y;p2[2]=x0.z;p2[3]=x0.w;p2[4]=x1.x;p2[5]=x1.y;p2[6]=x1.z;p2[7]=x1.w; }
        } else {
#pragma unroll
            for (int j = 0; j < 8; ++j) { p0[j] = 0.f; p1[j] = 0.f; p2[j] = 0.f; }
        }
#pragma unroll
        for (int t = 0; t < 8; ++t) {
            float x[8]; unpack8(*(const u32x4*)(ZX + (size_t)(R0 + t) * ZXW + 2048 + c0), x);
            float o[8];
#pragma unroll
            for (int j = 0; j < 8; ++j) { const float v = bs[j] + w0[j] * p0[j] + w1[j] * p1[j] + w2[j] * p2[j] + w3[j] * x[j]; o[j] = v * sigmoid_f(v); }
            u32x4 w; w.x = pkbf(o[0], o[1]); w.y = pkbf(o[2], o[3]); w.z = pkbf(o[4], o[5]); w.w = pkbf(o[6], o[7]);
            *(u32x4*)(XC + (size_t)(R0 + t) * CONVD + c0) = w;
            if (last && t >= 5 && kind != 2) {
                float* dst = (kind == 0) ? a->out + O_PCONV + ((size_t)(li * NPROMPT + b) * 3 + (t - 5)) * CONVD + c0 : a->out + O_SCONV + ((size_t)(li * NSAMP + b) * 3 + (t - 5)) * CONVD + c0;
                *(f32x4*)(dst) = (f32x4){x[0], x[1], x[2], x[3]}; *(f32x4*)(dst + 4) = (f32x4){x[4], x[5], x[6], x[7]};
            }
#pragma unroll
            for (int j = 0; j < 8; ++j) { p0[j] = p1[j]; p1[j] = p2[j]; p2[j] = x[j]; }
        }
    }
}

__device__ __forceinline__ void ssd_acs(const float* DT, const float* alog, int R0, int len, int h0, float* s_dt, float* s_acs, int wave, int lane) {
    if (wave < 4) {
        const int r = wave; const float An = -__expf(alog[h0 + r]);
        const int l0 = 2 * lane;
        const float d0 = (l0 < len) ? DT[(size_t)(R0 + l0) * 32 + h0 + r] : 0.f;
        const float d1 = (l0 + 1 < len) ? DT[(size_t)(R0 + l0 + 1) * 32 + h0 + r] : 0.f;
        const float a0 = d0 * An, a1 = d1 * An, s = a0 + a1;
        float incl = s;
#pragma unroll
        for (int o = 1; o < 64; o <<= 1) { const float t = __shfl_up(incl, o); if (lane >= o) incl += t; }
        const float excl = incl - s;
        s_dt[r * 128 + l0] = d0; s_dt[r * 128 + l0 + 1] = d1;
        s_acs[r * 128 + l0] = excl + a0; s_acs[r * 128 + l0 + 1] = excl + s;
    }
}
#define LFRAG(base, row, ld, ks) (*(const bf16x8*)((base) + (row) * (ld) + 32 * (ks) + 8 * fq))

__device__ __forceinline__ void ssd1_unit(ArgsP a, int li, unsigned char* lds, int slot, int g, int R0, int len, int, int, int) {
    const int tid = ltid(), lane = tid & 63, wave = __builtin_amdgcn_readfirstlane(tid >> 6);
    const bf16* XC = (const bf16*)(a->ws + WS_XC); const float* DT = (const float*)(a->ws + WS_DT);
    float* CS = (float*)(a->ws + WS_CS); float* CD = (float*)(a->ws + WS_CD);
    bf16* XsT = (bf16*)lds;
    bf16* BT = (bf16*)(lds + 256 * LDX * 2);
    float* s_dt = (float*)(lds + 384 * LDX * 2); float* s_acs = s_dt + 512;
    const int fr = lane & 15, fq = lane >> 4, h0 = g * 4;
    ssd_acs(DT, a->in[I_ALOG] + li * NHEADS, R0, len, h0, s_dt, s_acs, wave, lane);
    __syncthreads();
#pragma unroll
    for (int k = 0; k < 4; ++k) {
        const int item = tid + NTHREADS * k, cb = item & 31, tp = item >> 5, l = 2 * tp, r = cb >> 3;
        u32x4 v0 = (u32x4){0u, 0u, 0u, 0u}, v1 = v0;
        if (l < len) v0 = *(const u32x4*)(XC + (size_t)(R0 + l) * CONVD + g * 256 + cb * 8);
        if (l + 1 < len) v1 = *(const u32x4*)(XC + (size_t)(R0 + l + 1) * CONVD + g * 256 + cb * 8);
        const float tot = s_acs[r * 128 + 127];
        const float w0 = __expf(tot - s_acs[r * 128 + l]) * s_dt[r * 128 + l], w1 = __expf(tot - s_acs[r * 128 + l + 1]) * s_dt[r * 128 + l + 1];
        float x0[8], x1[8]; unpack8(v0, x0); unpack8(v1, x1);
#pragma unroll
        for (int j = 0; j < 8; ++j) *(unsigned*)(XsT + (cb * 8 + j) * LDX + l) = pkbf(x0[j] * w0, x1[j] * w1);
    }
#pragma unroll
    for (int k = 0; k < 2; ++k) {
        const int item = tid + NTHREADS * k, cb = item & 15, tp = item >> 4, l = 2 * tp;
        u32x4 v0 = (u32x4){0u, 0u, 0u, 0u}, v1 = v0;
        if (l < len) v0 = *(const u32x4*)(XC + (size_t)(R0 + l) * CONVD + 2048 + g * 128 + cb * 8);
        if (l + 1 < len) v1 = *(const u32x4*)(XC + (size_t)(R0 + l + 1) * CONVD + 2048 + g * 128 + cb * 8);
        const unsigned a0[4] = {v0.x, v0.y, v0.z, v0.w}, a1[4] = {v1.x, v1.y, v1.z, v1.w};
#pragma unroll
        for (int j = 0; j < 4; ++j) {
            *(unsigned*)(BT + (cb * 8 + 2 * j) * LDX + l) = (a0[j] & 0xffffu) | (a1[j] << 16);
            *(unsigned*)(BT + (cb * 8 + 2 * j + 1) * LDX + l) = (a0[j] >> 16) | (a1[j] & 0xffff0000u);
        }
    }
    __syncthreads();
    f32x4 acc[2][8];
#pragma unroll
    for (int mi = 0; mi < 2; ++mi)
#pragma unroll
        for (int ni = 0; ni < 8; ++ni) acc[mi][ni] = (f32x4){0.f, 0.f, 0.f, 0.f};
#pragma unroll
    for (int ks = 0; ks < 4; ++ks) {
        const bf16x8 a0 = LFRAG(XsT, 32 * wave + fr, LDX, ks), a1 = LFRAG(XsT, 32 * wave + 16 + fr, LDX, ks);
#pragma unroll
        for (int ni = 0; ni < 8; ++ni) { const bf16x8 bb = LFRAG(BT, 16 * ni + fr, LDX, ks); acc[0][ni] = MFMA16(bb, a0, acc[0][ni]); acc[1][ni] = MFMA16(bb, a1, acc[1][ni]); }
    }
#pragma unroll
    for (int mi = 0; mi < 2; ++mi) { const int hp = 32 * wave + 16 * mi + fr, r = hp >> 6, p = hp & 63;
        float* dst = CS + ((size_t)(slot * 32 + h0 + r) * 64 + p) * 128 + 4 * fq;
#pragma unroll
        for (int ni = 0; ni < 8; ++ni) *(f32x4*)(dst + 16 * ni) = acc[mi][ni]; }
    if (tid < 4) CD[slot * 32 + h0 + tid] = __expf(s_acs[tid * 128 + 127]);
    __syncthreads();
}

__device__ __forceinline__ void ssd_sample_unit(ArgsP a, int li, unsigned char* lds, int b, int g, int, int, int) {
    const int tid = ltid(), lane = tid & 63, wave = __builtin_amdgcn_readfirstlane(tid >> 6);
    const bf16* XC = (const bf16*)(a->ws + WS_XC); const bf16* ZX = (const bf16*)(a->ws + WS_ZX); const float* DT = (const float*)(a->ws + WS_DT); bf16* YN = (bf16*)(a->ws + WS_YN);
    float* sX = (float*)lds; float* sB = sX + 8 * 256; float* sC = sB + 8 * 128; float* sY = sC + 8 * 128; float* sDt = sY + 8 * 256;
    const int R0 = ROW_S + b * 8, h0 = g * 4;
    for (int idx = tid; idx < 8 * 512; idx += NTHREADS) { const int t = idx >> 9, c = idx & 511; const bf16* row = XC + (size_t)(R0 + t) * CONVD;
        if (c < 256) sX[t * 256 + c] = bf2f(row[g * 256 + c]); else if (c < 384) sB[t * 128 + c - 256] = bf2f(row[2048 + g * 128 + c - 256]); else sC[t * 128 + c - 384] = bf2f(row[3072 + g * 128 + c - 384]); }
    if (tid < 32) sDt[tid] = DT[(size_t)(R0 + (tid >> 2)) * 32 + h0 + (tid & 3)];
    __syncthreads();
    const int p = tid >> 3, nb = tid & 7;
#pragma unroll 1
    for (int r = 0; r < 4; ++r) {
        const int h = h0 + r;
        const float An = -__expf(a->in[I_ALOG][li * NHEADS + h]), Dk = a->in[I_ADSKIP][li * NHEADS + h];
        const float* sin_ = a->in[I_SSSM] + ((size_t)((li * NSAMP + b) * NHEADS + h) * 64 + p) * 128 + 4 * nb;
        float* sout = a->out + O_SSSM + ((size_t)((li * NSAMP + b) * NHEADS + h) * 64 + p) * 128 + 4 * nb;
        f32x4 st[4];
#pragma unroll
        for (int kk = 0; kk < 4; ++kk) st[kk] = *(const f32x4*)(sin_ + 32 * kk);
#pragma unroll
        for (int t = 0; t < 8; ++t) {
            const float dt = sDt[t * 4 + r], dA = __expf(dt * An), xv = sX[t * 256 + r * 64 + p], coef = dt * xv;
            float part = 0.f;
#pragma unroll
            for (int kk = 0; kk < 4; ++kk) { const f32x4 bv = *(const f32x4*)(sB + t * 128 + 32 * kk + 4 * nb), cv = *(const f32x4*)(sC + t * 128 + 32 * kk + 4 * nb);
                st[kk] = st[kk] * dA + bv * coef; part += (cv.x * st[kk].x + cv.y * st[kk].y) + (cv.z * st[kk].z + cv.w * st[kk].w); }
            part += __shfl_xor(part, 1); part += __shfl_xor(part, 2); part += __shfl_xor(part, 4);
            if (nb == 0) sY[t * 256 + r * 64 + p] = part + Dk * xv;
        }
#pragma unroll
        for (int kk = 0; kk < 4; ++kk) *(f32x4*)(sout + 32 * kk) = st[kk];
    }
    __syncthreads();
    {
        const int t = wave, c4 = lane * 4; const size_t row = (size_t)(R0 + t);
        const f32x4 y = *(const f32x4*)(sY + t * 256 + c4);
        const u32x2 zz = *(const u32x2*)(ZX + row * ZXW + g * 256 + c4);
        const float z0 = bflo(zz.x), z1 = bfhi(zz.x), z2 = bflo(zz.y), z3 = bfhi(zz.y);
        const float g0 = y.x * z0 * sigmoid_f(z0), g1 = y.y * z1 * sigmoid_f(z1), g2 = y.z * z2 * sigmoid_f(z2), g3 = y.w * z3 * sigmoid_f(z3);
        const float ss = wave_sum((g0 * g0 + g1 * g1) + (g2 * g2 + g3 * g3));
        const float rs = rsqrtf(ss * (1.f / 256.f) + EPS);
        u32x2 o; o.x = pkbf(g0 * rs, g1 * rs); o.y = pkbf(g2 * rs, g3 * rs);
        *(u32x2*)(YN + row * DINNER + g * 256 + c4) = o;
    }
    __syncthreads();
}

__device__ __forceinline__ void phase_ssd1(ArgsP a, int li, unsigned char* lds, int tid, int wave, int lane) {
    for (int u = blockIdx.x; u < 1032 + 1024; u += gridDim.x) {
        if (u < 1024) { const int slot = u >> 3, g = u & 7; ssd1_unit(a, li, lds, slot, g, (slot >> 6) * SEQ + (slot & 63) * 128, 128, tid, wave, lane); }
        else if (u < 1032) ssd1_unit(a, li, lds, 128, u - 1024, ROW_M, NMETA, tid, wave, lane);
        else { const int su = u - 1032; ssd_sample_unit(a, li, lds, su >> 3, su & 7, tid, wave, lane); }
    }
}

__device__ __forceinline__ void phase_scan(ArgsP a, int li) {
    float* CS = (float*)(a->ws + WS_CS); const float* CD = (const float*)(a->ws + WS_CD);
    const int gt = blockIdx.x * NTHREADS + ltid(), NT = gridDim.x * NTHREADS;
    for (int e = gt; e < 2 * 65536; e += NT) {
        const int b = e >> 16, rem = e & 65535, h = rem >> 11, pn4 = rem & 2047;
        f32x4 hc = *(const f32x4*)(CS + ((size_t)(128 * 32 + h) * 2048 + pn4) * 4);
#pragma unroll 8
        for (int c = 0; c < 64; ++c) { const int slot = b * 64 + c; f32x4* p = (f32x4*)(CS + ((size_t)(slot * 32 + h) * 2048 + pn4) * 4);
            const f32x4 s = *p; const float d = CD[slot * 32 + h]; *p = hc; hc = hc * d + s; }
        *(f32x4*)(a->out + O_PSSM + ((size_t)((li * NPROMPT + b) * NHEADS + h) * 2048 + pn4) * 4) = hc;
    }
}

__device__ __forceinline__ void ssd3_unit(ArgsP a, int li, unsigned char* lds, const float* hs, int g, int R0, int len, int, int, int) {
    const int tid = ltid(), lane = tid & 63, wave = __builtin_amdgcn_readfirstlane(tid >> 6);
    const bf16* XC = (const bf16*)(a->ws + WS_XC); const bf16* ZX = (const bf16*)(a->ws + WS_ZX); const float* DT = (const float*)(a->ws + WS_DT); bf16* YN = (bf16*)(a->ws + WS_YN);
    bf16* Cn = (bf16*)lds; bf16* Mb = Cn + 128 * LDX; bf16* Xt = Mb + 128 * LDX; bf16* Hs = Xt + 64 * LDX;
    float* s_dt = (float*)(Hs + 64 * LDX); float* s_acs = s_dt + 512;
    const int fr = lane & 15, fq = lane >> 4, h0 = g * 4;
    ssd_acs(DT, a->in[I_ALOG] + li * NHEADS, R0, len, h0, s_dt, s_acs, wave, lane);
#pragma unroll
    for (int k = 0; k < 4; ++k) { const int item = tid + NTHREADS * k, l = item >> 4, ch = item & 15;
        u32x4 vc = (u32x4){0u, 0u, 0u, 0u}, vb = vc;
        if (l < len) { vc = *(const u32x4*)(XC + (size_t)(R0 + l) * CONVD + 3072 + g * 128 + ch * 8); vb = *(const u32x4*)(XC + (size_t)(R0 + l) * CONVD + 2048 + g * 128 + ch * 8); }
        *(u32x4*)(Cn + l * LDX + ch * 8) = vc; *(u32x4*)(Mb + l * LDX + ch * 8) = vb; }
    __syncthreads();
    f32x4 cb[8];
#pragma unroll
    for (int ni = 0; ni < 8; ++ni) cb[ni] = (f32x4){0.f, 0.f, 0.f, 0.f};
#pragma unroll
    for (int ks = 0; ks < 4; ++ks) { const bf16x8 af = LFRAG(Cn, 16 * wave + fr, LDX, ks);
#pragma unroll
        for (int ni = 0; ni < 8; ++ni) if (ni <= wave) { const bf16x8 bb = LFRAG(Mb, 16 * ni + fr, LDX, ks); cb[ni] = MFMA16(bb, af, cb[ni]); } }
    __syncthreads();
    const int l = 16 * wave + fr;
    const size_t row = (size_t)(R0 + ((l < len) ? l : 0));
    f32x4 y0[4], y1[4], y2[4], y3[4];
#pragma unroll
    for (int ni = 0; ni < 4; ++ni) { y0[ni] = (f32x4){0.f, 0.f, 0.f, 0.f}; y1[ni] = y0[ni]; y2[ni] = y0[ni]; y3[ni] = y0[ni]; }
    float ss = 0.f;
#pragma unroll 1
    for (int r = 0; r < 4; ++r) {
        const float al = s_acs[r * 128 + l];
#pragma unroll
        for (int ni = 0; ni < 8; ++ni) { const int s0 = 16 * ni + 4 * fq; float m[4];
#pragma unroll
            for (int j = 0; j < 4; ++j) { const int s = s0 + j; m[j] = (s <= l) ? cb[ni][j] * __expf(al - s_acs[r * 128 + s]) * s_dt[r * 128 + s] : 0.f; }
            u32x2 w; w.x = pkbf(m[0], m[1]); w.y = pkbf(m[2], m[3]); *(u32x2*)(Mb + l * LDX + s0) = w; }
        { const int cbl = tid & 7, tp = tid >> 3, l0 = 2 * tp;
            u32x4 v0 = (u32x4){0u, 0u, 0u, 0u}, v1 = v0;
            if (l0 < len) v0 = *(const u32x4*)(XC + (size_t)(R0 + l0) * CONVD + g * 256 + r * 64 + cbl * 8);
            if (l0 + 1 < len) v1 = *(const u32x4*)(XC + (size_t)(R0 + l0 + 1) * CONVD + g * 256 + r * 64 + cbl * 8);
            const unsigned a0[4] = {v0.x, v0.y, v0.z, v0.w}, a1[4] = {v1.x, v1.y, v1.z, v1.w};
#pragma unroll
            for (int j = 0; j < 4; ++j) {
                *(unsigned*)(Xt + (cbl * 8 + 2 * j) * LDX + l0) = (a0[j] & 0xffffu) | (a1[j] << 16);
                *(unsigned*)(Xt + (cbl * 8 + 2 * j + 1) * LDX + l0) = (a0[j] >> 16) | (a1[j] & 0xffff0000u); } }
#pragma unroll
        for (int k = 0; k < 4; ++k) { const int item = tid + NTHREADS * k, p = item >> 5, n4 = item & 31;
            f32x4 v = (f32x4){0.f, 0.f, 0.f, 0.f}; if (hs) v = *(const f32x4*)(hs + ((size_t)(r * 64 + p) * 128) + n4 * 4);
            u32x2 w; w.x = pkbf(v.x, v.y); w.y = pkbf(v.z, v.w); *(u32x2*)(Hs + p * LDX + n4 * 4) = w; }
        __syncthreads();
        f32x4 yd[4], yo[4];
#pragma unroll
        for (int ni = 0; ni < 4; ++ni) { yd[ni] = (f32x4){0.f, 0.f, 0.f, 0.f}; yo[ni] = yd[ni]; }
#pragma unroll
        for (int ks = 0; ks < 4; ++ks) { const bf16x8 af = LFRAG(Mb, l, LDX, ks);
#pragma unroll
            for (int ni = 0; ni < 4; ++ni) { const bf16x8 bb = LFRAG(Xt, 16 * ni + fr, LDX, ks); yd[ni] = MFMA16(bb, af, yd[ni]); } }
#pragma unroll
        for (int ks = 0; ks < 4; ++ks) { const bf16x8 af = LFRAG(Cn, l, LDX, ks);
#pragma unroll
            for (int ni = 0; ni < 4; ++ni) { const bf16x8 bb = LFRAG(Hs, 16 * ni + fr, LDX, ks); yo[ni] = MFMA16(bb, af, yo[ni]); } }
        const float e = __expf(al);
        const float Dk = a->in[I_ADSKIP][li * NHEADS + h0 + r];
#pragma unroll
        for (int ni = 0; ni < 4; ++ni) { const int ch = g * 256 + r * 64 + 16 * ni + 4 * fq;
            const u32x2 xx = *(const u32x2*)(XC + row * CONVD + ch), zz = *(const u32x2*)(ZX + row * ZXW + ch);
            const float xv[4] = {bflo(xx.x), bfhi(xx.x), bflo(xx.y), bfhi(xx.y)}, zv[4] = {bflo(zz.x), bfhi(zz.x), bflo(zz.y), bfhi(zz.y)};
            f32x4 v = yd[ni] + yo[ni] * e;
#pragma unroll
            for (int j = 0; j < 4; ++j) { const float q = (v[j] + Dk * xv[j]) * zv[j] * sigmoid_f(zv[j]); v[j] = q; ss += q * q; }
            yd[ni] = v; }
        if (r == 0) {
#pragma unroll
            for (int ni = 0; ni < 4; ++ni) y0[ni] = yd[ni];
        } else if (r == 1) {
#pragma unroll
            for (int ni = 0; ni < 4; ++ni) y1[ni] = yd[ni];
        } else if (r == 2) {
#pragma unroll
            for (int ni = 0; ni < 4; ++ni) y2[ni] = yd[ni];
        } else {
#pragma unroll
            for (int ni = 0; ni < 4; ++ni) y3[ni] = yd[ni];
        }
        __syncthreads();
    }
    ss += __shfl_xor(ss, 16); ss += __shfl_xor(ss, 32);
    const float rs = rsqrtf(ss * (1.f / 256.f) + EPS);
    if (l < len) {
        bf16* yrow = YN + row * DINNER + g * 256 + 4 * fq;
#pragma unroll
        for (int ni = 0; ni < 4; ++ni) {
            u32x2 w;
            w.x = pkbf(y0[ni][0] * rs, y0[ni][1] * rs); w.y = pkbf(y0[ni][2] * rs, y0[ni][3] * rs); *(u32x2*)(yrow + 0 * 64 + 16 * ni) = w;
            w.x = pkbf(y1[ni][0] * rs, y1[ni][1] * rs); w.y = pkbf(y1[ni][2] * rs, y1[ni][3] * rs); *(u32x2*)(yrow + 1 * 64 + 16 * ni) = w;
            w.x = pkbf(y2[ni][0] * rs, y2[ni][1] * rs); w.y = pkbf(y2[ni][2] * rs, y2[ni][3] * rs); *(u32x2*)(yrow + 2 * 64 + 16 * ni) = w;
            w.x = pkbf(y3[ni][0] * rs, y3[ni][1] * rs); w.y = pkbf(y3[ni][2] * rs, y3[ni][3] * rs); *(u32x2*)(yrow + 3 * 64 + 16 * ni) = w;
        }
    }
}
__device__ __forceinline__ void phase_ssd3(ArgsP a, int li, unsigned char* lds, int tid, int wave, int lane) {
    const float* CS = (const float*)(a->ws + WS_CS);
    for (int u = blockIdx.x; u < 1032; u += gridDim.x) {
        if (u < 1024) { const int slot = u >> 3, g = u & 7; ssd3_unit(a, li, lds, CS + (size_t)(slot * 32 + g * 4) * 8192, g, (slot >> 6) * SEQ + (slot & 63) * 128, 128, tid, wave, lane); }
        else ssd3_unit(a, li, lds, nullptr, u - 1024, ROW_M, NMETA, tid, wave, lane);
    }
}

constexpr int KS_LD = 72, VT_LD = 232, NKEYS = 208;
__device__ __forceinline__ void attn_prompt_unit(ArgsP a, int lj, unsigned char* lds, int b, int kvh, int qb, int, int, int) {
    const int tid = ltid(), lane = tid & 63, wave = __builtin_amdgcn_readfirstlane(tid >> 6);
    const bf16* Q = (const bf16*)(a->ws + WS_Q); const bf16* KV = (const bf16*)(a->ws + WS_KV); bf16* AO = (bf16*)(a->ws + WS_AO);
    bf16* Ks = (bf16*)lds; bf16* Vt = Ks + NKEYS * KS_LD; bf16* Pw = Vt + 64 * VT_LD + wave * 16 * VT_LD;
    const int fr = lane & 15, fq = lane >> 4, t0 = qb * 64, Rb = b * SEQ;
    for (int it = tid; it < NKEYS * 8; it += NTHREADS) { const int key = it >> 3, ch = it & 7;
        int row; if (key < 16) row = ROW_M + key; else { int s = t0 - 128 + key - 16; if (s < 0) s = 0; row = Rb + s; }
        *(u32x4*)(Ks + key * KS_LD + ch * 8) = *(const u32x4*)(KV + (size_t)row * KVW + kvh * 64 + ch * 8); }
    for (int it = tid; it < (NKEYS / 2) * 8; it += NTHREADS) { const int dbl = it & 7, kp = it >> 3;
        int r0, r1; { const int k0 = 2 * kp, k1 = k0 + 1; int s0 = t0 - 128 + k0 - 16, s1 = t0 - 128 + k1 - 16; if (s0 < 0) s0 = 0; if (s1 < 0) s1 = 0; r0 = (k0 < 16) ? ROW_M + k0 : Rb + s0; r1 = (k1 < 16) ? ROW_M + k1 : Rb + s1; }
        const u32x4 v0 = *(const u32x4*)(KV + (size_t)r0 * KVW + 256 + kvh * 64 + dbl * 8), v1 = *(const u32x4*)(KV + (size_t)r1 * KVW + 256 + kvh * 64 + dbl * 8);
        const unsigned a0[4] = {v0.x, v0.y, v0.z, v0.w}, a1[4] = {v1.x, v1.y, v1.z, v1.w};
#pragma unroll
        for (int j = 0; j < 4; ++j) {
            *(unsigned*)(Vt + (dbl * 8 + 2 * j) * VT_LD + 2 * kp) = (a0[j] & 0xffffu) | (a1[j] << 16);
            *(unsigned*)(Vt + (dbl * 8 + 2 * j + 1) * VT_LD + 2 * kp) = (a0[j] >> 16) | (a1[j] & 0xffff0000u); } }
    { const int row = tid >> 3, c = NKEYS + 2 * (tid & 7); *(unsigned*)(Vt + row * VT_LD + c) = 0u; }
    __syncthreads();
    const int r = wave >> 1, th = (wave & 1) * 32, qh = kvh * 4 + r;
    const float sink = a->in[I_SINKS][lj * NQ + qh];
#pragma unroll 1
    for (int blk = 0; blk < 2; ++blk) {
        const int tq0 = t0 + th + blk * 16, t = tq0 + fr;
        bf16x8 qa[2];
#pragma unroll
        for (int ks = 0; ks < 2; ++ks) qa[ks] = *(const bf16x8*)(Q + (size_t)(Rb + t) * DM + qh * 64 + 32 * ks + 8 * fq);
        f32x4 sc[13];
#pragma unroll
        for (int ni = 0; ni < 13; ++ni) sc[ni] = (f32x4){0.f, 0.f, 0.f, 0.f};
#pragma unroll
        for (int ni = 0; ni < 13; ++ni) {
            const bf16x8 b0 = *(const bf16x8*)(Ks + (16 * ni + fr) * KS_LD + 8 * fq), b1 = *(const bf16x8*)(Ks + (16 * ni + fr) * KS_LD + 32 + 8 * fq);
            sc[ni] = MFMA16(b0, qa[0], sc[ni]); sc[ni] = MFMA16(b1, qa[1], sc[ni]);
            if ((ni & 3) == 3) asm volatile("" ::: "memory"); }
        float mx = -INFINITY;
#pragma unroll
        for (int ni = 0; ni < 13; ++ni)
#pragma unroll
            for (int j = 0; j < 4; ++j) { const int key = 16 * ni + 4 * fq + j; bool vis = true;
                if (key >= 16) { const int s = t0 - 128 + key - 16; vis = (s >= 0) && (s <= t) && (s > t - 128); }
                const float v = vis ? sc[ni][j] * 0.125f : -INFINITY; sc[ni][j] = v; mx = fmaxf(mx, v); }
        mx = fmaxf(mx, __shfl_xor(mx, 16)); mx = fmaxf(mx, __shfl_xor(mx, 32)); mx = fmaxf(mx, sink);
        float sum = 0.f;
#pragma unroll
        for (int ni = 0; ni < 13; ++ni)
#pragma unroll
            for (int j = 0; j < 4; ++j) { const float p = __expf(sc[ni][j] - mx); sc[ni][j] = p; sum += p; }
        sum += __shfl_xor(sum, 16); sum += __shfl_xor(sum, 32); sum += __expf(sink - mx);
        const float inv = 1.f / sum;
#pragma unroll
        for (int ni = 0; ni < 13; ++ni) { u32x2 w; w.x = pkbf(sc[ni][0] * inv, sc[ni][1] * inv); w.y = pkbf(sc[ni][2] * inv, sc[ni][3] * inv); *(u32x2*)(Pw + fr * VT_LD + 16 * ni + 4 * fq) = w; }
        *(u32x2*)(Pw + fr * VT_LD + NKEYS + 4 * fq) = (u32x2){0u, 0u};
        asm volatile("s_waitcnt lgkmcnt(0)" ::: "memory");
        f32x4 o[4];
#pragma unroll
        for (int ni = 0; ni < 4; ++ni) o[ni] = (f32x4){0.f, 0.f, 0.f, 0.f};
#pragma unroll
        for (int ks = 0; ks < 7; ++ks) { const bf16x8 af = *(const bf16x8*)(Pw + fr * VT_LD + 32 * ks + 8 * fq);
#pragma unroll
            for (int ni = 0; ni < 4; ++ni) { const bf16x8 bb = *(const bf16x8*)(Vt + (16 * ni + fr) * VT_LD + 32 * ks + 8 * fq); o[ni] = MFMA16(bb, af, o[ni]); }
            if (ks & 1) asm volatile("" ::: "memory"); }
#pragma unroll
        for (int ni = 0; ni < 4; ++ni) { u32x2 w; w.x = pkbf(o[ni][0], o[ni][1]); w.y = pkbf(o[ni][2], o[ni][3]); *(u32x2*)(AO + (size_t)(Rb + t) * DM + qh * 64 + 16 * ni + 4 * fq) = w; }
        asm volatile("s_waitcnt lgkmcnt(0)" ::: "memory");
    }
    __syncthreads();
}
__device__ __forceinline__ void attn_sample_unit(ArgsP a, int lj, unsigned char* lds, int b, int kvh, int, int, int) {
    const int tid = ltid(), lane = tid & 63, wave = __builtin_amdgcn_readfirstlane(tid >> 6);
    const bf16* Q = (const bf16*)(a->ws + WS_Q); const bf16* KV = (const bf16*)(a->ws + WS_KV); bf16* AO = (bf16*)(a->ws + WS_AO);
    float* Kf = (float*)lds; float* Vf = Kf + 152 * 65; float* Qf = Vf + 152 * 64; float* Sc = Qf + 32 * 64;
    for (int idx = tid; idx < 152 * 64; idx += NTHREADS) { const int s = idx >> 6, d = idx & 63; float kv, vv;
        if (s < 16) { const bf16* rowp = KV + (size_t)(ROW_M + s) * KVW + kvh * 64 + d; kv = bf2f(rowp[0]); vv = bf2f(rowp[256]); }
        else if (s < 144) { const size_t o = ((size_t)(b * 128 + (s - 16)) * NKV + kvh) * 64 + d; kv = a->in[I_CK][o]; vv = a->in[I_CV][o]; }
        else { const bf16* rowp = KV + (size_t)(ROW_S + b * 8 + (s - 144)) * KVW + kvh * 64 + d; kv = bf2f(rowp[0]); vv = bf2f(rowp[256]); }
        Kf[s * 65 + d] = kv; Vf[s * 64 + d] = vv; }
    for (int idx = tid; idx < 32 * 64; idx += NTHREADS) { const int qi = idx >> 6, d = idx & 63, r = qi >> 3, t = qi & 7;
        Qf[qi * 64 + d] = bf2f(Q[(size_t)(ROW_S + b * 8 + t) * DM + (kvh * 4 + r) * 64 + d]); }
    __syncthreads();
    if (lj == 0) {
        for (int idx = tid; idx < 128 * 64; idx += NTHREADS) { const int w = idx >> 6, d = idx & 63; const size_t o = ((size_t)(b * 128 + w) * NKV + kvh) * 64 + d;
            a->out[O_SCK + o] = Kf[(24 + w) * 65 + d]; a->out[O_SCV + o] = Vf[(24 + w) * 64 + d]; }
    }
    for (int idx = tid; idx < 32 * 152; idx += NTHREADS) { const int qi = idx / 152, s = idx - qi * 152, t = qi & 7;
        float dot = 0.f;
#pragma unroll 16
        for (int d = 0; d < 64; ++d) dot += Qf[qi * 64 + d] * Kf[s * 65 + d];
        const bool vis = (s < 16) || ((s < 144) ? ((s - 16) > t) : ((s - 144) <= t));
        Sc[qi * 153 + s] = vis ? dot * 0.125f : -INFINITY; }
    __syncthreads();
#pragma unroll 1
    for (int q = 0; q < 4; ++q) { const int qi = wave * 4 + q, r = qi >> 3; const float sink = a->in[I_SINKS][lj * NQ + kvh * 4 + r];
        float v0 = Sc[qi * 153 + lane], v1 = Sc[qi * 153 + 64 + lane], v2 = (lane < 24) ? Sc[qi * 153 + 128 + lane] : -INFINITY;
        float mx = fmaxf(fmaxf(v0, v1), v2);
#pragma unroll
        for (int o = 1; o < 64; o <<= 1) mx = fmaxf(mx, __shfl_xor(mx, o));
        mx = fmaxf(mx, sink);
        v0 = __expf(v0 - mx); v1 = __expf(v1 - mx); v2 = __expf(v2 - mx);
        const float sum = wave_sum(v0 + v1 + v2) + __expf(sink - mx), inv = 1.f / sum;
        Sc[qi * 153 + lane] = v0 * inv; Sc[qi * 153 + 64 + lane] = v1 * inv; if (lane < 24) Sc[qi * 153 + 128 + lane] = v2 * inv; }
    __syncthreads();
    { const int qi = tid >> 4, d4 = (tid & 15) * 4, r = qi >> 3, t = qi & 7; f32x4 o = (f32x4){0.f, 0.f, 0.f, 0.f};
#pragma unroll 8
        for (int s = 0; s < 152; ++s) { const float p = Sc[qi * 153 + s]; const f32x4 v = *(const f32x4*)(Vf + s * 64 + d4); o = o + v * p; }
        u32x2 w; w.x = pkbf(o.x, o.y); w.y = pkbf(o.z, o.w);
        *(u32x2*)(AO + (size_t)(ROW_S + b * 8 + t) * DM + (kvh * 4 + r) * 64 + d4) = w; }
    __syncthreads();
}
__device__ __forceinline__ void phase_attn(ArgsP a, int lj, unsigned char* lds, int tid, int wave, int lane) {
    if (lj == 0) {
        const bf16* KV = (const bf16*)(a->ws + WS_KV);
        const int gt = blockIdx.x * NTHREADS + tid, NT = gridDim.x * NTHREADS;
        for (int e = gt; e < 2 * 128 * 512; e += NT) { const int b = e >> 16, w = (e >> 9) & 127, c = e & 511;
            const float v = bf2f(KV[(size_t)(b * SEQ + SEQ - 128 + w) * KVW + c]);
            if (c < 256) a->out[O_PCK + (size_t)(b * 128 + w) * 256 + c] = v; else a->out[O_PCV + (size_t)(b * 128 + w) * 256 + (c - 256)] = v; }
    }
    for (int u = blockIdx.x; u < 1024 + 512; u += gridDim.x) {
#ifndef NO_PROMPT_ATTN
        if (u < 1024) { const int qb = u & 127, kvh = (u >> 7) & 3, b = u >> 9; attn_prompt_unit(a, lj, lds, b, kvh, qb, tid, wave, lane); }
#else
        if (u < 1024) {}
#endif
#ifndef NO_SAMPLE_ATTN
        else { const int su = u - 1024; attn_sample_unit(a, lj, lds, su >> 2, su & 3, tid, wave, lane); }
#endif
    }
}

constexpr int NPHASES = 36;
template <class Epi> __device__ __forceinline__ void run_gemm(LAS unsigned char* lds, const bf16* A, const bf16* Bt, int N, int K, const Epi& E) {
    pg8::Gemm g{A, Bt, MP, N, K}; pg8::StaticOrder S; S.init(MP, N, (int)gridDim.x, (int)blockIdx.x);
    pg8::gemm_phase<Epi, pg8::StaticOrder, true, true>(lds, g, S, E);
}

__global__ void __launch_bounds__(NTHREADS, 2) yoco_fwd(Args args) {
    extern __shared__ __attribute__((aligned(16))) unsigned char lds[];
    LAS unsigned char* ldsl = (LAS unsigned char*)lds;
    const int tid0 = threadIdx.x;
    for (int u = tid0; u < (LDS_BYTES - LDSCTL_OFF) / 4; u += NTHREADS) ((LAS unsigned*)(ldsl + LDSCTL_OFF))[u] = 0u;
    __syncthreads();
    const int lo = args.ph_lo, hi = args.ph_hi;
    XcdBarrier bar; bar.bar = (unsigned*)(args.ws + WS_CTL) + CW_BAR; bar.x = 0; bar.st = nullptr;
    if (hi - lo > 1) bar = xcd_barrier_post((unsigned*)(args.ws + WS_CTL) + CW_BAR, (volatile LAS unsigned*)(ldsl + MISC_OFF) + 8);
#pragma unroll 1
    for (int p = lo; p < hi; ++p) {
        ArgsP la = (ArgsP)__builtin_amdgcn_kernarg_segment_ptr(); asm volatile("" : "+s"(la));
        unsigned char* ws = la->ws;
        const int tid = ltid();
        const int lane = tid & 63, wave = __builtin_amdgcn_readfirstlane(tid >> 6);
        bf16* HN = (bf16*)(ws + WS_HN); float* H = (float*)(ws + WS_H);
        int kind, li = 0, lj = 0, layer = 0;
        if (p == 0) kind = 0;
        else if (p < 21) { li = (p - 1) / 10; layer = li; const int sub = (p - 1) % 10;
            kind = (sub == 0) ? (li == 0 ? 2 : 1) : (sub == 1) ? 3 : (sub == 2) ? 4 : (sub == 3) ? 5 : (sub == 4) ? 6 : (sub == 5) ? 7 : (sub == 6) ? 8 : (sub == 7) ? 1 : (sub == 8) ? 9 : 10; }
        else if (p < 35) { lj = (p - 21) / 7; layer = 2 + lj; const int sub = (p - 21) % 7;
            kind = (sub == 0) ? 1 : (sub == 1) ? 11 : (sub == 2) ? 12 : (sub == 3) ? 13 : (sub == 4) ? 1 : (sub == 5) ? 9 : 10; }
        else kind = 14;
#ifndef KMASK
#define KMASK 0xffff
#endif
#define KON(k) ((KMASK >> (k)) & 1)
        if (KON(0) && kind == 0) phase_prologue(la, ldsl, wave, lane);
        else if (KON(1) && kind == 1) phase_norm(la, 0, wave, lane);
        else if (KON(1) && kind == 2) phase_norm(la, 1, wave, lane);
        else if (KON(3) && kind == 3) { pg8::EpiInProj E{(bf16*)(ws + WS_ZX), (float*)(ws + WS_DT), la->in[I_ADTB] + li * NHEADS}; run_gemm(ldsl, HN, (const bf16*)(ws + WS_WIN + li * SZ_WIN), INPROJ_P, 1024, E); }
        else if (KON(4) && kind == 4) phase_conv(la, li);
        else if (KON(5) && kind == 5) phase_ssd1(la, li, lds, tid, wave, lane);
        else if (KON(6) && kind == 6) phase_scan(la, li);
        else if (KON(7) && kind == 7) phase_ssd3(la, li, lds, tid, wave, lane);
        else if (KON(8) && (kind == 8 || kind == 10 || kind == 13)) {
            const bf16* A; const bf16* Bt; int K;
            if (kind == 8) { A = (const bf16*)(ws + WS_YN); Bt = (const bf16*)(ws + WS_WOUT + li * SZ_WOUT); K = 2048; }
            else if (kind == 10) { A = (const bf16*)(ws + WS_U); Bt = (const bf16*)(ws + WS_WDN + layer * SZ_WDN); K = 4096; }
            else { A = (const bf16*)(ws + WS_AO); Bt = (const bf16*)(ws + WS_WO + lj * SZ_WO); K = 1024; }
            pg8::EpiRes E{H}; run_gemm(ldsl, A, Bt, 1024, K, E); }
        else if (KON(9) && kind == 9) { pg8::EpiBf<1> E{(bf16*)(ws + WS_U), 4096, 1 << 20, nullptr, 0}; run_gemm(ldsl, HN, (const bf16*)(ws + WS_WUP + layer * SZ_WUP), 4096, 1024, E); }
        else if (KON(11) && kind == 11) { pg8::EpiBf<0> E{(bf16*)(ws + WS_Q), 1024, 4, (bf16*)(ws + WS_KV), KVW};
            run_gemm(ldsl, HN, (const bf16*)(ws + (lj == 0 ? WS_WQKV0 : WS_WQ1)), lj == 0 ? 1536 : 1024, 1024, E); }
        else if (KON(12) && kind == 12) phase_attn(la, lj, lds, tid, wave, lane);
        else if (KON(14) && kind == 14) phase_final(la, wave, lane);
        if (p + 1 < hi) xcd_barrier(bar); else { asm volatile("s_waitcnt vmcnt(0)" ::: "memory"); __syncthreads(); }
    }
}

#ifndef MK_PER_PHASE
#define MK_PER_PHASE 0
#endif
extern "C" void kernel_launch(void* const* d_in, const int* in_sizes, int n_in, void* d_out, int out_size, void* d_ws, size_t ws_size, hipStream_t stream) {
    static int grid = 0;
    if (grid == 0) {
        if (n_in != 26 || (size_t)out_size != O_END || ws_size < WS_END) { fprintf(stderr, "kernel_launch: unexpected problem (n_in %d, out %d vs %zu, ws %zu vs %zu); nothing launched\n", n_in, out_size, (size_t)O_END, ws_size, (size_t)WS_END); grid = -1; return; }
        int dev = 0, cus = 0, per_cu = 0;
        if (hipGetDevice(&dev) != hipSuccess || hipDeviceGetAttribute(&cus, hipDeviceAttributeMultiprocessorCount, dev) != hipSuccess) { grid = -1; return; }
        if (hipFuncSetAttribute((const void*)yoco_fwd, hipFuncAttributeMaxDynamicSharedMemorySize, LDS_BYTES) != hipSuccess) { fprintf(stderr, "kernel_launch: hipFuncSetAttribute failed\n"); grid = -1; return; }
        if (hipOccupancyMaxActiveBlocksPerMultiprocessor(&per_cu, (const void*)yoco_fwd, NTHREADS, LDS_BYTES) != hipSuccess || per_cu < 1) { fprintf(stderr, "kernel_launch: occupancy query says %d\n", per_cu); per_cu = 1; }
        (void)hipGetLastError();
        grid = cus;
        if (grid > 256) grid = 256;
    }
    if (grid < 0) return;
    if (hipMemsetAsync((char*)d_ws + WS_CTL, 0, CTL_ZERO_BYTES, stream) != hipSuccess) { fprintf(stderr, "kernel_launch: memset failed\n"); return; }
    Args a{};
    for (int i = 0; i < 26; ++i) a.in[i] = (const float*)d_in[i];
    a.out = (float*)d_out; a.ws = (unsigned char*)d_ws;
#if MK_PER_PHASE
    for (int p = 0; p < NPHASES; ++p) { a.ph_lo = p; a.ph_hi = p + 1; hipLaunchKernelGGL(yoco_fwd, dim3(grid), dim3(NTHREADS), LDS_BYTES, stream, a); }
#else
    a.ph_lo = 0; a.ph_hi = NPHASES;
    void* kargs[] = {&a};
    hipError_t e = hipLaunchCooperativeKernel((const void*)yoco_fwd, dim3(grid), dim3(NTHREADS), kargs, LDS_BYTES, stream);
    if (e != hipSuccess) fprintf(stderr, "kernel_launch: cooperative launch failed: %s (grid %d)\n", hipGetErrorString(e), grid);
#endif
}
```

```cpp
#include <hip/hip_runtime.h>
#include <cstdio>
#include <cstdint>
#include <cmath>
namespace pg8 {
#define PG8_LAS __attribute__((address_space(3)))
typedef unsigned short bf16_t;
typedef short bf16x8 __attribute__((ext_vector_type(8)));
typedef float f32x4 __attribute__((ext_vector_type(4)));
typedef unsigned u32x4 __attribute__((ext_vector_type(4)));
constexpr int BM = 256, BK = 64, HALF = 128, HTB = HALF * BK * 2  , STAGE_BYTES = 8 * HTB, NXCD = 8, WGM = 8;

__host__ __device__ __forceinline__ int lds_byte(int r, int c) { const int st = (r >> 4) * 2 + (c >> 5), rr = r & 15, cc = c & 31, ob = rr * 64 + cc * 2; return st * 1024 + (ob ^ (((ob >> 9) & 1) << 5)); }
__host__ __device__ __forceinline__ void stage_rc(int b, int& R, int& C) { const int st = b / 1024, sb = b % 1024, swz = sb ^ (((sb >> 9) & 1) << 5); R = (st >> 1) * 16 + swz / 64; C = (st & 1) * 32 + (swz % 64) / 2; }
__host__ __device__ __forceinline__ int perm32(int rho) { const int n = rho >> 4, i = rho & 15; return 8 * (i >> 2) + 4 * n + (i & 3); }

struct Unit { int pm, pn, k0, nt, aux; };
struct Gemm { const bf16_t* A; const bf16_t* Bt; int M, N, K; };

struct StaticOrder {
    int nM, nN, nwg, G, c, nt0;
    __host__ __device__ void init(int M, int N, int K, int G_, int c_) { nM = M / BM; nN = N / BM; nwg = nM * nN; G = G_; c = c_; nt0 = K / BK; }
    __host__ __device__ bool next(int i, Unit& u) const {
        const long L = (long)i * G + c; if (L >= nwg) return false;
        int wgid = (int)L; { const int q = nwg / NXCD, r = nwg % NXCD, xcd = wgid % NXCD, off = wgid / NXCD; wgid = (xcd < r ? xcd * (q + 1) : r * (q + 1) + (xcd - r) * q) + off; }
        const int nig = WGM * nN, gid = wgid / nig, fm = gid * WGM, gsz = (nM - fm) < WGM ? (nM - fm) : WGM;
        u.pm = fm + ((wgid % nig) % gsz); u.pn = (wgid % nig) / gsz; u.k0 = 0; u.nt = nt0; u.aux = -1; return true;
    }
    __device__ __forceinline__ void a_ready(const Unit&) const {}
    __device__ __forceinline__ void done(const Unit&) const {}
};
struct ResOrder {
    StaticOrder so; int S, K, c;
    __host__ __device__ void init(int K_, int S_, int G_, int c_) { so.init(64 * BM, 1024, K_, G_, c_); S = S_; K = K_; c = c_; }
    __host__ __device__ bool next(int i, Unit& u) const {
        if (i == 0) return so.next(0, u);
        if (i == 1 && c < 20 * S) { const int t = c / S, sl = c - t * S; u.pm = 64 + (t >> 2); u.pn = t & 3; u.k0 = sl * (K / S); u.nt = K / S / BK; u.aux = sl; return true; }
        return false;
    }
    __device__ __forceinline__ void a_ready(const Unit&) const {}
    __device__ __forceinline__ void done(const Unit&) const {}
};

__device__ __forceinline__ unsigned cvt_pk_bf16(float lo, float hi) { unsigned r; asm volatile("v_cvt_pk_bf16_f32 %0, %1, %2" : "=v"(r) : "v"(lo), "v"(hi)); return r; }
typedef float f32x2 __attribute__((ext_vector_type(2)));
typedef unsigned u32x2 __attribute__((ext_vector_type(2)));
__device__ __forceinline__ float softplus_f(float x) { return x > 20.f ? x : log1pf(__expf(x)); }
struct EpiInProj {
    static constexpr bool PERM = true, AFTER_DRAIN = false;
    bf16_t* ZX; float* DT; const float* dt_bias;
    __device__ __forceinline__ void operator()(const f32x4 (&acc)[2][2][4][2], const Unit& u, int wr, int wc, int fr, int fq) const {
        const int row0 = u.pm * BM + wr * 64 + fr;
        if (u.pn < 24) {
            const int col0 = u.pn * BM + wc * 32 + 8 * fq;
#pragma unroll
            for (int ai = 0; ai < 2; ++ai)
#pragma unroll
                for (int m = 0; m < 4; ++m) { bf16_t* rowp = ZX + (size_t)(row0 + ai * HALF + m * 16) * 6144 + col0;
#pragma unroll
                    for (int bj = 0; bj < 2; ++bj) { const f32x4 v0 = acc[ai][bj][m][0], v1 = acc[ai][bj][m][1];
                        u32x4 w; w.x = cvt_pk_bf16(v0[0], v0[1]); w.y = cvt_pk_bf16(v0[2], v0[3]); w.z = cvt_pk_bf16(v1[0], v1[1]); w.w = cvt_pk_bf16(v1[2], v1[3]);
                        *(u32x4*)(rowp + bj * HALF) = w; } }
        } else if (wc == 0) {
            const int c0 = 8 * fq;
            const f32x4 b0 = *(const f32x4*)(dt_bias + c0), b1 = *(const f32x4*)(dt_bias + c0 + 4);
#pragma unroll
            for (int ai = 0; ai < 2; ++ai)
#pragma unroll
                for (int m = 0; m < 4; ++m) { float* rowp = DT + (size_t)(row0 + ai * HALF + m * 16) * 32 + c0;
                    const f32x4 v0 = acc[ai][0][m][0] + b0, v1 = acc[ai][0][m][1] + b1;
                    f32x4 o0, o1;
#pragma unroll
                    for (int j = 0; j < 4; ++j) { o0[j] = softplus_f(v0[j]); o1[j] = softplus_f(v1[j]); }
                    *(f32x4*)(rowp) = o0; *(f32x4*)(rowp + 4) = o1; }
        }
    }
};
struct EpiRes {
    static constexpr bool PERM = false, AFTER_DRAIN = false;
    float* H; float* SLAB;
    __device__ __forceinline__ void operator()(const f32x4 (&acc)[2][2][4][2], const Unit& u, int wr, int wc, int fr, int fq) const {
        const int row0 = u.pm * BM + wr * 64 + fr, col0 = u.pn * BM + wc * 32 + 4 * fq;
        if (u.aux >= 0) {
            float* base = SLAB + (size_t)u.aux * (1280 * 1024) + (size_t)(row0 - 16384) * 1024 + col0;
#pragma unroll
            for (int ai = 0; ai < 2; ++ai)
#pragma unroll
                for (int m = 0; m < 4; ++m) { float* rowp = base + (size_t)(ai * HALF + m * 16) * 1024;
#pragma unroll
                    for (int bj = 0; bj < 2; ++bj)
#pragma unroll
                        for (int n = 0; n < 2; ++n) *(f32x4*)(rowp + bj * HALF + n * 16) = acc[ai][bj][m][n]; }
            return;
        }
#pragma unroll
        for (int ai = 0; ai < 2; ++ai)
#pragma unroll
            for (int m = 0; m < 4; ++m) { float* rowp = H + (size_t)(row0 + ai * HALF + m * 16) * 1024 + col0;
#pragma unroll
                for (int bj = 0; bj < 2; ++bj)
#pragma unroll
                    for (int n = 0; n < 2; ++n) { f32x4* p = (f32x4*)(rowp + bj * HALF + n * 16); *p = *p + acc[ai][bj][m][n]; } }
    }
};
template <int ACT> struct EpiBf {
    static constexpr bool PERM = true, AFTER_DRAIN = false;
    bf16_t* O0; int ldc0; int nsplit; bf16_t* O1; int ldc1;
    __device__ __forceinline__ void operator()(const f32x4 (&acc)[2][2][4][2], const Unit& u, int wr, int wc, int fr, int fq) const {
        const int row0 = u.pm * BM + wr * 64 + fr;
        bf16_t* base; int ldc, colt;
        if (u.pn < nsplit) { base = O0; ldc = ldc0; colt = u.pn * BM; } else { base = O1; ldc = ldc1; colt = (u.pn - nsplit) * BM; }
        const int col0 = colt + wc * 32 + 8 * fq;
#pragma unroll
        for (int ai = 0; ai < 2; ++ai)
#pragma unroll
            for (int m = 0; m < 4; ++m) { bf16_t* rowp = base + (size_t)(row0 + ai * HALF + m * 16) * ldc + col0;
#pragma unroll
                for (int bj = 0; bj < 2; ++bj) { f32x4 v0 = acc[ai][bj][m][0], v1 = acc[ai][bj][m][1];
                    if (ACT == 1) {
#pragma unroll
                        for (int j = 0; j < 4; ++j) { const float a = fmaxf(v0[j], 0.f), b = fmaxf(v1[j], 0.f); v0[j] = a * a; v1[j] = b * b; } }
                    u32x4 w; w.x = cvt_pk_bf16(v0[0], v0[1]); w.y = cvt_pk_bf16(v0[2], v0[3]); w.z = cvt_pk_bf16(v1[0], v1[1]); w.w = cvt_pk_bf16(v1[2], v1[3]);
                    *(u32x4*)(rowp + bj * HALF) = w; } }
    }
};

template <class Epi, class Sched, bool ALIGN_EPI = false, bool SP2 = false>
__device__ __forceinline__ void gemm_phase(PG8_LAS unsigned char* lds, const Gemm g, const Sched& S, const Epi& E) {
    int tid_l = threadIdx.x; asm volatile("" : "+v"(tid_l));
    const int tid = tid_l, wid = __builtin_amdgcn_readfirstlane(tid >> 6), lane = tid & 63, wr = wid >> 2, wc = wid & 3, fr = lane & 15, fq = lane >> 4;
    const int K = g.K;
    unsigned voffA[2], voffB[2];
#pragma unroll
    for (int i = 0; i < 2; ++i) { int R, C; stage_rc(tid * 16 + i * 8192, R, C); const int Rb = Epi::PERM ? ((R & ~31) + perm32(R & 31)) : R;
        voffA[i] = (unsigned)(R * K + C) * 2u; voffB[i] = (unsigned)(Rb * K + C) * 2u; }
    const size_t kstep = (size_t)(BK * 2);
    const size_t hstep = (size_t)HALF * K * 2;
    const size_t tstep = 2 * hstep;
    const unsigned ldsw = (unsigned)wid * 1024u;
    const int aoff = lds_byte(wr * 64 + fr, fq * 8), boff = lds_byte(wc * 32 + fr, fq * 8);
#define PG8_SA(b, h) (((b) * 2 + (h)) * HTB)
#define PG8_SB(b, h) ((4 + (b) * 2 + (h)) * HTB)
#define PG8_STAGE(bufoff, gbase, voff) do { _Pragma("unroll") for (int _i = 0; _i < 2; ++_i) \
        __builtin_amdgcn_global_load_lds((const unsigned*)((const char*)(gbase) + (voff)[_i]), (PG8_LAS unsigned*)(lds + (bufoff) + ldsw + _i * 8192), 16, 0, 0); } while (0)
#define PG8_LDA(dst, b, h) do { _Pragma("unroll") for (int m = 0; m < 4; ++m) _Pragma("unroll") for (int k = 0; k < 2; ++k) dst[m][k] = *(const PG8_LAS bf16x8*)(lds + PG8_SA(b, h) + aoff + m * 2048 + k * 1024); } while (0)
#define PG8_LDB(dst, b, h) do { _Pragma("unroll") for (int n = 0; n < 2; ++n) _Pragma("unroll") for (int k = 0; k < 2; ++k) dst[n][k] = *(const PG8_LAS bf16x8*)(lds + PG8_SB(b, h) + boff + n * 2048 + k * 1024); } while (0)
#define PG8_MMA(ai, bj, At, Bt) do { __builtin_amdgcn_s_setprio(1); _Pragma("unroll") for (int m = 0; m < 4; ++m) _Pragma("unroll") for (int n = 0; n < 2; ++n) _Pragma("unroll") for (int k = 0; k < 2; ++k) \
        acc[ai][bj][m][n] = __builtin_amdgcn_mfma_f32_16x16x32_bf16(Bt[n][k], At[m][k], acc[ai][bj][m][n], 0, 0, 0); __builtin_amdgcn_s_setprio(0); } while (0)
#define PG8_WAIT_V(n) asm volatile("s_waitcnt vmcnt(" #n ")" ::: "memory")
#define PG8_WAIT_L(n) asm volatile("s_waitcnt lgkmcnt(" #n ")" ::: "memory")
#define PG8_BAR __builtin_amdgcn_s_barrier()
#define PG8_SCHED __builtin_amdgcn_sched_barrier(0)
    Unit cur, nxt; int ui = 0;
    if (!S.next(0, cur)) return;
    f32x4 acc[2][2][4][2];
#pragma unroll
    for (int a = 0; a < 2; ++a)
#pragma unroll
        for (int b = 0; b < 2; ++b)
#pragma unroll
            for (int m = 0; m < 4; ++m)
#pragma unroll
                for (int n = 0; n < 2; ++n) acc[a][b][m][n] = (f32x4){0.f, 0.f, 0.f, 0.f};
    bf16x8 At[4][2], B0[2][2], B1[2][2];
    const char* cA = (const char*)g.A + (size_t)cur.pm * tstep + (size_t)cur.k0 * 2; const char* cB = (const char*)g.Bt + (size_t)cur.pn * tstep + (size_t)cur.k0 * 2;
    S.a_ready(cur);
    if constexpr (SP2) {
        PG8_STAGE(PG8_SB(0, 0), cB, voffB); PG8_STAGE(PG8_SB(0, 1), cB + hstep, voffB); PG8_STAGE(PG8_SA(0, 0), cA, voffA); PG8_STAGE(PG8_SA(0, 1), cA + hstep, voffA);
        if (wr == 1) PG8_BAR;
        PG8_WAIT_V(2); PG8_BAR;
        PG8_STAGE(PG8_SB(1, 0), cB + kstep, voffB); PG8_STAGE(PG8_SA(1, 0), cA + kstep, voffA); PG8_STAGE(PG8_SB(1, 1), cB + hstep + kstep, voffB);
        PG8_WAIT_V(6); PG8_BAR;
    } else {
        PG8_STAGE(PG8_SB(0, 0), cB, voffB); PG8_STAGE(PG8_SA(0, 0), cA, voffA); PG8_STAGE(PG8_SB(0, 1), cB + hstep, voffB); PG8_STAGE(PG8_SA(0, 1), cA + hstep, voffA);
        if (wr == 1) PG8_BAR;
        PG8_WAIT_V(4); PG8_BAR;
        PG8_STAGE(PG8_SB(1, 0), cB + kstep, voffB); PG8_STAGE(PG8_SA(1, 0), cA + kstep, voffA); PG8_STAGE(PG8_SB(1, 1), cB + hstep + kstep, voffB);
        PG8_WAIT_V(6); PG8_BAR;
    }
    for (;;) {
        const bool has_next = S.next(ui + 1, nxt);
        const char* nA = has_next ? (const char*)g.A + (size_t)nxt.pm * tstep + (size_t)nxt.k0 * 2 : cA; const char* nB = has_next ? (const char*)g.Bt + (size_t)nxt.pn * tstep + (size_t)nxt.k0 * 2 : cB;
        const int nt = cur.nt;
        for (int t = 0; t < nt; t += 2) {
            const bool last = (t == nt - 2);
            const char* a1 = cA + (size_t)(t + 1) * kstep;
            const char* a2 = last ? nA : cA + (size_t)(t + 2) * kstep; const char* b2 = last ? nB : cB + (size_t)(t + 2) * kstep;
            const char* a3 = a2 + kstep; const char* b3 = b2 + kstep;
            if (last && has_next) S.a_ready(nxt);
            if constexpr (SP2) {
            PG8_LDB(B0, 0, 0); PG8_LDB(B1, 0, 1); PG8_SCHED; PG8_LDA(At, 0, 0); PG8_STAGE(PG8_SA(1, 1), a1 + hstep, voffA);
            PG8_WAIT_V(8); PG8_WAIT_L(0); PG8_BAR; PG8_MMA(0, 0, At, B0); PG8_MMA(0, 1, At, B1); PG8_BAR; PG8_SCHED;
            PG8_LDA(At, 0, 1); PG8_STAGE(PG8_SB(0, 0), b2, voffB); PG8_STAGE(PG8_SB(0, 1), b2 + hstep, voffB); PG8_STAGE(PG8_SA(0, 0), a2, voffA);
            PG8_WAIT_V(8); PG8_WAIT_L(0); PG8_BAR; PG8_MMA(1, 0, At, B0); PG8_MMA(1, 1, At, B1); PG8_BAR; PG8_SCHED;
            PG8_LDB(B0, 1, 0); PG8_LDB(B1, 1, 1); PG8_SCHED; PG8_LDA(At, 1, 0); PG8_STAGE(PG8_SA(0, 1), a2 + hstep, voffA);
            PG8_WAIT_V(8); PG8_WAIT_L(0); PG8_BAR; PG8_MMA(0, 0, At, B0); PG8_MMA(0, 1, At, B1); PG8_BAR; PG8_SCHED;
            PG8_LDA(At, 1, 1); PG8_STAGE(PG8_SB(1, 0), b3, voffB); PG8_STAGE(PG8_SB(1, 1), b3 + hstep, voffB); PG8_STAGE(PG8_SA(1, 0), a3, voffA);
            PG8_WAIT_V(8); PG8_WAIT_L(0); PG8_BAR; PG8_MMA(1, 0, At, B0); PG8_MMA(1, 1, At, B1); PG8_BAR; PG8_SCHED;
            } else {
            PG8_LDB(B0, 0, 0); PG8_SCHED; PG8_LDA(At, 0, 0); PG8_STAGE(PG8_SA(1, 1), a1 + hstep, voffA);
            PG8_WAIT_L(8); PG8_BAR; PG8_WAIT_L(0); PG8_MMA(0, 0, At, B0); PG8_BAR; PG8_SCHED;
            PG8_LDB(B1, 0, 1); PG8_STAGE(PG8_SB(0, 0), b2, voffB);
            PG8_BAR; PG8_WAIT_L(0); PG8_MMA(0, 1, At, B1); PG8_BAR;
            PG8_LDA(At, 0, 1); PG8_STAGE(PG8_SA(0, 0), a2, voffA);
            PG8_BAR; PG8_WAIT_L(0); PG8_MMA(1, 0, At, B0); PG8_BAR; PG8_SCHED;
            PG8_STAGE(PG8_SB(0, 1), b2 + hstep, voffB);
            PG8_WAIT_V(6); PG8_BAR; PG8_MMA(1, 1, At, B1); PG8_BAR;
            PG8_LDB(B0, 1, 0); PG8_SCHED; PG8_LDA(At, 1, 0); PG8_STAGE(PG8_SA(0, 1), a2 + hstep, voffA);
            PG8_WAIT_L(8); PG8_BAR; PG8_WAIT_L(0); PG8_MMA(0, 0, At, B0); PG8_BAR; PG8_SCHED;
            PG8_LDB(B1, 1, 1); PG8_STAGE(PG8_SB(1, 0), b3, voffB);
            PG8_BAR; PG8_WAIT_L(0); PG8_MMA(0, 1, At, B1); PG8_BAR;
            PG8_LDA(At, 1, 1); PG8_STAGE(PG8_SA(1, 0), a3, voffA);
            PG8_BAR; PG8_WAIT_L(0); PG8_MMA(1, 0, At, B0); PG8_BAR; PG8_SCHED;
            PG8_STAGE(PG8_SB(1, 1), b3 + hstep, voffB);
            PG8_WAIT_V(6); PG8_BAR; PG8_MMA(1, 1, At, B1); PG8_BAR;
            }
        }
        if constexpr (ALIGN_EPI) { if (wr == 0) PG8_BAR; }
        if constexpr (!Epi::AFTER_DRAIN) { E(acc, cur, wr, wc, fr, fq); S.done(cur); }
        if (!has_next) break;
#pragma unroll
        for (int a = 0; a < 2; ++a)
#pragma unroll
            for (int b = 0; b < 2; ++b)
#pragma unroll
                for (int m = 0; m < 4; ++m)
#pragma unroll
                    for (int n = 0; n < 2; ++n) acc[a][b][m][n] = (f32x4){0.f, 0.f, 0.f, 0.f};
        cur = nxt; cA = nA; cB = nB; ++ui;
        if constexpr (ALIGN_EPI) { if (wr == 1) PG8_BAR; }
    }
    PG8_WAIT_V(0);
    if constexpr (!ALIGN_EPI) { if (wr == 0) PG8_BAR; }
    PG8_BAR;
    if constexpr (Epi::AFTER_DRAIN) { E.fused(acc, cur, wr, wc, fr, fq, lds, wid, lane); S.done(cur); }
#undef PG8_SA
#undef PG8_SB
#undef PG8_STAGE
#undef PG8_LDA
#undef PG8_LDB
#undef PG8_MMA
#undef PG8_WAIT_V
#undef PG8_WAIT_L
#undef PG8_BAR
#undef PG8_SCHED
}
}
#define GAS __attribute__((address_space(1)))
#define LAS __attribute__((address_space(3)))
typedef unsigned short bf16;
typedef unsigned v4u __attribute__((ext_vector_type(4)));
typedef float f32x4 __attribute__((ext_vector_type(4)));
typedef short bf16x8 __attribute__((ext_vector_type(8)));
typedef GAS unsigned gu32;
typedef GAS unsigned long long gu64;
#define RLX_AGENT __ATOMIC_RELAXED, __HIP_MEMORY_SCOPE_AGENT
#define LDS_WAIT() asm volatile("s_waitcnt lgkmcnt(0)" ::: "memory")
#define VM_WAIT() asm volatile("s_waitcnt vmcnt(0)" ::: "memory")
__device__ __forceinline__ unsigned long long rt() { return __builtin_amdgcn_s_memrealtime(); }
__device__ __forceinline__ unsigned f2bf(float f) { unsigned u = __builtin_bit_cast(unsigned, f); return (u + 0x7fffu + ((u >> 16) & 1u)) >> 16; }
__device__ __forceinline__ unsigned pk2(float lo, float hi) { return f2bf(lo) | (f2bf(hi) << 16); }

#define XB_TMO      128
#define XB_XCNT(j)  (256  + 64 * (j))
#define XB_XSUB(j)  (1280 + 64 * (j))
#define XB_XGEN(j)  (2304 + 64 * (j))
#define XB_TOP      3328
#define XB_TOPGEN   3392
#define XCD_BAR_WORDS 3456
#define XB_SPIN_CAP (1u << 18)

__device__ __forceinline__ unsigned xb_ld(unsigned* p)              { return __hip_atomic_load(p, __ATOMIC_RELAXED, __HIP_MEMORY_SCOPE_AGENT); }
__device__ __forceinline__ unsigned xb_add(unsigned* p, unsigned v) { return __hip_atomic_fetch_add(p, v, __ATOMIC_RELAXED, __HIP_MEMORY_SCOPE_AGENT); }
__device__ __forceinline__ unsigned xb_xcc_id() { return (unsigned)__builtin_amdgcn_s_getreg((3 << 11) | 20) & 0xFu; }
#define XB_SPIN(cond, bar) do { unsigned _sp = 0; while (cond) { __builtin_amdgcn_s_sleep(1); \
    if ((++_sp & 255u) == 0u) { if (xb_ld(&(bar)[XB_TMO])) break; if (_sp > XB_SPIN_CAP) { atomicAdd(&(bar)[XB_TMO], 1u); break; } } } } while (0)

struct XcdBarrier {
    unsigned* bar; unsigned x;
    volatile LAS unsigned* st;
};

__device__ __forceinline__ XcdBarrier xcd_barrier_post(unsigned* bar, volatile LAS unsigned* st) {
    XcdBarrier b; b.bar = bar; b.x = xb_xcc_id(); b.st = st;
    if (threadIdx.x == 0) (void)xb_add(&bar[XB_XCNT(b.x)], 1u);
    return b;
}
__device__ __forceinline__ void xcd_barrier_complete(unsigned* bar, unsigned x, unsigned& nloc, unsigned& nx) {
    const unsigned G = gridDim.x * gridDim.y * gridDim.z;
    unsigned sum, cnt, mine, sp = 0u;
    for (;;) {
        sum = 0u; cnt = 0u; mine = 0u;
#pragma unroll
        for (unsigned j = 0; j < 16; ++j) { const unsigned c = xb_ld(&bar[XB_XCNT(j)]); sum += c; cnt += (c > 0u) ? 1u : 0u; mine = (j == x) ? c : mine; }
        if (sum == G) break;
        __builtin_amdgcn_s_sleep(1);
        if ((++sp & 255u) == 0u) { if (xb_ld(&bar[XB_TMO])) break; if (sp > XB_SPIN_CAP) { atomicAdd(&bar[XB_TMO], 1u); break; } }
    }
    nloc = mine > 0u ? mine : 1u; nx = cnt > 0u ? cnt : 1u;
}

__device__ __forceinline__ void xcd_barrier(const XcdBarrier& b) {
    asm volatile("s_waitcnt vmcnt(0)" ::: "memory");
    __syncthreads();
    if (threadIdx.x == 0) {
        unsigned* bar = b.bar;
        __builtin_amdgcn_s_waitcnt(0);
        unsigned nloc = b.st[0], nx = b.st[1];
        if (nloc == 0u) { xcd_barrier_complete(bar, b.x, nloc, nx); b.st[0] = nloc; b.st[1] = nx; }
        const unsigned old = xb_add(&bar[XB_XSUB(b.x)], 1u);
        const unsigned gen = old / nloc;
        if (old + 1u == (gen + 1u) * nloc) {
            __builtin_amdgcn_fence(__ATOMIC_RELEASE, "agent");
            asm volatile("s_waitcnt vmcnt(0)" ::: "memory");
            const unsigned og = xb_add(&bar[XB_TOP], 1u);
            const unsigned tg = og / nx;
            if (og + 1u == (tg + 1u) * nx) xb_add(&bar[XB_TOPGEN], 1u);
            else XB_SPIN(xb_ld(&bar[XB_TOPGEN]) == tg, bar);
            __builtin_amdgcn_fence(__ATOMIC_ACQUIRE, "agent");
            xb_add(&bar[XB_XGEN(b.x)], 1u);
            asm volatile("s_waitcnt vmcnt(0)" ::: "memory");
        } else {
            XB_SPIN(xb_ld(&bar[XB_XGEN(b.x)]) == gen, bar);
            __builtin_amdgcn_fence(__ATOMIC_ACQUIRE, "agent");
            asm volatile("s_waitcnt vmcnt(0)" ::: "memory");
        }
    }
    __syncthreads();
}
constexpr int NWAVES = 8, NTHREADS = 512;
constexpr int DM = 1024, SEQ = 8192, NPROMPT = 2, NSAMP = 128, TSAMP = 8, NMETA = 16;
constexpr int ROW_S = NPROMPT * SEQ;
constexpr int ROW_M = ROW_S + NSAMP * TSAMP;
constexpr int NROWS = ROW_M + NMETA;
constexpr int MP = 17664;
constexpr int DINNER = 2048, NHEADS = 32, HD = 64, NGROUPS = 8, DSTATE = 128, CONVD = 4096, INPROJ = 6176, INPROJ_P = 6400, ZXW = 6144;
constexpr int DFF = 4096, NKV = 4, NQ = 16, KVW = 512;
constexpr float EPS = 1e-5f;
constexpr int LDX = 136;

constexpr size_t O_YP = 0, O_YS = O_YP + (size_t)NPROMPT * SEQ * DM, O_PCONV = O_YS + (size_t)NSAMP * TSAMP * DM, O_PSSM = O_PCONV + 2 * 2 * 3 * 4096,
    O_PCK = O_PSSM + (size_t)2 * 2 * 32 * 64 * 128, O_PCV = O_PCK + 2 * 128 * 256, O_SCONV = O_PCV + 2 * 128 * 256, O_SSSM = O_SCONV + (size_t)2 * 128 * 3 * 4096,
    O_SCK = O_SSSM + (size_t)2 * 128 * 32 * 64 * 128, O_SCV = O_SCK + (size_t)128 * 128 * 256, O_END = O_SCV + (size_t)128 * 128 * 256;

constexpr size_t MiB = 1u << 20;
constexpr size_t WS_CTL = 0, CTL_ZERO_BYTES = 1 * MiB;
constexpr size_t SZ_WIN = (size_t)INPROJ_P * 1024 * 2, SZ_WOUT = (size_t)1024 * 2048 * 2, SZ_WUP = (size_t)4096 * 1024 * 2, SZ_WDN = SZ_WUP, SZ_WQKV0 = (size_t)1536 * 1024 * 2, SZ_WQ1 = (size_t)1024 * 1024 * 2, SZ_WO = SZ_WQ1;
constexpr size_t WS_WIN = 1 * MiB, WS_WOUT = WS_WIN + 2 * SZ_WIN, WS_WUP = WS_WOUT + 2 * SZ_WOUT, WS_WDN = WS_WUP + 4 * SZ_WUP, WS_WQKV0 = WS_WDN + 4 * SZ_WDN, WS_WQ1 = WS_WQKV0 + SZ_WQKV0, WS_WO = WS_WQ1 + SZ_WQ1, WS_WEND = WS_WO + 2 * SZ_WO;
constexpr size_t al1m(size_t x) { return (x + MiB - 1) / MiB * MiB; }
constexpr size_t WS_H = al1m(WS_WEND), WS_HN = al1m(WS_H + (size_t)MP * 1024 * 4), WS_ZX = al1m(WS_HN + (size_t)MP * 1024 * 2), WS_DT = al1m(WS_ZX + (size_t)MP * ZXW * 2),
    WS_XC = al1m(WS_DT + (size_t)MP * 32 * 4), WS_YN = al1m(WS_XC + (size_t)MP * 4096 * 2), WS_CS = al1m(WS_YN + (size_t)MP * 2048 * 2), WS_CD = al1m(WS_CS + (size_t)129 * 32 * 8192 * 4), WS_SLAB = al1m(WS_CD + 129 * 32 * 4), WS_END = al1m(WS_SLAB + (size_t)8 * 1280 * 1024 * 4);
constexpr size_t WS_U = WS_ZX;
constexpr size_t WS_Q = WS_XC, WS_KV = WS_Q + (size_t)MP * 1024 * 2, WS_AO = WS_KV + (size_t)MP * 512 * 2;
static_assert(WS_AO + (size_t)MP * 1024 * 2 <= WS_YN, "attention overlay");
constexpr int CW_BAR = 4096;

constexpr int RING_BYTES = 131072, LDSCTL_OFF = RING_BYTES, MISC_OFF = LDSCTL_OFF + 320, LDS_BYTES = 147456;

typedef unsigned u32x2 __attribute__((ext_vector_type(2)));
typedef unsigned u32x4 __attribute__((ext_vector_type(4)));
__device__ __forceinline__ int ltid() { int t = threadIdx.x; asm volatile("" : "+v"(t)); return t; }
__device__ __forceinline__ float bf2f(unsigned short b) { return __uint_as_float((unsigned)b << 16); }
__device__ __forceinline__ float bflo(unsigned w) { return __uint_as_float(w << 16); }
__device__ __forceinline__ float bfhi(unsigned w) { return __uint_as_float(w & 0xffff0000u); }
__device__ __forceinline__ unsigned pkbf(float lo, float hi) { return pg8::cvt_pk_bf16(lo, hi); }
__device__ __forceinline__ float wave_sum(float v) {
#pragma unroll
    for (int o = 1; o < 64; o <<= 1) v += __shfl_xor(v, o);
    return v;
}
__device__ __forceinline__ float sigmoid_f(float x) { return 1.f / (1.f + __expf(-x)); }
#define MFMA16(b, a, c) __builtin_amdgcn_mfma_f32_16x16x32_bf16((b), (a), (c), 0, 0, 0)

struct Args {
    const float* in[26]; float* out; unsigned char* ws; int ph_lo, ph_hi;
};
typedef const __attribute__((address_space(4))) Args* ArgsP;
enum { I_XP = 0, I_XS, I_SCONV, I_SSSM, I_CK, I_CV, I_META, I_ANORM, I_AIN, I_ACONVW, I_ACONVB, I_ADTB, I_ALOG, I_ADSKIP, I_AGATE, I_AOUT, I_KVNORM, I_WKV, I_BNORM, I_WQ, I_SINKS, I_WO, I_MLPNORM, I_WUP, I_WDOWN, I_FNORM };

__device__ __forceinline__ void transpose_item(const float* W, const float* scale, int K, int N, bf16* WT, int row_off, LAS float* scr, int item, int lane) {
    const int nblk = N / 32, kb = item / nblk, nb = item % nblk, k0 = 64 * kb, n0 = 32 * nb;
#pragma unroll 8
    for (int i = 0; i < 32; ++i) { const int kk = 2 * i + (lane >> 5); float v = W[(size_t)(k0 + kk) * N + n0 + (lane & 31)]; if (scale) v *= scale[k0 + kk]; scr[kk * 33 + (lane & 31)] = v; }
    LDS_WAIT(); asm volatile("" ::: "memory");
    const int c = lane & 7;
#pragma unroll
    for (int j = 0; j < 4; ++j) { const int n = (lane >> 3) + 8 * j; const LAS float* s = scr + (8 * c) * 33 + n;
        v4u o; o.x = pk2(s[0 * 33], s[1 * 33]); o.y = pk2(s[2 * 33], s[3 * 33]); o.z = pk2(s[4 * 33], s[5 * 33]); o.w = pk2(s[6 * 33], s[7 * 33]);
        *(GAS v4u*)(WT + (size_t)(row_off + n0 + n) * K + k0 + 8 * c) = o; }
    LDS_WAIT(); asm volatile("" ::: "memory");
}
struct WJob { const float* W; const float* scale; int K, N; bf16* WT; int row_off; int items; };

__device__ __forceinline__ void phase_prologue(ArgsP a, LAS unsigned char* lds, int wave, int lane) {
    LAS float* scr = (LAS float*)(lds + wave * 16384);
    const int gw = blockIdx.x * NWAVES + wave, NGW = gridDim.x * NWAVES;
    unsigned char* ws = a->ws;
    for (int jb = 0; jb < 21; ++jb) {
        WJob J;
        if (jb < 2)       { const int i = jb;      J = WJob{a->in[I_AIN] + (size_t)i * 1024 * INPROJ, a->in[I_ANORM] + i * 1024, 1024, INPROJ, (bf16*)(ws + WS_WIN + i * SZ_WIN), 0, 0}; }
        else if (jb < 4)  { const int i = jb - 2;  J = WJob{a->in[I_AOUT] + (size_t)i * 2048 * 1024, a->in[I_AGATE] + i * 2048, 2048, 1024, (bf16*)(ws + WS_WOUT + i * SZ_WOUT), 0, 0}; }
        else if (jb < 8)  { const int l = jb - 4;  J = WJob{a->in[I_WUP] + (size_t)l * 1024 * 4096, a->in[I_MLPNORM] + l * 1024, 1024, 4096, (bf16*)(ws + WS_WUP + l * SZ_WUP), 0, 0}; }
        else if (jb < 12) { const int l = jb - 8;  J = WJob{a->in[I_WDOWN] + (size_t)l * 4096 * 1024, nullptr, 4096, 1024, (bf16*)(ws + WS_WDN + l * SZ_WDN), 0, 0}; }
        else if (jb == 12) { J = WJob{a->in[I_WQ], a->in[I_BNORM], 1024, 1024, (bf16*)(ws + WS_WQKV0), 0, 0}; }
        else if (jb == 13) { J = WJob{a->in[I_WKV], a->in[I_KVNORM], 1024, 512, (bf16*)(ws + WS_WQKV0), 1024, 0}; }
        else if (jb == 14) { J = WJob{a->in[I_WQ] + (size_t)1024 * 1024, a->in[I_BNORM] + 1024, 1024, 1024, (bf16*)(ws + WS_WQ1), 0, 0}; }
        else if (jb < 17) { const int j = jb - 15; J = WJob{a->in[I_WO] + (size_t)j * 1024 * 1024, nullptr, 1024, 1024, (bf16*)(ws + WS_WO + j * SZ_WO), 0, 0}; }
        else break;
        const int items = (J.K / 64) * (J.N / 32);
        for (int it = gw; it < items; it += NGW) transpose_item(J.W, J.scale, J.K, J.N, J.WT, J.row_off, scr, it, lane);
    }
    {
        const int gt = blockIdx.x * NTHREADS + ltid(), NT = gridDim.x * NTHREADS;
        const int per = (INPROJ_P - INPROJ) * 1024 * 2 / 16;
        for (int e = gt; e < 2 * per; e += NT) { const int i = e / per, c = e % per;
            *(v4u*)(ws + WS_WIN + i * SZ_WIN + (size_t)INPROJ * 1024 * 2 + (size_t)c * 16) = (v4u){0u, 0u, 0u, 0u}; }
    }
}

__device__ __forceinline__ void phase_norm(ArgsP a, int from_inputs, int nslab, int wave, int lane) {
    float* H = (float*)(a->ws + WS_H); bf16* HN = (bf16*)(a->ws + WS_HN); const float* SLAB = (const float*)(a->ws + WS_SLAB);
    const int gw = blockIdx.x * NWAVES + wave, NGW = gridDim.x * NWAVES;
    for (int m = gw; m < MP; m += NGW) {
        unsigned long long* o8 = (unsigned long long*)(HN + (size_t)m * DM) + lane;
        if (m >= NROWS) {
#pragma unroll
            for (int j = 0; j < 4; ++j) o8[64 * j] = 0ull;
            continue;
        }
        const float* src;
        if (from_inputs) src = (m < ROW_S) ? a->in[I_XP] + (size_t)m * DM : (m < ROW_M) ? a->in[I_XS] + (size_t)(m - ROW_S) * DM : a->in[I_META] + (size_t)(m - ROW_M) * DM;
        else src = H + (size_t)m * DM;
        const f32x4* xr = (const f32x4*)src + lane;
        f32x4 v[4]; float s = 0.f;
#pragma unroll
        for (int j = 0; j < 4; ++j) v[j] = xr[64 * j];
        if (m >= ROW_S && nslab > 0) {
            for (int sl = 0; sl < nslab; ++sl) { const f32x4* sr = (const f32x4*)(SLAB + (size_t)sl * (1280 * 1024) + (size_t)(m - ROW_S) * DM) + lane;
#pragma unroll
                for (int j = 0; j < 4; ++j) v[j] = v[j] + sr[64 * j]; }
            f32x4* hr = (f32x4*)(H + (size_t)m * DM) + lane;
#pragma unroll
            for (int j = 0; j < 4; ++j) hr[64 * j] = v[j];
        }
#pragma unroll
        for (int j = 0; j < 4; ++j) s += (v[j].x * v[j].x + v[j].y * v[j].y) + (v[j].z * v[j].z + v[j].w * v[j].w);
        const float rs = rsqrtf(wave_sum(s) * (1.f / DM) + EPS);
        if (from_inputs) { f32x4* hr = (f32x4*)(H + (size_t)m * DM) + lane;
#pragma unroll
            for (int j = 0; j < 4; ++j) hr[64 * j] = v[j]; }
#pragma unroll
        for (int j = 0; j < 4; ++j) o8[64 * j] = (unsigned long long)pkbf(v[j].x * rs, v[j].y * rs) | ((unsigned long long)pkbf(v[j].z * rs, v[j].w * rs) << 32);
    }
}
__device__ __forceinline__ void phase_final(ArgsP a, int wave, int lane) {
    const float* H = (const float*)(a->ws + WS_H); const float* fw = a->in[I_FNORM]; const float* SLAB = (const float*)(a->ws + WS_SLAB);
    const int gw = blockIdx.x * NWAVES + wave, NGW = gridDim.x * NWAVES;
    f32x4 w[4];
#pragma unroll
    for (int j = 0; j < 4; ++j) w[j] = ((const f32x4*)fw)[lane + 64 * j];
    for (int m = gw; m < ROW_M; m += NGW) {
        const f32x4* xr = (const f32x4*)(H + (size_t)m * DM) + lane;
        f32x4 v[4]; float s = 0.f;
#pragma unroll
        for (int j = 0; j < 4; ++j) v[j] = xr[64 * j];
        if (m >= ROW_S) {
            for (int sl = 0; sl < 8; ++sl) { const f32x4* sr = (const f32x4*)(SLAB + (size_t)sl * (1280 * 1024) + (size_t)(m - ROW_S) * DM) + lane;
#pragma unroll
                for (int j = 0; j < 4; ++j) v[j] = v[j] + sr[64 * j]; }
        }
#pragma unroll
        for (int j = 0; j < 4; ++j) s += (v[j].x * v[j].x + v[j].y * v[j].y) + (v[j].z * v[j].z + v[j].w * v[j].w);
        const float rs = rsqrtf(wave_sum(s) * (1.f / DM) + EPS);
        f32x4* o = (f32x4*)(a->out + O_YP + (size_t)m * DM) + lane;
#pragma unroll
        for (int j = 0; j < 4; ++j) o[64 * j] = v[j] * rs * w[j];
    }
}

__device__ __forceinline__ void unpack8(const u32x4 w, float (&f)[8]) { f[0] = bflo(w.x); f[1] = bfhi(w.x); f[2] = bflo(w.y); f[3] = bfhi(w.y); f[4] = bflo(w.z); f[5] = bfhi(w.z); f[6] = bflo(w.w); f[7] = bfhi(w.w); }
__device__ __forceinline__ void phase_conv(ArgsP a, int li) {
    const bf16* ZX = (const bf16*)(a->ws + WS_ZX); bf16* XC = (bf16*)(a->ws + WS_XC);
    const float* cw = a->in[I_ACONVW] + (size_t)li * 4 * CONVD; const float* cb = a->in[I_ACONVB] + (size_t)li * CONVD;
    const float* sconv = a->in[I_SCONV] + (size_t)li * NSAMP * 3 * CONVD;
    constexpr int NRUNS = 2048 + 128 + 2;
    const int gt = blockIdx.x * NTHREADS + ltid(), NT = gridDim.x * NTHREADS;
    for (int item = gt; item < NRUNS * 512; item += NT) {
        const int run = item >> 9, c0 = (item & 511) * 8;
        int R0, kind, b = 0; bool last = false;
        if (run < 2048) { kind = 0; b = run >> 10; const int t0 = (run & 1023) * 8; R0 = b * SEQ + t0; last = (t0 == SEQ - 8); }
        else if (run < 2176) { kind = 1; b = run - 2048; R0 = ROW_S + b * 8; last = true; }
        else { kind = 2; R0 = ROW_M + (run - 2176) * 8; }
        float w0[8], w1[8], w2[8], w3[8], bs[8];
        { const f32x4* p = (const f32x4*)(cw + c0); f32x4 x0 = p[0], x1 = p[1]; w0[0]=x0.x;w0[1]=x0.y;w0[2]=x0.z;w0[3]=x0.w;w0[4]=x1.x;w0[5]=x1.y;w0[6]=x1.z;w0[7]=x1.w; }
        { const f32x4* p = (const f32x4*)(cw + CONVD + c0); f32x4 x0 = p[0], x1 = p[1]; w1[0]=x0.x;w1[1]=x0.y;w1[2]=x0.z;w1[3]=x0.w;w1[4]=x1.x;w1[5]=x1.y;w1[6]=x1.z;w1[7]=x1.w; }
        { const f32x4* p = (const f32x4*)(cw + 2 * CONVD + c0); f32x4 x0 = p[0], x1 = p[1]; w2[0]=x0.x;w2[1]=x0.y;w2[2]=x0.z;w2[3]=x0.w;w2[4]=x1.x;w2[5]=x1.y;w2[6]=x1.z;w2[7]=x1.w; }
        { const f32x4* p = (const f32x4*)(cw + 3 * CONVD + c0); f32x4 x0 = p[0], x1 = p[1]; w3[0]=x0.x;w3[1]=x0.y;w3[2]=x0.z;w3[3]=x0.w;w3[4]=x1.x;w3[5]=x1.y;w3[6]=x1.z;w3[7]=x1.w; }
        { const f32x4* p = (const f32x4*)(cb + c0); f32x4 x0 = p[0], x1 = p[1]; bs[0]=x0.x;bs[1]=x0.y;bs[2]=x0.z;bs[3]=x0.w;bs[4]=x1.x;bs[5]=x1.y;bs[6]=x1.z;bs[7]=x1.w; }
        float p0[8], p1[8], p2[8];
        const bool first = (kind == 0) ? ((run & 1023) == 0) : (kind == 1) ? true : (run == 2176);
        if (!first) {
            unpack8(*(const u32x4*)(ZX + (size_t)(R0 - 3) * ZXW + 2048 + c0), p0);
            unpack8(*(const u32x4*)(ZX + (size_t)(R0 - 2) * ZXW + 2048 + c0), p1);
            unpack8(*(const u32x4*)(ZX + (size_t)(R0 - 1) * ZXW + 2048 + c0), p2);
        } else if (kind == 0) {
            unpack8(*(const u32x4*)(ZX + (size_t)(ROW_M + 13) * ZXW + 2048 + c0), p0);
            unpack8(*(const u32x4*)(ZX + (size_t)(ROW_M + 14) * ZXW + 2048 + c0), p1);
            unpack8(*(const u32x4*)(ZX + (size_t)(ROW_M + 15) * ZXW + 2048 + c0), p2);
        } else if (kind == 1) {
            const float* s = sconv + (size_t)b * 3 * CONVD + c0;
            { f32x4 x0 = *(const f32x4*)(s), x1 = *(const f32x4*)(s + 4); p0[0]=x0.x;p0[1]=x0.y;p0[2]=x0.z;p0[3]=x0.w;p0[4]=x1.x;p0[5]=x1.y;p0[6]=x1.z;p0[7]=x1.w; }
            { f32x4 x0 = *(const f32x4*)(s + CONVD), x1 = *(const f32x4*)(s + CONVD + 4); p1[0]=x0.x;p1[1]=x0.y;p1[2]=x0.z;p1[3]=x0.w;p1[4]=x1.x;p1[5]=x1.y;p1[6]=x1.z;p1[7]=x1.w; }
            { f32x4 x0 = *(const f32x4*)(s + 2 * CONVD), x1 = *(const f32x4*)(s + 2 * CONVD + 4); p2[0]=x0.x;p2[1]=x0.y;p2[2]=x0.z;p2[3]=x0.w;p2[4]=x1.x;p2[5]=x1.y;p2[6]=x1.z;p2[7]=x1.w; }
        } else {
#pragma unroll
            for (int j = 0; j < 8; ++j) { p0[j] = 0.f; p1[j] = 0.f; p2[j] = 0.f; }
        }
#pragma unroll
        for (int t = 0; t < 8; ++t) {
            float x[8]; unpack8(*(const u32x4*)(ZX + (size_t)(R0 + t) * ZXW + 2048 + c0), x);
            float o[8];
#pragma unroll
            for (int j = 0; j < 8; ++j) { const float v = bs[j] + w0[j] * p0[j] + w1[j] * p1[j] + w2[j] * p2[j] + w3[j] * x[j]; o[j] = v * sigmoid_f(v); }
            u32x4 w; w.x = pkbf(o[0], o[1]); w.y = pkbf(o[2], o[3]); w.z = pkbf(o[4], o[5]); w.w = pkbf(o[6], o[7]);
            *(u32x4*)(XC + (size_t)(R0 + t) * CONVD + c0) = w;
            if (last && t >= 5 && kind != 2) {
                float* dst = (kind == 0) ? a->out + O_PCONV + ((size_t)(li * NPROMPT + b) * 3 + (t - 5)) * CONVD + c0 : a->out + O_SCONV + ((size_t)(li * NSAMP + b) * 3 + (t - 5)) * CONVD + c0;
                *(f32x4*)(dst) = (f32x4){x[0], x[1], x[2], x[3]}; *(f32x4*)(dst + 4) = (f32x4){x[4], x[5], x[6], x[7]};
            }
#pragma unroll
            for (int j = 0; j < 8; ++j) { p0[j] = p1[j]; p1[j] = p2[j]; p2[j] = x[j]; }
        }
    }
}

__device__ __forceinline__ void ssd_acs(const float* DT, const float* alog, int R0, int len, int h0, float* s_dt, float* s_acs, int wave, int lane) {
    if (wave < 4) {
        const int r = wave; const float An = -__expf(alog[h0 + r]);
        const int l0 = 2 * lane;
        const float d0 = (l0 < len) ? DT[(size_t)(R0 + l0) * 32 + h0 + r] : 0.f;
        const float d1 = (l0 + 1 < len) ? DT[(size_t)(R0 + l0 + 1) * 32 + h0 + r] : 0.f;
        const float a0 = d0 * An, a1 = d1 * An, s = a0 + a1;
        float incl = s;
#pragma unroll
        for (int o = 1; o < 64; o <<= 1) { const float t = __shfl_up(incl, o); if (lane >= o) incl += t; }
        const float excl = incl - s;
        s_dt[r * 128 + l0] = d0; s_dt[r * 128 + l0 + 1] = d1;
        s_acs[r * 128 + l0] = excl + a0; s_acs[r * 128 + l0 + 1] = excl + s;
    }
}
#define LFRAG(base, row, ld, ks) (*(const bf16x8*)((base) + (row) * (ld) + 32 * (ks) + 8 * fq))

__device__ __forceinline__ void ssd1_unit(ArgsP a, int li, unsigned char* lds, int slot, int g, int R0, int len, int, int, int) {
    const int tid = ltid(), lane = tid & 63, wave = __builtin_amdgcn_readfirstlane(tid >> 6);
    const bf16* XC = (const bf16*)(a->ws + WS_XC); const float* DT = (const float*)(a->ws + WS_DT);
    float* CS = (float*)(a->ws + WS_CS); float* CD = (float*)(a->ws + WS_CD);
    bf16* XsT = (bf16*)lds;
    bf16* BT = (bf16*)(lds + 256 * LDX * 2);
    float* s_dt = (float*)(lds + 384 * LDX * 2); float* s_acs = s_dt + 512;
    const int fr = lane & 15, fq = lane >> 4, h0 = g * 4;
    ssd_acs(DT, a->in[I_ALOG] + li * NHEADS, R0, len, h0, s_dt, s_acs, wave, lane);
    __syncthreads();
#pragma unroll
    for (int k = 0; k < 4; ++k) {
        const int item = tid + NTHREADS * k, cb = item & 31, tp = item >> 5, l = 2 * tp, r = cb >> 3;
        u32x4 v0 = (u32x4){0u, 0u, 0u, 0u}, v1 = v0;
        if (l < len) v0 = *(const u32x4*)(XC + (size_t)(R0 + l) * CONVD + g * 256 + cb * 8);
        if (l + 1 < len) v1 = *(const u32x4*)(XC + (size_t)(R0 + l + 1) * CONVD + g * 256 + cb * 8);
        const float tot = s_acs[r * 128 + 127];
        const float w0 = __expf(tot - s_acs[r * 128 + l]) * s_dt[r * 128 + l], w1 = __expf(tot - s_acs[r * 128 + l + 1]) * s_dt[r * 128 + l + 1];
        float x0[8], x1[8]; unpack8(v0, x0); unpack8(v1, x1);
#pragma unroll
        for (int j = 0; j < 8; ++j) *(unsigned*)(XsT + (cb * 8 + j) * LDX + l) = pkbf(x0[j] * w0, x1[j] * w1);
    }
#pragma unroll
    for (int k = 0; k < 2; ++k) {
        const int item = tid + NTHREADS * k, cb = item & 15, tp = item >> 4, l = 2 * tp;
        u32x4 v0 = (u32x4){0u, 0u, 0u, 0u}, v1 = v0;
        if (l < len) v0 = *(const u32x4*)(XC + (size_t)(R0 + l) * CONVD + 2048 + g * 128 + cb * 8);
        if (l + 1 < len) v1 = *(const u32x4*)(XC + (size_t)(R0 + l + 1) * CONVD + 2048 + g * 128 + cb * 8);
        const unsigned a0[4] = {v0.x, v0.y, v0.z, v0.w}, a1[4] = {v1.x, v1.y, v1.z, v1.w};
#pragma unroll
        for (int j = 0; j < 4; ++j) {
            *(unsigned*)(BT + (cb * 8 + 2 * j) * LDX + l) = (a0[j] & 0xffffu) | (a1[j] << 16);
            *(unsigned*)(BT + (cb * 8 + 2 * j + 1) * LDX + l) = (a0[j] >> 16) | (a1[j] & 0xffff0000u);
        }
    }
    __syncthreads();
    f32x4 acc[2][8];
#pragma unroll
    for (int mi = 0; mi < 2; ++mi)
#pragma unroll
        for (int ni = 0; ni < 8; ++ni) acc[mi][ni] = (f32x4){0.f, 0.f, 0.f, 0.f};
#pragma unroll
    for (int ks = 0; ks < 4; ++ks) {
        const bf16x8 a0 = LFRAG(XsT, 32 * wave + fr, LDX, ks), a1 = LFRAG(XsT, 32 * wave + 16 + fr, LDX, ks);
#pragma unroll
        for (int ni = 0; ni < 8; ++ni) { const bf16x8 bb = LFRAG(BT, 16 * ni + fr, LDX, ks); acc[0][ni] = MFMA16(bb, a0, acc[0][ni]); acc[1][ni] = MFMA16(bb, a1, acc[1][ni]); }
    }
#pragma unroll
    for (int mi = 0; mi < 2; ++mi) { const int hp = 32 * wave + 16 * mi + fr, r = hp >> 6, p = hp & 63;
        float* dst = CS + ((size_t)(slot * 32 + h0 + r) * 64 + p) * 128 + 4 * fq;
#pragma unroll
        for (int ni = 0; ni < 8; ++ni) *(f32x4*)(dst + 16 * ni) = acc[mi][ni]; }
    if (tid < 4) CD[slot * 32 + h0 + tid] = __expf(s_acs[tid * 128 + 127]);
    __syncthreads();
}

__device__ __forceinline__ void ssd_sample_unit(ArgsP a, int li, unsigned char* lds, int b, int g, int, int, int) {
    const int tid = ltid(), lane = tid & 63, wave = __builtin_amdgcn_readfirstlane(tid >> 6);
    const bf16* XC = (const bf16*)(a->ws + WS_XC); const bf16* ZX = (const bf16*)(a->ws + WS_ZX); const float* DT = (const float*)(a->ws + WS_DT); bf16* YN = (bf16*)(a->ws + WS_YN);
    float* sX = (float*)lds; float* sB = sX + 8 * 256; float* sC = sB + 8 * 128; float* sY = sC + 8 * 128; float* sDt = sY + 8 * 256;
    const int R0 = ROW_S + b * 8, h0 = g * 4;
    for (int idx = tid; idx < 8 * 512; idx += NTHREADS) { const int t = idx >> 9, c = idx & 511; const bf16* row = XC + (size_t)(R0 + t) * CONVD;
        if (c < 256) sX[t * 256 + c] = bf2f(row[g * 256 + c]); else if (c < 384) sB[t * 128 + c - 256] = bf2f(row[2048 + g * 128 + c - 256]); else sC[t * 128 + c - 384] = bf2f(row[3072 + g * 128 + c - 384]); }
    if (tid < 32) sDt[tid] = DT[(size_t)(R0 + (tid >> 2)) * 32 + h0 + (tid & 3)];
    __syncthreads();
    const int p = tid >> 3, nb = tid & 7;
#pragma unroll 1
    for (int r = 0; r < 4; ++r) {
        const int h = h0 + r;
        const float An = -__expf(a->in[I_ALOG][li * NHEADS + h]), Dk = a->in[I_ADSKIP][li * NHEADS + h];
        const float* sin_ = a->in[I_SSSM] + ((size_t)((li * NSAMP + b) * NHEADS + h) * 64 + p) * 128 + 4 * nb;
        float* sout = a->out + O_SSSM + ((size_t)((li * NSAMP + b) * NHEADS + h) * 64 + p) * 128 + 4 * nb;
        f32x4 st[4];
#pragma unroll
        for (int kk = 0; kk < 4; ++kk) st[kk] = *(const f32x4*)(sin_ + 32 * kk);
#pragma unroll
        for (int t = 0; t < 8; ++t) {
            const float dt = sDt[t * 4 + r], dA = __expf(dt * An), xv = sX[t * 256 + r * 64 + p], coef = dt * xv;
            float part = 0.f;
#pragma unroll
            for (int kk = 0; kk < 4; ++kk) { const f32x4 bv = *(const f32x4*)(sB + t * 128 + 32 * kk + 4 * nb), cv = *(const f32x4*)(sC + t * 128 + 32 * kk + 4 * nb);
                st[kk] = st[kk] * dA + bv * coef; part += (cv.x * st[kk].x + cv.y * st[kk].y) + (cv.z * st[kk].z + cv.w * st[kk].w); }
            part += __shfl_xor(part, 1); part += __shfl_xor(part, 2); part += __shfl_xor(part, 4);
            if (nb == 0) sY[t * 256 + r * 64 + p] = part + Dk * xv;
        }
#pragma unroll
        for (int kk = 0; kk < 4; ++kk) *(f32x4*)(sout + 32 * kk) = st[kk];
    }
    __syncthreads();
    {
        const int t = wave, c4 = lane * 4; const size_t row = (size_t)(R0 + t);
        const f32x4 y = *(const f32x4*)(sY + t * 256 + c4);
        const u32x2 zz = *(const u32x2*)(ZX + row * ZXW + g * 256 + c4);
        const float z0 = bflo(zz.x), z1 = bfhi(zz.x), z2 = bflo(zz.y), z3 = bfhi(zz.y);
        const float g0 = y.x * z0 * sigmoid_f(z0), g1 = y.y * z1 * sigmoid_f(z1), g2 = y.z * z2 * sigmoid_f(z2), g3 = y.w * z3 * sigmoid_f(z3);
        const float ss = wave_sum((g0 * g0 + g1 * g1) + (g2 * g2 + g3 * g3));
        const float rs = rsqrtf(ss * (1.f / 256.f) + EPS);
        u32x2 o; o.x = pkbf(g0 * rs, g1 * rs); o.y = pkbf(g2 * rs, g3 * rs);
        *(u32x2*)(YN + row * DINNER + g * 256 + c4) = o;
    }
    __syncthreads();
}

__device__ __forceinline__ void phase_ssd1(ArgsP a, int li, unsigned char* lds, int tid, int wave, int lane) {
    for (int u = blockIdx.x; u < 1032 + 1024; u += gridDim.x) {
        if (u < 1024) { const int slot = u >> 3, g = u & 7; ssd1_unit(a, li, lds, slot, g, (slot >> 6) * SEQ + (slot & 63) * 128, 128, tid, wave, lane); }
        else if (u < 1032) ssd1_unit(a, li, lds, 128, u - 1024, ROW_M, NMETA, tid, wave, lane);
        else { const int su = u - 1032; ssd_sample_unit(a, li, lds, su >> 3, su & 7, tid, wave, lane); }
    }
}

__device__ __forceinline__ void phase_scan(ArgsP a, int li) {
    float* CS = (float*)(a->ws + WS_CS); const float* CD = (const float*)(a->ws + WS_CD);
    const int gt = blockIdx.x * NTHREADS + ltid(), NT = gridDim.x * NTHREADS;
    for (int e = gt; e < 2 * 65536; e += NT) {
        const int b = e >> 16, rem = e & 65535, h = rem >> 11, pn4 = rem & 2047;
        f32x4 hc = *(const f32x4*)(CS + ((size_t)(128 * 32 + h) * 2048 + pn4) * 4);
#pragma unroll 8
        for (int c = 0; c < 64; ++c) { const int slot = b * 64 + c; f32x4* p = (f32x4*)(CS + ((size_t)(slot * 32 + h) * 2048 + pn4) * 4);
            const f32x4 s = *p; const float d = CD[slot * 32 + h]; *p = hc; hc = hc * d + s; }
        *(f32x4*)(a->out + O_PSSM + ((size_t)((li * NPROMPT + b) * NHEADS + h) * 2048 + pn4) * 4) = hc;
    }
}

__device__ __forceinline__ void ssd3_unit(ArgsP a, int li, unsigned char* lds, const float* hs, int g, int R0, int len, int, int, int) {
    const int tid = ltid(), lane = tid & 63, wave = __builtin_amdgcn_readfirstlane(tid >> 6);
    const bf16* XC = (const bf16*)(a->ws + WS_XC); const bf16* ZX = (const bf16*)(a->ws + WS_ZX); const float* DT = (const float*)(a->ws + WS_DT); bf16* YN = (bf16*)(a->ws + WS_YN);
    bf16* Cn = (bf16*)lds; bf16* Mb = Cn + 128 * LDX; bf16* Xt = Mb + 128 * LDX; bf16* Hs = Xt + 64 * LDX;
    float* s_dt = (float*)(Hs + 64 * LDX); float* s_acs = s_dt + 512;
    const int fr = lane & 15, fq = lane >> 4, h0 = g * 4;
    ssd_acs(DT, a->in[I_ALOG] + li * NHEADS, R0, len, h0, s_dt, s_acs, wave, lane);
#pragma unroll
    for (int k = 0; k < 4; ++k) { const int item = tid + NTHREADS * k, l = item >> 4, ch = item & 15;
        u32x4 vc = (u32x4){0u, 0u, 0u, 0u}, vb = vc;
        if (l < len) { vc = *(const u32x4*)(XC + (size_t)(R0 + l) * CONVD + 3072 + g * 128 + ch * 8); vb = *(const u32x4*)(XC + (size_t)(R0 + l) * CONVD + 2048 + g * 128 + ch * 8); }
        *(u32x4*)(Cn + l * LDX + ch * 8) = vc; *(u32x4*)(Mb + l * LDX + ch * 8) = vb; }
    __syncthreads();
    f32x4 cb[8];
#pragma unroll
    for (int ni = 0; ni < 8; ++ni) cb[ni] = (f32x4){0.f, 0.f, 0.f, 0.f};
#pragma unroll
    for (int ks = 0; ks < 4; ++ks) { const bf16x8 af = LFRAG(Cn, 16 * wave + fr, LDX, ks);
#pragma unroll
        for (int ni = 0; ni < 8; ++ni) if (ni <= wave) { const bf16x8 bb = LFRAG(Mb, 16 * ni + fr, LDX, ks); cb[ni] = MFMA16(bb, af, cb[ni]); } }
    __syncthreads();
    const int l = 16 * wave + fr;
    const size_t row = (size_t)(R0 + ((l < len) ? l : 0));
    f32x4 y0[4], y1[4], y2[4], y3[4];
#pragma unroll
    for (int ni = 0; ni < 4; ++ni) { y0[ni] = (f32x4){0.f, 0.f, 0.f, 0.f}; y1[ni] = y0[ni]; y2[ni] = y0[ni]; y3[ni] = y0[ni]; }
    float ss = 0.f;
#pragma unroll 1
    for (int r = 0; r < 4; ++r) {
        const float al = s_acs[r * 128 + l];
#pragma unroll
        for (int ni = 0; ni < 8; ++ni) { const int s0 = 16 * ni + 4 * fq; float m[4];
#pragma unroll
            for (int j = 0; j < 4; ++j) { const int s = s0 + j; m[j] = (s <= l) ? cb[ni][j] * __expf(al - s_acs[r * 128 + s]) * s_dt[r * 128 + s] : 0.f; }
            u32x2 w; w.x = pkbf(m[0], m[1]); w.y = pkbf(m[2], m[3]); *(u32x2*)(Mb + l * LDX + s0) = w; }
        { const int cbl = tid & 7, tp = tid >> 3, l0 = 2 * tp;
            u32x4 v0 = (u32x4){0u, 0u, 0u, 0u}, v1 = v0;
            if (l0 < len) v0 = *(const u32x4*)(XC + (size_t)(R0 + l0) * CONVD + g * 256 + r * 64 + cbl * 8);
            if (l0 + 1 < len) v1 = *(const u32x4*)(XC + (size_t)(R0 + l0 + 1) * CONVD + g * 256 + r * 64 + cbl * 8);
            const unsigned a0[4] = {v0.x, v0.y, v0.z, v0.w}, a1[4] = {v1.x, v1.y, v1.z, v1.w};
#pragma unroll
            for (int j = 0; j < 4; ++j) {
                *(unsigned*)(Xt + (cbl * 8 + 2 * j) * LDX + l0) = (a0[j] & 0xffffu) | (a1[j] << 16);
                *(unsigned*)(Xt + (cbl * 8 + 2 * j + 1) * LDX + l0) = (a0[j] >> 16) | (a1[j] & 0xffff0000u); } }
#pragma unroll
        for (int k = 0; k < 4; ++k) { const int item = tid + NTHREADS * k, p = item >> 5, n4 = item & 31;
            f32x4 v = (f32x4){0.f, 0.f, 0.f, 0.f}; if (hs) v = *(const f32x4*)(hs + ((size_t)(r * 64 + p) * 128) + n4 * 4);
            u32x2 w; w.x = pkbf(v.x, v.y); w.y = pkbf(v.z, v.w); *(u32x2*)(Hs + p * LDX + n4 * 4) = w; }
        __syncthreads();
        f32x4 yd[4], yo[4];
#pragma unroll
        for (int ni = 0; ni < 4; ++ni) { yd[ni] = (f32x4){0.f, 0.f, 0.f, 0.f}; yo[ni] = yd[ni]; }
#pragma unroll
        for (int ks = 0; ks < 4; ++ks) { const bf16x8 af = LFRAG(Mb, l, LDX, ks);
#pragma unroll
            for (int ni = 0; ni < 4; ++ni) { const bf16x8 bb = LFRAG(Xt, 16 * ni + fr, LDX, ks); yd[ni] = MFMA16(bb, af, yd[ni]); } }
#pragma unroll
        for (int ks = 0; ks < 4; ++ks) { const bf16x8 af = LFRAG(Cn, l, LDX, ks);
#pragma unroll
            for (int ni = 0; ni < 4; ++ni) { const bf16x8 bb = LFRAG(Hs, 16 * ni + fr, LDX, ks); yo[ni] = MFMA16(bb, af, yo[ni]); } }
        const float e = __expf(al);
        const float Dk = a->in[I_ADSKIP][li * NHEADS + h0 + r];
#pragma unroll
        for (int ni = 0; ni < 4; ++ni) { const int ch = g * 256 + r * 64 + 16 * ni + 4 * fq;
            const u32x2 xx = *(const u32x2*)(XC + row * CONVD + ch), zz = *(const u32x2*)(ZX + row * ZXW + ch);
            const float xv[4] = {bflo(xx.x), bfhi(xx.x), bflo(xx.y), bfhi(xx.y)}, zv[4] = {bflo(zz.x), bfhi(zz.x), bflo(zz.y), bfhi(zz.y)};
            f32x4 v = yd[ni] + yo[ni] * e;
#pragma unroll
            for (int j = 0; j < 4; ++j) { const float q = (v[j] + Dk * xv[j]) * zv[j] * sigmoid_f(zv[j]); v[j] = q; ss += q * q; }
            yd[ni] = v; }
        if (r == 0) {
#pragma unroll
            for (int ni = 0; ni < 4; ++ni) y0[ni] = yd[ni];
        } else if (r == 1) {
#pragma unroll
            for (int ni = 0; ni < 4; ++ni) y1[ni] = yd[ni];
        } else if (r == 2) {
#pragma unroll
            for (int ni = 0; ni < 4; ++ni) y2[ni] = yd[ni];
        } else {
#pragma unroll
            for (int ni = 0; ni < 4; ++ni) y3[ni] = yd[ni];
        }
        __syncthreads();
    }
    ss += __shfl_xor(ss, 16); ss += __shfl_xor(ss, 32);
    const float rs = rsqrtf(ss * (1.f / 256.f) + EPS);
    if (l < len) {
        bf16* yrow = YN + row * DINNER + g * 256 + 4 * fq;
#pragma unroll
        for (int ni = 0; ni < 4; ++ni) {
            u32x2 w;
            w.x = pkbf(y0[ni][0] * rs, y0[ni][1] * rs); w.y = pkbf(y0[ni][2] * rs, y0[ni][3] * rs); *(u32x2*)(yrow + 0 * 64 + 16 * ni) = w;
            w.x = pkbf(y1[ni][0] * rs, y1[ni][1] * rs); w.y = pkbf(y1[ni][2] * rs, y1[ni][3] * rs); *(u32x2*)(yrow + 1 * 64 + 16 * ni) = w;
            w.x = pkbf(y2[ni][0] * rs, y2[ni][1] * rs); w.y = pkbf(y2[ni][2] * rs, y2[ni][3] * rs); *(u32x2*)(yrow + 2 * 64 + 16 * ni) = w;
            w.x = pkbf(y3[ni][0] * rs, y3[ni][1] * rs); w.y = pkbf(y3[ni][2] * rs, y3[ni][3] * rs); *(u32x2*)(yrow + 3 * 64 + 16 * ni) = w;
        }
    }
}
__device__ __forceinline__ void phase_ssd3(ArgsP a, int li, unsigned char* lds, int tid, int wave, int lane) {
    const float* CS = (const float*)(a->ws + WS_CS);
    for (int u = blockIdx.x; u < 1032; u += gridDim.x) {
        if (u < 1024) { const int slot = u >> 3, g = u & 7; ssd3_unit(a, li, lds, CS + (size_t)(slot * 32 + g * 4) * 8192, g, (slot >> 6) * SEQ + (slot & 63) * 128, 128, tid, wave, lane); }
        else ssd3_unit(a, li, lds, nullptr, u - 1024, ROW_M, NMETA, tid, wave, lane);
    }
}

constexpr int KS_LD = 72, VT_LD = 232, NKEYS = 208;
__device__ __forceinline__ void attn_prompt_unit(ArgsP a, int lj, unsigned char* lds, int b, int kvh, int qb, int, int, int) {
    const int tid = ltid(), lane = tid & 63, wave = __builtin_amdgcn_readfirstlane(tid >> 6);
    const bf16* Q = (const bf16*)(a->ws + WS_Q); const bf16* KV = (const bf16*)(a->ws + WS_KV); bf16* AO = (bf16*)(a->ws + WS_AO);
    bf16* Ks = (bf16*)lds; bf16* Vt = Ks + NKEYS * KS_LD; bf16* Pw = Vt + 64 * VT_LD + wave * 16 * VT_LD;
    const int fr = lane & 15, fq = lane >> 4, t0 = qb * 64, Rb = b * SEQ;
    for (int it = tid; it < NKEYS * 8; it += NTHREADS) { const int key = it >> 3, ch = it & 7;
        int row; if (key < 16) row = ROW_M + key; else { int s = t0 - 128 + key - 16; if (s < 0) s = 0; row = Rb + s; }
        *(u32x4*)(Ks + key * KS_LD + ch * 8) = *(const u32x4*)(KV + (size_t)row * KVW + kvh * 64 + ch * 8); }
    for (int it = tid; it < (NKEYS / 2) * 8; it += NTHREADS) { const int dbl = it & 7, kp = it >> 3;
        int r0, r1; { const int k0 = 2 * kp, k1 = k0 + 1; int s0 = t0 - 128 + k0 - 16, s1 = t0 - 128 + k1 - 16; if (s0 < 0) s0 = 0; if (s1 < 0) s1 = 0; r0 = (k0 < 16) ? ROW_M + k0 : Rb + s0; r1 = (k1 < 16) ? ROW_M + k1 : Rb + s1; }
        const u32x4 v0 = *(const u32x4*)(KV + (size_t)r0 * KVW + 256 + kvh * 64 + dbl * 8), v1 = *(const u32x4*)(KV + (size_t)r1 * KVW + 256 + kvh * 64 + dbl * 8);
        const unsigned a0[4] = {v0.x, v0.y, v0.z, v0.w}, a1[4] = {v1.x, v1.y, v1.z, v1.w};
#pragma unroll
        for (int j = 0; j < 4; ++j) {
            *(unsigned*)(Vt + (dbl * 8 + 2 * j) * VT_LD + 2 * kp) = (a0[j] & 0xffffu) | (a1[j] << 16);
            *(unsigned*)(Vt + (dbl * 8 + 2 * j + 1) * VT_LD + 2 * kp) = (a0[j] >> 16) | (a1[j] & 0xffff0000u); } }
    { const int row = tid >> 3, c = NKEYS + 2 * (tid & 7); *(unsigned*)(Vt + row * VT_LD + c) = 0u; }
    __syncthreads();
    const int r = wave >> 1, th = (wave & 1) * 32, qh = kvh * 4 + r;
    const float sink = a->in[I_SINKS][lj * NQ + qh];
#pragma unroll 1
    for (int blk = 0; blk < 2; ++blk) {
        const int tq0 = t0 + th + blk * 16, t = tq0 + fr;
        bf16x8 qa[2];
#pragma unroll
        for (int ks = 0; ks < 2; ++ks) qa[ks] = *(const bf16x8*)(Q + (size_t)(Rb + t) * DM + qh * 64 + 32 * ks + 8 * fq);
        f32x4 sc[13];
#pragma unroll
        for (int ni = 0; ni < 13; ++ni) sc[ni] = (f32x4){0.f, 0.f, 0.f, 0.f};
#pragma unroll
        for (int ni = 0; ni < 13; ++ni) {
            const bf16x8 b0 = *(const bf16x8*)(Ks + (16 * ni + fr) * KS_LD + 8 * fq), b1 = *(const bf16x8*)(Ks + (16 * ni + fr) * KS_LD + 32 + 8 * fq);
            sc[ni] = MFMA16(b0, qa[0], sc[ni]); sc[ni] = MFMA16(b1, qa[1], sc[ni]);
            if ((ni & 3) == 3) asm volatile("" ::: "memory"); }
        float mx = -INFINITY;
#pragma unroll
        for (int ni = 0; ni < 13; ++ni)
#pragma unroll
            for (int j = 0; j < 4; ++j) { const int key = 16 * ni + 4 * fq + j; bool vis = true;
                if (key >= 16) { const int s = t0 - 128 + key - 16; vis = (s >= 0) && (s <= t) && (s > t - 128); }
                const float v = vis ? sc[ni][j] * 0.125f : -INFINITY; sc[ni][j] = v; mx = fmaxf(mx, v); }
        mx = fmaxf(mx, __shfl_xor(mx, 16)); mx = fmaxf(mx, __shfl_xor(mx, 32)); mx = fmaxf(mx, sink);
        float sum = 0.f;
#pragma unroll
        for (int ni = 0; ni < 13; ++ni)
#pragma unroll
            for (int j = 0; j < 4; ++j) { const float p = __expf(sc[ni][j] - mx); sc[ni][j] = p; sum += p; }
        sum += __shfl_xor(sum, 16); sum += __shfl_xor(sum, 32); sum += __expf(sink - mx);
        const float inv = 1.f / sum;
#pragma unroll
        for (int ni = 0; ni < 13; ++ni) { u32x2 w; w.x = pkbf(sc[ni][0] * inv, sc[ni][1] * inv); w.y = pkbf(sc[ni][2] * inv, sc[ni][3] * inv); *(u32x2*)(Pw + fr * VT_LD + 16 * ni + 4 * fq) = w; }
        *(u32x2*)(Pw + fr * VT_LD + NKEYS + 4 * fq) = (u32x2){0u, 0u};
        asm volatile("s_waitcnt lgkmcnt(0)" ::: "memory");
        f32x4 o[4];
#pragma unroll
        for (int ni = 0; ni < 4; ++ni) o[ni] = (f32x4){0.f, 0.f, 0.f, 0.f};
#pragma unroll
        for (int ks = 0; ks < 7; ++ks) { const bf16x8 af = *(const bf16x8*)(Pw + fr * VT_LD + 32 * ks + 8 * fq);
#pragma unroll
            for (int ni = 0; ni < 4; ++ni) { const bf16x8 bb = *(const bf16x8*)(Vt + (16 * ni + fr) * VT_LD + 32 * ks + 8 * fq); o[ni] = MFMA16(bb, af, o[ni]); }
            if (ks & 1) asm volatile("" ::: "memory"); }
#pragma unroll
        for (int ni = 0; ni < 4; ++ni) { u32x2 w; w.x = pkbf(o[ni][0], o[ni][1]); w.y = pkbf(o[ni][2], o[ni][3]); *(u32x2*)(AO + (size_t)(Rb + t) * DM + qh * 64 + 16 * ni + 4 * fq) = w; }
        asm volatile("s_waitcnt lgkmcnt(0)" ::: "memory");
    }
    __syncthreads();
}
__device__ __forceinline__ void attn_sample_unit(ArgsP a, int lj, unsigned char* lds, int b, int kvh, int, int, int) {
    const int tid = ltid(), lane = tid & 63, wave = __builtin_amdgcn_readfirstlane(tid >> 6);
    const bf16* Q = (const bf16*)(a->ws + WS_Q); const bf16* KV = (const bf16*)(a->ws + WS_KV); bf16* AO = (bf16*)(a->ws + WS_AO);
    float* Kf = (float*)lds; float* Vf = Kf + 152 * 65; float* Qf = Vf + 152 * 64; float* Sc = Qf + 32 * 64;
    for (int idx = tid; idx < 152 * 64; idx += NTHREADS) { const int s = idx >> 6, d = idx & 63; float kv, vv;
        if (s < 16) { const bf16* rowp = KV + (size_t)(ROW_M + s) * KVW + kvh * 64 + d; kv = bf2f(rowp[0]); vv = bf2f(rowp[256]); }
        else if (s < 144) { const size_t o = ((size_t)(b * 128 + (s - 16)) * NKV + kvh) * 64 + d; kv = a->in[I_CK][o]; vv = a->in[I_CV][o]; }
        else { const bf16* rowp = KV + (size_t)(ROW_S + b * 8 + (s - 144)) * KVW + kvh * 64 + d; kv = bf2f(rowp[0]); vv = bf2f(rowp[256]); }
        Kf[s * 65 + d] = kv; Vf[s * 64 + d] = vv; }
    for (int idx = tid; idx < 32 * 64; idx += NTHREADS) { const int qi = idx >> 6, d = idx & 63, r = qi >> 3, t = qi & 7;
        Qf[qi * 64 + d] = bf2f(Q[(size_t)(ROW_S + b * 8 + t) * DM + (kvh * 4 + r) * 64 + d]); }
    __syncthreads();
    if (lj == 0) {
        for (int idx = tid; idx < 128 * 64; idx += NTHREADS) { const int w = idx >> 6, d = idx & 63; const size_t o = ((size_t)(b * 128 + w) * NKV + kvh) * 64 + d;
            a->out[O_SCK + o] = Kf[(24 + w) * 65 + d]; a->out[O_SCV + o] = Vf[(24 + w) * 64 + d]; }
    }
    for (int idx = tid; idx < 32 * 152; idx += NTHREADS) { const int qi = idx / 152, s = idx - qi * 152, t = qi & 7;
        float dot = 0.f;
#pragma unroll 16
        for (int d = 0; d < 64; ++d) dot += Qf[qi * 64 + d] * Kf[s * 65 + d];
        const bool vis = (s < 16) || ((s < 144) ? ((s - 16) > t) : ((s - 144) <= t));
        Sc[qi * 153 + s] = vis ? dot * 0.125f : -INFINITY; }
    __syncthreads();
#pragma unroll 1
    for (int q = 0; q < 4; ++q) { const int qi = wave * 4 + q, r = qi >> 3; const float sink = a->in[I_SINKS][lj * NQ + kvh * 4 + r];
        float v0 = Sc[qi * 153 + lane], v1 = Sc[qi * 153 + 64 + lane], v2 = (lane < 24) ? Sc[qi * 153 + 128 + lane] : -INFINITY;
        float mx = fmaxf(fmaxf(v0, v1), v2);
#pragma unroll
        for (int o = 1; o < 64; o <<= 1) mx = fmaxf(mx, __shfl_xor(mx, o));
        mx = fmaxf(mx, sink);
        v0 = __expf(v0 - mx); v1 = __expf(v1 - mx); v2 = __expf(v2 - mx);
        const float sum = wave_sum(v0 + v1 + v2) + __expf(sink - mx), inv = 1.f / sum;
        Sc[qi * 153 + lane] = v0 * inv; Sc[qi * 153 + 64 + lane] = v1 * inv; if (lane < 24) Sc[qi * 153 + 128 + lane] = v2 * inv; }
    __syncthreads();
    { const int qi = tid >> 4, d4 = (tid & 15) * 4, r = qi >> 3, t = qi & 7; f32x4 o = (f32x4){0.f, 0.f, 0.f, 0.f};
#pragma unroll 8
        for (int s = 0; s < 152; ++s) { const float p = Sc[qi * 153 + s]; const f32x4 v = *(const f32x4*)(Vf + s * 64 + d4); o = o + v * p; }
        u32x2 w; w.x = pkbf(o.x, o.y); w.y = pkbf(o.z, o.w);
        *(u32x2*)(AO + (size_t)(ROW_S + b * 8 + t) * DM + (kvh * 4 + r) * 64 + d4) = w; }
    __syncthreads();
}
__device__ __forceinline__ void phase_attn(ArgsP a, int lj, unsigned char* lds, int tid, int wave, int lane) {
    if (lj == 0) {
        const bf16* KV = (const bf16*)(a->ws + WS_KV);
        const int gt = blockIdx.x * NTHREADS + tid, NT = gridDim.x * NTHREADS;
        for (int e = gt; e < 2 * 128 * 512; e += NT) { const int b = e >> 16, w = (e >> 9) & 127, c = e & 511;
            const float v = bf2f(KV[(size_t)(b * SEQ + SEQ - 128 + w) * KVW + c]);
            if (c < 256) a->out[O_PCK + (size_t)(b * 128 + w) * 256 + c] = v; else a->out[O_PCV + (size_t)(b * 128 + w) * 256 + (c - 256)] = v; }
    }
    for (int u = blockIdx.x; u < 1024 + 512; u += gridDim.x) {
#ifndef NO_PROMPT_ATTN
        if (u < 1024) { const int qb = u & 127, kvh = (u >> 7) & 3, b = u >> 9; attn_prompt_unit(a, lj, lds, b, kvh, qb, tid, wave, lane); }
#else
        if (u < 1024) {}
#endif
#ifndef NO_SAMPLE_ATTN
        else { const int su = u - 1024; attn_sample_unit(a, lj, lds, su >> 2, su & 3, tid, wave, lane); }
#endif
    }
}

constexpr int NPHASES = 36;
template <class Epi> __device__ __forceinline__ void run_gemm(LAS unsigned char* lds, const bf16* A, const bf16* Bt, int N, int K, const Epi& E) {
    pg8::Gemm g{A, Bt, MP, N, K}; pg8::StaticOrder S; S.init(MP, N, K, (int)gridDim.x, (int)blockIdx.x);
    pg8::gemm_phase<Epi, pg8::StaticOrder, true, true>(lds, g, S, E);
}
template <class Epi> __device__ __forceinline__ void run_gemm_res(LAS unsigned char* lds, const bf16* A, const bf16* Bt, int K, int S_, const Epi& E) {
    pg8::Gemm g{A, Bt, MP, 1024, K}; pg8::ResOrder S; S.init(K, S_, (int)gridDim.x, (int)blockIdx.x);
    pg8::gemm_phase<Epi, pg8::ResOrder, true, true>(lds, g, S, E);
}

__global__ void __launch_bounds__(NTHREADS, 2) yoco_fwd(Args args) {
    extern __shared__ __attribute__((aligned(16))) unsigned char lds[];
    LAS unsigned char* ldsl = (LAS unsigned char*)lds;
    const int tid0 = threadIdx.x;
    for (int u = tid0; u < (LDS_BYTES - LDSCTL_OFF) / 4; u += NTHREADS) ((LAS unsigned*)(ldsl + LDSCTL_OFF))[u] = 0u;
    __syncthreads();
    const int lo = args.ph_lo, hi = args.ph_hi;
    XcdBarrier bar; bar.bar = (unsigned*)(args.ws + WS_CTL) + CW_BAR; bar.x = 0; bar.st = nullptr;
    if (hi - lo > 1) bar = xcd_barrier_post((unsigned*)(args.ws + WS_CTL) + CW_BAR, (volatile LAS unsigned*)(ldsl + MISC_OFF) + 8);
    int rep = 0;
#pragma unroll 1
    for (int p = lo; p < hi;) {
        ArgsP la = (ArgsP)__builtin_amdgcn_kernarg_segment_ptr(); asm volatile("" : "+s"(la));
        unsigned char* ws = la->ws;
        const int tid = ltid();
        const int lane = tid & 63, wave = __builtin_amdgcn_readfirstlane(tid >> 6);
        bf16* HN = (bf16*)(ws + WS_HN); float* H = (float*)(ws + WS_H);
        int kind, li = 0, lj = 0, layer = 0;
        if (p == 0) kind = 0;
        else if (p < 21) { li = (p - 1) / 10; layer = li; const int sub = (p - 1) % 10;
            kind = (sub == 0) ? (li == 0 ? 2 : 1) : (sub == 1) ? 3 : (sub == 2) ? 4 : (sub == 3) ? 5 : (sub == 4) ? 6 : (sub == 5) ? 7 : (sub == 6) ? 8 : (sub == 7) ? 1 : (sub == 8) ? 9 : 10; }
        else if (p < 35) { lj = (p - 21) / 7; layer = 2 + lj; const int sub = (p - 21) % 7;
            kind = (sub == 0) ? 1 : (sub == 1) ? 11 : (sub == 2) ? 12 : (sub == 3) ? 13 : (sub == 4) ? 1 : (sub == 5) ? 9 : 10; }
        else kind = 14;
#ifndef KMASK
#define KMASK 0xffff
#endif
#define KON(k) ((KMASK >> (k)) & 1)
#ifndef REP_MASK
#define REP_MASK 0
#endif
        if (KON(0) && kind == 0) phase_prologue(la, ldsl, wave, lane);
        else if (KON(1) && kind == 1) { const int sub = (p < 21) ? (p - 1) % 10 : (p - 21) % 7; phase_norm(la, 0, (p >= 21 && sub == 4) ? 4 : 8, wave, lane); }
        else if (KON(1) && kind == 2) phase_norm(la, 1, 0, wave, lane);
        else if (KON(3) && kind == 3) { pg8::EpiInProj E{(bf16*)(ws + WS_ZX), (float*)(ws + WS_DT), la->in[I_ADTB] + li * NHEADS}; run_gemm(ldsl, HN, (const bf16*)(ws + WS_WIN + li * SZ_WIN), INPROJ_P, 1024, E); }
        else if (KON(4) && kind == 4) phase_conv(la, li);
        else if (KON(5) && kind == 5) phase_ssd1(la, li, lds, tid, wave, lane);
        else if (KON(6) && kind == 6) phase_scan(la, li);
        else if (KON(7) && kind == 7) phase_ssd3(la, li, lds, tid, wave, lane);
        else if (KON(8) && (kind == 8 || kind == 10 || kind == 13)) {
            const bf16* A; const bf16* Bt; int K;
            if (kind == 8) { A = (const bf16*)(ws + WS_YN); Bt = (const bf16*)(ws + WS_WOUT + li * SZ_WOUT); K = 2048; }
            else if (kind == 10) { A = (const bf16*)(ws + WS_U); Bt = (const bf16*)(ws + WS_WDN + layer * SZ_WDN); K = 4096; }
            else { A = (const bf16*)(ws + WS_AO); Bt = (const bf16*)(ws + WS_WO + lj * SZ_WO); K = 1024; }
            pg8::EpiRes E{H, (float*)(ws + WS_SLAB)}; run_gemm_res(ldsl, A, Bt, K, K == 1024 ? 4 : 8, E); }
        else if (KON(9) && kind == 9) { pg8::EpiBf<1> E{(bf16*)(ws + WS_U), 4096, 1 << 20, nullptr, 0}; run_gemm(ldsl, HN, (const bf16*)(ws + WS_WUP + layer * SZ_WUP), 4096, 1024, E); }
        else if (KON(11) && kind == 11) { pg8::EpiBf<0> E{(bf16*)(ws + WS_Q), 1024, 4, (bf16*)(ws + WS_KV), KVW};
            run_gemm(ldsl, HN, (const bf16*)(ws + (lj == 0 ? WS_WQKV0 : WS_WQ1)), lj == 0 ? 1536 : 1024, 1024, E); }
        else if (KON(12) && kind == 12) phase_attn(la, lj, lds, tid, wave, lane);
        else if (KON(14) && kind == 14) phase_final(la, wave, lane);
        bool again = false;
        if (REP_MASK != 0) { if (rep == 0 && ((REP_MASK >> kind) & 1)) { rep = 1; again = true; } else rep = 0; }
        if (p + 1 < hi || again) xcd_barrier(bar); else { asm volatile("s_waitcnt vmcnt(0)" ::: "memory"); __syncthreads(); }
        if (!again) ++p;
    }
}

#ifndef MK_PER_PHASE
#define MK_PER_PHASE 0
#endif
extern "C" void kernel_launch(void* const* d_in, const int* in_sizes, int n_in, void* d_out, int out_size, void* d_ws, size_t ws_size, hipStream_t stream) {
    static int grid = 0;
    if (grid == 0) {
        if (n_in != 26 || (size_t)out_size != O_END || ws_size < WS_END) { fprintf(stderr, "kernel_launch: unexpected problem (n_in %d, out %d vs %zu, ws %zu vs %zu); nothing launched\n", n_in, out_size, (size_t)O_END, ws_size, (size_t)WS_END); grid = -1; return; }
        int dev = 0, cus = 0, per_cu = 0;
        if (hipGetDevice(&dev) != hipSuccess || hipDeviceGetAttribute(&cus, hipDeviceAttributeMultiprocessorCount, dev) != hipSuccess) { grid = -1; return; }
        if (hipFuncSetAttribute((const void*)yoco_fwd, hipFuncAttributeMaxDynamicSharedMemorySize, LDS_BYTES) != hipSuccess) { fprintf(stderr, "kernel_launch: hipFuncSetAttribute failed\n"); grid = -1; return; }
        if (hipOccupancyMaxActiveBlocksPerMultiprocessor(&per_cu, (const void*)yoco_fwd, NTHREADS, LDS_BYTES) != hipSuccess || per_cu < 1) { fprintf(stderr, "kernel_launch: occupancy query says %d\n", per_cu); per_cu = 1; }
        (void)hipGetLastError();
        if (cus != 256) { fprintf(stderr, "kernel_launch: built for a 256-CU device (got %d); nothing launched\n", cus); grid = -1; return; }
        grid = cus;
    }
    if (grid < 0) return;
    if (hipMemsetAsync((char*)d_ws + WS_CTL, 0, CTL_ZERO_BYTES, stream) != hipSuccess) { fprintf(stderr, "kernel_launch: memset failed\n"); return; }
    Args a{};
    for (int i = 0; i < 26; ++i) a.in[i] = (const float*)d_in[i];
    a.out = (float*)d_out; a.ws = (unsigned char*)d_ws;
#if MK_PER_PHASE
    for (int p = 0; p < NPHASES; ++p) { a.ph_lo = p; a.ph_hi = p + 1; hipLaunchKernelGGL(yoco_fwd, dim3(grid), dim3(NTHREADS), LDS_BYTES, stream, a); }
#else
    a.ph_lo = 0; a.ph_hi = NPHASES;
    void* kargs[] = {&a};
    hipError_t e = hipLaunchCooperativeKernel((const void*)yoco_fwd, dim3(grid), dim3(NTHREADS), kargs, LDS_BYTES, stream);
    if (e != hipSuccess) fprintf(stderr, "kernel_launch: cooperative launch failed: %s (grid %d)\n", hipGetErrorString(e), grid);
#endif
}
```

```cpp
#include <hip/hip_runtime.h>
#include <cstdio>
#include <cstdint>
#include <cmath>
namespace pg8 {
#define PG8_LAS __attribute__((address_space(3)))
typedef unsigned short bf16_t;
typedef short bf16x8 __attribute__((ext_vector_type(8)));
typedef float f32x4 __attribute__((ext_vector_type(4)));
typedef unsigned u32x4 __attribute__((ext_vector_type(4)));
constexpr int BM = 256, BK = 64, HALF = 128, HTB = HALF * BK * 2  , STAGE_BYTES = 8 * HTB, NXCD = 8, WGM = 8;

__host__ __device__ __forceinline__ int lds_byte(int r, int c) { const int st = (r >> 4) * 2 + (c >> 5), rr = r & 15, cc = c & 31, ob = rr * 64 + cc * 2; return st * 1024 + (ob ^ (((ob >> 9) & 1) << 5)); }
__host__ __device__ __forceinline__ void stage_rc(int b, int& R, int& C) { const int st = b / 1024, sb = b % 1024, swz = sb ^ (((sb >> 9) & 1) << 5); R = (st >> 1) * 16 + swz / 64; C = (st & 1) * 32 + (swz % 64) / 2; }
__host__ __device__ __forceinline__ int perm32(int rho) { const int n = rho >> 4, i = rho & 15; return 8 * (i >> 2) + 4 * n + (i & 3); }

struct Unit { int pm, pn, k0, nt, aux; };
struct Gemm { const bf16_t* A; const bf16_t* Bt; int M, N, K; };

struct StaticOrder {
    int nM, nN, nwg, G, c, nt0;
    __host__ __device__ void init(int M, int N, int K, int G_, int c_) { nM = M / BM; nN = N / BM; nwg = nM * nN; G = G_; c = c_; nt0 = K / BK; }
    __host__ __device__ bool next(int i, Unit& u) const {
        const long L = (long)i * G + c; if (L >= nwg) return false;
        int wgid = (int)L; { const int q = nwg / NXCD, r = nwg % NXCD, xcd = wgid % NXCD, off = wgid / NXCD; wgid = (xcd < r ? xcd * (q + 1) : r * (q + 1) + (xcd - r) * q) + off; }
        const int nig = WGM * nN, gid = wgid / nig, fm = gid * WGM, gsz = (nM - fm) < WGM ? (nM - fm) : WGM;
        u.pm = fm + ((wgid % nig) % gsz); u.pn = (wgid % nig) / gsz; u.k0 = 0; u.nt = nt0; u.aux = -1; return true;
    }
    __device__ __forceinline__ void a_ready(const Unit&) const {}
    __device__ __forceinline__ void done(const Unit&) const {}
};
struct ResOrder {
    StaticOrder so; int S, K, c;
    __host__ __device__ void init(int K_, int S_, int G_, int c_) { so.init(64 * BM, 1024, K_, G_, c_); S = S_; K = K_; c = c_; }
    __host__ __device__ bool next(int i, Unit& u) const {
        if (i == 0) return so.next(0, u);
        if (i == 1 && c < 20 * S) { const int t = c / S, sl = c - t * S; u.pm = 64 + (t >> 2); u.pn = t & 3; u.k0 = sl * (K / S); u.nt = K / S / BK; u.aux = sl; return true; }
        return false;
    }
    __device__ __forceinline__ void a_ready(const Unit&) const {}
    __device__ __forceinline__ void done(const Unit&) const {}
};

__device__ __forceinline__ unsigned cvt_pk_bf16(float lo, float hi) { unsigned r; asm volatile("v_cvt_pk_bf16_f32 %0, %1, %2" : "=v"(r) : "v"(lo), "v"(hi)); return r; }
typedef float f32x2 __attribute__((ext_vector_type(2)));
typedef unsigned u32x2 __attribute__((ext_vector_type(2)));
__device__ __forceinline__ float softplus_f(float x) { return x > 20.f ? x : log1pf(__expf(x)); }
struct EpiInProj {
    static constexpr bool PERM = true, AFTER_DRAIN = false;
    bf16_t* ZX; float* DT; const float* dt_bias;
    __device__ __forceinline__ void operator()(const f32x4 (&acc)[2][2][4][2], const Unit& u, int wr, int wc, int fr, int fq) const {
        const int row0 = u.pm * BM + wr * 64 + fr;
        if (u.pn < 24) {
            const int col0 = u.pn * BM + wc * 32 + 8 * fq;
#pragma unroll
            for (int ai = 0; ai < 2; ++ai)
#pragma unroll
                for (int m = 0; m < 4; ++m) { bf16_t* rowp = ZX + (size_t)(row0 + ai * HALF + m * 16) * 6144 + col0;
#pragma unroll
                    for (int bj = 0; bj < 2; ++bj) { const f32x4 v0 = acc[ai][bj][m][0], v1 = acc[ai][bj][m][1];
                        u32x4 w; w.x = cvt_pk_bf16(v0[0], v0[1]); w.y = cvt_pk_bf16(v0[2], v0[3]); w.z = cvt_pk_bf16(v1[0], v1[1]); w.w = cvt_pk_bf16(v1[2], v1[3]);
                        *(u32x4*)(rowp + bj * HALF) = w; } }
        } else if (wc == 0) {
            const int c0 = 8 * fq;
            const f32x4 b0 = *(const f32x4*)(dt_bias + c0), b1 = *(const f32x4*)(dt_bias + c0 + 4);
#pragma unroll
            for (int ai = 0; ai < 2; ++ai)
#pragma unroll
                for (int m = 0; m < 4; ++m) { float* rowp = DT + (size_t)(row0 + ai * HALF + m * 16) * 32 + c0;
                    const f32x4 v0 = acc[ai][0][m][0] + b0, v1 = acc[ai][0][m][1] + b1;
                    f32x4 o0, o1;
#pragma unroll
                    for (int j = 0; j < 4; ++j) { o0[j] = softplus_f(v0[j]); o1[j] = softplus_f(v1[j]); }
                    *(f32x4*)(rowp) = o0; *(f32x4*)(rowp + 4) = o1; }
        }
    }
};
struct EpiRes {
    static constexpr bool PERM = false, AFTER_DRAIN = false;
    float* H; float* SLAB;
    __device__ __forceinline__ void operator()(const f32x4 (&acc)[2][2][4][2], const Unit& u, int wr, int wc, int fr, int fq) const {
        const int row0 = u.pm * BM + wr * 64 + fr, col0 = u.pn * BM + wc * 32 + 4 * fq;
        if (u.aux >= 0) {
            float* base = SLAB + (size_t)u.aux * (1280 * 1024) + (size_t)(row0 - 16384) * 1024 + col0;
#pragma unroll
            for (int ai = 0; ai < 2; ++ai)
#pragma unroll
                for (int m = 0; m < 4; ++m) { float* rowp = base + (size_t)(ai * HALF + m * 16) * 1024;
#pragma unroll
                    for (int bj = 0; bj < 2; ++bj)
#pragma unroll
                        for (int n = 0; n < 2; ++n) *(f32x4*)(rowp + bj * HALF + n * 16) = acc[ai][bj][m][n]; }
            return;
        }
#pragma unroll
        for (int ai = 0; ai < 2; ++ai)
#pragma unroll
            for (int m = 0; m < 4; ++m) { float* rowp = H + (size_t)(row0 + ai * HALF + m * 16) * 1024 + col0;
#pragma unroll
                for (int bj = 0; bj < 2; ++bj)
#pragma unroll
                    for (int n = 0; n < 2; ++n) { f32x4* p = (f32x4*)(rowp + bj * HALF + n * 16); *p = *p + acc[ai][bj][m][n]; } }
    }
};
template <int ACT> struct EpiBf {
    static constexpr bool PERM = true, AFTER_DRAIN = false;
    bf16_t* O0; int ldc0; int nsplit; bf16_t* O1; int ldc1;
    __device__ __forceinline__ void operator()(const f32x4 (&acc)[2][2][4][2], const Unit& u, int wr, int wc, int fr, int fq) const {
        const int row0 = u.pm * BM + wr * 64 + fr;
        bf16_t* base; int ldc, colt;
        if (u.pn < nsplit) { base = O0; ldc = ldc0; colt = u.pn * BM; } else { base = O1; ldc = ldc1; colt = (u.pn - nsplit) * BM; }
        const int col0 = colt + wc * 32 + 8 * fq;
#pragma unroll
        for (int ai = 0; ai < 2; ++ai)
#pragma unroll
            for (int m = 0; m < 4; ++m) { bf16_t* rowp = base + (size_t)(row0 + ai * HALF + m * 16) * ldc + col0;
#pragma unroll
                for (int bj = 0; bj < 2; ++bj) { f32x4 v0 = acc[ai][bj][m][0], v1 = acc[ai][bj][m][1];
                    if (ACT == 1) {
#pragma unroll
                        for (int j = 0; j < 4; ++j) { const float a = fmaxf(v0[j], 0.f), b = fmaxf(v1[j], 0.f); v0[j] = a * a; v1[j] = b * b; } }
                    u32x4 w; w.x = cvt_pk_bf16(v0[0], v0[1]); w.y = cvt_pk_bf16(v0[2], v0[3]); w.z = cvt_pk_bf16(v1[0], v1[1]); w.w = cvt_pk_bf16(v1[2], v1[3]);
                    *(u32x4*)(rowp + bj * HALF) = w; } }
    }
};

template <class Epi, class Sched, bool ALIGN_EPI = false, bool SP2 = false>
__device__ __forceinline__ void gemm_phase(PG8_LAS unsigned char* lds, const Gemm g, const Sched& S, const Epi& E) {
    int tid_l = threadIdx.x; asm volatile("" : "+v"(tid_l));
    const int tid = tid_l, wid = __builtin_amdgcn_readfirstlane(tid >> 6), lane = tid & 63, wr = wid >> 2, wc = wid & 3, fr = lane & 15, fq = lane >> 4;
    const int K = g.K;
    unsigned voffA[2], voffB[2];
#pragma unroll
    for (int i = 0; i < 2; ++i) { int R, C; stage_rc(tid * 16 + i * 8192, R, C); const int Rb = Epi::PERM ? ((R & ~31) + perm32(R & 31)) : R;
        voffA[i] = (unsigned)(R * K + C) * 2u; voffB[i] = (unsigned)(Rb * K + C) * 2u; }
    const size_t kstep = (size_t)(BK * 2);
    const size_t hstep = (size_t)HALF * K * 2;
    const size_t tstep = 2 * hstep;
    const unsigned ldsw = (unsigned)wid * 1024u;
    const int aoff = lds_byte(wr * 64 + fr, fq * 8), boff = lds_byte(wc * 32 + fr, fq * 8);
#define PG8_SA(b, h) (((b) * 2 + (h)) * HTB)
#define PG8_SB(b, h) ((4 + (b) * 2 + (h)) * HTB)
#define PG8_STAGE(bufoff, gbase, voff) do { _Pragma("unroll") for (int _i = 0; _i < 2; ++_i) \
        __builtin_amdgcn_global_load_lds((const unsigned*)((const char*)(gbase) + (voff)[_i]), (PG8_LAS unsigned*)(lds + (bufoff) + ldsw + _i * 8192), 16, 0, 0); } while (0)
#define PG8_LDA(dst, b, h) do { _Pragma("unroll") for (int m = 0; m < 4; ++m) _Pragma("unroll") for (int k = 0; k < 2; ++k) dst[m][k] = *(const PG8_LAS bf16x8*)(lds + PG8_SA(b, h) + aoff + m * 2048 + k * 1024); } while (0)
#define PG8_LDB(dst, b, h) do { _Pragma("unroll") for (int n = 0; n < 2; ++n) _Pragma("unroll") for (int k = 0; k < 2; ++k) dst[n][k] = *(const PG8_LAS bf16x8*)(lds + PG8_SB(b, h) + boff + n * 2048 + k * 1024); } while (0)
#define PG8_MMA(ai, bj, At, Bt) do { __builtin_amdgcn_s_setprio(1); _Pragma("unroll") for (int m = 0; m < 4; ++m) _Pragma("unroll") for (int n = 0; n < 2; ++n) _Pragma("unroll") for (int k = 0; k < 2; ++k) \
        acc[ai][bj][m][n] = __builtin_amdgcn_mfma_f32_16x16x32_bf16(Bt[n][k], At[m][k], acc[ai][bj][m][n], 0, 0, 0); __builtin_amdgcn_s_setprio(0); } while (0)
#define PG8_WAIT_V(n) asm volatile("s_waitcnt vmcnt(" #n ")" ::: "memory")
#define PG8_WAIT_L(n) asm volatile("s_waitcnt lgkmcnt(" #n ")" ::: "memory")
#define PG8_BAR __builtin_amdgcn_s_barrier()
#define PG8_SCHED __builtin_amdgcn_sched_barrier(0)
    Unit cur, nxt; int ui = 0;
    if (!S.next(0, cur)) return;
    f32x4 acc[2][2][4][2];
#pragma unroll
    for (int a = 0; a < 2; ++a)
#pragma unroll
        for (int b = 0; b < 2; ++b)
#pragma unroll
            for (int m = 0; m < 4; ++m)
#pragma unroll
                for (int n = 0; n < 2; ++n) acc[a][b][m][n] = (f32x4){0.f, 0.f, 0.f, 0.f};
    bf16x8 At[4][2], B0[2][2], B1[2][2];
    const char* cA = (const char*)g.A + (size_t)cur.pm * tstep + (size_t)cur.k0 * 2; const char* cB = (const char*)g.Bt + (size_t)cur.pn * tstep + (size_t)cur.k0 * 2;
    S.a_ready(cur);
    if constexpr (SP2) {
        PG8_STAGE(PG8_SB(0, 0), cB, voffB); PG8_STAGE(PG8_SB(0, 1), cB + hstep, voffB); PG8_STAGE(PG8_SA(0, 0), cA, voffA); PG8_STAGE(PG8_SA(0, 1), cA + hstep, voffA);
        if (wr == 1) PG8_BAR;
        PG8_WAIT_V(2); PG8_BAR;
        PG8_STAGE(PG8_SB(1, 0), cB + kstep, voffB); PG8_STAGE(PG8_SA(1, 0), cA + kstep, voffA); PG8_STAGE(PG8_SB(1, 1), cB + hstep + kstep, voffB);
        PG8_WAIT_V(6); PG8_BAR;
    } else {
        PG8_STAGE(PG8_SB(0, 0), cB, voffB); PG8_STAGE(PG8_SA(0, 0), cA, voffA); PG8_STAGE(PG8_SB(0, 1), cB + hstep, voffB); PG8_STAGE(PG8_SA(0, 1), cA + hstep, voffA);
        if (wr == 1) PG8_BAR;
        PG8_WAIT_V(4); PG8_BAR;
        PG8_STAGE(PG8_SB(1, 0), cB + kstep, voffB); PG8_STAGE(PG8_SA(1, 0), cA + kstep, voffA); PG8_STAGE(PG8_SB(1, 1), cB + hstep + kstep, voffB);
        PG8_WAIT_V(6); PG8_BAR;
    }
    for (;;) {
        const bool has_next = S.next(ui + 1, nxt);
        const char* nA = has_next ? (const char*)g.A + (size_t)nxt.pm * tstep + (size_t)nxt.k0 * 2 : cA; const char* nB = has_next ? (const char*)g.Bt + (size_t)nxt.pn * tstep + (size_t)nxt.k0 * 2 : cB;
        const int nt = cur.nt;
        for (int t = 0; t < nt; t += 2) {
            const bool last = (t == nt - 2);
            const char* a1 = cA + (size_t)(t + 1) * kstep;
            const char* a2 = last ? nA : cA + (size_t)(t + 2) * kstep; const char* b2 = last ? nB : cB + (size_t)(t + 2) * kstep;
            const char* a3 = a2 + kstep; const char* b3 = b2 + kstep;
            if (last && has_next) S.a_ready(nxt);
            if constexpr (SP2) {
            PG8_LDB(B0, 0, 0); PG8_LDB(B1, 0, 1); PG8_SCHED; PG8_LDA(At, 0, 0); PG8_STAGE(PG8_SA(1, 1), a1 + hstep, voffA);
            PG8_WAIT_V(8); PG8_WAIT_L(0); PG8_BAR; PG8_MMA(0, 0, At, B0); PG8_MMA(0, 1, At, B1); PG8_BAR; PG8_SCHED;
            PG8_LDA(At, 0, 1); PG8_STAGE(PG8_SB(0, 0), b2, voffB); PG8_STAGE(PG8_SB(0, 1), b2 + hstep, voffB); PG8_STAGE(PG8_SA(0, 0), a2, voffA);
            PG8_WAIT_V(8); PG8_WAIT_L(0); PG8_BAR; PG8_MMA(1, 0, At, B0); PG8_MMA(1, 1, At, B1); PG8_BAR; PG8_SCHED;
            PG8_LDB(B0, 1, 0); PG8_LDB(B1, 1, 1); PG8_SCHED; PG8_LDA(At, 1, 0); PG8_STAGE(PG8_SA(0, 1), a2 + hstep, voffA);
            PG8_WAIT_V(8); PG8_WAIT_L(0); PG8_BAR; PG8_MMA(0, 0, At, B0); PG8_MMA(0, 1, At, B1); PG8_BAR; PG8_SCHED;
            PG8_LDA(At, 1, 1); PG8_STAGE(PG8_SB(1, 0), b3, voffB); PG8_STAGE(PG8_SB(1, 1), b3 + hstep, voffB); PG8_STAGE(PG8_SA(1, 0), a3, voffA);
            PG8_WAIT_V(8); PG8_WAIT_L(0); PG8_BAR; PG8_MMA(1, 0, At, B0); PG8_MMA(1, 1, At, B1); PG8_BAR; PG8_SCHED;
            } else {
            PG8_LDB(B0, 0, 0); PG8_SCHED; PG8_LDA(At, 0, 0); PG8_STAGE(PG8_SA(1, 1), a1 + hstep, voffA);
            PG8_WAIT_L(8); PG8_BAR; PG8_WAIT_L(0); PG8_MMA(0, 0, At, B0); PG8_BAR; PG8_SCHED;
            PG8_LDB(B1, 0, 1); PG8_STAGE(PG8_SB(0, 0), b2, voffB);
            PG8_BAR; PG8_WAIT_L(0); PG8_MMA(0, 1, At, B1); PG8_BAR;
            PG8_LDA(At, 0, 1); PG8_STAGE(PG8_SA(0, 0), a2, voffA);
            PG8_BAR; PG8_WAIT_L(0); PG8_MMA(1, 0, At, B0); PG8_BAR; PG8_SCHED;
            PG8_STAGE(PG8_SB(0, 1), b2 + hstep, voffB);
            PG8_WAIT_V(6); PG8_BAR; PG8_MMA(1, 1, At, B1); PG8_BAR;
            PG8_LDB(B0, 1, 0); PG8_SCHED; PG8_LDA(At, 1, 0); PG8_STAGE(PG8_SA(0, 1), a2 + hstep, voffA);
            PG8_WAIT_L(8); PG8_BAR; PG8_WAIT_L(0); PG8_MMA(0, 0, At, B0); PG8_BAR; PG8_SCHED;
            PG8_LDB(B1, 1, 1); PG8_STAGE(PG8_SB(1, 0), b3, voffB);
            PG8_BAR; PG8_WAIT_L(0); PG8_MMA(0, 1, At, B1); PG8_BAR;
            PG8_LDA(At, 1, 1); PG8_STAGE(PG8_SA(1, 0), a3, voffA);
            PG8_BAR; PG8_WAIT_L(0); PG8_MMA(1, 0, At, B0); PG8_BAR; PG8_SCHED;
            PG8_STAGE(PG8_SB(1, 1), b3 + hstep, voffB);
            PG8_WAIT_V(6); PG8_BAR; PG8_MMA(1, 1, At, B1); PG8_BAR;
            }
        }
        if constexpr (ALIGN_EPI) { if (wr == 0) PG8_BAR; }
        if constexpr (!Epi::AFTER_DRAIN) { E(acc, cur, wr, wc, fr, fq); S.done(cur); }
        if (!has_next) break;
#pragma unroll
        for (int a = 0; a < 2; ++a)
#pragma unroll
            for (int b = 0; b < 2; ++b)
#pragma unroll
                for (int m = 0; m < 4; ++m)
#pragma unroll
                    for (int n = 0; n < 2; ++n) acc[a][b][m][n] = (f32x4){0.f, 0.f, 0.f, 0.f};
        cur = nxt; cA = nA; cB = nB; ++ui;
        if constexpr (ALIGN_EPI) { if (wr == 1) PG8_BAR; }
    }
    PG8_WAIT_V(0);
    if constexpr (!ALIGN_EPI) { if (wr == 0) PG8_BAR; }
    PG8_BAR;
    if constexpr (Epi::AFTER_DRAIN) { E.fused(acc, cur, wr, wc, fr, fq, lds, wid, lane); S.done(cur); }
#undef PG8_SA
#undef PG8_SB
#undef PG8_STAGE
#undef PG8_LDA
#undef PG8_LDB
#undef PG8_MMA
#undef PG8_WAIT_V
#undef PG8_WAIT_L
#undef PG8_BAR
#undef PG8_SCHED
}
}
#define GAS __attribute__((address_space(1)))
#define LAS __attribute__((address_space(3)))
typedef unsigned short bf16;
typedef unsigned v4u __attribute__((ext_vector_type(4)));
typedef float f32x4 __attribute__((ext_vector_type(4)));
typedef short bf16x8 __attribute__((ext_vector_type(8)));
typedef GAS unsigned gu32;
typedef GAS unsigned long long gu64;
#define RLX_AGENT __ATOMIC_RELAXED, __HIP_MEMORY_SCOPE_AGENT
#define LDS_WAIT() asm volatile("s_waitcnt lgkmcnt(0)" ::: "memory")
#define VM_WAIT() asm volatile("s_waitcnt vmcnt(0)" ::: "memory")
__device__ __forceinline__ unsigned long long rt() { return __builtin_amdgcn_s_memrealtime(); }
__device__ __forceinline__ unsigned f2bf(float f) { unsigned u = __builtin_bit_cast(unsigned, f); return (u + 0x7fffu + ((u >> 16) & 1u)) >> 16; }
__device__ __forceinline__ unsigned pk2(float lo, float hi) { return f2bf(lo) | (f2bf(hi) << 16); }

#define XB_TMO      128
#define XB_XCNT(j)  (256  + 64 * (j))
#define XB_XSUB(j)  (1280 + 64 * (j))
#define XB_XGEN(j)  (2304 + 64 * (j))
#define XB_TOP      3328
#define XB_TOPGEN   3392
#define XCD_BAR_WORDS 3456
#define XB_SPIN_CAP (1u << 18)

__device__ __forceinline__ unsigned xb_ld(unsigned* p)              { return __hip_atomic_load(p, __ATOMIC_RELAXED, __HIP_MEMORY_SCOPE_AGENT); }
__device__ __forceinline__ unsigned xb_add(unsigned* p, unsigned v) { return __hip_atomic_fetch_add(p, v, __ATOMIC_RELAXED, __HIP_MEMORY_SCOPE_AGENT); }
__device__ __forceinline__ unsigned xb_xcc_id() { return (unsigned)__builtin_amdgcn_s_getreg((3 << 11) | 20) & 0xFu; }
#define XB_SPIN(cond, bar) do { unsigned _sp = 0; while (cond) { __builtin_amdgcn_s_sleep(1); \
    if ((++_sp & 255u) == 0u) { if (xb_ld(&(bar)[XB_TMO])) break; if (_sp > XB_SPIN_CAP) { atomicAdd(&(bar)[XB_TMO], 1u); break; } } } } while (0)

struct XcdBarrier {
    unsigned* bar; unsigned x;
    volatile LAS unsigned* st;
};

__device__ __forceinline__ XcdBarrier xcd_barrier_post(unsigned* bar, volatile LAS unsigned* st) {
    XcdBarrier b; b.bar = bar; b.x = xb_xcc_id(); b.st = st;
    if (threadIdx.x == 0) (void)xb_add(&bar[XB_XCNT(b.x)], 1u);
    return b;
}
__device__ __forceinline__ void xcd_barrier_complete(unsigned* bar, unsigned x, unsigned& nloc, unsigned& nx) {
    const unsigned G = gridDim.x * gridDim.y * gridDim.z;
    unsigned sum, cnt, mine, sp = 0u;
    for (;;) {
        sum = 0u; cnt = 0u; mine = 0u;
#pragma unroll
        for (unsigned j = 0; j < 16; ++j) { const unsigned c = xb_ld(&bar[XB_XCNT(j)]); sum += c; cnt += (c > 0u) ? 1u : 0u; mine = (j == x) ? c : mine; }
        if (sum == G) break;
        __builtin_amdgcn_s_sleep(1);
        if ((++sp & 255u) == 0u) { if (xb_ld(&bar[XB_TMO])) break; if (sp > XB_SPIN_CAP) { atomicAdd(&bar[XB_TMO], 1u); break; } }
    }
    nloc = mine > 0u ? mine : 1u; nx = cnt > 0u ? cnt : 1u;
}

__device__ __forceinline__ void xcd_barrier(const XcdBarrier& b) {
    asm volatile("s_waitcnt vmcnt(0)" ::: "memory");
    __syncthreads();
    if (threadIdx.x == 0) {
        unsigned* bar = b.bar;
        __builtin_amdgcn_s_waitcnt(0);
        unsigned nloc = b.st[0], nx = b.st[1];
        if (nloc == 0u) { xcd_barrier_complete(bar, b.x, nloc, nx); b.st[0] = nloc; b.st[1] = nx; }
        const unsigned old = xb_add(&bar[XB_XSUB(b.x)], 1u);
        const unsigned gen = old / nloc;
        if (old + 1u == (gen + 1u) * nloc) {
            __builtin_amdgcn_fence(__ATOMIC_RELEASE, "agent");
            asm volatile("s_waitcnt vmcnt(0)" ::: "memory");
            const unsigned og = xb_add(&bar[XB_TOP], 1u);
            const unsigned tg = og / nx;
            if (og + 1u == (tg + 1u) * nx) xb_add(&bar[XB_TOPGEN], 1u);
            else XB_SPIN(xb_ld(&bar[XB_TOPGEN]) == tg, bar);
            __builtin_amdgcn_fence(__ATOMIC_ACQUIRE, "agent");
            xb_add(&bar[XB_XGEN(b.x)], 1u);
            asm volatile("s_waitcnt vmcnt(0)" ::: "memory");
        } else {
            XB_SPIN(xb_ld(&bar[XB_XGEN(b.x)]) == gen, bar);
            __builtin_amdgcn_fence(__ATOMIC_ACQUIRE, "agent");
            asm volatile("s_waitcnt vmcnt(0)" ::: "memory");
        }
    }
    __syncthreads();
}
constexpr int NWAVES = 8, NTHREADS = 512;
constexpr int DM = 1024, SEQ = 8192, NPROMPT = 2, NSAMP = 128, TSAMP = 8, NMETA = 16;
constexpr int ROW_S = NPROMPT * SEQ;
constexpr int ROW_M = ROW_S + NSAMP * TSAMP;
constexpr int NROWS = ROW_M + NMETA;
constexpr int MP = 17664;
constexpr int DINNER = 2048, NHEADS = 32, HD = 64, NGROUPS = 8, DSTATE = 128, CONVD = 4096, INPROJ = 6176, INPROJ_P = 6400, ZXW = 6144;
constexpr int DFF = 4096, NKV = 4, NQ = 16, KVW = 512;
constexpr float EPS = 1e-5f;
constexpr int LDX = 136;

constexpr size_t O_YP = 0, O_YS = O_YP + (size_t)NPROMPT * SEQ * DM, O_PCONV = O_YS + (size_t)NSAMP * TSAMP * DM, O_PSSM = O_PCONV + 2 * 2 * 3 * 4096,
    O_PCK = O_PSSM + (size_t)2 * 2 * 32 * 64 * 128, O_PCV = O_PCK + 2 * 128 * 256, O_SCONV = O_PCV + 2 * 128 * 256, O_SSSM = O_SCONV + (size_t)2 * 128 * 3 * 4096,
    O_SCK = O_SSSM + (size_t)2 * 128 * 32 * 64 * 128, O_SCV = O_SCK + (size_t)128 * 128 * 256, O_END = O_SCV + (size_t)128 * 128 * 256;

constexpr size_t MiB = 1u << 20;
constexpr size_t WS_CTL = 0, CTL_ZERO_BYTES = 1 * MiB;
constexpr size_t SZ_WIN = (size_t)INPROJ_P * 1024 * 2, SZ_WOUT = (size_t)1024 * 2048 * 2, SZ_WUP = (size_t)4096 * 1024 * 2, SZ_WDN = SZ_WUP, SZ_WQKV0 = (size_t)1536 * 1024 * 2, SZ_WQ1 = (size_t)1024 * 1024 * 2, SZ_WO = SZ_WQ1;
constexpr size_t WS_WIN = 1 * MiB, WS_WOUT = WS_WIN + 2 * SZ_WIN, WS_WUP = WS_WOUT + 2 * SZ_WOUT, WS_WDN = WS_WUP + 4 * SZ_WUP, WS_WQKV0 = WS_WDN + 4 * SZ_WDN, WS_WQ1 = WS_WQKV0 + SZ_WQKV0, WS_WO = WS_WQ1 + SZ_WQ1, WS_WEND = WS_WO + 2 * SZ_WO;
constexpr size_t al1m(size_t x) { return (x + MiB - 1) / MiB * MiB; }
constexpr size_t WS_H = al1m(WS_WEND), WS_HN = al1m(WS_H + (size_t)MP * 1024 * 4), WS_ZX = al1m(WS_HN + (size_t)MP * 1024 * 2), WS_DT = al1m(WS_ZX + (size_t)MP * ZXW * 2),
    WS_XC = al1m(WS_DT + (size_t)MP * 32 * 4), WS_YN = al1m(WS_XC + (size_t)MP * 4096 * 2), WS_CS = al1m(WS_YN + (size_t)MP * 2048 * 2), WS_CD = al1m(WS_CS + (size_t)129 * 32 * 8192 * 4), WS_SLAB = al1m(WS_CD + 129 * 32 * 4), WS_END = al1m(WS_SLAB + (size_t)8 * 1280 * 1024 * 4);
constexpr size_t WS_U = WS_ZX;
constexpr size_t WS_Q = WS_XC, WS_KV = WS_Q + (size_t)MP * 1024 * 2, WS_AO = WS_KV + (size_t)MP * 512 * 2;
static_assert(WS_AO + (size_t)MP * 1024 * 2 <= WS_YN, "attention overlay");
constexpr int CW_BAR = 4096;

constexpr int RING_BYTES = 131072, LDSCTL_OFF = RING_BYTES, MISC_OFF = LDSCTL_OFF + 320, LDS_BYTES = 147456;

typedef unsigned u32x2 __attribute__((ext_vector_type(2)));
typedef unsigned u32x4 __attribute__((ext_vector_type(4)));
__device__ __forceinline__ int ltid() { int t = threadIdx.x; asm volatile("" : "+v"(t)); return t; }
__device__ __forceinline__ float bf2f(unsigned short b) { return __uint_as_float((unsigned)b << 16); }
__device__ __forceinline__ float bflo(unsigned w) { return __uint_as_float(w << 16); }
__device__ __forceinline__ float bfhi(unsigned w) { return __uint_as_float(w & 0xffff0000u); }
__device__ __forceinline__ unsigned pkbf(float lo, float hi) { return pg8::cvt_pk_bf16(lo, hi); }
__device__ __forceinline__ float wave_sum(float v) {
#pragma unroll
    for (int o = 1; o < 64; o <<= 1) v += __shfl_xor(v, o);
    return v;
}
__device__ __forceinline__ float sigmoid_f(float x) { return 1.f / (1.f + __expf(-x)); }
#define MFMA16(b, a, c) __builtin_amdgcn_mfma_f32_16x16x32_bf16((b), (a), (c), 0, 0, 0)

struct Args {
    const float* in[26]; float* out; unsigned char* ws; int ph_lo, ph_hi;
};
typedef const __attribute__((address_space(4))) Args* ArgsP;
enum { I_XP = 0, I_XS, I_SCONV, I_SSSM, I_CK, I_CV, I_META, I_ANORM, I_AIN, I_ACONVW, I_ACONVB, I_ADTB, I_ALOG, I_ADSKIP, I_AGATE, I_AOUT, I_KVNORM, I_WKV, I_BNORM, I_WQ, I_SINKS, I_WO, I_MLPNORM, I_WUP, I_WDOWN, I_FNORM };

__device__ __forceinline__ void transpose_item(const float* W, const float* scale, int K, int N, bf16* WT, int row_off, LAS unsigned* scr, int item, int lane) {
    const int nblk = (N + 63) / 64, kb = item / nblk, nb = item % nblk, k0 = 64 * kb, n0 = 64 * nb;
    const bool ok = (n0 + lane < N);
    const float* src = W + (size_t)k0 * N + n0 + (ok ? lane : 0);
#pragma unroll
    for (int h = 0; h < 2; ++h) {
        float v[32];
#pragma unroll
        for (int i = 0; i < 32; ++i) v[i] = src[(size_t)(32 * h + i) * N];
        if (!ok) {
#pragma unroll
            for (int i = 0; i < 32; ++i) v[i] = 0.f;
        }
        if (scale) {
#pragma unroll
            for (int i = 0; i < 32; ++i) v[i] *= scale[k0 + 32 * h + i];
        }
#pragma unroll
        for (int i = 0; i < 16; ++i) scr[lane * 33 + 16 * h + i] = pkbf(v[2 * i], v[2 * i + 1]);
    }
    LDS_WAIT(); asm volatile("" ::: "memory");
    const int c = lane & 7;
#pragma unroll
    for (int j = 0; j < 8; ++j) { const int n = (lane >> 3) + 8 * j; const LAS unsigned* sp = scr + n * 33 + 4 * c;
        v4u o; o.x = sp[0]; o.y = sp[1]; o.z = sp[2]; o.w = sp[3];
        if (n0 + n < N) *(GAS v4u*)(WT + (size_t)(row_off + n0 + n) * K + k0 + 8 * c) = o; }
    LDS_WAIT(); asm volatile("" ::: "memory");
}
struct WJob { const float* W; const float* scale; int K, N; bf16* WT; int row_off; int items; };

__device__ __forceinline__ void phase_prologue(ArgsP a, LAS unsigned char* lds, int wave, int lane) {
    LAS unsigned* scr = (LAS unsigned*)(lds + wave * 16384);
    const int gw = blockIdx.x * NWAVES + wave, NGW = gridDim.x * NWAVES;
    unsigned char* ws = a->ws;
    for (int jb = 0; jb < 21; ++jb) {
        WJob J;
        if (jb < 2)       { const int i = jb;      J = WJob{a->in[I_AIN] + (size_t)i * 1024 * INPROJ, a->in[I_ANORM] + i * 1024, 1024, INPROJ, (bf16*)(ws + WS_WIN + i * SZ_WIN), 0, 0}; }
        else if (jb < 4)  { const int i = jb - 2;  J = WJob{a->in[I_AOUT] + (size_t)i * 2048 * 1024, a->in[I_AGATE] + i * 2048, 2048, 1024, (bf16*)(ws + WS_WOUT + i * SZ_WOUT), 0, 0}; }
        else if (jb < 8)  { const int l = jb - 4;  J = WJob{a->in[I_WUP] + (size_t)l * 1024 * 4096, a->in[I_MLPNORM] + l * 1024, 1024, 4096, (bf16*)(ws + WS_WUP + l * SZ_WUP), 0, 0}; }
        else if (jb < 12) { const int l = jb - 8;  J = WJob{a->in[I_WDOWN] + (size_t)l * 4096 * 1024, nullptr, 4096, 1024, (bf16*)(ws + WS_WDN + l * SZ_WDN), 0, 0}; }
        else if (jb == 12) { J = WJob{a->in[I_WQ], a->in[I_BNORM], 1024, 1024, (bf16*)(ws + WS_WQKV0), 0, 0}; }
        else if (jb == 13) { J = WJob{a->in[I_WKV], a->in[I_KVNORM], 1024, 512, (bf16*)(ws + WS_WQKV0), 1024, 0}; }
        else if (jb == 14) { J = WJob{a->in[I_WQ] + (size_t)1024 * 1024, a->in[I_BNORM] + 1024, 1024, 1024, (bf16*)(ws + WS_WQ1), 0, 0}; }
        else if (jb < 17) { const int j = jb - 15; J = WJob{a->in[I_WO] + (size_t)j * 1024 * 1024, nullptr, 1024, 1024, (bf16*)(ws + WS_WO + j * SZ_WO), 0, 0}; }
        else break;
        const int items = (J.K / 64) * ((J.N + 63) / 64);
        for (int it = gw; it < items; it += NGW) transpose_item(J.W, J.scale, J.K, J.N, J.WT, J.row_off, scr, it, lane);
    }
    {
        const int gt = blockIdx.x * NTHREADS + ltid(), NT = gridDim.x * NTHREADS;
        const int per = (INPROJ_P - INPROJ) * 1024 * 2 / 16;
        for (int e = gt; e < 2 * per; e += NT) { const int i = e / per, c = e % per;
            *(v4u*)(ws + WS_WIN + i * SZ_WIN + (size_t)INPROJ * 1024 * 2 + (size_t)c * 16) = (v4u){0u, 0u, 0u, 0u}; }
    }
}

__device__ __forceinline__ void phase_norm(ArgsP a, int from_inputs, int nslab, int wave, int lane) {
    float* H = (float*)(a->ws + WS_H); bf16* HN = (bf16*)(a->ws + WS_HN); const float* SLAB = (const float*)(a->ws + WS_SLAB);
    const int gw = blockIdx.x * NWAVES + wave, NGW = gridDim.x * NWAVES;
    for (int m = gw; m < MP; m += NGW) {
        unsigned long long* o8 = (unsigned long long*)(HN + (size_t)m * DM) + lane;
        if (m >= NROWS) {
#pragma unroll
            for (int j = 0; j < 4; ++j) o8[64 * j] = 0ull;
            continue;
        }
        const float* src;
        if (from_inputs) src = (m < ROW_S) ? a->in[I_XP] + (size_t)m * DM : (m < ROW_M) ? a->in[I_XS] + (size_t)(m - ROW_S) * DM : a->in[I_META] + (size_t)(m - ROW_M) * DM;
        else src = H + (size_t)m * DM;
        const f32x4* xr = (const f32x4*)src + lane;
        f32x4 v[4]; float s = 0.f;
#pragma unroll
        for (int j = 0; j < 4; ++j) v[j] = xr[64 * j];
        if (m >= ROW_S && nslab > 0) {
            for (int sl = 0; sl < nslab; ++sl) { const f32x4* sr = (const f32x4*)(SLAB + (size_t)sl * (1280 * 1024) + (size_t)(m - ROW_S) * DM) + lane;
#pragma unroll
                for (int j = 0; j < 4; ++j) v[j] = v[j] + sr[64 * j]; }
            f32x4* hr = (f32x4*)(H + (size_t)m * DM) + lane;
#pragma unroll
            for (int j = 0; j < 4; ++j) hr[64 * j] = v[j];
        }
#pragma unroll
        for (int j = 0; j < 4; ++j) s += (v[j].x * v[j].x + v[j].y * v[j].y) + (v[j].z * v[j].z + v[j].w * v[j].w);
        const float rs = rsqrtf(wave_sum(s) * (1.f / DM) + EPS);
        if (from_inputs) { f32x4* hr = (f32x4*)(H + (size_t)m * DM) + lane;
#pragma unroll
            for (int j = 0; j < 4; ++j) hr[64 * j] = v[j]; }
#pragma unroll
        for (int j = 0; j < 4; ++j) o8[64 * j] = (unsigned long long)pkbf(v[j].x * rs, v[j].y * rs) | ((unsigned long long)pkbf(v[j].z * rs, v[j].w * rs) << 32);
    }
}
__device__ __forceinline__ void phase_final(ArgsP a, int wave, int lane) {
    const float* H = (const float*)(a->ws + WS_H); const float* fw = a->in[I_FNORM]; const float* SLAB = (const float*)(a->ws + WS_SLAB);
    const int gw = blockIdx.x * NWAVES + wave, NGW = gridDim.x * NWAVES;
    f32x4 w[4];
#pragma unroll
    for (int j = 0; j < 4; ++j) w[j] = ((const f32x4*)fw)[lane + 64 * j];
    for (int m = gw; m < ROW_M; m += NGW) {
        const f32x4* xr = (const f32x4*)(H + (size_t)m * DM) + lane;
        f32x4 v[4]; float s = 0.f;
#pragma unroll
        for (int j = 0; j < 4; ++j) v[j] = xr[64 * j];
        if (m >= ROW_S) {
            for (int sl = 0; sl < 8; ++sl) { const f32x4* sr = (const f32x4*)(SLAB + (size_t)sl * (1280 * 1024) + (size_t)(m - ROW_S) * DM) + lane;
#pragma unroll
                for (int j = 0; j < 4; ++j) v[j] = v[j] + sr[64 * j]; }
        }
#pragma unroll
        for (int j = 0; j < 4; ++j) s += (v[j].x * v[j].x + v[j].y * v[j].y) + (v[j].z * v[j].z + v[j].w * v[j].w);
        const float rs = rsqrtf(wave_sum(s) * (1.f / DM) + EPS);
        f32x4* o = (f32x4*)(a->out + O_YP + (size_t)m * DM) + lane;
#pragma unroll
        for (int j = 0; j < 4; ++j) o[64 * j] = v[j] * rs * w[j];
    }
}

__device__ __forceinline__ void unpack8(const u32x4 w, float (&f)[8]) { f[0] = bflo(w.x); f[1] = bfhi(w.x); f[2] = bflo(w.y); f[3] = bfhi(w.y); f[4] = bflo(w.z); f[5] = bfhi(w.z); f[6] = bflo(w.w); f[7] = bfhi(w.w); }
__device__ __forceinline__ void phase_conv(ArgsP a, int li) {
    const bf16* ZX = (const bf16*)(a->ws + WS_ZX); bf16* XC = (bf16*)(a->ws + WS_XC);
    const float* cw = a->in[I_ACONVW] + (size_t)li * 4 * CONVD; const float* cb = a->in[I_ACONVB] + (size_t)li * CONVD;
    const float* sconv = a->in[I_SCONV] + (size_t)li * NSAMP * 3 * CONVD;
    constexpr int NRUNS = 2048 + 128 + 2;
    const int gt = blockIdx.x * NTHREADS + ltid(), NT = gridDim.x * NTHREADS;
    for (int item = gt; item < NRUNS * 512; item += NT) {
        const int run = item >> 9, c0 = (item & 511) * 8;
        int R0, kind, b = 0; bool last = false;
        if (run < 2048) { kind = 0; b = run >> 10; const int t0 = (run & 1023) * 8; R0 = b * SEQ + t0; last = (t0 == SEQ - 8); }
        else if (run < 2176) { kind = 1; b = run - 2048; R0 = ROW_S + b * 8; last = true; }
        else { kind = 2; R0 = ROW_M + (run - 2176) * 8; }
        float w0[8], w1[8], w2[8], w3[8], bs[8];
        { const f32x4* p = (const f32x4*)(cw + c0); f32x4 x0 = p[0], x1 = p[1]; w0[0]=x0.x;w0[1]=x0.y;w0[2]=x0.z;w0[3]=x0.w;w0[4]=x1.x;w0[5]=x1.y;w0[6]=x1.z;w0[7]=x1.w; }
        { const f32x4* p = (const f32x4*)(cw + CONVD + c0); f32x4 x0 = p[0], x1 = p[1]; w1[0]=x0.x;w1[1]=x0.y;w1[2]=x0.z;w1[3]=x0.w;w1[4]=x1.x;w1[5]=x1.y;w1[6]=x1.z;w1[7]=x1.w; }
        { const f32x4* p = (const f32x4*)(cw + 2 * CONVD + c0); f32x4 x0 = p[0], x1 = p[1]; w2[0]=x0.x;w2[1]=x0.y;w2[2]=x0.z;w2[3]=x0.w;w2[4]=x1.x;w2[5]=x1.y;w2[6]=x1.z;w2[7]=x1.w; }
        { const f32x4* p = (const f32x4*)(cw + 3 * CONVD + c0); f32x4 x0 = p[0], x1 = p[1]; w3[0]=x0.x;w3[1]=x0.y;w3[2]=x0.z;w3[3]=x0.w;w3[4]=x1.x;w3[5]=x1.y;w3[6]=x1.z;w3[7]=x1.w; }
        { const f32x4* p = (const f32x4*)(cb + c0); f32x4 x0 = p[0], x1 = p[1]; bs[0]=x0.x;bs[1]=x0.y;bs[2]=x0.z;bs[3]=x0.w;bs[4]=x1.x;bs[5]=x1.y;bs[6]=x1.z;bs[7]=x1.w; }
        float p0[8], p1[8], p2[8];
        const bool first = (kind == 0) ? ((run & 1023) == 0) : (kind == 1) ? true : (run == 2176);
        if (!first) {
            unpack8(*(const u32x4*)(ZX + (size_t)(R0 - 3) * ZXW + 2048 + c0), p0);
            unpack8(*(const u32x4*)(ZX + (size_t)(R0 - 2) * ZXW + 2048 + c0), p1);
            unpack8(*(const u32x4*)(ZX + (size_t)(R0 - 1) * ZXW + 2048 + c0), p2);
        } else if (kind == 0) {
            unpack8(*(const u32x4*)(ZX + (size_t)(ROW_M + 13) * ZXW + 2048 + c0), p0);
            unpack8(*(const u32x4*)(ZX + (size_t)(ROW_M + 14) * ZXW + 2048 + c0), p1);
            unpack8(*(const u32x4*)(ZX + (size_t)(ROW_M + 15) * ZXW + 2048 + c0), p2);
        } else if (kind == 1) {
            const float* s = sconv + (size_t)b * 3 * CONVD + c0;
            { f32x4 x0 = *(const f32x4*)(s), x1 = *(const f32x4*)(s + 4); p0[0]=x0.x;p0[1]=x0.y;p0[2]=x0.z;p0[3]=x0.w;p0[4]=x1.x;p0[5]=x1.y;p0[6]=x1.z;p0[7]=x1.w; }
            { f32x4 x0 = *(const f32x4*)(s + CONVD), x1 = *(const f32x4*)(s + CONVD + 4); p1[0]=x0.x;p1[1]=x0.y;p1[2]=x0.z;p1[3]=x0.w;p1[4]=x1.x;p1[5]=x1.y;p1[6]=x1.z;p1[7]=x1.w; }
            { f32x4 x0 = *(const f32x4*)(s + 2 * CONVD), x1 = *(const f32x4*)(s + 2 * CONVD + 4); p2[0]=x0.x;p2[1]=x0.y;p2[2]=x0.z;p2[3]=x0.w;p2[4]=x1.x;p2[5]=x1.y;p2[6]=x1.z;p2[7]=x1.w; }
        } else {
#pragma unroll
            for (int j = 0; j < 8; ++j) { p0[j] = 0.f; p1[j] = 0.f; p2[j] = 0.f; }
        }
#pragma unroll
        for (int t = 0; t < 8; ++t) {
            float x[8]; unpack8(*(const u32x4*)(ZX + (size_t)(R0 + t) * ZXW + 2048 + c0), x);
            float o[8];
#pragma unroll
            for (int j = 0; j < 8; ++j) { const float v = bs[j] + w0[j] * p0[j] + w1[j] * p1[j] + w2[j] * p2[j] + w3[j] * x[j]; o[j] = v * sigmoid_f(v); }
            u32x4 w; w.x = pkbf(o[0], o[1]); w.y = pkbf(o[2], o[3]); w.z = pkbf(o[4], o[5]); w.w = pkbf(o[6], o[7]);
            *(u32x4*)(XC + (size_t)(R0 + t) * CONVD + c0) = w;
            if (last && t >= 5 && kind != 2) {
                float* dst = (kind == 0) ? a->out + O_PCONV + ((size_t)(li * NPROMPT + b) * 3 + (t - 5)) * CONVD + c0 : a->out + O_SCONV + ((size_t)(li * NSAMP + b) * 3 + (t - 5)) * CONVD + c0;
                *(f32x4*)(dst) = (f32x4){x[0], x[1], x[2], x[3]}; *(f32x4*)(dst + 4) = (f32x4){x[4], x[5], x[6], x[7]};
            }
#pragma unroll
            for (int j = 0; j < 8; ++j) { p0[j] = p1[j]; p1[j] = p2[j]; p2[j] = x[j]; }
        }
    }
}

__device__ __forceinline__ void ssd_acs(const float* DT, const float* alog, int R0, int len, int h0, float* s_dt, float* s_acs, int wave, int lane) {
    if (wave < 4) {
        const int r = wave; const float An = -__expf(alog[h0 + r]);
        const int l0 = 2 * lane;
        const float d0 = (l0 < len) ? DT[(size_t)(R0 + l0) * 32 + h0 + r] : 0.f;
        const float d1 = (l0 + 1 < len) ? DT[(size_t)(R0 + l0 + 1) * 32 + h0 + r] : 0.f;
        const float a0 = d0 * An, a1 = d1 * An, s = a0 + a1;
        float incl = s;
#pragma unroll
        for (int o = 1; o < 64; o <<= 1) { const float t = __shfl_up(incl, o); if (lane >= o) incl += t; }
        const float excl = incl - s;
        s_dt[r * 128 + l0] = d0; s_dt[r * 128 + l0 + 1] = d1;
        s_acs[r * 128 + l0] = excl + a0; s_acs[r * 128 + l0 + 1] = excl + s;
    }
}
#define LFRAG(base, row, ld, ks) (*(const bf16x8*)((base) + (row) * (ld) + 32 * (ks) + 8 * fq))

__device__ __forceinline__ void ssd1_unit(ArgsP a, int li, unsigned char* lds, int slot, int g, int R0, int len, int, int, int) {
    const int tid = ltid(), lane = tid & 63, wave = __builtin_amdgcn_readfirstlane(tid >> 6);
    const bf16* XC = (const bf16*)(a->ws + WS_XC); const float* DT = (const float*)(a->ws + WS_DT);
    float* CS = (float*)(a->ws + WS_CS); float* CD = (float*)(a->ws + WS_CD);
    bf16* XsT = (bf16*)lds;
    bf16* BT = (bf16*)(lds + 256 * LDX * 2);
    float* s_dt = (float*)(lds + 384 * LDX * 2); float* s_acs = s_dt + 512;
    const int fr = lane & 15, fq = lane >> 4, h0 = g * 4;
    ssd_acs(DT, a->in[I_ALOG] + li * NHEADS, R0, len, h0, s_dt, s_acs, wave, lane);
    __syncthreads();
#pragma unroll
    for (int k = 0; k < 4; ++k) {
        const int item = tid + NTHREADS * k, cb = item & 31, tp = item >> 5, l = 2 * tp, r = cb >> 3;
        u32x4 v0 = (u32x4){0u, 0u, 0u, 0u}, v1 = v0;
        if (l < len) v0 = *(const u32x4*)(XC + (size_t)(R0 + l) * CONVD + g * 256 + cb * 8);
        if (l + 1 < len) v1 = *(const u32x4*)(XC + (size_t)(R0 + l + 1) * CONVD + g * 256 + cb * 8);
        const float tot = s_acs[r * 128 + 127];
        const float w0 = __expf(tot - s_acs[r * 128 + l]) * s_dt[r * 128 + l], w1 = __expf(tot - s_acs[r * 128 + l + 1]) * s_dt[r * 128 + l + 1];
        float x0[8], x1[8]; unpack8(v0, x0); unpack8(v1, x1);
#pragma unroll
        for (int j = 0; j < 8; ++j) *(unsigned*)(XsT + (cb * 8 + j) * LDX + l) = pkbf(x0[j] * w0, x1[j] * w1);
    }
#pragma unroll
    for (int k = 0; k < 2; ++k) {
        const int item = tid + NTHREADS * k, cb = item & 15, tp = item >> 4, l = 2 * tp;
        u32x4 v0 = (u32x4){0u, 0u, 0u, 0u}, v1 = v0;
        if (l < len) v0 = *(const u32x4*)(XC + (size_t)(R0 + l) * CONVD + 2048 + g * 128 + cb * 8);
        if (l + 1 < len) v1 = *(const u32x4*)(XC + (size_t)(R0 + l + 1) * CONVD + 2048 + g * 128 + cb * 8);
        const unsigned a0[4] = {v0.x, v0.y, v0.z, v0.w}, a1[4] = {v1.x, v1.y, v1.z, v1.w};
#pragma unroll
        for (int j = 0; j < 4; ++j) {
            *(unsigned*)(BT + (cb * 8 + 2 * j) * LDX + l) = (a0[j] & 0xffffu) | (a1[j] << 16);
            *(unsigned*)(BT + (cb * 8 + 2 * j + 1) * LDX + l) = (a0[j] >> 16) | (a1[j] & 0xffff0000u);
        }
    }
    __syncthreads();
    f32x4 acc[2][8];
#pragma unroll
    for (int mi = 0; mi < 2; ++mi)
#pragma unroll
        for (int ni = 0; ni < 8; ++ni) acc[mi][ni] = (f32x4){0.f, 0.f, 0.f, 0.f};
#pragma unroll
    for (int ks = 0; ks < 4; ++ks) {
        const bf16x8 a0 = LFRAG(XsT, 32 * wave + fr, LDX, ks), a1 = LFRAG(XsT, 32 * wave + 16 + fr, LDX, ks);
#pragma unroll
        for (int ni = 0; ni < 8; ++ni) { const bf16x8 bb = LFRAG(BT, 16 * ni + fr, LDX, ks); acc[0][ni] = MFMA16(bb, a0, acc[0][ni]); acc[1][ni] = MFMA16(bb, a1, acc[1][ni]); }
    }
#pragma unroll
    for (int mi = 0; mi < 2; ++mi) { const int hp = 32 * wave + 16 * mi + fr, r = hp >> 6, p = hp & 63;
        float* dst = CS + ((size_t)(slot * 32 + h0 + r) * 64 + p) * 128 + 4 * fq;
#pragma unroll
        for (int ni = 0; ni < 8; ++ni) *(f32x4*)(dst + 16 * ni) = acc[mi][ni]; }
    if (tid < 4) CD[slot * 32 + h0 + tid] = __expf(s_acs[tid * 128 + 127]);
    __syncthreads();
}

__device__ __forceinline__ void ssd_sample_unit(ArgsP a, int li, unsigned char* lds, int b, int g, int, int, int) {
    const int tid = ltid(), lane = tid & 63, wave = __builtin_amdgcn_readfirstlane(tid >> 6);
    const bf16* XC = (const bf16*)(a->ws + WS_XC); const bf16* ZX = (const bf16*)(a->ws + WS_ZX); const float* DT = (const float*)(a->ws + WS_DT); bf16* YN = (bf16*)(a->ws + WS_YN);
    float* sX = (float*)lds; float* sB = sX + 8 * 256; float* sC = sB + 8 * 128; float* sY = sC + 8 * 128; float* sDt = sY + 8 * 256;
    const int R0 = ROW_S + b * 8, h0 = g * 4;
    for (int idx = tid; idx < 8 * 512; idx += NTHREADS) { const int t = idx >> 9, c = idx & 511; const bf16* row = XC + (size_t)(R0 + t) * CONVD;
        if (c < 256) sX[t * 256 + c] = bf2f(row[g * 256 + c]); else if (c < 384) sB[t * 128 + c - 256] = bf2f(row[2048 + g * 128 + c - 256]); else sC[t * 128 + c - 384] = bf2f(row[3072 + g * 128 + c - 384]); }
    if (tid < 32) sDt[tid] = DT[(size_t)(R0 + (tid >> 2)) * 32 + h0 + (tid & 3)];
    __syncthreads();
    const int p = tid >> 3, nb = tid & 7;
#pragma unroll 1
    for (int r = 0; r < 4; ++r) {
        const int h = h0 + r;
        const float An = -__expf(a->in[I_ALOG][li * NHEADS + h]), Dk = a->in[I_ADSKIP][li * NHEADS + h];
        const float* sin_ = a->in[I_SSSM] + ((size_t)((li * NSAMP + b) * NHEADS + h) * 64 + p) * 128 + 4 * nb;
        float* sout = a->out + O_SSSM + ((size_t)((li * NSAMP + b) * NHEADS + h) * 64 + p) * 128 + 4 * nb;
        f32x4 st[4];
#pragma unroll
        for (int kk = 0; kk < 4; ++kk) st[kk] = *(const f32x4*)(sin_ + 32 * kk);
#pragma unroll
        for (int t = 0; t < 8; ++t) {
            const float dt = sDt[t * 4 + r], dA = __expf(dt * An), xv = sX[t * 256 + r * 64 + p], coef = dt * xv;
            float part = 0.f;
#pragma unroll
            for (int kk = 0; kk < 4; ++kk) { const f32x4 bv = *(const f32x4*)(sB + t * 128 + 32 * kk + 4 * nb), cv = *(const f32x4*)(sC + t * 128 + 32 * kk + 4 * nb);
                st[kk] = st[kk] * dA + bv * coef; part += (cv.x * st[kk].x + cv.y * st[kk].y) + (cv.z * st[kk].z + cv.w * st[kk].w); }
            part += __shfl_xor(part, 1); part += __shfl_xor(part, 2); part += __shfl_xor(part, 4);
            if (nb == 0) sY[t * 256 + r * 64 + p] = part + Dk * xv;
        }
#pragma unroll
        for (int kk = 0; kk < 4; ++kk) *(f32x4*)(sout + 32 * kk) = st[kk];
    }
    __syncthreads();
    {
        const int t = wave, c4 = lane * 4; const size_t row = (size_t)(R0 + t);
        const f32x4 y = *(const f32x4*)(sY + t * 256 + c4);
        const u32x2 zz = *(const u32x2*)(ZX + row * ZXW + g * 256 + c4);
        const float z0 = bflo(zz.x), z1 = bfhi(zz.x), z2 = bflo(zz.y), z3 = bfhi(zz.y);
        const float g0 = y.x * z0 * sigmoid_f(z0), g1 = y.y * z1 * sigmoid_f(z1), g2 = y.z * z2 * sigmoid_f(z2), g3 = y.w * z3 * sigmoid_f(z3);
        const float ss = wave_sum((g0 * g0 + g1 * g1) + (g2 * g2 + g3 * g3));
        const float rs = rsqrtf(ss * (1.f / 256.f) + EPS);
        u32x2 o; o.x = pkbf(g0 * rs, g1 * rs); o.y = pkbf(g2 * rs, g3 * rs);
        *(u32x2*)(YN + row * DINNER + g * 256 + c4) = o;
    }
    __syncthreads();
}

__device__ __forceinline__ void phase_ssd1(ArgsP a, int li, unsigned char* lds, int tid, int wave, int lane) {
    for (int u = blockIdx.x; u < 1032 + 1024; u += gridDim.x) {
        if (u < 1024) { const int slot = u >> 3, g = u & 7; ssd1_unit(a, li, lds, slot, g, (slot >> 6) * SEQ + (slot & 63) * 128, 128, tid, wave, lane); }
        else if (u < 1032) ssd1_unit(a, li, lds, 128, u - 1024, ROW_M, NMETA, tid, wave, lane);
        else { const int su = u - 1032; ssd_sample_unit(a, li, lds, su >> 3, su & 7, tid, wave, lane); }
    }
}

__device__ __forceinline__ void phase_scan(ArgsP a, int li) {
    float* CS = (float*)(a->ws + WS_CS); const float* CD = (const float*)(a->ws + WS_CD);
    const int gt = blockIdx.x * NTHREADS + ltid(), NT = gridDim.x * NTHREADS;
    for (int e = gt; e < 2 * 65536; e += NT) {
        const int b = e >> 16, rem = e & 65535, h = rem >> 11, pn4 = rem & 2047;
        f32x4 hc = *(const f32x4*)(CS + ((size_t)(128 * 32 + h) * 2048 + pn4) * 4);
#pragma unroll 8
        for (int c = 0; c < 64; ++c) { const int slot = b * 64 + c; f32x4* p = (f32x4*)(CS + ((size_t)(slot * 32 + h) * 2048 + pn4) * 4);
            const f32x4 s = *p; const float d = CD[slot * 32 + h]; *p = hc; hc = hc * d + s; }
        *(f32x4*)(a->out + O_PSSM + ((size_t)((li * NPROMPT + b) * NHEADS + h) * 2048 + pn4) * 4) = hc;
    }
}

__device__ __forceinline__ void ssd3_unit(ArgsP a, int li, unsigned char* lds, const float* hs, int g, int R0, int len, int, int, int) {
    const int tid = ltid(), lane = tid & 63, wave = __builtin_amdgcn_readfirstlane(tid >> 6);
    const bf16* XC = (const bf16*)(a->ws + WS_XC); const bf16* ZX = (const bf16*)(a->ws + WS_ZX); const float* DT = (const float*)(a->ws + WS_DT); bf16* YN = (bf16*)(a->ws + WS_YN);
    bf16* Cn = (bf16*)lds; bf16* Mb = Cn + 128 * LDX; bf16* Xt = Mb + 128 * LDX; bf16* Hs = Xt + 64 * LDX;
    float* s_dt = (float*)(Hs + 64 * LDX); float* s_acs = s_dt + 512;
    const int fr = lane & 15, fq = lane >> 4, h0 = g * 4;
    ssd_acs(DT, a->in[I_ALOG] + li * NHEADS, R0, len, h0, s_dt, s_acs, wave, lane);
#pragma unroll
    for (int k = 0; k < 4; ++k) { const int item = tid + NTHREADS * k, l = item >> 4, ch = item & 15;
        u32x4 vc = (u32x4){0u, 0u, 0u, 0u}, vb = vc;
        if (l < len) { vc = *(const u32x4*)(XC + (size_t)(R0 + l) * CONVD + 3072 + g * 128 + ch * 8); vb = *(const u32x4*)(XC + (size_t)(R0 + l) * CONVD + 2048 + g * 128 + ch * 8); }
        *(u32x4*)(Cn + l * LDX + ch * 8) = vc; *(u32x4*)(Mb + l * LDX + ch * 8) = vb; }
    __syncthreads();
    f32x4 cb[8];
#pragma unroll
    for (int ni = 0; ni < 8; ++ni) cb[ni] = (f32x4){0.f, 0.f, 0.f, 0.f};
#pragma unroll
    for (int ks = 0; ks < 4; ++ks) { const bf16x8 af = LFRAG(Cn, 16 * wave + fr, LDX, ks);
#pragma unroll
        for (int ni = 0; ni < 8; ++ni) if (ni <= wave) { const bf16x8 bb = LFRAG(Mb, 16 * ni + fr, LDX, ks); cb[ni] = MFMA16(bb, af, cb[ni]); } }
    __syncthreads();
    const int l = 16 * wave + fr;
    const size_t row = (size_t)(R0 + ((l < len) ? l : 0));
    f32x4 y0[4], y1[4], y2[4], y3[4];
#pragma unroll
    for (int ni = 0; ni < 4; ++ni) { y0[ni] = (f32x4){0.f, 0.f, 0.f, 0.f}; y1[ni] = y0[ni]; y2[ni] = y0[ni]; y3[ni] = y0[ni]; }
    float ss = 0.f;
#pragma unroll 1
    for (int r = 0; r < 4; ++r) {
        const float al = s_acs[r * 128 + l];
#pragma unroll
        for (int ni = 0; ni < 8; ++ni) { const int s0 = 16 * ni + 4 * fq; float m[4];
#pragma unroll
            for (int j = 0; j < 4; ++j) { const int s = s0 + j; m[j] = (s <= l) ? cb[ni][j] * __expf(al - s_acs[r * 128 + s]) * s_dt[r * 128 + s] : 0.f; }
            u32x2 w; w.x = pkbf(m[0], m[1]); w.y = pkbf(m[2], m[3]); *(u32x2*)(Mb + l * LDX + s0) = w; }
        { const int cbl = tid & 7, tp = tid >> 3, l0 = 2 * tp;
            u32x4 v0 = (u32x4){0u, 0u, 0u, 0u}, v1 = v0;
            if (l0 < len) v0 = *(const u32x4*)(XC + (size_t)(R0 + l0) * CONVD + g * 256 + r * 64 + cbl * 8);
            if (l0 + 1 < len) v1 = *(const u32x4*)(XC + (size_t)(R0 + l0 + 1) * CONVD + g * 256 + r * 64 + cbl * 8);
            const unsigned a0[4] = {v0.x, v0.y, v0.z, v0.w}, a1[4] = {v1.x, v1.y, v1.z, v1.w};
#pragma unroll
            for (int j = 0; j < 4; ++j) {
                *(unsigned*)(Xt + (cbl * 8 + 2 * j) * LDX + l0) = (a0[j] & 0xffffu) | (a1[j] << 16);
                *(unsigned*)(Xt + (cbl * 8 + 2 * j + 1) * LDX + l0) = (a0[j] >> 16) | (a1[j] & 0xffff0000u); } }
#pragma unroll
        for (int k = 0; k < 4; ++k) { const int item = tid + NTHREADS * k, p = item >> 5, n4 = item & 31;
            f32x4 v = (f32x4){0.f, 0.f, 0.f, 0.f}; if (hs) v = *(const f32x4*)(hs + ((size_t)(r * 64 + p) * 128) + n4 * 4);
            u32x2 w; w.x = pkbf(v.x, v.y); w.y = pkbf(v.z, v.w); *(u32x2*)(Hs + p * LDX + n4 * 4) = w; }
        __syncthreads();
        f32x4 yd[4], yo[4];
#pragma unroll
        for (int ni = 0; ni < 4; ++ni) { yd[ni] = (f32x4){0.f, 0.f, 0.f, 0.f}; yo[ni] = yd[ni]; }
#pragma unroll
        for (int ks = 0; ks < 4; ++ks) { const bf16x8 af = LFRAG(Mb, l, LDX, ks);
#pragma unroll
            for (int ni = 0; ni < 4; ++ni) { const bf16x8 bb = LFRAG(Xt, 16 * ni + fr, LDX, ks); yd[ni] = MFMA16(bb, af, yd[ni]); } }
#pragma unroll
        for (int ks = 0; ks < 4; ++ks) { const bf16x8 af = LFRAG(Cn, l, LDX, ks);
#pragma unroll
            for (int ni = 0; ni < 4; ++ni) { const bf16x8 bb = LFRAG(Hs, 16 * ni + fr, LDX, ks); yo[ni] = MFMA16(bb, af, yo[ni]); } }
        const float e = __expf(al);
        const float Dk = a->in[I_ADSKIP][li * NHEADS + h0 + r];
#pragma unroll
        for (int ni = 0; ni < 4; ++ni) { const int ch = g * 256 + r * 64 + 16 * ni + 4 * fq;
            const u32x2 xx = *(const u32x2*)(XC + row * CONVD + ch), zz = *(const u32x2*)(ZX + row * ZXW + ch);
            const float xv[4] = {bflo(xx.x), bfhi(xx.x), bflo(xx.y), bfhi(xx.y)}, zv[4] = {bflo(zz.x), bfhi(zz.x), bflo(zz.y), bfhi(zz.y)};
            f32x4 v = yd[ni] + yo[ni] * e;
#pragma unroll
            for (int j = 0; j < 4; ++j) { const float q = (v[j] + Dk * xv[j]) * zv[j] * sigmoid_f(zv[j]); v[j] = q; ss += q * q; }
            yd[ni] = v; }
        if (r == 0) {
#pragma unroll
            for (int ni = 0; ni < 4; ++ni) y0[ni] = yd[ni];
        } else if (r == 1) {
#pragma unroll
            for (int ni = 0; ni < 4; ++ni) y1[ni] = yd[ni];
        } else if (r == 2) {
#pragma unroll
            for (int ni = 0; ni < 4; ++ni) y2[ni] = yd[ni];
        } else {
#pragma unroll
            for (int ni = 0; ni < 4; ++ni) y3[ni] = yd[ni];
        }
        __syncthreads();
    }
    ss += __shfl_xor(ss, 16); ss += __shfl_xor(ss, 32);
    const float rs = rsqrtf(ss * (1.f / 256.f) + EPS);
    if (l < len) {
        bf16* yrow = YN + row * DINNER + g * 256 + 4 * fq;
#pragma unroll
        for (int ni = 0; ni < 4; ++ni) {
            u32x2 w;
            w.x = pkbf(y0[ni][0] * rs, y0[ni][1] * rs); w.y = pkbf(y0[ni][2] * rs, y0[ni][3] * rs); *(u32x2*)(yrow + 0 * 64 + 16 * ni) = w;
            w.x = pkbf(y1[ni][0] * rs, y1[ni][1] * rs); w.y = pkbf(y1[ni][2] * rs, y1[ni][3] * rs); *(u32x2*)(yrow + 1 * 64 + 16 * ni) = w;
            w.x = pkbf(y2[ni][0] * rs, y2[ni][1] * rs); w.y = pkbf(y2[ni][2] * rs, y2[ni][3] * rs); *(u32x2*)(yrow + 2 * 64 + 16 * ni) = w;
            w.x = pkbf(y3[ni][0] * rs, y3[ni][1] * rs); w.y = pkbf(y3[ni][2] * rs, y3[ni][3] * rs); *(u32x2*)(yrow + 3 * 64 + 16 * ni) = w;
        }
    }
}
__device__ __forceinline__ void phase_ssd3(ArgsP a, int li, unsigned char* lds, int tid, int wave, int lane) {
    const float* CS = (const float*)(a->ws + WS_CS);
    for (int u = blockIdx.x; u < 1032; u += gridDim.x) {
        if (u < 1024) { const int slot = u >> 3, g = u & 7; ssd3_unit(a, li, lds, CS + (size_t)(slot * 32 + g * 4) * 8192, g, (slot >> 6) * SEQ + (slot & 63) * 128, 128, tid, wave, lane); }
        else ssd3_unit(a, li, lds, nullptr, u - 1024, ROW_M, NMETA, tid, wave, lane);
    }
}

constexpr int KS_LD = 72, VT_LD = 232, NKEYS = 208;
__device__ __forceinline__ void attn_prompt_unit(ArgsP a, int lj, unsigned char* lds, int b, int kvh, int qb, int, int, int) {
    const int tid = ltid(), lane = tid & 63, wave = __builtin_amdgcn_readfirstlane(tid >> 6);
    const bf16* Q = (const bf16*)(a->ws + WS_Q); const bf16* KV = (const bf16*)(a->ws + WS_KV); bf16* AO = (bf16*)(a->ws + WS_AO);
    bf16* Ks = (bf16*)lds; bf16* Vt = Ks + NKEYS * KS_LD; bf16* Pw = Vt + 64 * VT_LD + wave * 16 * VT_LD;
    const int fr = lane & 15, fq = lane >> 4, t0 = qb * 64, Rb = b * SEQ;
    for (int it = tid; it < NKEYS * 8; it += NTHREADS) { const int key = it >> 3, ch = it & 7;
        int row; if (key < 16) row = ROW_M + key; else { int s = t0 - 128 + key - 16; if (s < 0) s = 0; row = Rb + s; }
        *(u32x4*)(Ks + key * KS_LD + ch * 8) = *(const u32x4*)(KV + (size_t)row * KVW + kvh * 64 + ch * 8); }
    for (int it = tid; it < (NKEYS / 2) * 8; it += NTHREADS) { const int dbl = it & 7, kp = it >> 3;
        int r0, r1; { const int k0 = 2 * kp, k1 = k0 + 1; int s0 = t0 - 128 + k0 - 16, s1 = t0 - 128 + k1 - 16; if (s0 < 0) s0 = 0; if (s1 < 0) s1 = 0; r0 = (k0 < 16) ? ROW_M + k0 : Rb + s0; r1 = (k1 < 16) ? ROW_M + k1 : Rb + s1; }
        const u32x4 v0 = *(const u32x4*)(KV + (size_t)r0 * KVW + 256 + kvh * 64 + dbl * 8), v1 = *(const u32x4*)(KV + (size_t)r1 * KVW + 256 + kvh * 64 + dbl * 8);
        const unsigned a0[4] = {v0.x, v0.y, v0.z, v0.w}, a1[4] = {v1.x, v1.y, v1.z, v1.w};
#pragma unroll
        for (int j = 0; j < 4; ++j) {
            *(unsigned*)(Vt + (dbl * 8 + 2 * j) * VT_LD + 2 * kp) = (a0[j] & 0xffffu) | (a1[j] << 16);
            *(unsigned*)(Vt + (dbl * 8 + 2 * j + 1) * VT_LD + 2 * kp) = (a0[j] >> 16) | (a1[j] & 0xffff0000u); } }
    { const int row = tid >> 3, c = NKEYS + 2 * (tid & 7); *(unsigned*)(Vt + row * VT_LD + c) = 0u; }
    __syncthreads();
    const int r = wave >> 1, th = (wave & 1) * 32, qh = kvh * 4 + r;
    const float sink = a->in[I_SINKS][lj * NQ + qh];
#pragma unroll 1
    for (int blk = 0; blk < 2; ++blk) {
        const int tq0 = t0 + th + blk * 16, t = tq0 + fr;
        bf16x8 qa[2];
#pragma unroll
        for (int ks = 0; ks < 2; ++ks) qa[ks] = *(const bf16x8*)(Q + (size_t)(Rb + t) * DM + qh * 64 + 32 * ks + 8 * fq);
        f32x4 sc[13];
#pragma unroll
        for (int ni = 0; ni < 13; ++ni) sc[ni] = (f32x4){0.f, 0.f, 0.f, 0.f};
#pragma unroll
        for (int ni = 0; ni < 13; ++ni) {
            const bf16x8 b0 = *(const bf16x8*)(Ks + (16 * ni + fr) * KS_LD + 8 * fq), b1 = *(const bf16x8*)(Ks + (16 * ni + fr) * KS_LD + 32 + 8 * fq);
            sc[ni] = MFMA16(b0, qa[0], sc[ni]); sc[ni] = MFMA16(b1, qa[1], sc[ni]);
            if ((ni & 3) == 3) asm volatile("" ::: "memory"); }
        float mx = -INFINITY;
#pragma unroll
        for (int ni = 0; ni < 13; ++ni)
#pragma unroll
            for (int j = 0; j < 4; ++j) { const int key = 16 * ni + 4 * fq + j; bool vis = true;
                if (key >= 16) { const int s = t0 - 128 + key - 16; vis = (s >= 0) && (s <= t) && (s > t - 128); }
                const float v = vis ? sc[ni][j] * 0.125f : -INFINITY; sc[ni][j] = v; mx = fmaxf(mx, v); }
        mx = fmaxf(mx, __shfl_xor(mx, 16)); mx = fmaxf(mx, __shfl_xor(mx, 32)); mx = fmaxf(mx, sink);
        float sum = 0.f;
#pragma unroll
        for (int ni = 0; ni < 13; ++ni)
#pragma unroll
            for (int j = 0; j < 4; ++j) { const float p = __expf(sc[ni][j] - mx); sc[ni][j] = p; sum += p; }
        sum += __shfl_xor(sum, 16); sum += __shfl_xor(sum, 32); sum += __expf(sink - mx);
        const float inv = 1.f / sum;
#pragma unroll
        for (int ni = 0; ni < 13; ++ni) { u32x2 w; w.x = pkbf(sc[ni][0] * inv, sc[ni][1] * inv); w.y = pkbf(sc[ni][2] * inv, sc[ni][3] * inv); *(u32x2*)(Pw + fr * VT_LD + 16 * ni + 4 * fq) = w; }
        *(u32x2*)(Pw + fr * VT_LD + NKEYS + 4 * fq) = (u32x2){0u, 0u};
        asm volatile("s_waitcnt lgkmcnt(0)" ::: "memory");
        f32x4 o[4];
#pragma unroll
        for (int ni = 0; ni < 4; ++ni) o[ni] = (f32x4){0.f, 0.f, 0.f, 0.f};
#pragma unroll
        for (int ks = 0; ks < 7; ++ks) { const bf16x8 af = *(const bf16x8*)(Pw + fr * VT_LD + 32 * ks + 8 * fq);
#pragma unroll
            for (int ni = 0; ni < 4; ++ni) { const bf16x8 bb = *(const bf16x8*)(Vt + (16 * ni + fr) * VT_LD + 32 * ks + 8 * fq); o[ni] = MFMA16(bb, af, o[ni]); }
            if (ks & 1) asm volatile("" ::: "memory"); }
#pragma unroll
        for (int ni = 0; ni < 4; ++ni) { u32x2 w; w.x = pkbf(o[ni][0], o[ni][1]); w.y = pkbf(o[ni][2], o[ni][3]); *(u32x2*)(AO + (size_t)(Rb + t) * DM + qh * 64 + 16 * ni + 4 * fq) = w; }
        asm volatile("s_waitcnt lgkmcnt(0)" ::: "memory");
    }
    __syncthreads();
}
__device__ __forceinline__ void attn_sample_unit(ArgsP a, int lj, unsigned char* lds, int b, int kvh, int, int, int) {
    const int tid = ltid(), lane = tid & 63, wave = __builtin_amdgcn_readfirstlane(tid >> 6);
    const bf16* Q = (const bf16*)(a->ws + WS_Q); const bf16* KV = (const bf16*)(a->ws + WS_KV); bf16* AO = (bf16*)(a->ws + WS_AO);
    float* Kf = (float*)lds; float* Vf = Kf + 152 * 65; float* Qf = Vf + 152 * 64; float* Sc = Qf + 32 * 64;
    for (int idx = tid; idx < 152 * 64; idx += NTHREADS) { const int s = idx >> 6, d = idx & 63; float kv, vv;
        if (s < 16) { const bf16* rowp = KV + (size_t)(ROW_M + s) * KVW + kvh * 64 + d; kv = bf2f(rowp[0]); vv = bf2f(rowp[256]); }
        else if (s < 144) { const size_t o = ((size_t)(b * 128 + (s - 16)) * NKV + kvh) * 64 + d; kv = a->in[I_CK][o]; vv = a->in[I_CV][o]; }
        else { const bf16* rowp = KV + (size_t)(ROW_S + b * 8 + (s - 144)) * KVW + kvh * 64 + d; kv = bf2f(rowp[0]); vv = bf2f(rowp[256]); }
        Kf[s * 65 + d] = kv; Vf[s * 64 + d] = vv; }
    for (int idx = tid; idx < 32 * 64; idx += NTHREADS) { const int qi = idx >> 6, d = idx & 63, r = qi >> 3, t = qi & 7;
        Qf[qi * 64 + d] = bf2f(Q[(size_t)(ROW_S + b * 8 + t) * DM + (kvh * 4 + r) * 64 + d]); }
    __syncthreads();
    if (lj == 0) {
        for (int idx = tid; idx < 128 * 64; idx += NTHREADS) { const int w = idx >> 6, d = idx & 63; const size_t o = ((size_t)(b * 128 + w) * NKV + kvh) * 64 + d;
            a->out[O_SCK + o] = Kf[(24 + w) * 65 + d]; a->out[O_SCV + o] = Vf[(24 + w) * 64 + d]; }
    }
    for (int idx = tid; idx < 32 * 152; idx += NTHREADS) { const int qi = idx / 152, s = idx - qi * 152, t = qi & 7;
        float dot = 0.f;
#pragma unroll 16
        for (int d = 0; d < 64; ++d) dot += Qf[qi * 64 + d] * Kf[s * 65 + d];
        const bool vis = (s < 16) || ((s < 144) ? ((s - 16) > t) : ((s - 144) <= t));
        Sc[qi * 153 + s] = vis ? dot * 0.125f : -INFINITY; }
    __syncthreads();
#pragma unroll 1
    for (int q = 0; q < 4; ++q) { const int qi = wave * 4 + q, r = qi >> 3; const float sink = a->in[I_SINKS][lj * NQ + kvh * 4 + r];
        float v0 = Sc[qi * 153 + lane], v1 = Sc[qi * 153 + 64 + lane], v2 = (lane < 24) ? Sc[qi * 153 + 128 + lane] : -INFINITY;
        float mx = fmaxf(fmaxf(v0, v1), v2);
#pragma unroll
        for (int o = 1; o < 64; o <<= 1) mx = fmaxf(mx, __shfl_xor(mx, o));
        mx = fmaxf(mx, sink);
        v0 = __expf(v0 - mx); v1 = __expf(v1 - mx); v2 = __expf(v2 - mx);
        const float sum = wave_sum(v0 + v1 + v2) + __expf(sink - mx), inv = 1.f / sum;
        Sc[qi * 153 + lane] = v0 * inv; Sc[qi * 153 + 64 + lane] = v1 * inv; if (lane < 24) Sc[qi * 153 + 128 + lane] = v2 * inv; }
    __syncthreads();
    { const int qi = tid >> 4, d4 = (tid & 15) * 4, r = qi >> 3, t = qi & 7; f32x4 o = (f32x4){0.f, 0.f, 0.f, 0.f};
#pragma unroll 8
        for (int s = 0; s < 152; ++s) { const float p = Sc[qi * 153 + s]; const f32x4 v = *(const f32x4*)(Vf + s * 64 + d4); o = o + v * p; }
        u32x2 w; w.x = pkbf(o.x, o.y); w.y = pkbf(o.z, o.w);
        *(u32x2*)(AO + (size_t)(ROW_S + b * 8 + t) * DM + (kvh * 4 + r) * 64 + d4) = w; }
    __syncthreads();
}
__device__ __forceinline__ void phase_attn(ArgsP a, int lj, unsigned char* lds, int tid, int wave, int lane) {
    if (lj == 0) {
        const bf16* KV = (const bf16*)(a->ws + WS_KV);
        const int gt = blockIdx.x * NTHREADS + tid, NT = gridDim.x * NTHREADS;
        for (int e = gt; e < 2 * 128 * 512; e += NT) { const int b = e >> 16, w = (e >> 9) & 127, c = e & 511;
            const float v = bf2f(KV[(size_t)(b * SEQ + SEQ - 128 + w) * KVW + c]);
            if (c < 256) a->out[O_PCK + (size_t)(b * 128 + w) * 256 + c] = v; else a->out[O_PCV + (size_t)(b * 128 + w) * 256 + (c - 256)] = v; }
    }
    for (int u = blockIdx.x; u < 1024 + 512; u += gridDim.x) {
#ifndef NO_PROMPT_ATTN
        if (u < 1024) { const int qb = u & 127, kvh = (u >> 7) & 3, b = u >> 9; attn_prompt_unit(a, lj, lds, b, kvh, qb, tid, wave, lane); }
#else
        if (u < 1024) {}
#endif
#ifndef NO_SAMPLE_ATTN
        else { const int su = u - 1024; attn_sample_unit(a, lj, lds, su >> 2, su & 3, tid, wave, lane); }
#endif
    }
}

constexpr int NPHASES = 36;
template <class Epi> __device__ __forceinline__ void run_gemm(LAS unsigned char* lds, const bf16* A, const bf16* Bt, int N, int K, const Epi& E) {
    pg8::Gemm g{A, Bt, MP, N, K}; pg8::StaticOrder S; S.init(MP, N, K, (int)gridDim.x, (int)blockIdx.x);
    pg8::gemm_phase<Epi, pg8::StaticOrder, true, true>(lds, g, S, E);
}
template <class Epi> __device__ __forceinline__ void run_gemm_res(LAS unsigned char* lds, const bf16* A, const bf16* Bt, int K, int S_, const Epi& E) {
    pg8::Gemm g{A, Bt, MP, 1024, K}; pg8::ResOrder S; S.init(K, S_, (int)gridDim.x, (int)blockIdx.x);
    pg8::gemm_phase<Epi, pg8::ResOrder, true, true>(lds, g, S, E);
}

__global__ void __launch_bounds__(NTHREADS, 2) yoco_fwd(Args args) {
    extern __shared__ __attribute__((aligned(16))) unsigned char lds[];
    LAS unsigned char* ldsl = (LAS unsigned char*)lds;
    const int tid0 = threadIdx.x;
    for (int u = tid0; u < (LDS_BYTES - LDSCTL_OFF) / 4; u += NTHREADS) ((LAS unsigned*)(ldsl + LDSCTL_OFF))[u] = 0u;
    __syncthreads();
    const int lo = args.ph_lo, hi = args.ph_hi;
    XcdBarrier bar; bar.bar = (unsigned*)(args.ws + WS_CTL) + CW_BAR; bar.x = 0; bar.st = nullptr;
    if (hi - lo > 1) bar = xcd_barrier_post((unsigned*)(args.ws + WS_CTL) + CW_BAR, (volatile LAS unsigned*)(ldsl + MISC_OFF) + 8);
    int rep = 0;
#pragma unroll 1
    for (int p = lo; p < hi;) {
        ArgsP la = (ArgsP)__builtin_amdgcn_kernarg_segment_ptr(); asm volatile("" : "+s"(la));
        unsigned char* ws = la->ws;
        const int tid = ltid();
        const int lane = tid & 63, wave = __builtin_amdgcn_readfirstlane(tid >> 6);
        bf16* HN = (bf16*)(ws + WS_HN); float* H = (float*)(ws + WS_H);
        int kind, li = 0, lj = 0, layer = 0;
        if (p == 0) kind = 0;
        else if (p < 21) { li = (p - 1) / 10; layer = li; const int sub = (p - 1) % 10;
            kind = (sub == 0) ? (li == 0 ? 2 : 1) : (sub == 1) ? 3 : (sub == 2) ? 4 : (sub == 3) ? 5 : (sub == 4) ? 6 : (sub == 5) ? 7 : (sub == 6) ? 8 : (sub == 7) ? 1 : (sub == 8) ? 9 : 10; }
        else if (p < 35) { lj = (p - 21) / 7; layer = 2 + lj; const int sub = (p - 21) % 7;
            kind = (sub == 0) ? 1 : (sub == 1) ? 11 : (sub == 2) ? 12 : (sub == 3) ? 13 : (sub == 4) ? 1 : (sub == 5) ? 9 : 10; }
        else kind = 14;
#ifndef KMASK
#define KMASK 0xffff
#endif
#define KON(k) ((KMASK >> (k)) & 1)
#ifndef REP_MASK
#define REP_MASK 0
#endif
        if (KON(0) && kind == 0) phase_prologue(la, ldsl, wave, lane);
        else if (KON(1) && kind == 1) { const int sub = (p < 21) ? (p - 1) % 10 : (p - 21) % 7; phase_norm(la, 0, (p >= 21 && sub == 4) ? 4 : 8, wave, lane); }
        else if (KON(1) && kind == 2) phase_norm(la, 1, 0, wave, lane);
        else if (KON(3) && kind == 3) { pg8::EpiInProj E{(bf16*)(ws + WS_ZX), (float*)(ws + WS_DT), la->in[I_ADTB] + li * NHEADS}; run_gemm(ldsl, HN, (const bf16*)(ws + WS_WIN + li * SZ_WIN), INPROJ_P, 1024, E); }
        else if (KON(4) && kind == 4) phase_conv(la, li);
        else if (KON(5) && kind == 5) phase_ssd1(la, li, lds, tid, wave, lane);
        else if (KON(6) && kind == 6) phase_scan(la, li);
        else if (KON(7) && kind == 7) phase_ssd3(la, li, lds, tid, wave, lane);
        else if (KON(8) && (kind == 8 || kind == 10 || kind == 13)) {
            const bf16* A; const bf16* Bt; int K;
            if (kind == 8) { A = (const bf16*)(ws + WS_YN); Bt = (const bf16*)(ws + WS_WOUT + li * SZ_WOUT); K = 2048; }
            else if (kind == 10) { A = (const bf16*)(ws + WS_U); Bt = (const bf16*)(ws + WS_WDN + layer * SZ_WDN); K = 4096; }
            else { A = (const bf16*)(ws + WS_AO); Bt = (const bf16*)(ws + WS_WO + lj * SZ_WO); K = 1024; }
            pg8::EpiRes E{H, (float*)(ws + WS_SLAB)}; run_gemm_res(ldsl, A, Bt, K, K == 1024 ? 4 : 8, E); }
        else if (KON(9) && kind == 9) { pg8::EpiBf<1> E{(bf16*)(ws + WS_U), 4096, 1 << 20, nullptr, 0}; run_gemm(ldsl, HN, (const bf16*)(ws + WS_WUP + layer * SZ_WUP), 4096, 1024, E); }
        else if (KON(11) && kind == 11) { pg8::EpiBf<0> E{(bf16*)(ws + WS_Q), 1024, 4, (bf16*)(ws + WS_KV), KVW};
            run_gemm(ldsl, HN, (const bf16*)(ws + (lj == 0 ? WS_WQKV0 : WS_WQ1)), lj == 0 ? 1536 : 1024, 1024, E); }
        else if (KON(12) && kind == 12) phase_attn(la, lj, lds, tid, wave, lane);
        else if (KON(14) && kind == 14) phase_final(la, wave, lane);
        bool again = false;
        if (REP_MASK != 0) { if (rep == 0 && ((REP_MASK >> kind) & 1)) { rep = 1; again = true; } else rep = 0; }
        if (p + 1 < hi || again) xcd_barrier(bar); else { asm volatile("s_waitcnt vmcnt(0)" ::: "memory"); __syncthreads(); }
        if (!again) ++p;
    }
}

#ifndef MK_PER_PHASE
#define MK_PER_PHASE 0
#endif
extern "C" void kernel_launch(void* const* d_in, const int* in_sizes, int n_in, void* d_out, int out_size, void* d_ws, size_t ws_size, hipStream_t stream) {
    static int grid = 0;
    if (grid == 0) {
        if (n_in != 26 || (size_t)out_size != O_END || ws_size < WS_END) { fprintf(stderr, "kernel_launch: unexpected problem (n_in %d, out %d vs %zu, ws %zu vs %zu); nothing launched\n", n_in, out_size, (size_t)O_END, ws_size, (size_t)WS_END); grid = -1; return; }
        int dev = 0, cus = 0, per_cu = 0;
        if (hipGetDevice(&dev) != hipSuccess || hipDeviceGetAttribute(&cus, hipDeviceAttributeMultiprocessorCount, dev) != hipSuccess) { grid = -1; return; }
        if (hipFuncSetAttribute((const void*)yoco_fwd, hipFuncAttributeMaxDynamicSharedMemorySize, LDS_BYTES) != hipSuccess) { fprintf(stderr, "kernel_launch: hipFuncSetAttribute failed\n"); grid = -1; return; }
        if (hipOccupancyMaxActiveBlocksPerMultiprocessor(&per_cu, (const void*)yoco_fwd, NTHREADS, LDS_BYTES) != hipSuccess || per_cu < 1) { fprintf(stderr, "kernel_launch: occupancy query says %d\n", per_cu); per_cu = 1; }
        (void)hipGetLastError();
        if (cus != 256) { fprintf(stderr, "kernel_launch: built for a 256-CU device (got %d); nothing launched\n", cus); grid = -1; return; }
        grid = cus;
    }
    if (grid < 0) return;
    if (hipMemsetAsync((char*)d_ws + WS_CTL, 0, CTL_ZERO_BYTES, stream) != hipSuccess) { fprintf(stderr, "kernel_launch: memset failed\n"); return; }
    Args a{};
    for (int i = 0; i < 26; ++i) a.in[i] = (const float*)d_in[i];
    a.out = (float*)d_out; a.ws = (unsigned char*)d_ws;
#if MK_PER_PHASE
    for (int p = 0; p < NPHASES; ++p) { a.ph_lo = p; a.ph_hi = p + 1; hipLaunchKernelGGL(yoco_fwd, dim3(grid), dim3(NTHREADS), LDS_BYTES, stream, a); }
#else
    a.ph_lo = 0; a.ph_hi = NPHASES;
    void* kargs[] = {&a};
    hipError_t e = hipLaunchCooperativeKernel((const void*)yoco_fwd, dim3(grid), dim3(NTHREADS), kargs, LDS_BYTES, stream);
    if (e != hipSuccess) fprintf(stderr, "kernel_launch: cooperative launch failed: %s (grid %d)\n", hipGetErrorString(e), grid);
#endif
}
```

```cpp
#include <hip/hip_runtime.h>
#include <cstdio>
#include <cstdint>
#include <cmath>
namespace pg8 {
#define PG8_LAS __attribute__((address_space(3)))
typedef unsigned short bf16_t;
typedef short bf16x8 __attribute__((ext_vector_type(8)));
typedef float f32x4 __attribute__((ext_vector_type(4)));
typedef unsigned u32x4 __attribute__((ext_vector_type(4)));
constexpr int BM = 256, BK = 64, HALF = 128, HTB = HALF * BK * 2  , STAGE_BYTES = 8 * HTB, NXCD = 8, WGM = 8;

__host__ __device__ __forceinline__ int lds_byte(int r, int c) { const int st = (r >> 4) * 2 + (c >> 5), rr = r & 15, cc = c & 31, ob = rr * 64 + cc * 2; return st * 1024 + (ob ^ (((ob >> 9) & 1) << 5)); }
__host__ __device__ __forceinline__ void stage_rc(int b, int& R, int& C) { const int st = b / 1024, sb = b % 1024, swz = sb ^ (((sb >> 9) & 1) << 5); R = (st >> 1) * 16 + swz / 64; C = (st & 1) * 32 + (swz % 64) / 2; }
__host__ __device__ __forceinline__ int perm32(int rho) { const int n = rho >> 4, i = rho & 15; return 8 * (i >> 2) + 4 * n + (i & 3); }

struct Unit { int pm, pn, k0, nt, aux; };
struct Gemm { const bf16_t* A; const bf16_t* Bt; int M, N, K; };

struct StaticOrder {
    int nM, nN, nwg, G, c, nt0;
    __host__ __device__ void init(int M, int N, int K, int G_, int c_) { nM = M / BM; nN = N / BM; nwg = nM * nN; G = G_; c = c_; nt0 = K / BK; }
    __host__ __device__ bool next(int i, Unit& u) const {
        const long L = (long)i * G + c; if (L >= nwg) return false;
        int wgid = (int)L; { const int q = nwg / NXCD, r = nwg % NXCD, xcd = wgid % NXCD, off = wgid / NXCD; wgid = (xcd < r ? xcd * (q + 1) : r * (q + 1) + (xcd - r) * q) + off; }
        const int nig = WGM * nN, gid = wgid / nig, fm = gid * WGM, gsz = (nM - fm) < WGM ? (nM - fm) : WGM;
        u.pm = fm + ((wgid % nig) % gsz); u.pn = (wgid % nig) / gsz; u.k0 = 0; u.nt = nt0; u.aux = -1; return true;
    }
    __device__ __forceinline__ void a_ready(const Unit&) const {}
    __device__ __forceinline__ void done(const Unit&) const {}
};
struct ResOrder {
    StaticOrder so; int S, K, c;
    __host__ __device__ void init(int K_, int S_, int G_, int c_) { so.init(64 * BM, 1024, K_, G_, c_); S = S_; K = K_; c = c_; }
    __host__ __device__ bool next(int i, Unit& u) const {
        if (i == 0) return so.next(0, u);
        if (i == 1 && c < 20 * S) { const int t = c / S, sl = c - t * S; u.pm = 64 + (t >> 2); u.pn = t & 3; u.k0 = sl * (K / S); u.nt = K / S / BK; u.aux = sl; return true; }
        return false;
    }
    __device__ __forceinline__ void a_ready(const Unit&) const {}
    __device__ __forceinline__ void done(const Unit&) const {}
};

__device__ __forceinline__ unsigned cvt_pk_bf16(float lo, float hi) { unsigned r; asm volatile("v_cvt_pk_bf16_f32 %0, %1, %2" : "=v"(r) : "v"(lo), "v"(hi)); return r; }
typedef float f32x2 __attribute__((ext_vector_type(2)));
typedef unsigned u32x2 __attribute__((ext_vector_type(2)));
__device__ __forceinline__ float softplus_f(float x) { return x > 20.f ? x : log1pf(__expf(x)); }
struct EpiInProj {
    static constexpr bool PERM = true, AFTER_DRAIN = false;
    bf16_t* ZX; float* DT; const float* dt_bias;
    __device__ __forceinline__ void operator()(const f32x4 (&acc)[2][2][4][2], const Unit& u, int wr, int wc, int fr, int fq) const {
        const int row0 = u.pm * BM + wr * 64 + fr;
        if (u.pn < 24) {
            const int col0 = u.pn * BM + wc * 32 + 8 * fq;
#pragma unroll
            for (int ai = 0; ai < 2; ++ai)
#pragma unroll
                for (int m = 0; m < 4; ++m) { bf16_t* rowp = ZX + (size_t)(row0 + ai * HALF + m * 16) * 6144 + col0;
#pragma unroll
                    for (int bj = 0; bj < 2; ++bj) { const f32x4 v0 = acc[ai][bj][m][0], v1 = acc[ai][bj][m][1];
                        u32x4 w; w.x = cvt_pk_bf16(v0[0], v0[1]); w.y = cvt_pk_bf16(v0[2], v0[3]); w.z = cvt_pk_bf16(v1[0], v1[1]); w.w = cvt_pk_bf16(v1[2], v1[3]);
                        *(u32x4*)(rowp + bj * HALF) = w; } }
        } else if (wc == 0) {
            const int c0 = 8 * fq;
            const f32x4 b0 = *(const f32x4*)(dt_bias + c0), b1 = *(const f32x4*)(dt_bias + c0 + 4);
#pragma unroll
            for (int ai = 0; ai < 2; ++ai)
#pragma unroll
                for (int m = 0; m < 4; ++m) { float* rowp = DT + (size_t)(row0 + ai * HALF + m * 16) * 32 + c0;
                    const f32x4 v0 = acc[ai][0][m][0] + b0, v1 = acc[ai][0][m][1] + b1;
                    f32x4 o0, o1;
#pragma unroll
                    for (int j = 0; j < 4; ++j) { o0[j] = softplus_f(v0[j]); o1[j] = softplus_f(v1[j]); }
                    *(f32x4*)(rowp) = o0; *(f32x4*)(rowp + 4) = o1; }
        }
    }
};
struct EpiRes {
    static constexpr bool PERM = false, AFTER_DRAIN = false;
    float* H; float* SLAB;
    __device__ __forceinline__ void operator()(const f32x4 (&acc)[2][2][4][2], const Unit& u, int wr, int wc, int fr, int fq) const {
        const int row0 = u.pm * BM + wr * 64 + fr, col0 = u.pn * BM + wc * 32 + 4 * fq;
        if (u.aux >= 0) {
            float* base = SLAB + (size_t)u.aux * (1280 * 1024) + (size_t)(row0 - 16384) * 1024 + col0;
#pragma unroll
            for (int ai = 0; ai < 2; ++ai)
#pragma unroll
                for (int m = 0; m < 4; ++m) { float* rowp = base + (size_t)(ai * HALF + m * 16) * 1024;
#pragma unroll
                    for (int bj = 0; bj < 2; ++bj)
#pragma unroll
                        for (int n = 0; n < 2; ++n) *(f32x4*)(rowp + bj * HALF + n * 16) = acc[ai][bj][m][n]; }
            return;
        }
#pragma unroll
        for (int ai = 0; ai < 2; ++ai)
#pragma unroll
            for (int m = 0; m < 4; ++m) { float* rowp = H + (size_t)(row0 + ai * HALF + m * 16) * 1024 + col0;
#pragma unroll
                for (int bj = 0; bj < 2; ++bj)
#pragma unroll
                    for (int n = 0; n < 2; ++n) { f32x4* p = (f32x4*)(rowp + bj * HALF + n * 16); *p = *p + acc[ai][bj][m][n]; } }
    }
};
template <int ACT> struct EpiBf {
    static constexpr bool PERM = true, AFTER_DRAIN = false;
    bf16_t* O0; int ldc0; int nsplit; bf16_t* O1; int ldc1;
    __device__ __forceinline__ void operator()(const f32x4 (&acc)[2][2][4][2], const Unit& u, int wr, int wc, int fr, int fq) const {
        const int row0 = u.pm * BM + wr * 64 + fr;
        bf16_t* base; int ldc, colt;
        if (u.pn < nsplit) { base = O0; ldc = ldc0; colt = u.pn * BM; } else { base = O1; ldc = ldc1; colt = (u.pn - nsplit) * BM; }
        const int col0 = colt + wc * 32 + 8 * fq;
#pragma unroll
        for (int ai = 0; ai < 2; ++ai)
#pragma unroll
            for (int m = 0; m < 4; ++m) { bf16_t* rowp = base + (size_t)(row0 + ai * HALF + m * 16) * ldc + col0;
#pragma unroll
                for (int bj = 0; bj < 2; ++bj) { f32x4 v0 = acc[ai][bj][m][0], v1 = acc[ai][bj][m][1];
                    if (ACT == 1) {
#pragma unroll
                        for (int j = 0; j < 4; ++j) { const float a = fmaxf(v0[j], 0.f), b = fmaxf(v1[j], 0.f); v0[j] = a * a; v1[j] = b * b; } }
                    u32x4 w; w.x = cvt_pk_bf16(v0[0], v0[1]); w.y = cvt_pk_bf16(v0[2], v0[3]); w.z = cvt_pk_bf16(v1[0], v1[1]); w.w = cvt_pk_bf16(v1[2], v1[3]);
                    *(u32x4*)(rowp + bj * HALF) = w; } }
    }
};

template <class Epi, class Sched, bool ALIGN_EPI = false, bool SP2 = false>
__device__ __forceinline__ void gemm_phase(PG8_LAS unsigned char* lds, const Gemm g, const Sched& S, const Epi& E) {
    int tid_l = threadIdx.x; asm volatile("" : "+v"(tid_l));
    const int tid = tid_l, wid = __builtin_amdgcn_readfirstlane(tid >> 6), lane = tid & 63, wr = wid >> 2, wc = wid & 3, fr = lane & 15, fq = lane >> 4;
    const int K = g.K;
    unsigned voffA[2], voffB[2];
#pragma unroll
    for (int i = 0; i < 2; ++i) { int R, C; stage_rc(tid * 16 + i * 8192, R, C); const int Rb = Epi::PERM ? ((R & ~31) + perm32(R & 31)) : R;
        voffA[i] = (unsigned)(R * K + C) * 2u; voffB[i] = (unsigned)(Rb * K + C) * 2u; }
    const size_t kstep = (size_t)(BK * 2);
    const size_t hstep = (size_t)HALF * K * 2;
    const size_t tstep = 2 * hstep;
    const unsigned ldsw = (unsigned)wid * 1024u;
    const int aoff = lds_byte(wr * 64 + fr, fq * 8), boff = lds_byte(wc * 32 + fr, fq * 8);
#define PG8_SA(b, h) (((b) * 2 + (h)) * HTB)
#define PG8_SB(b, h) ((4 + (b) * 2 + (h)) * HTB)
#define PG8_STAGE(bufoff, gbase, voff) do { _Pragma("unroll") for (int _i = 0; _i < 2; ++_i) \
        __builtin_amdgcn_global_load_lds((const unsigned*)((const char*)(gbase) + (voff)[_i]), (PG8_LAS unsigned*)(lds + (bufoff) + ldsw + _i * 8192), 16, 0, 0); } while (0)
#define PG8_LDA(dst, b, h) do { _Pragma("unroll") for (int m = 0; m < 4; ++m) _Pragma("unroll") for (int k = 0; k < 2; ++k) dst[m][k] = *(const PG8_LAS bf16x8*)(lds + PG8_SA(b, h) + aoff + m * 2048 + k * 1024); } while (0)
#define PG8_LDB(dst, b, h) do { _Pragma("unroll") for (int n = 0; n < 2; ++n) _Pragma("unroll") for (int k = 0; k < 2; ++k) dst[n][k] = *(const PG8_LAS bf16x8*)(lds + PG8_SB(b, h) + boff + n * 2048 + k * 1024); } while (0)
#define PG8_MMA(ai, bj, At, Bt) do { __builtin_amdgcn_s_setprio(1); _Pragma("unroll") for (int m = 0; m < 4; ++m) _Pragma("unroll") for (int n = 0; n < 2; ++n) _Pragma("unroll") for (int k = 0; k < 2; ++k) \
        acc[ai][bj][m][n] = __builtin_amdgcn_mfma_f32_16x16x32_bf16(Bt[n][k], At[m][k], acc[ai][bj][m][n], 0, 0, 0); __builtin_amdgcn_s_setprio(0); } while (0)
#define PG8_WAIT_V(n) asm volatile("s_waitcnt vmcnt(" #n ")" ::: "memory")
#define PG8_WAIT_L(n) asm volatile("s_waitcnt lgkmcnt(" #n ")" ::: "memory")
#define PG8_BAR __builtin_amdgcn_s_barrier()
#define PG8_SCHED __builtin_amdgcn_sched_barrier(0)
    Unit cur, nxt; int ui = 0;
    if (!S.next(0, cur)) return;
    f32x4 acc[2][2][4][2];
#pragma unroll
    for (int a = 0; a < 2; ++a)
#pragma unroll
        for (int b = 0; b < 2; ++b)
#pragma unroll
            for (int m = 0; m < 4; ++m)
#pragma unroll
                for (int n = 0; n < 2; ++n) acc[a][b][m][n] = (f32x4){0.f, 0.f, 0.f, 0.f};
    bf16x8 At[4][2], B0[2][2], B1[2][2];
    const char* cA = (const char*)g.A + (size_t)cur.pm * tstep + (size_t)cur.k0 * 2; const char* cB = (const char*)g.Bt + (size_t)cur.pn * tstep + (size_t)cur.k0 * 2;
    S.a_ready(cur);
    if constexpr (SP2) {
        PG8_STAGE(PG8_SB(0, 0), cB, voffB); PG8_STAGE(PG8_SB(0, 1), cB + hstep, voffB); PG8_STAGE(PG8_SA(0, 0), cA, voffA); PG8_STAGE(PG8_SA(0, 1), cA + hstep, voffA);
        if (wr == 1) PG8_BAR;
        PG8_WAIT_V(2); PG8_BAR;
        PG8_STAGE(PG8_SB(1, 0), cB + kstep, voffB); PG8_STAGE(PG8_SA(1, 0), cA + kstep, voffA); PG8_STAGE(PG8_SB(1, 1), cB + hstep + kstep, voffB);
        PG8_WAIT_V(6); PG8_BAR;
    } else {
        PG8_STAGE(PG8_SB(0, 0), cB, voffB); PG8_STAGE(PG8_SA(0, 0), cA, voffA); PG8_STAGE(PG8_SB(0, 1), cB + hstep, voffB); PG8_STAGE(PG8_SA(0, 1), cA + hstep, voffA);
        if (wr == 1) PG8_BAR;
        PG8_WAIT_V(4); PG8_BAR;
        PG8_STAGE(PG8_SB(1, 0), cB + kstep, voffB); PG8_STAGE(PG8_SA(1, 0), cA + kstep, voffA); PG8_STAGE(PG8_SB(1, 1), cB + hstep + kstep, voffB);
        PG8_WAIT_V(6); PG8_BAR;
    }
    for (;;) {
        const bool has_next = S.next(ui + 1, nxt);
        const char* nA = has_next ? (const char*)g.A + (size_t)nxt.pm * tstep + (size_t)nxt.k0 * 2 : cA; const char* nB = has_next ? (const char*)g.Bt + (size_t)nxt.pn * tstep + (size_t)nxt.k0 * 2 : cB;
        const int nt = cur.nt;
        for (int t = 0; t < nt; t += 2) {
            const bool last = (t == nt - 2);
            const char* a1 = cA + (size_t)(t + 1) * kstep;
            const char* a2 = last ? nA : cA + (size_t)(t + 2) * kstep; const char* b2 = last ? nB : cB + (size_t)(t + 2) * kstep;
            const char* a3 = a2 + kstep; const char* b3 = b2 + kstep;
            if (last && has_next) S.a_ready(nxt);
            if constexpr (SP2) {
            PG8_LDB(B0, 0, 0); PG8_LDB(B1, 0, 1); PG8_SCHED; PG8_LDA(At, 0, 0); PG8_STAGE(PG8_SA(1, 1), a1 + hstep, voffA);
            PG8_WAIT_V(8); PG8_WAIT_L(0); PG8_BAR; PG8_MMA(0, 0, At, B0); PG8_MMA(0, 1, At, B1); PG8_BAR; PG8_SCHED;
            PG8_LDA(At, 0, 1); PG8_STAGE(PG8_SB(0, 0), b2, voffB); PG8_STAGE(PG8_SB(0, 1), b2 + hstep, voffB); PG8_STAGE(PG8_SA(0, 0), a2, voffA);
            PG8_WAIT_V(8); PG8_WAIT_L(0); PG8_BAR; PG8_MMA(1, 0, At, B0); PG8_MMA(1, 1, At, B1); PG8_BAR; PG8_SCHED;
            PG8_LDB(B0, 1, 0); PG8_LDB(B1, 1, 1); PG8_SCHED; PG8_LDA(At, 1, 0); PG8_STAGE(PG8_SA(0, 1), a2 + hstep, voffA);
            PG8_WAIT_V(8); PG8_WAIT_L(0); PG8_BAR; PG8_MMA(0, 0, At, B0); PG8_MMA(0, 1, At, B1); PG8_BAR; PG8_SCHED;
            PG8_LDA(At, 1, 1); PG8_STAGE(PG8_SB(1, 0), b3, voffB); PG8_STAGE(PG8_SB(1, 1), b3 + hstep, voffB); PG8_STAGE(PG8_SA(1, 0), a3, voffA);
            PG8_WAIT_V(8); PG8_WAIT_L(0); PG8_BAR; PG8_MMA(1, 0, At, B0); PG8_MMA(1, 1, At, B1); PG8_BAR; PG8_SCHED;
            } else {
            PG8_LDB(B0, 0, 0); PG8_SCHED; PG8_LDA(At, 0, 0); PG8_STAGE(PG8_SA(1, 1), a1 + hstep, voffA);
            PG8_WAIT_L(8); PG8_BAR; PG8_WAIT_L(0); PG8_MMA(0, 0, At, B0); PG8_BAR; PG8_SCHED;
            PG8_LDB(B1, 0, 1); PG8_STAGE(PG8_SB(0, 0), b2, voffB);
            PG8_BAR; PG8_WAIT_L(0); PG8_MMA(0, 1, At, B1); PG8_BAR;
            PG8_LDA(At, 0, 1); PG8_STAGE(PG8_SA(0, 0), a2, voffA);
            PG8_BAR; PG8_WAIT_L(0); PG8_MMA(1, 0, At, B0); PG8_BAR; PG8_SCHED;
            PG8_STAGE(PG8_SB(0, 1), b2 + hstep, voffB);
            PG8_WAIT_V(6); PG8_BAR; PG8_MMA(1, 1, At, B1); PG8_BAR;
            PG8_LDB(B0, 1, 0); PG8_SCHED; PG8_LDA(At, 1, 0); PG8_STAGE(PG8_SA(0, 1), a2 + hstep, voffA);
            PG8_WAIT_L(8); PG8_BAR; PG8_WAIT_L(0); PG8_MMA(0, 0, At, B0); PG8_BAR; PG8_SCHED;
            PG8_LDB(B1, 1, 1); PG8_STAGE(PG8_SB(1, 0), b3, voffB);
            PG8_BAR; PG8_WAIT_L(0); PG8_MMA(0, 1, At, B1); PG8_BAR;
            PG8_LDA(At, 1, 1); PG8_STAGE(PG8_SA(1, 0), a3, voffA);
            PG8_BAR; PG8_WAIT_L(0); PG8_MMA(1, 0, At, B0); PG8_BAR; PG8_SCHED;
            PG8_STAGE(PG8_SB(1, 1), b3 + hstep, voffB);
            PG8_WAIT_V(6); PG8_BAR; PG8_MMA(1, 1, At, B1); PG8_BAR;
            }
        }
        if constexpr (ALIGN_EPI) { if (wr == 0) PG8_BAR; }
        if constexpr (!Epi::AFTER_DRAIN) { E(acc, cur, wr, wc, fr, fq); S.done(cur); }
        if (!has_next) break;
#pragma unroll
        for (int a = 0; a < 2; ++a)
#pragma unroll
            for (int b = 0; b < 2; ++b)
#pragma unroll
                for (int m = 0; m < 4; ++m)
#pragma unroll
                    for (int n = 0; n < 2; ++n) acc[a][b][m][n] = (f32x4){0.f, 0.f, 0.f, 0.f};
        cur = nxt; cA = nA; cB = nB; ++ui;
        if constexpr (ALIGN_EPI) { if (wr == 1) PG8_BAR; }
    }
    PG8_WAIT_V(0);
    if constexpr (!ALIGN_EPI) { if (wr == 0) PG8_BAR; }
    PG8_BAR;
    if constexpr (Epi::AFTER_DRAIN) { E.fused(acc, cur, wr, wc, fr, fq, lds, wid, lane); S.done(cur); }
#undef PG8_SA
#undef PG8_SB
#undef PG8_STAGE
#undef PG8_LDA
#undef PG8_LDB
#undef PG8_MMA
#undef PG8_WAIT_V
#undef PG8_WAIT_L
#undef PG8_BAR
#undef PG8_SCHED
}
}
#define GAS __attribute__((address_space(1)))
#define LAS __attribute__((address_space(3)))
typedef unsigned short bf16;
typedef unsigned v4u __attribute__((ext_vector_type(4)));
typedef float f32x4 __attribute__((ext_vector_type(4)));
typedef short bf16x8 __attribute__((ext_vector_type(8)));
typedef GAS unsigned gu32;
typedef GAS unsigned long long gu64;
#define RLX_AGENT __ATOMIC_RELAXED, __HIP_MEMORY_SCOPE_AGENT
#define LDS_WAIT() asm volatile("s_waitcnt lgkmcnt(0)" ::: "memory")
#define VM_WAIT() asm volatile("s_waitcnt vmcnt(0)" ::: "memory")
__device__ __forceinline__ unsigned long long rt() { return __builtin_amdgcn_s_memrealtime(); }
__device__ __forceinline__ unsigned f2bf(float f) { unsigned u = __builtin_bit_cast(unsigned, f); return (u + 0x7fffu + ((u >> 16) & 1u)) >> 16; }
__device__ __forceinline__ unsigned pk2(float lo, float hi) { return f2bf(lo) | (f2bf(hi) << 16); }

#define XB_TMO      128
#define XB_XCNT(j)  (256  + 64 * (j))
#define XB_XSUB(j)  (1280 + 64 * (j))
#define XB_XGEN(j)  (2304 + 64 * (j))
#define XB_TOP      3328
#define XB_TOPGEN   3392
#define XCD_BAR_WORDS 3456
#define XB_SPIN_CAP (1u << 18)

__device__ __forceinline__ unsigned xb_ld(unsigned* p)              { return __hip_atomic_load(p, __ATOMIC_RELAXED, __HIP_MEMORY_SCOPE_AGENT); }
__device__ __forceinline__ unsigned xb_add(unsigned* p, unsigned v) { return __hip_atomic_fetch_add(p, v, __ATOMIC_RELAXED, __HIP_MEMORY_SCOPE_AGENT); }
__device__ __forceinline__ unsigned xb_xcc_id() { return (unsigned)__builtin_amdgcn_s_getreg((3 << 11) | 20) & 0xFu; }
#define XB_SPIN(cond, bar) do { unsigned _sp = 0; while (cond) { __builtin_amdgcn_s_sleep(1); \
    if ((++_sp & 255u) == 0u) { if (xb_ld(&(bar)[XB_TMO])) break; if (_sp > XB_SPIN_CAP) { atomicAdd(&(bar)[XB_TMO], 1u); break; } } } } while (0)

struct XcdBarrier {
    unsigned* bar; unsigned x;
    volatile LAS unsigned* st;
};

__device__ __forceinline__ XcdBarrier xcd_barrier_post(unsigned* bar, volatile LAS unsigned* st) {
    XcdBarrier b; b.bar = bar; b.x = xb_xcc_id(); b.st = st;
    if (threadIdx.x == 0) (void)xb_add(&bar[XB_XCNT(b.x)], 1u);
    return b;
}
__device__ __forceinline__ void xcd_barrier_complete(unsigned* bar, unsigned x, unsigned& nloc, unsigned& nx) {
    const unsigned G = gridDim.x * gridDim.y * gridDim.z;
    unsigned sum, cnt, mine, sp = 0u;
    for (;;) {
        sum = 0u; cnt = 0u; mine = 0u;
#pragma unroll
        for (unsigned j = 0; j < 16; ++j) { const unsigned c = xb_ld(&bar[XB_XCNT(j)]); sum += c; cnt += (c > 0u) ? 1u : 0u; mine = (j == x) ? c : mine; }
        if (sum == G) break;
        __builtin_amdgcn_s_sleep(1);
        if ((++sp & 255u) == 0u) { if (xb_ld(&bar[XB_TMO])) break; if (sp > XB_SPIN_CAP) { atomicAdd(&bar[XB_TMO], 1u); break; } }
    }
    nloc = mine > 0u ? mine : 1u; nx = cnt > 0u ? cnt : 1u;
}

__device__ __forceinline__ void xcd_barrier(const XcdBarrier& b) {
    asm volatile("s_waitcnt vmcnt(0)" ::: "memory");
    __syncthreads();
    if (threadIdx.x == 0) {
        unsigned* bar = b.bar;
        __builtin_amdgcn_s_waitcnt(0);
        unsigned nloc = b.st[0], nx = b.st[1];
        if (nloc == 0u) { xcd_barrier_complete(bar, b.x, nloc, nx); b.st[0] = nloc; b.st[1] = nx; }
        const unsigned old = xb_add(&bar[XB_XSUB(b.x)], 1u);
        const unsigned gen = old / nloc;
        if (old + 1u == (gen + 1u) * nloc) {
            __builtin_amdgcn_fence(__ATOMIC_RELEASE, "agent");
            asm volatile("s_waitcnt vmcnt(0)" ::: "memory");
            const unsigned og = xb_add(&bar[XB_TOP], 1u);
            const unsigned tg = og / nx;
            if (og + 1u == (tg + 1u) * nx) xb_add(&bar[XB_TOPGEN], 1u);
            else XB_SPIN(xb_ld(&bar[XB_TOPGEN]) == tg, bar);
            __builtin_amdgcn_fence(__ATOMIC_ACQUIRE, "agent");
            xb_add(&bar[XB_XGEN(b.x)], 1u);
            asm volatile("s_waitcnt vmcnt(0)" ::: "memory");
        } else {
            XB_SPIN(xb_ld(&bar[XB_XGEN(b.x)]) == gen, bar);
            __builtin_amdgcn_fence(__ATOMIC_ACQUIRE, "agent");
            asm volatile("s_waitcnt vmcnt(0)" ::: "memory");
        }
    }
    __syncthreads();
}
constexpr int NWAVES = 8, NTHREADS = 512;
constexpr int DM = 1024, SEQ = 8192, NPROMPT = 2, NSAMP = 128, TSAMP = 8, NMETA = 16;
constexpr int ROW_S = NPROMPT * SEQ;
constexpr int ROW_M = ROW_S + NSAMP * TSAMP;
constexpr int NROWS = ROW_M + NMETA;
constexpr int MP = 17664;
constexpr int DINNER = 2048, NHEADS = 32, HD = 64, NGROUPS = 8, DSTATE = 128, CONVD = 4096, INPROJ = 6176, INPROJ_P = 6400, ZXW = 6144;
constexpr int DFF = 4096, NKV = 4, NQ = 16, KVW = 512;
constexpr float EPS = 1e-5f;
constexpr int LDX = 136;

constexpr size_t O_YP = 0, O_YS = O_YP + (size_t)NPROMPT * SEQ * DM, O_PCONV = O_YS + (size_t)NSAMP * TSAMP * DM, O_PSSM = O_PCONV + 2 * 2 * 3 * 4096,
    O_PCK = O_PSSM + (size_t)2 * 2 * 32 * 64 * 128, O_PCV = O_PCK + 2 * 128 * 256, O_SCONV = O_PCV + 2 * 128 * 256, O_SSSM = O_SCONV + (size_t)2 * 128 * 3 * 4096,
    O_SCK = O_SSSM + (size_t)2 * 128 * 32 * 64 * 128, O_SCV = O_SCK + (size_t)128 * 128 * 256, O_END = O_SCV + (size_t)128 * 128 * 256;

constexpr size_t MiB = 1u << 20;
constexpr size_t WS_CTL = 0, CTL_ZERO_BYTES = 1 * MiB;
constexpr size_t SZ_WIN = (size_t)INPROJ_P * 1024 * 2, SZ_WOUT = (size_t)1024 * 2048 * 2, SZ_WUP = (size_t)4096 * 1024 * 2, SZ_WDN = SZ_WUP, SZ_WQKV0 = (size_t)1536 * 1024 * 2, SZ_WQ1 = (size_t)1024 * 1024 * 2, SZ_WO = SZ_WQ1;
constexpr size_t WS_WIN = 1 * MiB, WS_WOUT = WS_WIN + 2 * SZ_WIN, WS_WUP = WS_WOUT + 2 * SZ_WOUT, WS_WDN = WS_WUP + 4 * SZ_WUP, WS_WQKV0 = WS_WDN + 4 * SZ_WDN, WS_WQ1 = WS_WQKV0 + SZ_WQKV0, WS_WO = WS_WQ1 + SZ_WQ1, WS_WEND = WS_WO + 2 * SZ_WO;
constexpr size_t al1m(size_t x) { return (x + MiB - 1) / MiB * MiB; }
constexpr size_t WS_H = al1m(WS_WEND), WS_HN = al1m(WS_H + (size_t)MP * 1024 * 4), WS_ZX = al1m(WS_HN + (size_t)MP * 1024 * 2), WS_DT = al1m(WS_ZX + (size_t)MP * ZXW * 2),
    WS_XC = al1m(WS_DT + (size_t)MP * 32 * 4), WS_YN = al1m(WS_XC + (size_t)MP * 4096 * 2), WS_CS = al1m(WS_YN + (size_t)MP * 2048 * 2), WS_CD = al1m(WS_CS + (size_t)129 * 32 * 8192 * 4), WS_SLAB = al1m(WS_CD + 129 * 32 * 4), WS_HSB = al1m(WS_SLAB + (size_t)8 * 1280 * 1024 * 4), WS_END = al1m(WS_HSB + (size_t)128 * 32 * 8192 * 2);
constexpr size_t WS_U = WS_ZX;
constexpr size_t WS_Q = WS_XC, WS_KV = WS_Q + (size_t)MP * 1024 * 2, WS_AO = WS_KV + (size_t)MP * 512 * 2;
static_assert(WS_AO + (size_t)MP * 1024 * 2 <= WS_YN, "attention overlay");
constexpr int CW_BAR = 4096;

constexpr int RING_BYTES = 131072, LDS_BYTES = 147456, LDSCTL_OFF = LDS_BYTES - 512, MISC_OFF = LDSCTL_OFF + 320;

typedef unsigned u32x2 __attribute__((ext_vector_type(2)));
typedef unsigned u32x4 __attribute__((ext_vector_type(4)));
__device__ __forceinline__ int ltid() { int t = threadIdx.x; asm volatile("" : "+v"(t)); return t; }
__device__ __forceinline__ float bf2f(unsigned short b) { return __uint_as_float((unsigned)b << 16); }
__device__ __forceinline__ float bflo(unsigned w) { return __uint_as_float(w << 16); }
__device__ __forceinline__ float bfhi(unsigned w) { return __uint_as_float(w & 0xffff0000u); }
__device__ __forceinline__ unsigned pkbf(float lo, float hi) { return pg8::cvt_pk_bf16(lo, hi); }
__device__ __forceinline__ float wave_sum(float v) {
#pragma unroll
    for (int o = 1; o < 64; o <<= 1) v += __shfl_xor(v, o);
    return v;
}
__device__ __forceinline__ float sigmoid_f(float x) { return 1.f / (1.f + __expf(-x)); }
#define MFMA16(b, a, c) __builtin_amdgcn_mfma_f32_16x16x32_bf16((b), (a), (c), 0, 0, 0)

struct Args {
    const float* in[26]; float* out; unsigned char* ws; int ph_lo, ph_hi;
};
typedef const __attribute__((address_space(4))) Args* ArgsP;
enum { I_XP = 0, I_XS, I_SCONV, I_SSSM, I_CK, I_CV, I_META, I_ANORM, I_AIN, I_ACONVW, I_ACONVB, I_ADTB, I_ALOG, I_ADSKIP, I_AGATE, I_AOUT, I_KVNORM, I_WKV, I_BNORM, I_WQ, I_SINKS, I_WO, I_MLPNORM, I_WUP, I_WDOWN, I_FNORM };

__device__ __forceinline__ void transpose_item(const float* W, const float* scale, int K, int N, bf16* WT, int row_off, LAS unsigned* scr, int item, int lane) {
    const int nblk = (N + 63) / 64, kb = item / nblk, nb = item % nblk, k0 = 64 * kb, n0 = 64 * nb;
    const bool ok = (n0 + lane < N);
    const float* src = W + (size_t)k0 * N + n0 + (ok ? lane : 0);
#pragma unroll
    for (int h = 0; h < 2; ++h) {
        float v[32];
#pragma unroll
        for (int i = 0; i < 32; ++i) v[i] = src[(size_t)(32 * h + i) * N];
        if (!ok) {
#pragma unroll
            for (int i = 0; i < 32; ++i) v[i] = 0.f;
        }
        if (scale) {
#pragma unroll
            for (int i = 0; i < 32; ++i) v[i] *= scale[k0 + 32 * h + i];
        }
#pragma unroll
        for (int i = 0; i < 16; ++i) scr[lane * 33 + 16 * h + i] = pkbf(v[2 * i], v[2 * i + 1]);
    }
    LDS_WAIT(); asm volatile("" ::: "memory");
    const int c = lane & 7;
#pragma unroll
    for (int j = 0; j < 8; ++j) { const int n = (lane >> 3) + 8 * j; const LAS unsigned* sp = scr + n * 33 + 4 * c;
        v4u o; o.x = sp[0]; o.y = sp[1]; o.z = sp[2]; o.w = sp[3];
        if (n0 + n < N) *(GAS v4u*)(WT + (size_t)(row_off + n0 + n) * K + k0 + 8 * c) = o; }
    LDS_WAIT(); asm volatile("" ::: "memory");
}
struct WJob { const float* W; const float* scale; int K, N; bf16* WT; int row_off; int items; };

__device__ __forceinline__ void phase_prologue(ArgsP a, LAS unsigned char* lds, int wave, int lane) {
    LAS unsigned* scr = (LAS unsigned*)(lds + wave * 16384);
    const int gw = blockIdx.x * NWAVES + wave, NGW = gridDim.x * NWAVES;
    unsigned char* ws = a->ws;
    for (int jb = 0; jb < 21; ++jb) {
        WJob J;
        if (jb < 2)       { const int i = jb;      J = WJob{a->in[I_AIN] + (size_t)i * 1024 * INPROJ, a->in[I_ANORM] + i * 1024, 1024, INPROJ, (bf16*)(ws + WS_WIN + i * SZ_WIN), 0, 0}; }
        else if (jb < 4)  { const int i = jb - 2;  J = WJob{a->in[I_AOUT] + (size_t)i * 2048 * 1024, a->in[I_AGATE] + i * 2048, 2048, 1024, (bf16*)(ws + WS_WOUT + i * SZ_WOUT), 0, 0}; }
        else if (jb < 8)  { const int l = jb - 4;  J = WJob{a->in[I_WUP] + (size_t)l * 1024 * 4096, a->in[I_MLPNORM] + l * 1024, 1024, 4096, (bf16*)(ws + WS_WUP + l * SZ_WUP), 0, 0}; }
        else if (jb < 12) { const int l = jb - 8;  J = WJob{a->in[I_WDOWN] + (size_t)l * 4096 * 1024, nullptr, 4096, 1024, (bf16*)(ws + WS_WDN + l * SZ_WDN), 0, 0}; }
        else if (jb == 12) { J = WJob{a->in[I_WQ], a->in[I_BNORM], 1024, 1024, (bf16*)(ws + WS_WQKV0), 0, 0}; }
        else if (jb == 13) { J = WJob{a->in[I_WKV], a->in[I_KVNORM], 1024, 512, (bf16*)(ws + WS_WQKV0), 1024, 0}; }
        else if (jb == 14) { J = WJob{a->in[I_WQ] + (size_t)1024 * 1024, a->in[I_BNORM] + 1024, 1024, 1024, (bf16*)(ws + WS_WQ1), 0, 0}; }
        else if (jb < 17) { const int j = jb - 15; J = WJob{a->in[I_WO] + (size_t)j * 1024 * 1024, nullptr, 1024, 1024, (bf16*)(ws + WS_WO + j * SZ_WO), 0, 0}; }
        else break;
        const int items = (J.K / 64) * ((J.N + 63) / 64);
        for (int it = gw; it < items; it += NGW) transpose_item(J.W, J.scale, J.K, J.N, J.WT, J.row_off, scr, it, lane);
    }
    {
        const int gt = blockIdx.x * NTHREADS + ltid(), NT = gridDim.x * NTHREADS;
        const int per = (INPROJ_P - INPROJ) * 1024 * 2 / 16;
        for (int e = gt; e < 2 * per; e += NT) { const int i = e / per, c = e % per;
            *(v4u*)(ws + WS_WIN + i * SZ_WIN + (size_t)INPROJ * 1024 * 2 + (size_t)c * 16) = (v4u){0u, 0u, 0u, 0u}; }
    }
}

__device__ __forceinline__ void phase_norm(ArgsP a, int from_inputs, int nslab, int wave, int lane) {
    float* H = (float*)(a->ws + WS_H); bf16* HN = (bf16*)(a->ws + WS_HN); const float* SLAB = (const float*)(a->ws + WS_SLAB);
    const int gw = blockIdx.x * NWAVES + wave, NGW = gridDim.x * NWAVES;
    for (int m = gw; m < MP; m += NGW) {
        unsigned long long* o8 = (unsigned long long*)(HN + (size_t)m * DM) + lane;
        if (m >= NROWS) {
#pragma unroll
            for (int j = 0; j < 4; ++j) o8[64 * j] = 0ull;
            continue;
        }
        const float* src;
        if (from_inputs) src = (m < ROW_S) ? a->in[I_XP] + (size_t)m * DM : (m < ROW_M) ? a->in[I_XS] + (size_t)(m - ROW_S) * DM : a->in[I_META] + (size_t)(m - ROW_M) * DM;
        else src = H + (size_t)m * DM;
        const f32x4* xr = (const f32x4*)src + lane;
        f32x4 v[4]; float s = 0.f;
#pragma unroll
        for (int j = 0; j < 4; ++j) v[j] = xr[64 * j];
        if (m >= ROW_S && nslab > 0) {
            for (int sl = 0; sl < nslab; ++sl) { const f32x4* sr = (const f32x4*)(SLAB + (size_t)sl * (1280 * 1024) + (size_t)(m - ROW_S) * DM) + lane;
#pragma unroll
                for (int j = 0; j < 4; ++j) v[j] = v[j] + sr[64 * j]; }
            f32x4* hr = (f32x4*)(H + (size_t)m * DM) + lane;
#pragma unroll
            for (int j = 0; j < 4; ++j) hr[64 * j] = v[j];
        }
#pragma unroll
        for (int j = 0; j < 4; ++j) s += (v[j].x * v[j].x + v[j].y * v[j].y) + (v[j].z * v[j].z + v[j].w * v[j].w);
        const float rs = rsqrtf(wave_sum(s) * (1.f / DM) + EPS);
        if (from_inputs) { f32x4* hr = (f32x4*)(H + (size_t)m * DM) + lane;
#pragma unroll
            for (int j = 0; j < 4; ++j) hr[64 * j] = v[j]; }
#pragma unroll
        for (int j = 0; j < 4; ++j) o8[64 * j] = (unsigned long long)pkbf(v[j].x * rs, v[j].y * rs) | ((unsigned long long)pkbf(v[j].z * rs, v[j].w * rs) << 32);
    }
}
__device__ __forceinline__ void phase_final(ArgsP a, int wave, int lane) {
    const float* H = (const float*)(a->ws + WS_H); const float* fw = a->in[I_FNORM]; const float* SLAB = (const float*)(a->ws + WS_SLAB);
    const int gw = blockIdx.x * NWAVES + wave, NGW = gridDim.x * NWAVES;
    f32x4 w[4];
#pragma unroll
    for (int j = 0; j < 4; ++j) w[j] = ((const f32x4*)fw)[lane + 64 * j];
    for (int m = gw; m < ROW_M; m += NGW) {
        const f32x4* xr = (const f32x4*)(H + (size_t)m * DM) + lane;
        f32x4 v[4]; float s = 0.f;
#pragma unroll
        for (int j = 0; j < 4; ++j) v[j] = xr[64 * j];
        if (m >= ROW_S) {
            for (int sl = 0; sl < 8; ++sl) { const f32x4* sr = (const f32x4*)(SLAB + (size_t)sl * (1280 * 1024) + (size_t)(m - ROW_S) * DM) + lane;
#pragma unroll
                for (int j = 0; j < 4; ++j) v[j] = v[j] + sr[64 * j]; }
        }
#pragma unroll
        for (int j = 0; j < 4; ++j) s += (v[j].x * v[j].x + v[j].y * v[j].y) + (v[j].z * v[j].z + v[j].w * v[j].w);
        const float rs = rsqrtf(wave_sum(s) * (1.f / DM) + EPS);
        f32x4* o = (f32x4*)(a->out + O_YP + (size_t)m * DM) + lane;
#pragma unroll
        for (int j = 0; j < 4; ++j) o[64 * j] = v[j] * rs * w[j];
    }
}

__device__ __forceinline__ void unpack8(const u32x4 w, float (&f)[8]) { f[0] = bflo(w.x); f[1] = bfhi(w.x); f[2] = bflo(w.y); f[3] = bfhi(w.y); f[4] = bflo(w.z); f[5] = bfhi(w.z); f[6] = bflo(w.w); f[7] = bfhi(w.w); }
__device__ __forceinline__ void ld8f(const float* __restrict__ p, float (&f)[8]) { const f32x4 x0 = *(const f32x4*)p, x1 = *(const f32x4*)(p + 4); f[0]=x0.x;f[1]=x0.y;f[2]=x0.z;f[3]=x0.w;f[4]=x1.x;f[5]=x1.y;f[6]=x1.z;f[7]=x1.w; }
__device__ __forceinline__ void phase_conv(ArgsP a, int li) {
    const bf16* __restrict__ ZX = (const bf16*)(a->ws + WS_ZX); bf16* __restrict__ XC = (bf16*)(a->ws + WS_XC);
    const float* __restrict__ cw = a->in[I_ACONVW] + (size_t)li * 4 * CONVD; const float* __restrict__ cb = a->in[I_ACONVB] + (size_t)li * CONVD;
    const float* __restrict__ sconv = a->in[I_SCONV] + (size_t)li * NSAMP * 3 * CONVD;
    float* __restrict__ outp = a->out;
    constexpr int NRUNS = 2048 + 128 + 2;
    const int gt = blockIdx.x * NTHREADS + ltid(), NT = gridDim.x * NTHREADS;
    for (int item = gt; item < NRUNS * 512; item += NT) {
        const int run = item >> 9, c0 = (item & 511) * 8;
        int R0, kind, b = 0; bool last = false;
        if (run < 2048) { kind = 0; b = run >> 10; const int t0 = (run & 1023) * 8; R0 = b * SEQ + t0; last = (t0 == SEQ - 8); }
        else if (run < 2176) { kind = 1; b = run - 2048; R0 = ROW_S + b * 8; last = true; }
        else { kind = 2; R0 = ROW_M + (run - 2176) * 8; }
        const bool first = (kind == 0) ? ((run & 1023) == 0) : (kind == 1) ? true : (run == 2176);
        u32x4 raw[11];
#pragma unroll
        for (int t = 0; t < 8; ++t) raw[3 + t] = *(const u32x4*)(ZX + (size_t)(R0 + t) * ZXW + 2048 + c0);
        float p0[8], p1[8], p2[8];
        if (!first || kind == 0) {
            const int Rp = first ? ROW_M + 16 : R0;
#pragma unroll
            for (int t = 0; t < 3; ++t) raw[t] = *(const u32x4*)(ZX + (size_t)(Rp - 3 + t) * ZXW + 2048 + c0);
            unpack8(raw[0], p0); unpack8(raw[1], p1); unpack8(raw[2], p2);
        } else if (kind == 1) {
            const float* s = sconv + (size_t)b * 3 * CONVD + c0;
            ld8f(s, p0); ld8f(s + CONVD, p1); ld8f(s + 2 * CONVD, p2);
        } else {
#pragma unroll
            for (int j = 0; j < 8; ++j) { p0[j] = 0.f; p1[j] = 0.f; p2[j] = 0.f; }
        }
        float w0[8], w1[8], w2[8], w3[8], bs[8];
        ld8f(cw + c0, w0); ld8f(cw + CONVD + c0, w1); ld8f(cw + 2 * CONVD + c0, w2); ld8f(cw + 3 * CONVD + c0, w3); ld8f(cb + c0, bs);
#pragma unroll
        for (int t = 0; t < 8; ++t) {
            float x[8]; unpack8(raw[3 + t], x);
            float o[8];
#pragma unroll
            for (int j = 0; j < 8; ++j) { const float v = bs[j] + w0[j] * p0[j] + w1[j] * p1[j] + w2[j] * p2[j] + w3[j] * x[j]; o[j] = v * sigmoid_f(v); }
            u32x4 w; w.x = pkbf(o[0], o[1]); w.y = pkbf(o[2], o[3]); w.z = pkbf(o[4], o[5]); w.w = pkbf(o[6], o[7]);
            *(u32x4*)(XC + (size_t)(R0 + t) * CONVD + c0) = w;
            if (last && t >= 5 && kind != 2) {
                float* dst = (kind == 0) ? outp + O_PCONV + ((size_t)(li * NPROMPT + b) * 3 + (t - 5)) * CONVD + c0 : outp + O_SCONV + ((size_t)(li * NSAMP + b) * 3 + (t - 5)) * CONVD + c0;
                *(f32x4*)(dst) = (f32x4){x[0], x[1], x[2], x[3]}; *(f32x4*)(dst + 4) = (f32x4){x[4], x[5], x[6], x[7]};
            }
#pragma unroll
            for (int j = 0; j < 8; ++j) { p0[j] = p1[j]; p1[j] = p2[j]; p2[j] = x[j]; }
        }
    }
}

__device__ __forceinline__ void ssd_acs(const float* DT, const float* alog, int R0, int len, int h0, float* s_dt, float* s_acs, int wave, int lane) {
    if (wave < 4) {
        const int r = wave; const float An = -__expf(alog[h0 + r]);
        const int l0 = 2 * lane;
        const float d0 = (l0 < len) ? DT[(size_t)(R0 + l0) * 32 + h0 + r] : 0.f;
        const float d1 = (l0 + 1 < len) ? DT[(size_t)(R0 + l0 + 1) * 32 + h0 + r] : 0.f;
        const float a0 = d0 * An, a1 = d1 * An, s = a0 + a1;
        float incl = s;
#pragma unroll
        for (int o = 1; o < 64; o <<= 1) { const float t = __shfl_up(incl, o); if (lane >= o) incl += t; }
        const float excl = incl - s;
        s_dt[r * 128 + l0] = d0; s_dt[r * 128 + l0 + 1] = d1;
        s_acs[r * 128 + l0] = excl + a0; s_acs[r * 128 + l0 + 1] = excl + s;
    }
}
#define LFRAG(base, row, ld, ks) (*(const bf16x8*)((base) + (row) * (ld) + 32 * (ks) + 8 * fq))

__device__ __forceinline__ void ssd1_unit(ArgsP a, int li, unsigned char* lds, int slot, int g, int R0, int len, int, int, int) {
    const int tid = ltid(), lane = tid & 63, wave = __builtin_amdgcn_readfirstlane(tid >> 6);
    const bf16* XC = (const bf16*)(a->ws + WS_XC); const float* DT = (const float*)(a->ws + WS_DT);
    float* CS = (float*)(a->ws + WS_CS); float* CD = (float*)(a->ws + WS_CD);
    bf16* XsT = (bf16*)lds;
    bf16* BT = (bf16*)(lds + 256 * LDX * 2);
    float* s_dt = (float*)(lds + 384 * LDX * 2); float* s_acs = s_dt + 512;
    const int fr = lane & 15, fq = lane >> 4, h0 = g * 4;
    ssd_acs(DT, a->in[I_ALOG] + li * NHEADS, R0, len, h0, s_dt, s_acs, wave, lane);
    __syncthreads();
#pragma unroll
    for (int k = 0; k < 4; ++k) {
        const int item = tid + NTHREADS * k, cb = item & 31, tp = item >> 5, l = 2 * tp, r = cb >> 3;
        u32x4 v0 = (u32x4){0u, 0u, 0u, 0u}, v1 = v0;
        if (l < len) v0 = *(const u32x4*)(XC + (size_t)(R0 + l) * CONVD + g * 256 + cb * 8);
        if (l + 1 < len) v1 = *(const u32x4*)(XC + (size_t)(R0 + l + 1) * CONVD + g * 256 + cb * 8);
        const float tot = s_acs[r * 128 + 127];
        const float w0 = __expf(tot - s_acs[r * 128 + l]) * s_dt[r * 128 + l], w1 = __expf(tot - s_acs[r * 128 + l + 1]) * s_dt[r * 128 + l + 1];
        float x0[8], x1[8]; unpack8(v0, x0); unpack8(v1, x1);
#pragma unroll
        for (int j = 0; j < 8; ++j) *(unsigned*)(XsT + (cb * 8 + j) * LDX + l) = pkbf(x0[j] * w0, x1[j] * w1);
    }
#pragma unroll
    for (int k = 0; k < 2; ++k) {
        const int item = tid + NTHREADS * k, cb = item & 15, tp = item >> 4, l = 2 * tp;
        u32x4 v0 = (u32x4){0u, 0u, 0u, 0u}, v1 = v0;
        if (l < len) v0 = *(const u32x4*)(XC + (size_t)(R0 + l) * CONVD + 2048 + g * 128 + cb * 8);
        if (l + 1 < len) v1 = *(const u32x4*)(XC + (size_t)(R0 + l + 1) * CONVD + 2048 + g * 128 + cb * 8);
        const unsigned a0[4] = {v0.x, v0.y, v0.z, v0.w}, a1[4] = {v1.x, v1.y, v1.z, v1.w};
#pragma unroll
        for (int j = 0; j < 4; ++j) {
            *(unsigned*)(BT + (cb * 8 + 2 * j) * LDX + l) = (a0[j] & 0xffffu) | (a1[j] << 16);
            *(unsigned*)(BT + (cb * 8 + 2 * j + 1) * LDX + l) = (a0[j] >> 16) | (a1[j] & 0xffff0000u);
        }
    }
    __syncthreads();
    f32x4 acc[2][8];
#pragma unroll
    for (int mi = 0; mi < 2; ++mi)
#pragma unroll
        for (int ni = 0; ni < 8; ++ni) acc[mi][ni] = (f32x4){0.f, 0.f, 0.f, 0.f};
#pragma unroll
    for (int ks = 0; ks < 4; ++ks) {
        const bf16x8 a0 = LFRAG(XsT, 32 * wave + fr, LDX, ks), a1 = LFRAG(XsT, 32 * wave + 16 + fr, LDX, ks);
#pragma unroll
        for (int ni = 0; ni < 8; ++ni) { const bf16x8 bb = LFRAG(BT, 16 * ni + fr, LDX, ks); acc[0][ni] = MFMA16(bb, a0, acc[0][ni]); acc[1][ni] = MFMA16(bb, a1, acc[1][ni]); }
    }
#pragma unroll
    for (int mi = 0; mi < 2; ++mi) { const int hp = 32 * wave + 16 * mi + fr, r = hp >> 6, p = hp & 63;
        float* dst = CS + ((size_t)(slot * 32 + h0 + r) * 64 + p) * 128 + 4 * fq;
#pragma unroll
        for (int ni = 0; ni < 8; ++ni) *(f32x4*)(dst + 16 * ni) = acc[mi][ni]; }
    if (tid < 4) CD[slot * 32 + h0 + tid] = __expf(s_acs[tid * 128 + 127]);
    __syncthreads();
}

__device__ __forceinline__ void ssd_sample_unit(ArgsP a, int li, unsigned char* lds, int b, int g, int, int, int) {
    const int tid = ltid(), lane = tid & 63, wave = __builtin_amdgcn_readfirstlane(tid >> 6);
    const bf16* __restrict__ XC = (const bf16*)(a->ws + WS_XC); const bf16* __restrict__ ZX = (const bf16*)(a->ws + WS_ZX); const float* __restrict__ DT = (const float*)(a->ws + WS_DT); bf16* __restrict__ YN = (bf16*)(a->ws + WS_YN);
    float* sX = (float*)lds; float* sB = sX + 8 * 256; float* sC = sB + 8 * 128; float* sY = sC + 8 * 128; float* sDt = sY + 8 * 256;
    const int R0 = ROW_S + b * 8, h0 = g * 4;
    const int p = tid >> 3, nb = tid & 7;
    const float* __restrict__ sin_ = a->in[I_SSSM] + ((size_t)((li * NSAMP + b) * NHEADS + h0) * 64 + p) * 128 + 4 * nb;
    float* __restrict__ sout = a->out + O_SSSM + ((size_t)((li * NSAMP + b) * NHEADS + h0) * 64 + p) * 128 + 4 * nb;
    f32x4 st[4][4];
#pragma unroll
    for (int r = 0; r < 4; ++r)
#pragma unroll
        for (int kk = 0; kk < 4; ++kk) st[r][kk] = *(const f32x4*)(sin_ + (size_t)r * 8192 + 32 * kk);
    {
        const int t = tid >> 6, ck = tid & 63;
        const int col = (ck < 32) ? g * 256 + ck * 8 : (ck < 48) ? 2048 + g * 128 + (ck - 32) * 8 : 3072 + g * 128 + (ck - 48) * 8;
        float f[8]; unpack8(*(const u32x4*)(XC + (size_t)(R0 + t) * CONVD + col), f);
        float* dst = (ck < 32) ? sX + t * 256 + ck * 8 : (ck < 48) ? sB + t * 128 + (ck - 32) * 8 : sC + t * 128 + (ck - 48) * 8;
        *(f32x4*)dst = (f32x4){f[0], f[1], f[2], f[3]}; *(f32x4*)(dst + 4) = (f32x4){f[4], f[5], f[6], f[7]};
        if (tid < 32) sDt[tid] = DT[(size_t)(R0 + (tid >> 2)) * 32 + h0 + (tid & 3)];
    }
    __syncthreads();
#pragma unroll
    for (int r = 0; r < 4; ++r) {
        const int h = h0 + r;
        const float An = -__expf(a->in[I_ALOG][li * NHEADS + h]), Dk = a->in[I_ADSKIP][li * NHEADS + h];
#pragma unroll
        for (int t = 0; t < 8; ++t) {
            const float dt = sDt[t * 4 + r], dA = __expf(dt * An), xv = sX[t * 256 + r * 64 + p], coef = dt * xv;
            float part = 0.f;
#pragma unroll
            for (int kk = 0; kk < 4; ++kk) { const f32x4 bv = *(const f32x4*)(sB + t * 128 + 32 * kk + 4 * nb), cv = *(const f32x4*)(sC + t * 128 + 32 * kk + 4 * nb);
                st[r][kk] = st[r][kk] * dA + bv * coef; part += (cv.x * st[r][kk].x + cv.y * st[r][kk].y) + (cv.z * st[r][kk].z + cv.w * st[r][kk].w); }
            part += __shfl_xor(part, 1); part += __shfl_xor(part, 2); part += __shfl_xor(part, 4);
            if (nb == 0) sY[t * 256 + r * 64 + p] = part + Dk * xv;
        }
#pragma unroll
        for (int kk = 0; kk < 4; ++kk) *(f32x4*)(sout + (size_t)r * 8192 + 32 * kk) = st[r][kk];
    }
    __syncthreads();
    {
        const int t = wave, c4 = lane * 4; const size_t row = (size_t)(R0 + t);
        const f32x4 y = *(const f32x4*)(sY + t * 256 + c4);
        const u32x2 zz = *(const u32x2*)(ZX + row * ZXW + g * 256 + c4);
        const float z0 = bflo(zz.x), z1 = bfhi(zz.x), z2 = bflo(zz.y), z3 = bfhi(zz.y);
        const float g0 = y.x * z0 * sigmoid_f(z0), g1 = y.y * z1 * sigmoid_f(z1), g2 = y.z * z2 * sigmoid_f(z2), g3 = y.w * z3 * sigmoid_f(z3);
        const float ss = wave_sum((g0 * g0 + g1 * g1) + (g2 * g2 + g3 * g3));
        const float rs = rsqrtf(ss * (1.f / 256.f) + EPS);
        u32x2 o; o.x = pkbf(g0 * rs, g1 * rs); o.y = pkbf(g2 * rs, g3 * rs);
        *(u32x2*)(YN + row * DINNER + g * 256 + c4) = o;
    }
    __syncthreads();
}

__device__ __forceinline__ void phase_scan(ArgsP a, int li) {
    const float* __restrict__ CS = (const float*)(a->ws + WS_CS); const float* __restrict__ CD = (const float*)(a->ws + WS_CD); bf16* __restrict__ HSB = (bf16*)(a->ws + WS_HSB);
    const int gt = blockIdx.x * NTHREADS + ltid(), NT = gridDim.x * NTHREADS;
    for (int e = gt; e < 2 * 65536; e += NT) {
        const int b = e >> 16, rem = e & 65535, h = rem >> 11, pn4 = rem & 2047;
        f32x4 hc = *(const f32x4*)(CS + ((size_t)(128 * 32 + h) * 2048 + pn4) * 4);
#pragma unroll 8
        for (int c = 0; c < 64; ++c) { const int slot = b * 64 + c; const size_t o = ((size_t)(slot * 32 + h) * 2048 + pn4) * 4;
            const f32x4 s = *(const f32x4*)(CS + o); const float d = CD[slot * 32 + h];
            u32x2 w; w.x = pkbf(hc.x, hc.y); w.y = pkbf(hc.z, hc.w); *(u32x2*)(HSB + o) = w;
            hc = hc * d + s; }
        *(f32x4*)(a->out + O_PSSM + ((size_t)((li * NPROMPT + b) * NHEADS + h) * 2048 + pn4) * 4) = hc;
    }
}

#define TSW(ch) ((((ch) >> 3) & 7) << 3)
__device__ __forceinline__ void ssd3_head(int r, int hb, const bf16* Cn, const bf16* BH, const bf16* Xt, const float* s_dt, const float* s_acs, const f32x4 (&cb)[8], f32x4 (&acc)[4],
                                          const bf16* __restrict__ XC, const bf16* __restrict__ ZX, size_t row, int g, float Dk, int l, int wave, int fr, int fq, float& ss) {
    u32x2 xx[4], zz[4];
#pragma unroll
    for (int ni = 0; ni < 4; ++ni) { const int ch = g * 256 + r * 64 + 16 * ni + 4 * fq; xx[ni] = *(const u32x2*)(XC + row * CONVD + ch); zz[ni] = *(const u32x2*)(ZX + row * ZXW + ch); }
    const float al = s_acs[r * 128 + l];
#pragma unroll
    for (int ni = 0; ni < 4; ++ni) acc[ni] = (f32x4){0.f, 0.f, 0.f, 0.f};
    const bf16* Hs = BH + hb * 64 * LDX;
#pragma unroll
    for (int ks = 0; ks < 4; ++ks) { const bf16x8 af = LFRAG(Cn, l, LDX, ks);
#pragma unroll
        for (int ni = 0; ni < 4; ++ni) { const bf16x8 bb = LFRAG(Hs, 16 * ni + fr, LDX, ks); acc[ni] = MFMA16(bb, af, acc[ni]); } }
    const float e = __expf(al);
#pragma unroll
    for (int ni = 0; ni < 4; ++ni) acc[ni] = acc[ni] * e;
#pragma unroll
    for (int ks = 0; ks < 4; ++ks) {
        unsigned mw[4];
#pragma unroll
        for (int hf = 0; hf < 2; ++hf) { const int ni = 2 * ks + hf, s0 = 16 * ni + 4 * fq;
            const f32x4 av = *(const f32x4*)(s_acs + r * 128 + s0), dv = *(const f32x4*)(s_dt + r * 128 + s0);
            float m[4];
#pragma unroll
            for (int j = 0; j < 4; ++j) m[j] = (s0 + j <= l) ? cb[ni][j] * __expf(al - av[j]) * dv[j] : 0.f;
            mw[2 * hf] = pkbf(m[0], m[1]); mw[2 * hf + 1] = pkbf(m[2], m[3]); }
        const u32x4 afu = (u32x4){mw[0], mw[1], mw[2], mw[3]};
        const bf16x8 af = __builtin_bit_cast(bf16x8, afu);
#pragma unroll
        for (int ni = 0; ni < 4; ++ni) { const int chl = r * 64 + 16 * ni + fr, sw = TSW(chl);
            const u32x2 b0 = *(const u32x2*)(Xt + chl * LDX + ((32 * ks + 4 * fq) ^ sw)), b1 = *(const u32x2*)(Xt + chl * LDX + ((32 * ks + 16 + 4 * fq) ^ sw));
            const u32x4 bu = (u32x4){b0.x, b0.y, b1.x, b1.y};
            acc[ni] = MFMA16(__builtin_bit_cast(bf16x8, bu), af, acc[ni]); }
    }
#pragma unroll
    for (int ni = 0; ni < 4; ++ni) {
        const float xv[4] = {bflo(xx[ni].x), bfhi(xx[ni].x), bflo(xx[ni].y), bfhi(xx[ni].y)}, zv[4] = {bflo(zz[ni].x), bfhi(zz[ni].x), bflo(zz[ni].y), bfhi(zz[ni].y)};
#pragma unroll
        for (int j = 0; j < 4; ++j) { const float q = (acc[ni][j] + Dk * xv[j]) * zv[j] * sigmoid_f(zv[j]); acc[ni][j] = q; ss += q * q; } }
}
__device__ __forceinline__ void ssd3_unit(ArgsP a, int li, unsigned char* lds, const bf16* __restrict__ hs, int g, int R0, int len, int, int, int) {
    const int tid = ltid(), lane = tid & 63, wave = __builtin_amdgcn_readfirstlane(tid >> 6);
    const bf16* __restrict__ XC = (const bf16*)(a->ws + WS_XC); const bf16* __restrict__ ZX = (const bf16*)(a->ws + WS_ZX); const float* __restrict__ DT = (const float*)(a->ws + WS_DT); bf16* __restrict__ YN = (bf16*)(a->ws + WS_YN);
    bf16* Cn = (bf16*)lds; bf16* BH = Cn + 128 * LDX; bf16* Xt = BH + 128 * LDX;
    float* s_dt = (float*)(Xt + 256 * LDX); float* s_acs = s_dt + 512;
    const int fr = lane & 15, fq = lane >> 4, h0 = g * 4;
    {
        u32x4 vc[4], vb[4], vx0[4], vx1[4];
#pragma unroll
        for (int k = 0; k < 4; ++k) { const int item = tid + NTHREADS * k, l = item >> 4, ch = item & 15;
            vc[k] = (u32x4){0u, 0u, 0u, 0u}; vb[k] = vc[k];
            if (l < len) { vc[k] = *(const u32x4*)(XC + (size_t)(R0 + l) * CONVD + 3072 + g * 128 + ch * 8); vb[k] = *(const u32x4*)(XC + (size_t)(R0 + l) * CONVD + 2048 + g * 128 + ch * 8); } }
        const int cbl = tid & 7, tp = tid >> 3, l0 = 2 * tp;
#pragma unroll
        for (int r = 0; r < 4; ++r) { vx0[r] = (u32x4){0u, 0u, 0u, 0u}; vx1[r] = vx0[r];
            if (l0 < len) vx0[r] = *(const u32x4*)(XC + (size_t)(R0 + l0) * CONVD + g * 256 + r * 64 + cbl * 8);
            if (l0 + 1 < len) vx1[r] = *(const u32x4*)(XC + (size_t)(R0 + l0 + 1) * CONVD + g * 256 + r * 64 + cbl * 8); }
        ssd_acs(DT, a->in[I_ALOG] + li * NHEADS, R0, len, h0, s_dt, s_acs, wave, lane);
#pragma unroll
        for (int k = 0; k < 4; ++k) { const int item = tid + NTHREADS * k, l = item >> 4, ch = item & 15; *(u32x4*)(Cn + l * LDX + ch * 8) = vc[k]; *(u32x4*)(BH + l * LDX + ch * 8) = vb[k]; }
#pragma unroll
        for (int r = 0; r < 4; ++r) { const unsigned a0[4] = {vx0[r].x, vx0[r].y, vx0[r].z, vx0[r].w}, a1[4] = {vx1[r].x, vx1[r].y, vx1[r].z, vx1[r].w};
            const int col = l0 ^ (8 * cbl);
#pragma unroll
            for (int j = 0; j < 4; ++j) {
                *(unsigned*)(Xt + (r * 64 + cbl * 8 + 2 * j) * LDX + col) = (a0[j] & 0xffffu) | (a1[j] << 16);
                *(unsigned*)(Xt + (r * 64 + cbl * 8 + 2 * j + 1) * LDX + col) = (a0[j] >> 16) | (a1[j] & 0xffff0000u); } }
    }
    __syncthreads();
    u32x2 hv[8];
#pragma unroll
    for (int k = 0; k < 8; ++k) { const int item = tid + NTHREADS * k; hv[k] = (u32x2){0u, 0u}; if (hs) hv[k] = *(const u32x2*)(hs + (size_t)item * 4); }
    const bool active = (16 * wave < len);
    f32x4 cb[8];
#pragma unroll
    for (int ni = 0; ni < 8; ++ni) cb[ni] = (f32x4){0.f, 0.f, 0.f, 0.f};
    if (active) {
#pragma unroll
    for (int ks = 0; ks < 4; ++ks) { const bf16x8 af = LFRAG(Cn, 16 * wave + fr, LDX, ks);
#pragma unroll
        for (int ni = 0; ni < 8; ++ni) { const bf16x8 bb = LFRAG(BH, 16 * ni + fr, LDX, ks); cb[ni] = MFMA16(bb, af, cb[ni]); } }
    }
    __syncthreads();
#pragma unroll
    for (int k = 0; k < 8; ++k) { const int item = tid + NTHREADS * k, hp = item >> 5, n4 = item & 31; *(u32x2*)(BH + hp * LDX + n4 * 4) = hv[k]; }
#pragma unroll
    for (int k = 0; k < 8; ++k) { const int item = tid + NTHREADS * k; hv[k] = (u32x2){0u, 0u}; if (hs) hv[k] = *(const u32x2*)(hs + (size_t)(2 * 8192) + (size_t)item * 4); }
    __syncthreads();
    const int l = 16 * wave + fr;
    const size_t row = (size_t)(R0 + ((l < len) ? l : 0));
    f32x4 y0[4], y1[4], y2[4], y3[4];
    float ss = 0.f;
    const float* dsk = a->in[I_ADSKIP] + li * NHEADS + h0;
    if (active) {
    ssd3_head(0, 0, Cn, BH, Xt, s_dt, s_acs, cb, y0, XC, ZX, row, g, dsk[0], l, wave, fr, fq, ss);
    asm volatile("" ::: "memory");
    ssd3_head(1, 1, Cn, BH, Xt, s_dt, s_acs, cb, y1, XC, ZX, row, g, dsk[1], l, wave, fr, fq, ss);
    }
    __syncthreads();
#pragma unroll
    for (int k = 0; k < 8; ++k) { const int item = tid + NTHREADS * k, hp = item >> 5, n4 = item & 31; *(u32x2*)(BH + hp * LDX + n4 * 4) = hv[k]; }
    __syncthreads();
    if (active) {
    ssd3_head(2, 0, Cn, BH, Xt, s_dt, s_acs, cb, y2, XC, ZX, row, g, dsk[2], l, wave, fr, fq, ss);
    asm volatile("" ::: "memory");
    ssd3_head(3, 1, Cn, BH, Xt, s_dt, s_acs, cb, y3, XC, ZX, row, g, dsk[3], l, wave, fr, fq, ss);
    ss += __shfl_xor(ss, 16); ss += __shfl_xor(ss, 32);
    }
    const float rs = rsqrtf(ss * (1.f / 256.f) + EPS);
    if (active && l < len) {
        bf16* yrow = YN + row * DINNER + g * 256 + 4 * fq;
#pragma unroll
        for (int ni = 0; ni < 4; ++ni) {
            u32x2 w;
            w.x = pkbf(y0[ni][0] * rs, y0[ni][1] * rs); w.y = pkbf(y0[ni][2] * rs, y0[ni][3] * rs); *(u32x2*)(yrow + 0 * 64 + 16 * ni) = w;
            w.x = pkbf(y1[ni][0] * rs, y1[ni][1] * rs); w.y = pkbf(y1[ni][2] * rs, y1[ni][3] * rs); *(u32x2*)(yrow + 1 * 64 + 16 * ni) = w;
            w.x = pkbf(y2[ni][0] * rs, y2[ni][1] * rs); w.y = pkbf(y2[ni][2] * rs, y2[ni][3] * rs); *(u32x2*)(yrow + 2 * 64 + 16 * ni) = w;
            w.x = pkbf(y3[ni][0] * rs, y3[ni][1] * rs); w.y = pkbf(y3[ni][2] * rs, y3[ni][3] * rs); *(u32x2*)(yrow + 3 * 64 + 16 * ni) = w;
        }
    }
    __syncthreads();
}
__device__ __forceinline__ void phase_ssd1(ArgsP a, int li, unsigned char* lds, int tid, int wave, int lane) {
    const int c = blockIdx.x;
#pragma unroll 1
    for (int k = 0; k < 8; ++k) {
        const int u = c + 256 * (k >> 1);
        if (((k + c) & 1) == 0) { const int slot = u >> 3, g = u & 7; ssd1_unit(a, li, lds, slot, g, (slot >> 6) * SEQ + (slot & 63) * 128, 128, tid, wave, lane); }
        else ssd_sample_unit(a, li, lds, u >> 3, u & 7, tid, wave, lane);
    }
    if (c < 8) ssd1_unit(a, li, lds, 128, c, ROW_M, NMETA, tid, wave, lane);
    else if (c < 16) ssd3_unit(a, li, lds, nullptr, c - 8, ROW_M, NMETA, tid, wave, lane);
}
__device__ __forceinline__ void phase_ssd3(ArgsP a, int li, unsigned char* lds, int tid, int wave, int lane) {
    const bf16* HSB = (const bf16*)(a->ws + WS_HSB);
#pragma unroll 1
    for (int u = blockIdx.x; u < 1024; u += gridDim.x) { const int slot = u >> 3, g = u & 7; ssd3_unit(a, li, lds, HSB + (size_t)(slot * 32 + g * 4) * 8192, g, (slot >> 6) * SEQ + (slot & 63) * 128, 128, tid, wave, lane); }
}

constexpr int KS_LD = 72, VT_LD = 232, NKEYS = 208;
__device__ __forceinline__ void attn_prompt_unit(ArgsP a, int lj, unsigned char* lds, int b, int kvh, int qb, int, int, int) {
    const int tid = ltid(), lane = tid & 63, wave = __builtin_amdgcn_readfirstlane(tid >> 6);
    const bf16* Q = (const bf16*)(a->ws + WS_Q); const bf16* KV = (const bf16*)(a->ws + WS_KV); bf16* AO = (bf16*)(a->ws + WS_AO);
    bf16* Ks = (bf16*)lds; bf16* Vt = Ks + NKEYS * KS_LD; bf16* Pw = Vt + 64 * VT_LD + wave * 16 * VT_LD;
    const int fr = lane & 15, fq = lane >> 4, t0 = qb * 64, Rb = b * SEQ;
    for (int it = tid; it < NKEYS * 8; it += NTHREADS) { const int key = it >> 3, ch = it & 7;
        int row; if (key < 16) row = ROW_M + key; else { int s = t0 - 128 + key - 16; if (s < 0) s = 0; row = Rb + s; }
        *(u32x4*)(Ks + key * KS_LD + ch * 8) = *(const u32x4*)(KV + (size_t)row * KVW + kvh * 64 + ch * 8); }
    for (int it = tid; it < (NKEYS / 2) * 8; it += NTHREADS) { const int dbl = it & 7, kp = it >> 3;
        int r0, r1; { const int k0 = 2 * kp, k1 = k0 + 1; int s0 = t0 - 128 + k0 - 16, s1 = t0 - 128 + k1 - 16; if (s0 < 0) s0 = 0; if (s1 < 0) s1 = 0; r0 = (k0 < 16) ? ROW_M + k0 : Rb + s0; r1 = (k1 < 16) ? ROW_M + k1 : Rb + s1; }
        const u32x4 v0 = *(const u32x4*)(KV + (size_t)r0 * KVW + 256 + kvh * 64 + dbl * 8), v1 = *(const u32x4*)(KV + (size_t)r1 * KVW + 256 + kvh * 64 + dbl * 8);
        const unsigned a0[4] = {v0.x, v0.y, v0.z, v0.w}, a1[4] = {v1.x, v1.y, v1.z, v1.w};
#pragma unroll
        for (int j = 0; j < 4; ++j) {
            *(unsigned*)(Vt + (dbl * 8 + 2 * j) * VT_LD + 2 * kp) = (a0[j] & 0xffffu) | (a1[j] << 16);
            *(unsigned*)(Vt + (dbl * 8 + 2 * j + 1) * VT_LD + 2 * kp) = (a0[j] >> 16) | (a1[j] & 0xffff0000u); } }
    { const int row = tid >> 3, c = NKEYS + 2 * (tid & 7); *(unsigned*)(Vt + row * VT_LD + c) = 0u; }
    __syncthreads();
    const int r = wave >> 1, th = (wave & 1) * 32, qh = kvh * 4 + r;
    const float sink = a->in[I_SINKS][lj * NQ + qh];
#pragma unroll 1
    for (int blk = 0; blk < 2; ++blk) {
        const int tq0 = t0 + th + blk * 16, t = tq0 + fr;
        bf16x8 qa[2];
#pragma unroll
        for (int ks = 0; ks < 2; ++ks) qa[ks] = *(const bf16x8*)(Q + (size_t)(Rb + t) * DM + qh * 64 + 32 * ks + 8 * fq);
        f32x4 sc[13];
#pragma unroll
        for (int ni = 0; ni < 13; ++ni) sc[ni] = (f32x4){0.f, 0.f, 0.f, 0.f};
#pragma unroll
        for (int ni = 0; ni < 13; ++ni) {
            const bf16x8 b0 = *(const bf16x8*)(Ks + (16 * ni + fr) * KS_LD + 8 * fq), b1 = *(const bf16x8*)(Ks + (16 * ni + fr) * KS_LD + 32 + 8 * fq);
            sc[ni] = MFMA16(b0, qa[0], sc[ni]); sc[ni] = MFMA16(b1, qa[1], sc[ni]);
            if ((ni & 3) == 3) asm volatile("" ::: "memory"); }
        float mx = -INFINITY;
#pragma unroll
        for (int ni = 0; ni < 13; ++ni)
#pragma unroll
            for (int j = 0; j < 4; ++j) { const int key = 16 * ni + 4 * fq + j; bool vis = true;
                if (key >= 16) { const int s = t0 - 128 + key - 16; vis = (s >= 0) && (s <= t) && (s > t - 128); }
                const float v = vis ? sc[ni][j] * 0.125f : -INFINITY; sc[ni][j] = v; mx = fmaxf(mx, v); }
        mx = fmaxf(mx, __shfl_xor(mx, 16)); mx = fmaxf(mx, __shfl_xor(mx, 32)); mx = fmaxf(mx, sink);
        float sum = 0.f;
#pragma unroll
        for (int ni = 0; ni < 13; ++ni)
#pragma unroll
            for (int j = 0; j < 4; ++j) { const float p = __expf(sc[ni][j] - mx); sc[ni][j] = p; sum += p; }
        sum += __shfl_xor(sum, 16); sum += __shfl_xor(sum, 32); sum += __expf(sink - mx);
        const float inv = 1.f / sum;
#pragma unroll
        for (int ni = 0; ni < 13; ++ni) { u32x2 w; w.x = pkbf(sc[ni][0] * inv, sc[ni][1] * inv); w.y = pkbf(sc[ni][2] * inv, sc[ni][3] * inv); *(u32x2*)(Pw + fr * VT_LD + 16 * ni + 4 * fq) = w; }
        *(u32x2*)(Pw + fr * VT_LD + NKEYS + 4 * fq) = (u32x2){0u, 0u};
        asm volatile("s_waitcnt lgkmcnt(0)" ::: "memory");
        f32x4 o[4];
#pragma unroll
        for (int ni = 0; ni < 4; ++ni) o[ni] = (f32x4){0.f, 0.f, 0.f, 0.f};
#pragma unroll
        for (int ks = 0; ks < 7; ++ks) { const bf16x8 af = *(const bf16x8*)(Pw + fr * VT_LD + 32 * ks + 8 * fq);
#pragma unroll
            for (int ni = 0; ni < 4; ++ni) { const bf16x8 bb = *(const bf16x8*)(Vt + (16 * ni + fr) * VT_LD + 32 * ks + 8 * fq); o[ni] = MFMA16(bb, af, o[ni]); }
            if (ks & 1) asm volatile("" ::: "memory"); }
#pragma unroll
        for (int ni = 0; ni < 4; ++ni) { u32x2 w; w.x = pkbf(o[ni][0], o[ni][1]); w.y = pkbf(o[ni][2], o[ni][3]); *(u32x2*)(AO + (size_t)(Rb + t) * DM + qh * 64 + 16 * ni + 4 * fq) = w; }
        asm volatile("s_waitcnt lgkmcnt(0)" ::: "memory");
    }
    __syncthreads();
}
__device__ __forceinline__ void attn_sample_unit(ArgsP a, int lj, unsigned char* lds, int b, int kvh, int, int, int) {
    const int tid = ltid(), lane = tid & 63, wave = __builtin_amdgcn_readfirstlane(tid >> 6);
    const bf16* Q = (const bf16*)(a->ws + WS_Q); const bf16* KV = (const bf16*)(a->ws + WS_KV); bf16* AO = (bf16*)(a->ws + WS_AO);
    float* Kf = (float*)lds; float* Vf = Kf + 152 * 65; float* Qf = Vf + 152 * 64; float* Sc = Qf + 32 * 64;
    for (int idx = tid; idx < 152 * 64; idx += NTHREADS) { const int s = idx >> 6, d = idx & 63; float kv, vv;
        if (s < 16) { const bf16* rowp = KV + (size_t)(ROW_M + s) * KVW + kvh * 64 + d; kv = bf2f(rowp[0]); vv = bf2f(rowp[256]); }
        else if (s < 144) { const size_t o = ((size_t)(b * 128 + (s - 16)) * NKV + kvh) * 64 + d; kv = a->in[I_CK][o]; vv = a->in[I_CV][o]; }
        else { const bf16* rowp = KV + (size_t)(ROW_S + b * 8 + (s - 144)) * KVW + kvh * 64 + d; kv = bf2f(rowp[0]); vv = bf2f(rowp[256]); }
        Kf[s * 65 + d] = kv; Vf[s * 64 + d] = vv; }
    for (int idx = tid; idx < 32 * 64; idx += NTHREADS) { const int qi = idx >> 6, d = idx & 63, r = qi >> 3, t = qi & 7;
        Qf[qi * 64 + d] = bf2f(Q[(size_t)(ROW_S + b * 8 + t) * DM + (kvh * 4 + r) * 64 + d]); }
    __syncthreads();
    if (lj == 0) {
        for (int idx = tid; idx < 128 * 64; idx += NTHREADS) { const int w = idx >> 6, d = idx & 63; const size_t o = ((size_t)(b * 128 + w) * NKV + kvh) * 64 + d;
            a->out[O_SCK + o] = Kf[(24 + w) * 65 + d]; a->out[O_SCV + o] = Vf[(24 + w) * 64 + d]; }
    }
    for (int idx = tid; idx < 32 * 152; idx += NTHREADS) { const int qi = idx / 152, s = idx - qi * 152, t = qi & 7;
        float dot = 0.f;
#pragma unroll 16
        for (int d = 0; d < 64; ++d) dot += Qf[qi * 64 + d] * Kf[s * 65 + d];
        const bool vis = (s < 16) || ((s < 144) ? ((s - 16) > t) : ((s - 144) <= t));
        Sc[qi * 153 + s] = vis ? dot * 0.125f : -INFINITY; }
    __syncthreads();
#pragma unroll 1
    for (int q = 0; q < 4; ++q) { const int qi = wave * 4 + q, r = qi >> 3; const float sink = a->in[I_SINKS][lj * NQ + kvh * 4 + r];
        float v0 = Sc[qi * 153 + lane], v1 = Sc[qi * 153 + 64 + lane], v2 = (lane < 24) ? Sc[qi * 153 + 128 + lane] : -INFINITY;
        float mx = fmaxf(fmaxf(v0, v1), v2);
#pragma unroll
        for (int o = 1; o < 64; o <<= 1) mx = fmaxf(mx, __shfl_xor(mx, o));
        mx = fmaxf(mx, sink);
        v0 = __expf(v0 - mx); v1 = __expf(v1 - mx); v2 = __expf(v2 - mx);
        const float sum = wave_sum(v0 + v1 + v2) + __expf(sink - mx), inv = 1.f / sum;
        Sc[qi * 153 + lane] = v0 * inv; Sc[qi * 153 + 64 + lane] = v1 * inv; if (lane < 24) Sc[qi * 153 + 128 + lane] = v2 * inv; }
    __syncthreads();
    { const int qi = tid >> 4, d4 = (tid & 15) * 4, r = qi >> 3, t = qi & 7; f32x4 o = (f32x4){0.f, 0.f, 0.f, 0.f};
#pragma unroll 8
        for (int s = 0; s < 152; ++s) { const float p = Sc[qi * 153 + s]; const f32x4 v = *(const f32x4*)(Vf + s * 64 + d4); o = o + v * p; }
        u32x2 w; w.x = pkbf(o.x, o.y); w.y = pkbf(o.z, o.w);
        *(u32x2*)(AO + (size_t)(ROW_S + b * 8 + t) * DM + (kvh * 4 + r) * 64 + d4) = w; }
    __syncthreads();
}
__device__ __forceinline__ void phase_attn(ArgsP a, int lj, unsigned char* lds, int tid, int wave, int lane) {
    if (lj == 0) {
        const bf16* KV = (const bf16*)(a->ws + WS_KV);
        const int gt = blockIdx.x * NTHREADS + tid, NT = gridDim.x * NTHREADS;
        for (int e = gt; e < 2 * 128 * 512; e += NT) { const int b = e >> 16, w = (e >> 9) & 127, c = e & 511;
            const float v = bf2f(KV[(size_t)(b * SEQ + SEQ - 128 + w) * KVW + c]);
            if (c < 256) a->out[O_PCK + (size_t)(b * 128 + w) * 256 + c] = v; else a->out[O_PCV + (size_t)(b * 128 + w) * 256 + (c - 256)] = v; }
    }
    for (int u = blockIdx.x; u < 1024 + 512; u += gridDim.x) {
#ifndef NO_PROMPT_ATTN
        if (u < 1024) { const int qb = u & 127, kvh = (u >> 7) & 3, b = u >> 9; attn_prompt_unit(a, lj, lds, b, kvh, qb, tid, wave, lane); }
#else
        if (u < 1024) {}
#endif
#ifndef NO_SAMPLE_ATTN
        else { const int su = u - 1024; attn_sample_unit(a, lj, lds, su >> 2, su & 3, tid, wave, lane); }
#endif
    }
}

constexpr int NPHASES = 36;
template <class Epi> __device__ __forceinline__ void run_gemm(LAS unsigned char* lds, const bf16* A, const bf16* Bt, int N, int K, const Epi& E) {
    pg8::Gemm g{A, Bt, MP, N, K}; pg8::StaticOrder S; S.init(MP, N, K, (int)gridDim.x, (int)blockIdx.x);
    pg8::gemm_phase<Epi, pg8::StaticOrder, true, true>(lds, g, S, E);
}
template <class Epi> __device__ __forceinline__ void run_gemm_res(LAS unsigned char* lds, const bf16* A, const bf16* Bt, int K, int S_, const Epi& E) {
    pg8::Gemm g{A, Bt, MP, 1024, K}; pg8::ResOrder S; S.init(K, S_, (int)gridDim.x, (int)blockIdx.x);
    pg8::gemm_phase<Epi, pg8::ResOrder, true, true>(lds, g, S, E);
}

__global__ void __launch_bounds__(NTHREADS, 2) yoco_fwd(Args args) {
    extern __shared__ __attribute__((aligned(16))) unsigned char lds[];
    LAS unsigned char* ldsl = (LAS unsigned char*)lds;
    const int tid0 = threadIdx.x;
    for (int u = tid0; u < (LDS_BYTES - LDSCTL_OFF) / 4; u += NTHREADS) ((LAS unsigned*)(ldsl + LDSCTL_OFF))[u] = 0u;
    __syncthreads();
    const int lo = args.ph_lo, hi = args.ph_hi;
    XcdBarrier bar; bar.bar = (unsigned*)(args.ws + WS_CTL) + CW_BAR; bar.x = 0; bar.st = nullptr;
    if (hi - lo > 1) bar = xcd_barrier_post((unsigned*)(args.ws + WS_CTL) + CW_BAR, (volatile LAS unsigned*)(ldsl + MISC_OFF) + 8);
    int rep = 0;
#pragma unroll 1
    for (int p = lo; p < hi;) {
        ArgsP la = (ArgsP)__builtin_amdgcn_kernarg_segment_ptr(); asm volatile("" : "+s"(la));
        unsigned char* ws = la->ws;
        const int tid = ltid();
        const int lane = tid & 63, wave = __builtin_amdgcn_readfirstlane(tid >> 6);
        bf16* HN = (bf16*)(ws + WS_HN); float* H = (float*)(ws + WS_H);
        int kind, li = 0, lj = 0, layer = 0;
        if (p == 0) kind = 0;
        else if (p < 21) { li = (p - 1) / 10; layer = li; const int sub = (p - 1) % 10;
            kind = (sub == 0) ? (li == 0 ? 2 : 1) : (sub == 1) ? 3 : (sub == 2) ? 4 : (sub == 3) ? 5 : (sub == 4) ? 6 : (sub == 5) ? 7 : (sub == 6) ? 8 : (sub == 7) ? 1 : (sub == 8) ? 9 : 10; }
        else if (p < 35) { lj = (p - 21) / 7; layer = 2 + lj; const int sub = (p - 21) % 7;
            kind = (sub == 0) ? 1 : (sub == 1) ? 11 : (sub == 2) ? 12 : (sub == 3) ? 13 : (sub == 4) ? 1 : (sub == 5) ? 9 : 10; }
        else kind = 14;
#ifndef KMASK
#define KMASK 0xffff
#endif
#define KON(k) ((KMASK >> (k)) & 1)
#ifndef REP_MASK
#define REP_MASK 0
#endif
        if (KON(0) && kind == 0) phase_prologue(la, ldsl, wave, lane);
        else if (KON(1) && kind == 1) { const int sub = (p < 21) ? (p - 1) % 10 : (p - 21) % 7; phase_norm(la, 0, (p >= 21 && sub == 4) ? 4 : 8, wave, lane); }
        else if (KON(1) && kind == 2) phase_norm(la, 1, 0, wave, lane);
        else if (KON(3) && kind == 3) { pg8::EpiInProj E{(bf16*)(ws + WS_ZX), (float*)(ws + WS_DT), la->in[I_ADTB] + li * NHEADS}; run_gemm(ldsl, HN, (const bf16*)(ws + WS_WIN + li * SZ_WIN), INPROJ_P, 1024, E); }
        else if (KON(4) && kind == 4) phase_conv(la, li);
        else if (KON(5) && kind == 5) phase_ssd1(la, li, lds, tid, wave, lane);
        else if (KON(6) && kind == 6) phase_scan(la, li);
        else if (KON(7) && kind == 7) phase_ssd3(la, li, lds, tid, wave, lane);
        else if (KON(8) && (kind == 8 || kind == 10 || kind == 13)) {
            const bf16* A; const bf16* Bt; int K;
            if (kind == 8) { A = (const bf16*)(ws + WS_YN); Bt = (const bf16*)(ws + WS_WOUT + li * SZ_WOUT); K = 2048; }
            else if (kind == 10) { A = (const bf16*)(ws + WS_U); Bt = (const bf16*)(ws + WS_WDN + layer * SZ_WDN); K = 4096; }
            else { A = (const bf16*)(ws + WS_AO); Bt = (const bf16*)(ws + WS_WO + lj * SZ_WO); K = 1024; }
            pg8::EpiRes E{H, (float*)(ws + WS_SLAB)}; run_gemm_res(ldsl, A, Bt, K, K == 1024 ? 4 : 8, E); }
        else if (KON(9) && kind == 9) { pg8::EpiBf<1> E{(bf16*)(ws + WS_U), 4096, 1 << 20, nullptr, 0}; run_gemm(ldsl, HN, (const bf16*)(ws + WS_WUP + layer * SZ_WUP), 4096, 1024, E); }
        else if (KON(11) && kind == 11) { pg8::EpiBf<0> E{(bf16*)(ws + WS_Q), 1024, 4, (bf16*)(ws + WS_KV), KVW};
            run_gemm(ldsl, HN, (const bf16*)(ws + (lj == 0 ? WS_WQKV0 : WS_WQ1)), lj == 0 ? 1536 : 1024, 1024, E); }
        else if (KON(12) && kind == 12) phase_attn(la, lj, lds, tid, wave, lane);
        else if (KON(14) && kind == 14) phase_final(la, wave, lane);
        bool again = false;
        if (REP_MASK != 0) { if (rep == 0 && ((REP_MASK >> kind) & 1)) { rep = 1; again = true; } else rep = 0; }
        if (p + 1 < hi || again) xcd_barrier(bar); else { asm volatile("s_waitcnt vmcnt(0)" ::: "memory"); __syncthreads(); }
        if (!again) ++p;
    }
}

#ifndef MK_PER_PHASE
#define MK_PER_PHASE 0
#endif
extern "C" void kernel_launch(void* const* d_in, const int* in_sizes, int n_in, void* d_out, int out_size, void* d_ws, size_t ws_size, hipStream_t stream) {
    static int grid = 0;
    if (grid == 0) {
        if (n_in != 26 || (size_t)out_size != O_END || ws_size < WS_END) { fprintf(stderr, "kernel_launch: unexpected problem (n_in %d, out %d vs %zu, ws %zu vs %zu); nothing launched\n", n_in, out_size, (size_t)O_END, ws_size, (size_t)WS_END); grid = -1; return; }
        int dev = 0, cus = 0, per_cu = 0;
        if (hipGetDevice(&dev) != hipSuccess || hipDeviceGetAttribute(&cus, hipDeviceAttributeMultiprocessorCount, dev) != hipSuccess) { grid = -1; return; }
        if (hipFuncSetAttribute((const void*)yoco_fwd, hipFuncAttributeMaxDynamicSharedMemorySize, LDS_BYTES) != hipSuccess) { fprintf(stderr, "kernel_launch: hipFuncSetAttribute failed\n"); grid = -1; return; }
        if (hipOccupancyMaxActiveBlocksPerMultiprocessor(&per_cu, (const void*)yoco_fwd, NTHREADS, LDS_BYTES) != hipSuccess || per_cu < 1) { fprintf(stderr, "kernel_launch: occupancy query says %d\n", per_cu); per_cu = 1; }
        (void)hipGetLastError();
        if (cus != 256) { fprintf(stderr, "kernel_launch: built for a 256-CU device (got %d); nothing launched\n", cus); grid = -1; return; }
        grid = cus;
    }
    if (grid < 0) return;
    if (hipMemsetAsync((char*)d_ws + WS_CTL, 0, CTL_ZERO_BYTES, stream) != hipSuccess) { fprintf(stderr, "kernel_launch: memset failed\n"); return; }
    Args a{};
    for (int i = 0; i < 26; ++i) a.in[i] = (const float*)d_in[i];
    a.out = (float*)d_out; a.ws = (unsigned char*)d_ws;
#if MK_PER_PHASE
    for (int p = 0; p < NPHASES; ++p) { a.ph_lo = p; a.ph_hi = p + 1; hipLaunchKernelGGL(yoco_fwd, dim3(grid), dim3(NTHREADS), LDS_BYTES, stream, a); }
#else
    a.ph_lo = 0; a.ph_hi = NPHASES;
    void* kargs[] = {&a};
    hipError_t e = hipLaunchCooperativeKernel((const void*)yoco_fwd, dim3(grid), dim3(NTHREADS), kargs, LDS_BYTES, stream);
    if (e != hipSuccess) fprintf(stderr, "kernel_launch: cooperative launch failed: %s (grid %d)\n", hipGetErrorString(e), grid);
#endif
}
```

```cpp
#include <hip/hip_runtime.h>
#include <cstdio>
#include <cstdint>
#include <cmath>
#define OLD_PROMPT_ATTN 1
namespace pg8 {
#define PG8_LAS __attribute__((address_space(3)))
typedef unsigned short bf16_t;
typedef short bf16x8 __attribute__((ext_vector_type(8)));
typedef float f32x4 __attribute__((ext_vector_type(4)));
typedef unsigned u32x4 __attribute__((ext_vector_type(4)));
constexpr int BM = 256, BK = 64, HALF = 128, HTB = HALF * BK * 2  , STAGE_BYTES = 8 * HTB, NXCD = 8, WGM = 8;

__host__ __device__ __forceinline__ int lds_byte(int r, int c) { const int st = (r >> 4) * 2 + (c >> 5), rr = r & 15, cc = c & 31, ob = rr * 64 + cc * 2; return st * 1024 + (ob ^ (((ob >> 9) & 1) << 5)); }
__host__ __device__ __forceinline__ void stage_rc(int b, int& R, int& C) { const int st = b / 1024, sb = b % 1024, swz = sb ^ (((sb >> 9) & 1) << 5); R = (st >> 1) * 16 + swz / 64; C = (st & 1) * 32 + (swz % 64) / 2; }
__host__ __device__ __forceinline__ int perm32(int rho) { const int n = rho >> 4, i = rho & 15; return 8 * (i >> 2) + 4 * n + (i & 3); }

struct Unit { int pm, pn, k0, nt, aux; };
struct Gemm { const bf16_t* A; const bf16_t* Bt; int M, N, K; };

struct StaticOrder {
    int nM, nN, nwg, G, c, nt0;
    __host__ __device__ void init(int M, int N, int K, int G_, int c_) { nM = M / BM; nN = N / BM; nwg = nM * nN; G = G_; c = c_; nt0 = K / BK; }
    __host__ __device__ bool next(int i, Unit& u) const {
        const long L = (long)i * G + c; if (L >= nwg) return false;
        int wgid = (int)L; { const int q = nwg / NXCD, r = nwg % NXCD, xcd = wgid % NXCD, off = wgid / NXCD; wgid = (xcd < r ? xcd * (q + 1) : r * (q + 1) + (xcd - r) * q) + off; }
        const int nig = WGM * nN, gid = wgid / nig, fm = gid * WGM, gsz = (nM - fm) < WGM ? (nM - fm) : WGM;
        u.pm = fm + ((wgid % nig) % gsz); u.pn = (wgid % nig) / gsz; u.k0 = 0; u.nt = nt0; u.aux = -1; return true;
    }
    __device__ __forceinline__ void a_ready(const Unit&) const {}
    __device__ __forceinline__ void done(const Unit&) const {}
};
struct ResOrder {
    StaticOrder so; int S, K, c;
    __host__ __device__ void init(int K_, int S_, int G_, int c_) { so.init(64 * BM, 1024, K_, G_, c_); S = S_; K = K_; c = c_; }
    __host__ __device__ bool next(int i, Unit& u) const {
        if (i == 0) return so.next(0, u);
        if (i == 1 && c < 20 * S) { const int t = c / S, sl = c - t * S; u.pm = 64 + (t >> 2); u.pn = t & 3; u.k0 = sl * (K / S); u.nt = K / S / BK; u.aux = sl; return true; }
        return false;
    }
    __device__ __forceinline__ void a_ready(const Unit&) const {}
    __device__ __forceinline__ void done(const Unit&) const {}
};

__device__ __forceinline__ unsigned cvt_pk_bf16(float lo, float hi) { unsigned r; asm volatile("v_cvt_pk_bf16_f32 %0, %1, %2" : "=v"(r) : "v"(lo), "v"(hi)); return r; }
typedef float f32x2 __attribute__((ext_vector_type(2)));
typedef unsigned u32x2 __attribute__((ext_vector_type(2)));
__device__ __forceinline__ float softplus_f(float x) { return x > 20.f ? x : log1pf(__expf(x)); }
struct EpiInProj {
    static constexpr bool PERM = true, AFTER_DRAIN = false;
    bf16_t* ZX; float* DT; const float* dt_bias;
    __device__ __forceinline__ void operator()(const f32x4 (&acc)[2][2][4][2], const Unit& u, int wr, int wc, int fr, int fq) const {
        const int row0 = u.pm * BM + wr * 64 + fr;
        if (u.pn < 24) {
            const int col0 = u.pn * BM + wc * 32 + 8 * fq;
#pragma unroll
            for (int ai = 0; ai < 2; ++ai)
#pragma unroll
                for (int m = 0; m < 4; ++m) { bf16_t* rowp = ZX + (size_t)(row0 + ai * HALF + m * 16) * 6144 + col0;
#pragma unroll
                    for (int bj = 0; bj < 2; ++bj) { const f32x4 v0 = acc[ai][bj][m][0], v1 = acc[ai][bj][m][1];
                        u32x4 w; w.x = cvt_pk_bf16(v0[0], v0[1]); w.y = cvt_pk_bf16(v0[2], v0[3]); w.z = cvt_pk_bf16(v1[0], v1[1]); w.w = cvt_pk_bf16(v1[2], v1[3]);
                        *(u32x4*)(rowp + bj * HALF) = w; } }
        } else if (wc == 0) {
            const int c0 = 8 * fq;
            const f32x4 b0 = *(const f32x4*)(dt_bias + c0), b1 = *(const f32x4*)(dt_bias + c0 + 4);
#pragma unroll
            for (int ai = 0; ai < 2; ++ai)
#pragma unroll
                for (int m = 0; m < 4; ++m) { float* rowp = DT + (size_t)(row0 + ai * HALF + m * 16) * 32 + c0;
                    const f32x4 v0 = acc[ai][0][m][0] + b0, v1 = acc[ai][0][m][1] + b1;
                    f32x4 o0, o1;
#pragma unroll
                    for (int j = 0; j < 4; ++j) { o0[j] = softplus_f(v0[j]); o1[j] = softplus_f(v1[j]); }
                    *(f32x4*)(rowp) = o0; *(f32x4*)(rowp + 4) = o1; }
        }
    }
};
struct EpiRes {
    static constexpr bool PERM = false, AFTER_DRAIN = false;
    float* H; float* SLAB;
    __device__ __forceinline__ void operator()(const f32x4 (&acc)[2][2][4][2], const Unit& u, int wr, int wc, int fr, int fq) const {
        const int row0 = u.pm * BM + wr * 64 + fr, col0 = u.pn * BM + wc * 32 + 4 * fq;
        if (u.aux >= 0) {
            float* base = SLAB + (size_t)u.aux * (1280 * 1024) + (size_t)(row0 - 16384) * 1024 + col0;
#pragma unroll
            for (int ai = 0; ai < 2; ++ai)
#pragma unroll
                for (int m = 0; m < 4; ++m) { float* rowp = base + (size_t)(ai * HALF + m * 16) * 1024;
#pragma unroll
                    for (int bj = 0; bj < 2; ++bj)
#pragma unroll
                        for (int n = 0; n < 2; ++n) *(f32x4*)(rowp + bj * HALF + n * 16) = acc[ai][bj][m][n]; }
            return;
        }
#pragma unroll
        for (int ai = 0; ai < 2; ++ai)
#pragma unroll
            for (int m = 0; m < 4; ++m) { float* rowp = H + (size_t)(row0 + ai * HALF + m * 16) * 1024 + col0;
#pragma unroll
                for (int bj = 0; bj < 2; ++bj)
#pragma unroll
                    for (int n = 0; n < 2; ++n) { f32x4* p = (f32x4*)(rowp + bj * HALF + n * 16); *p = *p + acc[ai][bj][m][n]; } }
    }
};
template <int ACT> struct EpiBf {
    static constexpr bool PERM = true, AFTER_DRAIN = false;
    bf16_t* O0; int ldc0; int nsplit; bf16_t* O1; int ldc1;
    __device__ __forceinline__ void operator()(const f32x4 (&acc)[2][2][4][2], const Unit& u, int wr, int wc, int fr, int fq) const {
        const int row0 = u.pm * BM + wr * 64 + fr;
        bf16_t* base; int ldc, colt;
        if (u.pn < nsplit) { base = O0; ldc = ldc0; colt = u.pn * BM; } else { base = O1; ldc = ldc1; colt = (u.pn - nsplit) * BM; }
        const int col0 = colt + wc * 32 + 8 * fq;
#pragma unroll
        for (int ai = 0; ai < 2; ++ai)
#pragma unroll
            for (int m = 0; m < 4; ++m) { bf16_t* rowp = base + (size_t)(row0 + ai * HALF + m * 16) * ldc + col0;
#pragma unroll
                for (int bj = 0; bj < 2; ++bj) { f32x4 v0 = acc[ai][bj][m][0], v1 = acc[ai][bj][m][1];
                    if (ACT == 1) {
#pragma unroll
                        for (int j = 0; j < 4; ++j) { const float a = fmaxf(v0[j], 0.f), b = fmaxf(v1[j], 0.f); v0[j] = a * a; v1[j] = b * b; } }
                    u32x4 w; w.x = cvt_pk_bf16(v0[0], v0[1]); w.y = cvt_pk_bf16(v0[2], v0[3]); w.z = cvt_pk_bf16(v1[0], v1[1]); w.w = cvt_pk_bf16(v1[2], v1[3]);
                    *(u32x4*)(rowp + bj * HALF) = w; } }
    }
};

template <class Epi, class Sched, bool ALIGN_EPI = false, bool SP2 = false>
__device__ __forceinline__ void gemm_phase(PG8_LAS unsigned char* lds, const Gemm g, const Sched& S, const Epi& E) {
    int tid_l = threadIdx.x; asm volatile("" : "+v"(tid_l));
    const int tid = tid_l, wid = __builtin_amdgcn_readfirstlane(tid >> 6), lane = tid & 63, wr = wid >> 2, wc = wid & 3, fr = lane & 15, fq = lane >> 4;
    const int K = g.K;
    unsigned voffA[2], voffB[2];
#pragma unroll
    for (int i = 0; i < 2; ++i) { int R, C; stage_rc(tid * 16 + i * 8192, R, C); const int Rb = Epi::PERM ? ((R & ~31) + perm32(R & 31)) : R;
        voffA[i] = (unsigned)(R * K + C) * 2u; voffB[i] = (unsigned)(Rb * K + C) * 2u; }
    const size_t kstep = (size_t)(BK * 2);
    const size_t hstep = (size_t)HALF * K * 2;
    const size_t tstep = 2 * hstep;
    const unsigned ldsw = (unsigned)wid * 1024u;
    const int aoff = lds_byte(wr * 64 + fr, fq * 8), boff = lds_byte(wc * 32 + fr, fq * 8);
#define PG8_SA(b, h) (((b) * 2 + (h)) * HTB)
#define PG8_SB(b, h) ((4 + (b) * 2 + (h)) * HTB)
#define PG8_STAGE(bufoff, gbase, voff) do { _Pragma("unroll") for (int _i = 0; _i < 2; ++_i) \
        __builtin_amdgcn_global_load_lds((const unsigned*)((const char*)(gbase) + (voff)[_i]), (PG8_LAS unsigned*)(lds + (bufoff) + ldsw + _i * 8192), 16, 0, 0); } while (0)
#define PG8_LDA(dst, b, h) do { _Pragma("unroll") for (int m = 0; m < 4; ++m) _Pragma("unroll") for (int k = 0; k < 2; ++k) dst[m][k] = *(const PG8_LAS bf16x8*)(lds + PG8_SA(b, h) + aoff + m * 2048 + k * 1024); } while (0)
#define PG8_LDB(dst, b, h) do { _Pragma("unroll") for (int n = 0; n < 2; ++n) _Pragma("unroll") for (int k = 0; k < 2; ++k) dst[n][k] = *(const PG8_LAS bf16x8*)(lds + PG8_SB(b, h) + boff + n * 2048 + k * 1024); } while (0)
#define PG8_MMA(ai, bj, At, Bt) do { __builtin_amdgcn_s_setprio(1); _Pragma("unroll") for (int m = 0; m < 4; ++m) _Pragma("unroll") for (int n = 0; n < 2; ++n) _Pragma("unroll") for (int k = 0; k < 2; ++k) \
        acc[ai][bj][m][n] = __builtin_amdgcn_mfma_f32_16x16x32_bf16(Bt[n][k], At[m][k], acc[ai][bj][m][n], 0, 0, 0); __builtin_amdgcn_s_setprio(0); } while (0)
#define PG8_WAIT_V(n) asm volatile("s_waitcnt vmcnt(" #n ")" ::: "memory")
#define PG8_WAIT_L(n) asm volatile("s_waitcnt lgkmcnt(" #n ")" ::: "memory")
#define PG8_BAR __builtin_amdgcn_s_barrier()
#define PG8_SCHED __builtin_amdgcn_sched_barrier(0)
    Unit cur, nxt; int ui = 0;
    if (!S.next(0, cur)) return;
    f32x4 acc[2][2][4][2];
#pragma unroll
    for (int a = 0; a < 2; ++a)
#pragma unroll
        for (int b = 0; b < 2; ++b)
#pragma unroll
            for (int m = 0; m < 4; ++m)
#pragma unroll
                for (int n = 0; n < 2; ++n) acc[a][b][m][n] = (f32x4){0.f, 0.f, 0.f, 0.f};
    bf16x8 At[4][2], B0[2][2], B1[2][2];
    const char* cA = (const char*)g.A + (size_t)cur.pm * tstep + (size_t)cur.k0 * 2; const char* cB = (const char*)g.Bt + (size_t)cur.pn * tstep + (size_t)cur.k0 * 2;
    S.a_ready(cur);
    if constexpr (SP2) {
        PG8_STAGE(PG8_SB(0, 0), cB, voffB); PG8_STAGE(PG8_SB(0, 1), cB + hstep, voffB); PG8_STAGE(PG8_SA(0, 0), cA, voffA); PG8_STAGE(PG8_SA(0, 1), cA + hstep, voffA);
        if (wr == 1) PG8_BAR;
        PG8_WAIT_V(2); PG8_BAR;
        PG8_STAGE(PG8_SB(1, 0), cB + kstep, voffB); PG8_STAGE(PG8_SA(1, 0), cA + kstep, voffA); PG8_STAGE(PG8_SB(1, 1), cB + hstep + kstep, voffB);
        PG8_WAIT_V(6); PG8_BAR;
    } else {
        PG8_STAGE(PG8_SB(0, 0), cB, voffB); PG8_STAGE(PG8_SA(0, 0), cA, voffA); PG8_STAGE(PG8_SB(0, 1), cB + hstep, voffB); PG8_STAGE(PG8_SA(0, 1), cA + hstep, voffA);
        if (wr == 1) PG8_BAR;
        PG8_WAIT_V(4); PG8_BAR;
        PG8_STAGE(PG8_SB(1, 0), cB + kstep, voffB); PG8_STAGE(PG8_SA(1, 0), cA + kstep, voffA); PG8_STAGE(PG8_SB(1, 1), cB + hstep + kstep, voffB);
        PG8_WAIT_V(6); PG8_BAR;
    }
    for (;;) {
        const bool has_next = S.next(ui + 1, nxt);
        const char* nA = has_next ? (const char*)g.A + (size_t)nxt.pm * tstep + (size_t)nxt.k0 * 2 : cA; const char* nB = has_next ? (const char*)g.Bt + (size_t)nxt.pn * tstep + (size_t)nxt.k0 * 2 : cB;
        const int nt = cur.nt;
        for (int t = 0; t < nt; t += 2) {
            const bool last = (t == nt - 2);
            const char* a1 = cA + (size_t)(t + 1) * kstep;
            const char* a2 = last ? nA : cA + (size_t)(t + 2) * kstep; const char* b2 = last ? nB : cB + (size_t)(t + 2) * kstep;
            const char* a3 = a2 + kstep; const char* b3 = b2 + kstep;
            if (last && has_next) S.a_ready(nxt);
            if constexpr (SP2) {
            PG8_LDB(B0, 0, 0); PG8_LDB(B1, 0, 1); PG8_SCHED; PG8_LDA(At, 0, 0); PG8_STAGE(PG8_SA(1, 1), a1 + hstep, voffA);
            PG8_WAIT_V(8); PG8_WAIT_L(0); PG8_BAR; PG8_MMA(0, 0, At, B0); PG8_MMA(0, 1, At, B1); PG8_BAR; PG8_SCHED;
            PG8_LDA(At, 0, 1); PG8_STAGE(PG8_SB(0, 0), b2, voffB); PG8_STAGE(PG8_SB(0, 1), b2 + hstep, voffB); PG8_STAGE(PG8_SA(0, 0), a2, voffA);
            PG8_WAIT_V(8); PG8_WAIT_L(0); PG8_BAR; PG8_MMA(1, 0, At, B0); PG8_MMA(1, 1, At, B1); PG8_BAR; PG8_SCHED;
            PG8_LDB(B0, 1, 0); PG8_LDB(B1, 1, 1); PG8_SCHED; PG8_LDA(At, 1, 0); PG8_STAGE(PG8_SA(0, 1), a2 + hstep, voffA);
            PG8_WAIT_V(8); PG8_WAIT_L(0); PG8_BAR; PG8_MMA(0, 0, At, B0); PG8_MMA(0, 1, At, B1); PG8_BAR; PG8_SCHED;
            PG8_LDA(At, 1, 1); PG8_STAGE(PG8_SB(1, 0), b3, voffB); PG8_STAGE(PG8_SB(1, 1), b3 + hstep, voffB); PG8_STAGE(PG8_SA(1, 0), a3, voffA);
            PG8_WAIT_V(8); PG8_WAIT_L(0); PG8_BAR; PG8_MMA(1, 0, At, B0); PG8_MMA(1, 1, At, B1); PG8_BAR; PG8_SCHED;
            } else {
            PG8_LDB(B0, 0, 0); PG8_SCHED; PG8_LDA(At, 0, 0); PG8_STAGE(PG8_SA(1, 1), a1 + hstep, voffA);
            PG8_WAIT_L(8); PG8_BAR; PG8_WAIT_L(0); PG8_MMA(0, 0, At, B0); PG8_BAR; PG8_SCHED;
            PG8_LDB(B1, 0, 1); PG8_STAGE(PG8_SB(0, 0), b2, voffB);
            PG8_BAR; PG8_WAIT_L(0); PG8_MMA(0, 1, At, B1); PG8_BAR;
            PG8_LDA(At, 0, 1); PG8_STAGE(PG8_SA(0, 0), a2, voffA);
            PG8_BAR; PG8_WAIT_L(0); PG8_MMA(1, 0, At, B0); PG8_BAR; PG8_SCHED;
            PG8_STAGE(PG8_SB(0, 1), b2 + hstep, voffB);
            PG8_WAIT_V(6); PG8_BAR; PG8_MMA(1, 1, At, B1); PG8_BAR;
            PG8_LDB(B0, 1, 0); PG8_SCHED; PG8_LDA(At, 1, 0); PG8_STAGE(PG8_SA(0, 1), a2 + hstep, voffA);
            PG8_WAIT_L(8); PG8_BAR; PG8_WAIT_L(0); PG8_MMA(0, 0, At, B0); PG8_BAR; PG8_SCHED;
            PG8_LDB(B1, 1, 1); PG8_STAGE(PG8_SB(1, 0), b3, voffB);
            PG8_BAR; PG8_WAIT_L(0); PG8_MMA(0, 1, At, B1); PG8_BAR;
            PG8_LDA(At, 1, 1); PG8_STAGE(PG8_SA(1, 0), a3, voffA);
            PG8_BAR; PG8_WAIT_L(0); PG8_MMA(1, 0, At, B0); PG8_BAR; PG8_SCHED;
            PG8_STAGE(PG8_SB(1, 1), b3 + hstep, voffB);
            PG8_WAIT_V(6); PG8_BAR; PG8_MMA(1, 1, At, B1); PG8_BAR;
            }
        }
        if constexpr (ALIGN_EPI) { if (wr == 0) PG8_BAR; }
        if constexpr (!Epi::AFTER_DRAIN) { E(acc, cur, wr, wc, fr, fq); S.done(cur); }
        if (!has_next) break;
#pragma unroll
        for (int a = 0; a < 2; ++a)
#pragma unroll
            for (int b = 0; b < 2; ++b)
#pragma unroll
                for (int m = 0; m < 4; ++m)
#pragma unroll
                    for (int n = 0; n < 2; ++n) acc[a][b][m][n] = (f32x4){0.f, 0.f, 0.f, 0.f};
        cur = nxt; cA = nA; cB = nB; ++ui;
        if constexpr (ALIGN_EPI) { if (wr == 1) PG8_BAR; }
    }
    PG8_WAIT_V(0);
    if constexpr (!ALIGN_EPI) { if (wr == 0) PG8_BAR; }
    PG8_BAR;
    if constexpr (Epi::AFTER_DRAIN) { E.fused(acc, cur, wr, wc, fr, fq, lds, wid, lane); S.done(cur); }
#undef PG8_SA
#undef PG8_SB
#undef PG8_STAGE
#undef PG8_LDA
#undef PG8_LDB
#undef PG8_MMA
#undef PG8_WAIT_V
#undef PG8_WAIT_L
#undef PG8_BAR
#undef PG8_SCHED
}
}
#define GAS __attribute__((address_space(1)))
#define LAS __attribute__((address_space(3)))
typedef unsigned short bf16;
typedef unsigned v4u __attribute__((ext_vector_type(4)));
typedef float f32x4 __attribute__((ext_vector_type(4)));
typedef short bf16x8 __attribute__((ext_vector_type(8)));
typedef GAS unsigned gu32;
typedef GAS unsigned long long gu64;
#define RLX_AGENT __ATOMIC_RELAXED, __HIP_MEMORY_SCOPE_AGENT
#define LDS_WAIT() asm volatile("s_waitcnt lgkmcnt(0)" ::: "memory")
#define VM_WAIT() asm volatile("s_waitcnt vmcnt(0)" ::: "memory")
__device__ __forceinline__ unsigned long long rt() { return __builtin_amdgcn_s_memrealtime(); }
__device__ __forceinline__ unsigned f2bf(float f) { unsigned u = __builtin_bit_cast(unsigned, f); return (u + 0x7fffu + ((u >> 16) & 1u)) >> 16; }
__device__ __forceinline__ unsigned pk2(float lo, float hi) { return f2bf(lo) | (f2bf(hi) << 16); }

#define XB_TMO      128
#define XB_XCNT(j)  (256  + 64 * (j))
#define XB_XSUB(j)  (1280 + 64 * (j))
#define XB_XGEN(j)  (2304 + 64 * (j))
#define XB_TOP      3328
#define XB_TOPGEN   3392
#define XCD_BAR_WORDS 3456
#define XB_SPIN_CAP (1u << 18)

__device__ __forceinline__ unsigned xb_ld(unsigned* p)              { return __hip_atomic_load(p, __ATOMIC_RELAXED, __HIP_MEMORY_SCOPE_AGENT); }
__device__ __forceinline__ unsigned xb_add(unsigned* p, unsigned v) { return __hip_atomic_fetch_add(p, v, __ATOMIC_RELAXED, __HIP_MEMORY_SCOPE_AGENT); }
__device__ __forceinline__ unsigned xb_xcc_id() { return (unsigned)__builtin_amdgcn_s_getreg((3 << 11) | 20) & 0xFu; }
#define XB_SPIN(cond, bar) do { unsigned _sp = 0; while (cond) { __builtin_amdgcn_s_sleep(1); \
    if ((++_sp & 255u) == 0u) { if (xb_ld(&(bar)[XB_TMO])) break; if (_sp > XB_SPIN_CAP) { atomicAdd(&(bar)[XB_TMO], 1u); break; } } } } while (0)

struct XcdBarrier {
    unsigned* bar; unsigned x;
    volatile LAS unsigned* st;
};

__device__ __forceinline__ XcdBarrier xcd_barrier_post(unsigned* bar, volatile LAS unsigned* st) {
    XcdBarrier b; b.bar = bar; b.x = xb_xcc_id(); b.st = st;
    if (threadIdx.x == 0) (void)xb_add(&bar[XB_XCNT(b.x)], 1u);
    return b;
}
__device__ __forceinline__ void xcd_barrier_complete(unsigned* bar, unsigned x, unsigned& nloc, unsigned& nx) {
    const unsigned G = gridDim.x * gridDim.y * gridDim.z;
    unsigned sum, cnt, mine, sp = 0u;
    for (;;) {
        sum = 0u; cnt = 0u; mine = 0u;
#pragma unroll
        for (unsigned j = 0; j < 16; ++j) { const unsigned c = xb_ld(&bar[XB_XCNT(j)]); sum += c; cnt += (c > 0u) ? 1u : 0u; mine = (j == x) ? c : mine; }
        if (sum == G) break;
        __builtin_amdgcn_s_sleep(1);
        if ((++sp & 255u) == 0u) { if (xb_ld(&bar[XB_TMO])) break; if (sp > XB_SPIN_CAP) { atomicAdd(&bar[XB_TMO], 1u); break; } }
    }
    nloc = mine > 0u ? mine : 1u; nx = cnt > 0u ? cnt : 1u;
}

__device__ __forceinline__ void xcd_barrier(const XcdBarrier& b) {
    asm volatile("s_waitcnt vmcnt(0)" ::: "memory");
    __syncthreads();
    if (threadIdx.x == 0) {
        unsigned* bar = b.bar;
        __builtin_amdgcn_s_waitcnt(0);
        unsigned nloc = b.st[0], nx = b.st[1];
        if (nloc == 0u) { xcd_barrier_complete(bar, b.x, nloc, nx); b.st[0] = nloc; b.st[1] = nx; }
        const unsigned old = xb_add(&bar[XB_XSUB(b.x)], 1u);
        const unsigned gen = old / nloc;
        if (old + 1u == (gen + 1u) * nloc) {
            __builtin_amdgcn_fence(__ATOMIC_RELEASE, "agent");
            asm volatile("s_waitcnt vmcnt(0)" ::: "memory");
            const unsigned og = xb_add(&bar[XB_TOP], 1u);
            const unsigned tg = og / nx;
            if (og + 1u == (tg + 1u) * nx) xb_add(&bar[XB_TOPGEN], 1u);
            else XB_SPIN(xb_ld(&bar[XB_TOPGEN]) == tg, bar);
            __builtin_amdgcn_fence(__ATOMIC_ACQUIRE, "agent");
            xb_add(&bar[XB_XGEN(b.x)], 1u);
            asm volatile("s_waitcnt vmcnt(0)" ::: "memory");
        } else {
            XB_SPIN(xb_ld(&bar[XB_XGEN(b.x)]) == gen, bar);
            __builtin_amdgcn_fence(__ATOMIC_ACQUIRE, "agent");
            asm volatile("s_waitcnt vmcnt(0)" ::: "memory");
        }
    }
    __syncthreads();
}
constexpr int NWAVES = 8, NTHREADS = 512;
constexpr int DM = 1024, SEQ = 8192, NPROMPT = 2, NSAMP = 128, TSAMP = 8, NMETA = 16;
constexpr int ROW_S = NPROMPT * SEQ;
constexpr int ROW_M = ROW_S + NSAMP * TSAMP;
constexpr int NROWS = ROW_M + NMETA;
constexpr int MP = 17664;
constexpr int DINNER = 2048, NHEADS = 32, HD = 64, NGROUPS = 8, DSTATE = 128, CONVD = 4096, INPROJ = 6176, INPROJ_P = 6400, ZXW = 6144;
constexpr int DFF = 4096, NKV = 4, NQ = 16, KVW = 512;
constexpr float EPS = 1e-5f;
constexpr int LDX = 136;

constexpr size_t O_YP = 0, O_YS = O_YP + (size_t)NPROMPT * SEQ * DM, O_PCONV = O_YS + (size_t)NSAMP * TSAMP * DM, O_PSSM = O_PCONV + 2 * 2 * 3 * 4096,
    O_PCK = O_PSSM + (size_t)2 * 2 * 32 * 64 * 128, O_PCV = O_PCK + 2 * 128 * 256, O_SCONV = O_PCV + 2 * 128 * 256, O_SSSM = O_SCONV + (size_t)2 * 128 * 3 * 4096,
    O_SCK = O_SSSM + (size_t)2 * 128 * 32 * 64 * 128, O_SCV = O_SCK + (size_t)128 * 128 * 256, O_END = O_SCV + (size_t)128 * 128 * 256;

constexpr size_t MiB = 1u << 20;
constexpr size_t WS_CTL = 0, CTL_ZERO_BYTES = 1 * MiB;
constexpr size_t SZ_WIN = (size_t)INPROJ_P * 1024 * 2, SZ_WOUT = (size_t)1024 * 2048 * 2, SZ_WUP = (size_t)4096 * 1024 * 2, SZ_WDN = SZ_WUP, SZ_WQKV0 = (size_t)1536 * 1024 * 2, SZ_WQ1 = (size_t)1024 * 1024 * 2, SZ_WO = SZ_WQ1;
constexpr size_t WS_WIN = 1 * MiB, WS_WOUT = WS_WIN + 2 * SZ_WIN, WS_WUP = WS_WOUT + 2 * SZ_WOUT, WS_WDN = WS_WUP + 4 * SZ_WUP, WS_WQKV0 = WS_WDN + 4 * SZ_WDN, WS_WQ1 = WS_WQKV0 + SZ_WQKV0, WS_WO = WS_WQ1 + SZ_WQ1, WS_WEND = WS_WO + 2 * SZ_WO;
constexpr size_t al1m(size_t x) { return (x + MiB - 1) / MiB * MiB; }
constexpr size_t WS_H = al1m(WS_WEND), WS_HN = al1m(WS_H + (size_t)MP * 1024 * 4), WS_ZX = al1m(WS_HN + (size_t)MP * 1024 * 2), WS_DT = al1m(WS_ZX + (size_t)MP * ZXW * 2),
    WS_XC = al1m(WS_DT + (size_t)MP * 32 * 4), WS_YN = al1m(WS_XC + (size_t)MP * 4096 * 2), WS_CS = al1m(WS_YN + (size_t)MP * 2048 * 2), WS_CD = al1m(WS_CS + (size_t)129 * 32 * 8192 * 4), WS_SLAB = al1m(WS_CD + 129 * 32 * 4), WS_HSB = al1m(WS_SLAB + (size_t)8 * 1280 * 1024 * 4), WS_END = al1m(WS_HSB + (size_t)128 * 32 * 8192 * 2);
constexpr size_t WS_U = WS_ZX;
constexpr size_t WS_Q = WS_XC, WS_KV = WS_Q + (size_t)MP * 1024 * 2, WS_AO = WS_KV + (size_t)MP * 512 * 2;
static_assert(WS_AO + (size_t)MP * 1024 * 2 <= WS_YN, "attention overlay");
constexpr int CW_BAR = 4096;

constexpr int RING_BYTES = 131072, LDS_BYTES = 147456, LDSCTL_OFF = LDS_BYTES - 512, MISC_OFF = LDSCTL_OFF + 320;

typedef unsigned u32x2 __attribute__((ext_vector_type(2)));
typedef unsigned u32x4 __attribute__((ext_vector_type(4)));
__device__ __forceinline__ int ltid() { int t = threadIdx.x; asm volatile("" : "+v"(t)); return t; }
__device__ __forceinline__ float bf2f(unsigned short b) { return __uint_as_float((unsigned)b << 16); }
__device__ __forceinline__ float bflo(unsigned w) { return __uint_as_float(w << 16); }
__device__ __forceinline__ float bfhi(unsigned w) { return __uint_as_float(w & 0xffff0000u); }
__device__ __forceinline__ unsigned pkbf(float lo, float hi) { return pg8::cvt_pk_bf16(lo, hi); }
__device__ __forceinline__ float wave_sum(float v) {
#pragma unroll
    for (int o = 1; o < 64; o <<= 1) v += __shfl_xor(v, o);
    return v;
}
__device__ __forceinline__ float frcp(float x) { return __builtin_amdgcn_rcpf(x); }
__device__ __forceinline__ float sigmoid_f(float x) { return frcp(1.f + __expf(-x)); }
#define MFMA16(b, a, c) __builtin_amdgcn_mfma_f32_16x16x32_bf16((b), (a), (c), 0, 0, 0)

struct Args {
    const float* in[26]; float* out; unsigned char* ws; int ph_lo, ph_hi;
};
typedef const __attribute__((address_space(4))) Args* ArgsP;
enum { I_XP = 0, I_XS, I_SCONV, I_SSSM, I_CK, I_CV, I_META, I_ANORM, I_AIN, I_ACONVW, I_ACONVB, I_ADTB, I_ALOG, I_ADSKIP, I_AGATE, I_AOUT, I_KVNORM, I_WKV, I_BNORM, I_WQ, I_SINKS, I_WO, I_MLPNORM, I_WUP, I_WDOWN, I_FNORM };

__device__ __forceinline__ void transpose_item(const float* W, const float* scale, int K, int N, bf16* WT, int row_off, LAS unsigned* scr, int item, int lane) {
    const int nblk = (N + 63) / 64, kb = item / nblk, nb = item % nblk, k0 = 64 * kb, n0 = 64 * nb;
    const bool ok = (n0 + lane < N);
    const float* src = W + (size_t)k0 * N + n0 + (ok ? lane : 0);
#pragma unroll
    for (int h = 0; h < 2; ++h) {
        float v[32];
#pragma unroll
        for (int i = 0; i < 32; ++i) v[i] = src[(size_t)(32 * h + i) * N];
        if (!ok) {
#pragma unroll
            for (int i = 0; i < 32; ++i) v[i] = 0.f;
        }
        if (scale) {
#pragma unroll
            for (int i = 0; i < 32; ++i) v[i] *= scale[k0 + 32 * h + i];
        }
#pragma unroll
        for (int i = 0; i < 16; ++i) scr[lane * 33 + 16 * h + i] = pkbf(v[2 * i], v[2 * i + 1]);
    }
    LDS_WAIT(); asm volatile("" ::: "memory");
    const int c = lane & 7;
#pragma unroll
    for (int j = 0; j < 8; ++j) { const int n = (lane >> 3) + 8 * j; const LAS unsigned* sp = scr + n * 33 + 4 * c;
        v4u o; o.x = sp[0]; o.y = sp[1]; o.z = sp[2]; o.w = sp[3];
        if (n0 + n < N) *(GAS v4u*)(WT + (size_t)(row_off + n0 + n) * K + k0 + 8 * c) = o; }
    LDS_WAIT(); asm volatile("" ::: "memory");
}
struct WJob { const float* W; const float* scale; int K, N; bf16* WT; int row_off; int items; };

__device__ __forceinline__ void phase_prologue(ArgsP a, LAS unsigned char* lds, int wave, int lane) {
    LAS unsigned* scr = (LAS unsigned*)(lds + wave * 16384);
    const int gw = blockIdx.x * NWAVES + wave, NGW = gridDim.x * NWAVES;
    unsigned char* ws = a->ws;
    for (int jb = 0; jb < 21; ++jb) {
        WJob J;
        if (jb < 2)       { const int i = jb;      J = WJob{a->in[I_AIN] + (size_t)i * 1024 * INPROJ, a->in[I_ANORM] + i * 1024, 1024, INPROJ, (bf16*)(ws + WS_WIN + i * SZ_WIN), 0, 0}; }
        else if (jb < 4)  { const int i = jb - 2;  J = WJob{a->in[I_AOUT] + (size_t)i * 2048 * 1024, a->in[I_AGATE] + i * 2048, 2048, 1024, (bf16*)(ws + WS_WOUT + i * SZ_WOUT), 0, 0}; }
        else if (jb < 8)  { const int l = jb - 4;  J = WJob{a->in[I_WUP] + (size_t)l * 1024 * 4096, a->in[I_MLPNORM] + l * 1024, 1024, 4096, (bf16*)(ws + WS_WUP + l * SZ_WUP), 0, 0}; }
        else if (jb < 12) { const int l = jb - 8;  J = WJob{a->in[I_WDOWN] + (size_t)l * 4096 * 1024, nullptr, 4096, 1024, (bf16*)(ws + WS_WDN + l * SZ_WDN), 0, 0}; }
        else if (jb == 12) { J = WJob{a->in[I_WQ], a->in[I_BNORM], 1024, 1024, (bf16*)(ws + WS_WQKV0), 0, 0}; }
        else if (jb == 13) { J = WJob{a->in[I_WKV], a->in[I_KVNORM], 1024, 512, (bf16*)(ws + WS_WQKV0), 1024, 0}; }
        else if (jb == 14) { J = WJob{a->in[I_WQ] + (size_t)1024 * 1024, a->in[I_BNORM] + 1024, 1024, 1024, (bf16*)(ws + WS_WQ1), 0, 0}; }
        else if (jb < 17) { const int j = jb - 15; J = WJob{a->in[I_WO] + (size_t)j * 1024 * 1024, nullptr, 1024, 1024, (bf16*)(ws + WS_WO + j * SZ_WO), 0, 0}; }
        else break;
        const int items = (J.K / 64) * ((J.N + 63) / 64);
        for (int it = gw; it < items; it += NGW) transpose_item(J.W, J.scale, J.K, J.N, J.WT, J.row_off, scr, it, lane);
    }
    {
        const int gt = blockIdx.x * NTHREADS + ltid(), NT = gridDim.x * NTHREADS;
        const int per = (INPROJ_P - INPROJ) * 1024 * 2 / 16;
        for (int e = gt; e < 2 * per; e += NT) { const int i = e / per, c = e % per;
            *(v4u*)(ws + WS_WIN + i * SZ_WIN + (size_t)INPROJ * 1024 * 2 + (size_t)c * 16) = (v4u){0u, 0u, 0u, 0u}; }
    }
}

__device__ __forceinline__ void phase_norm(ArgsP a, int from_inputs, int nslab, int wave, int lane) {
    float* H = (float*)(a->ws + WS_H); bf16* HN = (bf16*)(a->ws + WS_HN); const float* SLAB = (const float*)(a->ws + WS_SLAB);
    const int gw = blockIdx.x * NWAVES + wave, NGW = gridDim.x * NWAVES;
    for (int m = gw; m < MP; m += NGW) {
        unsigned long long* o8 = (unsigned long long*)(HN + (size_t)m * DM) + lane;
        if (m >= NROWS) {
#pragma unroll
            for (int j = 0; j < 4; ++j) o8[64 * j] = 0ull;
            continue;
        }
        const float* src;
        if (from_inputs) src = (m < ROW_S) ? a->in[I_XP] + (size_t)m * DM : (m < ROW_M) ? a->in[I_XS] + (size_t)(m - ROW_S) * DM : a->in[I_META] + (size_t)(m - ROW_M) * DM;
        else src = H + (size_t)m * DM;
        const f32x4* xr = (const f32x4*)src + lane;
        f32x4 v[4]; float s = 0.f;
#pragma unroll
        for (int j = 0; j < 4; ++j) v[j] = xr[64 * j];
        if (m >= ROW_S && nslab > 0) {
            for (int sl = 0; sl < nslab; ++sl) { const f32x4* sr = (const f32x4*)(SLAB + (size_t)sl * (1280 * 1024) + (size_t)(m - ROW_S) * DM) + lane;
#pragma unroll
                for (int j = 0; j < 4; ++j) v[j] = v[j] + sr[64 * j]; }
            f32x4* hr = (f32x4*)(H + (size_t)m * DM) + lane;
#pragma unroll
            for (int j = 0; j < 4; ++j) hr[64 * j] = v[j];
        }
#pragma unroll
        for (int j = 0; j < 4; ++j) s += (v[j].x * v[j].x + v[j].y * v[j].y) + (v[j].z * v[j].z + v[j].w * v[j].w);
        const float rs = rsqrtf(wave_sum(s) * (1.f / DM) + EPS);
        if (from_inputs) { f32x4* hr = (f32x4*)(H + (size_t)m * DM) + lane;
#pragma unroll
            for (int j = 0; j < 4; ++j) hr[64 * j] = v[j]; }
#pragma unroll
        for (int j = 0; j < 4; ++j) o8[64 * j] = (unsigned long long)pkbf(v[j].x * rs, v[j].y * rs) | ((unsigned long long)pkbf(v[j].z * rs, v[j].w * rs) << 32);
    }
}
__device__ __forceinline__ void phase_final(ArgsP a, int wave, int lane) {
    const float* H = (const float*)(a->ws + WS_H); const float* fw = a->in[I_FNORM]; const float* SLAB = (const float*)(a->ws + WS_SLAB);
    const int gw = blockIdx.x * NWAVES + wave, NGW = gridDim.x * NWAVES;
    f32x4 w[4];
#pragma unroll
    for (int j = 0; j < 4; ++j) w[j] = ((const f32x4*)fw)[lane + 64 * j];
    for (int m = gw; m < ROW_M; m += NGW) {
        const f32x4* xr = (const f32x4*)(H + (size_t)m * DM) + lane;
        f32x4 v[4]; float s = 0.f;
#pragma unroll
        for (int j = 0; j < 4; ++j) v[j] = xr[64 * j];
        if (m >= ROW_S) {
            for (int sl = 0; sl < 8; ++sl) { const f32x4* sr = (const f32x4*)(SLAB + (size_t)sl * (1280 * 1024) + (size_t)(m - ROW_S) * DM) + lane;
#pragma unroll
                for (int j = 0; j < 4; ++j) v[j] = v[j] + sr[64 * j]; }
        }
#pragma unroll
        for (int j = 0; j < 4; ++j) s += (v[j].x * v[j].x + v[j].y * v[j].y) + (v[j].z * v[j].z + v[j].w * v[j].w);
        const float rs = rsqrtf(wave_sum(s) * (1.f / DM) + EPS);
        f32x4* o = (f32x4*)(a->out + O_YP + (size_t)m * DM) + lane;
#pragma unroll
        for (int j = 0; j < 4; ++j) o[64 * j] = v[j] * rs * w[j];
    }
}

__device__ __forceinline__ void unpack8(const u32x4 w, float (&f)[8]) { f[0] = bflo(w.x); f[1] = bfhi(w.x); f[2] = bflo(w.y); f[3] = bfhi(w.y); f[4] = bflo(w.z); f[5] = bfhi(w.z); f[6] = bflo(w.w); f[7] = bfhi(w.w); }
__device__ __forceinline__ void ld8f(const float* __restrict__ p, float (&f)[8]) { const f32x4 x0 = *(const f32x4*)p, x1 = *(const f32x4*)(p + 4); f[0]=x0.x;f[1]=x0.y;f[2]=x0.z;f[3]=x0.w;f[4]=x1.x;f[5]=x1.y;f[6]=x1.z;f[7]=x1.w; }
__device__ __forceinline__ void phase_conv(ArgsP a, int li) {
    const bf16* __restrict__ ZX = (const bf16*)(a->ws + WS_ZX); bf16* __restrict__ XC = (bf16*)(a->ws + WS_XC);
    const float* __restrict__ cw = a->in[I_ACONVW] + (size_t)li * 4 * CONVD; const float* __restrict__ cb = a->in[I_ACONVB] + (size_t)li * CONVD;
    const float* __restrict__ sconv = a->in[I_SCONV] + (size_t)li * NSAMP * 3 * CONVD;
    float* __restrict__ outp = a->out;
    constexpr int NRUNS = 2048 + 128 + 2;
    const int gt = blockIdx.x * NTHREADS + ltid(), NT = gridDim.x * NTHREADS;
    for (int item = gt; item < NRUNS * 512; item += NT) {
        const int run = item >> 9, c0 = (item & 511) * 8;
        int R0, kind, b = 0; bool last = false;
        if (run < 2048) { kind = 0; b = run >> 10; const int t0 = (run & 1023) * 8; R0 = b * SEQ + t0; last = (t0 == SEQ - 8); }
        else if (run < 2176) { kind = 1; b = run - 2048; R0 = ROW_S + b * 8; last = true; }
        else { kind = 2; R0 = ROW_M + (run - 2176) * 8; }
        const bool first = (kind == 0) ? ((run & 1023) == 0) : (kind == 1) ? true : (run == 2176);
        u32x4 raw[11];
#pragma unroll
        for (int t = 0; t < 8; ++t) raw[3 + t] = *(const u32x4*)(ZX + (size_t)(R0 + t) * ZXW + 2048 + c0);
        float p0[8], p1[8], p2[8];
        if (!first || kind == 0) {
            const int Rp = first ? ROW_M + 16 : R0;
#pragma unroll
            for (int t = 0; t < 3; ++t) raw[t] = *(const u32x4*)(ZX + (size_t)(Rp - 3 + t) * ZXW + 2048 + c0);
            unpack8(raw[0], p0); unpack8(raw[1], p1); unpack8(raw[2], p2);
        } else if (kind == 1) {
            const float* s = sconv + (size_t)b * 3 * CONVD + c0;
            ld8f(s, p0); ld8f(s + CONVD, p1); ld8f(s + 2 * CONVD, p2);
        } else {
#pragma unroll
            for (int j = 0; j < 8; ++j) { p0[j] = 0.f; p1[j] = 0.f; p2[j] = 0.f; }
        }
        float w0[8], w1[8], w2[8], w3[8], bs[8];
        ld8f(cw + c0, w0); ld8f(cw + CONVD + c0, w1); ld8f(cw + 2 * CONVD + c0, w2); ld8f(cw + 3 * CONVD + c0, w3); ld8f(cb + c0, bs);
#pragma unroll
        for (int t = 0; t < 8; ++t) {
            float x[8]; unpack8(raw[3 + t], x);
            float o[8];
#pragma unroll
            for (int j = 0; j < 8; ++j) { const float v = bs[j] + w0[j] * p0[j] + w1[j] * p1[j] + w2[j] * p2[j] + w3[j] * x[j]; o[j] = v * sigmoid_f(v); }
            u32x4 w; w.x = pkbf(o[0], o[1]); w.y = pkbf(o[2], o[3]); w.z = pkbf(o[4], o[5]); w.w = pkbf(o[6], o[7]);
            *(u32x4*)(XC + (size_t)(R0 + t) * CONVD + c0) = w;
            if (last && t >= 5 && kind != 2) {
                float* dst = (kind == 0) ? outp + O_PCONV + ((size_t)(li * NPROMPT + b) * 3 + (t - 5)) * CONVD + c0 : outp + O_SCONV + ((size_t)(li * NSAMP + b) * 3 + (t - 5)) * CONVD + c0;
                *(f32x4*)(dst) = (f32x4){x[0], x[1], x[2], x[3]}; *(f32x4*)(dst + 4) = (f32x4){x[4], x[5], x[6], x[7]};
            }
#pragma unroll
            for (int j = 0; j < 8; ++j) { p0[j] = p1[j]; p1[j] = p2[j]; p2[j] = x[j]; }
        }
    }
}

__device__ __forceinline__ void ssd_acs(const float* DT, const float* alog, int R0, int len, int h0, float* s_dt, float* s_acs, int wave, int lane) {
    if (wave < 4) {
        const int r = wave; const float An = -__expf(alog[h0 + r]);
        const int l0 = 2 * lane;
        const float d0 = (l0 < len) ? DT[(size_t)(R0 + l0) * 32 + h0 + r] : 0.f;
        const float d1 = (l0 + 1 < len) ? DT[(size_t)(R0 + l0 + 1) * 32 + h0 + r] : 0.f;
        const float a0 = d0 * An, a1 = d1 * An, s = a0 + a1;
        float incl = s;
#pragma unroll
        for (int o = 1; o < 64; o <<= 1) { const float t = __shfl_up(incl, o); if (lane >= o) incl += t; }
        const float excl = incl - s;
        s_dt[r * 128 + l0] = d0; s_dt[r * 128 + l0 + 1] = d1;
        s_acs[r * 128 + l0] = excl + a0; s_acs[r * 128 + l0 + 1] = excl + s;
    }
}
#define TSW(ch) ((((ch) >> 3) & 7) << 3)
#define LFRAG(base, row, ld, ks) (*(const bf16x8*)((base) + (row) * (ld) + 32 * (ks) + 8 * fq))

__device__ __forceinline__ void ssd1_unit(ArgsP a, int li, unsigned char* lds, int slot, int g, int R0, int len, int, int, int) {
    const int tid = ltid(), lane = tid & 63, wave = __builtin_amdgcn_readfirstlane(tid >> 6);
    const bf16* __restrict__ XC = (const bf16*)(a->ws + WS_XC); const float* __restrict__ DT = (const float*)(a->ws + WS_DT);
    float* __restrict__ CS = (float*)(a->ws + WS_CS); float* __restrict__ CD = (float*)(a->ws + WS_CD);
    bf16* XsT = (bf16*)lds;
    bf16* BT = (bf16*)(lds + 256 * LDX * 2);
    float* s_dt = (float*)(lds + 384 * LDX * 2); float* s_acs = s_dt + 512;
    const int fr = lane & 15, fq = lane >> 4, h0 = g * 4;
    u32x4 x0[4], x1[4], b0[2], b1[2];
#pragma unroll
    for (int k = 0; k < 4; ++k) { const int item = tid + NTHREADS * k, cb = (item & 7) + 8 * ((item >> 5) & 3), tp = ((item >> 3) & 3) + 4 * (item >> 7), l = 2 * tp;
        x0[k] = (u32x4){0u, 0u, 0u, 0u}; x1[k] = x0[k];
        if (l < len) x0[k] = *(const u32x4*)(XC + (size_t)(R0 + l) * CONVD + g * 256 + cb * 8);
        if (l + 1 < len) x1[k] = *(const u32x4*)(XC + (size_t)(R0 + l + 1) * CONVD + g * 256 + cb * 8); }
#pragma unroll
    for (int k = 0; k < 2; ++k) { const int item = tid + NTHREADS * k, cb = (item & 7) + 8 * ((item >> 5) & 1), tp = ((item >> 3) & 3) + 4 * (item >> 6), l = 2 * tp;
        b0[k] = (u32x4){0u, 0u, 0u, 0u}; b1[k] = b0[k];
        if (l < len) b0[k] = *(const u32x4*)(XC + (size_t)(R0 + l) * CONVD + 2048 + g * 128 + cb * 8);
        if (l + 1 < len) b1[k] = *(const u32x4*)(XC + (size_t)(R0 + l + 1) * CONVD + 2048 + g * 128 + cb * 8); }
    ssd_acs(DT, a->in[I_ALOG] + li * NHEADS, R0, len, h0, s_dt, s_acs, wave, lane);
#pragma unroll
    for (int k = 0; k < 2; ++k) { const int item = tid + NTHREADS * k, cb = (item & 7) + 8 * ((item >> 5) & 1), tp = ((item >> 3) & 3) + 4 * (item >> 6), col = (2 * tp) ^ (8 * (cb & 7));
        const unsigned a0[4] = {b0[k].x, b0[k].y, b0[k].z, b0[k].w}, a1[4] = {b1[k].x, b1[k].y, b1[k].z, b1[k].w};
#pragma unroll
        for (int j = 0; j < 4; ++j) {
            *(unsigned*)(BT + (cb * 8 + 2 * j) * LDX + col) = (a0[j] & 0xffffu) | (a1[j] << 16);
            *(unsigned*)(BT + (cb * 8 + 2 * j + 1) * LDX + col) = (a0[j] >> 16) | (a1[j] & 0xffff0000u); } }
    __syncthreads();
#pragma unroll
    for (int k = 0; k < 4; ++k) {
        const int item = tid + NTHREADS * k, cb = (item & 7) + 8 * ((item >> 5) & 3), tp = ((item >> 3) & 3) + 4 * (item >> 7), l = 2 * tp, r = cb >> 3, col = l ^ (8 * (cb & 7));
        const float tot = s_acs[r * 128 + 127];
        const float w0 = __expf(tot - s_acs[r * 128 + l]) * s_dt[r * 128 + l], w1 = __expf(tot - s_acs[r * 128 + l + 1]) * s_dt[r * 128 + l + 1];
        float f0[8], f1[8]; unpack8(x0[k], f0); unpack8(x1[k], f1);
#pragma unroll
        for (int j = 0; j < 8; ++j) *(unsigned*)(XsT + (cb * 8 + j) * LDX + col) = pkbf(f0[j] * w0, f1[j] * w1);
    }
    __syncthreads();
    f32x4 acc[2][8];
#pragma unroll
    for (int mi = 0; mi < 2; ++mi)
#pragma unroll
        for (int ni = 0; ni < 8; ++ni) acc[mi][ni] = (f32x4){0.f, 0.f, 0.f, 0.f};
#pragma unroll
    for (int ks = 0; ks < 4; ++ks) {
        const int ra0 = 32 * wave + fr, ra1 = ra0 + 16;
        const bf16x8 a0 = *(const bf16x8*)(XsT + ra0 * LDX + ((32 * ks + 8 * fq) ^ TSW(ra0))), a1 = *(const bf16x8*)(XsT + ra1 * LDX + ((32 * ks + 8 * fq) ^ TSW(ra1)));
#pragma unroll
        for (int ni = 0; ni < 8; ++ni) { const int rb = 16 * ni + fr; const bf16x8 bb = *(const bf16x8*)(BT + rb * LDX + ((32 * ks + 8 * fq) ^ TSW(rb)));
            acc[0][ni] = MFMA16(bb, a0, acc[0][ni]); acc[1][ni] = MFMA16(bb, a1, acc[1][ni]); }
    }
#pragma unroll
    for (int mi = 0; mi < 2; ++mi) { const int hp = 32 * wave + 16 * mi + fr, r = hp >> 6, p = hp & 63;
        float* dst = CS + ((size_t)(slot * 32 + h0 + r) * 64 + p) * 128 + 4 * fq;
#pragma unroll
        for (int ni = 0; ni < 8; ++ni) *(f32x4*)(dst + 16 * ni) = acc[mi][ni]; }
    if (tid < 4) CD[slot * 32 + h0 + tid] = __expf(s_acs[tid * 128 + 127]);
    __syncthreads();
}

__device__ __forceinline__ void ssd_sample_unit(ArgsP a, int li, unsigned char* lds, int b, int g, int, int, int) {
    const int tid = ltid(), lane = tid & 63, wave = __builtin_amdgcn_readfirstlane(tid >> 6);
    const bf16* __restrict__ XC = (const bf16*)(a->ws + WS_XC); const bf16* __restrict__ ZX = (const bf16*)(a->ws + WS_ZX); const float* __restrict__ DT = (const float*)(a->ws + WS_DT); bf16* __restrict__ YN = (bf16*)(a->ws + WS_YN);
    float* sX = (float*)lds; float* sB = sX + 8 * 256; float* sC = sB + 8 * 128; float* sY = sC + 8 * 128; float* sDt = sY + 8 * 256;
    const int R0 = ROW_S + b * 8, h0 = g * 4;
    const int p = tid >> 3, nb = tid & 7;
    const float* __restrict__ sin_ = a->in[I_SSSM] + ((size_t)((li * NSAMP + b) * NHEADS + h0) * 64 + p) * 128 + 4 * nb;
    float* __restrict__ sout = a->out + O_SSSM + ((size_t)((li * NSAMP + b) * NHEADS + h0) * 64 + p) * 128 + 4 * nb;
    f32x4 st[4][4];
#pragma unroll
    for (int r = 0; r < 4; ++r)
#pragma unroll
        for (int kk = 0; kk < 4; ++kk) st[r][kk] = *(const f32x4*)(sin_ + (size_t)r * 8192 + 32 * kk);
    {
        const int t = tid >> 6, ck = tid & 63;
        const int col = (ck < 32) ? g * 256 + ck * 8 : (ck < 48) ? 2048 + g * 128 + (ck - 32) * 8 : 3072 + g * 128 + (ck - 48) * 8;
        float f[8]; unpack8(*(const u32x4*)(XC + (size_t)(R0 + t) * CONVD + col), f);
        float* dst = (ck < 32) ? sX + t * 256 + ck * 8 : (ck < 48) ? sB + t * 128 + (ck - 32) * 8 : sC + t * 128 + (ck - 48) * 8;
        *(f32x4*)dst = (f32x4){f[0], f[1], f[2], f[3]}; *(f32x4*)(dst + 4) = (f32x4){f[4], f[5], f[6], f[7]};
        if (tid < 32) sDt[tid] = DT[(size_t)(R0 + (tid >> 2)) * 32 + h0 + (tid & 3)];
    }
    __syncthreads();
    float An[4], Dk[4];
#pragma unroll
    for (int r = 0; r < 4; ++r) { An[r] = -__expf(a->in[I_ALOG][li * NHEADS + h0 + r]); Dk[r] = a->in[I_ADSKIP][li * NHEADS + h0 + r]; }
    float part[8][4];
#pragma unroll
    for (int t = 0; t < 8; ++t) {
        f32x4 bv[4], cv[4];
#pragma unroll
        for (int kk = 0; kk < 4; ++kk) { bv[kk] = *(const f32x4*)(sB + t * 128 + 32 * kk + 4 * nb); cv[kk] = *(const f32x4*)(sC + t * 128 + 32 * kk + 4 * nb); }
#pragma unroll
        for (int r = 0; r < 4; ++r) {
            const float dt = sDt[t * 4 + r], dA = __expf(dt * An[r]), xv = sX[t * 256 + r * 64 + p], coef = dt * xv;
            float pr = 0.f;
#pragma unroll
            for (int kk = 0; kk < 4; ++kk) { st[r][kk] = st[r][kk] * dA + bv[kk] * coef; pr += (cv[kk].x * st[r][kk].x + cv[kk].y * st[r][kk].y) + (cv[kk].z * st[r][kk].z + cv[kk].w * st[r][kk].w); }
            part[t][r] = pr;
        }
    }
#pragma unroll
    for (int r = 0; r < 4; ++r)
#pragma unroll
        for (int kk = 0; kk < 4; ++kk) *(f32x4*)(sout + (size_t)r * 8192 + 32 * kk) = st[r][kk];
#pragma unroll
    for (int t = 0; t < 8; ++t)
#pragma unroll
        for (int r = 0; r < 4; ++r) { float v = part[t][r]; v += __shfl_xor(v, 1); v += __shfl_xor(v, 2); v += __shfl_xor(v, 4); part[t][r] = v; }
    if (nb == 0) {
#pragma unroll
        for (int t = 0; t < 8; ++t)
#pragma unroll
            for (int r = 0; r < 4; ++r) sY[t * 256 + r * 64 + p] = part[t][r] + Dk[r] * sX[t * 256 + r * 64 + p];
    }
    __syncthreads();
    {
        const int t = wave, c4 = lane * 4; const size_t row = (size_t)(R0 + t);
        const f32x4 y = *(const f32x4*)(sY + t * 256 + c4);
        const u32x2 zz = *(const u32x2*)(ZX + row * ZXW + g * 256 + c4);
        const float z0 = bflo(zz.x), z1 = bfhi(zz.x), z2 = bflo(zz.y), z3 = bfhi(zz.y);
        const float g0 = y.x * z0 * sigmoid_f(z0), g1 = y.y * z1 * sigmoid_f(z1), g2 = y.z * z2 * sigmoid_f(z2), g3 = y.w * z3 * sigmoid_f(z3);
        const float ss = wave_sum((g0 * g0 + g1 * g1) + (g2 * g2 + g3 * g3));
        const float rs = rsqrtf(ss * (1.f / 256.f) + EPS);
        u32x2 o; o.x = pkbf(g0 * rs, g1 * rs); o.y = pkbf(g2 * rs, g3 * rs);
        *(u32x2*)(YN + row * DINNER + g * 256 + c4) = o;
    }
    __syncthreads();
}

__device__ __forceinline__ void phase_scan(ArgsP a, int li) {
    const float* __restrict__ CS = (const float*)(a->ws + WS_CS); const float* __restrict__ CD = (const float*)(a->ws + WS_CD); bf16* __restrict__ HSB = (bf16*)(a->ws + WS_HSB);
    const int gt = blockIdx.x * NTHREADS + ltid(), NT = gridDim.x * NTHREADS;
    for (int e = gt; e < 2 * 65536; e += NT) {
        const int b = e >> 16, rem = e & 65535, h = rem >> 11, pn4 = rem & 2047;
        f32x4 hc = *(const f32x4*)(CS + ((size_t)(128 * 32 + h) * 2048 + pn4) * 4);
#pragma unroll 8
        for (int c = 0; c < 64; ++c) { const int slot = b * 64 + c; const size_t o = ((size_t)(slot * 32 + h) * 2048 + pn4) * 4;
            const f32x4 s = *(const f32x4*)(CS + o); const float d = CD[slot * 32 + h];
            u32x2 w; w.x = pkbf(hc.x, hc.y); w.y = pkbf(hc.z, hc.w); *(u32x2*)(HSB + o) = w;
            hc = hc * d + s; }
        *(f32x4*)(a->out + O_PSSM + ((size_t)((li * NPROMPT + b) * NHEADS + h) * 2048 + pn4) * 4) = hc;
    }
}

__device__ __forceinline__ void ssd3_head(int r, int hb, const bf16* Cn, const bf16* BH, const bf16* Xt, const float* s_dt, const float* s_acs, const f32x4 (&cb)[8], f32x4 (&acc)[4],
                                          const bf16* __restrict__ XC, const bf16* __restrict__ ZX, size_t row, int g, float Dk, int l, int wave, int fr, int fq, float& ss) {
    u32x2 xx[4], zz[4];
#pragma unroll
    for (int ni = 0; ni < 4; ++ni) { const int ch = g * 256 + r * 64 + 16 * ni + 4 * fq; xx[ni] = *(const u32x2*)(XC + row * CONVD + ch); zz[ni] = *(const u32x2*)(ZX + row * ZXW + ch); }
    const float al = s_acs[r * 128 + l];
#pragma unroll
    for (int ni = 0; ni < 4; ++ni) acc[ni] = (f32x4){0.f, 0.f, 0.f, 0.f};
    const bf16* Hs = BH + hb * 64 * LDX;
#pragma unroll
    for (int ks = 0; ks < 4; ++ks) { const bf16x8 af = LFRAG(Cn, l, LDX, ks);
#pragma unroll
        for (int ni = 0; ni < 4; ++ni) { const bf16x8 bb = LFRAG(Hs, 16 * ni + fr, LDX, ks); acc[ni] = MFMA16(bb, af, acc[ni]); } }
    const float e = __expf(al);
#pragma unroll
    for (int ni = 0; ni < 4; ++ni) acc[ni] = acc[ni] * e;
#pragma unroll
    for (int ks = 0; ks < 4; ++ks) {
        unsigned mw[4];
#pragma unroll
        for (int hf = 0; hf < 2; ++hf) { const int ni = 2 * ks + hf, s0 = 16 * ni + 4 * fq;
            const f32x4 av = *(const f32x4*)(s_acs + r * 128 + s0), dv = *(const f32x4*)(s_dt + r * 128 + s0);
            float m[4];
#pragma unroll
            for (int j = 0; j < 4; ++j) m[j] = (s0 + j <= l) ? cb[ni][j] * __expf(al - av[j]) * dv[j] : 0.f;
            mw[2 * hf] = pkbf(m[0], m[1]); mw[2 * hf + 1] = pkbf(m[2], m[3]); }
        const u32x4 afu = (u32x4){mw[0], mw[1], mw[2], mw[3]};
        const bf16x8 af = __builtin_bit_cast(bf16x8, afu);
#pragma unroll
        for (int ni = 0; ni < 4; ++ni) { const int chl = r * 64 + 16 * ni + fr, sw = TSW(chl);
            const u32x2 b0 = *(const u32x2*)(Xt + chl * LDX + ((32 * ks + 4 * fq) ^ sw)), b1 = *(const u32x2*)(Xt + chl * LDX + ((32 * ks + 16 + 4 * fq) ^ sw));
            const u32x4 bu = (u32x4){b0.x, b0.y, b1.x, b1.y};
            acc[ni] = MFMA16(__builtin_bit_cast(bf16x8, bu), af, acc[ni]); }
    }
#pragma unroll
    for (int ni = 0; ni < 4; ++ni) {
        const float xv[4] = {bflo(xx[ni].x), bfhi(xx[ni].x), bflo(xx[ni].y), bfhi(xx[ni].y)}, zv[4] = {bflo(zz[ni].x), bfhi(zz[ni].x), bflo(zz[ni].y), bfhi(zz[ni].y)};
#pragma unroll
        for (int j = 0; j < 4; ++j) { const float q = (acc[ni][j] + Dk * xv[j]) * zv[j] * sigmoid_f(zv[j]); acc[ni][j] = q; ss += q * q; } }
}
__device__ __forceinline__ void ssd3_unit(ArgsP a, int li, unsigned char* lds, const bf16* __restrict__ hs, int g, int R0, int len, int, int, int) {
    const int tid = ltid(), lane = tid & 63, wave = __builtin_amdgcn_readfirstlane(tid >> 6);
    const bf16* __restrict__ XC = (const bf16*)(a->ws + WS_XC); const bf16* __restrict__ ZX = (const bf16*)(a->ws + WS_ZX); const float* __restrict__ DT = (const float*)(a->ws + WS_DT); bf16* __restrict__ YN = (bf16*)(a->ws + WS_YN);
    bf16* Cn = (bf16*)lds; bf16* BH = Cn + 128 * LDX; bf16* Xt = BH + 128 * LDX;
    float* s_dt = (float*)(Xt + 256 * LDX); float* s_acs = s_dt + 512;
    const int fr = lane & 15, fq = lane >> 4, h0 = g * 4;
    {
        u32x4 vc[4], vb[4], vx0[4], vx1[4];
#pragma unroll
        for (int k = 0; k < 4; ++k) { const int item = tid + NTHREADS * k, l = item >> 4, ch = item & 15;
            vc[k] = (u32x4){0u, 0u, 0u, 0u}; vb[k] = vc[k];
            if (l < len) { vc[k] = *(const u32x4*)(XC + (size_t)(R0 + l) * CONVD + 3072 + g * 128 + ch * 8); vb[k] = *(const u32x4*)(XC + (size_t)(R0 + l) * CONVD + 2048 + g * 128 + ch * 8); } }
        const int cbl = tid & 7, tp = tid >> 3, l0 = 2 * tp;
#pragma unroll
        for (int r = 0; r < 4; ++r) { vx0[r] = (u32x4){0u, 0u, 0u, 0u}; vx1[r] = vx0[r];
            if (l0 < len) vx0[r] = *(const u32x4*)(XC + (size_t)(R0 + l0) * CONVD + g * 256 + r * 64 + cbl * 8);
            if (l0 + 1 < len) vx1[r] = *(const u32x4*)(XC + (size_t)(R0 + l0 + 1) * CONVD + g * 256 + r * 64 + cbl * 8); }
        ssd_acs(DT, a->in[I_ALOG] + li * NHEADS, R0, len, h0, s_dt, s_acs, wave, lane);
#pragma unroll
        for (int k = 0; k < 4; ++k) { const int item = tid + NTHREADS * k, l = item >> 4, ch = item & 15; *(u32x4*)(Cn + l * LDX + ch * 8) = vc[k]; *(u32x4*)(BH + l * LDX + ch * 8) = vb[k]; }
#pragma unroll
        for (int r = 0; r < 4; ++r) { const unsigned a0[4] = {vx0[r].x, vx0[r].y, vx0[r].z, vx0[r].w}, a1[4] = {vx1[r].x, vx1[r].y, vx1[r].z, vx1[r].w};
            const int col = l0 ^ (8 * cbl);
#pragma unroll
            for (int j = 0; j < 4; ++j) {
                *(unsigned*)(Xt + (r * 64 + cbl * 8 + 2 * j) * LDX + col) = (a0[j] & 0xffffu) | (a1[j] << 16);
                *(unsigned*)(Xt + (r * 64 + cbl * 8 + 2 * j + 1) * LDX + col) = (a0[j] >> 16) | (a1[j] & 0xffff0000u); } }
    }
    __syncthreads();
    u32x2 hv[8];
#pragma unroll
    for (int k = 0; k < 8; ++k) { const int item = tid + NTHREADS * k; hv[k] = (u32x2){0u, 0u}; if (hs) hv[k] = *(const u32x2*)(hs + (size_t)item * 4); }
    const bool active = (16 * wave < len);
    f32x4 cb[8];
#pragma unroll
    for (int ni = 0; ni < 8; ++ni) cb[ni] = (f32x4){0.f, 0.f, 0.f, 0.f};
    if (active) {
#pragma unroll
    for (int ks = 0; ks < 4; ++ks) { const bf16x8 af = LFRAG(Cn, 16 * wave + fr, LDX, ks);
#pragma unroll
        for (int ni = 0; ni < 8; ++ni) { const bf16x8 bb = LFRAG(BH, 16 * ni + fr, LDX, ks); cb[ni] = MFMA16(bb, af, cb[ni]); } }
    }
    __syncthreads();
#pragma unroll
    for (int k = 0; k < 8; ++k) { const int item = tid + NTHREADS * k, hp = item >> 5, n4 = item & 31; *(u32x2*)(BH + hp * LDX + n4 * 4) = hv[k]; }
#pragma unroll
    for (int k = 0; k < 8; ++k) { const int item = tid + NTHREADS * k; hv[k] = (u32x2){0u, 0u}; if (hs) hv[k] = *(const u32x2*)(hs + (size_t)(2 * 8192) + (size_t)item * 4); }
    __syncthreads();
    const int l = 16 * wave + fr;
    const size_t row = (size_t)(R0 + ((l < len) ? l : 0));
    f32x4 y0[4], y1[4], y2[4], y3[4];
    float ss = 0.f;
    const float* dsk = a->in[I_ADSKIP] + li * NHEADS + h0;
    if (active) {
    ssd3_head(0, 0, Cn, BH, Xt, s_dt, s_acs, cb, y0, XC, ZX, row, g, dsk[0], l, wave, fr, fq, ss);
    asm volatile("" ::: "memory");
    ssd3_head(1, 1, Cn, BH, Xt, s_dt, s_acs, cb, y1, XC, ZX, row, g, dsk[1], l, wave, fr, fq, ss);
    }
    __syncthreads();
#pragma unroll
    for (int k = 0; k < 8; ++k) { const int item = tid + NTHREADS * k, hp = item >> 5, n4 = item & 31; *(u32x2*)(BH + hp * LDX + n4 * 4) = hv[k]; }
    __syncthreads();
    if (active) {
    ssd3_head(2, 0, Cn, BH, Xt, s_dt, s_acs, cb, y2, XC, ZX, row, g, dsk[2], l, wave, fr, fq, ss);
    asm volatile("" ::: "memory");
    ssd3_head(3, 1, Cn, BH, Xt, s_dt, s_acs, cb, y3, XC, ZX, row, g, dsk[3], l, wave, fr, fq, ss);
    ss += __shfl_xor(ss, 16); ss += __shfl_xor(ss, 32);
    }
    const float rs = rsqrtf(ss * (1.f / 256.f) + EPS);
    if (active && l < len) {
        bf16* yrow = YN + row * DINNER + g * 256 + 4 * fq;
#pragma unroll
        for (int ni = 0; ni < 4; ++ni) {
            u32x2 w;
            w.x = pkbf(y0[ni][0] * rs, y0[ni][1] * rs); w.y = pkbf(y0[ni][2] * rs, y0[ni][3] * rs); *(u32x2*)(yrow + 0 * 64 + 16 * ni) = w;
            w.x = pkbf(y1[ni][0] * rs, y1[ni][1] * rs); w.y = pkbf(y1[ni][2] * rs, y1[ni][3] * rs); *(u32x2*)(yrow + 1 * 64 + 16 * ni) = w;
            w.x = pkbf(y2[ni][0] * rs, y2[ni][1] * rs); w.y = pkbf(y2[ni][2] * rs, y2[ni][3] * rs); *(u32x2*)(yrow + 2 * 64 + 16 * ni) = w;
            w.x = pkbf(y3[ni][0] * rs, y3[ni][1] * rs); w.y = pkbf(y3[ni][2] * rs, y3[ni][3] * rs); *(u32x2*)(yrow + 3 * 64 + 16 * ni) = w;
        }
    }
    __syncthreads();
}
__device__ __forceinline__ void phase_ssd1(ArgsP a, int li, unsigned char* lds, int tid, int wave, int lane) {
    const int c = blockIdx.x;
#pragma unroll 1
    for (int k = 0; k < 8; ++k) {
        const int u = c + 256 * (k >> 1);
#ifndef PROBE_SSD1
#define PROBE_SSD1 0
#endif
        if (((k + c) & 1) == 0) { const int slot = u >> 3, g = u & 7;
#pragma unroll 1
            for (int rp = 0; rp < (PROBE_SSD1 == 1 ? 2 : 1); ++rp) ssd1_unit(a, li, lds, slot, g, (slot >> 6) * SEQ + (slot & 63) * 128, 128, tid, wave, lane); }
        else {
#pragma unroll 1
            for (int rp = 0; rp < (PROBE_SSD1 == 2 ? 2 : 1); ++rp) ssd_sample_unit(a, li, lds, u >> 3, u & 7, tid, wave, lane); }
    }
    if (c < 8) ssd1_unit(a, li, lds, 128, c, ROW_M, NMETA, tid, wave, lane);
    else if (c < 16) ssd3_unit(a, li, lds, nullptr, c - 8, ROW_M, NMETA, tid, wave, lane);
}
__device__ __forceinline__ void phase_ssd3(ArgsP a, int li, unsigned char* lds, int tid, int wave, int lane) {
    const bf16* HSB = (const bf16*)(a->ws + WS_HSB);
#pragma unroll 1
    for (int u = blockIdx.x; u < 1024; u += gridDim.x) { const int slot = u >> 3, g = u & 7; ssd3_unit(a, li, lds, HSB + (size_t)(slot * 32 + g * 4) * 8192, g, (slot >> 6) * SEQ + (slot & 63) * 128, 128, tid, wave, lane); }
}

constexpr int KS_LD = 72, VT_LD = 264, P_LD = 232, NKEYS = 208;
constexpr int VT1_LD = 232;
__device__ __forceinline__ void attn_prompt_unit_v1(ArgsP a, int lj, unsigned char* lds, int b, int kvh, int qb, int, int, int) {
    const int tid = ltid(), lane = tid & 63, wave = __builtin_amdgcn_readfirstlane(tid >> 6);
    const bf16* Q = (const bf16*)(a->ws + WS_Q); const bf16* KV = (const bf16*)(a->ws + WS_KV); bf16* AO = (bf16*)(a->ws + WS_AO);
    bf16* Ks = (bf16*)lds; bf16* Vt = Ks + NKEYS * KS_LD; bf16* Pw = Vt + 64 * VT1_LD + wave * 16 * VT1_LD;
    const int fr = lane & 15, fq = lane >> 4, t0 = qb * 64, Rb = b * SEQ;
    for (int it = tid; it < NKEYS * 8; it += NTHREADS) { const int key = it >> 3, ch = it & 7;
        int row; if (key < 16) row = ROW_M + key; else { int s = t0 - 128 + key - 16; if (s < 0) s = 0; row = Rb + s; }
        *(u32x4*)(Ks + key * KS_LD + ch * 8) = *(const u32x4*)(KV + (size_t)row * KVW + kvh * 64 + ch * 8); }
    for (int it = tid; it < (NKEYS / 2) * 8; it += NTHREADS) { const int dbl = it & 7, kp = it >> 3;
        int r0, r1; { const int k0 = 2 * kp, k1 = k0 + 1; int s0 = t0 - 128 + k0 - 16, s1 = t0 - 128 + k1 - 16; if (s0 < 0) s0 = 0; if (s1 < 0) s1 = 0; r0 = (k0 < 16) ? ROW_M + k0 : Rb + s0; r1 = (k1 < 16) ? ROW_M + k1 : Rb + s1; }
        const u32x4 v0 = *(const u32x4*)(KV + (size_t)r0 * KVW + 256 + kvh * 64 + dbl * 8), v1 = *(const u32x4*)(KV + (size_t)r1 * KVW + 256 + kvh * 64 + dbl * 8);
        const unsigned a0[4] = {v0.x, v0.y, v0.z, v0.w}, a1[4] = {v1.x, v1.y, v1.z, v1.w};
#pragma unroll
        for (int j = 0; j < 4; ++j) {
            *(unsigned*)(Vt + (dbl * 8 + 2 * j) * VT1_LD + 2 * kp) = (a0[j] & 0xffffu) | (a1[j] << 16);
            *(unsigned*)(Vt + (dbl * 8 + 2 * j + 1) * VT1_LD + 2 * kp) = (a0[j] >> 16) | (a1[j] & 0xffff0000u); } }
    { const int row = tid >> 3, c = NKEYS + 2 * (tid & 7); *(unsigned*)(Vt + row * VT1_LD + c) = 0u; }
    __syncthreads();
    const int r = wave >> 1, th = (wave & 1) * 32, qh = kvh * 4 + r;
    const float sink = a->in[I_SINKS][lj * NQ + qh];
#pragma unroll 1
    for (int blk = 0; blk < 2; ++blk) {
        const int tq0 = t0 + th + blk * 16, t = tq0 + fr;
        bf16x8 qa[2];
#pragma unroll
        for (int ks = 0; ks < 2; ++ks) qa[ks] = *(const bf16x8*)(Q + (size_t)(Rb + t) * DM + qh * 64 + 32 * ks + 8 * fq);
        f32x4 sc[13];
#pragma unroll
        for (int ni = 0; ni < 13; ++ni) sc[ni] = (f32x4){0.f, 0.f, 0.f, 0.f};
#pragma unroll
        for (int ni = 0; ni < 13; ++ni) {
            const bf16x8 b0 = *(const bf16x8*)(Ks + (16 * ni + fr) * KS_LD + 8 * fq), b1 = *(const bf16x8*)(Ks + (16 * ni + fr) * KS_LD + 32 + 8 * fq);
            sc[ni] = MFMA16(b0, qa[0], sc[ni]); sc[ni] = MFMA16(b1, qa[1], sc[ni]);
            if ((ni & 3) == 3) asm volatile("" ::: "memory"); }
        float mx = -INFINITY;
#pragma unroll
        for (int ni = 0; ni < 13; ++ni)
#pragma unroll
            for (int j = 0; j < 4; ++j) { const int key = 16 * ni + 4 * fq + j; bool vis = true;
                if (key >= 16) { const int s = t0 - 128 + key - 16; vis = (s >= 0) && (s <= t) && (s > t - 128); }
                const float v = vis ? sc[ni][j] * 0.125f : -INFINITY; sc[ni][j] = v; mx = fmaxf(mx, v); }
        mx = fmaxf(mx, __shfl_xor(mx, 16)); mx = fmaxf(mx, __shfl_xor(mx, 32)); mx = fmaxf(mx, sink);
        float sum = 0.f;
#pragma unroll
        for (int ni = 0; ni < 13; ++ni)
#pragma unroll
            for (int j = 0; j < 4; ++j) { const float p = __expf(sc[ni][j] - mx); sc[ni][j] = p; sum += p; }
        sum += __shfl_xor(sum, 16); sum += __shfl_xor(sum, 32); sum += __expf(sink - mx);
        const float inv = frcp(sum);
#pragma unroll
        for (int ni = 0; ni < 13; ++ni) { u32x2 w; w.x = pkbf(sc[ni][0] * inv, sc[ni][1] * inv); w.y = pkbf(sc[ni][2] * inv, sc[ni][3] * inv); *(u32x2*)(Pw + fr * VT1_LD + 16 * ni + 4 * fq) = w; }
        *(u32x2*)(Pw + fr * VT1_LD + NKEYS + 4 * fq) = (u32x2){0u, 0u};
        asm volatile("s_waitcnt lgkmcnt(0)" ::: "memory");
        f32x4 o[4];
#pragma unroll
        for (int ni = 0; ni < 4; ++ni) o[ni] = (f32x4){0.f, 0.f, 0.f, 0.f};
#pragma unroll
        for (int ks = 0; ks < 7; ++ks) { const bf16x8 af = *(const bf16x8*)(Pw + fr * VT1_LD + 32 * ks + 8 * fq);
#pragma unroll
            for (int ni = 0; ni < 4; ++ni) { const bf16x8 bb = *(const bf16x8*)(Vt + (16 * ni + fr) * VT1_LD + 32 * ks + 8 * fq); o[ni] = MFMA16(bb, af, o[ni]); }
            if (ks & 1) asm volatile("" ::: "memory"); }
#pragma unroll
        for (int ni = 0; ni < 4; ++ni) { u32x2 w; w.x = pkbf(o[ni][0], o[ni][1]); w.y = pkbf(o[ni][2], o[ni][3]); *(u32x2*)(AO + (size_t)(Rb + t) * DM + qh * 64 + 16 * ni + 4 * fq) = w; }
        asm volatile("s_waitcnt lgkmcnt(0)" ::: "memory");
    }
    __syncthreads();
}
__device__ __forceinline__ void attn_prompt_unit(ArgsP a, int lj, unsigned char* lds, int b, int kvh, int qb, int, int, int) {
    const int tid = ltid(), lane = tid & 63, wave = __builtin_amdgcn_readfirstlane(tid >> 6);
    const bf16* __restrict__ Q = (const bf16*)(a->ws + WS_Q); const bf16* __restrict__ KV = (const bf16*)(a->ws + WS_KV); bf16* __restrict__ AO = (bf16*)(a->ws + WS_AO);
    bf16* Ks = (bf16*)lds; bf16* Vt = Ks + NKEYS * KS_LD; bf16* Pw = Vt + 64 * VT_LD + wave * 16 * P_LD;
    const int fr = lane & 15, fq = lane >> 4, t0 = qb * 64, Rb = b * SEQ;
    const int r = wave >> 1, th = (wave & 1) * 32, qh = kvh * 4 + r;
    bf16x8 qa[2][2];
#pragma unroll
    for (int blk = 0; blk < 2; ++blk)
#pragma unroll
        for (int ks = 0; ks < 2; ++ks) qa[blk][ks] = *(const bf16x8*)(Q + (size_t)(Rb + t0 + th + blk * 16 + fr) * DM + qh * 64 + 32 * ks + 8 * fq);
    {
        u32x4 kv[4];
#pragma unroll
        for (int k = 0; k < 4; ++k) { const int it = tid + NTHREADS * k, key = it >> 3, ch = it & 7; kv[k] = (u32x4){0u, 0u, 0u, 0u};
            if (it < NKEYS * 8) { int row; if (key < 16) row = ROW_M + key; else { int s = t0 - 128 + key - 16; if (s < 0) s = 0; row = Rb + s; }
                kv[k] = *(const u32x4*)(KV + (size_t)row * KVW + kvh * 64 + ch * 8); } }
        u32x4 v0[2], v1[2];
#pragma unroll
        for (int k = 0; k < 2; ++k) { const int it = tid + NTHREADS * k, dbl = it & 7, kp = it >> 3; v0[k] = (u32x4){0u, 0u, 0u, 0u}; v1[k] = v0[k];
            if (it < (NKEYS / 2) * 8) { const int k0 = 2 * kp, k1 = k0 + 1; int s0 = t0 - 128 + k0 - 16, s1 = t0 - 128 + k1 - 16; if (s0 < 0) s0 = 0; if (s1 < 0) s1 = 0;
                const int r0 = (k0 < 16) ? ROW_M + k0 : Rb + s0, r1 = (k1 < 16) ? ROW_M + k1 : Rb + s1;
                v0[k] = *(const u32x4*)(KV + (size_t)r0 * KVW + 256 + kvh * 64 + dbl * 8); v1[k] = *(const u32x4*)(KV + (size_t)r1 * KVW + 256 + kvh * 64 + dbl * 8); } }
#pragma unroll
        for (int k = 0; k < 4; ++k) { const int it = tid + NTHREADS * k, key = it >> 3, ch = it & 7; if (it < NKEYS * 8) *(u32x4*)(Ks + key * KS_LD + ch * 8) = kv[k]; }
#pragma unroll
        for (int k = 0; k < 2; ++k) { const int it = tid + NTHREADS * k, dbl = it & 7, kp = it >> 3;
            if (it < (NKEYS / 2) * 8) { const int col = (2 * kp) ^ (8 * dbl);
                const unsigned a0[4] = {v0[k].x, v0[k].y, v0[k].z, v0[k].w}, a1[4] = {v1[k].x, v1[k].y, v1[k].z, v1[k].w};
#pragma unroll
                for (int j = 0; j < 4; ++j) {
                    *(unsigned*)(Vt + (dbl * 8 + 2 * j) * VT_LD + col) = (a0[j] & 0xffffu) | (a1[j] << 16);
                    *(unsigned*)(Vt + (dbl * 8 + 2 * j + 1) * VT_LD + col) = (a0[j] >> 16) | (a1[j] & 0xffff0000u); } } }
#pragma unroll
        for (int k = 0; k < 3; ++k) { const int idx = tid + NTHREADS * k, row = idx / 24, c = idx - row * 24; *(unsigned*)(Vt + row * VT_LD + ((NKEYS + 2 * c) ^ TSW(row))) = 0u; }
    }
    __syncthreads();
    const float sink = a->in[I_SINKS][lj * NQ + qh];
#pragma unroll
    for (int blk = 0; blk < 2; ++blk) {
        const int tq = th + blk * 16 + fr, t = t0 + tq;
        f32x4 sc[13];
#pragma unroll
        for (int ni = 0; ni < 13; ++ni) sc[ni] = (f32x4){0.f, 0.f, 0.f, 0.f};
#pragma unroll
        for (int ni = 0; ni < 13; ++ni) {
            const bf16x8 b0 = *(const bf16x8*)(Ks + (16 * ni + fr) * KS_LD + 8 * fq), b1 = *(const bf16x8*)(Ks + (16 * ni + fr) * KS_LD + 32 + 8 * fq);
            sc[ni] = MFMA16(b0, qa[blk][0], sc[ni]); sc[ni] = MFMA16(b1, qa[blk][1], sc[ni]);
            if ((ni & 3) == 3) asm volatile("" ::: "memory"); }
        int lo = tq + 17; { const int l2 = 144 - t0; if (l2 > lo) lo = l2; }
        const unsigned span = (unsigned)(tq + 144 - lo);
        float mx = -INFINITY;
#pragma unroll
        for (int ni = 0; ni < 13; ++ni)
#pragma unroll
            for (int j = 0; j < 4; ++j) { const int key = 16 * ni + 4 * fq + j; const bool vis = (ni == 0) || ((unsigned)(key - lo) <= span);
                const float v = vis ? sc[ni][j] * 0.125f : -INFINITY; sc[ni][j] = v; mx = fmaxf(mx, v); }
        mx = fmaxf(mx, __shfl_xor(mx, 16)); mx = fmaxf(mx, __shfl_xor(mx, 32)); mx = fmaxf(mx, sink);
        float sum = 0.f;
#pragma unroll
        for (int ni = 0; ni < 13; ++ni)
#pragma unroll
            for (int j = 0; j < 4; ++j) { const float p = __expf(sc[ni][j] - mx); sc[ni][j] = p; sum += p; }
        sum += __shfl_xor(sum, 16); sum += __shfl_xor(sum, 32); sum += __expf(sink - mx);
        const float inv = frcp(sum);
#pragma unroll
        for (int ni = 0; ni < 13; ++ni) { u32x2 w; w.x = pkbf(sc[ni][0] * inv, sc[ni][1] * inv); w.y = pkbf(sc[ni][2] * inv, sc[ni][3] * inv); *(u32x2*)(Pw + fr * P_LD + 16 * ni + 4 * fq) = w; }
        *(u32x2*)(Pw + fr * P_LD + NKEYS + 4 * fq) = (u32x2){0u, 0u};
        asm volatile("s_waitcnt lgkmcnt(0)" ::: "memory");
        f32x4 o[4];
#pragma unroll
        for (int ni = 0; ni < 4; ++ni) o[ni] = (f32x4){0.f, 0.f, 0.f, 0.f};
#pragma unroll
        for (int ks = 0; ks < 7; ++ks) { const bf16x8 af = *(const bf16x8*)(Pw + fr * P_LD + 32 * ks + 8 * fq);
#pragma unroll
            for (int ni = 0; ni < 4; ++ni) { const int vr = 16 * ni + fr; const bf16x8 bb = *(const bf16x8*)(Vt + vr * VT_LD + ((32 * ks + 8 * fq) ^ TSW(vr))); o[ni] = MFMA16(bb, af, o[ni]); }
            if (ks & 1) asm volatile("" ::: "memory"); }
#pragma unroll
        for (int ni = 0; ni < 4; ++ni) { u32x2 w; w.x = pkbf(o[ni][0], o[ni][1]); w.y = pkbf(o[ni][2], o[ni][3]); *(u32x2*)(AO + (size_t)(Rb + t) * DM + qh * 64 + 16 * ni + 4 * fq) = w; }
        asm volatile("s_waitcnt lgkmcnt(0)" ::: "memory");
    }
    __syncthreads();
}
constexpr int SK_LD = 72, SV_LD = 200, SP_LD = 168, SKEYS = 160;
__device__ __forceinline__ void attn_sample_pair(ArgsP a, int lj, unsigned char* lds, int bp, int kvh, int, int, int) {
    const int tid = ltid(), lane = tid & 63, wave = __builtin_amdgcn_readfirstlane(tid >> 6);
    const bf16* __restrict__ Q = (const bf16*)(a->ws + WS_Q); const bf16* __restrict__ KV = (const bf16*)(a->ws + WS_KV); bf16* __restrict__ AO = (bf16*)(a->ws + WS_AO);
    const float* __restrict__ CK = a->in[I_CK]; const float* __restrict__ CV = a->in[I_CV];
    constexpr int HALF_B = (SKEYS * SK_LD + 64 * SV_LD) * 2;
    const int fr = lane & 15, fq = lane >> 4;
#pragma unroll 1
    for (int it = tid; it < 2 * SKEYS * 8; it += NTHREADS) { const int hf = it / (SKEYS * 8), rem = it - hf * (SKEYS * 8), key = rem >> 3, ch = rem & 7, bb = 2 * bp + hf;
        bf16* Ks = (bf16*)(lds + hf * HALF_B);
        u32x4 w = (u32x4){0u, 0u, 0u, 0u};
        if (key < 16) w = *(const u32x4*)(KV + (size_t)(ROW_M + key) * KVW + kvh * 64 + ch * 8);
        else if (key < 144) { const float* p = CK + ((size_t)(bb * 128 + (key - 16)) * NKV + kvh) * 64 + ch * 8; const f32x4 x0 = *(const f32x4*)p, x1 = *(const f32x4*)(p + 4);
            w.x = pkbf(x0.x, x0.y); w.y = pkbf(x0.z, x0.w); w.z = pkbf(x1.x, x1.y); w.w = pkbf(x1.z, x1.w); }
        else if (key < 152) w = *(const u32x4*)(KV + (size_t)(ROW_S + bb * 8 + (key - 144)) * KVW + kvh * 64 + ch * 8);
        *(u32x4*)(Ks + key * SK_LD + ch * 8) = w; }
#pragma unroll 1
    for (int it = tid; it < 2 * 96 * 8; it += NTHREADS) { const int hf = it / (96 * 8), rem = it - hf * (96 * 8), dbl = rem & 7, kp = rem >> 3, bb = 2 * bp + hf;
        bf16* Vt = (bf16*)(lds + hf * HALF_B) + SKEYS * SK_LD;
        unsigned a0[4] = {0u, 0u, 0u, 0u}, a1[4] = {0u, 0u, 0u, 0u};
        const int k0 = 2 * kp;
        if (k0 < 16) { const u32x4 x = *(const u32x4*)(KV + (size_t)(ROW_M + k0) * KVW + 256 + kvh * 64 + dbl * 8), y = *(const u32x4*)(KV + (size_t)(ROW_M + k0 + 1) * KVW + 256 + kvh * 64 + dbl * 8);
            a0[0] = x.x; a0[1] = x.y; a0[2] = x.z; a0[3] = x.w; a1[0] = y.x; a1[1] = y.y; a1[2] = y.z; a1[3] = y.w; }
        else if (k0 < 144) { const float* p = CV + ((size_t)(bb * 128 + (k0 - 16)) * NKV + kvh) * 64 + dbl * 8; const f32x4 x0 = *(const f32x4*)p, x1 = *(const f32x4*)(p + 4), y0 = *(const f32x4*)(p + NKV * 64), y1 = *(const f32x4*)(p + NKV * 64 + 4);
            a0[0] = pkbf(x0.x, x0.y); a0[1] = pkbf(x0.z, x0.w); a0[2] = pkbf(x1.x, x1.y); a0[3] = pkbf(x1.z, x1.w); a1[0] = pkbf(y0.x, y0.y); a1[1] = pkbf(y0.z, y0.w); a1[2] = pkbf(y1.x, y1.y); a1[3] = pkbf(y1.z, y1.w); }
        else if (k0 < 152) { const u32x4 x = *(const u32x4*)(KV + (size_t)(ROW_S + bb * 8 + (k0 - 144)) * KVW + 256 + kvh * 64 + dbl * 8), y = *(const u32x4*)(KV + (size_t)(ROW_S + bb * 8 + (k0 - 143)) * KVW + 256 + kvh * 64 + dbl * 8);
            a0[0] = x.x; a0[1] = x.y; a0[2] = x.z; a0[3] = x.w; a1[0] = y.x; a1[1] = y.y; a1[2] = y.z; a1[3] = y.w; }
        const int col = (2 * kp) ^ (8 * dbl);
#pragma unroll
        for (int j = 0; j < 4; ++j) {
            *(unsigned*)(Vt + (dbl * 8 + 2 * j) * SV_LD + col) = (a0[j] & 0xffffu) | (a1[j] << 16);
            *(unsigned*)(Vt + (dbl * 8 + 2 * j + 1) * SV_LD + col) = (a0[j] >> 16) | (a1[j] & 0xffff0000u); } }
    if (lj == 0) {
#pragma unroll 1
        for (int it = tid; it < 2 * 128 * 16; it += NTHREADS) { const int hf = it >> 11, rem = it & 2047, w = rem >> 4, c4 = (rem & 15) * 4, bb = 2 * bp + hf;
            const size_t o = ((size_t)(bb * 128 + w) * NKV + kvh) * 64 + c4;
            f32x4 kx, vx;
            if (w < 120) { const size_t i = ((size_t)(bb * 128 + w + 8) * NKV + kvh) * 64 + c4; kx = *(const f32x4*)(CK + i); vx = *(const f32x4*)(CV + i); }
            else { const bf16* rp = KV + (size_t)(ROW_S + bb * 8 + (w - 120)) * KVW + kvh * 64 + c4; const u32x2 k2 = *(const u32x2*)rp, v2 = *(const u32x2*)(rp + 256);
                kx = (f32x4){bflo(k2.x), bfhi(k2.x), bflo(k2.y), bfhi(k2.y)}; vx = (f32x4){bflo(v2.x), bfhi(v2.x), bflo(v2.y), bfhi(v2.y)}; }
            *(f32x4*)(a->out + O_SCK + o) = kx; *(f32x4*)(a->out + O_SCV + o) = vx; }
    }
    __syncthreads();
    if (wave < 4) {
        const int hf = wave >> 1, rb = wave & 1, bb = 2 * bp + hf;
        const bf16* Ks = (const bf16*)(lds + hf * HALF_B); const bf16* Vt = Ks + SKEYS * SK_LD; bf16* Pw = (bf16*)(lds + 2 * HALF_B) + wave * 16 * SP_LD;
        const int r = 2 * rb + (fr >> 3), t = fr & 7, qh = kvh * 4 + r;
        const size_t qrow = (size_t)(ROW_S + bb * 8 + t);
        bf16x8 qa[2];
#pragma unroll
        for (int ks = 0; ks < 2; ++ks) qa[ks] = *(const bf16x8*)(Q + qrow * DM + qh * 64 + 32 * ks + 8 * fq);
        const float sink = a->in[I_SINKS][lj * NQ + qh];
        f32x4 sc[10];
#pragma unroll
        for (int ni = 0; ni < 10; ++ni) sc[ni] = (f32x4){0.f, 0.f, 0.f, 0.f};
#pragma unroll
        for (int ni = 0; ni < 10; ++ni) {
            const bf16x8 b0 = *(const bf16x8*)(Ks + (16 * ni + fr) * SK_LD + 8 * fq), b1 = *(const bf16x8*)(Ks + (16 * ni + fr) * SK_LD + 32 + 8 * fq);
            sc[ni] = MFMA16(b0, qa[0], sc[ni]); sc[ni] = MFMA16(b1, qa[1], sc[ni]); }
        float mx = -INFINITY;
#pragma unroll
        for (int ni = 0; ni < 10; ++ni)
#pragma unroll
            for (int j = 0; j < 4; ++j) { const int key = 16 * ni + 4 * fq + j;
                const bool vis = (ni == 0) || ((key < 144) ? (key - 16 > t) : (key - 144 <= t));
                const float v = vis ? sc[ni][j] * 0.125f : -INFINITY; sc[ni][j] = v; mx = fmaxf(mx, v); }
        mx = fmaxf(mx, __shfl_xor(mx, 16)); mx = fmaxf(mx, __shfl_xor(mx, 32)); mx = fmaxf(mx, sink);
        float sum = 0.f;
#pragma unroll
        for (int ni = 0; ni < 10; ++ni)
#pragma unroll
            for (int j = 0; j < 4; ++j) { const float p = __expf(sc[ni][j] - mx); sc[ni][j] = p; sum += p; }
        sum += __shfl_xor(sum, 16); sum += __shfl_xor(sum, 32); sum += __expf(sink - mx);
        const float inv = frcp(sum);
#pragma unroll
        for (int ni = 0; ni < 10; ++ni) { u32x2 w; w.x = pkbf(sc[ni][0] * inv, sc[ni][1] * inv); w.y = pkbf(sc[ni][2] * inv, sc[ni][3] * inv); *(u32x2*)(Pw + fr * SP_LD + 16 * ni + 4 * fq) = w; }
        asm volatile("s_waitcnt lgkmcnt(0)" ::: "memory");
        f32x4 o[4];
#pragma unroll
        for (int ni = 0; ni < 4; ++ni) o[ni] = (f32x4){0.f, 0.f, 0.f, 0.f};
#pragma unroll
        for (int ks = 0; ks < 5; ++ks) { const bf16x8 af = *(const bf16x8*)(Pw + fr * SP_LD + 32 * ks + 8 * fq);
#pragma unroll
            for (int ni = 0; ni < 4; ++ni) { const int vr = 16 * ni + fr; const bf16x8 bb2 = *(const bf16x8*)(Vt + vr * SV_LD + ((32 * ks + 8 * fq) ^ TSW(vr))); o[ni] = MFMA16(bb2, af, o[ni]); } }
#pragma unroll
        for (int ni = 0; ni < 4; ++ni) { u32x2 w; w.x = pkbf(o[ni][0], o[ni][1]); w.y = pkbf(o[ni][2], o[ni][3]); *(u32x2*)(AO + qrow * DM + qh * 64 + 16 * ni + 4 * fq) = w; }
    }
    __syncthreads();
}
__device__ __forceinline__ void attn_sample_unit(ArgsP a, int lj, unsigned char* lds, int b, int kvh, int, int, int) {
    const int tid = ltid(), lane = tid & 63, wave = __builtin_amdgcn_readfirstlane(tid >> 6);
    const bf16* Q = (const bf16*)(a->ws + WS_Q); const bf16* KV = (const bf16*)(a->ws + WS_KV); bf16* AO = (bf16*)(a->ws + WS_AO);
    float* Kf = (float*)lds; float* Vf = Kf + 152 * 65; float* Qf = Vf + 152 * 64; float* Sc = Qf + 32 * 64;
    for (int idx = tid; idx < 152 * 64; idx += NTHREADS) { const int s = idx >> 6, d = idx & 63; float kv, vv;
        if (s < 16) { const bf16* rowp = KV + (size_t)(ROW_M + s) * KVW + kvh * 64 + d; kv = bf2f(rowp[0]); vv = bf2f(rowp[256]); }
        else if (s < 144) { const size_t o = ((size_t)(b * 128 + (s - 16)) * NKV + kvh) * 64 + d; kv = a->in[I_CK][o]; vv = a->in[I_CV][o]; }
        else { const bf16* rowp = KV + (size_t)(ROW_S + b * 8 + (s - 144)) * KVW + kvh * 64 + d; kv = bf2f(rowp[0]); vv = bf2f(rowp[256]); }
        Kf[s * 65 + d] = kv; Vf[s * 64 + d] = vv; }
    for (int idx = tid; idx < 32 * 64; idx += NTHREADS) { const int qi = idx >> 6, d = idx & 63, r = qi >> 3, t = qi & 7;
        Qf[qi * 64 + d] = bf2f(Q[(size_t)(ROW_S + b * 8 + t) * DM + (kvh * 4 + r) * 64 + d]); }
    __syncthreads();
    if (lj == 0) {
        for (int idx = tid; idx < 128 * 64; idx += NTHREADS) { const int w = idx >> 6, d = idx & 63; const size_t o = ((size_t)(b * 128 + w) * NKV + kvh) * 64 + d;
            a->out[O_SCK + o] = Kf[(24 + w) * 65 + d]; a->out[O_SCV + o] = Vf[(24 + w) * 64 + d]; }
    }
    for (int idx = tid; idx < 32 * 152; idx += NTHREADS) { const int qi = idx / 152, s = idx - qi * 152, t = qi & 7;
        float dot = 0.f;
#pragma unroll 16
        for (int d = 0; d < 64; ++d) dot += Qf[qi * 64 + d] * Kf[s * 65 + d];
        const bool vis = (s < 16) || ((s < 144) ? ((s - 16) > t) : ((s - 144) <= t));
        Sc[qi * 153 + s] = vis ? dot * 0.125f : -INFINITY; }
    __syncthreads();
#pragma unroll 1
    for (int q = 0; q < 4; ++q) { const int qi = wave * 4 + q, r = qi >> 3; const float sink = a->in[I_SINKS][lj * NQ + kvh * 4 + r];
        float v0 = Sc[qi * 153 + lane], v1 = Sc[qi * 153 + 64 + lane], v2 = (lane < 24) ? Sc[qi * 153 + 128 + lane] : -INFINITY;
        float mx = fmaxf(fmaxf(v0, v1), v2);
#pragma unroll
        for (int o = 1; o < 64; o <<= 1) mx = fmaxf(mx, __shfl_xor(mx, o));
        mx = fmaxf(mx, sink);
        v0 = __expf(v0 - mx); v1 = __expf(v1 - mx); v2 = __expf(v2 - mx);
        const float sum = wave_sum(v0 + v1 + v2) + __expf(sink - mx), inv = frcp(sum);
        Sc[qi * 153 + lane] = v0 * inv; Sc[qi * 153 + 64 + lane] = v1 * inv; if (lane < 24) Sc[qi * 153 + 128 + lane] = v2 * inv; }
    __syncthreads();
    { const int qi = tid >> 4, d4 = (tid & 15) * 4, r = qi >> 3, t = qi & 7; f32x4 o = (f32x4){0.f, 0.f, 0.f, 0.f};
#pragma unroll 8
        for (int s = 0; s < 152; ++s) { const float p = Sc[qi * 153 + s]; const f32x4 v = *(const f32x4*)(Vf + s * 64 + d4); o = o + v * p; }
        u32x2 w; w.x = pkbf(o.x, o.y); w.y = pkbf(o.z, o.w);
        *(u32x2*)(AO + (size_t)(ROW_S + b * 8 + t) * DM + (kvh * 4 + r) * 64 + d4) = w; }
    __syncthreads();
}
__device__ __forceinline__ void phase_attn(ArgsP a, int lj, unsigned char* lds, int tid, int wave, int lane) {
    if (lj == 0) {
        const bf16* KV = (const bf16*)(a->ws + WS_KV);
        const int gt = blockIdx.x * NTHREADS + tid, NT = gridDim.x * NTHREADS;
        for (int e = gt; e < 2 * 128 * 512; e += NT) { const int b = e >> 16, w = (e >> 9) & 127, c = e & 511;
            const float v = bf2f(KV[(size_t)(b * SEQ + SEQ - 128 + w) * KVW + c]);
            if (c < 256) a->out[O_PCK + (size_t)(b * 128 + w) * 256 + c] = v; else a->out[O_PCV + (size_t)(b * 128 + w) * 256 + (c - 256)] = v; }
    }
#pragma unroll 1
#ifndef OLD_SAMPLE_ATTN
#define OLD_SAMPLE_ATTN 0
#endif
#if OLD_SAMPLE_ATTN
    for (int u = blockIdx.x; u < 1024 + 512; u += gridDim.x) {
        if (u < 1024) { const int qb = u & 127, kvh = (u >> 7) & 3, b = u >> 9; attn_prompt_unit(a, lj, lds, b, kvh, qb, tid, wave, lane); }
        else { const int su = u - 1024; attn_sample_unit(a, lj, lds, su >> 2, su & 3, tid, wave, lane); }
    }
#else
#ifndef OLD_PROMPT_ATTN
#define OLD_PROMPT_ATTN 0
#endif
    for (int u = blockIdx.x; u < 1024 + 256; u += gridDim.x) {
        if (u < 1024) { const int qb = u & 127, kvh = (u >> 7) & 3, b = u >> 9;
            if (OLD_PROMPT_ATTN) attn_prompt_unit_v1(a, lj, lds, b, kvh, qb, tid, wave, lane); else attn_prompt_unit(a, lj, lds, b, kvh, qb, tid, wave, lane); }
        else { const int su = u - 1024; attn_sample_pair(a, lj, lds, su >> 2, su & 3, tid, wave, lane); }
    }
#endif
}

constexpr int NPHASES = 36;
template <class Epi> __device__ __forceinline__ void run_gemm(LAS unsigned char* lds, const bf16* A, const bf16* Bt, int N, int K, const Epi& E) {
    pg8::Gemm g{A, Bt, MP, N, K}; pg8::StaticOrder S; S.init(MP, N, K, (int)gridDim.x, (int)blockIdx.x);
    pg8::gemm_phase<Epi, pg8::StaticOrder, true, true>(lds, g, S, E);
}
template <class Epi> __device__ __forceinline__ void run_gemm_res(LAS unsigned char* lds, const bf16* A, const bf16* Bt, int K, int S_, const Epi& E) {
    pg8::Gemm g{A, Bt, MP, 1024, K}; pg8::ResOrder S; S.init(K, S_, (int)gridDim.x, (int)blockIdx.x);
    pg8::gemm_phase<Epi, pg8::ResOrder, true, true>(lds, g, S, E);
}

__global__ void __launch_bounds__(NTHREADS, 2) yoco_fwd(Args args) {
    extern __shared__ __attribute__((aligned(16))) unsigned char lds[];
    LAS unsigned char* ldsl = (LAS unsigned char*)lds;
    const int tid0 = threadIdx.x;
    for (int u = tid0; u < (LDS_BYTES - LDSCTL_OFF) / 4; u += NTHREADS) ((LAS unsigned*)(ldsl + LDSCTL_OFF))[u] = 0u;
    __syncthreads();
    const int lo = args.ph_lo, hi = args.ph_hi;
    XcdBarrier bar; bar.bar = (unsigned*)(args.ws + WS_CTL) + CW_BAR; bar.x = 0; bar.st = nullptr;
    if (hi - lo > 1) bar = xcd_barrier_post((unsigned*)(args.ws + WS_CTL) + CW_BAR, (volatile LAS unsigned*)(ldsl + MISC_OFF) + 8);
    int rep = 0;
#pragma unroll 1
    for (int p = lo; p < hi;) {
        ArgsP la = (ArgsP)__builtin_amdgcn_kernarg_segment_ptr(); asm volatile("" : "+s"(la));
        unsigned char* ws = la->ws;
        const int tid = ltid();
        const int lane = tid & 63, wave = __builtin_amdgcn_readfirstlane(tid >> 6);
        bf16* HN = (bf16*)(ws + WS_HN); float* H = (float*)(ws + WS_H);
        int kind, li = 0, lj = 0, layer = 0;
        if (p == 0) kind = 0;
        else if (p < 21) { li = (p - 1) / 10; layer = li; const int sub = (p - 1) % 10;
            kind = (sub == 0) ? (li == 0 ? 2 : 1) : (sub == 1) ? 3 : (sub == 2) ? 4 : (sub == 3) ? 5 : (sub == 4) ? 6 : (sub == 5) ? 7 : (sub == 6) ? 8 : (sub == 7) ? 1 : (sub == 8) ? 9 : 10; }
        else if (p < 35) { lj = (p - 21) / 7; layer = 2 + lj; const int sub = (p - 21) % 7;
            kind = (sub == 0) ? 1 : (sub == 1) ? 11 : (sub == 2) ? 12 : (sub == 3) ? 13 : (sub == 4) ? 1 : (sub == 5) ? 9 : 10; }
        else kind = 14;
#ifndef KMASK
#define KMASK 0xffff
#endif
#define KON(k) ((KMASK >> (k)) & 1)
#ifndef REP_MASK
#define REP_MASK 0
#endif
        if (KON(0) && kind == 0) phase_prologue(la, ldsl, wave, lane);
        else if (KON(1) && kind == 1) { const int sub = (p < 21) ? (p - 1) % 10 : (p - 21) % 7; phase_norm(la, 0, (p >= 21 && sub == 4) ? 4 : 8, wave, lane); }
        else if (KON(1) && kind == 2) phase_norm(la, 1, 0, wave, lane);
        else if (KON(3) && kind == 3) { pg8::EpiInProj E{(bf16*)(ws + WS_ZX), (float*)(ws + WS_DT), la->in[I_ADTB] + li * NHEADS}; run_gemm(ldsl, HN, (const bf16*)(ws + WS_WIN + li * SZ_WIN), INPROJ_P, 1024, E); }
        else if (KON(4) && kind == 4) phase_conv(la, li);
        else if (KON(5) && kind == 5) phase_ssd1(la, li, lds, tid, wave, lane);
        else if (KON(6) && kind == 6) phase_scan(la, li);
        else if (KON(7) && kind == 7) phase_ssd3(la, li, lds, tid, wave, lane);
        else if (KON(8) && (kind == 8 || kind == 10 || kind == 13)) {
            const bf16* A; const bf16* Bt; int K;
            if (kind == 8) { A = (const bf16*)(ws + WS_YN); Bt = (const bf16*)(ws + WS_WOUT + li * SZ_WOUT); K = 2048; }
            else if (kind == 10) { A = (const bf16*)(ws + WS_U); Bt = (const bf16*)(ws + WS_WDN + layer * SZ_WDN); K = 4096; }
            else { A = (const bf16*)(ws + WS_AO); Bt = (const bf16*)(ws + WS_WO + lj * SZ_WO); K = 1024; }
            pg8::EpiRes E{H, (float*)(ws + WS_SLAB)}; run_gemm_res(ldsl, A, Bt, K, K == 1024 ? 4 : 8, E); }
        else if (KON(9) && kind == 9) { pg8::EpiBf<1> E{(bf16*)(ws + WS_U), 4096, 1 << 20, nullptr, 0}; run_gemm(ldsl, HN, (const bf16*)(ws + WS_WUP + layer * SZ_WUP), 4096, 1024, E); }
        else if (KON(11) && kind == 11) { pg8::EpiBf<0> E{(bf16*)(ws + WS_Q), 1024, 4, (bf16*)(ws + WS_KV), KVW};
            run_gemm(ldsl, HN, (const bf16*)(ws + (lj == 0 ? WS_WQKV0 : WS_WQ1)), lj == 0 ? 1536 : 1024, 1024, E); }
        else if (KON(12) && kind == 12) phase_attn(la, lj, lds, tid, wave, lane);
        else if (KON(14) && kind == 14) phase_final(la, wave, lane);
        bool again = false;
        if (REP_MASK != 0) { if (rep == 0 && ((REP_MASK >> kind) & 1)) { rep = 1; again = true; } else rep = 0; }
        if (p + 1 < hi || again) xcd_barrier(bar); else { asm volatile("s_waitcnt vmcnt(0)" ::: "memory"); __syncthreads(); }
        if (!again) ++p;
    }
}

#ifndef MK_PER_PHASE
#define MK_PER_PHASE 0
#endif
extern "C" void kernel_launch(void* const* d_in, const int* in_sizes, int n_in, void* d_out, int out_size, void* d_ws, size_t ws_size, hipStream_t stream) {
    static int grid = 0;
    if (grid == 0) {
        if (n_in != 26 || (size_t)out_size != O_END || ws_size < WS_END) { fprintf(stderr, "kernel_launch: unexpected problem (n_in %d, out %d vs %zu, ws %zu vs %zu); nothing launched\n", n_in, out_size, (size_t)O_END, ws_size, (size_t)WS_END); grid = -1; return; }
        int dev = 0, cus = 0, per_cu = 0;
        if (hipGetDevice(&dev) != hipSuccess || hipDeviceGetAttribute(&cus, hipDeviceAttributeMultiprocessorCount, dev) != hipSuccess) { grid = -1; return; }
        if (hipFuncSetAttribute((const void*)yoco_fwd, hipFuncAttributeMaxDynamicSharedMemorySize, LDS_BYTES) != hipSuccess) { fprintf(stderr, "kernel_launch: hipFuncSetAttribute failed\n"); grid = -1; return; }
        if (hipOccupancyMaxActiveBlocksPerMultiprocessor(&per_cu, (const void*)yoco_fwd, NTHREADS, LDS_BYTES) != hipSuccess || per_cu < 1) { fprintf(stderr, "kernel_launch: occupancy query says %d\n", per_cu); per_cu = 1; }
        (void)hipGetLastError();
        if (cus != 256) { fprintf(stderr, "kernel_launch: built for a 256-CU device (got %d); nothing launched\n", cus); grid = -1; return; }
        grid = cus;
    }
    if (grid < 0) return;
    if (hipMemsetAsync((char*)d_ws + WS_CTL, 0, CTL_ZERO_BYTES, stream) != hipSuccess) { fprintf(stderr, "kernel_launch: memset failed\n"); return; }
    Args a{};
    for (int i = 0; i < 26; ++i) a.in[i] = (const float*)d_in[i];
    a.out = (float*)d_out; a.ws = (unsigned char*)d_ws;
#if MK_PER_PHASE
    for (int p = 0; p < NPHASES; ++p) { a.ph_lo = p; a.ph_hi = p + 1; hipLaunchKernelGGL(yoco_fwd, dim3(grid), dim3(NTHREADS), LDS_BYTES, stream, a); }
#else
    a.ph_lo = 0; a.ph_hi = NPHASES;
    void* kargs[] = {&a};
    hipError_t e = hipLaunchCooperativeKernel((const void*)yoco_fwd, dim3(grid), dim3(NTHREADS), kargs, LDS_BYTES, stream);
    if (e != hipSuccess) fprintf(stderr, "kernel_launch: cooperative launch failed: %s (grid %d)\n", hipGetErrorString(e), grid);
#endif
}
```

```cpp
#include <hip/hip_runtime.h>
#include <cstdio>
#include <cstdint>
#include <cmath>
namespace pg8 {
#define PG8_LAS __attribute__((address_space(3)))
typedef unsigned short bf16_t;
typedef short bf16x8 __attribute__((ext_vector_type(8)));
typedef float f32x4 __attribute__((ext_vector_type(4)));
typedef unsigned u32x4 __attribute__((ext_vector_type(4)));
constexpr int BM = 256, BK = 64, HALF = 128, HTB = HALF * BK * 2  , STAGE_BYTES = 8 * HTB, NXCD = 8, WGM = 8;

__host__ __device__ __forceinline__ int lds_byte(int r, int c) { const int st = (r >> 4) * 2 + (c >> 5), rr = r & 15, cc = c & 31, ob = rr * 64 + cc * 2; return st * 1024 + (ob ^ (((ob >> 9) & 1) << 5)); }
__host__ __device__ __forceinline__ void stage_rc(int b, int& R, int& C) { const int st = b / 1024, sb = b % 1024, swz = sb ^ (((sb >> 9) & 1) << 5); R = (st >> 1) * 16 + swz / 64; C = (st & 1) * 32 + (swz % 64) / 2; }
__host__ __device__ __forceinline__ int perm32(int rho) { const int n = rho >> 4, i = rho & 15; return 8 * (i >> 2) + 4 * n + (i & 3); }

struct Unit { int pm, pn, k0, nt, aux; };
struct Gemm { const bf16_t* A; const bf16_t* Bt; int M, N, K; };

struct StaticOrder {
    int nM, nN, nwg, G, c, nt0;
    __host__ __device__ void init(int M, int N, int K, int G_, int c_) { nM = M / BM; nN = N / BM; nwg = nM * nN; G = G_; c = c_; nt0 = K / BK; }
    __host__ __device__ bool next(int i, Unit& u) const {
        const long L = (long)i * G + c; if (L >= nwg) return false;
        int wgid = (int)L; { const int q = nwg / NXCD, r = nwg % NXCD, xcd = wgid % NXCD, off = wgid / NXCD; wgid = (xcd < r ? xcd * (q + 1) : r * (q + 1) + (xcd - r) * q) + off; }
        const int nig = WGM * nN, gid = wgid / nig, fm = gid * WGM, gsz = (nM - fm) < WGM ? (nM - fm) : WGM;
        u.pm = fm + ((wgid % nig) % gsz); u.pn = (wgid % nig) / gsz; u.k0 = 0; u.nt = nt0; u.aux = -1; return true;
    }
    __device__ __forceinline__ void a_ready(const Unit&) const {}
    __device__ __forceinline__ void done(const Unit&) const {}
};
struct ResOrder {
    StaticOrder so; int S, K, c;
    __host__ __device__ void init(int K_, int S_, int G_, int c_) { so.init(64 * BM, 1024, K_, G_, c_); S = S_; K = K_; c = c_; }
    __host__ __device__ bool next(int i, Unit& u) const {
        if (i == 0) return so.next(0, u);
        if (i == 1 && c < 20 * S) { const int t = c / S, sl = c - t * S; u.pm = 64 + (t >> 2); u.pn = t & 3; u.k0 = sl * (K / S); u.nt = K / S / BK; u.aux = sl; return true; }
        return false;
    }
    __device__ __forceinline__ void a_ready(const Unit&) const {}
    __device__ __forceinline__ void done(const Unit&) const {}
};

__device__ __forceinline__ unsigned cvt_pk_bf16(float lo, float hi) { unsigned r; asm volatile("v_cvt_pk_bf16_f32 %0, %1, %2" : "=v"(r) : "v"(lo), "v"(hi)); return r; }
typedef float f32x2 __attribute__((ext_vector_type(2)));
typedef unsigned u32x2 __attribute__((ext_vector_type(2)));
__device__ __forceinline__ float softplus_f(float x) { return x > 20.f ? x : log1pf(__expf(x)); }
struct EpiInProj {
    static constexpr bool PERM = true, AFTER_DRAIN = false;
    bf16_t* ZX; float* DT; const float* dt_bias;
    __device__ __forceinline__ void operator()(const f32x4 (&acc)[2][2][4][2], const Unit& u, int wr, int wc, int fr, int fq) const {
        const int row0 = u.pm * BM + wr * 64 + fr;
        if (u.pn < 24) {
            const int col0 = u.pn * BM + wc * 32 + 8 * fq;
#pragma unroll
            for (int ai = 0; ai < 2; ++ai)
#pragma unroll
                for (int m = 0; m < 4; ++m) { bf16_t* rowp = ZX + (size_t)(row0 + ai * HALF + m * 16) * 6144 + col0;
#pragma unroll
                    for (int bj = 0; bj < 2; ++bj) { const f32x4 v0 = acc[ai][bj][m][0], v1 = acc[ai][bj][m][1];
                        u32x4 w; w.x = cvt_pk_bf16(v0[0], v0[1]); w.y = cvt_pk_bf16(v0[2], v0[3]); w.z = cvt_pk_bf16(v1[0], v1[1]); w.w = cvt_pk_bf16(v1[2], v1[3]);
                        *(u32x4*)(rowp + bj * HALF) = w; } }
        } else if (wc == 0) {
            const int c0 = 8 * fq;
            const f32x4 b0 = *(const f32x4*)(dt_bias + c0), b1 = *(const f32x4*)(dt_bias + c0 + 4);
#pragma unroll
            for (int ai = 0; ai < 2; ++ai)
#pragma unroll
                for (int m = 0; m < 4; ++m) { float* rowp = DT + (size_t)(row0 + ai * HALF + m * 16) * 32 + c0;
                    const f32x4 v0 = acc[ai][0][m][0] + b0, v1 = acc[ai][0][m][1] + b1;
                    f32x4 o0, o1;
#pragma unroll
                    for (int j = 0; j < 4; ++j) { o0[j] = softplus_f(v0[j]); o1[j] = softplus_f(v1[j]); }
                    *(f32x4*)(rowp) = o0; *(f32x4*)(rowp + 4) = o1; }
        }
    }
};
struct EpiRes {
    static constexpr bool PERM = false, AFTER_DRAIN = false;
    float* H; float* SLAB;
    __device__ __forceinline__ void operator()(const f32x4 (&acc)[2][2][4][2], const Unit& u, int wr, int wc, int fr, int fq) const {
        const int row0 = u.pm * BM + wr * 64 + fr, col0 = u.pn * BM + wc * 32 + 4 * fq;
        if (u.aux >= 0) {
            float* base = SLAB + (size_t)u.aux * (1280 * 1024) + (size_t)(row0 - 16384) * 1024 + col0;
#pragma unroll
            for (int ai = 0; ai < 2; ++ai)
#pragma unroll
                for (int m = 0; m < 4; ++m) { float* rowp = base + (size_t)(ai * HALF + m * 16) * 1024;
#pragma unroll
                    for (int bj = 0; bj < 2; ++bj)
#pragma unroll
                        for (int n = 0; n < 2; ++n) *(f32x4*)(rowp + bj * HALF + n * 16) = acc[ai][bj][m][n]; }
            return;
        }
#pragma unroll
        for (int ai = 0; ai < 2; ++ai)
#pragma unroll
            for (int m = 0; m < 4; ++m) { float* rowp = H + (size_t)(row0 + ai * HALF + m * 16) * 1024 + col0;
#pragma unroll
                for (int bj = 0; bj < 2; ++bj)
#pragma unroll
                    for (int n = 0; n < 2; ++n) { f32x4* p = (f32x4*)(rowp + bj * HALF + n * 16); *p = *p + acc[ai][bj][m][n]; } }
    }
};
template <int ACT> struct EpiBf {
    static constexpr bool PERM = true, AFTER_DRAIN = false;
    bf16_t* O0; int ldc0; int nsplit; bf16_t* O1; int ldc1;
    __device__ __forceinline__ void operator()(const f32x4 (&acc)[2][2][4][2], const Unit& u, int wr, int wc, int fr, int fq) const {
        const int row0 = u.pm * BM + wr * 64 + fr;
        bf16_t* base; int ldc, colt;
        if (u.pn < nsplit) { base = O0; ldc = ldc0; colt = u.pn * BM; } else { base = O1; ldc = ldc1; colt = (u.pn - nsplit) * BM; }
        const int col0 = colt + wc * 32 + 8 * fq;
#pragma unroll
        for (int ai = 0; ai < 2; ++ai)
#pragma unroll
            for (int m = 0; m < 4; ++m) { bf16_t* rowp = base + (size_t)(row0 + ai * HALF + m * 16) * ldc + col0;
#pragma unroll
                for (int bj = 0; bj < 2; ++bj) { f32x4 v0 = acc[ai][bj][m][0], v1 = acc[ai][bj][m][1];
                    if (ACT == 1) {
#pragma unroll
                        for (int j = 0; j < 4; ++j) { const float a = fmaxf(v0[j], 0.f), b = fmaxf(v1[j], 0.f); v0[j] = a * a; v1[j] = b * b; } }
                    u32x4 w; w.x = cvt_pk_bf16(v0[0], v0[1]); w.y = cvt_pk_bf16(v0[2], v0[3]); w.z = cvt_pk_bf16(v1[0], v1[1]); w.w = cvt_pk_bf16(v1[2], v1[3]);
                    *(u32x4*)(rowp + bj * HALF) = w; } }
    }
};

template <class Epi, class Sched, bool ALIGN_EPI = false, bool SP2 = false>
__device__ __forceinline__ void gemm_phase(PG8_LAS unsigned char* lds, const Gemm g, const Sched& S, const Epi& E) {
    int tid_l = threadIdx.x; asm volatile("" : "+v"(tid_l));
    const int tid = tid_l, wid = __builtin_amdgcn_readfirstlane(tid >> 6), lane = tid & 63, wr = wid >> 2, wc = wid & 3, fr = lane & 15, fq = lane >> 4;
    const int K = g.K;
    unsigned voffA[2], voffB[2];
#pragma unroll
    for (int i = 0; i < 2; ++i) { int R, C; stage_rc(tid * 16 + i * 8192, R, C); const int Rb = Epi::PERM ? ((R & ~31) + perm32(R & 31)) : R;
        voffA[i] = (unsigned)(R * K + C) * 2u; voffB[i] = (unsigned)(Rb * K + C) * 2u; }
    const size_t kstep = (size_t)(BK * 2);
    const size_t hstep = (size_t)HALF * K * 2;
    const size_t tstep = 2 * hstep;
    const unsigned ldsw = (unsigned)wid * 1024u;
    const int aoff = lds_byte(wr * 64 + fr, fq * 8), boff = lds_byte(wc * 32 + fr, fq * 8);
#define PG8_SA(b, h) (((b) * 2 + (h)) * HTB)
#define PG8_SB(b, h) ((4 + (b) * 2 + (h)) * HTB)
#define PG8_STAGE(bufoff, gbase, voff) do { _Pragma("unroll") for (int _i = 0; _i < 2; ++_i) \
        __builtin_amdgcn_global_load_lds((const unsigned*)((const char*)(gbase) + (voff)[_i]), (PG8_LAS unsigned*)(lds + (bufoff) + ldsw + _i * 8192), 16, 0, 0); } while (0)
#define PG8_LDA(dst, b, h) do { _Pragma("unroll") for (int m = 0; m < 4; ++m) _Pragma("unroll") for (int k = 0; k < 2; ++k) dst[m][k] = *(const PG8_LAS bf16x8*)(lds + PG8_SA(b, h) + aoff + m * 2048 + k * 1024); } while (0)
#define PG8_LDB(dst, b, h) do { _Pragma("unroll") for (int n = 0; n < 2; ++n) _Pragma("unroll") for (int k = 0; k < 2; ++k) dst[n][k] = *(const PG8_LAS bf16x8*)(lds + PG8_SB(b, h) + boff + n * 2048 + k * 1024); } while (0)
#define PG8_MMA(ai, bj, At, Bt) do { __builtin_amdgcn_s_setprio(1); _Pragma("unroll") for (int m = 0; m < 4; ++m) _Pragma("unroll") for (int n = 0; n < 2; ++n) _Pragma("unroll") for (int k = 0; k < 2; ++k) \
        acc[ai][bj][m][n] = __builtin_amdgcn_mfma_f32_16x16x32_bf16(Bt[n][k], At[m][k], acc[ai][bj][m][n], 0, 0, 0); __builtin_amdgcn_s_setprio(0); } while (0)
#define PG8_WAIT_V(n) asm volatile("s_waitcnt vmcnt(" #n ")" ::: "memory")
#define PG8_WAIT_L(n) asm volatile("s_waitcnt lgkmcnt(" #n ")" ::: "memory")
#define PG8_BAR __builtin_amdgcn_s_barrier()
#define PG8_SCHED __builtin_amdgcn_sched_barrier(0)
    Unit cur, nxt; int ui = 0;
    if (!S.next(0, cur)) return;
    f32x4 acc[2][2][4][2];
#pragma unroll
    for (int a = 0; a < 2; ++a)
#pragma unroll
        for (int b = 0; b < 2; ++b)
#pragma unroll
            for (int m = 0; m < 4; ++m)
#pragma unroll
                for (int n = 0; n < 2; ++n) acc[a][b][m][n] = (f32x4){0.f, 0.f, 0.f, 0.f};
    bf16x8 At[4][2], B0[2][2], B1[2][2];
    const char* cA = (const char*)g.A + (size_t)cur.pm * tstep + (size_t)cur.k0 * 2; const char* cB = (const char*)g.Bt + (size_t)cur.pn * tstep + (size_t)cur.k0 * 2;
    S.a_ready(cur);
    if constexpr (SP2) {
        PG8_STAGE(PG8_SB(0, 0), cB, voffB); PG8_STAGE(PG8_SB(0, 1), cB + hstep, voffB); PG8_STAGE(PG8_SA(0, 0), cA, voffA); PG8_STAGE(PG8_SA(0, 1), cA + hstep, voffA);
        if (wr == 1) PG8_BAR;
        PG8_WAIT_V(2); PG8_BAR;
        PG8_STAGE(PG8_SB(1, 0), cB + kstep, voffB); PG8_STAGE(PG8_SA(1, 0), cA + kstep, voffA); PG8_STAGE(PG8_SB(1, 1), cB + hstep + kstep, voffB);
        PG8_WAIT_V(6); PG8_BAR;
    } else {
        PG8_STAGE(PG8_SB(0, 0), cB, voffB); PG8_STAGE(PG8_SA(0, 0), cA, voffA); PG8_STAGE(PG8_SB(0, 1), cB + hstep, voffB); PG8_STAGE(PG8_SA(0, 1), cA + hstep, voffA);
        if (wr == 1) PG8_BAR;
        PG8_WAIT_V(4); PG8_BAR;
        PG8_STAGE(PG8_SB(1, 0), cB + kstep, voffB); PG8_STAGE(PG8_SA(1, 0), cA + kstep, voffA); PG8_STAGE(PG8_SB(1, 1), cB + hstep + kstep, voffB);
        PG8_WAIT_V(6); PG8_BAR;
    }
    for (;;) {
        const bool has_next = S.next(ui + 1, nxt);
        const char* nA = has_next ? (const char*)g.A + (size_t)nxt.pm * tstep + (size_t)nxt.k0 * 2 : cA; const char* nB = has_next ? (const char*)g.Bt + (size_t)nxt.pn * tstep + (size_t)nxt.k0 * 2 : cB;
        const int nt = cur.nt;
        for (int t = 0; t < nt; t += 2) {
            const bool last = (t == nt - 2);
            const char* a1 = cA + (size_t)(t + 1) * kstep;
            const char* a2 = last ? nA : cA + (size_t)(t + 2) * kstep; const char* b2 = last ? nB : cB + (size_t)(t + 2) * kstep;
            const char* a3 = a2 + kstep; const char* b3 = b2 + kstep;
            if (last && has_next) S.a_ready(nxt);
            if constexpr (SP2) {
            PG8_LDB(B0, 0, 0); PG8_LDB(B1, 0, 1); PG8_SCHED; PG8_LDA(At, 0, 0); PG8_STAGE(PG8_SA(1, 1), a1 + hstep, voffA);
            PG8_WAIT_V(8); PG8_WAIT_L(0); PG8_BAR; PG8_MMA(0, 0, At, B0); PG8_MMA(0, 1, At, B1); PG8_BAR; PG8_SCHED;
            PG8_LDA(At, 0, 1); PG8_STAGE(PG8_SB(0, 0), b2, voffB); PG8_STAGE(PG8_SB(0, 1), b2 + hstep, voffB); PG8_STAGE(PG8_SA(0, 0), a2, voffA);
            PG8_WAIT_V(8); PG8_WAIT_L(0); PG8_BAR; PG8_MMA(1, 0, At, B0); PG8_MMA(1, 1, At, B1); PG8_BAR; PG8_SCHED;
            PG8_LDB(B0, 1, 0); PG8_LDB(B1, 1, 1); PG8_SCHED; PG8_LDA(At, 1, 0); PG8_STAGE(PG8_SA(0, 1), a2 + hstep, voffA);
            PG8_WAIT_V(8); PG8_WAIT_L(0); PG8_BAR; PG8_MMA(0, 0, At, B0); PG8_MMA(0, 1, At, B1); PG8_BAR; PG8_SCHED;
            PG8_LDA(At, 1, 1); PG8_STAGE(PG8_SB(1, 0), b3, voffB); PG8_STAGE(PG8_SB(1, 1), b3 + hstep, voffB); PG8_STAGE(PG8_SA(1, 0), a3, voffA);
            PG8_WAIT_V(8); PG8_WAIT_L(0); PG8_BAR; PG8_MMA(1, 0, At, B0); PG8_MMA(1, 1, At, B1); PG8_BAR; PG8_SCHED;
            } else {
            PG8_LDB(B0, 0, 0); PG8_SCHED; PG8_LDA(At, 0, 0); PG8_STAGE(PG8_SA(1, 1), a1 + hstep, voffA);
            PG8_WAIT_L(8); PG8_BAR; PG8_WAIT_L(0); PG8_MMA(0, 0, At, B0); PG8_BAR; PG8_SCHED;
            PG8_LDB(B1, 0, 1); PG8_STAGE(PG8_SB(0, 0), b2, voffB);
            PG8_BAR; PG8_WAIT_L(0); PG8_MMA(0, 1, At, B1); PG8_BAR;
            PG8_LDA(At, 0, 1); PG8_STAGE(PG8_SA(0, 0), a2, voffA);
            PG8_BAR; PG8_WAIT_L(0); PG8_MMA(1, 0, At, B0); PG8_BAR; PG8_SCHED;
            PG8_STAGE(PG8_SB(0, 1), b2 + hstep, voffB);
            PG8_WAIT_V(6); PG8_BAR; PG8_MMA(1, 1, At, B1); PG8_BAR;
            PG8_LDB(B0, 1, 0); PG8_SCHED; PG8_LDA(At, 1, 0); PG8_STAGE(PG8_SA(0, 1), a2 + hstep, voffA);
            PG8_WAIT_L(8); PG8_BAR; PG8_WAIT_L(0); PG8_MMA(0, 0, At, B0); PG8_BAR; PG8_SCHED;
            PG8_LDB(B1, 1, 1); PG8_STAGE(PG8_SB(1, 0), b3, voffB);
            PG8_BAR; PG8_WAIT_L(0); PG8_MMA(0, 1, At, B1); PG8_BAR;
            PG8_LDA(At, 1, 1); PG8_STAGE(PG8_SA(1, 0), a3, voffA);
            PG8_BAR; PG8_WAIT_L(0); PG8_MMA(1, 0, At, B0); PG8_BAR; PG8_SCHED;
            PG8_STAGE(PG8_SB(1, 1), b3 + hstep, voffB);
            PG8_WAIT_V(6); PG8_BAR; PG8_MMA(1, 1, At, B1); PG8_BAR;
            }
        }
        if constexpr (ALIGN_EPI) { if (wr == 0) PG8_BAR; }
        if constexpr (!Epi::AFTER_DRAIN) { E(acc, cur, wr, wc, fr, fq); S.done(cur); }
        if (!has_next) break;
#pragma unroll
        for (int a = 0; a < 2; ++a)
#pragma unroll
            for (int b = 0; b < 2; ++b)
#pragma unroll
                for (int m = 0; m < 4; ++m)
#pragma unroll
                    for (int n = 0; n < 2; ++n) acc[a][b][m][n] = (f32x4){0.f, 0.f, 0.f, 0.f};
        cur = nxt; cA = nA; cB = nB; ++ui;
        if constexpr (ALIGN_EPI) { if (wr == 1) PG8_BAR; }
    }
    PG8_WAIT_V(0);
    if constexpr (!ALIGN_EPI) { if (wr == 0) PG8_BAR; }
    PG8_BAR;
    if constexpr (Epi::AFTER_DRAIN) { E.fused(acc, cur, wr, wc, fr, fq, lds, wid, lane); S.done(cur); }
#undef PG8_SA
#undef PG8_SB
#undef PG8_STAGE
#undef PG8_LDA
#undef PG8_LDB
#undef PG8_MMA
#undef PG8_WAIT_V
#undef PG8_WAIT_L
#undef PG8_BAR
#undef PG8_SCHED
}
}
#define GAS __attribute__((address_space(1)))
#define LAS __attribute__((address_space(3)))
typedef unsigned short bf16;
typedef unsigned v4u __attribute__((ext_vector_type(4)));
typedef float f32x4 __attribute__((ext_vector_type(4)));
typedef short bf16x8 __attribute__((ext_vector_type(8)));
typedef GAS unsigned gu32;
typedef GAS unsigned long long gu64;
#define RLX_AGENT __ATOMIC_RELAXED, __HIP_MEMORY_SCOPE_AGENT
#define LDS_WAIT() asm volatile("s_waitcnt lgkmcnt(0)" ::: "memory")
#define VM_WAIT() asm volatile("s_waitcnt vmcnt(0)" ::: "memory")
__device__ __forceinline__ unsigned long long rt() { return __builtin_amdgcn_s_memrealtime(); }
__device__ __forceinline__ unsigned f2bf(float f) { unsigned u = __builtin_bit_cast(unsigned, f); return (u + 0x7fffu + ((u >> 16) & 1u)) >> 16; }
__device__ __forceinline__ unsigned pk2(float lo, float hi) { return f2bf(lo) | (f2bf(hi) << 16); }

#define XB_TMO      128
#define XB_XCNT(j)  (256  + 64 * (j))
#define XB_XSUB(j)  (1280 + 64 * (j))
#define XB_XGEN(j)  (2304 + 64 * (j))
#define XB_TOP      3328
#define XB_TOPGEN   3392
#define XCD_BAR_WORDS 3456
#define XB_SPIN_CAP (1u << 18)

__device__ __forceinline__ unsigned xb_ld(unsigned* p)              { return __hip_atomic_load(p, __ATOMIC_RELAXED, __HIP_MEMORY_SCOPE_AGENT); }
__device__ __forceinline__ unsigned xb_add(unsigned* p, unsigned v) { return __hip_atomic_fetch_add(p, v, __ATOMIC_RELAXED, __HIP_MEMORY_SCOPE_AGENT); }
__device__ __forceinline__ unsigned xb_xcc_id() { return (unsigned)__builtin_amdgcn_s_getreg((3 << 11) | 20) & 0xFu; }
#define XB_SPIN(cond, bar) do { unsigned _sp = 0; while (cond) { __builtin_amdgcn_s_sleep(1); \
    if ((++_sp & 255u) == 0u) { if (xb_ld(&(bar)[XB_TMO])) break; if (_sp > XB_SPIN_CAP) { atomicAdd(&(bar)[XB_TMO], 1u); break; } } } } while (0)

struct XcdBarrier {
    unsigned* bar; unsigned x;
    volatile LAS unsigned* st;
};

__device__ __forceinline__ XcdBarrier xcd_barrier_post(unsigned* bar, volatile LAS unsigned* st) {
    XcdBarrier b; b.bar = bar; b.x = xb_xcc_id(); b.st = st;
    if (threadIdx.x == 0) (void)xb_add(&bar[XB_XCNT(b.x)], 1u);
    return b;
}
__device__ __forceinline__ void xcd_barrier_complete(unsigned* bar, unsigned x, unsigned& nloc, unsigned& nx) {
    const unsigned G = gridDim.x * gridDim.y * gridDim.z;
    unsigned sum, cnt, mine, sp = 0u;
    for (;;) {
        sum = 0u; cnt = 0u; mine = 0u;
#pragma unroll
        for (unsigned j = 0; j < 16; ++j) { const unsigned c = xb_ld(&bar[XB_XCNT(j)]); sum += c; cnt += (c > 0u) ? 1u : 0u; mine = (j == x) ? c : mine; }
        if (sum == G) break;
        __builtin_amdgcn_s_sleep(1);
        if ((++sp & 255u) == 0u) { if (xb_ld(&bar[XB_TMO])) break; if (sp > XB_SPIN_CAP) { atomicAdd(&bar[XB_TMO], 1u); break; } }
    }
    nloc = mine > 0u ? mine : 1u; nx = cnt > 0u ? cnt : 1u;
}

__device__ __forceinline__ void xcd_barrier(const XcdBarrier& b) {
    asm volatile("s_waitcnt vmcnt(0)" ::: "memory");
    __syncthreads();
    if (threadIdx.x == 0) {
        unsigned* bar = b.bar;
        __builtin_amdgcn_s_waitcnt(0);
        unsigned nloc = b.st[0], nx = b.st[1];
        if (nloc == 0u) { xcd_barrier_complete(bar, b.x, nloc, nx); b.st[0] = nloc; b.st[1] = nx; }
        const unsigned old = xb_add(&bar[XB_XSUB(b.x)], 1u);
        const unsigned gen = old / nloc;
        if (old + 1u == (gen + 1u) * nloc) {
            __builtin_amdgcn_fence(__ATOMIC_RELEASE, "agent");
            asm volatile("s_waitcnt vmcnt(0)" ::: "memory");
            const unsigned og = xb_add(&bar[XB_TOP], 1u);
            const unsigned tg = og / nx;
            if (og + 1u == (tg + 1u) * nx) xb_add(&bar[XB_TOPGEN], 1u);
            else XB_SPIN(xb_ld(&bar[XB_TOPGEN]) == tg, bar);
            __builtin_amdgcn_fence(__ATOMIC_ACQUIRE, "agent");
            xb_add(&bar[XB_XGEN(b.x)], 1u);
            asm volatile("s_waitcnt vmcnt(0)" ::: "memory");
        } else {
            XB_SPIN(xb_ld(&bar[XB_XGEN(b.x)]) == gen, bar);
            __builtin_amdgcn_fence(__ATOMIC_ACQUIRE, "agent");
            asm volatile("s_waitcnt vmcnt(0)" ::: "memory");
        }
    }
    __syncthreads();
}
constexpr int NWAVES = 8, NTHREADS = 512;
constexpr int DM = 1024, SEQ = 8192, NPROMPT = 2, NSAMP = 128, TSAMP = 8, NMETA = 16;
constexpr int ROW_S = NPROMPT * SEQ;
constexpr int ROW_M = ROW_S + NSAMP * TSAMP;
constexpr int NROWS = ROW_M + NMETA;
constexpr int MP = 17664;
constexpr int DINNER = 2048, NHEADS = 32, HD = 64, NGROUPS = 8, DSTATE = 128, CONVD = 4096, INPROJ = 6176, INPROJ_P = 6400, ZXW = 6144;
constexpr int DFF = 4096, NKV = 4, NQ = 16, KVW = 512;
constexpr float EPS = 1e-5f;
constexpr int LDX = 136;

constexpr size_t O_YP = 0, O_YS = O_YP + (size_t)NPROMPT * SEQ * DM, O_PCONV = O_YS + (size_t)NSAMP * TSAMP * DM, O_PSSM = O_PCONV + 2 * 2 * 3 * 4096,
    O_PCK = O_PSSM + (size_t)2 * 2 * 32 * 64 * 128, O_PCV = O_PCK + 2 * 128 * 256, O_SCONV = O_PCV + 2 * 128 * 256, O_SSSM = O_SCONV + (size_t)2 * 128 * 3 * 4096,
    O_SCK = O_SSSM + (size_t)2 * 128 * 32 * 64 * 128, O_SCV = O_SCK + (size_t)128 * 128 * 256, O_END = O_SCV + (size_t)128 * 128 * 256;

constexpr size_t MiB = 1u << 20;
constexpr size_t WS_CTL = 0, CTL_ZERO_BYTES = 1 * MiB;
constexpr size_t SZ_WIN = (size_t)INPROJ_P * 1024 * 2, SZ_WOUT = (size_t)1024 * 2048 * 2, SZ_WUP = (size_t)4096 * 1024 * 2, SZ_WDN = SZ_WUP, SZ_WQKV0 = (size_t)1536 * 1024 * 2, SZ_WQ1 = (size_t)1024 * 1024 * 2, SZ_WO = SZ_WQ1;
constexpr size_t WS_WIN = 1 * MiB, WS_WOUT = WS_WIN + 2 * SZ_WIN, WS_WUP = WS_WOUT + 2 * SZ_WOUT, WS_WDN = WS_WUP + 4 * SZ_WUP, WS_WQKV0 = WS_WDN + 4 * SZ_WDN, WS_WQ1 = WS_WQKV0 + SZ_WQKV0, WS_WO = WS_WQ1 + SZ_WQ1, WS_WEND = WS_WO + 2 * SZ_WO;
constexpr size_t al1m(size_t x) { return (x + MiB - 1) / MiB * MiB; }
constexpr size_t WS_H = al1m(WS_WEND), WS_HN = al1m(WS_H + (size_t)MP * 1024 * 4), WS_ZX = al1m(WS_HN + (size_t)MP * 1024 * 2), WS_DT = al1m(WS_ZX + (size_t)MP * ZXW * 2),
    WS_XC = al1m(WS_DT + (size_t)MP * 32 * 4), WS_YN = al1m(WS_XC + (size_t)MP * 4096 * 2), WS_CS = al1m(WS_YN + (size_t)MP * 2048 * 2), WS_CD = al1m(WS_CS + (size_t)129 * 32 * 8192 * 4), WS_SLAB = al1m(WS_CD + 129 * 32 * 4), WS_HSB = al1m(WS_SLAB + (size_t)8 * 1280 * 1024 * 4), WS_END = al1m(WS_HSB + (size_t)128 * 32 * 8192 * 2);
constexpr size_t WS_U = WS_ZX;
constexpr size_t WS_Q = WS_XC, WS_KV = WS_Q + (size_t)MP * 1024 * 2, WS_AO = WS_KV + (size_t)MP * 512 * 2;
static_assert(WS_AO + (size_t)MP * 1024 * 2 <= WS_YN, "attention overlay");
constexpr int CW_BAR = 4096;

constexpr int RING_BYTES = 131072, LDS_BYTES = 147456, LDSCTL_OFF = LDS_BYTES - 512, MISC_OFF = LDSCTL_OFF + 320;

typedef unsigned u32x2 __attribute__((ext_vector_type(2)));
typedef unsigned u32x4 __attribute__((ext_vector_type(4)));
__device__ __forceinline__ int ltid() { int t = threadIdx.x; asm volatile("" : "+v"(t)); return t; }
__device__ __forceinline__ float bf2f(unsigned short b) { return __uint_as_float((unsigned)b << 16); }
__device__ __forceinline__ float bflo(unsigned w) { return __uint_as_float(w << 16); }
__device__ __forceinline__ float bfhi(unsigned w) { return __uint_as_float(w & 0xffff0000u); }
__device__ __forceinline__ unsigned pkbf(float lo, float hi) { return pg8::cvt_pk_bf16(lo, hi); }
__device__ __forceinline__ float wave_sum(float v) {
#pragma unroll
    for (int o = 1; o < 64; o <<= 1) v += __shfl_xor(v, o);
    return v;
}
__device__ __forceinline__ float frcp(float x) { return __builtin_amdgcn_rcpf(x); }
__device__ __forceinline__ float sigmoid_f(float x) { return frcp(1.f + __expf(-x)); }
#define MFMA16(b, a, c) __builtin_amdgcn_mfma_f32_16x16x32_bf16((b), (a), (c), 0, 0, 0)

struct Args {
    const float* in[26]; float* out; unsigned char* ws; int ph_lo, ph_hi;
};
typedef const __attribute__((address_space(4))) Args* ArgsP;
enum { I_XP = 0, I_XS, I_SCONV, I_SSSM, I_CK, I_CV, I_META, I_ANORM, I_AIN, I_ACONVW, I_ACONVB, I_ADTB, I_ALOG, I_ADSKIP, I_AGATE, I_AOUT, I_KVNORM, I_WKV, I_BNORM, I_WQ, I_SINKS, I_WO, I_MLPNORM, I_WUP, I_WDOWN, I_FNORM };

__device__ __forceinline__ void transpose_item(const float* W, const float* scale, int K, int N, bf16* WT, int row_off, LAS unsigned* scr, int item, int lane) {
    const int nblk = (N + 63) / 64, kb = item / nblk, nb = item % nblk, k0 = 64 * kb, n0 = 64 * nb;
    const bool ok = (n0 + lane < N);
    const float* src = W + (size_t)k0 * N + n0 + (ok ? lane : 0);
#pragma unroll
    for (int h = 0; h < 2; ++h) {
        float v[32];
#pragma unroll
        for (int i = 0; i < 32; ++i) v[i] = src[(size_t)(32 * h + i) * N];
        if (!ok) {
#pragma unroll
            for (int i = 0; i < 32; ++i) v[i] = 0.f;
        }
        if (scale) {
#pragma unroll
            for (int i = 0; i < 32; ++i) v[i] *= scale[k0 + 32 * h + i];
        }
#pragma unroll
        for (int i = 0; i < 16; ++i) scr[lane * 33 + 16 * h + i] = pkbf(v[2 * i], v[2 * i + 1]);
    }
    LDS_WAIT(); asm volatile("" ::: "memory");
    const int c = lane & 7;
#pragma unroll
    for (int j = 0; j < 8; ++j) { const int n = (lane >> 3) + 8 * j; const LAS unsigned* sp = scr + n * 33 + 4 * c;
        v4u o; o.x = sp[0]; o.y = sp[1]; o.z = sp[2]; o.w = sp[3];
        if (n0 + n < N) *(GAS v4u*)(WT + (size_t)(row_off + n0 + n) * K + k0 + 8 * c) = o; }
    LDS_WAIT(); asm volatile("" ::: "memory");
}
struct WJob { const float* W; const float* scale; int K, N; bf16* WT; int row_off; int items; };

__device__ __forceinline__ void phase_prologue(ArgsP a, LAS unsigned char* lds, int wave, int lane) {
    LAS unsigned* scr = (LAS unsigned*)(lds + wave * 16384);
    const int gw = blockIdx.x * NWAVES + wave, NGW = gridDim.x * NWAVES;
    unsigned char* ws = a->ws;
    for (int jb = 0; jb < 21; ++jb) {
        WJob J;
        if (jb < 2)       { const int i = jb;      J = WJob{a->in[I_AIN] + (size_t)i * 1024 * INPROJ, a->in[I_ANORM] + i * 1024, 1024, INPROJ, (bf16*)(ws + WS_WIN + i * SZ_WIN), 0, 0}; }
        else if (jb < 4)  { const int i = jb - 2;  J = WJob{a->in[I_AOUT] + (size_t)i * 2048 * 1024, a->in[I_AGATE] + i * 2048, 2048, 1024, (bf16*)(ws + WS_WOUT + i * SZ_WOUT), 0, 0}; }
        else if (jb < 8)  { const int l = jb - 4;  J = WJob{a->in[I_WUP] + (size_t)l * 1024 * 4096, a->in[I_MLPNORM] + l * 1024, 1024, 4096, (bf16*)(ws + WS_WUP + l * SZ_WUP), 0, 0}; }
        else if (jb < 12) { const int l = jb - 8;  J = WJob{a->in[I_WDOWN] + (size_t)l * 4096 * 1024, nullptr, 4096, 1024, (bf16*)(ws + WS_WDN + l * SZ_WDN), 0, 0}; }
        else if (jb == 12) { J = WJob{a->in[I_WQ], a->in[I_BNORM], 1024, 1024, (bf16*)(ws + WS_WQKV0), 0, 0}; }
        else if (jb == 13) { J = WJob{a->in[I_WKV], a->in[I_KVNORM], 1024, 512, (bf16*)(ws + WS_WQKV0), 1024, 0}; }
        else if (jb == 14) { J = WJob{a->in[I_WQ] + (size_t)1024 * 1024, a->in[I_BNORM] + 1024, 1024, 1024, (bf16*)(ws + WS_WQ1), 0, 0}; }
        else if (jb < 17) { const int j = jb - 15; J = WJob{a->in[I_WO] + (size_t)j * 1024 * 1024, nullptr, 1024, 1024, (bf16*)(ws + WS_WO + j * SZ_WO), 0, 0}; }
        else break;
        const int items = (J.K / 64) * ((J.N + 63) / 64);
        for (int it = gw; it < items; it += NGW) transpose_item(J.W, J.scale, J.K, J.N, J.WT, J.row_off, scr, it, lane);
    }
    {
        const int gt = blockIdx.x * NTHREADS + ltid(), NT = gridDim.x * NTHREADS;
        const int per = (INPROJ_P - INPROJ) * 1024 * 2 / 16;
        for (int e = gt; e < 2 * per; e += NT) { const int i = e / per, c = e % per;
            *(v4u*)(ws + WS_WIN + i * SZ_WIN + (size_t)INPROJ * 1024 * 2 + (size_t)c * 16) = (v4u){0u, 0u, 0u, 0u}; }
    }
}

__device__ __forceinline__ void phase_norm(ArgsP a, int from_inputs, int nslab, int wave, int lane) {
    float* H = (float*)(a->ws + WS_H); bf16* HN = (bf16*)(a->ws + WS_HN); const float* SLAB = (const float*)(a->ws + WS_SLAB);
    const int gw = blockIdx.x * NWAVES + wave, NGW = gridDim.x * NWAVES;
    for (int m = gw; m < MP; m += NGW) {
        unsigned long long* o8 = (unsigned long long*)(HN + (size_t)m * DM) + lane;
        if (m >= NROWS) {
#pragma unroll
            for (int j = 0; j < 4; ++j) o8[64 * j] = 0ull;
            continue;
        }
        const float* src;
        if (from_inputs) src = (m < ROW_S) ? a->in[I_XP] + (size_t)m * DM : (m < ROW_M) ? a->in[I_XS] + (size_t)(m - ROW_S) * DM : a->in[I_META] + (size_t)(m - ROW_M) * DM;
        else src = H + (size_t)m * DM;
        const f32x4* xr = (const f32x4*)src + lane;
        f32x4 v[4]; float s = 0.f;
#pragma unroll
        for (int j = 0; j < 4; ++j) v[j] = xr[64 * j];
        if (m >= ROW_S && nslab > 0) {
            for (int sl = 0; sl < nslab; ++sl) { const f32x4* sr = (const f32x4*)(SLAB + (size_t)sl * (1280 * 1024) + (size_t)(m - ROW_S) * DM) + lane;
#pragma unroll
                for (int j = 0; j < 4; ++j) v[j] = v[j] + sr[64 * j]; }
            f32x4* hr = (f32x4*)(H + (size_t)m * DM) + lane;
#pragma unroll
            for (int j = 0; j < 4; ++j) hr[64 * j] = v[j];
        }
#pragma unroll
        for (int j = 0; j < 4; ++j) s += (v[j].x * v[j].x + v[j].y * v[j].y) + (v[j].z * v[j].z + v[j].w * v[j].w);
        const float rs = rsqrtf(wave_sum(s) * (1.f / DM) + EPS);
        if (from_inputs) { f32x4* hr = (f32x4*)(H + (size_t)m * DM) + lane;
#pragma unroll
            for (int j = 0; j < 4; ++j) hr[64 * j] = v[j]; }
#pragma unroll
        for (int j = 0; j < 4; ++j) o8[64 * j] = (unsigned long long)pkbf(v[j].x * rs, v[j].y * rs) | ((unsigned long long)pkbf(v[j].z * rs, v[j].w * rs) << 32);
    }
}
__device__ __forceinline__ void phase_final(ArgsP a, int wave, int lane) {
    const float* H = (const float*)(a->ws + WS_H); const float* fw = a->in[I_FNORM]; const float* SLAB = (const float*)(a->ws + WS_SLAB);
    const int gw = blockIdx.x * NWAVES + wave, NGW = gridDim.x * NWAVES;
    f32x4 w[4];
#pragma unroll
    for (int j = 0; j < 4; ++j) w[j] = ((const f32x4*)fw)[lane + 64 * j];
    for (int m = gw; m < ROW_M; m += NGW) {
        const f32x4* xr = (const f32x4*)(H + (size_t)m * DM) + lane;
        f32x4 v[4]; float s = 0.f;
#pragma unroll
        for (int j = 0; j < 4; ++j) v[j] = xr[64 * j];
        if (m >= ROW_S) {
            for (int sl = 0; sl < 8; ++sl) { const f32x4* sr = (const f32x4*)(SLAB + (size_t)sl * (1280 * 1024) + (size_t)(m - ROW_S) * DM) + lane;
#pragma unroll
                for (int j = 0; j < 4; ++j) v[j] = v[j] + sr[64 * j]; }
        }
#pragma unroll
        for (int j = 0; j < 4; ++j) s += (v[j].x * v[j].x + v[j].y * v[j].y) + (v[j].z * v[j].z + v[j].w * v[j].w);
        const float rs = rsqrtf(wave_sum(s) * (1.f / DM) + EPS);
        f32x4* o = (f32x4*)(a->out + O_YP + (size_t)m * DM) + lane;
#pragma unroll
        for (int j = 0; j < 4; ++j) o[64 * j] = v[j] * rs * w[j];
    }
}

__device__ __forceinline__ void unpack8(const u32x4 w, float (&f)[8]) { f[0] = bflo(w.x); f[1] = bfhi(w.x); f[2] = bflo(w.y); f[3] = bfhi(w.y); f[4] = bflo(w.z); f[5] = bfhi(w.z); f[6] = bflo(w.w); f[7] = bfhi(w.w); }
__device__ __forceinline__ void ld8f(const float* __restrict__ p, float (&f)[8]) { const f32x4 x0 = *(const f32x4*)p, x1 = *(const f32x4*)(p + 4); f[0]=x0.x;f[1]=x0.y;f[2]=x0.z;f[3]=x0.w;f[4]=x1.x;f[5]=x1.y;f[6]=x1.z;f[7]=x1.w; }
__device__ __forceinline__ void phase_conv(ArgsP a, int li) {
    const bf16* __restrict__ ZX = (const bf16*)(a->ws + WS_ZX); bf16* __restrict__ XC = (bf16*)(a->ws + WS_XC);
    const float* __restrict__ cw = a->in[I_ACONVW] + (size_t)li * 4 * CONVD; const float* __restrict__ cb = a->in[I_ACONVB] + (size_t)li * CONVD;
    const float* __restrict__ sconv = a->in[I_SCONV] + (size_t)li * NSAMP * 3 * CONVD;
    float* __restrict__ outp = a->out;
    constexpr int NRUNS = 2048 + 128 + 2;
    const int gt = blockIdx.x * NTHREADS + ltid(), NT = gridDim.x * NTHREADS;
    for (int item = gt; item < NRUNS * 512; item += NT) {
        const int run = item >> 9, c0 = (item & 511) * 8;
        int R0, kind, b = 0; bool last = false;
        if (run < 2048) { kind = 0; b = run >> 10; const int t0 = (run & 1023) * 8; R0 = b * SEQ + t0; last = (t0 == SEQ - 8); }
        else if (run < 2176) { kind = 1; b = run - 2048; R0 = ROW_S + b * 8; last = true; }
        else { kind = 2; R0 = ROW_M + (run - 2176) * 8; }
        const bool first = (kind == 0) ? ((run & 1023) == 0) : (kind == 1) ? true : (run == 2176);
        u32x4 raw[11];
#pragma unroll
        for (int t = 0; t < 8; ++t) raw[3 + t] = *(const u32x4*)(ZX + (size_t)(R0 + t) * ZXW + 2048 + c0);
        float p0[8], p1[8], p2[8];
        if (!first || kind == 0) {
            const int Rp = first ? ROW_M + 16 : R0;
#pragma unroll
            for (int t = 0; t < 3; ++t) raw[t] = *(const u32x4*)(ZX + (size_t)(Rp - 3 + t) * ZXW + 2048 + c0);
            unpack8(raw[0], p0); unpack8(raw[1], p1); unpack8(raw[2], p2);
        } else if (kind == 1) {
            const float* s = sconv + (size_t)b * 3 * CONVD + c0;
            ld8f(s, p0); ld8f(s + CONVD, p1); ld8f(s + 2 * CONVD, p2);
        } else {
#pragma unroll
            for (int j = 0; j < 8; ++j) { p0[j] = 0.f; p1[j] = 0.f; p2[j] = 0.f; }
        }
        float w0[8], w1[8], w2[8], w3[8], bs[8];
        ld8f(cw + c0, w0); ld8f(cw + CONVD + c0, w1); ld8f(cw + 2 * CONVD + c0, w2); ld8f(cw + 3 * CONVD + c0, w3); ld8f(cb + c0, bs);
#pragma unroll
        for (int t = 0; t < 8; ++t) {
            float x[8]; unpack8(raw[3 + t], x);
            float o[8];
#pragma unroll
            for (int j = 0; j < 8; ++j) { const float v = bs[j] + w0[j] * p0[j] + w1[j] * p1[j] + w2[j] * p2[j] + w3[j] * x[j]; o[j] = v * sigmoid_f(v); }
            u32x4 w; w.x = pkbf(o[0], o[1]); w.y = pkbf(o[2], o[3]); w.z = pkbf(o[4], o[5]); w.w = pkbf(o[6], o[7]);
            *(u32x4*)(XC + (size_t)(R0 + t) * CONVD + c0) = w;
            if (last && t >= 5 && kind != 2) {
                float* dst = (kind == 0) ? outp + O_PCONV + ((size_t)(li * NPROMPT + b) * 3 + (t - 5)) * CONVD + c0 : outp + O_SCONV + ((size_t)(li * NSAMP + b) * 3 + (t - 5)) * CONVD + c0;
                *(f32x4*)(dst) = (f32x4){x[0], x[1], x[2], x[3]}; *(f32x4*)(dst + 4) = (f32x4){x[4], x[5], x[6], x[7]};
            }
#pragma unroll
            for (int j = 0; j < 8; ++j) { p0[j] = p1[j]; p1[j] = p2[j]; p2[j] = x[j]; }
        }
    }
}

__device__ __forceinline__ void ssd_acs(const float* DT, const float* alog, int R0, int len, int h0, float* s_dt, float* s_acs, int wave, int lane) {
    if (wave < 4) {
        const int r = wave; const float An = -__expf(alog[h0 + r]);
        const int l0 = 2 * lane;
        const float d0 = (l0 < len) ? DT[(size_t)(R0 + l0) * 32 + h0 + r] : 0.f;
        const float d1 = (l0 + 1 < len) ? DT[(size_t)(R0 + l0 + 1) * 32 + h0 + r] : 0.f;
        const float a0 = d0 * An, a1 = d1 * An, s = a0 + a1;
        float incl = s;
#pragma unroll
        for (int o = 1; o < 64; o <<= 1) { const float t = __shfl_up(incl, o); if (lane >= o) incl += t; }
        const float excl = incl - s;
        s_dt[r * 128 + l0] = d0; s_dt[r * 128 + l0 + 1] = d1;
        s_acs[r * 128 + l0] = excl + a0; s_acs[r * 128 + l0 + 1] = excl + s;
    }
}
#define TSW(ch) ((((ch) >> 3) & 7) << 3)
#define LFRAG(base, row, ld, ks) (*(const bf16x8*)((base) + (row) * (ld) + 32 * (ks) + 8 * fq))

__device__ __forceinline__ void ssd1_unit(ArgsP a, int li, unsigned char* lds, int slot, int g, int R0, int len, int, int, int) {
    const int tid = ltid(), lane = tid & 63, wave = __builtin_amdgcn_readfirstlane(tid >> 6);
    const bf16* __restrict__ XC = (const bf16*)(a->ws + WS_XC); const float* __restrict__ DT = (const float*)(a->ws + WS_DT);
    bf16* __restrict__ CS = (bf16*)(a->ws + WS_CS); float* __restrict__ CD = (float*)(a->ws + WS_CD);
    bf16* XsT = (bf16*)lds;
    bf16* BT = (bf16*)(lds + 256 * LDX * 2);
    float* s_dt = (float*)(lds + 384 * LDX * 2); float* s_acs = s_dt + 512;
    const int fr = lane & 15, fq = lane >> 4, h0 = g * 4;
    u32x4 x0[4], x1[4], b0[2], b1[2];
#pragma unroll
    for (int k = 0; k < 4; ++k) { const int item = tid + NTHREADS * k, cb = (item & 7) + 8 * ((item >> 5) & 3), tp = ((item >> 3) & 3) + 4 * (item >> 7), l = 2 * tp;
        x0[k] = (u32x4){0u, 0u, 0u, 0u}; x1[k] = x0[k];
        if (l < len) x0[k] = *(const u32x4*)(XC + (size_t)(R0 + l) * CONVD + g * 256 + cb * 8);
        if (l + 1 < len) x1[k] = *(const u32x4*)(XC + (size_t)(R0 + l + 1) * CONVD + g * 256 + cb * 8); }
#pragma unroll
    for (int k = 0; k < 2; ++k) { const int item = tid + NTHREADS * k, cb = (item & 7) + 8 * ((item >> 5) & 1), tp = ((item >> 3) & 3) + 4 * (item >> 6), l = 2 * tp;
        b0[k] = (u32x4){0u, 0u, 0u, 0u}; b1[k] = b0[k];
        if (l < len) b0[k] = *(const u32x4*)(XC + (size_t)(R0 + l) * CONVD + 2048 + g * 128 + cb * 8);
        if (l + 1 < len) b1[k] = *(const u32x4*)(XC + (size_t)(R0 + l + 1) * CONVD + 2048 + g * 128 + cb * 8); }
    ssd_acs(DT, a->in[I_ALOG] + li * NHEADS, R0, len, h0, s_dt, s_acs, wave, lane);
#pragma unroll
    for (int k = 0; k < 2; ++k) { const int item = tid + NTHREADS * k, cb = (item & 7) + 8 * ((item >> 5) & 1), tp = ((item >> 3) & 3) + 4 * (item >> 6), col = (2 * tp) ^ (8 * (cb & 7));
        const unsigned a0[4] = {b0[k].x, b0[k].y, b0[k].z, b0[k].w}, a1[4] = {b1[k].x, b1[k].y, b1[k].z, b1[k].w};
#pragma unroll
        for (int j = 0; j < 4; ++j) {
            *(unsigned*)(BT + (cb * 8 + 2 * j) * LDX + col) = (a0[j] & 0xffffu) | (a1[j] << 16);
            *(unsigned*)(BT + (cb * 8 + 2 * j + 1) * LDX + col) = (a0[j] >> 16) | (a1[j] & 0xffff0000u); } }
    __syncthreads();
#pragma unroll
    for (int k = 0; k < 4; ++k) {
        const int item = tid + NTHREADS * k, cb = (item & 7) + 8 * ((item >> 5) & 3), tp = ((item >> 3) & 3) + 4 * (item >> 7), l = 2 * tp, r = cb >> 3, col = l ^ (8 * (cb & 7));
        const float tot = s_acs[r * 128 + 127];
        const float w0 = __expf(tot - s_acs[r * 128 + l]) * s_dt[r * 128 + l], w1 = __expf(tot - s_acs[r * 128 + l + 1]) * s_dt[r * 128 + l + 1];
        float f0[8], f1[8]; unpack8(x0[k], f0); unpack8(x1[k], f1);
#pragma unroll
        for (int j = 0; j < 8; ++j) *(unsigned*)(XsT + (cb * 8 + j) * LDX + col) = pkbf(f0[j] * w0, f1[j] * w1);
    }
    __syncthreads();
    f32x4 acc[2][8];
#pragma unroll
    for (int mi = 0; mi < 2; ++mi)
#pragma unroll
        for (int ni = 0; ni < 8; ++ni) acc[mi][ni] = (f32x4){0.f, 0.f, 0.f, 0.f};
#pragma unroll
    for (int ks = 0; ks < 4; ++ks) {
        const int ra0 = 32 * wave + fr, ra1 = ra0 + 16;
        const bf16x8 a0 = *(const bf16x8*)(XsT + ra0 * LDX + ((32 * ks + 8 * fq) ^ TSW(ra0))), a1 = *(const bf16x8*)(XsT + ra1 * LDX + ((32 * ks + 8 * fq) ^ TSW(ra1)));
#pragma unroll
        for (int ni = 0; ni < 8; ++ni) { const int rb = 16 * ni + fr; const bf16x8 bb = *(const bf16x8*)(BT + rb * LDX + ((32 * ks + 8 * fq) ^ TSW(rb)));
            acc[0][ni] = MFMA16(bb, a0, acc[0][ni]); acc[1][ni] = MFMA16(bb, a1, acc[1][ni]); }
    }
#pragma unroll
    for (int mi = 0; mi < 2; ++mi) { const int hp = 32 * wave + 16 * mi + fr, r = hp >> 6, p = hp & 63;
        bf16* dst = CS + ((size_t)(slot * 32 + h0 + r) * 64 + p) * 128 + 4 * fq;
#pragma unroll
        for (int ni = 0; ni < 8; ++ni) { u32x2 w; w.x = pkbf(acc[mi][ni][0], acc[mi][ni][1]); w.y = pkbf(acc[mi][ni][2], acc[mi][ni][3]); *(u32x2*)(dst + 16 * ni) = w; } }
    if (tid < 4) CD[slot * 32 + h0 + tid] = __expf(s_acs[tid * 128 + 127]);
    __syncthreads();
}

__device__ __forceinline__ void ssd_sample_unit(ArgsP a, int li, unsigned char* lds, int b, int g, int, int, int) {
    const int tid = ltid(), lane = tid & 63, wave = __builtin_amdgcn_readfirstlane(tid >> 6);
    const bf16* __restrict__ XC = (const bf16*)(a->ws + WS_XC); const bf16* __restrict__ ZX = (const bf16*)(a->ws + WS_ZX); const float* __restrict__ DT = (const float*)(a->ws + WS_DT); bf16* __restrict__ YN = (bf16*)(a->ws + WS_YN);
    float* sX = (float*)lds; float* sB = sX + 8 * 256; float* sC = sB + 8 * 128; float* sY = sC + 8 * 128; float* sDt = sY + 8 * 256;
    const int R0 = ROW_S + b * 8, h0 = g * 4;
    const int p = tid >> 3, nb = tid & 7;
    const float* __restrict__ sin_ = a->in[I_SSSM] + ((size_t)((li * NSAMP + b) * NHEADS + h0) * 64 + p) * 128 + 4 * nb;
    float* __restrict__ sout = a->out + O_SSSM + ((size_t)((li * NSAMP + b) * NHEADS + h0) * 64 + p) * 128 + 4 * nb;
    f32x4 st[4][4];
#pragma unroll
    for (int r = 0; r < 4; ++r)
#pragma unroll
        for (int kk = 0; kk < 4; ++kk) st[r][kk] = *(const f32x4*)(sin_ + (size_t)r * 8192 + 32 * kk);
    {
        const int t = tid >> 6, ck = tid & 63;
        const int col = (ck < 32) ? g * 256 + ck * 8 : (ck < 48) ? 2048 + g * 128 + (ck - 32) * 8 : 3072 + g * 128 + (ck - 48) * 8;
        float f[8]; unpack8(*(const u32x4*)(XC + (size_t)(R0 + t) * CONVD + col), f);
        float* dst = (ck < 32) ? sX + t * 256 + ck * 8 : (ck < 48) ? sB + t * 128 + (ck - 32) * 8 : sC + t * 128 + (ck - 48) * 8;
        *(f32x4*)dst = (f32x4){f[0], f[1], f[2], f[3]}; *(f32x4*)(dst + 4) = (f32x4){f[4], f[5], f[6], f[7]};
        if (tid < 32) sDt[tid] = DT[(size_t)(R0 + (tid >> 2)) * 32 + h0 + (tid & 3)];
    }
    __syncthreads();
    float An[4], Dk[4];
#pragma unroll
    for (int r = 0; r < 4; ++r) { An[r] = -__expf(a->in[I_ALOG][li * NHEADS + h0 + r]); Dk[r] = a->in[I_ADSKIP][li * NHEADS + h0 + r]; }
    float part[8][4];
#pragma unroll
    for (int t = 0; t < 8; ++t) {
        f32x4 bv[4], cv[4];
#pragma unroll
        for (int kk = 0; kk < 4; ++kk) { bv[kk] = *(const f32x4*)(sB + t * 128 + 32 * kk + 4 * nb); cv[kk] = *(const f32x4*)(sC + t * 128 + 32 * kk + 4 * nb); }
#pragma unroll
        for (int r = 0; r < 4; ++r) {
            const float dt = sDt[t * 4 + r], dA = __expf(dt * An[r]), xv = sX[t * 256 + r * 64 + p], coef = dt * xv;
            float pr = 0.f;
#pragma unroll
            for (int kk = 0; kk < 4; ++kk) { st[r][kk] = st[r][kk] * dA + bv[kk] * coef; pr += (cv[kk].x * st[r][kk].x + cv[kk].y * st[r][kk].y) + (cv[kk].z * st[r][kk].z + cv[kk].w * st[r][kk].w); }
            part[t][r] = pr;
        }
    }
#pragma unroll
    for (int r = 0; r < 4; ++r)
#pragma unroll
        for (int kk = 0; kk < 4; ++kk) *(f32x4*)(sout + (size_t)r * 8192 + 32 * kk) = st[r][kk];
#pragma unroll
    for (int t = 0; t < 8; ++t)
#pragma unroll
        for (int r = 0; r < 4; ++r) { float v = part[t][r]; v += __shfl_xor(v, 1); v += __shfl_xor(v, 2); v += __shfl_xor(v, 4); part[t][r] = v; }
    if (nb == 0) {
#pragma unroll
        for (int t = 0; t < 8; ++t)
#pragma unroll
            for (int r = 0; r < 4; ++r) sY[t * 256 + r * 64 + p] = part[t][r] + Dk[r] * sX[t * 256 + r * 64 + p];
    }
    __syncthreads();
    {
        const int t = wave, c4 = lane * 4; const size_t row = (size_t)(R0 + t);
        const f32x4 y = *(const f32x4*)(sY + t * 256 + c4);
        const u32x2 zz = *(const u32x2*)(ZX + row * ZXW + g * 256 + c4);
        const float z0 = bflo(zz.x), z1 = bfhi(zz.x), z2 = bflo(zz.y), z3 = bfhi(zz.y);
        const float g0 = y.x * z0 * sigmoid_f(z0), g1 = y.y * z1 * sigmoid_f(z1), g2 = y.z * z2 * sigmoid_f(z2), g3 = y.w * z3 * sigmoid_f(z3);
        const float ss = wave_sum((g0 * g0 + g1 * g1) + (g2 * g2 + g3 * g3));
        const float rs = rsqrtf(ss * (1.f / 256.f) + EPS);
        u32x2 o; o.x = pkbf(g0 * rs, g1 * rs); o.y = pkbf(g2 * rs, g3 * rs);
        *(u32x2*)(YN + row * DINNER + g * 256 + c4) = o;
    }
    __syncthreads();
}

__device__ __forceinline__ void phase_scan(ArgsP a, int li) {
    const bf16* __restrict__ CS = (const bf16*)(a->ws + WS_CS); const float* __restrict__ CD = (const float*)(a->ws + WS_CD); bf16* __restrict__ HSB = (bf16*)(a->ws + WS_HSB);
    const int gt = blockIdx.x * NTHREADS + ltid(), NT = gridDim.x * NTHREADS;
    for (int e = gt; e < 2 * 65536; e += NT) {
        const int b = e >> 16, rem = e & 65535, h = rem >> 11, pn4 = rem & 2047;
        f32x4 hc; { const u32x2 w0 = *(const u32x2*)(CS + ((size_t)(128 * 32 + h) * 2048 + pn4) * 4); hc = (f32x4){bflo(w0.x), bfhi(w0.x), bflo(w0.y), bfhi(w0.y)}; }
#pragma unroll 8
        for (int c = 0; c < 64; ++c) { const int slot = b * 64 + c; const size_t o = ((size_t)(slot * 32 + h) * 2048 + pn4) * 4;
            const u32x2 sw = *(const u32x2*)(CS + o); const f32x4 s = (f32x4){bflo(sw.x), bfhi(sw.x), bflo(sw.y), bfhi(sw.y)}; const float d = CD[slot * 32 + h];
            u32x2 w; w.x = pkbf(hc.x, hc.y); w.y = pkbf(hc.z, hc.w); *(u32x2*)(HSB + o) = w;
            hc = hc * d + s; }
        *(f32x4*)(a->out + O_PSSM + ((size_t)((li * NPROMPT + b) * NHEADS + h) * 2048 + pn4) * 4) = hc;
    }
}

__device__ __forceinline__ void ssd3_head(int r, int hb, const bf16* Cn, const bf16* BH, const bf16* Xt, const float* s_dt, const float* s_acs, const f32x4 (&cb)[8], f32x4 (&acc)[4],
                                          const bf16* __restrict__ XC, const bf16* __restrict__ ZX, size_t row, int g, float Dk, int l, int wave, int fr, int fq, float& ss) {
    u32x2 xx[4], zz[4];
#pragma unroll
    for (int ni = 0; ni < 4; ++ni) { const int ch = g * 256 + r * 64 + 16 * ni + 4 * fq; xx[ni] = *(const u32x2*)(XC + row * CONVD + ch); zz[ni] = *(const u32x2*)(ZX + row * ZXW + ch); }
    const float al = s_acs[r * 128 + l];
#pragma unroll
    for (int ni = 0; ni < 4; ++ni) acc[ni] = (f32x4){0.f, 0.f, 0.f, 0.f};
    const bf16* Hs = BH + hb * 64 * LDX;
#pragma unroll
    for (int ks = 0; ks < 4; ++ks) { const bf16x8 af = LFRAG(Cn, l, LDX, ks);
#pragma unroll
        for (int ni = 0; ni < 4; ++ni) { const bf16x8 bb = LFRAG(Hs, 16 * ni + fr, LDX, ks); acc[ni] = MFMA16(bb, af, acc[ni]); } }
    const float e = __expf(al);
#pragma unroll
    for (int ni = 0; ni < 4; ++ni) acc[ni] = acc[ni] * e;
#pragma unroll
    for (int ks = 0; ks < 4; ++ks) if (2 * ks <= wave) {
        unsigned mw[4];
#pragma unroll
        for (int hf = 0; hf < 2; ++hf) { const int ni = 2 * ks + hf, s0 = 16 * ni + 4 * fq;
            const f32x4 av = *(const f32x4*)(s_acs + r * 128 + s0), dv = *(const f32x4*)(s_dt + r * 128 + s0);
            float m[4];
#pragma unroll
            for (int j = 0; j < 4; ++j) m[j] = (s0 + j <= l) ? cb[ni][j] * __expf(al - av[j]) * dv[j] : 0.f;
            mw[2 * hf] = pkbf(m[0], m[1]); mw[2 * hf + 1] = pkbf(m[2], m[3]); }
        const u32x4 afu = (u32x4){mw[0], mw[1], mw[2], mw[3]};
        const bf16x8 af = __builtin_bit_cast(bf16x8, afu);
#pragma unroll
        for (int ni = 0; ni < 4; ++ni) { const int chl = r * 64 + 16 * ni + fr, sw = TSW(chl);
            const u32x2 b0 = *(const u32x2*)(Xt + chl * LDX + ((32 * ks + 4 * fq) ^ sw)), b1 = *(const u32x2*)(Xt + chl * LDX + ((32 * ks + 16 + 4 * fq) ^ sw));
            const u32x4 bu = (u32x4){b0.x, b0.y, b1.x, b1.y};
            acc[ni] = MFMA16(__builtin_bit_cast(bf16x8, bu), af, acc[ni]); }
    }
#pragma unroll
    for (int ni = 0; ni < 4; ++ni) {
        const float xv[4] = {bflo(xx[ni].x), bfhi(xx[ni].x), bflo(xx[ni].y), bfhi(xx[ni].y)}, zv[4] = {bflo(zz[ni].x), bfhi(zz[ni].x), bflo(zz[ni].y), bfhi(zz[ni].y)};
#pragma unroll
        for (int j = 0; j < 4; ++j) { const float q = (acc[ni][j] + Dk * xv[j]) * zv[j] * sigmoid_f(zv[j]); acc[ni][j] = q; ss += q * q; } }
}
__device__ __forceinline__ void ssd3_unit(ArgsP a, int li, unsigned char* lds, const bf16* __restrict__ hs, int g, int R0, int len, int, int, int) {
    const int tid = ltid(), lane = tid & 63, wave = __builtin_amdgcn_readfirstlane(tid >> 6);
    const bf16* __restrict__ XC = (const bf16*)(a->ws + WS_XC); const bf16* __restrict__ ZX = (const bf16*)(a->ws + WS_ZX); const float* __restrict__ DT = (const float*)(a->ws + WS_DT); bf16* __restrict__ YN = (bf16*)(a->ws + WS_YN);
    bf16* Cn = (bf16*)lds; bf16* BH = Cn + 128 * LDX; bf16* Xt = BH + 128 * LDX;
    float* s_dt = (float*)(Xt + 256 * LDX); float* s_acs = s_dt + 512;
    const int fr = lane & 15, fq = lane >> 4, h0 = g * 4;
    {
        u32x4 vc[4], vb[4], vx0[4], vx1[4];
#pragma unroll
        for (int k = 0; k < 4; ++k) { const int item = tid + NTHREADS * k, l = item >> 4, ch = item & 15;
            vc[k] = (u32x4){0u, 0u, 0u, 0u}; vb[k] = vc[k];
            if (l < len) { vc[k] = *(const u32x4*)(XC + (size_t)(R0 + l) * CONVD + 3072 + g * 128 + ch * 8); vb[k] = *(const u32x4*)(XC + (size_t)(R0 + l) * CONVD + 2048 + g * 128 + ch * 8); } }
        const int cbl = tid & 7, tp = tid >> 3, l0 = 2 * tp;
#pragma unroll
        for (int r = 0; r < 4; ++r) { vx0[r] = (u32x4){0u, 0u, 0u, 0u}; vx1[r] = vx0[r];
            if (l0 < len) vx0[r] = *(const u32x4*)(XC + (size_t)(R0 + l0) * CONVD + g * 256 + r * 64 + cbl * 8);
            if (l0 + 1 < len) vx1[r] = *(const u32x4*)(XC + (size_t)(R0 + l0 + 1) * CONVD + g * 256 + r * 64 + cbl * 8); }
        ssd_acs(DT, a->in[I_ALOG] + li * NHEADS, R0, len, h0, s_dt, s_acs, wave, lane);
#pragma unroll
        for (int k = 0; k < 4; ++k) { const int item = tid + NTHREADS * k, l = item >> 4, ch = item & 15; *(u32x4*)(Cn + l * LDX + ch * 8) = vc[k]; *(u32x4*)(BH + l * LDX + ch * 8) = vb[k]; }
#pragma unroll
        for (int r = 0; r < 4; ++r) { const unsigned a0[4] = {vx0[r].x, vx0[r].y, vx0[r].z, vx0[r].w}, a1[4] = {vx1[r].x, vx1[r].y, vx1[r].z, vx1[r].w};
            const int col = l0 ^ (8 * cbl);
#pragma unroll
            for (int j = 0; j < 4; ++j) {
                *(unsigned*)(Xt + (r * 64 + cbl * 8 + 2 * j) * LDX + col) = (a0[j] & 0xffffu) | (a1[j] << 16);
                *(unsigned*)(Xt + (r * 64 + cbl * 8 + 2 * j + 1) * LDX + col) = (a0[j] >> 16) | (a1[j] & 0xffff0000u); } }
    }
    __syncthreads();
    u32x2 hv[8];
#pragma unroll
    for (int k = 0; k < 8; ++k) { const int item = tid + NTHREADS * k; hv[k] = (u32x2){0u, 0u}; if (hs) hv[k] = *(const u32x2*)(hs + (size_t)item * 4); }
    const bool active = (16 * wave < len);
    f32x4 cb[8];
#pragma unroll
    for (int ni = 0; ni < 8; ++ni) cb[ni] = (f32x4){0.f, 0.f, 0.f, 0.f};
    if (active) {
#pragma unroll
    for (int ks = 0; ks < 4; ++ks) { const bf16x8 af = LFRAG(Cn, 16 * wave + fr, LDX, ks);
#pragma unroll
        for (int ni = 0; ni < 8; ++ni) { const bf16x8 bb = LFRAG(BH, 16 * ni + fr, LDX, ks); cb[ni] = MFMA16(bb, af, cb[ni]); } }
    }
    __syncthreads();
#pragma unroll
    for (int k = 0; k < 8; ++k) { const int item = tid + NTHREADS * k, hp = item >> 5, n4 = item & 31; *(u32x2*)(BH + hp * LDX + n4 * 4) = hv[k]; }
#pragma unroll
    for (int k = 0; k < 8; ++k) { const int item = tid + NTHREADS * k; hv[k] = (u32x2){0u, 0u}; if (hs) hv[k] = *(const u32x2*)(hs + (size_t)(2 * 8192) + (size_t)item * 4); }
    __syncthreads();
    const int l = 16 * wave + fr;
    const size_t row = (size_t)(R0 + ((l < len) ? l : 0));
    f32x4 y0[4], y1[4], y2[4], y3[4];
    float ss = 0.f;
    const float* dsk = a->in[I_ADSKIP] + li * NHEADS + h0;
    if (active) {
    ssd3_head(0, 0, Cn, BH, Xt, s_dt, s_acs, cb, y0, XC, ZX, row, g, dsk[0], l, wave, fr, fq, ss);
    asm volatile("" ::: "memory");
    ssd3_head(1, 1, Cn, BH, Xt, s_dt, s_acs, cb, y1, XC, ZX, row, g, dsk[1], l, wave, fr, fq, ss);
    }
    __syncthreads();
#pragma unroll
    for (int k = 0; k < 8; ++k) { const int item = tid + NTHREADS * k, hp = item >> 5, n4 = item & 31; *(u32x2*)(BH + hp * LDX + n4 * 4) = hv[k]; }
    __syncthreads();
    if (active) {
    ssd3_head(2, 0, Cn, BH, Xt, s_dt, s_acs, cb, y2, XC, ZX, row, g, dsk[2], l, wave, fr, fq, ss);
    asm volatile("" ::: "memory");
    ssd3_head(3, 1, Cn, BH, Xt, s_dt, s_acs, cb, y3, XC, ZX, row, g, dsk[3], l, wave, fr, fq, ss);
    ss += __shfl_xor(ss, 16); ss += __shfl_xor(ss, 32);
    }
    const float rs = rsqrtf(ss * (1.f / 256.f) + EPS);
    if (active && l < len) {
        bf16* yrow = YN + row * DINNER + g * 256 + 4 * fq;
#pragma unroll
        for (int ni = 0; ni < 4; ++ni) {
            u32x2 w;
            w.x = pkbf(y0[ni][0] * rs, y0[ni][1] * rs); w.y = pkbf(y0[ni][2] * rs, y0[ni][3] * rs); *(u32x2*)(yrow + 0 * 64 + 16 * ni) = w;
            w.x = pkbf(y1[ni][0] * rs, y1[ni][1] * rs); w.y = pkbf(y1[ni][2] * rs, y1[ni][3] * rs); *(u32x2*)(yrow + 1 * 64 + 16 * ni) = w;
            w.x = pkbf(y2[ni][0] * rs, y2[ni][1] * rs); w.y = pkbf(y2[ni][2] * rs, y2[ni][3] * rs); *(u32x2*)(yrow + 2 * 64 + 16 * ni) = w;
            w.x = pkbf(y3[ni][0] * rs, y3[ni][1] * rs); w.y = pkbf(y3[ni][2] * rs, y3[ni][3] * rs); *(u32x2*)(yrow + 3 * 64 + 16 * ni) = w;
        }
    }
    __syncthreads();
}
__device__ __forceinline__ void phase_ssd1(ArgsP a, int li, unsigned char* lds, int tid, int wave, int lane) {
    const int c = blockIdx.x;
#pragma unroll 1
    for (int k = 0; k < 8; ++k) {
        const int u = c + 256 * (k >> 1);
#ifndef PROBE_SSD1
#define PROBE_SSD1 0
#endif
        if (((k + c) & 1) == 0) { const int slot = u >> 3, g = u & 7;
#pragma unroll 1
            for (int rp = 0; rp < (PROBE_SSD1 == 1 ? 2 : 1); ++rp) ssd1_unit(a, li, lds, slot, g, (slot >> 6) * SEQ + (slot & 63) * 128, 128, tid, wave, lane); }
        else {
#pragma unroll 1
            for (int rp = 0; rp < (PROBE_SSD1 == 2 ? 2 : 1); ++rp) ssd_sample_unit(a, li, lds, u >> 3, u & 7, tid, wave, lane); }
    }
    if (c < 8) ssd1_unit(a, li, lds, 128, c, ROW_M, NMETA, tid, wave, lane);
    else if (c < 16) ssd3_unit(a, li, lds, nullptr, c - 8, ROW_M, NMETA, tid, wave, lane);
}
__device__ __forceinline__ void phase_ssd3(ArgsP a, int li, unsigned char* lds, int tid, int wave, int lane) {
    const bf16* HSB = (const bf16*)(a->ws + WS_HSB);
#pragma unroll 1
    for (int u = blockIdx.x; u < 1024; u += gridDim.x) { const int slot = u >> 3, g = u & 7; ssd3_unit(a, li, lds, HSB + (size_t)(slot * 32 + g * 4) * 8192, g, (slot >> 6) * SEQ + (slot & 63) * 128, 128, tid, wave, lane); }
}

constexpr int KS_LD = 72, VT_LD = 264, P_LD = 232, NKEYS = 208;
constexpr int VT1_LD = 232;
__device__ __forceinline__ void attn_prompt_unit_v1(ArgsP a, int lj, unsigned char* lds, int b, int kvh, int qb, int, int, int) {
    const int tid = ltid(), lane = tid & 63, wave = __builtin_amdgcn_readfirstlane(tid >> 6);
    const bf16* Q = (const bf16*)(a->ws + WS_Q); const bf16* KV = (const bf16*)(a->ws + WS_KV); bf16* AO = (bf16*)(a->ws + WS_AO);
    bf16* Ks = (bf16*)lds; bf16* Vt = Ks + NKEYS * KS_LD; bf16* Pw = Vt + 64 * VT1_LD + wave * 16 * VT1_LD;
    const int fr = lane & 15, fq = lane >> 4, t0 = qb * 64, Rb = b * SEQ;
    for (int it = tid; it < NKEYS * 8; it += NTHREADS) { const int key = it >> 3, ch = it & 7;
        int row; if (key < 16) row = ROW_M + key; else { int s = t0 - 128 + key - 16; if (s < 0) s = 0; row = Rb + s; }
        *(u32x4*)(Ks + key * KS_LD + ch * 8) = *(const u32x4*)(KV + (size_t)row * KVW + kvh * 64 + ch * 8); }
    for (int it = tid; it < (NKEYS / 2) * 8; it += NTHREADS) { const int dbl = it & 7, kp = it >> 3;
        int r0, r1; { const int k0 = 2 * kp, k1 = k0 + 1; int s0 = t0 - 128 + k0 - 16, s1 = t0 - 128 + k1 - 16; if (s0 < 0) s0 = 0; if (s1 < 0) s1 = 0; r0 = (k0 < 16) ? ROW_M + k0 : Rb + s0; r1 = (k1 < 16) ? ROW_M + k1 : Rb + s1; }
        const u32x4 v0 = *(const u32x4*)(KV + (size_t)r0 * KVW + 256 + kvh * 64 + dbl * 8), v1 = *(const u32x4*)(KV + (size_t)r1 * KVW + 256 + kvh * 64 + dbl * 8);
        const unsigned a0[4] = {v0.x, v0.y, v0.z, v0.w}, a1[4] = {v1.x, v1.y, v1.z, v1.w};
#pragma unroll
        for (int j = 0; j < 4; ++j) {
            *(unsigned*)(Vt + (dbl * 8 + 2 * j) * VT1_LD + 2 * kp) = (a0[j] & 0xffffu) | (a1[j] << 16);
            *(unsigned*)(Vt + (dbl * 8 + 2 * j + 1) * VT1_LD + 2 * kp) = (a0[j] >> 16) | (a1[j] & 0xffff0000u); } }
    { const int row = tid >> 3, c = NKEYS + 2 * (tid & 7); *(unsigned*)(Vt + row * VT1_LD + c) = 0u; }
    __syncthreads();
    const int r = wave >> 1, th = (wave & 1) * 32, qh = kvh * 4 + r;
    const float sink = a->in[I_SINKS][lj * NQ + qh];
#pragma unroll 1
    for (int blk = 0; blk < 2; ++blk) {
        const int tq0 = t0 + th + blk * 16, t = tq0 + fr;
        bf16x8 qa[2];
#pragma unroll
        for (int ks = 0; ks < 2; ++ks) qa[ks] = *(const bf16x8*)(Q + (size_t)(Rb + t) * DM + qh * 64 + 32 * ks + 8 * fq);
        f32x4 sc[13];
#pragma unroll
        for (int ni = 0; ni < 13; ++ni) sc[ni] = (f32x4){0.f, 0.f, 0.f, 0.f};
#pragma unroll
        for (int ni = 0; ni < 13; ++ni) {
            const bf16x8 b0 = *(const bf16x8*)(Ks + (16 * ni + fr) * KS_LD + 8 * fq), b1 = *(const bf16x8*)(Ks + (16 * ni + fr) * KS_LD + 32 + 8 * fq);
            sc[ni] = MFMA16(b0, qa[0], sc[ni]); sc[ni] = MFMA16(b1, qa[1], sc[ni]);
            if ((ni & 3) == 3) asm volatile("" ::: "memory"); }
        float mx = -INFINITY;
#pragma unroll
        for (int ni = 0; ni < 13; ++ni)
#pragma unroll
            for (int j = 0; j < 4; ++j) { const int key = 16 * ni + 4 * fq + j; bool vis = true;
                if (key >= 16) { const int s = t0 - 128 + key - 16; vis = (s >= 0) && (s <= t) && (s > t - 128); }
                const float v = vis ? sc[ni][j] * 0.125f : -INFINITY; sc[ni][j] = v; mx = fmaxf(mx, v); }
        mx = fmaxf(mx, __shfl_xor(mx, 16)); mx = fmaxf(mx, __shfl_xor(mx, 32)); mx = fmaxf(mx, sink);
        float sum = 0.f;
#pragma unroll
        for (int ni = 0; ni < 13; ++ni)
#pragma unroll
            for (int j = 0; j < 4; ++j) { const float p = __expf(sc[ni][j] - mx); sc[ni][j] = p; sum += p; }
        sum += __shfl_xor(sum, 16); sum += __shfl_xor(sum, 32); sum += __expf(sink - mx);
        const float inv = frcp(sum);
#pragma unroll
        for (int ni = 0; ni < 13; ++ni) { u32x2 w; w.x = pkbf(sc[ni][0] * inv, sc[ni][1] * inv); w.y = pkbf(sc[ni][2] * inv, sc[ni][3] * inv); *(u32x2*)(Pw + fr * VT1_LD + 16 * ni + 4 * fq) = w; }
        *(u32x2*)(Pw + fr * VT1_LD + NKEYS + 4 * fq) = (u32x2){0u, 0u};
        asm volatile("s_waitcnt lgkmcnt(0)" ::: "memory");
        f32x4 o[4];
#pragma unroll
        for (int ni = 0; ni < 4; ++ni) o[ni] = (f32x4){0.f, 0.f, 0.f, 0.f};
#pragma unroll
        for (int ks = 0; ks < 7; ++ks) { const bf16x8 af = *(const bf16x8*)(Pw + fr * VT1_LD + 32 * ks + 8 * fq);
#pragma unroll
            for (int ni = 0; ni < 4; ++ni) { const bf16x8 bb = *(const bf16x8*)(Vt + (16 * ni + fr) * VT1_LD + 32 * ks + 8 * fq); o[ni] = MFMA16(bb, af, o[ni]); }
            if (ks & 1) asm volatile("" ::: "memory"); }
#pragma unroll
        for (int ni = 0; ni < 4; ++ni) { u32x2 w; w.x = pkbf(o[ni][0], o[ni][1]); w.y = pkbf(o[ni][2], o[ni][3]); *(u32x2*)(AO + (size_t)(Rb + t) * DM + qh * 64 + 16 * ni + 4 * fq) = w; }
        asm volatile("s_waitcnt lgkmcnt(0)" ::: "memory");
    }
    __syncthreads();
}
__device__ __forceinline__ void attn_prompt_unit(ArgsP a, int lj, unsigned char* lds, int b, int kvh, int qb, int, int, int) {
    const int tid = ltid(), lane = tid & 63, wave = __builtin_amdgcn_readfirstlane(tid >> 6);
    const bf16* __restrict__ Q = (const bf16*)(a->ws + WS_Q); const bf16* __restrict__ KV = (const bf16*)(a->ws + WS_KV); bf16* __restrict__ AO = (bf16*)(a->ws + WS_AO);
    bf16* Ks = (bf16*)lds; bf16* Vt = Ks + NKEYS * KS_LD; bf16* Pw = Vt + 64 * VT_LD + wave * 16 * P_LD;
    const int fr = lane & 15, fq = lane >> 4, t0 = qb * 64, Rb = b * SEQ;
    const int r = wave >> 1, th = (wave & 1) * 32, qh = kvh * 4 + r;
    bf16x8 q0[2], q1[2];
#pragma unroll
    for (int ks = 0; ks < 2; ++ks) { q0[ks] = *(const bf16x8*)(Q + (size_t)(Rb + t0 + th + fr) * DM + qh * 64 + 32 * ks + 8 * fq); q1[ks] = *(const bf16x8*)(Q + (size_t)(Rb + t0 + th + 16 + fr) * DM + qh * 64 + 32 * ks + 8 * fq); }
    {
        u32x4 kv[4];
#pragma unroll
        for (int k = 0; k < 4; ++k) { const int it = tid + NTHREADS * k, key = it >> 3, ch = it & 7; kv[k] = (u32x4){0u, 0u, 0u, 0u};
            if (it < NKEYS * 8) { int row; if (key < 16) row = ROW_M + key; else { int s = t0 - 128 + key - 16; if (s < 0) s = 0; row = Rb + s; }
                kv[k] = *(const u32x4*)(KV + (size_t)row * KVW + kvh * 64 + ch * 8); } }
        u32x4 v0[2], v1[2];
#pragma unroll
        for (int k = 0; k < 2; ++k) { const int it = tid + NTHREADS * k, dbl = it & 7, kp = it >> 3; v0[k] = (u32x4){0u, 0u, 0u, 0u}; v1[k] = v0[k];
            if (it < (NKEYS / 2) * 8) { const int k0 = 2 * kp, k1 = k0 + 1; int s0 = t0 - 128 + k0 - 16, s1 = t0 - 128 + k1 - 16; if (s0 < 0) s0 = 0; if (s1 < 0) s1 = 0;
                const int r0 = (k0 < 16) ? ROW_M + k0 : Rb + s0, r1 = (k1 < 16) ? ROW_M + k1 : Rb + s1;
                v0[k] = *(const u32x4*)(KV + (size_t)r0 * KVW + 256 + kvh * 64 + dbl * 8); v1[k] = *(const u32x4*)(KV + (size_t)r1 * KVW + 256 + kvh * 64 + dbl * 8); } }
#pragma unroll
        for (int k = 0; k < 4; ++k) { const int it = tid + NTHREADS * k, key = it >> 3, ch = it & 7; if (it < NKEYS * 8) *(u32x4*)(Ks + key * KS_LD + ch * 8) = kv[k]; }
#pragma unroll
        for (int k = 0; k < 2; ++k) { const int it = tid + NTHREADS * k, dbl = it & 7, kp = it >> 3;
            if (it < (NKEYS / 2) * 8) { const int col = (2 * kp) ^ (8 * dbl);
                const unsigned a0[4] = {v0[k].x, v0[k].y, v0[k].z, v0[k].w}, a1[4] = {v1[k].x, v1[k].y, v1[k].z, v1[k].w};
#pragma unroll
                for (int j = 0; j < 4; ++j) {
                    *(unsigned*)(Vt + (dbl * 8 + 2 * j) * VT_LD + col) = (a0[j] & 0xffffu) | (a1[j] << 16);
                    *(unsigned*)(Vt + (dbl * 8 + 2 * j + 1) * VT_LD + col) = (a0[j] >> 16) | (a1[j] & 0xffff0000u); } } }
#pragma unroll
        for (int k = 0; k < 3; ++k) { const int idx = tid + NTHREADS * k, row = idx / 24, c = idx - row * 24; *(unsigned*)(Vt + row * VT_LD + ((NKEYS + 2 * c) ^ TSW(row))) = 0u; }
    }
    __syncthreads();
    const float sink = a->in[I_SINKS][lj * NQ + qh];
#pragma unroll 1
    for (int blk = 0; blk < 2; ++blk) {
        const int tq = th + blk * 16 + fr, t = t0 + tq;
        bf16x8 qa2[2];
#pragma unroll
        for (int ks = 0; ks < 2; ++ks) qa2[ks] = (blk == 0) ? q0[ks] : q1[ks];
        f32x4 sc[13];
#pragma unroll
        for (int ni = 0; ni < 13; ++ni) sc[ni] = (f32x4){0.f, 0.f, 0.f, 0.f};
#pragma unroll
        for (int ni = 0; ni < 13; ++ni) {
            const bf16x8 b0 = *(const bf16x8*)(Ks + (16 * ni + fr) * KS_LD + 8 * fq), b1 = *(const bf16x8*)(Ks + (16 * ni + fr) * KS_LD + 32 + 8 * fq);
            sc[ni] = MFMA16(b0, qa2[0], sc[ni]); sc[ni] = MFMA16(b1, qa2[1], sc[ni]);
            if ((ni & 3) == 3) asm volatile("" ::: "memory"); }
        int lo = tq + 17; { const int l2 = 144 - t0; if (l2 > lo) lo = l2; }
        const unsigned span = (unsigned)(tq + 144 - lo);
        float mx = -INFINITY;
#pragma unroll
        for (int ni = 0; ni < 13; ++ni)
#pragma unroll
            for (int j = 0; j < 4; ++j) { const int key = 16 * ni + 4 * fq + j; const bool vis = (ni == 0) || ((unsigned)(key - lo) <= span);
                const float v = vis ? sc[ni][j] * 0.125f : -INFINITY; sc[ni][j] = v; mx = fmaxf(mx, v); }
        mx = fmaxf(mx, __shfl_xor(mx, 16)); mx = fmaxf(mx, __shfl_xor(mx, 32)); mx = fmaxf(mx, sink);
        float sum = 0.f;
#pragma unroll
        for (int ni = 0; ni < 13; ++ni)
#pragma unroll
            for (int j = 0; j < 4; ++j) { const float p = __expf(sc[ni][j] - mx); sc[ni][j] = p; sum += p; }
        sum += __shfl_xor(sum, 16); sum += __shfl_xor(sum, 32); sum += __expf(sink - mx);
        const float inv = frcp(sum);
#pragma unroll
        for (int ni = 0; ni < 13; ++ni) { u32x2 w; w.x = pkbf(sc[ni][0] * inv, sc[ni][1] * inv); w.y = pkbf(sc[ni][2] * inv, sc[ni][3] * inv); *(u32x2*)(Pw + fr * P_LD + 16 * ni + 4 * fq) = w; }
        *(u32x2*)(Pw + fr * P_LD + NKEYS + 4 * fq) = (u32x2){0u, 0u};
        asm volatile("s_waitcnt lgkmcnt(0)" ::: "memory");
        f32x4 o[4];
#pragma unroll
        for (int ni = 0; ni < 4; ++ni) o[ni] = (f32x4){0.f, 0.f, 0.f, 0.f};
#pragma unroll
        for (int ks = 0; ks < 7; ++ks) { const bf16x8 af = *(const bf16x8*)(Pw + fr * P_LD + 32 * ks + 8 * fq);
#pragma unroll
            for (int ni = 0; ni < 4; ++ni) { const int vr = 16 * ni + fr; const bf16x8 bb = *(const bf16x8*)(Vt + vr * VT_LD + ((32 * ks + 8 * fq) ^ TSW(vr))); o[ni] = MFMA16(bb, af, o[ni]); }
            if (ks & 1) asm volatile("" ::: "memory"); }
#pragma unroll
        for (int ni = 0; ni < 4; ++ni) { u32x2 w; w.x = pkbf(o[ni][0], o[ni][1]); w.y = pkbf(o[ni][2], o[ni][3]); *(u32x2*)(AO + (size_t)(Rb + t) * DM + qh * 64 + 16 * ni + 4 * fq) = w; }
        asm volatile("s_waitcnt lgkmcnt(0)" ::: "memory");
    }
    __syncthreads();
}
constexpr int SK_LD = 72, SV_LD = 200, SP_LD = 168, SKEYS = 160;
__device__ __forceinline__ void attn_sample_pair(ArgsP a, int lj, unsigned char* lds, int bp, int kvh, int, int, int) {
    const int tid = ltid(), lane = tid & 63, wave = __builtin_amdgcn_readfirstlane(tid >> 6);
    const bf16* __restrict__ Q = (const bf16*)(a->ws + WS_Q); const bf16* __restrict__ KV = (const bf16*)(a->ws + WS_KV); bf16* __restrict__ AO = (bf16*)(a->ws + WS_AO);
    const float* __restrict__ CK = a->in[I_CK]; const float* __restrict__ CV = a->in[I_CV];
    constexpr int HALF_B = (SKEYS * SK_LD + 64 * SV_LD) * 2;
    const int fr = lane & 15, fq = lane >> 4;
#pragma unroll 1
    for (int it = tid; it < 2 * SKEYS * 8; it += NTHREADS) { const int hf = it / (SKEYS * 8), rem = it - hf * (SKEYS * 8), key = rem >> 3, ch = rem & 7, bb = 2 * bp + hf;
        bf16* Ks = (bf16*)(lds + hf * HALF_B);
        u32x4 w = (u32x4){0u, 0u, 0u, 0u};
        if (key < 16) w = *(const u32x4*)(KV + (size_t)(ROW_M + key) * KVW + kvh * 64 + ch * 8);
        else if (key < 144) { const float* p = CK + ((size_t)(bb * 128 + (key - 16)) * NKV + kvh) * 64 + ch * 8; const f32x4 x0 = *(const f32x4*)p, x1 = *(const f32x4*)(p + 4);
            w.x = pkbf(x0.x, x0.y); w.y = pkbf(x0.z, x0.w); w.z = pkbf(x1.x, x1.y); w.w = pkbf(x1.z, x1.w); }
        else if (key < 152) w = *(const u32x4*)(KV + (size_t)(ROW_S + bb * 8 + (key - 144)) * KVW + kvh * 64 + ch * 8);
        *(u32x4*)(Ks + key * SK_LD + ch * 8) = w; }
#pragma unroll 1
    for (int it = tid; it < 2 * 96 * 8; it += NTHREADS) { const int hf = it / (96 * 8), rem = it - hf * (96 * 8), dbl = rem & 7, kp = rem >> 3, bb = 2 * bp + hf;
        bf16* Vt = (bf16*)(lds + hf * HALF_B) + SKEYS * SK_LD;
        unsigned a0[4] = {0u, 0u, 0u, 0u}, a1[4] = {0u, 0u, 0u, 0u};
        const int k0 = 2 * kp;
        if (k0 < 16) { const u32x4 x = *(const u32x4*)(KV + (size_t)(ROW_M + k0) * KVW + 256 + kvh * 64 + dbl * 8), y = *(const u32x4*)(KV + (size_t)(ROW_M + k0 + 1) * KVW + 256 + kvh * 64 + dbl * 8);
            a0[0] = x.x; a0[1] = x.y; a0[2] = x.z; a0[3] = x.w; a1[0] = y.x; a1[1] = y.y; a1[2] = y.z; a1[3] = y.w; }
        else if (k0 < 144) { const float* p = CV + ((size_t)(bb * 128 + (k0 - 16)) * NKV + kvh) * 64 + dbl * 8; const f32x4 x0 = *(const f32x4*)p, x1 = *(const f32x4*)(p + 4), y0 = *(const f32x4*)(p + NKV * 64), y1 = *(const f32x4*)(p + NKV * 64 + 4);
            a0[0] = pkbf(x0.x, x0.y); a0[1] = pkbf(x0.z, x0.w); a0[2] = pkbf(x1.x, x1.y); a0[3] = pkbf(x1.z, x1.w); a1[0] = pkbf(y0.x, y0.y); a1[1] = pkbf(y0.z, y0.w); a1[2] = pkbf(y1.x, y1.y); a1[3] = pkbf(y1.z, y1.w); }
        else if (k0 < 152) { const u32x4 x = *(const u32x4*)(KV + (size_t)(ROW_S + bb * 8 + (k0 - 144)) * KVW + 256 + kvh * 64 + dbl * 8), y = *(const u32x4*)(KV + (size_t)(ROW_S + bb * 8 + (k0 - 143)) * KVW + 256 + kvh * 64 + dbl * 8);
            a0[0] = x.x; a0[1] = x.y; a0[2] = x.z; a0[3] = x.w; a1[0] = y.x; a1[1] = y.y; a1[2] = y.z; a1[3] = y.w; }
        const int col = (2 * kp) ^ (8 * dbl);
#pragma unroll
        for (int j = 0; j < 4; ++j) {
            *(unsigned*)(Vt + (dbl * 8 + 2 * j) * SV_LD + col) = (a0[j] & 0xffffu) | (a1[j] << 16);
            *(unsigned*)(Vt + (dbl * 8 + 2 * j + 1) * SV_LD + col) = (a0[j] >> 16) | (a1[j] & 0xffff0000u); } }
    if (lj == 0) {
#pragma unroll 1
        for (int it = tid; it < 2 * 128 * 16; it += NTHREADS) { const int hf = it >> 11, rem = it & 2047, w = rem >> 4, c4 = (rem & 15) * 4, bb = 2 * bp + hf;
            const size_t o = ((size_t)(bb * 128 + w) * NKV + kvh) * 64 + c4;
            f32x4 kx, vx;
            if (w < 120) { const size_t i = ((size_t)(bb * 128 + w + 8) * NKV + kvh) * 64 + c4; kx = *(const f32x4*)(CK + i); vx = *(const f32x4*)(CV + i); }
            else { const bf16* rp = KV + (size_t)(ROW_S + bb * 8 + (w - 120)) * KVW + kvh * 64 + c4; const u32x2 k2 = *(const u32x2*)rp, v2 = *(const u32x2*)(rp + 256);
                kx = (f32x4){bflo(k2.x), bfhi(k2.x), bflo(k2.y), bfhi(k2.y)}; vx = (f32x4){bflo(v2.x), bfhi(v2.x), bflo(v2.y), bfhi(v2.y)}; }
            *(f32x4*)(a->out + O_SCK + o) = kx; *(f32x4*)(a->out + O_SCV + o) = vx; }
    }
    __syncthreads();
    if (wave < 4) {
        const int hf = wave >> 1, rb = wave & 1, bb = 2 * bp + hf;
        const bf16* Ks = (const bf16*)(lds + hf * HALF_B); const bf16* Vt = Ks + SKEYS * SK_LD; bf16* Pw = (bf16*)(lds + 2 * HALF_B) + wave * 16 * SP_LD;
        const int r = 2 * rb + (fr >> 3), t = fr & 7, qh = kvh * 4 + r;
        const size_t qrow = (size_t)(ROW_S + bb * 8 + t);
        bf16x8 qa[2];
#pragma unroll
        for (int ks = 0; ks < 2; ++ks) qa[ks] = *(const bf16x8*)(Q + qrow * DM + qh * 64 + 32 * ks + 8 * fq);
        const float sink = a->in[I_SINKS][lj * NQ + qh];
        f32x4 sc[10];
#pragma unroll
        for (int ni = 0; ni < 10; ++ni) sc[ni] = (f32x4){0.f, 0.f, 0.f, 0.f};
#pragma unroll
        for (int ni = 0; ni < 10; ++ni) {
            const bf16x8 b0 = *(const bf16x8*)(Ks + (16 * ni + fr) * SK_LD + 8 * fq), b1 = *(const bf16x8*)(Ks + (16 * ni + fr) * SK_LD + 32 + 8 * fq);
            sc[ni] = MFMA16(b0, qa[0], sc[ni]); sc[ni] = MFMA16(b1, qa[1], sc[ni]); }
        float mx = -INFINITY;
#pragma unroll
        for (int ni = 0; ni < 10; ++ni)
#pragma unroll
            for (int j = 0; j < 4; ++j) { const int key = 16 * ni + 4 * fq + j;
                const bool vis = (ni == 0) || ((key < 144) ? (key - 16 > t) : (key - 144 <= t));
                const float v = vis ? sc[ni][j] * 0.125f : -INFINITY; sc[ni][j] = v; mx = fmaxf(mx, v); }
        mx = fmaxf(mx, __shfl_xor(mx, 16)); mx = fmaxf(mx, __shfl_xor(mx, 32)); mx = fmaxf(mx, sink);
        float sum = 0.f;
#pragma unroll
        for (int ni = 0; ni < 10; ++ni)
#pragma unroll
            for (int j = 0; j < 4; ++j) { const float p = __expf(sc[ni][j] - mx); sc[ni][j] = p; sum += p; }
        sum += __shfl_xor(sum, 16); sum += __shfl_xor(sum, 32); sum += __expf(sink - mx);
        const float inv = frcp(sum);
#pragma unroll
        for (int ni = 0; ni < 10; ++ni) { u32x2 w; w.x = pkbf(sc[ni][0] * inv, sc[ni][1] * inv); w.y = pkbf(sc[ni][2] * inv, sc[ni][3] * inv); *(u32x2*)(Pw + fr * SP_LD + 16 * ni + 4 * fq) = w; }
        asm volatile("s_waitcnt lgkmcnt(0)" ::: "memory");
        f32x4 o[4];
#pragma unroll
        for (int ni = 0; ni < 4; ++ni) o[ni] = (f32x4){0.f, 0.f, 0.f, 0.f};
#pragma unroll
        for (int ks = 0; ks < 5; ++ks) { const bf16x8 af = *(const bf16x8*)(Pw + fr * SP_LD + 32 * ks + 8 * fq);
#pragma unroll
            for (int ni = 0; ni < 4; ++ni) { const int vr = 16 * ni + fr; const bf16x8 bb2 = *(const bf16x8*)(Vt + vr * SV_LD + ((32 * ks + 8 * fq) ^ TSW(vr))); o[ni] = MFMA16(bb2, af, o[ni]); } }
#pragma unroll
        for (int ni = 0; ni < 4; ++ni) { u32x2 w; w.x = pkbf(o[ni][0], o[ni][1]); w.y = pkbf(o[ni][2], o[ni][3]); *(u32x2*)(AO + qrow * DM + qh * 64 + 16 * ni + 4 * fq) = w; }
    }
    __syncthreads();
}
__device__ __forceinline__ void attn_sample_unit(ArgsP a, int lj, unsigned char* lds, int b, int kvh, int, int, int) {
    const int tid = ltid(), lane = tid & 63, wave = __builtin_amdgcn_readfirstlane(tid >> 6);
    const bf16* Q = (const bf16*)(a->ws + WS_Q); const bf16* KV = (const bf16*)(a->ws + WS_KV); bf16* AO = (bf16*)(a->ws + WS_AO);
    float* Kf = (float*)lds; float* Vf = Kf + 152 * 65; float* Qf = Vf + 152 * 64; float* Sc = Qf + 32 * 64;
    for (int idx = tid; idx < 152 * 64; idx += NTHREADS) { const int s = idx >> 6, d = idx & 63; float kv, vv;
        if (s < 16) { const bf16* rowp = KV + (size_t)(ROW_M + s) * KVW + kvh * 64 + d; kv = bf2f(rowp[0]); vv = bf2f(rowp[256]); }
        else if (s < 144) { const size_t o = ((size_t)(b * 128 + (s - 16)) * NKV + kvh) * 64 + d; kv = a->in[I_CK][o]; vv = a->in[I_CV][o]; }
        else { const bf16* rowp = KV + (size_t)(ROW_S + b * 8 + (s - 144)) * KVW + kvh * 64 + d; kv = bf2f(rowp[0]); vv = bf2f(rowp[256]); }
        Kf[s * 65 + d] = kv; Vf[s * 64 + d] = vv; }
    for (int idx = tid; idx < 32 * 64; idx += NTHREADS) { const int qi = idx >> 6, d = idx & 63, r = qi >> 3, t = qi & 7;
        Qf[qi * 64 + d] = bf2f(Q[(size_t)(ROW_S + b * 8 + t) * DM + (kvh * 4 + r) * 64 + d]); }
    __syncthreads();
    if (lj == 0) {
        for (int idx = tid; idx < 128 * 64; idx += NTHREADS) { const int w = idx >> 6, d = idx & 63; const size_t o = ((size_t)(b * 128 + w) * NKV + kvh) * 64 + d;
            a->out[O_SCK + o] = Kf[(24 + w) * 65 + d]; a->out[O_SCV + o] = Vf[(24 + w) * 64 + d]; }
    }
    for (int idx = tid; idx < 32 * 152; idx += NTHREADS) { const int qi = idx / 152, s = idx - qi * 152, t = qi & 7;
        float dot = 0.f;
#pragma unroll 16
        for (int d = 0; d < 64; ++d) dot += Qf[qi * 64 + d] * Kf[s * 65 + d];
        const bool vis = (s < 16) || ((s < 144) ? ((s - 16) > t) : ((s - 144) <= t));
        Sc[qi * 153 + s] = vis ? dot * 0.125f : -INFINITY; }
    __syncthreads();
#pragma unroll 1
    for (int q = 0; q < 4; ++q) { const int qi = wave * 4 + q, r = qi >> 3; const float sink = a->in[I_SINKS][lj * NQ + kvh * 4 + r];
        float v0 = Sc[qi * 153 + lane], v1 = Sc[qi * 153 + 64 + lane], v2 = (lane < 24) ? Sc[qi * 153 + 128 + lane] : -INFINITY;
        float mx = fmaxf(fmaxf(v0, v1), v2);
#pragma unroll
        for (int o = 1; o < 64; o <<= 1) mx = fmaxf(mx, __shfl_xor(mx, o));
        mx = fmaxf(mx, sink);
        v0 = __expf(v0 - mx); v1 = __expf(v1 - mx); v2 = __expf(v2 - mx);
        const float sum = wave_sum(v0 + v1 + v2) + __expf(sink - mx), inv = frcp(sum);
        Sc[qi * 153 + lane] = v0 * inv; Sc[qi * 153 + 64 + lane] = v1 * inv; if (lane < 24) Sc[qi * 153 + 128 + lane] = v2 * inv; }
    __syncthreads();
    { const int qi = tid >> 4, d4 = (tid & 15) * 4, r = qi >> 3, t = qi & 7; f32x4 o = (f32x4){0.f, 0.f, 0.f, 0.f};
#pragma unroll 8
        for (int s = 0; s < 152; ++s) { const float p = Sc[qi * 153 + s]; const f32x4 v = *(const f32x4*)(Vf + s * 64 + d4); o = o + v * p; }
        u32x2 w; w.x = pkbf(o.x, o.y); w.y = pkbf(o.z, o.w);
        *(u32x2*)(AO + (size_t)(ROW_S + b * 8 + t) * DM + (kvh * 4 + r) * 64 + d4) = w; }
    __syncthreads();
}
__device__ __forceinline__ void phase_attn(ArgsP a, int lj, unsigned char* lds, int tid, int wave, int lane) {
    if (lj == 0) {
        const bf16* KV = (const bf16*)(a->ws + WS_KV);
        const int gt = blockIdx.x * NTHREADS + tid, NT = gridDim.x * NTHREADS;
        for (int e = gt; e < 2 * 128 * 512; e += NT) { const int b = e >> 16, w = (e >> 9) & 127, c = e & 511;
            const float v = bf2f(KV[(size_t)(b * SEQ + SEQ - 128 + w) * KVW + c]);
            if (c < 256) a->out[O_PCK + (size_t)(b * 128 + w) * 256 + c] = v; else a->out[O_PCV + (size_t)(b * 128 + w) * 256 + (c - 256)] = v; }
    }
#pragma unroll 1
#ifndef OLD_SAMPLE_ATTN
#define OLD_SAMPLE_ATTN 0
#endif
#if OLD_SAMPLE_ATTN
    for (int u = blockIdx.x; u < 1024 + 512; u += gridDim.x) {
        if (u < 1024) { const int qb = u & 127, kvh = (u >> 7) & 3, b = u >> 9; attn_prompt_unit(a, lj, lds, b, kvh, qb, tid, wave, lane); }
        else { const int su = u - 1024; attn_sample_unit(a, lj, lds, su >> 2, su & 3, tid, wave, lane); }
    }
#else
#ifndef OLD_PROMPT_ATTN
#define OLD_PROMPT_ATTN 0
#endif
    for (int u = blockIdx.x; u < 1024 + 256; u += gridDim.x) {
        if (u < 1024) { const int qb = u & 127, kvh = (u >> 7) & 3, b = u >> 9;
            if (OLD_PROMPT_ATTN) attn_prompt_unit_v1(a, lj, lds, b, kvh, qb, tid, wave, lane); else attn_prompt_unit(a, lj, lds, b, kvh, qb, tid, wave, lane); }
        else { const int su = u - 1024; attn_sample_pair(a, lj, lds, su >> 2, su & 3, tid, wave, lane); }
    }
#endif
}

constexpr int NPHASES = 36;
template <class Epi> __device__ __forceinline__ void run_gemm(LAS unsigned char* lds, const bf16* A, const bf16* Bt, int N, int K, const Epi& E) {
    pg8::Gemm g{A, Bt, MP, N, K}; pg8::StaticOrder S; S.init(MP, N, K, (int)gridDim.x, (int)blockIdx.x);
    pg8::gemm_phase<Epi, pg8::StaticOrder, true, true>(lds, g, S, E);
}
template <class Epi> __device__ __forceinline__ void run_gemm_res(LAS unsigned char* lds, const bf16* A, const bf16* Bt, int K, int S_, const Epi& E) {
    pg8::Gemm g{A, Bt, MP, 1024, K}; pg8::ResOrder S; S.init(K, S_, (int)gridDim.x, (int)blockIdx.x);
    pg8::gemm_phase<Epi, pg8::ResOrder, true, true>(lds, g, S, E);
}

__global__ void __launch_bounds__(NTHREADS, 2) yoco_fwd(Args args) {
    extern __shared__ __attribute__((aligned(16))) unsigned char lds[];
    LAS unsigned char* ldsl = (LAS unsigned char*)lds;
    const int tid0 = threadIdx.x;
    for (int u = tid0; u < (LDS_BYTES - LDSCTL_OFF) / 4; u += NTHREADS) ((LAS unsigned*)(ldsl + LDSCTL_OFF))[u] = 0u;
    __syncthreads();
    const int lo = args.ph_lo, hi = args.ph_hi;
    XcdBarrier bar; bar.bar = (unsigned*)(args.ws + WS_CTL) + CW_BAR; bar.x = 0; bar.st = nullptr;
    if (hi - lo > 1) bar = xcd_barrier_post((unsigned*)(args.ws + WS_CTL) + CW_BAR, (volatile LAS unsigned*)(ldsl + MISC_OFF) + 8);
    int rep = 0;
#pragma unroll 1
    for (int p = lo; p < hi;) {
        ArgsP la = (ArgsP)__builtin_amdgcn_kernarg_segment_ptr(); asm volatile("" : "+s"(la));
        unsigned char* ws = la->ws;
        const int tid = ltid();
        const int lane = tid & 63, wave = __builtin_amdgcn_readfirstlane(tid >> 6);
        bf16* HN = (bf16*)(ws + WS_HN); float* H = (float*)(ws + WS_H);
        int kind, li = 0, lj = 0, layer = 0;
        if (p == 0) kind = 0;
        else if (p < 21) { li = (p - 1) / 10; layer = li; const int sub = (p - 1) % 10;
            kind = (sub == 0) ? (li == 0 ? 2 : 1) : (sub == 1) ? 3 : (sub == 2) ? 4 : (sub == 3) ? 5 : (sub == 4) ? 6 : (sub == 5) ? 7 : (sub == 6) ? 8 : (sub == 7) ? 1 : (sub == 8) ? 9 : 10; }
        else if (p < 35) { lj = (p - 21) / 7; layer = 2 + lj; const int sub = (p - 21) % 7;
            kind = (sub == 0) ? 1 : (sub == 1) ? 11 : (sub == 2) ? 12 : (sub == 3) ? 13 : (sub == 4) ? 1 : (sub == 5) ? 9 : 10; }
        else kind = 14;
#ifndef KMASK
#define KMASK 0xffff
#endif
#define KON(k) ((KMASK >> (k)) & 1)
#ifndef REP_MASK
#define REP_MASK 0
#endif
        if (KON(0) && kind == 0) phase_prologue(la, ldsl, wave, lane);
        else if (KON(1) && kind == 1) { const int sub = (p < 21) ? (p - 1) % 10 : (p - 21) % 7; phase_norm(la, 0, (p >= 21 && sub == 4) ? 4 : 8, wave, lane); }
        else if (KON(1) && kind == 2) phase_norm(la, 1, 0, wave, lane);
        else if (KON(3) && kind == 3) { pg8::EpiInProj E{(bf16*)(ws + WS_ZX), (float*)(ws + WS_DT), la->in[I_ADTB] + li * NHEADS}; run_gemm(ldsl, HN, (const bf16*)(ws + WS_WIN + li * SZ_WIN), INPROJ_P, 1024, E); }
        else if (KON(4) && kind == 4) phase_conv(la, li);
        else if (KON(5) && kind == 5) phase_ssd1(la, li, lds, tid, wave, lane);
        else if (KON(6) && kind == 6) phase_scan(la, li);
        else if (KON(7) && kind == 7) phase_ssd3(la, li, lds, tid, wave, lane);
        else if (KON(8) && (kind == 8 || kind == 10 || kind == 13)) {
            const bf16* A; const bf16* Bt; int K;
            if (kind == 8) { A = (const bf16*)(ws + WS_YN); Bt = (const bf16*)(ws + WS_WOUT + li * SZ_WOUT); K = 2048; }
            else if (kind == 10) { A = (const bf16*)(ws + WS_U); Bt = (const bf16*)(ws + WS_WDN + layer * SZ_WDN); K = 4096; }
            else { A = (const bf16*)(ws + WS_AO); Bt = (const bf16*)(ws + WS_WO + lj * SZ_WO); K = 1024; }
            pg8::EpiRes E{H, (float*)(ws + WS_SLAB)}; run_gemm_res(ldsl, A, Bt, K, K == 1024 ? 4 : 8, E); }
        else if (KON(9) && kind == 9) { pg8::EpiBf<1> E{(bf16*)(ws + WS_U), 4096, 1 << 20, nullptr, 0}; run_gemm(ldsl, HN, (const bf16*)(ws + WS_WUP + layer * SZ_WUP), 4096, 1024, E); }
        else if (KON(11) && kind == 11) { pg8::EpiBf<0> E{(bf16*)(ws + WS_Q), 1024, 4, (bf16*)(ws + WS_KV), KVW};
            run_gemm(ldsl, HN, (const bf16*)(ws + (lj == 0 ? WS_WQKV0 : WS_WQ1)), lj == 0 ? 1536 : 1024, 1024, E); }
        else if (KON(12) && kind == 12) phase_attn(la, lj, lds, tid, wave, lane);
        else if (KON(14) && kind == 14) phase_final(la, wave, lane);
        bool again = false;
        if (REP_MASK != 0) { if (rep == 0 && ((REP_MASK >> kind) & 1)) { rep = 1; again = true; } else rep = 0; }
        if (p + 1 < hi || again) xcd_barrier(bar); else { asm volatile("s_waitcnt vmcnt(0)" ::: "memory"); __syncthreads(); }
        if (!again) ++p;
    }
}

#ifndef MK_PER_PHASE
#define MK_PER_PHASE 0
#endif
extern "C" void kernel_launch(void* const* d_in, const int* in_sizes, int n_in, void* d_out, int out_size, void* d_ws, size_t ws_size, hipStream_t stream) {
    static int grid = 0;
    if (grid == 0) {
        if (n_in != 26 || (size_t)out_size != O_END || ws_size < WS_END) { fprintf(stderr, "kernel_launch: unexpected problem (n_in %d, out %d vs %zu, ws %zu vs %zu); nothing launched\n", n_in, out_size, (size_t)O_END, ws_size, (size_t)WS_END); grid = -1; return; }
        int dev = 0, cus = 0, per_cu = 0;
        if (hipGetDevice(&dev) != hipSuccess || hipDeviceGetAttribute(&cus, hipDeviceAttributeMultiprocessorCount, dev) != hipSuccess) { grid = -1; return; }
        if (hipFuncSetAttribute((const void*)yoco_fwd, hipFuncAttributeMaxDynamicSharedMemorySize, LDS_BYTES) != hipSuccess) { fprintf(stderr, "kernel_launch: hipFuncSetAttribute failed\n"); grid = -1; return; }
        if (hipOccupancyMaxActiveBlocksPerMultiprocessor(&per_cu, (const void*)yoco_fwd, NTHREADS, LDS_BYTES) != hipSuccess || per_cu < 1) { fprintf(stderr, "kernel_launch: occupancy query says %d\n", per_cu); per_cu = 1; }
        (void)hipGetLastError();
        if (cus != 256) { fprintf(stderr, "kernel_launch: built for a 256-CU device (got %d); nothing launched\n", cus); grid = -1; return; }
        grid = cus;
    }
    if (grid < 0) return;
    if (hipMemsetAsync((char*)d_ws + WS_CTL, 0, CTL_ZERO_BYTES, stream) != hipSuccess) { fprintf(stderr, "kernel_launch: memset failed\n"); return; }
    Args a{};
    for (int i = 0; i < 26; ++i) a.in[i] = (const float*)d_in[i];
    a.out = (float*)d_out; a.ws = (unsigned char*)d_ws;
#if MK_PER_PHASE
    for (int p = 0; p < NPHASES; ++p) { a.ph_lo = p; a.ph_hi = p + 1; hipLaunchKernelGGL(yoco_fwd, dim3(grid), dim3(NTHREADS), LDS_BYTES, stream, a); }
#else
    a.ph_lo = 0; a.ph_hi = NPHASES;
    void* kargs[] = {&a};
    hipError_t e = hipLaunchCooperativeKernel((const void*)yoco_fwd, dim3(grid), dim3(NTHREADS), kargs, LDS_BYTES, stream);
    if (e != hipSuccess) fprintf(stderr, "kernel_launch: cooperative launch failed: %s (grid %d)\n", hipGetErrorString(e), grid);
#endif
}
```

```cpp
#include <hip/hip_runtime.h>
#include <cstdio>
#include <cstdint>
#include <cmath>
namespace pg8 {
#define PG8_LAS __attribute__((address_space(3)))
typedef unsigned short bf16_t;
typedef short bf16x8 __attribute__((ext_vector_type(8)));
typedef float f32x4 __attribute__((ext_vector_type(4)));
typedef unsigned u32x4 __attribute__((ext_vector_type(4)));
constexpr int BM = 256, BK = 64, HALF = 128, HTB = HALF * BK * 2  , STAGE_BYTES = 8 * HTB, NXCD = 8, WGM = 8;

__host__ __device__ __forceinline__ int lds_byte(int r, int c) { const int st = (r >> 4) * 2 + (c >> 5), rr = r & 15, cc = c & 31, ob = rr * 64 + cc * 2; return st * 1024 + (ob ^ (((ob >> 9) & 1) << 5)); }
__host__ __device__ __forceinline__ void stage_rc(int b, int& R, int& C) { const int st = b / 1024, sb = b % 1024, swz = sb ^ (((sb >> 9) & 1) << 5); R = (st >> 1) * 16 + swz / 64; C = (st & 1) * 32 + (swz % 64) / 2; }
__host__ __device__ __forceinline__ int perm32(int rho) { const int n = rho >> 4, i = rho & 15; return 8 * (i >> 2) + 4 * n + (i & 3); }

struct Unit { int pm, pn, k0, nt, aux; };
struct Gemm { const bf16_t* A; const bf16_t* Bt; int M, N, K; };

struct StaticOrder {
    int nM, nN, nwg, G, c, nt0;
    __host__ __device__ void init(int M, int N, int K, int G_, int c_) { nM = M / BM; nN = N / BM; nwg = nM * nN; G = G_; c = c_; nt0 = K / BK; }
    __host__ __device__ bool next(int i, Unit& u) const {
        const long L = (long)i * G + c; if (L >= nwg) return false;
        int wgid = (int)L; { const int q = nwg / NXCD, r = nwg % NXCD, xcd = wgid % NXCD, off = wgid / NXCD; wgid = (xcd < r ? xcd * (q + 1) : r * (q + 1) + (xcd - r) * q) + off; }
        const int nig = WGM * nN, gid = wgid / nig, fm = gid * WGM, gsz = (nM - fm) < WGM ? (nM - fm) : WGM;
        u.pm = fm + ((wgid % nig) % gsz); u.pn = (wgid % nig) / gsz; u.k0 = 0; u.nt = nt0; u.aux = -1; return true;
    }
    __device__ __forceinline__ void a_ready(const Unit&) const {}
    __device__ __forceinline__ void done(const Unit&) const {}
};
struct ResOrder {
    StaticOrder so; int S, K, c;
    __host__ __device__ void init(int K_, int S_, int G_, int c_) { so.init(64 * BM, 1024, K_, G_, c_); S = S_; K = K_; c = c_; }
    __host__ __device__ bool next(int i, Unit& u) const {
        if (i == 0) return so.next(0, u);
        if (i == 1 && c < 20 * S) { const int t = c / S, sl = c - t * S; u.pm = 64 + (t >> 2); u.pn = t & 3; u.k0 = sl * (K / S); u.nt = K / S / BK; u.aux = sl; return true; }
        return false;
    }
    __device__ __forceinline__ void a_ready(const Unit&) const {}
    __device__ __forceinline__ void done(const Unit&) const {}
};

typedef float f32x2_cv0 __attribute__((ext_vector_type(2))); typedef __bf16 bf16x2_cv0 __attribute__((ext_vector_type(2)));
__device__ __forceinline__ unsigned cvt_pk_bf16(float lo, float hi) { const f32x2_cv0 v = {lo, hi}; const bf16x2_cv0 b = __builtin_convertvector(v, bf16x2_cv0); return __builtin_bit_cast(unsigned, b); }
typedef float f32x2 __attribute__((ext_vector_type(2)));
typedef unsigned u32x2 __attribute__((ext_vector_type(2)));
__device__ __forceinline__ float softplus_f(float x) { const float y = __expf(-fabsf(x)); const float l = (y < 0.03125f) ? y * (1.f - y * (0.5f - y * (1.f / 3.f - 0.25f * y))) : __logf(1.f + y); return fmaxf(x, 0.f) + l; }
struct EpiInProj {
    static constexpr bool PERM = true, AFTER_DRAIN = false;
    bf16_t* ZX; float* DT; const float* dt_bias;
    __device__ __forceinline__ void operator()(const f32x4 (&acc)[2][2][4][2], const Unit& u, int wr, int wc, int fr, int fq) const {
        const int row0 = u.pm * BM + wr * 64 + fr;
        if (u.pn < 24) {
            const int col0 = u.pn * BM + wc * 32 + 8 * fq;
#pragma unroll
            for (int ai = 0; ai < 2; ++ai)
#pragma unroll
                for (int m = 0; m < 4; ++m) { bf16_t* rowp = ZX + (size_t)(row0 + ai * HALF + m * 16) * 6144 + col0;
#pragma unroll
                    for (int bj = 0; bj < 2; ++bj) { const f32x4 v0 = acc[ai][bj][m][0], v1 = acc[ai][bj][m][1];
                        u32x4 w; w.x = cvt_pk_bf16(v0[0], v0[1]); w.y = cvt_pk_bf16(v0[2], v0[3]); w.z = cvt_pk_bf16(v1[0], v1[1]); w.w = cvt_pk_bf16(v1[2], v1[3]);
                        *(u32x4*)(rowp + bj * HALF) = w; } }
        } else if (wc == 0) {
            const int c0 = 8 * fq;
            const f32x4 b0 = *(const f32x4*)(dt_bias + c0), b1 = *(const f32x4*)(dt_bias + c0 + 4);
#pragma unroll
            for (int ai = 0; ai < 2; ++ai)
#pragma unroll
                for (int m = 0; m < 4; ++m) { float* rowp = DT + (size_t)(row0 + ai * HALF + m * 16) * 32 + c0;
                    const f32x4 v0 = acc[ai][0][m][0] + b0, v1 = acc[ai][0][m][1] + b1;
                    f32x4 o0, o1;
#pragma unroll
                    for (int j = 0; j < 4; ++j) { o0[j] = softplus_f(v0[j]); o1[j] = softplus_f(v1[j]); }
                    *(f32x4*)(rowp) = o0; *(f32x4*)(rowp + 4) = o1; }
        }
    }
};
struct EpiRes {
    static constexpr bool PERM = false, AFTER_DRAIN = false;
    const float* B; float* H; float* SLAB;
    __device__ __forceinline__ void operator()(const f32x4 (&acc)[2][2][4][2], const Unit& u, int wr, int wc, int fr, int fq) const {
        const int row0 = u.pm * BM + wr * 64 + fr, col0 = u.pn * BM + wc * 32 + 4 * fq;
        if (u.aux >= 0) {
            float* base = SLAB + (size_t)u.aux * (1280 * 1024) + (size_t)(row0 - 16384) * 1024 + col0;
#pragma unroll
            for (int ai = 0; ai < 2; ++ai)
#pragma unroll
                for (int m = 0; m < 4; ++m) { float* rowp = base + (size_t)(ai * HALF + m * 16) * 1024;
#pragma unroll
                    for (int bj = 0; bj < 2; ++bj)
#pragma unroll
                        for (int n = 0; n < 2; ++n) *(f32x4*)(rowp + bj * HALF + n * 16) = acc[ai][bj][m][n]; }
            return;
        }
#pragma unroll
        for (int ai = 0; ai < 2; ++ai)
#pragma unroll
            for (int m = 0; m < 4; ++m) { const size_t off = (size_t)(row0 + ai * HALF + m * 16) * 1024 + col0;
#pragma unroll
                for (int bj = 0; bj < 2; ++bj)
#pragma unroll
                    for (int n = 0; n < 2; ++n) *(f32x4*)(H + off + bj * HALF + n * 16) = *(const f32x4*)(B + off + bj * HALF + n * 16) + acc[ai][bj][m][n]; }
    }
};
template <int ACT> struct EpiBf {
    static constexpr bool PERM = true, AFTER_DRAIN = false;
    bf16_t* O0; int ldc0; int nsplit; bf16_t* O1; int ldc1;
    __device__ __forceinline__ void operator()(const f32x4 (&acc)[2][2][4][2], const Unit& u, int wr, int wc, int fr, int fq) const {
        const int row0 = u.pm * BM + wr * 64 + fr;
        bf16_t* base; int ldc, colt;
        if (u.pn < nsplit) { base = O0; ldc = ldc0; colt = u.pn * BM; } else { base = O1; ldc = ldc1; colt = (u.pn - nsplit) * BM; }
        const int col0 = colt + wc * 32 + 8 * fq;
#pragma unroll
        for (int ai = 0; ai < 2; ++ai)
#pragma unroll
            for (int m = 0; m < 4; ++m) { bf16_t* rowp = base + (size_t)(row0 + ai * HALF + m * 16) * ldc + col0;
#pragma unroll
                for (int bj = 0; bj < 2; ++bj) { f32x4 v0 = acc[ai][bj][m][0], v1 = acc[ai][bj][m][1];
                    if (ACT == 1) {
#pragma unroll
                        for (int j = 0; j < 4; ++j) { const float a = fmaxf(v0[j], 0.f), b = fmaxf(v1[j], 0.f); v0[j] = a * a; v1[j] = b * b; } }
                    u32x4 w; w.x = cvt_pk_bf16(v0[0], v0[1]); w.y = cvt_pk_bf16(v0[2], v0[3]); w.z = cvt_pk_bf16(v1[0], v1[1]); w.w = cvt_pk_bf16(v1[2], v1[3]);
                    *(u32x4*)(rowp + bj * HALF) = w; } }
    }
};

template <class Epi, class Sched, bool ALIGN_EPI = false, bool SP2 = false>
__device__ __forceinline__ void gemm_phase(PG8_LAS unsigned char* lds, const Gemm g, const Sched& S, const Epi& E) {
    int tid_l = threadIdx.x; asm volatile("" : "+v"(tid_l));
    const int tid = tid_l, wid = __builtin_amdgcn_readfirstlane(tid >> 6), lane = tid & 63, wr = wid >> 2, wc = wid & 3, fr = lane & 15, fq = lane >> 4;
    const int K = g.K;
    unsigned voffA[2], voffB[2];
#pragma unroll
    for (int i = 0; i < 2; ++i) { int R, C; stage_rc(tid * 16 + i * 8192, R, C); const int Rb = Epi::PERM ? ((R & ~31) + perm32(R & 31)) : R;
        voffA[i] = (unsigned)(R * K + C) * 2u; voffB[i] = (unsigned)(Rb * K + C) * 2u; }
    const size_t kstep = (size_t)(BK * 2);
    const size_t hstep = (size_t)HALF * K * 2;
    const size_t tstep = 2 * hstep;
    const unsigned ldsw = (unsigned)wid * 1024u;
    const int aoff = lds_byte(wr * 64 + fr, fq * 8), boff = lds_byte(wc * 32 + fr, fq * 8);
#define PG8_SA(b, h) (((b) * 2 + (h)) * HTB)
#define PG8_SB(b, h) ((4 + (b) * 2 + (h)) * HTB)
#define PG8_STAGE(bufoff, gbase, voff) do { _Pragma("unroll") for (int _i = 0; _i < 2; ++_i) \
        __builtin_amdgcn_global_load_lds((const unsigned*)((const char*)(gbase) + (voff)[_i]), (PG8_LAS unsigned*)(lds + (bufoff) + ldsw + _i * 8192), 16, 0, 0); } while (0)
#define PG8_LDA(dst, b, h) do { _Pragma("unroll") for (int m = 0; m < 4; ++m) _Pragma("unroll") for (int k = 0; k < 2; ++k) dst[m][k] = *(const PG8_LAS bf16x8*)(lds + PG8_SA(b, h) + aoff + m * 2048 + k * 1024); } while (0)
#define PG8_LDB(dst, b, h) do { _Pragma("unroll") for (int n = 0; n < 2; ++n) _Pragma("unroll") for (int k = 0; k < 2; ++k) dst[n][k] = *(const PG8_LAS bf16x8*)(lds + PG8_SB(b, h) + boff + n * 2048 + k * 1024); } while (0)
#define PG8_MMA(ai, bj, At, Bt) do { __builtin_amdgcn_s_setprio(1); _Pragma("unroll") for (int m = 0; m < 4; ++m) _Pragma("unroll") for (int n = 0; n < 2; ++n) _Pragma("unroll") for (int k = 0; k < 2; ++k) \
        acc[ai][bj][m][n] = __builtin_amdgcn_mfma_f32_16x16x32_bf16(Bt[n][k], At[m][k], acc[ai][bj][m][n], 0, 0, 0); __builtin_amdgcn_s_setprio(0); } while (0)
#define PG8_WAIT_V(n) asm volatile("s_waitcnt vmcnt(" #n ")" ::: "memory")
#define PG8_WAIT_L(n) asm volatile("s_waitcnt lgkmcnt(" #n ")" ::: "memory")
#define PG8_BAR __builtin_amdgcn_s_barrier()
#define PG8_SCHED __builtin_amdgcn_sched_barrier(0)
    Unit cur, nxt; int ui = 0;
    if (!S.next(0, cur)) return;
    f32x4 acc[2][2][4][2];
#pragma unroll
    for (int a = 0; a < 2; ++a)
#pragma unroll
        for (int b = 0; b < 2; ++b)
#pragma unroll
            for (int m = 0; m < 4; ++m)
#pragma unroll
                for (int n = 0; n < 2; ++n) acc[a][b][m][n] = (f32x4){0.f, 0.f, 0.f, 0.f};
    bf16x8 At[4][2], B0[2][2], B1[2][2];
    const char* cA = (const char*)g.A + (size_t)cur.pm * tstep + (size_t)cur.k0 * 2; const char* cB = (const char*)g.Bt + (size_t)cur.pn * tstep + (size_t)cur.k0 * 2;
    S.a_ready(cur);
    if constexpr (SP2) {
        PG8_STAGE(PG8_SB(0, 0), cB, voffB); PG8_STAGE(PG8_SB(0, 1), cB + hstep, voffB); PG8_STAGE(PG8_SA(0, 0), cA, voffA); PG8_STAGE(PG8_SA(0, 1), cA + hstep, voffA);
        if (wr == 1) PG8_BAR;
        PG8_WAIT_V(2); PG8_BAR;
        PG8_STAGE(PG8_SB(1, 0), cB + kstep, voffB); PG8_STAGE(PG8_SA(1, 0), cA + kstep, voffA); PG8_STAGE(PG8_SB(1, 1), cB + hstep + kstep, voffB);
        PG8_WAIT_V(6); PG8_BAR;
    } else {
        PG8_STAGE(PG8_SB(0, 0), cB, voffB); PG8_STAGE(PG8_SA(0, 0), cA, voffA); PG8_STAGE(PG8_SB(0, 1), cB + hstep, voffB); PG8_STAGE(PG8_SA(0, 1), cA + hstep, voffA);
        if (wr == 1) PG8_BAR;
        PG8_WAIT_V(4); PG8_BAR;
        PG8_STAGE(PG8_SB(1, 0), cB + kstep, voffB); PG8_STAGE(PG8_SA(1, 0), cA + kstep, voffA); PG8_STAGE(PG8_SB(1, 1), cB + hstep + kstep, voffB);
        PG8_WAIT_V(6); PG8_BAR;
    }
    for (;;) {
        const bool has_next = S.next(ui + 1, nxt);
        const char* nA = has_next ? (const char*)g.A + (size_t)nxt.pm * tstep + (size_t)nxt.k0 * 2 : cA; const char* nB = has_next ? (const char*)g.Bt + (size_t)nxt.pn * tstep + (size_t)nxt.k0 * 2 : cB;
        const int nt = cur.nt;
        for (int t = 0; t < nt; t += 2) {
            const bool last = (t == nt - 2);
            const char* a1 = cA + (size_t)(t + 1) * kstep;
            const char* a2 = last ? nA : cA + (size_t)(t + 2) * kstep; const char* b2 = last ? nB : cB + (size_t)(t + 2) * kstep;
            const char* a3 = a2 + kstep; const char* b3 = b2 + kstep;
            if (last && has_next) S.a_ready(nxt);
            if constexpr (SP2) {
            PG8_LDB(B0, 0, 0); PG8_LDB(B1, 0, 1); PG8_SCHED; PG8_LDA(At, 0, 0); PG8_STAGE(PG8_SA(1, 1), a1 + hstep, voffA);
            PG8_WAIT_V(8); PG8_WAIT_L(0); PG8_BAR; PG8_MMA(0, 0, At, B0); PG8_MMA(0, 1, At, B1); PG8_BAR; PG8_SCHED;
            PG8_LDA(At, 0, 1); PG8_STAGE(PG8_SB(0, 0), b2, voffB); PG8_STAGE(PG8_SB(0, 1), b2 + hstep, voffB); PG8_STAGE(PG8_SA(0, 0), a2, voffA);
            PG8_WAIT_V(8); PG8_WAIT_L(0); PG8_BAR; PG8_MMA(1, 0, At, B0); PG8_MMA(1, 1, At, B1); PG8_BAR; PG8_SCHED;
            PG8_LDB(B0, 1, 0); PG8_LDB(B1, 1, 1); PG8_SCHED; PG8_LDA(At, 1, 0); PG8_STAGE(PG8_SA(0, 1), a2 + hstep, voffA);
            PG8_WAIT_V(8); PG8_WAIT_L(0); PG8_BAR; PG8_MMA(0, 0, At, B0); PG8_MMA(0, 1, At, B1); PG8_BAR; PG8_SCHED;
            PG8_LDA(At, 1, 1); PG8_STAGE(PG8_SB(1, 0), b3, voffB); PG8_STAGE(PG8_SB(1, 1), b3 + hstep, voffB); PG8_STAGE(PG8_SA(1, 0), a3, voffA);
            PG8_WAIT_V(8); PG8_WAIT_L(0); PG8_BAR; PG8_MMA(1, 0, At, B0); PG8_MMA(1, 1, At, B1); PG8_BAR; PG8_SCHED;
            } else {
            PG8_LDB(B0, 0, 0); PG8_SCHED; PG8_LDA(At, 0, 0); PG8_STAGE(PG8_SA(1, 1), a1 + hstep, voffA);
            PG8_WAIT_L(8); PG8_BAR; PG8_WAIT_L(0); PG8_MMA(0, 0, At, B0); PG8_BAR; PG8_SCHED;
            PG8_LDB(B1, 0, 1); PG8_STAGE(PG8_SB(0, 0), b2, voffB);
            PG8_BAR; PG8_WAIT_L(0); PG8_MMA(0, 1, At, B1); PG8_BAR;
            PG8_LDA(At, 0, 1); PG8_STAGE(PG8_SA(0, 0), a2, voffA);
            PG8_BAR; PG8_WAIT_L(0); PG8_MMA(1, 0, At, B0); PG8_BAR; PG8_SCHED;
            PG8_STAGE(PG8_SB(0, 1), b2 + hstep, voffB);
            PG8_WAIT_V(6); PG8_BAR; PG8_MMA(1, 1, At, B1); PG8_BAR;
            PG8_LDB(B0, 1, 0); PG8_SCHED; PG8_LDA(At, 1, 0); PG8_STAGE(PG8_SA(0, 1), a2 + hstep, voffA);
            PG8_WAIT_L(8); PG8_BAR; PG8_WAIT_L(0); PG8_MMA(0, 0, At, B0); PG8_BAR; PG8_SCHED;
            PG8_LDB(B1, 1, 1); PG8_STAGE(PG8_SB(1, 0), b3, voffB);
            PG8_BAR; PG8_WAIT_L(0); PG8_MMA(0, 1, At, B1); PG8_BAR;
            PG8_LDA(At, 1, 1); PG8_STAGE(PG8_SA(1, 0), a3, voffA);
            PG8_BAR; PG8_WAIT_L(0); PG8_MMA(1, 0, At, B0); PG8_BAR; PG8_SCHED;
            PG8_STAGE(PG8_SB(1, 1), b3 + hstep, voffB);
            PG8_WAIT_V(6); PG8_BAR; PG8_MMA(1, 1, At, B1); PG8_BAR;
            }
        }
        if constexpr (ALIGN_EPI) { if (wr == 0) PG8_BAR; }
        if constexpr (!Epi::AFTER_DRAIN) { E(acc, cur, wr, wc, fr, fq); S.done(cur); }
        if (!has_next) break;
#pragma unroll
        for (int a = 0; a < 2; ++a)
#pragma unroll
            for (int b = 0; b < 2; ++b)
#pragma unroll
                for (int m = 0; m < 4; ++m)
#pragma unroll
                    for (int n = 0; n < 2; ++n) acc[a][b][m][n] = (f32x4){0.f, 0.f, 0.f, 0.f};
        cur = nxt; cA = nA; cB = nB; ++ui;
        if constexpr (ALIGN_EPI) { if (wr == 1) PG8_BAR; }
    }
    PG8_WAIT_V(0);
    if constexpr (!ALIGN_EPI) { if (wr == 0) PG8_BAR; }
    PG8_BAR;
    if constexpr (Epi::AFTER_DRAIN) { E.fused(acc, cur, wr, wc, fr, fq, lds, wid, lane); S.done(cur); }
#undef PG8_SA
#undef PG8_SB
#undef PG8_STAGE
#undef PG8_LDA
#undef PG8_LDB
#undef PG8_MMA
#undef PG8_WAIT_V
#undef PG8_WAIT_L
#undef PG8_BAR
#undef PG8_SCHED
}
}
#define GAS __attribute__((address_space(1)))
#define LAS __attribute__((address_space(3)))
typedef unsigned short bf16;
typedef unsigned v4u __attribute__((ext_vector_type(4)));
typedef float f32x4 __attribute__((ext_vector_type(4)));
typedef short bf16x8 __attribute__((ext_vector_type(8)));
typedef GAS unsigned gu32;
typedef GAS unsigned long long gu64;
#define RLX_AGENT __ATOMIC_RELAXED, __HIP_MEMORY_SCOPE_AGENT
#define LDS_WAIT() asm volatile("s_waitcnt lgkmcnt(0)" ::: "memory")
#define VM_WAIT() asm volatile("s_waitcnt vmcnt(0)" ::: "memory")
__device__ __forceinline__ unsigned long long rt() { return __builtin_amdgcn_s_memrealtime(); }
__device__ __forceinline__ unsigned f2bf(float f) { unsigned u = __builtin_bit_cast(unsigned, f); return (u + 0x7fffu + ((u >> 16) & 1u)) >> 16; }
__device__ __forceinline__ unsigned pk2(float lo, float hi) { return f2bf(lo) | (f2bf(hi) << 16); }

#define XB_TMO      128
#define XB_XCNT(j)  (256  + 64 * (j))
#define XB_XSUB(j)  (1280 + 64 * (j))
#define XB_XGEN(j)  (2304 + 64 * (j))
#define XB_TOP      3328
#define XB_TOPGEN   3392
#define XCD_BAR_WORDS 3456
#define XB_SPIN_CAP (1u << 18)

__device__ __forceinline__ unsigned xb_ld(unsigned* p)              { return __hip_atomic_load(p, __ATOMIC_RELAXED, __HIP_MEMORY_SCOPE_AGENT); }
__device__ __forceinline__ unsigned xb_add(unsigned* p, unsigned v) { return __hip_atomic_fetch_add(p, v, __ATOMIC_RELAXED, __HIP_MEMORY_SCOPE_AGENT); }
__device__ __forceinline__ unsigned xb_xcc_id() { return (unsigned)__builtin_amdgcn_s_getreg((3 << 11) | 20) & 0xFu; }
#define XB_SPIN(cond, bar) do { unsigned _sp = 0; while (cond) { __builtin_amdgcn_s_sleep(1); \
    if ((++_sp & 255u) == 0u) { if (xb_ld(&(bar)[XB_TMO])) break; if (_sp > XB_SPIN_CAP) { atomicAdd(&(bar)[XB_TMO], 1u); break; } } } } while (0)

struct XcdBarrier {
    unsigned* bar; unsigned x;
    volatile LAS unsigned* st;
};

__device__ __forceinline__ XcdBarrier xcd_barrier_post(unsigned* bar, volatile LAS unsigned* st) {
    XcdBarrier b; b.bar = bar; b.x = xb_xcc_id(); b.st = st;
    if (threadIdx.x == 0) (void)xb_add(&bar[XB_XCNT(b.x)], 1u);
    return b;
}
__device__ __forceinline__ void xcd_barrier_complete(unsigned* bar, unsigned x, unsigned& nloc, unsigned& nx) {
    const unsigned G = gridDim.x * gridDim.y * gridDim.z;
    unsigned sum, cnt, mine, sp = 0u;
    for (;;) {
        sum = 0u; cnt = 0u; mine = 0u;
#pragma unroll
        for (unsigned j = 0; j < 16; ++j) { const unsigned c = xb_ld(&bar[XB_XCNT(j)]); sum += c; cnt += (c > 0u) ? 1u : 0u; mine = (j == x) ? c : mine; }
        if (sum == G) break;
        __builtin_amdgcn_s_sleep(1);
        if ((++sp & 255u) == 0u) { if (xb_ld(&bar[XB_TMO])) break; if (sp > XB_SPIN_CAP) { atomicAdd(&bar[XB_TMO], 1u); break; } }
    }
    nloc = mine > 0u ? mine : 1u; nx = cnt > 0u ? cnt : 1u;
}

__device__ __forceinline__ void xcd_barrier(const XcdBarrier& b) {
    asm volatile("s_waitcnt vmcnt(0)" ::: "memory");
    __syncthreads();
    if (threadIdx.x == 0) {
        unsigned* bar = b.bar;
        __builtin_amdgcn_s_waitcnt(0);
        unsigned nloc = b.st[0], nx = b.st[1];
        if (nloc == 0u) { xcd_barrier_complete(bar, b.x, nloc, nx); b.st[0] = nloc; b.st[1] = nx; }
        const unsigned old = xb_add(&bar[XB_XSUB(b.x)], 1u);
        const unsigned gen = old / nloc;
        if (old + 1u == (gen + 1u) * nloc) {
            __builtin_amdgcn_fence(__ATOMIC_RELEASE, "agent");
            asm volatile("s_waitcnt vmcnt(0)" ::: "memory");
            const unsigned og = xb_add(&bar[XB_TOP], 1u);
            const unsigned tg = og / nx;
            if (og + 1u == (tg + 1u) * nx) xb_add(&bar[XB_TOPGEN], 1u);
            else XB_SPIN(xb_ld(&bar[XB_TOPGEN]) == tg, bar);
            __builtin_amdgcn_fence(__ATOMIC_ACQUIRE, "agent");
            xb_add(&bar[XB_XGEN(b.x)], 1u);
            asm volatile("s_waitcnt vmcnt(0)" ::: "memory");
        } else {
            XB_SPIN(xb_ld(&bar[XB_XGEN(b.x)]) == gen, bar);
            __builtin_amdgcn_fence(__ATOMIC_ACQUIRE, "agent");
            asm volatile("s_waitcnt vmcnt(0)" ::: "memory");
        }
    }
    __syncthreads();
}
constexpr int NWAVES = 8, NTHREADS = 512;
constexpr int DM = 1024, SEQ = 8192, NPROMPT = 2, NSAMP = 128, TSAMP = 8, NMETA = 16;
constexpr int ROW_S = NPROMPT * SEQ;
constexpr int ROW_M = ROW_S + NSAMP * TSAMP;
constexpr int NROWS = ROW_M + NMETA;
constexpr int MP = 17664;
constexpr int DINNER = 2048, NHEADS = 32, HD = 64, NGROUPS = 8, DSTATE = 128, CONVD = 4096, INPROJ = 6176, INPROJ_P = 6400, ZXW = 6144;
constexpr int DFF = 4096, NKV = 4, NQ = 16, KVW = 512;
constexpr float EPS = 1e-5f;
constexpr int LDX = 136;

constexpr size_t O_YP = 0, O_YS = O_YP + (size_t)NPROMPT * SEQ * DM, O_PCONV = O_YS + (size_t)NSAMP * TSAMP * DM, O_PSSM = O_PCONV + 2 * 2 * 3 * 4096,
    O_PCK = O_PSSM + (size_t)2 * 2 * 32 * 64 * 128, O_PCV = O_PCK + 2 * 128 * 256, O_SCONV = O_PCV + 2 * 128 * 256, O_SSSM = O_SCONV + (size_t)2 * 128 * 3 * 4096,
    O_SCK = O_SSSM + (size_t)2 * 128 * 32 * 64 * 128, O_SCV = O_SCK + (size_t)128 * 128 * 256, O_END = O_SCV + (size_t)128 * 128 * 256;

constexpr size_t MiB = 1u << 20;
constexpr size_t WS_CTL = 0, CTL_ZERO_BYTES = 1 * MiB;
constexpr size_t SZ_WIN = (size_t)INPROJ_P * 1024 * 2, SZ_WOUT = (size_t)1024 * 2048 * 2, SZ_WUP = (size_t)4096 * 1024 * 2, SZ_WDN = SZ_WUP, SZ_WQKV0 = (size_t)1536 * 1024 * 2, SZ_WQ1 = (size_t)1024 * 1024 * 2, SZ_WO = SZ_WQ1;
constexpr size_t WS_WIN = 1 * MiB, WS_WOUT = WS_WIN + 2 * SZ_WIN, WS_WUP = WS_WOUT + 2 * SZ_WOUT, WS_WDN = WS_WUP + 4 * SZ_WUP, WS_WQKV0 = WS_WDN + 4 * SZ_WDN, WS_WQ1 = WS_WQKV0 + SZ_WQKV0, WS_WO = WS_WQ1 + SZ_WQ1, WS_WEND = WS_WO + 2 * SZ_WO;
constexpr size_t al1m(size_t x) { return (x + MiB - 1) / MiB * MiB; }
constexpr size_t WS_H = al1m(WS_WEND), WS_HN = al1m(WS_H + (size_t)MP * 1024 * 4), WS_ZX = al1m(WS_HN + (size_t)MP * 1024 * 2), WS_DT = al1m(WS_ZX + (size_t)MP * ZXW * 2),
    WS_XC = al1m(WS_DT + (size_t)MP * 32 * 4), WS_YN = al1m(WS_XC + (size_t)MP * 4096 * 2), WS_CS = al1m(WS_YN + (size_t)MP * 2048 * 2), WS_CD = al1m(WS_CS + (size_t)129 * 32 * 8192 * 4), WS_SLAB = al1m(WS_CD + 129 * 32 * 4), WS_HSB = al1m(WS_SLAB + (size_t)8 * 1280 * 1024 * 4), WS_END = al1m(WS_HSB + (size_t)128 * 32 * 8192 * 2);
constexpr size_t WS_U = WS_ZX;
constexpr size_t WS_Q = WS_XC, WS_KV = WS_Q + (size_t)MP * 1024 * 2, WS_AO = WS_KV + (size_t)MP * 512 * 2;
static_assert(WS_AO + (size_t)MP * 1024 * 2 <= WS_YN, "attention overlay");
constexpr int CW_BAR = 4096;

constexpr int RING_BYTES = 131072, LDS_BYTES = 147456, LDSCTL_OFF = LDS_BYTES - 512, MISC_OFF = LDSCTL_OFF + 320;

typedef unsigned u32x2 __attribute__((ext_vector_type(2)));
typedef unsigned u32x4 __attribute__((ext_vector_type(4)));
__device__ __forceinline__ int ltid() { int t = threadIdx.x; asm volatile("" : "+v"(t)); return t; }
__device__ __forceinline__ float bf2f(unsigned short b) { return __uint_as_float((unsigned)b << 16); }
__device__ __forceinline__ float bflo(unsigned w) { return __uint_as_float(w << 16); }
__device__ __forceinline__ float bfhi(unsigned w) { return __uint_as_float(w & 0xffff0000u); }
__device__ __forceinline__ unsigned pkbf(float lo, float hi) { return pg8::cvt_pk_bf16(lo, hi); }
__device__ __forceinline__ float wave_sum(float v) {
#pragma unroll
    for (int o = 1; o < 64; o <<= 1) v += __shfl_xor(v, o);
    return v;
}
__device__ __forceinline__ float frcp(float x) { return __builtin_amdgcn_rcpf(x); }
__device__ __forceinline__ float sigmoid_f(float x) { return frcp(1.f + __expf(-x)); }
#define MFMA16(b, a, c) __builtin_amdgcn_mfma_f32_16x16x32_bf16((b), (a), (c), 0, 0, 0)

struct Args {
    const float* in[26]; float* out; unsigned char* ws; int ph_lo, ph_hi;
};
typedef const __attribute__((address_space(4))) Args* ArgsP;
enum { I_XP = 0, I_XS, I_SCONV, I_SSSM, I_CK, I_CV, I_META, I_ANORM, I_AIN, I_ACONVW, I_ACONVB, I_ADTB, I_ALOG, I_ADSKIP, I_AGATE, I_AOUT, I_KVNORM, I_WKV, I_BNORM, I_WQ, I_SINKS, I_WO, I_MLPNORM, I_WUP, I_WDOWN, I_FNORM };

__device__ __forceinline__ void transpose_item(const float* W, const float* scale, int K, int N, bf16* WT, int row_off, LAS unsigned* scr, int item, int lane) {
    const int nblk = (N + 63) / 64, kb = item / nblk, nb = item % nblk, k0 = 64 * kb, n0 = 64 * nb;
    const bool ok = (n0 + lane < N);
    const float* src = W + (size_t)k0 * N + n0 + (ok ? lane : 0);
#pragma unroll
    for (int h = 0; h < 2; ++h) {
        float v[32];
#pragma unroll
        for (int i = 0; i < 32; ++i) v[i] = src[(size_t)(32 * h + i) * N];
        if (!ok) {
#pragma unroll
            for (int i = 0; i < 32; ++i) v[i] = 0.f;
        }
        if (scale) {
#pragma unroll
            for (int i = 0; i < 32; ++i) v[i] *= scale[k0 + 32 * h + i];
        }
#pragma unroll
        for (int i = 0; i < 16; ++i) scr[lane * 33 + 16 * h + i] = pkbf(v[2 * i], v[2 * i + 1]);
    }
    LDS_WAIT(); asm volatile("" ::: "memory");
    const int c = lane & 7;
#pragma unroll
    for (int j = 0; j < 8; ++j) { const int n = (lane >> 3) + 8 * j; const LAS unsigned* sp = scr + n * 33 + 4 * c;
        v4u o; o.x = sp[0]; o.y = sp[1]; o.z = sp[2]; o.w = sp[3];
        if (n0 + n < N) *(GAS v4u*)(WT + (size_t)(row_off + n0 + n) * K + k0 + 8 * c) = o; }
    LDS_WAIT(); asm volatile("" ::: "memory");
}
struct WJob { const float* W; const float* scale; int K, N; bf16* WT; int row_off; int items; };

__device__ __forceinline__ void phase_prologue(ArgsP a, LAS unsigned char* lds, int wave, int lane) {
    LAS unsigned* scr = (LAS unsigned*)(lds + wave * 16384);
    const int gw = blockIdx.x * NWAVES + wave, NGW = gridDim.x * NWAVES;
    unsigned char* ws = a->ws;
    for (int jb = 0; jb < 21; ++jb) {
        WJob J;
        if (jb < 2)       { const int i = jb;      J = WJob{a->in[I_AIN] + (size_t)i * 1024 * INPROJ, a->in[I_ANORM] + i * 1024, 1024, INPROJ, (bf16*)(ws + WS_WIN + i * SZ_WIN), 0, 0}; }
        else if (jb < 4)  { const int i = jb - 2;  J = WJob{a->in[I_AOUT] + (size_t)i * 2048 * 1024, a->in[I_AGATE] + i * 2048, 2048, 1024, (bf16*)(ws + WS_WOUT + i * SZ_WOUT), 0, 0}; }
        else if (jb < 8)  { const int l = jb - 4;  J = WJob{a->in[I_WUP] + (size_t)l * 1024 * 4096, a->in[I_MLPNORM] + l * 1024, 1024, 4096, (bf16*)(ws + WS_WUP + l * SZ_WUP), 0, 0}; }
        else if (jb < 12) { const int l = jb - 8;  J = WJob{a->in[I_WDOWN] + (size_t)l * 4096 * 1024, nullptr, 4096, 1024, (bf16*)(ws + WS_WDN + l * SZ_WDN), 0, 0}; }
        else if (jb == 12) { J = WJob{a->in[I_WQ], a->in[I_BNORM], 1024, 1024, (bf16*)(ws + WS_WQKV0), 0, 0}; }
        else if (jb == 13) { J = WJob{a->in[I_WKV], a->in[I_KVNORM], 1024, 512, (bf16*)(ws + WS_WQKV0), 1024, 0}; }
        else if (jb == 14) { J = WJob{a->in[I_WQ] + (size_t)1024 * 1024, a->in[I_BNORM] + 1024, 1024, 1024, (bf16*)(ws + WS_WQ1), 0, 0}; }
        else if (jb < 17) { const int j = jb - 15; J = WJob{a->in[I_WO] + (size_t)j * 1024 * 1024, nullptr, 1024, 1024, (bf16*)(ws + WS_WO + j * SZ_WO), 0, 0}; }
        else break;
        const int items = (J.K / 64) * ((J.N + 63) / 64);
        for (int it = gw; it < items; it += NGW) transpose_item(J.W, J.scale, J.K, J.N, J.WT, J.row_off, scr, it, lane);
    }
    {
        const int gt = blockIdx.x * NTHREADS + ltid(), NT = gridDim.x * NTHREADS;
        const int per = (INPROJ_P - INPROJ) * 1024 * 2 / 16;
        for (int e = gt; e < 2 * per; e += NT) { const int i = e / per, c = e % per;
            *(v4u*)(ws + WS_WIN + i * SZ_WIN + (size_t)INPROJ * 1024 * 2 + (size_t)c * 16) = (v4u){0u, 0u, 0u, 0u}; }
    }
}

__device__ __forceinline__ void norm_store(bf16* __restrict__ HN, int m, int lane, const f32x4 (&v)[4]) {
    float s = 0.f;
#pragma unroll
    for (int j = 0; j < 4; ++j) s += (v[j].x * v[j].x + v[j].y * v[j].y) + (v[j].z * v[j].z + v[j].w * v[j].w);
    const float rs = rsqrtf(wave_sum(s) * (1.f / DM) + EPS);
    unsigned long long* o8 = (unsigned long long*)(HN + (size_t)m * DM) + lane;
#pragma unroll
    for (int j = 0; j < 4; ++j) o8[64 * j] = (unsigned long long)pkbf(v[j].x * rs, v[j].y * rs) | ((unsigned long long)pkbf(v[j].z * rs, v[j].w * rs) << 32);
}
__device__ __forceinline__ void phase_norm(ArgsP a, int from_inputs, int nslab, int wave, int lane) {
    float* __restrict__ H = (float*)(a->ws + WS_H); bf16* __restrict__ HN = (bf16*)(a->ws + WS_HN); const float* __restrict__ SLAB = (const float*)(a->ws + WS_SLAB);
    const int gw = blockIdx.x * NWAVES + wave, NGW = gridDim.x * NWAVES;
    for (int m = ROW_S + gw; m < MP; m += NGW) {
        if (m >= NROWS) { unsigned long long* o8 = (unsigned long long*)(HN + (size_t)m * DM) + lane;
#pragma unroll
            for (int j = 0; j < 4; ++j) o8[64 * j] = 0ull;
            continue; }
        const float* src = from_inputs ? ((m < ROW_M) ? a->in[I_XS] + (size_t)(m - ROW_S) * DM : a->in[I_META] + (size_t)(m - ROW_M) * DM) : H + (size_t)m * DM;
        f32x4 v[4], sv[8][4];
#pragma unroll
        for (int j = 0; j < 4; ++j) v[j] = ((const f32x4*)src + lane)[64 * j];
#pragma unroll
        for (int sl = 0; sl < 8; ++sl)
#pragma unroll
            for (int j = 0; j < 4; ++j) { sv[sl][j] = (f32x4){0.f, 0.f, 0.f, 0.f}; if (sl < nslab) sv[sl][j] = ((const f32x4*)(SLAB + (size_t)sl * (1280 * 1024) + (size_t)(m - ROW_S) * DM) + lane)[64 * j]; }
#pragma unroll
        for (int sl = 0; sl < 8; ++sl)
#pragma unroll
            for (int j = 0; j < 4; ++j) v[j] = v[j] + sv[sl][j];
        if (nslab > 0 || from_inputs) { f32x4* hr = (f32x4*)(H + (size_t)m * DM) + lane;
#pragma unroll
            for (int j = 0; j < 4; ++j) hr[64 * j] = v[j]; }
        norm_store(HN, m, lane, v);
    }
    const float* __restrict__ P = from_inputs ? a->in[I_XP] : (const float*)H;
    for (int m0 = 2 * gw; m0 < ROW_S; m0 += 2 * NGW) {
        f32x4 v[2][4];
#pragma unroll
        for (int q = 0; q < 2; ++q)
#pragma unroll
            for (int j = 0; j < 4; ++j) v[q][j] = ((const f32x4*)(P + (size_t)(m0 + q) * DM) + lane)[64 * j];
#pragma unroll
        for (int q = 0; q < 2; ++q) norm_store(HN, m0 + q, lane, v[q]);
    }
}
__device__ __forceinline__ void phase_final(ArgsP a, int wave, int lane) {
    const float* H = (const float*)(a->ws + WS_H); const float* fw = a->in[I_FNORM]; const float* SLAB = (const float*)(a->ws + WS_SLAB);
    const int gw = blockIdx.x * NWAVES + wave, NGW = gridDim.x * NWAVES;
    f32x4 w[4];
#pragma unroll
    for (int j = 0; j < 4; ++j) w[j] = ((const f32x4*)fw)[lane + 64 * j];
    for (int m = gw; m < ROW_M; m += NGW) {
        const f32x4* xr = (const f32x4*)(H + (size_t)m * DM) + lane;
        f32x4 v[4]; float s = 0.f;
#pragma unroll
        for (int j = 0; j < 4; ++j) v[j] = xr[64 * j];
        if (m >= ROW_S) {
            for (int sl = 0; sl < 8; ++sl) { const f32x4* sr = (const f32x4*)(SLAB + (size_t)sl * (1280 * 1024) + (size_t)(m - ROW_S) * DM) + lane;
#pragma unroll
                for (int j = 0; j < 4; ++j) v[j] = v[j] + sr[64 * j]; }
        }
#pragma unroll
        for (int j = 0; j < 4; ++j) s += (v[j].x * v[j].x + v[j].y * v[j].y) + (v[j].z * v[j].z + v[j].w * v[j].w);
        const float rs = rsqrtf(wave_sum(s) * (1.f / DM) + EPS);
        f32x4* o = (f32x4*)(a->out + O_YP + (size_t)m * DM) + lane;
#pragma unroll
        for (int j = 0; j < 4; ++j) o[64 * j] = v[j] * rs * w[j];
    }
}

__device__ __forceinline__ void unpack8(const u32x4 w, float (&f)[8]) { f[0] = bflo(w.x); f[1] = bfhi(w.x); f[2] = bflo(w.y); f[3] = bfhi(w.y); f[4] = bflo(w.z); f[5] = bfhi(w.z); f[6] = bflo(w.w); f[7] = bfhi(w.w); }
__device__ __forceinline__ void ld8f(const float* __restrict__ p, float (&f)[8]) { const f32x4 x0 = *(const f32x4*)p, x1 = *(const f32x4*)(p + 4); f[0]=x0.x;f[1]=x0.y;f[2]=x0.z;f[3]=x0.w;f[4]=x1.x;f[5]=x1.y;f[6]=x1.z;f[7]=x1.w; }
#define TSW(ch) ((((ch) >> 3) & 7) << 3)
struct ConvW { float w0[8], w1[8], w2[8], w3[8], bs[8]; };
__device__ __forceinline__ void conv_load_w(const float* __restrict__ cw, const float* __restrict__ cb, int c0, ConvW& W) { ld8f(cw + c0, W.w0); ld8f(cw + CONVD + c0, W.w1); ld8f(cw + 2 * CONVD + c0, W.w2); ld8f(cw + 3 * CONVD + c0, W.w3); ld8f(cb + c0, W.bs); }
__device__ __forceinline__ void conv_load_run(const bf16* __restrict__ ZX, int Rrow, int c0, int pk, bool valid, u32x4 (&raw)[11]) {
#pragma unroll
    for (int t = 0; t < 8; ++t) { raw[3 + t] = (u32x4){0u, 0u, 0u, 0u}; if (valid) raw[3 + t] = *(const u32x4*)(ZX + (size_t)(Rrow + t) * ZXW + 2048 + c0); }
#pragma unroll
    for (int t = 0; t < 3; ++t) { const int rr = (pk == 1) ? ROW_M + 13 + t : Rrow - 3 + t; raw[t] = (u32x4){0u, 0u, 0u, 0u}; if (valid && pk != 2) raw[t] = *(const u32x4*)(ZX + (size_t)rr * ZXW + 2048 + c0); }
}
template <int J> __device__ __forceinline__ void conv_channel(const u32x4 (&raw)[11], const ConvW& W, float (&o)[8]) {
    float x[11];
#pragma unroll
    for (int i = 0; i < 11; ++i) { const unsigned w = raw[i][J >> 1]; x[i] = (J & 1) ? bfhi(w) : bflo(w); }
#pragma unroll
    for (int t = 0; t < 8; ++t) { const float v = W.bs[J] + W.w0[J] * x[t] + W.w1[J] * x[t + 1] + W.w2[J] * x[t + 2] + W.w3[J] * x[t + 3]; o[t] = v * sigmoid_f(v); }
}
template <int J> __device__ __forceinline__ void conv_store_t(const u32x4 (&raw)[11], const ConvW& W, const float (&scale)[8], bf16* T, int ch0, int run) {
    float o[8]; conv_channel<J>(raw, W, o);
    u32x4 w; w.x = pkbf(o[0] * scale[0], o[1] * scale[1]); w.y = pkbf(o[2] * scale[2], o[3] * scale[3]); w.z = pkbf(o[4] * scale[4], o[5] * scale[5]); w.w = pkbf(o[6] * scale[6], o[7] * scale[7]);
    *(u32x4*)(T + (ch0 + J) * LDX + ((8 * run) ^ TSW(ch0 + J))) = w;
}
__device__ __forceinline__ void conv_item_t(const u32x4 (&raw)[11], const ConvW& W, const float (&scale)[8], bf16* T, int ch0, int run) {
    conv_store_t<0>(raw, W, scale, T, ch0, run); conv_store_t<1>(raw, W, scale, T, ch0, run); conv_store_t<2>(raw, W, scale, T, ch0, run); conv_store_t<3>(raw, W, scale, T, ch0, run);
    conv_store_t<4>(raw, W, scale, T, ch0, run); conv_store_t<5>(raw, W, scale, T, ch0, run); conv_store_t<6>(raw, W, scale, T, ch0, run); conv_store_t<7>(raw, W, scale, T, ch0, run);
}
__device__ __forceinline__ void conv_item_n(const u32x4 (&raw)[11], const ConvW& W, bf16* N, int run, int colel) {
    float p0[8], p1[8], p2[8]; unpack8(raw[0], p0); unpack8(raw[1], p1); unpack8(raw[2], p2);
#pragma unroll
    for (int t = 0; t < 8; ++t) { float x[8]; unpack8(raw[3 + t], x); float o[8];
#pragma unroll
        for (int j = 0; j < 8; ++j) { const float v = W.bs[j] + W.w0[j] * p0[j] + W.w1[j] * p1[j] + W.w2[j] * p2[j] + W.w3[j] * x[j]; o[j] = v * sigmoid_f(v); }
        u32x4 w; w.x = pkbf(o[0], o[1]); w.y = pkbf(o[2], o[3]); w.z = pkbf(o[4], o[5]); w.w = pkbf(o[6], o[7]);
        *(u32x4*)(N + (8 * run + t) * LDX + colel) = w;
#pragma unroll
        for (int j = 0; j < 8; ++j) { p0[j] = p1[j]; p1[j] = p2[j]; p2[j] = x[j]; } }
}
__device__ __forceinline__ void conv_state_out(const u32x4 (&raw)[11], float* __restrict__ dst  ) {
#pragma unroll
    for (int k = 0; k < 3; ++k) { float x[8]; unpack8(raw[8 + k], x); *(f32x4*)(dst + (size_t)k * CONVD) = (f32x4){x[0], x[1], x[2], x[3]}; *(f32x4*)(dst + (size_t)k * CONVD + 4) = (f32x4){x[4], x[5], x[6], x[7]}; }
}

__device__ __forceinline__ void ssd_acs(const float* DT, const float* alog, int R0, int len, int h0, float* s_dt, float* s_acs, int wave, int lane) {
    if (wave < 4) {
        const int r = wave; const float An = -__expf(alog[h0 + r]);
        const int l0 = 2 * lane;
        const float d0 = (l0 < len) ? DT[(size_t)(R0 + l0) * 32 + h0 + r] : 0.f;
        const float d1 = (l0 + 1 < len) ? DT[(size_t)(R0 + l0 + 1) * 32 + h0 + r] : 0.f;
        const float a0 = d0 * An, a1 = d1 * An, s = a0 + a1;
        float incl = s;
#pragma unroll
        for (int o = 1; o < 64; o <<= 1) { const float t = __shfl_up(incl, o); if (lane >= o) incl += t; }
        const float excl = incl - s;
        s_dt[r * 128 + l0] = d0; s_dt[r * 128 + l0 + 1] = d1;
        s_acs[r * 128 + l0] = excl + a0; s_acs[r * 128 + l0 + 1] = excl + s;
    }
}
#define LFRAG(base, row, ld, ks) (*(const bf16x8*)((base) + (row) * (ld) + 32 * (ks) + 8 * fq))

__device__ __forceinline__ void ssd1_unit(ArgsP a, int li, unsigned char* lds, int slot, int g, int R0, int len, int, int, int) {
    const int tid = ltid(), lane = tid & 63, wave = __builtin_amdgcn_readfirstlane(tid >> 6);
    const float* __restrict__ DT = (const float*)(a->ws + WS_DT);
    bf16* __restrict__ CS = (bf16*)(a->ws + WS_CS); float* __restrict__ CD = (float*)(a->ws + WS_CD);
    bf16* XsT = (bf16*)lds;
    bf16* BT = (bf16*)(lds + 256 * LDX * 2);
    float* s_dt = (float*)(lds + 384 * LDX * 2); float* s_acs = s_dt + 512;
    const int fr = lane & 15, fq = lane >> 4, h0 = g * 4;
    const float* __restrict__ cw = a->in[I_ACONVW] + (size_t)li * 4 * CONVD; const float* __restrict__ cbias = a->in[I_ACONVB] + (size_t)li * CONVD;
    const bf16* __restrict__ ZX = (const bf16*)(a->ws + WS_ZX);
    const bool meta = (slot == 128), chunk0 = (!meta && (slot & 63) == 0);
    const int xcb = tid & 31, xrun = tid >> 5, xc0 = g * 256 + xcb * 8;
    const int bcb = tid & 15, brun = (tid >> 4) & 15, bc0 = 2048 + g * 128 + bcb * 8;
    u32x4 rx[11], rb[11];
    conv_load_run(ZX, R0 + 8 * xrun, xc0, (xrun == 0) ? (meta ? 2 : (chunk0 ? 1 : 0)) : 0, 8 * xrun < len, rx);
    if (tid < 256) conv_load_run(ZX, R0 + 8 * brun, bc0, (brun == 0) ? (meta ? 2 : (chunk0 ? 1 : 0)) : 0, 8 * brun < len, rb);
    ssd_acs(DT, a->in[I_ALOG] + li * NHEADS, R0, len, h0, s_dt, s_acs, wave, lane);
    if (tid < 256) { ConvW W; conv_load_w(cw, cbias, bc0, W); const float one[8] = {1.f, 1.f, 1.f, 1.f, 1.f, 1.f, 1.f, 1.f}; conv_item_t(rb, W, one, BT, bcb * 8, brun); }
    __syncthreads();
    {   ConvW W; conv_load_w(cw, cbias, xc0, W);
        const int r = xcb >> 3; const float tot = s_acs[r * 128 + 127];
        const f32x4 a0 = *(const f32x4*)(s_acs + r * 128 + 8 * xrun), a1 = *(const f32x4*)(s_acs + r * 128 + 8 * xrun + 4), d0 = *(const f32x4*)(s_dt + r * 128 + 8 * xrun), d1 = *(const f32x4*)(s_dt + r * 128 + 8 * xrun + 4);
        float wl[8];
#pragma unroll
        for (int t = 0; t < 4; ++t) { wl[t] = __expf(tot - a0[t]) * d0[t]; wl[4 + t] = __expf(tot - a1[t]) * d1[t]; }
        conv_item_t(rx, W, wl, XsT, xcb * 8, xrun);
    }
    __syncthreads();
    f32x4 acc[2][8];
#pragma unroll
    for (int mi = 0; mi < 2; ++mi)
#pragma unroll
        for (int ni = 0; ni < 8; ++ni) acc[mi][ni] = (f32x4){0.f, 0.f, 0.f, 0.f};
#pragma unroll
    for (int ks = 0; ks < 4; ++ks) {
        const int ra0 = 32 * wave + fr, ra1 = ra0 + 16;
        const bf16x8 a0 = *(const bf16x8*)(XsT + ra0 * LDX + ((32 * ks + 8 * fq) ^ TSW(ra0))), a1 = *(const bf16x8*)(XsT + ra1 * LDX + ((32 * ks + 8 * fq) ^ TSW(ra1)));
#pragma unroll
        for (int ni = 0; ni < 8; ++ni) { const int rb = 16 * ni + fr; const bf16x8 bb = *(const bf16x8*)(BT + rb * LDX + ((32 * ks + 8 * fq) ^ TSW(rb)));
            acc[0][ni] = MFMA16(bb, a0, acc[0][ni]); acc[1][ni] = MFMA16(bb, a1, acc[1][ni]); }
    }
#pragma unroll
    for (int mi = 0; mi < 2; ++mi) { const int hp = 32 * wave + 16 * mi + fr, r = hp >> 6, p = hp & 63;
        bf16* dst = CS + ((size_t)(slot * 32 + h0 + r) * 64 + p) * 128 + 4 * fq;
#pragma unroll
        for (int ni = 0; ni < 8; ++ni) { u32x2 w; w.x = pkbf(acc[mi][ni][0], acc[mi][ni][1]); w.y = pkbf(acc[mi][ni][2], acc[mi][ni][3]); *(u32x2*)(dst + 16 * ni) = w; } }
    if (tid < 4) CD[slot * 32 + h0 + tid] = __expf(s_acs[tid * 128 + 127]);
    __syncthreads();
}

__device__ __forceinline__ void ssd_sample_issue(ArgsP a, int li, int b, int g, f32x4 (&st)[4][4]) {
    const int tid = ltid(), p = tid >> 3, nb = tid & 7;
    const float* __restrict__ sin_ = a->in[I_SSSM] + ((size_t)((li * NSAMP + b) * NHEADS + g * 4) * 64 + p) * 128 + 4 * nb;
#pragma unroll
    for (int r = 0; r < 4; ++r)
#pragma unroll
        for (int kk = 0; kk < 4; ++kk) st[r][kk] = *(const f32x4*)(sin_ + (size_t)r * 8192 + 32 * kk);
}
__device__ __forceinline__ void ssd_sample_unit(ArgsP a, int li, unsigned char* lds, int b, int g, f32x4 (&st)[4][4]) {
    const int tid = ltid(), lane = tid & 63, wave = __builtin_amdgcn_readfirstlane(tid >> 6);
    const bf16* __restrict__ ZX = (const bf16*)(a->ws + WS_ZX); const float* __restrict__ DT = (const float*)(a->ws + WS_DT); bf16* __restrict__ YN = (bf16*)(a->ws + WS_YN);
    float* sX = (float*)lds; float* sB = sX + 8 * 256; float* sC = sB + 8 * 128; float* sY = sC + 8 * 128; float* sDt = sY + 8 * 256;
    const int R0 = ROW_S + b * 8, h0 = g * 4;
    const int p = tid >> 3, nb = tid & 7;
    float* __restrict__ sout = a->out + O_SSSM + ((size_t)((li * NSAMP + b) * NHEADS + h0) * 64 + p) * 128 + 4 * nb;
    {
        const float* __restrict__ cw = a->in[I_ACONVW] + (size_t)li * 4 * CONVD; const float* __restrict__ cbias = a->in[I_ACONVB] + (size_t)li * CONVD;
        const int t = tid >> 6, ck = tid & 63;
        const int c0 = (ck < 32) ? g * 256 + ck * 8 : (ck < 48) ? 2048 + g * 128 + (ck - 32) * 8 : 3072 + g * 128 + (ck - 48) * 8;
        float* dst = (ck < 32) ? sX + t * 256 + ck * 8 : (ck < 48) ? sB + t * 128 + (ck - 32) * 8 : sC + t * 128 + (ck - 48) * 8;
        const float* __restrict__ sc = a->in[I_SCONV] + ((size_t)(li * NSAMP + b) * 3) * CONVD + c0;
        float xr[4][8];
#pragma unroll
        for (int k = 0; k < 4; ++k) { const int tt = t - 3 + k;
            if (tt >= 0) unpack8(*(const u32x4*)(ZX + (size_t)(R0 + tt) * ZXW + 2048 + c0), xr[k]); else ld8f(sc + (size_t)(tt + 3) * CONVD, xr[k]); }
        ConvW W; conv_load_w(cw, cbias, c0, W);
        float o[8];
#pragma unroll
        for (int j = 0; j < 8; ++j) { const float v = W.bs[j] + W.w0[j] * xr[0][j] + W.w1[j] * xr[1][j] + W.w2[j] * xr[2][j] + W.w3[j] * xr[3][j]; o[j] = v * sigmoid_f(v); }
        *(f32x4*)dst = (f32x4){o[0], o[1], o[2], o[3]}; *(f32x4*)(dst + 4) = (f32x4){o[4], o[5], o[6], o[7]};
        if (t >= 5) { float* __restrict__ so = a->out + O_SCONV + ((size_t)(li * NSAMP + b) * 3 + (t - 5)) * CONVD + c0;
            *(f32x4*)so = (f32x4){xr[3][0], xr[3][1], xr[3][2], xr[3][3]}; *(f32x4*)(so + 4) = (f32x4){xr[3][4], xr[3][5], xr[3][6], xr[3][7]}; }
    }
    if (tid < 32) sDt[tid] = DT[(size_t)(R0 + (tid >> 2)) * 32 + h0 + (tid & 3)];
    __syncthreads();
    float An[4], Dk[4];
#pragma unroll
    for (int r = 0; r < 4; ++r) { An[r] = -__expf(a->in[I_ALOG][li * NHEADS + h0 + r]); Dk[r] = a->in[I_ADSKIP][li * NHEADS + h0 + r]; }
    float part[8][4];
#pragma unroll
    for (int t = 0; t < 8; ++t) {
        f32x4 bv[4], cv[4];
#pragma unroll
        for (int kk = 0; kk < 4; ++kk) { bv[kk] = *(const f32x4*)(sB + t * 128 + 32 * kk + 4 * nb); cv[kk] = *(const f32x4*)(sC + t * 128 + 32 * kk + 4 * nb); }
#pragma unroll
        for (int r = 0; r < 4; ++r) {
            const float dt = sDt[t * 4 + r], dA = __expf(dt * An[r]), xv = sX[t * 256 + r * 64 + p], coef = dt * xv;
            float pr = 0.f;
#pragma unroll
            for (int kk = 0; kk < 4; ++kk) { st[r][kk] = st[r][kk] * dA + bv[kk] * coef; pr += (cv[kk].x * st[r][kk].x + cv[kk].y * st[r][kk].y) + (cv[kk].z * st[r][kk].z + cv[kk].w * st[r][kk].w); }
            part[t][r] = pr;
        }
    }
#pragma unroll
    for (int r = 0; r < 4; ++r)
#pragma unroll
        for (int kk = 0; kk < 4; ++kk) *(f32x4*)(sout + (size_t)r * 8192 + 32 * kk) = st[r][kk];
#pragma unroll
    for (int t = 0; t < 8; ++t)
#pragma unroll
        for (int r = 0; r < 4; ++r) { float v = part[t][r]; v += __shfl_xor(v, 1); v += __shfl_xor(v, 2); v += __shfl_xor(v, 4); part[t][r] = v; }
    if (nb == 0) {
#pragma unroll
        for (int t = 0; t < 8; ++t)
#pragma unroll
            for (int r = 0; r < 4; ++r) sY[t * 256 + r * 64 + p] = part[t][r] + Dk[r] * sX[t * 256 + r * 64 + p];
    }
    __syncthreads();
    {
        const int t = wave, c4 = lane * 4; const size_t row = (size_t)(R0 + t);
        const f32x4 y = *(const f32x4*)(sY + t * 256 + c4);
        const u32x2 zz = *(const u32x2*)(ZX + row * ZXW + g * 256 + c4);
        const float z0 = bflo(zz.x), z1 = bfhi(zz.x), z2 = bflo(zz.y), z3 = bfhi(zz.y);
        const float g0 = y.x * z0 * sigmoid_f(z0), g1 = y.y * z1 * sigmoid_f(z1), g2 = y.z * z2 * sigmoid_f(z2), g3 = y.w * z3 * sigmoid_f(z3);
        const float ss = wave_sum((g0 * g0 + g1 * g1) + (g2 * g2 + g3 * g3));
        const float rs = rsqrtf(ss * (1.f / 256.f) + EPS);
        u32x2 o; o.x = pkbf(g0 * rs, g1 * rs); o.y = pkbf(g2 * rs, g3 * rs);
        *(u32x2*)(YN + row * DINNER + g * 256 + c4) = o;
    }
    __syncthreads();
}

__device__ __forceinline__ void phase_scan(ArgsP a, int li) {
    const bf16* __restrict__ CS = (const bf16*)(a->ws + WS_CS); const float* __restrict__ CD = (const float*)(a->ws + WS_CD); bf16* __restrict__ HSB = (bf16*)(a->ws + WS_HSB);
    const int gt = blockIdx.x * NTHREADS + ltid(), NT = gridDim.x * NTHREADS;
    for (int e = gt; e < 2 * 65536; e += NT) {
        const int b = e >> 16, rem = e & 65535, h = rem >> 11, pn4 = rem & 2047;
        f32x4 hc; { const u32x2 w0 = *(const u32x2*)(CS + ((size_t)(128 * 32 + h) * 2048 + pn4) * 4); hc = (f32x4){bflo(w0.x), bfhi(w0.x), bflo(w0.y), bfhi(w0.y)}; }
#pragma unroll 8
        for (int c = 0; c < 64; ++c) { const int slot = b * 64 + c; const size_t o = ((size_t)(slot * 32 + h) * 2048 + pn4) * 4;
            const u32x2 sw = *(const u32x2*)(CS + o); const f32x4 s = (f32x4){bflo(sw.x), bfhi(sw.x), bflo(sw.y), bfhi(sw.y)}; const float d = CD[slot * 32 + h];
            u32x2 w; w.x = pkbf(hc.x, hc.y); w.y = pkbf(hc.z, hc.w); *(u32x2*)(HSB + o) = w;
            hc = hc * d + s; }
        *(f32x4*)(a->out + O_PSSM + ((size_t)((li * NPROMPT + b) * NHEADS + h) * 2048 + pn4) * 4) = hc;
    }
}

__device__ __forceinline__ void ssd3_head(int r, int hb, const bf16* Cn, const bf16* BH, const bf16* Xt, const float* s_dt, const float* s_acs, const f32x4 (&cb)[8], f32x4 (&acc)[4],
                                          const bf16* __restrict__ ZX, size_t row, int g, float Dk, int l, int wave, int fr, int fq, float& ss) {
    u32x2 zz[4];
#pragma unroll
    for (int ni = 0; ni < 4; ++ni) { const int ch = g * 256 + r * 64 + 16 * ni + 4 * fq; zz[ni] = *(const u32x2*)(ZX + row * ZXW + ch); }
    const float al = s_acs[r * 128 + l];
#pragma unroll
    for (int ni = 0; ni < 4; ++ni) acc[ni] = (f32x4){0.f, 0.f, 0.f, 0.f};
    const bf16* Hs = BH + hb * 64 * LDX;
#pragma unroll
    for (int ks = 0; ks < 4; ++ks) { const bf16x8 af = LFRAG(Cn, l, LDX, ks);
#pragma unroll
        for (int ni = 0; ni < 4; ++ni) { const bf16x8 bb = LFRAG(Hs, 16 * ni + fr, LDX, ks); acc[ni] = MFMA16(bb, af, acc[ni]); } }
    const float e = __expf(al);
#pragma unroll
    for (int ni = 0; ni < 4; ++ni) acc[ni] = acc[ni] * e;
#pragma unroll
    for (int ks = 0; ks < 4; ++ks) if (2 * ks <= wave) {
        unsigned mw[4];
#pragma unroll
        for (int hf = 0; hf < 2; ++hf) { const int ni = 2 * ks + hf, s0 = 16 * ni + 4 * fq;
            const f32x4 av = *(const f32x4*)(s_acs + r * 128 + s0), dv = *(const f32x4*)(s_dt + r * 128 + s0);
            float m[4];
#pragma unroll
            for (int j = 0; j < 4; ++j) m[j] = (s0 + j <= l) ? cb[ni][j] * __expf(al - av[j]) * dv[j] : 0.f;
            mw[2 * hf] = pkbf(m[0], m[1]); mw[2 * hf + 1] = pkbf(m[2], m[3]); }
        const u32x4 afu = (u32x4){mw[0], mw[1], mw[2], mw[3]};
        const bf16x8 af = __builtin_bit_cast(bf16x8, afu);
#pragma unroll
        for (int ni = 0; ni < 4; ++ni) { const int chl = r * 64 + 16 * ni + fr, sw = TSW(chl);
            const u32x2 b0 = *(const u32x2*)(Xt + chl * LDX + ((32 * ks + 4 * fq) ^ sw)), b1 = *(const u32x2*)(Xt + chl * LDX + ((32 * ks + 16 + 4 * fq) ^ sw));
            const u32x4 bu = (u32x4){b0.x, b0.y, b1.x, b1.y};
            acc[ni] = MFMA16(__builtin_bit_cast(bf16x8, bu), af, acc[ni]); }
    }
#pragma unroll
    for (int ni = 0; ni < 4; ++ni) {
        float xv[4];
#pragma unroll
        for (int j = 0; j < 4; ++j) { const int chl = r * 64 + 16 * ni + 4 * fq + j; xv[j] = bf2f(Xt[chl * LDX + (l ^ TSW(chl))]); }
        const float zv[4] = {bflo(zz[ni].x), bfhi(zz[ni].x), bflo(zz[ni].y), bfhi(zz[ni].y)};
#pragma unroll
        for (int j = 0; j < 4; ++j) { const float q = (acc[ni][j] + Dk * xv[j]) * zv[j] * sigmoid_f(zv[j]); acc[ni][j] = q; ss += q * q; } }
}
__device__ __forceinline__ void ssd3_unit(ArgsP a, int li, unsigned char* lds, const bf16* __restrict__ hs, int slot, int g, int R0, int len, int, int, int) {
    const int tid = ltid(), lane = tid & 63, wave = __builtin_amdgcn_readfirstlane(tid >> 6);
    const bf16* __restrict__ ZX = (const bf16*)(a->ws + WS_ZX); const float* __restrict__ DT = (const float*)(a->ws + WS_DT); bf16* __restrict__ YN = (bf16*)(a->ws + WS_YN);
    bf16* Cn = (bf16*)lds; bf16* BH = Cn + 128 * LDX; bf16* Xt = BH + 128 * LDX;
    float* s_dt = (float*)(Xt + 256 * LDX); float* s_acs = s_dt + 512;
    const int fr = lane & 15, fq = lane >> 4, h0 = g * 4;
    {
        const float* __restrict__ cw = a->in[I_ACONVW] + (size_t)li * 4 * CONVD; const float* __restrict__ cbias = a->in[I_ACONVB] + (size_t)li * CONVD;
        const bool meta = (slot == 128), chunk0 = (!meta && (slot & 63) == 0);
        const int half = tid >> 8, ncb = tid & 15, nrun = (tid >> 4) & 15, nc0 = (half ? 2048 : 3072) + g * 128 + ncb * 8;
        const int xcb = tid & 31, xrun = tid >> 5, xc0 = g * 256 + xcb * 8;
        u32x4 rn[11], rx[11];
        conv_load_run(ZX, R0 + 8 * nrun, nc0, (nrun == 0) ? (meta ? 2 : (chunk0 ? 1 : 0)) : 0, 8 * nrun < len, rn);
        conv_load_run(ZX, R0 + 8 * xrun, xc0, (xrun == 0) ? (meta ? 2 : (chunk0 ? 1 : 0)) : 0, 8 * xrun < len, rx);
        ssd_acs(DT, a->in[I_ALOG] + li * NHEADS, R0, len, h0, s_dt, s_acs, wave, lane);
        { ConvW W; conv_load_w(cw, cbias, nc0, W); conv_item_n(rn, W, half ? BH : Cn, nrun, ncb * 8); }
        { ConvW W; conv_load_w(cw, cbias, xc0, W); const float one[8] = {1.f, 1.f, 1.f, 1.f, 1.f, 1.f, 1.f, 1.f}; conv_item_t(rx, W, one, Xt, xcb * 8, xrun); }
        if (!meta && (slot & 63) == 63) {
            float* __restrict__ dst = a->out + O_PCONV + (size_t)((li * NPROMPT + (slot >> 6)) * 3) * CONVD;
            if (nrun == 15) conv_state_out(rn, dst + nc0);
            if (xrun == 15) conv_state_out(rx, dst + xc0);
        }
    }
    __syncthreads();
    u32x2 hv[8];
#pragma unroll
    for (int k = 0; k < 8; ++k) { const int item = tid + NTHREADS * k; hv[k] = (u32x2){0u, 0u}; if (hs) hv[k] = *(const u32x2*)(hs + (size_t)item * 4); }
    const bool active = (16 * wave < len);
    f32x4 cb[8];
#pragma unroll
    for (int ni = 0; ni < 8; ++ni) cb[ni] = (f32x4){0.f, 0.f, 0.f, 0.f};
    if (active) {
#pragma unroll
    for (int ks = 0; ks < 4; ++ks) { const bf16x8 af = LFRAG(Cn, 16 * wave + fr, LDX, ks);
#pragma unroll
        for (int ni = 0; ni < 8; ++ni) { const bf16x8 bb = LFRAG(BH, 16 * ni + fr, LDX, ks); cb[ni] = MFMA16(bb, af, cb[ni]); } }
    }
    __syncthreads();
#pragma unroll
    for (int k = 0; k < 8; ++k) { const int item = tid + NTHREADS * k, hp = item >> 5, n4 = item & 31; *(u32x2*)(BH + hp * LDX + n4 * 4) = hv[k]; }
#pragma unroll
    for (int k = 0; k < 8; ++k) { const int item = tid + NTHREADS * k; hv[k] = (u32x2){0u, 0u}; if (hs) hv[k] = *(const u32x2*)(hs + (size_t)(2 * 8192) + (size_t)item * 4); }
    __syncthreads();
    const int l = 16 * wave + fr;
    const size_t row = (size_t)(R0 + ((l < len) ? l : 0));
    f32x4 y0[4], y1[4], y2[4], y3[4];
    float ss = 0.f;
    const float* dsk = a->in[I_ADSKIP] + li * NHEADS + h0;
    if (active) {
    ssd3_head(0, 0, Cn, BH, Xt, s_dt, s_acs, cb, y0, ZX, row, g, dsk[0], l, wave, fr, fq, ss);
    asm volatile("" ::: "memory");
    ssd3_head(1, 1, Cn, BH, Xt, s_dt, s_acs, cb, y1, ZX, row, g, dsk[1], l, wave, fr, fq, ss);
    }
    __syncthreads();
#pragma unroll
    for (int k = 0; k < 8; ++k) { const int item = tid + NTHREADS * k, hp = item >> 5, n4 = item & 31; *(u32x2*)(BH + hp * LDX + n4 * 4) = hv[k]; }
    __syncthreads();
    if (active) {
    ssd3_head(2, 0, Cn, BH, Xt, s_dt, s_acs, cb, y2, ZX, row, g, dsk[2], l, wave, fr, fq, ss);
    asm volatile("" ::: "memory");
    ssd3_head(3, 1, Cn, BH, Xt, s_dt, s_acs, cb, y3, ZX, row, g, dsk[3], l, wave, fr, fq, ss);
    ss += __shfl_xor(ss, 16); ss += __shfl_xor(ss, 32);
    }
    const float rs = rsqrtf(ss * (1.f / 256.f) + EPS);
    if (active && l < len) {
        bf16* yrow = YN + row * DINNER + g * 256 + 4 * fq;
#pragma unroll
        for (int ni = 0; ni < 4; ++ni) {
            u32x2 w;
            w.x = pkbf(y0[ni][0] * rs, y0[ni][1] * rs); w.y = pkbf(y0[ni][2] * rs, y0[ni][3] * rs); *(u32x2*)(yrow + 0 * 64 + 16 * ni) = w;
            w.x = pkbf(y1[ni][0] * rs, y1[ni][1] * rs); w.y = pkbf(y1[ni][2] * rs, y1[ni][3] * rs); *(u32x2*)(yrow + 1 * 64 + 16 * ni) = w;
            w.x = pkbf(y2[ni][0] * rs, y2[ni][1] * rs); w.y = pkbf(y2[ni][2] * rs, y2[ni][3] * rs); *(u32x2*)(yrow + 2 * 64 + 16 * ni) = w;
            w.x = pkbf(y3[ni][0] * rs, y3[ni][1] * rs); w.y = pkbf(y3[ni][2] * rs, y3[ni][3] * rs); *(u32x2*)(yrow + 3 * 64 + 16 * ni) = w;
        }
    }
    __syncthreads();
}
__device__ __forceinline__ void phase_ssd1(ArgsP a, int li, unsigned char* lds, int tid, int wave, int lane) {
    const int c = blockIdx.x;
#pragma unroll 1
    for (int j = 0; j < 4; ++j) {
        const int u = c + 256 * j;
        f32x4 st[4][4];
        ssd_sample_issue(a, li, u >> 3, u & 7, st);
#ifndef PROBE_SSD1
#define PROBE_SSD1 0
#endif
#pragma unroll 1
        for (int rp = 0; rp < (PROBE_SSD1 == 1 ? 2 : 1); ++rp) { const int slot = u >> 3, g = u & 7; ssd1_unit(a, li, lds, slot, g, (slot >> 6) * SEQ + (slot & 63) * 128, 128, tid, wave, lane); }
        ssd_sample_unit(a, li, lds, u >> 3, u & 7, st);
    }
    if (c < 8) ssd1_unit(a, li, lds, 128, c, ROW_M, NMETA, tid, wave, lane);
    else if (c < 16) ssd3_unit(a, li, lds, nullptr, 128, c - 8, ROW_M, NMETA, tid, wave, lane);
}
__device__ __forceinline__ void phase_ssd3(ArgsP a, int li, unsigned char* lds, int tid, int wave, int lane) {
    const bf16* HSB = (const bf16*)(a->ws + WS_HSB);
#pragma unroll 1
    for (int u = blockIdx.x; u < 1024; u += gridDim.x) { const int slot = u >> 3, g = u & 7; ssd3_unit(a, li, lds, HSB + (size_t)(slot * 32 + g * 4) * 8192, slot, g, (slot >> 6) * SEQ + (slot & 63) * 128, 128, tid, wave, lane); }
}

constexpr int KS_LD = 72, VT_LD = 264, P_LD = 232, NKEYS = 208;
constexpr int VT1_LD = 232;
__device__ __forceinline__ void attn_prompt_unit_v1(ArgsP a, int lj, unsigned char* lds, int b, int kvh, int qb, int, int, int) {
    const int tid = ltid(), lane = tid & 63, wave = __builtin_amdgcn_readfirstlane(tid >> 6);
    const bf16* Q = (const bf16*)(a->ws + WS_Q); const bf16* KV = (const bf16*)(a->ws + WS_KV); bf16* AO = (bf16*)(a->ws + WS_AO);
    bf16* Ks = (bf16*)lds; bf16* Vt = Ks + NKEYS * KS_LD; bf16* Pw = Vt + 64 * VT1_LD + wave * 16 * VT1_LD;
    const int fr = lane & 15, fq = lane >> 4, t0 = qb * 64, Rb = b * SEQ;
    for (int it = tid; it < NKEYS * 8; it += NTHREADS) { const int key = it >> 3, ch = it & 7;
        int row; if (key < 16) row = ROW_M + key; else { int s = t0 - 128 + key - 16; if (s < 0) s = 0; row = Rb + s; }
        *(u32x4*)(Ks + key * KS_LD + ch * 8) = *(const u32x4*)(KV + (size_t)row * KVW + kvh * 64 + ch * 8); }
    for (int it = tid; it < (NKEYS / 2) * 8; it += NTHREADS) { const int dbl = it & 7, kp = it >> 3;
        int r0, r1; { const int k0 = 2 * kp, k1 = k0 + 1; int s0 = t0 - 128 + k0 - 16, s1 = t0 - 128 + k1 - 16; if (s0 < 0) s0 = 0; if (s1 < 0) s1 = 0; r0 = (k0 < 16) ? ROW_M + k0 : Rb + s0; r1 = (k1 < 16) ? ROW_M + k1 : Rb + s1; }
        const u32x4 v0 = *(const u32x4*)(KV + (size_t)r0 * KVW + 256 + kvh * 64 + dbl * 8), v1 = *(const u32x4*)(KV + (size_t)r1 * KVW + 256 + kvh * 64 + dbl * 8);
        const unsigned a0[4] = {v0.x, v0.y, v0.z, v0.w}, a1[4] = {v1.x, v1.y, v1.z, v1.w};
#pragma unroll
        for (int j = 0; j < 4; ++j) {
            *(unsigned*)(Vt + (dbl * 8 + 2 * j) * VT1_LD + 2 * kp) = (a0[j] & 0xffffu) | (a1[j] << 16);
            *(unsigned*)(Vt + (dbl * 8 + 2 * j + 1) * VT1_LD + 2 * kp) = (a0[j] >> 16) | (a1[j] & 0xffff0000u); } }
    { const int row = tid >> 3, c = NKEYS + 2 * (tid & 7); *(unsigned*)(Vt + row * VT1_LD + c) = 0u; }
    __syncthreads();
    const int r = wave >> 1, th = (wave & 1) * 32, qh = kvh * 4 + r;
    const float sink = a->in[I_SINKS][lj * NQ + qh];
#pragma unroll 1
    for (int blk = 0; blk < 2; ++blk) {
        const int tq0 = t0 + th + blk * 16, t = tq0 + fr;
        bf16x8 qa[2];
#pragma unroll
        for (int ks = 0; ks < 2; ++ks) qa[ks] = *(const bf16x8*)(Q + (size_t)(Rb + t) * DM + qh * 64 + 32 * ks + 8 * fq);
        f32x4 sc[13];
#pragma unroll
        for (int ni = 0; ni < 13; ++ni) sc[ni] = (f32x4){0.f, 0.f, 0.f, 0.f};
#pragma unroll
        for (int ni = 0; ni < 13; ++ni) {
            const bf16x8 b0 = *(const bf16x8*)(Ks + (16 * ni + fr) * KS_LD + 8 * fq), b1 = *(const bf16x8*)(Ks + (16 * ni + fr) * KS_LD + 32 + 8 * fq);
            sc[ni] = MFMA16(b0, qa[0], sc[ni]); sc[ni] = MFMA16(b1, qa[1], sc[ni]);
            if ((ni & 3) == 3) asm volatile("" ::: "memory"); }
        float mx = -INFINITY;
#pragma unroll
        for (int ni = 0; ni < 13; ++ni)
#pragma unroll
            for (int j = 0; j < 4; ++j) { const int key = 16 * ni + 4 * fq + j; bool vis = true;
                if (key >= 16) { const int s = t0 - 128 + key - 16; vis = (s >= 0) && (s <= t) && (s > t - 128); }
                const float v = vis ? sc[ni][j] * 0.125f : -INFINITY; sc[ni][j] = v; mx = fmaxf(mx, v); }
        mx = fmaxf(mx, __shfl_xor(mx, 16)); mx = fmaxf(mx, __shfl_xor(mx, 32)); mx = fmaxf(mx, sink);
        float sum = 0.f;
#pragma unroll
        for (int ni = 0; ni < 13; ++ni)
#pragma unroll
            for (int j = 0; j < 4; ++j) { const float p = __expf(sc[ni][j] - mx); sc[ni][j] = p; sum += p; }
        sum += __shfl_xor(sum, 16); sum += __shfl_xor(sum, 32); sum += __expf(sink - mx);
        const float inv = frcp(sum);
#pragma unroll
        for (int ni = 0; ni < 13; ++ni) { u32x2 w; w.x = pkbf(sc[ni][0] * inv, sc[ni][1] * inv); w.y = pkbf(sc[ni][2] * inv, sc[ni][3] * inv); *(u32x2*)(Pw + fr * VT1_LD + 16 * ni + 4 * fq) = w; }
        *(u32x2*)(Pw + fr * VT1_LD + NKEYS + 4 * fq) = (u32x2){0u, 0u};
        asm volatile("s_waitcnt lgkmcnt(0)" ::: "memory");
        f32x4 o[4];
#pragma unroll
        for (int ni = 0; ni < 4; ++ni) o[ni] = (f32x4){0.f, 0.f, 0.f, 0.f};
#pragma unroll
        for (int ks = 0; ks < 7; ++ks) { const bf16x8 af = *(const bf16x8*)(Pw + fr * VT1_LD + 32 * ks + 8 * fq);
#pragma unroll
            for (int ni = 0; ni < 4; ++ni) { const bf16x8 bb = *(const bf16x8*)(Vt + (16 * ni + fr) * VT1_LD + 32 * ks + 8 * fq); o[ni] = MFMA16(bb, af, o[ni]); }
            if (ks & 1) asm volatile("" ::: "memory"); }
#pragma unroll
        for (int ni = 0; ni < 4; ++ni) { u32x2 w; w.x = pkbf(o[ni][0], o[ni][1]); w.y = pkbf(o[ni][2], o[ni][3]); *(u32x2*)(AO + (size_t)(Rb + t) * DM + qh * 64 + 16 * ni + 4 * fq) = w; }
        asm volatile("s_waitcnt lgkmcnt(0)" ::: "memory");
    }
    __syncthreads();
}
__device__ __forceinline__ void attn_prompt_unit(ArgsP a, int lj, unsigned char* lds, int b, int kvh, int qb, int, int, int) {
    const int tid = ltid(), lane = tid & 63, wave = __builtin_amdgcn_readfirstlane(tid >> 6);
    const bf16* __restrict__ Q = (const bf16*)(a->ws + WS_Q); const bf16* __restrict__ KV = (const bf16*)(a->ws + WS_KV); bf16* __restrict__ AO = (bf16*)(a->ws + WS_AO);
    bf16* Ks = (bf16*)lds; bf16* Vt = Ks + NKEYS * KS_LD; bf16* Pw = Vt + 64 * VT_LD + wave * 16 * P_LD;
    const int fr = lane & 15, fq = lane >> 4, t0 = qb * 64, Rb = b * SEQ;
    const int r = wave >> 1, th = (wave & 1) * 32, qh = kvh * 4 + r;
    bf16x8 q0[2], q1[2];
#pragma unroll
    for (int ks = 0; ks < 2; ++ks) { q0[ks] = *(const bf16x8*)(Q + (size_t)(Rb + t0 + th + fr) * DM + qh * 64 + 32 * ks + 8 * fq); q1[ks] = *(const bf16x8*)(Q + (size_t)(Rb + t0 + th + 16 + fr) * DM + qh * 64 + 32 * ks + 8 * fq); }
    {
        u32x4 kv[4];
#pragma unroll
        for (int k = 0; k < 4; ++k) { const int it = tid + NTHREADS * k, key = it >> 3, ch = it & 7; kv[k] = (u32x4){0u, 0u, 0u, 0u};
            if (it < NKEYS * 8) { int row; if (key < 16) row = ROW_M + key; else { int s = t0 - 128 + key - 16; if (s < 0) s = 0; row = Rb + s; }
                kv[k] = *(const u32x4*)(KV + (size_t)row * KVW + kvh * 64 + ch * 8); } }
        u32x4 v0[2], v1[2];
#pragma unroll
        for (int k = 0; k < 2; ++k) { const int it = tid + NTHREADS * k, dbl = it & 7, kp = it >> 3; v0[k] = (u32x4){0u, 0u, 0u, 0u}; v1[k] = v0[k];
            if (it < (NKEYS / 2) * 8) { const int k0 = 2 * kp, k1 = k0 + 1; int s0 = t0 - 128 + k0 - 16, s1 = t0 - 128 + k1 - 16; if (s0 < 0) s0 = 0; if (s1 < 0) s1 = 0;
                const int r0 = (k0 < 16) ? ROW_M + k0 : Rb + s0, r1 = (k1 < 16) ? ROW_M + k1 : Rb + s1;
                v0[k] = *(const u32x4*)(KV + (size_t)r0 * KVW + 256 + kvh * 64 + dbl * 8); v1[k] = *(const u32x4*)(KV + (size_t)r1 * KVW + 256 + kvh * 64 + dbl * 8); } }
#pragma unroll
        for (int k = 0; k < 4; ++k) { const int it = tid + NTHREADS * k, key = it >> 3, ch = it & 7; if (it < NKEYS * 8) *(u32x4*)(Ks + key * KS_LD + ch * 8) = kv[k]; }
#pragma unroll
        for (int k = 0; k < 2; ++k) { const int it = tid + NTHREADS * k, dbl = it & 7, kp = it >> 3;
            if (it < (NKEYS / 2) * 8) { const int col = (2 * kp) ^ (8 * dbl);
                const unsigned a0[4] = {v0[k].x, v0[k].y, v0[k].z, v0[k].w}, a1[4] = {v1[k].x, v1[k].y, v1[k].z, v1[k].w};
#pragma unroll
                for (int j = 0; j < 4; ++j) {
                    *(unsigned*)(Vt + (dbl * 8 + 2 * j) * VT_LD + col) = (a0[j] & 0xffffu) | (a1[j] << 16);
                    *(unsigned*)(Vt + (dbl * 8 + 2 * j + 1) * VT_LD + col) = (a0[j] >> 16) | (a1[j] & 0xffff0000u); } } }
#pragma unroll
        for (int k = 0; k < 3; ++k) { const int idx = tid + NTHREADS * k, row = idx / 24, c = idx - row * 24; *(unsigned*)(Vt + row * VT_LD + ((NKEYS + 2 * c) ^ TSW(row))) = 0u; }
    }
    __syncthreads();
    const float sink = a->in[I_SINKS][lj * NQ + qh];
#pragma unroll 1
    for (int blk = 0; blk < 2; ++blk) {
        const int tq = th + blk * 16 + fr, t = t0 + tq;
        bf16x8 qa2[2];
#pragma unroll
        for (int ks = 0; ks < 2; ++ks) qa2[ks] = (blk == 0) ? q0[ks] : q1[ks];
        f32x4 sc[13];
#pragma unroll
        for (int ni = 0; ni < 13; ++ni) sc[ni] = (f32x4){0.f, 0.f, 0.f, 0.f};
#pragma unroll
        for (int ni = 0; ni < 13; ++ni) {
            const bf16x8 b0 = *(const bf16x8*)(Ks + (16 * ni + fr) * KS_LD + 8 * fq), b1 = *(const bf16x8*)(Ks + (16 * ni + fr) * KS_LD + 32 + 8 * fq);
            sc[ni] = MFMA16(b0, qa2[0], sc[ni]); sc[ni] = MFMA16(b1, qa2[1], sc[ni]);
            if ((ni & 3) == 3) asm volatile("" ::: "memory"); }
        int lo = tq + 17; { const int l2 = 144 - t0; if (l2 > lo) lo = l2; }
        const unsigned span = (unsigned)(tq + 144 - lo);
        float mx = -INFINITY;
#pragma unroll
        for (int ni = 0; ni < 13; ++ni)
#pragma unroll
            for (int j = 0; j < 4; ++j) { const int key = 16 * ni + 4 * fq + j; const bool vis = (ni == 0) || ((unsigned)(key - lo) <= span);
                const float v = vis ? sc[ni][j] * 0.125f : -INFINITY; sc[ni][j] = v; mx = fmaxf(mx, v); }
        mx = fmaxf(mx, __shfl_xor(mx, 16)); mx = fmaxf(mx, __shfl_xor(mx, 32)); mx = fmaxf(mx, sink);
        float sum = 0.f;
#pragma unroll
        for (int ni = 0; ni < 13; ++ni)
#pragma unroll
            for (int j = 0; j < 4; ++j) { const float p = __expf(sc[ni][j] - mx); sc[ni][j] = p; sum += p; }
        sum += __shfl_xor(sum, 16); sum += __shfl_xor(sum, 32); sum += __expf(sink - mx);
        const float inv = frcp(sum);
#pragma unroll
        for (int ni = 0; ni < 13; ++ni) { u32x2 w; w.x = pkbf(sc[ni][0] * inv, sc[ni][1] * inv); w.y = pkbf(sc[ni][2] * inv, sc[ni][3] * inv); *(u32x2*)(Pw + fr * P_LD + 16 * ni + 4 * fq) = w; }
        *(u32x2*)(Pw + fr * P_LD + NKEYS + 4 * fq) = (u32x2){0u, 0u};
        asm volatile("s_waitcnt lgkmcnt(0)" ::: "memory");
        f32x4 o[4];
#pragma unroll
        for (int ni = 0; ni < 4; ++ni) o[ni] = (f32x4){0.f, 0.f, 0.f, 0.f};
#pragma unroll
        for (int ks = 0; ks < 7; ++ks) { const bf16x8 af = *(const bf16x8*)(Pw + fr * P_LD + 32 * ks + 8 * fq);
#pragma unroll
            for (int ni = 0; ni < 4; ++ni) { const int vr = 16 * ni + fr; const bf16x8 bb = *(const bf16x8*)(Vt + vr * VT_LD + ((32 * ks + 8 * fq) ^ TSW(vr))); o[ni] = MFMA16(bb, af, o[ni]); }
            if (ks & 1) asm volatile("" ::: "memory"); }
#pragma unroll
        for (int ni = 0; ni < 4; ++ni) { u32x2 w; w.x = pkbf(o[ni][0], o[ni][1]); w.y = pkbf(o[ni][2], o[ni][3]); *(u32x2*)(AO + (size_t)(Rb + t) * DM + qh * 64 + 16 * ni + 4 * fq) = w; }
        asm volatile("s_waitcnt lgkmcnt(0)" ::: "memory");
    }
    __syncthreads();
}
constexpr int SK_LD = 72, SV_LD = 200, SP_LD = 168, SKEYS = 160;
__device__ __forceinline__ void attn_sample_pair(ArgsP a, int lj, unsigned char* lds, int bp, int kvh, int, int, int) {
    const int tid = ltid(), lane = tid & 63, wave = __builtin_amdgcn_readfirstlane(tid >> 6);
    const bf16* __restrict__ Q = (const bf16*)(a->ws + WS_Q); const bf16* __restrict__ KV = (const bf16*)(a->ws + WS_KV); bf16* __restrict__ AO = (bf16*)(a->ws + WS_AO);
    const float* __restrict__ CK = a->in[I_CK]; const float* __restrict__ CV = a->in[I_CV];
    constexpr int HALF_B = (SKEYS * SK_LD + 64 * SV_LD) * 2;
    const int fr = lane & 15, fq = lane >> 4;
#pragma unroll 1
    for (int it = tid; it < 2 * SKEYS * 8; it += NTHREADS) { const int hf = it / (SKEYS * 8), rem = it - hf * (SKEYS * 8), key = rem >> 3, ch = rem & 7, bb = 2 * bp + hf;
        bf16* Ks = (bf16*)(lds + hf * HALF_B);
        u32x4 w = (u32x4){0u, 0u, 0u, 0u};
        if (key < 16) w = *(const u32x4*)(KV + (size_t)(ROW_M + key) * KVW + kvh * 64 + ch * 8);
        else if (key < 144) { const float* p = CK + ((size_t)(bb * 128 + (key - 16)) * NKV + kvh) * 64 + ch * 8; const f32x4 x0 = *(const f32x4*)p, x1 = *(const f32x4*)(p + 4);
            w.x = pkbf(x0.x, x0.y); w.y = pkbf(x0.z, x0.w); w.z = pkbf(x1.x, x1.y); w.w = pkbf(x1.z, x1.w); }
        else if (key < 152) w = *(const u32x4*)(KV + (size_t)(ROW_S + bb * 8 + (key - 144)) * KVW + kvh * 64 + ch * 8);
        *(u32x4*)(Ks + key * SK_LD + ch * 8) = w; }
#pragma unroll 1
    for (int it = tid; it < 2 * 96 * 8; it += NTHREADS) { const int hf = it / (96 * 8), rem = it - hf * (96 * 8), dbl = rem & 7, kp = rem >> 3, bb = 2 * bp + hf;
        bf16* Vt = (bf16*)(lds + hf * HALF_B) + SKEYS * SK_LD;
        unsigned a0[4] = {0u, 0u, 0u, 0u}, a1[4] = {0u, 0u, 0u, 0u};
        const int k0 = 2 * kp;
        if (k0 < 16) { const u32x4 x = *(const u32x4*)(KV + (size_t)(ROW_M + k0) * KVW + 256 + kvh * 64 + dbl * 8), y = *(const u32x4*)(KV + (size_t)(ROW_M + k0 + 1) * KVW + 256 + kvh * 64 + dbl * 8);
            a0[0] = x.x; a0[1] = x.y; a0[2] = x.z; a0[3] = x.w; a1[0] = y.x; a1[1] = y.y; a1[2] = y.z; a1[3] = y.w; }
        else if (k0 < 144) { const float* p = CV + ((size_t)(bb * 128 + (k0 - 16)) * NKV + kvh) * 64 + dbl * 8; const f32x4 x0 = *(const f32x4*)p, x1 = *(const f32x4*)(p + 4), y0 = *(const f32x4*)(p + NKV * 64), y1 = *(const f32x4*)(p + NKV * 64 + 4);
            a0[0] = pkbf(x0.x, x0.y); a0[1] = pkbf(x0.z, x0.w); a0[2] = pkbf(x1.x, x1.y); a0[3] = pkbf(x1.z, x1.w); a1[0] = pkbf(y0.x, y0.y); a1[1] = pkbf(y0.z, y0.w); a1[2] = pkbf(y1.x, y1.y); a1[3] = pkbf(y1.z, y1.w); }
        else if (k0 < 152) { const u32x4 x = *(const u32x4*)(KV + (size_t)(ROW_S + bb * 8 + (k0 - 144)) * KVW + 256 + kvh * 64 + dbl * 8), y = *(const u32x4*)(KV + (size_t)(ROW_S + bb * 8 + (k0 - 143)) * KVW + 256 + kvh * 64 + dbl * 8);
            a0[0] = x.x; a0[1] = x.y; a0[2] = x.z; a0[3] = x.w; a1[0] = y.x; a1[1] = y.y; a1[2] = y.z; a1[3] = y.w; }
        const int col = (2 * kp) ^ (8 * dbl);
#pragma unroll
        for (int j = 0; j < 4; ++j) {
            *(unsigned*)(Vt + (dbl * 8 + 2 * j) * SV_LD + col) = (a0[j] & 0xffffu) | (a1[j] << 16);
            *(unsigned*)(Vt + (dbl * 8 + 2 * j + 1) * SV_LD + col) = (a0[j] >> 16) | (a1[j] & 0xffff0000u); } }
    if (lj == 0) {
#pragma unroll 1
        for (int it = tid; it < 2 * 128 * 16; it += NTHREADS) { const int hf = it >> 11, rem = it & 2047, w = rem >> 4, c4 = (rem & 15) * 4, bb = 2 * bp + hf;
            const size_t o = ((size_t)(bb * 128 + w) * NKV + kvh) * 64 + c4;
            f32x4 kx, vx;
            if (w < 120) { const size_t i = ((size_t)(bb * 128 + w + 8) * NKV + kvh) * 64 + c4; kx = *(const f32x4*)(CK + i); vx = *(const f32x4*)(CV + i); }
            else { const bf16* rp = KV + (size_t)(ROW_S + bb * 8 + (w - 120)) * KVW + kvh * 64 + c4; const u32x2 k2 = *(const u32x2*)rp, v2 = *(const u32x2*)(rp + 256);
                kx = (f32x4){bflo(k2.x), bfhi(k2.x), bflo(k2.y), bfhi(k2.y)}; vx = (f32x4){bflo(v2.x), bfhi(v2.x), bflo(v2.y), bfhi(v2.y)}; }
            *(f32x4*)(a->out + O_SCK + o) = kx; *(f32x4*)(a->out + O_SCV + o) = vx; }
    }
    __syncthreads();
    if (wave < 4) {
        const int hf = wave >> 1, rb = wave & 1, bb = 2 * bp + hf;
        const bf16* Ks = (const bf16*)(lds + hf * HALF_B); const bf16* Vt = Ks + SKEYS * SK_LD; bf16* Pw = (bf16*)(lds + 2 * HALF_B) + wave * 16 * SP_LD;
        const int r = 2 * rb + (fr >> 3), t = fr & 7, qh = kvh * 4 + r;
        const size_t qrow = (size_t)(ROW_S + bb * 8 + t);
        bf16x8 qa[2];
#pragma unroll
        for (int ks = 0; ks < 2; ++ks) qa[ks] = *(const bf16x8*)(Q + qrow * DM + qh * 64 + 32 * ks + 8 * fq);
        const float sink = a->in[I_SINKS][lj * NQ + qh];
        f32x4 sc[10];
#pragma unroll
        for (int ni = 0; ni < 10; ++ni) sc[ni] = (f32x4){0.f, 0.f, 0.f, 0.f};
#pragma unroll
        for (int ni = 0; ni < 10; ++ni) {
            const bf16x8 b0 = *(const bf16x8*)(Ks + (16 * ni + fr) * SK_LD + 8 * fq), b1 = *(const bf16x8*)(Ks + (16 * ni + fr) * SK_LD + 32 + 8 * fq);
            sc[ni] = MFMA16(b0, qa[0], sc[ni]); sc[ni] = MFMA16(b1, qa[1], sc[ni]); }
        float mx = -INFINITY;
#pragma unroll
        for (int ni = 0; ni < 10; ++ni)
#pragma unroll
            for (int j = 0; j < 4; ++j) { const int key = 16 * ni + 4 * fq + j;
                const bool vis = (ni == 0) || ((key < 144) ? (key - 16 > t) : (key - 144 <= t));
                const float v = vis ? sc[ni][j] * 0.125f : -INFINITY; sc[ni][j] = v; mx = fmaxf(mx, v); }
        mx = fmaxf(mx, __shfl_xor(mx, 16)); mx = fmaxf(mx, __shfl_xor(mx, 32)); mx = fmaxf(mx, sink);
        float sum = 0.f;
#pragma unroll
        for (int ni = 0; ni < 10; ++ni)
#pragma unroll
            for (int j = 0; j < 4; ++j) { const float p = __expf(sc[ni][j] - mx); sc[ni][j] = p; sum += p; }
        sum += __shfl_xor(sum, 16); sum += __shfl_xor(sum, 32); sum += __expf(sink - mx);
        const float inv = frcp(sum);
#pragma unroll
        for (int ni = 0; ni < 10; ++ni) { u32x2 w; w.x = pkbf(sc[ni][0] * inv, sc[ni][1] * inv); w.y = pkbf(sc[ni][2] * inv, sc[ni][3] * inv); *(u32x2*)(Pw + fr * SP_LD + 16 * ni + 4 * fq) = w; }
        asm volatile("s_waitcnt lgkmcnt(0)" ::: "memory");
        f32x4 o[4];
#pragma unroll
        for (int ni = 0; ni < 4; ++ni) o[ni] = (f32x4){0.f, 0.f, 0.f, 0.f};
#pragma unroll
        for (int ks = 0; ks < 5; ++ks) { const bf16x8 af = *(const bf16x8*)(Pw + fr * SP_LD + 32 * ks + 8 * fq);
#pragma unroll
            for (int ni = 0; ni < 4; ++ni) { const int vr = 16 * ni + fr; const bf16x8 bb2 = *(const bf16x8*)(Vt + vr * SV_LD + ((32 * ks + 8 * fq) ^ TSW(vr))); o[ni] = MFMA16(bb2, af, o[ni]); } }
#pragma unroll
        for (int ni = 0; ni < 4; ++ni) { u32x2 w; w.x = pkbf(o[ni][0], o[ni][1]); w.y = pkbf(o[ni][2], o[ni][3]); *(u32x2*)(AO + qrow * DM + qh * 64 + 16 * ni + 4 * fq) = w; }
    }
    __syncthreads();
}
__device__ __forceinline__ void attn_sample_unit(ArgsP a, int lj, unsigned char* lds, int b, int kvh, int, int, int) {
    const int tid = ltid(), lane = tid & 63, wave = __builtin_amdgcn_readfirstlane(tid >> 6);
    const bf16* Q = (const bf16*)(a->ws + WS_Q); const bf16* KV = (const bf16*)(a->ws + WS_KV); bf16* AO = (bf16*)(a->ws + WS_AO);
    float* Kf = (float*)lds; float* Vf = Kf + 152 * 65; float* Qf = Vf + 152 * 64; float* Sc = Qf + 32 * 64;
    for (int idx = tid; idx < 152 * 64; idx += NTHREADS) { const int s = idx >> 6, d = idx & 63; float kv, vv;
        if (s < 16) { const bf16* rowp = KV + (size_t)(ROW_M + s) * KVW + kvh * 64 + d; kv = bf2f(rowp[0]); vv = bf2f(rowp[256]); }
        else if (s < 144) { const size_t o = ((size_t)(b * 128 + (s - 16)) * NKV + kvh) * 64 + d; kv = a->in[I_CK][o]; vv = a->in[I_CV][o]; }
        else { const bf16* rowp = KV + (size_t)(ROW_S + b * 8 + (s - 144)) * KVW + kvh * 64 + d; kv = bf2f(rowp[0]); vv = bf2f(rowp[256]); }
        Kf[s * 65 + d] = kv; Vf[s * 64 + d] = vv; }
    for (int idx = tid; idx < 32 * 64; idx += NTHREADS) { const int qi = idx >> 6, d = idx & 63, r = qi >> 3, t = qi & 7;
        Qf[qi * 64 + d] = bf2f(Q[(size_t)(ROW_S + b * 8 + t) * DM + (kvh * 4 + r) * 64 + d]); }
    __syncthreads();
    if (lj == 0) {
        for (int idx = tid; idx < 128 * 64; idx += NTHREADS) { const int w = idx >> 6, d = idx & 63; const size_t o = ((size_t)(b * 128 + w) * NKV + kvh) * 64 + d;
            a->out[O_SCK + o] = Kf[(24 + w) * 65 + d]; a->out[O_SCV + o] = Vf[(24 + w) * 64 + d]; }
    }
    for (int idx = tid; idx < 32 * 152; idx += NTHREADS) { const int qi = idx / 152, s = idx - qi * 152, t = qi & 7;
        float dot = 0.f;
#pragma unroll 16
        for (int d = 0; d < 64; ++d) dot += Qf[qi * 64 + d] * Kf[s * 65 + d];
        const bool vis = (s < 16) || ((s < 144) ? ((s - 16) > t) : ((s - 144) <= t));
        Sc[qi * 153 + s] = vis ? dot * 0.125f : -INFINITY; }
    __syncthreads();
#pragma unroll 1
    for (int q = 0; q < 4; ++q) { const int qi = wave * 4 + q, r = qi >> 3; const float sink = a->in[I_SINKS][lj * NQ + kvh * 4 + r];
        float v0 = Sc[qi * 153 + lane], v1 = Sc[qi * 153 + 64 + lane], v2 = (lane < 24) ? Sc[qi * 153 + 128 + lane] : -INFINITY;
        float mx = fmaxf(fmaxf(v0, v1), v2);
#pragma unroll
        for (int o = 1; o < 64; o <<= 1) mx = fmaxf(mx, __shfl_xor(mx, o));
        mx = fmaxf(mx, sink);
        v0 = __expf(v0 - mx); v1 = __expf(v1 - mx); v2 = __expf(v2 - mx);
        const float sum = wave_sum(v0 + v1 + v2) + __expf(sink - mx), inv = frcp(sum);
        Sc[qi * 153 + lane] = v0 * inv; Sc[qi * 153 + 64 + lane] = v1 * inv; if (lane < 24) Sc[qi * 153 + 128 + lane] = v2 * inv; }
    __syncthreads();
    { const int qi = tid >> 4, d4 = (tid & 15) * 4, r = qi >> 3, t = qi & 7; f32x4 o = (f32x4){0.f, 0.f, 0.f, 0.f};
#pragma unroll 8
        for (int s = 0; s < 152; ++s) { const float p = Sc[qi * 153 + s]; const f32x4 v = *(const f32x4*)(Vf + s * 64 + d4); o = o + v * p; }
        u32x2 w; w.x = pkbf(o.x, o.y); w.y = pkbf(o.z, o.w);
        *(u32x2*)(AO + (size_t)(ROW_S + b * 8 + t) * DM + (kvh * 4 + r) * 64 + d4) = w; }
    __syncthreads();
}
__device__ __forceinline__ void phase_attn(ArgsP a, int lj, unsigned char* lds, int tid, int wave, int lane) {
    if (lj == 0) {
        const bf16* KV = (const bf16*)(a->ws + WS_KV);
        const int gt = blockIdx.x * NTHREADS + tid, NT = gridDim.x * NTHREADS;
        for (int e = gt; e < 2 * 128 * 512; e += NT) { const int b = e >> 16, w = (e >> 9) & 127, c = e & 511;
            const float v = bf2f(KV[(size_t)(b * SEQ + SEQ - 128 + w) * KVW + c]);
            if (c < 256) a->out[O_PCK + (size_t)(b * 128 + w) * 256 + c] = v; else a->out[O_PCV + (size_t)(b * 128 + w) * 256 + (c - 256)] = v; }
    }
#pragma unroll 1
#ifndef OLD_SAMPLE_ATTN
#define OLD_SAMPLE_ATTN 0
#endif
#if OLD_SAMPLE_ATTN
    for (int u = blockIdx.x; u < 1024 + 512; u += gridDim.x) {
        if (u < 1024) { const int qb = u & 127, kvh = (u >> 7) & 3, b = u >> 9; attn_prompt_unit(a, lj, lds, b, kvh, qb, tid, wave, lane); }
        else { const int su = u - 1024; attn_sample_unit(a, lj, lds, su >> 2, su & 3, tid, wave, lane); }
    }
#else
#ifndef OLD_PROMPT_ATTN
#define OLD_PROMPT_ATTN 0
#endif
    for (int u = blockIdx.x; u < 1024 + 256; u += gridDim.x) {
        if (u < 1024) { const int qb = u & 127, kvh = (u >> 7) & 3, b = u >> 9;
            if (OLD_PROMPT_ATTN) attn_prompt_unit_v1(a, lj, lds, b, kvh, qb, tid, wave, lane); else attn_prompt_unit(a, lj, lds, b, kvh, qb, tid, wave, lane); }
        else { const int su = u - 1024; attn_sample_pair(a, lj, lds, su >> 2, su & 3, tid, wave, lane); }
    }
#endif
}

constexpr int PH_B = 9 * 2, PH_F = PH_B + 7 * 2, NPHASES = PH_F + 1;
template <class Epi> __device__ __forceinline__ void run_gemm(LAS unsigned char* lds, const bf16* A, const bf16* Bt, int N, int K, const Epi& E) {
    pg8::Gemm g{A, Bt, MP, N, K}; pg8::StaticOrder S; S.init(MP, N, K, (int)gridDim.x, (int)blockIdx.x);
    pg8::gemm_phase<Epi, pg8::StaticOrder, true, true>(lds, g, S, E);
}
template <class Epi> __device__ __forceinline__ void run_gemm_res(LAS unsigned char* lds, const bf16* A, const bf16* Bt, int K, int S_, const Epi& E) {
    pg8::Gemm g{A, Bt, MP, 1024, K}; pg8::ResOrder S; S.init(K, S_, (int)gridDim.x, (int)blockIdx.x);
    pg8::gemm_phase<Epi, pg8::ResOrder, true, true>(lds, g, S, E);
}

__global__ void __launch_bounds__(NTHREADS, 2) yoco_fwd(Args args) {
    extern __shared__ __attribute__((aligned(16))) unsigned char lds[];
    LAS unsigned char* ldsl = (LAS unsigned char*)lds;
    const int tid0 = threadIdx.x;
    for (int u = tid0; u < (LDS_BYTES - LDSCTL_OFF) / 4; u += NTHREADS) ((LAS unsigned*)(ldsl + LDSCTL_OFF))[u] = 0u;
    __syncthreads();
    const int lo = args.ph_lo, hi = args.ph_hi;
    XcdBarrier bar; bar.bar = (unsigned*)(args.ws + WS_CTL) + CW_BAR; bar.x = 0; bar.st = nullptr;
    if (hi - lo > 1) bar = xcd_barrier_post((unsigned*)(args.ws + WS_CTL) + CW_BAR, (volatile LAS unsigned*)(ldsl + MISC_OFF) + 8);
    int rep = 0;
#pragma unroll 1
    for (int p = lo; p < hi;) {
        ArgsP la = (ArgsP)__builtin_amdgcn_kernarg_segment_ptr(); asm volatile("" : "+s"(la));
        unsigned char* ws = la->ws;
        const int tid = ltid();
        const int lane = tid & 63, wave = __builtin_amdgcn_readfirstlane(tid >> 6);
        bf16* HN = (bf16*)(ws + WS_HN); float* H = (float*)(ws + WS_H);
        int kind, li = 0, lj = 0, layer = 0;
        int nslab = 8;
        if (p == 0) kind = 0;
        else if (p < PH_B) { li = p / 9; layer = li; const int sub = p % 9;
            kind = (sub == 0) ? 1 : (sub == 1) ? 3 : (sub == 2) ? 5 : (sub == 3) ? 6 : (sub == 4) ? 7 : (sub == 5) ? 8 : (sub == 6) ? 1 : (sub == 7) ? 9 : 10; }
        else if (p < PH_F) { lj = (p - PH_B) / 7; layer = 2 + lj; const int sub = (p - PH_B) % 7;
            kind = (sub == 0) ? 1 : (sub == 1) ? 11 : (sub == 2) ? 12 : (sub == 3) ? 13 : (sub == 4) ? 1 : (sub == 5) ? 9 : 10; if (sub == 4) nslab = 4; }
        else kind = 14;
#ifndef KMASK
#define KMASK 0xffff
#endif
#define KON(k) ((KMASK >> (k)) & 1)
#ifndef REP_MASK
#define REP_MASK 0
#endif
        if (KON(0) && kind == 0) { phase_prologue(la, ldsl, wave, lane); phase_norm(la, 1, 0, wave, lane); }
        else if (KON(1) && kind == 1) phase_norm(la, 0, nslab, wave, lane);
        else if (KON(3) && kind == 3) { pg8::EpiInProj E{(bf16*)(ws + WS_ZX), (float*)(ws + WS_DT), la->in[I_ADTB] + li * NHEADS}; run_gemm(ldsl, HN, (const bf16*)(ws + WS_WIN + li * SZ_WIN), INPROJ_P, 1024, E); }
        else if (KON(5) && kind == 5) phase_ssd1(la, li, lds, tid, wave, lane);
        else if (KON(6) && kind == 6) phase_scan(la, li);
        else if (KON(7) && kind == 7) phase_ssd3(la, li, lds, tid, wave, lane);
        else if (KON(8) && (kind == 8 || kind == 10 || kind == 13)) {
            const bf16* A; const bf16* Bt; int K;
            if (kind == 8) { A = (const bf16*)(ws + WS_YN); Bt = (const bf16*)(ws + WS_WOUT + li * SZ_WOUT); K = 2048; }
            else if (kind == 10) { A = (const bf16*)(ws + WS_U); Bt = (const bf16*)(ws + WS_WDN + layer * SZ_WDN); K = 4096; }
            else { A = (const bf16*)(ws + WS_AO); Bt = (const bf16*)(ws + WS_WO + lj * SZ_WO); K = 1024; }
            pg8::EpiRes E{(kind == 8 && li == 0) ? la->in[I_XP] : (const float*)H, H, (float*)(ws + WS_SLAB)}; run_gemm_res(ldsl, A, Bt, K, K == 1024 ? 4 : 8, E); }
        else if (KON(9) && kind == 9) { pg8::EpiBf<1> E{(bf16*)(ws + WS_U), 4096, 1 << 20, nullptr, 0}; run_gemm(ldsl, HN, (const bf16*)(ws + WS_WUP + layer * SZ_WUP), 4096, 1024, E); }
        else if (KON(11) && kind == 11) { pg8::EpiBf<0> E{(bf16*)(ws + WS_Q), 1024, 4, (bf16*)(ws + WS_KV), KVW};
            run_gemm(ldsl, HN, (const bf16*)(ws + (lj == 0 ? WS_WQKV0 : WS_WQ1)), lj == 0 ? 1536 : 1024, 1024, E); }
        else if (KON(12) && kind == 12) phase_attn(la, lj, lds, tid, wave, lane);
        else if (KON(14) && kind == 14) phase_final(la, wave, lane);
        bool again = false;
        if (REP_MASK != 0) { if (rep == 0 && ((REP_MASK >> kind) & 1)) { rep = 1; again = true; } else rep = 0; }
        if (p + 1 < hi || again) xcd_barrier(bar); else { asm volatile("s_waitcnt vmcnt(0)" ::: "memory"); __syncthreads(); }
        if (!again) ++p;
    }
}

#ifndef MK_PER_PHASE
#define MK_PER_PHASE 0
#endif
extern "C" void kernel_launch(void* const* d_in, const int* in_sizes, int n_in, void* d_out, int out_size, void* d_ws, size_t ws_size, hipStream_t stream) {
    static int grid = 0;
    if (grid == 0) {
        if (n_in != 26 || (size_t)out_size != O_END || ws_size < WS_END) { fprintf(stderr, "kernel_launch: unexpected problem (n_in %d, out %d vs %zu, ws %zu vs %zu); nothing launched\n", n_in, out_size, (size_t)O_END, ws_size, (size_t)WS_END); grid = -1; return; }
        int dev = 0, cus = 0, per_cu = 0;
        if (hipGetDevice(&dev) != hipSuccess || hipDeviceGetAttribute(&cus, hipDeviceAttributeMultiprocessorCount, dev) != hipSuccess) { grid = -1; return; }
        if (hipFuncSetAttribute((const void*)yoco_fwd, hipFuncAttributeMaxDynamicSharedMemorySize, LDS_BYTES) != hipSuccess) { fprintf(stderr, "kernel_launch: hipFuncSetAttribute failed\n"); grid = -1; return; }
        if (hipOccupancyMaxActiveBlocksPerMultiprocessor(&per_cu, (const void*)yoco_fwd, NTHREADS, LDS_BYTES) != hipSuccess || per_cu < 1) { fprintf(stderr, "kernel_launch: occupancy query says %d\n", per_cu); per_cu = 1; }
        (void)hipGetLastError();
        if (cus != 256) { fprintf(stderr, "kernel_launch: built for a 256-CU device (got %d); nothing launched\n", cus); grid = -1; return; }
        grid = cus;
    }
    if (grid < 0) return;
    if (hipMemsetAsync((char*)d_ws + WS_CTL, 0, CTL_ZERO_BYTES, stream) != hipSuccess) { fprintf(stderr, "kernel_launch: memset failed\n"); return; }
    Args a{};
    for (int i = 0; i < 26; ++i) a.in[i] = (const float*)d_in[i];
    a.out = (float*)d_out; a.ws = (unsigned char*)d_ws;
#if MK_PER_PHASE
    for (int p = 0; p < NPHASES; ++p) { a.ph_lo = p; a.ph_hi = p + 1; hipLaunchKernelGGL(yoco_fwd, dim3(grid), dim3(NTHREADS), LDS_BYTES, stream, a); }
#else
    a.ph_lo = 0; a.ph_hi = NPHASES;
    void* kargs[] = {&a};
    hipError_t e = hipLaunchCooperativeKernel((const void*)yoco_fwd, dim3(grid), dim3(NTHREADS), kargs, LDS_BYTES, stream);
    if (e != hipSuccess) fprintf(stderr, "kernel_launch: cooperative launch failed: %s (grid %d)\n", hipGetErrorString(e), grid);
#endif
}
```

```cpp
#include <hip/hip_runtime.h>
#include <cstdio>
#include <cstdint>
#include <cmath>
namespace pg8 {
#define PG8_LAS __attribute__((address_space(3)))
typedef unsigned short bf16_t;
typedef short bf16x8 __attribute__((ext_vector_type(8)));
typedef float f32x4 __attribute__((ext_vector_type(4)));
typedef unsigned u32x4 __attribute__((ext_vector_type(4)));
constexpr int BM = 256, BK = 64, HALF = 128, HTB = HALF * BK * 2  , STAGE_BYTES = 8 * HTB, NXCD = 8, WGM = 8;

__host__ __device__ __forceinline__ int lds_byte(int r, int c) { const int st = (r >> 4) * 2 + (c >> 5), rr = r & 15, cc = c & 31, ob = rr * 64 + cc * 2; return st * 1024 + (ob ^ (((ob >> 9) & 1) << 5)); }
__host__ __device__ __forceinline__ void stage_rc(int b, int& R, int& C) { const int st = b / 1024, sb = b % 1024, swz = sb ^ (((sb >> 9) & 1) << 5); R = (st >> 1) * 16 + swz / 64; C = (st & 1) * 32 + (swz % 64) / 2; }
__host__ __device__ __forceinline__ int perm32(int rho) { const int n = rho >> 4, i = rho & 15; return 8 * (i >> 2) + 4 * n + (i & 3); }

struct Unit { int pm, pn, k0, nt, aux; };
struct Gemm { const bf16_t* A; const bf16_t* Bt; int M, N, K; };

struct StaticOrder {
    int nM, nN, nwg, G, c, nt0;
    __host__ __device__ void init(int M, int N, int K, int G_, int c_) { nM = M / BM; nN = N / BM; nwg = nM * nN; G = G_; c = c_; nt0 = K / BK; }
    __host__ __device__ bool next(int i, Unit& u) const {
        const long L = (long)i * G + c; if (L >= nwg) return false;
        int wgid = (int)L; { const int q = nwg / NXCD, r = nwg % NXCD, xcd = wgid % NXCD, off = wgid / NXCD; wgid = (xcd < r ? xcd * (q + 1) : r * (q + 1) + (xcd - r) * q) + off; }
        const int nig = WGM * nN, gid = wgid / nig, fm = gid * WGM, gsz = (nM - fm) < WGM ? (nM - fm) : WGM;
        u.pm = fm + ((wgid % nig) % gsz); u.pn = (wgid % nig) / gsz; u.k0 = 0; u.nt = nt0; u.aux = -1; return true;
    }
    __device__ __forceinline__ void a_ready(const Unit&) const {}
    __device__ __forceinline__ void done(const Unit&) const {}
};
struct ResOrder {
    StaticOrder so; int S, K, c;
    __host__ __device__ void init(int K_, int S_, int G_, int c_) { so.init(64 * BM, 1024, K_, G_, c_); S = S_; K = K_; c = c_; }
    __host__ __device__ bool next(int i, Unit& u) const {
        if (i == 0) return so.next(0, u);
        if (i == 1 && c < 20 * S) { const int t = c / S, sl = c - t * S; u.pm = 64 + (t >> 2); u.pn = t & 3; u.k0 = sl * (K / S); u.nt = K / S / BK; u.aux = sl; return true; }
        return false;
    }
    __device__ __forceinline__ void a_ready(const Unit&) const {}
    __device__ __forceinline__ void done(const Unit&) const {}
};

typedef float f32x2_cv0 __attribute__((ext_vector_type(2))); typedef __bf16 bf16x2_cv0 __attribute__((ext_vector_type(2)));
__device__ __forceinline__ unsigned cvt_pk_bf16(float lo, float hi) { const f32x2_cv0 v = {lo, hi}; const bf16x2_cv0 b = __builtin_convertvector(v, bf16x2_cv0); return __builtin_bit_cast(unsigned, b); }
typedef float f32x2 __attribute__((ext_vector_type(2)));
typedef unsigned u32x2 __attribute__((ext_vector_type(2)));
__device__ __forceinline__ float softplus_f(float x) { const float y = __expf(-fabsf(x)); const float l = (y < 0.03125f) ? y * (1.f - y * (0.5f - y * (1.f / 3.f - 0.25f * y))) : __logf(1.f + y); return fmaxf(x, 0.f) + l; }
struct EpiInProj {
    static constexpr bool PERM = true, AFTER_DRAIN = false;
    bf16_t* ZX; float* DT; const float* dt_bias;
    __device__ __forceinline__ void operator()(const f32x4 (&acc)[2][2][4][2], const Unit& u, int wr, int wc, int fr, int fq) const {
        const int row0 = u.pm * BM + wr * 64 + fr;
        if (u.pn < 24) {
            const int col0 = u.pn * BM + wc * 32 + 8 * fq;
#pragma unroll
            for (int ai = 0; ai < 2; ++ai)
#pragma unroll
                for (int m = 0; m < 4; ++m) { bf16_t* rowp = ZX + (size_t)(row0 + ai * HALF + m * 16) * 6144 + col0;
#pragma unroll
                    for (int bj = 0; bj < 2; ++bj) { const f32x4 v0 = acc[ai][bj][m][0], v1 = acc[ai][bj][m][1];
                        u32x4 w; w.x = cvt_pk_bf16(v0[0], v0[1]); w.y = cvt_pk_bf16(v0[2], v0[3]); w.z = cvt_pk_bf16(v1[0], v1[1]); w.w = cvt_pk_bf16(v1[2], v1[3]);
                        *(u32x4*)(rowp + bj * HALF) = w; } }
        } else if (wc == 0) {
            const int c0 = 8 * fq;
            const f32x4 b0 = *(const f32x4*)(dt_bias + c0), b1 = *(const f32x4*)(dt_bias + c0 + 4);
#pragma unroll
            for (int ai = 0; ai < 2; ++ai)
#pragma unroll
                for (int m = 0; m < 4; ++m) { float* rowp = DT + (size_t)(row0 + ai * HALF + m * 16) * 32 + c0;
                    const f32x4 v0 = acc[ai][0][m][0] + b0, v1 = acc[ai][0][m][1] + b1;
                    f32x4 o0, o1;
#pragma unroll
                    for (int j = 0; j < 4; ++j) { o0[j] = softplus_f(v0[j]); o1[j] = softplus_f(v1[j]); }
                    *(f32x4*)(rowp) = o0; *(f32x4*)(rowp + 4) = o1; }
        }
    }
};
struct EpiRes {
    static constexpr bool PERM = false, AFTER_DRAIN = false;
    const float* B; float* H; float* SLAB;
    __device__ __forceinline__ void operator()(const f32x4 (&acc)[2][2][4][2], const Unit& u, int wr, int wc, int fr, int fq) const {
        const int row0 = u.pm * BM + wr * 64 + fr, col0 = u.pn * BM + wc * 32 + 4 * fq;
        if (u.aux >= 0) {
            float* base = SLAB + (size_t)u.aux * (1280 * 1024) + (size_t)(row0 - 16384) * 1024 + col0;
#pragma unroll
            for (int ai = 0; ai < 2; ++ai)
#pragma unroll
                for (int m = 0; m < 4; ++m) { float* rowp = base + (size_t)(ai * HALF + m * 16) * 1024;
#pragma unroll
                    for (int bj = 0; bj < 2; ++bj)
#pragma unroll
                        for (int n = 0; n < 2; ++n) *(f32x4*)(rowp + bj * HALF + n * 16) = acc[ai][bj][m][n]; }
            return;
        }
#pragma unroll
        for (int ai = 0; ai < 2; ++ai)
#pragma unroll
            for (int m = 0; m < 4; ++m) { const size_t off = (size_t)(row0 + ai * HALF + m * 16) * 1024 + col0;
#pragma unroll
                for (int bj = 0; bj < 2; ++bj)
#pragma unroll
                    for (int n = 0; n < 2; ++n) *(f32x4*)(H + off + bj * HALF + n * 16) = *(const f32x4*)(B + off + bj * HALF + n * 16) + acc[ai][bj][m][n]; }
    }
};
template <int ACT> struct EpiBf {
    static constexpr bool PERM = true, AFTER_DRAIN = false;
    bf16_t* O0; int ldc0; int nsplit; bf16_t* O1; int ldc1;
    __device__ __forceinline__ void operator()(const f32x4 (&acc)[2][2][4][2], const Unit& u, int wr, int wc, int fr, int fq) const {
        const int row0 = u.pm * BM + wr * 64 + fr;
        bf16_t* base; int ldc, colt;
        if (u.pn < nsplit) { base = O0; ldc = ldc0; colt = u.pn * BM; } else { base = O1; ldc = ldc1; colt = (u.pn - nsplit) * BM; }
        const int col0 = colt + wc * 32 + 8 * fq;
#pragma unroll
        for (int ai = 0; ai < 2; ++ai)
#pragma unroll
            for (int m = 0; m < 4; ++m) { bf16_t* rowp = base + (size_t)(row0 + ai * HALF + m * 16) * ldc + col0;
#pragma unroll
                for (int bj = 0; bj < 2; ++bj) { f32x4 v0 = acc[ai][bj][m][0], v1 = acc[ai][bj][m][1];
                    if (ACT == 1) {
#pragma unroll
                        for (int j = 0; j < 4; ++j) { const float a = fmaxf(v0[j], 0.f), b = fmaxf(v1[j], 0.f); v0[j] = a * a; v1[j] = b * b; } }
                    u32x4 w; w.x = cvt_pk_bf16(v0[0], v0[1]); w.y = cvt_pk_bf16(v0[2], v0[3]); w.z = cvt_pk_bf16(v1[0], v1[1]); w.w = cvt_pk_bf16(v1[2], v1[3]);
                    *(u32x4*)(rowp + bj * HALF) = w; } }
    }
};
struct EpiQSplit {
    static constexpr bool PERM = true, AFTER_DRAIN = false;
    bf16_t* Q; float* SLAB;
    __device__ __forceinline__ void operator()(const f32x4 (&acc)[2][2][4][2], const Unit& u, int wr, int wc, int fr, int fq) const {
        const int row0 = u.pm * BM + wr * 64 + fr, col0 = u.pn * BM + wc * 32 + 8 * fq;
        if (u.aux >= 0) {
            float* base = SLAB + (size_t)u.aux * (1280 * 1024) + (size_t)(row0 - 16384) * 1024 + col0;
#pragma unroll
            for (int ai = 0; ai < 2; ++ai)
#pragma unroll
                for (int m = 0; m < 4; ++m) { float* rowp = base + (size_t)(ai * HALF + m * 16) * 1024;
#pragma unroll
                    for (int bj = 0; bj < 2; ++bj) { *(f32x4*)(rowp + bj * HALF) = acc[ai][bj][m][0]; *(f32x4*)(rowp + bj * HALF + 4) = acc[ai][bj][m][1]; } }
            return;
        }
#pragma unroll
        for (int ai = 0; ai < 2; ++ai)
#pragma unroll
            for (int m = 0; m < 4; ++m) { bf16_t* rowp = Q + (size_t)(row0 + ai * HALF + m * 16) * 1024 + col0;
#pragma unroll
                for (int bj = 0; bj < 2; ++bj) { const f32x4 v0 = acc[ai][bj][m][0], v1 = acc[ai][bj][m][1];
                    u32x4 w; w.x = cvt_pk_bf16(v0[0], v0[1]); w.y = cvt_pk_bf16(v0[2], v0[3]); w.z = cvt_pk_bf16(v1[0], v1[1]); w.w = cvt_pk_bf16(v1[2], v1[3]);
                    *(u32x4*)(rowp + bj * HALF) = w; } }
    }
};

template <class Epi, class Sched, bool ALIGN_EPI = false, bool SP2 = false>
__device__ __forceinline__ void gemm_phase(PG8_LAS unsigned char* lds, const Gemm g, const Sched& S, const Epi& E) {
    int tid_l = threadIdx.x; asm volatile("" : "+v"(tid_l));
    const int tid = tid_l, wid = __builtin_amdgcn_readfirstlane(tid >> 6), lane = tid & 63, wr = wid >> 2, wc = wid & 3, fr = lane & 15, fq = lane >> 4;
    const int K = g.K;
    unsigned voffA[2], voffB[2];
#pragma unroll
    for (int i = 0; i < 2; ++i) { int R, C; stage_rc(tid * 16 + i * 8192, R, C); const int Rb = Epi::PERM ? ((R & ~31) + perm32(R & 31)) : R;
        voffA[i] = (unsigned)(R * K + C) * 2u; voffB[i] = (unsigned)(Rb * K + C) * 2u; }
    const size_t kstep = (size_t)(BK * 2);
    const size_t hstep = (size_t)HALF * K * 2;
    const size_t tstep = 2 * hstep;
    const unsigned ldsw = (unsigned)wid * 1024u;
    const int aoff = lds_byte(wr * 64 + fr, fq * 8), boff = lds_byte(wc * 32 + fr, fq * 8);
#define PG8_SA(b, h) (((b) * 2 + (h)) * HTB)
#define PG8_SB(b, h) ((4 + (b) * 2 + (h)) * HTB)
#define PG8_STAGE(bufoff, gbase, voff) do { _Pragma("unroll") for (int _i = 0; _i < 2; ++_i) \
        __builtin_amdgcn_global_load_lds((const unsigned*)((const char*)(gbase) + (voff)[_i]), (PG8_LAS unsigned*)(lds + (bufoff) + ldsw + _i * 8192), 16, 0, 0); } while (0)
#define PG8_LDA(dst, b, h) do { _Pragma("unroll") for (int m = 0; m < 4; ++m) _Pragma("unroll") for (int k = 0; k < 2; ++k) dst[m][k] = *(const PG8_LAS bf16x8*)(lds + PG8_SA(b, h) + aoff + m * 2048 + k * 1024); } while (0)
#define PG8_LDB(dst, b, h) do { _Pragma("unroll") for (int n = 0; n < 2; ++n) _Pragma("unroll") for (int k = 0; k < 2; ++k) dst[n][k] = *(const PG8_LAS bf16x8*)(lds + PG8_SB(b, h) + boff + n * 2048 + k * 1024); } while (0)
#define PG8_MMA(ai, bj, At, Bt) do { __builtin_amdgcn_s_setprio(1); _Pragma("unroll") for (int m = 0; m < 4; ++m) _Pragma("unroll") for (int n = 0; n < 2; ++n) _Pragma("unroll") for (int k = 0; k < 2; ++k) \
        acc[ai][bj][m][n] = __builtin_amdgcn_mfma_f32_16x16x32_bf16(Bt[n][k], At[m][k], acc[ai][bj][m][n], 0, 0, 0); __builtin_amdgcn_s_setprio(0); } while (0)
#define PG8_WAIT_V(n) asm volatile("s_waitcnt vmcnt(" #n ")" ::: "memory")
#define PG8_WAIT_L(n) asm volatile("s_waitcnt lgkmcnt(" #n ")" ::: "memory")
#define PG8_BAR __builtin_amdgcn_s_barrier()
#define PG8_SCHED __builtin_amdgcn_sched_barrier(0)
    Unit cur, nxt; int ui = 0;
    if (!S.next(0, cur)) return;
    f32x4 acc[2][2][4][2];
#pragma unroll
    for (int a = 0; a < 2; ++a)
#pragma unroll
        for (int b = 0; b < 2; ++b)
#pragma unroll
            for (int m = 0; m < 4; ++m)
#pragma unroll
                for (int n = 0; n < 2; ++n) acc[a][b][m][n] = (f32x4){0.f, 0.f, 0.f, 0.f};
    bf16x8 At[4][2], B0[2][2], B1[2][2];
    const char* cA = (const char*)g.A + (size_t)cur.pm * tstep + (size_t)cur.k0 * 2; const char* cB = (const char*)g.Bt + (size_t)cur.pn * tstep + (size_t)cur.k0 * 2;
    S.a_ready(cur);
    if constexpr (SP2) {
        PG8_STAGE(PG8_SB(0, 0), cB, voffB); PG8_STAGE(PG8_SB(0, 1), cB + hstep, voffB); PG8_STAGE(PG8_SA(0, 0), cA, voffA); PG8_STAGE(PG8_SA(0, 1), cA + hstep, voffA);
        if (wr == 1) PG8_BAR;
        PG8_WAIT_V(2); PG8_BAR;
        PG8_STAGE(PG8_SB(1, 0), cB + kstep, voffB); PG8_STAGE(PG8_SA(1, 0), cA + kstep, voffA); PG8_STAGE(PG8_SB(1, 1), cB + hstep + kstep, voffB);
        PG8_WAIT_V(6); PG8_BAR;
    } else {
        PG8_STAGE(PG8_SB(0, 0), cB, voffB); PG8_STAGE(PG8_SA(0, 0), cA, voffA); PG8_STAGE(PG8_SB(0, 1), cB + hstep, voffB); PG8_STAGE(PG8_SA(0, 1), cA + hstep, voffA);
        if (wr == 1) PG8_BAR;
        PG8_WAIT_V(4); PG8_BAR;
        PG8_STAGE(PG8_SB(1, 0), cB + kstep, voffB); PG8_STAGE(PG8_SA(1, 0), cA + kstep, voffA); PG8_STAGE(PG8_SB(1, 1), cB + hstep + kstep, voffB);
        PG8_WAIT_V(6); PG8_BAR;
    }
    for (;;) {
        const bool has_next = S.next(ui + 1, nxt);
        const char* nA = has_next ? (const char*)g.A + (size_t)nxt.pm * tstep + (size_t)nxt.k0 * 2 : cA; const char* nB = has_next ? (const char*)g.Bt + (size_t)nxt.pn * tstep + (size_t)nxt.k0 * 2 : cB;
        const int nt = cur.nt;
        for (int t = 0; t < nt; t += 2) {
            const bool last = (t == nt - 2);
            const char* a1 = cA + (size_t)(t + 1) * kstep;
            const char* a2 = last ? nA : cA + (size_t)(t + 2) * kstep; const char* b2 = last ? nB : cB + (size_t)(t + 2) * kstep;
            const char* a3 = a2 + kstep; const char* b3 = b2 + kstep;
            if (last && has_next) S.a_ready(nxt);
            if constexpr (SP2) {
            PG8_LDB(B0, 0, 0); PG8_LDB(B1, 0, 1); PG8_SCHED; PG8_LDA(At, 0, 0); PG8_STAGE(PG8_SA(1, 1), a1 + hstep, voffA);
            PG8_WAIT_V(8); PG8_WAIT_L(0); PG8_BAR; PG8_MMA(0, 0, At, B0); PG8_MMA(0, 1, At, B1); PG8_BAR; PG8_SCHED;
            PG8_LDA(At, 0, 1); PG8_STAGE(PG8_SB(0, 0), b2, voffB); PG8_STAGE(PG8_SB(0, 1), b2 + hstep, voffB); PG8_STAGE(PG8_SA(0, 0), a2, voffA);
            PG8_WAIT_V(8); PG8_WAIT_L(0); PG8_BAR; PG8_MMA(1, 0, At, B0); PG8_MMA(1, 1, At, B1); PG8_BAR; PG8_SCHED;
            PG8_LDB(B0, 1, 0); PG8_LDB(B1, 1, 1); PG8_SCHED; PG8_LDA(At, 1, 0); PG8_STAGE(PG8_SA(0, 1), a2 + hstep, voffA);
            PG8_WAIT_V(8); PG8_WAIT_L(0); PG8_BAR; PG8_MMA(0, 0, At, B0); PG8_MMA(0, 1, At, B1); PG8_BAR; PG8_SCHED;
            PG8_LDA(At, 1, 1); PG8_STAGE(PG8_SB(1, 0), b3, voffB); PG8_STAGE(PG8_SB(1, 1), b3 + hstep, voffB); PG8_STAGE(PG8_SA(1, 0), a3, voffA);
            PG8_WAIT_V(8); PG8_WAIT_L(0); PG8_BAR; PG8_MMA(1, 0, At, B0); PG8_MMA(1, 1, At, B1); PG8_BAR; PG8_SCHED;
            } else {
            PG8_LDB(B0, 0, 0); PG8_SCHED; PG8_LDA(At, 0, 0); PG8_STAGE(PG8_SA(1, 1), a1 + hstep, voffA);
            PG8_WAIT_L(8); PG8_BAR; PG8_WAIT_L(0); PG8_MMA(0, 0, At, B0); PG8_BAR; PG8_SCHED;
            PG8_LDB(B1, 0, 1); PG8_STAGE(PG8_SB(0, 0), b2, voffB);
            PG8_BAR; PG8_WAIT_L(0); PG8_MMA(0, 1, At, B1); PG8_BAR;
            PG8_LDA(At, 0, 1); PG8_STAGE(PG8_SA(0, 0), a2, voffA);
            PG8_BAR; PG8_WAIT_L(0); PG8_MMA(1, 0, At, B0); PG8_BAR; PG8_SCHED;
            PG8_STAGE(PG8_SB(0, 1), b2 + hstep, voffB);
            PG8_WAIT_V(6); PG8_BAR; PG8_MMA(1, 1, At, B1); PG8_BAR;
            PG8_LDB(B0, 1, 0); PG8_SCHED; PG8_LDA(At, 1, 0); PG8_STAGE(PG8_SA(0, 1), a2 + hstep, voffA);
            PG8_WAIT_L(8); PG8_BAR; PG8_WAIT_L(0); PG8_MMA(0, 0, At, B0); PG8_BAR; PG8_SCHED;
            PG8_LDB(B1, 1, 1); PG8_STAGE(PG8_SB(1, 0), b3, voffB);
            PG8_BAR; PG8_WAIT_L(0); PG8_MMA(0, 1, At, B1); PG8_BAR;
            PG8_LDA(At, 1, 1); PG8_STAGE(PG8_SA(1, 0), a3, voffA);
            PG8_BAR; PG8_WAIT_L(0); PG8_MMA(1, 0, At, B0); PG8_BAR; PG8_SCHED;
            PG8_STAGE(PG8_SB(1, 1), b3 + hstep, voffB);
            PG8_WAIT_V(6); PG8_BAR; PG8_MMA(1, 1, At, B1); PG8_BAR;
            }
        }
        if constexpr (ALIGN_EPI) { if (wr == 0) PG8_BAR; }
        if constexpr (!Epi::AFTER_DRAIN) { E(acc, cur, wr, wc, fr, fq); S.done(cur); }
        if (!has_next) break;
#pragma unroll
        for (int a = 0; a < 2; ++a)
#pragma unroll
            for (int b = 0; b < 2; ++b)
#pragma unroll
                for (int m = 0; m < 4; ++m)
#pragma unroll
                    for (int n = 0; n < 2; ++n) acc[a][b][m][n] = (f32x4){0.f, 0.f, 0.f, 0.f};
        cur = nxt; cA = nA; cB = nB; ++ui;
        if constexpr (ALIGN_EPI) { if (wr == 1) PG8_BAR; }
    }
    PG8_WAIT_V(0);
    if constexpr (!ALIGN_EPI) { if (wr == 0) PG8_BAR; }
    PG8_BAR;
    if constexpr (Epi::AFTER_DRAIN) { E.fused(acc, cur, wr, wc, fr, fq, lds, wid, lane); S.done(cur); }
#undef PG8_SA
#undef PG8_SB
#undef PG8_STAGE
#undef PG8_LDA
#undef PG8_LDB
#undef PG8_MMA
#undef PG8_WAIT_V
#undef PG8_WAIT_L
#undef PG8_BAR
#undef PG8_SCHED
}
}
#define GAS __attribute__((address_space(1)))
#define LAS __attribute__((address_space(3)))
typedef unsigned short bf16;
typedef unsigned v4u __attribute__((ext_vector_type(4)));
typedef float f32x4 __attribute__((ext_vector_type(4)));
typedef short bf16x8 __attribute__((ext_vector_type(8)));
typedef GAS unsigned gu32;
typedef GAS unsigned long long gu64;
#define RLX_AGENT __ATOMIC_RELAXED, __HIP_MEMORY_SCOPE_AGENT
#define LDS_WAIT() asm volatile("s_waitcnt lgkmcnt(0)" ::: "memory")
#define VM_WAIT() asm volatile("s_waitcnt vmcnt(0)" ::: "memory")
__device__ __forceinline__ unsigned long long rt() { return __builtin_amdgcn_s_memrealtime(); }
__device__ __forceinline__ unsigned f2bf(float f) { unsigned u = __builtin_bit_cast(unsigned, f); return (u + 0x7fffu + ((u >> 16) & 1u)) >> 16; }
__device__ __forceinline__ unsigned pk2(float lo, float hi) { return f2bf(lo) | (f2bf(hi) << 16); }

#define XB_TMO      128
#define XB_XCNT(j)  (256  + 64 * (j))
#define XB_XSUB(j)  (1280 + 64 * (j))
#define XB_XGEN(j)  (2304 + 64 * (j))
#define XB_TOP      3328
#define XB_TOPGEN   3392
#define XCD_BAR_WORDS 3456
#define XB_SPIN_CAP (1u << 18)

__device__ __forceinline__ unsigned xb_ld(unsigned* p)              { return __hip_atomic_load(p, __ATOMIC_RELAXED, __HIP_MEMORY_SCOPE_AGENT); }
__device__ __forceinline__ unsigned xb_add(unsigned* p, unsigned v) { return __hip_atomic_fetch_add(p, v, __ATOMIC_RELAXED, __HIP_MEMORY_SCOPE_AGENT); }
__device__ __forceinline__ unsigned xb_xcc_id() { return (unsigned)__builtin_amdgcn_s_getreg((3 << 11) | 20) & 0xFu; }
#define XB_SPIN(cond, bar) do { unsigned _sp = 0; while (cond) { __builtin_amdgcn_s_sleep(1); \
    if ((++_sp & 255u) == 0u) { if (xb_ld(&(bar)[XB_TMO])) break; if (_sp > XB_SPIN_CAP) { atomicAdd(&(bar)[XB_TMO], 1u); break; } } } } while (0)

struct XcdBarrier {
    unsigned* bar; unsigned x;
    volatile LAS unsigned* st;
};

__device__ __forceinline__ XcdBarrier xcd_barrier_post(unsigned* bar, volatile LAS unsigned* st) {
    XcdBarrier b; b.bar = bar; b.x = xb_xcc_id(); b.st = st;
    if (threadIdx.x == 0) (void)xb_add(&bar[XB_XCNT(b.x)], 1u);
    return b;
}
__device__ __forceinline__ void xcd_barrier_complete(unsigned* bar, unsigned x, unsigned& nloc, unsigned& nx) {
    const unsigned G = gridDim.x * gridDim.y * gridDim.z;
    unsigned sum, cnt, mine, sp = 0u;
    for (;;) {
        sum = 0u; cnt = 0u; mine = 0u;
#pragma unroll
        for (unsigned j = 0; j < 16; ++j) { const unsigned c = xb_ld(&bar[XB_XCNT(j)]); sum += c; cnt += (c > 0u) ? 1u : 0u; mine = (j == x) ? c : mine; }
        if (sum == G) break;
        __builtin_amdgcn_s_sleep(1);
        if ((++sp & 255u) == 0u) { if (xb_ld(&bar[XB_TMO])) break; if (sp > XB_SPIN_CAP) { atomicAdd(&bar[XB_TMO], 1u); break; } }
    }
    nloc = mine > 0u ? mine : 1u; nx = cnt > 0u ? cnt : 1u;
}

__device__ __forceinline__ void xcd_barrier(const XcdBarrier& b) {
    asm volatile("s_waitcnt vmcnt(0)" ::: "memory");
    __syncthreads();
    if (threadIdx.x == 0) {
        unsigned* bar = b.bar;
        __builtin_amdgcn_s_waitcnt(0);
        unsigned nloc = b.st[0], nx = b.st[1];
        if (nloc == 0u) { xcd_barrier_complete(bar, b.x, nloc, nx); b.st[0] = nloc; b.st[1] = nx; }
        const unsigned old = xb_add(&bar[XB_XSUB(b.x)], 1u);
        const unsigned gen = old / nloc;
        if (old + 1u == (gen + 1u) * nloc) {
            __builtin_amdgcn_fence(__ATOMIC_RELEASE, "agent");
            asm volatile("s_waitcnt vmcnt(0)" ::: "memory");
            const unsigned og = xb_add(&bar[XB_TOP], 1u);
            const unsigned tg = og / nx;
            if (og + 1u == (tg + 1u) * nx) xb_add(&bar[XB_TOPGEN], 1u);
            else XB_SPIN(xb_ld(&bar[XB_TOPGEN]) == tg, bar);
            __builtin_amdgcn_fence(__ATOMIC_ACQUIRE, "agent");
            xb_add(&bar[XB_XGEN(b.x)], 1u);
            asm volatile("s_waitcnt vmcnt(0)" ::: "memory");
        } else {
            XB_SPIN(xb_ld(&bar[XB_XGEN(b.x)]) == gen, bar);
            __builtin_amdgcn_fence(__ATOMIC_ACQUIRE, "agent");
            asm volatile("s_waitcnt vmcnt(0)" ::: "memory");
        }
    }
    __syncthreads();
}
constexpr int NWAVES = 8, NTHREADS = 512;
constexpr int DM = 1024, SEQ = 8192, NPROMPT = 2, NSAMP = 128, TSAMP = 8, NMETA = 16;
constexpr int ROW_S = NPROMPT * SEQ;
constexpr int ROW_M = ROW_S + NSAMP * TSAMP;
constexpr int NROWS = ROW_M + NMETA;
constexpr int MP = 17664;
constexpr int DINNER = 2048, NHEADS = 32, HD = 64, NGROUPS = 8, DSTATE = 128, CONVD = 4096, INPROJ = 6176, INPROJ_P = 6400, ZXW = 6144;
constexpr int DFF = 4096, NKV = 4, NQ = 16, KVW = 512;
constexpr float EPS = 1e-5f;
constexpr int LDX = 136;

constexpr size_t O_YP = 0, O_YS = O_YP + (size_t)NPROMPT * SEQ * DM, O_PCONV = O_YS + (size_t)NSAMP * TSAMP * DM, O_PSSM = O_PCONV + 2 * 2 * 3 * 4096,
    O_PCK = O_PSSM + (size_t)2 * 2 * 32 * 64 * 128, O_PCV = O_PCK + 2 * 128 * 256, O_SCONV = O_PCV + 2 * 128 * 256, O_SSSM = O_SCONV + (size_t)2 * 128 * 3 * 4096,
    O_SCK = O_SSSM + (size_t)2 * 128 * 32 * 64 * 128, O_SCV = O_SCK + (size_t)128 * 128 * 256, O_END = O_SCV + (size_t)128 * 128 * 256;

constexpr size_t MiB = 1u << 20;
constexpr size_t WS_CTL = 0, CTL_ZERO_BYTES = 1 * MiB;
constexpr size_t SZ_WIN = (size_t)INPROJ_P * 1024 * 2, SZ_WOUT = (size_t)1024 * 2048 * 2, SZ_WUP = (size_t)4096 * 1024 * 2, SZ_WDN = SZ_WUP, SZ_WQKV0 = (size_t)1536 * 1024 * 2, SZ_WQ1 = (size_t)1024 * 1024 * 2, SZ_WO = SZ_WQ1;
constexpr size_t WS_WIN = 1 * MiB, WS_WOUT = WS_WIN + 2 * SZ_WIN, WS_WUP = WS_WOUT + 2 * SZ_WOUT, WS_WDN = WS_WUP + 4 * SZ_WUP, WS_WQKV0 = WS_WDN + 4 * SZ_WDN, WS_WQ1 = WS_WQKV0 + SZ_WQKV0, WS_WO = WS_WQ1 + SZ_WQ1, WS_WEND = WS_WO + 2 * SZ_WO;
constexpr size_t al1m(size_t x) { return (x + MiB - 1) / MiB * MiB; }
constexpr size_t WS_H = al1m(WS_WEND), WS_HN = al1m(WS_H + (size_t)MP * 1024 * 4), WS_ZX = al1m(WS_HN + (size_t)MP * 1024 * 2), WS_DT = al1m(WS_ZX + (size_t)MP * ZXW * 2),
    WS_XC = al1m(WS_DT + (size_t)MP * 32 * 4), WS_YN = al1m(WS_XC + (size_t)MP * 4096 * 2), WS_CS = al1m(WS_YN + (size_t)MP * 2048 * 2), WS_CD = al1m(WS_CS + (size_t)129 * 32 * 8192 * 4), WS_SLAB = al1m(WS_CD + 129 * 32 * 4), WS_HSB = al1m(WS_SLAB + (size_t)8 * 1280 * 1024 * 4), WS_END = al1m(WS_HSB + (size_t)128 * 32 * 8192 * 2);
constexpr size_t WS_U = WS_ZX;
constexpr size_t WS_Q = WS_XC, WS_KV = WS_Q + (size_t)MP * 1024 * 2, WS_AO = WS_KV + (size_t)MP * 512 * 2;
static_assert(WS_AO + (size_t)MP * 1024 * 2 <= WS_YN, "attention overlay");
constexpr int CW_BAR = 4096;

constexpr int RING_BYTES = 131072, LDS_BYTES = 147456, LDSCTL_OFF = LDS_BYTES - 512, MISC_OFF = LDSCTL_OFF + 320;

typedef unsigned u32x2 __attribute__((ext_vector_type(2)));
typedef unsigned u32x4 __attribute__((ext_vector_type(4)));
__device__ __forceinline__ int ltid() { int t = threadIdx.x; asm volatile("" : "+v"(t)); return t; }
__device__ __forceinline__ float bf2f(unsigned short b) { return __uint_as_float((unsigned)b << 16); }
__device__ __forceinline__ float bflo(unsigned w) { return __uint_as_float(w << 16); }
__device__ __forceinline__ float bfhi(unsigned w) { return __uint_as_float(w & 0xffff0000u); }
__device__ __forceinline__ unsigned pkbf(float lo, float hi) { return pg8::cvt_pk_bf16(lo, hi); }
__device__ __forceinline__ float wave_sum(float v) {
#pragma unroll
    for (int o = 1; o < 64; o <<= 1) v += __shfl_xor(v, o);
    return v;
}
__device__ __forceinline__ float frcp(float x) { return __builtin_amdgcn_rcpf(x); }
__device__ __forceinline__ float sigmoid_f(float x) { return frcp(1.f + __expf(-x)); }
#define MFMA16(b, a, c) __builtin_amdgcn_mfma_f32_16x16x32_bf16((b), (a), (c), 0, 0, 0)

struct Args {
    const float* in[26]; float* out; unsigned char* ws; int ph_lo, ph_hi;
};
typedef const __attribute__((address_space(4))) Args* ArgsP;
enum { I_XP = 0, I_XS, I_SCONV, I_SSSM, I_CK, I_CV, I_META, I_ANORM, I_AIN, I_ACONVW, I_ACONVB, I_ADTB, I_ALOG, I_ADSKIP, I_AGATE, I_AOUT, I_KVNORM, I_WKV, I_BNORM, I_WQ, I_SINKS, I_WO, I_MLPNORM, I_WUP, I_WDOWN, I_FNORM };

__device__ __forceinline__ void transpose_item(const float* W, const float* scale, int K, int N, bf16* WT, int row_off, LAS unsigned* scr, int item, int lane) {
    const int nblk = (N + 63) / 64, kb = item / nblk, nb = item % nblk, k0 = 64 * kb, n0 = 64 * nb;
    const bool ok = (n0 + lane < N);
    const float* src = W + (size_t)k0 * N + n0 + (ok ? lane : 0);
    float v[64];
#pragma unroll
    for (int i = 0; i < 64; ++i) v[i] = src[(size_t)i * N];
    if (!ok) {
#pragma unroll
        for (int i = 0; i < 64; ++i) v[i] = 0.f;
    }
    if (scale) {
#pragma unroll
        for (int i = 0; i < 64; ++i) v[i] *= scale[k0 + i];
    }
#pragma unroll
    for (int i = 0; i < 32; ++i) scr[lane * 33 + i] = pkbf(v[2 * i], v[2 * i + 1]);
    LDS_WAIT(); asm volatile("" ::: "memory");
    const int c = lane & 7;
#pragma unroll
    for (int j = 0; j < 8; ++j) { const int n = (lane >> 3) + 8 * j; const LAS unsigned* sp = scr + n * 33 + 4 * c;
        v4u o; o.x = sp[0]; o.y = sp[1]; o.z = sp[2]; o.w = sp[3];
        if (n0 + n < N) *(GAS v4u*)(WT + (size_t)(row_off + n0 + n) * K + k0 + 8 * c) = o; }
    LDS_WAIT(); asm volatile("" ::: "memory");
}
struct WJob { const float* W; const float* scale; int K, N; bf16* WT; int row_off; int items; };

__device__ __forceinline__ void phase_prologue(ArgsP a, LAS unsigned char* lds, int wave, int lane) {
    LAS unsigned* scr = (LAS unsigned*)(lds + wave * 16384);
    const int gw = blockIdx.x * NWAVES + wave, NGW = gridDim.x * NWAVES;
    unsigned char* ws = a->ws;
    for (int jb = 0; jb < 21; ++jb) {
        WJob J;
        if (jb < 2)       { const int i = jb;      J = WJob{a->in[I_AIN] + (size_t)i * 1024 * INPROJ, a->in[I_ANORM] + i * 1024, 1024, INPROJ, (bf16*)(ws + WS_WIN + i * SZ_WIN), 0, 0}; }
        else if (jb < 4)  { const int i = jb - 2;  J = WJob{a->in[I_AOUT] + (size_t)i * 2048 * 1024, a->in[I_AGATE] + i * 2048, 2048, 1024, (bf16*)(ws + WS_WOUT + i * SZ_WOUT), 0, 0}; }
        else if (jb < 8)  { const int l = jb - 4;  J = WJob{a->in[I_WUP] + (size_t)l * 1024 * 4096, a->in[I_MLPNORM] + l * 1024, 1024, 4096, (bf16*)(ws + WS_WUP + l * SZ_WUP), 0, 0}; }
        else if (jb < 12) { const int l = jb - 8;  J = WJob{a->in[I_WDOWN] + (size_t)l * 4096 * 1024, nullptr, 4096, 1024, (bf16*)(ws + WS_WDN + l * SZ_WDN), 0, 0}; }
        else if (jb == 12) { J = WJob{a->in[I_WQ], a->in[I_BNORM], 1024, 1024, (bf16*)(ws + WS_WQKV0), 0, 0}; }
        else if (jb == 13) { J = WJob{a->in[I_WKV], a->in[I_KVNORM], 1024, 512, (bf16*)(ws + WS_WQKV0), 1024, 0}; }
        else if (jb == 14) { J = WJob{a->in[I_WQ] + (size_t)1024 * 1024, a->in[I_BNORM] + 1024, 1024, 1024, (bf16*)(ws + WS_WQ1), 0, 0}; }
        else if (jb < 17) { const int j = jb - 15; J = WJob{a->in[I_WO] + (size_t)j * 1024 * 1024, nullptr, 1024, 1024, (bf16*)(ws + WS_WO + j * SZ_WO), 0, 0}; }
        else break;
        const int items = (J.K / 64) * ((J.N + 63) / 64);
        for (int it = gw; it < items; it += NGW) transpose_item(J.W, J.scale, J.K, J.N, J.WT, J.row_off, scr, it, lane);
    }
    {
        const int gt = blockIdx.x * NTHREADS + ltid(), NT = gridDim.x * NTHREADS;
        const int per = (INPROJ_P - INPROJ) * 1024 * 2 / 16;
        for (int e = gt; e < 2 * per; e += NT) { const int i = e / per, c = e % per;
            *(v4u*)(ws + WS_WIN + i * SZ_WIN + (size_t)INPROJ * 1024 * 2 + (size_t)c * 16) = (v4u){0u, 0u, 0u, 0u}; }
    }
}

__device__ __forceinline__ void norm_store(bf16* __restrict__ HN, int m, int lane, const f32x4 (&v)[4]) {
    float s = 0.f;
#pragma unroll
    for (int j = 0; j < 4; ++j) s += (v[j].x * v[j].x + v[j].y * v[j].y) + (v[j].z * v[j].z + v[j].w * v[j].w);
    const float rs = rsqrtf(wave_sum(s) * (1.f / DM) + EPS);
    unsigned long long* o8 = (unsigned long long*)(HN + (size_t)m * DM) + lane;
#pragma unroll
    for (int j = 0; j < 4; ++j) o8[64 * j] = (unsigned long long)pkbf(v[j].x * rs, v[j].y * rs) | ((unsigned long long)pkbf(v[j].z * rs, v[j].w * rs) << 32);
}
__device__ __forceinline__ void phase_norm(ArgsP a, int from_inputs, int nslab, int wave, int lane) {
    float* __restrict__ H = (float*)(a->ws + WS_H); bf16* __restrict__ HN = (bf16*)(a->ws + WS_HN); const float* __restrict__ SLAB = (const float*)(a->ws + WS_SLAB);
    const int gw = blockIdx.x * NWAVES + wave, NGW = gridDim.x * NWAVES;
    for (int m = ROW_S + gw; m < MP; m += NGW) {
        if (m >= NROWS) { unsigned long long* o8 = (unsigned long long*)(HN + (size_t)m * DM) + lane;
#pragma unroll
            for (int j = 0; j < 4; ++j) o8[64 * j] = 0ull;
            continue; }
        const float* src = from_inputs ? ((m < ROW_M) ? a->in[I_XS] + (size_t)(m - ROW_S) * DM : a->in[I_META] + (size_t)(m - ROW_M) * DM) : H + (size_t)m * DM;
        f32x4 v[4], sv[8][4];
#pragma unroll
        for (int j = 0; j < 4; ++j) v[j] = ((const f32x4*)src + lane)[64 * j];
#pragma unroll
        for (int sl = 0; sl < 8; ++sl)
#pragma unroll
            for (int j = 0; j < 4; ++j) { sv[sl][j] = (f32x4){0.f, 0.f, 0.f, 0.f}; if (sl < nslab) sv[sl][j] = ((const f32x4*)(SLAB + (size_t)sl * (1280 * 1024) + (size_t)(m - ROW_S) * DM) + lane)[64 * j]; }
#pragma unroll
        for (int sl = 0; sl < 8; ++sl)
#pragma unroll
            for (int j = 0; j < 4; ++j) v[j] = v[j] + sv[sl][j];
        if (nslab > 0 || from_inputs) { f32x4* hr = (f32x4*)(H + (size_t)m * DM) + lane;
#pragma unroll
            for (int j = 0; j < 4; ++j) hr[64 * j] = v[j]; }
        norm_store(HN, m, lane, v);
    }
    const float* __restrict__ P = from_inputs ? a->in[I_XP] : (const float*)H;
    for (int m0 = 2 * gw; m0 < ROW_S; m0 += 2 * NGW) {
        f32x4 v[2][4];
#pragma unroll
        for (int q = 0; q < 2; ++q)
#pragma unroll
            for (int j = 0; j < 4; ++j) v[q][j] = ((const f32x4*)(P + (size_t)(m0 + q) * DM) + lane)[64 * j];
#pragma unroll
        for (int q = 0; q < 2; ++q) norm_store(HN, m0 + q, lane, v[q]);
    }
}
__device__ __forceinline__ void phase_final(ArgsP a, int wave, int lane) {
    const float* H = (const float*)(a->ws + WS_H); const float* fw = a->in[I_FNORM]; const float* SLAB = (const float*)(a->ws + WS_SLAB);
    const int gw = blockIdx.x * NWAVES + wave, NGW = gridDim.x * NWAVES;
    f32x4 w[4];
#pragma unroll
    for (int j = 0; j < 4; ++j) w[j] = ((const f32x4*)fw)[lane + 64 * j];
    for (int m = gw; m < ROW_M; m += NGW) {
        const f32x4* xr = (const f32x4*)(H + (size_t)m * DM) + lane;
        f32x4 v[4]; float s = 0.f;
#pragma unroll
        for (int j = 0; j < 4; ++j) v[j] = xr[64 * j];
        if (m >= ROW_S) {
            for (int sl = 0; sl < 8; ++sl) { const f32x4* sr = (const f32x4*)(SLAB + (size_t)sl * (1280 * 1024) + (size_t)(m - ROW_S) * DM) + lane;
#pragma unroll
                for (int j = 0; j < 4; ++j) v[j] = v[j] + sr[64 * j]; }
        }
#pragma unroll
        for (int j = 0; j < 4; ++j) s += (v[j].x * v[j].x + v[j].y * v[j].y) + (v[j].z * v[j].z + v[j].w * v[j].w);
        const float rs = rsqrtf(wave_sum(s) * (1.f / DM) + EPS);
        f32x4* o = (f32x4*)(a->out + O_YP + (size_t)m * DM) + lane;
#pragma unroll
        for (int j = 0; j < 4; ++j) o[64 * j] = v[j] * rs * w[j];
    }
}

__device__ __forceinline__ void unpack8(const u32x4 w, float (&f)[8]) { f[0] = bflo(w.x); f[1] = bfhi(w.x); f[2] = bflo(w.y); f[3] = bfhi(w.y); f[4] = bflo(w.z); f[5] = bfhi(w.z); f[6] = bflo(w.w); f[7] = bfhi(w.w); }
__device__ __forceinline__ void ld8f(const float* __restrict__ p, float (&f)[8]) { const f32x4 x0 = *(const f32x4*)p, x1 = *(const f32x4*)(p + 4); f[0]=x0.x;f[1]=x0.y;f[2]=x0.z;f[3]=x0.w;f[4]=x1.x;f[5]=x1.y;f[6]=x1.z;f[7]=x1.w; }
#define TSW(ch) ((((ch) >> 3) & 7) << 3)
struct ConvW { float w0[8], w1[8], w2[8], w3[8], bs[8]; };
__device__ __forceinline__ void conv_load_w(const float* __restrict__ cw, const float* __restrict__ cb, int c0, ConvW& W) { ld8f(cw + c0, W.w0); ld8f(cw + CONVD + c0, W.w1); ld8f(cw + 2 * CONVD + c0, W.w2); ld8f(cw + 3 * CONVD + c0, W.w3); ld8f(cb + c0, W.bs); }
__device__ __forceinline__ void conv_load_run(const bf16* __restrict__ ZX, int Rrow, int c0, int pk, bool valid, u32x4 (&raw)[11]) {
#pragma unroll
    for (int t = 0; t < 8; ++t) { raw[3 + t] = (u32x4){0u, 0u, 0u, 0u}; if (valid) raw[3 + t] = *(const u32x4*)(ZX + (size_t)(Rrow + t) * ZXW + 2048 + c0); }
#pragma unroll
    for (int t = 0; t < 3; ++t) { const int rr = (pk == 1) ? ROW_M + 13 + t : Rrow - 3 + t; raw[t] = (u32x4){0u, 0u, 0u, 0u}; if (valid && pk != 2) raw[t] = *(const u32x4*)(ZX + (size_t)rr * ZXW + 2048 + c0); }
}
template <int J> __device__ __forceinline__ void conv_channel(const u32x4 (&raw)[11], const ConvW& W, float (&o)[8]) {
    float x[11];
#pragma unroll
    for (int i = 0; i < 11; ++i) { const unsigned w = raw[i][J >> 1]; x[i] = (J & 1) ? bfhi(w) : bflo(w); }
#pragma unroll
    for (int t = 0; t < 8; ++t) { const float v = W.bs[J] + W.w0[J] * x[t] + W.w1[J] * x[t + 1] + W.w2[J] * x[t + 2] + W.w3[J] * x[t + 3]; o[t] = v * sigmoid_f(v); }
}
template <int J> __device__ __forceinline__ void conv_store_t(const u32x4 (&raw)[11], const ConvW& W, const float (&scale)[8], bf16* T, int ch0, int run) {
    float o[8]; conv_channel<J>(raw, W, o);
    u32x4 w; w.x = pkbf(o[0] * scale[0], o[1] * scale[1]); w.y = pkbf(o[2] * scale[2], o[3] * scale[3]); w.z = pkbf(o[4] * scale[4], o[5] * scale[5]); w.w = pkbf(o[6] * scale[6], o[7] * scale[7]);
    *(u32x4*)(T + (ch0 + J) * LDX + ((8 * run) ^ TSW(ch0 + J))) = w;
}
__device__ __forceinline__ void conv_item_t(const u32x4 (&raw)[11], const ConvW& W, const float (&scale)[8], bf16* T, int ch0, int run) {
    conv_store_t<0>(raw, W, scale, T, ch0, run); conv_store_t<1>(raw, W, scale, T, ch0, run); conv_store_t<2>(raw, W, scale, T, ch0, run); conv_store_t<3>(raw, W, scale, T, ch0, run);
    conv_store_t<4>(raw, W, scale, T, ch0, run); conv_store_t<5>(raw, W, scale, T, ch0, run); conv_store_t<6>(raw, W, scale, T, ch0, run); conv_store_t<7>(raw, W, scale, T, ch0, run);
}
__device__ __forceinline__ void conv_item_n(const u32x4 (&raw)[11], const ConvW& W, bf16* N, int run, int colel) {
    float p0[8], p1[8], p2[8]; unpack8(raw[0], p0); unpack8(raw[1], p1); unpack8(raw[2], p2);
#pragma unroll
    for (int t = 0; t < 8; ++t) { float x[8]; unpack8(raw[3 + t], x); float o[8];
#pragma unroll
        for (int j = 0; j < 8; ++j) { const float v = W.bs[j] + W.w0[j] * p0[j] + W.w1[j] * p1[j] + W.w2[j] * p2[j] + W.w3[j] * x[j]; o[j] = v * sigmoid_f(v); }
        u32x4 w; w.x = pkbf(o[0], o[1]); w.y = pkbf(o[2], o[3]); w.z = pkbf(o[4], o[5]); w.w = pkbf(o[6], o[7]);
        *(u32x4*)(N + (8 * run + t) * LDX + colel) = w;
#pragma unroll
        for (int j = 0; j < 8; ++j) { p0[j] = p1[j]; p1[j] = p2[j]; p2[j] = x[j]; } }
}
__device__ __forceinline__ void conv_state_out(const u32x4 (&raw)[11], float* __restrict__ dst  ) {
#pragma unroll
    for (int k = 0; k < 3; ++k) { float x[8]; unpack8(raw[8 + k], x); *(f32x4*)(dst + (size_t)k * CONVD) = (f32x4){x[0], x[1], x[2], x[3]}; *(f32x4*)(dst + (size_t)k * CONVD + 4) = (f32x4){x[4], x[5], x[6], x[7]}; }
}

__device__ __forceinline__ void ssd_acs(const float* DT, const float* alog, int R0, int len, int h0, float* s_dt, float* s_acs, int wave, int lane) {
    if (wave < 4) {
        const int r = wave; const float An = -__expf(alog[h0 + r]);
        const int l0 = 2 * lane;
        const float d0 = (l0 < len) ? DT[(size_t)(R0 + l0) * 32 + h0 + r] : 0.f;
        const float d1 = (l0 + 1 < len) ? DT[(size_t)(R0 + l0 + 1) * 32 + h0 + r] : 0.f;
        const float a0 = d0 * An, a1 = d1 * An, s = a0 + a1;
        float incl = s;
#pragma unroll
        for (int o = 1; o < 64; o <<= 1) { const float t = __shfl_up(incl, o); if (lane >= o) incl += t; }
        const float excl = incl - s;
        s_dt[r * 128 + l0] = d0; s_dt[r * 128 + l0 + 1] = d1;
        s_acs[r * 128 + l0] = excl + a0; s_acs[r * 128 + l0 + 1] = excl + s;
    }
}
#define LFRAG(base, row, ld, ks) (*(const bf16x8*)((base) + (row) * (ld) + 32 * (ks) + 8 * fq))

__device__ __forceinline__ void ssd1_unit(ArgsP a, int li, unsigned char* lds, int slot, int g, int R0, int len, int, int, int) {
    const int tid = ltid(), lane = tid & 63, wave = __builtin_amdgcn_readfirstlane(tid >> 6);
    const float* __restrict__ DT = (const float*)(a->ws + WS_DT);
    bf16* __restrict__ CS = (bf16*)(a->ws + WS_CS); float* __restrict__ CD = (float*)(a->ws + WS_CD);
    bf16* XsT = (bf16*)lds;
    bf16* BT = (bf16*)(lds + 256 * LDX * 2);
    float* s_dt = (float*)(lds + 384 * LDX * 2); float* s_acs = s_dt + 512;
    const int fr = lane & 15, fq = lane >> 4, h0 = g * 4;
    const float* __restrict__ cw = a->in[I_ACONVW] + (size_t)li * 4 * CONVD; const float* __restrict__ cbias = a->in[I_ACONVB] + (size_t)li * CONVD;
    const bf16* __restrict__ ZX = (const bf16*)(a->ws + WS_ZX);
    const bool meta = (slot == 128), chunk0 = (!meta && (slot & 63) == 0);
    const int xcb = tid & 31, xrun = tid >> 5, xc0 = g * 256 + xcb * 8;
    const int bcb = tid & 15, brun = (tid >> 4) & 15, bc0 = 2048 + g * 128 + bcb * 8;
    u32x4 rx[11], rb[11];
    conv_load_run(ZX, R0 + 8 * xrun, xc0, (xrun == 0) ? (meta ? 2 : (chunk0 ? 1 : 0)) : 0, 8 * xrun < len, rx);
    if (tid < 256) conv_load_run(ZX, R0 + 8 * brun, bc0, (brun == 0) ? (meta ? 2 : (chunk0 ? 1 : 0)) : 0, 8 * brun < len, rb);
    ssd_acs(DT, a->in[I_ALOG] + li * NHEADS, R0, len, h0, s_dt, s_acs, wave, lane);
    if (tid < 256) { ConvW W; conv_load_w(cw, cbias, bc0, W); const float one[8] = {1.f, 1.f, 1.f, 1.f, 1.f, 1.f, 1.f, 1.f}; conv_item_t(rb, W, one, BT, bcb * 8, brun); }
    __syncthreads();
    {   ConvW W; conv_load_w(cw, cbias, xc0, W);
        const int r = xcb >> 3; const float tot = s_acs[r * 128 + 127];
        const f32x4 a0 = *(const f32x4*)(s_acs + r * 128 + 8 * xrun), a1 = *(const f32x4*)(s_acs + r * 128 + 8 * xrun + 4), d0 = *(const f32x4*)(s_dt + r * 128 + 8 * xrun), d1 = *(const f32x4*)(s_dt + r * 128 + 8 * xrun + 4);
        float wl[8];
#pragma unroll
        for (int t = 0; t < 4; ++t) { wl[t] = __expf(tot - a0[t]) * d0[t]; wl[4 + t] = __expf(tot - a1[t]) * d1[t]; }
        conv_item_t(rx, W, wl, XsT, xcb * 8, xrun);
    }
    __syncthreads();
    f32x4 acc[2][8];
#pragma unroll
    for (int mi = 0; mi < 2; ++mi)
#pragma unroll
        for (int ni = 0; ni < 8; ++ni) acc[mi][ni] = (f32x4){0.f, 0.f, 0.f, 0.f};
#pragma unroll
    for (int ks = 0; ks < 4; ++ks) {
        const int ra0 = 32 * wave + fr, ra1 = ra0 + 16;
        const bf16x8 a0 = *(const bf16x8*)(XsT + ra0 * LDX + ((32 * ks + 8 * fq) ^ TSW(ra0))), a1 = *(const bf16x8*)(XsT + ra1 * LDX + ((32 * ks + 8 * fq) ^ TSW(ra1)));
#pragma unroll
        for (int ni = 0; ni < 8; ++ni) { const int rb = 16 * ni + fr; const bf16x8 bb = *(const bf16x8*)(BT + rb * LDX + ((32 * ks + 8 * fq) ^ TSW(rb)));
            acc[0][ni] = MFMA16(bb, a0, acc[0][ni]); acc[1][ni] = MFMA16(bb, a1, acc[1][ni]); }
    }
#pragma unroll
    for (int mi = 0; mi < 2; ++mi) { const int hp = 32 * wave + 16 * mi + fr, r = hp >> 6, p = hp & 63;
        bf16* dst = CS + ((size_t)(slot * 32 + h0 + r) * 64 + p) * 128 + 4 * fq;
#pragma unroll
        for (int ni = 0; ni < 8; ++ni) { u32x2 w; w.x = pkbf(acc[mi][ni][0], acc[mi][ni][1]); w.y = pkbf(acc[mi][ni][2], acc[mi][ni][3]); *(u32x2*)(dst + 16 * ni) = w; } }
    if (tid < 4) CD[slot * 32 + h0 + tid] = __expf(s_acs[tid * 128 + 127]);
    __syncthreads();
}

__device__ __forceinline__ void ssd_sample_issue(ArgsP a, int li, int b, int g, f32x4 (&st)[4][4]) {
    const int tid = ltid(), p = tid >> 3, nb = tid & 7;
    const float* __restrict__ sin_ = a->in[I_SSSM] + ((size_t)((li * NSAMP + b) * NHEADS + g * 4) * 64 + p) * 128 + 4 * nb;
#pragma unroll
    for (int r = 0; r < 4; ++r)
#pragma unroll
        for (int kk = 0; kk < 4; ++kk) st[r][kk] = *(const f32x4*)(sin_ + (size_t)r * 8192 + 32 * kk);
}
__device__ __forceinline__ void ssd_sample_unit(ArgsP a, int li, unsigned char* lds, int b, int g, f32x4 (&st)[4][4]) {
    const int tid = ltid(), lane = tid & 63, wave = __builtin_amdgcn_readfirstlane(tid >> 6);
    const bf16* __restrict__ ZX = (const bf16*)(a->ws + WS_ZX); const float* __restrict__ DT = (const float*)(a->ws + WS_DT); bf16* __restrict__ YN = (bf16*)(a->ws + WS_YN);
    float* sX = (float*)lds; float* sB = sX + 8 * 256; float* sC = sB + 8 * 128; float* sY = sC + 8 * 128; float* sDt = sY + 8 * 256;
    const int R0 = ROW_S + b * 8, h0 = g * 4;
    const int p = tid >> 3, nb = tid & 7;
    float* __restrict__ sout = a->out + O_SSSM + ((size_t)((li * NSAMP + b) * NHEADS + h0) * 64 + p) * 128 + 4 * nb;
    {
        const float* __restrict__ cw = a->in[I_ACONVW] + (size_t)li * 4 * CONVD; const float* __restrict__ cbias = a->in[I_ACONVB] + (size_t)li * CONVD;
        const int t = tid >> 6, ck = tid & 63;
        const int c0 = (ck < 32) ? g * 256 + ck * 8 : (ck < 48) ? 2048 + g * 128 + (ck - 32) * 8 : 3072 + g * 128 + (ck - 48) * 8;
        float* dst = (ck < 32) ? sX + t * 256 + ck * 8 : (ck < 48) ? sB + t * 128 + (ck - 32) * 8 : sC + t * 128 + (ck - 48) * 8;
        const float* __restrict__ sc = a->in[I_SCONV] + ((size_t)(li * NSAMP + b) * 3) * CONVD + c0;
        float xr[4][8];
#pragma unroll
        for (int k = 0; k < 4; ++k) { const int tt = t - 3 + k;
            if (tt >= 0) unpack8(*(const u32x4*)(ZX + (size_t)(R0 + tt) * ZXW + 2048 + c0), xr[k]); else ld8f(sc + (size_t)(tt + 3) * CONVD, xr[k]); }
        ConvW W; conv_load_w(cw, cbias, c0, W);
        float o[8];
#pragma unroll
        for (int j = 0; j < 8; ++j) { const float v = W.bs[j] + W.w0[j] * xr[0][j] + W.w1[j] * xr[1][j] + W.w2[j] * xr[2][j] + W.w3[j] * xr[3][j]; o[j] = v * sigmoid_f(v); }
        *(f32x4*)dst = (f32x4){o[0], o[1], o[2], o[3]}; *(f32x4*)(dst + 4) = (f32x4){o[4], o[5], o[6], o[7]};
        if (t >= 5) { float* __restrict__ so = a->out + O_SCONV + ((size_t)(li * NSAMP + b) * 3 + (t - 5)) * CONVD + c0;
            *(f32x4*)so = (f32x4){xr[3][0], xr[3][1], xr[3][2], xr[3][3]}; *(f32x4*)(so + 4) = (f32x4){xr[3][4], xr[3][5], xr[3][6], xr[3][7]}; }
    }
    if (tid < 32) sDt[tid] = DT[(size_t)(R0 + (tid >> 2)) * 32 + h0 + (tid & 3)];
    __syncthreads();
    float An[4], Dk[4];
#pragma unroll
    for (int r = 0; r < 4; ++r) { An[r] = -__expf(a->in[I_ALOG][li * NHEADS + h0 + r]); Dk[r] = a->in[I_ADSKIP][li * NHEADS + h0 + r]; }
    float part[8][4];
#pragma unroll
    for (int t = 0; t < 8; ++t) {
        f32x4 bv[4], cv[4];
#pragma unroll
        for (int kk = 0; kk < 4; ++kk) { bv[kk] = *(const f32x4*)(sB + t * 128 + 32 * kk + 4 * nb); cv[kk] = *(const f32x4*)(sC + t * 128 + 32 * kk + 4 * nb); }
#pragma unroll
        for (int r = 0; r < 4; ++r) {
            const float dt = sDt[t * 4 + r], dA = __expf(dt * An[r]), xv = sX[t * 256 + r * 64 + p], coef = dt * xv;
            float pr = 0.f;
#pragma unroll
            for (int kk = 0; kk < 4; ++kk) { st[r][kk] = st[r][kk] * dA + bv[kk] * coef; pr += (cv[kk].x * st[r][kk].x + cv[kk].y * st[r][kk].y) + (cv[kk].z * st[r][kk].z + cv[kk].w * st[r][kk].w); }
            part[t][r] = pr;
        }
    }
#pragma unroll
    for (int r = 0; r < 4; ++r)
#pragma unroll
        for (int kk = 0; kk < 4; ++kk) *(f32x4*)(sout + (size_t)r * 8192 + 32 * kk) = st[r][kk];
#pragma unroll
    for (int t = 0; t < 8; ++t)
#pragma unroll
        for (int r = 0; r < 4; ++r) { float v = part[t][r]; v += __shfl_xor(v, 1); v += __shfl_xor(v, 2); v += __shfl_xor(v, 4); part[t][r] = v; }
    if (nb == 0) {
#pragma unroll
        for (int t = 0; t < 8; ++t)
#pragma unroll
            for (int r = 0; r < 4; ++r) sY[t * 256 + r * 64 + p] = part[t][r] + Dk[r] * sX[t * 256 + r * 64 + p];
    }
    __syncthreads();
    {
        const int t = wave, c4 = lane * 4; const size_t row = (size_t)(R0 + t);
        const f32x4 y = *(const f32x4*)(sY + t * 256 + c4);
        const u32x2 zz = *(const u32x2*)(ZX + row * ZXW + g * 256 + c4);
        const float z0 = bflo(zz.x), z1 = bfhi(zz.x), z2 = bflo(zz.y), z3 = bfhi(zz.y);
        const float g0 = y.x * z0 * sigmoid_f(z0), g1 = y.y * z1 * sigmoid_f(z1), g2 = y.z * z2 * sigmoid_f(z2), g3 = y.w * z3 * sigmoid_f(z3);
        const float ss = wave_sum((g0 * g0 + g1 * g1) + (g2 * g2 + g3 * g3));
        const float rs = rsqrtf(ss * (1.f / 256.f) + EPS);
        u32x2 o; o.x = pkbf(g0 * rs, g1 * rs); o.y = pkbf(g2 * rs, g3 * rs);
        *(u32x2*)(YN + row * DINNER + g * 256 + c4) = o;
    }
    __syncthreads();
}

__device__ __forceinline__ void phase_scan(ArgsP a, int li) {
    const bf16* __restrict__ CS = (const bf16*)(a->ws + WS_CS); const float* __restrict__ CD = (const float*)(a->ws + WS_CD); bf16* __restrict__ HSB = (bf16*)(a->ws + WS_HSB);
    const int gt = blockIdx.x * NTHREADS + ltid(), NT = gridDim.x * NTHREADS;
    for (int e = gt; e < 2 * 65536; e += NT) {
        const int b = e >> 16, rem = e & 65535, h = rem >> 11, pn4 = rem & 2047;
        f32x4 hc; { const u32x2 w0 = *(const u32x2*)(CS + ((size_t)(128 * 32 + h) * 2048 + pn4) * 4); hc = (f32x4){bflo(w0.x), bfhi(w0.x), bflo(w0.y), bfhi(w0.y)}; }
#pragma unroll 8
        for (int c = 0; c < 64; ++c) { const int slot = b * 64 + c; const size_t o = ((size_t)(slot * 32 + h) * 2048 + pn4) * 4;
            const u32x2 sw = *(const u32x2*)(CS + o); const f32x4 s = (f32x4){bflo(sw.x), bfhi(sw.x), bflo(sw.y), bfhi(sw.y)}; const float d = CD[slot * 32 + h];
            u32x2 w; w.x = pkbf(hc.x, hc.y); w.y = pkbf(hc.z, hc.w); *(u32x2*)(HSB + o) = w;
            hc = hc * d + s; }
        *(f32x4*)(a->out + O_PSSM + ((size_t)((li * NPROMPT + b) * NHEADS + h) * 2048 + pn4) * 4) = hc;
    }
}

__device__ __forceinline__ void ssd3_head(int r, int hb, const bf16* Cn, const bf16* BH, const bf16* Xt, const float* s_dt, const float* s_acs, const f32x4 (&cb)[8], f32x4 (&acc)[4],
                                          const bf16* __restrict__ ZX, size_t row, int g, float Dk, int l, int wave, int fr, int fq, float& ss) {
    u32x2 zz[4];
#pragma unroll
    for (int ni = 0; ni < 4; ++ni) { const int ch = g * 256 + r * 64 + 16 * ni + 4 * fq; zz[ni] = *(const u32x2*)(ZX + row * ZXW + ch); }
    const float al = s_acs[r * 128 + l];
#pragma unroll
    for (int ni = 0; ni < 4; ++ni) acc[ni] = (f32x4){0.f, 0.f, 0.f, 0.f};
    const bf16* Hs = BH + hb * 64 * LDX;
#pragma unroll
    for (int ks = 0; ks < 4; ++ks) { const bf16x8 af = LFRAG(Cn, l, LDX, ks);
#pragma unroll
        for (int ni = 0; ni < 4; ++ni) { const bf16x8 bb = LFRAG(Hs, 16 * ni + fr, LDX, ks); acc[ni] = MFMA16(bb, af, acc[ni]); } }
    const float e = __expf(al);
#pragma unroll
    for (int ni = 0; ni < 4; ++ni) acc[ni] = acc[ni] * e;
#pragma unroll
    for (int ks = 0; ks < 4; ++ks) if (2 * ks <= wave) {
        unsigned mw[4];
#pragma unroll
        for (int hf = 0; hf < 2; ++hf) { const int ni = 2 * ks + hf, s0 = 16 * ni + 4 * fq;
            const f32x4 av = *(const f32x4*)(s_acs + r * 128 + s0), dv = *(const f32x4*)(s_dt + r * 128 + s0);
            float m[4];
#pragma unroll
            for (int j = 0; j < 4; ++j) m[j] = (s0 + j <= l) ? cb[ni][j] * __expf(al - av[j]) * dv[j] : 0.f;
            mw[2 * hf] = pkbf(m[0], m[1]); mw[2 * hf + 1] = pkbf(m[2], m[3]); }
        const u32x4 afu = (u32x4){mw[0], mw[1], mw[2], mw[3]};
        const bf16x8 af = __builtin_bit_cast(bf16x8, afu);
#pragma unroll
        for (int ni = 0; ni < 4; ++ni) { const int chl = r * 64 + 16 * ni + fr, sw = TSW(chl);
            const u32x2 b0 = *(const u32x2*)(Xt + chl * LDX + ((32 * ks + 4 * fq) ^ sw)), b1 = *(const u32x2*)(Xt + chl * LDX + ((32 * ks + 16 + 4 * fq) ^ sw));
            const u32x4 bu = (u32x4){b0.x, b0.y, b1.x, b1.y};
            acc[ni] = MFMA16(__builtin_bit_cast(bf16x8, bu), af, acc[ni]); }
    }
#pragma unroll
    for (int ni = 0; ni < 4; ++ni) {
        float xv[4];
#pragma unroll
        for (int j = 0; j < 4; ++j) { const int chl = r * 64 + 16 * ni + 4 * fq + j; xv[j] = bf2f(Xt[chl * LDX + (l ^ TSW(chl))]); }
        const float zv[4] = {bflo(zz[ni].x), bfhi(zz[ni].x), bflo(zz[ni].y), bfhi(zz[ni].y)};
#pragma unroll
        for (int j = 0; j < 4; ++j) { const float q = (acc[ni][j] + Dk * xv[j]) * zv[j] * sigmoid_f(zv[j]); acc[ni][j] = q; ss += q * q; } }
}
__device__ __forceinline__ void ssd3_unit(ArgsP a, int li, unsigned char* lds, const bf16* __restrict__ hs, int slot, int g, int R0, int len, int, int, int) {
    const int tid = ltid(), lane = tid & 63, wave = __builtin_amdgcn_readfirstlane(tid >> 6);
    const bf16* __restrict__ ZX = (const bf16*)(a->ws + WS_ZX); const float* __restrict__ DT = (const float*)(a->ws + WS_DT); bf16* __restrict__ YN = (bf16*)(a->ws + WS_YN);
    bf16* Cn = (bf16*)lds; bf16* BH = Cn + 128 * LDX; bf16* Xt = BH + 128 * LDX;
    float* s_dt = (float*)(Xt + 256 * LDX); float* s_acs = s_dt + 512;
    const int fr = lane & 15, fq = lane >> 4, h0 = g * 4;
    {
        const float* __restrict__ cw = a->in[I_ACONVW] + (size_t)li * 4 * CONVD; const float* __restrict__ cbias = a->in[I_ACONVB] + (size_t)li * CONVD;
        const bool meta = (slot == 128), chunk0 = (!meta && (slot & 63) == 0);
        const int half = tid >> 8, ncb = tid & 15, nrun = (tid >> 4) & 15, nc0 = (half ? 2048 : 3072) + g * 128 + ncb * 8;
        const int xcb = tid & 31, xrun = tid >> 5, xc0 = g * 256 + xcb * 8;
        u32x4 rn[11], rx[11];
        conv_load_run(ZX, R0 + 8 * nrun, nc0, (nrun == 0) ? (meta ? 2 : (chunk0 ? 1 : 0)) : 0, 8 * nrun < len, rn);
        conv_load_run(ZX, R0 + 8 * xrun, xc0, (xrun == 0) ? (meta ? 2 : (chunk0 ? 1 : 0)) : 0, 8 * xrun < len, rx);
        ssd_acs(DT, a->in[I_ALOG] + li * NHEADS, R0, len, h0, s_dt, s_acs, wave, lane);
        { ConvW W; conv_load_w(cw, cbias, nc0, W); conv_item_n(rn, W, half ? BH : Cn, nrun, ncb * 8); }
        { ConvW W; conv_load_w(cw, cbias, xc0, W); const float one[8] = {1.f, 1.f, 1.f, 1.f, 1.f, 1.f, 1.f, 1.f}; conv_item_t(rx, W, one, Xt, xcb * 8, xrun); }
        if (!meta && (slot & 63) == 63) {
            float* __restrict__ dst = a->out + O_PCONV + (size_t)((li * NPROMPT + (slot >> 6)) * 3) * CONVD;
            if (nrun == 15) conv_state_out(rn, dst + nc0);
            if (xrun == 15) conv_state_out(rx, dst + xc0);
        }
    }
    __syncthreads();
    u32x2 hv[8];
#pragma unroll
    for (int k = 0; k < 8; ++k) { const int item = tid + NTHREADS * k; hv[k] = (u32x2){0u, 0u}; if (hs) hv[k] = *(const u32x2*)(hs + (size_t)item * 4); }
    const bool active = (16 * wave < len);
    f32x4 cb[8];
#pragma unroll
    for (int ni = 0; ni < 8; ++ni) cb[ni] = (f32x4){0.f, 0.f, 0.f, 0.f};
    if (active) {
#pragma unroll
    for (int ks = 0; ks < 4; ++ks) { const bf16x8 af = LFRAG(Cn, 16 * wave + fr, LDX, ks);
#pragma unroll
        for (int ni = 0; ni < 8; ++ni) { const bf16x8 bb = LFRAG(BH, 16 * ni + fr, LDX, ks); cb[ni] = MFMA16(bb, af, cb[ni]); } }
    }
    __syncthreads();
#pragma unroll
    for (int k = 0; k < 8; ++k) { const int item = tid + NTHREADS * k, hp = item >> 5, n4 = item & 31; *(u32x2*)(BH + hp * LDX + n4 * 4) = hv[k]; }
#pragma unroll
    for (int k = 0; k < 8; ++k) { const int item = tid + NTHREADS * k; hv[k] = (u32x2){0u, 0u}; if (hs) hv[k] = *(const u32x2*)(hs + (size_t)(2 * 8192) + (size_t)item * 4); }
    __syncthreads();
    const int l = 16 * wave + fr;
    const size_t row = (size_t)(R0 + ((l < len) ? l : 0));
    f32x4 y0[4], y1[4], y2[4], y3[4];
    float ss = 0.f;
    const float* dsk = a->in[I_ADSKIP] + li * NHEADS + h0;
    if (active) {
    ssd3_head(0, 0, Cn, BH, Xt, s_dt, s_acs, cb, y0, ZX, row, g, dsk[0], l, wave, fr, fq, ss);
    asm volatile("" ::: "memory");
    ssd3_head(1, 1, Cn, BH, Xt, s_dt, s_acs, cb, y1, ZX, row, g, dsk[1], l, wave, fr, fq, ss);
    }
    __syncthreads();
#pragma unroll
    for (int k = 0; k < 8; ++k) { const int item = tid + NTHREADS * k, hp = item >> 5, n4 = item & 31; *(u32x2*)(BH + hp * LDX + n4 * 4) = hv[k]; }
    __syncthreads();
    if (active) {
    ssd3_head(2, 0, Cn, BH, Xt, s_dt, s_acs, cb, y2, ZX, row, g, dsk[2], l, wave, fr, fq, ss);
    asm volatile("" ::: "memory");
    ssd3_head(3, 1, Cn, BH, Xt, s_dt, s_acs, cb, y3, ZX, row, g, dsk[3], l, wave, fr, fq, ss);
    ss += __shfl_xor(ss, 16); ss += __shfl_xor(ss, 32);
    }
    const float rs = rsqrtf(ss * (1.f / 256.f) + EPS);
    if (active && l < len) {
        bf16* yrow = YN + row * DINNER + g * 256 + 4 * fq;
#pragma unroll
        for (int ni = 0; ni < 4; ++ni) {
            u32x2 w;
            w.x = pkbf(y0[ni][0] * rs, y0[ni][1] * rs); w.y = pkbf(y0[ni][2] * rs, y0[ni][3] * rs); *(u32x2*)(yrow + 0 * 64 + 16 * ni) = w;
            w.x = pkbf(y1[ni][0] * rs, y1[ni][1] * rs); w.y = pkbf(y1[ni][2] * rs, y1[ni][3] * rs); *(u32x2*)(yrow + 1 * 64 + 16 * ni) = w;
            w.x = pkbf(y2[ni][0] * rs, y2[ni][1] * rs); w.y = pkbf(y2[ni][2] * rs, y2[ni][3] * rs); *(u32x2*)(yrow + 2 * 64 + 16 * ni) = w;
            w.x = pkbf(y3[ni][0] * rs, y3[ni][1] * rs); w.y = pkbf(y3[ni][2] * rs, y3[ni][3] * rs); *(u32x2*)(yrow + 3 * 64 + 16 * ni) = w;
        }
    }
    __syncthreads();
}
__device__ __forceinline__ void phase_ssd1(ArgsP a, int li, unsigned char* lds, int tid, int wave, int lane) {
    const int c = blockIdx.x;
#pragma unroll 1
    for (int j = 0; j < 4; ++j) {
        const int u = c + 256 * j;
        f32x4 st[4][4];
        ssd_sample_issue(a, li, u >> 3, u & 7, st);
#ifndef PROBE_SSD1
#define PROBE_SSD1 0
#endif
#pragma unroll 1
        for (int rp = 0; rp < (PROBE_SSD1 == 1 ? 2 : 1); ++rp) { const int slot = u >> 3, g = u & 7; ssd1_unit(a, li, lds, slot, g, (slot >> 6) * SEQ + (slot & 63) * 128, 128, tid, wave, lane); }
        ssd_sample_unit(a, li, lds, u >> 3, u & 7, st);
    }
    if (c < 8) ssd1_unit(a, li, lds, 128, c, ROW_M, NMETA, tid, wave, lane);
    else if (c < 16) ssd3_unit(a, li, lds, nullptr, 128, c - 8, ROW_M, NMETA, tid, wave, lane);
}
__device__ __forceinline__ void phase_ssd3(ArgsP a, int li, unsigned char* lds, int tid, int wave, int lane) {
    const bf16* HSB = (const bf16*)(a->ws + WS_HSB);
#pragma unroll 1
    for (int u = blockIdx.x; u < 1024; u += gridDim.x) { const int slot = u >> 3, g = u & 7; ssd3_unit(a, li, lds, HSB + (size_t)(slot * 32 + g * 4) * 8192, slot, g, (slot >> 6) * SEQ + (slot & 63) * 128, 128, tid, wave, lane); }
}

constexpr int KS_LD = 72, VT_LD = 264, P_LD = 232, NKEYS = 208;
__device__ __forceinline__ void attn_prompt_unit(ArgsP a, int lj, unsigned char* lds, int b, int kvh, int qb, int, int, int) {
    const int tid = ltid(), lane = tid & 63, wave = __builtin_amdgcn_readfirstlane(tid >> 6);
    const bf16* __restrict__ Q = (const bf16*)(a->ws + WS_Q); const bf16* __restrict__ KV = (const bf16*)(a->ws + WS_KV); bf16* __restrict__ AO = (bf16*)(a->ws + WS_AO);
    bf16* Ks = (bf16*)lds; bf16* Vt = Ks + NKEYS * KS_LD; bf16* Pw = Vt + 64 * VT_LD + wave * 16 * P_LD;
    const int fr = lane & 15, fq = lane >> 4, t0 = qb * 64, Rb = b * SEQ;
    const int r = wave >> 1, th = (wave & 1) * 32, qh = kvh * 4 + r;
    bf16x8 q0[2], q1[2];
#pragma unroll
    for (int ks = 0; ks < 2; ++ks) { q0[ks] = *(const bf16x8*)(Q + (size_t)(Rb + t0 + th + fr) * DM + qh * 64 + 32 * ks + 8 * fq); q1[ks] = *(const bf16x8*)(Q + (size_t)(Rb + t0 + th + 16 + fr) * DM + qh * 64 + 32 * ks + 8 * fq); }
    {
        u32x4 kv[4];
#pragma unroll
        for (int k = 0; k < 4; ++k) { const int it = tid + NTHREADS * k, key = it >> 3, ch = it & 7; kv[k] = (u32x4){0u, 0u, 0u, 0u};
            if (it < NKEYS * 8) { int row; if (key < 16) row = ROW_M + key; else { int s = t0 - 128 + key - 16; if (s < 0) s = 0; row = Rb + s; }
                kv[k] = *(const u32x4*)(KV + (size_t)row * KVW + kvh * 64 + ch * 8); } }
        u32x4 v0[2], v1[2];
#pragma unroll
        for (int k = 0; k < 2; ++k) { const int it = tid + NTHREADS * k, dbl = it & 7, kp = it >> 3; v0[k] = (u32x4){0u, 0u, 0u, 0u}; v1[k] = v0[k];
            if (it < (NKEYS / 2) * 8) { const int k0 = 2 * kp, k1 = k0 + 1; int s0 = t0 - 128 + k0 - 16, s1 = t0 - 128 + k1 - 16; if (s0 < 0) s0 = 0; if (s1 < 0) s1 = 0;
                const int r0 = (k0 < 16) ? ROW_M + k0 : Rb + s0, r1 = (k1 < 16) ? ROW_M + k1 : Rb + s1;
                v0[k] = *(const u32x4*)(KV + (size_t)r0 * KVW + 256 + kvh * 64 + dbl * 8); v1[k] = *(const u32x4*)(KV + (size_t)r1 * KVW + 256 + kvh * 64 + dbl * 8); } }
#pragma unroll
        for (int k = 0; k < 4; ++k) { const int it = tid + NTHREADS * k, key = it >> 3, ch = it & 7; if (it < NKEYS * 8) *(u32x4*)(Ks + key * KS_LD + ch * 8) = kv[k]; }
#pragma unroll
        for (int k = 0; k < 2; ++k) { const int it = tid + NTHREADS * k, dbl = it & 7, kp = it >> 3;
            if (it < (NKEYS / 2) * 8) { const int col = (2 * kp) ^ (8 * dbl);
                const unsigned a0[4] = {v0[k].x, v0[k].y, v0[k].z, v0[k].w}, a1[4] = {v1[k].x, v1[k].y, v1[k].z, v1[k].w};
#pragma unroll
                for (int j = 0; j < 4; ++j) {
                    *(unsigned*)(Vt + (dbl * 8 + 2 * j) * VT_LD + col) = (a0[j] & 0xffffu) | (a1[j] << 16);
                    *(unsigned*)(Vt + (dbl * 8 + 2 * j + 1) * VT_LD + col) = (a0[j] >> 16) | (a1[j] & 0xffff0000u); } } }
#pragma unroll
        for (int k = 0; k < 3; ++k) { const int idx = tid + NTHREADS * k, row = idx / 24, c = idx - row * 24; *(unsigned*)(Vt + row * VT_LD + ((NKEYS + 2 * c) ^ TSW(row))) = 0u; }
    }
    __syncthreads();
    const float sink = a->in[I_SINKS][lj * NQ + qh];
#pragma unroll 1
    for (int blk = 0; blk < 2; ++blk) {
        const int tq = th + blk * 16 + fr, t = t0 + tq;
        bf16x8 qa2[2];
#pragma unroll
        for (int ks = 0; ks < 2; ++ks) qa2[ks] = (blk == 0) ? q0[ks] : q1[ks];
        f32x4 sc[13];
#pragma unroll
        for (int ni = 0; ni < 13; ++ni) sc[ni] = (f32x4){0.f, 0.f, 0.f, 0.f};
#pragma unroll
        for (int ni = 0; ni < 13; ++ni) {
            const bf16x8 b0 = *(const bf16x8*)(Ks + (16 * ni + fr) * KS_LD + 8 * fq), b1 = *(const bf16x8*)(Ks + (16 * ni + fr) * KS_LD + 32 + 8 * fq);
            sc[ni] = MFMA16(b0, qa2[0], sc[ni]); sc[ni] = MFMA16(b1, qa2[1], sc[ni]);
            if ((ni & 3) == 3) asm volatile("" ::: "memory"); }
        int lo = tq + 17; { const int l2 = 144 - t0; if (l2 > lo) lo = l2; }
        const unsigned span = (unsigned)(tq + 144 - lo);
        float mx = -INFINITY;
#pragma unroll
        for (int ni = 0; ni < 13; ++ni)
#pragma unroll
            for (int j = 0; j < 4; ++j) { const int key = 16 * ni + 4 * fq + j; const bool vis = (ni == 0) || ((unsigned)(key - lo) <= span);
                const float v = vis ? sc[ni][j] * 0.125f : -INFINITY; sc[ni][j] = v; mx = fmaxf(mx, v); }
        mx = fmaxf(mx, __shfl_xor(mx, 16)); mx = fmaxf(mx, __shfl_xor(mx, 32)); mx = fmaxf(mx, sink);
        float sum = 0.f;
#pragma unroll
        for (int ni = 0; ni < 13; ++ni)
#pragma unroll
            for (int j = 0; j < 4; ++j) { const float p = __expf(sc[ni][j] - mx); sc[ni][j] = p; sum += p; }
        sum += __shfl_xor(sum, 16); sum += __shfl_xor(sum, 32); sum += __expf(sink - mx);
        const float inv = frcp(sum);
#pragma unroll
        for (int ni = 0; ni < 13; ++ni) { u32x2 w; w.x = pkbf(sc[ni][0] * inv, sc[ni][1] * inv); w.y = pkbf(sc[ni][2] * inv, sc[ni][3] * inv); *(u32x2*)(Pw + fr * P_LD + 16 * ni + 4 * fq) = w; }
        *(u32x2*)(Pw + fr * P_LD + NKEYS + 4 * fq) = (u32x2){0u, 0u};
        asm volatile("s_waitcnt lgkmcnt(0)" ::: "memory");
        f32x4 o[4];
#pragma unroll
        for (int ni = 0; ni < 4; ++ni) o[ni] = (f32x4){0.f, 0.f, 0.f, 0.f};
#pragma unroll
        for (int ks = 0; ks < 7; ++ks) { const bf16x8 af = *(const bf16x8*)(Pw + fr * P_LD + 32 * ks + 8 * fq);
#pragma unroll
            for (int ni = 0; ni < 4; ++ni) { const int vr = 16 * ni + fr; const bf16x8 bb = *(const bf16x8*)(Vt + vr * VT_LD + ((32 * ks + 8 * fq) ^ TSW(vr))); o[ni] = MFMA16(bb, af, o[ni]); }
            if (ks & 1) asm volatile("" ::: "memory"); }
#pragma unroll
        for (int ni = 0; ni < 4; ++ni) { u32x2 w; w.x = pkbf(o[ni][0], o[ni][1]); w.y = pkbf(o[ni][2], o[ni][3]); *(u32x2*)(AO + (size_t)(Rb + t) * DM + qh * 64 + 16 * ni + 4 * fq) = w; }
        asm volatile("s_waitcnt lgkmcnt(0)" ::: "memory");
    }
    __syncthreads();
}
constexpr int SK_LD = 72, SV_LD = 200, SP_LD = 168, SKEYS = 160;
__device__ __forceinline__ void attn_sample_pair(ArgsP a, int lj, unsigned char* lds, int bp, int kvh, int, int, int) {
    const int tid = ltid(), lane = tid & 63, wave = __builtin_amdgcn_readfirstlane(tid >> 6);
    const bf16* __restrict__ Q = (const bf16*)(a->ws + WS_Q); const bf16* __restrict__ KV = (const bf16*)(a->ws + WS_KV); bf16* __restrict__ AO = (bf16*)(a->ws + WS_AO);
    const float* __restrict__ CK = a->in[I_CK]; const float* __restrict__ CV = a->in[I_CV];
    constexpr int HALF_B = (SKEYS * SK_LD + 64 * SV_LD) * 2;
    const int fr = lane & 15, fq = lane >> 4;
#pragma unroll 1
    for (int it = tid; it < 2 * SKEYS * 8; it += NTHREADS) { const int hf = it / (SKEYS * 8), rem = it - hf * (SKEYS * 8), key = rem >> 3, ch = rem & 7, bb = 2 * bp + hf;
        bf16* Ks = (bf16*)(lds + hf * HALF_B);
        u32x4 w = (u32x4){0u, 0u, 0u, 0u};
        if (key < 16) w = *(const u32x4*)(KV + (size_t)(ROW_M + key) * KVW + kvh * 64 + ch * 8);
        else if (key < 144) { const float* p = CK + ((size_t)(bb * 128 + (key - 16)) * NKV + kvh) * 64 + ch * 8; const f32x4 x0 = *(const f32x4*)p, x1 = *(const f32x4*)(p + 4);
            w.x = pkbf(x0.x, x0.y); w.y = pkbf(x0.z, x0.w); w.z = pkbf(x1.x, x1.y); w.w = pkbf(x1.z, x1.w); }
        else if (key < 152) w = *(const u32x4*)(KV + (size_t)(ROW_S + bb * 8 + (key - 144)) * KVW + kvh * 64 + ch * 8);
        *(u32x4*)(Ks + key * SK_LD + ch * 8) = w; }
#pragma unroll 1
    for (int it = tid; it < 2 * 96 * 8; it += NTHREADS) { const int hf = it / (96 * 8), rem = it - hf * (96 * 8), dbl = rem & 7, kp = rem >> 3, bb = 2 * bp + hf;
        bf16* Vt = (bf16*)(lds + hf * HALF_B) + SKEYS * SK_LD;
        unsigned a0[4] = {0u, 0u, 0u, 0u}, a1[4] = {0u, 0u, 0u, 0u};
        const int k0 = 2 * kp;
        if (k0 < 16) { const u32x4 x = *(const u32x4*)(KV + (size_t)(ROW_M + k0) * KVW + 256 + kvh * 64 + dbl * 8), y = *(const u32x4*)(KV + (size_t)(ROW_M + k0 + 1) * KVW + 256 + kvh * 64 + dbl * 8);
            a0[0] = x.x; a0[1] = x.y; a0[2] = x.z; a0[3] = x.w; a1[0] = y.x; a1[1] = y.y; a1[2] = y.z; a1[3] = y.w; }
        else if (k0 < 144) { const float* p = CV + ((size_t)(bb * 128 + (k0 - 16)) * NKV + kvh) * 64 + dbl * 8; const f32x4 x0 = *(const f32x4*)p, x1 = *(const f32x4*)(p + 4), y0 = *(const f32x4*)(p + NKV * 64), y1 = *(const f32x4*)(p + NKV * 64 + 4);
            a0[0] = pkbf(x0.x, x0.y); a0[1] = pkbf(x0.z, x0.w); a0[2] = pkbf(x1.x, x1.y); a0[3] = pkbf(x1.z, x1.w); a1[0] = pkbf(y0.x, y0.y); a1[1] = pkbf(y0.z, y0.w); a1[2] = pkbf(y1.x, y1.y); a1[3] = pkbf(y1.z, y1.w); }
        else if (k0 < 152) { const u32x4 x = *(const u32x4*)(KV + (size_t)(ROW_S + bb * 8 + (k0 - 144)) * KVW + 256 + kvh * 64 + dbl * 8), y = *(const u32x4*)(KV + (size_t)(ROW_S + bb * 8 + (k0 - 143)) * KVW + 256 + kvh * 64 + dbl * 8);
            a0[0] = x.x; a0[1] = x.y; a0[2] = x.z; a0[3] = x.w; a1[0] = y.x; a1[1] = y.y; a1[2] = y.z; a1[3] = y.w; }
        const int col = (2 * kp) ^ (8 * dbl);
#pragma unroll
        for (int j = 0; j < 4; ++j) {
            *(unsigned*)(Vt + (dbl * 8 + 2 * j) * SV_LD + col) = (a0[j] & 0xffffu) | (a1[j] << 16);
            *(unsigned*)(Vt + (dbl * 8 + 2 * j + 1) * SV_LD + col) = (a0[j] >> 16) | (a1[j] & 0xffff0000u); } }
    if (lj == 0) {
#pragma unroll 1
        for (int it = tid; it < 2 * 128 * 16; it += NTHREADS) { const int hf = it >> 11, rem = it & 2047, w = rem >> 4, c4 = (rem & 15) * 4, bb = 2 * bp + hf;
            const size_t o = ((size_t)(bb * 128 + w) * NKV + kvh) * 64 + c4;
            f32x4 kx, vx;
            if (w < 120) { const size_t i = ((size_t)(bb * 128 + w + 8) * NKV + kvh) * 64 + c4; kx = *(const f32x4*)(CK + i); vx = *(const f32x4*)(CV + i); }
            else { const bf16* rp = KV + (size_t)(ROW_S + bb * 8 + (w - 120)) * KVW + kvh * 64 + c4; const u32x2 k2 = *(const u32x2*)rp, v2 = *(const u32x2*)(rp + 256);
                kx = (f32x4){bflo(k2.x), bfhi(k2.x), bflo(k2.y), bfhi(k2.y)}; vx = (f32x4){bflo(v2.x), bfhi(v2.x), bflo(v2.y), bfhi(v2.y)}; }
            *(f32x4*)(a->out + O_SCK + o) = kx; *(f32x4*)(a->out + O_SCV + o) = vx; }
    }
    __syncthreads();
    if (wave < 4) {
        const int hf = wave >> 1, rb = wave & 1, bb = 2 * bp + hf;
        const bf16* Ks = (const bf16*)(lds + hf * HALF_B); const bf16* Vt = Ks + SKEYS * SK_LD; bf16* Pw = (bf16*)(lds + 2 * HALF_B) + wave * 16 * SP_LD;
        const int r = 2 * rb + (fr >> 3), t = fr & 7, qh = kvh * 4 + r;
        const size_t qrow = (size_t)(ROW_S + bb * 8 + t);
        bf16x8 qa[2];
        if (lj == 0) {
#pragma unroll
            for (int ks = 0; ks < 2; ++ks) qa[ks] = *(const bf16x8*)(Q + qrow * DM + qh * 64 + 32 * ks + 8 * fq);
        } else {
            const float* __restrict__ SL = (const float*)(a->ws + WS_SLAB) + (size_t)(qrow - ROW_S) * DM + qh * 64 + 8 * fq;
#pragma unroll
            for (int ks = 0; ks < 2; ++ks) { f32x4 x0 = (f32x4){0.f, 0.f, 0.f, 0.f}, x1 = x0;
#pragma unroll
                for (int sl = 0; sl < 4; ++sl) { const float* p = SL + (size_t)sl * (1280 * 1024) + 32 * ks; x0 = x0 + *(const f32x4*)p; x1 = x1 + *(const f32x4*)(p + 4); }
                const u32x4 w = (u32x4){pkbf(x0.x, x0.y), pkbf(x0.z, x0.w), pkbf(x1.x, x1.y), pkbf(x1.z, x1.w)}; qa[ks] = __builtin_bit_cast(bf16x8, w); }
        }
        const float sink = a->in[I_SINKS][lj * NQ + qh];
        f32x4 sc[10];
#pragma unroll
        for (int ni = 0; ni < 10; ++ni) sc[ni] = (f32x4){0.f, 0.f, 0.f, 0.f};
#pragma unroll
        for (int ni = 0; ni < 10; ++ni) {
            const bf16x8 b0 = *(const bf16x8*)(Ks + (16 * ni + fr) * SK_LD + 8 * fq), b1 = *(const bf16x8*)(Ks + (16 * ni + fr) * SK_LD + 32 + 8 * fq);
            sc[ni] = MFMA16(b0, qa[0], sc[ni]); sc[ni] = MFMA16(b1, qa[1], sc[ni]); }
        float mx = -INFINITY;
#pragma unroll
        for (int ni = 0; ni < 10; ++ni)
#pragma unroll
            for (int j = 0; j < 4; ++j) { const int key = 16 * ni + 4 * fq + j;
                const bool vis = (ni == 0) || ((key < 144) ? (key - 16 > t) : (key - 144 <= t));
                const float v = vis ? sc[ni][j] * 0.125f : -INFINITY; sc[ni][j] = v; mx = fmaxf(mx, v); }
        mx = fmaxf(mx, __shfl_xor(mx, 16)); mx = fmaxf(mx, __shfl_xor(mx, 32)); mx = fmaxf(mx, sink);
        float sum = 0.f;
#pragma unroll
        for (int ni = 0; ni < 10; ++ni)
#pragma unroll
            for (int j = 0; j < 4; ++j) { const float p = __expf(sc[ni][j] - mx); sc[ni][j] = p; sum += p; }
        sum += __shfl_xor(sum, 16); sum += __shfl_xor(sum, 32); sum += __expf(sink - mx);
        const float inv = frcp(sum);
#pragma unroll
        for (int ni = 0; ni < 10; ++ni) { u32x2 w; w.x = pkbf(sc[ni][0] * inv, sc[ni][1] * inv); w.y = pkbf(sc[ni][2] * inv, sc[ni][3] * inv); *(u32x2*)(Pw + fr * SP_LD + 16 * ni + 4 * fq) = w; }
        asm volatile("s_waitcnt lgkmcnt(0)" ::: "memory");
        f32x4 o[4];
#pragma unroll
        for (int ni = 0; ni < 4; ++ni) o[ni] = (f32x4){0.f, 0.f, 0.f, 0.f};
#pragma unroll
        for (int ks = 0; ks < 5; ++ks) { const bf16x8 af = *(const bf16x8*)(Pw + fr * SP_LD + 32 * ks + 8 * fq);
#pragma unroll
            for (int ni = 0; ni < 4; ++ni) { const int vr = 16 * ni + fr; const bf16x8 bb2 = *(const bf16x8*)(Vt + vr * SV_LD + ((32 * ks + 8 * fq) ^ TSW(vr))); o[ni] = MFMA16(bb2, af, o[ni]); } }
#pragma unroll
        for (int ni = 0; ni < 4; ++ni) { u32x2 w; w.x = pkbf(o[ni][0], o[ni][1]); w.y = pkbf(o[ni][2], o[ni][3]); *(u32x2*)(AO + qrow * DM + qh * 64 + 16 * ni + 4 * fq) = w; }
    }
    __syncthreads();
}
__device__ __forceinline__ void phase_attn(ArgsP a, int lj, unsigned char* lds, int tid, int wave, int lane) {
    if (lj == 0) {
        const bf16* KV = (const bf16*)(a->ws + WS_KV);
        const int gt = blockIdx.x * NTHREADS + tid, NT = gridDim.x * NTHREADS;
        for (int e = gt; e < 2 * 128 * 512; e += NT) { const int b = e >> 16, w = (e >> 9) & 127, c = e & 511;
            const float v = bf2f(KV[(size_t)(b * SEQ + SEQ - 128 + w) * KVW + c]);
            if (c < 256) a->out[O_PCK + (size_t)(b * 128 + w) * 256 + c] = v; else a->out[O_PCV + (size_t)(b * 128 + w) * 256 + (c - 256)] = v; }
    }
#pragma unroll 1
    for (int u = blockIdx.x; u < 1024 + 256; u += gridDim.x) {
        if (u < 1024) { const int qb = u & 127, kvh = (u >> 7) & 3, b = u >> 9; attn_prompt_unit(a, lj, lds, b, kvh, qb, tid, wave, lane); }
        else { const int su = u - 1024; attn_sample_pair(a, lj, lds, su >> 2, su & 3, tid, wave, lane); }
    }
}

constexpr int PH_B = 9 * 2, PH_F = PH_B + 7 * 2, NPHASES = PH_F + 1;
template <class Epi> __device__ __forceinline__ void run_gemm(LAS unsigned char* lds, const bf16* A, const bf16* Bt, int N, int K, const Epi& E) {
    pg8::Gemm g{A, Bt, MP, N, K}; pg8::StaticOrder S; S.init(MP, N, K, (int)gridDim.x, (int)blockIdx.x);
    pg8::gemm_phase<Epi, pg8::StaticOrder, true, true>(lds, g, S, E);
}
template <class Epi> __device__ __forceinline__ void run_gemm_res(LAS unsigned char* lds, const bf16* A, const bf16* Bt, int K, int S_, const Epi& E) {
    pg8::Gemm g{A, Bt, MP, 1024, K}; pg8::ResOrder S; S.init(K, S_, (int)gridDim.x, (int)blockIdx.x);
    pg8::gemm_phase<Epi, pg8::ResOrder, true, true>(lds, g, S, E);
}

__global__ void __launch_bounds__(NTHREADS, 2) yoco_fwd(Args args) {
    extern __shared__ __attribute__((aligned(16))) unsigned char lds[];
    LAS unsigned char* ldsl = (LAS unsigned char*)lds;
    const int tid0 = threadIdx.x;
    for (int u = tid0; u < (LDS_BYTES - LDSCTL_OFF) / 4; u += NTHREADS) ((LAS unsigned*)(ldsl + LDSCTL_OFF))[u] = 0u;
    __syncthreads();
    const int lo = args.ph_lo, hi = args.ph_hi;
    XcdBarrier bar; bar.bar = (unsigned*)(args.ws + WS_CTL) + CW_BAR; bar.x = 0; bar.st = nullptr;
    if (hi - lo > 1) bar = xcd_barrier_post((unsigned*)(args.ws + WS_CTL) + CW_BAR, (volatile LAS unsigned*)(ldsl + MISC_OFF) + 8);
    int rep = 0;
#pragma unroll 1
    for (int p = lo; p < hi;) {
        ArgsP la = (ArgsP)__builtin_amdgcn_kernarg_segment_ptr(); asm volatile("" : "+s"(la));
        unsigned char* ws = la->ws;
        const int tid = ltid();
        const int lane = tid & 63, wave = __builtin_amdgcn_readfirstlane(tid >> 6);
        bf16* HN = (bf16*)(ws + WS_HN); float* H = (float*)(ws + WS_H);
        int kind, li = 0, lj = 0, layer = 0;
        int nslab = 8;
        if (p == 0) kind = 0;
        else if (p < PH_B) { li = p / 9; layer = li; const int sub = p % 9;
            kind = (sub == 0) ? 1 : (sub == 1) ? 3 : (sub == 2) ? 5 : (sub == 3) ? 6 : (sub == 4) ? 7 : (sub == 5) ? 8 : (sub == 6) ? 1 : (sub == 7) ? 9 : 10; }
        else if (p < PH_F) { lj = (p - PH_B) / 7; layer = 2 + lj; const int sub = (p - PH_B) % 7;
            kind = (sub == 0) ? 1 : (sub == 1) ? 11 : (sub == 2) ? 12 : (sub == 3) ? 13 : (sub == 4) ? 1 : (sub == 5) ? 9 : 10; if (sub == 4) nslab = 4; }
        else kind = 14;
#ifndef KMASK
#define KMASK 0xffff
#endif
#define KON(k) ((KMASK >> (k)) & 1)
#ifndef REP_MASK
#define REP_MASK 0
#endif
        if (KON(0) && kind == 0) { phase_prologue(la, ldsl, wave, lane); phase_norm(la, 1, 0, wave, lane); }
        else if (KON(1) && kind == 1) phase_norm(la, 0, nslab, wave, lane);
        else if (KON(3) && kind == 3) { pg8::EpiInProj E{(bf16*)(ws + WS_ZX), (float*)(ws + WS_DT), la->in[I_ADTB] + li * NHEADS}; run_gemm(ldsl, HN, (const bf16*)(ws + WS_WIN + li * SZ_WIN), INPROJ_P, 1024, E); }
        else if (KON(5) && kind == 5) phase_ssd1(la, li, lds, tid, wave, lane);
        else if (KON(6) && kind == 6) phase_scan(la, li);
        else if (KON(7) && kind == 7) phase_ssd3(la, li, lds, tid, wave, lane);
        else if (KON(8) && (kind == 8 || kind == 10 || kind == 13)) {
            const bf16* A; const bf16* Bt; int K;
            if (kind == 8) { A = (const bf16*)(ws + WS_YN); Bt = (const bf16*)(ws + WS_WOUT + li * SZ_WOUT); K = 2048; }
            else if (kind == 10) { A = (const bf16*)(ws + WS_U); Bt = (const bf16*)(ws + WS_WDN + layer * SZ_WDN); K = 4096; }
            else { A = (const bf16*)(ws + WS_AO); Bt = (const bf16*)(ws + WS_WO + lj * SZ_WO); K = 1024; }
            pg8::EpiRes E{(kind == 8 && li == 0) ? la->in[I_XP] : (const float*)H, H, (float*)(ws + WS_SLAB)}; run_gemm_res(ldsl, A, Bt, K, K == 1024 ? 4 : 8, E); }
        else if (KON(9) && kind == 9) { pg8::EpiBf<1> E{(bf16*)(ws + WS_U), 4096, 1 << 20, nullptr, 0}; run_gemm(ldsl, HN, (const bf16*)(ws + WS_WUP + layer * SZ_WUP), 4096, 1024, E); }
        else if (KON(11) && kind == 11) { pg8::EpiBf<0> E{(bf16*)(ws + WS_Q), 1024, 4, (bf16*)(ws + WS_KV), KVW};
            if (lj == 0) run_gemm(ldsl, HN, (const bf16*)(ws + WS_WQKV0), 1536, 1024, E);
            else { pg8::EpiQSplit E2{(bf16*)(ws + WS_Q), (float*)(ws + WS_SLAB)}; run_gemm_res(ldsl, HN, (const bf16*)(ws + WS_WQ1), 1024, 4, E2); } }
        else if (KON(12) && kind == 12) phase_attn(la, lj, lds, tid, wave, lane);
        else if (KON(14) && kind == 14) phase_final(la, wave, lane);
        bool again = false;
        if (REP_MASK != 0) { if (rep == 0 && ((REP_MASK >> kind) & 1)) { rep = 1; again = true; } else rep = 0; }
#ifdef PROBE_DOUBLE_BARRIER
        if (p + 1 < hi || again) xcd_barrier(bar);
#endif
        if (p + 1 < hi || again) xcd_barrier(bar); else { asm volatile("s_waitcnt vmcnt(0)" ::: "memory"); __syncthreads(); }
        if (!again) ++p;
    }
}

#ifndef MK_PER_PHASE
#define MK_PER_PHASE 0
#endif
extern "C" void kernel_launch(void* const* d_in, const int* in_sizes, int n_in, void* d_out, int out_size, void* d_ws, size_t ws_size, hipStream_t stream) {
    static int grid = 0;
    if (grid == 0) {
        if (n_in != 26 || (size_t)out_size != O_END || ws_size < WS_END) { fprintf(stderr, "kernel_launch: unexpected problem (n_in %d, out %d vs %zu, ws %zu vs %zu); nothing launched\n", n_in, out_size, (size_t)O_END, ws_size, (size_t)WS_END); grid = -1; return; }
        int dev = 0, cus = 0, per_cu = 0;
        if (hipGetDevice(&dev) != hipSuccess || hipDeviceGetAttribute(&cus, hipDeviceAttributeMultiprocessorCount, dev) != hipSuccess) { grid = -1; return; }
        if (hipFuncSetAttribute((const void*)yoco_fwd, hipFuncAttributeMaxDynamicSharedMemorySize, LDS_BYTES) != hipSuccess) { fprintf(stderr, "kernel_launch: hipFuncSetAttribute failed\n"); grid = -1; return; }
        if (hipOccupancyMaxActiveBlocksPerMultiprocessor(&per_cu, (const void*)yoco_fwd, NTHREADS, LDS_BYTES) != hipSuccess || per_cu < 1) { fprintf(stderr, "kernel_launch: occupancy query says %d\n", per_cu); per_cu = 1; }
        (void)hipGetLastError();
        if (cus != 256) { fprintf(stderr, "kernel_launch: built for a 256-CU device (got %d); nothing launched\n", cus); grid = -1; return; }
        grid = cus;
    }
    if (grid < 0) return;
    if (hipMemsetAsync((char*)d_ws + WS_CTL, 0, CTL_ZERO_BYTES, stream) != hipSuccess) { fprintf(stderr, "kernel_launch: memset failed\n"); return; }
    Args a{};
    for (int i = 0; i < 26; ++i) a.in[i] = (const float*)d_in[i];
    a.out = (float*)d_out; a.ws = (unsigned char*)d_ws;
#if MK_PER_PHASE
    for (int p = 0; p < NPHASES; ++p) { a.ph_lo = p; a.ph_hi = p + 1; hipLaunchKernelGGL(yoco_fwd, dim3(grid), dim3(NTHREADS), LDS_BYTES, stream, a); }
#else
    a.ph_lo = 0; a.ph_hi = NPHASES;
    void* kargs[] = {&a};
    hipError_t e = hipLaunchCooperativeKernel((const void*)yoco_fwd, dim3(grid), dim3(NTHREADS), kargs, LDS_BYTES, stream);
    if (e != hipSuccess) fprintf(stderr, "kernel_launch: cooperative launch failed: %s (grid %d)\n", hipGetErrorString(e), grid);
#endif
}
```

```cpp
#include <hip/hip_runtime.h>
#include <cstdio>
#include <cstdint>
#include <cmath>
namespace pg8 {
#define PG8_LAS __attribute__((address_space(3)))
typedef unsigned short bf16_t;
typedef short bf16x8 __attribute__((ext_vector_type(8)));
typedef float f32x4 __attribute__((ext_vector_type(4)));
typedef unsigned u32x4 __attribute__((ext_vector_type(4)));
constexpr int BM = 256, BK = 64, HALF = 128, HTB = HALF * BK * 2  , STAGE_BYTES = 8 * HTB, NXCD = 8, WGM = 8;

__host__ __device__ __forceinline__ int lds_byte(int r, int c) { const int st = (r >> 4) * 2 + (c >> 5), rr = r & 15, cc = c & 31, ob = rr * 64 + cc * 2; return st * 1024 + (ob ^ (((ob >> 9) & 1) << 5)); }
__host__ __device__ __forceinline__ void stage_rc(int b, int& R, int& C) { const int st = b / 1024, sb = b % 1024, swz = sb ^ (((sb >> 9) & 1) << 5); R = (st >> 1) * 16 + swz / 64; C = (st & 1) * 32 + (swz % 64) / 2; }
__host__ __device__ __forceinline__ int perm32(int rho) { const int n = rho >> 4, i = rho & 15; return 8 * (i >> 2) + 4 * n + (i & 3); }

struct Unit { int pm, pn, k0, nt, aux; };
struct Gemm { const bf16_t* A; const bf16_t* Bt; int M, N, K; };

struct StaticOrder {
    int nM, nN, nwg, G, c, nt0;
    __host__ __device__ void init(int M, int N, int K, int G_, int c_) { nM = M / BM; nN = N / BM; nwg = nM * nN; G = G_; c = c_; nt0 = K / BK; }
    __host__ __device__ bool next(int i, Unit& u) const {
        const long L = (long)i * G + c; if (L >= nwg) return false;
        int wgid = (int)L; { const int q = nwg / NXCD, r = nwg % NXCD, xcd = wgid % NXCD, off = wgid / NXCD; wgid = (xcd < r ? xcd * (q + 1) : r * (q + 1) + (xcd - r) * q) + off; }
        const int nig = WGM * nN, gid = wgid / nig, fm = gid * WGM, gsz = (nM - fm) < WGM ? (nM - fm) : WGM;
        u.pm = fm + ((wgid % nig) % gsz); u.pn = (wgid % nig) / gsz; u.k0 = 0; u.nt = nt0; u.aux = -1; return true;
    }
    __device__ __forceinline__ void a_ready(const Unit&) const {}
    __device__ __forceinline__ void done(const Unit&) const {}
};
struct ResOrder {
    StaticOrder so; int S, K, c;
    __host__ __device__ void init(int K_, int S_, int G_, int c_) { so.init(64 * BM, 1024, K_, G_, c_); S = S_; K = K_; c = c_; }
    __host__ __device__ bool next(int i, Unit& u) const {
        if (i == 0) return so.next(0, u);
        if (i == 1 && c < 20 * S) { const int t = c / S, sl = c - t * S; u.pm = 64 + (t >> 2); u.pn = t & 3; u.k0 = sl * (K / S); u.nt = K / S / BK; u.aux = sl; return true; }
        return false;
    }
    __device__ __forceinline__ void a_ready(const Unit&) const {}
    __device__ __forceinline__ void done(const Unit&) const {}
};

typedef float f32x2_cv0 __attribute__((ext_vector_type(2))); typedef __bf16 bf16x2_cv0 __attribute__((ext_vector_type(2)));
__device__ __forceinline__ unsigned cvt_pk_bf16(float lo, float hi) { const f32x2_cv0 v = {lo, hi}; const bf16x2_cv0 b = __builtin_convertvector(v, bf16x2_cv0); return __builtin_bit_cast(unsigned, b); }
typedef float f32x2 __attribute__((ext_vector_type(2)));
typedef unsigned u32x2 __attribute__((ext_vector_type(2)));
__device__ __forceinline__ float softplus_f(float x) { const float y = __expf(-fabsf(x)); const float l = (y < 0.03125f) ? y * (1.f - y * (0.5f - y * (1.f / 3.f - 0.25f * y))) : __logf(1.f + y); return fmaxf(x, 0.f) + l; }
struct EpiInProj {
    static constexpr bool PERM = true, AFTER_DRAIN = false;
    bf16_t* ZX; float* DT; const float* dt_bias;
    __device__ __forceinline__ void operator()(const f32x4 (&acc)[2][2][4][2], const Unit& u, int wr, int wc, int fr, int fq) const {
        const int row0 = u.pm * BM + wr * 64 + fr;
        if (u.pn < 24) {
            const int col0 = u.pn * BM + wc * 32 + 8 * fq;
#pragma unroll
            for (int ai = 0; ai < 2; ++ai)
#pragma unroll
                for (int m = 0; m < 4; ++m) { bf16_t* rowp = ZX + (size_t)(row0 + ai * HALF + m * 16) * 6144 + col0;
#pragma unroll
                    for (int bj = 0; bj < 2; ++bj) { const f32x4 v0 = acc[ai][bj][m][0], v1 = acc[ai][bj][m][1];
                        u32x4 w; w.x = cvt_pk_bf16(v0[0], v0[1]); w.y = cvt_pk_bf16(v0[2], v0[3]); w.z = cvt_pk_bf16(v1[0], v1[1]); w.w = cvt_pk_bf16(v1[2], v1[3]);
                        *(u32x4*)(rowp + bj * HALF) = w; } }
        } else if (wc == 0) {
            const int c0 = 8 * fq;
            const f32x4 b0 = *(const f32x4*)(dt_bias + c0), b1 = *(const f32x4*)(dt_bias + c0 + 4);
#pragma unroll
            for (int ai = 0; ai < 2; ++ai)
#pragma unroll
                for (int m = 0; m < 4; ++m) { float* rowp = DT + (size_t)(row0 + ai * HALF + m * 16) * 32 + c0;
                    const f32x4 v0 = acc[ai][0][m][0] + b0, v1 = acc[ai][0][m][1] + b1;
                    f32x4 o0, o1;
#pragma unroll
                    for (int j = 0; j < 4; ++j) { o0[j] = softplus_f(v0[j]); o1[j] = softplus_f(v1[j]); }
                    *(f32x4*)(rowp) = o0; *(f32x4*)(rowp + 4) = o1; }
        }
    }
};
struct EpiRes {
    static constexpr bool PERM = false, AFTER_DRAIN = false;
    const float* B; float* H; float* SLAB;
    __device__ __forceinline__ void operator()(const f32x4 (&acc)[2][2][4][2], const Unit& u, int wr, int wc, int fr, int fq) const {
        const int row0 = u.pm * BM + wr * 64 + fr, col0 = u.pn * BM + wc * 32 + 4 * fq;
        if (u.aux >= 0) {
            float* base = SLAB + (size_t)u.aux * (1280 * 1024) + (size_t)(row0 - 16384) * 1024 + col0;
#pragma unroll
            for (int ai = 0; ai < 2; ++ai)
#pragma unroll
                for (int m = 0; m < 4; ++m) { float* rowp = base + (size_t)(ai * HALF + m * 16) * 1024;
#pragma unroll
                    for (int bj = 0; bj < 2; ++bj)
#pragma unroll
                        for (int n = 0; n < 2; ++n) *(f32x4*)(rowp + bj * HALF + n * 16) = acc[ai][bj][m][n]; }
            return;
        }
#pragma unroll
        for (int ai = 0; ai < 2; ++ai)
#pragma unroll
            for (int m = 0; m < 4; ++m) { const size_t off = (size_t)(row0 + ai * HALF + m * 16) * 1024 + col0;
#pragma unroll
                for (int bj = 0; bj < 2; ++bj)
#pragma unroll
                    for (int n = 0; n < 2; ++n) *(f32x4*)(H + off + bj * HALF + n * 16) = *(const f32x4*)(B + off + bj * HALF + n * 16) + acc[ai][bj][m][n]; }
    }
};
template <int ACT> struct EpiBf {
    static constexpr bool PERM = true, AFTER_DRAIN = false;
    bf16_t* O0; int ldc0; int nsplit; bf16_t* O1; int ldc1;
    __device__ __forceinline__ void operator()(const f32x4 (&acc)[2][2][4][2], const Unit& u, int wr, int wc, int fr, int fq) const {
        const int row0 = u.pm * BM + wr * 64 + fr;
        bf16_t* base; int ldc, colt;
        if (u.pn < nsplit) { base = O0; ldc = ldc0; colt = u.pn * BM; } else { base = O1; ldc = ldc1; colt = (u.pn - nsplit) * BM; }
        const int col0 = colt + wc * 32 + 8 * fq;
#pragma unroll
        for (int ai = 0; ai < 2; ++ai)
#pragma unroll
            for (int m = 0; m < 4; ++m) { bf16_t* rowp = base + (size_t)(row0 + ai * HALF + m * 16) * ldc + col0;
#pragma unroll
                for (int bj = 0; bj < 2; ++bj) { f32x4 v0 = acc[ai][bj][m][0], v1 = acc[ai][bj][m][1];
                    if (ACT == 1) {
#pragma unroll
                        for (int j = 0; j < 4; ++j) { const float a = fmaxf(v0[j], 0.f), b = fmaxf(v1[j], 0.f); v0[j] = a * a; v1[j] = b * b; } }
                    u32x4 w; w.x = cvt_pk_bf16(v0[0], v0[1]); w.y = cvt_pk_bf16(v0[2], v0[3]); w.z = cvt_pk_bf16(v1[0], v1[1]); w.w = cvt_pk_bf16(v1[2], v1[3]);
                    *(u32x4*)(rowp + bj * HALF) = w; } }
    }
};
struct EpiQSplit {
    static constexpr bool PERM = true, AFTER_DRAIN = false;
    bf16_t* Q; float* SLAB;
    __device__ __forceinline__ void operator()(const f32x4 (&acc)[2][2][4][2], const Unit& u, int wr, int wc, int fr, int fq) const {
        const int row0 = u.pm * BM + wr * 64 + fr, col0 = u.pn * BM + wc * 32 + 8 * fq;
        if (u.aux >= 0) {
            float* base = SLAB + (size_t)u.aux * (1280 * 1024) + (size_t)(row0 - 16384) * 1024 + col0;
#pragma unroll
            for (int ai = 0; ai < 2; ++ai)
#pragma unroll
                for (int m = 0; m < 4; ++m) { float* rowp = base + (size_t)(ai * HALF + m * 16) * 1024;
#pragma unroll
                    for (int bj = 0; bj < 2; ++bj) { *(f32x4*)(rowp + bj * HALF) = acc[ai][bj][m][0]; *(f32x4*)(rowp + bj * HALF + 4) = acc[ai][bj][m][1]; } }
            return;
        }
#pragma unroll
        for (int ai = 0; ai < 2; ++ai)
#pragma unroll
            for (int m = 0; m < 4; ++m) { bf16_t* rowp = Q + (size_t)(row0 + ai * HALF + m * 16) * 1024 + col0;
#pragma unroll
                for (int bj = 0; bj < 2; ++bj) { const f32x4 v0 = acc[ai][bj][m][0], v1 = acc[ai][bj][m][1];
                    u32x4 w; w.x = cvt_pk_bf16(v0[0], v0[1]); w.y = cvt_pk_bf16(v0[2], v0[3]); w.z = cvt_pk_bf16(v1[0], v1[1]); w.w = cvt_pk_bf16(v1[2], v1[3]);
                    *(u32x4*)(rowp + bj * HALF) = w; } }
    }
};

template <class Epi, class Sched, bool ALIGN_EPI = false, bool SP2 = false>
__device__ __forceinline__ void gemm_phase(PG8_LAS unsigned char* lds, const Gemm g, const Sched& S, const Epi& E) {
    int tid_l = threadIdx.x; asm volatile("" : "+v"(tid_l));
    const int tid = tid_l, wid = __builtin_amdgcn_readfirstlane(tid >> 6), lane = tid & 63, wr = wid >> 2, wc = wid & 3, fr = lane & 15, fq = lane >> 4;
    const int K = g.K;
    unsigned voffA[2], voffB[2];
#pragma unroll
    for (int i = 0; i < 2; ++i) { int R, C; stage_rc(tid * 16 + i * 8192, R, C); const int Rb = Epi::PERM ? ((R & ~31) + perm32(R & 31)) : R;
        voffA[i] = (unsigned)(R * K + C) * 2u; voffB[i] = (unsigned)(Rb * K + C) * 2u; }
    const size_t kstep = (size_t)(BK * 2);
    const size_t hstep = (size_t)HALF * K * 2;
    const size_t tstep = 2 * hstep;
    const unsigned ldsw = (unsigned)wid * 1024u;
    const int aoff = lds_byte(wr * 64 + fr, fq * 8), boff = lds_byte(wc * 32 + fr, fq * 8);
#define PG8_SA(b, h) (((b) * 2 + (h)) * HTB)
#define PG8_SB(b, h) ((4 + (b) * 2 + (h)) * HTB)
#define PG8_STAGE(bufoff, gbase, voff) do { _Pragma("unroll") for (int _i = 0; _i < 2; ++_i) \
        __builtin_amdgcn_global_load_lds((const unsigned*)((const char*)(gbase) + (voff)[_i]), (PG8_LAS unsigned*)(lds + (bufoff) + ldsw + _i * 8192), 16, 0, 0); } while (0)
#define PG8_LDA(dst, b, h) do { _Pragma("unroll") for (int m = 0; m < 4; ++m) _Pragma("unroll") for (int k = 0; k < 2; ++k) dst[m][k] = *(const PG8_LAS bf16x8*)(lds + PG8_SA(b, h) + aoff + m * 2048 + k * 1024); } while (0)
#define PG8_LDB(dst, b, h) do { _Pragma("unroll") for (int n = 0; n < 2; ++n) _Pragma("unroll") for (int k = 0; k < 2; ++k) dst[n][k] = *(const PG8_LAS bf16x8*)(lds + PG8_SB(b, h) + boff + n * 2048 + k * 1024); } while (0)
#define PG8_MMA(ai, bj, At, Bt) do { __builtin_amdgcn_s_setprio(1); _Pragma("unroll") for (int m = 0; m < 4; ++m) _Pragma("unroll") for (int n = 0; n < 2; ++n) _Pragma("unroll") for (int k = 0; k < 2; ++k) \
        acc[ai][bj][m][n] = __builtin_amdgcn_mfma_f32_16x16x32_bf16(Bt[n][k], At[m][k], acc[ai][bj][m][n], 0, 0, 0); __builtin_amdgcn_s_setprio(0); } while (0)
#define PG8_WAIT_V(n) asm volatile("s_waitcnt vmcnt(" #n ")" ::: "memory")
#define PG8_WAIT_L(n) asm volatile("s_waitcnt lgkmcnt(" #n ")" ::: "memory")
#define PG8_BAR __builtin_amdgcn_s_barrier()
#define PG8_SCHED __builtin_amdgcn_sched_barrier(0)
    Unit cur, nxt; int ui = 0;
    if (!S.next(0, cur)) return;
    f32x4 acc[2][2][4][2];
#pragma unroll
    for (int a = 0; a < 2; ++a)
#pragma unroll
        for (int b = 0; b < 2; ++b)
#pragma unroll
            for (int m = 0; m < 4; ++m)
#pragma unroll
                for (int n = 0; n < 2; ++n) acc[a][b][m][n] = (f32x4){0.f, 0.f, 0.f, 0.f};
    bf16x8 At[4][2], B0[2][2], B1[2][2];
    const char* cA = (const char*)g.A + (size_t)cur.pm * tstep + (size_t)cur.k0 * 2; const char* cB = (const char*)g.Bt + (size_t)cur.pn * tstep + (size_t)cur.k0 * 2;
    S.a_ready(cur);
    if constexpr (SP2) {
        PG8_STAGE(PG8_SB(0, 0), cB, voffB); PG8_STAGE(PG8_SB(0, 1), cB + hstep, voffB); PG8_STAGE(PG8_SA(0, 0), cA, voffA); PG8_STAGE(PG8_SA(0, 1), cA + hstep, voffA);
        if (wr == 1) PG8_BAR;
        PG8_WAIT_V(2); PG8_BAR;
        PG8_STAGE(PG8_SB(1, 0), cB + kstep, voffB); PG8_STAGE(PG8_SA(1, 0), cA + kstep, voffA); PG8_STAGE(PG8_SB(1, 1), cB + hstep + kstep, voffB);
        PG8_WAIT_V(6); PG8_BAR;
    } else {
        PG8_STAGE(PG8_SB(0, 0), cB, voffB); PG8_STAGE(PG8_SA(0, 0), cA, voffA); PG8_STAGE(PG8_SB(0, 1), cB + hstep, voffB); PG8_STAGE(PG8_SA(0, 1), cA + hstep, voffA);
        if (wr == 1) PG8_BAR;
        PG8_WAIT_V(4); PG8_BAR;
        PG8_STAGE(PG8_SB(1, 0), cB + kstep, voffB); PG8_STAGE(PG8_SA(1, 0), cA + kstep, voffA); PG8_STAGE(PG8_SB(1, 1), cB + hstep + kstep, voffB);
        PG8_WAIT_V(6); PG8_BAR;
    }
    for (;;) {
        const bool has_next = S.next(ui + 1, nxt);
        const char* nA = has_next ? (const char*)g.A + (size_t)nxt.pm * tstep + (size_t)nxt.k0 * 2 : cA; const char* nB = has_next ? (const char*)g.Bt + (size_t)nxt.pn * tstep + (size_t)nxt.k0 * 2 : cB;
        const int nt = cur.nt;
        for (int t = 0; t < nt; t += 2) {
            const bool last = (t == nt - 2);
            const char* a1 = cA + (size_t)(t + 1) * kstep;
            const char* a2 = last ? nA : cA + (size_t)(t + 2) * kstep; const char* b2 = last ? nB : cB + (size_t)(t + 2) * kstep;
            const char* a3 = a2 + kstep; const char* b3 = b2 + kstep;
            if (last && has_next) S.a_ready(nxt);
            if constexpr (SP2) {
            PG8_LDB(B0, 0, 0); PG8_LDB(B1, 0, 1); PG8_SCHED; PG8_LDA(At, 0, 0); PG8_STAGE(PG8_SA(1, 1), a1 + hstep, voffA);
            PG8_WAIT_V(8); PG8_WAIT_L(0); PG8_BAR; PG8_MMA(0, 0, At, B0); PG8_MMA(0, 1, At, B1); PG8_BAR; PG8_SCHED;
            PG8_LDA(At, 0, 1); PG8_STAGE(PG8_SB(0, 0), b2, voffB); PG8_STAGE(PG8_SB(0, 1), b2 + hstep, voffB); PG8_STAGE(PG8_SA(0, 0), a2, voffA);
            PG8_WAIT_V(8); PG8_WAIT_L(0); PG8_BAR; PG8_MMA(1, 0, At, B0); PG8_MMA(1, 1, At, B1); PG8_BAR; PG8_SCHED;
            PG8_LDB(B0, 1, 0); PG8_LDB(B1, 1, 1); PG8_SCHED; PG8_LDA(At, 1, 0); PG8_STAGE(PG8_SA(0, 1), a2 + hstep, voffA);
            PG8_WAIT_V(8); PG8_WAIT_L(0); PG8_BAR; PG8_MMA(0, 0, At, B0); PG8_MMA(0, 1, At, B1); PG8_BAR; PG8_SCHED;
            PG8_LDA(At, 1, 1); PG8_STAGE(PG8_SB(1, 0), b3, voffB); PG8_STAGE(PG8_SB(1, 1), b3 + hstep, voffB); PG8_STAGE(PG8_SA(1, 0), a3, voffA);
            PG8_WAIT_V(8); PG8_WAIT_L(0); PG8_BAR; PG8_MMA(1, 0, At, B0); PG8_MMA(1, 1, At, B1); PG8_BAR; PG8_SCHED;
            } else {
            PG8_LDB(B0, 0, 0); PG8_SCHED; PG8_LDA(At, 0, 0); PG8_STAGE(PG8_SA(1, 1), a1 + hstep, voffA);
            PG8_WAIT_L(8); PG8_BAR; PG8_WAIT_L(0); PG8_MMA(0, 0, At, B0); PG8_BAR; PG8_SCHED;
            PG8_LDB(B1, 0, 1); PG8_STAGE(PG8_SB(0, 0), b2, voffB);
            PG8_BAR; PG8_WAIT_L(0); PG8_MMA(0, 1, At, B1); PG8_BAR;
            PG8_LDA(At, 0, 1); PG8_STAGE(PG8_SA(0, 0), a2, voffA);
            PG8_BAR; PG8_WAIT_L(0); PG8_MMA(1, 0, At, B0); PG8_BAR; PG8_SCHED;
            PG8_STAGE(PG8_SB(0, 1), b2 + hstep, voffB);
            PG8_WAIT_V(6); PG8_BAR; PG8_MMA(1, 1, At, B1); PG8_BAR;
            PG8_LDB(B0, 1, 0); PG8_SCHED; PG8_LDA(At, 1, 0); PG8_STAGE(PG8_SA(0, 1), a2 + hstep, voffA);
            PG8_WAIT_L(8); PG8_BAR; PG8_WAIT_L(0); PG8_MMA(0, 0, At, B0); PG8_BAR; PG8_SCHED;
            PG8_LDB(B1, 1, 1); PG8_STAGE(PG8_SB(1, 0), b3, voffB);
            PG8_BAR; PG8_WAIT_L(0); PG8_MMA(0, 1, At, B1); PG8_BAR;
            PG8_LDA(At, 1, 1); PG8_STAGE(PG8_SA(1, 0), a3, voffA);
            PG8_BAR; PG8_WAIT_L(0); PG8_MMA(1, 0, At, B0); PG8_BAR; PG8_SCHED;
            PG8_STAGE(PG8_SB(1, 1), b3 + hstep, voffB);
            PG8_WAIT_V(6); PG8_BAR; PG8_MMA(1, 1, At, B1); PG8_BAR;
            }
        }
        if constexpr (ALIGN_EPI) { if (wr == 0) PG8_BAR; }
        if constexpr (!Epi::AFTER_DRAIN) { E(acc, cur, wr, wc, fr, fq); S.done(cur); }
        if (!has_next) break;
#pragma unroll
        for (int a = 0; a < 2; ++a)
#pragma unroll
            for (int b = 0; b < 2; ++b)
#pragma unroll
                for (int m = 0; m < 4; ++m)
#pragma unroll
                    for (int n = 0; n < 2; ++n) acc[a][b][m][n] = (f32x4){0.f, 0.f, 0.f, 0.f};
        cur = nxt; cA = nA; cB = nB; ++ui;
        if constexpr (ALIGN_EPI) { if (wr == 1) PG8_BAR; }
    }
    PG8_WAIT_V(0);
    if constexpr (!ALIGN_EPI) { if (wr == 0) PG8_BAR; }
    PG8_BAR;
    if constexpr (Epi::AFTER_DRAIN) { E.fused(acc, cur, wr, wc, fr, fq, lds, wid, lane); S.done(cur); }
#undef PG8_SA
#undef PG8_SB
#undef PG8_STAGE
#undef PG8_LDA
#undef PG8_LDB
#undef PG8_MMA
#undef PG8_WAIT_V
#undef PG8_WAIT_L
#undef PG8_BAR
#undef PG8_SCHED
}
}
#define GAS __attribute__((address_space(1)))
#define LAS __attribute__((address_space(3)))
typedef unsigned short bf16;
typedef unsigned v4u __attribute__((ext_vector_type(4)));
typedef float f32x4 __attribute__((ext_vector_type(4)));
typedef short bf16x8 __attribute__((ext_vector_type(8)));
typedef GAS unsigned gu32;
typedef GAS unsigned long long gu64;
#define RLX_AGENT __ATOMIC_RELAXED, __HIP_MEMORY_SCOPE_AGENT
#define LDS_WAIT() asm volatile("s_waitcnt lgkmcnt(0)" ::: "memory")
#define VM_WAIT() asm volatile("s_waitcnt vmcnt(0)" ::: "memory")
__device__ __forceinline__ unsigned long long rt() { return __builtin_amdgcn_s_memrealtime(); }
__device__ __forceinline__ unsigned f2bf(float f) { unsigned u = __builtin_bit_cast(unsigned, f); return (u + 0x7fffu + ((u >> 16) & 1u)) >> 16; }
__device__ __forceinline__ unsigned pk2(float lo, float hi) { return f2bf(lo) | (f2bf(hi) << 16); }

#define XB_TMO      128
#define XB_XCNT(j)  (256  + 64 * (j))
#define XB_XSUB(j)  (1280 + 64 * (j))
#define XB_XGEN(j)  (2304 + 64 * (j))
#define XB_TOP      3328
#define XB_TOPGEN   3392
#define XCD_BAR_WORDS 3456
#define XB_SPIN_CAP (1u << 18)

__device__ __forceinline__ unsigned xb_ld(unsigned* p)              { return __hip_atomic_load(p, __ATOMIC_RELAXED, __HIP_MEMORY_SCOPE_AGENT); }
__device__ __forceinline__ unsigned xb_add(unsigned* p, unsigned v) { return __hip_atomic_fetch_add(p, v, __ATOMIC_RELAXED, __HIP_MEMORY_SCOPE_AGENT); }
__device__ __forceinline__ unsigned xb_xcc_id() { return (unsigned)__builtin_amdgcn_s_getreg((3 << 11) | 20) & 0xFu; }
#define XB_SPIN(cond, bar) do { unsigned _sp = 0; while (cond) { __builtin_amdgcn_s_sleep(1); \
    if ((++_sp & 255u) == 0u) { if (xb_ld(&(bar)[XB_TMO])) break; if (_sp > XB_SPIN_CAP) { atomicAdd(&(bar)[XB_TMO], 1u); break; } } } } while (0)

struct XcdBarrier {
    unsigned* bar; unsigned x;
    volatile LAS unsigned* st;
};

__device__ __forceinline__ XcdBarrier xcd_barrier_post(unsigned* bar, volatile LAS unsigned* st) {
    XcdBarrier b; b.bar = bar; b.x = xb_xcc_id(); b.st = st;
    if (threadIdx.x == 0) (void)xb_add(&bar[XB_XCNT(b.x)], 1u);
    return b;
}
__device__ __forceinline__ void xcd_barrier_complete(unsigned* bar, unsigned x, unsigned& nloc, unsigned& nx) {
    const unsigned G = gridDim.x * gridDim.y * gridDim.z;
    unsigned sum, cnt, mine, sp = 0u;
    for (;;) {
        sum = 0u; cnt = 0u; mine = 0u;
#pragma unroll
        for (unsigned j = 0; j < 16; ++j) { const unsigned c = xb_ld(&bar[XB_XCNT(j)]); sum += c; cnt += (c > 0u) ? 1u : 0u; mine = (j == x) ? c : mine; }
        if (sum == G) break;
        __builtin_amdgcn_s_sleep(1);
        if ((++sp & 255u) == 0u) { if (xb_ld(&bar[XB_TMO])) break; if (sp > XB_SPIN_CAP) { atomicAdd(&bar[XB_TMO], 1u); break; } }
    }
    nloc = mine > 0u ? mine : 1u; nx = cnt > 0u ? cnt : 1u;
}

__device__ __forceinline__ void xcd_barrier(const XcdBarrier& b) {
    asm volatile("s_waitcnt vmcnt(0)" ::: "memory");
    __syncthreads();
    if (threadIdx.x == 0) {
        unsigned* bar = b.bar;
        __builtin_amdgcn_s_waitcnt(0);
        unsigned nloc = b.st[0], nx = b.st[1];
        if (nloc == 0u) { xcd_barrier_complete(bar, b.x, nloc, nx); b.st[0] = nloc; b.st[1] = nx; }
        const unsigned old = xb_add(&bar[XB_XSUB(b.x)], 1u);
        const unsigned gen = old / nloc;
        if (old + 1u == (gen + 1u) * nloc) {
            __builtin_amdgcn_fence(__ATOMIC_RELEASE, "agent");
            asm volatile("s_waitcnt vmcnt(0)" ::: "memory");
            const unsigned og = xb_add(&bar[XB_TOP], 1u);
            const unsigned tg = og / nx;
            if (og + 1u == (tg + 1u) * nx) xb_add(&bar[XB_TOPGEN], 1u);
            else XB_SPIN(xb_ld(&bar[XB_TOPGEN]) == tg, bar);
            __builtin_amdgcn_fence(__ATOMIC_ACQUIRE, "agent");
            xb_add(&bar[XB_XGEN(b.x)], 1u);
            asm volatile("s_waitcnt vmcnt(0)" ::: "memory");
        } else {
            XB_SPIN(xb_ld(&bar[XB_XGEN(b.x)]) == gen, bar);
            __builtin_amdgcn_fence(__ATOMIC_ACQUIRE, "agent");
            asm volatile("s_waitcnt vmcnt(0)" ::: "memory");
        }
    }
    __syncthreads();
}
constexpr int NWAVES = 8, NTHREADS = 512;
constexpr int DM = 1024, SEQ = 8192, NPROMPT = 2, NSAMP = 128, TSAMP = 8, NMETA = 16;
constexpr int ROW_S = NPROMPT * SEQ;
constexpr int ROW_M = ROW_S + NSAMP * TSAMP;
constexpr int NROWS = ROW_M + NMETA;
constexpr int MP = 17664;
constexpr int DINNER = 2048, NHEADS = 32, HD = 64, NGROUPS = 8, DSTATE = 128, CONVD = 4096, INPROJ = 6176, INPROJ_P = 6400, ZXW = 6144;
constexpr int DFF = 4096, NKV = 4, NQ = 16, KVW = 512;
constexpr float EPS = 1e-5f;
constexpr int LDX = 136;

constexpr size_t O_YP = 0, O_YS = O_YP + (size_t)NPROMPT * SEQ * DM, O_PCONV = O_YS + (size_t)NSAMP * TSAMP * DM, O_PSSM = O_PCONV + 2 * 2 * 3 * 4096,
    O_PCK = O_PSSM + (size_t)2 * 2 * 32 * 64 * 128, O_PCV = O_PCK + 2 * 128 * 256, O_SCONV = O_PCV + 2 * 128 * 256, O_SSSM = O_SCONV + (size_t)2 * 128 * 3 * 4096,
    O_SCK = O_SSSM + (size_t)2 * 128 * 32 * 64 * 128, O_SCV = O_SCK + (size_t)128 * 128 * 256, O_END = O_SCV + (size_t)128 * 128 * 256;

constexpr size_t MiB = 1u << 20;
constexpr size_t WS_CTL = 0, CTL_ZERO_BYTES = 1 * MiB;
constexpr size_t SZ_WIN = (size_t)INPROJ_P * 1024 * 2, SZ_WOUT = (size_t)1024 * 2048 * 2, SZ_WUP = (size_t)4096 * 1024 * 2, SZ_WDN = SZ_WUP, SZ_WQKV0 = (size_t)1536 * 1024 * 2, SZ_WQ1 = (size_t)1024 * 1024 * 2, SZ_WO = SZ_WQ1;
constexpr size_t WS_WIN = 1 * MiB, WS_WOUT = WS_WIN + 2 * SZ_WIN, WS_WUP = WS_WOUT + 2 * SZ_WOUT, WS_WDN = WS_WUP + 4 * SZ_WUP, WS_WQKV0 = WS_WDN + 4 * SZ_WDN, WS_WQ1 = WS_WQKV0 + SZ_WQKV0, WS_WO = WS_WQ1 + SZ_WQ1, WS_WEND = WS_WO + 2 * SZ_WO;
constexpr size_t al1m(size_t x) { return (x + MiB - 1) / MiB * MiB; }
constexpr size_t WS_H = al1m(WS_WEND), WS_HN = al1m(WS_H + (size_t)MP * 1024 * 4), WS_ZX = al1m(WS_HN + (size_t)MP * 1024 * 2), WS_DT = al1m(WS_ZX + (size_t)MP * ZXW * 2),
    WS_XC = al1m(WS_DT + (size_t)MP * 32 * 4), WS_YN = al1m(WS_XC + (size_t)MP * 4096 * 2), WS_CS = al1m(WS_YN + (size_t)MP * 2048 * 2), WS_CD = al1m(WS_CS + (size_t)129 * 32 * 8192 * 4), WS_SLAB = al1m(WS_CD + 129 * 32 * 4), WS_HSB = al1m(WS_SLAB + (size_t)8 * 1280 * 1024 * 4), WS_END = al1m(WS_HSB + (size_t)128 * 32 * 8192 * 2);
constexpr size_t WS_U = WS_ZX;
constexpr size_t WS_Q = WS_XC, WS_KV = WS_Q + (size_t)MP * 1024 * 2, WS_AO = WS_KV + (size_t)MP * 512 * 2;
static_assert(WS_AO + (size_t)MP * 1024 * 2 <= WS_YN, "attention overlay");
constexpr int CW_BAR = 4096;

constexpr int RING_BYTES = 131072, LDS_BYTES = 147456, LDSCTL_OFF = LDS_BYTES - 512, MISC_OFF = LDSCTL_OFF + 320;

typedef unsigned u32x2 __attribute__((ext_vector_type(2)));
typedef unsigned u32x4 __attribute__((ext_vector_type(4)));
__device__ __forceinline__ int ltid() { int t = threadIdx.x; asm volatile("" : "+v"(t)); return t; }
__device__ __forceinline__ float bf2f(unsigned short b) { return __uint_as_float((unsigned)b << 16); }
__device__ __forceinline__ float bflo(unsigned w) { return __uint_as_float(w << 16); }
__device__ __forceinline__ float bfhi(unsigned w) { return __uint_as_float(w & 0xffff0000u); }
__device__ __forceinline__ unsigned pkbf(float lo, float hi) { return pg8::cvt_pk_bf16(lo, hi); }
__device__ __forceinline__ float wave_sum(float v) {
#pragma unroll
    for (int o = 1; o < 64; o <<= 1) v += __shfl_xor(v, o);
    return v;
}
__device__ __forceinline__ float frcp(float x) { return __builtin_amdgcn_rcpf(x); }
__device__ __forceinline__ float sigmoid_f(float x) { return frcp(1.f + __expf(-x)); }
#define MFMA16(b, a, c) __builtin_amdgcn_mfma_f32_16x16x32_bf16((b), (a), (c), 0, 0, 0)

struct Args {
    const float* in[26]; float* out; unsigned char* ws; int ph_lo, ph_hi;
};
typedef const __attribute__((address_space(4))) Args* ArgsP;
enum { I_XP = 0, I_XS, I_SCONV, I_SSSM, I_CK, I_CV, I_META, I_ANORM, I_AIN, I_ACONVW, I_ACONVB, I_ADTB, I_ALOG, I_ADSKIP, I_AGATE, I_AOUT, I_KVNORM, I_WKV, I_BNORM, I_WQ, I_SINKS, I_WO, I_MLPNORM, I_WUP, I_WDOWN, I_FNORM };

__device__ __forceinline__ void transpose_item(const float* W, const float* scale, int K, int N, bf16* WT, int row_off, LAS unsigned* scr, int item, int lane) {
    const int nblk = (N + 63) / 64, kb = item / nblk, nb = item % nblk, k0 = 64 * kb, n0 = 64 * nb;
    const bool ok = (n0 + lane < N);
    const float* src = W + (size_t)k0 * N + n0 + (ok ? lane : 0);
    float v[64];
#pragma unroll
    for (int i = 0; i < 64; ++i) v[i] = src[(size_t)i * N];
    if (!ok) {
#pragma unroll
        for (int i = 0; i < 64; ++i) v[i] = 0.f;
    }
    if (scale) {
#pragma unroll
        for (int i = 0; i < 64; ++i) v[i] *= scale[k0 + i];
    }
#pragma unroll
    for (int i = 0; i < 32; ++i) scr[lane * 33 + i] = pkbf(v[2 * i], v[2 * i + 1]);
    LDS_WAIT(); asm volatile("" ::: "memory");
    const int c = lane & 7;
#pragma unroll
    for (int j = 0; j < 8; ++j) { const int n = (lane >> 3) + 8 * j; const LAS unsigned* sp = scr + n * 33 + 4 * c;
        v4u o; o.x = sp[0]; o.y = sp[1]; o.z = sp[2]; o.w = sp[3];
        if (n0 + n < N) *(GAS v4u*)(WT + (size_t)(row_off + n0 + n) * K + k0 + 8 * c) = o; }
    LDS_WAIT(); asm volatile("" ::: "memory");
}
struct WJob { const float* W; const float* scale; int K, N; bf16* WT; int row_off; int items; };

__device__ __forceinline__ void phase_prologue(ArgsP a, LAS unsigned char* lds, int wave, int lane) {
    LAS unsigned* scr = (LAS unsigned*)(lds + wave * 16384);
    const int gw = blockIdx.x * NWAVES + wave, NGW = gridDim.x * NWAVES;
    unsigned char* ws = a->ws;
    for (int jb = 0; jb < 21; ++jb) {
        WJob J;
        if (jb < 2)       { const int i = jb;      J = WJob{a->in[I_AIN] + (size_t)i * 1024 * INPROJ, a->in[I_ANORM] + i * 1024, 1024, INPROJ, (bf16*)(ws + WS_WIN + i * SZ_WIN), 0, 0}; }
        else if (jb < 4)  { const int i = jb - 2;  J = WJob{a->in[I_AOUT] + (size_t)i * 2048 * 1024, a->in[I_AGATE] + i * 2048, 2048, 1024, (bf16*)(ws + WS_WOUT + i * SZ_WOUT), 0, 0}; }
        else if (jb < 8)  { const int l = jb - 4;  J = WJob{a->in[I_WUP] + (size_t)l * 1024 * 4096, a->in[I_MLPNORM] + l * 1024, 1024, 4096, (bf16*)(ws + WS_WUP + l * SZ_WUP), 0, 0}; }
        else if (jb < 12) { const int l = jb - 8;  J = WJob{a->in[I_WDOWN] + (size_t)l * 4096 * 1024, nullptr, 4096, 1024, (bf16*)(ws + WS_WDN + l * SZ_WDN), 0, 0}; }
        else if (jb == 12) { J = WJob{a->in[I_WQ], a->in[I_BNORM], 1024, 1024, (bf16*)(ws + WS_WQKV0), 0, 0}; }
        else if (jb == 13) { J = WJob{a->in[I_WKV], a->in[I_KVNORM], 1024, 512, (bf16*)(ws + WS_WQKV0), 1024, 0}; }
        else if (jb == 14) { J = WJob{a->in[I_WQ] + (size_t)1024 * 1024, a->in[I_BNORM] + 1024, 1024, 1024, (bf16*)(ws + WS_WQ1), 0, 0}; }
        else if (jb < 17) { const int j = jb - 15; J = WJob{a->in[I_WO] + (size_t)j * 1024 * 1024, nullptr, 1024, 1024, (bf16*)(ws + WS_WO + j * SZ_WO), 0, 0}; }
        else break;
        const int items = (J.K / 64) * ((J.N + 63) / 64);
        for (int it = gw; it < items; it += NGW) transpose_item(J.W, J.scale, J.K, J.N, J.WT, J.row_off, scr, it, lane);
    }
    {
        const int gt = blockIdx.x * NTHREADS + ltid(), NT = gridDim.x * NTHREADS;
        const int per = (INPROJ_P - INPROJ) * 1024 * 2 / 16;
        for (int e = gt; e < 2 * per; e += NT) { const int i = e / per, c = e % per;
            *(v4u*)(ws + WS_WIN + i * SZ_WIN + (size_t)INPROJ * 1024 * 2 + (size_t)c * 16) = (v4u){0u, 0u, 0u, 0u}; }
    }
}

__device__ __forceinline__ void norm_store(bf16* __restrict__ HN, int m, int lane, const f32x4 (&v)[4]) {
    float s = 0.f;
#pragma unroll
    for (int j = 0; j < 4; ++j) s += (v[j].x * v[j].x + v[j].y * v[j].y) + (v[j].z * v[j].z + v[j].w * v[j].w);
    const float rs = rsqrtf(wave_sum(s) * (1.f / DM) + EPS);
    unsigned long long* o8 = (unsigned long long*)(HN + (size_t)m * DM) + lane;
#pragma unroll
    for (int j = 0; j < 4; ++j) o8[64 * j] = (unsigned long long)pkbf(v[j].x * rs, v[j].y * rs) | ((unsigned long long)pkbf(v[j].z * rs, v[j].w * rs) << 32);
}
__device__ __forceinline__ void phase_norm(ArgsP a, int from_inputs, int nslab, int wave, int lane) {
    float* __restrict__ H = (float*)(a->ws + WS_H); bf16* __restrict__ HN = (bf16*)(a->ws + WS_HN); const float* __restrict__ SLAB = (const float*)(a->ws + WS_SLAB);
    const int gw = blockIdx.x * NWAVES + wave, NGW = gridDim.x * NWAVES;
    for (int m = ROW_S + gw; m < MP; m += NGW) {
        if (m >= NROWS) { unsigned long long* o8 = (unsigned long long*)(HN + (size_t)m * DM) + lane;
#pragma unroll
            for (int j = 0; j < 4; ++j) o8[64 * j] = 0ull;
            continue; }
        const float* src = from_inputs ? ((m < ROW_M) ? a->in[I_XS] + (size_t)(m - ROW_S) * DM : a->in[I_META] + (size_t)(m - ROW_M) * DM) : H + (size_t)m * DM;
        f32x4 v[4], sv[8][4];
#pragma unroll
        for (int j = 0; j < 4; ++j) v[j] = ((const f32x4*)src + lane)[64 * j];
#pragma unroll
        for (int sl = 0; sl < 8; ++sl)
#pragma unroll
            for (int j = 0; j < 4; ++j) { sv[sl][j] = (f32x4){0.f, 0.f, 0.f, 0.f}; if (sl < nslab) sv[sl][j] = ((const f32x4*)(SLAB + (size_t)sl * (1280 * 1024) + (size_t)(m - ROW_S) * DM) + lane)[64 * j]; }
#pragma unroll
        for (int sl = 0; sl < 8; ++sl)
#pragma unroll
            for (int j = 0; j < 4; ++j) v[j] = v[j] + sv[sl][j];
        if (nslab > 0 || from_inputs) { f32x4* hr = (f32x4*)(H + (size_t)m * DM) + lane;
#pragma unroll
            for (int j = 0; j < 4; ++j) hr[64 * j] = v[j]; }
        norm_store(HN, m, lane, v);
    }
    const float* __restrict__ P = from_inputs ? a->in[I_XP] : (const float*)H;
    for (int m0 = 2 * gw; m0 < ROW_S; m0 += 2 * NGW) {
        f32x4 v[2][4];
#pragma unroll
        for (int q = 0; q < 2; ++q)
#pragma unroll
            for (int j = 0; j < 4; ++j) v[q][j] = ((const f32x4*)(P + (size_t)(m0 + q) * DM) + lane)[64 * j];
#pragma unroll
        for (int q = 0; q < 2; ++q) norm_store(HN, m0 + q, lane, v[q]);
    }
}
__device__ __forceinline__ void phase_final(ArgsP a, int wave, int lane) {
    const float* H = (const float*)(a->ws + WS_H); const float* fw = a->in[I_FNORM]; const float* SLAB = (const float*)(a->ws + WS_SLAB);
    const int gw = blockIdx.x * NWAVES + wave, NGW = gridDim.x * NWAVES;
    f32x4 w[4];
#pragma unroll
    for (int j = 0; j < 4; ++j) w[j] = ((const f32x4*)fw)[lane + 64 * j];
    for (int m = gw; m < ROW_M; m += NGW) {
        const f32x4* xr = (const f32x4*)(H + (size_t)m * DM) + lane;
        f32x4 v[4]; float s = 0.f;
#pragma unroll
        for (int j = 0; j < 4; ++j) v[j] = xr[64 * j];
        if (m >= ROW_S) {
            for (int sl = 0; sl < 8; ++sl) { const f32x4* sr = (const f32x4*)(SLAB + (size_t)sl * (1280 * 1024) + (size_t)(m - ROW_S) * DM) + lane;
#pragma unroll
                for (int j = 0; j < 4; ++j) v[j] = v[j] + sr[64 * j]; }
        }
#pragma unroll
        for (int j = 0; j < 4; ++j) s += (v[j].x * v[j].x + v[j].y * v[j].y) + (v[j].z * v[j].z + v[j].w * v[j].w);
        const float rs = rsqrtf(wave_sum(s) * (1.f / DM) + EPS);
        f32x4* o = (f32x4*)(a->out + O_YP + (size_t)m * DM) + lane;
#pragma unroll
        for (int j = 0; j < 4; ++j) o[64 * j] = v[j] * rs * w[j];
    }
}

__device__ __forceinline__ void unpack8(const u32x4 w, float (&f)[8]) { f[0] = bflo(w.x); f[1] = bfhi(w.x); f[2] = bflo(w.y); f[3] = bfhi(w.y); f[4] = bflo(w.z); f[5] = bfhi(w.z); f[6] = bflo(w.w); f[7] = bfhi(w.w); }
__device__ __forceinline__ void ld8f(const float* __restrict__ p, float (&f)[8]) { const f32x4 x0 = *(const f32x4*)p, x1 = *(const f32x4*)(p + 4); f[0]=x0.x;f[1]=x0.y;f[2]=x0.z;f[3]=x0.w;f[4]=x1.x;f[5]=x1.y;f[6]=x1.z;f[7]=x1.w; }
#define TSW(ch) ((((ch) >> 3) & 7) << 3)
struct ConvW { float w0[8], w1[8], w2[8], w3[8], bs[8]; };
__device__ __forceinline__ void conv_load_w(const float* __restrict__ cw, const float* __restrict__ cb, int c0, ConvW& W) { ld8f(cw + c0, W.w0); ld8f(cw + CONVD + c0, W.w1); ld8f(cw + 2 * CONVD + c0, W.w2); ld8f(cw + 3 * CONVD + c0, W.w3); ld8f(cb + c0, W.bs); }
__device__ __forceinline__ void conv_load_run(const bf16* __restrict__ ZX, int Rrow, int c0, int pk, bool valid, u32x4 (&raw)[11]) {
#pragma unroll
    for (int t = 0; t < 8; ++t) { raw[3 + t] = (u32x4){0u, 0u, 0u, 0u}; if (valid) raw[3 + t] = *(const u32x4*)(ZX + (size_t)(Rrow + t) * ZXW + 2048 + c0); }
#pragma unroll
    for (int t = 0; t < 3; ++t) { const int rr = (pk == 1) ? ROW_M + 13 + t : Rrow - 3 + t; raw[t] = (u32x4){0u, 0u, 0u, 0u}; if (valid && pk != 2) raw[t] = *(const u32x4*)(ZX + (size_t)rr * ZXW + 2048 + c0); }
}
template <int J> __device__ __forceinline__ void conv_channel(const u32x4 (&raw)[11], const ConvW& W, float (&o)[8]) {
    float x[11];
#pragma unroll
    for (int i = 0; i < 11; ++i) { const unsigned w = raw[i][J >> 1]; x[i] = (J & 1) ? bfhi(w) : bflo(w); }
#pragma unroll
    for (int t = 0; t < 8; ++t) { const float v = W.bs[J] + W.w0[J] * x[t] + W.w1[J] * x[t + 1] + W.w2[J] * x[t + 2] + W.w3[J] * x[t + 3]; o[t] = v * sigmoid_f(v); }
}
template <int J> __device__ __forceinline__ void conv_store_t(const u32x4 (&raw)[11], const ConvW& W, const float (&scale)[8], bf16* T, int ch0, int run) {
    float o[8]; conv_channel<J>(raw, W, o);
    u32x4 w; w.x = pkbf(o[0] * scale[0], o[1] * scale[1]); w.y = pkbf(o[2] * scale[2], o[3] * scale[3]); w.z = pkbf(o[4] * scale[4], o[5] * scale[5]); w.w = pkbf(o[6] * scale[6], o[7] * scale[7]);
    *(u32x4*)(T + (ch0 + J) * LDX + ((8 * run) ^ TSW(ch0 + J))) = w;
}
__device__ __forceinline__ void conv_item_t(const u32x4 (&raw)[11], const ConvW& W, const float (&scale)[8], bf16* T, int ch0, int run) {
    conv_store_t<0>(raw, W, scale, T, ch0, run); conv_store_t<1>(raw, W, scale, T, ch0, run); conv_store_t<2>(raw, W, scale, T, ch0, run); conv_store_t<3>(raw, W, scale, T, ch0, run);
    conv_store_t<4>(raw, W, scale, T, ch0, run); conv_store_t<5>(raw, W, scale, T, ch0, run); conv_store_t<6>(raw, W, scale, T, ch0, run); conv_store_t<7>(raw, W, scale, T, ch0, run);
}
__device__ __forceinline__ void conv_item_n(const u32x4 (&raw)[11], const ConvW& W, bf16* N, int run, int colel) {
    float p0[8], p1[8], p2[8]; unpack8(raw[0], p0); unpack8(raw[1], p1); unpack8(raw[2], p2);
#pragma unroll
    for (int t = 0; t < 8; ++t) { float x[8]; unpack8(raw[3 + t], x); float o[8];
#pragma unroll
        for (int j = 0; j < 8; ++j) { const float v = W.bs[j] + W.w0[j] * p0[j] + W.w1[j] * p1[j] + W.w2[j] * p2[j] + W.w3[j] * x[j]; o[j] = v * sigmoid_f(v); }
        u32x4 w; w.x = pkbf(o[0], o[1]); w.y = pkbf(o[2], o[3]); w.z = pkbf(o[4], o[5]); w.w = pkbf(o[6], o[7]);
        *(u32x4*)(N + (8 * run + t) * LDX + colel) = w;
#pragma unroll
        for (int j = 0; j < 8; ++j) { p0[j] = p1[j]; p1[j] = p2[j]; p2[j] = x[j]; } }
}
__device__ __forceinline__ void conv_state_out(const u32x4 (&raw)[11], float* __restrict__ dst  ) {
#pragma unroll
    for (int k = 0; k < 3; ++k) { float x[8]; unpack8(raw[8 + k], x); *(f32x4*)(dst + (size_t)k * CONVD) = (f32x4){x[0], x[1], x[2], x[3]}; *(f32x4*)(dst + (size_t)k * CONVD + 4) = (f32x4){x[4], x[5], x[6], x[7]}; }
}

__device__ __forceinline__ void ssd_acs(const float* DT, const float* alog, int R0, int len, int h0, float* s_dt, float* s_acs, int wave, int lane) {
    if (wave < 4) {
        const int r = wave; const float An = -__expf(alog[h0 + r]);
        const int l0 = 2 * lane;
        const float d0 = (l0 < len) ? DT[(size_t)(R0 + l0) * 32 + h0 + r] : 0.f;
        const float d1 = (l0 + 1 < len) ? DT[(size_t)(R0 + l0 + 1) * 32 + h0 + r] : 0.f;
        const float a0 = d0 * An, a1 = d1 * An, s = a0 + a1;
        float incl = s;
#pragma unroll
        for (int o = 1; o < 64; o <<= 1) { const float t = __shfl_up(incl, o); if (lane >= o) incl += t; }
        const float excl = incl - s;
        s_dt[r * 128 + l0] = d0; s_dt[r * 128 + l0 + 1] = d1;
        s_acs[r * 128 + l0] = excl + a0; s_acs[r * 128 + l0 + 1] = excl + s;
    }
}
#define LFRAG(base, row, ld, ks) (*(const bf16x8*)((base) + (row) * (ld) + 32 * (ks) + 8 * fq))

__device__ __forceinline__ void ssd1_unit(ArgsP a, int li, unsigned char* lds, int slot, int g, int R0, int len, int, int, int) {
    const int tid = ltid(), lane = tid & 63, wave = __builtin_amdgcn_readfirstlane(tid >> 6);
    const float* __restrict__ DT = (const float*)(a->ws + WS_DT);
    bf16* __restrict__ CS = (bf16*)(a->ws + WS_CS); float* __restrict__ CD = (float*)(a->ws + WS_CD);
    bf16* XsT = (bf16*)lds;
    bf16* BT = (bf16*)(lds + 256 * LDX * 2);
    float* s_dt = (float*)(lds + 384 * LDX * 2); float* s_acs = s_dt + 512;
    const int fr = lane & 15, fq = lane >> 4, h0 = g * 4;
    const float* __restrict__ cw = a->in[I_ACONVW] + (size_t)li * 4 * CONVD; const float* __restrict__ cbias = a->in[I_ACONVB] + (size_t)li * CONVD;
    const bf16* __restrict__ ZX = (const bf16*)(a->ws + WS_ZX);
    const bool meta = (slot == 128), chunk0 = (!meta && (slot & 63) == 0);
    const int xcb = tid & 31, xrun = tid >> 5, xc0 = g * 256 + xcb * 8;
    const int bcb = tid & 15, brun = (tid >> 4) & 15, bc0 = 2048 + g * 128 + bcb * 8;
    u32x4 rx[11], rb[11];
    conv_load_run(ZX, R0 + 8 * xrun, xc0, (xrun == 0) ? (meta ? 2 : (chunk0 ? 1 : 0)) : 0, 8 * xrun < len, rx);
    if (tid < 256) conv_load_run(ZX, R0 + 8 * brun, bc0, (brun == 0) ? (meta ? 2 : (chunk0 ? 1 : 0)) : 0, 8 * brun < len, rb);
    ssd_acs(DT, a->in[I_ALOG] + li * NHEADS, R0, len, h0, s_dt, s_acs, wave, lane);
    if (tid < 256) { ConvW W; conv_load_w(cw, cbias, bc0, W); const float one[8] = {1.f, 1.f, 1.f, 1.f, 1.f, 1.f, 1.f, 1.f}; conv_item_t(rb, W, one, BT, bcb * 8, brun); }
    __syncthreads();
    {   ConvW W; conv_load_w(cw, cbias, xc0, W);
        const int r = xcb >> 3; const float tot = s_acs[r * 128 + 127];
        const f32x4 a0 = *(const f32x4*)(s_acs + r * 128 + 8 * xrun), a1 = *(const f32x4*)(s_acs + r * 128 + 8 * xrun + 4), d0 = *(const f32x4*)(s_dt + r * 128 + 8 * xrun), d1 = *(const f32x4*)(s_dt + r * 128 + 8 * xrun + 4);
        float wl[8];
#pragma unroll
        for (int t = 0; t < 4; ++t) { wl[t] = __expf(tot - a0[t]) * d0[t]; wl[4 + t] = __expf(tot - a1[t]) * d1[t]; }
        conv_item_t(rx, W, wl, XsT, xcb * 8, xrun);
    }
    __syncthreads();
    f32x4 acc[2][8];
#pragma unroll
    for (int mi = 0; mi < 2; ++mi)
#pragma unroll
        for (int ni = 0; ni < 8; ++ni) acc[mi][ni] = (f32x4){0.f, 0.f, 0.f, 0.f};
#pragma unroll
    for (int ks = 0; ks < 4; ++ks) {
        const int ra0 = 32 * wave + fr, ra1 = ra0 + 16;
        const bf16x8 a0 = *(const bf16x8*)(XsT + ra0 * LDX + ((32 * ks + 8 * fq) ^ TSW(ra0))), a1 = *(const bf16x8*)(XsT + ra1 * LDX + ((32 * ks + 8 * fq) ^ TSW(ra1)));
#pragma unroll
        for (int ni = 0; ni < 8; ++ni) { const int rb = 16 * ni + fr; const bf16x8 bb = *(const bf16x8*)(BT + rb * LDX + ((32 * ks + 8 * fq) ^ TSW(rb)));
            acc[0][ni] = MFMA16(bb, a0, acc[0][ni]); acc[1][ni] = MFMA16(bb, a1, acc[1][ni]); }
    }
#pragma unroll
    for (int mi = 0; mi < 2; ++mi) { const int hp = 32 * wave + 16 * mi + fr, r = hp >> 6, p = hp & 63;
        bf16* dst = CS + ((size_t)(slot * 32 + h0 + r) * 64 + p) * 128 + 4 * fq;
#pragma unroll
        for (int ni = 0; ni < 8; ++ni) { u32x2 w; w.x = pkbf(acc[mi][ni][0], acc[mi][ni][1]); w.y = pkbf(acc[mi][ni][2], acc[mi][ni][3]); *(u32x2*)(dst + 16 * ni) = w; } }
    if (tid < 4) CD[slot * 32 + h0 + tid] = __expf(s_acs[tid * 128 + 127]);
    __syncthreads();
}

__device__ __forceinline__ void ssd_sample_issue(ArgsP a, int li, int b, int g, f32x4 (&st)[4][4]) {
    const int tid = ltid(), p = tid >> 3, nb = tid & 7;
    const float* __restrict__ sin_ = a->in[I_SSSM] + ((size_t)((li * NSAMP + b) * NHEADS + g * 4) * 64 + p) * 128 + 4 * nb;
#pragma unroll
    for (int r = 0; r < 4; ++r)
#pragma unroll
        for (int kk = 0; kk < 4; ++kk) st[r][kk] = *(const f32x4*)(sin_ + (size_t)r * 8192 + 32 * kk);
}
__device__ __forceinline__ void ssd_sample_unit(ArgsP a, int li, unsigned char* lds, int b, int g, f32x4 (&st)[4][4]) {
    const int tid = ltid(), lane = tid & 63, wave = __builtin_amdgcn_readfirstlane(tid >> 6);
    const bf16* __restrict__ ZX = (const bf16*)(a->ws + WS_ZX); const float* __restrict__ DT = (const float*)(a->ws + WS_DT); bf16* __restrict__ YN = (bf16*)(a->ws + WS_YN);
    float* sX = (float*)lds; float* sB = sX + 8 * 256; float* sC = sB + 8 * 128; float* sY = sC + 8 * 128; float* sDt = sY + 8 * 256;
    const int R0 = ROW_S + b * 8, h0 = g * 4;
    const int p = tid >> 3, nb = tid & 7;
    float* __restrict__ sout = a->out + O_SSSM + ((size_t)((li * NSAMP + b) * NHEADS + h0) * 64 + p) * 128 + 4 * nb;
    {
        const float* __restrict__ cw = a->in[I_ACONVW] + (size_t)li * 4 * CONVD; const float* __restrict__ cbias = a->in[I_ACONVB] + (size_t)li * CONVD;
        const int t = tid >> 6, ck = tid & 63;
        const int c0 = (ck < 32) ? g * 256 + ck * 8 : (ck < 48) ? 2048 + g * 128 + (ck - 32) * 8 : 3072 + g * 128 + (ck - 48) * 8;
        float* dst = (ck < 32) ? sX + t * 256 + ck * 8 : (ck < 48) ? sB + t * 128 + (ck - 32) * 8 : sC + t * 128 + (ck - 48) * 8;
        const float* __restrict__ sc = a->in[I_SCONV] + ((size_t)(li * NSAMP + b) * 3) * CONVD + c0;
        float xr[4][8];
#pragma unroll
        for (int k = 0; k < 4; ++k) { const int tt = t - 3 + k;
            if (tt >= 0) unpack8(*(const u32x4*)(ZX + (size_t)(R0 + tt) * ZXW + 2048 + c0), xr[k]); else ld8f(sc + (size_t)(tt + 3) * CONVD, xr[k]); }
        ConvW W; conv_load_w(cw, cbias, c0, W);
        float o[8];
#pragma unroll
        for (int j = 0; j < 8; ++j) { const float v = W.bs[j] + W.w0[j] * xr[0][j] + W.w1[j] * xr[1][j] + W.w2[j] * xr[2][j] + W.w3[j] * xr[3][j]; o[j] = v * sigmoid_f(v); }
        *(f32x4*)dst = (f32x4){o[0], o[1], o[2], o[3]}; *(f32x4*)(dst + 4) = (f32x4){o[4], o[5], o[6], o[7]};
        if (t >= 5) { float* __restrict__ so = a->out + O_SCONV + ((size_t)(li * NSAMP + b) * 3 + (t - 5)) * CONVD + c0;
            *(f32x4*)so = (f32x4){xr[3][0], xr[3][1], xr[3][2], xr[3][3]}; *(f32x4*)(so + 4) = (f32x4){xr[3][4], xr[3][5], xr[3][6], xr[3][7]}; }
    }
    if (tid < 32) sDt[tid] = DT[(size_t)(R0 + (tid >> 2)) * 32 + h0 + (tid & 3)];
    __syncthreads();
    float An[4], Dk[4];
#pragma unroll
    for (int r = 0; r < 4; ++r) { An[r] = -__expf(a->in[I_ALOG][li * NHEADS + h0 + r]); Dk[r] = a->in[I_ADSKIP][li * NHEADS + h0 + r]; }
    float part[8][4];
#pragma unroll
    for (int t = 0; t < 8; ++t) {
        f32x4 bv[4], cv[4];
#pragma unroll
        for (int kk = 0; kk < 4; ++kk) { bv[kk] = *(const f32x4*)(sB + t * 128 + 32 * kk + 4 * nb); cv[kk] = *(const f32x4*)(sC + t * 128 + 32 * kk + 4 * nb); }
#pragma unroll
        for (int r = 0; r < 4; ++r) {
            const float dt = sDt[t * 4 + r], dA = __expf(dt * An[r]), xv = sX[t * 256 + r * 64 + p], coef = dt * xv;
            float pr = 0.f;
#pragma unroll
            for (int kk = 0; kk < 4; ++kk) { st[r][kk] = st[r][kk] * dA + bv[kk] * coef; pr += (cv[kk].x * st[r][kk].x + cv[kk].y * st[r][kk].y) + (cv[kk].z * st[r][kk].z + cv[kk].w * st[r][kk].w); }
            part[t][r] = pr;
        }
    }
#pragma unroll
    for (int r = 0; r < 4; ++r)
#pragma unroll
        for (int kk = 0; kk < 4; ++kk) *(f32x4*)(sout + (size_t)r * 8192 + 32 * kk) = st[r][kk];
#pragma unroll
    for (int t = 0; t < 8; ++t)
#pragma unroll
        for (int r = 0; r < 4; ++r) { float v = part[t][r]; v += __shfl_xor(v, 1); v += __shfl_xor(v, 2); v += __shfl_xor(v, 4); part[t][r] = v; }
    if (nb == 0) {
#pragma unroll
        for (int t = 0; t < 8; ++t)
#pragma unroll
            for (int r = 0; r < 4; ++r) sY[t * 256 + r * 64 + p] = part[t][r] + Dk[r] * sX[t * 256 + r * 64 + p];
    }
    __syncthreads();
    {
        const int t = wave, c4 = lane * 4; const size_t row = (size_t)(R0 + t);
        const f32x4 y = *(const f32x4*)(sY + t * 256 + c4);
        const u32x2 zz = *(const u32x2*)(ZX + row * ZXW + g * 256 + c4);
        const float z0 = bflo(zz.x), z1 = bfhi(zz.x), z2 = bflo(zz.y), z3 = bfhi(zz.y);
        const float g0 = y.x * z0 * sigmoid_f(z0), g1 = y.y * z1 * sigmoid_f(z1), g2 = y.z * z2 * sigmoid_f(z2), g3 = y.w * z3 * sigmoid_f(z3);
        const float ss = wave_sum((g0 * g0 + g1 * g1) + (g2 * g2 + g3 * g3));
        const float rs = rsqrtf(ss * (1.f / 256.f) + EPS);
        u32x2 o; o.x = pkbf(g0 * rs, g1 * rs); o.y = pkbf(g2 * rs, g3 * rs);
        *(u32x2*)(YN + row * DINNER + g * 256 + c4) = o;
    }
    __syncthreads();
}

__device__ __forceinline__ void phase_scan(ArgsP a, int li) {
    const bf16* __restrict__ CS = (const bf16*)(a->ws + WS_CS); const float* __restrict__ CD = (const float*)(a->ws + WS_CD); bf16* __restrict__ HSB = (bf16*)(a->ws + WS_HSB);
    const int gt = blockIdx.x * NTHREADS + ltid(), NT = gridDim.x * NTHREADS;
    for (int e = gt; e < 2 * 65536; e += NT) {
        const int b = e >> 16, rem = e & 65535, h = rem >> 11, pn4 = rem & 2047;
        f32x4 hc; { const u32x2 w0 = *(const u32x2*)(CS + ((size_t)(128 * 32 + h) * 2048 + pn4) * 4); hc = (f32x4){bflo(w0.x), bfhi(w0.x), bflo(w0.y), bfhi(w0.y)}; }
#pragma unroll 8
        for (int c = 0; c < 64; ++c) { const int slot = b * 64 + c; const size_t o = ((size_t)(slot * 32 + h) * 2048 + pn4) * 4;
            const u32x2 sw = *(const u32x2*)(CS + o); const f32x4 s = (f32x4){bflo(sw.x), bfhi(sw.x), bflo(sw.y), bfhi(sw.y)}; const float d = CD[slot * 32 + h];
            u32x2 w; w.x = pkbf(hc.x, hc.y); w.y = pkbf(hc.z, hc.w); *(u32x2*)(HSB + o) = w;
            hc = hc * d + s; }
        *(f32x4*)(a->out + O_PSSM + ((size_t)((li * NPROMPT + b) * NHEADS + h) * 2048 + pn4) * 4) = hc;
    }
}

__device__ __forceinline__ void ssd3_head(int r, int hb, const bf16* Cn, const bf16* BH, const bf16* Xt, const float* s_dt, const float* s_acs, const f32x4 (&cb)[8], f32x4 (&acc)[4],
                                          const bf16* __restrict__ ZX, size_t row, int g, float Dk, int l, int wave, int fr, int fq, float& ss) {
    u32x2 zz[4];
#pragma unroll
    for (int ni = 0; ni < 4; ++ni) { const int ch = g * 256 + r * 64 + 16 * ni + 4 * fq; zz[ni] = *(const u32x2*)(ZX + row * ZXW + ch); }
    const float al = s_acs[r * 128 + l];
#pragma unroll
    for (int ni = 0; ni < 4; ++ni) acc[ni] = (f32x4){0.f, 0.f, 0.f, 0.f};
    const bf16* Hs = BH + hb * 64 * LDX;
#pragma unroll
    for (int ks = 0; ks < 4; ++ks) { const bf16x8 af = LFRAG(Cn, l, LDX, ks);
#pragma unroll
        for (int ni = 0; ni < 4; ++ni) { const bf16x8 bb = LFRAG(Hs, 16 * ni + fr, LDX, ks); acc[ni] = MFMA16(bb, af, acc[ni]); } }
    const float e = __expf(al);
#pragma unroll
    for (int ni = 0; ni < 4; ++ni) acc[ni] = acc[ni] * e;
#pragma unroll
    for (int ks = 0; ks < 4; ++ks) if (2 * ks <= wave) {
        unsigned mw[4];
#pragma unroll
        for (int hf = 0; hf < 2; ++hf) { const int ni = 2 * ks + hf, s0 = 16 * ni + 4 * fq;
            const f32x4 av = *(const f32x4*)(s_acs + r * 128 + s0), dv = *(const f32x4*)(s_dt + r * 128 + s0);
            float m[4];
#pragma unroll
            for (int j = 0; j < 4; ++j) m[j] = (s0 + j <= l) ? cb[ni][j] * __expf(al - av[j]) * dv[j] : 0.f;
            mw[2 * hf] = pkbf(m[0], m[1]); mw[2 * hf + 1] = pkbf(m[2], m[3]); }
        const u32x4 afu = (u32x4){mw[0], mw[1], mw[2], mw[3]};
        const bf16x8 af = __builtin_bit_cast(bf16x8, afu);
#pragma unroll
        for (int ni = 0; ni < 4; ++ni) { const int chl = r * 64 + 16 * ni + fr, sw = TSW(chl);
            const u32x2 b0 = *(const u32x2*)(Xt + chl * LDX + ((32 * ks + 4 * fq) ^ sw)), b1 = *(const u32x2*)(Xt + chl * LDX + ((32 * ks + 16 + 4 * fq) ^ sw));
            const u32x4 bu = (u32x4){b0.x, b0.y, b1.x, b1.y};
            acc[ni] = MFMA16(__builtin_bit_cast(bf16x8, bu), af, acc[ni]); }
    }
#pragma unroll
    for (int ni = 0; ni < 4; ++ni) {
        float xv[4];
#pragma unroll
        for (int j = 0; j < 4; ++j) { const int chl = r * 64 + 16 * ni + 4 * fq + j; xv[j] = bf2f(Xt[chl * LDX + (l ^ TSW(chl))]); }
        const float zv[4] = {bflo(zz[ni].x), bfhi(zz[ni].x), bflo(zz[ni].y), bfhi(zz[ni].y)};
#pragma unroll
        for (int j = 0; j < 4; ++j) { const float q = (acc[ni][j] + Dk * xv[j]) * zv[j] * sigmoid_f(zv[j]); acc[ni][j] = q; ss += q * q; } }
}
__device__ __forceinline__ void ssd3_unit(ArgsP a, int li, unsigned char* lds, const bf16* __restrict__ hs, int slot, int g, int R0, int len, int, int, int) {
    const int tid = ltid(), lane = tid & 63, wave = __builtin_amdgcn_readfirstlane(tid >> 6);
    const bf16* __restrict__ ZX = (const bf16*)(a->ws + WS_ZX); const float* __restrict__ DT = (const float*)(a->ws + WS_DT); bf16* __restrict__ YN = (bf16*)(a->ws + WS_YN);
    bf16* Cn = (bf16*)lds; bf16* BH = Cn + 128 * LDX; bf16* Xt = BH + 128 * LDX;
    float* s_dt = (float*)(Xt + 256 * LDX); float* s_acs = s_dt + 512;
    const int fr = lane & 15, fq = lane >> 4, h0 = g * 4;
    {
        const float* __restrict__ cw = a->in[I_ACONVW] + (size_t)li * 4 * CONVD; const float* __restrict__ cbias = a->in[I_ACONVB] + (size_t)li * CONVD;
        const bool meta = (slot == 128), chunk0 = (!meta && (slot & 63) == 0);
        const int half = tid >> 8, ncb = tid & 15, nrun = (tid >> 4) & 15, nc0 = (half ? 2048 : 3072) + g * 128 + ncb * 8;
        const int xcb = tid & 31, xrun = tid >> 5, xc0 = g * 256 + xcb * 8;
        u32x4 rn[11], rx[11];
        conv_load_run(ZX, R0 + 8 * nrun, nc0, (nrun == 0) ? (meta ? 2 : (chunk0 ? 1 : 0)) : 0, 8 * nrun < len, rn);
        conv_load_run(ZX, R0 + 8 * xrun, xc0, (xrun == 0) ? (meta ? 2 : (chunk0 ? 1 : 0)) : 0, 8 * xrun < len, rx);
        ssd_acs(DT, a->in[I_ALOG] + li * NHEADS, R0, len, h0, s_dt, s_acs, wave, lane);
        { ConvW W; conv_load_w(cw, cbias, nc0, W); conv_item_n(rn, W, half ? BH : Cn, nrun, ncb * 8); }
        { ConvW W; conv_load_w(cw, cbias, xc0, W); const float one[8] = {1.f, 1.f, 1.f, 1.f, 1.f, 1.f, 1.f, 1.f}; conv_item_t(rx, W, one, Xt, xcb * 8, xrun); }
        if (!meta && (slot & 63) == 63) {
            float* __restrict__ dst = a->out + O_PCONV + (size_t)((li * NPROMPT + (slot >> 6)) * 3) * CONVD;
            if (nrun == 15) conv_state_out(rn, dst + nc0);
            if (xrun == 15) conv_state_out(rx, dst + xc0);
        }
    }
    __syncthreads();
    u32x2 hv[8];
#pragma unroll
    for (int k = 0; k < 8; ++k) { const int item = tid + NTHREADS * k; hv[k] = (u32x2){0u, 0u}; if (hs) hv[k] = *(const u32x2*)(hs + (size_t)item * 4); }
    const bool active = (16 * wave < len);
    f32x4 cb[8];
#pragma unroll
    for (int ni = 0; ni < 8; ++ni) cb[ni] = (f32x4){0.f, 0.f, 0.f, 0.f};
    if (active) {
#pragma unroll
    for (int ks = 0; ks < 4; ++ks) { const bf16x8 af = LFRAG(Cn, 16 * wave + fr, LDX, ks);
#pragma unroll
        for (int ni = 0; ni < 8; ++ni) { const bf16x8 bb = LFRAG(BH, 16 * ni + fr, LDX, ks); cb[ni] = MFMA16(bb, af, cb[ni]); } }
    }
    __syncthreads();
#pragma unroll
    for (int k = 0; k < 8; ++k) { const int item = tid + NTHREADS * k, hp = item >> 5, n4 = item & 31; *(u32x2*)(BH + hp * LDX + n4 * 4) = hv[k]; }
#pragma unroll
    for (int k = 0; k < 8; ++k) { const int item = tid + NTHREADS * k; hv[k] = (u32x2){0u, 0u}; if (hs) hv[k] = *(const u32x2*)(hs + (size_t)(2 * 8192) + (size_t)item * 4); }
    __syncthreads();
    const int l = 16 * wave + fr;
    const size_t row = (size_t)(R0 + ((l < len) ? l : 0));
    f32x4 y0[4], y1[4], y2[4], y3[4];
    float ss = 0.f;
    const float* dsk = a->in[I_ADSKIP] + li * NHEADS + h0;
    if (active) {
    ssd3_head(0, 0, Cn, BH, Xt, s_dt, s_acs, cb, y0, ZX, row, g, dsk[0], l, wave, fr, fq, ss);
    ssd3_head(1, 1, Cn, BH, Xt, s_dt, s_acs, cb, y1, ZX, row, g, dsk[1], l, wave, fr, fq, ss);
    }
    __syncthreads();
#pragma unroll
    for (int k = 0; k < 8; ++k) { const int item = tid + NTHREADS * k, hp = item >> 5, n4 = item & 31; *(u32x2*)(BH + hp * LDX + n4 * 4) = hv[k]; }
    __syncthreads();
    if (active) {
    ssd3_head(2, 0, Cn, BH, Xt, s_dt, s_acs, cb, y2, ZX, row, g, dsk[2], l, wave, fr, fq, ss);
    ssd3_head(3, 1, Cn, BH, Xt, s_dt, s_acs, cb, y3, ZX, row, g, dsk[3], l, wave, fr, fq, ss);
    ss += __shfl_xor(ss, 16); ss += __shfl_xor(ss, 32);
    }
    const float rs = rsqrtf(ss * (1.f / 256.f) + EPS);
    if (active && l < len) {
        bf16* yrow = YN + row * DINNER + g * 256 + 4 * fq;
#pragma unroll
        for (int ni = 0; ni < 4; ++ni) {
            u32x2 w;
            w.x = pkbf(y0[ni][0] * rs, y0[ni][1] * rs); w.y = pkbf(y0[ni][2] * rs, y0[ni][3] * rs); *(u32x2*)(yrow + 0 * 64 + 16 * ni) = w;
            w.x = pkbf(y1[ni][0] * rs, y1[ni][1] * rs); w.y = pkbf(y1[ni][2] * rs, y1[ni][3] * rs); *(u32x2*)(yrow + 1 * 64 + 16 * ni) = w;
            w.x = pkbf(y2[ni][0] * rs, y2[ni][1] * rs); w.y = pkbf(y2[ni][2] * rs, y2[ni][3] * rs); *(u32x2*)(yrow + 2 * 64 + 16 * ni) = w;
            w.x = pkbf(y3[ni][0] * rs, y3[ni][1] * rs); w.y = pkbf(y3[ni][2] * rs, y3[ni][3] * rs); *(u32x2*)(yrow + 3 * 64 + 16 * ni) = w;
        }
    }
    __syncthreads();
}
__device__ __forceinline__ void phase_ssd1(ArgsP a, int li, unsigned char* lds, int tid, int wave, int lane) {
    const int c = blockIdx.x;
#pragma unroll 1
    for (int j = 0; j < 4; ++j) {
        const int u = c + 256 * j;
        f32x4 st[4][4];
        ssd_sample_issue(a, li, u >> 3, u & 7, st);
#ifndef PROBE_SSD1
#define PROBE_SSD1 0
#endif
#pragma unroll 1
        for (int rp = 0; rp < (PROBE_SSD1 == 1 ? 2 : 1); ++rp) { const int slot = u >> 3, g = u & 7; ssd1_unit(a, li, lds, slot, g, (slot >> 6) * SEQ + (slot & 63) * 128, 128, tid, wave, lane); }
        ssd_sample_unit(a, li, lds, u >> 3, u & 7, st);
    }
    if (c < 8) ssd1_unit(a, li, lds, 128, c, ROW_M, NMETA, tid, wave, lane);
    else if (c < 16) ssd3_unit(a, li, lds, nullptr, 128, c - 8, ROW_M, NMETA, tid, wave, lane);
}
__device__ __forceinline__ void phase_ssd3(ArgsP a, int li, unsigned char* lds, int tid, int wave, int lane) {
    const bf16* HSB = (const bf16*)(a->ws + WS_HSB);
#pragma unroll 1
    for (int u = blockIdx.x; u < 1024; u += gridDim.x) { const int slot = u >> 3, g = u & 7; ssd3_unit(a, li, lds, HSB + (size_t)(slot * 32 + g * 4) * 8192, slot, g, (slot >> 6) * SEQ + (slot & 63) * 128, 128, tid, wave, lane); }
}

constexpr int KS_LD = 72, VT_LD = 264, P_LD = 232, NKEYS = 208;
__device__ __forceinline__ void attn_prompt_unit(ArgsP a, int lj, unsigned char* lds, int b, int kvh, int qb, int, int, int) {
    const int tid = ltid(), lane = tid & 63, wave = __builtin_amdgcn_readfirstlane(tid >> 6);
    const bf16* __restrict__ Q = (const bf16*)(a->ws + WS_Q); const bf16* __restrict__ KV = (const bf16*)(a->ws + WS_KV); bf16* __restrict__ AO = (bf16*)(a->ws + WS_AO);
    bf16* Ks = (bf16*)lds; bf16* Vt = Ks + NKEYS * KS_LD; bf16* Pw = Vt + 64 * VT_LD + wave * 16 * P_LD;
    const int fr = lane & 15, fq = lane >> 4, t0 = qb * 64, Rb = b * SEQ;
    const int r = wave >> 1, th = (wave & 1) * 32, qh = kvh * 4 + r;
    bf16x8 q0[2], q1[2];
#pragma unroll
    for (int ks = 0; ks < 2; ++ks) { q0[ks] = *(const bf16x8*)(Q + (size_t)(Rb + t0 + th + fr) * DM + qh * 64 + 32 * ks + 8 * fq); q1[ks] = *(const bf16x8*)(Q + (size_t)(Rb + t0 + th + 16 + fr) * DM + qh * 64 + 32 * ks + 8 * fq); }
    {
        u32x4 kv[4];
#pragma unroll
        for (int k = 0; k < 4; ++k) { const int it = tid + NTHREADS * k, key = it >> 3, ch = it & 7; kv[k] = (u32x4){0u, 0u, 0u, 0u};
            if (it < NKEYS * 8) { int row; if (key < 16) row = ROW_M + key; else { int s = t0 - 128 + key - 16; if (s < 0) s = 0; row = Rb + s; }
                kv[k] = *(const u32x4*)(KV + (size_t)row * KVW + kvh * 64 + ch * 8); } }
        u32x4 v0[2], v1[2];
#pragma unroll
        for (int k = 0; k < 2; ++k) { const int it = tid + NTHREADS * k, dbl = it & 7, kp = it >> 3; v0[k] = (u32x4){0u, 0u, 0u, 0u}; v1[k] = v0[k];
            if (it < (NKEYS / 2) * 8) { const int k0 = 2 * kp, k1 = k0 + 1; int s0 = t0 - 128 + k0 - 16, s1 = t0 - 128 + k1 - 16; if (s0 < 0) s0 = 0; if (s1 < 0) s1 = 0;
                const int r0 = (k0 < 16) ? ROW_M + k0 : Rb + s0, r1 = (k1 < 16) ? ROW_M + k1 : Rb + s1;
                v0[k] = *(const u32x4*)(KV + (size_t)r0 * KVW + 256 + kvh * 64 + dbl * 8); v1[k] = *(const u32x4*)(KV + (size_t)r1 * KVW + 256 + kvh * 64 + dbl * 8); } }
#pragma unroll
        for (int k = 0; k < 4; ++k) { const int it = tid + NTHREADS * k, key = it >> 3, ch = it & 7; if (it < NKEYS * 8) *(u32x4*)(Ks + key * KS_LD + ch * 8) = kv[k]; }
#pragma unroll
        for (int k = 0; k < 2; ++k) { const int it = tid + NTHREADS * k, dbl = it & 7, kp = it >> 3;
            if (it < (NKEYS / 2) * 8) { const int col = (2 * kp) ^ (8 * dbl);
                const unsigned a0[4] = {v0[k].x, v0[k].y, v0[k].z, v0[k].w}, a1[4] = {v1[k].x, v1[k].y, v1[k].z, v1[k].w};
#pragma unroll
                for (int j = 0; j < 4; ++j) {
                    *(unsigned*)(Vt + (dbl * 8 + 2 * j) * VT_LD + col) = (a0[j] & 0xffffu) | (a1[j] << 16);
                    *(unsigned*)(Vt + (dbl * 8 + 2 * j + 1) * VT_LD + col) = (a0[j] >> 16) | (a1[j] & 0xffff0000u); } } }
#pragma unroll
        for (int k = 0; k < 3; ++k) { const int idx = tid + NTHREADS * k, row = idx / 24, c = idx - row * 24; *(unsigned*)(Vt + row * VT_LD + ((NKEYS + 2 * c) ^ TSW(row))) = 0u; }
    }
    __syncthreads();
    const float sink = a->in[I_SINKS][lj * NQ + qh];
#pragma unroll 1
    for (int blk = 0; blk < 2; ++blk) {
        const int tq = th + blk * 16 + fr, t = t0 + tq;
        bf16x8 qa2[2];
#pragma unroll
        for (int ks = 0; ks < 2; ++ks) qa2[ks] = (blk == 0) ? q0[ks] : q1[ks];
        f32x4 sc[13];
#pragma unroll
        for (int ni = 0; ni < 13; ++ni) sc[ni] = (f32x4){0.f, 0.f, 0.f, 0.f};
#pragma unroll
        for (int ni = 0; ni < 13; ++ni) {
            const bf16x8 b0 = *(const bf16x8*)(Ks + (16 * ni + fr) * KS_LD + 8 * fq), b1 = *(const bf16x8*)(Ks + (16 * ni + fr) * KS_LD + 32 + 8 * fq);
            sc[ni] = MFMA16(b0, qa2[0], sc[ni]); sc[ni] = MFMA16(b1, qa2[1], sc[ni]);
            }
        int lo = tq + 17; { const int l2 = 144 - t0; if (l2 > lo) lo = l2; }
        const unsigned span = (unsigned)(tq + 144 - lo);
        float mx = -INFINITY;
#pragma unroll
        for (int ni = 0; ni < 13; ++ni)
#pragma unroll
            for (int j = 0; j < 4; ++j) { const int key = 16 * ni + 4 * fq + j; const bool vis = (ni == 0) || ((unsigned)(key - lo) <= span);
                const float v = vis ? sc[ni][j] * 0.125f : -INFINITY; sc[ni][j] = v; mx = fmaxf(mx, v); }
        mx = fmaxf(mx, __shfl_xor(mx, 16)); mx = fmaxf(mx, __shfl_xor(mx, 32)); mx = fmaxf(mx, sink);
        float sum = 0.f;
#pragma unroll
        for (int ni = 0; ni < 13; ++ni)
#pragma unroll
            for (int j = 0; j < 4; ++j) { const float p = __expf(sc[ni][j] - mx); sc[ni][j] = p; sum += p; }
        sum += __shfl_xor(sum, 16); sum += __shfl_xor(sum, 32); sum += __expf(sink - mx);
        const float inv = frcp(sum);
#pragma unroll
        for (int ni = 0; ni < 13; ++ni) { u32x2 w; w.x = pkbf(sc[ni][0] * inv, sc[ni][1] * inv); w.y = pkbf(sc[ni][2] * inv, sc[ni][3] * inv); *(u32x2*)(Pw + fr * P_LD + 16 * ni + 4 * fq) = w; }
        *(u32x2*)(Pw + fr * P_LD + NKEYS + 4 * fq) = (u32x2){0u, 0u};
        asm volatile("s_waitcnt lgkmcnt(0)" ::: "memory");
        f32x4 o[4];
#pragma unroll
        for (int ni = 0; ni < 4; ++ni) o[ni] = (f32x4){0.f, 0.f, 0.f, 0.f};
#pragma unroll
        for (int ks = 0; ks < 7; ++ks) { const bf16x8 af = *(const bf16x8*)(Pw + fr * P_LD + 32 * ks + 8 * fq);
#pragma unroll
            for (int ni = 0; ni < 4; ++ni) { const int vr = 16 * ni + fr; const bf16x8 bb = *(const bf16x8*)(Vt + vr * VT_LD + ((32 * ks + 8 * fq) ^ TSW(vr))); o[ni] = MFMA16(bb, af, o[ni]); }
            }
#pragma unroll
        for (int ni = 0; ni < 4; ++ni) { u32x2 w; w.x = pkbf(o[ni][0], o[ni][1]); w.y = pkbf(o[ni][2], o[ni][3]); *(u32x2*)(AO + (size_t)(Rb + t) * DM + qh * 64 + 16 * ni + 4 * fq) = w; }
        asm volatile("s_waitcnt lgkmcnt(0)" ::: "memory");
    }
    __syncthreads();
}
constexpr int SK_LD = 72, SV_LD = 200, SP_LD = 168, SKEYS = 160;
__device__ __forceinline__ void attn_sample_pair(ArgsP a, int lj, unsigned char* lds, int bp, int kvh, int, int, int) {
    const int tid = ltid(), lane = tid & 63, wave = __builtin_amdgcn_readfirstlane(tid >> 6);
    const bf16* __restrict__ Q = (const bf16*)(a->ws + WS_Q); const bf16* __restrict__ KV = (const bf16*)(a->ws + WS_KV); bf16* __restrict__ AO = (bf16*)(a->ws + WS_AO);
    const float* __restrict__ CK = a->in[I_CK]; const float* __restrict__ CV = a->in[I_CV];
    constexpr int HALF_B = (SKEYS * SK_LD + 64 * SV_LD) * 2;
    const int fr = lane & 15, fq = lane >> 4;
#pragma unroll 1
    for (int it = tid; it < 2 * SKEYS * 8; it += NTHREADS) { const int hf = it / (SKEYS * 8), rem = it - hf * (SKEYS * 8), key = rem >> 3, ch = rem & 7, bb = 2 * bp + hf;
        bf16* Ks = (bf16*)(lds + hf * HALF_B);
        u32x4 w = (u32x4){0u, 0u, 0u, 0u};
        if (key < 16) w = *(const u32x4*)(KV + (size_t)(ROW_M + key) * KVW + kvh * 64 + ch * 8);
        else if (key < 144) { const float* p = CK + ((size_t)(bb * 128 + (key - 16)) * NKV + kvh) * 64 + ch * 8; const f32x4 x0 = *(const f32x4*)p, x1 = *(const f32x4*)(p + 4);
            w.x = pkbf(x0.x, x0.y); w.y = pkbf(x0.z, x0.w); w.z = pkbf(x1.x, x1.y); w.w = pkbf(x1.z, x1.w); }
        else if (key < 152) w = *(const u32x4*)(KV + (size_t)(ROW_S + bb * 8 + (key - 144)) * KVW + kvh * 64 + ch * 8);
        *(u32x4*)(Ks + key * SK_LD + ch * 8) = w; }
#pragma unroll 1
    for (int it = tid; it < 2 * 96 * 8; it += NTHREADS) { const int hf = it / (96 * 8), rem = it - hf * (96 * 8), dbl = rem & 7, kp = rem >> 3, bb = 2 * bp + hf;
        bf16* Vt = (bf16*)(lds + hf * HALF_B) + SKEYS * SK_LD;
        unsigned a0[4] = {0u, 0u, 0u, 0u}, a1[4] = {0u, 0u, 0u, 0u};
        const int k0 = 2 * kp;
        if (k0 < 16) { const u32x4 x = *(const u32x4*)(KV + (size_t)(ROW_M + k0) * KVW + 256 + kvh * 64 + dbl * 8), y = *(const u32x4*)(KV + (size_t)(ROW_M + k0 + 1) * KVW + 256 + kvh * 64 + dbl * 8);
            a0[0] = x.x; a0[1] = x.y; a0[2] = x.z; a0[3] = x.w; a1[0] = y.x; a1[1] = y.y; a1[2] = y.z; a1[3] = y.w; }
        else if (k0 < 144) { const float* p = CV + ((size_t)(bb * 128 + (k0 - 16)) * NKV + kvh) * 64 + dbl * 8; const f32x4 x0 = *(const f32x4*)p, x1 = *(const f32x4*)(p + 4), y0 = *(const f32x4*)(p + NKV * 64), y1 = *(const f32x4*)(p + NKV * 64 + 4);
            a0[0] = pkbf(x0.x, x0.y); a0[1] = pkbf(x0.z, x0.w); a0[2] = pkbf(x1.x, x1.y); a0[3] = pkbf(x1.z, x1.w); a1[0] = pkbf(y0.x, y0.y); a1[1] = pkbf(y0.z, y0.w); a1[2] = pkbf(y1.x, y1.y); a1[3] = pkbf(y1.z, y1.w); }
        else if (k0 < 152) { const u32x4 x = *(const u32x4*)(KV + (size_t)(ROW_S + bb * 8 + (k0 - 144)) * KVW + 256 + kvh * 64 + dbl * 8), y = *(const u32x4*)(KV + (size_t)(ROW_S + bb * 8 + (k0 - 143)) * KVW + 256 + kvh * 64 + dbl * 8);
            a0[0] = x.x; a0[1] = x.y; a0[2] = x.z; a0[3] = x.w; a1[0] = y.x; a1[1] = y.y; a1[2] = y.z; a1[3] = y.w; }
        const int col = (2 * kp) ^ (8 * dbl);
#pragma unroll
        for (int j = 0; j < 4; ++j) {
            *(unsigned*)(Vt + (dbl * 8 + 2 * j) * SV_LD + col) = (a0[j] & 0xffffu) | (a1[j] << 16);
            *(unsigned*)(Vt + (dbl * 8 + 2 * j + 1) * SV_LD + col) = (a0[j] >> 16) | (a1[j] & 0xffff0000u); } }
    if (lj == 0) {
#pragma unroll 1
        for (int it = tid; it < 2 * 128 * 16; it += NTHREADS) { const int hf = it >> 11, rem = it & 2047, w = rem >> 4, c4 = (rem & 15) * 4, bb = 2 * bp + hf;
            const size_t o = ((size_t)(bb * 128 + w) * NKV + kvh) * 64 + c4;
            f32x4 kx, vx;
            if (w < 120) { const size_t i = ((size_t)(bb * 128 + w + 8) * NKV + kvh) * 64 + c4; kx = *(const f32x4*)(CK + i); vx = *(const f32x4*)(CV + i); }
            else { const bf16* rp = KV + (size_t)(ROW_S + bb * 8 + (w - 120)) * KVW + kvh * 64 + c4; const u32x2 k2 = *(const u32x2*)rp, v2 = *(const u32x2*)(rp + 256);
                kx = (f32x4){bflo(k2.x), bfhi(k2.x), bflo(k2.y), bfhi(k2.y)}; vx = (f32x4){bflo(v2.x), bfhi(v2.x), bflo(v2.y), bfhi(v2.y)}; }
            *(f32x4*)(a->out + O_SCK + o) = kx; *(f32x4*)(a->out + O_SCV + o) = vx; }
    }
    __syncthreads();
    if (wave < 4) {
        const int hf = wave >> 1, rb = wave & 1, bb = 2 * bp + hf;
        const bf16* Ks = (const bf16*)(lds + hf * HALF_B); const bf16* Vt = Ks + SKEYS * SK_LD; bf16* Pw = (bf16*)(lds + 2 * HALF_B) + wave * 16 * SP_LD;
        const int r = 2 * rb + (fr >> 3), t = fr & 7, qh = kvh * 4 + r;
        const size_t qrow = (size_t)(ROW_S + bb * 8 + t);
        bf16x8 qa[2];
        if (lj == 0) {
#pragma unroll
            for (int ks = 0; ks < 2; ++ks) qa[ks] = *(const bf16x8*)(Q + qrow * DM + qh * 64 + 32 * ks + 8 * fq);
        } else {
            const float* __restrict__ SL = (const float*)(a->ws + WS_SLAB) + (size_t)(qrow - ROW_S) * DM + qh * 64 + 8 * fq;
#pragma unroll
            for (int ks = 0; ks < 2; ++ks) { f32x4 x0 = (f32x4){0.f, 0.f, 0.f, 0.f}, x1 = x0;
#pragma unroll
                for (int sl = 0; sl < 4; ++sl) { const float* p = SL + (size_t)sl * (1280 * 1024) + 32 * ks; x0 = x0 + *(const f32x4*)p; x1 = x1 + *(const f32x4*)(p + 4); }
                const u32x4 w = (u32x4){pkbf(x0.x, x0.y), pkbf(x0.z, x0.w), pkbf(x1.x, x1.y), pkbf(x1.z, x1.w)}; qa[ks] = __builtin_bit_cast(bf16x8, w); }
        }
        const float sink = a->in[I_SINKS][lj * NQ + qh];
        f32x4 sc[10];
#pragma unroll
        for (int ni = 0; ni < 10; ++ni) sc[ni] = (f32x4){0.f, 0.f, 0.f, 0.f};
#pragma unroll
        for (int ni = 0; ni < 10; ++ni) {
            const bf16x8 b0 = *(const bf16x8*)(Ks + (16 * ni + fr) * SK_LD + 8 * fq), b1 = *(const bf16x8*)(Ks + (16 * ni + fr) * SK_LD + 32 + 8 * fq);
            sc[ni] = MFMA16(b0, qa[0], sc[ni]); sc[ni] = MFMA16(b1, qa[1], sc[ni]); }
        float mx = -INFINITY;
#pragma unroll
        for (int ni = 0; ni < 10; ++ni)
#pragma unroll
            for (int j = 0; j < 4; ++j) { const int key = 16 * ni + 4 * fq + j;
                const bool vis = (ni == 0) || ((key < 144) ? (key - 16 > t) : (key - 144 <= t));
                const float v = vis ? sc[ni][j] * 0.125f : -INFINITY; sc[ni][j] = v; mx = fmaxf(mx, v); }
        mx = fmaxf(mx, __shfl_xor(mx, 16)); mx = fmaxf(mx, __shfl_xor(mx, 32)); mx = fmaxf(mx, sink);
        float sum = 0.f;
#pragma unroll
        for (int ni = 0; ni < 10; ++ni)
#pragma unroll
            for (int j = 0; j < 4; ++j) { const float p = __expf(sc[ni][j] - mx); sc[ni][j] = p; sum += p; }
        sum += __shfl_xor(sum, 16); sum += __shfl_xor(sum, 32); sum += __expf(sink - mx);
        const float inv = frcp(sum);
#pragma unroll
        for (int ni = 0; ni < 10; ++ni) { u32x2 w; w.x = pkbf(sc[ni][0] * inv, sc[ni][1] * inv); w.y = pkbf(sc[ni][2] * inv, sc[ni][3] * inv); *(u32x2*)(Pw + fr * SP_LD + 16 * ni + 4 * fq) = w; }
        asm volatile("s_waitcnt lgkmcnt(0)" ::: "memory");
        f32x4 o[4];
#pragma unroll
        for (int ni = 0; ni < 4; ++ni) o[ni] = (f32x4){0.f, 0.f, 0.f, 0.f};
#pragma unroll
        for (int ks = 0; ks < 5; ++ks) { const bf16x8 af = *(const bf16x8*)(Pw + fr * SP_LD + 32 * ks + 8 * fq);
#pragma unroll
            for (int ni = 0; ni < 4; ++ni) { const int vr = 16 * ni + fr; const bf16x8 bb2 = *(const bf16x8*)(Vt + vr * SV_LD + ((32 * ks + 8 * fq) ^ TSW(vr))); o[ni] = MFMA16(bb2, af, o[ni]); } }
#pragma unroll
        for (int ni = 0; ni < 4; ++ni) { u32x2 w; w.x = pkbf(o[ni][0], o[ni][1]); w.y = pkbf(o[ni][2], o[ni][3]); *(u32x2*)(AO + qrow * DM + qh * 64 + 16 * ni + 4 * fq) = w; }
    }
    __syncthreads();
}
__device__ __forceinline__ void phase_attn(ArgsP a, int lj, unsigned char* lds, int tid, int wave, int lane) {
    if (lj == 0) {
        const bf16* KV = (const bf16*)(a->ws + WS_KV);
        const int gt = blockIdx.x * NTHREADS + tid, NT = gridDim.x * NTHREADS;
        for (int e = gt; e < 2 * 128 * 512; e += NT) { const int b = e >> 16, w = (e >> 9) & 127, c = e & 511;
            const float v = bf2f(KV[(size_t)(b * SEQ + SEQ - 128 + w) * KVW + c]);
            if (c < 256) a->out[O_PCK + (size_t)(b * 128 + w) * 256 + c] = v; else a->out[O_PCV + (size_t)(b * 128 + w) * 256 + (c - 256)] = v; }
    }
#pragma unroll 1
    for (int u = blockIdx.x; u < 1024 + 256; u += gridDim.x) {
        if (u < 1024) { const int qb = u & 127, kvh = (u >> 7) & 3, b = u >> 9; attn_prompt_unit(a, lj, lds, b, kvh, qb, tid, wave, lane); }
        else { const int su = u - 1024; attn_sample_pair(a, lj, lds, su >> 2, su & 3, tid, wave, lane); }
    }
}

constexpr int PH_B = 9 * 2, PH_F = PH_B + 7 * 2, NPHASES = PH_F + 1;
template <class Epi> __device__ __forceinline__ void run_gemm(LAS unsigned char* lds, const bf16* A, const bf16* Bt, int N, int K, const Epi& E) {
    pg8::Gemm g{A, Bt, MP, N, K}; pg8::StaticOrder S; S.init(MP, N, K, (int)gridDim.x, (int)blockIdx.x);
    pg8::gemm_phase<Epi, pg8::StaticOrder, true, true>(lds, g, S, E);
}
template <class Epi> __device__ __forceinline__ void run_gemm_res(LAS unsigned char* lds, const bf16* A, const bf16* Bt, int K, int S_, const Epi& E) {
    pg8::Gemm g{A, Bt, MP, 1024, K}; pg8::ResOrder S; S.init(K, S_, (int)gridDim.x, (int)blockIdx.x);
    pg8::gemm_phase<Epi, pg8::ResOrder, true, true>(lds, g, S, E);
}

__global__ void __launch_bounds__(NTHREADS, 2) yoco_fwd(Args args) {
    extern __shared__ __attribute__((aligned(16))) unsigned char lds[];
    LAS unsigned char* ldsl = (LAS unsigned char*)lds;
    const int tid0 = threadIdx.x;
    for (int u = tid0; u < (LDS_BYTES - LDSCTL_OFF) / 4; u += NTHREADS) ((LAS unsigned*)(ldsl + LDSCTL_OFF))[u] = 0u;
    __syncthreads();
    const int lo = args.ph_lo, hi = args.ph_hi;
    XcdBarrier bar; bar.bar = (unsigned*)(args.ws + WS_CTL) + CW_BAR; bar.x = 0; bar.st = nullptr;
    if (hi - lo > 1) bar = xcd_barrier_post((unsigned*)(args.ws + WS_CTL) + CW_BAR, (volatile LAS unsigned*)(ldsl + MISC_OFF) + 8);
    int rep = 0;
#pragma unroll 1
    for (int p = lo; p < hi;) {
        ArgsP la = (ArgsP)__builtin_amdgcn_kernarg_segment_ptr(); asm volatile("" : "+s"(la));
        unsigned char* ws = la->ws;
        const int tid = ltid();
        const int lane = tid & 63, wave = __builtin_amdgcn_readfirstlane(tid >> 6);
        bf16* HN = (bf16*)(ws + WS_HN); float* H = (float*)(ws + WS_H);
        int kind, li = 0, lj = 0, layer = 0;
        int nslab = 8;
        if (p == 0) kind = 0;
        else if (p < PH_B) { li = p / 9; layer = li; const int sub = p % 9;
            kind = (sub == 0) ? 1 : (sub == 1) ? 3 : (sub == 2) ? 5 : (sub == 3) ? 6 : (sub == 4) ? 7 : (sub == 5) ? 8 : (sub == 6) ? 1 : (sub == 7) ? 9 : 10; }
        else if (p < PH_F) { lj = (p - PH_B) / 7; layer = 2 + lj; const int sub = (p - PH_B) % 7;
            kind = (sub == 0) ? 1 : (sub == 1) ? 11 : (sub == 2) ? 12 : (sub == 3) ? 13 : (sub == 4) ? 1 : (sub == 5) ? 9 : 10; if (sub == 4) nslab = 4; }
        else kind = 14;
#ifndef KMASK
#define KMASK 0xffff
#endif
#define KON(k) ((KMASK >> (k)) & 1)
#ifndef REP_MASK
#define REP_MASK 0
#endif
        if (KON(0) && kind == 0) { phase_prologue(la, ldsl, wave, lane); phase_norm(la, 1, 0, wave, lane); }
        else if (KON(1) && kind == 1) phase_norm(la, 0, nslab, wave, lane);
        else if (KON(3) && kind == 3) { pg8::EpiInProj E{(bf16*)(ws + WS_ZX), (float*)(ws + WS_DT), la->in[I_ADTB] + li * NHEADS}; run_gemm(ldsl, HN, (const bf16*)(ws + WS_WIN + li * SZ_WIN), INPROJ_P, 1024, E); }
        else if (KON(5) && kind == 5) phase_ssd1(la, li, lds, tid, wave, lane);
        else if (KON(6) && kind == 6) phase_scan(la, li);
        else if (KON(7) && kind == 7) phase_ssd3(la, li, lds, tid, wave, lane);
        else if (KON(8) && (kind == 8 || kind == 10 || kind == 13)) {
            const bf16* A; const bf16* Bt; int K;
            if (kind == 8) { A = (const bf16*)(ws + WS_YN); Bt = (const bf16*)(ws + WS_WOUT + li * SZ_WOUT); K = 2048; }
            else if (kind == 10) { A = (const bf16*)(ws + WS_U); Bt = (const bf16*)(ws + WS_WDN + layer * SZ_WDN); K = 4096; }
            else { A = (const bf16*)(ws + WS_AO); Bt = (const bf16*)(ws + WS_WO + lj * SZ_WO); K = 1024; }
            pg8::EpiRes E{(kind == 8 && li == 0) ? la->in[I_XP] : (const float*)H, H, (float*)(ws + WS_SLAB)}; run_gemm_res(ldsl, A, Bt, K, K == 1024 ? 4 : 8, E); }
        else if (KON(9) && kind == 9) { pg8::EpiBf<1> E{(bf16*)(ws + WS_U), 4096, 1 << 20, nullptr, 0}; run_gemm(ldsl, HN, (const bf16*)(ws + WS_WUP + layer * SZ_WUP), 4096, 1024, E); }
        else if (KON(11) && kind == 11) { pg8::EpiBf<0> E{(bf16*)(ws + WS_Q), 1024, 4, (bf16*)(ws + WS_KV), KVW};
            if (lj == 0) run_gemm(ldsl, HN, (const bf16*)(ws + WS_WQKV0), 1536, 1024, E);
            else { pg8::EpiQSplit E2{(bf16*)(ws + WS_Q), (float*)(ws + WS_SLAB)}; run_gemm_res(ldsl, HN, (const bf16*)(ws + WS_WQ1), 1024, 4, E2); } }
        else if (KON(12) && kind == 12) phase_attn(la, lj, lds, tid, wave, lane);
        else if (KON(14) && kind == 14) phase_final(la, wave, lane);
        bool again = false;
        if (REP_MASK != 0) { if (rep == 0 && ((REP_MASK >> kind) & 1)) { rep = 1; again = true; } else rep = 0; }
#ifdef PROBE_DOUBLE_BARRIER
        if (p + 1 < hi || again) xcd_barrier(bar);
#endif
        if (p + 1 < hi || again) xcd_barrier(bar); else { asm volatile("s_waitcnt vmcnt(0)" ::: "memory"); __syncthreads(); }
        if (!again) ++p;
    }
}

#ifndef MK_PER_PHASE
#define MK_PER_PHASE 0
#endif
extern "C" void kernel_launch(void* const* d_in, const int* in_sizes, int n_in, void* d_out, int out_size, void* d_ws, size_t ws_size, hipStream_t stream) {
    static int grid = 0;
    if (grid == 0) {
        if (n_in != 26 || (size_t)out_size != O_END || ws_size < WS_END) { fprintf(stderr, "kernel_launch: unexpected problem (n_in %d, out %d vs %zu, ws %zu vs %zu); nothing launched\n", n_in, out_size, (size_t)O_END, ws_size, (size_t)WS_END); grid = -1; return; }
        int dev = 0, cus = 0, per_cu = 0;
        if (hipGetDevice(&dev) != hipSuccess || hipDeviceGetAttribute(&cus, hipDeviceAttributeMultiprocessorCount, dev) != hipSuccess) { grid = -1; return; }
        if (hipFuncSetAttribute((const void*)yoco_fwd, hipFuncAttributeMaxDynamicSharedMemorySize, LDS_BYTES) != hipSuccess) { fprintf(stderr, "kernel_launch: hipFuncSetAttribute failed\n"); grid = -1; return; }
        if (hipOccupancyMaxActiveBlocksPerMultiprocessor(&per_cu, (const void*)yoco_fwd, NTHREADS, LDS_BYTES) != hipSuccess || per_cu < 1) { fprintf(stderr, "kernel_launch: occupancy query says %d\n", per_cu); per_cu = 1; }
        (void)hipGetLastError();
        if (cus != 256) { fprintf(stderr, "kernel_launch: built for a 256-CU device (got %d); nothing launched\n", cus); grid = -1; return; }
        grid = cus;
    }
    if (grid < 0) return;
    if (hipMemsetAsync((char*)d_ws + WS_CTL, 0, CTL_ZERO_BYTES, stream) != hipSuccess) { fprintf(stderr, "kernel_launch: memset failed\n"); return; }
    Args a{};
    for (int i = 0; i < 26; ++i) a.in[i] = (const float*)d_in[i];
    a.out = (float*)d_out; a.ws = (unsigned char*)d_ws;
#if MK_PER_PHASE
    for (int p = 0; p < NPHASES; ++p) { a.ph_lo = p; a.ph_hi = p + 1; hipLaunchKernelGGL(yoco_fwd, dim3(grid), dim3(NTHREADS), LDS_BYTES, stream, a); }
#else
    a.ph_lo = 0; a.ph_hi = NPHASES;
    void* kargs[] = {&a};
    hipError_t e = hipLaunchCooperativeKernel((const void*)yoco_fwd, dim3(grid), dim3(NTHREADS), kargs, LDS_BYTES, stream);
    if (e != hipSuccess) fprintf(stderr, "kernel_launch: cooperative launch failed: %s (grid %d)\n", hipGetErrorString(e), grid);
#endif
}
```

```cpp
#include <hip/hip_runtime.h>
#include <cstdio>
#include <cstdint>
#include <cmath>
namespace pg8 {
#define PG8_LAS __attribute__((address_space(3)))
typedef unsigned short bf16_t;
typedef short bf16x8 __attribute__((ext_vector_type(8)));
typedef float f32x4 __attribute__((ext_vector_type(4)));
typedef unsigned u32x4 __attribute__((ext_vector_type(4)));
constexpr int BM = 256, BK = 64, HALF = 128, HTB = HALF * BK * 2  , STAGE_BYTES = 8 * HTB, NXCD = 8, WGM = 8;

__host__ __device__ __forceinline__ int lds_byte(int r, int c) { const int st = (r >> 4) * 2 + (c >> 5), rr = r & 15, cc = c & 31, ob = rr * 64 + cc * 2; return st * 1024 + (ob ^ (((ob >> 9) & 1) << 5)); }
__host__ __device__ __forceinline__ void stage_rc(int b, int& R, int& C) { const int st = b / 1024, sb = b % 1024, swz = sb ^ (((sb >> 9) & 1) << 5); R = (st >> 1) * 16 + swz / 64; C = (st & 1) * 32 + (swz % 64) / 2; }
__host__ __device__ __forceinline__ int perm32(int rho) { const int n = rho >> 4, i = rho & 15; return 8 * (i >> 2) + 4 * n + (i & 3); }

struct Unit { int pm, pn, k0, nt, aux; };
struct Gemm { const bf16_t* A; const bf16_t* Bt; int M, N, K; };

struct StaticOrder {
    int nM, nN, nwg, G, c, nt0;
    __host__ __device__ void init(int M, int N, int K, int G_, int c_) { nM = M / BM; nN = N / BM; nwg = nM * nN; G = G_; c = c_; nt0 = K / BK; }
    __host__ __device__ bool next(int i, Unit& u) const {
        const long L = (long)i * G + c; if (L >= nwg) return false;
        int wgid = (int)L; { const int q = nwg / NXCD, r = nwg % NXCD, xcd = wgid % NXCD, off = wgid / NXCD; wgid = (xcd < r ? xcd * (q + 1) : r * (q + 1) + (xcd - r) * q) + off; }
        const int nig = WGM * nN, gid = wgid / nig, fm = gid * WGM, gsz = (nM - fm) < WGM ? (nM - fm) : WGM;
        u.pm = fm + ((wgid % nig) % gsz); u.pn = (wgid % nig) / gsz; u.k0 = 0; u.nt = nt0; u.aux = -1; return true;
    }
    __device__ __forceinline__ void a_ready(const Unit&) const {}
    __device__ __forceinline__ void done(const Unit&) const {}
};
struct ResOrder {
    StaticOrder so; int S, K, c;
    __host__ __device__ void init(int K_, int S_, int G_, int c_) { so.init(64 * BM, 1024, K_, G_, c_); S = S_; K = K_; c = c_; }
    __host__ __device__ bool next(int i, Unit& u) const {
        if (i == 0) return so.next(0, u);
        if (i == 1 && c < 20 * S) { const int t = c / S, sl = c - t * S; u.pm = 64 + (t >> 2); u.pn = t & 3; u.k0 = sl * (K / S); u.nt = K / S / BK; u.aux = sl; return true; }
        return false;
    }
    __device__ __forceinline__ void a_ready(const Unit&) const {}
    __device__ __forceinline__ void done(const Unit&) const {}
};

typedef float f32x2_cv0 __attribute__((ext_vector_type(2))); typedef __bf16 bf16x2_cv0 __attribute__((ext_vector_type(2)));
__device__ __forceinline__ unsigned cvt_pk_bf16(float lo, float hi) { const f32x2_cv0 v = {lo, hi}; const bf16x2_cv0 b = __builtin_convertvector(v, bf16x2_cv0); return __builtin_bit_cast(unsigned, b); }
typedef float f32x2 __attribute__((ext_vector_type(2)));
typedef unsigned u32x2 __attribute__((ext_vector_type(2)));
__device__ __forceinline__ float softplus_f(float x) { const float y = __expf(-fabsf(x)); const float l = (y < 0.03125f) ? y * (1.f - y * (0.5f - y * (1.f / 3.f - 0.25f * y))) : __logf(1.f + y); return fmaxf(x, 0.f) + l; }
struct EpiInProj {
    static constexpr bool PERM = true, AFTER_DRAIN = false;
    bf16_t* ZX; float* DT; const float* dt_bias;
    __device__ __forceinline__ void operator()(const f32x4 (&acc)[2][2][4][2], const Unit& u, int wr, int wc, int fr, int fq) const {
        const int row0 = u.pm * BM + wr * 64 + fr;
        if (u.pn < 24) {
            const int col0 = u.pn * BM + wc * 32 + 8 * fq;
#pragma unroll
            for (int ai = 0; ai < 2; ++ai)
#pragma unroll
                for (int m = 0; m < 4; ++m) { bf16_t* rowp = ZX + (size_t)(row0 + ai * HALF + m * 16) * 6144 + col0;
#pragma unroll
                    for (int bj = 0; bj < 2; ++bj) { const f32x4 v0 = acc[ai][bj][m][0], v1 = acc[ai][bj][m][1];
                        u32x4 w; w.x = cvt_pk_bf16(v0[0], v0[1]); w.y = cvt_pk_bf16(v0[2], v0[3]); w.z = cvt_pk_bf16(v1[0], v1[1]); w.w = cvt_pk_bf16(v1[2], v1[3]);
                        *(u32x4*)(rowp + bj * HALF) = w; } }
        } else if (wc == 0) {
            const int c0 = 8 * fq;
            const f32x4 b0 = *(const f32x4*)(dt_bias + c0), b1 = *(const f32x4*)(dt_bias + c0 + 4);
#pragma unroll
            for (int ai = 0; ai < 2; ++ai)
#pragma unroll
                for (int m = 0; m < 4; ++m) { float* rowp = DT + (size_t)(row0 + ai * HALF + m * 16) * 32 + c0;
                    const f32x4 v0 = acc[ai][0][m][0] + b0, v1 = acc[ai][0][m][1] + b1;
                    f32x4 o0, o1;
#pragma unroll
                    for (int j = 0; j < 4; ++j) { o0[j] = softplus_f(v0[j]); o1[j] = softplus_f(v1[j]); }
                    *(f32x4*)(rowp) = o0; *(f32x4*)(rowp + 4) = o1; }
        }
    }
};
struct EpiRes {
    static constexpr bool PERM = false, AFTER_DRAIN = false;
    const float* B; float* H; float* SLAB;
    __device__ __forceinline__ void operator()(const f32x4 (&acc)[2][2][4][2], const Unit& u, int wr, int wc, int fr, int fq) const {
        const int row0 = u.pm * BM + wr * 64 + fr, col0 = u.pn * BM + wc * 32 + 4 * fq;
        if (u.aux >= 0) {
            float* base = SLAB + (size_t)u.aux * (1280 * 1024) + (size_t)(row0 - 16384) * 1024 + col0;
#pragma unroll
            for (int ai = 0; ai < 2; ++ai)
#pragma unroll
                for (int m = 0; m < 4; ++m) { float* rowp = base + (size_t)(ai * HALF + m * 16) * 1024;
#pragma unroll
                    for (int bj = 0; bj < 2; ++bj)
#pragma unroll
                        for (int n = 0; n < 2; ++n) *(f32x4*)(rowp + bj * HALF + n * 16) = acc[ai][bj][m][n]; }
            return;
        }
#pragma unroll
        for (int ai = 0; ai < 2; ++ai)
#pragma unroll
            for (int m = 0; m < 4; ++m) { const size_t off = (size_t)(row0 + ai * HALF + m * 16) * 1024 + col0;
                if (B == H) {
                    float* rowp = H + off;
#pragma unroll
                    for (int bj = 0; bj < 2; ++bj)
#pragma unroll
                        for (int n = 0; n < 2; ++n) { f32x4* p = (f32x4*)(rowp + bj * HALF + n * 16); *p = *p + acc[ai][bj][m][n]; }
                } else {
                    f32x4 bv[2][2];
#pragma unroll
                    for (int bj = 0; bj < 2; ++bj)
#pragma unroll
                        for (int n = 0; n < 2; ++n) bv[bj][n] = *(const f32x4*)(B + off + bj * HALF + n * 16);
#pragma unroll
                    for (int bj = 0; bj < 2; ++bj)
#pragma unroll
                        for (int n = 0; n < 2; ++n) *(f32x4*)(H + off + bj * HALF + n * 16) = bv[bj][n] + acc[ai][bj][m][n];
                } }
    }
};
template <int ACT> struct EpiBf {
    static constexpr bool PERM = true, AFTER_DRAIN = false;
    bf16_t* O0; int ldc0; int nsplit; bf16_t* O1; int ldc1;
    __device__ __forceinline__ void operator()(const f32x4 (&acc)[2][2][4][2], const Unit& u, int wr, int wc, int fr, int fq) const {
        const int row0 = u.pm * BM + wr * 64 + fr;
        bf16_t* base; int ldc, colt;
        if (u.pn < nsplit) { base = O0; ldc = ldc0; colt = u.pn * BM; } else { base = O1; ldc = ldc1; colt = (u.pn - nsplit) * BM; }
        const int col0 = colt + wc * 32 + 8 * fq;
#pragma unroll
        for (int ai = 0; ai < 2; ++ai)
#pragma unroll
            for (int m = 0; m < 4; ++m) { bf16_t* rowp = base + (size_t)(row0 + ai * HALF + m * 16) * ldc + col0;
#pragma unroll
                for (int bj = 0; bj < 2; ++bj) { f32x4 v0 = acc[ai][bj][m][0], v1 = acc[ai][bj][m][1];
                    if (ACT == 1) {
#pragma unroll
                        for (int j = 0; j < 4; ++j) { const float a = fmaxf(v0[j], 0.f), b = fmaxf(v1[j], 0.f); v0[j] = a * a; v1[j] = b * b; } }
                    u32x4 w; w.x = cvt_pk_bf16(v0[0], v0[1]); w.y = cvt_pk_bf16(v0[2], v0[3]); w.z = cvt_pk_bf16(v1[0], v1[1]); w.w = cvt_pk_bf16(v1[2], v1[3]);
                    *(u32x4*)(rowp + bj * HALF) = w; } }
    }
};
struct EpiQSplit {
    static constexpr bool PERM = true, AFTER_DRAIN = false;
    bf16_t* Q; float* SLAB;
    __device__ __forceinline__ void operator()(const f32x4 (&acc)[2][2][4][2], const Unit& u, int wr, int wc, int fr, int fq) const {
        const int row0 = u.pm * BM + wr * 64 + fr, col0 = u.pn * BM + wc * 32 + 8 * fq;
        if (u.aux >= 0) {
            float* base = SLAB + (size_t)u.aux * (1280 * 1024) + (size_t)(row0 - 16384) * 1024 + col0;
#pragma unroll
            for (int ai = 0; ai < 2; ++ai)
#pragma unroll
                for (int m = 0; m < 4; ++m) { float* rowp = base + (size_t)(ai * HALF + m * 16) * 1024;
#pragma unroll
                    for (int bj = 0; bj < 2; ++bj) { *(f32x4*)(rowp + bj * HALF) = acc[ai][bj][m][0]; *(f32x4*)(rowp + bj * HALF + 4) = acc[ai][bj][m][1]; } }
            return;
        }
#pragma unroll
        for (int ai = 0; ai < 2; ++ai)
#pragma unroll
            for (int m = 0; m < 4; ++m) { bf16_t* rowp = Q + (size_t)(row0 + ai * HALF + m * 16) * 1024 + col0;
#pragma unroll
                for (int bj = 0; bj < 2; ++bj) { const f32x4 v0 = acc[ai][bj][m][0], v1 = acc[ai][bj][m][1];
                    u32x4 w; w.x = cvt_pk_bf16(v0[0], v0[1]); w.y = cvt_pk_bf16(v0[2], v0[3]); w.z = cvt_pk_bf16(v1[0], v1[1]); w.w = cvt_pk_bf16(v1[2], v1[3]);
                    *(u32x4*)(rowp + bj * HALF) = w; } }
    }
};

template <class Epi, class Sched, bool ALIGN_EPI = false, bool SP2 = false>
__device__ __forceinline__ void gemm_phase(PG8_LAS unsigned char* lds, const Gemm g, const Sched& S, const Epi& E) {
    int tid_l = threadIdx.x; asm volatile("" : "+v"(tid_l));
    const int tid = tid_l, wid = __builtin_amdgcn_readfirstlane(tid >> 6), lane = tid & 63, wr = wid >> 2, wc = wid & 3, fr = lane & 15, fq = lane >> 4;
    const int K = g.K;
    unsigned voffA[2], voffB[2];
#pragma unroll
    for (int i = 0; i < 2; ++i) { int R, C; stage_rc(tid * 16 + i * 8192, R, C); const int Rb = Epi::PERM ? ((R & ~31) + perm32(R & 31)) : R;
        voffA[i] = (unsigned)(R * K + C) * 2u; voffB[i] = (unsigned)(Rb * K + C) * 2u; }
    const size_t kstep = (size_t)(BK * 2);
    const size_t hstep = (size_t)HALF * K * 2;
    const size_t tstep = 2 * hstep;
    const unsigned ldsw = (unsigned)wid * 1024u;
    const int aoff = lds_byte(wr * 64 + fr, fq * 8), boff = lds_byte(wc * 32 + fr, fq * 8);
#define PG8_SA(b, h) (((b) * 2 + (h)) * HTB)
#define PG8_SB(b, h) ((4 + (b) * 2 + (h)) * HTB)
#define PG8_STAGE(bufoff, gbase, voff) do { _Pragma("unroll") for (int _i = 0; _i < 2; ++_i) \
        __builtin_amdgcn_global_load_lds((const unsigned*)((const char*)(gbase) + (voff)[_i]), (PG8_LAS unsigned*)(lds + (bufoff) + ldsw + _i * 8192), 16, 0, 0); } while (0)
#define PG8_LDA(dst, b, h) do { _Pragma("unroll") for (int m = 0; m < 4; ++m) _Pragma("unroll") for (int k = 0; k < 2; ++k) dst[m][k] = *(const PG8_LAS bf16x8*)(lds + PG8_SA(b, h) + aoff + m * 2048 + k * 1024); } while (0)
#define PG8_LDB(dst, b, h) do { _Pragma("unroll") for (int n = 0; n < 2; ++n) _Pragma("unroll") for (int k = 0; k < 2; ++k) dst[n][k] = *(const PG8_LAS bf16x8*)(lds + PG8_SB(b, h) + boff + n * 2048 + k * 1024); } while (0)
#define PG8_MMA(ai, bj, At, Bt) do { __builtin_amdgcn_s_setprio(1); _Pragma("unroll") for (int m = 0; m < 4; ++m) _Pragma("unroll") for (int n = 0; n < 2; ++n) _Pragma("unroll") for (int k = 0; k < 2; ++k) \
        acc[ai][bj][m][n] = __builtin_amdgcn_mfma_f32_16x16x32_bf16(Bt[n][k], At[m][k], acc[ai][bj][m][n], 0, 0, 0); __builtin_amdgcn_s_setprio(0); } while (0)
#define PG8_WAIT_V(n) asm volatile("s_waitcnt vmcnt(" #n ")" ::: "memory")
#define PG8_WAIT_L(n) asm volatile("s_waitcnt lgkmcnt(" #n ")" ::: "memory")
#define PG8_BAR __builtin_amdgcn_s_barrier()
#define PG8_SCHED __builtin_amdgcn_sched_barrier(0)
    Unit cur, nxt; int ui = 0;
    if (!S.next(0, cur)) return;
    f32x4 acc[2][2][4][2];
#pragma unroll
    for (int a = 0; a < 2; ++a)
#pragma unroll
        for (int b = 0; b < 2; ++b)
#pragma unroll
            for (int m = 0; m < 4; ++m)
#pragma unroll
                for (int n = 0; n < 2; ++n) acc[a][b][m][n] = (f32x4){0.f, 0.f, 0.f, 0.f};
    bf16x8 At[4][2], B0[2][2], B1[2][2];
    const char* cA = (const char*)g.A + (size_t)cur.pm * tstep + (size_t)cur.k0 * 2; const char* cB = (const char*)g.Bt + (size_t)cur.pn * tstep + (size_t)cur.k0 * 2;
    S.a_ready(cur);
    if constexpr (SP2) {
        PG8_STAGE(PG8_SB(0, 0), cB, voffB); PG8_STAGE(PG8_SB(0, 1), cB + hstep, voffB); PG8_STAGE(PG8_SA(0, 0), cA, voffA); PG8_STAGE(PG8_SA(0, 1), cA + hstep, voffA);
        if (wr == 1) PG8_BAR;
        PG8_WAIT_V(2); PG8_BAR;
        PG8_STAGE(PG8_SB(1, 0), cB + kstep, voffB); PG8_STAGE(PG8_SA(1, 0), cA + kstep, voffA); PG8_STAGE(PG8_SB(1, 1), cB + hstep + kstep, voffB);
        PG8_WAIT_V(6); PG8_BAR;
    } else {
        PG8_STAGE(PG8_SB(0, 0), cB, voffB); PG8_STAGE(PG8_SA(0, 0), cA, voffA); PG8_STAGE(PG8_SB(0, 1), cB + hstep, voffB); PG8_STAGE(PG8_SA(0, 1), cA + hstep, voffA);
        if (wr == 1) PG8_BAR;
        PG8_WAIT_V(4); PG8_BAR;
        PG8_STAGE(PG8_SB(1, 0), cB + kstep, voffB); PG8_STAGE(PG8_SA(1, 0), cA + kstep, voffA); PG8_STAGE(PG8_SB(1, 1), cB + hstep + kstep, voffB);
        PG8_WAIT_V(6); PG8_BAR;
    }
    for (;;) {
        const bool has_next = S.next(ui + 1, nxt);
        const char* nA = has_next ? (const char*)g.A + (size_t)nxt.pm * tstep + (size_t)nxt.k0 * 2 : cA; const char* nB = has_next ? (const char*)g.Bt + (size_t)nxt.pn * tstep + (size_t)nxt.k0 * 2 : cB;
        const int nt = cur.nt;
        for (int t = 0; t < nt; t += 2) {
            const bool last = (t == nt - 2);
            const char* a1 = cA + (size_t)(t + 1) * kstep;
            const char* a2 = last ? nA : cA + (size_t)(t + 2) * kstep; const char* b2 = last ? nB : cB + (size_t)(t + 2) * kstep;
            const char* a3 = a2 + kstep; const char* b3 = b2 + kstep;
            if (last && has_next) S.a_ready(nxt);
            if constexpr (SP2) {
            PG8_LDB(B0, 0, 0); PG8_LDB(B1, 0, 1); PG8_SCHED; PG8_LDA(At, 0, 0); PG8_STAGE(PG8_SA(1, 1), a1 + hstep, voffA);
            PG8_WAIT_V(8); PG8_WAIT_L(0); PG8_BAR; PG8_MMA(0, 0, At, B0); PG8_MMA(0, 1, At, B1); PG8_BAR; PG8_SCHED;
            PG8_LDA(At, 0, 1); PG8_STAGE(PG8_SB(0, 0), b2, voffB); PG8_STAGE(PG8_SB(0, 1), b2 + hstep, voffB); PG8_STAGE(PG8_SA(0, 0), a2, voffA);
            PG8_WAIT_V(8); PG8_WAIT_L(0); PG8_BAR; PG8_MMA(1, 0, At, B0); PG8_MMA(1, 1, At, B1); PG8_BAR; PG8_SCHED;
            PG8_LDB(B0, 1, 0); PG8_LDB(B1, 1, 1); PG8_SCHED; PG8_LDA(At, 1, 0); PG8_STAGE(PG8_SA(0, 1), a2 + hstep, voffA);
            PG8_WAIT_V(8); PG8_WAIT_L(0); PG8_BAR; PG8_MMA(0, 0, At, B0); PG8_MMA(0, 1, At, B1); PG8_BAR; PG8_SCHED;
            PG8_LDA(At, 1, 1); PG8_STAGE(PG8_SB(1, 0), b3, voffB); PG8_STAGE(PG8_SB(1, 1), b3 + hstep, voffB); PG8_STAGE(PG8_SA(1, 0), a3, voffA);
            PG8_WAIT_V(8); PG8_WAIT_L(0); PG8_BAR; PG8_MMA(1, 0, At, B0); PG8_MMA(1, 1, At, B1); PG8_BAR; PG8_SCHED;
            } else {
            PG8_LDB(B0, 0, 0); PG8_SCHED; PG8_LDA(At, 0, 0); PG8_STAGE(PG8_SA(1, 1), a1 + hstep, voffA);
            PG8_WAIT_L(8); PG8_BAR; PG8_WAIT_L(0); PG8_MMA(0, 0, At, B0); PG8_BAR; PG8_SCHED;
            PG8_LDB(B1, 0, 1); PG8_STAGE(PG8_SB(0, 0), b2, voffB);
            PG8_BAR; PG8_WAIT_L(0); PG8_MMA(0, 1, At, B1); PG8_BAR;
            PG8_LDA(At, 0, 1); PG8_STAGE(PG8_SA(0, 0), a2, voffA);
            PG8_BAR; PG8_WAIT_L(0); PG8_MMA(1, 0, At, B0); PG8_BAR; PG8_SCHED;
            PG8_STAGE(PG8_SB(0, 1), b2 + hstep, voffB);
            PG8_WAIT_V(6); PG8_BAR; PG8_MMA(1, 1, At, B1); PG8_BAR;
            PG8_LDB(B0, 1, 0); PG8_SCHED; PG8_LDA(At, 1, 0); PG8_STAGE(PG8_SA(0, 1), a2 + hstep, voffA);
            PG8_WAIT_L(8); PG8_BAR; PG8_WAIT_L(0); PG8_MMA(0, 0, At, B0); PG8_BAR; PG8_SCHED;
            PG8_LDB(B1, 1, 1); PG8_STAGE(PG8_SB(1, 0), b3, voffB);
            PG8_BAR; PG8_WAIT_L(0); PG8_MMA(0, 1, At, B1); PG8_BAR;
            PG8_LDA(At, 1, 1); PG8_STAGE(PG8_SA(1, 0), a3, voffA);
            PG8_BAR; PG8_WAIT_L(0); PG8_MMA(1, 0, At, B0); PG8_BAR; PG8_SCHED;
            PG8_STAGE(PG8_SB(1, 1), b3 + hstep, voffB);
            PG8_WAIT_V(6); PG8_BAR; PG8_MMA(1, 1, At, B1); PG8_BAR;
            }
        }
        if constexpr (ALIGN_EPI) { if (wr == 0) PG8_BAR; }
        if constexpr (!Epi::AFTER_DRAIN) { E(acc, cur, wr, wc, fr, fq); S.done(cur); }
        if (!has_next) break;
#pragma unroll
        for (int a = 0; a < 2; ++a)
#pragma unroll
            for (int b = 0; b < 2; ++b)
#pragma unroll
                for (int m = 0; m < 4; ++m)
#pragma unroll
                    for (int n = 0; n < 2; ++n) acc[a][b][m][n] = (f32x4){0.f, 0.f, 0.f, 0.f};
        cur = nxt; cA = nA; cB = nB; ++ui;
        if constexpr (ALIGN_EPI) { if (wr == 1) PG8_BAR; }
    }
    PG8_WAIT_V(0);
    if constexpr (!ALIGN_EPI) { if (wr == 0) PG8_BAR; }
    PG8_BAR;
    if constexpr (Epi::AFTER_DRAIN) { E.fused(acc, cur, wr, wc, fr, fq, lds, wid, lane); S.done(cur); }
#undef PG8_SA
#undef PG8_SB
#undef PG8_STAGE
#undef PG8_LDA
#undef PG8_LDB
#undef PG8_MMA
#undef PG8_WAIT_V
#undef PG8_WAIT_L
#undef PG8_BAR
#undef PG8_SCHED
}
}
#define GAS __attribute__((address_space(1)))
#define LAS __attribute__((address_space(3)))
typedef unsigned short bf16;
typedef unsigned v4u __attribute__((ext_vector_type(4)));
typedef float f32x4 __attribute__((ext_vector_type(4)));
typedef short bf16x8 __attribute__((ext_vector_type(8)));
typedef GAS unsigned gu32;
typedef GAS unsigned long long gu64;
#define RLX_AGENT __ATOMIC_RELAXED, __HIP_MEMORY_SCOPE_AGENT
#define LDS_WAIT() asm volatile("s_waitcnt lgkmcnt(0)" ::: "memory")
#define VM_WAIT() asm volatile("s_waitcnt vmcnt(0)" ::: "memory")
__device__ __forceinline__ unsigned long long rt() { return __builtin_amdgcn_s_memrealtime(); }
__device__ __forceinline__ unsigned f2bf(float f) { unsigned u = __builtin_bit_cast(unsigned, f); return (u + 0x7fffu + ((u >> 16) & 1u)) >> 16; }
__device__ __forceinline__ unsigned pk2(float lo, float hi) { return f2bf(lo) | (f2bf(hi) << 16); }

#define XB_TMO      128
#define XB_XCNT(j)  (256  + 64 * (j))
#define XB_XSUB(j)  (1280 + 64 * (j))
#define XB_XGEN(j)  (2304 + 64 * (j))
#define XB_TOP      3328
#define XB_TOPGEN   3392
#define XCD_BAR_WORDS 3456
#define XB_SPIN_CAP (1u << 18)

__device__ __forceinline__ unsigned xb_ld(unsigned* p)              { return __hip_atomic_load(p, __ATOMIC_RELAXED, __HIP_MEMORY_SCOPE_AGENT); }
__device__ __forceinline__ unsigned xb_add(unsigned* p, unsigned v) { return __hip_atomic_fetch_add(p, v, __ATOMIC_RELAXED, __HIP_MEMORY_SCOPE_AGENT); }
__device__ __forceinline__ unsigned xb_xcc_id() { return (unsigned)__builtin_amdgcn_s_getreg((3 << 11) | 20) & 0xFu; }
#define XB_SPIN(cond, bar) do { unsigned _sp = 0; while (cond) { __builtin_amdgcn_s_sleep(1); \
    if ((++_sp & 255u) == 0u) { if (xb_ld(&(bar)[XB_TMO])) break; if (_sp > XB_SPIN_CAP) { atomicAdd(&(bar)[XB_TMO], 1u); break; } } } } while (0)

struct XcdBarrier {
    unsigned* bar; unsigned x;
    volatile LAS unsigned* st;
};

__device__ __forceinline__ XcdBarrier xcd_barrier_post(unsigned* bar, volatile LAS unsigned* st) {
    XcdBarrier b; b.bar = bar; b.x = xb_xcc_id(); b.st = st;
    if (threadIdx.x == 0) (void)xb_add(&bar[XB_XCNT(b.x)], 1u);
    return b;
}
__device__ __forceinline__ void xcd_barrier_complete(unsigned* bar, unsigned x, unsigned& nloc, unsigned& nx) {
    const unsigned G = gridDim.x * gridDim.y * gridDim.z;
    unsigned sum, cnt, mine, sp = 0u;
    for (;;) {
        sum = 0u; cnt = 0u; mine = 0u;
#pragma unroll
        for (unsigned j = 0; j < 16; ++j) { const unsigned c = xb_ld(&bar[XB_XCNT(j)]); sum += c; cnt += (c > 0u) ? 1u : 0u; mine = (j == x) ? c : mine; }
        if (sum == G) break;
        __builtin_amdgcn_s_sleep(1);
        if ((++sp & 255u) == 0u) { if (xb_ld(&bar[XB_TMO])) break; if (sp > XB_SPIN_CAP) { atomicAdd(&bar[XB_TMO], 1u); break; } }
    }
    nloc = mine > 0u ? mine : 1u; nx = cnt > 0u ? cnt : 1u;
}

__device__ __forceinline__ void xcd_barrier(const XcdBarrier& b) {
    asm volatile("s_waitcnt vmcnt(0)" ::: "memory");
    __syncthreads();
    if (threadIdx.x == 0) {
        unsigned* bar = b.bar;
        __builtin_amdgcn_s_waitcnt(0);
        unsigned nloc = b.st[0], nx = b.st[1];
        if (nloc == 0u) { xcd_barrier_complete(bar, b.x, nloc, nx); b.st[0] = nloc; b.st[1] = nx; }
        const unsigned old = xb_add(&bar[XB_XSUB(b.x)], 1u);
        const unsigned gen = old / nloc;
        if (old + 1u == (gen + 1u) * nloc) {
            __builtin_amdgcn_fence(__ATOMIC_RELEASE, "agent");
            asm volatile("s_waitcnt vmcnt(0)" ::: "memory");
            const unsigned og = xb_add(&bar[XB_TOP], 1u);
            const unsigned tg = og / nx;
            if (og + 1u == (tg + 1u) * nx) xb_add(&bar[XB_TOPGEN], 1u);
            else XB_SPIN(xb_ld(&bar[XB_TOPGEN]) == tg, bar);
            __builtin_amdgcn_fence(__ATOMIC_ACQUIRE, "agent");
            xb_add(&bar[XB_XGEN(b.x)], 1u);
            asm volatile("s_waitcnt vmcnt(0)" ::: "memory");
        } else {
            XB_SPIN(xb_ld(&bar[XB_XGEN(b.x)]) == gen, bar);
            __builtin_amdgcn_fence(__ATOMIC_ACQUIRE, "agent");
            asm volatile("s_waitcnt vmcnt(0)" ::: "memory");
        }
    }
    __syncthreads();
}
constexpr int NWAVES = 8, NTHREADS = 512;
constexpr int DM = 1024, SEQ = 8192, NPROMPT = 2, NSAMP = 128, TSAMP = 8, NMETA = 16;
constexpr int ROW_S = NPROMPT * SEQ;
constexpr int ROW_M = ROW_S + NSAMP * TSAMP;
constexpr int NROWS = ROW_M + NMETA;
constexpr int MP = 17664;
constexpr int DINNER = 2048, NHEADS = 32, HD = 64, NGROUPS = 8, DSTATE = 128, CONVD = 4096, INPROJ = 6176, INPROJ_P = 6400, ZXW = 6144;
constexpr int DFF = 4096, NKV = 4, NQ = 16, KVW = 512;
constexpr float EPS = 1e-5f;
constexpr int LDX = 136;

constexpr size_t O_YP = 0, O_YS = O_YP + (size_t)NPROMPT * SEQ * DM, O_PCONV = O_YS + (size_t)NSAMP * TSAMP * DM, O_PSSM = O_PCONV + 2 * 2 * 3 * 4096,
    O_PCK = O_PSSM + (size_t)2 * 2 * 32 * 64 * 128, O_PCV = O_PCK + 2 * 128 * 256, O_SCONV = O_PCV + 2 * 128 * 256, O_SSSM = O_SCONV + (size_t)2 * 128 * 3 * 4096,
    O_SCK = O_SSSM + (size_t)2 * 128 * 32 * 64 * 128, O_SCV = O_SCK + (size_t)128 * 128 * 256, O_END = O_SCV + (size_t)128 * 128 * 256;

constexpr size_t MiB = 1u << 20;
constexpr size_t WS_CTL = 0, CTL_ZERO_BYTES = 1 * MiB;
constexpr size_t SZ_WIN = (size_t)INPROJ_P * 1024 * 2, SZ_WOUT = (size_t)1024 * 2048 * 2, SZ_WUP = (size_t)4096 * 1024 * 2, SZ_WDN = SZ_WUP, SZ_WQKV0 = (size_t)1536 * 1024 * 2, SZ_WQ1 = (size_t)1024 * 1024 * 2, SZ_WO = SZ_WQ1;
constexpr size_t WS_WIN = 1 * MiB, WS_WOUT = WS_WIN + 2 * SZ_WIN, WS_WUP = WS_WOUT + 2 * SZ_WOUT, WS_WDN = WS_WUP + 4 * SZ_WUP, WS_WQKV0 = WS_WDN + 4 * SZ_WDN, WS_WQ1 = WS_WQKV0 + SZ_WQKV0, WS_WO = WS_WQ1 + SZ_WQ1, WS_WEND = WS_WO + 2 * SZ_WO;
constexpr size_t al1m(size_t x) { return (x + MiB - 1) / MiB * MiB; }
constexpr size_t WS_H = al1m(WS_WEND), WS_HN = al1m(WS_H + (size_t)MP * 1024 * 4), WS_ZX = al1m(WS_HN + (size_t)MP * 1024 * 2), WS_DT = al1m(WS_ZX + (size_t)MP * ZXW * 2),
    WS_XC = al1m(WS_DT + (size_t)MP * 32 * 4), WS_YN = al1m(WS_XC + (size_t)MP * 4096 * 2), WS_CS = al1m(WS_YN + (size_t)MP * 2048 * 2), WS_CD = al1m(WS_CS + (size_t)129 * 32 * 8192 * 4), WS_SLAB = al1m(WS_CD + 129 * 32 * 4), WS_HSB = al1m(WS_SLAB + (size_t)8 * 1280 * 1024 * 4), WS_END = al1m(WS_HSB + (size_t)128 * 32 * 8192 * 2);
constexpr size_t WS_U = WS_ZX;
constexpr size_t WS_Q = WS_XC, WS_KV = WS_Q + (size_t)MP * 1024 * 2, WS_AO = WS_KV + (size_t)MP * 512 * 2;
static_assert(WS_AO + (size_t)MP * 1024 * 2 <= WS_YN, "attention overlay");
constexpr int CW_BAR = 4096;

constexpr int RING_BYTES = 131072, LDS_BYTES = 147456, LDSCTL_OFF = LDS_BYTES - 512, MISC_OFF = LDSCTL_OFF + 320;

typedef unsigned u32x2 __attribute__((ext_vector_type(2)));
typedef unsigned u32x4 __attribute__((ext_vector_type(4)));
__device__ __forceinline__ int ltid() { int t = threadIdx.x; asm volatile("" : "+v"(t)); return t; }
__device__ __forceinline__ float bf2f(unsigned short b) { return __uint_as_float((unsigned)b << 16); }
__device__ __forceinline__ float bflo(unsigned w) { return __uint_as_float(w << 16); }
__device__ __forceinline__ float bfhi(unsigned w) { return __uint_as_float(w & 0xffff0000u); }
__device__ __forceinline__ unsigned pkbf(float lo, float hi) { return pg8::cvt_pk_bf16(lo, hi); }
__device__ __forceinline__ float wave_sum(float v) {
#pragma unroll
    for (int o = 1; o < 64; o <<= 1) v += __shfl_xor(v, o);
    return v;
}
__device__ __forceinline__ float frcp(float x) { return __builtin_amdgcn_rcpf(x); }
__device__ __forceinline__ float sigmoid_f(float x) { return frcp(1.f + __expf(-x)); }
#define MFMA16(b, a, c) __builtin_amdgcn_mfma_f32_16x16x32_bf16((b), (a), (c), 0, 0, 0)

struct Args {
    const float* in[26]; float* out; unsigned char* ws; int ph_lo, ph_hi;
};
typedef const __attribute__((address_space(4))) Args* ArgsP;
enum { I_XP = 0, I_XS, I_SCONV, I_SSSM, I_CK, I_CV, I_META, I_ANORM, I_AIN, I_ACONVW, I_ACONVB, I_ADTB, I_ALOG, I_ADSKIP, I_AGATE, I_AOUT, I_KVNORM, I_WKV, I_BNORM, I_WQ, I_SINKS, I_WO, I_MLPNORM, I_WUP, I_WDOWN, I_FNORM };

__device__ __forceinline__ void transpose_item(const float* W, const float* scale, int K, int N, bf16* WT, int row_off, LAS unsigned* scr, int item, int lane) {
    const int nblk = (N + 63) / 64, kb = item / nblk, nb = item % nblk, k0 = 64 * kb, n0 = 64 * nb;
    const bool ok = (n0 + lane < N);
    const float* src = W + (size_t)k0 * N + n0 + (ok ? lane : 0);
    float v[64];
#pragma unroll
    for (int i = 0; i < 64; ++i) v[i] = src[(size_t)i * N];
    if (!ok) {
#pragma unroll
        for (int i = 0; i < 64; ++i) v[i] = 0.f;
    }
    if (scale) {
#pragma unroll
        for (int i = 0; i < 64; ++i) v[i] *= scale[k0 + i];
    }
#pragma unroll
    for (int i = 0; i < 32; ++i) scr[lane * 33 + i] = pkbf(v[2 * i], v[2 * i + 1]);
    LDS_WAIT(); asm volatile("" ::: "memory");
    const int c = lane & 7;
#pragma unroll
    for (int j = 0; j < 8; ++j) { const int n = (lane >> 3) + 8 * j; const LAS unsigned* sp = scr + n * 33 + 4 * c;
        v4u o; o.x = sp[0]; o.y = sp[1]; o.z = sp[2]; o.w = sp[3];
        if (n0 + n < N) *(GAS v4u*)(WT + (size_t)(row_off + n0 + n) * K + k0 + 8 * c) = o; }
    LDS_WAIT(); asm volatile("" ::: "memory");
}
struct WJob { const float* W; const float* scale; int K, N; bf16* WT; int row_off; int items; };

__device__ __forceinline__ void phase_prologue(ArgsP a, LAS unsigned char* lds, int wave, int lane) {
    LAS unsigned* scr = (LAS unsigned*)(lds + wave * 16384);
    const int gw = blockIdx.x * NWAVES + wave, NGW = gridDim.x * NWAVES;
    unsigned char* ws = a->ws;
    for (int jb = 0; jb < 21; ++jb) {
        WJob J;
        if (jb < 2)       { const int i = jb;      J = WJob{a->in[I_AIN] + (size_t)i * 1024 * INPROJ, a->in[I_ANORM] + i * 1024, 1024, INPROJ, (bf16*)(ws + WS_WIN + i * SZ_WIN), 0, 0}; }
        else if (jb < 4)  { const int i = jb - 2;  J = WJob{a->in[I_AOUT] + (size_t)i * 2048 * 1024, a->in[I_AGATE] + i * 2048, 2048, 1024, (bf16*)(ws + WS_WOUT + i * SZ_WOUT), 0, 0}; }
        else if (jb < 8)  { const int l = jb - 4;  J = WJob{a->in[I_WUP] + (size_t)l * 1024 * 4096, a->in[I_MLPNORM] + l * 1024, 1024, 4096, (bf16*)(ws + WS_WUP + l * SZ_WUP), 0, 0}; }
        else if (jb < 12) { const int l = jb - 8;  J = WJob{a->in[I_WDOWN] + (size_t)l * 4096 * 1024, nullptr, 4096, 1024, (bf16*)(ws + WS_WDN + l * SZ_WDN), 0, 0}; }
        else if (jb == 12) { J = WJob{a->in[I_WQ], a->in[I_BNORM], 1024, 1024, (bf16*)(ws + WS_WQKV0), 0, 0}; }
        else if (jb == 13) { J = WJob{a->in[I_WKV], a->in[I_KVNORM], 1024, 512, (bf16*)(ws + WS_WQKV0), 1024, 0}; }
        else if (jb == 14) { J = WJob{a->in[I_WQ] + (size_t)1024 * 1024, a->in[I_BNORM] + 1024, 1024, 1024, (bf16*)(ws + WS_WQ1), 0, 0}; }
        else if (jb < 17) { const int j = jb - 15; J = WJob{a->in[I_WO] + (size_t)j * 1024 * 1024, nullptr, 1024, 1024, (bf16*)(ws + WS_WO + j * SZ_WO), 0, 0}; }
        else break;
        const int items = (J.K / 64) * ((J.N + 63) / 64);
        for (int it = gw; it < items; it += NGW) transpose_item(J.W, J.scale, J.K, J.N, J.WT, J.row_off, scr, it, lane);
    }
    {
        const int gt = blockIdx.x * NTHREADS + ltid(), NT = gridDim.x * NTHREADS;
        const int per = (INPROJ_P - INPROJ) * 1024 * 2 / 16;
        for (int e = gt; e < 2 * per; e += NT) { const int i = e / per, c = e % per;
            *(v4u*)(ws + WS_WIN + i * SZ_WIN + (size_t)INPROJ * 1024 * 2 + (size_t)c * 16) = (v4u){0u, 0u, 0u, 0u}; }
    }
}

__device__ __forceinline__ void norm_store(bf16* __restrict__ HN, int m, int lane, const f32x4 (&v)[4]) {
    float s = 0.f;
#pragma unroll
    for (int j = 0; j < 4; ++j) s += (v[j].x * v[j].x + v[j].y * v[j].y) + (v[j].z * v[j].z + v[j].w * v[j].w);
    const float rs = rsqrtf(wave_sum(s) * (1.f / DM) + EPS);
    unsigned long long* o8 = (unsigned long long*)(HN + (size_t)m * DM) + lane;
#pragma unroll
    for (int j = 0; j < 4; ++j) o8[64 * j] = (unsigned long long)pkbf(v[j].x * rs, v[j].y * rs) | ((unsigned long long)pkbf(v[j].z * rs, v[j].w * rs) << 32);
}
__device__ __forceinline__ void phase_norm(ArgsP a, int from_inputs, int nslab, int wave, int lane) {
    float* __restrict__ H = (float*)(a->ws + WS_H); bf16* __restrict__ HN = (bf16*)(a->ws + WS_HN); const float* __restrict__ SLAB = (const float*)(a->ws + WS_SLAB);
    const int gw = blockIdx.x * NWAVES + wave, NGW = gridDim.x * NWAVES;
    for (int m = ROW_S + gw; m < MP; m += NGW) {
        if (m >= NROWS) { unsigned long long* o8 = (unsigned long long*)(HN + (size_t)m * DM) + lane;
#pragma unroll
            for (int j = 0; j < 4; ++j) o8[64 * j] = 0ull;
            continue; }
        const float* src = from_inputs ? ((m < ROW_M) ? a->in[I_XS] + (size_t)(m - ROW_S) * DM : a->in[I_META] + (size_t)(m - ROW_M) * DM) : H + (size_t)m * DM;
        f32x4 v[4], sv[8][4];
#pragma unroll
        for (int j = 0; j < 4; ++j) v[j] = ((const f32x4*)src + lane)[64 * j];
#pragma unroll
        for (int sl = 0; sl < 8; ++sl)
#pragma unroll
            for (int j = 0; j < 4; ++j) { sv[sl][j] = (f32x4){0.f, 0.f, 0.f, 0.f}; if (sl < nslab) sv[sl][j] = ((const f32x4*)(SLAB + (size_t)sl * (1280 * 1024) + (size_t)(m - ROW_S) * DM) + lane)[64 * j]; }
#pragma unroll
        for (int sl = 0; sl < 8; ++sl)
#pragma unroll
            for (int j = 0; j < 4; ++j) v[j] = v[j] + sv[sl][j];
        if (nslab > 0 || from_inputs) { f32x4* hr = (f32x4*)(H + (size_t)m * DM) + lane;
#pragma unroll
            for (int j = 0; j < 4; ++j) hr[64 * j] = v[j]; }
        norm_store(HN, m, lane, v);
    }
    const float* __restrict__ P = from_inputs ? a->in[I_XP] : (const float*)H;
    for (int m0 = 2 * gw; m0 < ROW_S; m0 += 2 * NGW) {
        f32x4 v[2][4];
#pragma unroll
        for (int q = 0; q < 2; ++q)
#pragma unroll
            for (int j = 0; j < 4; ++j) v[q][j] = ((const f32x4*)(P + (size_t)(m0 + q) * DM) + lane)[64 * j];
#pragma unroll
        for (int q = 0; q < 2; ++q) norm_store(HN, m0 + q, lane, v[q]);
    }
}
__device__ __forceinline__ void phase_final(ArgsP a, int wave, int lane) {
    const float* H = (const float*)(a->ws + WS_H); const float* fw = a->in[I_FNORM]; const float* SLAB = (const float*)(a->ws + WS_SLAB);
    const int gw = blockIdx.x * NWAVES + wave, NGW = gridDim.x * NWAVES;
    f32x4 w[4];
#pragma unroll
    for (int j = 0; j < 4; ++j) w[j] = ((const f32x4*)fw)[lane + 64 * j];
    for (int m = gw; m < ROW_M; m += NGW) {
        const f32x4* xr = (const f32x4*)(H + (size_t)m * DM) + lane;
        f32x4 v[4]; float s = 0.f;
#pragma unroll
        for (int j = 0; j < 4; ++j) v[j] = xr[64 * j];
        if (m >= ROW_S) {
            for (int sl = 0; sl < 8; ++sl) { const f32x4* sr = (const f32x4*)(SLAB + (size_t)sl * (1280 * 1024) + (size_t)(m - ROW_S) * DM) + lane;
#pragma unroll
                for (int j = 0; j < 4; ++j) v[j] = v[j] + sr[64 * j]; }
        }
#pragma unroll
        for (int j = 0; j < 4; ++j) s += (v[j].x * v[j].x + v[j].y * v[j].y) + (v[j].z * v[j].z + v[j].w * v[j].w);
        const float rs = rsqrtf(wave_sum(s) * (1.f / DM) + EPS);
        f32x4* o = (f32x4*)(a->out + O_YP + (size_t)m * DM) + lane;
#pragma unroll
        for (int j = 0; j < 4; ++j) o[64 * j] = v[j] * rs * w[j];
    }
}

__device__ __forceinline__ void unpack8(const u32x4 w, float (&f)[8]) { f[0] = bflo(w.x); f[1] = bfhi(w.x); f[2] = bflo(w.y); f[3] = bfhi(w.y); f[4] = bflo(w.z); f[5] = bfhi(w.z); f[6] = bflo(w.w); f[7] = bfhi(w.w); }
__device__ __forceinline__ void ld8f(const float* __restrict__ p, float (&f)[8]) { const f32x4 x0 = *(const f32x4*)p, x1 = *(const f32x4*)(p + 4); f[0]=x0.x;f[1]=x0.y;f[2]=x0.z;f[3]=x0.w;f[4]=x1.x;f[5]=x1.y;f[6]=x1.z;f[7]=x1.w; }
#define TSW(ch) ((((ch) >> 3) & 7) << 3)
struct ConvW { float w0[8], w1[8], w2[8], w3[8], bs[8]; };
__device__ __forceinline__ void conv_load_w(const float* __restrict__ cw, const float* __restrict__ cb, int c0, ConvW& W) { ld8f(cw + c0, W.w0); ld8f(cw + CONVD + c0, W.w1); ld8f(cw + 2 * CONVD + c0, W.w2); ld8f(cw + 3 * CONVD + c0, W.w3); ld8f(cb + c0, W.bs); }
__device__ __forceinline__ void conv_load_run(const bf16* __restrict__ ZX, int Rrow, int c0, int pk, bool valid, u32x4 (&raw)[11]) {
#pragma unroll
    for (int t = 0; t < 8; ++t) { raw[3 + t] = (u32x4){0u, 0u, 0u, 0u}; if (valid) raw[3 + t] = *(const u32x4*)(ZX + (size_t)(Rrow + t) * ZXW + 2048 + c0); }
#pragma unroll
    for (int t = 0; t < 3; ++t) { const int rr = (pk == 1) ? ROW_M + 13 + t : Rrow - 3 + t; raw[t] = (u32x4){0u, 0u, 0u, 0u}; if (valid && pk != 2) raw[t] = *(const u32x4*)(ZX + (size_t)rr * ZXW + 2048 + c0); }
}
template <int J> __device__ __forceinline__ void conv_channel(const u32x4 (&raw)[11], const ConvW& W, float (&o)[8]) {
    float x[11];
#pragma unroll
    for (int i = 0; i < 11; ++i) { const unsigned w = raw[i][J >> 1]; x[i] = (J & 1) ? bfhi(w) : bflo(w); }
#pragma unroll
    for (int t = 0; t < 8; ++t) { const float v = W.bs[J] + W.w0[J] * x[t] + W.w1[J] * x[t + 1] + W.w2[J] * x[t + 2] + W.w3[J] * x[t + 3]; o[t] = v * sigmoid_f(v); }
}
template <int J> __device__ __forceinline__ void conv_store_t(const u32x4 (&raw)[11], const ConvW& W, const float (&scale)[8], bf16* T, int ch0, int run) {
    float o[8]; conv_channel<J>(raw, W, o);
    u32x4 w; w.x = pkbf(o[0] * scale[0], o[1] * scale[1]); w.y = pkbf(o[2] * scale[2], o[3] * scale[3]); w.z = pkbf(o[4] * scale[4], o[5] * scale[5]); w.w = pkbf(o[6] * scale[6], o[7] * scale[7]);
    *(u32x4*)(T + (ch0 + J) * LDX + ((8 * run) ^ TSW(ch0 + J))) = w;
}
__device__ __forceinline__ void conv_item_t(const u32x4 (&raw)[11], const ConvW& W, const float (&scale)[8], bf16* T, int ch0, int run) {
    conv_store_t<0>(raw, W, scale, T, ch0, run); conv_store_t<1>(raw, W, scale, T, ch0, run); conv_store_t<2>(raw, W, scale, T, ch0, run); conv_store_t<3>(raw, W, scale, T, ch0, run);
    conv_store_t<4>(raw, W, scale, T, ch0, run); conv_store_t<5>(raw, W, scale, T, ch0, run); conv_store_t<6>(raw, W, scale, T, ch0, run); conv_store_t<7>(raw, W, scale, T, ch0, run);
}
__device__ __forceinline__ void conv_item_n(const u32x4 (&raw)[11], const ConvW& W, bf16* N, int run, int colel) {
    float p0[8], p1[8], p2[8]; unpack8(raw[0], p0); unpack8(raw[1], p1); unpack8(raw[2], p2);
#pragma unroll
    for (int t = 0; t < 8; ++t) { float x[8]; unpack8(raw[3 + t], x); float o[8];
#pragma unroll
        for (int j = 0; j < 8; ++j) { const float v = W.bs[j] + W.w0[j] * p0[j] + W.w1[j] * p1[j] + W.w2[j] * p2[j] + W.w3[j] * x[j]; o[j] = v * sigmoid_f(v); }
        u32x4 w; w.x = pkbf(o[0], o[1]); w.y = pkbf(o[2], o[3]); w.z = pkbf(o[4], o[5]); w.w = pkbf(o[6], o[7]);
        *(u32x4*)(N + (8 * run + t) * LDX + colel) = w;
#pragma unroll
        for (int j = 0; j < 8; ++j) { p0[j] = p1[j]; p1[j] = p2[j]; p2[j] = x[j]; } }
}
__device__ __forceinline__ void conv_state_out(const u32x4 (&raw)[11], float* __restrict__ dst  ) {
#pragma unroll
    for (int k = 0; k < 3; ++k) { float x[8]; unpack8(raw[8 + k], x); *(f32x4*)(dst + (size_t)k * CONVD) = (f32x4){x[0], x[1], x[2], x[3]}; *(f32x4*)(dst + (size_t)k * CONVD + 4) = (f32x4){x[4], x[5], x[6], x[7]}; }
}

__device__ __forceinline__ void ssd_acs(const float* DT, const float* alog, int R0, int len, int h0, float* s_dt, float* s_acs, int wave, int lane) {
    if (wave < 4) {
        const int r = wave; const float An = -__expf(alog[h0 + r]);
        const int l0 = 2 * lane;
        const float d0 = (l0 < len) ? DT[(size_t)(R0 + l0) * 32 + h0 + r] : 0.f;
        const float d1 = (l0 + 1 < len) ? DT[(size_t)(R0 + l0 + 1) * 32 + h0 + r] : 0.f;
        const float a0 = d0 * An, a1 = d1 * An, s = a0 + a1;
        float incl = s;
#pragma unroll
        for (int o = 1; o < 64; o <<= 1) { const float t = __shfl_up(incl, o); if (lane >= o) incl += t; }
        const float excl = incl - s;
        s_dt[r * 128 + l0] = d0; s_dt[r * 128 + l0 + 1] = d1;
        s_acs[r * 128 + l0] = excl + a0; s_acs[r * 128 + l0 + 1] = excl + s;
    }
}
#define LFRAG(base, row, ld, ks) (*(const bf16x8*)((base) + (row) * (ld) + 32 * (ks) + 8 * fq))

__device__ __forceinline__ void ssd1_unit(ArgsP a, int li, unsigned char* lds, int slot, int g, int R0, int len, int, int, int) {
    const int tid = ltid(), lane = tid & 63, wave = __builtin_amdgcn_readfirstlane(tid >> 6);
    const float* __restrict__ DT = (const float*)(a->ws + WS_DT);
    bf16* __restrict__ CS = (bf16*)(a->ws + WS_CS); float* __restrict__ CD = (float*)(a->ws + WS_CD);
    bf16* XsT = (bf16*)lds;
    bf16* BT = (bf16*)(lds + 256 * LDX * 2);
    float* s_dt = (float*)(lds + 384 * LDX * 2); float* s_acs = s_dt + 512;
    const int fr = lane & 15, fq = lane >> 4, h0 = g * 4;
    const float* __restrict__ cw = a->in[I_ACONVW] + (size_t)li * 4 * CONVD; const float* __restrict__ cbias = a->in[I_ACONVB] + (size_t)li * CONVD;
    const bf16* __restrict__ ZX = (const bf16*)(a->ws + WS_ZX);
    const bool meta = (slot == 128), chunk0 = (!meta && (slot & 63) == 0);
    const int xcb = tid & 31, xrun = tid >> 5, xc0 = g * 256 + xcb * 8;
    const int bcb = tid & 15, brun = (tid >> 4) & 15, bc0 = 2048 + g * 128 + bcb * 8;
    u32x4 rx[11], rb[11];
    conv_load_run(ZX, R0 + 8 * xrun, xc0, (xrun == 0) ? (meta ? 2 : (chunk0 ? 1 : 0)) : 0, 8 * xrun < len, rx);
    if (tid < 256) conv_load_run(ZX, R0 + 8 * brun, bc0, (brun == 0) ? (meta ? 2 : (chunk0 ? 1 : 0)) : 0, 8 * brun < len, rb);
    ssd_acs(DT, a->in[I_ALOG] + li * NHEADS, R0, len, h0, s_dt, s_acs, wave, lane);
    if (tid < 256) { ConvW W; conv_load_w(cw, cbias, bc0, W); const float one[8] = {1.f, 1.f, 1.f, 1.f, 1.f, 1.f, 1.f, 1.f}; conv_item_t(rb, W, one, BT, bcb * 8, brun); }
    __syncthreads();
    {   ConvW W; conv_load_w(cw, cbias, xc0, W);
        const int r = xcb >> 3; const float tot = s_acs[r * 128 + 127];
        const f32x4 a0 = *(const f32x4*)(s_acs + r * 128 + 8 * xrun), a1 = *(const f32x4*)(s_acs + r * 128 + 8 * xrun + 4), d0 = *(const f32x4*)(s_dt + r * 128 + 8 * xrun), d1 = *(const f32x4*)(s_dt + r * 128 + 8 * xrun + 4);
        float wl[8];
#pragma unroll
        for (int t = 0; t < 4; ++t) { wl[t] = __expf(tot - a0[t]) * d0[t]; wl[4 + t] = __expf(tot - a1[t]) * d1[t]; }
        conv_item_t(rx, W, wl, XsT, xcb * 8, xrun);
    }
    __syncthreads();
    f32x4 acc[2][8];
#pragma unroll
    for (int mi = 0; mi < 2; ++mi)
#pragma unroll
        for (int ni = 0; ni < 8; ++ni) acc[mi][ni] = (f32x4){0.f, 0.f, 0.f, 0.f};
#pragma unroll
    for (int ks = 0; ks < 4; ++ks) {
        const int ra0 = 32 * wave + fr, ra1 = ra0 + 16;
        const bf16x8 a0 = *(const bf16x8*)(XsT + ra0 * LDX + ((32 * ks + 8 * fq) ^ TSW(ra0))), a1 = *(const bf16x8*)(XsT + ra1 * LDX + ((32 * ks + 8 * fq) ^ TSW(ra1)));
#pragma unroll
        for (int ni = 0; ni < 8; ++ni) { const int rb = 16 * ni + fr; const bf16x8 bb = *(const bf16x8*)(BT + rb * LDX + ((32 * ks + 8 * fq) ^ TSW(rb)));
            acc[0][ni] = MFMA16(bb, a0, acc[0][ni]); acc[1][ni] = MFMA16(bb, a1, acc[1][ni]); }
    }
#pragma unroll
    for (int mi = 0; mi < 2; ++mi) { const int hp = 32 * wave + 16 * mi + fr, r = hp >> 6, p = hp & 63;
        bf16* dst = CS + ((size_t)(slot * 32 + h0 + r) * 64 + p) * 128 + 4 * fq;
#pragma unroll
        for (int ni = 0; ni < 8; ++ni) { u32x2 w; w.x = pkbf(acc[mi][ni][0], acc[mi][ni][1]); w.y = pkbf(acc[mi][ni][2], acc[mi][ni][3]); *(u32x2*)(dst + 16 * ni) = w; } }
    if (tid < 4) CD[slot * 32 + h0 + tid] = __expf(s_acs[tid * 128 + 127]);
    __syncthreads();
}

__device__ __forceinline__ void ssd_sample_issue(ArgsP a, int li, int b, int g, f32x4 (&st)[4][4]) {
    const int tid = ltid(), p = tid >> 3, nb = tid & 7;
    const float* __restrict__ sin_ = a->in[I_SSSM] + ((size_t)((li * NSAMP + b) * NHEADS + g * 4) * 64 + p) * 128 + 4 * nb;
#pragma unroll
    for (int r = 0; r < 4; ++r)
#pragma unroll
        for (int kk = 0; kk < 4; ++kk) st[r][kk] = *(const f32x4*)(sin_ + (size_t)r * 8192 + 32 * kk);
}
__device__ __forceinline__ void ssd_sample_unit(ArgsP a, int li, unsigned char* lds, int b, int g, f32x4 (&st)[4][4]) {
    const int tid = ltid(), lane = tid & 63, wave = __builtin_amdgcn_readfirstlane(tid >> 6);
    const bf16* __restrict__ ZX = (const bf16*)(a->ws + WS_ZX); const float* __restrict__ DT = (const float*)(a->ws + WS_DT); bf16* __restrict__ YN = (bf16*)(a->ws + WS_YN);
    float* sX = (float*)lds; float* sB = sX + 8 * 256; float* sC = sB + 8 * 128; float* sY = sC + 8 * 128; float* sDt = sY + 8 * 256;
    const int R0 = ROW_S + b * 8, h0 = g * 4;
    const int p = tid >> 3, nb = tid & 7;
    float* __restrict__ sout = a->out + O_SSSM + ((size_t)((li * NSAMP + b) * NHEADS + h0) * 64 + p) * 128 + 4 * nb;
    {
        const float* __restrict__ cw = a->in[I_ACONVW] + (size_t)li * 4 * CONVD; const float* __restrict__ cbias = a->in[I_ACONVB] + (size_t)li * CONVD;
        const int t = tid >> 6, ck = tid & 63;
        const int c0 = (ck < 32) ? g * 256 + ck * 8 : (ck < 48) ? 2048 + g * 128 + (ck - 32) * 8 : 3072 + g * 128 + (ck - 48) * 8;
        float* dst = (ck < 32) ? sX + t * 256 + ck * 8 : (ck < 48) ? sB + t * 128 + (ck - 32) * 8 : sC + t * 128 + (ck - 48) * 8;
        const float* __restrict__ sc = a->in[I_SCONV] + ((size_t)(li * NSAMP + b) * 3) * CONVD + c0;
        float xr[4][8];
#pragma unroll
        for (int k = 0; k < 4; ++k) { const int tt = t - 3 + k;
            if (tt >= 0) unpack8(*(const u32x4*)(ZX + (size_t)(R0 + tt) * ZXW + 2048 + c0), xr[k]); else ld8f(sc + (size_t)(tt + 3) * CONVD, xr[k]); }
        ConvW W; conv_load_w(cw, cbias, c0, W);
        float o[8];
#pragma unroll
        for (int j = 0; j < 8; ++j) { const float v = W.bs[j] + W.w0[j] * xr[0][j] + W.w1[j] * xr[1][j] + W.w2[j] * xr[2][j] + W.w3[j] * xr[3][j]; o[j] = v * sigmoid_f(v); }
        *(f32x4*)dst = (f32x4){o[0], o[1], o[2], o[3]}; *(f32x4*)(dst + 4) = (f32x4){o[4], o[5], o[6], o[7]};
        if (t >= 5) { float* __restrict__ so = a->out + O_SCONV + ((size_t)(li * NSAMP + b) * 3 + (t - 5)) * CONVD + c0;
            *(f32x4*)so = (f32x4){xr[3][0], xr[3][1], xr[3][2], xr[3][3]}; *(f32x4*)(so + 4) = (f32x4){xr[3][4], xr[3][5], xr[3][6], xr[3][7]}; }
    }
    if (tid < 32) sDt[tid] = DT[(size_t)(R0 + (tid >> 2)) * 32 + h0 + (tid & 3)];
    __syncthreads();
    float An[4], Dk[4];
#pragma unroll
    for (int r = 0; r < 4; ++r) { An[r] = -__expf(a->in[I_ALOG][li * NHEADS + h0 + r]); Dk[r] = a->in[I_ADSKIP][li * NHEADS + h0 + r]; }
    float part[8][4];
#pragma unroll
    for (int t = 0; t < 8; ++t) {
        f32x4 bv[4], cv[4];
#pragma unroll
        for (int kk = 0; kk < 4; ++kk) { bv[kk] = *(const f32x4*)(sB + t * 128 + 32 * kk + 4 * nb); cv[kk] = *(const f32x4*)(sC + t * 128 + 32 * kk + 4 * nb); }
#pragma unroll
        for (int r = 0; r < 4; ++r) {
            const float dt = sDt[t * 4 + r], dA = __expf(dt * An[r]), xv = sX[t * 256 + r * 64 + p], coef = dt * xv;
            float pr = 0.f;
#pragma unroll
            for (int kk = 0; kk < 4; ++kk) { st[r][kk] = st[r][kk] * dA + bv[kk] * coef; pr += (cv[kk].x * st[r][kk].x + cv[kk].y * st[r][kk].y) + (cv[kk].z * st[r][kk].z + cv[kk].w * st[r][kk].w); }
            part[t][r] = pr;
        }
    }
#pragma unroll
    for (int r = 0; r < 4; ++r)
#pragma unroll
        for (int kk = 0; kk < 4; ++kk) *(f32x4*)(sout + (size_t)r * 8192 + 32 * kk) = st[r][kk];
#pragma unroll
    for (int t = 0; t < 8; ++t)
#pragma unroll
        for (int r = 0; r < 4; ++r) { float v = part[t][r]; v += __shfl_xor(v, 1); v += __shfl_xor(v, 2); v += __shfl_xor(v, 4); part[t][r] = v; }
    if (nb == 0) {
#pragma unroll
        for (int t = 0; t < 8; ++t)
#pragma unroll
            for (int r = 0; r < 4; ++r) sY[t * 256 + r * 64 + p] = part[t][r] + Dk[r] * sX[t * 256 + r * 64 + p];
    }
    __syncthreads();
    {
        const int t = wave, c4 = lane * 4; const size_t row = (size_t)(R0 + t);
        const f32x4 y = *(const f32x4*)(sY + t * 256 + c4);
        const u32x2 zz = *(const u32x2*)(ZX + row * ZXW + g * 256 + c4);
        const float z0 = bflo(zz.x), z1 = bfhi(zz.x), z2 = bflo(zz.y), z3 = bfhi(zz.y);
        const float g0 = y.x * z0 * sigmoid_f(z0), g1 = y.y * z1 * sigmoid_f(z1), g2 = y.z * z2 * sigmoid_f(z2), g3 = y.w * z3 * sigmoid_f(z3);
        const float ss = wave_sum((g0 * g0 + g1 * g1) + (g2 * g2 + g3 * g3));
        const float rs = rsqrtf(ss * (1.f / 256.f) + EPS);
        u32x2 o; o.x = pkbf(g0 * rs, g1 * rs); o.y = pkbf(g2 * rs, g3 * rs);
        *(u32x2*)(YN + row * DINNER + g * 256 + c4) = o;
    }
    __syncthreads();
}

__device__ __forceinline__ void phase_scan(ArgsP a, int li) {
    const bf16* __restrict__ CS = (const bf16*)(a->ws + WS_CS); const float* __restrict__ CD = (const float*)(a->ws + WS_CD); bf16* __restrict__ HSB = (bf16*)(a->ws + WS_HSB);
    const int gt = blockIdx.x * NTHREADS + ltid(), NT = gridDim.x * NTHREADS;
    for (int e = gt; e < 2 * 65536; e += NT) {
        const int b = e >> 16, rem = e & 65535, h = rem >> 11, pn4 = rem & 2047;
        f32x4 hc; { const u32x2 w0 = *(const u32x2*)(CS + ((size_t)(128 * 32 + h) * 2048 + pn4) * 4); hc = (f32x4){bflo(w0.x), bfhi(w0.x), bflo(w0.y), bfhi(w0.y)}; }
#pragma unroll 8
        for (int c = 0; c < 64; ++c) { const int slot = b * 64 + c; const size_t o = ((size_t)(slot * 32 + h) * 2048 + pn4) * 4;
            const u32x2 sw = *(const u32x2*)(CS + o); const f32x4 s = (f32x4){bflo(sw.x), bfhi(sw.x), bflo(sw.y), bfhi(sw.y)}; const float d = CD[slot * 32 + h];
            u32x2 w; w.x = pkbf(hc.x, hc.y); w.y = pkbf(hc.z, hc.w); *(u32x2*)(HSB + o) = w;
            hc = hc * d + s; }
        *(f32x4*)(a->out + O_PSSM + ((size_t)((li * NPROMPT + b) * NHEADS + h) * 2048 + pn4) * 4) = hc;
    }
}

__device__ __forceinline__ void ssd3_head(int r, int hb, const bf16* Cn, const bf16* BH, const bf16* Xt, const float* s_dt, const float* s_acs, const f32x4 (&cb)[8], f32x4 (&acc)[4],
                                          const bf16* __restrict__ ZX, size_t row, int g, float Dk, int l, int wave, int fr, int fq, float& ss) {
    u32x2 zz[4];
#pragma unroll
    for (int ni = 0; ni < 4; ++ni) { const int ch = g * 256 + r * 64 + 16 * ni + 4 * fq; zz[ni] = *(const u32x2*)(ZX + row * ZXW + ch); }
    const float al = s_acs[r * 128 + l];
#pragma unroll
    for (int ni = 0; ni < 4; ++ni) acc[ni] = (f32x4){0.f, 0.f, 0.f, 0.f};
    const bf16* Hs = BH + hb * 64 * LDX;
#pragma unroll
    for (int ks = 0; ks < 4; ++ks) { const bf16x8 af = LFRAG(Cn, l, LDX, ks);
#pragma unroll
        for (int ni = 0; ni < 4; ++ni) { const bf16x8 bb = LFRAG(Hs, 16 * ni + fr, LDX, ks); acc[ni] = MFMA16(bb, af, acc[ni]); } }
    const float e = __expf(al);
#pragma unroll
    for (int ni = 0; ni < 4; ++ni) acc[ni] = acc[ni] * e;
#pragma unroll
    for (int ks = 0; ks < 4; ++ks) if (2 * ks <= wave) {
        unsigned mw[4];
#pragma unroll
        for (int hf = 0; hf < 2; ++hf) { const int ni = 2 * ks + hf, s0 = 16 * ni + 4 * fq;
            const f32x4 av = *(const f32x4*)(s_acs + r * 128 + s0), dv = *(const f32x4*)(s_dt + r * 128 + s0);
            float m[4];
#pragma unroll
            for (int j = 0; j < 4; ++j) m[j] = (s0 + j <= l) ? cb[ni][j] * __expf(al - av[j]) * dv[j] : 0.f;
            mw[2 * hf] = pkbf(m[0], m[1]); mw[2 * hf + 1] = pkbf(m[2], m[3]); }
        const u32x4 afu = (u32x4){mw[0], mw[1], mw[2], mw[3]};
        const bf16x8 af = __builtin_bit_cast(bf16x8, afu);
#pragma unroll
        for (int ni = 0; ni < 4; ++ni) { const int chl = r * 64 + 16 * ni + fr, sw = TSW(chl);
            const u32x2 b0 = *(const u32x2*)(Xt + chl * LDX + ((32 * ks + 4 * fq) ^ sw)), b1 = *(const u32x2*)(Xt + chl * LDX + ((32 * ks + 16 + 4 * fq) ^ sw));
            const u32x4 bu = (u32x4){b0.x, b0.y, b1.x, b1.y};
            acc[ni] = MFMA16(__builtin_bit_cast(bf16x8, bu), af, acc[ni]); }
    }
#pragma unroll
    for (int ni = 0; ni < 4; ++ni) {
        float xv[4];
#pragma unroll
        for (int j = 0; j < 4; ++j) { const int chl = r * 64 + 16 * ni + 4 * fq + j; xv[j] = bf2f(Xt[chl * LDX + (l ^ TSW(chl))]); }
        const float zv[4] = {bflo(zz[ni].x), bfhi(zz[ni].x), bflo(zz[ni].y), bfhi(zz[ni].y)};
#pragma unroll
        for (int j = 0; j < 4; ++j) { const float q = (acc[ni][j] + Dk * xv[j]) * zv[j] * sigmoid_f(zv[j]); acc[ni][j] = q; ss += q * q; } }
}
__device__ __forceinline__ void ssd3_unit(ArgsP a, int li, unsigned char* lds, const bf16* __restrict__ hs, int slot, int g, int R0, int len, int, int, int) {
    const int tid = ltid(), lane = tid & 63, wave = __builtin_amdgcn_readfirstlane(tid >> 6);
    const bf16* __restrict__ ZX = (const bf16*)(a->ws + WS_ZX); const float* __restrict__ DT = (const float*)(a->ws + WS_DT); bf16* __restrict__ YN = (bf16*)(a->ws + WS_YN);
    bf16* Cn = (bf16*)lds; bf16* BH = Cn + 128 * LDX; bf16* Xt = BH + 128 * LDX;
    float* s_dt = (float*)(Xt + 256 * LDX); float* s_acs = s_dt + 512;
    const int fr = lane & 15, fq = lane >> 4, h0 = g * 4;
    {
        const float* __restrict__ cw = a->in[I_ACONVW] + (size_t)li * 4 * CONVD; const float* __restrict__ cbias = a->in[I_ACONVB] + (size_t)li * CONVD;
        const bool meta = (slot == 128), chunk0 = (!meta && (slot & 63) == 0);
        const int half = tid >> 8, ncb = tid & 15, nrun = (tid >> 4) & 15, nc0 = (half ? 2048 : 3072) + g * 128 + ncb * 8;
        const int xcb = tid & 31, xrun = tid >> 5, xc0 = g * 256 + xcb * 8;
        u32x4 rn[11], rx[11];
        conv_load_run(ZX, R0 + 8 * nrun, nc0, (nrun == 0) ? (meta ? 2 : (chunk0 ? 1 : 0)) : 0, 8 * nrun < len, rn);
        conv_load_run(ZX, R0 + 8 * xrun, xc0, (xrun == 0) ? (meta ? 2 : (chunk0 ? 1 : 0)) : 0, 8 * xrun < len, rx);
        ssd_acs(DT, a->in[I_ALOG] + li * NHEADS, R0, len, h0, s_dt, s_acs, wave, lane);
        { ConvW W; conv_load_w(cw, cbias, nc0, W); conv_item_n(rn, W, half ? BH : Cn, nrun, ncb * 8); }
        { ConvW W; conv_load_w(cw, cbias, xc0, W); const float one[8] = {1.f, 1.f, 1.f, 1.f, 1.f, 1.f, 1.f, 1.f}; conv_item_t(rx, W, one, Xt, xcb * 8, xrun); }
        if (!meta && (slot & 63) == 63) {
            float* __restrict__ dst = a->out + O_PCONV + (size_t)((li * NPROMPT + (slot >> 6)) * 3) * CONVD;
            if (nrun == 15) conv_state_out(rn, dst + nc0);
            if (xrun == 15) conv_state_out(rx, dst + xc0);
        }
    }
    __syncthreads();
    u32x2 hv[8];
#pragma unroll
    for (int k = 0; k < 8; ++k) { const int item = tid + NTHREADS * k; hv[k] = (u32x2){0u, 0u}; if (hs) hv[k] = *(const u32x2*)(hs + (size_t)item * 4); }
    const bool active = (16 * wave < len);
    f32x4 cb[8];
#pragma unroll
    for (int ni = 0; ni < 8; ++ni) cb[ni] = (f32x4){0.f, 0.f, 0.f, 0.f};
    if (active) {
#pragma unroll
    for (int ks = 0; ks < 4; ++ks) { const bf16x8 af = LFRAG(Cn, 16 * wave + fr, LDX, ks);
#pragma unroll
        for (int ni = 0; ni < 8; ++ni) { const bf16x8 bb = LFRAG(BH, 16 * ni + fr, LDX, ks); cb[ni] = MFMA16(bb, af, cb[ni]); } }
    }
    __syncthreads();
#pragma unroll
    for (int k = 0; k < 8; ++k) { const int item = tid + NTHREADS * k, hp = item >> 5, n4 = item & 31; *(u32x2*)(BH + hp * LDX + n4 * 4) = hv[k]; }
#pragma unroll
    for (int k = 0; k < 8; ++k) { const int item = tid + NTHREADS * k; hv[k] = (u32x2){0u, 0u}; if (hs) hv[k] = *(const u32x2*)(hs + (size_t)(2 * 8192) + (size_t)item * 4); }
    __syncthreads();
    const int l = 16 * wave + fr;
    const size_t row = (size_t)(R0 + ((l < len) ? l : 0));
    f32x4 y0[4], y1[4], y2[4], y3[4];
    float ss = 0.f;
    const float* dsk = a->in[I_ADSKIP] + li * NHEADS + h0;
    if (active) {
    ssd3_head(0, 0, Cn, BH, Xt, s_dt, s_acs, cb, y0, ZX, row, g, dsk[0], l, wave, fr, fq, ss);
    ssd3_head(1, 1, Cn, BH, Xt, s_dt, s_acs, cb, y1, ZX, row, g, dsk[1], l, wave, fr, fq, ss);
    }
    __syncthreads();
#pragma unroll
    for (int k = 0; k < 8; ++k) { const int item = tid + NTHREADS * k, hp = item >> 5, n4 = item & 31; *(u32x2*)(BH + hp * LDX + n4 * 4) = hv[k]; }
    __syncthreads();
    if (active) {
    ssd3_head(2, 0, Cn, BH, Xt, s_dt, s_acs, cb, y2, ZX, row, g, dsk[2], l, wave, fr, fq, ss);
    ssd3_head(3, 1, Cn, BH, Xt, s_dt, s_acs, cb, y3, ZX, row, g, dsk[3], l, wave, fr, fq, ss);
    ss += __shfl_xor(ss, 16); ss += __shfl_xor(ss, 32);
    }
    const float rs = rsqrtf(ss * (1.f / 256.f) + EPS);
    if (active && l < len) {
        bf16* yrow = YN + row * DINNER + g * 256 + 4 * fq;
#pragma unroll
        for (int ni = 0; ni < 4; ++ni) {
            u32x2 w;
            w.x = pkbf(y0[ni][0] * rs, y0[ni][1] * rs); w.y = pkbf(y0[ni][2] * rs, y0[ni][3] * rs); *(u32x2*)(yrow + 0 * 64 + 16 * ni) = w;
            w.x = pkbf(y1[ni][0] * rs, y1[ni][1] * rs); w.y = pkbf(y1[ni][2] * rs, y1[ni][3] * rs); *(u32x2*)(yrow + 1 * 64 + 16 * ni) = w;
            w.x = pkbf(y2[ni][0] * rs, y2[ni][1] * rs); w.y = pkbf(y2[ni][2] * rs, y2[ni][3] * rs); *(u32x2*)(yrow + 2 * 64 + 16 * ni) = w;
            w.x = pkbf(y3[ni][0] * rs, y3[ni][1] * rs); w.y = pkbf(y3[ni][2] * rs, y3[ni][3] * rs); *(u32x2*)(yrow + 3 * 64 + 16 * ni) = w;
        }
    }
    __syncthreads();
}
__device__ __forceinline__ void phase_ssd1(ArgsP a, int li, unsigned char* lds, int tid, int wave, int lane) {
    const int c = blockIdx.x;
#pragma unroll 1
    for (int j = 0; j < 4; ++j) {
        const int u = c + 256 * j;
        f32x4 st[4][4];
        ssd_sample_issue(a, li, u >> 3, u & 7, st);
#ifndef PROBE_SSD1
#define PROBE_SSD1 0
#endif
#pragma unroll 1
        for (int rp = 0; rp < (PROBE_SSD1 == 1 ? 2 : 1); ++rp) { const int slot = u >> 3, g = u & 7; ssd1_unit(a, li, lds, slot, g, (slot >> 6) * SEQ + (slot & 63) * 128, 128, tid, wave, lane); }
        ssd_sample_unit(a, li, lds, u >> 3, u & 7, st);
    }
    if (c < 8) ssd1_unit(a, li, lds, 128, c, ROW_M, NMETA, tid, wave, lane);
    else if (c < 16) ssd3_unit(a, li, lds, nullptr, 128, c - 8, ROW_M, NMETA, tid, wave, lane);
}
__device__ __forceinline__ void phase_ssd3(ArgsP a, int li, unsigned char* lds, int tid, int wave, int lane) {
    const bf16* HSB = (const bf16*)(a->ws + WS_HSB);
#pragma unroll 1
    for (int u = blockIdx.x; u < 1024; u += gridDim.x) { const int slot = u >> 3, g = u & 7; ssd3_unit(a, li, lds, HSB + (size_t)(slot * 32 + g * 4) * 8192, slot, g, (slot >> 6) * SEQ + (slot & 63) * 128, 128, tid, wave, lane); }
}

constexpr int KS_LD = 72, VT_LD = 264, P_LD = 232, NKEYS = 208;
__device__ __forceinline__ void attn_prompt_unit(ArgsP a, int lj, unsigned char* lds, int b, int kvh, int qb, int, int, int) {
    const int tid = ltid(), lane = tid & 63, wave = __builtin_amdgcn_readfirstlane(tid >> 6);
    const bf16* __restrict__ Q = (const bf16*)(a->ws + WS_Q); const bf16* __restrict__ KV = (const bf16*)(a->ws + WS_KV); bf16* __restrict__ AO = (bf16*)(a->ws + WS_AO);
    bf16* Ks = (bf16*)lds; bf16* Vt = Ks + NKEYS * KS_LD; bf16* Pw = Vt + 64 * VT_LD + wave * 16 * P_LD;
    const int fr = lane & 15, fq = lane >> 4, t0 = qb * 64, Rb = b * SEQ;
    const int r = wave >> 1, th = (wave & 1) * 32, qh = kvh * 4 + r;
    bf16x8 q0[2], q1[2];
#pragma unroll
    for (int ks = 0; ks < 2; ++ks) { q0[ks] = *(const bf16x8*)(Q + (size_t)(Rb + t0 + th + fr) * DM + qh * 64 + 32 * ks + 8 * fq); q1[ks] = *(const bf16x8*)(Q + (size_t)(Rb + t0 + th + 16 + fr) * DM + qh * 64 + 32 * ks + 8 * fq); }
    {
        u32x4 kv[4];
#pragma unroll
        for (int k = 0; k < 4; ++k) { const int it = tid + NTHREADS * k, key = it >> 3, ch = it & 7; kv[k] = (u32x4){0u, 0u, 0u, 0u};
            if (it < NKEYS * 8) { int row; if (key < 16) row = ROW_M + key; else { int s = t0 - 128 + key - 16; if (s < 0) s = 0; row = Rb + s; }
                kv[k] = *(const u32x4*)(KV + (size_t)row * KVW + kvh * 64 + ch * 8); } }
        u32x4 v0[2], v1[2];
#pragma unroll
        for (int k = 0; k < 2; ++k) { const int it = tid + NTHREADS * k, dbl = it & 7, kp = it >> 3; v0[k] = (u32x4){0u, 0u, 0u, 0u}; v1[k] = v0[k];
            if (it < (NKEYS / 2) * 8) { const int k0 = 2 * kp, k1 = k0 + 1; int s0 = t0 - 128 + k0 - 16, s1 = t0 - 128 + k1 - 16; if (s0 < 0) s0 = 0; if (s1 < 0) s1 = 0;
                const int r0 = (k0 < 16) ? ROW_M + k0 : Rb + s0, r1 = (k1 < 16) ? ROW_M + k1 : Rb + s1;
                v0[k] = *(const u32x4*)(KV + (size_t)r0 * KVW + 256 + kvh * 64 + dbl * 8); v1[k] = *(const u32x4*)(KV + (size_t)r1 * KVW + 256 + kvh * 64 + dbl * 8); } }
#pragma unroll
        for (int k = 0; k < 4; ++k) { const int it = tid + NTHREADS * k, key = it >> 3, ch = it & 7; if (it < NKEYS * 8) *(u32x4*)(Ks + key * KS_LD + ch * 8) = kv[k]; }
#pragma unroll
        for (int k = 0; k < 2; ++k) { const int it = tid + NTHREADS * k, dbl = it & 7, kp = it >> 3;
            if (it < (NKEYS / 2) * 8) { const int col = (2 * kp) ^ (8 * dbl);
                const unsigned a0[4] = {v0[k].x, v0[k].y, v0[k].z, v0[k].w}, a1[4] = {v1[k].x, v1[k].y, v1[k].z, v1[k].w};
#pragma unroll
                for (int j = 0; j < 4; ++j) {
                    *(unsigned*)(Vt + (dbl * 8 + 2 * j) * VT_LD + col) = (a0[j] & 0xffffu) | (a1[j] << 16);
                    *(unsigned*)(Vt + (dbl * 8 + 2 * j + 1) * VT_LD + col) = (a0[j] >> 16) | (a1[j] & 0xffff0000u); } } }
#pragma unroll
        for (int k = 0; k < 3; ++k) { const int idx = tid + NTHREADS * k, row = idx / 24, c = idx - row * 24; *(unsigned*)(Vt + row * VT_LD + ((NKEYS + 2 * c) ^ TSW(row))) = 0u; }
    }
    __syncthreads();
    const float sink = a->in[I_SINKS][lj * NQ + qh];
#pragma unroll 1
    for (int blk = 0; blk < 2; ++blk) {
        const int tq = th + blk * 16 + fr, t = t0 + tq;
        bf16x8 qa2[2];
#pragma unroll
        for (int ks = 0; ks < 2; ++ks) qa2[ks] = (blk == 0) ? q0[ks] : q1[ks];
        f32x4 sc[13];
#pragma unroll
        for (int ni = 0; ni < 13; ++ni) sc[ni] = (f32x4){0.f, 0.f, 0.f, 0.f};
#pragma unroll
        for (int ni = 0; ni < 13; ++ni) {
            const bf16x8 b0 = *(const bf16x8*)(Ks + (16 * ni + fr) * KS_LD + 8 * fq), b1 = *(const bf16x8*)(Ks + (16 * ni + fr) * KS_LD + 32 + 8 * fq);
            sc[ni] = MFMA16(b0, qa2[0], sc[ni]); sc[ni] = MFMA16(b1, qa2[1], sc[ni]);
            }
        int lo = tq + 17; { const int l2 = 144 - t0; if (l2 > lo) lo = l2; }
        const unsigned span = (unsigned)(tq + 144 - lo);
        float mx = -INFINITY;
#pragma unroll
        for (int ni = 0; ni < 13; ++ni)
#pragma unroll
            for (int j = 0; j < 4; ++j) { const int key = 16 * ni + 4 * fq + j; const bool vis = (ni == 0) || ((unsigned)(key - lo) <= span);
                const float v = vis ? sc[ni][j] * 0.125f : -INFINITY; sc[ni][j] = v; mx = fmaxf(mx, v); }
        mx = fmaxf(mx, __shfl_xor(mx, 16)); mx = fmaxf(mx, __shfl_xor(mx, 32)); mx = fmaxf(mx, sink);
        float sum = 0.f;
#pragma unroll
        for (int ni = 0; ni < 13; ++ni)
#pragma unroll
            for (int j = 0; j < 4; ++j) { const float p = __expf(sc[ni][j] - mx); sc[ni][j] = p; sum += p; }
        sum += __shfl_xor(sum, 16); sum += __shfl_xor(sum, 32); sum += __expf(sink - mx);
        const float inv = frcp(sum);
#pragma unroll
        for (int ni = 0; ni < 13; ++ni) { u32x2 w; w.x = pkbf(sc[ni][0] * inv, sc[ni][1] * inv); w.y = pkbf(sc[ni][2] * inv, sc[ni][3] * inv); *(u32x2*)(Pw + fr * P_LD + 16 * ni + 4 * fq) = w; }
        *(u32x2*)(Pw + fr * P_LD + NKEYS + 4 * fq) = (u32x2){0u, 0u};
        asm volatile("s_waitcnt lgkmcnt(0)" ::: "memory");
        f32x4 o[4];
#pragma unroll
        for (int ni = 0; ni < 4; ++ni) o[ni] = (f32x4){0.f, 0.f, 0.f, 0.f};
#pragma unroll
        for (int ks = 0; ks < 7; ++ks) { const bf16x8 af = *(const bf16x8*)(Pw + fr * P_LD + 32 * ks + 8 * fq);
#pragma unroll
            for (int ni = 0; ni < 4; ++ni) { const int vr = 16 * ni + fr; const bf16x8 bb = *(const bf16x8*)(Vt + vr * VT_LD + ((32 * ks + 8 * fq) ^ TSW(vr))); o[ni] = MFMA16(bb, af, o[ni]); }
            }
#pragma unroll
        for (int ni = 0; ni < 4; ++ni) { u32x2 w; w.x = pkbf(o[ni][0], o[ni][1]); w.y = pkbf(o[ni][2], o[ni][3]); *(u32x2*)(AO + (size_t)(Rb + t) * DM + qh * 64 + 16 * ni + 4 * fq) = w; }
        asm volatile("s_waitcnt lgkmcnt(0)" ::: "memory");
    }
    __syncthreads();
}
constexpr int SK_LD = 72, SV_LD = 200, SP_LD = 168, SKEYS = 160;
__device__ __forceinline__ void attn_sample_pair(ArgsP a, int lj, unsigned char* lds, int bp, int kvh, int, int, int) {
    const int tid = ltid(), lane = tid & 63, wave = __builtin_amdgcn_readfirstlane(tid >> 6);
    const bf16* __restrict__ Q = (const bf16*)(a->ws + WS_Q); const bf16* __restrict__ KV = (const bf16*)(a->ws + WS_KV); bf16* __restrict__ AO = (bf16*)(a->ws + WS_AO);
    const float* __restrict__ CK = a->in[I_CK]; const float* __restrict__ CV = a->in[I_CV];
    constexpr int HALF_B = (SKEYS * SK_LD + 64 * SV_LD) * 2;
    const int fr = lane & 15, fq = lane >> 4;
#pragma unroll 1
    for (int it = tid; it < 2 * SKEYS * 8; it += NTHREADS) { const int hf = it / (SKEYS * 8), rem = it - hf * (SKEYS * 8), key = rem >> 3, ch = rem & 7, bb = 2 * bp + hf;
        bf16* Ks = (bf16*)(lds + hf * HALF_B);
        u32x4 w = (u32x4){0u, 0u, 0u, 0u};
        if (key < 16) w = *(const u32x4*)(KV + (size_t)(ROW_M + key) * KVW + kvh * 64 + ch * 8);
        else if (key < 144) { const float* p = CK + ((size_t)(bb * 128 + (key - 16)) * NKV + kvh) * 64 + ch * 8; const f32x4 x0 = *(const f32x4*)p, x1 = *(const f32x4*)(p + 4);
            w.x = pkbf(x0.x, x0.y); w.y = pkbf(x0.z, x0.w); w.z = pkbf(x1.x, x1.y); w.w = pkbf(x1.z, x1.w); }
        else if (key < 152) w = *(const u32x4*)(KV + (size_t)(ROW_S + bb * 8 + (key - 144)) * KVW + kvh * 64 + ch * 8);
        *(u32x4*)(Ks + key * SK_LD + ch * 8) = w; }
#pragma unroll 1
    for (int it = tid; it < 2 * 96 * 8; it += NTHREADS) { const int hf = it / (96 * 8), rem = it - hf * (96 * 8), dbl = rem & 7, kp = rem >> 3, bb = 2 * bp + hf;
        bf16* Vt = (bf16*)(lds + hf * HALF_B) + SKEYS * SK_LD;
        unsigned a0[4] = {0u, 0u, 0u, 0u}, a1[4] = {0u, 0u, 0u, 0u};
        const int k0 = 2 * kp;
        if (k0 < 16) { const u32x4 x = *(const u32x4*)(KV + (size_t)(ROW_M + k0) * KVW + 256 + kvh * 64 + dbl * 8), y = *(const u32x4*)(KV + (size_t)(ROW_M + k0 + 1) * KVW + 256 + kvh * 64 + dbl * 8);
            a0[0] = x.x; a0[1] = x.y; a0[2] = x.z; a0[3] = x.w; a1[0] = y.x; a1[1] = y.y; a1[2] = y.z; a1[3] = y.w; }
        else if (k0 < 144) { const float* p = CV + ((size_t)(bb * 128 + (k0 - 16)) * NKV + kvh) * 64 + dbl * 8; const f32x4 x0 = *(const f32x4*)p, x1 = *(const f32x4*)(p + 4), y0 = *(const f32x4*)(p + NKV * 64), y1 = *(const f32x4*)(p + NKV * 64 + 4);
            a0[0] = pkbf(x0.x, x0.y); a0[1] = pkbf(x0.z, x0.w); a0[2] = pkbf(x1.x, x1.y); a0[3] = pkbf(x1.z, x1.w); a1[0] = pkbf(y0.x, y0.y); a1[1] = pkbf(y0.z, y0.w); a1[2] = pkbf(y1.x, y1.y); a1[3] = pkbf(y1.z, y1.w); }
        else if (k0 < 152) { const u32x4 x = *(const u32x4*)(KV + (size_t)(ROW_S + bb * 8 + (k0 - 144)) * KVW + 256 + kvh * 64 + dbl * 8), y = *(const u32x4*)(KV + (size_t)(ROW_S + bb * 8 + (k0 - 143)) * KVW + 256 + kvh * 64 + dbl * 8);
            a0[0] = x.x; a0[1] = x.y; a0[2] = x.z; a0[3] = x.w; a1[0] = y.x; a1[1] = y.y; a1[2] = y.z; a1[3] = y.w; }
        const int col = (2 * kp) ^ (8 * dbl);
#pragma unroll
        for (int j = 0; j < 4; ++j) {
            *(unsigned*)(Vt + (dbl * 8 + 2 * j) * SV_LD + col) = (a0[j] & 0xffffu) | (a1[j] << 16);
            *(unsigned*)(Vt + (dbl * 8 + 2 * j + 1) * SV_LD + col) = (a0[j] >> 16) | (a1[j] & 0xffff0000u); } }
    if (lj == 0) {
#pragma unroll 1
        for (int it = tid; it < 2 * 128 * 16; it += NTHREADS) { const int hf = it >> 11, rem = it & 2047, w = rem >> 4, c4 = (rem & 15) * 4, bb = 2 * bp + hf;
            const size_t o = ((size_t)(bb * 128 + w) * NKV + kvh) * 64 + c4;
            f32x4 kx, vx;
            if (w < 120) { const size_t i = ((size_t)(bb * 128 + w + 8) * NKV + kvh) * 64 + c4; kx = *(const f32x4*)(CK + i); vx = *(const f32x4*)(CV + i); }
            else { const bf16* rp = KV + (size_t)(ROW_S + bb * 8 + (w - 120)) * KVW + kvh * 64 + c4; const u32x2 k2 = *(const u32x2*)rp, v2 = *(const u32x2*)(rp + 256);
                kx = (f32x4){bflo(k2.x), bfhi(k2.x), bflo(k2.y), bfhi(k2.y)}; vx = (f32x4){bflo(v2.x), bfhi(v2.x), bflo(v2.y), bfhi(v2.y)}; }
            *(f32x4*)(a->out + O_SCK + o) = kx; *(f32x4*)(a->out + O_SCV + o) = vx; }
    }
    __syncthreads();
    if (wave < 4) {
        const int hf = wave >> 1, rb = wave & 1, bb = 2 * bp + hf;
        const bf16* Ks = (const bf16*)(lds + hf * HALF_B); const bf16* Vt = Ks + SKEYS * SK_LD; bf16* Pw = (bf16*)(lds + 2 * HALF_B) + wave * 16 * SP_LD;
        const int r = 2 * rb + (fr >> 3), t = fr & 7, qh = kvh * 4 + r;
        const size_t qrow = (size_t)(ROW_S + bb * 8 + t);
        bf16x8 qa[2];
        if (lj == 0) {
#pragma unroll
            for (int ks = 0; ks < 2; ++ks) qa[ks] = *(const bf16x8*)(Q + qrow * DM + qh * 64 + 32 * ks + 8 * fq);
        } else {
            const float* __restrict__ SL = (const float*)(a->ws + WS_SLAB) + (size_t)(qrow - ROW_S) * DM + qh * 64 + 8 * fq;
#pragma unroll
            for (int ks = 0; ks < 2; ++ks) { f32x4 x0 = (f32x4){0.f, 0.f, 0.f, 0.f}, x1 = x0;
#pragma unroll
                for (int sl = 0; sl < 4; ++sl) { const float* p = SL + (size_t)sl * (1280 * 1024) + 32 * ks; x0 = x0 + *(const f32x4*)p; x1 = x1 + *(const f32x4*)(p + 4); }
                const u32x4 w = (u32x4){pkbf(x0.x, x0.y), pkbf(x0.z, x0.w), pkbf(x1.x, x1.y), pkbf(x1.z, x1.w)}; qa[ks] = __builtin_bit_cast(bf16x8, w); }
        }
        const float sink = a->in[I_SINKS][lj * NQ + qh];
        f32x4 sc[10];
#pragma unroll
        for (int ni = 0; ni < 10; ++ni) sc[ni] = (f32x4){0.f, 0.f, 0.f, 0.f};
#pragma unroll
        for (int ni = 0; ni < 10; ++ni) {
            const bf16x8 b0 = *(const bf16x8*)(Ks + (16 * ni + fr) * SK_LD + 8 * fq), b1 = *(const bf16x8*)(Ks + (16 * ni + fr) * SK_LD + 32 + 8 * fq);
            sc[ni] = MFMA16(b0, qa[0], sc[ni]); sc[ni] = MFMA16(b1, qa[1], sc[ni]); }
        float mx = -INFINITY;
#pragma unroll
        for (int ni = 0; ni < 10; ++ni)
#pragma unroll
            for (int j = 0; j < 4; ++j) { const int key = 16 * ni + 4 * fq + j;
                const bool vis = (ni == 0) || ((key < 144) ? (key - 16 > t) : (key - 144 <= t));
                const float v = vis ? sc[ni][j] * 0.125f : -INFINITY; sc[ni][j] = v; mx = fmaxf(mx, v); }
        mx = fmaxf(mx, __shfl_xor(mx, 16)); mx = fmaxf(mx, __shfl_xor(mx, 32)); mx = fmaxf(mx, sink);
        float sum = 0.f;
#pragma unroll
        for (int ni = 0; ni < 10; ++ni)
#pragma unroll
            for (int j = 0; j < 4; ++j) { const float p = __expf(sc[ni][j] - mx); sc[ni][j] = p; sum += p; }
        sum += __shfl_xor(sum, 16); sum += __shfl_xor(sum, 32); sum += __expf(sink - mx);
        const float inv = frcp(sum);
#pragma unroll
        for (int ni = 0; ni < 10; ++ni) { u32x2 w; w.x = pkbf(sc[ni][0] * inv, sc[ni][1] * inv); w.y = pkbf(sc[ni][2] * inv, sc[ni][3] * inv); *(u32x2*)(Pw + fr * SP_LD + 16 * ni + 4 * fq) = w; }
        asm volatile("s_waitcnt lgkmcnt(0)" ::: "memory");
        f32x4 o[4];
#pragma unroll
        for (int ni = 0; ni < 4; ++ni) o[ni] = (f32x4){0.f, 0.f, 0.f, 0.f};
#pragma unroll
        for (int ks = 0; ks < 5; ++ks) { const bf16x8 af = *(const bf16x8*)(Pw + fr * SP_LD + 32 * ks + 8 * fq);
#pragma unroll
            for (int ni = 0; ni < 4; ++ni) { const int vr = 16 * ni + fr; const bf16x8 bb2 = *(const bf16x8*)(Vt + vr * SV_LD + ((32 * ks + 8 * fq) ^ TSW(vr))); o[ni] = MFMA16(bb2, af, o[ni]); } }
#pragma unroll
        for (int ni = 0; ni < 4; ++ni) { u32x2 w; w.x = pkbf(o[ni][0], o[ni][1]); w.y = pkbf(o[ni][2], o[ni][3]); *(u32x2*)(AO + qrow * DM + qh * 64 + 16 * ni + 4 * fq) = w; }
    }
    __syncthreads();
}
__device__ __forceinline__ void phase_attn(ArgsP a, int lj, unsigned char* lds, int tid, int wave, int lane) {
    if (lj == 0) {
        const bf16* KV = (const bf16*)(a->ws + WS_KV);
        const int gt = blockIdx.x * NTHREADS + tid, NT = gridDim.x * NTHREADS;
        for (int e = gt; e < 2 * 128 * 512; e += NT) { const int b = e >> 16, w = (e >> 9) & 127, c = e & 511;
            const float v = bf2f(KV[(size_t)(b * SEQ + SEQ - 128 + w) * KVW + c]);
            if (c < 256) a->out[O_PCK + (size_t)(b * 128 + w) * 256 + c] = v; else a->out[O_PCV + (size_t)(b * 128 + w) * 256 + (c - 256)] = v; }
    }
    const int xg = blockIdx.x & 7, xi = blockIdx.x >> 3;
#pragma unroll 1
    for (int j = 0; j < 4; ++j) { const int u = 128 * xg + 4 * xi + j, qb = u & 127, kvh = (u >> 7) & 3, b = u >> 9; attn_prompt_unit(a, lj, lds, b, kvh, qb, tid, wave, lane); }
    { const int su = blockIdx.x; attn_sample_pair(a, lj, lds, su >> 2, su & 3, tid, wave, lane); }
}

constexpr int PH_B = 9 * 2, PH_F = PH_B + 7 * 2, NPHASES = PH_F + 1;
template <class Epi> __device__ __forceinline__ void run_gemm(LAS unsigned char* lds, const bf16* A, const bf16* Bt, int N, int K, const Epi& E) {
    pg8::Gemm g{A, Bt, MP, N, K}; pg8::StaticOrder S; S.init(MP, N, K, (int)gridDim.x, (int)blockIdx.x);
    pg8::gemm_phase<Epi, pg8::StaticOrder, true, true>(lds, g, S, E);
}
template <class Epi> __device__ __forceinline__ void run_gemm_res(LAS unsigned char* lds, const bf16* A, const bf16* Bt, int K, int S_, const Epi& E) {
    pg8::Gemm g{A, Bt, MP, 1024, K}; pg8::ResOrder S; S.init(K, S_, (int)gridDim.x, (int)blockIdx.x);
    pg8::gemm_phase<Epi, pg8::ResOrder, true, true>(lds, g, S, E);
}

__global__ void __launch_bounds__(NTHREADS, 2) yoco_fwd(Args args) {
    extern __shared__ __attribute__((aligned(16))) unsigned char lds[];
    LAS unsigned char* ldsl = (LAS unsigned char*)lds;
    const int tid0 = threadIdx.x;
    for (int u = tid0; u < (LDS_BYTES - LDSCTL_OFF) / 4; u += NTHREADS) ((LAS unsigned*)(ldsl + LDSCTL_OFF))[u] = 0u;
    __syncthreads();
    const int lo = args.ph_lo, hi = args.ph_hi;
    XcdBarrier bar; bar.bar = (unsigned*)(args.ws + WS_CTL) + CW_BAR; bar.x = 0; bar.st = nullptr;
    if (hi - lo > 1) bar = xcd_barrier_post((unsigned*)(args.ws + WS_CTL) + CW_BAR, (volatile LAS unsigned*)(ldsl + MISC_OFF) + 8);
    int rep = 0;
#pragma unroll 1
    for (int p = lo; p < hi;) {
        ArgsP la = (ArgsP)__builtin_amdgcn_kernarg_segment_ptr(); asm volatile("" : "+s"(la));
        unsigned char* ws = la->ws;
        const int tid = ltid();
        const int lane = tid & 63, wave = __builtin_amdgcn_readfirstlane(tid >> 6);
        bf16* HN = (bf16*)(ws + WS_HN); float* H = (float*)(ws + WS_H);
        int kind, li = 0, lj = 0, layer = 0;
        int nslab = 8;
        if (p == 0) kind = 0;
        else if (p < PH_B) { li = p / 9; layer = li; const int sub = p % 9;
            kind = (sub == 0) ? 1 : (sub == 1) ? 3 : (sub == 2) ? 5 : (sub == 3) ? 6 : (sub == 4) ? 7 : (sub == 5) ? 8 : (sub == 6) ? 1 : (sub == 7) ? 9 : 10; }
        else if (p < PH_F) { lj = (p - PH_B) / 7; layer = 2 + lj; const int sub = (p - PH_B) % 7;
            kind = (sub == 0) ? 1 : (sub == 1) ? 11 : (sub == 2) ? 12 : (sub == 3) ? 13 : (sub == 4) ? 1 : (sub == 5) ? 9 : 10; if (sub == 4) nslab = 4; }
        else kind = 14;
#ifndef KMASK
#define KMASK 0xffff
#endif
#define KON(k) ((KMASK >> (k)) & 1)
#ifndef REP_MASK
#define REP_MASK 0
#endif
        if (KON(0) && kind == 0) { phase_prologue(la, ldsl, wave, lane); phase_norm(la, 1, 0, wave, lane); }
        else if (KON(1) && kind == 1) phase_norm(la, 0, nslab, wave, lane);
        else if (KON(3) && kind == 3) { pg8::EpiInProj E{(bf16*)(ws + WS_ZX), (float*)(ws + WS_DT), la->in[I_ADTB] + li * NHEADS}; run_gemm(ldsl, HN, (const bf16*)(ws + WS_WIN + li * SZ_WIN), INPROJ_P, 1024, E); }
        else if (KON(5) && kind == 5) phase_ssd1(la, li, lds, tid, wave, lane);
        else if (KON(6) && kind == 6) phase_scan(la, li);
        else if (KON(7) && kind == 7) phase_ssd3(la, li, lds, tid, wave, lane);
        else if (KON(8) && (kind == 8 || kind == 10 || kind == 13)) {
            const bf16* A; const bf16* Bt; int K;
            if (kind == 8) { A = (const bf16*)(ws + WS_YN); Bt = (const bf16*)(ws + WS_WOUT + li * SZ_WOUT); K = 2048; }
            else if (kind == 10) { A = (const bf16*)(ws + WS_U); Bt = (const bf16*)(ws + WS_WDN + layer * SZ_WDN); K = 4096; }
            else { A = (const bf16*)(ws + WS_AO); Bt = (const bf16*)(ws + WS_WO + lj * SZ_WO); K = 1024; }
            pg8::EpiRes E{(kind == 8 && li == 0) ? la->in[I_XP] : (const float*)H, H, (float*)(ws + WS_SLAB)}; run_gemm_res(ldsl, A, Bt, K, K == 1024 ? 4 : 8, E); }
        else if (KON(9) && kind == 9) { pg8::EpiBf<1> E{(bf16*)(ws + WS_U), 4096, 1 << 20, nullptr, 0}; run_gemm(ldsl, HN, (const bf16*)(ws + WS_WUP + layer * SZ_WUP), 4096, 1024, E); }
        else if (KON(11) && kind == 11) { pg8::EpiBf<0> E{(bf16*)(ws + WS_Q), 1024, 4, (bf16*)(ws + WS_KV), KVW};
            if (lj == 0) run_gemm(ldsl, HN, (const bf16*)(ws + WS_WQKV0), 1536, 1024, E);
            else { pg8::EpiQSplit E2{(bf16*)(ws + WS_Q), (float*)(ws + WS_SLAB)}; run_gemm_res(ldsl, HN, (const bf16*)(ws + WS_WQ1), 1024, 4, E2); } }
        else if (KON(12) && kind == 12) phase_attn(la, lj, lds, tid, wave, lane);
        else if (KON(14) && kind == 14) phase_final(la, wave, lane);
        bool again = false;
        if (REP_MASK != 0) { if (rep == 0 && ((REP_MASK >> kind) & 1)) { rep = 1; again = true; } else rep = 0; }
#ifdef PROBE_DOUBLE_BARRIER
        if (p + 1 < hi || again) xcd_barrier(bar);
#endif
        if (p + 1 < hi || again) xcd_barrier(bar); else { asm volatile("s_waitcnt vmcnt(0)" ::: "memory"); __syncthreads(); }
        if (!again) ++p;
    }
}

#ifndef MK_PER_PHASE
#define MK_PER_PHASE 0
#endif
extern "C" void kernel_launch(void* const* d_in, const int* in_sizes, int n_in, void* d_out, int out_size, void* d_ws, size_t ws_size, hipStream_t stream) {
    static int grid = 0;
    if (grid == 0) {
        if (n_in != 26 || (size_t)out_size != O_END || ws_size < WS_END) { fprintf(stderr, "kernel_launch: unexpected problem (n_in %d, out %d vs %zu, ws %zu vs %zu); nothing launched\n", n_in, out_size, (size_t)O_END, ws_size, (size_t)WS_END); grid = -1; return; }
        int dev = 0, cus = 0, per_cu = 0;
        if (hipGetDevice(&dev) != hipSuccess || hipDeviceGetAttribute(&cus, hipDeviceAttributeMultiprocessorCount, dev) != hipSuccess) { grid = -1; return; }
        if (hipFuncSetAttribute((const void*)yoco_fwd, hipFuncAttributeMaxDynamicSharedMemorySize, LDS_BYTES) != hipSuccess) { fprintf(stderr, "kernel_launch: hipFuncSetAttribute failed\n"); grid = -1; return; }
        if (hipOccupancyMaxActiveBlocksPerMultiprocessor(&per_cu, (const void*)yoco_fwd, NTHREADS, LDS_BYTES) != hipSuccess || per_cu < 1) { fprintf(stderr, "kernel_launch: occupancy query says %d\n", per_cu); per_cu = 1; }
        (void)hipGetLastError();
        if (cus != 256) { fprintf(stderr, "kernel_launch: built for a 256-CU device (got %d); nothing launched\n", cus); grid = -1; return; }
        grid = cus;
    }
    if (grid < 0) return;
    if (hipMemsetAsync((char*)d_ws + WS_CTL, 0, CTL_ZERO_BYTES, stream) != hipSuccess) { fprintf(stderr, "kernel_launch: memset failed\n"); return; }
    Args a{};
    for (int i = 0; i < 26; ++i) a.in[i] = (const float*)d_in[i];
    a.out = (float*)d_out; a.ws = (unsigned char*)d_ws;
#if MK_PER_PHASE
    for (int p = 0; p < NPHASES; ++p) { a.ph_lo = p; a.ph_hi = p + 1; hipLaunchKernelGGL(yoco_fwd, dim3(grid), dim3(NTHREADS), LDS_BYTES, stream, a); }
#else
    a.ph_lo = 0; a.ph_hi = NPHASES;
    void* kargs[] = {&a};
    hipError_t e = hipLaunchCooperativeKernel((const void*)yoco_fwd, dim3(grid), dim3(NTHREADS), kargs, LDS_BYTES, stream);
    if (e != hipSuccess) fprintf(stderr, "kernel_launch: cooperative launch failed: %s (grid %d)\n", hipGetErrorString(e), grid);
#endif
}
```

```cpp
#include <hip/hip_runtime.h>
#include <cstdio>
#include <cstdint>
#include <cmath>
namespace pg8 {
#define PG8_LAS __attribute__((address_space(3)))
typedef unsigned short bf16_t;
typedef short bf16x8 __attribute__((ext_vector_type(8)));
typedef float f32x4 __attribute__((ext_vector_type(4)));
typedef unsigned u32x4 __attribute__((ext_vector_type(4)));
constexpr int BM = 256, BK = 64, HALF = 128, HTB = HALF * BK * 2  , STAGE_BYTES = 8 * HTB, NXCD = 8, WGM = 8;

__host__ __device__ __forceinline__ int lds_byte(int r, int c) { const int st = (r >> 4) * 2 + (c >> 5), rr = r & 15, cc = c & 31, ob = rr * 64 + cc * 2; return st * 1024 + (ob ^ (((ob >> 9) & 1) << 5)); }
__host__ __device__ __forceinline__ void stage_rc(int b, int& R, int& C) { const int st = b / 1024, sb = b % 1024, swz = sb ^ (((sb >> 9) & 1) << 5); R = (st >> 1) * 16 + swz / 64; C = (st & 1) * 32 + (swz % 64) / 2; }
__host__ __device__ __forceinline__ int perm32(int rho) { const int n = rho >> 4, i = rho & 15; return 8 * (i >> 2) + 4 * n + (i & 3); }

struct Unit { int pm, pn, k0, nt, aux; };
struct Gemm { const bf16_t* A; const bf16_t* Bt; int M, N, K; };

struct StaticOrder {
    int nM, nN, nwg, G, c, nt0;
    __host__ __device__ void init(int M, int N, int K, int G_, int c_) { nM = M / BM; nN = N / BM; nwg = nM * nN; G = G_; c = c_; nt0 = K / BK; }
    __host__ __device__ bool next(int i, Unit& u) const {
        const long L = (long)i * G + c; if (L >= nwg) return false;
        int wgid = (int)L; { const int q = nwg / NXCD, r = nwg % NXCD, xcd = wgid % NXCD, off = wgid / NXCD; wgid = (xcd < r ? xcd * (q + 1) : r * (q + 1) + (xcd - r) * q) + off; }
        const int nig = WGM * nN, gid = wgid / nig, fm = gid * WGM, gsz = (nM - fm) < WGM ? (nM - fm) : WGM;
        u.pm = fm + ((wgid % nig) % gsz); u.pn = (wgid % nig) / gsz; u.k0 = 0; u.nt = nt0; u.aux = -1; return true;
    }
    __device__ __forceinline__ void a_ready(const Unit&) const {}
    __device__ __forceinline__ void done(const Unit&) const {}
};
struct ResOrder {
    StaticOrder so; int S, K, c;
    __host__ __device__ void init(int K_, int S_, int G_, int c_) { so.init(64 * BM, 1024, K_, G_, c_); S = S_; K = K_; c = c_; }
    __host__ __device__ bool next(int i, Unit& u) const {
        if (i == 0) return so.next(0, u);
        if (i == 1 && c < 20 * S) { const int t = c / S, sl = c - t * S; u.pm = 64 + (t >> 2); u.pn = t & 3; u.k0 = sl * (K / S); u.nt = K / S / BK; u.aux = sl; return true; }
        return false;
    }
    __device__ __forceinline__ void a_ready(const Unit&) const {}
    __device__ __forceinline__ void done(const Unit&) const {}
};

typedef float f32x2_cv0 __attribute__((ext_vector_type(2))); typedef __bf16 bf16x2_cv0 __attribute__((ext_vector_type(2)));
__device__ __forceinline__ unsigned cvt_pk_bf16(float lo, float hi) { const f32x2_cv0 v = {lo, hi}; const bf16x2_cv0 b = __builtin_convertvector(v, bf16x2_cv0); return __builtin_bit_cast(unsigned, b); }
typedef float f32x2 __attribute__((ext_vector_type(2)));
typedef unsigned u32x2 __attribute__((ext_vector_type(2)));
__device__ __forceinline__ float softplus_f(float x) { const float y = __expf(-fabsf(x)); const float l = (y < 0.03125f) ? y * (1.f - y * (0.5f - y * (1.f / 3.f - 0.25f * y))) : __logf(1.f + y); return fmaxf(x, 0.f) + l; }
struct EpiInProj {
    static constexpr bool PERM = true, AFTER_DRAIN = false;
    bf16_t* ZX; float* DT; const float* dt_bias;
    __device__ __forceinline__ void operator()(const f32x4 (&acc)[2][2][4][2], const Unit& u, int wr, int wc, int fr, int fq) const {
        const int row0 = u.pm * BM + wr * 64 + fr;
        if (u.pn < 24) {
            const int col0 = u.pn * BM + wc * 32 + 8 * fq;
#pragma unroll
            for (int ai = 0; ai < 2; ++ai)
#pragma unroll
                for (int m = 0; m < 4; ++m) { bf16_t* rowp = ZX + (size_t)(row0 + ai * HALF + m * 16) * 6144 + col0;
#pragma unroll
                    for (int bj = 0; bj < 2; ++bj) { const f32x4 v0 = acc[ai][bj][m][0], v1 = acc[ai][bj][m][1];
                        u32x4 w; w.x = cvt_pk_bf16(v0[0], v0[1]); w.y = cvt_pk_bf16(v0[2], v0[3]); w.z = cvt_pk_bf16(v1[0], v1[1]); w.w = cvt_pk_bf16(v1[2], v1[3]);
                        *(u32x4*)(rowp + bj * HALF) = w; } }
        } else if (wc == 0) {
            const int c0 = 8 * fq;
            const f32x4 b0 = *(const f32x4*)(dt_bias + c0), b1 = *(const f32x4*)(dt_bias + c0 + 4);
#pragma unroll
            for (int ai = 0; ai < 2; ++ai)
#pragma unroll
                for (int m = 0; m < 4; ++m) { float* rowp = DT + (size_t)(row0 + ai * HALF + m * 16) * 32 + c0;
                    const f32x4 v0 = acc[ai][0][m][0] + b0, v1 = acc[ai][0][m][1] + b1;
                    f32x4 o0, o1;
#pragma unroll
                    for (int j = 0; j < 4; ++j) { o0[j] = softplus_f(v0[j]); o1[j] = softplus_f(v1[j]); }
                    *(f32x4*)(rowp) = o0; *(f32x4*)(rowp + 4) = o1; }
        }
    }
};
struct EpiRes {
    static constexpr bool PERM = false, AFTER_DRAIN = false;
    const float* B; float* H; float* SLAB;
    __device__ __forceinline__ void operator()(const f32x4 (&acc)[2][2][4][2], const Unit& u, int wr, int wc, int fr, int fq) const {
        const int row0 = u.pm * BM + wr * 64 + fr, col0 = u.pn * BM + wc * 32 + 4 * fq;
        if (u.aux >= 0) {
            float* base = SLAB + (size_t)u.aux * (1280 * 1024) + (size_t)(row0 - 16384) * 1024 + col0;
#pragma unroll
            for (int ai = 0; ai < 2; ++ai)
#pragma unroll
                for (int m = 0; m < 4; ++m) { float* rowp = base + (size_t)(ai * HALF + m * 16) * 1024;
#pragma unroll
                    for (int bj = 0; bj < 2; ++bj)
#pragma unroll
                        for (int n = 0; n < 2; ++n) *(f32x4*)(rowp + bj * HALF + n * 16) = acc[ai][bj][m][n]; }
            return;
        }
#pragma unroll
        for (int ai = 0; ai < 2; ++ai)
#pragma unroll
            for (int m = 0; m < 4; ++m) { const size_t off = (size_t)(row0 + ai * HALF + m * 16) * 1024 + col0;
                if (B == H) {
                    float* rowp = H + off;
#pragma unroll
                    for (int bj = 0; bj < 2; ++bj)
#pragma unroll
                        for (int n = 0; n < 2; ++n) { f32x4* p = (f32x4*)(rowp + bj * HALF + n * 16); *p = *p + acc[ai][bj][m][n]; }
                } else {
                    f32x4 bv[2][2];
#pragma unroll
                    for (int bj = 0; bj < 2; ++bj)
#pragma unroll
                        for (int n = 0; n < 2; ++n) bv[bj][n] = *(const f32x4*)(B + off + bj * HALF + n * 16);
#pragma unroll
                    for (int bj = 0; bj < 2; ++bj)
#pragma unroll
                        for (int n = 0; n < 2; ++n) *(f32x4*)(H + off + bj * HALF + n * 16) = bv[bj][n] + acc[ai][bj][m][n];
                } }
    }
};
template <int ACT> struct EpiBf {
    static constexpr bool PERM = true, AFTER_DRAIN = false;
    bf16_t* O0; int ldc0; int nsplit; bf16_t* O1; int ldc1;
    __device__ __forceinline__ void operator()(const f32x4 (&acc)[2][2][4][2], const Unit& u, int wr, int wc, int fr, int fq) const {
        const int row0 = u.pm * BM + wr * 64 + fr;
        bf16_t* base; int ldc, colt;
        if (u.pn < nsplit) { base = O0; ldc = ldc0; colt = u.pn * BM; } else { base = O1; ldc = ldc1; colt = (u.pn - nsplit) * BM; }
        const int col0 = colt + wc * 32 + 8 * fq;
#pragma unroll
        for (int ai = 0; ai < 2; ++ai)
#pragma unroll
            for (int m = 0; m < 4; ++m) { bf16_t* rowp = base + (size_t)(row0 + ai * HALF + m * 16) * ldc + col0;
#pragma unroll
                for (int bj = 0; bj < 2; ++bj) { f32x4 v0 = acc[ai][bj][m][0], v1 = acc[ai][bj][m][1];
                    if (ACT == 1) {
#pragma unroll
                        for (int j = 0; j < 4; ++j) { const float a = fmaxf(v0[j], 0.f), b = fmaxf(v1[j], 0.f); v0[j] = a * a; v1[j] = b * b; } }
                    u32x4 w; w.x = cvt_pk_bf16(v0[0], v0[1]); w.y = cvt_pk_bf16(v0[2], v0[3]); w.z = cvt_pk_bf16(v1[0], v1[1]); w.w = cvt_pk_bf16(v1[2], v1[3]);
                    *(u32x4*)(rowp + bj * HALF) = w; } }
    }
};
struct EpiQSplit {
    static constexpr bool PERM = true, AFTER_DRAIN = false;
    bf16_t* Q; float* SLAB;
    __device__ __forceinline__ void operator()(const f32x4 (&acc)[2][2][4][2], const Unit& u, int wr, int wc, int fr, int fq) const {
        const int row0 = u.pm * BM + wr * 64 + fr, col0 = u.pn * BM + wc * 32 + 8 * fq;
        if (u.aux >= 0) {
            float* base = SLAB + (size_t)u.aux * (1280 * 1024) + (size_t)(row0 - 16384) * 1024 + col0;
#pragma unroll
            for (int ai = 0; ai < 2; ++ai)
#pragma unroll
                for (int m = 0; m < 4; ++m) { float* rowp = base + (size_t)(ai * HALF + m * 16) * 1024;
#pragma unroll
                    for (int bj = 0; bj < 2; ++bj) { *(f32x4*)(rowp + bj * HALF) = acc[ai][bj][m][0]; *(f32x4*)(rowp + bj * HALF + 4) = acc[ai][bj][m][1]; } }
            return;
        }
#pragma unroll
        for (int ai = 0; ai < 2; ++ai)
#pragma unroll
            for (int m = 0; m < 4; ++m) { bf16_t* rowp = Q + (size_t)(row0 + ai * HALF + m * 16) * 1024 + col0;
#pragma unroll
                for (int bj = 0; bj < 2; ++bj) { const f32x4 v0 = acc[ai][bj][m][0], v1 = acc[ai][bj][m][1];
                    u32x4 w; w.x = cvt_pk_bf16(v0[0], v0[1]); w.y = cvt_pk_bf16(v0[2], v0[3]); w.z = cvt_pk_bf16(v1[0], v1[1]); w.w = cvt_pk_bf16(v1[2], v1[3]);
                    *(u32x4*)(rowp + bj * HALF) = w; } }
    }
};

template <class Epi, class Sched, bool ALIGN_EPI = false, bool SP2 = false>
__device__ __forceinline__ void gemm_phase(PG8_LAS unsigned char* lds, const Gemm g, const Sched& S, const Epi& E) {
    int tid_l = threadIdx.x; asm volatile("" : "+v"(tid_l));
    const int tid = tid_l, wid = __builtin_amdgcn_readfirstlane(tid >> 6), lane = tid & 63, wr = wid >> 2, wc = wid & 3, fr = lane & 15, fq = lane >> 4;
    const int K = g.K;
    unsigned voffA[2], voffB[2];
#pragma unroll
    for (int i = 0; i < 2; ++i) { int R, C; stage_rc(tid * 16 + i * 8192, R, C); const int Rb = Epi::PERM ? ((R & ~31) + perm32(R & 31)) : R;
        voffA[i] = (unsigned)(R * K + C) * 2u; voffB[i] = (unsigned)(Rb * K + C) * 2u; }
    const size_t kstep = (size_t)(BK * 2);
    const size_t hstep = (size_t)HALF * K * 2;
    const size_t tstep = 2 * hstep;
    const unsigned ldsw = (unsigned)wid * 1024u;
    const int aoff = lds_byte(wr * 64 + fr, fq * 8), boff = lds_byte(wc * 32 + fr, fq * 8);
#define PG8_SA(b, h) (((b) * 2 + (h)) * HTB)
#define PG8_SB(b, h) ((4 + (b) * 2 + (h)) * HTB)
#define PG8_STAGE(bufoff, gbase, voff) do { _Pragma("unroll") for (int _i = 0; _i < 2; ++_i) \
        __builtin_amdgcn_global_load_lds((const unsigned*)((const char*)(gbase) + (voff)[_i]), (PG8_LAS unsigned*)(lds + (bufoff) + ldsw + _i * 8192), 16, 0, 0); } while (0)
#define PG8_LDA(dst, b, h) do { _Pragma("unroll") for (int m = 0; m < 4; ++m) _Pragma("unroll") for (int k = 0; k < 2; ++k) dst[m][k] = *(const PG8_LAS bf16x8*)(lds + PG8_SA(b, h) + aoff + m * 2048 + k * 1024); } while (0)
#define PG8_LDB(dst, b, h) do { _Pragma("unroll") for (int n = 0; n < 2; ++n) _Pragma("unroll") for (int k = 0; k < 2; ++k) dst[n][k] = *(const PG8_LAS bf16x8*)(lds + PG8_SB(b, h) + boff + n * 2048 + k * 1024); } while (0)
#define PG8_MMA(ai, bj, At, Bt) do { __builtin_amdgcn_s_setprio(1); _Pragma("unroll") for (int m = 0; m < 4; ++m) _Pragma("unroll") for (int n = 0; n < 2; ++n) _Pragma("unroll") for (int k = 0; k < 2; ++k) \
        acc[ai][bj][m][n] = __builtin_amdgcn_mfma_f32_16x16x32_bf16(Bt[n][k], At[m][k], acc[ai][bj][m][n], 0, 0, 0); __builtin_amdgcn_s_setprio(0); } while (0)
#define PG8_WAIT_V(n) asm volatile("s_waitcnt vmcnt(" #n ")" ::: "memory")
#define PG8_WAIT_L(n) asm volatile("s_waitcnt lgkmcnt(" #n ")" ::: "memory")
#define PG8_BAR __builtin_amdgcn_s_barrier()
#define PG8_SCHED __builtin_amdgcn_sched_barrier(0)
    Unit cur, nxt; int ui = 0;
    if (!S.next(0, cur)) return;
    f32x4 acc[2][2][4][2];
#pragma unroll
    for (int a = 0; a < 2; ++a)
#pragma unroll
        for (int b = 0; b < 2; ++b)
#pragma unroll
            for (int m = 0; m < 4; ++m)
#pragma unroll
                for (int n = 0; n < 2; ++n) acc[a][b][m][n] = (f32x4){0.f, 0.f, 0.f, 0.f};
    bf16x8 At[4][2], B0[2][2], B1[2][2];
    const char* cA = (const char*)g.A + (size_t)cur.pm * tstep + (size_t)cur.k0 * 2; const char* cB = (const char*)g.Bt + (size_t)cur.pn * tstep + (size_t)cur.k0 * 2;
    S.a_ready(cur);
    if constexpr (SP2) {
        PG8_STAGE(PG8_SB(0, 0), cB, voffB); PG8_STAGE(PG8_SB(0, 1), cB + hstep, voffB); PG8_STAGE(PG8_SA(0, 0), cA, voffA); PG8_STAGE(PG8_SA(0, 1), cA + hstep, voffA);
        if (wr == 1) PG8_BAR;
        PG8_WAIT_V(2); PG8_BAR;
        PG8_STAGE(PG8_SB(1, 0), cB + kstep, voffB); PG8_STAGE(PG8_SA(1, 0), cA + kstep, voffA); PG8_STAGE(PG8_SB(1, 1), cB + hstep + kstep, voffB);
        PG8_WAIT_V(6); PG8_BAR;
    } else {
        PG8_STAGE(PG8_SB(0, 0), cB, voffB); PG8_STAGE(PG8_SA(0, 0), cA, voffA); PG8_STAGE(PG8_SB(0, 1), cB + hstep, voffB); PG8_STAGE(PG8_SA(0, 1), cA + hstep, voffA);
        if (wr == 1) PG8_BAR;
        PG8_WAIT_V(4); PG8_BAR;
        PG8_STAGE(PG8_SB(1, 0), cB + kstep, voffB); PG8_STAGE(PG8_SA(1, 0), cA + kstep, voffA); PG8_STAGE(PG8_SB(1, 1), cB + hstep + kstep, voffB);
        PG8_WAIT_V(6); PG8_BAR;
    }
    for (;;) {
        const bool has_next = S.next(ui + 1, nxt);
        const char* nA = has_next ? (const char*)g.A + (size_t)nxt.pm * tstep + (size_t)nxt.k0 * 2 : cA; const char* nB = has_next ? (const char*)g.Bt + (size_t)nxt.pn * tstep + (size_t)nxt.k0 * 2 : cB;
        const int nt = cur.nt;
        for (int t = 0; t < nt; t += 2) {
            const bool last = (t == nt - 2);
            const char* a1 = cA + (size_t)(t + 1) * kstep;
            const char* a2 = last ? nA : cA + (size_t)(t + 2) * kstep; const char* b2 = last ? nB : cB + (size_t)(t + 2) * kstep;
            const char* a3 = a2 + kstep; const char* b3 = b2 + kstep;
            if (last && has_next) S.a_ready(nxt);
            if constexpr (SP2) {
            PG8_LDB(B0, 0, 0); PG8_LDB(B1, 0, 1); PG8_SCHED; PG8_LDA(At, 0, 0); PG8_STAGE(PG8_SA(1, 1), a1 + hstep, voffA);
            PG8_WAIT_V(8); PG8_WAIT_L(0); PG8_BAR; PG8_MMA(0, 0, At, B0); PG8_MMA(0, 1, At, B1); PG8_BAR; PG8_SCHED;
            PG8_LDA(At, 0, 1); PG8_STAGE(PG8_SB(0, 0), b2, voffB); PG8_STAGE(PG8_SB(0, 1), b2 + hstep, voffB); PG8_STAGE(PG8_SA(0, 0), a2, voffA);
            PG8_WAIT_V(8); PG8_WAIT_L(0); PG8_BAR; PG8_MMA(1, 0, At, B0); PG8_MMA(1, 1, At, B1); PG8_BAR; PG8_SCHED;
            PG8_LDB(B0, 1, 0); PG8_LDB(B1, 1, 1); PG8_SCHED; PG8_LDA(At, 1, 0); PG8_STAGE(PG8_SA(0, 1), a2 + hstep, voffA);
            PG8_WAIT_V(8); PG8_WAIT_L(0); PG8_BAR; PG8_MMA(0, 0, At, B0); PG8_MMA(0, 1, At, B1); PG8_BAR; PG8_SCHED;
            PG8_LDA(At, 1, 1); PG8_STAGE(PG8_SB(1, 0), b3, voffB); PG8_STAGE(PG8_SB(1, 1), b3 + hstep, voffB); PG8_STAGE(PG8_SA(1, 0), a3, voffA);
            PG8_WAIT_V(8); PG8_WAIT_L(0); PG8_BAR; PG8_MMA(1, 0, At, B0); PG8_MMA(1, 1, At, B1); PG8_BAR; PG8_SCHED;
            } else {
            PG8_LDB(B0, 0, 0); PG8_SCHED; PG8_LDA(At, 0, 0); PG8_STAGE(PG8_SA(1, 1), a1 + hstep, voffA);
            PG8_WAIT_L(8); PG8_BAR; PG8_WAIT_L(0); PG8_MMA(0, 0, At, B0); PG8_BAR; PG8_SCHED;
            PG8_LDB(B1, 0, 1); PG8_STAGE(PG8_SB(0, 0), b2, voffB);
            PG8_BAR; PG8_WAIT_L(0); PG8_MMA(0, 1, At, B1); PG8_BAR;
            PG8_LDA(At, 0, 1); PG8_STAGE(PG8_SA(0, 0), a2, voffA);
            PG8_BAR; PG8_WAIT_L(0); PG8_MMA(1, 0, At, B0); PG8_BAR; PG8_SCHED;
            PG8_STAGE(PG8_SB(0, 1), b2 + hstep, voffB);
            PG8_WAIT_V(6); PG8_BAR; PG8_MMA(1, 1, At, B1); PG8_BAR;
            PG8_LDB(B0, 1, 0); PG8_SCHED; PG8_LDA(At, 1, 0); PG8_STAGE(PG8_SA(0, 1), a2 + hstep, voffA);
            PG8_WAIT_L(8); PG8_BAR; PG8_WAIT_L(0); PG8_MMA(0, 0, At, B0); PG8_BAR; PG8_SCHED;
            PG8_LDB(B1, 1, 1); PG8_STAGE(PG8_SB(1, 0), b3, voffB);
            PG8_BAR; PG8_WAIT_L(0); PG8_MMA(0, 1, At, B1); PG8_BAR;
            PG8_LDA(At, 1, 1); PG8_STAGE(PG8_SA(1, 0), a3, voffA);
            PG8_BAR; PG8_WAIT_L(0); PG8_MMA(1, 0, At, B0); PG8_BAR; PG8_SCHED;
            PG8_STAGE(PG8_SB(1, 1), b3 + hstep, voffB);
            PG8_WAIT_V(6); PG8_BAR; PG8_MMA(1, 1, At, B1); PG8_BAR;
            }
        }
        if constexpr (ALIGN_EPI) { if (wr == 0) PG8_BAR; }
        if constexpr (!Epi::AFTER_DRAIN) { E(acc, cur, wr, wc, fr, fq); S.done(cur); }
        if (!has_next) break;
#pragma unroll
        for (int a = 0; a < 2; ++a)
#pragma unroll
            for (int b = 0; b < 2; ++b)
#pragma unroll
                for (int m = 0; m < 4; ++m)
#pragma unroll
                    for (int n = 0; n < 2; ++n) acc[a][b][m][n] = (f32x4){0.f, 0.f, 0.f, 0.f};
        cur = nxt; cA = nA; cB = nB; ++ui;
        if constexpr (ALIGN_EPI) { if (wr == 1) PG8_BAR; }
    }
    PG8_WAIT_V(0);
    if constexpr (!ALIGN_EPI) { if (wr == 0) PG8_BAR; }
    PG8_BAR;
    if constexpr (Epi::AFTER_DRAIN) { E.fused(acc, cur, wr, wc, fr, fq, lds, wid, lane); S.done(cur); }
#undef PG8_SA
#undef PG8_SB
#undef PG8_STAGE
#undef PG8_LDA
#undef PG8_LDB
#undef PG8_MMA
#undef PG8_WAIT_V
#undef PG8_WAIT_L
#undef PG8_BAR
#undef PG8_SCHED
}
}
#define GAS __attribute__((address_space(1)))
#define LAS __attribute__((address_space(3)))
typedef unsigned short bf16;
typedef unsigned v4u __attribute__((ext_vector_type(4)));
typedef float f32x4 __attribute__((ext_vector_type(4)));
typedef short bf16x8 __attribute__((ext_vector_type(8)));
typedef GAS unsigned gu32;
typedef GAS unsigned long long gu64;
#define RLX_AGENT __ATOMIC_RELAXED, __HIP_MEMORY_SCOPE_AGENT
#define LDS_WAIT() asm volatile("s_waitcnt lgkmcnt(0)" ::: "memory")
#define VM_WAIT() asm volatile("s_waitcnt vmcnt(0)" ::: "memory")
__device__ __forceinline__ unsigned long long rt() { return __builtin_amdgcn_s_memrealtime(); }
__device__ __forceinline__ unsigned f2bf(float f) { unsigned u = __builtin_bit_cast(unsigned, f); return (u + 0x7fffu + ((u >> 16) & 1u)) >> 16; }
__device__ __forceinline__ unsigned pk2(float lo, float hi) { return f2bf(lo) | (f2bf(hi) << 16); }

#define XB_TMO      128
#define XB_XCNT(j)  (256  + 64 * (j))
#define XB_XSUB(j)  (1280 + 64 * (j))
#define XB_XGEN(j)  (2304 + 64 * (j))
#define XB_TOP      3328
#define XB_TOPGEN   3392
#define XCD_BAR_WORDS 3456
#define XB_SPIN_CAP (1u << 18)

__device__ __forceinline__ unsigned xb_ld(unsigned* p)              { return __hip_atomic_load(p, __ATOMIC_RELAXED, __HIP_MEMORY_SCOPE_AGENT); }
__device__ __forceinline__ unsigned xb_add(unsigned* p, unsigned v) { return __hip_atomic_fetch_add(p, v, __ATOMIC_RELAXED, __HIP_MEMORY_SCOPE_AGENT); }
__device__ __forceinline__ unsigned xb_xcc_id() { return (unsigned)__builtin_amdgcn_s_getreg((3 << 11) | 20) & 0xFu; }
#define XB_SPIN(cond, bar) do { unsigned _sp = 0; while (cond) { __builtin_amdgcn_s_sleep(1); \
    if ((++_sp & 255u) == 0u) { if (xb_ld(&(bar)[XB_TMO])) break; if (_sp > XB_SPIN_CAP) { atomicAdd(&(bar)[XB_TMO], 1u); break; } } } } while (0)

struct XcdBarrier {
    unsigned* bar; unsigned x;
    volatile LAS unsigned* st;
};

__device__ __forceinline__ XcdBarrier xcd_barrier_post(unsigned* bar, volatile LAS unsigned* st) {
    XcdBarrier b; b.bar = bar; b.x = xb_xcc_id(); b.st = st;
    if (threadIdx.x == 0) (void)xb_add(&bar[XB_XCNT(b.x)], 1u);
    return b;
}
__device__ __forceinline__ void xcd_barrier_complete(unsigned* bar, unsigned x, unsigned& nloc, unsigned& nx) {
    const unsigned G = gridDim.x * gridDim.y * gridDim.z;
    unsigned sum, cnt, mine, sp = 0u;
    for (;;) {
        sum = 0u; cnt = 0u; mine = 0u;
#pragma unroll
        for (unsigned j = 0; j < 16; ++j) { const unsigned c = xb_ld(&bar[XB_XCNT(j)]); sum += c; cnt += (c > 0u) ? 1u : 0u; mine = (j == x) ? c : mine; }
        if (sum == G) break;
        __builtin_amdgcn_s_sleep(1);
        if ((++sp & 255u) == 0u) { if (xb_ld(&bar[XB_TMO])) break; if (sp > XB_SPIN_CAP) { atomicAdd(&bar[XB_TMO], 1u); break; } }
    }
    nloc = mine > 0u ? mine : 1u; nx = cnt > 0u ? cnt : 1u;
}

__device__ __forceinline__ void xcd_barrier(const XcdBarrier& b) {
    asm volatile("s_waitcnt vmcnt(0)" ::: "memory");
    __syncthreads();
    if (threadIdx.x == 0) {
        unsigned* bar = b.bar;
        __builtin_amdgcn_s_waitcnt(0);
        unsigned nloc = b.st[0], nx = b.st[1];
        if (nloc == 0u) { xcd_barrier_complete(bar, b.x, nloc, nx); b.st[0] = nloc; b.st[1] = nx; }
        const unsigned old = xb_add(&bar[XB_XSUB(b.x)], 1u);
        const unsigned gen = old / nloc;
        if (old + 1u == (gen + 1u) * nloc) {
            __builtin_amdgcn_fence(__ATOMIC_RELEASE, "agent");
            asm volatile("s_waitcnt vmcnt(0)" ::: "memory");
            const unsigned og = xb_add(&bar[XB_TOP], 1u);
            const unsigned tg = og / nx;
            if (og + 1u == (tg + 1u) * nx) xb_add(&bar[XB_TOPGEN], 1u);
            else XB_SPIN(xb_ld(&bar[XB_TOPGEN]) == tg, bar);
            __builtin_amdgcn_fence(__ATOMIC_ACQUIRE, "agent");
            xb_add(&bar[XB_XGEN(b.x)], 1u);
            asm volatile("s_waitcnt vmcnt(0)" ::: "memory");
        } else {
            XB_SPIN(xb_ld(&bar[XB_XGEN(b.x)]) == gen, bar);
            __builtin_amdgcn_fence(__ATOMIC_ACQUIRE, "agent");
            asm volatile("s_waitcnt vmcnt(0)" ::: "memory");
        }
    }
    __syncthreads();
}
constexpr int NWAVES = 8, NTHREADS = 512;
constexpr int DM = 1024, SEQ = 8192, NPROMPT = 2, NSAMP = 128, TSAMP = 8, NMETA = 16;
constexpr int ROW_S = NPROMPT * SEQ;
constexpr int ROW_M = ROW_S + NSAMP * TSAMP;
constexpr int NROWS = ROW_M + NMETA;
constexpr int MP = 17664;
constexpr int DINNER = 2048, NHEADS = 32, HD = 64, NGROUPS = 8, DSTATE = 128, CONVD = 4096, INPROJ = 6176, INPROJ_P = 6400, ZXW = 6144;
constexpr int DFF = 4096, NKV = 4, NQ = 16, KVW = 512;
constexpr float EPS = 1e-5f;
constexpr int LDX = 136;

constexpr size_t O_YP = 0, O_YS = O_YP + (size_t)NPROMPT * SEQ * DM, O_PCONV = O_YS + (size_t)NSAMP * TSAMP * DM, O_PSSM = O_PCONV + 2 * 2 * 3 * 4096,
    O_PCK = O_PSSM + (size_t)2 * 2 * 32 * 64 * 128, O_PCV = O_PCK + 2 * 128 * 256, O_SCONV = O_PCV + 2 * 128 * 256, O_SSSM = O_SCONV + (size_t)2 * 128 * 3 * 4096,
    O_SCK = O_SSSM + (size_t)2 * 128 * 32 * 64 * 128, O_SCV = O_SCK + (size_t)128 * 128 * 256, O_END = O_SCV + (size_t)128 * 128 * 256;

constexpr size_t MiB = 1u << 20;
constexpr size_t WS_CTL = 0, CTL_ZERO_BYTES = 1 * MiB;
constexpr size_t SZ_WIN = (size_t)INPROJ_P * 1024 * 2, SZ_WOUT = (size_t)1024 * 2048 * 2, SZ_WUP = (size_t)4096 * 1024 * 2, SZ_WDN = SZ_WUP, SZ_WQKV0 = (size_t)1536 * 1024 * 2, SZ_WQ1 = (size_t)1024 * 1024 * 2, SZ_WO = SZ_WQ1;
constexpr size_t WS_WIN = 1 * MiB, WS_WOUT = WS_WIN + 2 * SZ_WIN, WS_WUP = WS_WOUT + 2 * SZ_WOUT, WS_WDN = WS_WUP + 4 * SZ_WUP, WS_WQKV0 = WS_WDN + 4 * SZ_WDN, WS_WQ1 = WS_WQKV0 + SZ_WQKV0, WS_WO = WS_WQ1 + SZ_WQ1, WS_WEND = WS_WO + 2 * SZ_WO;
constexpr size_t al1m(size_t x) { return (x + MiB - 1) / MiB * MiB; }
constexpr size_t WS_H = al1m(WS_WEND), WS_HN = al1m(WS_H + (size_t)MP * 1024 * 4), WS_ZX = al1m(WS_HN + (size_t)MP * 1024 * 2), WS_DT = al1m(WS_ZX + (size_t)MP * ZXW * 2),
    WS_XC = al1m(WS_DT + (size_t)MP * 32 * 4), WS_YN = al1m(WS_XC + (size_t)MP * 4096 * 2), WS_CS = al1m(WS_YN + (size_t)MP * 2048 * 2), WS_CD = al1m(WS_CS + (size_t)129 * 32 * 8192 * 4), WS_SLAB = al1m(WS_CD + 129 * 32 * 4), WS_HSB = al1m(WS_SLAB + (size_t)8 * 1280 * 1024 * 4), WS_END = al1m(WS_HSB + (size_t)128 * 32 * 8192 * 2);
constexpr size_t WS_U = WS_ZX;
constexpr size_t WS_Q = WS_XC, WS_KV = WS_Q + (size_t)MP * 1024 * 2, WS_AO = WS_KV + (size_t)MP * 512 * 2;
static_assert(WS_AO + (size_t)MP * 1024 * 2 <= WS_YN, "attention overlay");
constexpr int CW_BAR = 4096;

constexpr int RING_BYTES = 131072, LDS_BYTES = 147456, LDSCTL_OFF = LDS_BYTES - 512, MISC_OFF = LDSCTL_OFF + 320;

typedef unsigned u32x2 __attribute__((ext_vector_type(2)));
typedef unsigned u32x4 __attribute__((ext_vector_type(4)));
__device__ __forceinline__ int ltid() { int t = threadIdx.x; asm volatile("" : "+v"(t)); return t; }
__device__ __forceinline__ float bf2f(unsigned short b) { return __uint_as_float((unsigned)b << 16); }
__device__ __forceinline__ float bflo(unsigned w) { return __uint_as_float(w << 16); }
__device__ __forceinline__ float bfhi(unsigned w) { return __uint_as_float(w & 0xffff0000u); }
__device__ __forceinline__ unsigned pkbf(float lo, float hi) { return pg8::cvt_pk_bf16(lo, hi); }
__device__ __forceinline__ float wave_sum(float v) {
#pragma unroll
    for (int o = 1; o < 64; o <<= 1) v += __shfl_xor(v, o);
    return v;
}
__device__ __forceinline__ float frcp(float x) { return __builtin_amdgcn_rcpf(x); }
__device__ __forceinline__ float sigmoid_f(float x) { return frcp(1.f + __expf(-x)); }
#define MFMA16(b, a, c) __builtin_amdgcn_mfma_f32_16x16x32_bf16((b), (a), (c), 0, 0, 0)

struct Args {
    const float* in[26]; float* out; unsigned char* ws; int ph_lo, ph_hi;
};
typedef const __attribute__((address_space(4))) Args* ArgsP;
enum { I_XP = 0, I_XS, I_SCONV, I_SSSM, I_CK, I_CV, I_META, I_ANORM, I_AIN, I_ACONVW, I_ACONVB, I_ADTB, I_ALOG, I_ADSKIP, I_AGATE, I_AOUT, I_KVNORM, I_WKV, I_BNORM, I_WQ, I_SINKS, I_WO, I_MLPNORM, I_WUP, I_WDOWN, I_FNORM };

__device__ __forceinline__ void transpose_item(const float* W, const float* scale, int K, int N, bf16* WT, int row_off, LAS unsigned* scr, int item, int lane) {
    const int nblk = (N + 63) / 64, kb = item / nblk, nb = item % nblk, k0 = 64 * kb, n0 = 64 * nb;
    const bool ok = (n0 + lane < N);
    const float* src = W + (size_t)k0 * N + n0 + (ok ? lane : 0);
    float v[64];
#pragma unroll
    for (int i = 0; i < 64; ++i) v[i] = __builtin_nontemporal_load(src + (size_t)i * N);
    if (!ok) {
#pragma unroll
        for (int i = 0; i < 64; ++i) v[i] = 0.f;
    }
    if (scale) {
#pragma unroll
        for (int i = 0; i < 64; ++i) v[i] *= scale[k0 + i];
    }
#pragma unroll
    for (int i = 0; i < 32; ++i) scr[lane * 33 + i] = pkbf(v[2 * i], v[2 * i + 1]);
    LDS_WAIT(); asm volatile("" ::: "memory");
    const int c = lane & 7;
#pragma unroll
    for (int j = 0; j < 8; ++j) { const int n = (lane >> 3) + 8 * j; const LAS unsigned* sp = scr + n * 33 + 4 * c;
        v4u o; o.x = sp[0]; o.y = sp[1]; o.z = sp[2]; o.w = sp[3];
        if (n0 + n < N) *(GAS v4u*)(WT + (size_t)(row_off + n0 + n) * K + k0 + 8 * c) = o; }
    LDS_WAIT(); asm volatile("" ::: "memory");
}
struct WJob { const float* W; const float* scale; int K, N; bf16* WT; int row_off; int items; };

__device__ __forceinline__ void phase_prologue(ArgsP a, LAS unsigned char* lds, int wave, int lane) {
    LAS unsigned* scr = (LAS unsigned*)(lds + wave * 16384);
    const int gw = blockIdx.x * NWAVES + wave, NGW = gridDim.x * NWAVES;
    unsigned char* ws = a->ws;
    for (int jb = 0; jb < 21; ++jb) {
        WJob J;
        if (jb < 2)       { const int i = jb;      J = WJob{a->in[I_AIN] + (size_t)i * 1024 * INPROJ, a->in[I_ANORM] + i * 1024, 1024, INPROJ, (bf16*)(ws + WS_WIN + i * SZ_WIN), 0, 0}; }
        else if (jb < 4)  { const int i = jb - 2;  J = WJob{a->in[I_AOUT] + (size_t)i * 2048 * 1024, a->in[I_AGATE] + i * 2048, 2048, 1024, (bf16*)(ws + WS_WOUT + i * SZ_WOUT), 0, 0}; }
        else if (jb < 8)  { const int l = jb - 4;  J = WJob{a->in[I_WUP] + (size_t)l * 1024 * 4096, a->in[I_MLPNORM] + l * 1024, 1024, 4096, (bf16*)(ws + WS_WUP + l * SZ_WUP), 0, 0}; }
        else if (jb < 12) { const int l = jb - 8;  J = WJob{a->in[I_WDOWN] + (size_t)l * 4096 * 1024, nullptr, 4096, 1024, (bf16*)(ws + WS_WDN + l * SZ_WDN), 0, 0}; }
        else if (jb == 12) { J = WJob{a->in[I_WQ], a->in[I_BNORM], 1024, 1024, (bf16*)(ws + WS_WQKV0), 0, 0}; }
        else if (jb == 13) { J = WJob{a->in[I_WKV], a->in[I_KVNORM], 1024, 512, (bf16*)(ws + WS_WQKV0), 1024, 0}; }
        else if (jb == 14) { J = WJob{a->in[I_WQ] + (size_t)1024 * 1024, a->in[I_BNORM] + 1024, 1024, 1024, (bf16*)(ws + WS_WQ1), 0, 0}; }
        else if (jb < 17) { const int j = jb - 15; J = WJob{a->in[I_WO] + (size_t)j * 1024 * 1024, nullptr, 1024, 1024, (bf16*)(ws + WS_WO + j * SZ_WO), 0, 0}; }
        else break;
        const int items = (J.K / 64) * ((J.N + 63) / 64);
        for (int it = gw; it < items; it += NGW) transpose_item(J.W, J.scale, J.K, J.N, J.WT, J.row_off, scr, it, lane);
    }
    {
        const int gt = blockIdx.x * NTHREADS + ltid(), NT = gridDim.x * NTHREADS;
        const int per = (INPROJ_P - INPROJ) * 1024 * 2 / 16;
        for (int e = gt; e < 2 * per; e += NT) { const int i = e / per, c = e % per;
            *(v4u*)(ws + WS_WIN + i * SZ_WIN + (size_t)INPROJ * 1024 * 2 + (size_t)c * 16) = (v4u){0u, 0u, 0u, 0u}; }
    }
}

__device__ __forceinline__ void norm_store(bf16* __restrict__ HN, int m, int lane, const f32x4 (&v)[4]) {
    float s = 0.f;
#pragma unroll
    for (int j = 0; j < 4; ++j) s += (v[j].x * v[j].x + v[j].y * v[j].y) + (v[j].z * v[j].z + v[j].w * v[j].w);
    const float rs = rsqrtf(wave_sum(s) * (1.f / DM) + EPS);
    unsigned long long* o8 = (unsigned long long*)(HN + (size_t)m * DM) + lane;
#pragma unroll
    for (int j = 0; j < 4; ++j) o8[64 * j] = (unsigned long long)pkbf(v[j].x * rs, v[j].y * rs) | ((unsigned long long)pkbf(v[j].z * rs, v[j].w * rs) << 32);
}
__device__ __forceinline__ void phase_norm(ArgsP a, int from_inputs, int nslab, int wave, int lane) {
    float* __restrict__ H = (float*)(a->ws + WS_H); bf16* __restrict__ HN = (bf16*)(a->ws + WS_HN); const float* __restrict__ SLAB = (const float*)(a->ws + WS_SLAB);
    const int gw = blockIdx.x * NWAVES + wave, NGW = gridDim.x * NWAVES;
    for (int m = ROW_S + gw; m < MP; m += NGW) {
        if (m >= NROWS) { unsigned long long* o8 = (unsigned long long*)(HN + (size_t)m * DM) + lane;
#pragma unroll
            for (int j = 0; j < 4; ++j) o8[64 * j] = 0ull;
            continue; }
        const float* src = from_inputs ? ((m < ROW_M) ? a->in[I_XS] + (size_t)(m - ROW_S) * DM : a->in[I_META] + (size_t)(m - ROW_M) * DM) : H + (size_t)m * DM;
        f32x4 v[4], sv[8][4];
#pragma unroll
        for (int j = 0; j < 4; ++j) v[j] = ((const f32x4*)src + lane)[64 * j];
#pragma unroll
        for (int sl = 0; sl < 8; ++sl)
#pragma unroll
            for (int j = 0; j < 4; ++j) { sv[sl][j] = (f32x4){0.f, 0.f, 0.f, 0.f}; if (sl < nslab) sv[sl][j] = ((const f32x4*)(SLAB + (size_t)sl * (1280 * 1024) + (size_t)(m - ROW_S) * DM) + lane)[64 * j]; }
#pragma unroll
        for (int sl = 0; sl < 8; ++sl)
#pragma unroll
            for (int j = 0; j < 4; ++j) v[j] = v[j] + sv[sl][j];
        if (nslab > 0 || from_inputs) { f32x4* hr = (f32x4*)(H + (size_t)m * DM) + lane;
#pragma unroll
            for (int j = 0; j < 4; ++j) hr[64 * j] = v[j]; }
        norm_store(HN, m, lane, v);
    }
    const float* __restrict__ P = from_inputs ? a->in[I_XP] : (const float*)H;
    for (int m0 = 2 * gw; m0 < ROW_S; m0 += 2 * NGW) {
        f32x4 v[2][4];
#pragma unroll
        for (int q = 0; q < 2; ++q)
#pragma unroll
            for (int j = 0; j < 4; ++j) v[q][j] = ((const f32x4*)(P + (size_t)(m0 + q) * DM) + lane)[64 * j];
#pragma unroll
        for (int q = 0; q < 2; ++q) norm_store(HN, m0 + q, lane, v[q]);
    }
}
__device__ __forceinline__ void phase_final(ArgsP a, int wave, int lane) {
    const float* H = (const float*)(a->ws + WS_H); const float* fw = a->in[I_FNORM]; const float* SLAB = (const float*)(a->ws + WS_SLAB);
    const int gw = blockIdx.x * NWAVES + wave, NGW = gridDim.x * NWAVES;
    f32x4 w[4];
#pragma unroll
    for (int j = 0; j < 4; ++j) w[j] = ((const f32x4*)fw)[lane + 64 * j];
    for (int m = gw; m < ROW_M; m += NGW) {
        const f32x4* xr = (const f32x4*)(H + (size_t)m * DM) + lane;
        f32x4 v[4]; float s = 0.f;
#pragma unroll
        for (int j = 0; j < 4; ++j) v[j] = __builtin_nontemporal_load(xr + 64 * j);
        if (m >= ROW_S) {
            for (int sl = 0; sl < 8; ++sl) { const f32x4* sr = (const f32x4*)(SLAB + (size_t)sl * (1280 * 1024) + (size_t)(m - ROW_S) * DM) + lane;
#pragma unroll
                for (int j = 0; j < 4; ++j) v[j] = v[j] + sr[64 * j]; }
        }
#pragma unroll
        for (int j = 0; j < 4; ++j) s += (v[j].x * v[j].x + v[j].y * v[j].y) + (v[j].z * v[j].z + v[j].w * v[j].w);
        const float rs = rsqrtf(wave_sum(s) * (1.f / DM) + EPS);
        f32x4* o = (f32x4*)(a->out + O_YP + (size_t)m * DM) + lane;
#pragma unroll
        for (int j = 0; j < 4; ++j) __builtin_nontemporal_store(v[j] * rs * w[j], o + 64 * j);
    }
}

__device__ __forceinline__ void unpack8(const u32x4 w, float (&f)[8]) { f[0] = bflo(w.x); f[1] = bfhi(w.x); f[2] = bflo(w.y); f[3] = bfhi(w.y); f[4] = bflo(w.z); f[5] = bfhi(w.z); f[6] = bflo(w.w); f[7] = bfhi(w.w); }
__device__ __forceinline__ void ld8f(const float* __restrict__ p, float (&f)[8]) { const f32x4 x0 = *(const f32x4*)p, x1 = *(const f32x4*)(p + 4); f[0]=x0.x;f[1]=x0.y;f[2]=x0.z;f[3]=x0.w;f[4]=x1.x;f[5]=x1.y;f[6]=x1.z;f[7]=x1.w; }
#define TSW(ch) ((((ch) >> 3) & 7) << 3)
struct ConvW { float w0[8], w1[8], w2[8], w3[8], bs[8]; };
__device__ __forceinline__ void conv_load_w(const float* __restrict__ cw, const float* __restrict__ cb, int c0, ConvW& W) { ld8f(cw + c0, W.w0); ld8f(cw + CONVD + c0, W.w1); ld8f(cw + 2 * CONVD + c0, W.w2); ld8f(cw + 3 * CONVD + c0, W.w3); ld8f(cb + c0, W.bs); }
__device__ __forceinline__ void conv_load_run(const bf16* __restrict__ ZX, int Rrow, int c0, int pk, bool valid, u32x4 (&raw)[11]) {
#pragma unroll
    for (int t = 0; t < 8; ++t) { raw[3 + t] = (u32x4){0u, 0u, 0u, 0u}; if (valid) raw[3 + t] = *(const u32x4*)(ZX + (size_t)(Rrow + t) * ZXW + 2048 + c0); }
#pragma unroll
    for (int t = 0; t < 3; ++t) { const int rr = (pk == 1) ? ROW_M + 13 + t : Rrow - 3 + t; raw[t] = (u32x4){0u, 0u, 0u, 0u}; if (valid && pk != 2) raw[t] = *(const u32x4*)(ZX + (size_t)rr * ZXW + 2048 + c0); }
}
template <int J> __device__ __forceinline__ void conv_channel(const u32x4 (&raw)[11], const ConvW& W, float (&o)[8]) {
    float x[11];
#pragma unroll
    for (int i = 0; i < 11; ++i) { const unsigned w = raw[i][J >> 1]; x[i] = (J & 1) ? bfhi(w) : bflo(w); }
#pragma unroll
    for (int t = 0; t < 8; ++t) { const float v = W.bs[J] + W.w0[J] * x[t] + W.w1[J] * x[t + 1] + W.w2[J] * x[t + 2] + W.w3[J] * x[t + 3]; o[t] = v * sigmoid_f(v); }
}
template <int J> __device__ __forceinline__ void conv_store_t(const u32x4 (&raw)[11], const ConvW& W, const float (&scale)[8], bf16* T, int ch0, int run) {
    float o[8]; conv_channel<J>(raw, W, o);
    u32x4 w; w.x = pkbf(o[0] * scale[0], o[1] * scale[1]); w.y = pkbf(o[2] * scale[2], o[3] * scale[3]); w.z = pkbf(o[4] * scale[4], o[5] * scale[5]); w.w = pkbf(o[6] * scale[6], o[7] * scale[7]);
    *(u32x4*)(T + (ch0 + J) * LDX + ((8 * run) ^ TSW(ch0 + J))) = w;
}
__device__ __forceinline__ void conv_item_t(const u32x4 (&raw)[11], const ConvW& W, const float (&scale)[8], bf16* T, int ch0, int run) {
    conv_store_t<0>(raw, W, scale, T, ch0, run); conv_store_t<1>(raw, W, scale, T, ch0, run); conv_store_t<2>(raw, W, scale, T, ch0, run); conv_store_t<3>(raw, W, scale, T, ch0, run);
    conv_store_t<4>(raw, W, scale, T, ch0, run); conv_store_t<5>(raw, W, scale, T, ch0, run); conv_store_t<6>(raw, W, scale, T, ch0, run); conv_store_t<7>(raw, W, scale, T, ch0, run);
}
__device__ __forceinline__ void conv_item_n(const u32x4 (&raw)[11], const ConvW& W, bf16* N, int run, int colel) {
    float p0[8], p1[8], p2[8]; unpack8(raw[0], p0); unpack8(raw[1], p1); unpack8(raw[2], p2);
#pragma unroll
    for (int t = 0; t < 8; ++t) { float x[8]; unpack8(raw[3 + t], x); float o[8];
#pragma unroll
        for (int j = 0; j < 8; ++j) { const float v = W.bs[j] + W.w0[j] * p0[j] + W.w1[j] * p1[j] + W.w2[j] * p2[j] + W.w3[j] * x[j]; o[j] = v * sigmoid_f(v); }
        u32x4 w; w.x = pkbf(o[0], o[1]); w.y = pkbf(o[2], o[3]); w.z = pkbf(o[4], o[5]); w.w = pkbf(o[6], o[7]);
        *(u32x4*)(N + (8 * run + t) * LDX + colel) = w;
#pragma unroll
        for (int j = 0; j < 8; ++j) { p0[j] = p1[j]; p1[j] = p2[j]; p2[j] = x[j]; } }
}
__device__ __forceinline__ void conv_state_out(const u32x4 (&raw)[11], float* __restrict__ dst  ) {
#pragma unroll
    for (int k = 0; k < 3; ++k) { float x[8]; unpack8(raw[8 + k], x); *(f32x4*)(dst + (size_t)k * CONVD) = (f32x4){x[0], x[1], x[2], x[3]}; *(f32x4*)(dst + (size_t)k * CONVD + 4) = (f32x4){x[4], x[5], x[6], x[7]}; }
}

__device__ __forceinline__ void ssd_acs(const float* DT, const float* alog, int R0, int len, int h0, float* s_dt, float* s_acs, int wave, int lane) {
    if (wave < 4) {
        const int r = wave; const float An = -__expf(alog[h0 + r]);
        const int l0 = 2 * lane;
        const float d0 = (l0 < len) ? DT[(size_t)(R0 + l0) * 32 + h0 + r] : 0.f;
        const float d1 = (l0 + 1 < len) ? DT[(size_t)(R0 + l0 + 1) * 32 + h0 + r] : 0.f;
        const float a0 = d0 * An, a1 = d1 * An, s = a0 + a1;
        float incl = s;
#pragma unroll
        for (int o = 1; o < 64; o <<= 1) { const float t = __shfl_up(incl, o); if (lane >= o) incl += t; }
        const float excl = incl - s;
        s_dt[r * 128 + l0] = d0; s_dt[r * 128 + l0 + 1] = d1;
        s_acs[r * 128 + l0] = excl + a0; s_acs[r * 128 + l0 + 1] = excl + s;
    }
}
#define LFRAG(base, row, ld, ks) (*(const bf16x8*)((base) + (row) * (ld) + 32 * (ks) + 8 * fq))

__device__ __forceinline__ void ssd1_unit(ArgsP a, int li, unsigned char* lds, int slot, int g, int R0, int len, int, int, int) {
    const int tid = ltid(), lane = tid & 63, wave = __builtin_amdgcn_readfirstlane(tid >> 6);
    const float* __restrict__ DT = (const float*)(a->ws + WS_DT);
    bf16* __restrict__ CS = (bf16*)(a->ws + WS_CS); float* __restrict__ CD = (float*)(a->ws + WS_CD);
    bf16* XsT = (bf16*)lds;
    bf16* BT = (bf16*)(lds + 256 * LDX * 2);
    float* s_dt = (float*)(lds + 384 * LDX * 2); float* s_acs = s_dt + 512;
    const int fr = lane & 15, fq = lane >> 4, h0 = g * 4;
    const float* __restrict__ cw = a->in[I_ACONVW] + (size_t)li * 4 * CONVD; const float* __restrict__ cbias = a->in[I_ACONVB] + (size_t)li * CONVD;
    const bf16* __restrict__ ZX = (const bf16*)(a->ws + WS_ZX);
    const bool meta = (slot == 128), chunk0 = (!meta && (slot & 63) == 0);
    const int xcb = tid & 31, xrun = tid >> 5, xc0 = g * 256 + xcb * 8;
    const int bcb = tid & 15, brun = (tid >> 4) & 15, bc0 = 2048 + g * 128 + bcb * 8;
    u32x4 rx[11], rb[11];
    conv_load_run(ZX, R0 + 8 * xrun, xc0, (xrun == 0) ? (meta ? 2 : (chunk0 ? 1 : 0)) : 0, 8 * xrun < len, rx);
    if (tid < 256) conv_load_run(ZX, R0 + 8 * brun, bc0, (brun == 0) ? (meta ? 2 : (chunk0 ? 1 : 0)) : 0, 8 * brun < len, rb);
    ssd_acs(DT, a->in[I_ALOG] + li * NHEADS, R0, len, h0, s_dt, s_acs, wave, lane);
    if (tid < 256) { ConvW W; conv_load_w(cw, cbias, bc0, W); const float one[8] = {1.f, 1.f, 1.f, 1.f, 1.f, 1.f, 1.f, 1.f}; conv_item_t(rb, W, one, BT, bcb * 8, brun); }
    __syncthreads();
    {   ConvW W; conv_load_w(cw, cbias, xc0, W);
        const int r = xcb >> 3; const float tot = s_acs[r * 128 + 127];
        const f32x4 a0 = *(const f32x4*)(s_acs + r * 128 + 8 * xrun), a1 = *(const f32x4*)(s_acs + r * 128 + 8 * xrun + 4), d0 = *(const f32x4*)(s_dt + r * 128 + 8 * xrun), d1 = *(const f32x4*)(s_dt + r * 128 + 8 * xrun + 4);
        float wl[8];
#pragma unroll
        for (int t = 0; t < 4; ++t) { wl[t] = __expf(tot - a0[t]) * d0[t]; wl[4 + t] = __expf(tot - a1[t]) * d1[t]; }
        conv_item_t(rx, W, wl, XsT, xcb * 8, xrun);
    }
    __syncthreads();
    f32x4 acc[2][8];
#pragma unroll
    for (int mi = 0; mi < 2; ++mi)
#pragma unroll
        for (int ni = 0; ni < 8; ++ni) acc[mi][ni] = (f32x4){0.f, 0.f, 0.f, 0.f};
#pragma unroll
    for (int ks = 0; ks < 4; ++ks) {
        const int ra0 = 32 * wave + fr, ra1 = ra0 + 16;
        const bf16x8 a0 = *(const bf16x8*)(XsT + ra0 * LDX + ((32 * ks + 8 * fq) ^ TSW(ra0))), a1 = *(const bf16x8*)(XsT + ra1 * LDX + ((32 * ks + 8 * fq) ^ TSW(ra1)));
#pragma unroll
        for (int ni = 0; ni < 8; ++ni) { const int rb = 16 * ni + fr; const bf16x8 bb = *(const bf16x8*)(BT + rb * LDX + ((32 * ks + 8 * fq) ^ TSW(rb)));
            acc[0][ni] = MFMA16(bb, a0, acc[0][ni]); acc[1][ni] = MFMA16(bb, a1, acc[1][ni]); }
    }
#pragma unroll
    for (int mi = 0; mi < 2; ++mi) { const int hp = 32 * wave + 16 * mi + fr, r = hp >> 6, p = hp & 63;
        bf16* dst = CS + ((size_t)(slot * 32 + h0 + r) * 64 + p) * 128 + 4 * fq;
#pragma unroll
        for (int ni = 0; ni < 8; ++ni) { u32x2 w; w.x = pkbf(acc[mi][ni][0], acc[mi][ni][1]); w.y = pkbf(acc[mi][ni][2], acc[mi][ni][3]); *(u32x2*)(dst + 16 * ni) = w; } }
    if (tid < 4) CD[slot * 32 + h0 + tid] = __expf(s_acs[tid * 128 + 127]);
    __syncthreads();
}

__device__ __forceinline__ void ssd_sample_issue(ArgsP a, int li, int b, int g, f32x4 (&st)[4][4]) {
    const int tid = ltid(), p = tid >> 3, nb = tid & 7;
    const float* __restrict__ sin_ = a->in[I_SSSM] + ((size_t)((li * NSAMP + b) * NHEADS + g * 4) * 64 + p) * 128 + 4 * nb;
#pragma unroll
    for (int r = 0; r < 4; ++r)
#pragma unroll
        for (int kk = 0; kk < 4; ++kk) st[r][kk] = __builtin_nontemporal_load((const f32x4*)(sin_ + (size_t)r * 8192 + 32 * kk));
}
__device__ __forceinline__ void ssd_sample_unit(ArgsP a, int li, unsigned char* lds, int b, int g, f32x4 (&st)[4][4]) {
    const int tid = ltid(), lane = tid & 63, wave = __builtin_amdgcn_readfirstlane(tid >> 6);
    const bf16* __restrict__ ZX = (const bf16*)(a->ws + WS_ZX); const float* __restrict__ DT = (const float*)(a->ws + WS_DT); bf16* __restrict__ YN = (bf16*)(a->ws + WS_YN);
    float* sX = (float*)lds; float* sB = sX + 8 * 256; float* sC = sB + 8 * 128; float* sY = sC + 8 * 128; float* sDt = sY + 8 * 256;
    const int R0 = ROW_S + b * 8, h0 = g * 4;
    const int p = tid >> 3, nb = tid & 7;
    float* __restrict__ sout = a->out + O_SSSM + ((size_t)((li * NSAMP + b) * NHEADS + h0) * 64 + p) * 128 + 4 * nb;
    {
        const float* __restrict__ cw = a->in[I_ACONVW] + (size_t)li * 4 * CONVD; const float* __restrict__ cbias = a->in[I_ACONVB] + (size_t)li * CONVD;
        const int t = tid >> 6, ck = tid & 63;
        const int c0 = (ck < 32) ? g * 256 + ck * 8 : (ck < 48) ? 2048 + g * 128 + (ck - 32) * 8 : 3072 + g * 128 + (ck - 48) * 8;
        float* dst = (ck < 32) ? sX + t * 256 + ck * 8 : (ck < 48) ? sB + t * 128 + (ck - 32) * 8 : sC + t * 128 + (ck - 48) * 8;
        const float* __restrict__ sc = a->in[I_SCONV] + ((size_t)(li * NSAMP + b) * 3) * CONVD + c0;
        float xr[4][8];
#pragma unroll
        for (int k = 0; k < 4; ++k) { const int tt = t - 3 + k;
            if (tt >= 0) unpack8(*(const u32x4*)(ZX + (size_t)(R0 + tt) * ZXW + 2048 + c0), xr[k]); else ld8f(sc + (size_t)(tt + 3) * CONVD, xr[k]); }
        ConvW W; conv_load_w(cw, cbias, c0, W);
        float o[8];
#pragma unroll
        for (int j = 0; j < 8; ++j) { const float v = W.bs[j] + W.w0[j] * xr[0][j] + W.w1[j] * xr[1][j] + W.w2[j] * xr[2][j] + W.w3[j] * xr[3][j]; o[j] = v * sigmoid_f(v); }
        *(f32x4*)dst = (f32x4){o[0], o[1], o[2], o[3]}; *(f32x4*)(dst + 4) = (f32x4){o[4], o[5], o[6], o[7]};
        if (t >= 5) { float* __restrict__ so = a->out + O_SCONV + ((size_t)(li * NSAMP + b) * 3 + (t - 5)) * CONVD + c0;
            *(f32x4*)so = (f32x4){xr[3][0], xr[3][1], xr[3][2], xr[3][3]}; *(f32x4*)(so + 4) = (f32x4){xr[3][4], xr[3][5], xr[3][6], xr[3][7]}; }
    }
    if (tid < 32) sDt[tid] = DT[(size_t)(R0 + (tid >> 2)) * 32 + h0 + (tid & 3)];
    __syncthreads();
    float An[4], Dk[4];
#pragma unroll
    for (int r = 0; r < 4; ++r) { An[r] = -__expf(a->in[I_ALOG][li * NHEADS + h0 + r]); Dk[r] = a->in[I_ADSKIP][li * NHEADS + h0 + r]; }
    float part[8][4];
#pragma unroll
    for (int t = 0; t < 8; ++t) {
        f32x4 bv[4], cv[4];
#pragma unroll
        for (int kk = 0; kk < 4; ++kk) { bv[kk] = *(const f32x4*)(sB + t * 128 + 32 * kk + 4 * nb); cv[kk] = *(const f32x4*)(sC + t * 128 + 32 * kk + 4 * nb); }
#pragma unroll
        for (int r = 0; r < 4; ++r) {
            const float dt = sDt[t * 4 + r], dA = __expf(dt * An[r]), xv = sX[t * 256 + r * 64 + p], coef = dt * xv;
            float pr = 0.f;
#pragma unroll
            for (int kk = 0; kk < 4; ++kk) { st[r][kk] = st[r][kk] * dA + bv[kk] * coef; pr += (cv[kk].x * st[r][kk].x + cv[kk].y * st[r][kk].y) + (cv[kk].z * st[r][kk].z + cv[kk].w * st[r][kk].w); }
            part[t][r] = pr;
        }
    }
#pragma unroll
    for (int r = 0; r < 4; ++r)
#pragma unroll
        for (int kk = 0; kk < 4; ++kk) __builtin_nontemporal_store(st[r][kk], (f32x4*)(sout + (size_t)r * 8192 + 32 * kk));
#pragma unroll
    for (int t = 0; t < 8; ++t)
#pragma unroll
        for (int r = 0; r < 4; ++r) { float v = part[t][r]; v += __shfl_xor(v, 1); v += __shfl_xor(v, 2); v += __shfl_xor(v, 4); part[t][r] = v; }
    if (nb == 0) {
#pragma unroll
        for (int t = 0; t < 8; ++t)
#pragma unroll
            for (int r = 0; r < 4; ++r) sY[t * 256 + r * 64 + p] = part[t][r] + Dk[r] * sX[t * 256 + r * 64 + p];
    }
    __syncthreads();
    {
        const int t = wave, c4 = lane * 4; const size_t row = (size_t)(R0 + t);
        const f32x4 y = *(const f32x4*)(sY + t * 256 + c4);
        const u32x2 zz = *(const u32x2*)(ZX + row * ZXW + g * 256 + c4);
        const float z0 = bflo(zz.x), z1 = bfhi(zz.x), z2 = bflo(zz.y), z3 = bfhi(zz.y);
        const float g0 = y.x * z0 * sigmoid_f(z0), g1 = y.y * z1 * sigmoid_f(z1), g2 = y.z * z2 * sigmoid_f(z2), g3 = y.w * z3 * sigmoid_f(z3);
        const float ss = wave_sum((g0 * g0 + g1 * g1) + (g2 * g2 + g3 * g3));
        const float rs = rsqrtf(ss * (1.f / 256.f) + EPS);
        u32x2 o; o.x = pkbf(g0 * rs, g1 * rs); o.y = pkbf(g2 * rs, g3 * rs);
        *(u32x2*)(YN + row * DINNER + g * 256 + c4) = o;
    }
    __syncthreads();
}

__device__ __forceinline__ void phase_scan(ArgsP a, int li) {
    const bf16* __restrict__ CS = (const bf16*)(a->ws + WS_CS); const float* __restrict__ CD = (const float*)(a->ws + WS_CD); bf16* __restrict__ HSB = (bf16*)(a->ws + WS_HSB);
    const int gt = blockIdx.x * NTHREADS + ltid(), NT = gridDim.x * NTHREADS;
    for (int e = gt; e < 2 * 65536; e += NT) {
        const int b = e >> 16, rem = e & 65535, h = rem >> 11, pn4 = rem & 2047;
        f32x4 hc; { const u32x2 w0 = *(const u32x2*)(CS + ((size_t)(128 * 32 + h) * 2048 + pn4) * 4); hc = (f32x4){bflo(w0.x), bfhi(w0.x), bflo(w0.y), bfhi(w0.y)}; }
#pragma unroll 8
        for (int c = 0; c < 64; ++c) { const int slot = b * 64 + c; const size_t o = ((size_t)(slot * 32 + h) * 2048 + pn4) * 4;
            const u32x2 sw = __builtin_nontemporal_load((const u32x2*)(CS + o)); const f32x4 s = (f32x4){bflo(sw.x), bfhi(sw.x), bflo(sw.y), bfhi(sw.y)}; const float d = CD[slot * 32 + h];
            u32x2 w; w.x = pkbf(hc.x, hc.y); w.y = pkbf(hc.z, hc.w); *(u32x2*)(HSB + o) = w;
            hc = hc * d + s; }
        __builtin_nontemporal_store(hc, (f32x4*)(a->out + O_PSSM + ((size_t)((li * NPROMPT + b) * NHEADS + h) * 2048 + pn4) * 4));
    }
}

__device__ __forceinline__ void ssd3_head(int r, int hb, const bf16* Cn, const bf16* BH, const bf16* Xt, const float* s_dt, const float* s_acs, const f32x4 (&cb)[8], f32x4 (&acc)[4],
                                          const bf16* __restrict__ ZX, size_t row, int g, float Dk, int l, int wave, int fr, int fq, float& ss) {
    u32x2 zz[4];
#pragma unroll
    for (int ni = 0; ni < 4; ++ni) { const int ch = g * 256 + r * 64 + 16 * ni + 4 * fq; zz[ni] = *(const u32x2*)(ZX + row * ZXW + ch); }
    const float al = s_acs[r * 128 + l];
#pragma unroll
    for (int ni = 0; ni < 4; ++ni) acc[ni] = (f32x4){0.f, 0.f, 0.f, 0.f};
    const bf16* Hs = BH + hb * 64 * LDX;
#pragma unroll
    for (int ks = 0; ks < 4; ++ks) { const bf16x8 af = LFRAG(Cn, l, LDX, ks);
#pragma unroll
        for (int ni = 0; ni < 4; ++ni) { const bf16x8 bb = LFRAG(Hs, 16 * ni + fr, LDX, ks); acc[ni] = MFMA16(bb, af, acc[ni]); } }
    const float e = __expf(al);
#pragma unroll
    for (int ni = 0; ni < 4; ++ni) acc[ni] = acc[ni] * e;
#pragma unroll
    for (int ks = 0; ks < 4; ++ks) if (2 * ks <= wave) {
        unsigned mw[4];
#pragma unroll
        for (int hf = 0; hf < 2; ++hf) { const int ni = 2 * ks + hf, s0 = 16 * ni + 4 * fq;
            const f32x4 av = *(const f32x4*)(s_acs + r * 128 + s0), dv = *(const f32x4*)(s_dt + r * 128 + s0);
            float m[4];
#pragma unroll
            for (int j = 0; j < 4; ++j) m[j] = (s0 + j <= l) ? cb[ni][j] * __expf(al - av[j]) * dv[j] : 0.f;
            mw[2 * hf] = pkbf(m[0], m[1]); mw[2 * hf + 1] = pkbf(m[2], m[3]); }
        const u32x4 afu = (u32x4){mw[0], mw[1], mw[2], mw[3]};
        const bf16x8 af = __builtin_bit_cast(bf16x8, afu);
#pragma unroll
        for (int ni = 0; ni < 4; ++ni) { const int chl = r * 64 + 16 * ni + fr, sw = TSW(chl);
            const u32x2 b0 = *(const u32x2*)(Xt + chl * LDX + ((32 * ks + 4 * fq) ^ sw)), b1 = *(const u32x2*)(Xt + chl * LDX + ((32 * ks + 16 + 4 * fq) ^ sw));
            const u32x4 bu = (u32x4){b0.x, b0.y, b1.x, b1.y};
            acc[ni] = MFMA16(__builtin_bit_cast(bf16x8, bu), af, acc[ni]); }
    }
#pragma unroll
    for (int ni = 0; ni < 4; ++ni) {
        float xv[4];
#pragma unroll
        for (int j = 0; j < 4; ++j) { const int chl = r * 64 + 16 * ni + 4 * fq + j; xv[j] = bf2f(Xt[chl * LDX + (l ^ TSW(chl))]); }
        const float zv[4] = {bflo(zz[ni].x), bfhi(zz[ni].x), bflo(zz[ni].y), bfhi(zz[ni].y)};
#pragma unroll
        for (int j = 0; j < 4; ++j) { const float q = (acc[ni][j] + Dk * xv[j]) * zv[j] * sigmoid_f(zv[j]); acc[ni][j] = q; ss += q * q; } }
}
__device__ __forceinline__ void ssd3_unit(ArgsP a, int li, unsigned char* lds, const bf16* __restrict__ hs, int slot, int g, int R0, int len, int, int, int) {
    const int tid = ltid(), lane = tid & 63, wave = __builtin_amdgcn_readfirstlane(tid >> 6);
    const bf16* __restrict__ ZX = (const bf16*)(a->ws + WS_ZX); const float* __restrict__ DT = (const float*)(a->ws + WS_DT); bf16* __restrict__ YN = (bf16*)(a->ws + WS_YN);
    bf16* Cn = (bf16*)lds; bf16* BH = Cn + 128 * LDX; bf16* Xt = BH + 128 * LDX;
    float* s_dt = (float*)(Xt + 256 * LDX); float* s_acs = s_dt + 512;
    const int fr = lane & 15, fq = lane >> 4, h0 = g * 4;
    {
        const float* __restrict__ cw = a->in[I_ACONVW] + (size_t)li * 4 * CONVD; const float* __restrict__ cbias = a->in[I_ACONVB] + (size_t)li * CONVD;
        const bool meta = (slot == 128), chunk0 = (!meta && (slot & 63) == 0);
        const int half = tid >> 8, ncb = tid & 15, nrun = (tid >> 4) & 15, nc0 = (half ? 2048 : 3072) + g * 128 + ncb * 8;
        const int xcb = tid & 31, xrun = tid >> 5, xc0 = g * 256 + xcb * 8;
        u32x4 rn[11], rx[11];
        conv_load_run(ZX, R0 + 8 * nrun, nc0, (nrun == 0) ? (meta ? 2 : (chunk0 ? 1 : 0)) : 0, 8 * nrun < len, rn);
        conv_load_run(ZX, R0 + 8 * xrun, xc0, (xrun == 0) ? (meta ? 2 : (chunk0 ? 1 : 0)) : 0, 8 * xrun < len, rx);
        ssd_acs(DT, a->in[I_ALOG] + li * NHEADS, R0, len, h0, s_dt, s_acs, wave, lane);
        { ConvW W; conv_load_w(cw, cbias, nc0, W); conv_item_n(rn, W, half ? BH : Cn, nrun, ncb * 8); }
        { ConvW W; conv_load_w(cw, cbias, xc0, W); const float one[8] = {1.f, 1.f, 1.f, 1.f, 1.f, 1.f, 1.f, 1.f}; conv_item_t(rx, W, one, Xt, xcb * 8, xrun); }
        if (!meta && (slot & 63) == 63) {
            float* __restrict__ dst = a->out + O_PCONV + (size_t)((li * NPROMPT + (slot >> 6)) * 3) * CONVD;
            if (nrun == 15) conv_state_out(rn, dst + nc0);
            if (xrun == 15) conv_state_out(rx, dst + xc0);
        }
    }
    __syncthreads();
    u32x2 hv[8];
#pragma unroll
    for (int k = 0; k < 8; ++k) { const int item = tid + NTHREADS * k; hv[k] = (u32x2){0u, 0u}; if (hs) hv[k] = __builtin_nontemporal_load((const u32x2*)(hs + (size_t)item * 4)); }
    const bool active = (16 * wave < len);
    f32x4 cb[8];
#pragma unroll
    for (int ni = 0; ni < 8; ++ni) cb[ni] = (f32x4){0.f, 0.f, 0.f, 0.f};
    if (active) {
#pragma unroll
    for (int ks = 0; ks < 4; ++ks) { const bf16x8 af = LFRAG(Cn, 16 * wave + fr, LDX, ks);
#pragma unroll
        for (int ni = 0; ni < 8; ++ni) { const bf16x8 bb = LFRAG(BH, 16 * ni + fr, LDX, ks); cb[ni] = MFMA16(bb, af, cb[ni]); } }
    }
    __syncthreads();
#pragma unroll
    for (int k = 0; k < 8; ++k) { const int item = tid + NTHREADS * k, hp = item >> 5, n4 = item & 31; *(u32x2*)(BH + hp * LDX + n4 * 4) = hv[k]; }
#pragma unroll
    for (int k = 0; k < 8; ++k) { const int item = tid + NTHREADS * k; hv[k] = (u32x2){0u, 0u}; if (hs) hv[k] = __builtin_nontemporal_load((const u32x2*)(hs + (size_t)(2 * 8192) + (size_t)item * 4)); }
    __syncthreads();
    const int l = 16 * wave + fr;
    const size_t row = (size_t)(R0 + ((l < len) ? l : 0));
    f32x4 y0[4], y1[4], y2[4], y3[4];
    float ss = 0.f;
    const float* dsk = a->in[I_ADSKIP] + li * NHEADS + h0;
    if (active) {
    ssd3_head(0, 0, Cn, BH, Xt, s_dt, s_acs, cb, y0, ZX, row, g, dsk[0], l, wave, fr, fq, ss);
    ssd3_head(1, 1, Cn, BH, Xt, s_dt, s_acs, cb, y1, ZX, row, g, dsk[1], l, wave, fr, fq, ss);
    }
    __syncthreads();
#pragma unroll
    for (int k = 0; k < 8; ++k) { const int item = tid + NTHREADS * k, hp = item >> 5, n4 = item & 31; *(u32x2*)(BH + hp * LDX + n4 * 4) = hv[k]; }
    __syncthreads();
    if (active) {
    ssd3_head(2, 0, Cn, BH, Xt, s_dt, s_acs, cb, y2, ZX, row, g, dsk[2], l, wave, fr, fq, ss);
    ssd3_head(3, 1, Cn, BH, Xt, s_dt, s_acs, cb, y3, ZX, row, g, dsk[3], l, wave, fr, fq, ss);
    ss += __shfl_xor(ss, 16); ss += __shfl_xor(ss, 32);
    }
    const float rs = rsqrtf(ss * (1.f / 256.f) + EPS);
    if (active && l < len) {
        bf16* yrow = YN + row * DINNER + g * 256 + 4 * fq;
#pragma unroll
        for (int ni = 0; ni < 4; ++ni) {
            u32x2 w;
            w.x = pkbf(y0[ni][0] * rs, y0[ni][1] * rs); w.y = pkbf(y0[ni][2] * rs, y0[ni][3] * rs); *(u32x2*)(yrow + 0 * 64 + 16 * ni) = w;
            w.x = pkbf(y1[ni][0] * rs, y1[ni][1] * rs); w.y = pkbf(y1[ni][2] * rs, y1[ni][3] * rs); *(u32x2*)(yrow + 1 * 64 + 16 * ni) = w;
            w.x = pkbf(y2[ni][0] * rs, y2[ni][1] * rs); w.y = pkbf(y2[ni][2] * rs, y2[ni][3] * rs); *(u32x2*)(yrow + 2 * 64 + 16 * ni) = w;
            w.x = pkbf(y3[ni][0] * rs, y3[ni][1] * rs); w.y = pkbf(y3[ni][2] * rs, y3[ni][3] * rs); *(u32x2*)(yrow + 3 * 64 + 16 * ni) = w;
        }
    }
    __syncthreads();
}
__device__ __forceinline__ void phase_ssd1(ArgsP a, int li, unsigned char* lds, int tid, int wave, int lane) {
    const int c = blockIdx.x;
#pragma unroll 1
    for (int j = 0; j < 4; ++j) {
        const int u = c + 256 * j;
        f32x4 st[4][4];
        ssd_sample_issue(a, li, u >> 3, u & 7, st);
#ifndef PROBE_SSD1
#define PROBE_SSD1 0
#endif
#pragma unroll 1
        for (int rp = 0; rp < (PROBE_SSD1 == 1 ? 2 : 1); ++rp) { const int slot = u >> 3, g = u & 7; ssd1_unit(a, li, lds, slot, g, (slot >> 6) * SEQ + (slot & 63) * 128, 128, tid, wave, lane); }
        ssd_sample_unit(a, li, lds, u >> 3, u & 7, st);
    }
    if (c < 8) ssd1_unit(a, li, lds, 128, c, ROW_M, NMETA, tid, wave, lane);
    else if (c < 16) ssd3_unit(a, li, lds, nullptr, 128, c - 8, ROW_M, NMETA, tid, wave, lane);
}
__device__ __forceinline__ void phase_ssd3(ArgsP a, int li, unsigned char* lds, int tid, int wave, int lane) {
    const bf16* HSB = (const bf16*)(a->ws + WS_HSB);
#pragma unroll 1
    for (int u = blockIdx.x; u < 1024; u += gridDim.x) { const int slot = u >> 3, g = u & 7; ssd3_unit(a, li, lds, HSB + (size_t)(slot * 32 + g * 4) * 8192, slot, g, (slot >> 6) * SEQ + (slot & 63) * 128, 128, tid, wave, lane); }
}

constexpr int KS_LD = 72, VT_LD = 264, P_LD = 232, NKEYS = 208;
__device__ __forceinline__ void attn_prompt_unit(ArgsP a, int lj, unsigned char* lds, int b, int kvh, int qb, int, int, int) {
    const int tid = ltid(), lane = tid & 63, wave = __builtin_amdgcn_readfirstlane(tid >> 6);
    const bf16* __restrict__ Q = (const bf16*)(a->ws + WS_Q); const bf16* __restrict__ KV = (const bf16*)(a->ws + WS_KV); bf16* __restrict__ AO = (bf16*)(a->ws + WS_AO);
    bf16* Ks = (bf16*)lds; bf16* Vt = Ks + NKEYS * KS_LD; bf16* Pw = Vt + 64 * VT_LD + wave * 16 * P_LD;
    const int fr = lane & 15, fq = lane >> 4, t0 = qb * 64, Rb = b * SEQ;
    const int r = wave >> 1, th = (wave & 1) * 32, qh = kvh * 4 + r;
    bf16x8 q0[2], q1[2];
#pragma unroll
    for (int ks = 0; ks < 2; ++ks) { q0[ks] = *(const bf16x8*)(Q + (size_t)(Rb + t0 + th + fr) * DM + qh * 64 + 32 * ks + 8 * fq); q1[ks] = *(const bf16x8*)(Q + (size_t)(Rb + t0 + th + 16 + fr) * DM + qh * 64 + 32 * ks + 8 * fq); }
    {
        u32x4 kv[4];
#pragma unroll
        for (int k = 0; k < 4; ++k) { const int it = tid + NTHREADS * k, key = it >> 3, ch = it & 7; kv[k] = (u32x4){0u, 0u, 0u, 0u};
            if (it < NKEYS * 8) { int row; if (key < 16) row = ROW_M + key; else { int s = t0 - 128 + key - 16; if (s < 0) s = 0; row = Rb + s; }
                kv[k] = *(const u32x4*)(KV + (size_t)row * KVW + kvh * 64 + ch * 8); } }
        u32x4 v0[2], v1[2];
#pragma unroll
        for (int k = 0; k < 2; ++k) { const int it = tid + NTHREADS * k, dbl = it & 7, kp = it >> 3; v0[k] = (u32x4){0u, 0u, 0u, 0u}; v1[k] = v0[k];
            if (it < (NKEYS / 2) * 8) { const int k0 = 2 * kp, k1 = k0 + 1; int s0 = t0 - 128 + k0 - 16, s1 = t0 - 128 + k1 - 16; if (s0 < 0) s0 = 0; if (s1 < 0) s1 = 0;
                const int r0 = (k0 < 16) ? ROW_M + k0 : Rb + s0, r1 = (k1 < 16) ? ROW_M + k1 : Rb + s1;
                v0[k] = *(const u32x4*)(KV + (size_t)r0 * KVW + 256 + kvh * 64 + dbl * 8); v1[k] = *(const u32x4*)(KV + (size_t)r1 * KVW + 256 + kvh * 64 + dbl * 8); } }
#pragma unroll
        for (int k = 0; k < 4; ++k) { const int it = tid + NTHREADS * k, key = it >> 3, ch = it & 7; if (it < NKEYS * 8) *(u32x4*)(Ks + key * KS_LD + ch * 8) = kv[k]; }
#pragma unroll
        for (int k = 0; k < 2; ++k) { const int it = tid + NTHREADS * k, dbl = it & 7, kp = it >> 3;
            if (it < (NKEYS / 2) * 8) { const int col = (2 * kp) ^ (8 * dbl);
                const unsigned a0[4] = {v0[k].x, v0[k].y, v0[k].z, v0[k].w}, a1[4] = {v1[k].x, v1[k].y, v1[k].z, v1[k].w};
#pragma unroll
                for (int j = 0; j < 4; ++j) {
                    *(unsigned*)(Vt + (dbl * 8 + 2 * j) * VT_LD + col) = (a0[j] & 0xffffu) | (a1[j] << 16);
                    *(unsigned*)(Vt + (dbl * 8 + 2 * j + 1) * VT_LD + col) = (a0[j] >> 16) | (a1[j] & 0xffff0000u); } } }
#pragma unroll
        for (int k = 0; k < 3; ++k) { const int idx = tid + NTHREADS * k, row = idx / 24, c = idx - row * 24; *(unsigned*)(Vt + row * VT_LD + ((NKEYS + 2 * c) ^ TSW(row))) = 0u; }
    }
    __syncthreads();
    const float sink = a->in[I_SINKS][lj * NQ + qh];
#pragma unroll 1
    for (int blk = 0; blk < 2; ++blk) {
        const int tq = th + blk * 16 + fr, t = t0 + tq;
        bf16x8 qa2[2];
#pragma unroll
        for (int ks = 0; ks < 2; ++ks) qa2[ks] = (blk == 0) ? q0[ks] : q1[ks];
        f32x4 sc[13];
#pragma unroll
        for (int ni = 0; ni < 13; ++ni) sc[ni] = (f32x4){0.f, 0.f, 0.f, 0.f};
#pragma unroll
        for (int ni = 0; ni < 13; ++ni) {
            const bf16x8 b0 = *(const bf16x8*)(Ks + (16 * ni + fr) * KS_LD + 8 * fq), b1 = *(const bf16x8*)(Ks + (16 * ni + fr) * KS_LD + 32 + 8 * fq);
            sc[ni] = MFMA16(b0, qa2[0], sc[ni]); sc[ni] = MFMA16(b1, qa2[1], sc[ni]);
            }
        int lo = tq + 17; { const int l2 = 144 - t0; if (l2 > lo) lo = l2; }
        const unsigned span = (unsigned)(tq + 144 - lo);
        float mx = -INFINITY;
#pragma unroll
        for (int ni = 0; ni < 13; ++ni)
#pragma unroll
            for (int j = 0; j < 4; ++j) { const int key = 16 * ni + 4 * fq + j; const bool vis = (ni == 0) || ((unsigned)(key - lo) <= span);
                const float v = vis ? sc[ni][j] * 0.125f : -INFINITY; sc[ni][j] = v; mx = fmaxf(mx, v); }
        mx = fmaxf(mx, __shfl_xor(mx, 16)); mx = fmaxf(mx, __shfl_xor(mx, 32)); mx = fmaxf(mx, sink);
        float sum = 0.f;
#pragma unroll
        for (int ni = 0; ni < 13; ++ni)
#pragma unroll
            for (int j = 0; j < 4; ++j) { const float p = __expf(sc[ni][j] - mx); sc[ni][j] = p; sum += p; }
        sum += __shfl_xor(sum, 16); sum += __shfl_xor(sum, 32); sum += __expf(sink - mx);
        const float inv = frcp(sum);
#pragma unroll
        for (int ni = 0; ni < 13; ++ni) { u32x2 w; w.x = pkbf(sc[ni][0] * inv, sc[ni][1] * inv); w.y = pkbf(sc[ni][2] * inv, sc[ni][3] * inv); *(u32x2*)(Pw + fr * P_LD + 16 * ni + 4 * fq) = w; }
        *(u32x2*)(Pw + fr * P_LD + NKEYS + 4 * fq) = (u32x2){0u, 0u};
        asm volatile("s_waitcnt lgkmcnt(0)" ::: "memory");
        f32x4 o[4];
#pragma unroll
        for (int ni = 0; ni < 4; ++ni) o[ni] = (f32x4){0.f, 0.f, 0.f, 0.f};
#pragma unroll
        for (int ks = 0; ks < 7; ++ks) { const bf16x8 af = *(const bf16x8*)(Pw + fr * P_LD + 32 * ks + 8 * fq);
#pragma unroll
            for (int ni = 0; ni < 4; ++ni) { const int vr = 16 * ni + fr; const bf16x8 bb = *(const bf16x8*)(Vt + vr * VT_LD + ((32 * ks + 8 * fq) ^ TSW(vr))); o[ni] = MFMA16(bb, af, o[ni]); }
            }
#pragma unroll
        for (int ni = 0; ni < 4; ++ni) { u32x2 w; w.x = pkbf(o[ni][0], o[ni][1]); w.y = pkbf(o[ni][2], o[ni][3]); *(u32x2*)(AO + (size_t)(Rb + t) * DM + qh * 64 + 16 * ni + 4 * fq) = w; }
        asm volatile("s_waitcnt lgkmcnt(0)" ::: "memory");
    }
    __syncthreads();
}
constexpr int SK_LD = 72, SV_LD = 200, SP_LD = 168, SKEYS = 160;
__device__ __forceinline__ void attn_sample_pair(ArgsP a, int lj, unsigned char* lds, int bp, int kvh, int, int, int) {
    const int tid = ltid(), lane = tid & 63, wave = __builtin_amdgcn_readfirstlane(tid >> 6);
    const bf16* __restrict__ Q = (const bf16*)(a->ws + WS_Q); const bf16* __restrict__ KV = (const bf16*)(a->ws + WS_KV); bf16* __restrict__ AO = (bf16*)(a->ws + WS_AO);
    const float* __restrict__ CK = a->in[I_CK]; const float* __restrict__ CV = a->in[I_CV];
    constexpr int HALF_B = (SKEYS * SK_LD + 64 * SV_LD) * 2;
    const int fr = lane & 15, fq = lane >> 4;
#pragma unroll 1
    for (int it = tid; it < 2 * SKEYS * 8; it += NTHREADS) { const int hf = it / (SKEYS * 8), rem = it - hf * (SKEYS * 8), key = rem >> 3, ch = rem & 7, bb = 2 * bp + hf;
        bf16* Ks = (bf16*)(lds + hf * HALF_B);
        u32x4 w = (u32x4){0u, 0u, 0u, 0u};
        if (key < 16) w = *(const u32x4*)(KV + (size_t)(ROW_M + key) * KVW + kvh * 64 + ch * 8);
        else if (key < 144) { const float* p = CK + ((size_t)(bb * 128 + (key - 16)) * NKV + kvh) * 64 + ch * 8; const f32x4 x0 = *(const f32x4*)p, x1 = *(const f32x4*)(p + 4);
            w.x = pkbf(x0.x, x0.y); w.y = pkbf(x0.z, x0.w); w.z = pkbf(x1.x, x1.y); w.w = pkbf(x1.z, x1.w); }
        else if (key < 152) w = *(const u32x4*)(KV + (size_t)(ROW_S + bb * 8 + (key - 144)) * KVW + kvh * 64 + ch * 8);
        *(u32x4*)(Ks + key * SK_LD + ch * 8) = w; }
#pragma unroll 1
    for (int it = tid; it < 2 * 96 * 8; it += NTHREADS) { const int hf = it / (96 * 8), rem = it - hf * (96 * 8), dbl = rem & 7, kp = rem >> 3, bb = 2 * bp + hf;
        bf16* Vt = (bf16*)(lds + hf * HALF_B) + SKEYS * SK_LD;
        unsigned a0[4] = {0u, 0u, 0u, 0u}, a1[4] = {0u, 0u, 0u, 0u};
        const int k0 = 2 * kp;
        if (k0 < 16) { const u32x4 x = *(const u32x4*)(KV + (size_t)(ROW_M + k0) * KVW + 256 + kvh * 64 + dbl * 8), y = *(const u32x4*)(KV + (size_t)(ROW_M + k0 + 1) * KVW + 256 + kvh * 64 + dbl * 8);
            a0[0] = x.x; a0[1] = x.y; a0[2] = x.z; a0[3] = x.w; a1[0] = y.x; a1[1] = y.y; a1[2] = y.z; a1[3] = y.w; }
        else if (k0 < 144) { const float* p = CV + ((size_t)(bb * 128 + (k0 - 16)) * NKV + kvh) * 64 + dbl * 8; const f32x4 x0 = *(const f32x4*)p, x1 = *(const f32x4*)(p + 4), y0 = *(const f32x4*)(p + NKV * 64), y1 = *(const f32x4*)(p + NKV * 64 + 4);
            a0[0] = pkbf(x0.x, x0.y); a0[1] = pkbf(x0.z, x0.w); a0[2] = pkbf(x1.x, x1.y); a0[3] = pkbf(x1.z, x1.w); a1[0] = pkbf(y0.x, y0.y); a1[1] = pkbf(y0.z, y0.w); a1[2] = pkbf(y1.x, y1.y); a1[3] = pkbf(y1.z, y1.w); }
        else if (k0 < 152) { const u32x4 x = *(const u32x4*)(KV + (size_t)(ROW_S + bb * 8 + (k0 - 144)) * KVW + 256 + kvh * 64 + dbl * 8), y = *(const u32x4*)(KV + (size_t)(ROW_S + bb * 8 + (k0 - 143)) * KVW + 256 + kvh * 64 + dbl * 8);
            a0[0] = x.x; a0[1] = x.y; a0[2] = x.z; a0[3] = x.w; a1[0] = y.x; a1[1] = y.y; a1[2] = y.z; a1[3] = y.w; }
        const int col = (2 * kp) ^ (8 * dbl);
#pragma unroll
        for (int j = 0; j < 4; ++j) {
            *(unsigned*)(Vt + (dbl * 8 + 2 * j) * SV_LD + col) = (a0[j] & 0xffffu) | (a1[j] << 16);
            *(unsigned*)(Vt + (dbl * 8 + 2 * j + 1) * SV_LD + col) = (a0[j] >> 16) | (a1[j] & 0xffff0000u); } }
    if (lj == 0) {
#pragma unroll 1
        for (int it = tid; it < 2 * 128 * 16; it += NTHREADS) { const int hf = it >> 11, rem = it & 2047, w = rem >> 4, c4 = (rem & 15) * 4, bb = 2 * bp + hf;
            const size_t o = ((size_t)(bb * 128 + w) * NKV + kvh) * 64 + c4;
            f32x4 kx, vx;
            if (w < 120) { const size_t i = ((size_t)(bb * 128 + w + 8) * NKV + kvh) * 64 + c4; kx = *(const f32x4*)(CK + i); vx = *(const f32x4*)(CV + i); }
            else { const bf16* rp = KV + (size_t)(ROW_S + bb * 8 + (w - 120)) * KVW + kvh * 64 + c4; const u32x2 k2 = *(const u32x2*)rp, v2 = *(const u32x2*)(rp + 256);
                kx = (f32x4){bflo(k2.x), bfhi(k2.x), bflo(k2.y), bfhi(k2.y)}; vx = (f32x4){bflo(v2.x), bfhi(v2.x), bflo(v2.y), bfhi(v2.y)}; }
            __builtin_nontemporal_store(kx, (f32x4*)(a->out + O_SCK + o)); __builtin_nontemporal_store(vx, (f32x4*)(a->out + O_SCV + o)); }
    }
    __syncthreads();
    if (wave < 4) {
        const int hf = wave >> 1, rb = wave & 1, bb = 2 * bp + hf;
        const bf16* Ks = (const bf16*)(lds + hf * HALF_B); const bf16* Vt = Ks + SKEYS * SK_LD; bf16* Pw = (bf16*)(lds + 2 * HALF_B) + wave * 16 * SP_LD;
        const int r = 2 * rb + (fr >> 3), t = fr & 7, qh = kvh * 4 + r;
        const size_t qrow = (size_t)(ROW_S + bb * 8 + t);
        bf16x8 qa[2];
        if (lj == 0) {
#pragma unroll
            for (int ks = 0; ks < 2; ++ks) qa[ks] = *(const bf16x8*)(Q + qrow * DM + qh * 64 + 32 * ks + 8 * fq);
        } else {
            const float* __restrict__ SL = (const float*)(a->ws + WS_SLAB) + (size_t)(qrow - ROW_S) * DM + qh * 64 + 8 * fq;
#pragma unroll
            for (int ks = 0; ks < 2; ++ks) { f32x4 x0 = (f32x4){0.f, 0.f, 0.f, 0.f}, x1 = x0;
#pragma unroll
                for (int sl = 0; sl < 4; ++sl) { const float* p = SL + (size_t)sl * (1280 * 1024) + 32 * ks; x0 = x0 + *(const f32x4*)p; x1 = x1 + *(const f32x4*)(p + 4); }
                const u32x4 w = (u32x4){pkbf(x0.x, x0.y), pkbf(x0.z, x0.w), pkbf(x1.x, x1.y), pkbf(x1.z, x1.w)}; qa[ks] = __builtin_bit_cast(bf16x8, w); }
        }
        const float sink = a->in[I_SINKS][lj * NQ + qh];
        f32x4 sc[10];
#pragma unroll
        for (int ni = 0; ni < 10; ++ni) sc[ni] = (f32x4){0.f, 0.f, 0.f, 0.f};
#pragma unroll
        for (int ni = 0; ni < 10; ++ni) {
            const bf16x8 b0 = *(const bf16x8*)(Ks + (16 * ni + fr) * SK_LD + 8 * fq), b1 = *(const bf16x8*)(Ks + (16 * ni + fr) * SK_LD + 32 + 8 * fq);
            sc[ni] = MFMA16(b0, qa[0], sc[ni]); sc[ni] = MFMA16(b1, qa[1], sc[ni]); }
        float mx = -INFINITY;
#pragma unroll
        for (int ni = 0; ni < 10; ++ni)
#pragma unroll
            for (int j = 0; j < 4; ++j) { const int key = 16 * ni + 4 * fq + j;
                const bool vis = (ni == 0) || ((key < 144) ? (key - 16 > t) : (key - 144 <= t));
                const float v = vis ? sc[ni][j] * 0.125f : -INFINITY; sc[ni][j] = v; mx = fmaxf(mx, v); }
        mx = fmaxf(mx, __shfl_xor(mx, 16)); mx = fmaxf(mx, __shfl_xor(mx, 32)); mx = fmaxf(mx, sink);
        float sum = 0.f;
#pragma unroll
        for (int ni = 0; ni < 10; ++ni)
#pragma unroll
            for (int j = 0; j < 4; ++j) { const float p = __expf(sc[ni][j] - mx); sc[ni][j] = p; sum += p; }
        sum += __shfl_xor(sum, 16); sum += __shfl_xor(sum, 32); sum += __expf(sink - mx);
        const float inv = frcp(sum);
#pragma unroll
        for (int ni = 0; ni < 10; ++ni) { u32x2 w; w.x = pkbf(sc[ni][0] * inv, sc[ni][1] * inv); w.y = pkbf(sc[ni][2] * inv, sc[ni][3] * inv); *(u32x2*)(Pw + fr * SP_LD + 16 * ni + 4 * fq) = w; }
        asm volatile("s_waitcnt lgkmcnt(0)" ::: "memory");
        f32x4 o[4];
#pragma unroll
        for (int ni = 0; ni < 4; ++ni) o[ni] = (f32x4){0.f, 0.f, 0.f, 0.f};
#pragma unroll
        for (int ks = 0; ks < 5; ++ks) { const bf16x8 af = *(const bf16x8*)(Pw + fr * SP_LD + 32 * ks + 8 * fq);
#pragma unroll
            for (int ni = 0; ni < 4; ++ni) { const int vr = 16 * ni + fr; const bf16x8 bb2 = *(const bf16x8*)(Vt + vr * SV_LD + ((32 * ks + 8 * fq) ^ TSW(vr))); o[ni] = MFMA16(bb2, af, o[ni]); } }
#pragma unroll
        for (int ni = 0; ni < 4; ++ni) { u32x2 w; w.x = pkbf(o[ni][0], o[ni][1]); w.y = pkbf(o[ni][2], o[ni][3]); *(u32x2*)(AO + qrow * DM + qh * 64 + 16 * ni + 4 * fq) = w; }
    }
    __syncthreads();
}
__device__ __forceinline__ void phase_attn(ArgsP a, int lj, unsigned char* lds, int tid, int wave, int lane) {
    if (lj == 0) {
        const bf16* KV = (const bf16*)(a->ws + WS_KV);
        const int gt = blockIdx.x * NTHREADS + tid, NT = gridDim.x * NTHREADS;
        for (int e = gt; e < 2 * 128 * 512; e += NT) { const int b = e >> 16, w = (e >> 9) & 127, c = e & 511;
            const float v = bf2f(KV[(size_t)(b * SEQ + SEQ - 128 + w) * KVW + c]);
            if (c < 256) a->out[O_PCK + (size_t)(b * 128 + w) * 256 + c] = v; else a->out[O_PCV + (size_t)(b * 128 + w) * 256 + (c - 256)] = v; }
    }
    const int xg = blockIdx.x & 7, xi = blockIdx.x >> 3;
#pragma unroll 1
    for (int j = 0; j < 4; ++j) { const int u = 128 * xg + 4 * xi + j, qb = u & 127, kvh = (u >> 7) & 3, b = u >> 9; attn_prompt_unit(a, lj, lds, b, kvh, qb, tid, wave, lane); }
    { const int su = blockIdx.x; attn_sample_pair(a, lj, lds, su >> 2, su & 3, tid, wave, lane); }
}

constexpr int PH_B = 9 * 2, PH_F = PH_B + 7 * 2, NPHASES = PH_F + 1;
template <class Epi> __device__ __forceinline__ void run_gemm(LAS unsigned char* lds, const bf16* A, const bf16* Bt, int N, int K, const Epi& E) {
    pg8::Gemm g{A, Bt, MP, N, K}; pg8::StaticOrder S; S.init(MP, N, K, (int)gridDim.x, (int)blockIdx.x);
    pg8::gemm_phase<Epi, pg8::StaticOrder, true, true>(lds, g, S, E);
}
template <class Epi> __device__ __forceinline__ void run_gemm_res(LAS unsigned char* lds, const bf16* A, const bf16* Bt, int K, int S_, const Epi& E) {
    pg8::Gemm g{A, Bt, MP, 1024, K}; pg8::ResOrder S; S.init(K, S_, (int)gridDim.x, (int)blockIdx.x);
    pg8::gemm_phase<Epi, pg8::ResOrder, true, true>(lds, g, S, E);
}

__global__ void __launch_bounds__(NTHREADS, 2) yoco_fwd(Args args) {
    extern __shared__ __attribute__((aligned(16))) unsigned char lds[];
    LAS unsigned char* ldsl = (LAS unsigned char*)lds;
    const int tid0 = threadIdx.x;
    for (int u = tid0; u < (LDS_BYTES - LDSCTL_OFF) / 4; u += NTHREADS) ((LAS unsigned*)(ldsl + LDSCTL_OFF))[u] = 0u;
    __syncthreads();
    const int lo = args.ph_lo, hi = args.ph_hi;
    XcdBarrier bar; bar.bar = (unsigned*)(args.ws + WS_CTL) + CW_BAR; bar.x = 0; bar.st = nullptr;
    if (hi - lo > 1) bar = xcd_barrier_post((unsigned*)(args.ws + WS_CTL) + CW_BAR, (volatile LAS unsigned*)(ldsl + MISC_OFF) + 8);
    int rep = 0;
#pragma unroll 1
    for (int p = lo; p < hi;) {
        ArgsP la = (ArgsP)__builtin_amdgcn_kernarg_segment_ptr(); asm volatile("" : "+s"(la));
        unsigned char* ws = la->ws;
        const int tid = ltid();
        const int lane = tid & 63, wave = __builtin_amdgcn_readfirstlane(tid >> 6);
        bf16* HN = (bf16*)(ws + WS_HN); float* H = (float*)(ws + WS_H);
        int kind, li = 0, lj = 0, layer = 0;
        int nslab = 8;
        if (p == 0) kind = 0;
        else if (p < PH_B) { li = p / 9; layer = li; const int sub = p % 9;
            kind = (sub == 0) ? 1 : (sub == 1) ? 3 : (sub == 2) ? 5 : (sub == 3) ? 6 : (sub == 4) ? 7 : (sub == 5) ? 8 : (sub == 6) ? 1 : (sub == 7) ? 9 : 10; }
        else if (p < PH_F) { lj = (p - PH_B) / 7; layer = 2 + lj; const int sub = (p - PH_B) % 7;
            kind = (sub == 0) ? 1 : (sub == 1) ? 11 : (sub == 2) ? 12 : (sub == 3) ? 13 : (sub == 4) ? 1 : (sub == 5) ? 9 : 10; if (sub == 4) nslab = 4; }
        else kind = 14;
#ifndef KMASK
#define KMASK 0xffff
#endif
#define KON(k) ((KMASK >> (k)) & 1)
#ifndef REP_MASK
#define REP_MASK 0
#endif
        if (KON(0) && kind == 0) { phase_prologue(la, ldsl, wave, lane); phase_norm(la, 1, 0, wave, lane); }
        else if (KON(1) && kind == 1) phase_norm(la, 0, nslab, wave, lane);
        else if (KON(3) && kind == 3) { pg8::EpiInProj E{(bf16*)(ws + WS_ZX), (float*)(ws + WS_DT), la->in[I_ADTB] + li * NHEADS}; run_gemm(ldsl, HN, (const bf16*)(ws + WS_WIN + li * SZ_WIN), INPROJ_P, 1024, E); }
        else if (KON(5) && kind == 5) phase_ssd1(la, li, lds, tid, wave, lane);
        else if (KON(6) && kind == 6) phase_scan(la, li);
        else if (KON(7) && kind == 7) phase_ssd3(la, li, lds, tid, wave, lane);
        else if (KON(8) && (kind == 8 || kind == 10 || kind == 13)) {
            const bf16* A; const bf16* Bt; int K;
            if (kind == 8) { A = (const bf16*)(ws + WS_YN); Bt = (const bf16*)(ws + WS_WOUT + li * SZ_WOUT); K = 2048; }
            else if (kind == 10) { A = (const bf16*)(ws + WS_U); Bt = (const bf16*)(ws + WS_WDN + layer * SZ_WDN); K = 4096; }
            else { A = (const bf16*)(ws + WS_AO); Bt = (const bf16*)(ws + WS_WO + lj * SZ_WO); K = 1024; }
            pg8::EpiRes E{(kind == 8 && li == 0) ? la->in[I_XP] : (const float*)H, H, (float*)(ws + WS_SLAB)}; run_gemm_res(ldsl, A, Bt, K, K == 1024 ? 4 : 8, E); }
        else if (KON(9) && kind == 9) { pg8::EpiBf<1> E{(bf16*)(ws + WS_U), 4096, 1 << 20, nullptr, 0}; run_gemm(ldsl, HN, (const bf16*)(ws + WS_WUP + layer * SZ_WUP), 4096, 1024, E); }
        else if (KON(11) && kind == 11) { pg8::EpiBf<0> E{(bf16*)(ws + WS_Q), 1024, 4, (bf16*)(ws + WS_KV), KVW};
            if (lj == 0) run_gemm(ldsl, HN, (const bf16*)(ws + WS_WQKV0), 1536, 1024, E);
            else { pg8::EpiQSplit E2{(bf16*)(ws + WS_Q), (float*)(ws + WS_SLAB)}; run_gemm_res(ldsl, HN, (const bf16*)(ws + WS_WQ1), 1024, 4, E2); } }
        else if (KON(12) && kind == 12) phase_attn(la, lj, lds, tid, wave, lane);
        else if (KON(14) && kind == 14) phase_final(la, wave, lane);
        bool again = false;
        if (REP_MASK != 0) { if (rep == 0 && ((REP_MASK >> kind) & 1)) { rep = 1; again = true; } else rep = 0; }
#ifdef PROBE_DOUBLE_BARRIER
        if (p + 1 < hi || again) xcd_barrier(bar);
#endif
        if (p + 1 < hi || again) xcd_barrier(bar); else { asm volatile("s_waitcnt vmcnt(0)" ::: "memory"); __syncthreads(); }
        if (!again) ++p;
    }
}

#ifndef MK_PER_PHASE
#define MK_PER_PHASE 0
#endif
extern "C" void kernel_launch(void* const* d_in, const int* in_sizes, int n_in, void* d_out, int out_size, void* d_ws, size_t ws_size, hipStream_t stream) {
    static int grid = 0;
    if (grid == 0) {
        if (n_in != 26 || (size_t)out_size != O_END || ws_size < WS_END) { fprintf(stderr, "kernel_launch: unexpected problem (n_in %d, out %d vs %zu, ws %zu vs %zu); nothing launched\n", n_in, out_size, (size_t)O_END, ws_size, (size_t)WS_END); grid = -1; return; }
        int dev = 0, cus = 0, per_cu = 0;
        if (hipGetDevice(&dev) != hipSuccess || hipDeviceGetAttribute(&cus, hipDeviceAttributeMultiprocessorCount, dev) != hipSuccess) { grid = -1; return; }
        if (hipFuncSetAttribute((const void*)yoco_fwd, hipFuncAttributeMaxDynamicSharedMemorySize, LDS_BYTES) != hipSuccess) { fprintf(stderr, "kernel_launch: hipFuncSetAttribute failed\n"); grid = -1; return; }
        if (hipOccupancyMaxActiveBlocksPerMultiprocessor(&per_cu, (const void*)yoco_fwd, NTHREADS, LDS_BYTES) != hipSuccess || per_cu < 1) { fprintf(stderr, "kernel_launch: occupancy query says %d\n", per_cu); per_cu = 1; }
        (void)hipGetLastError();
        if (cus != 256) { fprintf(stderr, "kernel_launch: built for a 256-CU device (got %d); nothing launched\n", cus); grid = -1; return; }
        grid = cus;
    }
    if (grid < 0) return;
    if (hipMemsetAsync((char*)d_ws + WS_CTL, 0, CTL_ZERO_BYTES, stream) != hipSuccess) { fprintf(stderr, "kernel_launch: memset failed\n"); return; }
    Args a{};
    for (int i = 0; i < 26; ++i) a.in[i] = (const float*)d_in[i];
    a.out = (float*)d_out; a.ws = (unsigned char*)d_ws;
#if MK_PER_PHASE
    for (int p = 0; p < NPHASES; ++p) { a.ph_lo = p; a.ph_hi = p + 1; hipLaunchKernelGGL(yoco_fwd, dim3(grid), dim3(NTHREADS), LDS_BYTES, stream, a); }
#else
    a.ph_lo = 0; a.ph_hi = NPHASES;
    void* kargs[] = {&a};
    hipError_t e = hipLaunchCooperativeKernel((const void*)yoco_fwd, dim3(grid), dim3(NTHREADS), kargs, LDS_BYTES, stream);
    if (e != hipSuccess) fprintf(stderr, "kernel_launch: cooperative launch failed: %s (grid %d)\n", hipGetErrorString(e), grid);
#endif
}
```

```cpp
#include <hip/hip_runtime.h>
#include <cstdio>
#include <cstdint>
#include <cmath>
namespace pg8 {
#define PG8_LAS __attribute__((address_space(3)))
typedef unsigned short bf16_t;
typedef short bf16x8 __attribute__((ext_vector_type(8)));
typedef float f32x4 __attribute__((ext_vector_type(4)));
typedef unsigned u32x4 __attribute__((ext_vector_type(4)));
constexpr int BM = 256, BK = 64, HALF = 128, HTB = HALF * BK * 2  , STAGE_BYTES = 8 * HTB, NXCD = 8, WGM = 8;

__host__ __device__ __forceinline__ int lds_byte(int r, int c) { const int st = (r >> 4) * 2 + (c >> 5), rr = r & 15, cc = c & 31, ob = rr * 64 + cc * 2; return st * 1024 + (ob ^ (((ob >> 9) & 1) << 5)); }
__host__ __device__ __forceinline__ void stage_rc(int b, int& R, int& C) { const int st = b / 1024, sb = b % 1024, swz = sb ^ (((sb >> 9) & 1) << 5); R = (st >> 1) * 16 + swz / 64; C = (st & 1) * 32 + (swz % 64) / 2; }
__host__ __device__ __forceinline__ int perm32(int rho) { const int n = rho >> 4, i = rho & 15; return 8 * (i >> 2) + 4 * n + (i & 3); }

struct Unit { int pm, pn, k0, nt, aux; };
struct Gemm { const bf16_t* A; const bf16_t* Bt; int M, N, K; };

struct StaticOrder {
    int nM, nN, nwg, G, c, nt0;
    __host__ __device__ void init(int M, int N, int K, int G_, int c_) { nM = M / BM; nN = N / BM; nwg = nM * nN; G = G_; c = c_; nt0 = K / BK; }
    __host__ __device__ bool next(int i, Unit& u) const {
        const long L = (long)i * G + c; if (L >= nwg) return false;
        int wgid = (int)L; { const int q = nwg / NXCD, r = nwg % NXCD, xcd = wgid % NXCD, off = wgid / NXCD; wgid = (xcd < r ? xcd * (q + 1) : r * (q + 1) + (xcd - r) * q) + off; }
        const int nig = WGM * nN, gid = wgid / nig, fm = gid * WGM, gsz = (nM - fm) < WGM ? (nM - fm) : WGM;
        u.pm = fm + ((wgid % nig) % gsz); u.pn = (wgid % nig) / gsz; u.k0 = 0; u.nt = nt0; u.aux = -1; return true;
    }
    __device__ __forceinline__ void a_ready(const Unit&) const {}
    __device__ __forceinline__ void done(const Unit&) const {}
};
struct ResOrder {
    StaticOrder so; int S, K, c;
    __host__ __device__ void init(int K_, int S_, int G_, int c_) { so.init(64 * BM, 1024, K_, G_, c_); S = S_; K = K_; c = c_; }
    __host__ __device__ bool next(int i, Unit& u) const {
        if (i == 0) return so.next(0, u);
        if (i == 1 && c < 20 * S) { const int t = c / S, sl = c - t * S; u.pm = 64 + (t >> 2); u.pn = t & 3; u.k0 = sl * (K / S); u.nt = K / S / BK; u.aux = sl; return true; }
        return false;
    }
    __device__ __forceinline__ void a_ready(const Unit&) const {}
    __device__ __forceinline__ void done(const Unit&) const {}
};

typedef float f32x2_cv0 __attribute__((ext_vector_type(2))); typedef __bf16 bf16x2_cv0 __attribute__((ext_vector_type(2)));
__device__ __forceinline__ unsigned cvt_pk_bf16(float lo, float hi) { const f32x2_cv0 v = {lo, hi}; const bf16x2_cv0 b = __builtin_convertvector(v, bf16x2_cv0); return __builtin_bit_cast(unsigned, b); }
typedef float f32x2 __attribute__((ext_vector_type(2)));
typedef unsigned u32x2 __attribute__((ext_vector_type(2)));
__device__ __forceinline__ float softplus_f(float x) { const float y = __expf(-fabsf(x)); const float l = (y < 0.03125f) ? y * (1.f - y * (0.5f - y * (1.f / 3.f - 0.25f * y))) : __logf(1.f + y); return fmaxf(x, 0.f) + l; }
struct EpiInProj {
    static constexpr bool PERM = true, AFTER_DRAIN = false;
    bf16_t* ZX; float* DT; const float* dt_bias;
    __device__ __forceinline__ void operator()(const f32x4 (&acc)[2][2][4][2], const Unit& u, int wr, int wc, int fr, int fq) const {
        const int row0 = u.pm * BM + wr * 64 + fr;
        if (u.pn < 24) {
            const int col0 = u.pn * BM + wc * 32 + 8 * fq;
#pragma unroll
            for (int ai = 0; ai < 2; ++ai)
#pragma unroll
                for (int m = 0; m < 4; ++m) { bf16_t* rowp = ZX + (size_t)(row0 + ai * HALF + m * 16) * 6144 + col0;
#pragma unroll
                    for (int bj = 0; bj < 2; ++bj) { const f32x4 v0 = acc[ai][bj][m][0], v1 = acc[ai][bj][m][1];
                        u32x4 w; w.x = cvt_pk_bf16(v0[0], v0[1]); w.y = cvt_pk_bf16(v0[2], v0[3]); w.z = cvt_pk_bf16(v1[0], v1[1]); w.w = cvt_pk_bf16(v1[2], v1[3]);
                        *(u32x4*)(rowp + bj * HALF) = w; } }
        } else if (wc == 0) {
            const int c0 = 8 * fq;
            const f32x4 b0 = *(const f32x4*)(dt_bias + c0), b1 = *(const f32x4*)(dt_bias + c0 + 4);
#pragma unroll
            for (int ai = 0; ai < 2; ++ai)
#pragma unroll
                for (int m = 0; m < 4; ++m) { float* rowp = DT + (size_t)(row0 + ai * HALF + m * 16) * 32 + c0;
                    const f32x4 v0 = acc[ai][0][m][0] + b0, v1 = acc[ai][0][m][1] + b1;
                    f32x4 o0, o1;
#pragma unroll
                    for (int j = 0; j < 4; ++j) { o0[j] = softplus_f(v0[j]); o1[j] = softplus_f(v1[j]); }
                    *(f32x4*)(rowp) = o0; *(f32x4*)(rowp + 4) = o1; }
        }
    }
};
struct EpiRes {
    static constexpr bool PERM = false, AFTER_DRAIN = false;
    const float* B; float* H; float* SLAB;
    __device__ __forceinline__ void operator()(const f32x4 (&acc)[2][2][4][2], const Unit& u, int wr, int wc, int fr, int fq) const {
        const int row0 = u.pm * BM + wr * 64 + fr, col0 = u.pn * BM + wc * 32 + 4 * fq;
        if (u.aux >= 0) {
            float* base = SLAB + (size_t)u.aux * (1280 * 1024) + (size_t)(row0 - 16384) * 1024 + col0;
#pragma unroll
            for (int ai = 0; ai < 2; ++ai)
#pragma unroll
                for (int m = 0; m < 4; ++m) { float* rowp = base + (size_t)(ai * HALF + m * 16) * 1024;
#pragma unroll
                    for (int bj = 0; bj < 2; ++bj)
#pragma unroll
                        for (int n = 0; n < 2; ++n) *(f32x4*)(rowp + bj * HALF + n * 16) = acc[ai][bj][m][n]; }
            return;
        }
#pragma unroll
        for (int ai = 0; ai < 2; ++ai)
#pragma unroll
            for (int m = 0; m < 4; ++m) { const size_t off = (size_t)(row0 + ai * HALF + m * 16) * 1024 + col0;
                if (B == H) {
                    float* rowp = H + off;
#pragma unroll
                    for (int bj = 0; bj < 2; ++bj)
#pragma unroll
                        for (int n = 0; n < 2; ++n) { f32x4* p = (f32x4*)(rowp + bj * HALF + n * 16); *p = *p + acc[ai][bj][m][n]; }
                } else {
                    f32x4 bv[2][2];
#pragma unroll
                    for (int bj = 0; bj < 2; ++bj)
#pragma unroll
                        for (int n = 0; n < 2; ++n) bv[bj][n] = *(const f32x4*)(B + off + bj * HALF + n * 16);
#pragma unroll
                    for (int bj = 0; bj < 2; ++bj)
#pragma unroll
                        for (int n = 0; n < 2; ++n) *(f32x4*)(H + off + bj * HALF + n * 16) = bv[bj][n] + acc[ai][bj][m][n];
                } }
    }
};
template <int ACT> struct EpiBf {
    static constexpr bool PERM = true, AFTER_DRAIN = false;
    bf16_t* O0; int ldc0; int nsplit; bf16_t* O1; int ldc1;
    __device__ __forceinline__ void operator()(const f32x4 (&acc)[2][2][4][2], const Unit& u, int wr, int wc, int fr, int fq) const {
        const int row0 = u.pm * BM + wr * 64 + fr;
        bf16_t* base; int ldc, colt;
        if (u.pn < nsplit) { base = O0; ldc = ldc0; colt = u.pn * BM; } else { base = O1; ldc = ldc1; colt = (u.pn - nsplit) * BM; }
        const int col0 = colt + wc * 32 + 8 * fq;
#pragma unroll
        for (int ai = 0; ai < 2; ++ai)
#pragma unroll
            for (int m = 0; m < 4; ++m) { bf16_t* rowp = base + (size_t)(row0 + ai * HALF + m * 16) * ldc + col0;
#pragma unroll
                for (int bj = 0; bj < 2; ++bj) { f32x4 v0 = acc[ai][bj][m][0], v1 = acc[ai][bj][m][1];
                    if (ACT == 1) {
#pragma unroll
                        for (int j = 0; j < 4; ++j) { const float a = fmaxf(v0[j], 0.f), b = fmaxf(v1[j], 0.f); v0[j] = a * a; v1[j] = b * b; } }
                    u32x4 w; w.x = cvt_pk_bf16(v0[0], v0[1]); w.y = cvt_pk_bf16(v0[2], v0[3]); w.z = cvt_pk_bf16(v1[0], v1[1]); w.w = cvt_pk_bf16(v1[2], v1[3]);
                    *(u32x4*)(rowp + bj * HALF) = w; } }
    }
};
struct EpiQSplit {
    static constexpr bool PERM = true, AFTER_DRAIN = false;
    bf16_t* Q; float* SLAB;
    __device__ __forceinline__ void operator()(const f32x4 (&acc)[2][2][4][2], const Unit& u, int wr, int wc, int fr, int fq) const {
        const int row0 = u.pm * BM + wr * 64 + fr, col0 = u.pn * BM + wc * 32 + 8 * fq;
        if (u.aux >= 0) {
            float* base = SLAB + (size_t)u.aux * (1280 * 1024) + (size_t)(row0 - 16384) * 1024 + col0;
#pragma unroll
            for (int ai = 0; ai < 2; ++ai)
#pragma unroll
                for (int m = 0; m < 4; ++m) { float* rowp = base + (size_t)(ai * HALF + m * 16) * 1024;
#pragma unroll
                    for (int bj = 0; bj < 2; ++bj) { *(f32x4*)(rowp + bj * HALF) = acc[ai][bj][m][0]; *(f32x4*)(rowp + bj * HALF + 4) = acc[ai][bj][m][1]; } }
            return;
        }
#pragma unroll
        for (int ai = 0; ai < 2; ++ai)
#pragma unroll
            for (int m = 0; m < 4; ++m) { bf16_t* rowp = Q + (size_t)(row0 + ai * HALF + m * 16) * 1024 + col0;
#pragma unroll
                for (int bj = 0; bj < 2; ++bj) { const f32x4 v0 = acc[ai][bj][m][0], v1 = acc[ai][bj][m][1];
                    u32x4 w; w.x = cvt_pk_bf16(v0[0], v0[1]); w.y = cvt_pk_bf16(v0[2], v0[3]); w.z = cvt_pk_bf16(v1[0], v1[1]); w.w = cvt_pk_bf16(v1[2], v1[3]);
                    *(u32x4*)(rowp + bj * HALF) = w; } }
    }
};

template <class Epi, class Sched, bool ALIGN_EPI = false, bool SP2 = false>
__device__ __forceinline__ void gemm_phase(PG8_LAS unsigned char* lds, const Gemm g, const Sched& S, const Epi& E) {
    int tid_l = threadIdx.x; asm volatile("" : "+v"(tid_l));
    const int tid = tid_l, wid = __builtin_amdgcn_readfirstlane(tid >> 6), lane = tid & 63, wr = wid >> 2, wc = wid & 3, fr = lane & 15, fq = lane >> 4;
    const int K = g.K;
    unsigned voffA[2], voffB[2];
#pragma unroll
    for (int i = 0; i < 2; ++i) { int R, C; stage_rc(tid * 16 + i * 8192, R, C); const int Rb = Epi::PERM ? ((R & ~31) + perm32(R & 31)) : R;
        voffA[i] = (unsigned)(R * K + C) * 2u; voffB[i] = (unsigned)(Rb * K + C) * 2u; }
    const size_t kstep = (size_t)(BK * 2);
    const size_t hstep = (size_t)HALF * K * 2;
    const size_t tstep = 2 * hstep;
    const unsigned ldsw = (unsigned)wid * 1024u;
    const int aoff = lds_byte(wr * 64 + fr, fq * 8), boff = lds_byte(wc * 32 + fr, fq * 8);
#define PG8_SA(b, h) (((b) * 2 + (h)) * HTB)
#define PG8_SB(b, h) ((4 + (b) * 2 + (h)) * HTB)
#define PG8_STAGE(bufoff, gbase, voff) do { _Pragma("unroll") for (int _i = 0; _i < 2; ++_i) \
        __builtin_amdgcn_global_load_lds((const unsigned*)((const char*)(gbase) + (voff)[_i]), (PG8_LAS unsigned*)(lds + (bufoff) + ldsw + _i * 8192), 16, 0, 0); } while (0)
#define PG8_LDA(dst, b, h) do { _Pragma("unroll") for (int m = 0; m < 4; ++m) _Pragma("unroll") for (int k = 0; k < 2; ++k) dst[m][k] = *(const PG8_LAS bf16x8*)(lds + PG8_SA(b, h) + aoff + m * 2048 + k * 1024); } while (0)
#define PG8_LDB(dst, b, h) do { _Pragma("unroll") for (int n = 0; n < 2; ++n) _Pragma("unroll") for (int k = 0; k < 2; ++k) dst[n][k] = *(const PG8_LAS bf16x8*)(lds + PG8_SB(b, h) + boff + n * 2048 + k * 1024); } while (0)
#define PG8_MMA(ai, bj, At, Bt) do { __builtin_amdgcn_s_setprio(1); _Pragma("unroll") for (int m = 0; m < 4; ++m) _Pragma("unroll") for (int n = 0; n < 2; ++n) _Pragma("unroll") for (int k = 0; k < 2; ++k) \
        acc[ai][bj][m][n] = __builtin_amdgcn_mfma_f32_16x16x32_bf16(Bt[n][k], At[m][k], acc[ai][bj][m][n], 0, 0, 0); __builtin_amdgcn_s_setprio(0); } while (0)
#define PG8_WAIT_V(n) asm volatile("s_waitcnt vmcnt(" #n ")" ::: "memory")
#define PG8_WAIT_L(n) asm volatile("s_waitcnt lgkmcnt(" #n ")" ::: "memory")
#define PG8_BAR __builtin_amdgcn_s_barrier()
#define PG8_SCHED __builtin_amdgcn_sched_barrier(0)
    Unit cur, nxt; int ui = 0;
    if (!S.next(0, cur)) return;
    f32x4 acc[2][2][4][2];
#pragma unroll
    for (int a = 0; a < 2; ++a)
#pragma unroll
        for (int b = 0; b < 2; ++b)
#pragma unroll
            for (int m = 0; m < 4; ++m)
#pragma unroll
                for (int n = 0; n < 2; ++n) acc[a][b][m][n] = (f32x4){0.f, 0.f, 0.f, 0.f};
    bf16x8 At[4][2], B0[2][2], B1[2][2];
    const char* cA = (const char*)g.A + (size_t)cur.pm * tstep + (size_t)cur.k0 * 2; const char* cB = (const char*)g.Bt + (size_t)cur.pn * tstep + (size_t)cur.k0 * 2;
    S.a_ready(cur);
    if constexpr (SP2) {
        PG8_STAGE(PG8_SB(0, 0), cB, voffB); PG8_STAGE(PG8_SB(0, 1), cB + hstep, voffB); PG8_STAGE(PG8_SA(0, 0), cA, voffA); PG8_STAGE(PG8_SA(0, 1), cA + hstep, voffA);
        if (wr == 1) PG8_BAR;
        PG8_WAIT_V(2); PG8_BAR;
        PG8_STAGE(PG8_SB(1, 0), cB + kstep, voffB); PG8_STAGE(PG8_SA(1, 0), cA + kstep, voffA); PG8_STAGE(PG8_SB(1, 1), cB + hstep + kstep, voffB);
        PG8_WAIT_V(6); PG8_BAR;
    } else {
        PG8_STAGE(PG8_SB(0, 0), cB, voffB); PG8_STAGE(PG8_SA(0, 0), cA, voffA); PG8_STAGE(PG8_SB(0, 1), cB + hstep, voffB); PG8_STAGE(PG8_SA(0, 1), cA + hstep, voffA);
        if (wr == 1) PG8_BAR;
        PG8_WAIT_V(4); PG8_BAR;
        PG8_STAGE(PG8_SB(1, 0), cB + kstep, voffB); PG8_STAGE(PG8_SA(1, 0), cA + kstep, voffA); PG8_STAGE(PG8_SB(1, 1), cB + hstep + kstep, voffB);
        PG8_WAIT_V(6); PG8_BAR;
    }
    for (;;) {
        const bool has_next = S.next(ui + 1, nxt);
        const char* nA = has_next ? (const char*)g.A + (size_t)nxt.pm * tstep + (size_t)nxt.k0 * 2 : cA; const char* nB = has_next ? (const char*)g.Bt + (size_t)nxt.pn * tstep + (size_t)nxt.k0 * 2 : cB;
        const int nt = cur.nt;
        for (int t = 0; t < nt; t += 2) {
            const bool last = (t == nt - 2);
            const char* a1 = cA + (size_t)(t + 1) * kstep;
            const char* a2 = last ? nA : cA + (size_t)(t + 2) * kstep; const char* b2 = last ? nB : cB + (size_t)(t + 2) * kstep;
            const char* a3 = a2 + kstep; const char* b3 = b2 + kstep;
            if (last && has_next) S.a_ready(nxt);
            if constexpr (SP2) {
            PG8_LDB(B0, 0, 0); PG8_LDB(B1, 0, 1); PG8_SCHED; PG8_LDA(At, 0, 0); PG8_STAGE(PG8_SA(1, 1), a1 + hstep, voffA);
            PG8_WAIT_V(8); PG8_WAIT_L(0); PG8_BAR; PG8_MMA(0, 0, At, B0); PG8_MMA(0, 1, At, B1); PG8_BAR; PG8_SCHED;
            PG8_LDA(At, 0, 1); PG8_STAGE(PG8_SB(0, 0), b2, voffB); PG8_STAGE(PG8_SB(0, 1), b2 + hstep, voffB); PG8_STAGE(PG8_SA(0, 0), a2, voffA);
            PG8_WAIT_V(8); PG8_WAIT_L(0); PG8_BAR; PG8_MMA(1, 0, At, B0); PG8_MMA(1, 1, At, B1); PG8_BAR; PG8_SCHED;
            PG8_LDB(B0, 1, 0); PG8_LDB(B1, 1, 1); PG8_SCHED; PG8_LDA(At, 1, 0); PG8_STAGE(PG8_SA(0, 1), a2 + hstep, voffA);
            PG8_WAIT_V(8); PG8_WAIT_L(0); PG8_BAR; PG8_MMA(0, 0, At, B0); PG8_MMA(0, 1, At, B1); PG8_BAR; PG8_SCHED;
            PG8_LDA(At, 1, 1); PG8_STAGE(PG8_SB(1, 0), b3, voffB); PG8_STAGE(PG8_SB(1, 1), b3 + hstep, voffB); PG8_STAGE(PG8_SA(1, 0), a3, voffA);
            PG8_WAIT_V(8); PG8_WAIT_L(0); PG8_BAR; PG8_MMA(1, 0, At, B0); PG8_MMA(1, 1, At, B1); PG8_BAR; PG8_SCHED;
            } else {
            PG8_LDB(B0, 0, 0); PG8_SCHED; PG8_LDA(At, 0, 0); PG8_STAGE(PG8_SA(1, 1), a1 + hstep, voffA);
            PG8_WAIT_L(8); PG8_BAR; PG8_WAIT_L(0); PG8_MMA(0, 0, At, B0); PG8_BAR; PG8_SCHED;
            PG8_LDB(B1, 0, 1); PG8_STAGE(PG8_SB(0, 0), b2, voffB);
            PG8_BAR; PG8_WAIT_L(0); PG8_MMA(0, 1, At, B1); PG8_BAR;
            PG8_LDA(At, 0, 1); PG8_STAGE(PG8_SA(0, 0), a2, voffA);
            PG8_BAR; PG8_WAIT_L(0); PG8_MMA(1, 0, At, B0); PG8_BAR; PG8_SCHED;
            PG8_STAGE(PG8_SB(0, 1), b2 + hstep, voffB);
            PG8_WAIT_V(6); PG8_BAR; PG8_MMA(1, 1, At, B1); PG8_BAR;
            PG8_LDB(B0, 1, 0); PG8_SCHED; PG8_LDA(At, 1, 0); PG8_STAGE(PG8_SA(0, 1), a2 + hstep, voffA);
            PG8_WAIT_L(8); PG8_BAR; PG8_WAIT_L(0); PG8_MMA(0, 0, At, B0); PG8_BAR; PG8_SCHED;
            PG8_LDB(B1, 1, 1); PG8_STAGE(PG8_SB(1, 0), b3, voffB);
            PG8_BAR; PG8_WAIT_L(0); PG8_MMA(0, 1, At, B1); PG8_BAR;
            PG8_LDA(At, 1, 1); PG8_STAGE(PG8_SA(1, 0), a3, voffA);
            PG8_BAR; PG8_WAIT_L(0); PG8_MMA(1, 0, At, B0); PG8_BAR; PG8_SCHED;
            PG8_STAGE(PG8_SB(1, 1), b3 + hstep, voffB);
            PG8_WAIT_V(6); PG8_BAR; PG8_MMA(1, 1, At, B1); PG8_BAR;
            }
        }
        if constexpr (ALIGN_EPI) { if (wr == 0) PG8_BAR; }
        if constexpr (!Epi::AFTER_DRAIN) { E(acc, cur, wr, wc, fr, fq); S.done(cur); }
        if (!has_next) break;
#pragma unroll
        for (int a = 0; a < 2; ++a)
#pragma unroll
            for (int b = 0; b < 2; ++b)
#pragma unroll
                for (int m = 0; m < 4; ++m)
#pragma unroll
                    for (int n = 0; n < 2; ++n) acc[a][b][m][n] = (f32x4){0.f, 0.f, 0.f, 0.f};
        cur = nxt; cA = nA; cB = nB; ++ui;
        if constexpr (ALIGN_EPI) { if (wr == 1) PG8_BAR; }
    }
    PG8_WAIT_V(0);
    if constexpr (!ALIGN_EPI) { if (wr == 0) PG8_BAR; }
    PG8_BAR;
    if constexpr (Epi::AFTER_DRAIN) { E.fused(acc, cur, wr, wc, fr, fq, lds, wid, lane); S.done(cur); }
#undef PG8_SA
#undef PG8_SB
#undef PG8_STAGE
#undef PG8_LDA
#undef PG8_LDB
#undef PG8_MMA
#undef PG8_WAIT_V
#undef PG8_WAIT_L
#undef PG8_BAR
#undef PG8_SCHED
}
}
#define GAS __attribute__((address_space(1)))
#define LAS __attribute__((address_space(3)))
typedef unsigned short bf16;
typedef unsigned v4u __attribute__((ext_vector_type(4)));
typedef float f32x4 __attribute__((ext_vector_type(4)));
typedef short bf16x8 __attribute__((ext_vector_type(8)));
typedef GAS unsigned gu32;
typedef GAS unsigned long long gu64;
#define RLX_AGENT __ATOMIC_RELAXED, __HIP_MEMORY_SCOPE_AGENT
#define LDS_WAIT() asm volatile("s_waitcnt lgkmcnt(0)" ::: "memory")
#define VM_WAIT() asm volatile("s_waitcnt vmcnt(0)" ::: "memory")
__device__ __forceinline__ unsigned long long rt() { return __builtin_amdgcn_s_memrealtime(); }
__device__ __forceinline__ unsigned f2bf(float f) { unsigned u = __builtin_bit_cast(unsigned, f); return (u + 0x7fffu + ((u >> 16) & 1u)) >> 16; }
__device__ __forceinline__ unsigned pk2(float lo, float hi) { return f2bf(lo) | (f2bf(hi) << 16); }

#define XB_TMO      128
#define XB_XCNT(j)  (256  + 64 * (j))
#define XB_XSUB(j)  (1280 + 64 * (j))
#define XB_XGEN(j)  (2304 + 64 * (j))
#define XB_TOP      3328
#define XB_TOPGEN   3392
#define XCD_BAR_WORDS 3456
#define XB_SPIN_CAP (1u << 18)

__device__ __forceinline__ unsigned xb_ld(unsigned* p)              { return __hip_atomic_load(p, __ATOMIC_RELAXED, __HIP_MEMORY_SCOPE_AGENT); }
__device__ __forceinline__ unsigned xb_add(unsigned* p, unsigned v) { return __hip_atomic_fetch_add(p, v, __ATOMIC_RELAXED, __HIP_MEMORY_SCOPE_AGENT); }
__device__ __forceinline__ unsigned xb_xcc_id() { return (unsigned)__builtin_amdgcn_s_getreg((3 << 11) | 20) & 0xFu; }
#define XB_SPIN(cond, bar) do { unsigned _sp = 0; while (cond) { __builtin_amdgcn_s_sleep(1); \
    if ((++_sp & 255u) == 0u) { if (xb_ld(&(bar)[XB_TMO])) break; if (_sp > XB_SPIN_CAP) { atomicAdd(&(bar)[XB_TMO], 1u); break; } } } } while (0)

struct XcdBarrier {
    unsigned* bar; unsigned x;
    volatile LAS unsigned* st;
};

__device__ __forceinline__ XcdBarrier xcd_barrier_post(unsigned* bar, volatile LAS unsigned* st) {
    XcdBarrier b; b.bar = bar; b.x = xb_xcc_id(); b.st = st;
    if (threadIdx.x == 0) (void)xb_add(&bar[XB_XCNT(b.x)], 1u);
    return b;
}
__device__ __forceinline__ void xcd_barrier_complete(unsigned* bar, unsigned x, unsigned& nloc, unsigned& nx) {
    const unsigned G = gridDim.x * gridDim.y * gridDim.z;
    unsigned sum, cnt, mine, sp = 0u;
    for (;;) {
        sum = 0u; cnt = 0u; mine = 0u;
#pragma unroll
        for (unsigned j = 0; j < 16; ++j) { const unsigned c = xb_ld(&bar[XB_XCNT(j)]); sum += c; cnt += (c > 0u) ? 1u : 0u; mine = (j == x) ? c : mine; }
        if (sum == G) break;
        __builtin_amdgcn_s_sleep(1);
        if ((++sp & 255u) == 0u) { if (xb_ld(&bar[XB_TMO])) break; if (sp > XB_SPIN_CAP) { atomicAdd(&bar[XB_TMO], 1u); break; } }
    }
    nloc = mine > 0u ? mine : 1u; nx = cnt > 0u ? cnt : 1u;
}

__device__ __forceinline__ void xcd_barrier(const XcdBarrier& b) {
    asm volatile("s_waitcnt vmcnt(0)" ::: "memory");
    __syncthreads();
    if (threadIdx.x == 0) {
        unsigned* bar = b.bar;
        __builtin_amdgcn_s_waitcnt(0);
        unsigned nloc = b.st[0], nx = b.st[1];
        if (nloc == 0u) { xcd_barrier_complete(bar, b.x, nloc, nx); b.st[0] = nloc; b.st[1] = nx; }
        const unsigned old = xb_add(&bar[XB_XSUB(b.x)], 1u);
        const unsigned gen = old / nloc;
        if (old + 1u == (gen + 1u) * nloc) {
            __builtin_amdgcn_fence(__ATOMIC_RELEASE, "agent");
            asm volatile("s_waitcnt vmcnt(0)" ::: "memory");
            const unsigned og = xb_add(&bar[XB_TOP], 1u);
            const unsigned tg = og / nx;
            if (og + 1u == (tg + 1u) * nx) xb_add(&bar[XB_TOPGEN], 1u);
            else XB_SPIN(xb_ld(&bar[XB_TOPGEN]) == tg, bar);
            __builtin_amdgcn_fence(__ATOMIC_ACQUIRE, "agent");
            xb_add(&bar[XB_XGEN(b.x)], 1u);
            asm volatile("s_waitcnt vmcnt(0)" ::: "memory");
        } else {
            XB_SPIN(xb_ld(&bar[XB_XGEN(b.x)]) == gen, bar);
            __builtin_amdgcn_fence(__ATOMIC_ACQUIRE, "agent");
            asm volatile("s_waitcnt vmcnt(0)" ::: "memory");
        }
    }
    __syncthreads();
}
constexpr int NWAVES = 8, NTHREADS = 512;
constexpr int DM = 1024, SEQ = 8192, NPROMPT = 2, NSAMP = 128, TSAMP = 8, NMETA = 16;
constexpr int ROW_S = NPROMPT * SEQ;
constexpr int ROW_M = ROW_S + NSAMP * TSAMP;
constexpr int NROWS = ROW_M + NMETA;
constexpr int MP = 17664;
constexpr int DINNER = 2048, NHEADS = 32, HD = 64, NGROUPS = 8, DSTATE = 128, CONVD = 4096, INPROJ = 6176, INPROJ_P = 6400, ZXW = 6144;
constexpr int DFF = 4096, NKV = 4, NQ = 16, KVW = 512;
constexpr float EPS = 1e-5f;
constexpr int LDX = 136;

constexpr size_t O_YP = 0, O_YS = O_YP + (size_t)NPROMPT * SEQ * DM, O_PCONV = O_YS + (size_t)NSAMP * TSAMP * DM, O_PSSM = O_PCONV + 2 * 2 * 3 * 4096,
    O_PCK = O_PSSM + (size_t)2 * 2 * 32 * 64 * 128, O_PCV = O_PCK + 2 * 128 * 256, O_SCONV = O_PCV + 2 * 128 * 256, O_SSSM = O_SCONV + (size_t)2 * 128 * 3 * 4096,
    O_SCK = O_SSSM + (size_t)2 * 128 * 32 * 64 * 128, O_SCV = O_SCK + (size_t)128 * 128 * 256, O_END = O_SCV + (size_t)128 * 128 * 256;

constexpr size_t MiB = 1u << 20;
constexpr size_t WS_CTL = 0, CTL_ZERO_BYTES = 1 * MiB;
constexpr size_t SZ_WIN = (size_t)INPROJ_P * 1024 * 2, SZ_WOUT = (size_t)1024 * 2048 * 2, SZ_WUP = (size_t)4096 * 1024 * 2, SZ_WDN = SZ_WUP, SZ_WQKV0 = (size_t)1536 * 1024 * 2, SZ_WQ1 = (size_t)1024 * 1024 * 2, SZ_WO = SZ_WQ1;
constexpr size_t WS_WIN = 1 * MiB, WS_WOUT = WS_WIN + 2 * SZ_WIN, WS_WUP = WS_WOUT + 2 * SZ_WOUT, WS_WDN = WS_WUP + 4 * SZ_WUP, WS_WQKV0 = WS_WDN + 4 * SZ_WDN, WS_WQ1 = WS_WQKV0 + SZ_WQKV0, WS_WO = WS_WQ1 + SZ_WQ1, WS_WEND = WS_WO + 2 * SZ_WO;
constexpr size_t al1m(size_t x) { return (x + MiB - 1) / MiB * MiB; }
constexpr size_t WS_H = al1m(WS_WEND), WS_HN = al1m(WS_H + (size_t)MP * 1024 * 4), WS_ZX = al1m(WS_HN + (size_t)MP * 1024 * 2), WS_DT = al1m(WS_ZX + (size_t)MP * ZXW * 2),
    WS_XC = al1m(WS_DT + (size_t)MP * 32 * 4), WS_YN = al1m(WS_XC + (size_t)MP * 4096 * 2), WS_CS = al1m(WS_YN + (size_t)MP * 2048 * 2), WS_CD = al1m(WS_CS + (size_t)129 * 32 * 8192 * 4), WS_SLAB = al1m(WS_CD + 129 * 32 * 4), WS_HSB = al1m(WS_SLAB + (size_t)8 * 1280 * 1024 * 4), WS_END = al1m(WS_HSB + (size_t)128 * 32 * 8192 * 2);
constexpr size_t WS_U = WS_ZX;
constexpr size_t WS_Q = WS_XC, WS_KV = WS_Q + (size_t)MP * 1024 * 2, WS_AO = WS_KV + (size_t)MP * 512 * 2;
static_assert(WS_AO + (size_t)MP * 1024 * 2 <= WS_YN, "attention overlay");
constexpr int CW_BAR = 4096;

constexpr int RING_BYTES = 131072, LDS_BYTES = 147456, LDSCTL_OFF = LDS_BYTES - 512, MISC_OFF = LDSCTL_OFF + 320;

typedef unsigned u32x2 __attribute__((ext_vector_type(2)));
typedef unsigned u32x4 __attribute__((ext_vector_type(4)));
__device__ __forceinline__ int ltid() { int t = threadIdx.x; asm volatile("" : "+v"(t)); return t; }
__device__ __forceinline__ float bf2f(unsigned short b) { return __uint_as_float((unsigned)b << 16); }
__device__ __forceinline__ float bflo(unsigned w) { return __uint_as_float(w << 16); }
__device__ __forceinline__ float bfhi(unsigned w) { return __uint_as_float(w & 0xffff0000u); }
__device__ __forceinline__ unsigned pkbf(float lo, float hi) { return pg8::cvt_pk_bf16(lo, hi); }
__device__ __forceinline__ float wave_sum(float v) {
#pragma unroll
    for (int o = 1; o < 64; o <<= 1) v += __shfl_xor(v, o);
    return v;
}
__device__ __forceinline__ float frcp(float x) { return __builtin_amdgcn_rcpf(x); }
__device__ __forceinline__ float sigmoid_f(float x) { return frcp(1.f + __expf(-x)); }
#define MFMA16(b, a, c) __builtin_amdgcn_mfma_f32_16x16x32_bf16((b), (a), (c), 0, 0, 0)

struct Args {
    const float* in[26]; float* out; unsigned char* ws; int ph_lo, ph_hi;
};
typedef const __attribute__((address_space(4))) Args* ArgsP;
enum { I_XP = 0, I_XS, I_SCONV, I_SSSM, I_CK, I_CV, I_META, I_ANORM, I_AIN, I_ACONVW, I_ACONVB, I_ADTB, I_ALOG, I_ADSKIP, I_AGATE, I_AOUT, I_KVNORM, I_WKV, I_BNORM, I_WQ, I_SINKS, I_WO, I_MLPNORM, I_WUP, I_WDOWN, I_FNORM };

__device__ __forceinline__ void transpose_item(const float* W, const float* scale, int K, int N, bf16* WT, int row_off, LAS unsigned* scr, int item, int lane) {
    const int nblk = (N + 63) / 64, kb = item / nblk, nb = item % nblk, k0 = 64 * kb, n0 = 64 * nb;
    const bool ok = (n0 + lane < N);
    const float* src = W + (size_t)k0 * N + n0 + (ok ? lane : 0);
    float v[64];
#pragma unroll
    for (int i = 0; i < 64; ++i) v[i] = __builtin_nontemporal_load(src + (size_t)i * N);
    if (!ok) {
#pragma unroll
        for (int i = 0; i < 64; ++i) v[i] = 0.f;
    }
    if (scale) {
#pragma unroll
        for (int i = 0; i < 64; ++i) v[i] *= scale[k0 + i];
    }
#pragma unroll
    for (int i = 0; i < 32; ++i) scr[lane * 33 + i] = pkbf(v[2 * i], v[2 * i + 1]);
    LDS_WAIT(); asm volatile("" ::: "memory");
    const int c = lane & 7;
#pragma unroll
    for (int j = 0; j < 8; ++j) { const int n = (lane >> 3) + 8 * j; const LAS unsigned* sp = scr + n * 33 + 4 * c;
        v4u o; o.x = sp[0]; o.y = sp[1]; o.z = sp[2]; o.w = sp[3];
        if (n0 + n < N) *(GAS v4u*)(WT + (size_t)(row_off + n0 + n) * K + k0 + 8 * c) = o; }
    LDS_WAIT(); asm volatile("" ::: "memory");
}
struct WJob { const float* W; const float* scale; int K, N; bf16* WT; int row_off; int items; };

__device__ __forceinline__ void phase_prologue(ArgsP a, LAS unsigned char* lds, int wave, int lane) {
    LAS unsigned* scr = (LAS unsigned*)(lds + wave * 16384);
    const int gw = blockIdx.x * NWAVES + wave, NGW = gridDim.x * NWAVES;
    unsigned char* ws = a->ws;
    for (int jb = 0; jb < 21; ++jb) {
        WJob J;
        if (jb < 2)       { const int i = jb;      J = WJob{a->in[I_AIN] + (size_t)i * 1024 * INPROJ, a->in[I_ANORM] + i * 1024, 1024, INPROJ, (bf16*)(ws + WS_WIN + i * SZ_WIN), 0, 0}; }
        else if (jb < 4)  { const int i = jb - 2;  J = WJob{a->in[I_AOUT] + (size_t)i * 2048 * 1024, a->in[I_AGATE] + i * 2048, 2048, 1024, (bf16*)(ws + WS_WOUT + i * SZ_WOUT), 0, 0}; }
        else if (jb < 8)  { const int l = jb - 4;  J = WJob{a->in[I_WUP] + (size_t)l * 1024 * 4096, a->in[I_MLPNORM] + l * 1024, 1024, 4096, (bf16*)(ws + WS_WUP + l * SZ_WUP), 0, 0}; }
        else if (jb < 12) { const int l = jb - 8;  J = WJob{a->in[I_WDOWN] + (size_t)l * 4096 * 1024, nullptr, 4096, 1024, (bf16*)(ws + WS_WDN + l * SZ_WDN), 0, 0}; }
        else if (jb == 12) { J = WJob{a->in[I_WQ], a->in[I_BNORM], 1024, 1024, (bf16*)(ws + WS_WQKV0), 0, 0}; }
        else if (jb == 13) { J = WJob{a->in[I_WKV], a->in[I_KVNORM], 1024, 512, (bf16*)(ws + WS_WQKV0), 1024, 0}; }
        else if (jb == 14) { J = WJob{a->in[I_WQ] + (size_t)1024 * 1024, a->in[I_BNORM] + 1024, 1024, 1024, (bf16*)(ws + WS_WQ1), 0, 0}; }
        else if (jb < 17) { const int j = jb - 15; J = WJob{a->in[I_WO] + (size_t)j * 1024 * 1024, nullptr, 1024, 1024, (bf16*)(ws + WS_WO + j * SZ_WO), 0, 0}; }
        else break;
        const int items = (J.K / 64) * ((J.N + 63) / 64);
        for (int it = gw; it < items; it += NGW) transpose_item(J.W, J.scale, J.K, J.N, J.WT, J.row_off, scr, it, lane);
    }
    {
        const int gt = blockIdx.x * NTHREADS + ltid(), NT = gridDim.x * NTHREADS;
        const int per = (INPROJ_P - INPROJ) * 1024 * 2 / 16;
        for (int e = gt; e < 2 * per; e += NT) { const int i = e / per, c = e % per;
            *(v4u*)(ws + WS_WIN + i * SZ_WIN + (size_t)INPROJ * 1024 * 2 + (size_t)c * 16) = (v4u){0u, 0u, 0u, 0u}; }
    }
}

__device__ __forceinline__ void norm_store(bf16* __restrict__ HN, int m, int lane, const f32x4 (&v)[4]) {
    float s = 0.f;
#pragma unroll
    for (int j = 0; j < 4; ++j) s += (v[j].x * v[j].x + v[j].y * v[j].y) + (v[j].z * v[j].z + v[j].w * v[j].w);
    const float rs = rsqrtf(wave_sum(s) * (1.f / DM) + EPS);
    unsigned long long* o8 = (unsigned long long*)(HN + (size_t)m * DM) + lane;
#pragma unroll
    for (int j = 0; j < 4; ++j) o8[64 * j] = (unsigned long long)pkbf(v[j].x * rs, v[j].y * rs) | ((unsigned long long)pkbf(v[j].z * rs, v[j].w * rs) << 32);
}
__device__ __forceinline__ void phase_norm(ArgsP a, int from_inputs, int nslab, int wave, int lane) {
    float* __restrict__ H = (float*)(a->ws + WS_H); bf16* __restrict__ HN = (bf16*)(a->ws + WS_HN); const float* __restrict__ SLAB = (const float*)(a->ws + WS_SLAB);
    const int gw = blockIdx.x * NWAVES + wave, NGW = gridDim.x * NWAVES;
    for (int m = ROW_S + gw; m < MP; m += NGW) {
        if (m >= NROWS) { unsigned long long* o8 = (unsigned long long*)(HN + (size_t)m * DM) + lane;
#pragma unroll
            for (int j = 0; j < 4; ++j) o8[64 * j] = 0ull;
            continue; }
        const float* src = from_inputs ? ((m < ROW_M) ? a->in[I_XS] + (size_t)(m - ROW_S) * DM : a->in[I_META] + (size_t)(m - ROW_M) * DM) : H + (size_t)m * DM;
        f32x4 v[4], sv[8][4];
#pragma unroll
        for (int j = 0; j < 4; ++j) v[j] = ((const f32x4*)src + lane)[64 * j];
#pragma unroll
        for (int sl = 0; sl < 8; ++sl)
#pragma unroll
            for (int j = 0; j < 4; ++j) { sv[sl][j] = (f32x4){0.f, 0.f, 0.f, 0.f}; if (sl < nslab) sv[sl][j] = __builtin_nontemporal_load((const f32x4*)(SLAB + (size_t)sl * (1280 * 1024) + (size_t)(m - ROW_S) * DM) + lane + 64 * j); }
#pragma unroll
        for (int sl = 0; sl < 8; ++sl)
#pragma unroll
            for (int j = 0; j < 4; ++j) v[j] = v[j] + sv[sl][j];
        if (nslab > 0 || from_inputs) { f32x4* hr = (f32x4*)(H + (size_t)m * DM) + lane;
#pragma unroll
            for (int j = 0; j < 4; ++j) hr[64 * j] = v[j]; }
        norm_store(HN, m, lane, v);
    }
    const float* __restrict__ P = from_inputs ? a->in[I_XP] : (const float*)H;
    for (int m0 = 2 * gw; m0 < ROW_S; m0 += 2 * NGW) {
        f32x4 v[2][4];
#pragma unroll
        for (int q = 0; q < 2; ++q)
#pragma unroll
            for (int j = 0; j < 4; ++j) v[q][j] = ((const f32x4*)(P + (size_t)(m0 + q) * DM) + lane)[64 * j];
#pragma unroll
        for (int q = 0; q < 2; ++q) norm_store(HN, m0 + q, lane, v[q]);
    }
}
__device__ __forceinline__ void phase_final(ArgsP a, int wave, int lane) {
    const float* H = (const float*)(a->ws + WS_H); const float* fw = a->in[I_FNORM]; const float* SLAB = (const float*)(a->ws + WS_SLAB);
    const int gw = blockIdx.x * NWAVES + wave, NGW = gridDim.x * NWAVES;
    f32x4 w[4];
#pragma unroll
    for (int j = 0; j < 4; ++j) w[j] = ((const f32x4*)fw)[lane + 64 * j];
    for (int m = gw; m < ROW_M; m += NGW) {
        const f32x4* xr = (const f32x4*)(H + (size_t)m * DM) + lane;
        f32x4 v[4]; float s = 0.f;
#pragma unroll
        for (int j = 0; j < 4; ++j) v[j] = __builtin_nontemporal_load(xr + 64 * j);
        if (m >= ROW_S) {
            for (int sl = 0; sl < 8; ++sl) { const f32x4* sr = (const f32x4*)(SLAB + (size_t)sl * (1280 * 1024) + (size_t)(m - ROW_S) * DM) + lane;
#pragma unroll
                for (int j = 0; j < 4; ++j) v[j] = v[j] + sr[64 * j]; }
        }
#pragma unroll
        for (int j = 0; j < 4; ++j) s += (v[j].x * v[j].x + v[j].y * v[j].y) + (v[j].z * v[j].z + v[j].w * v[j].w);
        const float rs = rsqrtf(wave_sum(s) * (1.f / DM) + EPS);
        f32x4* o = (f32x4*)(a->out + O_YP + (size_t)m * DM) + lane;
#pragma unroll
        for (int j = 0; j < 4; ++j) __builtin_nontemporal_store(v[j] * rs * w[j], o + 64 * j);
    }
}

__device__ __forceinline__ void unpack8(const u32x4 w, float (&f)[8]) { f[0] = bflo(w.x); f[1] = bfhi(w.x); f[2] = bflo(w.y); f[3] = bfhi(w.y); f[4] = bflo(w.z); f[5] = bfhi(w.z); f[6] = bflo(w.w); f[7] = bfhi(w.w); }
__device__ __forceinline__ void ld8f(const float* __restrict__ p, float (&f)[8]) { const f32x4 x0 = *(const f32x4*)p, x1 = *(const f32x4*)(p + 4); f[0]=x0.x;f[1]=x0.y;f[2]=x0.z;f[3]=x0.w;f[4]=x1.x;f[5]=x1.y;f[6]=x1.z;f[7]=x1.w; }
#define TSW(ch) ((((ch) >> 3) & 7) << 3)
struct ConvW { float w0[8], w1[8], w2[8], w3[8], bs[8]; };
__device__ __forceinline__ void conv_load_w(const float* __restrict__ cw, const float* __restrict__ cb, int c0, ConvW& W) { ld8f(cw + c0, W.w0); ld8f(cw + CONVD + c0, W.w1); ld8f(cw + 2 * CONVD + c0, W.w2); ld8f(cw + 3 * CONVD + c0, W.w3); ld8f(cb + c0, W.bs); }
__device__ __forceinline__ void conv_load_run(const bf16* __restrict__ ZX, int Rrow, int c0, int pk, bool valid, u32x4 (&raw)[11]) {
#pragma unroll
    for (int t = 0; t < 8; ++t) { raw[3 + t] = (u32x4){0u, 0u, 0u, 0u}; if (valid) raw[3 + t] = *(const u32x4*)(ZX + (size_t)(Rrow + t) * ZXW + 2048 + c0); }
#pragma unroll
    for (int t = 0; t < 3; ++t) { const int rr = (pk == 1) ? ROW_M + 13 + t : Rrow - 3 + t; raw[t] = (u32x4){0u, 0u, 0u, 0u}; if (valid && pk != 2) raw[t] = *(const u32x4*)(ZX + (size_t)rr * ZXW + 2048 + c0); }
}
template <int J> __device__ __forceinline__ void conv_channel(const u32x4 (&raw)[11], const ConvW& W, float (&o)[8]) {
    float x[11];
#pragma unroll
    for (int i = 0; i < 11; ++i) { const unsigned w = raw[i][J >> 1]; x[i] = (J & 1) ? bfhi(w) : bflo(w); }
#pragma unroll
    for (int t = 0; t < 8; ++t) { const float v = W.bs[J] + W.w0[J] * x[t] + W.w1[J] * x[t + 1] + W.w2[J] * x[t + 2] + W.w3[J] * x[t + 3]; o[t] = v * sigmoid_f(v); }
}
template <int J> __device__ __forceinline__ void conv_store_t(const u32x4 (&raw)[11], const ConvW& W, const float (&scale)[8], bf16* T, int ch0, int run) {
    float o[8]; conv_channel<J>(raw, W, o);
    u32x4 w; w.x = pkbf(o[0] * scale[0], o[1] * scale[1]); w.y = pkbf(o[2] * scale[2], o[3] * scale[3]); w.z = pkbf(o[4] * scale[4], o[5] * scale[5]); w.w = pkbf(o[6] * scale[6], o[7] * scale[7]);
    *(u32x4*)(T + (ch0 + J) * LDX + ((8 * run) ^ TSW(ch0 + J))) = w;
}
__device__ __forceinline__ void conv_item_t(const u32x4 (&raw)[11], const ConvW& W, const float (&scale)[8], bf16* T, int ch0, int run) {
    conv_store_t<0>(raw, W, scale, T, ch0, run); conv_store_t<1>(raw, W, scale, T, ch0, run); conv_store_t<2>(raw, W, scale, T, ch0, run); conv_store_t<3>(raw, W, scale, T, ch0, run);
    conv_store_t<4>(raw, W, scale, T, ch0, run); conv_store_t<5>(raw, W, scale, T, ch0, run); conv_store_t<6>(raw, W, scale, T, ch0, run); conv_store_t<7>(raw, W, scale, T, ch0, run);
}
__device__ __forceinline__ void conv_item_n(const u32x4 (&raw)[11], const ConvW& W, bf16* N, int run, int colel) {
    float p0[8], p1[8], p2[8]; unpack8(raw[0], p0); unpack8(raw[1], p1); unpack8(raw[2], p2);
#pragma unroll
    for (int t = 0; t < 8; ++t) { float x[8]; unpack8(raw[3 + t], x); float o[8];
#pragma unroll
        for (int j = 0; j < 8; ++j) { const float v = W.bs[j] + W.w0[j] * p0[j] + W.w1[j] * p1[j] + W.w2[j] * p2[j] + W.w3[j] * x[j]; o[j] = v * sigmoid_f(v); }
        u32x4 w; w.x = pkbf(o[0], o[1]); w.y = pkbf(o[2], o[3]); w.z = pkbf(o[4], o[5]); w.w = pkbf(o[6], o[7]);
        *(u32x4*)(N + (8 * run + t) * LDX + colel) = w;
#pragma unroll
        for (int j = 0; j < 8; ++j) { p0[j] = p1[j]; p1[j] = p2[j]; p2[j] = x[j]; } }
}
__device__ __forceinline__ void conv_state_out(const u32x4 (&raw)[11], float* __restrict__ dst  ) {
#pragma unroll
    for (int k = 0; k < 3; ++k) { float x[8]; unpack8(raw[8 + k], x); *(f32x4*)(dst + (size_t)k * CONVD) = (f32x4){x[0], x[1], x[2], x[3]}; *(f32x4*)(dst + (size_t)k * CONVD + 4) = (f32x4){x[4], x[5], x[6], x[7]}; }
}

__device__ __forceinline__ void ssd_acs(const float* DT, const float* alog, int R0, int len, int h0, float* s_dt, float* s_acs, int wave, int lane) {
    if (wave < 4) {
        const int r = wave; const float An = -__expf(alog[h0 + r]);
        const int l0 = 2 * lane;
        const float d0 = (l0 < len) ? DT[(size_t)(R0 + l0) * 32 + h0 + r] : 0.f;
        const float d1 = (l0 + 1 < len) ? DT[(size_t)(R0 + l0 + 1) * 32 + h0 + r] : 0.f;
        const float a0 = d0 * An, a1 = d1 * An, s = a0 + a1;
        float incl = s;
#pragma unroll
        for (int o = 1; o < 64; o <<= 1) { const float t = __shfl_up(incl, o); if (lane >= o) incl += t; }
        const float excl = incl - s;
        s_dt[r * 128 + l0] = d0; s_dt[r * 128 + l0 + 1] = d1;
        s_acs[r * 128 + l0] = excl + a0; s_acs[r * 128 + l0 + 1] = excl + s;
    }
}
#define LFRAG(base, row, ld, ks) (*(const bf16x8*)((base) + (row) * (ld) + 32 * (ks) + 8 * fq))

__device__ __forceinline__ void ssd1_unit(ArgsP a, int li, unsigned char* lds, int slot, int g, int R0, int len, int, int, int) {
    const int tid = ltid(), lane = tid & 63, wave = __builtin_amdgcn_readfirstlane(tid >> 6);
    const float* __restrict__ DT = (const float*)(a->ws + WS_DT);
    bf16* __restrict__ CS = (bf16*)(a->ws + WS_CS); float* __restrict__ CD = (float*)(a->ws + WS_CD);
    bf16* XsT = (bf16*)lds;
    bf16* BT = (bf16*)(lds + 256 * LDX * 2);
    float* s_dt = (float*)(lds + 384 * LDX * 2); float* s_acs = s_dt + 512;
    const int fr = lane & 15, fq = lane >> 4, h0 = g * 4;
    const float* __restrict__ cw = a->in[I_ACONVW] + (size_t)li * 4 * CONVD; const float* __restrict__ cbias = a->in[I_ACONVB] + (size_t)li * CONVD;
    const bf16* __restrict__ ZX = (const bf16*)(a->ws + WS_ZX);
    const bool meta = (slot == 128), chunk0 = (!meta && (slot & 63) == 0);
    const int xcb = tid & 31, xrun = tid >> 5, xc0 = g * 256 + xcb * 8;
    const int bcb = tid & 15, brun = (tid >> 4) & 15, bc0 = 2048 + g * 128 + bcb * 8;
    u32x4 rx[11], rb[11];
    conv_load_run(ZX, R0 + 8 * xrun, xc0, (xrun == 0) ? (meta ? 2 : (chunk0 ? 1 : 0)) : 0, 8 * xrun < len, rx);
    if (tid < 256) conv_load_run(ZX, R0 + 8 * brun, bc0, (brun == 0) ? (meta ? 2 : (chunk0 ? 1 : 0)) : 0, 8 * brun < len, rb);
    ssd_acs(DT, a->in[I_ALOG] + li * NHEADS, R0, len, h0, s_dt, s_acs, wave, lane);
    if (tid < 256) { ConvW W; conv_load_w(cw, cbias, bc0, W); const float one[8] = {1.f, 1.f, 1.f, 1.f, 1.f, 1.f, 1.f, 1.f}; conv_item_t(rb, W, one, BT, bcb * 8, brun); }
    __syncthreads();
    {   ConvW W; conv_load_w(cw, cbias, xc0, W);
        const int r = xcb >> 3; const float tot = s_acs[r * 128 + 127];
        const f32x4 a0 = *(const f32x4*)(s_acs + r * 128 + 8 * xrun), a1 = *(const f32x4*)(s_acs + r * 128 + 8 * xrun + 4), d0 = *(const f32x4*)(s_dt + r * 128 + 8 * xrun), d1 = *(const f32x4*)(s_dt + r * 128 + 8 * xrun + 4);
        float wl[8];
#pragma unroll
        for (int t = 0; t < 4; ++t) { wl[t] = __expf(tot - a0[t]) * d0[t]; wl[4 + t] = __expf(tot - a1[t]) * d1[t]; }
        conv_item_t(rx, W, wl, XsT, xcb * 8, xrun);
    }
    __syncthreads();
    f32x4 acc[2][8];
#pragma unroll
    for (int mi = 0; mi < 2; ++mi)
#pragma unroll
        for (int ni = 0; ni < 8; ++ni) acc[mi][ni] = (f32x4){0.f, 0.f, 0.f, 0.f};
#pragma unroll
    for (int ks = 0; ks < 4; ++ks) {
        const int ra0 = 32 * wave + fr, ra1 = ra0 + 16;
        const bf16x8 a0 = *(const bf16x8*)(XsT + ra0 * LDX + ((32 * ks + 8 * fq) ^ TSW(ra0))), a1 = *(const bf16x8*)(XsT + ra1 * LDX + ((32 * ks + 8 * fq) ^ TSW(ra1)));
#pragma unroll
        for (int ni = 0; ni < 8; ++ni) { const int rb = 16 * ni + fr; const bf16x8 bb = *(const bf16x8*)(BT + rb * LDX + ((32 * ks + 8 * fq) ^ TSW(rb)));
            acc[0][ni] = MFMA16(bb, a0, acc[0][ni]); acc[1][ni] = MFMA16(bb, a1, acc[1][ni]); }
    }
#pragma unroll
    for (int mi = 0; mi < 2; ++mi) { const int hp = 32 * wave + 16 * mi + fr, r = hp >> 6, p = hp & 63;
        bf16* dst = CS + ((size_t)(slot * 32 + h0 + r) * 64 + p) * 128 + 4 * fq;
#pragma unroll
        for (int ni = 0; ni < 8; ++ni) { u32x2 w; w.x = pkbf(acc[mi][ni][0], acc[mi][ni][1]); w.y = pkbf(acc[mi][ni][2], acc[mi][ni][3]); *(u32x2*)(dst + 16 * ni) = w; } }
    if (tid < 4) CD[slot * 32 + h0 + tid] = __expf(s_acs[tid * 128 + 127]);
    __syncthreads();
}

__device__ __forceinline__ void ssd_sample_issue(ArgsP a, int li, int b, int g, f32x4 (&st)[4][4]) {
    const int tid = ltid(), p = tid >> 3, nb = tid & 7;
    const float* __restrict__ sin_ = a->in[I_SSSM] + ((size_t)((li * NSAMP + b) * NHEADS + g * 4) * 64 + p) * 128 + 4 * nb;
#pragma unroll
    for (int r = 0; r < 4; ++r)
#pragma unroll
        for (int kk = 0; kk < 4; ++kk) st[r][kk] = __builtin_nontemporal_load((const f32x4*)(sin_ + (size_t)r * 8192 + 32 * kk));
}
__device__ __forceinline__ void ssd_sample_unit(ArgsP a, int li, unsigned char* lds, int b, int g, f32x4 (&st)[4][4]) {
    const int tid = ltid(), lane = tid & 63, wave = __builtin_amdgcn_readfirstlane(tid >> 6);
    const bf16* __restrict__ ZX = (const bf16*)(a->ws + WS_ZX); const float* __restrict__ DT = (const float*)(a->ws + WS_DT); bf16* __restrict__ YN = (bf16*)(a->ws + WS_YN);
    float* sX = (float*)lds; float* sB = sX + 8 * 256; float* sC = sB + 8 * 128; float* sY = sC + 8 * 128; float* sDt = sY + 8 * 256;
    const int R0 = ROW_S + b * 8, h0 = g * 4;
    const int p = tid >> 3, nb = tid & 7;
    float* __restrict__ sout = a->out + O_SSSM + ((size_t)((li * NSAMP + b) * NHEADS + h0) * 64 + p) * 128 + 4 * nb;
    {
        const float* __restrict__ cw = a->in[I_ACONVW] + (size_t)li * 4 * CONVD; const float* __restrict__ cbias = a->in[I_ACONVB] + (size_t)li * CONVD;
        const int t = tid >> 6, ck = tid & 63;
        const int c0 = (ck < 32) ? g * 256 + ck * 8 : (ck < 48) ? 2048 + g * 128 + (ck - 32) * 8 : 3072 + g * 128 + (ck - 48) * 8;
        float* dst = (ck < 32) ? sX + t * 256 + ck * 8 : (ck < 48) ? sB + t * 128 + (ck - 32) * 8 : sC + t * 128 + (ck - 48) * 8;
        const float* __restrict__ sc = a->in[I_SCONV] + ((size_t)(li * NSAMP + b) * 3) * CONVD + c0;
        float xr[4][8];
#pragma unroll
        for (int k = 0; k < 4; ++k) { const int tt = t - 3 + k;
            if (tt >= 0) unpack8(*(const u32x4*)(ZX + (size_t)(R0 + tt) * ZXW + 2048 + c0), xr[k]); else ld8f(sc + (size_t)(tt + 3) * CONVD, xr[k]); }
        ConvW W; conv_load_w(cw, cbias, c0, W);
        float o[8];
#pragma unroll
        for (int j = 0; j < 8; ++j) { const float v = W.bs[j] + W.w0[j] * xr[0][j] + W.w1[j] * xr[1][j] + W.w2[j] * xr[2][j] + W.w3[j] * xr[3][j]; o[j] = v * sigmoid_f(v); }
        *(f32x4*)dst = (f32x4){o[0], o[1], o[2], o[3]}; *(f32x4*)(dst + 4) = (f32x4){o[4], o[5], o[6], o[7]};
        if (t >= 5) { float* __restrict__ so = a->out + O_SCONV + ((size_t)(li * NSAMP + b) * 3 + (t - 5)) * CONVD + c0;
            *(f32x4*)so = (f32x4){xr[3][0], xr[3][1], xr[3][2], xr[3][3]}; *(f32x4*)(so + 4) = (f32x4){xr[3][4], xr[3][5], xr[3][6], xr[3][7]}; }
    }
    if (tid < 32) sDt[tid] = DT[(size_t)(R0 + (tid >> 2)) * 32 + h0 + (tid & 3)];
    __syncthreads();
    float An[4], Dk[4];
#pragma unroll
    for (int r = 0; r < 4; ++r) { An[r] = -__expf(a->in[I_ALOG][li * NHEADS + h0 + r]); Dk[r] = a->in[I_ADSKIP][li * NHEADS + h0 + r]; }
    float part[8][4];
#pragma unroll
    for (int t = 0; t < 8; ++t) {
        f32x4 bv[4], cv[4];
#pragma unroll
        for (int kk = 0; kk < 4; ++kk) { bv[kk] = *(const f32x4*)(sB + t * 128 + 32 * kk + 4 * nb); cv[kk] = *(const f32x4*)(sC + t * 128 + 32 * kk + 4 * nb); }
#pragma unroll
        for (int r = 0; r < 4; ++r) {
            const float dt = sDt[t * 4 + r], dA = __expf(dt * An[r]), xv = sX[t * 256 + r * 64 + p], coef = dt * xv;
            float pr = 0.f;
#pragma unroll
            for (int kk = 0; kk < 4; ++kk) { st[r][kk] = st[r][kk] * dA + bv[kk] * coef; pr += (cv[kk].x * st[r][kk].x + cv[kk].y * st[r][kk].y) + (cv[kk].z * st[r][kk].z + cv[kk].w * st[r][kk].w); }
            part[t][r] = pr;
        }
    }
#pragma unroll
    for (int r = 0; r < 4; ++r)
#pragma unroll
        for (int kk = 0; kk < 4; ++kk) __builtin_nontemporal_store(st[r][kk], (f32x4*)(sout + (size_t)r * 8192 + 32 * kk));
#pragma unroll
    for (int t = 0; t < 8; ++t)
#pragma unroll
        for (int r = 0; r < 4; ++r) { float v = part[t][r]; v += __shfl_xor(v, 1); v += __shfl_xor(v, 2); v += __shfl_xor(v, 4); part[t][r] = v; }
    if (nb == 0) {
#pragma unroll
        for (int t = 0; t < 8; ++t)
#pragma unroll
            for (int r = 0; r < 4; ++r) sY[t * 256 + r * 64 + p] = part[t][r] + Dk[r] * sX[t * 256 + r * 64 + p];
    }
    __syncthreads();
    {
        const int t = wave, c4 = lane * 4; const size_t row = (size_t)(R0 + t);
        const f32x4 y = *(const f32x4*)(sY + t * 256 + c4);
        const u32x2 zz = *(const u32x2*)(ZX + row * ZXW + g * 256 + c4);
        const float z0 = bflo(zz.x), z1 = bfhi(zz.x), z2 = bflo(zz.y), z3 = bfhi(zz.y);
        const float g0 = y.x * z0 * sigmoid_f(z0), g1 = y.y * z1 * sigmoid_f(z1), g2 = y.z * z2 * sigmoid_f(z2), g3 = y.w * z3 * sigmoid_f(z3);
        const float ss = wave_sum((g0 * g0 + g1 * g1) + (g2 * g2 + g3 * g3));
        const float rs = rsqrtf(ss * (1.f / 256.f) + EPS);
        u32x2 o; o.x = pkbf(g0 * rs, g1 * rs); o.y = pkbf(g2 * rs, g3 * rs);
        *(u32x2*)(YN + row * DINNER + g * 256 + c4) = o;
    }
    __syncthreads();
}

__device__ __forceinline__ void phase_scan(ArgsP a, int li) {
    const bf16* __restrict__ CS = (const bf16*)(a->ws + WS_CS); const float* __restrict__ CD = (const float*)(a->ws + WS_CD); bf16* __restrict__ HSB = (bf16*)(a->ws + WS_HSB);
    const int gt = blockIdx.x * NTHREADS + ltid(), NT = gridDim.x * NTHREADS;
    for (int e = gt; e < 2 * 65536; e += NT) {
        const int b = e >> 16, rem = e & 65535, h = rem >> 11, pn4 = rem & 2047;
        f32x4 hc; { const u32x2 w0 = *(const u32x2*)(CS + ((size_t)(128 * 32 + h) * 2048 + pn4) * 4); hc = (f32x4){bflo(w0.x), bfhi(w0.x), bflo(w0.y), bfhi(w0.y)}; }
#pragma unroll 8
        for (int c = 0; c < 64; ++c) { const int slot = b * 64 + c; const size_t o = ((size_t)(slot * 32 + h) * 2048 + pn4) * 4;
            const u32x2 sw = __builtin_nontemporal_load((const u32x2*)(CS + o)); const f32x4 s = (f32x4){bflo(sw.x), bfhi(sw.x), bflo(sw.y), bfhi(sw.y)}; const float d = CD[slot * 32 + h];
            u32x2 w; w.x = pkbf(hc.x, hc.y); w.y = pkbf(hc.z, hc.w); *(u32x2*)(HSB + o) = w;
            hc = hc * d + s; }
        __builtin_nontemporal_store(hc, (f32x4*)(a->out + O_PSSM + ((size_t)((li * NPROMPT + b) * NHEADS + h) * 2048 + pn4) * 4));
    }
}

__device__ __forceinline__ void ssd3_head(int r, int hb, const bf16* Cn, const bf16* BH, const bf16* Xt, const float* s_dt, const float* s_acs, const f32x4 (&cb)[8], f32x4 (&acc)[4],
                                          const bf16* __restrict__ ZX, size_t row, int g, float Dk, int l, int wave, int fr, int fq, float& ss) {
    u32x2 zz[4];
#pragma unroll
    for (int ni = 0; ni < 4; ++ni) { const int ch = g * 256 + r * 64 + 16 * ni + 4 * fq; zz[ni] = __builtin_nontemporal_load((const u32x2*)(ZX + row * ZXW + ch)); }
    const float al = s_acs[r * 128 + l];
#pragma unroll
    for (int ni = 0; ni < 4; ++ni) acc[ni] = (f32x4){0.f, 0.f, 0.f, 0.f};
    const bf16* Hs = BH + hb * 64 * LDX;
#pragma unroll
    for (int ks = 0; ks < 4; ++ks) { const bf16x8 af = LFRAG(Cn, l, LDX, ks);
#pragma unroll
        for (int ni = 0; ni < 4; ++ni) { const bf16x8 bb = LFRAG(Hs, 16 * ni + fr, LDX, ks); acc[ni] = MFMA16(bb, af, acc[ni]); } }
    const float e = __expf(al);
#pragma unroll
    for (int ni = 0; ni < 4; ++ni) acc[ni] = acc[ni] * e;
#pragma unroll
    for (int ks = 0; ks < 4; ++ks) if (2 * ks <= wave) {
        unsigned mw[4];
#pragma unroll
        for (int hf = 0; hf < 2; ++hf) { const int ni = 2 * ks + hf, s0 = 16 * ni + 4 * fq;
            const f32x4 av = *(const f32x4*)(s_acs + r * 128 + s0), dv = *(const f32x4*)(s_dt + r * 128 + s0);
            float m[4];
#pragma unroll
            for (int j = 0; j < 4; ++j) m[j] = (s0 + j <= l) ? cb[ni][j] * __expf(al - av[j]) * dv[j] : 0.f;
            mw[2 * hf] = pkbf(m[0], m[1]); mw[2 * hf + 1] = pkbf(m[2], m[3]); }
        const u32x4 afu = (u32x4){mw[0], mw[1], mw[2], mw[3]};
        const bf16x8 af = __builtin_bit_cast(bf16x8, afu);
#pragma unroll
        for (int ni = 0; ni < 4; ++ni) { const int chl = r * 64 + 16 * ni + fr, sw = TSW(chl);
            const u32x2 b0 = *(const u32x2*)(Xt + chl * LDX + ((32 * ks + 4 * fq) ^ sw)), b1 = *(const u32x2*)(Xt + chl * LDX + ((32 * ks + 16 + 4 * fq) ^ sw));
            const u32x4 bu = (u32x4){b0.x, b0.y, b1.x, b1.y};
            acc[ni] = MFMA16(__builtin_bit_cast(bf16x8, bu), af, acc[ni]); }
    }
#pragma unroll
    for (int ni = 0; ni < 4; ++ni) {
        float xv[4];
#pragma unroll
        for (int j = 0; j < 4; ++j) { const int chl = r * 64 + 16 * ni + 4 * fq + j; xv[j] = bf2f(Xt[chl * LDX + (l ^ TSW(chl))]); }
        const float zv[4] = {bflo(zz[ni].x), bfhi(zz[ni].x), bflo(zz[ni].y), bfhi(zz[ni].y)};
#pragma unroll
        for (int j = 0; j < 4; ++j) { const float q = (acc[ni][j] + Dk * xv[j]) * zv[j] * sigmoid_f(zv[j]); acc[ni][j] = q; ss += q * q; } }
}
__device__ __forceinline__ void ssd3_unit(ArgsP a, int li, unsigned char* lds, const bf16* __restrict__ hs, int slot, int g, int R0, int len, int, int, int) {
    const int tid = ltid(), lane = tid & 63, wave = __builtin_amdgcn_readfirstlane(tid >> 6);
    const bf16* __restrict__ ZX = (const bf16*)(a->ws + WS_ZX); const float* __restrict__ DT = (const float*)(a->ws + WS_DT); bf16* __restrict__ YN = (bf16*)(a->ws + WS_YN);
    bf16* Cn = (bf16*)lds; bf16* BH = Cn + 128 * LDX; bf16* Xt = BH + 128 * LDX;
    float* s_dt = (float*)(Xt + 256 * LDX); float* s_acs = s_dt + 512;
    const int fr = lane & 15, fq = lane >> 4, h0 = g * 4;
    {
        const float* __restrict__ cw = a->in[I_ACONVW] + (size_t)li * 4 * CONVD; const float* __restrict__ cbias = a->in[I_ACONVB] + (size_t)li * CONVD;
        const bool meta = (slot == 128), chunk0 = (!meta && (slot & 63) == 0);
        const int half = tid >> 8, ncb = tid & 15, nrun = (tid >> 4) & 15, nc0 = (half ? 2048 : 3072) + g * 128 + ncb * 8;
        const int xcb = tid & 31, xrun = tid >> 5, xc0 = g * 256 + xcb * 8;
        u32x4 rn[11], rx[11];
        conv_load_run(ZX, R0 + 8 * nrun, nc0, (nrun == 0) ? (meta ? 2 : (chunk0 ? 1 : 0)) : 0, 8 * nrun < len, rn);
        conv_load_run(ZX, R0 + 8 * xrun, xc0, (xrun == 0) ? (meta ? 2 : (chunk0 ? 1 : 0)) : 0, 8 * xrun < len, rx);
        ssd_acs(DT, a->in[I_ALOG] + li * NHEADS, R0, len, h0, s_dt, s_acs, wave, lane);
        { ConvW W; conv_load_w(cw, cbias, nc0, W); conv_item_n(rn, W, half ? BH : Cn, nrun, ncb * 8); }
        { ConvW W; conv_load_w(cw, cbias, xc0, W); const float one[8] = {1.f, 1.f, 1.f, 1.f, 1.f, 1.f, 1.f, 1.f}; conv_item_t(rx, W, one, Xt, xcb * 8, xrun); }
        if (!meta && (slot & 63) == 63) {
            float* __restrict__ dst = a->out + O_PCONV + (size_t)((li * NPROMPT + (slot >> 6)) * 3) * CONVD;
            if (nrun == 15) conv_state_out(rn, dst + nc0);
            if (xrun == 15) conv_state_out(rx, dst + xc0);
        }
    }
    __syncthreads();
    u32x2 hv[8];
#pragma unroll
    for (int k = 0; k < 8; ++k) { const int item = tid + NTHREADS * k; hv[k] = (u32x2){0u, 0u}; if (hs) hv[k] = __builtin_nontemporal_load((const u32x2*)(hs + (size_t)item * 4)); }
    const bool active = (16 * wave < len);
    f32x4 cb[8];
#pragma unroll
    for (int ni = 0; ni < 8; ++ni) cb[ni] = (f32x4){0.f, 0.f, 0.f, 0.f};
    if (active) {
#pragma unroll
    for (int ks = 0; ks < 4; ++ks) { const bf16x8 af = LFRAG(Cn, 16 * wave + fr, LDX, ks);
#pragma unroll
        for (int ni = 0; ni < 8; ++ni) { const bf16x8 bb = LFRAG(BH, 16 * ni + fr, LDX, ks); cb[ni] = MFMA16(bb, af, cb[ni]); } }
    }
    __syncthreads();
#pragma unroll
    for (int k = 0; k < 8; ++k) { const int item = tid + NTHREADS * k, hp = item >> 5, n4 = item & 31; *(u32x2*)(BH + hp * LDX + n4 * 4) = hv[k]; }
#pragma unroll
    for (int k = 0; k < 8; ++k) { const int item = tid + NTHREADS * k; hv[k] = (u32x2){0u, 0u}; if (hs) hv[k] = __builtin_nontemporal_load((const u32x2*)(hs + (size_t)(2 * 8192) + (size_t)item * 4)); }
    __syncthreads();
    const int l = 16 * wave + fr;
    const size_t row = (size_t)(R0 + ((l < len) ? l : 0));
    f32x4 y0[4], y1[4], y2[4], y3[4];
    float ss = 0.f;
    const float* dsk = a->in[I_ADSKIP] + li * NHEADS + h0;
    if (active) {
    ssd3_head(0, 0, Cn, BH, Xt, s_dt, s_acs, cb, y0, ZX, row, g, dsk[0], l, wave, fr, fq, ss);
    ssd3_head(1, 1, Cn, BH, Xt, s_dt, s_acs, cb, y1, ZX, row, g, dsk[1], l, wave, fr, fq, ss);
    }
    __syncthreads();
#pragma unroll
    for (int k = 0; k < 8; ++k) { const int item = tid + NTHREADS * k, hp = item >> 5, n4 = item & 31; *(u32x2*)(BH + hp * LDX + n4 * 4) = hv[k]; }
    __syncthreads();
    if (active) {
    ssd3_head(2, 0, Cn, BH, Xt, s_dt, s_acs, cb, y2, ZX, row, g, dsk[2], l, wave, fr, fq, ss);
    ssd3_head(3, 1, Cn, BH, Xt, s_dt, s_acs, cb, y3, ZX, row, g, dsk[3], l, wave, fr, fq, ss);
    ss += __shfl_xor(ss, 16); ss += __shfl_xor(ss, 32);
    }
    const float rs = rsqrtf(ss * (1.f / 256.f) + EPS);
    if (active && l < len) {
        bf16* yrow = YN + row * DINNER + g * 256 + 4 * fq;
#pragma unroll
        for (int ni = 0; ni < 4; ++ni) {
            u32x2 w;
            w.x = pkbf(y0[ni][0] * rs, y0[ni][1] * rs); w.y = pkbf(y0[ni][2] * rs, y0[ni][3] * rs); *(u32x2*)(yrow + 0 * 64 + 16 * ni) = w;
            w.x = pkbf(y1[ni][0] * rs, y1[ni][1] * rs); w.y = pkbf(y1[ni][2] * rs, y1[ni][3] * rs); *(u32x2*)(yrow + 1 * 64 + 16 * ni) = w;
            w.x = pkbf(y2[ni][0] * rs, y2[ni][1] * rs); w.y = pkbf(y2[ni][2] * rs, y2[ni][3] * rs); *(u32x2*)(yrow + 2 * 64 + 16 * ni) = w;
            w.x = pkbf(y3[ni][0] * rs, y3[ni][1] * rs); w.y = pkbf(y3[ni][2] * rs, y3[ni][3] * rs); *(u32x2*)(yrow + 3 * 64 + 16 * ni) = w;
        }
    }
    __syncthreads();
}
__device__ __forceinline__ void phase_ssd1(ArgsP a, int li, unsigned char* lds, int tid, int wave, int lane) {
    const int c = blockIdx.x;
#pragma unroll 1
    for (int j = 0; j < 4; ++j) {
        const int u = c + 256 * j;
        f32x4 st[4][4];
        ssd_sample_issue(a, li, u >> 3, u & 7, st);
#ifndef PROBE_SSD1
#define PROBE_SSD1 0
#endif
#pragma unroll 1
        for (int rp = 0; rp < (PROBE_SSD1 == 1 ? 2 : 1); ++rp) { const int slot = u >> 3, g = u & 7; ssd1_unit(a, li, lds, slot, g, (slot >> 6) * SEQ + (slot & 63) * 128, 128, tid, wave, lane); }
        ssd_sample_unit(a, li, lds, u >> 3, u & 7, st);
    }
    if (c < 8) ssd1_unit(a, li, lds, 128, c, ROW_M, NMETA, tid, wave, lane);
    else if (c < 16) ssd3_unit(a, li, lds, nullptr, 128, c - 8, ROW_M, NMETA, tid, wave, lane);
}
__device__ __forceinline__ void phase_ssd3(ArgsP a, int li, unsigned char* lds, int tid, int wave, int lane) {
    const bf16* HSB = (const bf16*)(a->ws + WS_HSB);
#pragma unroll 1
    for (int u = blockIdx.x; u < 1024; u += gridDim.x) { const int slot = u >> 3, g = u & 7; ssd3_unit(a, li, lds, HSB + (size_t)(slot * 32 + g * 4) * 8192, slot, g, (slot >> 6) * SEQ + (slot & 63) * 128, 128, tid, wave, lane); }
}

constexpr int KS_LD = 72, VT_LD = 264, P_LD = 232, NKEYS = 208;
__device__ __forceinline__ void attn_prompt_unit(ArgsP a, int lj, unsigned char* lds, int b, int kvh, int qb, int, int, int) {
    const int tid = ltid(), lane = tid & 63, wave = __builtin_amdgcn_readfirstlane(tid >> 6);
    const bf16* __restrict__ Q = (const bf16*)(a->ws + WS_Q); const bf16* __restrict__ KV = (const bf16*)(a->ws + WS_KV); bf16* __restrict__ AO = (bf16*)(a->ws + WS_AO);
    bf16* Ks = (bf16*)lds; bf16* Vt = Ks + NKEYS * KS_LD; bf16* Pw = Vt + 64 * VT_LD + wave * 16 * P_LD;
    const int fr = lane & 15, fq = lane >> 4, t0 = qb * 64, Rb = b * SEQ;
    const int r = wave >> 1, th = (wave & 1) * 32, qh = kvh * 4 + r;
    bf16x8 q0[2], q1[2];
#pragma unroll
    for (int ks = 0; ks < 2; ++ks) { q0[ks] = *(const bf16x8*)(Q + (size_t)(Rb + t0 + th + fr) * DM + qh * 64 + 32 * ks + 8 * fq); q1[ks] = *(const bf16x8*)(Q + (size_t)(Rb + t0 + th + 16 + fr) * DM + qh * 64 + 32 * ks + 8 * fq); }
    {
        u32x4 kv[4];
#pragma unroll
        for (int k = 0; k < 4; ++k) { const int it = tid + NTHREADS * k, key = it >> 3, ch = it & 7; kv[k] = (u32x4){0u, 0u, 0u, 0u};
            if (it < NKEYS * 8) { int row; if (key < 16) row = ROW_M + key; else { int s = t0 - 128 + key - 16; if (s < 0) s = 0; row = Rb + s; }
                kv[k] = *(const u32x4*)(KV + (size_t)row * KVW + kvh * 64 + ch * 8); } }
        u32x4 v0[2], v1[2];
#pragma unroll
        for (int k = 0; k < 2; ++k) { const int it = tid + NTHREADS * k, dbl = it & 7, kp = it >> 3; v0[k] = (u32x4){0u, 0u, 0u, 0u}; v1[k] = v0[k];
            if (it < (NKEYS / 2) * 8) { const int k0 = 2 * kp, k1 = k0 + 1; int s0 = t0 - 128 + k0 - 16, s1 = t0 - 128 + k1 - 16; if (s0 < 0) s0 = 0; if (s1 < 0) s1 = 0;
                const int r0 = (k0 < 16) ? ROW_M + k0 : Rb + s0, r1 = (k1 < 16) ? ROW_M + k1 : Rb + s1;
                v0[k] = *(const u32x4*)(KV + (size_t)r0 * KVW + 256 + kvh * 64 + dbl * 8); v1[k] = *(const u32x4*)(KV + (size_t)r1 * KVW + 256 + kvh * 64 + dbl * 8); } }
#pragma unroll
        for (int k = 0; k < 4; ++k) { const int it = tid + NTHREADS * k, key = it >> 3, ch = it & 7; if (it < NKEYS * 8) *(u32x4*)(Ks + key * KS_LD + ch * 8) = kv[k]; }
#pragma unroll
        for (int k = 0; k < 2; ++k) { const int it = tid + NTHREADS * k, dbl = it & 7, kp = it >> 3;
            if (it < (NKEYS / 2) * 8) { const int col = (2 * kp) ^ (8 * dbl);
                const unsigned a0[4] = {v0[k].x, v0[k].y, v0[k].z, v0[k].w}, a1[4] = {v1[k].x, v1[k].y, v1[k].z, v1[k].w};
#pragma unroll
                for (int j = 0; j < 4; ++j) {
                    *(unsigned*)(Vt + (dbl * 8 + 2 * j) * VT_LD + col) = (a0[j] & 0xffffu) | (a1[j] << 16);
                    *(unsigned*)(Vt + (dbl * 8 + 2 * j + 1) * VT_LD + col) = (a0[j] >> 16) | (a1[j] & 0xffff0000u); } } }
#pragma unroll
        for (int k = 0; k < 3; ++k) { const int idx = tid + NTHREADS * k, row = idx / 24, c = idx - row * 24; *(unsigned*)(Vt + row * VT_LD + ((NKEYS + 2 * c) ^ TSW(row))) = 0u; }
    }
    __syncthreads();
    const float sink = a->in[I_SINKS][lj * NQ + qh];
#pragma unroll 1
    for (int blk = 0; blk < 2; ++blk) {
        const int tq = th + blk * 16 + fr, t = t0 + tq;
        bf16x8 qa2[2];
#pragma unroll
        for (int ks = 0; ks < 2; ++ks) qa2[ks] = (blk == 0) ? q0[ks] : q1[ks];
        f32x4 sc[13];
#pragma unroll
        for (int ni = 0; ni < 13; ++ni) sc[ni] = (f32x4){0.f, 0.f, 0.f, 0.f};
#pragma unroll
        for (int ni = 0; ni < 13; ++ni) {
            const bf16x8 b0 = *(const bf16x8*)(Ks + (16 * ni + fr) * KS_LD + 8 * fq), b1 = *(const bf16x8*)(Ks + (16 * ni + fr) * KS_LD + 32 + 8 * fq);
            sc[ni] = MFMA16(b0, qa2[0], sc[ni]); sc[ni] = MFMA16(b1, qa2[1], sc[ni]);
            }
        int lo = tq + 17; { const int l2 = 144 - t0; if (l2 > lo) lo = l2; }
        const unsigned span = (unsigned)(tq + 144 - lo);
        float mx = -INFINITY;
#pragma unroll
        for (int ni = 0; ni < 13; ++ni)
#pragma unroll
            for (int j = 0; j < 4; ++j) { const int key = 16 * ni + 4 * fq + j; const bool vis = (ni == 0) || ((unsigned)(key - lo) <= span);
                const float v = vis ? sc[ni][j] * 0.125f : -INFINITY; sc[ni][j] = v; mx = fmaxf(mx, v); }
        mx = fmaxf(mx, __shfl_xor(mx, 16)); mx = fmaxf(mx, __shfl_xor(mx, 32)); mx = fmaxf(mx, sink);
        float sum = 0.f;
#pragma unroll
        for (int ni = 0; ni < 13; ++ni)
#pragma unroll
            for (int j = 0; j < 4; ++j) { const float p = __expf(sc[ni][j] - mx); sc[ni][j] = p; sum += p; }
        sum += __shfl_xor(sum, 16); sum += __shfl_xor(sum, 32); sum += __expf(sink - mx);
        const float inv = frcp(sum);
#pragma unroll
        for (int ni = 0; ni < 13; ++ni) { u32x2 w; w.x = pkbf(sc[ni][0] * inv, sc[ni][1] * inv); w.y = pkbf(sc[ni][2] * inv, sc[ni][3] * inv); *(u32x2*)(Pw + fr * P_LD + 16 * ni + 4 * fq) = w; }
        *(u32x2*)(Pw + fr * P_LD + NKEYS + 4 * fq) = (u32x2){0u, 0u};
        asm volatile("s_waitcnt lgkmcnt(0)" ::: "memory");
        f32x4 o[4];
#pragma unroll
        for (int ni = 0; ni < 4; ++ni) o[ni] = (f32x4){0.f, 0.f, 0.f, 0.f};
#pragma unroll
        for (int ks = 0; ks < 7; ++ks) { const bf16x8 af = *(const bf16x8*)(Pw + fr * P_LD + 32 * ks + 8 * fq);
#pragma unroll
            for (int ni = 0; ni < 4; ++ni) { const int vr = 16 * ni + fr; const bf16x8 bb = *(const bf16x8*)(Vt + vr * VT_LD + ((32 * ks + 8 * fq) ^ TSW(vr))); o[ni] = MFMA16(bb, af, o[ni]); }
            }
#pragma unroll
        for (int ni = 0; ni < 4; ++ni) { u32x2 w; w.x = pkbf(o[ni][0], o[ni][1]); w.y = pkbf(o[ni][2], o[ni][3]); *(u32x2*)(AO + (size_t)(Rb + t) * DM + qh * 64 + 16 * ni + 4 * fq) = w; }
        asm volatile("s_waitcnt lgkmcnt(0)" ::: "memory");
    }
    __syncthreads();
}
constexpr int SK_LD = 72, SV_LD = 200, SP_LD = 168, SKEYS = 160;
__device__ __forceinline__ void attn_sample_pair(ArgsP a, int lj, unsigned char* lds, int bp, int kvh, int, int, int) {
    const int tid = ltid(), lane = tid & 63, wave = __builtin_amdgcn_readfirstlane(tid >> 6);
    const bf16* __restrict__ Q = (const bf16*)(a->ws + WS_Q); const bf16* __restrict__ KV = (const bf16*)(a->ws + WS_KV); bf16* __restrict__ AO = (bf16*)(a->ws + WS_AO);
    const float* __restrict__ CK = a->in[I_CK]; const float* __restrict__ CV = a->in[I_CV];
    constexpr int HALF_B = (SKEYS * SK_LD + 64 * SV_LD) * 2;
    const int fr = lane & 15, fq = lane >> 4;
#pragma unroll 1
    for (int it = tid; it < 2 * SKEYS * 8; it += NTHREADS) { const int hf = it / (SKEYS * 8), rem = it - hf * (SKEYS * 8), key = rem >> 3, ch = rem & 7, bb = 2 * bp + hf;
        bf16* Ks = (bf16*)(lds + hf * HALF_B);
        u32x4 w = (u32x4){0u, 0u, 0u, 0u};
        if (key < 16) w = *(const u32x4*)(KV + (size_t)(ROW_M + key) * KVW + kvh * 64 + ch * 8);
        else if (key < 144) { const float* p = CK + ((size_t)(bb * 128 + (key - 16)) * NKV + kvh) * 64 + ch * 8; const f32x4 x0 = __builtin_nontemporal_load((const f32x4*)p), x1 = __builtin_nontemporal_load((const f32x4*)(p + 4));
            w.x = pkbf(x0.x, x0.y); w.y = pkbf(x0.z, x0.w); w.z = pkbf(x1.x, x1.y); w.w = pkbf(x1.z, x1.w); }
        else if (key < 152) w = *(const u32x4*)(KV + (size_t)(ROW_S + bb * 8 + (key - 144)) * KVW + kvh * 64 + ch * 8);
        *(u32x4*)(Ks + key * SK_LD + ch * 8) = w; }
#pragma unroll 1
    for (int it = tid; it < 2 * 96 * 8; it += NTHREADS) { const int hf = it / (96 * 8), rem = it - hf * (96 * 8), dbl = rem & 7, kp = rem >> 3, bb = 2 * bp + hf;
        bf16* Vt = (bf16*)(lds + hf * HALF_B) + SKEYS * SK_LD;
        unsigned a0[4] = {0u, 0u, 0u, 0u}, a1[4] = {0u, 0u, 0u, 0u};
        const int k0 = 2 * kp;
        if (k0 < 16) { const u32x4 x = *(const u32x4*)(KV + (size_t)(ROW_M + k0) * KVW + 256 + kvh * 64 + dbl * 8), y = *(const u32x4*)(KV + (size_t)(ROW_M + k0 + 1) * KVW + 256 + kvh * 64 + dbl * 8);
            a0[0] = x.x; a0[1] = x.y; a0[2] = x.z; a0[3] = x.w; a1[0] = y.x; a1[1] = y.y; a1[2] = y.z; a1[3] = y.w; }
        else if (k0 < 144) { const float* p = CV + ((size_t)(bb * 128 + (k0 - 16)) * NKV + kvh) * 64 + dbl * 8; const f32x4 x0 = __builtin_nontemporal_load((const f32x4*)p), x1 = __builtin_nontemporal_load((const f32x4*)(p + 4)), y0 = __builtin_nontemporal_load((const f32x4*)(p + NKV * 64)), y1 = __builtin_nontemporal_load((const f32x4*)(p + NKV * 64 + 4));
            a0[0] = pkbf(x0.x, x0.y); a0[1] = pkbf(x0.z, x0.w); a0[2] = pkbf(x1.x, x1.y); a0[3] = pkbf(x1.z, x1.w); a1[0] = pkbf(y0.x, y0.y); a1[1] = pkbf(y0.z, y0.w); a1[2] = pkbf(y1.x, y1.y); a1[3] = pkbf(y1.z, y1.w); }
        else if (k0 < 152) { const u32x4 x = *(const u32x4*)(KV + (size_t)(ROW_S + bb * 8 + (k0 - 144)) * KVW + 256 + kvh * 64 + dbl * 8), y = *(const u32x4*)(KV + (size_t)(ROW_S + bb * 8 + (k0 - 143)) * KVW + 256 + kvh * 64 + dbl * 8);
            a0[0] = x.x; a0[1] = x.y; a0[2] = x.z; a0[3] = x.w; a1[0] = y.x; a1[1] = y.y; a1[2] = y.z; a1[3] = y.w; }
        const int col = (2 * kp) ^ (8 * dbl);
#pragma unroll
        for (int j = 0; j < 4; ++j) {
            *(unsigned*)(Vt + (dbl * 8 + 2 * j) * SV_LD + col) = (a0[j] & 0xffffu) | (a1[j] << 16);
            *(unsigned*)(Vt + (dbl * 8 + 2 * j + 1) * SV_LD + col) = (a0[j] >> 16) | (a1[j] & 0xffff0000u); } }
    if (lj == 0) {
#pragma unroll 1
        for (int it = tid; it < 2 * 128 * 16; it += NTHREADS) { const int hf = it >> 11, rem = it & 2047, w = rem >> 4, c4 = (rem & 15) * 4, bb = 2 * bp + hf;
            const size_t o = ((size_t)(bb * 128 + w) * NKV + kvh) * 64 + c4;
            f32x4 kx, vx;
            if (w < 120) { const size_t i = ((size_t)(bb * 128 + w + 8) * NKV + kvh) * 64 + c4; kx = *(const f32x4*)(CK + i); vx = *(const f32x4*)(CV + i); }
            else { const bf16* rp = KV + (size_t)(ROW_S + bb * 8 + (w - 120)) * KVW + kvh * 64 + c4; const u32x2 k2 = *(const u32x2*)rp, v2 = *(const u32x2*)(rp + 256);
                kx = (f32x4){bflo(k2.x), bfhi(k2.x), bflo(k2.y), bfhi(k2.y)}; vx = (f32x4){bflo(v2.x), bfhi(v2.x), bflo(v2.y), bfhi(v2.y)}; }
            __builtin_nontemporal_store(kx, (f32x4*)(a->out + O_SCK + o)); __builtin_nontemporal_store(vx, (f32x4*)(a->out + O_SCV + o)); }
    }
    __syncthreads();
    if (wave < 4) {
        const int hf = wave >> 1, rb = wave & 1, bb = 2 * bp + hf;
        const bf16* Ks = (const bf16*)(lds + hf * HALF_B); const bf16* Vt = Ks + SKEYS * SK_LD; bf16* Pw = (bf16*)(lds + 2 * HALF_B) + wave * 16 * SP_LD;
        const int r = 2 * rb + (fr >> 3), t = fr & 7, qh = kvh * 4 + r;
        const size_t qrow = (size_t)(ROW_S + bb * 8 + t);
        bf16x8 qa[2];
        if (lj == 0) {
#pragma unroll
            for (int ks = 0; ks < 2; ++ks) qa[ks] = *(const bf16x8*)(Q + qrow * DM + qh * 64 + 32 * ks + 8 * fq);
        } else {
            const float* __restrict__ SL = (const float*)(a->ws + WS_SLAB) + (size_t)(qrow - ROW_S) * DM + qh * 64 + 8 * fq;
#pragma unroll
            for (int ks = 0; ks < 2; ++ks) { f32x4 x0 = (f32x4){0.f, 0.f, 0.f, 0.f}, x1 = x0;
#pragma unroll
                for (int sl = 0; sl < 4; ++sl) { const float* p = SL + (size_t)sl * (1280 * 1024) + 32 * ks; x0 = x0 + *(const f32x4*)p; x1 = x1 + *(const f32x4*)(p + 4); }
                const u32x4 w = (u32x4){pkbf(x0.x, x0.y), pkbf(x0.z, x0.w), pkbf(x1.x, x1.y), pkbf(x1.z, x1.w)}; qa[ks] = __builtin_bit_cast(bf16x8, w); }
        }
        const float sink = a->in[I_SINKS][lj * NQ + qh];
        f32x4 sc[10];
#pragma unroll
        for (int ni = 0; ni < 10; ++ni) sc[ni] = (f32x4){0.f, 0.f, 0.f, 0.f};
#pragma unroll
        for (int ni = 0; ni < 10; ++ni) {
            const bf16x8 b0 = *(const bf16x8*)(Ks + (16 * ni + fr) * SK_LD + 8 * fq), b1 = *(const bf16x8*)(Ks + (16 * ni + fr) * SK_LD + 32 + 8 * fq);
            sc[ni] = MFMA16(b0, qa[0], sc[ni]); sc[ni] = MFMA16(b1, qa[1], sc[ni]); }
        float mx = -INFINITY;
#pragma unroll
        for (int ni = 0; ni < 10; ++ni)
#pragma unroll
            for (int j = 0; j < 4; ++j) { const int key = 16 * ni + 4 * fq + j;
                const bool vis = (ni == 0) || ((key < 144) ? (key - 16 > t) : (key - 144 <= t));
                const float v = vis ? sc[ni][j] * 0.125f : -INFINITY; sc[ni][j] = v; mx = fmaxf(mx, v); }
        mx = fmaxf(mx, __shfl_xor(mx, 16)); mx = fmaxf(mx, __shfl_xor(mx, 32)); mx = fmaxf(mx, sink);
        float sum = 0.f;
#pragma unroll
        for (int ni = 0; ni < 10; ++ni)
#pragma unroll
            for (int j = 0; j < 4; ++j) { const float p = __expf(sc[ni][j] - mx); sc[ni][j] = p; sum += p; }
        sum += __shfl_xor(sum, 16); sum += __shfl_xor(sum, 32); sum += __expf(sink - mx);
        const float inv = frcp(sum);
#pragma unroll
        for (int ni = 0; ni < 10; ++ni) { u32x2 w; w.x = pkbf(sc[ni][0] * inv, sc[ni][1] * inv); w.y = pkbf(sc[ni][2] * inv, sc[ni][3] * inv); *(u32x2*)(Pw + fr * SP_LD + 16 * ni + 4 * fq) = w; }
        asm volatile("s_waitcnt lgkmcnt(0)" ::: "memory");
        f32x4 o[4];
#pragma unroll
        for (int ni = 0; ni < 4; ++ni) o[ni] = (f32x4){0.f, 0.f, 0.f, 0.f};
#pragma unroll
        for (int ks = 0; ks < 5; ++ks) { const bf16x8 af = *(const bf16x8*)(Pw + fr * SP_LD + 32 * ks + 8 * fq);
#pragma unroll
            for (int ni = 0; ni < 4; ++ni) { const int vr = 16 * ni + fr; const bf16x8 bb2 = *(const bf16x8*)(Vt + vr * SV_LD + ((32 * ks + 8 * fq) ^ TSW(vr))); o[ni] = MFMA16(bb2, af, o[ni]); } }
#pragma unroll
        for (int ni = 0; ni < 4; ++ni) { u32x2 w; w.x = pkbf(o[ni][0], o[ni][1]); w.y = pkbf(o[ni][2], o[ni][3]); *(u32x2*)(AO + qrow * DM + qh * 64 + 16 * ni + 4 * fq) = w; }
    }
    __syncthreads();
}
__device__ __forceinline__ void phase_attn(ArgsP a, int lj, unsigned char* lds, int tid, int wave, int lane) {
    if (lj == 0) {
        const bf16* KV = (const bf16*)(a->ws + WS_KV);
        const int gt = blockIdx.x * NTHREADS + tid, NT = gridDim.x * NTHREADS;
        for (int e = gt; e < 2 * 128 * 512; e += NT) { const int b = e >> 16, w = (e >> 9) & 127, c = e & 511;
            const float v = bf2f(KV[(size_t)(b * SEQ + SEQ - 128 + w) * KVW + c]);
            if (c < 256) a->out[O_PCK + (size_t)(b * 128 + w) * 256 + c] = v; else a->out[O_PCV + (size_t)(b * 128 + w) * 256 + (c - 256)] = v; }
    }
    const int xg = blockIdx.x & 7, xi = blockIdx.x >> 3;
#pragma unroll 1
    for (int j = 0; j < 4; ++j) { const int u = 128 * xg + 4 * xi + j, qb = u & 127, kvh = (u >> 7) & 3, b = u >> 9; attn_prompt_unit(a, lj, lds, b, kvh, qb, tid, wave, lane); }
    { const int su = blockIdx.x; attn_sample_pair(a, lj, lds, su >> 2, su & 3, tid, wave, lane); }
}

constexpr int PH_B = 9 * 2, PH_F = PH_B + 7 * 2, NPHASES = PH_F + 1;
template <class Epi> __device__ __forceinline__ void run_gemm(LAS unsigned char* lds, const bf16* A, const bf16* Bt, int N, int K, const Epi& E) {
    pg8::Gemm g{A, Bt, MP, N, K}; pg8::StaticOrder S; S.init(MP, N, K, (int)gridDim.x, (int)blockIdx.x);
    pg8::gemm_phase<Epi, pg8::StaticOrder, true, true>(lds, g, S, E);
}
template <class Epi> __device__ __forceinline__ void run_gemm_res(LAS unsigned char* lds, const bf16* A, const bf16* Bt, int K, int S_, const Epi& E) {
    pg8::Gemm g{A, Bt, MP, 1024, K}; pg8::ResOrder S; S.init(K, S_, (int)gridDim.x, (int)blockIdx.x);
    pg8::gemm_phase<Epi, pg8::ResOrder, true, true>(lds, g, S, E);
}

__global__ void __launch_bounds__(NTHREADS, 2) yoco_fwd(Args args) {
    extern __shared__ __attribute__((aligned(16))) unsigned char lds[];
    LAS unsigned char* ldsl = (LAS unsigned char*)lds;
    const int tid0 = threadIdx.x;
    for (int u = tid0; u < (LDS_BYTES - LDSCTL_OFF) / 4; u += NTHREADS) ((LAS unsigned*)(ldsl + LDSCTL_OFF))[u] = 0u;
    __syncthreads();
    const int lo = args.ph_lo, hi = args.ph_hi;
    XcdBarrier bar; bar.bar = (unsigned*)(args.ws + WS_CTL) + CW_BAR; bar.x = 0; bar.st = nullptr;
    if (hi - lo > 1) bar = xcd_barrier_post((unsigned*)(args.ws + WS_CTL) + CW_BAR, (volatile LAS unsigned*)(ldsl + MISC_OFF) + 8);
    int rep = 0;
#pragma unroll 1
    for (int p = lo; p < hi;) {
        ArgsP la = (ArgsP)__builtin_amdgcn_kernarg_segment_ptr(); asm volatile("" : "+s"(la));
        unsigned char* ws = la->ws;
        const int tid = ltid();
        const int lane = tid & 63, wave = __builtin_amdgcn_readfirstlane(tid >> 6);
        bf16* HN = (bf16*)(ws + WS_HN); float* H = (float*)(ws + WS_H);
        int kind, li = 0, lj = 0, layer = 0;
        int nslab = 8;
        if (p == 0) kind = 0;
        else if (p < PH_B) { li = p / 9; layer = li; const int sub = p % 9;
            kind = (sub == 0) ? 1 : (sub == 1) ? 3 : (sub == 2) ? 5 : (sub == 3) ? 6 : (sub == 4) ? 7 : (sub == 5) ? 8 : (sub == 6) ? 1 : (sub == 7) ? 9 : 10; }
        else if (p < PH_F) { lj = (p - PH_B) / 7; layer = 2 + lj; const int sub = (p - PH_B) % 7;
            kind = (sub == 0) ? 1 : (sub == 1) ? 11 : (sub == 2) ? 12 : (sub == 3) ? 13 : (sub == 4) ? 1 : (sub == 5) ? 9 : 10; if (sub == 4) nslab = 4; }
        else kind = 14;
#ifndef KMASK
#define KMASK 0xffff
#endif
#define KON(k) ((KMASK >> (k)) & 1)
#ifndef REP_MASK
#define REP_MASK 0
#endif
        if (KON(0) && kind == 0) { phase_prologue(la, ldsl, wave, lane); phase_norm(la, 1, 0, wave, lane); }
        else if (KON(1) && kind == 1) phase_norm(la, 0, nslab, wave, lane);
        else if (KON(3) && kind == 3) { pg8::EpiInProj E{(bf16*)(ws + WS_ZX), (float*)(ws + WS_DT), la->in[I_ADTB] + li * NHEADS}; run_gemm(ldsl, HN, (const bf16*)(ws + WS_WIN + li * SZ_WIN), INPROJ_P, 1024, E); }
        else if (KON(5) && kind == 5) phase_ssd1(la, li, lds, tid, wave, lane);
        else if (KON(6) && kind == 6) phase_scan(la, li);
        else if (KON(7) && kind == 7) phase_ssd3(la, li, lds, tid, wave, lane);
        else if (KON(8) && (kind == 8 || kind == 10 || kind == 13)) {
            const bf16* A; const bf16* Bt; int K;
            if (kind == 8) { A = (const bf16*)(ws + WS_YN); Bt = (const bf16*)(ws + WS_WOUT + li * SZ_WOUT); K = 2048; }
            else if (kind == 10) { A = (const bf16*)(ws + WS_U); Bt = (const bf16*)(ws + WS_WDN + layer * SZ_WDN); K = 4096; }
            else { A = (const bf16*)(ws + WS_AO); Bt = (const bf16*)(ws + WS_WO + lj * SZ_WO); K = 1024; }
            pg8::EpiRes E{(kind == 8 && li == 0) ? la->in[I_XP] : (const float*)H, H, (float*)(ws + WS_SLAB)}; run_gemm_res(ldsl, A, Bt, K, K == 1024 ? 4 : 8, E); }
        else if (KON(9) && kind == 9) { pg8::EpiBf<1> E{(bf16*)(ws + WS_U), 4096, 1 << 20, nullptr, 0}; run_gemm(ldsl, HN, (const bf16*)(ws + WS_WUP + layer * SZ_WUP), 4096, 1024, E); }
        else if (KON(11) && kind == 11) { pg8::EpiBf<0> E{(bf16*)(ws + WS_Q), 1024, 4, (bf16*)(ws + WS_KV), KVW};
            if (lj == 0) run_gemm(ldsl, HN, (const bf16*)(ws + WS_WQKV0), 1536, 1024, E);
            else { pg8::EpiQSplit E2{(bf16*)(ws + WS_Q), (float*)(ws + WS_SLAB)}; run_gemm_res(ldsl, HN, (const bf16*)(ws + WS_WQ1), 1024, 4, E2); } }
        else if (KON(12) && kind == 12) phase_attn(la, lj, lds, tid, wave, lane);
        else if (KON(14) && kind == 14) phase_final(la, wave, lane);
        bool again = false;
        if (REP_MASK != 0) { if (rep == 0 && ((REP_MASK >> kind) & 1)) { rep = 1; again = true; } else rep = 0; }
#ifdef PROBE_DOUBLE_BARRIER
        if (p + 1 < hi || again) xcd_barrier(bar);
#endif
        if (p + 1 < hi || again) xcd_barrier(bar); else { asm volatile("s_waitcnt vmcnt(0)" ::: "memory"); __syncthreads(); }
        if (!again) ++p;
    }
}

#ifndef MK_PER_PHASE
#define MK_PER_PHASE 0
#endif
extern "C" void kernel_launch(void* const* d_in, const int* in_sizes, int n_in, void* d_out, int out_size, void* d_ws, size_t ws_size, hipStream_t stream) {
    static int grid = 0;
    if (grid == 0) {
        if (n_in != 26 || (size_t)out_size != O_END || ws_size < WS_END) { fprintf(stderr, "kernel_launch: unexpected problem (n_in %d, out %d vs %zu, ws %zu vs %zu); nothing launched\n", n_in, out_size, (size_t)O_END, ws_size, (size_t)WS_END); grid = -1; return; }
        int dev = 0, cus = 0, per_cu = 0;
        if (hipGetDevice(&dev) != hipSuccess || hipDeviceGetAttribute(&cus, hipDeviceAttributeMultiprocessorCount, dev) != hipSuccess) { grid = -1; return; }
        if (hipFuncSetAttribute((const void*)yoco_fwd, hipFuncAttributeMaxDynamicSharedMemorySize, LDS_BYTES) != hipSuccess) { fprintf(stderr, "kernel_launch: hipFuncSetAttribute failed\n"); grid = -1; return; }
        if (hipOccupancyMaxActiveBlocksPerMultiprocessor(&per_cu, (const void*)yoco_fwd, NTHREADS, LDS_BYTES) != hipSuccess || per_cu < 1) { fprintf(stderr, "kernel_launch: occupancy query says %d\n", per_cu); per_cu = 1; }
        (void)hipGetLastError();
        if (cus != 256) { fprintf(stderr, "kernel_launch: built for a 256-CU device (got %d); nothing launched\n", cus); grid = -1; return; }
        grid = cus;
    }
    if (grid < 0) return;
    if (hipMemsetAsync((char*)d_ws + WS_CTL, 0, CTL_ZERO_BYTES, stream) != hipSuccess) { fprintf(stderr, "kernel_launch: memset failed\n"); return; }
    Args a{};
    for (int i = 0; i < 26; ++i) a.in[i] = (const float*)d_in[i];
    a.out = (float*)d_out; a.ws = (unsigned char*)d_ws;
#if MK_PER_PHASE
    for (int p = 0; p < NPHASES; ++p) { a.ph_lo = p; a.ph_hi = p + 1; hipLaunchKernelGGL(yoco_fwd, dim3(grid), dim3(NTHREADS), LDS_BYTES, stream, a); }
#else
    a.ph_lo = 0; a.ph_hi = NPHASES;
    void* kargs[] = {&a};
    hipError_t e = hipLaunchCooperativeKernel((const void*)yoco_fwd, dim3(grid), dim3(NTHREADS), kargs, LDS_BYTES, stream);
    if (e != hipSuccess) fprintf(stderr, "kernel_launch: cooperative launch failed: %s (grid %d)\n", hipGetErrorString(e), grid);
#endif
}
```

```cpp
#include <hip/hip_runtime.h>
#include <cstdio>
#include <cstdint>
#include <cmath>
namespace pg8 {
#define PG8_LAS __attribute__((address_space(3)))
typedef unsigned short bf16_t;
typedef short bf16x8 __attribute__((ext_vector_type(8)));
typedef float f32x4 __attribute__((ext_vector_type(4)));
typedef unsigned u32x4 __attribute__((ext_vector_type(4)));
constexpr int BM = 256, BK = 64, HALF = 128, HTB = HALF * BK * 2  , STAGE_BYTES = 8 * HTB, NXCD = 8, WGM = 8;

__host__ __device__ __forceinline__ int lds_byte(int r, int c) { const int st = (r >> 4) * 2 + (c >> 5), rr = r & 15, cc = c & 31, ob = rr * 64 + cc * 2; return st * 1024 + (ob ^ (((ob >> 9) & 1) << 5)); }
__host__ __device__ __forceinline__ void stage_rc(int b, int& R, int& C) { const int st = b / 1024, sb = b % 1024, swz = sb ^ (((sb >> 9) & 1) << 5); R = (st >> 1) * 16 + swz / 64; C = (st & 1) * 32 + (swz % 64) / 2; }
__host__ __device__ __forceinline__ int perm32(int rho) { const int n = rho >> 4, i = rho & 15; return 8 * (i >> 2) + 4 * n + (i & 3); }

struct Unit { int pm, pn, k0, nt, aux; };
struct Gemm { const bf16_t* A; const bf16_t* Bt; int M, N, K; };

struct StaticOrder {
    int nM, nN, nwg, G, c, nt0;
    __host__ __device__ void init(int M, int N, int K, int G_, int c_) { nM = M / BM; nN = N / BM; nwg = nM * nN; G = G_; c = c_; nt0 = K / BK; }
    __host__ __device__ bool next(int i, Unit& u) const {
        const long L = (long)i * G + c; if (L >= nwg) return false;
        int wgid = (int)L; { const int q = nwg / NXCD, r = nwg % NXCD, xcd = wgid % NXCD, off = wgid / NXCD; wgid = (xcd < r ? xcd * (q + 1) : r * (q + 1) + (xcd - r) * q) + off; }
        const int nig = WGM * nN, gid = wgid / nig, fm = gid * WGM, gsz = (nM - fm) < WGM ? (nM - fm) : WGM;
        u.pm = fm + ((wgid % nig) % gsz); u.pn = (wgid % nig) / gsz; u.k0 = 0; u.nt = nt0; u.aux = -1; return true;
    }
    __device__ __forceinline__ void a_ready(const Unit&) const {}
    __device__ __forceinline__ void done(const Unit&) const {}
};
struct ResOrder {
    StaticOrder so; int S, K, c;
    __host__ __device__ void init(int K_, int S_, int G_, int c_) { so.init(64 * BM, 1024, K_, G_, c_); S = S_; K = K_; c = c_; }
    __host__ __device__ bool next(int i, Unit& u) const {
        if (i == 0) return so.next(0, u);
        if (i == 1 && c < 20 * S) { const int t = c / S, sl = c - t * S; u.pm = 64 + (t >> 2); u.pn = t & 3; u.k0 = sl * (K / S); u.nt = K / S / BK; u.aux = sl; return true; }
        return false;
    }
    __device__ __forceinline__ void a_ready(const Unit&) const {}
    __device__ __forceinline__ void done(const Unit&) const {}
};

typedef float f32x2_cv0 __attribute__((ext_vector_type(2))); typedef __bf16 bf16x2_cv0 __attribute__((ext_vector_type(2)));
__device__ __forceinline__ unsigned cvt_pk_bf16(float lo, float hi) { const f32x2_cv0 v = {lo, hi}; const bf16x2_cv0 b = __builtin_convertvector(v, bf16x2_cv0); return __builtin_bit_cast(unsigned, b); }
typedef float f32x2 __attribute__((ext_vector_type(2)));
typedef unsigned u32x2 __attribute__((ext_vector_type(2)));
__device__ __forceinline__ float softplus_f(float x) { const float y = __expf(-fabsf(x)); const float l = (y < 0.03125f) ? y * (1.f - y * (0.5f - y * (1.f / 3.f - 0.25f * y))) : __logf(1.f + y); return fmaxf(x, 0.f) + l; }
struct EpiInProj {
    static constexpr bool PERM = true, AFTER_DRAIN = false;
    bf16_t* ZX; float* DT; const float* dt_bias;
    __device__ __forceinline__ void operator()(const f32x4 (&acc)[2][2][4][2], const Unit& u, int wr, int wc, int fr, int fq) const {
        const int row0 = u.pm * BM + wr * 64 + fr;
        if (u.pn < 24) {
            const int col0 = u.pn * BM + wc * 32 + 8 * fq;
#pragma unroll
            for (int ai = 0; ai < 2; ++ai)
#pragma unroll
                for (int m = 0; m < 4; ++m) { bf16_t* rowp = ZX + (size_t)(row0 + ai * HALF + m * 16) * 6144 + col0;
#pragma unroll
                    for (int bj = 0; bj < 2; ++bj) { const f32x4 v0 = acc[ai][bj][m][0], v1 = acc[ai][bj][m][1];
                        u32x4 w; w.x = cvt_pk_bf16(v0[0], v0[1]); w.y = cvt_pk_bf16(v0[2], v0[3]); w.z = cvt_pk_bf16(v1[0], v1[1]); w.w = cvt_pk_bf16(v1[2], v1[3]);
                        *(u32x4*)(rowp + bj * HALF) = w; } }
        } else if (wc == 0) {
            const int c0 = 8 * fq;
            const f32x4 b0 = *(const f32x4*)(dt_bias + c0), b1 = *(const f32x4*)(dt_bias + c0 + 4);
#pragma unroll
            for (int ai = 0; ai < 2; ++ai)
#pragma unroll
                for (int m = 0; m < 4; ++m) { float* rowp = DT + (size_t)(row0 + ai * HALF + m * 16) * 32 + c0;
                    const f32x4 v0 = acc[ai][0][m][0] + b0, v1 = acc[ai][0][m][1] + b1;
                    f32x4 o0, o1;
#pragma unroll
                    for (int j = 0; j < 4; ++j) { o0[j] = softplus_f(v0[j]); o1[j] = softplus_f(v1[j]); }
                    *(f32x4*)(rowp) = o0; *(f32x4*)(rowp + 4) = o1; }
        }
    }
};
struct EpiRes {
    static constexpr bool PERM = false, AFTER_DRAIN = false;
    const float* B; float* H; float* SLAB;
    __device__ __forceinline__ void operator()(const f32x4 (&acc)[2][2][4][2], const Unit& u, int wr, int wc, int fr, int fq) const {
        const int row0 = u.pm * BM + wr * 64 + fr, col0 = u.pn * BM + wc * 32 + 4 * fq;
        if (u.aux >= 0) {
            float* base = SLAB + (size_t)u.aux * (1280 * 1024) + (size_t)(row0 - 16384) * 1024 + col0;
#pragma unroll
            for (int ai = 0; ai < 2; ++ai)
#pragma unroll
                for (int m = 0; m < 4; ++m) { float* rowp = base + (size_t)(ai * HALF + m * 16) * 1024;
#pragma unroll
                    for (int bj = 0; bj < 2; ++bj)
#pragma unroll
                        for (int n = 0; n < 2; ++n) *(f32x4*)(rowp + bj * HALF + n * 16) = acc[ai][bj][m][n]; }
            return;
        }
#pragma unroll
        for (int ai = 0; ai < 2; ++ai) {
            f32x4 bv[4][2][2];
#pragma unroll
            for (int m = 0; m < 4; ++m) { const size_t off = (size_t)(row0 + ai * HALF + m * 16) * 1024 + col0;
#pragma unroll
                for (int bj = 0; bj < 2; ++bj)
#pragma unroll
                    for (int n = 0; n < 2; ++n) bv[m][bj][n] = *(const f32x4*)(B + off + bj * HALF + n * 16); }
#pragma unroll
            for (int m = 0; m < 4; ++m) { const size_t off = (size_t)(row0 + ai * HALF + m * 16) * 1024 + col0;
#pragma unroll
                for (int bj = 0; bj < 2; ++bj)
#pragma unroll
                    for (int n = 0; n < 2; ++n) *(f32x4*)(H + off + bj * HALF + n * 16) = bv[m][bj][n] + acc[ai][bj][m][n]; }
        }
    }
};
template <int ACT> struct EpiBf {
    static constexpr bool PERM = true, AFTER_DRAIN = false;
    bf16_t* O0; int ldc0; int nsplit; bf16_t* O1; int ldc1;
    __device__ __forceinline__ void operator()(const f32x4 (&acc)[2][2][4][2], const Unit& u, int wr, int wc, int fr, int fq) const {
        const int row0 = u.pm * BM + wr * 64 + fr;
        bf16_t* base; int ldc, colt;
        if (u.pn < nsplit) { base = O0; ldc = ldc0; colt = u.pn * BM; } else { base = O1; ldc = ldc1; colt = (u.pn - nsplit) * BM; }
        const int col0 = colt + wc * 32 + 8 * fq;
#pragma unroll
        for (int ai = 0; ai < 2; ++ai)
#pragma unroll
            for (int m = 0; m < 4; ++m) { bf16_t* rowp = base + (size_t)(row0 + ai * HALF + m * 16) * ldc + col0;
#pragma unroll
                for (int bj = 0; bj < 2; ++bj) { f32x4 v0 = acc[ai][bj][m][0], v1 = acc[ai][bj][m][1];
                    if (ACT == 1) {
#pragma unroll
                        for (int j = 0; j < 4; ++j) { const float a = fmaxf(v0[j], 0.f), b = fmaxf(v1[j], 0.f); v0[j] = a * a; v1[j] = b * b; } }
                    u32x4 w; w.x = cvt_pk_bf16(v0[0], v0[1]); w.y = cvt_pk_bf16(v0[2], v0[3]); w.z = cvt_pk_bf16(v1[0], v1[1]); w.w = cvt_pk_bf16(v1[2], v1[3]);
                    *(u32x4*)(rowp + bj * HALF) = w; } }
    }
};
struct EpiQSplit {
    static constexpr bool PERM = true, AFTER_DRAIN = false;
    bf16_t* Q; float* SLAB;
    __device__ __forceinline__ void operator()(const f32x4 (&acc)[2][2][4][2], const Unit& u, int wr, int wc, int fr, int fq) const {
        const int row0 = u.pm * BM + wr * 64 + fr, col0 = u.pn * BM + wc * 32 + 8 * fq;
        if (u.aux >= 0) {
            float* base = SLAB + (size_t)u.aux * (1280 * 1024) + (size_t)(row0 - 16384) * 1024 + col0;
#pragma unroll
            for (int ai = 0; ai < 2; ++ai)
#pragma unroll
                for (int m = 0; m < 4; ++m) { float* rowp = base + (size_t)(ai * HALF + m * 16) * 1024;
#pragma unroll
                    for (int bj = 0; bj < 2; ++bj) { *(f32x4*)(rowp + bj * HALF) = acc[ai][bj][m][0]; *(f32x4*)(rowp + bj * HALF + 4) = acc[ai][bj][m][1]; } }
            return;
        }
#pragma unroll
        for (int ai = 0; ai < 2; ++ai)
#pragma unroll
            for (int m = 0; m < 4; ++m) { bf16_t* rowp = Q + (size_t)(row0 + ai * HALF + m * 16) * 1024 + col0;
#pragma unroll
                for (int bj = 0; bj < 2; ++bj) { const f32x4 v0 = acc[ai][bj][m][0], v1 = acc[ai][bj][m][1];
                    u32x4 w; w.x = cvt_pk_bf16(v0[0], v0[1]); w.y = cvt_pk_bf16(v0[2], v0[3]); w.z = cvt_pk_bf16(v1[0], v1[1]); w.w = cvt_pk_bf16(v1[2], v1[3]);
                    *(u32x4*)(rowp + bj * HALF) = w; } }
    }
};

template <class Epi, class Sched, bool ALIGN_EPI = false, bool SP2 = false>
__device__ __forceinline__ void gemm_phase(PG8_LAS unsigned char* lds, const Gemm g, const Sched& S, const Epi& E) {
    int tid_l = threadIdx.x; asm volatile("" : "+v"(tid_l));
    const int tid = tid_l, wid = __builtin_amdgcn_readfirstlane(tid >> 6), lane = tid & 63, wr = wid >> 2, wc = wid & 3, fr = lane & 15, fq = lane >> 4;
    const int K = g.K;
    unsigned voffA[2], voffB[2];
#pragma unroll
    for (int i = 0; i < 2; ++i) { int R, C; stage_rc(tid * 16 + i * 8192, R, C); const int Rb = Epi::PERM ? ((R & ~31) + perm32(R & 31)) : R;
        voffA[i] = (unsigned)(R * K + C) * 2u; voffB[i] = (unsigned)(Rb * K + C) * 2u; }
    const size_t kstep = (size_t)(BK * 2);
    const size_t hstep = (size_t)HALF * K * 2;
    const size_t tstep = 2 * hstep;
    const unsigned ldsw = (unsigned)wid * 1024u;
    const int aoff = lds_byte(wr * 64 + fr, fq * 8), boff = lds_byte(wc * 32 + fr, fq * 8);
#define PG8_SA(b, h) (((b) * 2 + (h)) * HTB)
#define PG8_SB(b, h) ((4 + (b) * 2 + (h)) * HTB)
#define PG8_STAGE(bufoff, gbase, voff) do { _Pragma("unroll") for (int _i = 0; _i < 2; ++_i) \
        __builtin_amdgcn_global_load_lds((const unsigned*)((const char*)(gbase) + (voff)[_i]), (PG8_LAS unsigned*)(lds + (bufoff) + ldsw + _i * 8192), 16, 0, 0); } while (0)
#define PG8_LDA(dst, b, h) do { _Pragma("unroll") for (int m = 0; m < 4; ++m) _Pragma("unroll") for (int k = 0; k < 2; ++k) dst[m][k] = *(const PG8_LAS bf16x8*)(lds + PG8_SA(b, h) + aoff + m * 2048 + k * 1024); } while (0)
#define PG8_LDB(dst, b, h) do { _Pragma("unroll") for (int n = 0; n < 2; ++n) _Pragma("unroll") for (int k = 0; k < 2; ++k) dst[n][k] = *(const PG8_LAS bf16x8*)(lds + PG8_SB(b, h) + boff + n * 2048 + k * 1024); } while (0)
#define PG8_MMA(ai, bj, At, Bt) do { __builtin_amdgcn_s_setprio(1); _Pragma("unroll") for (int m = 0; m < 4; ++m) _Pragma("unroll") for (int n = 0; n < 2; ++n) _Pragma("unroll") for (int k = 0; k < 2; ++k) \
        acc[ai][bj][m][n] = __builtin_amdgcn_mfma_f32_16x16x32_bf16(Bt[n][k], At[m][k], acc[ai][bj][m][n], 0, 0, 0); __builtin_amdgcn_s_setprio(0); } while (0)
#define PG8_WAIT_V(n) asm volatile("s_waitcnt vmcnt(" #n ")" ::: "memory")
#define PG8_WAIT_L(n) asm volatile("s_waitcnt lgkmcnt(" #n ")" ::: "memory")
#define PG8_BAR __builtin_amdgcn_s_barrier()
#define PG8_SCHED __builtin_amdgcn_sched_barrier(0)
    Unit cur, nxt; int ui = 0;
    if (!S.next(0, cur)) return;
    f32x4 acc[2][2][4][2];
#pragma unroll
    for (int a = 0; a < 2; ++a)
#pragma unroll
        for (int b = 0; b < 2; ++b)
#pragma unroll
            for (int m = 0; m < 4; ++m)
#pragma unroll
                for (int n = 0; n < 2; ++n) acc[a][b][m][n] = (f32x4){0.f, 0.f, 0.f, 0.f};
    bf16x8 At[4][2], B0[2][2], B1[2][2];
    const char* cA = (const char*)g.A + (size_t)cur.pm * tstep + (size_t)cur.k0 * 2; const char* cB = (const char*)g.Bt + (size_t)cur.pn * tstep + (size_t)cur.k0 * 2;
    S.a_ready(cur);
    if constexpr (SP2) {
        PG8_STAGE(PG8_SB(0, 0), cB, voffB); PG8_STAGE(PG8_SB(0, 1), cB + hstep, voffB); PG8_STAGE(PG8_SA(0, 0), cA, voffA); PG8_STAGE(PG8_SA(0, 1), cA + hstep, voffA);
        if (wr == 1) PG8_BAR;
        PG8_WAIT_V(2); PG8_BAR;
        PG8_STAGE(PG8_SB(1, 0), cB + kstep, voffB); PG8_STAGE(PG8_SA(1, 0), cA + kstep, voffA); PG8_STAGE(PG8_SB(1, 1), cB + hstep + kstep, voffB);
        PG8_WAIT_V(6); PG8_BAR;
    } else {
        PG8_STAGE(PG8_SB(0, 0), cB, voffB); PG8_STAGE(PG8_SA(0, 0), cA, voffA); PG8_STAGE(PG8_SB(0, 1), cB + hstep, voffB); PG8_STAGE(PG8_SA(0, 1), cA + hstep, voffA);
        if (wr == 1) PG8_BAR;
        PG8_WAIT_V(4); PG8_BAR;
        PG8_STAGE(PG8_SB(1, 0), cB + kstep, voffB); PG8_STAGE(PG8_SA(1, 0), cA + kstep, voffA); PG8_STAGE(PG8_SB(1, 1), cB + hstep + kstep, voffB);
        PG8_WAIT_V(6); PG8_BAR;
    }
    for (;;) {
        const bool has_next = S.next(ui + 1, nxt);
        const char* nA = has_next ? (const char*)g.A + (size_t)nxt.pm * tstep + (size_t)nxt.k0 * 2 : cA; const char* nB = has_next ? (const char*)g.Bt + (size_t)nxt.pn * tstep + (size_t)nxt.k0 * 2 : cB;
        const int nt = cur.nt;
        for (int t = 0; t < nt; t += 2) {
            const bool last = (t == nt - 2);
            const char* a1 = cA + (size_t)(t + 1) * kstep;
            const char* a2 = last ? nA : cA + (size_t)(t + 2) * kstep; const char* b2 = last ? nB : cB + (size_t)(t + 2) * kstep;
            const char* a3 = a2 + kstep; const char* b3 = b2 + kstep;
            if (last && has_next) S.a_ready(nxt);
            if constexpr (SP2) {
            PG8_LDB(B0, 0, 0); PG8_LDB(B1, 0, 1); PG8_SCHED; PG8_LDA(At, 0, 0); PG8_STAGE(PG8_SA(1, 1), a1 + hstep, voffA);
            PG8_WAIT_V(8); PG8_WAIT_L(0); PG8_BAR; PG8_MMA(0, 0, At, B0); PG8_MMA(0, 1, At, B1); PG8_BAR; PG8_SCHED;
            PG8_LDA(At, 0, 1); PG8_STAGE(PG8_SB(0, 0), b2, voffB); PG8_STAGE(PG8_SB(0, 1), b2 + hstep, voffB); PG8_STAGE(PG8_SA(0, 0), a2, voffA);
            PG8_WAIT_V(8); PG8_WAIT_L(0); PG8_BAR; PG8_MMA(1, 0, At, B0); PG8_MMA(1, 1, At, B1); PG8_BAR; PG8_SCHED;
            PG8_LDB(B0, 1, 0); PG8_LDB(B1, 1, 1); PG8_SCHED; PG8_LDA(At, 1, 0); PG8_STAGE(PG8_SA(0, 1), a2 + hstep, voffA);
            PG8_WAIT_V(8); PG8_WAIT_L(0); PG8_BAR; PG8_MMA(0, 0, At, B0); PG8_MMA(0, 1, At, B1); PG8_BAR; PG8_SCHED;
            PG8_LDA(At, 1, 1); PG8_STAGE(PG8_SB(1, 0), b3, voffB); PG8_STAGE(PG8_SB(1, 1), b3 + hstep, voffB); PG8_STAGE(PG8_SA(1, 0), a3, voffA);
            PG8_WAIT_V(8); PG8_WAIT_L(0); PG8_BAR; PG8_MMA(1, 0, At, B0); PG8_MMA(1, 1, At, B1); PG8_BAR; PG8_SCHED;
            } else {
            PG8_LDB(B0, 0, 0); PG8_SCHED; PG8_LDA(At, 0, 0); PG8_STAGE(PG8_SA(1, 1), a1 + hstep, voffA);
            PG8_WAIT_L(8); PG8_BAR; PG8_WAIT_L(0); PG8_MMA(0, 0, At, B0); PG8_BAR; PG8_SCHED;
            PG8_LDB(B1, 0, 1); PG8_STAGE(PG8_SB(0, 0), b2, voffB);
            PG8_BAR; PG8_WAIT_L(0); PG8_MMA(0, 1, At, B1); PG8_BAR;
            PG8_LDA(At, 0, 1); PG8_STAGE(PG8_SA(0, 0), a2, voffA);
            PG8_BAR; PG8_WAIT_L(0); PG8_MMA(1, 0, At, B0); PG8_BAR; PG8_SCHED;
            PG8_STAGE(PG8_SB(0, 1), b2 + hstep, voffB);
            PG8_WAIT_V(6); PG8_BAR; PG8_MMA(1, 1, At, B1); PG8_BAR;
            PG8_LDB(B0, 1, 0); PG8_SCHED; PG8_LDA(At, 1, 0); PG8_STAGE(PG8_SA(0, 1), a2 + hstep, voffA);
            PG8_WAIT_L(8); PG8_BAR; PG8_WAIT_L(0); PG8_MMA(0, 0, At, B0); PG8_BAR; PG8_SCHED;
            PG8_LDB(B1, 1, 1); PG8_STAGE(PG8_SB(1, 0), b3, voffB);
            PG8_BAR; PG8_WAIT_L(0); PG8_MMA(0, 1, At, B1); PG8_BAR;
            PG8_LDA(At, 1, 1); PG8_STAGE(PG8_SA(1, 0), a3, voffA);
            PG8_BAR; PG8_WAIT_L(0); PG8_MMA(1, 0, At, B0); PG8_BAR; PG8_SCHED;
            PG8_STAGE(PG8_SB(1, 1), b3 + hstep, voffB);
            PG8_WAIT_V(6); PG8_BAR; PG8_MMA(1, 1, At, B1); PG8_BAR;
            }
        }
        if constexpr (ALIGN_EPI) { if (wr == 0) PG8_BAR; }
        if constexpr (!Epi::AFTER_DRAIN) { E(acc, cur, wr, wc, fr, fq); S.done(cur); }
        if (!has_next) break;
#pragma unroll
        for (int a = 0; a < 2; ++a)
#pragma unroll
            for (int b = 0; b < 2; ++b)
#pragma unroll
                for (int m = 0; m < 4; ++m)
#pragma unroll
                    for (int n = 0; n < 2; ++n) acc[a][b][m][n] = (f32x4){0.f, 0.f, 0.f, 0.f};
        cur = nxt; cA = nA; cB = nB; ++ui;
        if constexpr (ALIGN_EPI) { if (wr == 1) PG8_BAR; }
    }
    PG8_WAIT_V(0);
    if constexpr (!ALIGN_EPI) { if (wr == 0) PG8_BAR; }
    PG8_BAR;
    if constexpr (Epi::AFTER_DRAIN) { E.fused(acc, cur, wr, wc, fr, fq, lds, wid, lane); S.done(cur); }
#undef PG8_SA
#undef PG8_SB
#undef PG8_STAGE
#undef PG8_LDA
#undef PG8_LDB
#undef PG8_MMA
#undef PG8_WAIT_V
#undef PG8_WAIT_L
#undef PG8_BAR
#undef PG8_SCHED
}
}
#define GAS __attribute__((address_space(1)))
#define LAS __attribute__((address_space(3)))
typedef unsigned short bf16;
typedef unsigned v4u __attribute__((ext_vector_type(4)));
typedef float f32x4 __attribute__((ext_vector_type(4)));
typedef short bf16x8 __attribute__((ext_vector_type(8)));
typedef GAS unsigned gu32;
typedef GAS unsigned long long gu64;
#define RLX_AGENT __ATOMIC_RELAXED, __HIP_MEMORY_SCOPE_AGENT
#define LDS_WAIT() asm volatile("s_waitcnt lgkmcnt(0)" ::: "memory")
#define VM_WAIT() asm volatile("s_waitcnt vmcnt(0)" ::: "memory")
__device__ __forceinline__ unsigned long long rt() { return __builtin_amdgcn_s_memrealtime(); }
__device__ __forceinline__ unsigned f2bf(float f) { unsigned u = __builtin_bit_cast(unsigned, f); return (u + 0x7fffu + ((u >> 16) & 1u)) >> 16; }
__device__ __forceinline__ unsigned pk2(float lo, float hi) { return f2bf(lo) | (f2bf(hi) << 16); }

#define XB_TMO      128
#define XB_XCNT(j)  (256  + 64 * (j))
#define XB_XSUB(j)  (1280 + 64 * (j))
#define XB_XGEN(j)  (2304 + 64 * (j))
#define XB_TOP      3328
#define XB_TOPGEN   3392
#define XCD_BAR_WORDS 3456
#define XB_SPIN_CAP (1u << 18)

__device__ __forceinline__ unsigned xb_ld(unsigned* p)              { return __hip_atomic_load(p, __ATOMIC_RELAXED, __HIP_MEMORY_SCOPE_AGENT); }
__device__ __forceinline__ unsigned xb_add(unsigned* p, unsigned v) { return __hip_atomic_fetch_add(p, v, __ATOMIC_RELAXED, __HIP_MEMORY_SCOPE_AGENT); }
__device__ __forceinline__ unsigned xb_xcc_id() { return (unsigned)__builtin_amdgcn_s_getreg((3 << 11) | 20) & 0xFu; }
#define XB_SPIN(cond, bar) do { unsigned _sp = 0; while (cond) { __builtin_amdgcn_s_sleep(1); \
    if ((++_sp & 255u) == 0u) { if (xb_ld(&(bar)[XB_TMO])) break; if (_sp > XB_SPIN_CAP) { atomicAdd(&(bar)[XB_TMO], 1u); break; } } } } while (0)

struct XcdBarrier {
    unsigned* bar; unsigned x;
    volatile LAS unsigned* st;
};

__device__ __forceinline__ XcdBarrier xcd_barrier_post(unsigned* bar, volatile LAS unsigned* st) {
    XcdBarrier b; b.bar = bar; b.x = xb_xcc_id(); b.st = st;
    if (threadIdx.x == 0) (void)xb_add(&bar[XB_XCNT(b.x)], 1u);
    return b;
}
__device__ __forceinline__ void xcd_barrier_complete(unsigned* bar, unsigned x, unsigned& nloc, unsigned& nx) {
    const unsigned G = gridDim.x * gridDim.y * gridDim.z;
    unsigned sum, cnt, mine, sp = 0u;
    for (;;) {
        sum = 0u; cnt = 0u; mine = 0u;
#pragma unroll
        for (unsigned j = 0; j < 16; ++j) { const unsigned c = xb_ld(&bar[XB_XCNT(j)]); sum += c; cnt += (c > 0u) ? 1u : 0u; mine = (j == x) ? c : mine; }
        if (sum == G) break;
        __builtin_amdgcn_s_sleep(1);
        if ((++sp & 255u) == 0u) { if (xb_ld(&bar[XB_TMO])) break; if (sp > XB_SPIN_CAP) { atomicAdd(&bar[XB_TMO], 1u); break; } }
    }
    nloc = mine > 0u ? mine : 1u; nx = cnt > 0u ? cnt : 1u;
}

__device__ __forceinline__ void xcd_barrier(const XcdBarrier& b) {
    asm volatile("s_waitcnt vmcnt(0)" ::: "memory");
    __syncthreads();
    if (threadIdx.x == 0) {
        unsigned* bar = b.bar;
        __builtin_amdgcn_s_waitcnt(0);
        unsigned nloc = b.st[0], nx = b.st[1];
        if (nloc == 0u) { xcd_barrier_complete(bar, b.x, nloc, nx); b.st[0] = nloc; b.st[1] = nx; }
        const unsigned old = xb_add(&bar[XB_XSUB(b.x)], 1u);
        const unsigned gen = old / nloc;
        if (old + 1u == (gen + 1u) * nloc) {
            __builtin_amdgcn_fence(__ATOMIC_RELEASE, "agent");
            asm volatile("s_waitcnt vmcnt(0)" ::: "memory");
            const unsigned og = xb_add(&bar[XB_TOP], 1u);
            const unsigned tg = og / nx;
            if (og + 1u == (tg + 1u) * nx) xb_add(&bar[XB_TOPGEN], 1u);
            else XB_SPIN(xb_ld(&bar[XB_TOPGEN]) == tg, bar);
            __builtin_amdgcn_fence(__ATOMIC_ACQUIRE, "agent");
            xb_add(&bar[XB_XGEN(b.x)], 1u);
            asm volatile("s_waitcnt vmcnt(0)" ::: "memory");
        } else {
            XB_SPIN(xb_ld(&bar[XB_XGEN(b.x)]) == gen, bar);
            __builtin_amdgcn_fence(__ATOMIC_ACQUIRE, "agent");
            asm volatile("s_waitcnt vmcnt(0)" ::: "memory");
        }
    }
    __syncthreads();
}
constexpr int NWAVES = 8, NTHREADS = 512;
constexpr int DM = 1024, SEQ = 8192, NPROMPT = 2, NSAMP = 128, TSAMP = 8, NMETA = 16;
constexpr int ROW_S = NPROMPT * SEQ;
constexpr int ROW_M = ROW_S + NSAMP * TSAMP;
constexpr int NROWS = ROW_M + NMETA;
constexpr int MP = 17664;
constexpr int DINNER = 2048, NHEADS = 32, HD = 64, NGROUPS = 8, DSTATE = 128, CONVD = 4096, INPROJ = 6176, INPROJ_P = 6400, ZXW = 6144;
constexpr int DFF = 4096, NKV = 4, NQ = 16, KVW = 512;
constexpr float EPS = 1e-5f;
constexpr int LDX = 136;

constexpr size_t O_YP = 0, O_YS = O_YP + (size_t)NPROMPT * SEQ * DM, O_PCONV = O_YS + (size_t)NSAMP * TSAMP * DM, O_PSSM = O_PCONV + 2 * 2 * 3 * 4096,
    O_PCK = O_PSSM + (size_t)2 * 2 * 32 * 64 * 128, O_PCV = O_PCK + 2 * 128 * 256, O_SCONV = O_PCV + 2 * 128 * 256, O_SSSM = O_SCONV + (size_t)2 * 128 * 3 * 4096,
    O_SCK = O_SSSM + (size_t)2 * 128 * 32 * 64 * 128, O_SCV = O_SCK + (size_t)128 * 128 * 256, O_END = O_SCV + (size_t)128 * 128 * 256;

constexpr size_t MiB = 1u << 20;
constexpr size_t WS_CTL = 0, CTL_ZERO_BYTES = 1 * MiB;
constexpr size_t SZ_WIN = (size_t)INPROJ_P * 1024 * 2, SZ_WOUT = (size_t)1024 * 2048 * 2, SZ_WUP = (size_t)4096 * 1024 * 2, SZ_WDN = SZ_WUP, SZ_WQKV0 = (size_t)1536 * 1024 * 2, SZ_WQ1 = (size_t)1024 * 1024 * 2, SZ_WO = SZ_WQ1;
constexpr size_t WS_WIN = 1 * MiB, WS_WOUT = WS_WIN + 2 * SZ_WIN, WS_WUP = WS_WOUT + 2 * SZ_WOUT, WS_WDN = WS_WUP + 4 * SZ_WUP, WS_WQKV0 = WS_WDN + 4 * SZ_WDN, WS_WQ1 = WS_WQKV0 + SZ_WQKV0, WS_WO = WS_WQ1 + SZ_WQ1, WS_WEND = WS_WO + 2 * SZ_WO;
constexpr size_t al1m(size_t x) { return (x + MiB - 1) / MiB * MiB; }
constexpr size_t WS_H = al1m(WS_WEND), WS_HN = al1m(WS_H + (size_t)MP * 1024 * 4), WS_ZX = al1m(WS_HN + (size_t)MP * 1024 * 2), WS_DT = al1m(WS_ZX + (size_t)MP * ZXW * 2),
    WS_XC = al1m(WS_DT + (size_t)MP * 32 * 4), WS_YN = al1m(WS_XC + (size_t)MP * 4096 * 2), WS_CS = al1m(WS_YN + (size_t)MP * 2048 * 2), WS_CD = al1m(WS_CS + (size_t)129 * 32 * 8192 * 4), WS_SLAB = al1m(WS_CD + 129 * 32 * 4), WS_HSB = al1m(WS_SLAB + (size_t)8 * 1280 * 1024 * 4), WS_END = al1m(WS_HSB + (size_t)128 * 32 * 8192 * 2);
constexpr size_t WS_U = WS_ZX;
constexpr size_t WS_Q = WS_XC, WS_KV = WS_Q + (size_t)MP * 1024 * 2, WS_AO = WS_KV + (size_t)MP * 512 * 2;
static_assert(WS_AO + (size_t)MP * 1024 * 2 <= WS_YN, "attention overlay");
constexpr int CW_BAR = 4096;

constexpr int RING_BYTES = 131072, LDS_BYTES = 147456, LDSCTL_OFF = LDS_BYTES - 512, MISC_OFF = LDSCTL_OFF + 320;

typedef unsigned u32x2 __attribute__((ext_vector_type(2)));
typedef unsigned u32x4 __attribute__((ext_vector_type(4)));
__device__ __forceinline__ int ltid() { int t = threadIdx.x; asm volatile("" : "+v"(t)); return t; }
__device__ __forceinline__ float bf2f(unsigned short b) { return __uint_as_float((unsigned)b << 16); }
__device__ __forceinline__ float bflo(unsigned w) { return __uint_as_float(w << 16); }
__device__ __forceinline__ float bfhi(unsigned w) { return __uint_as_float(w & 0xffff0000u); }
__device__ __forceinline__ unsigned pkbf(float lo, float hi) { return pg8::cvt_pk_bf16(lo, hi); }
__device__ __forceinline__ float wave_sum(float v) {
#pragma unroll
    for (int o = 1; o < 64; o <<= 1) v += __shfl_xor(v, o);
    return v;
}
__device__ __forceinline__ float frcp(float x) { return __builtin_amdgcn_rcpf(x); }
__device__ __forceinline__ float sigmoid_f(float x) { return frcp(1.f + __expf(-x)); }
#define MFMA16(b, a, c) __builtin_amdgcn_mfma_f32_16x16x32_bf16((b), (a), (c), 0, 0, 0)

struct Args {
    const float* in[26]; float* out; unsigned char* ws; int ph_lo, ph_hi;
};
typedef const __attribute__((address_space(4))) Args* ArgsP;
enum { I_XP = 0, I_XS, I_SCONV, I_SSSM, I_CK, I_CV, I_META, I_ANORM, I_AIN, I_ACONVW, I_ACONVB, I_ADTB, I_ALOG, I_ADSKIP, I_AGATE, I_AOUT, I_KVNORM, I_WKV, I_BNORM, I_WQ, I_SINKS, I_WO, I_MLPNORM, I_WUP, I_WDOWN, I_FNORM };

__device__ __forceinline__ void transpose_item(const float* W, const float* scale, int K, int N, bf16* WT, int row_off, LAS unsigned* scr, int item, int lane) {
    const int nblk = (N + 63) / 64, kb = item / nblk, nb = item % nblk, k0 = 64 * kb, n0 = 64 * nb;
    const bool ok = (n0 + lane < N);
    const float* src = W + (size_t)k0 * N + n0 + (ok ? lane : 0);
    float v[64];
#pragma unroll
    for (int i = 0; i < 64; ++i) v[i] = __builtin_nontemporal_load(src + (size_t)i * N);
    if (!ok) {
#pragma unroll
        for (int i = 0; i < 64; ++i) v[i] = 0.f;
    }
    if (scale) {
#pragma unroll
        for (int i = 0; i < 64; ++i) v[i] *= scale[k0 + i];
    }
#pragma unroll
    for (int i = 0; i < 32; ++i) scr[lane * 33 + i] = pkbf(v[2 * i], v[2 * i + 1]);
    LDS_WAIT(); asm volatile("" ::: "memory");
    const int c = lane & 7;
#pragma unroll
    for (int j = 0; j < 8; ++j) { const int n = (lane >> 3) + 8 * j; const LAS unsigned* sp = scr + n * 33 + 4 * c;
        v4u o; o.x = sp[0]; o.y = sp[1]; o.z = sp[2]; o.w = sp[3];
        if (n0 + n < N) *(GAS v4u*)(WT + (size_t)(row_off + n0 + n) * K + k0 + 8 * c) = o; }
    LDS_WAIT(); asm volatile("" ::: "memory");
}
struct WJob { const float* W; const float* scale; int K, N; bf16* WT; int row_off; int items; };

__device__ __forceinline__ void phase_prologue(ArgsP a, LAS unsigned char* lds, int wave, int lane) {
    LAS unsigned* scr = (LAS unsigned*)(lds + wave * 16384);
    const int gw = blockIdx.x * NWAVES + wave, NGW = gridDim.x * NWAVES;
    unsigned char* ws = a->ws;
    for (int jb = 0; jb < 21; ++jb) {
        WJob J;
        if (jb < 2)       { const int i = jb;      J = WJob{a->in[I_AIN] + (size_t)i * 1024 * INPROJ, a->in[I_ANORM] + i * 1024, 1024, INPROJ, (bf16*)(ws + WS_WIN + i * SZ_WIN), 0, 0}; }
        else if (jb < 4)  { const int i = jb - 2;  J = WJob{a->in[I_AOUT] + (size_t)i * 2048 * 1024, a->in[I_AGATE] + i * 2048, 2048, 1024, (bf16*)(ws + WS_WOUT + i * SZ_WOUT), 0, 0}; }
        else if (jb < 8)  { const int l = jb - 4;  J = WJob{a->in[I_WUP] + (size_t)l * 1024 * 4096, a->in[I_MLPNORM] + l * 1024, 1024, 4096, (bf16*)(ws + WS_WUP + l * SZ_WUP), 0, 0}; }
        else if (jb < 12) { const int l = jb - 8;  J = WJob{a->in[I_WDOWN] + (size_t)l * 4096 * 1024, nullptr, 4096, 1024, (bf16*)(ws + WS_WDN + l * SZ_WDN), 0, 0}; }
        else if (jb == 12) { J = WJob{a->in[I_WQ], a->in[I_BNORM], 1024, 1024, (bf16*)(ws + WS_WQKV0), 0, 0}; }
        else if (jb == 13) { J = WJob{a->in[I_WKV], a->in[I_KVNORM], 1024, 512, (bf16*)(ws + WS_WQKV0), 1024, 0}; }
        else if (jb == 14) { J = WJob{a->in[I_WQ] + (size_t)1024 * 1024, a->in[I_BNORM] + 1024, 1024, 1024, (bf16*)(ws + WS_WQ1), 0, 0}; }
        else if (jb < 17) { const int j = jb - 15; J = WJob{a->in[I_WO] + (size_t)j * 1024 * 1024, nullptr, 1024, 1024, (bf16*)(ws + WS_WO + j * SZ_WO), 0, 0}; }
        else break;
        const int items = (J.K / 64) * ((J.N + 63) / 64);
        for (int it = gw; it < items; it += NGW) transpose_item(J.W, J.scale, J.K, J.N, J.WT, J.row_off, scr, it, lane);
    }
    {
        const int gt = blockIdx.x * NTHREADS + ltid(), NT = gridDim.x * NTHREADS;
        const int per = (INPROJ_P - INPROJ) * 1024 * 2 / 16;
        for (int e = gt; e < 2 * per; e += NT) { const int i = e / per, c = e % per;
            *(v4u*)(ws + WS_WIN + i * SZ_WIN + (size_t)INPROJ * 1024 * 2 + (size_t)c * 16) = (v4u){0u, 0u, 0u, 0u}; }
    }
}

__device__ __forceinline__ void norm_store(bf16* __restrict__ HN, int m, int lane, const f32x4 (&v)[4]) {
    float s = 0.f;
#pragma unroll
    for (int j = 0; j < 4; ++j) s += (v[j].x * v[j].x + v[j].y * v[j].y) + (v[j].z * v[j].z + v[j].w * v[j].w);
    const float rs = rsqrtf(wave_sum(s) * (1.f / DM) + EPS);
    unsigned long long* o8 = (unsigned long long*)(HN + (size_t)m * DM) + lane;
#pragma unroll
    for (int j = 0; j < 4; ++j) o8[64 * j] = (unsigned long long)pkbf(v[j].x * rs, v[j].y * rs) | ((unsigned long long)pkbf(v[j].z * rs, v[j].w * rs) << 32);
}
__device__ __forceinline__ void phase_norm(ArgsP a, int from_inputs, int nslab, int wave, int lane) {
    float* __restrict__ H = (float*)(a->ws + WS_H); bf16* __restrict__ HN = (bf16*)(a->ws + WS_HN); const float* __restrict__ SLAB = (const float*)(a->ws + WS_SLAB);
    const int gw = blockIdx.x * NWAVES + wave, NGW = gridDim.x * NWAVES;
    for (int m = ROW_S + gw; m < MP; m += NGW) {
        if (m >= NROWS) { unsigned long long* o8 = (unsigned long long*)(HN + (size_t)m * DM) + lane;
#pragma unroll
            for (int j = 0; j < 4; ++j) o8[64 * j] = 0ull;
            continue; }
        const float* src = from_inputs ? ((m < ROW_M) ? a->in[I_XS] + (size_t)(m - ROW_S) * DM : a->in[I_META] + (size_t)(m - ROW_M) * DM) : H + (size_t)m * DM;
        f32x4 v[4], sv[8][4];
#pragma unroll
        for (int j = 0; j < 4; ++j) v[j] = ((const f32x4*)src + lane)[64 * j];
#pragma unroll
        for (int sl = 0; sl < 8; ++sl)
#pragma unroll
            for (int j = 0; j < 4; ++j) { sv[sl][j] = (f32x4){0.f, 0.f, 0.f, 0.f}; if (sl < nslab) sv[sl][j] = __builtin_nontemporal_load((const f32x4*)(SLAB + (size_t)sl * (1280 * 1024) + (size_t)(m - ROW_S) * DM) + lane + 64 * j); }
#pragma unroll
        for (int sl = 0; sl < 8; ++sl)
#pragma unroll
            for (int j = 0; j < 4; ++j) v[j] = v[j] + sv[sl][j];
        if (nslab > 0 || from_inputs) { f32x4* hr = (f32x4*)(H + (size_t)m * DM) + lane;
#pragma unroll
            for (int j = 0; j < 4; ++j) hr[64 * j] = v[j]; }
        norm_store(HN, m, lane, v);
    }
    const float* __restrict__ P = from_inputs ? a->in[I_XP] : (const float*)H;
    for (int m0 = 2 * gw; m0 < ROW_S; m0 += 2 * NGW) {
        f32x4 v[2][4];
#pragma unroll
        for (int q = 0; q < 2; ++q)
#pragma unroll
            for (int j = 0; j < 4; ++j) v[q][j] = ((const f32x4*)(P + (size_t)(m0 + q) * DM) + lane)[64 * j];
#pragma unroll
        for (int q = 0; q < 2; ++q) norm_store(HN, m0 + q, lane, v[q]);
    }
}
__device__ __forceinline__ void phase_final(ArgsP a, int wave, int lane) {
    const float* H = (const float*)(a->ws + WS_H); const float* fw = a->in[I_FNORM]; const float* SLAB = (const float*)(a->ws + WS_SLAB);
    const int gw = blockIdx.x * NWAVES + wave, NGW = gridDim.x * NWAVES;
    f32x4 w[4];
#pragma unroll
    for (int j = 0; j < 4; ++j) w[j] = ((const f32x4*)fw)[lane + 64 * j];
    for (int m = gw; m < ROW_M; m += NGW) {
        const f32x4* xr = (const f32x4*)(H + (size_t)m * DM) + lane;
        f32x4 v[4]; float s = 0.f;
#pragma unroll
        for (int j = 0; j < 4; ++j) v[j] = __builtin_nontemporal_load(xr + 64 * j);
        if (m >= ROW_S) {
            for (int sl = 0; sl < 8; ++sl) { const f32x4* sr = (const f32x4*)(SLAB + (size_t)sl * (1280 * 1024) + (size_t)(m - ROW_S) * DM) + lane;
#pragma unroll
                for (int j = 0; j < 4; ++j) v[j] = v[j] + sr[64 * j]; }
        }
#pragma unroll
        for (int j = 0; j < 4; ++j) s += (v[j].x * v[j].x + v[j].y * v[j].y) + (v[j].z * v[j].z + v[j].w * v[j].w);
        const float rs = rsqrtf(wave_sum(s) * (1.f / DM) + EPS);
        f32x4* o = (f32x4*)(a->out + O_YP + (size_t)m * DM) + lane;
#pragma unroll
        for (int j = 0; j < 4; ++j) __builtin_nontemporal_store(v[j] * rs * w[j], o + 64 * j);
    }
}

__device__ __forceinline__ void unpack8(const u32x4 w, float (&f)[8]) { f[0] = bflo(w.x); f[1] = bfhi(w.x); f[2] = bflo(w.y); f[3] = bfhi(w.y); f[4] = bflo(w.z); f[5] = bfhi(w.z); f[6] = bflo(w.w); f[7] = bfhi(w.w); }
__device__ __forceinline__ void ld8f(const float* __restrict__ p, float (&f)[8]) { const f32x4 x0 = *(const f32x4*)p, x1 = *(const f32x4*)(p + 4); f[0]=x0.x;f[1]=x0.y;f[2]=x0.z;f[3]=x0.w;f[4]=x1.x;f[5]=x1.y;f[6]=x1.z;f[7]=x1.w; }
#define TSW(ch) ((((ch) >> 3) & 7) << 3)
struct ConvW { float w0[8], w1[8], w2[8], w3[8], bs[8]; };
__device__ __forceinline__ void conv_load_w(const float* __restrict__ cw, const float* __restrict__ cb, int c0, ConvW& W) { ld8f(cw + c0, W.w0); ld8f(cw + CONVD + c0, W.w1); ld8f(cw + 2 * CONVD + c0, W.w2); ld8f(cw + 3 * CONVD + c0, W.w3); ld8f(cb + c0, W.bs); }
__device__ __forceinline__ void conv_load_run(const bf16* __restrict__ ZX, int Rrow, int c0, int pk, bool valid, u32x4 (&raw)[11]) {
#pragma unroll
    for (int t = 0; t < 8; ++t) { raw[3 + t] = (u32x4){0u, 0u, 0u, 0u}; if (valid) raw[3 + t] = *(const u32x4*)(ZX + (size_t)(Rrow + t) * ZXW + 2048 + c0); }
#pragma unroll
    for (int t = 0; t < 3; ++t) { const int rr = (pk == 1) ? ROW_M + 13 + t : Rrow - 3 + t; raw[t] = (u32x4){0u, 0u, 0u, 0u}; if (valid && pk != 2) raw[t] = *(const u32x4*)(ZX + (size_t)rr * ZXW + 2048 + c0); }
}
template <int J> __device__ __forceinline__ void conv_channel(const u32x4 (&raw)[11], const ConvW& W, float (&o)[8]) {
    float x[11];
#pragma unroll
    for (int i = 0; i < 11; ++i) { const unsigned w = raw[i][J >> 1]; x[i] = (J & 1) ? bfhi(w) : bflo(w); }
#pragma unroll
    for (int t = 0; t < 8; ++t) { const float v = W.bs[J] + W.w0[J] * x[t] + W.w1[J] * x[t + 1] + W.w2[J] * x[t + 2] + W.w3[J] * x[t + 3]; o[t] = v * sigmoid_f(v); }
}
template <int J> __device__ __forceinline__ void conv_store_t(const u32x4 (&raw)[11], const ConvW& W, const float (&scale)[8], bf16* T, int ch0, int run) {
    float o[8]; conv_channel<J>(raw, W, o);
    u32x4 w; w.x = pkbf(o[0] * scale[0], o[1] * scale[1]); w.y = pkbf(o[2] * scale[2], o[3] * scale[3]); w.z = pkbf(o[4] * scale[4], o[5] * scale[5]); w.w = pkbf(o[6] * scale[6], o[7] * scale[7]);
    *(u32x4*)(T + (ch0 + J) * LDX + ((8 * run) ^ TSW(ch0 + J))) = w;
}
__device__ __forceinline__ void conv_item_t(const u32x4 (&raw)[11], const ConvW& W, const float (&scale)[8], bf16* T, int ch0, int run) {
    conv_store_t<0>(raw, W, scale, T, ch0, run); conv_store_t<1>(raw, W, scale, T, ch0, run); conv_store_t<2>(raw, W, scale, T, ch0, run); conv_store_t<3>(raw, W, scale, T, ch0, run);
    conv_store_t<4>(raw, W, scale, T, ch0, run); conv_store_t<5>(raw, W, scale, T, ch0, run); conv_store_t<6>(raw, W, scale, T, ch0, run); conv_store_t<7>(raw, W, scale, T, ch0, run);
}
__device__ __forceinline__ void conv_item_n(const u32x4 (&raw)[11], const ConvW& W, bf16* N, int run, int colel) {
    float p0[8], p1[8], p2[8]; unpack8(raw[0], p0); unpack8(raw[1], p1); unpack8(raw[2], p2);
#pragma unroll
    for (int t = 0; t < 8; ++t) { float x[8]; unpack8(raw[3 + t], x); float o[8];
#pragma unroll
        for (int j = 0; j < 8; ++j) { const float v = W.bs[j] + W.w0[j] * p0[j] + W.w1[j] * p1[j] + W.w2[j] * p2[j] + W.w3[j] * x[j]; o[j] = v * sigmoid_f(v); }
        u32x4 w; w.x = pkbf(o[0], o[1]); w.y = pkbf(o[2], o[3]); w.z = pkbf(o[4], o[5]); w.w = pkbf(o[6], o[7]);
        *(u32x4*)(N + (8 * run + t) * LDX + colel) = w;
#pragma unroll
        for (int j = 0; j < 8; ++j) { p0[j] = p1[j]; p1[j] = p2[j]; p2[j] = x[j]; } }
}
__device__ __forceinline__ void conv_state_out(const u32x4 (&raw)[11], float* __restrict__ dst  ) {
#pragma unroll
    for (int k = 0; k < 3; ++k) { float x[8]; unpack8(raw[8 + k], x); *(f32x4*)(dst + (size_t)k * CONVD) = (f32x4){x[0], x[1], x[2], x[3]}; *(f32x4*)(dst + (size_t)k * CONVD + 4) = (f32x4){x[4], x[5], x[6], x[7]}; }
}

__device__ __forceinline__ void ssd_acs(const float* DT, const float* alog, int R0, int len, int h0, float* s_dt, float* s_acs, int wave, int lane) {
    if (wave < 4) {
        const int r = wave; const float An = -__expf(alog[h0 + r]);
        const int l0 = 2 * lane;
        const float d0 = (l0 < len) ? DT[(size_t)(R0 + l0) * 32 + h0 + r] : 0.f;
        const float d1 = (l0 + 1 < len) ? DT[(size_t)(R0 + l0 + 1) * 32 + h0 + r] : 0.f;
        const float a0 = d0 * An, a1 = d1 * An, s = a0 + a1;
        float incl = s;
#pragma unroll
        for (int o = 1; o < 64; o <<= 1) { const float t = __shfl_up(incl, o); if (lane >= o) incl += t; }
        const float excl = incl - s;
        s_dt[r * 128 + l0] = d0; s_dt[r * 128 + l0 + 1] = d1;
        s_acs[r * 128 + l0] = excl + a0; s_acs[r * 128 + l0 + 1] = excl + s;
    }
}
#define LFRAG(base, row, ld, ks) (*(const bf16x8*)((base) + (row) * (ld) + 32 * (ks) + 8 * fq))

__device__ __forceinline__ void ssd1_unit(ArgsP a, int li, unsigned char* lds, int slot, int g, int R0, int len, int, int, int) {
    const int tid = ltid(), lane = tid & 63, wave = __builtin_amdgcn_readfirstlane(tid >> 6);
    const float* __restrict__ DT = (const float*)(a->ws + WS_DT);
    bf16* __restrict__ CS = (bf16*)(a->ws + WS_CS); float* __restrict__ CD = (float*)(a->ws + WS_CD);
    bf16* XsT = (bf16*)lds;
    bf16* BT = (bf16*)(lds + 256 * LDX * 2);
    float* s_dt = (float*)(lds + 384 * LDX * 2); float* s_acs = s_dt + 512;
    const int fr = lane & 15, fq = lane >> 4, h0 = g * 4;
    const float* __restrict__ cw = a->in[I_ACONVW] + (size_t)li * 4 * CONVD; const float* __restrict__ cbias = a->in[I_ACONVB] + (size_t)li * CONVD;
    const bf16* __restrict__ ZX = (const bf16*)(a->ws + WS_ZX);
    const bool meta = (slot == 128), chunk0 = (!meta && (slot & 63) == 0);
    const int xcb = tid & 31, xrun = tid >> 5, xc0 = g * 256 + xcb * 8;
    const int bcb = tid & 15, brun = (tid >> 4) & 15, bc0 = 2048 + g * 128 + bcb * 8;
    u32x4 rx[11], rb[11];
    conv_load_run(ZX, R0 + 8 * xrun, xc0, (xrun == 0) ? (meta ? 2 : (chunk0 ? 1 : 0)) : 0, 8 * xrun < len, rx);
    if (tid < 256) conv_load_run(ZX, R0 + 8 * brun, bc0, (brun == 0) ? (meta ? 2 : (chunk0 ? 1 : 0)) : 0, 8 * brun < len, rb);
    ssd_acs(DT, a->in[I_ALOG] + li * NHEADS, R0, len, h0, s_dt, s_acs, wave, lane);
    if (tid < 256) { ConvW W; conv_load_w(cw, cbias, bc0, W); const float one[8] = {1.f, 1.f, 1.f, 1.f, 1.f, 1.f, 1.f, 1.f}; conv_item_t(rb, W, one, BT, bcb * 8, brun); }
    __syncthreads();
    {   ConvW W; conv_load_w(cw, cbias, xc0, W);
        const int r = xcb >> 3; const float tot = s_acs[r * 128 + 127];
        const f32x4 a0 = *(const f32x4*)(s_acs + r * 128 + 8 * xrun), a1 = *(const f32x4*)(s_acs + r * 128 + 8 * xrun + 4), d0 = *(const f32x4*)(s_dt + r * 128 + 8 * xrun), d1 = *(const f32x4*)(s_dt + r * 128 + 8 * xrun + 4);
        float wl[8];
#pragma unroll
        for (int t = 0; t < 4; ++t) { wl[t] = __expf(tot - a0[t]) * d0[t]; wl[4 + t] = __expf(tot - a1[t]) * d1[t]; }
        conv_item_t(rx, W, wl, XsT, xcb * 8, xrun);
    }
    __syncthreads();
    f32x4 acc[2][8];
#pragma unroll
    for (int mi = 0; mi < 2; ++mi)
#pragma unroll
        for (int ni = 0; ni < 8; ++ni) acc[mi][ni] = (f32x4){0.f, 0.f, 0.f, 0.f};
#pragma unroll
    for (int ks = 0; ks < 4; ++ks) {
        const int ra0 = 32 * wave + fr, ra1 = ra0 + 16;
        const bf16x8 a0 = *(const bf16x8*)(XsT + ra0 * LDX + ((32 * ks + 8 * fq) ^ TSW(ra0))), a1 = *(const bf16x8*)(XsT + ra1 * LDX + ((32 * ks + 8 * fq) ^ TSW(ra1)));
#pragma unroll
        for (int ni = 0; ni < 8; ++ni) { const int rb = 16 * ni + fr; const bf16x8 bb = *(const bf16x8*)(BT + rb * LDX + ((32 * ks + 8 * fq) ^ TSW(rb)));
            acc[0][ni] = MFMA16(bb, a0, acc[0][ni]); acc[1][ni] = MFMA16(bb, a1, acc[1][ni]); }
    }
#pragma unroll
    for (int mi = 0; mi < 2; ++mi) { const int hp = 32 * wave + 16 * mi + fr, r = hp >> 6, p = hp & 63;
        bf16* dst = CS + ((size_t)(slot * 32 + h0 + r) * 64 + p) * 128 + 4 * fq;
#pragma unroll
        for (int ni = 0; ni < 8; ++ni) { u32x2 w; w.x = pkbf(acc[mi][ni][0], acc[mi][ni][1]); w.y = pkbf(acc[mi][ni][2], acc[mi][ni][3]); *(u32x2*)(dst + 16 * ni) = w; } }
    if (tid < 4) CD[slot * 32 + h0 + tid] = __expf(s_acs[tid * 128 + 127]);
    __syncthreads();
}

__device__ __forceinline__ void ssd_sample_issue(ArgsP a, int li, int b, int g, f32x4 (&st)[4][4]) {
    const int tid = ltid(), p = tid >> 3, nb = tid & 7;
    const float* __restrict__ sin_ = a->in[I_SSSM] + ((size_t)((li * NSAMP + b) * NHEADS + g * 4) * 64 + p) * 128 + 4 * nb;
#pragma unroll
    for (int r = 0; r < 4; ++r)
#pragma unroll
        for (int kk = 0; kk < 4; ++kk) st[r][kk] = __builtin_nontemporal_load((const f32x4*)(sin_ + (size_t)r * 8192 + 32 * kk));
}
__device__ __forceinline__ void ssd_sample_unit(ArgsP a, int li, unsigned char* lds, int b, int g, f32x4 (&st)[4][4]) {
    const int tid = ltid(), lane = tid & 63, wave = __builtin_amdgcn_readfirstlane(tid >> 6);
    const bf16* __restrict__ ZX = (const bf16*)(a->ws + WS_ZX); const float* __restrict__ DT = (const float*)(a->ws + WS_DT); bf16* __restrict__ YN = (bf16*)(a->ws + WS_YN);
    float* sX = (float*)lds; float* sB = sX + 8 * 256; float* sC = sB + 8 * 128; float* sY = sC + 8 * 128; float* sDt = sY + 8 * 256;
    const int R0 = ROW_S + b * 8, h0 = g * 4;
    const int p = tid >> 3, nb = tid & 7;
    float* __restrict__ sout = a->out + O_SSSM + ((size_t)((li * NSAMP + b) * NHEADS + h0) * 64 + p) * 128 + 4 * nb;
    {
        const float* __restrict__ cw = a->in[I_ACONVW] + (size_t)li * 4 * CONVD; const float* __restrict__ cbias = a->in[I_ACONVB] + (size_t)li * CONVD;
        const int t = tid >> 6, ck = tid & 63;
        const int c0 = (ck < 32) ? g * 256 + ck * 8 : (ck < 48) ? 2048 + g * 128 + (ck - 32) * 8 : 3072 + g * 128 + (ck - 48) * 8;
        float* dst = (ck < 32) ? sX + t * 256 + ck * 8 : (ck < 48) ? sB + t * 128 + (ck - 32) * 8 : sC + t * 128 + (ck - 48) * 8;
        const float* __restrict__ sc = a->in[I_SCONV] + ((size_t)(li * NSAMP + b) * 3) * CONVD + c0;
        float xr[4][8];
#pragma unroll
        for (int k = 0; k < 4; ++k) { const int tt = t - 3 + k;
            if (tt >= 0) unpack8(*(const u32x4*)(ZX + (size_t)(R0 + tt) * ZXW + 2048 + c0), xr[k]); else ld8f(sc + (size_t)(tt + 3) * CONVD, xr[k]); }
        ConvW W; conv_load_w(cw, cbias, c0, W);
        float o[8];
#pragma unroll
        for (int j = 0; j < 8; ++j) { const float v = W.bs[j] + W.w0[j] * xr[0][j] + W.w1[j] * xr[1][j] + W.w2[j] * xr[2][j] + W.w3[j] * xr[3][j]; o[j] = v * sigmoid_f(v); }
        *(f32x4*)dst = (f32x4){o[0], o[1], o[2], o[3]}; *(f32x4*)(dst + 4) = (f32x4){o[4], o[5], o[6], o[7]};
        if (t >= 5) { float* __restrict__ so = a->out + O_SCONV + ((size_t)(li * NSAMP + b) * 3 + (t - 5)) * CONVD + c0;
            *(f32x4*)so = (f32x4){xr[3][0], xr[3][1], xr[3][2], xr[3][3]}; *(f32x4*)(so + 4) = (f32x4){xr[3][4], xr[3][5], xr[3][6], xr[3][7]}; }
    }
    if (tid < 32) sDt[tid] = DT[(size_t)(R0 + (tid >> 2)) * 32 + h0 + (tid & 3)];
    __syncthreads();
    float An[4], Dk[4];
#pragma unroll
    for (int r = 0; r < 4; ++r) { An[r] = -__expf(a->in[I_ALOG][li * NHEADS + h0 + r]); Dk[r] = a->in[I_ADSKIP][li * NHEADS + h0 + r]; }
    float part[8][4];
#pragma unroll
    for (int t = 0; t < 8; ++t) {
        f32x4 bv[4], cv[4];
#pragma unroll
        for (int kk = 0; kk < 4; ++kk) { bv[kk] = *(const f32x4*)(sB + t * 128 + 32 * kk + 4 * nb); cv[kk] = *(const f32x4*)(sC + t * 128 + 32 * kk + 4 * nb); }
#pragma unroll
        for (int r = 0; r < 4; ++r) {
            const float dt = sDt[t * 4 + r], dA = __expf(dt * An[r]), xv = sX[t * 256 + r * 64 + p], coef = dt * xv;
            float pr = 0.f;
#pragma unroll
            for (int kk = 0; kk < 4; ++kk) { st[r][kk] = st[r][kk] * dA + bv[kk] * coef; pr += (cv[kk].x * st[r][kk].x + cv[kk].y * st[r][kk].y) + (cv[kk].z * st[r][kk].z + cv[kk].w * st[r][kk].w); }
            part[t][r] = pr;
        }
    }
#pragma unroll
    for (int r = 0; r < 4; ++r)
#pragma unroll
        for (int kk = 0; kk < 4; ++kk) __builtin_nontemporal_store(st[r][kk], (f32x4*)(sout + (size_t)r * 8192 + 32 * kk));
#pragma unroll
    for (int t = 0; t < 8; ++t)
#pragma unroll
        for (int r = 0; r < 4; ++r) { float v = part[t][r]; v += __shfl_xor(v, 1); v += __shfl_xor(v, 2); v += __shfl_xor(v, 4); part[t][r] = v; }
    if (nb == 0) {
#pragma unroll
        for (int t = 0; t < 8; ++t)
#pragma unroll
            for (int r = 0; r < 4; ++r) sY[t * 256 + r * 64 + p] = part[t][r] + Dk[r] * sX[t * 256 + r * 64 + p];
    }
    __syncthreads();
    {
        const int t = wave, c4 = lane * 4; const size_t row = (size_t)(R0 + t);
        const f32x4 y = *(const f32x4*)(sY + t * 256 + c4);
        const u32x2 zz = *(const u32x2*)(ZX + row * ZXW + g * 256 + c4);
        const float z0 = bflo(zz.x), z1 = bfhi(zz.x), z2 = bflo(zz.y), z3 = bfhi(zz.y);
        const float g0 = y.x * z0 * sigmoid_f(z0), g1 = y.y * z1 * sigmoid_f(z1), g2 = y.z * z2 * sigmoid_f(z2), g3 = y.w * z3 * sigmoid_f(z3);
        const float ss = wave_sum((g0 * g0 + g1 * g1) + (g2 * g2 + g3 * g3));
        const float rs = rsqrtf(ss * (1.f / 256.f) + EPS);
        u32x2 o; o.x = pkbf(g0 * rs, g1 * rs); o.y = pkbf(g2 * rs, g3 * rs);
        *(u32x2*)(YN + row * DINNER + g * 256 + c4) = o;
    }
    __syncthreads();
}

__device__ __forceinline__ void phase_scan(ArgsP a, int li) {
    const bf16* __restrict__ CS = (const bf16*)(a->ws + WS_CS); const float* __restrict__ CD = (const float*)(a->ws + WS_CD); bf16* __restrict__ HSB = (bf16*)(a->ws + WS_HSB);
    const int gt = blockIdx.x * NTHREADS + ltid(), NT = gridDim.x * NTHREADS;
    for (int e = gt; e < 2 * 65536; e += NT) {
        const int b = e >> 16, rem = e & 65535, h = rem >> 11, pn4 = rem & 2047;
        f32x4 hc; { const u32x2 w0 = *(const u32x2*)(CS + ((size_t)(128 * 32 + h) * 2048 + pn4) * 4); hc = (f32x4){bflo(w0.x), bfhi(w0.x), bflo(w0.y), bfhi(w0.y)}; }
#pragma unroll 1
        for (int c0 = 0; c0 < 64; c0 += 16) {
            u32x2 sw[16]; float dd[16];
#pragma unroll
            for (int k = 0; k < 16; ++k) { const int slot = b * 64 + c0 + k; sw[k] = __builtin_nontemporal_load((const u32x2*)(CS + ((size_t)(slot * 32 + h) * 2048 + pn4) * 4)); dd[k] = CD[slot * 32 + h]; }
#pragma unroll
            for (int k = 0; k < 16; ++k) { const int slot = b * 64 + c0 + k; const size_t o = ((size_t)(slot * 32 + h) * 2048 + pn4) * 4;
                const f32x4 sv = (f32x4){bflo(sw[k].x), bfhi(sw[k].x), bflo(sw[k].y), bfhi(sw[k].y)};
                u32x2 w; w.x = pkbf(hc.x, hc.y); w.y = pkbf(hc.z, hc.w); *(u32x2*)(HSB + o) = w;
                hc = hc * dd[k] + sv; }
        }
        __builtin_nontemporal_store(hc, (f32x4*)(a->out + O_PSSM + ((size_t)((li * NPROMPT + b) * NHEADS + h) * 2048 + pn4) * 4));
    }
}

__device__ __forceinline__ void ssd3_head(int r, int hb, const bf16* Cn, const bf16* BH, const bf16* Xt, const float* s_dt, const float* s_acs, const f32x4 (&cb)[8], f32x4 (&acc)[4],
                                          const bf16* __restrict__ ZX, size_t row, int g, float Dk, int l, int wave, int fr, int fq, float& ss) {
    u32x2 zz[4];
#pragma unroll
    for (int ni = 0; ni < 4; ++ni) { const int ch = g * 256 + r * 64 + 16 * ni + 4 * fq; zz[ni] = __builtin_nontemporal_load((const u32x2*)(ZX + row * ZXW + ch)); }
    const float al = s_acs[r * 128 + l];
#pragma unroll
    for (int ni = 0; ni < 4; ++ni) acc[ni] = (f32x4){0.f, 0.f, 0.f, 0.f};
    const bf16* Hs = BH + hb * 64 * LDX;
#pragma unroll
    for (int ks = 0; ks < 4; ++ks) { const bf16x8 af = LFRAG(Cn, l, LDX, ks);
#pragma unroll
        for (int ni = 0; ni < 4; ++ni) { const bf16x8 bb = LFRAG(Hs, 16 * ni + fr, LDX, ks); acc[ni] = MFMA16(bb, af, acc[ni]); } }
    const float e = __expf(al);
#pragma unroll
    for (int ni = 0; ni < 4; ++ni) acc[ni] = acc[ni] * e;
#pragma unroll
    for (int ks = 0; ks < 4; ++ks) if (2 * ks <= wave) {
        unsigned mw[4];
#pragma unroll
        for (int hf = 0; hf < 2; ++hf) { const int ni = 2 * ks + hf, s0 = 16 * ni + 4 * fq;
            const f32x4 av = *(const f32x4*)(s_acs + r * 128 + s0), dv = *(const f32x4*)(s_dt + r * 128 + s0);
            float m[4];
#pragma unroll
            for (int j = 0; j < 4; ++j) m[j] = (s0 + j <= l) ? cb[ni][j] * __expf(al - av[j]) * dv[j] : 0.f;
            mw[2 * hf] = pkbf(m[0], m[1]); mw[2 * hf + 1] = pkbf(m[2], m[3]); }
        const u32x4 afu = (u32x4){mw[0], mw[1], mw[2], mw[3]};
        const bf16x8 af = __builtin_bit_cast(bf16x8, afu);
#pragma unroll
        for (int ni = 0; ni < 4; ++ni) { const int chl = r * 64 + 16 * ni + fr, sw = TSW(chl);
            const u32x2 b0 = *(const u32x2*)(Xt + chl * LDX + ((32 * ks + 4 * fq) ^ sw)), b1 = *(const u32x2*)(Xt + chl * LDX + ((32 * ks + 16 + 4 * fq) ^ sw));
            const u32x4 bu = (u32x4){b0.x, b0.y, b1.x, b1.y};
            acc[ni] = MFMA16(__builtin_bit_cast(bf16x8, bu), af, acc[ni]); }
    }
#pragma unroll
    for (int ni = 0; ni < 4; ++ni) {
        float xv[4];
#pragma unroll
        for (int j = 0; j < 4; ++j) { const int chl = r * 64 + 16 * ni + 4 * fq + j; xv[j] = bf2f(Xt[chl * LDX + (l ^ TSW(chl))]); }
        const float zv[4] = {bflo(zz[ni].x), bfhi(zz[ni].x), bflo(zz[ni].y), bfhi(zz[ni].y)};
#pragma unroll
        for (int j = 0; j < 4; ++j) { const float q = (acc[ni][j] + Dk * xv[j]) * zv[j] * sigmoid_f(zv[j]); acc[ni][j] = q; ss += q * q; } }
}
__device__ __forceinline__ void ssd3_unit(ArgsP a, int li, unsigned char* lds, const bf16* __restrict__ hs, int slot, int g, int R0, int len, int, int, int) {
    const int tid = ltid(), lane = tid & 63, wave = __builtin_amdgcn_readfirstlane(tid >> 6);
    const bf16* __restrict__ ZX = (const bf16*)(a->ws + WS_ZX); const float* __restrict__ DT = (const float*)(a->ws + WS_DT); bf16* __restrict__ YN = (bf16*)(a->ws + WS_YN);
    bf16* Cn = (bf16*)lds; bf16* BH = Cn + 128 * LDX; bf16* Xt = BH + 128 * LDX;
    float* s_dt = (float*)(Xt + 256 * LDX); float* s_acs = s_dt + 512;
    const int fr = lane & 15, fq = lane >> 4, h0 = g * 4;
    {
        const float* __restrict__ cw = a->in[I_ACONVW] + (size_t)li * 4 * CONVD; const float* __restrict__ cbias = a->in[I_ACONVB] + (size_t)li * CONVD;
        const bool meta = (slot == 128), chunk0 = (!meta && (slot & 63) == 0);
        const int half = tid >> 8, ncb = tid & 15, nrun = (tid >> 4) & 15, nc0 = (half ? 2048 : 3072) + g * 128 + ncb * 8;
        const int xcb = tid & 31, xrun = tid >> 5, xc0 = g * 256 + xcb * 8;
        u32x4 rn[11], rx[11];
        conv_load_run(ZX, R0 + 8 * nrun, nc0, (nrun == 0) ? (meta ? 2 : (chunk0 ? 1 : 0)) : 0, 8 * nrun < len, rn);
        conv_load_run(ZX, R0 + 8 * xrun, xc0, (xrun == 0) ? (meta ? 2 : (chunk0 ? 1 : 0)) : 0, 8 * xrun < len, rx);
        ssd_acs(DT, a->in[I_ALOG] + li * NHEADS, R0, len, h0, s_dt, s_acs, wave, lane);
        { ConvW W; conv_load_w(cw, cbias, nc0, W); conv_item_n(rn, W, half ? BH : Cn, nrun, ncb * 8); }
        { ConvW W; conv_load_w(cw, cbias, xc0, W); const float one[8] = {1.f, 1.f, 1.f, 1.f, 1.f, 1.f, 1.f, 1.f}; conv_item_t(rx, W, one, Xt, xcb * 8, xrun); }
        if (!meta && (slot & 63) == 63) {
            float* __restrict__ dst = a->out + O_PCONV + (size_t)((li * NPROMPT + (slot >> 6)) * 3) * CONVD;
            if (nrun == 15) conv_state_out(rn, dst + nc0);
            if (xrun == 15) conv_state_out(rx, dst + xc0);
        }
    }
    __syncthreads();
    u32x2 hv[8];
#pragma unroll
    for (int k = 0; k < 8; ++k) { const int item = tid + NTHREADS * k; hv[k] = (u32x2){0u, 0u}; if (hs) hv[k] = __builtin_nontemporal_load((const u32x2*)(hs + (size_t)item * 4)); }
    const bool active = (16 * wave < len);
    f32x4 cb[8];
#pragma unroll
    for (int ni = 0; ni < 8; ++ni) cb[ni] = (f32x4){0.f, 0.f, 0.f, 0.f};
    if (active) {
#pragma unroll
    for (int ks = 0; ks < 4; ++ks) { const bf16x8 af = LFRAG(Cn, 16 * wave + fr, LDX, ks);
#pragma unroll
        for (int ni = 0; ni < 8; ++ni) { const bf16x8 bb = LFRAG(BH, 16 * ni + fr, LDX, ks); cb[ni] = MFMA16(bb, af, cb[ni]); } }
    }
    __syncthreads();
#pragma unroll
    for (int k = 0; k < 8; ++k) { const int item = tid + NTHREADS * k, hp = item >> 5, n4 = item & 31; *(u32x2*)(BH + hp * LDX + n4 * 4) = hv[k]; }
#pragma unroll
    for (int k = 0; k < 8; ++k) { const int item = tid + NTHREADS * k; hv[k] = (u32x2){0u, 0u}; if (hs) hv[k] = __builtin_nontemporal_load((const u32x2*)(hs + (size_t)(2 * 8192) + (size_t)item * 4)); }
    __syncthreads();
    const int l = 16 * wave + fr;
    const size_t row = (size_t)(R0 + ((l < len) ? l : 0));
    f32x4 y0[4], y1[4], y2[4], y3[4];
    float ss = 0.f;
    const float* dsk = a->in[I_ADSKIP] + li * NHEADS + h0;
    if (active) {
    ssd3_head(0, 0, Cn, BH, Xt, s_dt, s_acs, cb, y0, ZX, row, g, dsk[0], l, wave, fr, fq, ss);
    ssd3_head(1, 1, Cn, BH, Xt, s_dt, s_acs, cb, y1, ZX, row, g, dsk[1], l, wave, fr, fq, ss);
    }
    __syncthreads();
#pragma unroll
    for (int k = 0; k < 8; ++k) { const int item = tid + NTHREADS * k, hp = item >> 5, n4 = item & 31; *(u32x2*)(BH + hp * LDX + n4 * 4) = hv[k]; }
    __syncthreads();
    if (active) {
    ssd3_head(2, 0, Cn, BH, Xt, s_dt, s_acs, cb, y2, ZX, row, g, dsk[2], l, wave, fr, fq, ss);
    ssd3_head(3, 1, Cn, BH, Xt, s_dt, s_acs, cb, y3, ZX, row, g, dsk[3], l, wave, fr, fq, ss);
    ss += __shfl_xor(ss, 16); ss += __shfl_xor(ss, 32);
    }
    const float rs = rsqrtf(ss * (1.f / 256.f) + EPS);
    if (active && l < len) {
        bf16* yrow = YN + row * DINNER + g * 256 + 4 * fq;
#pragma unroll
        for (int ni = 0; ni < 4; ++ni) {
            u32x2 w;
            w.x = pkbf(y0[ni][0] * rs, y0[ni][1] * rs); w.y = pkbf(y0[ni][2] * rs, y0[ni][3] * rs); *(u32x2*)(yrow + 0 * 64 + 16 * ni) = w;
            w.x = pkbf(y1[ni][0] * rs, y1[ni][1] * rs); w.y = pkbf(y1[ni][2] * rs, y1[ni][3] * rs); *(u32x2*)(yrow + 1 * 64 + 16 * ni) = w;
            w.x = pkbf(y2[ni][0] * rs, y2[ni][1] * rs); w.y = pkbf(y2[ni][2] * rs, y2[ni][3] * rs); *(u32x2*)(yrow + 2 * 64 + 16 * ni) = w;
            w.x = pkbf(y3[ni][0] * rs, y3[ni][1] * rs); w.y = pkbf(y3[ni][2] * rs, y3[ni][3] * rs); *(u32x2*)(yrow + 3 * 64 + 16 * ni) = w;
        }
    }
    __syncthreads();
}
__device__ __forceinline__ void phase_ssd1(ArgsP a, int li, unsigned char* lds, int tid, int wave, int lane) {
    const int c = blockIdx.x;
#pragma unroll 1
    for (int j = 0; j < 4; ++j) {
        const int u = c + 256 * j;
        f32x4 st[4][4];
        ssd_sample_issue(a, li, u >> 3, u & 7, st);
#ifndef PROBE_SSD1
#define PROBE_SSD1 0
#endif
#pragma unroll 1
        for (int rp = 0; rp < (PROBE_SSD1 == 1 ? 2 : 1); ++rp) { const int slot = u >> 3, g = u & 7; ssd1_unit(a, li, lds, slot, g, (slot >> 6) * SEQ + (slot & 63) * 128, 128, tid, wave, lane); }
        ssd_sample_unit(a, li, lds, u >> 3, u & 7, st);
    }
    if (c < 8) ssd1_unit(a, li, lds, 128, c, ROW_M, NMETA, tid, wave, lane);
    else if (c < 16) ssd3_unit(a, li, lds, nullptr, 128, c - 8, ROW_M, NMETA, tid, wave, lane);
}
__device__ __forceinline__ void phase_ssd3(ArgsP a, int li, unsigned char* lds, int tid, int wave, int lane) {
    const bf16* HSB = (const bf16*)(a->ws + WS_HSB);
#pragma unroll 1
    for (int u = blockIdx.x; u < 1024; u += gridDim.x) { const int slot = u >> 3, g = u & 7; ssd3_unit(a, li, lds, HSB + (size_t)(slot * 32 + g * 4) * 8192, slot, g, (slot >> 6) * SEQ + (slot & 63) * 128, 128, tid, wave, lane); }
}

constexpr int KS_LD = 72, VT_LD = 264, P_LD = 232, NKEYS = 208;
__device__ __forceinline__ void attn_prompt_unit(ArgsP a, int lj, unsigned char* lds, int b, int kvh, int qb, int, int, int) {
    const int tid = ltid(), lane = tid & 63, wave = __builtin_amdgcn_readfirstlane(tid >> 6);
    const bf16* __restrict__ Q = (const bf16*)(a->ws + WS_Q); const bf16* __restrict__ KV = (const bf16*)(a->ws + WS_KV); bf16* __restrict__ AO = (bf16*)(a->ws + WS_AO);
    bf16* Ks = (bf16*)lds; bf16* Vt = Ks + NKEYS * KS_LD; bf16* Pw = Vt + 64 * VT_LD + wave * 16 * P_LD;
    const int fr = lane & 15, fq = lane >> 4, t0 = qb * 64, Rb = b * SEQ;
    const int r = wave >> 1, th = (wave & 1) * 32, qh = kvh * 4 + r;
    bf16x8 q0[2], q1[2];
#pragma unroll
    for (int ks = 0; ks < 2; ++ks) { q0[ks] = *(const bf16x8*)(Q + (size_t)(Rb + t0 + th + fr) * DM + qh * 64 + 32 * ks + 8 * fq); q1[ks] = *(const bf16x8*)(Q + (size_t)(Rb + t0 + th + 16 + fr) * DM + qh * 64 + 32 * ks + 8 * fq); }
    {
        u32x4 kv[4];
#pragma unroll
        for (int k = 0; k < 4; ++k) { const int it = tid + NTHREADS * k, key = it >> 3, ch = it & 7; kv[k] = (u32x4){0u, 0u, 0u, 0u};
            if (it < NKEYS * 8) { int row; if (key < 16) row = ROW_M + key; else { int s = t0 - 128 + key - 16; if (s < 0) s = 0; row = Rb + s; }
                kv[k] = *(const u32x4*)(KV + (size_t)row * KVW + kvh * 64 + ch * 8); } }
        u32x4 v0[2], v1[2];
#pragma unroll
        for (int k = 0; k < 2; ++k) { const int it = tid + NTHREADS * k, dbl = it & 7, kp = it >> 3; v0[k] = (u32x4){0u, 0u, 0u, 0u}; v1[k] = v0[k];
            if (it < (NKEYS / 2) * 8) { const int k0 = 2 * kp, k1 = k0 + 1; int s0 = t0 - 128 + k0 - 16, s1 = t0 - 128 + k1 - 16; if (s0 < 0) s0 = 0; if (s1 < 0) s1 = 0;
                const int r0 = (k0 < 16) ? ROW_M + k0 : Rb + s0, r1 = (k1 < 16) ? ROW_M + k1 : Rb + s1;
                v0[k] = *(const u32x4*)(KV + (size_t)r0 * KVW + 256 + kvh * 64 + dbl * 8); v1[k] = *(const u32x4*)(KV + (size_t)r1 * KVW + 256 + kvh * 64 + dbl * 8); } }
#pragma unroll
        for (int k = 0; k < 4; ++k) { const int it = tid + NTHREADS * k, key = it >> 3, ch = it & 7; if (it < NKEYS * 8) *(u32x4*)(Ks + key * KS_LD + ch * 8) = kv[k]; }
#pragma unroll
        for (int k = 0; k < 2; ++k) { const int it = tid + NTHREADS * k, dbl = it & 7, kp = it >> 3;
            if (it < (NKEYS / 2) * 8) { const int col = (2 * kp) ^ (8 * dbl);
                const unsigned a0[4] = {v0[k].x, v0[k].y, v0[k].z, v0[k].w}, a1[4] = {v1[k].x, v1[k].y, v1[k].z, v1[k].w};
#pragma unroll
                for (int j = 0; j < 4; ++j) {
                    *(unsigned*)(Vt + (dbl * 8 + 2 * j) * VT_LD + col) = (a0[j] & 0xffffu) | (a1[j] << 16);
                    *(unsigned*)(Vt + (dbl * 8 + 2 * j + 1) * VT_LD + col) = (a0[j] >> 16) | (a1[j] & 0xffff0000u); } } }
#pragma unroll
        for (int k = 0; k < 3; ++k) { const int idx = tid + NTHREADS * k, row = idx / 24, c = idx - row * 24; *(unsigned*)(Vt + row * VT_LD + ((NKEYS + 2 * c) ^ TSW(row))) = 0u; }
    }
    __syncthreads();
    const float sink = a->in[I_SINKS][lj * NQ + qh];
#pragma unroll 1
    for (int blk = 0; blk < 2; ++blk) {
        const int tq = th + blk * 16 + fr, t = t0 + tq;
        bf16x8 qa2[2];
#pragma unroll
        for (int ks = 0; ks < 2; ++ks) qa2[ks] = (blk == 0) ? q0[ks] : q1[ks];
        f32x4 sc[13];
#pragma unroll
        for (int ni = 0; ni < 13; ++ni) sc[ni] = (f32x4){0.f, 0.f, 0.f, 0.f};
#pragma unroll
        for (int ni = 0; ni < 13; ++ni) {
            const bf16x8 b0 = *(const bf16x8*)(Ks + (16 * ni + fr) * KS_LD + 8 * fq), b1 = *(const bf16x8*)(Ks + (16 * ni + fr) * KS_LD + 32 + 8 * fq);
            sc[ni] = MFMA16(b0, qa2[0], sc[ni]); sc[ni] = MFMA16(b1, qa2[1], sc[ni]);
            }
        int lo = tq + 17; { const int l2 = 144 - t0; if (l2 > lo) lo = l2; }
        const unsigned span = (unsigned)(tq + 144 - lo);
        float mx = -INFINITY;
#pragma unroll
        for (int ni = 0; ni < 13; ++ni)
#pragma unroll
            for (int j = 0; j < 4; ++j) { const int key = 16 * ni + 4 * fq + j; const bool vis = (ni == 0) || ((unsigned)(key - lo) <= span);
                const float v = vis ? sc[ni][j] * 0.125f : -INFINITY; sc[ni][j] = v; mx = fmaxf(mx, v); }
        mx = fmaxf(mx, __shfl_xor(mx, 16)); mx = fmaxf(mx, __shfl_xor(mx, 32)); mx = fmaxf(mx, sink);
        float sum = 0.f;
#pragma unroll
        for (int ni = 0; ni < 13; ++ni)
#pragma unroll
            for (int j = 0; j < 4; ++j) { const float p = __expf(sc[ni][j] - mx); sc[ni][j] = p; sum += p; }
        sum += __shfl_xor(sum, 16); sum += __shfl_xor(sum, 32); sum += __expf(sink - mx);
        const float inv = frcp(sum);
#pragma unroll
        for (int ni = 0; ni < 13; ++ni) { u32x2 w; w.x = pkbf(sc[ni][0] * inv, sc[ni][1] * inv); w.y = pkbf(sc[ni][2] * inv, sc[ni][3] * inv); *(u32x2*)(Pw + fr * P_LD + 16 * ni + 4 * fq) = w; }
        *(u32x2*)(Pw + fr * P_LD + NKEYS + 4 * fq) = (u32x2){0u, 0u};
        asm volatile("s_waitcnt lgkmcnt(0)" ::: "memory");
        f32x4 o[4];
#pragma unroll
        for (int ni = 0; ni < 4; ++ni) o[ni] = (f32x4){0.f, 0.f, 0.f, 0.f};
#pragma unroll
        for (int ks = 0; ks < 7; ++ks) { const bf16x8 af = *(const bf16x8*)(Pw + fr * P_LD + 32 * ks + 8 * fq);
#pragma unroll
            for (int ni = 0; ni < 4; ++ni) { const int vr = 16 * ni + fr; const bf16x8 bb = *(const bf16x8*)(Vt + vr * VT_LD + ((32 * ks + 8 * fq) ^ TSW(vr))); o[ni] = MFMA16(bb, af, o[ni]); }
            }
#pragma unroll
        for (int ni = 0; ni < 4; ++ni) { u32x2 w; w.x = pkbf(o[ni][0], o[ni][1]); w.y = pkbf(o[ni][2], o[ni][3]); *(u32x2*)(AO + (size_t)(Rb + t) * DM + qh * 64 + 16 * ni + 4 * fq) = w; }
        asm volatile("s_waitcnt lgkmcnt(0)" ::: "memory");
    }
    __syncthreads();
}
constexpr int SK_LD = 72, SV_LD = 200, SP_LD = 168, SKEYS = 160;
__device__ __forceinline__ void attn_sample_pair(ArgsP a, int lj, unsigned char* lds, int bp, int kvh, int, int, int) {
    const int tid = ltid(), lane = tid & 63, wave = __builtin_amdgcn_readfirstlane(tid >> 6);
    const bf16* __restrict__ Q = (const bf16*)(a->ws + WS_Q); const bf16* __restrict__ KV = (const bf16*)(a->ws + WS_KV); bf16* __restrict__ AO = (bf16*)(a->ws + WS_AO);
    const float* __restrict__ CK = a->in[I_CK]; const float* __restrict__ CV = a->in[I_CV];
    constexpr int HALF_B = (SKEYS * SK_LD + 64 * SV_LD) * 2;
    const int fr = lane & 15, fq = lane >> 4;
    {
        u32x4 r0[5], r1[5];
#pragma unroll
        for (int k = 0; k < 5; ++k) { const int it = tid + NTHREADS * k, hf = it / (SKEYS * 8), rem = it - hf * (SKEYS * 8), key = rem >> 3, ch = rem & 7, bb = 2 * bp + hf;
            r0[k] = (u32x4){0u, 0u, 0u, 0u}; r1[k] = r0[k];
            if (key < 16) r0[k] = *(const u32x4*)(KV + (size_t)(ROW_M + key) * KVW + kvh * 64 + ch * 8);
            else if (key < 144) { const float* p = CK + ((size_t)(bb * 128 + (key - 16)) * NKV + kvh) * 64 + ch * 8; r0[k] = __builtin_nontemporal_load((const u32x4*)p); r1[k] = __builtin_nontemporal_load((const u32x4*)(p + 4)); }
            else if (key < 152) r0[k] = *(const u32x4*)(KV + (size_t)(ROW_S + bb * 8 + (key - 144)) * KVW + kvh * 64 + ch * 8); }
#pragma unroll
        for (int k = 0; k < 5; ++k) { const int it = tid + NTHREADS * k, hf = it / (SKEYS * 8), rem = it - hf * (SKEYS * 8), key = rem >> 3, ch = rem & 7;
            bf16* Ks = (bf16*)(lds + hf * HALF_B);
            u32x4 w = r0[k];
            if (key >= 16 && key < 144) { w.x = pkbf(__uint_as_float(r0[k].x), __uint_as_float(r0[k].y)); w.y = pkbf(__uint_as_float(r0[k].z), __uint_as_float(r0[k].w)); w.z = pkbf(__uint_as_float(r1[k].x), __uint_as_float(r1[k].y)); w.w = pkbf(__uint_as_float(r1[k].z), __uint_as_float(r1[k].w)); }
            *(u32x4*)(Ks + key * SK_LD + ch * 8) = w; }
    }
    {
        u32x4 x0[3], x1[3], y0[3], y1[3];
#pragma unroll
        for (int k = 0; k < 3; ++k) { const int it = tid + NTHREADS * k, hf = it / (96 * 8), rem = it - hf * (96 * 8), dbl = rem & 7, kp = rem >> 3, bb = 2 * bp + hf, k0 = 2 * kp;
            x0[k] = (u32x4){0u, 0u, 0u, 0u}; x1[k] = x0[k]; y0[k] = x0[k]; y1[k] = x0[k];
            if (k0 < 16) { x0[k] = *(const u32x4*)(KV + (size_t)(ROW_M + k0) * KVW + 256 + kvh * 64 + dbl * 8); y0[k] = *(const u32x4*)(KV + (size_t)(ROW_M + k0 + 1) * KVW + 256 + kvh * 64 + dbl * 8); }
            else if (k0 < 144) { const float* p = CV + ((size_t)(bb * 128 + (k0 - 16)) * NKV + kvh) * 64 + dbl * 8;
                x0[k] = __builtin_nontemporal_load((const u32x4*)p); x1[k] = __builtin_nontemporal_load((const u32x4*)(p + 4)); y0[k] = __builtin_nontemporal_load((const u32x4*)(p + NKV * 64)); y1[k] = __builtin_nontemporal_load((const u32x4*)(p + NKV * 64 + 4)); }
            else if (k0 < 152) { x0[k] = *(const u32x4*)(KV + (size_t)(ROW_S + bb * 8 + (k0 - 144)) * KVW + 256 + kvh * 64 + dbl * 8); y0[k] = *(const u32x4*)(KV + (size_t)(ROW_S + bb * 8 + (k0 - 143)) * KVW + 256 + kvh * 64 + dbl * 8); } }
#pragma unroll
        for (int k = 0; k < 3; ++k) { const int it = tid + NTHREADS * k, hf = it / (96 * 8), rem = it - hf * (96 * 8), dbl = rem & 7, kp = rem >> 3, k0 = 2 * kp;
            bf16* Vt = (bf16*)(lds + hf * HALF_B) + SKEYS * SK_LD;
            unsigned a0[4] = {x0[k].x, x0[k].y, x0[k].z, x0[k].w}, a1[4] = {y0[k].x, y0[k].y, y0[k].z, y0[k].w};
            if (k0 >= 16 && k0 < 144) {
                a0[0] = pkbf(__uint_as_float(x0[k].x), __uint_as_float(x0[k].y)); a0[1] = pkbf(__uint_as_float(x0[k].z), __uint_as_float(x0[k].w)); a0[2] = pkbf(__uint_as_float(x1[k].x), __uint_as_float(x1[k].y)); a0[3] = pkbf(__uint_as_float(x1[k].z), __uint_as_float(x1[k].w));
                a1[0] = pkbf(__uint_as_float(y0[k].x), __uint_as_float(y0[k].y)); a1[1] = pkbf(__uint_as_float(y0[k].z), __uint_as_float(y0[k].w)); a1[2] = pkbf(__uint_as_float(y1[k].x), __uint_as_float(y1[k].y)); a1[3] = pkbf(__uint_as_float(y1[k].z), __uint_as_float(y1[k].w)); }
            const int col = (2 * kp) ^ (8 * dbl);
#pragma unroll
            for (int j = 0; j < 4; ++j) {
                *(unsigned*)(Vt + (dbl * 8 + 2 * j) * SV_LD + col) = (a0[j] & 0xffffu) | (a1[j] << 16);
                *(unsigned*)(Vt + (dbl * 8 + 2 * j + 1) * SV_LD + col) = (a0[j] >> 16) | (a1[j] & 0xffff0000u); } }
    }
    if (lj == 0) {
        u32x4 kx[8], vx[8];
#pragma unroll
        for (int k = 0; k < 8; ++k) { const int it = tid + NTHREADS * k, hf = it >> 11, rem = it & 2047, w = rem >> 4, c4 = (rem & 15) * 4, bb = 2 * bp + hf;
            if (w < 120) { const size_t i = ((size_t)(bb * 128 + w + 8) * NKV + kvh) * 64 + c4; kx[k] = __builtin_nontemporal_load((const u32x4*)(CK + i)); vx[k] = __builtin_nontemporal_load((const u32x4*)(CV + i)); }
            else { const bf16* rp = KV + (size_t)(ROW_S + bb * 8 + (w - 120)) * KVW + kvh * 64 + c4; const u32x2 k2 = *(const u32x2*)rp, v2 = *(const u32x2*)(rp + 256);
                kx[k] = (u32x4){k2.x << 16, k2.x & 0xffff0000u, k2.y << 16, k2.y & 0xffff0000u}; vx[k] = (u32x4){v2.x << 16, v2.x & 0xffff0000u, v2.y << 16, v2.y & 0xffff0000u}; } }
#pragma unroll
        for (int k = 0; k < 8; ++k) { const int it = tid + NTHREADS * k, hf = it >> 11, rem = it & 2047, w = rem >> 4, c4 = (rem & 15) * 4, bb = 2 * bp + hf;
            const size_t o = ((size_t)(bb * 128 + w) * NKV + kvh) * 64 + c4;
            __builtin_nontemporal_store(kx[k], (u32x4*)(a->out + O_SCK + o)); __builtin_nontemporal_store(vx[k], (u32x4*)(a->out + O_SCV + o)); }
    }
    __syncthreads();
    if (wave < 4) {
        const int hf = wave >> 1, rb = wave & 1, bb = 2 * bp + hf;
        const bf16* Ks = (const bf16*)(lds + hf * HALF_B); const bf16* Vt = Ks + SKEYS * SK_LD; bf16* Pw = (bf16*)(lds + 2 * HALF_B) + wave * 16 * SP_LD;
        const int r = 2 * rb + (fr >> 3), t = fr & 7, qh = kvh * 4 + r;
        const size_t qrow = (size_t)(ROW_S + bb * 8 + t);
        bf16x8 qa[2];
        if (lj == 0) {
#pragma unroll
            for (int ks = 0; ks < 2; ++ks) qa[ks] = *(const bf16x8*)(Q + qrow * DM + qh * 64 + 32 * ks + 8 * fq);
        } else {
            const float* __restrict__ SL = (const float*)(a->ws + WS_SLAB) + (size_t)(qrow - ROW_S) * DM + qh * 64 + 8 * fq;
#pragma unroll
            for (int ks = 0; ks < 2; ++ks) { f32x4 x0 = (f32x4){0.f, 0.f, 0.f, 0.f}, x1 = x0;
#pragma unroll
                for (int sl = 0; sl < 4; ++sl) { const float* p = SL + (size_t)sl * (1280 * 1024) + 32 * ks; x0 = x0 + *(const f32x4*)p; x1 = x1 + *(const f32x4*)(p + 4); }
                const u32x4 w = (u32x4){pkbf(x0.x, x0.y), pkbf(x0.z, x0.w), pkbf(x1.x, x1.y), pkbf(x1.z, x1.w)}; qa[ks] = __builtin_bit_cast(bf16x8, w); }
        }
        const float sink = a->in[I_SINKS][lj * NQ + qh];
        f32x4 sc[10];
#pragma unroll
        for (int ni = 0; ni < 10; ++ni) sc[ni] = (f32x4){0.f, 0.f, 0.f, 0.f};
#pragma unroll
        for (int ni = 0; ni < 10; ++ni) {
            const bf16x8 b0 = *(const bf16x8*)(Ks + (16 * ni + fr) * SK_LD + 8 * fq), b1 = *(const bf16x8*)(Ks + (16 * ni + fr) * SK_LD + 32 + 8 * fq);
            sc[ni] = MFMA16(b0, qa[0], sc[ni]); sc[ni] = MFMA16(b1, qa[1], sc[ni]); }
        float mx = -INFINITY;
#pragma unroll
        for (int ni = 0; ni < 10; ++ni)
#pragma unroll
            for (int j = 0; j < 4; ++j) { const int key = 16 * ni + 4 * fq + j;
                const bool vis = (ni == 0) || ((key < 144) ? (key - 16 > t) : (key - 144 <= t));
                const float v = vis ? sc[ni][j] * 0.125f : -INFINITY; sc[ni][j] = v; mx = fmaxf(mx, v); }
        mx = fmaxf(mx, __shfl_xor(mx, 16)); mx = fmaxf(mx, __shfl_xor(mx, 32)); mx = fmaxf(mx, sink);
        float sum = 0.f;
#pragma unroll
        for (int ni = 0; ni < 10; ++ni)
#pragma unroll
            for (int j = 0; j < 4; ++j) { const float p = __expf(sc[ni][j] - mx); sc[ni][j] = p; sum += p; }
        sum += __shfl_xor(sum, 16); sum += __shfl_xor(sum, 32); sum += __expf(sink - mx);
        const float inv = frcp(sum);
#pragma unroll
        for (int ni = 0; ni < 10; ++ni) { u32x2 w; w.x = pkbf(sc[ni][0] * inv, sc[ni][1] * inv); w.y = pkbf(sc[ni][2] * inv, sc[ni][3] * inv); *(u32x2*)(Pw + fr * SP_LD + 16 * ni + 4 * fq) = w; }
        asm volatile("s_waitcnt lgkmcnt(0)" ::: "memory");
        f32x4 o[4];
#pragma unroll
        for (int ni = 0; ni < 4; ++ni) o[ni] = (f32x4){0.f, 0.f, 0.f, 0.f};
#pragma unroll
        for (int ks = 0; ks < 5; ++ks) { const bf16x8 af = *(const bf16x8*)(Pw + fr * SP_LD + 32 * ks + 8 * fq);
#pragma unroll
            for (int ni = 0; ni < 4; ++ni) { const int vr = 16 * ni + fr; const bf16x8 bb2 = *(const bf16x8*)(Vt + vr * SV_LD + ((32 * ks + 8 * fq) ^ TSW(vr))); o[ni] = MFMA16(bb2, af, o[ni]); } }
#pragma unroll
        for (int ni = 0; ni < 4; ++ni) { u32x2 w; w.x = pkbf(o[ni][0], o[ni][1]); w.y = pkbf(o[ni][2], o[ni][3]); *(u32x2*)(AO + qrow * DM + qh * 64 + 16 * ni + 4 * fq) = w; }
    }
    __syncthreads();
}
__device__ __forceinline__ void phase_attn(ArgsP a, int lj, unsigned char* lds, int tid, int wave, int lane) {
    if (lj == 0) {
        const bf16* KV = (const bf16*)(a->ws + WS_KV);
        const int gt = blockIdx.x * NTHREADS + tid, NT = gridDim.x * NTHREADS;
        for (int e = gt; e < 2 * 128 * 512; e += NT) { const int b = e >> 16, w = (e >> 9) & 127, c = e & 511;
            const float v = bf2f(KV[(size_t)(b * SEQ + SEQ - 128 + w) * KVW + c]);
            if (c < 256) a->out[O_PCK + (size_t)(b * 128 + w) * 256 + c] = v; else a->out[O_PCV + (size_t)(b * 128 + w) * 256 + (c - 256)] = v; }
    }
    const int xg = blockIdx.x & 7, xi = blockIdx.x >> 3;
#pragma unroll 1
    for (int j = 0; j < 4; ++j) { const int u = 128 * xg + 4 * xi + j, qb = u & 127, kvh = (u >> 7) & 3, b = u >> 9; attn_prompt_unit(a, lj, lds, b, kvh, qb, tid, wave, lane); }
    { const int su = blockIdx.x; attn_sample_pair(a, lj, lds, su >> 2, su & 3, tid, wave, lane); }
}

constexpr int PH_B = 9 * 2, PH_F = PH_B + 7 * 2, NPHASES = PH_F + 1;
template <class Epi> __device__ __forceinline__ void run_gemm(LAS unsigned char* lds, const bf16* A, const bf16* Bt, int N, int K, const Epi& E) {
    pg8::Gemm g{A, Bt, MP, N, K}; pg8::StaticOrder S; S.init(MP, N, K, (int)gridDim.x, (int)blockIdx.x);
    pg8::gemm_phase<Epi, pg8::StaticOrder, true, true>(lds, g, S, E);
}
template <class Epi> __device__ __forceinline__ void run_gemm_res(LAS unsigned char* lds, const bf16* A, const bf16* Bt, int K, int S_, const Epi& E) {
    pg8::Gemm g{A, Bt, MP, 1024, K}; pg8::ResOrder S; S.init(K, S_, (int)gridDim.x, (int)blockIdx.x);
    pg8::gemm_phase<Epi, pg8::ResOrder, true, true>(lds, g, S, E);
}

__global__ void __launch_bounds__(NTHREADS, 2) yoco_fwd(Args args) {
    extern __shared__ __attribute__((aligned(16))) unsigned char lds[];
    LAS unsigned char* ldsl = (LAS unsigned char*)lds;
    const int tid0 = threadIdx.x;
    for (int u = tid0; u < (LDS_BYTES - LDSCTL_OFF) / 4; u += NTHREADS) ((LAS unsigned*)(ldsl + LDSCTL_OFF))[u] = 0u;
    __syncthreads();
    const int lo = args.ph_lo, hi = args.ph_hi;
    XcdBarrier bar; bar.bar = (unsigned*)(args.ws + WS_CTL) + CW_BAR; bar.x = 0; bar.st = nullptr;
    if (hi - lo > 1) bar = xcd_barrier_post((unsigned*)(args.ws + WS_CTL) + CW_BAR, (volatile LAS unsigned*)(ldsl + MISC_OFF) + 8);
    int rep = 0;
#pragma unroll 1
    for (int p = lo; p < hi;) {
        ArgsP la = (ArgsP)__builtin_amdgcn_kernarg_segment_ptr(); asm volatile("" : "+s"(la));
        unsigned char* ws = la->ws;
        const int tid = ltid();
        const int lane = tid & 63, wave = __builtin_amdgcn_readfirstlane(tid >> 6);
        bf16* HN = (bf16*)(ws + WS_HN); float* H = (float*)(ws + WS_H);
        int kind, li = 0, lj = 0, layer = 0;
        int nslab = 8;
        if (p == 0) kind = 0;
        else if (p < PH_B) { li = p / 9; layer = li; const int sub = p % 9;
            kind = (sub == 0) ? 1 : (sub == 1) ? 3 : (sub == 2) ? 5 : (sub == 3) ? 6 : (sub == 4) ? 7 : (sub == 5) ? 8 : (sub == 6) ? 1 : (sub == 7) ? 9 : 10; }
        else if (p < PH_F) { lj = (p - PH_B) / 7; layer = 2 + lj; const int sub = (p - PH_B) % 7;
            kind = (sub == 0) ? 1 : (sub == 1) ? 11 : (sub == 2) ? 12 : (sub == 3) ? 13 : (sub == 4) ? 1 : (sub == 5) ? 9 : 10; if (sub == 4) nslab = 4; }
        else kind = 14;
#ifndef KMASK
#define KMASK 0xffff
#endif
#define KON(k) ((KMASK >> (k)) & 1)
#ifndef REP_MASK
#define REP_MASK 0
#endif
        if (KON(0) && kind == 0) { phase_prologue(la, ldsl, wave, lane); phase_norm(la, 1, 0, wave, lane); }
        else if (KON(1) && kind == 1) phase_norm(la, 0, nslab, wave, lane);
        else if (KON(3) && kind == 3) { pg8::EpiInProj E{(bf16*)(ws + WS_ZX), (float*)(ws + WS_DT), la->in[I_ADTB] + li * NHEADS}; run_gemm(ldsl, HN, (const bf16*)(ws + WS_WIN + li * SZ_WIN), INPROJ_P, 1024, E); }
        else if (KON(5) && kind == 5) phase_ssd1(la, li, lds, tid, wave, lane);
        else if (KON(6) && kind == 6) phase_scan(la, li);
        else if (KON(7) && kind == 7) phase_ssd3(la, li, lds, tid, wave, lane);
        else if (KON(8) && (kind == 8 || kind == 10 || kind == 13)) {
            const bf16* A; const bf16* Bt; int K;
            if (kind == 8) { A = (const bf16*)(ws + WS_YN); Bt = (const bf16*)(ws + WS_WOUT + li * SZ_WOUT); K = 2048; }
            else if (kind == 10) { A = (const bf16*)(ws + WS_U); Bt = (const bf16*)(ws + WS_WDN + layer * SZ_WDN); K = 4096; }
            else { A = (const bf16*)(ws + WS_AO); Bt = (const bf16*)(ws + WS_WO + lj * SZ_WO); K = 1024; }
            pg8::EpiRes E{(kind == 8 && li == 0) ? la->in[I_XP] : (const float*)H, H, (float*)(ws + WS_SLAB)}; run_gemm_res(ldsl, A, Bt, K, K == 1024 ? 4 : 8, E); }
        else if (KON(9) && kind == 9) { pg8::EpiBf<1> E{(bf16*)(ws + WS_U), 4096, 1 << 20, nullptr, 0}; run_gemm(ldsl, HN, (const bf16*)(ws + WS_WUP + layer * SZ_WUP), 4096, 1024, E); }
        else if (KON(11) && kind == 11) { pg8::EpiBf<0> E{(bf16*)(ws + WS_Q), 1024, 4, (bf16*)(ws + WS_KV), KVW};
            if (lj == 0) run_gemm(ldsl, HN, (const bf16*)(ws + WS_WQKV0), 1536, 1024, E);
            else { pg8::EpiQSplit E2{(bf16*)(ws + WS_Q), (float*)(ws + WS_SLAB)}; run_gemm_res(ldsl, HN, (const bf16*)(ws + WS_WQ1), 1024, 4, E2); } }
        else if (KON(12) && kind == 12) phase_attn(la, lj, lds, tid, wave, lane);
        else if (KON(14) && kind == 14) phase_final(la, wave, lane);
        bool again = false;
        if (REP_MASK != 0) { if (rep == 0 && ((REP_MASK >> kind) & 1)) { rep = 1; again = true; } else rep = 0; }
#ifdef PROBE_DOUBLE_BARRIER
        if (p + 1 < hi || again) xcd_barrier(bar);
#endif
        if (p + 1 < hi || again) xcd_barrier(bar); else { asm volatile("s_waitcnt vmcnt(0)" ::: "memory"); __syncthreads(); }
        if (!again) ++p;
    }
}

#ifndef MK_PER_PHASE
#define MK_PER_PHASE 0
#endif
extern "C" void kernel_launch(void* const* d_in, const int* in_sizes, int n_in, void* d_out, int out_size, void* d_ws, size_t ws_size, hipStream_t stream) {
    static int grid = 0;
    if (grid == 0) {
        if (n_in != 26 || (size_t)out_size != O_END || ws_size < WS_END) { fprintf(stderr, "kernel_launch: unexpected problem (n_in %d, out %d vs %zu, ws %zu vs %zu); nothing launched\n", n_in, out_size, (size_t)O_END, ws_size, (size_t)WS_END); grid = -1; return; }
        int dev = 0, cus = 0, per_cu = 0;
        if (hipGetDevice(&dev) != hipSuccess || hipDeviceGetAttribute(&cus, hipDeviceAttributeMultiprocessorCount, dev) != hipSuccess) { grid = -1; return; }
        if (hipFuncSetAttribute((const void*)yoco_fwd, hipFuncAttributeMaxDynamicSharedMemorySize, LDS_BYTES) != hipSuccess) { fprintf(stderr, "kernel_launch: hipFuncSetAttribute failed\n"); grid = -1; return; }
        if (hipOccupancyMaxActiveBlocksPerMultiprocessor(&per_cu, (const void*)yoco_fwd, NTHREADS, LDS_BYTES) != hipSuccess || per_cu < 1) { fprintf(stderr, "kernel_launch: occupancy query says %d\n", per_cu); per_cu = 1; }
        (void)hipGetLastError();
        if (cus != 256) { fprintf(stderr, "kernel_launch: built for a 256-CU device (got %d); nothing launched\n", cus); grid = -1; return; }
        grid = cus;
    }
    if (grid < 0) return;
    if (hipMemsetAsync((char*)d_ws + WS_CTL, 0, CTL_ZERO_BYTES, stream) != hipSuccess) { fprintf(stderr, "kernel_launch: memset failed\n"); return; }
    Args a{};
    for (int i = 0; i < 26; ++i) a.in[i] = (const float*)d_in[i];
    a.out = (float*)d_out; a.ws = (unsigned char*)d_ws;
#if MK_PER_PHASE
    for (int p = 0; p < NPHASES; ++p) { a.ph_lo = p; a.ph_hi = p + 1; hipLaunchKernelGGL(yoco_fwd, dim3(grid), dim3(NTHREADS), LDS_BYTES, stream, a); }
#else
    a.ph_lo = 0; a.ph_hi = NPHASES;
    void* kargs[] = {&a};
    hipError_t e = hipLaunchCooperativeKernel((const void*)yoco_fwd, dim3(grid), dim3(NTHREADS), kargs, LDS_BYTES, stream);
    if (e != hipSuccess) fprintf(stderr, "kernel_launch: cooperative launch failed: %s (grid %d)\n", hipGetErrorString(e), grid);
#endif
}
```

```cpp
#include <hip/hip_runtime.h>
#include <cstdio>
#include <cstdint>
#include <cmath>
namespace pg8 {
#define PG8_LAS __attribute__((address_space(3)))
typedef unsigned short bf16_t;
typedef short bf16x8 __attribute__((ext_vector_type(8)));
typedef float f32x4 __attribute__((ext_vector_type(4)));
typedef unsigned u32x4 __attribute__((ext_vector_type(4)));
constexpr int BM = 256, BK = 64, HALF = 128, HTB = HALF * BK * 2  , STAGE_BYTES = 8 * HTB, NXCD = 8, WGM = 8;

__host__ __device__ __forceinline__ int lds_byte(int r, int c) { const int st = (r >> 4) * 2 + (c >> 5), rr = r & 15, cc = c & 31, ob = rr * 64 + cc * 2; return st * 1024 + (ob ^ (((ob >> 9) & 1) << 5)); }
__host__ __device__ __forceinline__ void stage_rc(int b, int& R, int& C) { const int st = b / 1024, sb = b % 1024, swz = sb ^ (((sb >> 9) & 1) << 5); R = (st >> 1) * 16 + swz / 64; C = (st & 1) * 32 + (swz % 64) / 2; }
__host__ __device__ __forceinline__ int perm32(int rho) { const int n = rho >> 4, i = rho & 15; return 8 * (i >> 2) + 4 * n + (i & 3); }

struct Unit { int pm, pn, k0, nt, aux; };
struct Gemm { const bf16_t* A; const bf16_t* Bt; int M, N, K; };

struct StaticOrder {
    int nM, nN, nwg, G, c, nt0;
    __host__ __device__ void init(int M, int N, int K, int G_, int c_) { nM = M / BM; nN = N / BM; nwg = nM * nN; G = G_; c = c_; nt0 = K / BK; }
    __host__ __device__ bool next(int i, Unit& u) const {
        const long L = (long)i * G + c; if (L >= nwg) return false;
        int wgid = (int)L; { const int q = nwg / NXCD, r = nwg % NXCD, xcd = wgid % NXCD, off = wgid / NXCD; wgid = (xcd < r ? xcd * (q + 1) : r * (q + 1) + (xcd - r) * q) + off; }
        const int nig = WGM * nN, gid = wgid / nig, fm = gid * WGM, gsz = (nM - fm) < WGM ? (nM - fm) : WGM;
        u.pm = fm + ((wgid % nig) % gsz); u.pn = (wgid % nig) / gsz; u.k0 = 0; u.nt = nt0; u.aux = -1; return true;
    }
    __device__ __forceinline__ void a_ready(const Unit&) const {}
    __device__ __forceinline__ void done(const Unit&) const {}
};
struct ResOrder {
    StaticOrder so; int S, K, c;
    __host__ __device__ void init(int K_, int S_, int G_, int c_) { so.init(64 * BM, 1024, K_, G_, c_); S = S_; K = K_; c = c_; }
    __host__ __device__ bool next(int i, Unit& u) const {
        if (i == 0) return so.next(0, u);
        if (i == 1 && c < 20 * S) { const int t = c / S, sl = c - t * S; u.pm = 64 + (t >> 2); u.pn = t & 3; u.k0 = sl * (K / S); u.nt = K / S / BK; u.aux = sl; return true; }
        return false;
    }
    __device__ __forceinline__ void a_ready(const Unit&) const {}
    __device__ __forceinline__ void done(const Unit&) const {}
};

typedef float f32x2_cv0 __attribute__((ext_vector_type(2))); typedef __bf16 bf16x2_cv0 __attribute__((ext_vector_type(2)));
__device__ __forceinline__ unsigned cvt_pk_bf16(float lo, float hi) { const f32x2_cv0 v = {lo, hi}; const bf16x2_cv0 b = __builtin_convertvector(v, bf16x2_cv0); return __builtin_bit_cast(unsigned, b); }
typedef float f32x2 __attribute__((ext_vector_type(2)));
typedef unsigned u32x2 __attribute__((ext_vector_type(2)));
__device__ __forceinline__ float softplus_f(float x) { const float y = __expf(-fabsf(x)); const float l = (y < 0.03125f) ? y * (1.f - y * (0.5f - y * (1.f / 3.f - 0.25f * y))) : __logf(1.f + y); return fmaxf(x, 0.f) + l; }
struct EpiInProj {
    static constexpr bool PERM = true, AFTER_DRAIN = false;
    bf16_t* ZX; float* DT; const float* dt_bias;
    __device__ __forceinline__ void operator()(const f32x4 (&acc)[2][2][4][2], const Unit& u, int wr, int wc, int fr, int fq) const {
        const int row0 = u.pm * BM + wr * 64 + fr;
        if (u.pn < 24) {
            const int col0 = u.pn * BM + wc * 32 + 8 * fq;
#pragma unroll
            for (int ai = 0; ai < 2; ++ai)
#pragma unroll
                for (int m = 0; m < 4; ++m) { bf16_t* rowp = ZX + (size_t)(row0 + ai * HALF + m * 16) * 6144 + col0;
#pragma unroll
                    for (int bj = 0; bj < 2; ++bj) { const f32x4 v0 = acc[ai][bj][m][0], v1 = acc[ai][bj][m][1];
                        u32x4 w; w.x = cvt_pk_bf16(v0[0], v0[1]); w.y = cvt_pk_bf16(v0[2], v0[3]); w.z = cvt_pk_bf16(v1[0], v1[1]); w.w = cvt_pk_bf16(v1[2], v1[3]);
                        *(u32x4*)(rowp + bj * HALF) = w; } }
        } else if (wc == 0) {
            const int c0 = 8 * fq;
            const f32x4 b0 = *(const f32x4*)(dt_bias + c0), b1 = *(const f32x4*)(dt_bias + c0 + 4);
#pragma unroll
            for (int ai = 0; ai < 2; ++ai)
#pragma unroll
                for (int m = 0; m < 4; ++m) { float* rowp = DT + (size_t)(row0 + ai * HALF + m * 16) * 32 + c0;
                    const f32x4 v0 = acc[ai][0][m][0] + b0, v1 = acc[ai][0][m][1] + b1;
                    f32x4 o0, o1;
#pragma unroll
                    for (int j = 0; j < 4; ++j) { o0[j] = softplus_f(v0[j]); o1[j] = softplus_f(v1[j]); }
                    *(f32x4*)(rowp) = o0; *(f32x4*)(rowp + 4) = o1; }
        }
    }
};
struct EpiRes {
    static constexpr bool PERM = true, AFTER_DRAIN = false;
    const float* X; bf16_t* H; float* SLAB;
    __device__ __forceinline__ void operator()(const f32x4 (&acc)[2][2][4][2], const Unit& u, int wr, int wc, int fr, int fq) const {
        const int row0 = u.pm * BM + wr * 64 + fr, col0 = u.pn * BM + wc * 32 + 8 * fq;
        if (u.aux >= 0) {
            float* base = SLAB + (size_t)u.aux * (1280 * 1024) + (size_t)(row0 - 16384) * 1024 + col0;
#pragma unroll
            for (int ai = 0; ai < 2; ++ai)
#pragma unroll
                for (int m = 0; m < 4; ++m) { float* rowp = base + (size_t)(ai * HALF + m * 16) * 1024;
#pragma unroll
                    for (int bj = 0; bj < 2; ++bj) { *(f32x4*)(rowp + bj * HALF) = acc[ai][bj][m][0]; *(f32x4*)(rowp + bj * HALF + 4) = acc[ai][bj][m][1]; } }
            return;
        }
#pragma unroll
        for (int ai = 0; ai < 2; ++ai) {
            f32x4 r0[4][2], r1[4][2];
            if (X) {
#pragma unroll
                for (int m = 0; m < 4; ++m)
#pragma unroll
                    for (int bj = 0; bj < 2; ++bj) { const float* p = X + (size_t)(row0 + ai * HALF + m * 16) * 1024 + col0 + bj * HALF; r0[m][bj] = *(const f32x4*)p; r1[m][bj] = *(const f32x4*)(p + 4); }
            } else {
                u32x4 hb[4][2];
#pragma unroll
                for (int m = 0; m < 4; ++m)
#pragma unroll
                    for (int bj = 0; bj < 2; ++bj) hb[m][bj] = *(const u32x4*)(H + (size_t)(row0 + ai * HALF + m * 16) * 1024 + col0 + bj * HALF);
#pragma unroll
                for (int m = 0; m < 4; ++m)
#pragma unroll
                    for (int bj = 0; bj < 2; ++bj) { const u32x4 w = hb[m][bj];
                        r0[m][bj] = (f32x4){__uint_as_float(w.x << 16), __uint_as_float(w.x & 0xffff0000u), __uint_as_float(w.y << 16), __uint_as_float(w.y & 0xffff0000u)};
                        r1[m][bj] = (f32x4){__uint_as_float(w.z << 16), __uint_as_float(w.z & 0xffff0000u), __uint_as_float(w.w << 16), __uint_as_float(w.w & 0xffff0000u)}; }
            }
#pragma unroll
            for (int m = 0; m < 4; ++m)
#pragma unroll
                for (int bj = 0; bj < 2; ++bj) { const f32x4 v0 = r0[m][bj] + acc[ai][bj][m][0], v1 = r1[m][bj] + acc[ai][bj][m][1];
                    u32x4 w; w.x = cvt_pk_bf16(v0[0], v0[1]); w.y = cvt_pk_bf16(v0[2], v0[3]); w.z = cvt_pk_bf16(v1[0], v1[1]); w.w = cvt_pk_bf16(v1[2], v1[3]);
                    *(u32x4*)(H + (size_t)(row0 + ai * HALF + m * 16) * 1024 + col0 + bj * HALF) = w; }
        }
    }
};
template <int ACT> struct EpiBf {
    static constexpr bool PERM = true, AFTER_DRAIN = false;
    bf16_t* O0; int ldc0; int nsplit; bf16_t* O1; int ldc1;
    __device__ __forceinline__ void operator()(const f32x4 (&acc)[2][2][4][2], const Unit& u, int wr, int wc, int fr, int fq) const {
        const int row0 = u.pm * BM + wr * 64 + fr;
        bf16_t* base; int ldc, colt;
        if (u.pn < nsplit) { base = O0; ldc = ldc0; colt = u.pn * BM; } else { base = O1; ldc = ldc1; colt = (u.pn - nsplit) * BM; }
        const int col0 = colt + wc * 32 + 8 * fq;
#pragma unroll
        for (int ai = 0; ai < 2; ++ai)
#pragma unroll
            for (int m = 0; m < 4; ++m) { bf16_t* rowp = base + (size_t)(row0 + ai * HALF + m * 16) * ldc + col0;
#pragma unroll
                for (int bj = 0; bj < 2; ++bj) { f32x4 v0 = acc[ai][bj][m][0], v1 = acc[ai][bj][m][1];
                    if (ACT == 1) {
#pragma unroll
                        for (int j = 0; j < 4; ++j) { const float a = fmaxf(v0[j], 0.f), b = fmaxf(v1[j], 0.f); v0[j] = a * a; v1[j] = b * b; } }
                    u32x4 w; w.x = cvt_pk_bf16(v0[0], v0[1]); w.y = cvt_pk_bf16(v0[2], v0[3]); w.z = cvt_pk_bf16(v1[0], v1[1]); w.w = cvt_pk_bf16(v1[2], v1[3]);
                    *(u32x4*)(rowp + bj * HALF) = w; } }
    }
};
struct EpiQSplit {
    static constexpr bool PERM = true, AFTER_DRAIN = false;
    bf16_t* Q; float* SLAB;
    __device__ __forceinline__ void operator()(const f32x4 (&acc)[2][2][4][2], const Unit& u, int wr, int wc, int fr, int fq) const {
        const int row0 = u.pm * BM + wr * 64 + fr, col0 = u.pn * BM + wc * 32 + 8 * fq;
        if (u.aux >= 0) {
            float* base = SLAB + (size_t)u.aux * (1280 * 1024) + (size_t)(row0 - 16384) * 1024 + col0;
#pragma unroll
            for (int ai = 0; ai < 2; ++ai)
#pragma unroll
                for (int m = 0; m < 4; ++m) { float* rowp = base + (size_t)(ai * HALF + m * 16) * 1024;
#pragma unroll
                    for (int bj = 0; bj < 2; ++bj) { *(f32x4*)(rowp + bj * HALF) = acc[ai][bj][m][0]; *(f32x4*)(rowp + bj * HALF + 4) = acc[ai][bj][m][1]; } }
            return;
        }
#pragma unroll
        for (int ai = 0; ai < 2; ++ai)
#pragma unroll
            for (int m = 0; m < 4; ++m) { bf16_t* rowp = Q + (size_t)(row0 + ai * HALF + m * 16) * 1024 + col0;
#pragma unroll
                for (int bj = 0; bj < 2; ++bj) { const f32x4 v0 = acc[ai][bj][m][0], v1 = acc[ai][bj][m][1];
                    u32x4 w; w.x = cvt_pk_bf16(v0[0], v0[1]); w.y = cvt_pk_bf16(v0[2], v0[3]); w.z = cvt_pk_bf16(v1[0], v1[1]); w.w = cvt_pk_bf16(v1[2], v1[3]);
                    *(u32x4*)(rowp + bj * HALF) = w; } }
    }
};

template <class Epi, class Sched, bool ALIGN_EPI = false, bool SP2 = false>
__device__ __forceinline__ void gemm_phase(PG8_LAS unsigned char* lds, const Gemm g, const Sched& S, const Epi& E) {
    int tid_l = threadIdx.x; asm volatile("" : "+v"(tid_l));
    const int tid = tid_l, wid = __builtin_amdgcn_readfirstlane(tid >> 6), lane = tid & 63, wr = wid >> 2, wc = wid & 3, fr = lane & 15, fq = lane >> 4;
    const int K = g.K;
    unsigned voffA[2], voffB[2];
#pragma unroll
    for (int i = 0; i < 2; ++i) { int R, C; stage_rc(tid * 16 + i * 8192, R, C); const int Rb = Epi::PERM ? ((R & ~31) + perm32(R & 31)) : R;
        voffA[i] = (unsigned)(R * K + C) * 2u; voffB[i] = (unsigned)(Rb * K + C) * 2u; }
    const size_t kstep = (size_t)(BK * 2);
    const size_t hstep = (size_t)HALF * K * 2;
    const size_t tstep = 2 * hstep;
    const unsigned ldsw = (unsigned)wid * 1024u;
    const int aoff = lds_byte(wr * 64 + fr, fq * 8), boff = lds_byte(wc * 32 + fr, fq * 8);
#define PG8_SA(b, h) (((b) * 2 + (h)) * HTB)
#define PG8_SB(b, h) ((4 + (b) * 2 + (h)) * HTB)
#define PG8_STAGE(bufoff, gbase, voff) do { _Pragma("unroll") for (int _i = 0; _i < 2; ++_i) \
        __builtin_amdgcn_global_load_lds((const unsigned*)((const char*)(gbase) + (voff)[_i]), (PG8_LAS unsigned*)(lds + (bufoff) + ldsw + _i * 8192), 16, 0, 0); } while (0)
#define PG8_LDA(dst, b, h) do { _Pragma("unroll") for (int m = 0; m < 4; ++m) _Pragma("unroll") for (int k = 0; k < 2; ++k) dst[m][k] = *(const PG8_LAS bf16x8*)(lds + PG8_SA(b, h) + aoff + m * 2048 + k * 1024); } while (0)
#define PG8_LDB(dst, b, h) do { _Pragma("unroll") for (int n = 0; n < 2; ++n) _Pragma("unroll") for (int k = 0; k < 2; ++k) dst[n][k] = *(const PG8_LAS bf16x8*)(lds + PG8_SB(b, h) + boff + n * 2048 + k * 1024); } while (0)
#define PG8_MMA(ai, bj, At, Bt) do { __builtin_amdgcn_s_setprio(1); _Pragma("unroll") for (int m = 0; m < 4; ++m) _Pragma("unroll") for (int n = 0; n < 2; ++n) _Pragma("unroll") for (int k = 0; k < 2; ++k) \
        acc[ai][bj][m][n] = __builtin_amdgcn_mfma_f32_16x16x32_bf16(Bt[n][k], At[m][k], acc[ai][bj][m][n], 0, 0, 0); __builtin_amdgcn_s_setprio(0); } while (0)
#define PG8_WAIT_V(n) asm volatile("s_waitcnt vmcnt(" #n ")" ::: "memory")
#define PG8_WAIT_L(n) asm volatile("s_waitcnt lgkmcnt(" #n ")" ::: "memory")
#define PG8_BAR __builtin_amdgcn_s_barrier()
#define PG8_SCHED __builtin_amdgcn_sched_barrier(0)
    Unit cur, nxt; int ui = 0;
    if (!S.next(0, cur)) return;
    f32x4 acc[2][2][4][2];
#pragma unroll
    for (int a = 0; a < 2; ++a)
#pragma unroll
        for (int b = 0; b < 2; ++b)
#pragma unroll
            for (int m = 0; m < 4; ++m)
#pragma unroll
                for (int n = 0; n < 2; ++n) acc[a][b][m][n] = (f32x4){0.f, 0.f, 0.f, 0.f};
    bf16x8 At[4][2], B0[2][2], B1[2][2];
    const char* cA = (const char*)g.A + (size_t)cur.pm * tstep + (size_t)cur.k0 * 2; const char* cB = (const char*)g.Bt + (size_t)cur.pn * tstep + (size_t)cur.k0 * 2;
    S.a_ready(cur);
    if constexpr (SP2) {
        PG8_STAGE(PG8_SB(0, 0), cB, voffB); PG8_STAGE(PG8_SB(0, 1), cB + hstep, voffB); PG8_STAGE(PG8_SA(0, 0), cA, voffA); PG8_STAGE(PG8_SA(0, 1), cA + hstep, voffA);
        if (wr == 1) PG8_BAR;
        PG8_WAIT_V(2); PG8_BAR;
        PG8_STAGE(PG8_SB(1, 0), cB + kstep, voffB); PG8_STAGE(PG8_SA(1, 0), cA + kstep, voffA); PG8_STAGE(PG8_SB(1, 1), cB + hstep + kstep, voffB);
        PG8_WAIT_V(6); PG8_BAR;
    } else {
        PG8_STAGE(PG8_SB(0, 0), cB, voffB); PG8_STAGE(PG8_SA(0, 0), cA, voffA); PG8_STAGE(PG8_SB(0, 1), cB + hstep, voffB); PG8_STAGE(PG8_SA(0, 1), cA + hstep, voffA);
        if (wr == 1) PG8_BAR;
        PG8_WAIT_V(4); PG8_BAR;
        PG8_STAGE(PG8_SB(1, 0), cB + kstep, voffB); PG8_STAGE(PG8_SA(1, 0), cA + kstep, voffA); PG8_STAGE(PG8_SB(1, 1), cB + hstep + kstep, voffB);
        PG8_WAIT_V(6); PG8_BAR;
    }
    for (;;) {
        const bool has_next = S.next(ui + 1, nxt);
        const char* nA = has_next ? (const char*)g.A + (size_t)nxt.pm * tstep + (size_t)nxt.k0 * 2 : cA; const char* nB = has_next ? (const char*)g.Bt + (size_t)nxt.pn * tstep + (size_t)nxt.k0 * 2 : cB;
        const int nt = cur.nt;
        for (int t = 0; t < nt; t += 2) {
            const bool last = (t == nt - 2);
            const char* a1 = cA + (size_t)(t + 1) * kstep;
            const char* a2 = last ? nA : cA + (size_t)(t + 2) * kstep; const char* b2 = last ? nB : cB + (size_t)(t + 2) * kstep;
            const char* a3 = a2 + kstep; const char* b3 = b2 + kstep;
            if (last && has_next) S.a_ready(nxt);
            if constexpr (SP2) {
            PG8_LDB(B0, 0, 0); PG8_LDB(B1, 0, 1); PG8_SCHED; PG8_LDA(At, 0, 0); PG8_STAGE(PG8_SA(1, 1), a1 + hstep, voffA);
            PG8_WAIT_V(8); PG8_WAIT_L(0); PG8_BAR; PG8_MMA(0, 0, At, B0); PG8_MMA(0, 1, At, B1); PG8_BAR; PG8_SCHED;
            PG8_LDA(At, 0, 1); PG8_STAGE(PG8_SB(0, 0), b2, voffB); PG8_STAGE(PG8_SB(0, 1), b2 + hstep, voffB); PG8_STAGE(PG8_SA(0, 0), a2, voffA);
            PG8_WAIT_V(8); PG8_WAIT_L(0); PG8_BAR; PG8_MMA(1, 0, At, B0); PG8_MMA(1, 1, At, B1); PG8_BAR; PG8_SCHED;
            PG8_LDB(B0, 1, 0); PG8_LDB(B1, 1, 1); PG8_SCHED; PG8_LDA(At, 1, 0); PG8_STAGE(PG8_SA(0, 1), a2 + hstep, voffA);
            PG8_WAIT_V(8); PG8_WAIT_L(0); PG8_BAR; PG8_MMA(0, 0, At, B0); PG8_MMA(0, 1, At, B1); PG8_BAR; PG8_SCHED;
            PG8_LDA(At, 1, 1); PG8_STAGE(PG8_SB(1, 0), b3, voffB); PG8_STAGE(PG8_SB(1, 1), b3 + hstep, voffB); PG8_STAGE(PG8_SA(1, 0), a3, voffA);
            PG8_WAIT_V(8); PG8_WAIT_L(0); PG8_BAR; PG8_MMA(1, 0, At, B0); PG8_MMA(1, 1, At, B1); PG8_BAR; PG8_SCHED;
            } else {
            PG8_LDB(B0, 0, 0); PG8_SCHED; PG8_LDA(At, 0, 0); PG8_STAGE(PG8_SA(1, 1), a1 + hstep, voffA);
            PG8_WAIT_L(8); PG8_BAR; PG8_WAIT_L(0); PG8_MMA(0, 0, At, B0); PG8_BAR; PG8_SCHED;
            PG8_LDB(B1, 0, 1); PG8_STAGE(PG8_SB(0, 0), b2, voffB);
            PG8_BAR; PG8_WAIT_L(0); PG8_MMA(0, 1, At, B1); PG8_BAR;
            PG8_LDA(At, 0, 1); PG8_STAGE(PG8_SA(0, 0), a2, voffA);
            PG8_BAR; PG8_WAIT_L(0); PG8_MMA(1, 0, At, B0); PG8_BAR; PG8_SCHED;
            PG8_STAGE(PG8_SB(0, 1), b2 + hstep, voffB);
            PG8_WAIT_V(6); PG8_BAR; PG8_MMA(1, 1, At, B1); PG8_BAR;
            PG8_LDB(B0, 1, 0); PG8_SCHED; PG8_LDA(At, 1, 0); PG8_STAGE(PG8_SA(0, 1), a2 + hstep, voffA);
            PG8_WAIT_L(8); PG8_BAR; PG8_WAIT_L(0); PG8_MMA(0, 0, At, B0); PG8_BAR; PG8_SCHED;
            PG8_LDB(B1, 1, 1); PG8_STAGE(PG8_SB(1, 0), b3, voffB);
            PG8_BAR; PG8_WAIT_L(0); PG8_MMA(0, 1, At, B1); PG8_BAR;
            PG8_LDA(At, 1, 1); PG8_STAGE(PG8_SA(1, 0), a3, voffA);
            PG8_BAR; PG8_WAIT_L(0); PG8_MMA(1, 0, At, B0); PG8_BAR; PG8_SCHED;
            PG8_STAGE(PG8_SB(1, 1), b3 + hstep, voffB);
            PG8_WAIT_V(6); PG8_BAR; PG8_MMA(1, 1, At, B1); PG8_BAR;
            }
        }
        if constexpr (ALIGN_EPI) { if (wr == 0) PG8_BAR; }
        if constexpr (!Epi::AFTER_DRAIN) { E(acc, cur, wr, wc, fr, fq); S.done(cur); }
        if (!has_next) break;
#pragma unroll
        for (int a = 0; a < 2; ++a)
#pragma unroll
            for (int b = 0; b < 2; ++b)
#pragma unroll
                for (int m = 0; m < 4; ++m)
#pragma unroll
                    for (int n = 0; n < 2; ++n) acc[a][b][m][n] = (f32x4){0.f, 0.f, 0.f, 0.f};
        cur = nxt; cA = nA; cB = nB; ++ui;
        if constexpr (ALIGN_EPI) { if (wr == 1) PG8_BAR; }
    }
    PG8_WAIT_V(0);
    if constexpr (!ALIGN_EPI) { if (wr == 0) PG8_BAR; }
    PG8_BAR;
    if constexpr (Epi::AFTER_DRAIN) { E.fused(acc, cur, wr, wc, fr, fq, lds, wid, lane); S.done(cur); }
#undef PG8_SA
#undef PG8_SB
#undef PG8_STAGE
#undef PG8_LDA
#undef PG8_LDB
#undef PG8_MMA
#undef PG8_WAIT_V
#undef PG8_WAIT_L
#undef PG8_BAR
#undef PG8_SCHED
}
}
#define GAS __attribute__((address_space(1)))
#define LAS __attribute__((address_space(3)))
typedef unsigned short bf16;
typedef unsigned v4u __attribute__((ext_vector_type(4)));
typedef float f32x4 __attribute__((ext_vector_type(4)));
typedef short bf16x8 __attribute__((ext_vector_type(8)));
typedef GAS unsigned gu32;
typedef GAS unsigned long long gu64;
#define RLX_AGENT __ATOMIC_RELAXED, __HIP_MEMORY_SCOPE_AGENT
#define LDS_WAIT() asm volatile("s_waitcnt lgkmcnt(0)" ::: "memory")
#define VM_WAIT() asm volatile("s_waitcnt vmcnt(0)" ::: "memory")
__device__ __forceinline__ unsigned long long rt() { return __builtin_amdgcn_s_memrealtime(); }
__device__ __forceinline__ unsigned f2bf(float f) { unsigned u = __builtin_bit_cast(unsigned, f); return (u + 0x7fffu + ((u >> 16) & 1u)) >> 16; }
__device__ __forceinline__ unsigned pk2(float lo, float hi) { return f2bf(lo) | (f2bf(hi) << 16); }

#define XB_TMO      128
#define XB_XCNT(j)  (256  + 64 * (j))
#define XB_XSUB(j)  (1280 + 64 * (j))
#define XB_XGEN(j)  (2304 + 64 * (j))
#define XB_TOP      3328
#define XB_TOPGEN   3392
#define XCD_BAR_WORDS 3456
#define XB_SPIN_CAP (1u << 18)

__device__ __forceinline__ unsigned xb_ld(unsigned* p)              { return __hip_atomic_load(p, __ATOMIC_RELAXED, __HIP_MEMORY_SCOPE_AGENT); }
__device__ __forceinline__ unsigned xb_add(unsigned* p, unsigned v) { return __hip_atomic_fetch_add(p, v, __ATOMIC_RELAXED, __HIP_MEMORY_SCOPE_AGENT); }
__device__ __forceinline__ unsigned xb_xcc_id() { return (unsigned)__builtin_amdgcn_s_getreg((3 << 11) | 20) & 0xFu; }
#define XB_SPIN(cond, bar) do { unsigned _sp = 0; while (cond) { __builtin_amdgcn_s_sleep(1); \
    if ((++_sp & 255u) == 0u) { if (xb_ld(&(bar)[XB_TMO])) break; if (_sp > XB_SPIN_CAP) { atomicAdd(&(bar)[XB_TMO], 1u); break; } } } } while (0)

struct XcdBarrier {
    unsigned* bar; unsigned x;
    volatile LAS unsigned* st;
};

__device__ __forceinline__ XcdBarrier xcd_barrier_post(unsigned* bar, volatile LAS unsigned* st) {
    XcdBarrier b; b.bar = bar; b.x = xb_xcc_id(); b.st = st;
    if (threadIdx.x == 0) (void)xb_add(&bar[XB_XCNT(b.x)], 1u);
    return b;
}
__device__ __forceinline__ void xcd_barrier_complete(unsigned* bar, unsigned x, unsigned& nloc, unsigned& nx) {
    const unsigned G = gridDim.x * gridDim.y * gridDim.z;
    unsigned sum, cnt, mine, sp = 0u;
    for (;;) {
        sum = 0u; cnt = 0u; mine = 0u;
#pragma unroll
        for (unsigned j = 0; j < 16; ++j) { const unsigned c = xb_ld(&bar[XB_XCNT(j)]); sum += c; cnt += (c > 0u) ? 1u : 0u; mine = (j == x) ? c : mine; }
        if (sum == G) break;
        __builtin_amdgcn_s_sleep(1);
        if ((++sp & 255u) == 0u) { if (xb_ld(&bar[XB_TMO])) break; if (sp > XB_SPIN_CAP) { atomicAdd(&bar[XB_TMO], 1u); break; } }
    }
    nloc = mine > 0u ? mine : 1u; nx = cnt > 0u ? cnt : 1u;
}

__device__ __forceinline__ void xcd_barrier(const XcdBarrier& b) {
    asm volatile("s_waitcnt vmcnt(0)" ::: "memory");
    __syncthreads();
    if (threadIdx.x == 0) {
        unsigned* bar = b.bar;
        __builtin_amdgcn_s_waitcnt(0);
        unsigned nloc = b.st[0], nx = b.st[1];
        if (nloc == 0u) { xcd_barrier_complete(bar, b.x, nloc, nx); b.st[0] = nloc; b.st[1] = nx; }
        const unsigned old = xb_add(&bar[XB_XSUB(b.x)], 1u);
        const unsigned gen = old / nloc;
        if (old + 1u == (gen + 1u) * nloc) {
            __builtin_amdgcn_fence(__ATOMIC_RELEASE, "agent");
            asm volatile("s_waitcnt vmcnt(0)" ::: "memory");
            const unsigned og = xb_add(&bar[XB_TOP], 1u);
            const unsigned tg = og / nx;
            if (og + 1u == (tg + 1u) * nx) xb_add(&bar[XB_TOPGEN], 1u);
            else XB_SPIN(xb_ld(&bar[XB_TOPGEN]) == tg, bar);
            __builtin_amdgcn_fence(__ATOMIC_ACQUIRE, "agent");
            xb_add(&bar[XB_XGEN(b.x)], 1u);
            asm volatile("s_waitcnt vmcnt(0)" ::: "memory");
        } else {
            XB_SPIN(xb_ld(&bar[XB_XGEN(b.x)]) == gen, bar);
            __builtin_amdgcn_fence(__ATOMIC_ACQUIRE, "agent");
            asm volatile("s_waitcnt vmcnt(0)" ::: "memory");
        }
    }
    __syncthreads();
}
constexpr int NWAVES = 8, NTHREADS = 512;
constexpr int DM = 1024, SEQ = 8192, NPROMPT = 2, NSAMP = 128, TSAMP = 8, NMETA = 16;
constexpr int ROW_S = NPROMPT * SEQ;
constexpr int ROW_M = ROW_S + NSAMP * TSAMP;
constexpr int NROWS = ROW_M + NMETA;
constexpr int MP = 17664;
constexpr int DINNER = 2048, NHEADS = 32, HD = 64, NGROUPS = 8, DSTATE = 128, CONVD = 4096, INPROJ = 6176, INPROJ_P = 6400, ZXW = 6144;
constexpr int DFF = 4096, NKV = 4, NQ = 16, KVW = 512;
constexpr float EPS = 1e-5f;
constexpr int LDX = 136;

constexpr size_t O_YP = 0, O_YS = O_YP + (size_t)NPROMPT * SEQ * DM, O_PCONV = O_YS + (size_t)NSAMP * TSAMP * DM, O_PSSM = O_PCONV + 2 * 2 * 3 * 4096,
    O_PCK = O_PSSM + (size_t)2 * 2 * 32 * 64 * 128, O_PCV = O_PCK + 2 * 128 * 256, O_SCONV = O_PCV + 2 * 128 * 256, O_SSSM = O_SCONV + (size_t)2 * 128 * 3 * 4096,
    O_SCK = O_SSSM + (size_t)2 * 128 * 32 * 64 * 128, O_SCV = O_SCK + (size_t)128 * 128 * 256, O_END = O_SCV + (size_t)128 * 128 * 256;

constexpr size_t MiB = 1u << 20;
constexpr size_t WS_CTL = 0, CTL_ZERO_BYTES = 1 * MiB;
constexpr size_t SZ_WIN = (size_t)INPROJ_P * 1024 * 2, SZ_WOUT = (size_t)1024 * 2048 * 2, SZ_WUP = (size_t)4096 * 1024 * 2, SZ_WDN = SZ_WUP, SZ_WQKV0 = (size_t)1536 * 1024 * 2, SZ_WQ1 = (size_t)1024 * 1024 * 2, SZ_WO = SZ_WQ1;
constexpr size_t WS_WIN = 1 * MiB, WS_WOUT = WS_WIN + 2 * SZ_WIN, WS_WUP = WS_WOUT + 2 * SZ_WOUT, WS_WDN = WS_WUP + 4 * SZ_WUP, WS_WQKV0 = WS_WDN + 4 * SZ_WDN, WS_WQ1 = WS_WQKV0 + SZ_WQKV0, WS_WO = WS_WQ1 + SZ_WQ1, WS_WEND = WS_WO + 2 * SZ_WO;
constexpr size_t al1m(size_t x) { return (x + MiB - 1) / MiB * MiB; }
constexpr size_t WS_H = al1m(WS_WEND), WS_HN = al1m(WS_H + (size_t)MP * 1024 * 4), WS_ZX = al1m(WS_HN + (size_t)MP * 1024 * 2), WS_DT = al1m(WS_ZX + (size_t)MP * ZXW * 2),
    WS_XC = al1m(WS_DT + (size_t)MP * 32 * 4), WS_YN = al1m(WS_XC + (size_t)MP * 4096 * 2), WS_CS = al1m(WS_YN + (size_t)MP * 2048 * 2), WS_CD = al1m(WS_CS + (size_t)129 * 32 * 8192 * 4), WS_SLAB = al1m(WS_CD + 129 * 32 * 4), WS_HSB = al1m(WS_SLAB + (size_t)8 * 1280 * 1024 * 4), WS_END = al1m(WS_HSB + (size_t)128 * 32 * 8192 * 2);
constexpr size_t WS_U = WS_ZX;
constexpr size_t WS_Q = WS_XC, WS_KV = WS_Q + (size_t)MP * 1024 * 2, WS_AO = WS_KV + (size_t)MP * 512 * 2;
static_assert(WS_AO + (size_t)MP * 1024 * 2 <= WS_YN, "attention overlay");
constexpr int CW_BAR = 4096;

constexpr int RING_BYTES = 131072, LDS_BYTES = 147456, LDSCTL_OFF = LDS_BYTES - 512, MISC_OFF = LDSCTL_OFF + 320;

typedef unsigned u32x2 __attribute__((ext_vector_type(2)));
typedef unsigned u32x4 __attribute__((ext_vector_type(4)));
__device__ __forceinline__ int ltid() { int t = threadIdx.x; asm volatile("" : "+v"(t)); return t; }
__device__ __forceinline__ float bf2f(unsigned short b) { return __uint_as_float((unsigned)b << 16); }
__device__ __forceinline__ float bflo(unsigned w) { return __uint_as_float(w << 16); }
__device__ __forceinline__ float bfhi(unsigned w) { return __uint_as_float(w & 0xffff0000u); }
__device__ __forceinline__ unsigned pkbf(float lo, float hi) { return pg8::cvt_pk_bf16(lo, hi); }
__device__ __forceinline__ float wave_sum(float v) {
#pragma unroll
    for (int o = 1; o < 64; o <<= 1) v += __shfl_xor(v, o);
    return v;
}
__device__ __forceinline__ float frcp(float x) { return __builtin_amdgcn_rcpf(x); }
__device__ __forceinline__ float sigmoid_f(float x) { return frcp(1.f + __expf(-x)); }
#define MFMA16(b, a, c) __builtin_amdgcn_mfma_f32_16x16x32_bf16((b), (a), (c), 0, 0, 0)

struct Args {
    const float* in[26]; float* out; unsigned char* ws; int ph_lo, ph_hi;
};
typedef const __attribute__((address_space(4))) Args* ArgsP;
enum { I_XP = 0, I_XS, I_SCONV, I_SSSM, I_CK, I_CV, I_META, I_ANORM, I_AIN, I_ACONVW, I_ACONVB, I_ADTB, I_ALOG, I_ADSKIP, I_AGATE, I_AOUT, I_KVNORM, I_WKV, I_BNORM, I_WQ, I_SINKS, I_WO, I_MLPNORM, I_WUP, I_WDOWN, I_FNORM };

__device__ __forceinline__ void transpose_item(const float* W, const float* scale, int K, int N, bf16* WT, int row_off, LAS unsigned* scr, int item, int lane) {
    const int nblk = (N + 63) / 64, kb = item / nblk, nb = item % nblk, k0 = 64 * kb, n0 = 64 * nb;
    const bool ok = (n0 + lane < N);
    const float* src = W + (size_t)k0 * N + n0 + (ok ? lane : 0);
    float v[64];
#pragma unroll
    for (int i = 0; i < 64; ++i) v[i] = __builtin_nontemporal_load(src + (size_t)i * N);
    if (!ok) {
#pragma unroll
        for (int i = 0; i < 64; ++i) v[i] = 0.f;
    }
    if (scale) {
#pragma unroll
        for (int i = 0; i < 64; ++i) v[i] *= scale[k0 + i];
    }
#pragma unroll
    for (int i = 0; i < 32; ++i) scr[lane * 33 + i] = pkbf(v[2 * i], v[2 * i + 1]);
    LDS_WAIT(); asm volatile("" ::: "memory");
    const int c = lane & 7;
#pragma unroll
    for (int j = 0; j < 8; ++j) { const int n = (lane >> 3) + 8 * j; const LAS unsigned* sp = scr + n * 33 + 4 * c;
        v4u o; o.x = sp[0]; o.y = sp[1]; o.z = sp[2]; o.w = sp[3];
        if (n0 + n < N) *(GAS v4u*)(WT + (size_t)(row_off + n0 + n) * K + k0 + 8 * c) = o; }
    LDS_WAIT(); asm volatile("" ::: "memory");
}
struct WJob { const float* W; const float* scale; int K, N; bf16* WT; int row_off; int items; };

__device__ __forceinline__ void phase_prologue(ArgsP a, LAS unsigned char* lds, int wave, int lane) {
    LAS unsigned* scr = (LAS unsigned*)(lds + wave * 16384);
    const int gw = blockIdx.x * NWAVES + wave, NGW = gridDim.x * NWAVES;
    unsigned char* ws = a->ws;
    for (int jb = 0; jb < 21; ++jb) {
        WJob J;
        if (jb < 2)       { const int i = jb;      J = WJob{a->in[I_AIN] + (size_t)i * 1024 * INPROJ, a->in[I_ANORM] + i * 1024, 1024, INPROJ, (bf16*)(ws + WS_WIN + i * SZ_WIN), 0, 0}; }
        else if (jb < 4)  { const int i = jb - 2;  J = WJob{a->in[I_AOUT] + (size_t)i * 2048 * 1024, a->in[I_AGATE] + i * 2048, 2048, 1024, (bf16*)(ws + WS_WOUT + i * SZ_WOUT), 0, 0}; }
        else if (jb < 8)  { const int l = jb - 4;  J = WJob{a->in[I_WUP] + (size_t)l * 1024 * 4096, a->in[I_MLPNORM] + l * 1024, 1024, 4096, (bf16*)(ws + WS_WUP + l * SZ_WUP), 0, 0}; }
        else if (jb < 12) { const int l = jb - 8;  J = WJob{a->in[I_WDOWN] + (size_t)l * 4096 * 1024, nullptr, 4096, 1024, (bf16*)(ws + WS_WDN + l * SZ_WDN), 0, 0}; }
        else if (jb == 12) { J = WJob{a->in[I_WQ], a->in[I_BNORM], 1024, 1024, (bf16*)(ws + WS_WQKV0), 0, 0}; }
        else if (jb == 13) { J = WJob{a->in[I_WKV], a->in[I_KVNORM], 1024, 512, (bf16*)(ws + WS_WQKV0), 1024, 0}; }
        else if (jb == 14) { J = WJob{a->in[I_WQ] + (size_t)1024 * 1024, a->in[I_BNORM] + 1024, 1024, 1024, (bf16*)(ws + WS_WQ1), 0, 0}; }
        else if (jb < 17) { const int j = jb - 15; J = WJob{a->in[I_WO] + (size_t)j * 1024 * 1024, nullptr, 1024, 1024, (bf16*)(ws + WS_WO + j * SZ_WO), 0, 0}; }
        else break;
        const int items = (J.K / 64) * ((J.N + 63) / 64);
        for (int it = gw; it < items; it += NGW) transpose_item(J.W, J.scale, J.K, J.N, J.WT, J.row_off, scr, it, lane);
    }
    {
        const int gt = blockIdx.x * NTHREADS + ltid(), NT = gridDim.x * NTHREADS;
        const int per = (INPROJ_P - INPROJ) * 1024 * 2 / 16;
        for (int e = gt; e < 2 * per; e += NT) { const int i = e / per, c = e % per;
            *(v4u*)(ws + WS_WIN + i * SZ_WIN + (size_t)INPROJ * 1024 * 2 + (size_t)c * 16) = (v4u){0u, 0u, 0u, 0u}; }
    }
}

__device__ __forceinline__ void row_ld_bf(const bf16* __restrict__ p, int lane, float (&v)[16]) {
    const u32x4 a0 = *(const u32x4*)(p + 8 * lane), a1 = *(const u32x4*)(p + 512 + 8 * lane);
    v[0] = bflo(a0.x); v[1] = bfhi(a0.x); v[2] = bflo(a0.y); v[3] = bfhi(a0.y); v[4] = bflo(a0.z); v[5] = bfhi(a0.z); v[6] = bflo(a0.w); v[7] = bfhi(a0.w);
    v[8] = bflo(a1.x); v[9] = bfhi(a1.x); v[10] = bflo(a1.y); v[11] = bfhi(a1.y); v[12] = bflo(a1.z); v[13] = bfhi(a1.z); v[14] = bflo(a1.w); v[15] = bfhi(a1.w);
}
__device__ __forceinline__ void row_ld_f32(const float* __restrict__ p, int lane, float (&v)[16], bool nt) {
    f32x4 q[4];
    if (nt) { q[0] = __builtin_nontemporal_load((const f32x4*)(p + 8 * lane)); q[1] = __builtin_nontemporal_load((const f32x4*)(p + 8 * lane + 4)); q[2] = __builtin_nontemporal_load((const f32x4*)(p + 512 + 8 * lane)); q[3] = __builtin_nontemporal_load((const f32x4*)(p + 512 + 8 * lane + 4)); }
    else { q[0] = *(const f32x4*)(p + 8 * lane); q[1] = *(const f32x4*)(p + 8 * lane + 4); q[2] = *(const f32x4*)(p + 512 + 8 * lane); q[3] = *(const f32x4*)(p + 512 + 8 * lane + 4); }
#pragma unroll
    for (int k = 0; k < 4; ++k) { v[4 * k] = q[k].x; v[4 * k + 1] = q[k].y; v[4 * k + 2] = q[k].z; v[4 * k + 3] = q[k].w; }
}
__device__ __forceinline__ void row_st_bf(bf16* __restrict__ p, int lane, const float (&v)[16], float sc) {
    u32x4 a0, a1;
    a0.x = pkbf(v[0] * sc, v[1] * sc); a0.y = pkbf(v[2] * sc, v[3] * sc); a0.z = pkbf(v[4] * sc, v[5] * sc); a0.w = pkbf(v[6] * sc, v[7] * sc);
    a1.x = pkbf(v[8] * sc, v[9] * sc); a1.y = pkbf(v[10] * sc, v[11] * sc); a1.z = pkbf(v[12] * sc, v[13] * sc); a1.w = pkbf(v[14] * sc, v[15] * sc);
    *(u32x4*)(p + 8 * lane) = a0; *(u32x4*)(p + 512 + 8 * lane) = a1;
}
__device__ __forceinline__ float row_rs(const float (&v)[16]) {
    float s = 0.f;
#pragma unroll
    for (int k = 0; k < 16; ++k) s += v[k] * v[k];
    return rsqrtf(wave_sum(s) * (1.f / DM) + EPS);
}
__device__ __forceinline__ void phase_norm(ArgsP a, int from_inputs, int nslab, int wave, int lane) {
    bf16* __restrict__ H = (bf16*)(a->ws + WS_H); bf16* __restrict__ HN = (bf16*)(a->ws + WS_HN); const float* __restrict__ SLAB = (const float*)(a->ws + WS_SLAB);
    const int gw = blockIdx.x * NWAVES + wave, NGW = gridDim.x * NWAVES;
    for (int m = ROW_S + gw; m < MP; m += NGW) {
        if (m >= NROWS) { *(u32x4*)(HN + (size_t)m * DM + 8 * lane) = (u32x4){0u, 0u, 0u, 0u}; *(u32x4*)(HN + (size_t)m * DM + 512 + 8 * lane) = (u32x4){0u, 0u, 0u, 0u}; continue; }
        float v[16];
        if (from_inputs) row_ld_f32((m < ROW_M) ? a->in[I_XS] + (size_t)(m - ROW_S) * DM : a->in[I_META] + (size_t)(m - ROW_M) * DM, lane, v, false);
        else row_ld_bf(H + (size_t)m * DM, lane, v);
        float sv[8][16];
#pragma unroll
        for (int sl = 0; sl < 8; ++sl) { if (sl < nslab) row_ld_f32(SLAB + (size_t)sl * (1280 * 1024) + (size_t)(m - ROW_S) * DM, lane, sv[sl], true); else {
#pragma unroll
                for (int k = 0; k < 16; ++k) sv[sl][k] = 0.f; } }
#pragma unroll
        for (int sl = 0; sl < 8; ++sl)
#pragma unroll
            for (int k = 0; k < 16; ++k) v[k] += sv[sl][k];
        if (nslab > 0 || from_inputs) row_st_bf(H + (size_t)m * DM, lane, v, 1.f);
        row_st_bf(HN + (size_t)m * DM, lane, v, row_rs(v));
    }
    for (int m0 = 4 * gw; m0 < ROW_S; m0 += 4 * NGW) {
        float v[4][16];
#pragma unroll
        for (int q = 0; q < 4; ++q) { if (from_inputs) row_ld_f32(a->in[I_XP] + (size_t)(m0 + q) * DM, lane, v[q], false); else row_ld_bf(H + (size_t)(m0 + q) * DM, lane, v[q]); }
#pragma unroll
        for (int q = 0; q < 4; ++q) row_st_bf(HN + (size_t)(m0 + q) * DM, lane, v[q], row_rs(v[q]));
    }
}
__device__ __forceinline__ void phase_final(ArgsP a, int wave, int lane) {
    const bf16* __restrict__ H = (const bf16*)(a->ws + WS_H); const float* __restrict__ fw = a->in[I_FNORM]; const float* __restrict__ SLAB = (const float*)(a->ws + WS_SLAB);
    const int gw = blockIdx.x * NWAVES + wave, NGW = gridDim.x * NWAVES;
    float w[16]; row_ld_f32(fw, lane, w, false);
    for (int m = gw; m < ROW_M; m += NGW) {
        float v[16]; row_ld_bf(H + (size_t)m * DM, lane, v);
        if (m >= ROW_S) {
#pragma unroll 1
            for (int sl = 0; sl < 8; ++sl) { float t[16]; row_ld_f32(SLAB + (size_t)sl * (1280 * 1024) + (size_t)(m - ROW_S) * DM, lane, t, true);
#pragma unroll
                for (int k = 0; k < 16; ++k) v[k] += t[k]; }
        }
        const float rs = row_rs(v);
        float* o = a->out + O_YP + (size_t)m * DM;
        __builtin_nontemporal_store((f32x4){v[0] * rs * w[0], v[1] * rs * w[1], v[2] * rs * w[2], v[3] * rs * w[3]}, (f32x4*)(o + 8 * lane));
        __builtin_nontemporal_store((f32x4){v[4] * rs * w[4], v[5] * rs * w[5], v[6] * rs * w[6], v[7] * rs * w[7]}, (f32x4*)(o + 8 * lane + 4));
        __builtin_nontemporal_store((f32x4){v[8] * rs * w[8], v[9] * rs * w[9], v[10] * rs * w[10], v[11] * rs * w[11]}, (f32x4*)(o + 512 + 8 * lane));
        __builtin_nontemporal_store((f32x4){v[12] * rs * w[12], v[13] * rs * w[13], v[14] * rs * w[14], v[15] * rs * w[15]}, (f32x4*)(o + 512 + 8 * lane + 4));
    }
}

__device__ __forceinline__ void unpack8(const u32x4 w, float (&f)[8]) { f[0] = bflo(w.x); f[1] = bfhi(w.x); f[2] = bflo(w.y); f[3] = bfhi(w.y); f[4] = bflo(w.z); f[5] = bfhi(w.z); f[6] = bflo(w.w); f[7] = bfhi(w.w); }
__device__ __forceinline__ void ld8f(const float* __restrict__ p, float (&f)[8]) { const f32x4 x0 = *(const f32x4*)p, x1 = *(const f32x4*)(p + 4); f[0]=x0.x;f[1]=x0.y;f[2]=x0.z;f[3]=x0.w;f[4]=x1.x;f[5]=x1.y;f[6]=x1.z;f[7]=x1.w; }
#define TSW(ch) ((((ch) >> 3) & 7) << 3)
struct ConvW { float w0[8], w1[8], w2[8], w3[8], bs[8]; };
__device__ __forceinline__ void conv_load_w(const float* __restrict__ cw, const float* __restrict__ cb, int c0, ConvW& W) { ld8f(cw + c0, W.w0); ld8f(cw + CONVD + c0, W.w1); ld8f(cw + 2 * CONVD + c0, W.w2); ld8f(cw + 3 * CONVD + c0, W.w3); ld8f(cb + c0, W.bs); }
__device__ __forceinline__ void conv_load_run(const bf16* __restrict__ ZX, int Rrow, int c0, int pk, bool valid, u32x4 (&raw)[11]) {
#pragma unroll
    for (int t = 0; t < 8; ++t) { raw[3 + t] = (u32x4){0u, 0u, 0u, 0u}; if (valid) raw[3 + t] = *(const u32x4*)(ZX + (size_t)(Rrow + t) * ZXW + 2048 + c0); }
#pragma unroll
    for (int t = 0; t < 3; ++t) { const int rr = (pk == 1) ? ROW_M + 13 + t : Rrow - 3 + t; raw[t] = (u32x4){0u, 0u, 0u, 0u}; if (valid && pk != 2) raw[t] = *(const u32x4*)(ZX + (size_t)rr * ZXW + 2048 + c0); }
}
template <int J> __device__ __forceinline__ void conv_channel(const u32x4 (&raw)[11], const ConvW& W, float (&o)[8]) {
    float x[11];
#pragma unroll
    for (int i = 0; i < 11; ++i) { const unsigned w = raw[i][J >> 1]; x[i] = (J & 1) ? bfhi(w) : bflo(w); }
#pragma unroll
    for (int t = 0; t < 8; ++t) { const float v = W.bs[J] + W.w0[J] * x[t] + W.w1[J] * x[t + 1] + W.w2[J] * x[t + 2] + W.w3[J] * x[t + 3]; o[t] = v * sigmoid_f(v); }
}
template <int J> __device__ __forceinline__ void conv_store_t(const u32x4 (&raw)[11], const ConvW& W, const float (&scale)[8], bf16* T, int ch0, int run) {
    float o[8]; conv_channel<J>(raw, W, o);
    u32x4 w; w.x = pkbf(o[0] * scale[0], o[1] * scale[1]); w.y = pkbf(o[2] * scale[2], o[3] * scale[3]); w.z = pkbf(o[4] * scale[4], o[5] * scale[5]); w.w = pkbf(o[6] * scale[6], o[7] * scale[7]);
    *(u32x4*)(T + (ch0 + J) * LDX + ((8 * run) ^ TSW(ch0 + J))) = w;
}
__device__ __forceinline__ void conv_item_t(const u32x4 (&raw)[11], const ConvW& W, const float (&scale)[8], bf16* T, int ch0, int run) {
    conv_store_t<0>(raw, W, scale, T, ch0, run); conv_store_t<1>(raw, W, scale, T, ch0, run); conv_store_t<2>(raw, W, scale, T, ch0, run); conv_store_t<3>(raw, W, scale, T, ch0, run);
    conv_store_t<4>(raw, W, scale, T, ch0, run); conv_store_t<5>(raw, W, scale, T, ch0, run); conv_store_t<6>(raw, W, scale, T, ch0, run); conv_store_t<7>(raw, W, scale, T, ch0, run);
}
__device__ __forceinline__ void conv_item_n(const u32x4 (&raw)[11], const ConvW& W, bf16* N, int run, int colel) {
    float p0[8], p1[8], p2[8]; unpack8(raw[0], p0); unpack8(raw[1], p1); unpack8(raw[2], p2);
#pragma unroll
    for (int t = 0; t < 8; ++t) { float x[8]; unpack8(raw[3 + t], x); float o[8];
#pragma unroll
        for (int j = 0; j < 8; ++j) { const float v = W.bs[j] + W.w0[j] * p0[j] + W.w1[j] * p1[j] + W.w2[j] * p2[j] + W.w3[j] * x[j]; o[j] = v * sigmoid_f(v); }
        u32x4 w; w.x = pkbf(o[0], o[1]); w.y = pkbf(o[2], o[3]); w.z = pkbf(o[4], o[5]); w.w = pkbf(o[6], o[7]);
        *(u32x4*)(N + (8 * run + t) * LDX + colel) = w;
#pragma unroll
        for (int j = 0; j < 8; ++j) { p0[j] = p1[j]; p1[j] = p2[j]; p2[j] = x[j]; } }
}
__device__ __forceinline__ void conv_state_out(const u32x4 (&raw)[11], float* __restrict__ dst  ) {
#pragma unroll
    for (int k = 0; k < 3; ++k) { float x[8]; unpack8(raw[8 + k], x); *(f32x4*)(dst + (size_t)k * CONVD) = (f32x4){x[0], x[1], x[2], x[3]}; *(f32x4*)(dst + (size_t)k * CONVD + 4) = (f32x4){x[4], x[5], x[6], x[7]}; }
}

__device__ __forceinline__ void ssd_acs(const float* DT, const float* alog, int R0, int len, int h0, float* s_dt, float* s_acs, int wave, int lane) {
    if (wave < 4) {
        const int r = wave; const float An = -__expf(alog[h0 + r]);
        const int l0 = 2 * lane;
        const float d0 = (l0 < len) ? DT[(size_t)(R0 + l0) * 32 + h0 + r] : 0.f;
        const float d1 = (l0 + 1 < len) ? DT[(size_t)(R0 + l0 + 1) * 32 + h0 + r] : 0.f;
        const float a0 = d0 * An, a1 = d1 * An, s = a0 + a1;
        float incl = s;
#pragma unroll
        for (int o = 1; o < 64; o <<= 1) { const float t = __shfl_up(incl, o); if (lane >= o) incl += t; }
        const float excl = incl - s;
        s_dt[r * 128 + l0] = d0; s_dt[r * 128 + l0 + 1] = d1;
        s_acs[r * 128 + l0] = excl + a0; s_acs[r * 128 + l0 + 1] = excl + s;
    }
}
#define LFRAG(base, row, ld, ks) (*(const bf16x8*)((base) + (row) * (ld) + 32 * (ks) + 8 * fq))

__device__ __forceinline__ void ssd1_unit(ArgsP a, int li, unsigned char* lds, int slot, int g, int R0, int len, int, int, int) {
    const int tid = ltid(), lane = tid & 63, wave = __builtin_amdgcn_readfirstlane(tid >> 6);
    const float* __restrict__ DT = (const float*)(a->ws + WS_DT);
    bf16* __restrict__ CS = (bf16*)(a->ws + WS_CS); float* __restrict__ CD = (float*)(a->ws + WS_CD);
    bf16* XsT = (bf16*)lds;
    bf16* BT = (bf16*)(lds + 256 * LDX * 2);
    float* s_dt = (float*)(lds + 384 * LDX * 2); float* s_acs = s_dt + 512;
    const int fr = lane & 15, fq = lane >> 4, h0 = g * 4;
    const float* __restrict__ cw = a->in[I_ACONVW] + (size_t)li * 4 * CONVD; const float* __restrict__ cbias = a->in[I_ACONVB] + (size_t)li * CONVD;
    const bf16* __restrict__ ZX = (const bf16*)(a->ws + WS_ZX);
    const bool meta = (slot == 128), chunk0 = (!meta && (slot & 63) == 0);
    const int xcb = tid & 31, xrun = tid >> 5, xc0 = g * 256 + xcb * 8;
    const int bcb = tid & 15, brun = (tid >> 4) & 15, bc0 = 2048 + g * 128 + bcb * 8;
    u32x4 rx[11], rb[11];
    conv_load_run(ZX, R0 + 8 * xrun, xc0, (xrun == 0) ? (meta ? 2 : (chunk0 ? 1 : 0)) : 0, 8 * xrun < len, rx);
    if (tid < 256) conv_load_run(ZX, R0 + 8 * brun, bc0, (brun == 0) ? (meta ? 2 : (chunk0 ? 1 : 0)) : 0, 8 * brun < len, rb);
    ssd_acs(DT, a->in[I_ALOG] + li * NHEADS, R0, len, h0, s_dt, s_acs, wave, lane);
    if (tid < 256) { ConvW W; conv_load_w(cw, cbias, bc0, W); const float one[8] = {1.f, 1.f, 1.f, 1.f, 1.f, 1.f, 1.f, 1.f}; conv_item_t(rb, W, one, BT, bcb * 8, brun); }
    __syncthreads();
    {   ConvW W; conv_load_w(cw, cbias, xc0, W);
        const int r = xcb >> 3; const float tot = s_acs[r * 128 + 127];
        const f32x4 a0 = *(const f32x4*)(s_acs + r * 128 + 8 * xrun), a1 = *(const f32x4*)(s_acs + r * 128 + 8 * xrun + 4), d0 = *(const f32x4*)(s_dt + r * 128 + 8 * xrun), d1 = *(const f32x4*)(s_dt + r * 128 + 8 * xrun + 4);
        float wl[8];
#pragma unroll
        for (int t = 0; t < 4; ++t) { wl[t] = __expf(tot - a0[t]) * d0[t]; wl[4 + t] = __expf(tot - a1[t]) * d1[t]; }
        conv_item_t(rx, W, wl, XsT, xcb * 8, xrun);
    }
    __syncthreads();
    f32x4 acc[2][8];
#pragma unroll
    for (int mi = 0; mi < 2; ++mi)
#pragma unroll
        for (int ni = 0; ni < 8; ++ni) acc[mi][ni] = (f32x4){0.f, 0.f, 0.f, 0.f};
#pragma unroll
    for (int ks = 0; ks < 4; ++ks) {
        const int ra0 = 32 * wave + fr, ra1 = ra0 + 16;
        const bf16x8 a0 = *(const bf16x8*)(XsT + ra0 * LDX + ((32 * ks + 8 * fq) ^ TSW(ra0))), a1 = *(const bf16x8*)(XsT + ra1 * LDX + ((32 * ks + 8 * fq) ^ TSW(ra1)));
#pragma unroll
        for (int ni = 0; ni < 8; ++ni) { const int rb = 16 * ni + fr; const bf16x8 bb = *(const bf16x8*)(BT + rb * LDX + ((32 * ks + 8 * fq) ^ TSW(rb)));
            acc[0][ni] = MFMA16(bb, a0, acc[0][ni]); acc[1][ni] = MFMA16(bb, a1, acc[1][ni]); }
    }
#pragma unroll
    for (int mi = 0; mi < 2; ++mi) { const int hp = 32 * wave + 16 * mi + fr, r = hp >> 6, p = hp & 63;
        bf16* dst = CS + ((size_t)(slot * 32 + h0 + r) * 64 + p) * 128 + 4 * fq;
#pragma unroll
        for (int ni = 0; ni < 8; ++ni) { u32x2 w; w.x = pkbf(acc[mi][ni][0], acc[mi][ni][1]); w.y = pkbf(acc[mi][ni][2], acc[mi][ni][3]); *(u32x2*)(dst + 16 * ni) = w; } }
    if (tid < 4) CD[slot * 32 + h0 + tid] = __expf(s_acs[tid * 128 + 127]);
    __syncthreads();
}

__device__ __forceinline__ void ssd_sample_issue(ArgsP a, int li, int b, int g, f32x4 (&st)[4][4]) {
    const int tid = ltid(), p = tid >> 3, nb = tid & 7;
    const float* __restrict__ sin_ = a->in[I_SSSM] + ((size_t)((li * NSAMP + b) * NHEADS + g * 4) * 64 + p) * 128 + 4 * nb;
#pragma unroll
    for (int r = 0; r < 4; ++r)
#pragma unroll
        for (int kk = 0; kk < 4; ++kk) st[r][kk] = __builtin_nontemporal_load((const f32x4*)(sin_ + (size_t)r * 8192 + 32 * kk));
}
__device__ __forceinline__ void ssd_sample_unit(ArgsP a, int li, unsigned char* lds, int b, int g, f32x4 (&st)[4][4]) {
    const int tid = ltid(), lane = tid & 63, wave = __builtin_amdgcn_readfirstlane(tid >> 6);
    const bf16* __restrict__ ZX = (const bf16*)(a->ws + WS_ZX); const float* __restrict__ DT = (const float*)(a->ws + WS_DT); bf16* __restrict__ YN = (bf16*)(a->ws + WS_YN);
    float* sX = (float*)lds; float* sB = sX + 8 * 256; float* sC = sB + 8 * 128; float* sY = sC + 8 * 128; float* sDt = sY + 8 * 256;
    const int R0 = ROW_S + b * 8, h0 = g * 4;
    const int p = tid >> 3, nb = tid & 7;
    float* __restrict__ sout = a->out + O_SSSM + ((size_t)((li * NSAMP + b) * NHEADS + h0) * 64 + p) * 128 + 4 * nb;
    {
        const float* __restrict__ cw = a->in[I_ACONVW] + (size_t)li * 4 * CONVD; const float* __restrict__ cbias = a->in[I_ACONVB] + (size_t)li * CONVD;
        const int t = tid >> 6, ck = tid & 63;
        const int c0 = (ck < 32) ? g * 256 + ck * 8 : (ck < 48) ? 2048 + g * 128 + (ck - 32) * 8 : 3072 + g * 128 + (ck - 48) * 8;
        float* dst = (ck < 32) ? sX + t * 256 + ck * 8 : (ck < 48) ? sB + t * 128 + (ck - 32) * 8 : sC + t * 128 + (ck - 48) * 8;
        const float* __restrict__ sc = a->in[I_SCONV] + ((size_t)(li * NSAMP + b) * 3) * CONVD + c0;
        float xr[4][8];
#pragma unroll
        for (int k = 0; k < 4; ++k) { const int tt = t - 3 + k;
            if (tt >= 0) unpack8(*(const u32x4*)(ZX + (size_t)(R0 + tt) * ZXW + 2048 + c0), xr[k]); else ld8f(sc + (size_t)(tt + 3) * CONVD, xr[k]); }
        ConvW W; conv_load_w(cw, cbias, c0, W);
        float o[8];
#pragma unroll
        for (int j = 0; j < 8; ++j) { const float v = W.bs[j] + W.w0[j] * xr[0][j] + W.w1[j] * xr[1][j] + W.w2[j] * xr[2][j] + W.w3[j] * xr[3][j]; o[j] = v * sigmoid_f(v); }
        *(f32x4*)dst = (f32x4){o[0], o[1], o[2], o[3]}; *(f32x4*)(dst + 4) = (f32x4){o[4], o[5], o[6], o[7]};
        if (t >= 5) { float* __restrict__ so = a->out + O_SCONV + ((size_t)(li * NSAMP + b) * 3 + (t - 5)) * CONVD + c0;
            *(f32x4*)so = (f32x4){xr[3][0], xr[3][1], xr[3][2], xr[3][3]}; *(f32x4*)(so + 4) = (f32x4){xr[3][4], xr[3][5], xr[3][6], xr[3][7]}; }
    }
    if (tid < 32) sDt[tid] = DT[(size_t)(R0 + (tid >> 2)) * 32 + h0 + (tid & 3)];
    __syncthreads();
    float An[4], Dk[4];
#pragma unroll
    for (int r = 0; r < 4; ++r) { An[r] = -__expf(a->in[I_ALOG][li * NHEADS + h0 + r]); Dk[r] = a->in[I_ADSKIP][li * NHEADS + h0 + r]; }
    float part[8][4];
#pragma unroll
    for (int t = 0; t < 8; ++t) {
        f32x4 bv[4], cv[4];
#pragma unroll
        for (int kk = 0; kk < 4; ++kk) { bv[kk] = *(const f32x4*)(sB + t * 128 + 32 * kk + 4 * nb); cv[kk] = *(const f32x4*)(sC + t * 128 + 32 * kk + 4 * nb); }
#pragma unroll
        for (int r = 0; r < 4; ++r) {
            const float dt = sDt[t * 4 + r], dA = __expf(dt * An[r]), xv = sX[t * 256 + r * 64 + p], coef = dt * xv;
            float pr = 0.f;
#pragma unroll
            for (int kk = 0; kk < 4; ++kk) { st[r][kk] = st[r][kk] * dA + bv[kk] * coef; pr += (cv[kk].x * st[r][kk].x + cv[kk].y * st[r][kk].y) + (cv[kk].z * st[r][kk].z + cv[kk].w * st[r][kk].w); }
            part[t][r] = pr;
        }
    }
#pragma unroll
    for (int r = 0; r < 4; ++r)
#pragma unroll
        for (int kk = 0; kk < 4; ++kk) __builtin_nontemporal_store(st[r][kk], (f32x4*)(sout + (size_t)r * 8192 + 32 * kk));
#pragma unroll
    for (int t = 0; t < 8; ++t)
#pragma unroll
        for (int r = 0; r < 4; ++r) { float v = part[t][r]; v += __shfl_xor(v, 1); v += __shfl_xor(v, 2); v += __shfl_xor(v, 4); part[t][r] = v; }
    if (nb == 0) {
#pragma unroll
        for (int t = 0; t < 8; ++t)
#pragma unroll
            for (int r = 0; r < 4; ++r) sY[t * 256 + r * 64 + p] = part[t][r] + Dk[r] * sX[t * 256 + r * 64 + p];
    }
    __syncthreads();
    {
        const int t = wave, c4 = lane * 4; const size_t row = (size_t)(R0 + t);
        const f32x4 y = *(const f32x4*)(sY + t * 256 + c4);
        const u32x2 zz = *(const u32x2*)(ZX + row * ZXW + g * 256 + c4);
        const float z0 = bflo(zz.x), z1 = bfhi(zz.x), z2 = bflo(zz.y), z3 = bfhi(zz.y);
        const float g0 = y.x * z0 * sigmoid_f(z0), g1 = y.y * z1 * sigmoid_f(z1), g2 = y.z * z2 * sigmoid_f(z2), g3 = y.w * z3 * sigmoid_f(z3);
        const float ss = wave_sum((g0 * g0 + g1 * g1) + (g2 * g2 + g3 * g3));
        const float rs = rsqrtf(ss * (1.f / 256.f) + EPS);
        u32x2 o; o.x = pkbf(g0 * rs, g1 * rs); o.y = pkbf(g2 * rs, g3 * rs);
        *(u32x2*)(YN + row * DINNER + g * 256 + c4) = o;
    }
    __syncthreads();
}

__device__ __forceinline__ void phase_scan(ArgsP a, int li) {
    const bf16* __restrict__ CS = (const bf16*)(a->ws + WS_CS); const float* __restrict__ CD = (const float*)(a->ws + WS_CD); bf16* __restrict__ HSB = (bf16*)(a->ws + WS_HSB);
    const int gt = blockIdx.x * NTHREADS + ltid(), NT = gridDim.x * NTHREADS;
    for (int e = gt; e < 2 * 65536; e += NT) {
        const int b = e >> 16, rem = e & 65535, h = rem >> 11, pn4 = rem & 2047;
        f32x4 hc; { const u32x2 w0 = *(const u32x2*)(CS + ((size_t)(128 * 32 + h) * 2048 + pn4) * 4); hc = (f32x4){bflo(w0.x), bfhi(w0.x), bflo(w0.y), bfhi(w0.y)}; }
#pragma unroll 1
        for (int c0 = 0; c0 < 64; c0 += 16) {
            u32x2 sw[16]; float dd[16];
#pragma unroll
            for (int k = 0; k < 16; ++k) { const int slot = b * 64 + c0 + k; sw[k] = __builtin_nontemporal_load((const u32x2*)(CS + ((size_t)(slot * 32 + h) * 2048 + pn4) * 4)); dd[k] = CD[slot * 32 + h]; }
#pragma unroll
            for (int k = 0; k < 16; ++k) { const int slot = b * 64 + c0 + k; const size_t o = ((size_t)(slot * 32 + h) * 2048 + pn4) * 4;
                const f32x4 sv = (f32x4){bflo(sw[k].x), bfhi(sw[k].x), bflo(sw[k].y), bfhi(sw[k].y)};
                u32x2 w; w.x = pkbf(hc.x, hc.y); w.y = pkbf(hc.z, hc.w); *(u32x2*)(HSB + o) = w;
                hc = hc * dd[k] + sv; }
        }
        __builtin_nontemporal_store(hc, (f32x4*)(a->out + O_PSSM + ((size_t)((li * NPROMPT + b) * NHEADS + h) * 2048 + pn4) * 4));
    }
}

__device__ __forceinline__ void ssd3_head(int r, int hb, const bf16* Cn, const bf16* BH, const bf16* Xt, const float* s_dt, const float* s_acs, const f32x4 (&cb)[8], f32x4 (&acc)[4],
                                          const bf16* __restrict__ ZX, size_t row, int g, float Dk, int l, int wave, int fr, int fq, float& ss) {
    u32x2 zz[4];
#pragma unroll
    for (int ni = 0; ni < 4; ++ni) { const int ch = g * 256 + r * 64 + 16 * ni + 4 * fq; zz[ni] = __builtin_nontemporal_load((const u32x2*)(ZX + row * ZXW + ch)); }
    const float al = s_acs[r * 128 + l];
#pragma unroll
    for (int ni = 0; ni < 4; ++ni) acc[ni] = (f32x4){0.f, 0.f, 0.f, 0.f};
    const bf16* Hs = BH + hb * 64 * LDX;
#pragma unroll
    for (int ks = 0; ks < 4; ++ks) { const bf16x8 af = LFRAG(Cn, l, LDX, ks);
#pragma unroll
        for (int ni = 0; ni < 4; ++ni) { const bf16x8 bb = LFRAG(Hs, 16 * ni + fr, LDX, ks); acc[ni] = MFMA16(bb, af, acc[ni]); } }
    const float e = __expf(al);
#pragma unroll
    for (int ni = 0; ni < 4; ++ni) acc[ni] = acc[ni] * e;
#pragma unroll
    for (int ks = 0; ks < 4; ++ks) if (2 * ks <= wave) {
        unsigned mw[4];
#pragma unroll
        for (int hf = 0; hf < 2; ++hf) { const int ni = 2 * ks + hf, s0 = 16 * ni + 4 * fq;
            const f32x4 av = *(const f32x4*)(s_acs + r * 128 + s0), dv = *(const f32x4*)(s_dt + r * 128 + s0);
            float m[4];
#pragma unroll
            for (int j = 0; j < 4; ++j) m[j] = (s0 + j <= l) ? cb[ni][j] * __expf(al - av[j]) * dv[j] : 0.f;
            mw[2 * hf] = pkbf(m[0], m[1]); mw[2 * hf + 1] = pkbf(m[2], m[3]); }
        const u32x4 afu = (u32x4){mw[0], mw[1], mw[2], mw[3]};
        const bf16x8 af = __builtin_bit_cast(bf16x8, afu);
#pragma unroll
        for (int ni = 0; ni < 4; ++ni) { const int chl = r * 64 + 16 * ni + fr, sw = TSW(chl);
            const u32x2 b0 = *(const u32x2*)(Xt + chl * LDX + ((32 * ks + 4 * fq) ^ sw)), b1 = *(const u32x2*)(Xt + chl * LDX + ((32 * ks + 16 + 4 * fq) ^ sw));
            const u32x4 bu = (u32x4){b0.x, b0.y, b1.x, b1.y};
            acc[ni] = MFMA16(__builtin_bit_cast(bf16x8, bu), af, acc[ni]); }
    }
#pragma unroll
    for (int ni = 0; ni < 4; ++ni) {
        float xv[4];
#pragma unroll
        for (int j = 0; j < 4; ++j) { const int chl = r * 64 + 16 * ni + 4 * fq + j; xv[j] = bf2f(Xt[chl * LDX + (l ^ TSW(chl))]); }
        const float zv[4] = {bflo(zz[ni].x), bfhi(zz[ni].x), bflo(zz[ni].y), bfhi(zz[ni].y)};
#pragma unroll
        for (int j = 0; j < 4; ++j) { const float q = (acc[ni][j] + Dk * xv[j]) * zv[j] * sigmoid_f(zv[j]); acc[ni][j] = q; ss += q * q; } }
}
__device__ __forceinline__ void ssd3_unit(ArgsP a, int li, unsigned char* lds, const bf16* __restrict__ hs, int slot, int g, int R0, int len, int, int, int) {
    const int tid = ltid(), lane = tid & 63, wave = __builtin_amdgcn_readfirstlane(tid >> 6);
    const bf16* __restrict__ ZX = (const bf16*)(a->ws + WS_ZX); const float* __restrict__ DT = (const float*)(a->ws + WS_DT); bf16* __restrict__ YN = (bf16*)(a->ws + WS_YN);
    bf16* Cn = (bf16*)lds; bf16* BH = Cn + 128 * LDX; bf16* Xt = BH + 128 * LDX;
    float* s_dt = (float*)(Xt + 256 * LDX); float* s_acs = s_dt + 512;
    const int fr = lane & 15, fq = lane >> 4, h0 = g * 4;
    {
        const float* __restrict__ cw = a->in[I_ACONVW] + (size_t)li * 4 * CONVD; const float* __restrict__ cbias = a->in[I_ACONVB] + (size_t)li * CONVD;
        const bool meta = (slot == 128), chunk0 = (!meta && (slot & 63) == 0);
        const int half = tid >> 8, ncb = tid & 15, nrun = (tid >> 4) & 15, nc0 = (half ? 2048 : 3072) + g * 128 + ncb * 8;
        const int xcb = tid & 31, xrun = tid >> 5, xc0 = g * 256 + xcb * 8;
        u32x4 rn[11], rx[11];
        conv_load_run(ZX, R0 + 8 * nrun, nc0, (nrun == 0) ? (meta ? 2 : (chunk0 ? 1 : 0)) : 0, 8 * nrun < len, rn);
        conv_load_run(ZX, R0 + 8 * xrun, xc0, (xrun == 0) ? (meta ? 2 : (chunk0 ? 1 : 0)) : 0, 8 * xrun < len, rx);
        ssd_acs(DT, a->in[I_ALOG] + li * NHEADS, R0, len, h0, s_dt, s_acs, wave, lane);
        { ConvW W; conv_load_w(cw, cbias, nc0, W); conv_item_n(rn, W, half ? BH : Cn, nrun, ncb * 8); }
        { ConvW W; conv_load_w(cw, cbias, xc0, W); const float one[8] = {1.f, 1.f, 1.f, 1.f, 1.f, 1.f, 1.f, 1.f}; conv_item_t(rx, W, one, Xt, xcb * 8, xrun); }
        if (!meta && (slot & 63) == 63) {
            float* __restrict__ dst = a->out + O_PCONV + (size_t)((li * NPROMPT + (slot >> 6)) * 3) * CONVD;
            if (nrun == 15) conv_state_out(rn, dst + nc0);
            if (xrun == 15) conv_state_out(rx, dst + xc0);
        }
    }
    __syncthreads();
    u32x2 hv[8];
#pragma unroll
    for (int k = 0; k < 8; ++k) { const int item = tid + NTHREADS * k; hv[k] = (u32x2){0u, 0u}; if (hs) hv[k] = __builtin_nontemporal_load((const u32x2*)(hs + (size_t)item * 4)); }
    const bool active = (16 * wave < len);
    f32x4 cb[8];
#pragma unroll
    for (int ni = 0; ni < 8; ++ni) cb[ni] = (f32x4){0.f, 0.f, 0.f, 0.f};
    if (active) {
#pragma unroll
    for (int ks = 0; ks < 4; ++ks) { const bf16x8 af = LFRAG(Cn, 16 * wave + fr, LDX, ks);
#pragma unroll
        for (int ni = 0; ni < 8; ++ni) { const bf16x8 bb = LFRAG(BH, 16 * ni + fr, LDX, ks); cb[ni] = MFMA16(bb, af, cb[ni]); } }
    }
    __syncthreads();
#pragma unroll
    for (int k = 0; k < 8; ++k) { const int item = tid + NTHREADS * k, hp = item >> 5, n4 = item & 31; *(u32x2*)(BH + hp * LDX + n4 * 4) = hv[k]; }
#pragma unroll
    for (int k = 0; k < 8; ++k) { const int item = tid + NTHREADS * k; hv[k] = (u32x2){0u, 0u}; if (hs) hv[k] = __builtin_nontemporal_load((const u32x2*)(hs + (size_t)(2 * 8192) + (size_t)item * 4)); }
    __syncthreads();
    const int l = 16 * wave + fr;
    const size_t row = (size_t)(R0 + ((l < len) ? l : 0));
    f32x4 y0[4], y1[4], y2[4], y3[4];
    float ss = 0.f;
    const float* dsk = a->in[I_ADSKIP] + li * NHEADS + h0;
    if (active) {
    ssd3_head(0, 0, Cn, BH, Xt, s_dt, s_acs, cb, y0, ZX, row, g, dsk[0], l, wave, fr, fq, ss);
    ssd3_head(1, 1, Cn, BH, Xt, s_dt, s_acs, cb, y1, ZX, row, g, dsk[1], l, wave, fr, fq, ss);
    }
    __syncthreads();
#pragma unroll
    for (int k = 0; k < 8; ++k) { const int item = tid + NTHREADS * k, hp = item >> 5, n4 = item & 31; *(u32x2*)(BH + hp * LDX + n4 * 4) = hv[k]; }
    __syncthreads();
    if (active) {
    ssd3_head(2, 0, Cn, BH, Xt, s_dt, s_acs, cb, y2, ZX, row, g, dsk[2], l, wave, fr, fq, ss);
    ssd3_head(3, 1, Cn, BH, Xt, s_dt, s_acs, cb, y3, ZX, row, g, dsk[3], l, wave, fr, fq, ss);
    ss += __shfl_xor(ss, 16); ss += __shfl_xor(ss, 32);
    }
    const float rs = rsqrtf(ss * (1.f / 256.f) + EPS);
    if (active && l < len) {
        bf16* yrow = YN + row * DINNER + g * 256 + 4 * fq;
#pragma unroll
        for (int ni = 0; ni < 4; ++ni) {
            u32x2 w;
            w.x = pkbf(y0[ni][0] * rs, y0[ni][1] * rs); w.y = pkbf(y0[ni][2] * rs, y0[ni][3] * rs); *(u32x2*)(yrow + 0 * 64 + 16 * ni) = w;
            w.x = pkbf(y1[ni][0] * rs, y1[ni][1] * rs); w.y = pkbf(y1[ni][2] * rs, y1[ni][3] * rs); *(u32x2*)(yrow + 1 * 64 + 16 * ni) = w;
            w.x = pkbf(y2[ni][0] * rs, y2[ni][1] * rs); w.y = pkbf(y2[ni][2] * rs, y2[ni][3] * rs); *(u32x2*)(yrow + 2 * 64 + 16 * ni) = w;
            w.x = pkbf(y3[ni][0] * rs, y3[ni][1] * rs); w.y = pkbf(y3[ni][2] * rs, y3[ni][3] * rs); *(u32x2*)(yrow + 3 * 64 + 16 * ni) = w;
        }
    }
    __syncthreads();
}
__device__ __forceinline__ void phase_ssd1(ArgsP a, int li, unsigned char* lds, int tid, int wave, int lane) {
    const int c = blockIdx.x;
#pragma unroll 1
    for (int j = 0; j < 4; ++j) {
        const int u = c + 256 * j;
        f32x4 st[4][4];
        ssd_sample_issue(a, li, u >> 3, u & 7, st);
#ifndef PROBE_SSD1
#define PROBE_SSD1 0
#endif
#pragma unroll 1
        for (int rp = 0; rp < (PROBE_SSD1 == 1 ? 2 : 1); ++rp) { const int slot = u >> 3, g = u & 7; ssd1_unit(a, li, lds, slot, g, (slot >> 6) * SEQ + (slot & 63) * 128, 128, tid, wave, lane); }
        ssd_sample_unit(a, li, lds, u >> 3, u & 7, st);
    }
    if (c < 8) ssd1_unit(a, li, lds, 128, c, ROW_M, NMETA, tid, wave, lane);
    else if (c < 16) ssd3_unit(a, li, lds, nullptr, 128, c - 8, ROW_M, NMETA, tid, wave, lane);
}
__device__ __forceinline__ void phase_ssd3(ArgsP a, int li, unsigned char* lds, int tid, int wave, int lane) {
    const bf16* HSB = (const bf16*)(a->ws + WS_HSB);
#pragma unroll 1
    for (int u = blockIdx.x; u < 1024; u += gridDim.x) { const int slot = u >> 3, g = u & 7; ssd3_unit(a, li, lds, HSB + (size_t)(slot * 32 + g * 4) * 8192, slot, g, (slot >> 6) * SEQ + (slot & 63) * 128, 128, tid, wave, lane); }
}

constexpr int KS_LD = 72, VT_LD = 264, P_LD = 232, NKEYS = 208;
__device__ __forceinline__ void attn_prompt_unit(ArgsP a, int lj, unsigned char* lds, int b, int kvh, int qb, int, int, int) {
    const int tid = ltid(), lane = tid & 63, wave = __builtin_amdgcn_readfirstlane(tid >> 6);
    const bf16* __restrict__ Q = (const bf16*)(a->ws + WS_Q); const bf16* __restrict__ KV = (const bf16*)(a->ws + WS_KV); bf16* __restrict__ AO = (bf16*)(a->ws + WS_AO);
    bf16* Ks = (bf16*)lds; bf16* Vt = Ks + NKEYS * KS_LD; bf16* Pw = Vt + 64 * VT_LD + wave * 16 * P_LD;
    const int fr = lane & 15, fq = lane >> 4, t0 = qb * 64, Rb = b * SEQ;
    const int r = wave >> 1, th = (wave & 1) * 32, qh = kvh * 4 + r;
    bf16x8 q0[2], q1[2];
#pragma unroll
    for (int ks = 0; ks < 2; ++ks) { q0[ks] = *(const bf16x8*)(Q + (size_t)(Rb + t0 + th + fr) * DM + qh * 64 + 32 * ks + 8 * fq); q1[ks] = *(const bf16x8*)(Q + (size_t)(Rb + t0 + th + 16 + fr) * DM + qh * 64 + 32 * ks + 8 * fq); }
    {
        u32x4 kv[4];
#pragma unroll
        for (int k = 0; k < 4; ++k) { const int it = tid + NTHREADS * k, key = it >> 3, ch = it & 7; kv[k] = (u32x4){0u, 0u, 0u, 0u};
            if (it < NKEYS * 8) { int row; if (key < 16) row = ROW_M + key; else { int s = t0 - 128 + key - 16; if (s < 0) s = 0; row = Rb + s; }
                kv[k] = *(const u32x4*)(KV + (size_t)row * KVW + kvh * 64 + ch * 8); } }
        u32x4 v0[2], v1[2];
#pragma unroll
        for (int k = 0; k < 2; ++k) { const int it = tid + NTHREADS * k, dbl = it & 7, kp = it >> 3; v0[k] = (u32x4){0u, 0u, 0u, 0u}; v1[k] = v0[k];
            if (it < (NKEYS / 2) * 8) { const int k0 = 2 * kp, k1 = k0 + 1; int s0 = t0 - 128 + k0 - 16, s1 = t0 - 128 + k1 - 16; if (s0 < 0) s0 = 0; if (s1 < 0) s1 = 0;
                const int r0 = (k0 < 16) ? ROW_M + k0 : Rb + s0, r1 = (k1 < 16) ? ROW_M + k1 : Rb + s1;
                v0[k] = *(const u32x4*)(KV + (size_t)r0 * KVW + 256 + kvh * 64 + dbl * 8); v1[k] = *(const u32x4*)(KV + (size_t)r1 * KVW + 256 + kvh * 64 + dbl * 8); } }
#pragma unroll
        for (int k = 0; k < 4; ++k) { const int it = tid + NTHREADS * k, key = it >> 3, ch = it & 7; if (it < NKEYS * 8) *(u32x4*)(Ks + key * KS_LD + ch * 8) = kv[k]; }
#pragma unroll
        for (int k = 0; k < 2; ++k) { const int it = tid + NTHREADS * k, dbl = it & 7, kp = it >> 3;
            if (it < (NKEYS / 2) * 8) { const int col = (2 * kp) ^ (8 * dbl);
                const unsigned a0[4] = {v0[k].x, v0[k].y, v0[k].z, v0[k].w}, a1[4] = {v1[k].x, v1[k].y, v1[k].z, v1[k].w};
#pragma unroll
                for (int j = 0; j < 4; ++j) {
                    *(unsigned*)(Vt + (dbl * 8 + 2 * j) * VT_LD + col) = (a0[j] & 0xffffu) | (a1[j] << 16);
                    *(unsigned*)(Vt + (dbl * 8 + 2 * j + 1) * VT_LD + col) = (a0[j] >> 16) | (a1[j] & 0xffff0000u); } } }
#pragma unroll
        for (int k = 0; k < 3; ++k) { const int idx = tid + NTHREADS * k, row = idx / 24, c = idx - row * 24; *(unsigned*)(Vt + row * VT_LD + ((NKEYS + 2 * c) ^ TSW(row))) = 0u; }
    }
    __syncthreads();
    const float sink = a->in[I_SINKS][lj * NQ + qh];
#pragma unroll 1
    for (int blk = 0; blk < 2; ++blk) {
        const int tq = th + blk * 16 + fr, t = t0 + tq;
        bf16x8 qa2[2];
#pragma unroll
        for (int ks = 0; ks < 2; ++ks) qa2[ks] = (blk == 0) ? q0[ks] : q1[ks];
        f32x4 sc[13];
#pragma unroll
        for (int ni = 0; ni < 13; ++ni) sc[ni] = (f32x4){0.f, 0.f, 0.f, 0.f};
#pragma unroll
        for (int ni = 0; ni < 13; ++ni) {
            const bf16x8 b0 = *(const bf16x8*)(Ks + (16 * ni + fr) * KS_LD + 8 * fq), b1 = *(const bf16x8*)(Ks + (16 * ni + fr) * KS_LD + 32 + 8 * fq);
            sc[ni] = MFMA16(b0, qa2[0], sc[ni]); sc[ni] = MFMA16(b1, qa2[1], sc[ni]);
            }
        int lo = tq + 17; { const int l2 = 144 - t0; if (l2 > lo) lo = l2; }
        const unsigned span = (unsigned)(tq + 144 - lo);
        float mx = -INFINITY;
#pragma unroll
        for (int ni = 0; ni < 13; ++ni)
#pragma unroll
            for (int j = 0; j < 4; ++j) { const int key = 16 * ni + 4 * fq + j; const bool vis = (ni == 0) || ((unsigned)(key - lo) <= span);
                const float v = vis ? sc[ni][j] * 0.125f : -INFINITY; sc[ni][j] = v; mx = fmaxf(mx, v); }
        mx = fmaxf(mx, __shfl_xor(mx, 16)); mx = fmaxf(mx, __shfl_xor(mx, 32)); mx = fmaxf(mx, sink);
        float sum = 0.f;
#pragma unroll
        for (int ni = 0; ni < 13; ++ni)
#pragma unroll
            for (int j = 0; j < 4; ++j) { const float p = __expf(sc[ni][j] - mx); sc[ni][j] = p; sum += p; }
        sum += __shfl_xor(sum, 16); sum += __shfl_xor(sum, 32); sum += __expf(sink - mx);
        const float inv = frcp(sum);
#pragma unroll
        for (int ni = 0; ni < 13; ++ni) { u32x2 w; w.x = pkbf(sc[ni][0] * inv, sc[ni][1] * inv); w.y = pkbf(sc[ni][2] * inv, sc[ni][3] * inv); *(u32x2*)(Pw + fr * P_LD + 16 * ni + 4 * fq) = w; }
        *(u32x2*)(Pw + fr * P_LD + NKEYS + 4 * fq) = (u32x2){0u, 0u};
        asm volatile("s_waitcnt lgkmcnt(0)" ::: "memory");
        f32x4 o[4];
#pragma unroll
        for (int ni = 0; ni < 4; ++ni) o[ni] = (f32x4){0.f, 0.f, 0.f, 0.f};
#pragma unroll
        for (int ks = 0; ks < 7; ++ks) { const bf16x8 af = *(const bf16x8*)(Pw + fr * P_LD + 32 * ks + 8 * fq);
#pragma unroll
            for (int ni = 0; ni < 4; ++ni) { const int vr = 16 * ni + fr; const bf16x8 bb = *(const bf16x8*)(Vt + vr * VT_LD + ((32 * ks + 8 * fq) ^ TSW(vr))); o[ni] = MFMA16(bb, af, o[ni]); }
            }
#pragma unroll
        for (int ni = 0; ni < 4; ++ni) { u32x2 w; w.x = pkbf(o[ni][0], o[ni][1]); w.y = pkbf(o[ni][2], o[ni][3]); *(u32x2*)(AO + (size_t)(Rb + t) * DM + qh * 64 + 16 * ni + 4 * fq) = w; }
        asm volatile("s_waitcnt lgkmcnt(0)" ::: "memory");
    }
    __syncthreads();
}
constexpr int SK_LD = 72, SV_LD = 200, SP_LD = 168, SKEYS = 160;
__device__ __forceinline__ void attn_sample_pair(ArgsP a, int lj, unsigned char* lds, int bp, int kvh, int, int, int) {
    const int tid = ltid(), lane = tid & 63, wave = __builtin_amdgcn_readfirstlane(tid >> 6);
    const bf16* __restrict__ Q = (const bf16*)(a->ws + WS_Q); const bf16* __restrict__ KV = (const bf16*)(a->ws + WS_KV); bf16* __restrict__ AO = (bf16*)(a->ws + WS_AO);
    const float* __restrict__ CK = a->in[I_CK]; const float* __restrict__ CV = a->in[I_CV];
    constexpr int HALF_B = (SKEYS * SK_LD + 64 * SV_LD) * 2;
    const int fr = lane & 15, fq = lane >> 4;
    {
        u32x4 r0[5], r1[5];
#pragma unroll
        for (int k = 0; k < 5; ++k) { const int it = tid + NTHREADS * k, hf = it / (SKEYS * 8), rem = it - hf * (SKEYS * 8), key = rem >> 3, ch = rem & 7, bb = 2 * bp + hf;
            r0[k] = (u32x4){0u, 0u, 0u, 0u}; r1[k] = r0[k];
            if (key < 16) r0[k] = *(const u32x4*)(KV + (size_t)(ROW_M + key) * KVW + kvh * 64 + ch * 8);
            else if (key < 144) { const float* p = CK + ((size_t)(bb * 128 + (key - 16)) * NKV + kvh) * 64 + ch * 8; r0[k] = __builtin_nontemporal_load((const u32x4*)p); r1[k] = __builtin_nontemporal_load((const u32x4*)(p + 4)); }
            else if (key < 152) r0[k] = *(const u32x4*)(KV + (size_t)(ROW_S + bb * 8 + (key - 144)) * KVW + kvh * 64 + ch * 8); }
#pragma unroll
        for (int k = 0; k < 5; ++k) { const int it = tid + NTHREADS * k, hf = it / (SKEYS * 8), rem = it - hf * (SKEYS * 8), key = rem >> 3, ch = rem & 7;
            bf16* Ks = (bf16*)(lds + hf * HALF_B);
            u32x4 w = r0[k];
            if (key >= 16 && key < 144) { w.x = pkbf(__uint_as_float(r0[k].x), __uint_as_float(r0[k].y)); w.y = pkbf(__uint_as_float(r0[k].z), __uint_as_float(r0[k].w)); w.z = pkbf(__uint_as_float(r1[k].x), __uint_as_float(r1[k].y)); w.w = pkbf(__uint_as_float(r1[k].z), __uint_as_float(r1[k].w)); }
            *(u32x4*)(Ks + key * SK_LD + ch * 8) = w; }
    }
    {
        u32x4 x0[3], x1[3], y0[3], y1[3];
#pragma unroll
        for (int k = 0; k < 3; ++k) { const int it = tid + NTHREADS * k, hf = it / (96 * 8), rem = it - hf * (96 * 8), dbl = rem & 7, kp = rem >> 3, bb = 2 * bp + hf, k0 = 2 * kp;
            x0[k] = (u32x4){0u, 0u, 0u, 0u}; x1[k] = x0[k]; y0[k] = x0[k]; y1[k] = x0[k];
            if (k0 < 16) { x0[k] = *(const u32x4*)(KV + (size_t)(ROW_M + k0) * KVW + 256 + kvh * 64 + dbl * 8); y0[k] = *(const u32x4*)(KV + (size_t)(ROW_M + k0 + 1) * KVW + 256 + kvh * 64 + dbl * 8); }
            else if (k0 < 144) { const float* p = CV + ((size_t)(bb * 128 + (k0 - 16)) * NKV + kvh) * 64 + dbl * 8;
                x0[k] = __builtin_nontemporal_load((const u32x4*)p); x1[k] = __builtin_nontemporal_load((const u32x4*)(p + 4)); y0[k] = __builtin_nontemporal_load((const u32x4*)(p + NKV * 64)); y1[k] = __builtin_nontemporal_load((const u32x4*)(p + NKV * 64 + 4)); }
            else if (k0 < 152) { x0[k] = *(const u32x4*)(KV + (size_t)(ROW_S + bb * 8 + (k0 - 144)) * KVW + 256 + kvh * 64 + dbl * 8); y0[k] = *(const u32x4*)(KV + (size_t)(ROW_S + bb * 8 + (k0 - 143)) * KVW + 256 + kvh * 64 + dbl * 8); } }
#pragma unroll
        for (int k = 0; k < 3; ++k) { const int it = tid + NTHREADS * k, hf = it / (96 * 8), rem = it - hf * (96 * 8), dbl = rem & 7, kp = rem >> 3, k0 = 2 * kp;
            bf16* Vt = (bf16*)(lds + hf * HALF_B) + SKEYS * SK_LD;
            unsigned a0[4] = {x0[k].x, x0[k].y, x0[k].z, x0[k].w}, a1[4] = {y0[k].x, y0[k].y, y0[k].z, y0[k].w};
            if (k0 >= 16 && k0 < 144) {
                a0[0] = pkbf(__uint_as_float(x0[k].x), __uint_as_float(x0[k].y)); a0[1] = pkbf(__uint_as_float(x0[k].z), __uint_as_float(x0[k].w)); a0[2] = pkbf(__uint_as_float(x1[k].x), __uint_as_float(x1[k].y)); a0[3] = pkbf(__uint_as_float(x1[k].z), __uint_as_float(x1[k].w));
                a1[0] = pkbf(__uint_as_float(y0[k].x), __uint_as_float(y0[k].y)); a1[1] = pkbf(__uint_as_float(y0[k].z), __uint_as_float(y0[k].w)); a1[2] = pkbf(__uint_as_float(y1[k].x), __uint_as_float(y1[k].y)); a1[3] = pkbf(__uint_as_float(y1[k].z), __uint_as_float(y1[k].w)); }
            const int col = (2 * kp) ^ (8 * dbl);
#pragma unroll
            for (int j = 0; j < 4; ++j) {
                *(unsigned*)(Vt + (dbl * 8 + 2 * j) * SV_LD + col) = (a0[j] & 0xffffu) | (a1[j] << 16);
                *(unsigned*)(Vt + (dbl * 8 + 2 * j + 1) * SV_LD + col) = (a0[j] >> 16) | (a1[j] & 0xffff0000u); } }
    }
    if (lj == 0) {
        u32x4 kx[8], vx[8];
#pragma unroll
        for (int k = 0; k < 8; ++k) { const int it = tid + NTHREADS * k, hf = it >> 11, rem = it & 2047, w = rem >> 4, c4 = (rem & 15) * 4, bb = 2 * bp + hf;
            if (w < 120) { const size_t i = ((size_t)(bb * 128 + w + 8) * NKV + kvh) * 64 + c4; kx[k] = __builtin_nontemporal_load((const u32x4*)(CK + i)); vx[k] = __builtin_nontemporal_load((const u32x4*)(CV + i)); }
            else { const bf16* rp = KV + (size_t)(ROW_S + bb * 8 + (w - 120)) * KVW + kvh * 64 + c4; const u32x2 k2 = *(const u32x2*)rp, v2 = *(const u32x2*)(rp + 256);
                kx[k] = (u32x4){k2.x << 16, k2.x & 0xffff0000u, k2.y << 16, k2.y & 0xffff0000u}; vx[k] = (u32x4){v2.x << 16, v2.x & 0xffff0000u, v2.y << 16, v2.y & 0xffff0000u}; } }
#pragma unroll
        for (int k = 0; k < 8; ++k) { const int it = tid + NTHREADS * k, hf = it >> 11, rem = it & 2047, w = rem >> 4, c4 = (rem & 15) * 4, bb = 2 * bp + hf;
            const size_t o = ((size_t)(bb * 128 + w) * NKV + kvh) * 64 + c4;
            __builtin_nontemporal_store(kx[k], (u32x4*)(a->out + O_SCK + o)); __builtin_nontemporal_store(vx[k], (u32x4*)(a->out + O_SCV + o)); }
    }
    __syncthreads();
    if (wave < 4) {
        const int hf = wave >> 1, rb = wave & 1, bb = 2 * bp + hf;
        const bf16* Ks = (const bf16*)(lds + hf * HALF_B); const bf16* Vt = Ks + SKEYS * SK_LD; bf16* Pw = (bf16*)(lds + 2 * HALF_B) + wave * 16 * SP_LD;
        const int r = 2 * rb + (fr >> 3), t = fr & 7, qh = kvh * 4 + r;
        const size_t qrow = (size_t)(ROW_S + bb * 8 + t);
        bf16x8 qa[2];
        if (lj == 0) {
#pragma unroll
            for (int ks = 0; ks < 2; ++ks) qa[ks] = *(const bf16x8*)(Q + qrow * DM + qh * 64 + 32 * ks + 8 * fq);
        } else {
            const float* __restrict__ SL = (const float*)(a->ws + WS_SLAB) + (size_t)(qrow - ROW_S) * DM + qh * 64 + 8 * fq;
#pragma unroll
            for (int ks = 0; ks < 2; ++ks) { f32x4 x0 = (f32x4){0.f, 0.f, 0.f, 0.f}, x1 = x0;
#pragma unroll
                for (int sl = 0; sl < 4; ++sl) { const float* p = SL + (size_t)sl * (1280 * 1024) + 32 * ks; x0 = x0 + *(const f32x4*)p; x1 = x1 + *(const f32x4*)(p + 4); }
                const u32x4 w = (u32x4){pkbf(x0.x, x0.y), pkbf(x0.z, x0.w), pkbf(x1.x, x1.y), pkbf(x1.z, x1.w)}; qa[ks] = __builtin_bit_cast(bf16x8, w); }
        }
        const float sink = a->in[I_SINKS][lj * NQ + qh];
        f32x4 sc[10];
#pragma unroll
        for (int ni = 0; ni < 10; ++ni) sc[ni] = (f32x4){0.f, 0.f, 0.f, 0.f};
#pragma unroll
        for (int ni = 0; ni < 10; ++ni) {
            const bf16x8 b0 = *(const bf16x8*)(Ks + (16 * ni + fr) * SK_LD + 8 * fq), b1 = *(const bf16x8*)(Ks + (16 * ni + fr) * SK_LD + 32 + 8 * fq);
            sc[ni] = MFMA16(b0, qa[0], sc[ni]); sc[ni] = MFMA16(b1, qa[1], sc[ni]); }
        float mx = -INFINITY;
#pragma unroll
        for (int ni = 0; ni < 10; ++ni)
#pragma unroll
            for (int j = 0; j < 4; ++j) { const int key = 16 * ni + 4 * fq + j;
                const bool vis = (ni == 0) || ((key < 144) ? (key - 16 > t) : (key - 144 <= t));
                const float v = vis ? sc[ni][j] * 0.125f : -INFINITY; sc[ni][j] = v; mx = fmaxf(mx, v); }
        mx = fmaxf(mx, __shfl_xor(mx, 16)); mx = fmaxf(mx, __shfl_xor(mx, 32)); mx = fmaxf(mx, sink);
        float sum = 0.f;
#pragma unroll
        for (int ni = 0; ni < 10; ++ni)
#pragma unroll
            for (int j = 0; j < 4; ++j) { const float p = __expf(sc[ni][j] - mx); sc[ni][j] = p; sum += p; }
        sum += __shfl_xor(sum, 16); sum += __shfl_xor(sum, 32); sum += __expf(sink - mx);
        const float inv = frcp(sum);
#pragma unroll
        for (int ni = 0; ni < 10; ++ni) { u32x2 w; w.x = pkbf(sc[ni][0] * inv, sc[ni][1] * inv); w.y = pkbf(sc[ni][2] * inv, sc[ni][3] * inv); *(u32x2*)(Pw + fr * SP_LD + 16 * ni + 4 * fq) = w; }
        asm volatile("s_waitcnt lgkmcnt(0)" ::: "memory");
        f32x4 o[4];
#pragma unroll
        for (int ni = 0; ni < 4; ++ni) o[ni] = (f32x4){0.f, 0.f, 0.f, 0.f};
#pragma unroll
        for (int ks = 0; ks < 5; ++ks) { const bf16x8 af = *(const bf16x8*)(Pw + fr * SP_LD + 32 * ks + 8 * fq);
#pragma unroll
            for (int ni = 0; ni < 4; ++ni) { const int vr = 16 * ni + fr; const bf16x8 bb2 = *(const bf16x8*)(Vt + vr * SV_LD + ((32 * ks + 8 * fq) ^ TSW(vr))); o[ni] = MFMA16(bb2, af, o[ni]); } }
#pragma unroll
        for (int ni = 0; ni < 4; ++ni) { u32x2 w; w.x = pkbf(o[ni][0], o[ni][1]); w.y = pkbf(o[ni][2], o[ni][3]); *(u32x2*)(AO + qrow * DM + qh * 64 + 16 * ni + 4 * fq) = w; }
    }
    __syncthreads();
}
__device__ __forceinline__ void phase_attn(ArgsP a, int lj, unsigned char* lds, int tid, int wave, int lane) {
    if (lj == 0) {
        const bf16* KV = (const bf16*)(a->ws + WS_KV);
        const int gt = blockIdx.x * NTHREADS + tid, NT = gridDim.x * NTHREADS;
        for (int e = gt; e < 2 * 128 * 512; e += NT) { const int b = e >> 16, w = (e >> 9) & 127, c = e & 511;
            const float v = bf2f(KV[(size_t)(b * SEQ + SEQ - 128 + w) * KVW + c]);
            if (c < 256) a->out[O_PCK + (size_t)(b * 128 + w) * 256 + c] = v; else a->out[O_PCV + (size_t)(b * 128 + w) * 256 + (c - 256)] = v; }
    }
    const int xg = blockIdx.x & 7, xi = blockIdx.x >> 3;
#pragma unroll 1
    for (int j = 0; j < 4; ++j) { const int u = 128 * xg + 4 * xi + j, qb = u & 127, kvh = (u >> 7) & 3, b = u >> 9; attn_prompt_unit(a, lj, lds, b, kvh, qb, tid, wave, lane); }
    { const int su = blockIdx.x; attn_sample_pair(a, lj, lds, su >> 2, su & 3, tid, wave, lane); }
}

constexpr int PH_B = 9 * 2, PH_F = PH_B + 7 * 2, NPHASES = PH_F + 1;
template <class Epi> __device__ __forceinline__ void run_gemm(LAS unsigned char* lds, const bf16* A, const bf16* Bt, int N, int K, const Epi& E) {
    pg8::Gemm g{A, Bt, MP, N, K}; pg8::StaticOrder S; S.init(MP, N, K, (int)gridDim.x, (int)blockIdx.x);
    pg8::gemm_phase<Epi, pg8::StaticOrder, true, true>(lds, g, S, E);
}
template <class Epi> __device__ __forceinline__ void run_gemm_res(LAS unsigned char* lds, const bf16* A, const bf16* Bt, int K, int S_, const Epi& E) {
    pg8::Gemm g{A, Bt, MP, 1024, K}; pg8::ResOrder S; S.init(K, S_, (int)gridDim.x, (int)blockIdx.x);
    pg8::gemm_phase<Epi, pg8::ResOrder, true, true>(lds, g, S, E);
}

__global__ void __launch_bounds__(NTHREADS, 2) yoco_fwd(Args args) {
    extern __shared__ __attribute__((aligned(16))) unsigned char lds[];
    LAS unsigned char* ldsl = (LAS unsigned char*)lds;
    const int tid0 = threadIdx.x;
    for (int u = tid0; u < (LDS_BYTES - LDSCTL_OFF) / 4; u += NTHREADS) ((LAS unsigned*)(ldsl + LDSCTL_OFF))[u] = 0u;
    __syncthreads();
    const int lo = args.ph_lo, hi = args.ph_hi;
    XcdBarrier bar; bar.bar = (unsigned*)(args.ws + WS_CTL) + CW_BAR; bar.x = 0; bar.st = nullptr;
    if (hi - lo > 1) bar = xcd_barrier_post((unsigned*)(args.ws + WS_CTL) + CW_BAR, (volatile LAS unsigned*)(ldsl + MISC_OFF) + 8);
    int rep = 0;
#pragma unroll 1
    for (int p = lo; p < hi;) {
        ArgsP la = (ArgsP)__builtin_amdgcn_kernarg_segment_ptr(); asm volatile("" : "+s"(la));
        unsigned char* ws = la->ws;
        const int tid = ltid();
        const int lane = tid & 63, wave = __builtin_amdgcn_readfirstlane(tid >> 6);
        bf16* HN = (bf16*)(ws + WS_HN); float* H = (float*)(ws + WS_H);
        int kind, li = 0, lj = 0, layer = 0;
        int nslab = 8;
        if (p == 0) kind = 0;
        else if (p < PH_B) { li = p / 9; layer = li; const int sub = p % 9;
            kind = (sub == 0) ? 1 : (sub == 1) ? 3 : (sub == 2) ? 5 : (sub == 3) ? 6 : (sub == 4) ? 7 : (sub == 5) ? 8 : (sub == 6) ? 1 : (sub == 7) ? 9 : 10; }
        else if (p < PH_F) { lj = (p - PH_B) / 7; layer = 2 + lj; const int sub = (p - PH_B) % 7;
            kind = (sub == 0) ? 1 : (sub == 1) ? 11 : (sub == 2) ? 12 : (sub == 3) ? 13 : (sub == 4) ? 1 : (sub == 5) ? 9 : 10; if (sub == 4) nslab = 4; }
        else kind = 14;
#ifndef KMASK
#define KMASK 0xffff
#endif
#define KON(k) ((KMASK >> (k)) & 1)
#ifndef REP_MASK
#define REP_MASK 0
#endif
        if (KON(0) && kind == 0) { phase_prologue(la, ldsl, wave, lane); phase_norm(la, 1, 0, wave, lane); }
        else if (KON(1) && kind == 1) phase_norm(la, 0, nslab, wave, lane);
        else if (KON(3) && kind == 3) { pg8::EpiInProj E{(bf16*)(ws + WS_ZX), (float*)(ws + WS_DT), la->in[I_ADTB] + li * NHEADS}; run_gemm(ldsl, HN, (const bf16*)(ws + WS_WIN + li * SZ_WIN), INPROJ_P, 1024, E); }
        else if (KON(5) && kind == 5) phase_ssd1(la, li, lds, tid, wave, lane);
        else if (KON(6) && kind == 6) phase_scan(la, li);
        else if (KON(7) && kind == 7) phase_ssd3(la, li, lds, tid, wave, lane);
        else if (KON(8) && (kind == 8 || kind == 10 || kind == 13)) {
            const bf16* A; const bf16* Bt; int K;
            if (kind == 8) { A = (const bf16*)(ws + WS_YN); Bt = (const bf16*)(ws + WS_WOUT + li * SZ_WOUT); K = 2048; }
            else if (kind == 10) { A = (const bf16*)(ws + WS_U); Bt = (const bf16*)(ws + WS_WDN + layer * SZ_WDN); K = 4096; }
            else { A = (const bf16*)(ws + WS_AO); Bt = (const bf16*)(ws + WS_WO + lj * SZ_WO); K = 1024; }
            pg8::EpiRes E{(kind == 8 && li == 0) ? la->in[I_XP] : nullptr, (bf16*)H, (float*)(ws + WS_SLAB)}; run_gemm_res(ldsl, A, Bt, K, K == 1024 ? 4 : 8, E); }
        else if (KON(9) && kind == 9) { pg8::EpiBf<1> E{(bf16*)(ws + WS_U), 4096, 1 << 20, nullptr, 0}; run_gemm(ldsl, HN, (const bf16*)(ws + WS_WUP + layer * SZ_WUP), 4096, 1024, E); }
        else if (KON(11) && kind == 11) { pg8::EpiBf<0> E{(bf16*)(ws + WS_Q), 1024, 4, (bf16*)(ws + WS_KV), KVW};
            if (lj == 0) run_gemm(ldsl, HN, (const bf16*)(ws + WS_WQKV0), 1536, 1024, E);
            else { pg8::EpiQSplit E2{(bf16*)(ws + WS_Q), (float*)(ws + WS_SLAB)}; run_gemm_res(ldsl, HN, (const bf16*)(ws + WS_WQ1), 1024, 4, E2); } }
        else if (KON(12) && kind == 12) phase_attn(la, lj, lds, tid, wave, lane);
        else if (KON(14) && kind == 14) phase_final(la, wave, lane);
        bool again = false;
        if (REP_MASK != 0) { if (rep == 0 && ((REP_MASK >> kind) & 1)) { rep = 1; again = true; } else rep = 0; }
#ifdef PROBE_DOUBLE_BARRIER
        if (p + 1 < hi || again) xcd_barrier(bar);
#endif
        if (p + 1 < hi || again) xcd_barrier(bar); else { asm volatile("s_waitcnt vmcnt(0)" ::: "memory"); __syncthreads(); }
        if (!again) ++p;
    }
}

#ifndef MK_PER_PHASE
#define MK_PER_PHASE 0
#endif
extern "C" void kernel_launch(void* const* d_in, const int* in_sizes, int n_in, void* d_out, int out_size, void* d_ws, size_t ws_size, hipStream_t stream) {
    static int grid = 0;
    if (grid == 0) {
        if (n_in != 26 || (size_t)out_size != O_END || ws_size < WS_END) { fprintf(stderr, "kernel_launch: unexpected problem (n_in %d, out %d vs %zu, ws %zu vs %zu); nothing launched\n", n_in, out_size, (size_t)O_END, ws_size, (size_t)WS_END); grid = -1; return; }
        int dev = 0, cus = 0, per_cu = 0;
        if (hipGetDevice(&dev) != hipSuccess || hipDeviceGetAttribute(&cus, hipDeviceAttributeMultiprocessorCount, dev) != hipSuccess) { grid = -1; return; }
        if (hipFuncSetAttribute((const void*)yoco_fwd, hipFuncAttributeMaxDynamicSharedMemorySize, LDS_BYTES) != hipSuccess) { fprintf(stderr, "kernel_launch: hipFuncSetAttribute failed\n"); grid = -1; return; }
        if (hipOccupancyMaxActiveBlocksPerMultiprocessor(&per_cu, (const void*)yoco_fwd, NTHREADS, LDS_BYTES) != hipSuccess || per_cu < 1) { fprintf(stderr, "kernel_launch: occupancy query says %d\n", per_cu); per_cu = 1; }
        (void)hipGetLastError();
        if (cus != 256) { fprintf(stderr, "kernel_launch: built for a 256-CU device (got %d); nothing launched\n", cus); grid = -1; return; }
        grid = cus;
    }
    if (grid < 0) return;
    if (hipMemsetAsync((char*)d_ws + WS_CTL, 0, CTL_ZERO_BYTES, stream) != hipSuccess) { fprintf(stderr, "kernel_launch: memset failed\n"); return; }
    Args a{};
    for (int i = 0; i < 26; ++i) a.in[i] = (const float*)d_in[i];
    a.out = (float*)d_out; a.ws = (unsigned char*)d_ws;
#if MK_PER_PHASE
    for (int p = 0; p < NPHASES; ++p) { a.ph_lo = p; a.ph_hi = p + 1; hipLaunchKernelGGL(yoco_fwd, dim3(grid), dim3(NTHREADS), LDS_BYTES, stream, a); }
#else
    a.ph_lo = 0; a.ph_hi = NPHASES;
    void* kargs[] = {&a};
    hipError_t e = hipLaunchCooperativeKernel((const void*)yoco_fwd, dim3(grid), dim3(NTHREADS), kargs, LDS_BYTES, stream);
    if (e != hipSuccess) fprintf(stderr, "kernel_launch: cooperative launch failed: %s (grid %d)\n", hipGetErrorString(e), grid);
#endif
}
```

```cpp
#include <hip/hip_runtime.h>
#include <cstdio>
#include <cstdint>
#include <cmath>
namespace pg8 {
#define PG8_LAS __attribute__((address_space(3)))
typedef unsigned short bf16_t;
typedef short bf16x8 __attribute__((ext_vector_type(8)));
typedef float f32x4 __attribute__((ext_vector_type(4)));
typedef unsigned u32x4 __attribute__((ext_vector_type(4)));
constexpr int BM = 256, BK = 64, HALF = 128, HTB = HALF * BK * 2  , STAGE_BYTES = 8 * HTB, NXCD = 8, WGM = 8;

__host__ __device__ __forceinline__ int lds_byte(int r, int c) { const int st = (r >> 4) * 2 + (c >> 5), rr = r & 15, cc = c & 31, ob = rr * 64 + cc * 2; return st * 1024 + (ob ^ (((ob >> 9) & 1) << 5)); }
__host__ __device__ __forceinline__ void stage_rc(int b, int& R, int& C) { const int st = b / 1024, sb = b % 1024, swz = sb ^ (((sb >> 9) & 1) << 5); R = (st >> 1) * 16 + swz / 64; C = (st & 1) * 32 + (swz % 64) / 2; }
__host__ __device__ __forceinline__ int perm32(int rho) { const int n = rho >> 4, i = rho & 15; return 8 * (i >> 2) + 4 * n + (i & 3); }

struct Unit { int pm, pn, k0, nt, aux; };
struct Gemm { const bf16_t* A; const bf16_t* Bt; int M, N, K; };

struct StaticOrder {
    int nM, nN, nwg, G, c, nt0;
    __host__ __device__ void init(int M, int N, int K, int G_, int c_) { nM = M / BM; nN = N / BM; nwg = nM * nN; G = G_; c = c_; nt0 = K / BK; }
    __host__ __device__ bool next(int i, Unit& u) const {
        const long L = (long)i * G + c; if (L >= nwg) return false;
        int wgid = (int)L; { const int q = nwg / NXCD, r = nwg % NXCD, xcd = wgid % NXCD, off = wgid / NXCD; wgid = (xcd < r ? xcd * (q + 1) : r * (q + 1) + (xcd - r) * q) + off; }
        const int nig = WGM * nN, gid = wgid / nig, fm = gid * WGM, gsz = (nM - fm) < WGM ? (nM - fm) : WGM;
        u.pm = fm + ((wgid % nig) % gsz); u.pn = (wgid % nig) / gsz; u.k0 = 0; u.nt = nt0; u.aux = -1; return true;
    }
    __device__ __forceinline__ void a_ready(const Unit&) const {}
    __device__ __forceinline__ void done(const Unit&) const {}
};
struct ResOrder {
    StaticOrder so; int S, K, c;
    __host__ __device__ void init(int K_, int S_, int G_, int c_) { so.init(64 * BM, 1024, K_, G_, c_); S = S_; K = K_; c = c_; }
    __host__ __device__ bool next(int i, Unit& u) const {
        if (i == 0) return so.next(0, u);
        if (i == 1 && c < 20 * S) { const int t = c / S, sl = c - t * S; u.pm = 64 + (t >> 2); u.pn = t & 3; u.k0 = sl * (K / S); u.nt = K / S / BK; u.aux = sl; return true; }
        return false;
    }
    __device__ __forceinline__ void a_ready(const Unit&) const {}
    __device__ __forceinline__ void done(const Unit&) const {}
};

typedef float f32x2_cv0 __attribute__((ext_vector_type(2))); typedef __bf16 bf16x2_cv0 __attribute__((ext_vector_type(2)));
__device__ __forceinline__ unsigned cvt_pk_bf16(float lo, float hi) { const f32x2_cv0 v = {lo, hi}; const bf16x2_cv0 b = __builtin_convertvector(v, bf16x2_cv0); return __builtin_bit_cast(unsigned, b); }
typedef float f32x2 __attribute__((ext_vector_type(2)));
typedef unsigned u32x2 __attribute__((ext_vector_type(2)));
__device__ __forceinline__ float softplus_f(float x) { const float y = __expf(-fabsf(x)); const float l = (y < 0.03125f) ? y * (1.f - y * (0.5f - y * (1.f / 3.f - 0.25f * y))) : __logf(1.f + y); return fmaxf(x, 0.f) + l; }
struct EpiInProj {
    static constexpr bool PERM = true, AFTER_DRAIN = false;
    bf16_t* ZX; float* DT; const float* dt_bias;
    __device__ __forceinline__ void operator()(const f32x4 (&acc)[2][2][4][2], const Unit& u, int wr, int wc, int fr, int fq) const {
        const int row0 = u.pm * BM + wr * 64 + fr;
        if (u.pn < 24) {
            const int col0 = u.pn * BM + wc * 32 + 8 * fq;
#pragma unroll
            for (int ai = 0; ai < 2; ++ai)
#pragma unroll
                for (int m = 0; m < 4; ++m) { bf16_t* rowp = ZX + (size_t)(row0 + ai * HALF + m * 16) * 6144 + col0;
#pragma unroll
                    for (int bj = 0; bj < 2; ++bj) { const f32x4 v0 = acc[ai][bj][m][0], v1 = acc[ai][bj][m][1];
                        u32x4 w; w.x = cvt_pk_bf16(v0[0], v0[1]); w.y = cvt_pk_bf16(v0[2], v0[3]); w.z = cvt_pk_bf16(v1[0], v1[1]); w.w = cvt_pk_bf16(v1[2], v1[3]);
                        *(u32x4*)(rowp + bj * HALF) = w; } }
        } else if (wc == 0) {
            const int c0 = 8 * fq;
            const f32x4 b0 = *(const f32x4*)(dt_bias + c0), b1 = *(const f32x4*)(dt_bias + c0 + 4);
#pragma unroll
            for (int ai = 0; ai < 2; ++ai)
#pragma unroll
                for (int m = 0; m < 4; ++m) { float* rowp = DT + (size_t)(row0 + ai * HALF + m * 16) * 32 + c0;
                    const f32x4 v0 = acc[ai][0][m][0] + b0, v1 = acc[ai][0][m][1] + b1;
                    f32x4 o0, o1;
#pragma unroll
                    for (int j = 0; j < 4; ++j) { o0[j] = softplus_f(v0[j]); o1[j] = softplus_f(v1[j]); }
                    *(f32x4*)(rowp) = o0; *(f32x4*)(rowp + 4) = o1; }
        }
    }
};
struct EpiRes {
    static constexpr bool PERM = true, AFTER_DRAIN = false;
    const float* X; bf16_t* H; float* SLAB;
    __device__ __forceinline__ void operator()(const f32x4 (&acc)[2][2][4][2], const Unit& u, int wr, int wc, int fr, int fq) const {
        const int row0 = u.pm * BM + wr * 64 + fr, col0 = u.pn * BM + wc * 32 + 8 * fq;
        if (u.aux >= 0) {
            bf16_t* base = (bf16_t*)SLAB + (size_t)u.aux * (1280 * 1024) + (size_t)(row0 - 16384) * 1024 + col0;
#pragma unroll
            for (int ai = 0; ai < 2; ++ai)
#pragma unroll
                for (int m = 0; m < 4; ++m) { bf16_t* rowp = base + (size_t)(ai * HALF + m * 16) * 1024;
#pragma unroll
                    for (int bj = 0; bj < 2; ++bj) { const f32x4 v0 = acc[ai][bj][m][0], v1 = acc[ai][bj][m][1];
                        u32x4 w; w.x = cvt_pk_bf16(v0[0], v0[1]); w.y = cvt_pk_bf16(v0[2], v0[3]); w.z = cvt_pk_bf16(v1[0], v1[1]); w.w = cvt_pk_bf16(v1[2], v1[3]);
                        *(u32x4*)(rowp + bj * HALF) = w; } }
            return;
        }
#pragma unroll
        for (int ai = 0; ai < 2; ++ai) {
            f32x4 r0[4][2], r1[4][2];
            if (X) {
#pragma unroll
                for (int m = 0; m < 4; ++m)
#pragma unroll
                    for (int bj = 0; bj < 2; ++bj) { const float* p = X + (size_t)(row0 + ai * HALF + m * 16) * 1024 + col0 + bj * HALF; r0[m][bj] = *(const f32x4*)p; r1[m][bj] = *(const f32x4*)(p + 4); }
            } else {
                u32x4 hb[4][2];
#pragma unroll
                for (int m = 0; m < 4; ++m)
#pragma unroll
                    for (int bj = 0; bj < 2; ++bj) hb[m][bj] = *(const u32x4*)(H + (size_t)(row0 + ai * HALF + m * 16) * 1024 + col0 + bj * HALF);
#pragma unroll
                for (int m = 0; m < 4; ++m)
#pragma unroll
                    for (int bj = 0; bj < 2; ++bj) { const u32x4 w = hb[m][bj];
                        r0[m][bj] = (f32x4){__uint_as_float(w.x << 16), __uint_as_float(w.x & 0xffff0000u), __uint_as_float(w.y << 16), __uint_as_float(w.y & 0xffff0000u)};
                        r1[m][bj] = (f32x4){__uint_as_float(w.z << 16), __uint_as_float(w.z & 0xffff0000u), __uint_as_float(w.w << 16), __uint_as_float(w.w & 0xffff0000u)}; }
            }
#pragma unroll
            for (int m = 0; m < 4; ++m)
#pragma unroll
                for (int bj = 0; bj < 2; ++bj) { const f32x4 v0 = r0[m][bj] + acc[ai][bj][m][0], v1 = r1[m][bj] + acc[ai][bj][m][1];
                    u32x4 w; w.x = cvt_pk_bf16(v0[0], v0[1]); w.y = cvt_pk_bf16(v0[2], v0[3]); w.z = cvt_pk_bf16(v1[0], v1[1]); w.w = cvt_pk_bf16(v1[2], v1[3]);
                    *(u32x4*)(H + (size_t)(row0 + ai * HALF + m * 16) * 1024 + col0 + bj * HALF) = w; }
        }
    }
};
template <int ACT> struct EpiBf {
    static constexpr bool PERM = true, AFTER_DRAIN = false;
    bf16_t* O0; int ldc0; int nsplit; bf16_t* O1; int ldc1;
    __device__ __forceinline__ void operator()(const f32x4 (&acc)[2][2][4][2], const Unit& u, int wr, int wc, int fr, int fq) const {
        const int row0 = u.pm * BM + wr * 64 + fr;
        bf16_t* base; int ldc, colt;
        if (u.pn < nsplit) { base = O0; ldc = ldc0; colt = u.pn * BM; } else { base = O1; ldc = ldc1; colt = (u.pn - nsplit) * BM; }
        const int col0 = colt + wc * 32 + 8 * fq;
#pragma unroll
        for (int ai = 0; ai < 2; ++ai)
#pragma unroll
            for (int m = 0; m < 4; ++m) { bf16_t* rowp = base + (size_t)(row0 + ai * HALF + m * 16) * ldc + col0;
#pragma unroll
                for (int bj = 0; bj < 2; ++bj) { f32x4 v0 = acc[ai][bj][m][0], v1 = acc[ai][bj][m][1];
                    if (ACT == 1) {
#pragma unroll
                        for (int j = 0; j < 4; ++j) { const float a = fmaxf(v0[j], 0.f), b = fmaxf(v1[j], 0.f); v0[j] = a * a; v1[j] = b * b; } }
                    u32x4 w; w.x = cvt_pk_bf16(v0[0], v0[1]); w.y = cvt_pk_bf16(v0[2], v0[3]); w.z = cvt_pk_bf16(v1[0], v1[1]); w.w = cvt_pk_bf16(v1[2], v1[3]);
                    *(u32x4*)(rowp + bj * HALF) = w; } }
    }
};
struct EpiQSplit {
    static constexpr bool PERM = true, AFTER_DRAIN = false;
    bf16_t* Q; float* SLAB;
    __device__ __forceinline__ void operator()(const f32x4 (&acc)[2][2][4][2], const Unit& u, int wr, int wc, int fr, int fq) const {
        const int row0 = u.pm * BM + wr * 64 + fr, col0 = u.pn * BM + wc * 32 + 8 * fq;
        if (u.aux >= 0) {
            float* base = SLAB + (size_t)u.aux * (1280 * 1024) + (size_t)(row0 - 16384) * 1024 + col0;
#pragma unroll
            for (int ai = 0; ai < 2; ++ai)
#pragma unroll
                for (int m = 0; m < 4; ++m) { float* rowp = base + (size_t)(ai * HALF + m * 16) * 1024;
#pragma unroll
                    for (int bj = 0; bj < 2; ++bj) { *(f32x4*)(rowp + bj * HALF) = acc[ai][bj][m][0]; *(f32x4*)(rowp + bj * HALF + 4) = acc[ai][bj][m][1]; } }
            return;
        }
#pragma unroll
        for (int ai = 0; ai < 2; ++ai)
#pragma unroll
            for (int m = 0; m < 4; ++m) { bf16_t* rowp = Q + (size_t)(row0 + ai * HALF + m * 16) * 1024 + col0;
#pragma unroll
                for (int bj = 0; bj < 2; ++bj) { const f32x4 v0 = acc[ai][bj][m][0], v1 = acc[ai][bj][m][1];
                    u32x4 w; w.x = cvt_pk_bf16(v0[0], v0[1]); w.y = cvt_pk_bf16(v0[2], v0[3]); w.z = cvt_pk_bf16(v1[0], v1[1]); w.w = cvt_pk_bf16(v1[2], v1[3]);
                    *(u32x4*)(rowp + bj * HALF) = w; } }
    }
};

template <class Epi, class Sched, bool ALIGN_EPI = false, bool SP2 = false>
__device__ __forceinline__ void gemm_phase(PG8_LAS unsigned char* lds, const Gemm g, const Sched& S, const Epi& E) {
    int tid_l = threadIdx.x; asm volatile("" : "+v"(tid_l));
    const int tid = tid_l, wid = __builtin_amdgcn_readfirstlane(tid >> 6), lane = tid & 63, wr = wid >> 2, wc = wid & 3, fr = lane & 15, fq = lane >> 4;
    const int K = g.K;
    unsigned voffA[2], voffB[2];
#pragma unroll
    for (int i = 0; i < 2; ++i) { int R, C; stage_rc(tid * 16 + i * 8192, R, C); const int Rb = Epi::PERM ? ((R & ~31) + perm32(R & 31)) : R;
        voffA[i] = (unsigned)(R * K + C) * 2u; voffB[i] = (unsigned)(Rb * K + C) * 2u; }
    const size_t kstep = (size_t)(BK * 2);
    const size_t hstep = (size_t)HALF * K * 2;
    const size_t tstep = 2 * hstep;
    const unsigned ldsw = (unsigned)wid * 1024u;
    const int aoff = lds_byte(wr * 64 + fr, fq * 8), boff = lds_byte(wc * 32 + fr, fq * 8);
#define PG8_SA(b, h) (((b) * 2 + (h)) * HTB)
#define PG8_SB(b, h) ((4 + (b) * 2 + (h)) * HTB)
#define PG8_STAGE(bufoff, gbase, voff) do { _Pragma("unroll") for (int _i = 0; _i < 2; ++_i) \
        __builtin_amdgcn_global_load_lds((const unsigned*)((const char*)(gbase) + (voff)[_i]), (PG8_LAS unsigned*)(lds + (bufoff) + ldsw + _i * 8192), 16, 0, 0); } while (0)
#define PG8_LDA(dst, b, h) do { _Pragma("unroll") for (int m = 0; m < 4; ++m) _Pragma("unroll") for (int k = 0; k < 2; ++k) dst[m][k] = *(const PG8_LAS bf16x8*)(lds + PG8_SA(b, h) + aoff + m * 2048 + k * 1024); } while (0)
#define PG8_LDB(dst, b, h) do { _Pragma("unroll") for (int n = 0; n < 2; ++n) _Pragma("unroll") for (int k = 0; k < 2; ++k) dst[n][k] = *(const PG8_LAS bf16x8*)(lds + PG8_SB(b, h) + boff + n * 2048 + k * 1024); } while (0)
#define PG8_MMA(ai, bj, At, Bt) do { __builtin_amdgcn_s_setprio(1); _Pragma("unroll") for (int m = 0; m < 4; ++m) _Pragma("unroll") for (int n = 0; n < 2; ++n) _Pragma("unroll") for (int k = 0; k < 2; ++k) \
        acc[ai][bj][m][n] = __builtin_amdgcn_mfma_f32_16x16x32_bf16(Bt[n][k], At[m][k], acc[ai][bj][m][n], 0, 0, 0); __builtin_amdgcn_s_setprio(0); } while (0)
#define PG8_WAIT_V(n) asm volatile("s_waitcnt vmcnt(" #n ")" ::: "memory")
#define PG8_WAIT_L(n) asm volatile("s_waitcnt lgkmcnt(" #n ")" ::: "memory")
#define PG8_BAR __builtin_amdgcn_s_barrier()
#define PG8_SCHED __builtin_amdgcn_sched_barrier(0)
    Unit cur, nxt; int ui = 0;
    if (!S.next(0, cur)) return;
    f32x4 acc[2][2][4][2];
#pragma unroll
    for (int a = 0; a < 2; ++a)
#pragma unroll
        for (int b = 0; b < 2; ++b)
#pragma unroll
            for (int m = 0; m < 4; ++m)
#pragma unroll
                for (int n = 0; n < 2; ++n) acc[a][b][m][n] = (f32x4){0.f, 0.f, 0.f, 0.f};
    bf16x8 At[4][2], B0[2][2], B1[2][2];
    const char* cA = (const char*)g.A + (size_t)cur.pm * tstep + (size_t)cur.k0 * 2; const char* cB = (const char*)g.Bt + (size_t)cur.pn * tstep + (size_t)cur.k0 * 2;
    S.a_ready(cur);
    if constexpr (SP2) {
        PG8_STAGE(PG8_SB(0, 0), cB, voffB); PG8_STAGE(PG8_SB(0, 1), cB + hstep, voffB); PG8_STAGE(PG8_SA(0, 0), cA, voffA); PG8_STAGE(PG8_SA(0, 1), cA + hstep, voffA);
        if (wr == 1) PG8_BAR;
        PG8_WAIT_V(2); PG8_BAR;
        PG8_STAGE(PG8_SB(1, 0), cB + kstep, voffB); PG8_STAGE(PG8_SA(1, 0), cA + kstep, voffA); PG8_STAGE(PG8_SB(1, 1), cB + hstep + kstep, voffB);
        PG8_WAIT_V(6); PG8_BAR;
    } else {
        PG8_STAGE(PG8_SB(0, 0), cB, voffB); PG8_STAGE(PG8_SA(0, 0), cA, voffA); PG8_STAGE(PG8_SB(0, 1), cB + hstep, voffB); PG8_STAGE(PG8_SA(0, 1), cA + hstep, voffA);
        if (wr == 1) PG8_BAR;
        PG8_WAIT_V(4); PG8_BAR;
        PG8_STAGE(PG8_SB(1, 0), cB + kstep, voffB); PG8_STAGE(PG8_SA(1, 0), cA + kstep, voffA); PG8_STAGE(PG8_SB(1, 1), cB + hstep + kstep, voffB);
        PG8_WAIT_V(6); PG8_BAR;
    }
    for (;;) {
        const bool has_next = S.next(ui + 1, nxt);
        const char* nA = has_next ? (const char*)g.A + (size_t)nxt.pm * tstep + (size_t)nxt.k0 * 2 : cA; const char* nB = has_next ? (const char*)g.Bt + (size_t)nxt.pn * tstep + (size_t)nxt.k0 * 2 : cB;
        const int nt = cur.nt;
        for (int t = 0; t < nt; t += 2) {
            const bool last = (t == nt - 2);
            const char* a1 = cA + (size_t)(t + 1) * kstep;
            const char* a2 = last ? nA : cA + (size_t)(t + 2) * kstep; const char* b2 = last ? nB : cB + (size_t)(t + 2) * kstep;
            const char* a3 = a2 + kstep; const char* b3 = b2 + kstep;
            if (last && has_next) S.a_ready(nxt);
            if constexpr (SP2) {
            PG8_LDB(B0, 0, 0); PG8_LDB(B1, 0, 1); PG8_SCHED; PG8_LDA(At, 0, 0); PG8_STAGE(PG8_SA(1, 1), a1 + hstep, voffA);
            PG8_WAIT_V(8); PG8_WAIT_L(0); PG8_BAR; PG8_MMA(0, 0, At, B0); PG8_MMA(0, 1, At, B1); PG8_BAR; PG8_SCHED;
            PG8_LDA(At, 0, 1); PG8_STAGE(PG8_SB(0, 0), b2, voffB); PG8_STAGE(PG8_SB(0, 1), b2 + hstep, voffB); PG8_STAGE(PG8_SA(0, 0), a2, voffA);
            PG8_WAIT_V(8); PG8_WAIT_L(0); PG8_BAR; PG8_MMA(1, 0, At, B0); PG8_MMA(1, 1, At, B1); PG8_BAR; PG8_SCHED;
            PG8_LDB(B0, 1, 0); PG8_LDB(B1, 1, 1); PG8_SCHED; PG8_LDA(At, 1, 0); PG8_STAGE(PG8_SA(0, 1), a2 + hstep, voffA);
            PG8_WAIT_V(8); PG8_WAIT_L(0); PG8_BAR; PG8_MMA(0, 0, At, B0); PG8_MMA(0, 1, At, B1); PG8_BAR; PG8_SCHED;
            PG8_LDA(At, 1, 1); PG8_STAGE(PG8_SB(1, 0), b3, voffB); PG8_STAGE(PG8_SB(1, 1), b3 + hstep, voffB); PG8_STAGE(PG8_SA(1, 0), a3, voffA);
            PG8_WAIT_V(8); PG8_WAIT_L(0); PG8_BAR; PG8_MMA(1, 0, At, B0); PG8_MMA(1, 1, At, B1); PG8_BAR; PG8_SCHED;
            } else {
            PG8_LDB(B0, 0, 0); PG8_SCHED; PG8_LDA(At, 0, 0); PG8_STAGE(PG8_SA(1, 1), a1 + hstep, voffA);
            PG8_WAIT_L(8); PG8_BAR; PG8_WAIT_L(0); PG8_MMA(0, 0, At, B0); PG8_BAR; PG8_SCHED;
            PG8_LDB(B1, 0, 1); PG8_STAGE(PG8_SB(0, 0), b2, voffB);
            PG8_BAR; PG8_WAIT_L(0); PG8_MMA(0, 1, At, B1); PG8_BAR;
            PG8_LDA(At, 0, 1); PG8_STAGE(PG8_SA(0, 0), a2, voffA);
            PG8_BAR; PG8_WAIT_L(0); PG8_MMA(1, 0, At, B0); PG8_BAR; PG8_SCHED;
            PG8_STAGE(PG8_SB(0, 1), b2 + hstep, voffB);
            PG8_WAIT_V(6); PG8_BAR; PG8_MMA(1, 1, At, B1); PG8_BAR;
            PG8_LDB(B0, 1, 0); PG8_SCHED; PG8_LDA(At, 1, 0); PG8_STAGE(PG8_SA(0, 1), a2 + hstep, voffA);
            PG8_WAIT_L(8); PG8_BAR; PG8_WAIT_L(0); PG8_MMA(0, 0, At, B0); PG8_BAR; PG8_SCHED;
            PG8_LDB(B1, 1, 1); PG8_STAGE(PG8_SB(1, 0), b3, voffB);
            PG8_BAR; PG8_WAIT_L(0); PG8_MMA(0, 1, At, B1); PG8_BAR;
            PG8_LDA(At, 1, 1); PG8_STAGE(PG8_SA(1, 0), a3, voffA);
            PG8_BAR; PG8_WAIT_L(0); PG8_MMA(1, 0, At, B0); PG8_BAR; PG8_SCHED;
            PG8_STAGE(PG8_SB(1, 1), b3 + hstep, voffB);
            PG8_WAIT_V(6); PG8_BAR; PG8_MMA(1, 1, At, B1); PG8_BAR;
            }
        }
        if constexpr (ALIGN_EPI) { if (wr == 0) PG8_BAR; }
        if constexpr (!Epi::AFTER_DRAIN) { E(acc, cur, wr, wc, fr, fq); S.done(cur); }
        if (!has_next) break;
#pragma unroll
        for (int a = 0; a < 2; ++a)
#pragma unroll
            for (int b = 0; b < 2; ++b)
#pragma unroll
                for (int m = 0; m < 4; ++m)
#pragma unroll
                    for (int n = 0; n < 2; ++n) acc[a][b][m][n] = (f32x4){0.f, 0.f, 0.f, 0.f};
        cur = nxt; cA = nA; cB = nB; ++ui;
        if constexpr (ALIGN_EPI) { if (wr == 1) PG8_BAR; }
    }
    PG8_WAIT_V(0);
    if constexpr (!ALIGN_EPI) { if (wr == 0) PG8_BAR; }
    PG8_BAR;
    if constexpr (Epi::AFTER_DRAIN) { E.fused(acc, cur, wr, wc, fr, fq, lds, wid, lane); S.done(cur); }
#undef PG8_SA
#undef PG8_SB
#undef PG8_STAGE
#undef PG8_LDA
#undef PG8_LDB
#undef PG8_MMA
#undef PG8_WAIT_V
#undef PG8_WAIT_L
#undef PG8_BAR
#undef PG8_SCHED
}
}
#define GAS __attribute__((address_space(1)))
#define LAS __attribute__((address_space(3)))
typedef unsigned short bf16;
typedef unsigned v4u __attribute__((ext_vector_type(4)));
typedef float f32x4 __attribute__((ext_vector_type(4)));
typedef short bf16x8 __attribute__((ext_vector_type(8)));
typedef GAS unsigned gu32;
typedef GAS unsigned long long gu64;
#define RLX_AGENT __ATOMIC_RELAXED, __HIP_MEMORY_SCOPE_AGENT
#define LDS_WAIT() asm volatile("s_waitcnt lgkmcnt(0)" ::: "memory")
#define VM_WAIT() asm volatile("s_waitcnt vmcnt(0)" ::: "memory")
__device__ __forceinline__ unsigned long long rt() { return __builtin_amdgcn_s_memrealtime(); }
__device__ __forceinline__ unsigned f2bf(float f) { unsigned u = __builtin_bit_cast(unsigned, f); return (u + 0x7fffu + ((u >> 16) & 1u)) >> 16; }
__device__ __forceinline__ unsigned pk2(float lo, float hi) { return f2bf(lo) | (f2bf(hi) << 16); }

#define XB_TMO      128
#define XB_XCNT(j)  (256  + 64 * (j))
#define XB_XSUB(j)  (1280 + 64 * (j))
#define XB_XGEN(j)  (2304 + 64 * (j))
#define XB_TOP      3328
#define XB_TOPGEN   3392
#define XCD_BAR_WORDS 3456
#define XB_SPIN_CAP (1u << 18)

__device__ __forceinline__ unsigned xb_ld(unsigned* p)              { return __hip_atomic_load(p, __ATOMIC_RELAXED, __HIP_MEMORY_SCOPE_AGENT); }
__device__ __forceinline__ unsigned xb_add(unsigned* p, unsigned v) { return __hip_atomic_fetch_add(p, v, __ATOMIC_RELAXED, __HIP_MEMORY_SCOPE_AGENT); }
__device__ __forceinline__ unsigned xb_xcc_id() { return (unsigned)__builtin_amdgcn_s_getreg((3 << 11) | 20) & 0xFu; }
#define XB_SPIN(cond, bar) do { unsigned _sp = 0; while (cond) { __builtin_amdgcn_s_sleep(1); \
    if ((++_sp & 255u) == 0u) { if (xb_ld(&(bar)[XB_TMO])) break; if (_sp > XB_SPIN_CAP) { atomicAdd(&(bar)[XB_TMO], 1u); break; } } } } while (0)

struct XcdBarrier {
    unsigned* bar; unsigned x;
    volatile LAS unsigned* st;
};

__device__ __forceinline__ XcdBarrier xcd_barrier_post(unsigned* bar, volatile LAS unsigned* st) {
    XcdBarrier b; b.bar = bar; b.x = xb_xcc_id(); b.st = st;
    if (threadIdx.x == 0) (void)xb_add(&bar[XB_XCNT(b.x)], 1u);
    return b;
}
__device__ __forceinline__ void xcd_barrier_complete(unsigned* bar, unsigned x, unsigned& nloc, unsigned& nx) {
    const unsigned G = gridDim.x * gridDim.y * gridDim.z;
    unsigned sum, cnt, mine, sp = 0u;
    for (;;) {
        sum = 0u; cnt = 0u; mine = 0u;
#pragma unroll
        for (unsigned j = 0; j < 16; ++j) { const unsigned c = xb_ld(&bar[XB_XCNT(j)]); sum += c; cnt += (c > 0u) ? 1u : 0u; mine = (j == x) ? c : mine; }
        if (sum == G) break;
        __builtin_amdgcn_s_sleep(1);
        if ((++sp & 255u) == 0u) { if (xb_ld(&bar[XB_TMO])) break; if (sp > XB_SPIN_CAP) { atomicAdd(&bar[XB_TMO], 1u); break; } }
    }
    nloc = mine > 0u ? mine : 1u; nx = cnt > 0u ? cnt : 1u;
}

__device__ __forceinline__ void xcd_barrier(const XcdBarrier& b) {
    asm volatile("s_waitcnt vmcnt(0)" ::: "memory");
    __syncthreads();
    if (threadIdx.x == 0) {
        unsigned* bar = b.bar;
        __builtin_amdgcn_s_waitcnt(0);
        unsigned nloc = b.st[0], nx = b.st[1];
        if (nloc == 0u) { xcd_barrier_complete(bar, b.x, nloc, nx); b.st[0] = nloc; b.st[1] = nx; }
        const unsigned old = xb_add(&bar[XB_XSUB(b.x)], 1u);
        const unsigned gen = old / nloc;
        if (old + 1u == (gen + 1u) * nloc) {
            __builtin_amdgcn_fence(__ATOMIC_RELEASE, "agent");
            asm volatile("s_waitcnt vmcnt(0)" ::: "memory");
            const unsigned og = xb_add(&bar[XB_TOP], 1u);
            const unsigned tg = og / nx;
            if (og + 1u == (tg + 1u) * nx) xb_add(&bar[XB_TOPGEN], 1u);
            else XB_SPIN(xb_ld(&bar[XB_TOPGEN]) == tg, bar);
            __builtin_amdgcn_fence(__ATOMIC_ACQUIRE, "agent");
            xb_add(&bar[XB_XGEN(b.x)], 1u);
            asm volatile("s_waitcnt vmcnt(0)" ::: "memory");
        } else {
            XB_SPIN(xb_ld(&bar[XB_XGEN(b.x)]) == gen, bar);
            __builtin_amdgcn_fence(__ATOMIC_ACQUIRE, "agent");
            asm volatile("s_waitcnt vmcnt(0)" ::: "memory");
        }
    }
    __syncthreads();
}
constexpr int NWAVES = 8, NTHREADS = 512;
constexpr int DM = 1024, SEQ = 8192, NPROMPT = 2, NSAMP = 128, TSAMP = 8, NMETA = 16;
constexpr int ROW_S = NPROMPT * SEQ;
constexpr int ROW_M = ROW_S + NSAMP * TSAMP;
constexpr int NROWS = ROW_M + NMETA;
constexpr int MP = 17664;
constexpr int DINNER = 2048, NHEADS = 32, HD = 64, NGROUPS = 8, DSTATE = 128, CONVD = 4096, INPROJ = 6176, INPROJ_P = 6400, ZXW = 6144;
constexpr int DFF = 4096, NKV = 4, NQ = 16, KVW = 512;
constexpr float EPS = 1e-5f;
constexpr int LDX = 136;

constexpr size_t O_YP = 0, O_YS = O_YP + (size_t)NPROMPT * SEQ * DM, O_PCONV = O_YS + (size_t)NSAMP * TSAMP * DM, O_PSSM = O_PCONV + 2 * 2 * 3 * 4096,
    O_PCK = O_PSSM + (size_t)2 * 2 * 32 * 64 * 128, O_PCV = O_PCK + 2 * 128 * 256, O_SCONV = O_PCV + 2 * 128 * 256, O_SSSM = O_SCONV + (size_t)2 * 128 * 3 * 4096,
    O_SCK = O_SSSM + (size_t)2 * 128 * 32 * 64 * 128, O_SCV = O_SCK + (size_t)128 * 128 * 256, O_END = O_SCV + (size_t)128 * 128 * 256;

constexpr size_t MiB = 1u << 20;
constexpr size_t WS_CTL = 0, CTL_ZERO_BYTES = 1 * MiB;
constexpr size_t SZ_WIN = (size_t)INPROJ_P * 1024 * 2, SZ_WOUT = (size_t)1024 * 2048 * 2, SZ_WUP = (size_t)4096 * 1024 * 2, SZ_WDN = SZ_WUP, SZ_WQKV0 = (size_t)1536 * 1024 * 2, SZ_WQ1 = (size_t)1024 * 1024 * 2, SZ_WO = SZ_WQ1;
constexpr size_t WS_WIN = 1 * MiB, WS_WOUT = WS_WIN + 2 * SZ_WIN, WS_WUP = WS_WOUT + 2 * SZ_WOUT, WS_WDN = WS_WUP + 4 * SZ_WUP, WS_WQKV0 = WS_WDN + 4 * SZ_WDN, WS_WQ1 = WS_WQKV0 + SZ_WQKV0, WS_WO = WS_WQ1 + SZ_WQ1, WS_WEND = WS_WO + 2 * SZ_WO;
constexpr size_t al1m(size_t x) { return (x + MiB - 1) / MiB * MiB; }
constexpr size_t WS_H = al1m(WS_WEND), WS_HN = al1m(WS_H + (size_t)MP * 1024 * 4), WS_ZX = al1m(WS_HN + (size_t)MP * 1024 * 2), WS_DT = al1m(WS_ZX + (size_t)MP * ZXW * 2),
    WS_XC = al1m(WS_DT + (size_t)MP * 32 * 4), WS_YN = al1m(WS_XC + (size_t)MP * 4096 * 2), WS_CS = al1m(WS_YN + (size_t)MP * 2048 * 2), WS_CD = al1m(WS_CS + (size_t)129 * 32 * 8192 * 4), WS_SLAB = al1m(WS_CD + 129 * 32 * 4), WS_HSB = al1m(WS_SLAB + (size_t)8 * 1280 * 1024 * 4), WS_END = al1m(WS_HSB + (size_t)128 * 32 * 8192 * 2);
constexpr size_t WS_U = WS_ZX;
constexpr size_t WS_Q = WS_XC, WS_KV = WS_Q + (size_t)MP * 1024 * 2, WS_AO = WS_KV + (size_t)MP * 512 * 2;
static_assert(WS_AO + (size_t)MP * 1024 * 2 <= WS_YN, "attention overlay");
constexpr int CW_BAR = 4096;

constexpr int RING_BYTES = 131072, LDS_BYTES = 147456, LDSCTL_OFF = LDS_BYTES - 512, MISC_OFF = LDSCTL_OFF + 320;

typedef unsigned u32x2 __attribute__((ext_vector_type(2)));
typedef unsigned u32x4 __attribute__((ext_vector_type(4)));
__device__ __forceinline__ int ltid() { int t = threadIdx.x; asm volatile("" : "+v"(t)); return t; }
__device__ __forceinline__ float bf2f(unsigned short b) { return __uint_as_float((unsigned)b << 16); }
__device__ __forceinline__ float bflo(unsigned w) { return __uint_as_float(w << 16); }
__device__ __forceinline__ float bfhi(unsigned w) { return __uint_as_float(w & 0xffff0000u); }
__device__ __forceinline__ unsigned pkbf(float lo, float hi) { return pg8::cvt_pk_bf16(lo, hi); }
__device__ __forceinline__ float wave_sum(float v) {
#pragma unroll
    for (int o = 1; o < 64; o <<= 1) v += __shfl_xor(v, o);
    return v;
}
__device__ __forceinline__ float frcp(float x) { return __builtin_amdgcn_rcpf(x); }
__device__ __forceinline__ float sigmoid_f(float x) { return frcp(1.f + __expf(-x)); }
#define MFMA16(b, a, c) __builtin_amdgcn_mfma_f32_16x16x32_bf16((b), (a), (c), 0, 0, 0)

struct Args {
    const float* in[26]; float* out; unsigned char* ws; int ph_lo, ph_hi;
};
typedef const __attribute__((address_space(4))) Args* ArgsP;
enum { I_XP = 0, I_XS, I_SCONV, I_SSSM, I_CK, I_CV, I_META, I_ANORM, I_AIN, I_ACONVW, I_ACONVB, I_ADTB, I_ALOG, I_ADSKIP, I_AGATE, I_AOUT, I_KVNORM, I_WKV, I_BNORM, I_WQ, I_SINKS, I_WO, I_MLPNORM, I_WUP, I_WDOWN, I_FNORM };

__device__ __forceinline__ void transpose_item(const float* W, const float* scale, int K, int N, bf16* WT, int row_off, LAS unsigned* scr, int item, int lane) {
    const int nblk = (N + 63) / 64, kb = item / nblk, nb = item % nblk, k0 = 64 * kb, n0 = 64 * nb;
    const bool ok = (n0 + lane < N);
    const float* src = W + (size_t)k0 * N + n0 + (ok ? lane : 0);
    float v[64];
#pragma unroll
    for (int i = 0; i < 64; ++i) v[i] = __builtin_nontemporal_load(src + (size_t)i * N);
    if (!ok) {
#pragma unroll
        for (int i = 0; i < 64; ++i) v[i] = 0.f;
    }
    if (scale) {
#pragma unroll
        for (int i = 0; i < 64; ++i) v[i] *= scale[k0 + i];
    }
#pragma unroll
    for (int i = 0; i < 32; ++i) scr[lane * 33 + i] = pkbf(v[2 * i], v[2 * i + 1]);
    LDS_WAIT(); asm volatile("" ::: "memory");
    const int c = lane & 7;
#pragma unroll
    for (int j = 0; j < 8; ++j) { const int n = (lane >> 3) + 8 * j; const LAS unsigned* sp = scr + n * 33 + 4 * c;
        v4u o; o.x = sp[0]; o.y = sp[1]; o.z = sp[2]; o.w = sp[3];
        if (n0 + n < N) *(GAS v4u*)(WT + (size_t)(row_off + n0 + n) * K + k0 + 8 * c) = o; }
    LDS_WAIT(); asm volatile("" ::: "memory");
}
struct WJob { const float* W; const float* scale; int K, N; bf16* WT; int row_off; int items; };

__device__ __forceinline__ void phase_prologue(ArgsP a, LAS unsigned char* lds, int wave, int lane) {
    LAS unsigned* scr = (LAS unsigned*)(lds + wave * 16384);
    const int gw = blockIdx.x * NWAVES + wave, NGW = gridDim.x * NWAVES;
    unsigned char* ws = a->ws;
    for (int jb = 0; jb < 21; ++jb) {
        WJob J;
        if (jb < 2)       { const int i = jb;      J = WJob{a->in[I_AIN] + (size_t)i * 1024 * INPROJ, a->in[I_ANORM] + i * 1024, 1024, INPROJ, (bf16*)(ws + WS_WIN + i * SZ_WIN), 0, 0}; }
        else if (jb < 4)  { const int i = jb - 2;  J = WJob{a->in[I_AOUT] + (size_t)i * 2048 * 1024, a->in[I_AGATE] + i * 2048, 2048, 1024, (bf16*)(ws + WS_WOUT + i * SZ_WOUT), 0, 0}; }
        else if (jb < 8)  { const int l = jb - 4;  J = WJob{a->in[I_WUP] + (size_t)l * 1024 * 4096, a->in[I_MLPNORM] + l * 1024, 1024, 4096, (bf16*)(ws + WS_WUP + l * SZ_WUP), 0, 0}; }
        else if (jb < 12) { const int l = jb - 8;  J = WJob{a->in[I_WDOWN] + (size_t)l * 4096 * 1024, nullptr, 4096, 1024, (bf16*)(ws + WS_WDN + l * SZ_WDN), 0, 0}; }
        else if (jb == 12) { J = WJob{a->in[I_WQ], a->in[I_BNORM], 1024, 1024, (bf16*)(ws + WS_WQKV0), 0, 0}; }
        else if (jb == 13) { J = WJob{a->in[I_WKV], a->in[I_KVNORM], 1024, 512, (bf16*)(ws + WS_WQKV0), 1024, 0}; }
        else if (jb == 14) { J = WJob{a->in[I_WQ] + (size_t)1024 * 1024, a->in[I_BNORM] + 1024, 1024, 1024, (bf16*)(ws + WS_WQ1), 0, 0}; }
        else if (jb < 17) { const int j = jb - 15; J = WJob{a->in[I_WO] + (size_t)j * 1024 * 1024, nullptr, 1024, 1024, (bf16*)(ws + WS_WO + j * SZ_WO), 0, 0}; }
        else break;
        const int items = (J.K / 64) * ((J.N + 63) / 64);
        for (int it = gw; it < items; it += NGW) transpose_item(J.W, J.scale, J.K, J.N, J.WT, J.row_off, scr, it, lane);
    }
    {
        const int gt = blockIdx.x * NTHREADS + ltid(), NT = gridDim.x * NTHREADS;
        const int per = (INPROJ_P - INPROJ) * 1024 * 2 / 16;
        for (int e = gt; e < 2 * per; e += NT) { const int i = e / per, c = e % per;
            *(v4u*)(ws + WS_WIN + i * SZ_WIN + (size_t)INPROJ * 1024 * 2 + (size_t)c * 16) = (v4u){0u, 0u, 0u, 0u}; }
    }
}

__device__ __forceinline__ void row_ld_bf(const bf16* __restrict__ p, int lane, float (&v)[16]) {
    const u32x4 a0 = *(const u32x4*)(p + 8 * lane), a1 = *(const u32x4*)(p + 512 + 8 * lane);
    v[0] = bflo(a0.x); v[1] = bfhi(a0.x); v[2] = bflo(a0.y); v[3] = bfhi(a0.y); v[4] = bflo(a0.z); v[5] = bfhi(a0.z); v[6] = bflo(a0.w); v[7] = bfhi(a0.w);
    v[8] = bflo(a1.x); v[9] = bfhi(a1.x); v[10] = bflo(a1.y); v[11] = bfhi(a1.y); v[12] = bflo(a1.z); v[13] = bfhi(a1.z); v[14] = bflo(a1.w); v[15] = bfhi(a1.w);
}
__device__ __forceinline__ void row_ld_f32(const float* __restrict__ p, int lane, float (&v)[16], bool nt) {
    f32x4 q[4];
    if (nt) { q[0] = __builtin_nontemporal_load((const f32x4*)(p + 8 * lane)); q[1] = __builtin_nontemporal_load((const f32x4*)(p + 8 * lane + 4)); q[2] = __builtin_nontemporal_load((const f32x4*)(p + 512 + 8 * lane)); q[3] = __builtin_nontemporal_load((const f32x4*)(p + 512 + 8 * lane + 4)); }
    else { q[0] = *(const f32x4*)(p + 8 * lane); q[1] = *(const f32x4*)(p + 8 * lane + 4); q[2] = *(const f32x4*)(p + 512 + 8 * lane); q[3] = *(const f32x4*)(p + 512 + 8 * lane + 4); }
#pragma unroll
    for (int k = 0; k < 4; ++k) { v[4 * k] = q[k].x; v[4 * k + 1] = q[k].y; v[4 * k + 2] = q[k].z; v[4 * k + 3] = q[k].w; }
}
__device__ __forceinline__ void row_st_bf(bf16* __restrict__ p, int lane, const float (&v)[16], float sc) {
    u32x4 a0, a1;
    a0.x = pkbf(v[0] * sc, v[1] * sc); a0.y = pkbf(v[2] * sc, v[3] * sc); a0.z = pkbf(v[4] * sc, v[5] * sc); a0.w = pkbf(v[6] * sc, v[7] * sc);
    a1.x = pkbf(v[8] * sc, v[9] * sc); a1.y = pkbf(v[10] * sc, v[11] * sc); a1.z = pkbf(v[12] * sc, v[13] * sc); a1.w = pkbf(v[14] * sc, v[15] * sc);
    *(u32x4*)(p + 8 * lane) = a0; *(u32x4*)(p + 512 + 8 * lane) = a1;
}
__device__ __forceinline__ float row_rs(const float (&v)[16]) {
    float s = 0.f;
#pragma unroll
    for (int k = 0; k < 16; ++k) s += v[k] * v[k];
    return rsqrtf(wave_sum(s) * (1.f / DM) + EPS);
}
__device__ __forceinline__ void phase_norm(ArgsP a, int from_inputs, int nslab, int wave, int lane) {
    bf16* __restrict__ H = (bf16*)(a->ws + WS_H); bf16* __restrict__ HN = (bf16*)(a->ws + WS_HN); const float* __restrict__ SLAB = (const float*)(a->ws + WS_SLAB);
    const int gw = blockIdx.x * NWAVES + wave, NGW = gridDim.x * NWAVES;
    for (int m = ROW_S + gw; m < MP; m += NGW) {
        if (m >= NROWS) { *(u32x4*)(HN + (size_t)m * DM + 8 * lane) = (u32x4){0u, 0u, 0u, 0u}; *(u32x4*)(HN + (size_t)m * DM + 512 + 8 * lane) = (u32x4){0u, 0u, 0u, 0u}; continue; }
        float v[16];
        if (from_inputs) row_ld_f32((m < ROW_M) ? a->in[I_XS] + (size_t)(m - ROW_S) * DM : a->in[I_META] + (size_t)(m - ROW_M) * DM, lane, v, false);
        else row_ld_bf(H + (size_t)m * DM, lane, v);
        float sv[8][16];
#pragma unroll
        for (int sl = 0; sl < 8; ++sl) { if (sl < nslab) row_ld_bf((const bf16*)SLAB + (size_t)sl * (1280 * 1024) + (size_t)(m - ROW_S) * DM, lane, sv[sl]); else {
#pragma unroll
                for (int k = 0; k < 16; ++k) sv[sl][k] = 0.f; } }
#pragma unroll
        for (int sl = 0; sl < 8; ++sl)
#pragma unroll
            for (int k = 0; k < 16; ++k) v[k] += sv[sl][k];
        if (nslab > 0 || from_inputs) row_st_bf(H + (size_t)m * DM, lane, v, 1.f);
        row_st_bf(HN + (size_t)m * DM, lane, v, row_rs(v));
    }
    for (int m0 = 4 * gw; m0 < ROW_S; m0 += 4 * NGW) {
        float v[4][16];
#pragma unroll
        for (int q = 0; q < 4; ++q) { if (from_inputs) row_ld_f32(a->in[I_XP] + (size_t)(m0 + q) * DM, lane, v[q], false); else row_ld_bf(H + (size_t)(m0 + q) * DM, lane, v[q]); }
#pragma unroll
        for (int q = 0; q < 4; ++q) row_st_bf(HN + (size_t)(m0 + q) * DM, lane, v[q], row_rs(v[q]));
    }
}
__device__ __forceinline__ void phase_final(ArgsP a, int wave, int lane) {
    const bf16* __restrict__ H = (const bf16*)(a->ws + WS_H); const float* __restrict__ fw = a->in[I_FNORM]; const float* __restrict__ SLAB = (const float*)(a->ws + WS_SLAB);
    const int gw = blockIdx.x * NWAVES + wave, NGW = gridDim.x * NWAVES;
    float w[16]; row_ld_f32(fw, lane, w, false);
    for (int m = gw; m < ROW_M; m += NGW) {
        float v[16]; row_ld_bf(H + (size_t)m * DM, lane, v);
        if (m >= ROW_S) {
#pragma unroll 1
            for (int sl = 0; sl < 8; ++sl) { float t[16]; row_ld_bf((const bf16*)SLAB + (size_t)sl * (1280 * 1024) + (size_t)(m - ROW_S) * DM, lane, t);
#pragma unroll
                for (int k = 0; k < 16; ++k) v[k] += t[k]; }
        }
        const float rs = row_rs(v);
        float* o = a->out + O_YP + (size_t)m * DM;
        __builtin_nontemporal_store((f32x4){v[0] * rs * w[0], v[1] * rs * w[1], v[2] * rs * w[2], v[3] * rs * w[3]}, (f32x4*)(o + 8 * lane));
        __builtin_nontemporal_store((f32x4){v[4] * rs * w[4], v[5] * rs * w[5], v[6] * rs * w[6], v[7] * rs * w[7]}, (f32x4*)(o + 8 * lane + 4));
        __builtin_nontemporal_store((f32x4){v[8] * rs * w[8], v[9] * rs * w[9], v[10] * rs * w[10], v[11] * rs * w[11]}, (f32x4*)(o + 512 + 8 * lane));
        __builtin_nontemporal_store((f32x4){v[12] * rs * w[12], v[13] * rs * w[13], v[14] * rs * w[14], v[15] * rs * w[15]}, (f32x4*)(o + 512 + 8 * lane + 4));
    }
}

__device__ __forceinline__ void unpack8(const u32x4 w, float (&f)[8]) { f[0] = bflo(w.x); f[1] = bfhi(w.x); f[2] = bflo(w.y); f[3] = bfhi(w.y); f[4] = bflo(w.z); f[5] = bfhi(w.z); f[6] = bflo(w.w); f[7] = bfhi(w.w); }
__device__ __forceinline__ void ld8f(const float* __restrict__ p, float (&f)[8]) { const f32x4 x0 = *(const f32x4*)p, x1 = *(const f32x4*)(p + 4); f[0]=x0.x;f[1]=x0.y;f[2]=x0.z;f[3]=x0.w;f[4]=x1.x;f[5]=x1.y;f[6]=x1.z;f[7]=x1.w; }
#define TSW(ch) ((((ch) >> 3) & 7) << 3)
struct ConvW { float w0[8], w1[8], w2[8], w3[8], bs[8]; };
__device__ __forceinline__ void conv_load_w(const float* __restrict__ cw, const float* __restrict__ cb, int c0, ConvW& W) { ld8f(cw + c0, W.w0); ld8f(cw + CONVD + c0, W.w1); ld8f(cw + 2 * CONVD + c0, W.w2); ld8f(cw + 3 * CONVD + c0, W.w3); ld8f(cb + c0, W.bs); }
__device__ __forceinline__ void conv_load_run(const bf16* __restrict__ ZX, int Rrow, int c0, int pk, bool valid, u32x4 (&raw)[11]) {
#pragma unroll
    for (int t = 0; t < 8; ++t) { raw[3 + t] = (u32x4){0u, 0u, 0u, 0u}; if (valid) raw[3 + t] = *(const u32x4*)(ZX + (size_t)(Rrow + t) * ZXW + 2048 + c0); }
#pragma unroll
    for (int t = 0; t < 3; ++t) { const int rr = (pk == 1) ? ROW_M + 13 + t : Rrow - 3 + t; raw[t] = (u32x4){0u, 0u, 0u, 0u}; if (valid && pk != 2) raw[t] = *(const u32x4*)(ZX + (size_t)rr * ZXW + 2048 + c0); }
}
template <int J> __device__ __forceinline__ void conv_channel(const u32x4 (&raw)[11], const ConvW& W, float (&o)[8]) {
    float x[11];
#pragma unroll
    for (int i = 0; i < 11; ++i) { const unsigned w = raw[i][J >> 1]; x[i] = (J & 1) ? bfhi(w) : bflo(w); }
#pragma unroll
    for (int t = 0; t < 8; ++t) { const float v = W.bs[J] + W.w0[J] * x[t] + W.w1[J] * x[t + 1] + W.w2[J] * x[t + 2] + W.w3[J] * x[t + 3]; o[t] = v * sigmoid_f(v); }
}
template <int J> __device__ __forceinline__ void conv_store_t(const u32x4 (&raw)[11], const ConvW& W, const float (&scale)[8], bf16* T, int ch0, int run) {
    float o[8]; conv_channel<J>(raw, W, o);
    u32x4 w; w.x = pkbf(o[0] * scale[0], o[1] * scale[1]); w.y = pkbf(o[2] * scale[2], o[3] * scale[3]); w.z = pkbf(o[4] * scale[4], o[5] * scale[5]); w.w = pkbf(o[6] * scale[6], o[7] * scale[7]);
    *(u32x4*)(T + (ch0 + J) * LDX + ((8 * run) ^ TSW(ch0 + J))) = w;
}
__device__ __forceinline__ void conv_item_t(const u32x4 (&raw)[11], const ConvW& W, const float (&scale)[8], bf16* T, int ch0, int run) {
    conv_store_t<0>(raw, W, scale, T, ch0, run); conv_store_t<1>(raw, W, scale, T, ch0, run); conv_store_t<2>(raw, W, scale, T, ch0, run); conv_store_t<3>(raw, W, scale, T, ch0, run);
    conv_store_t<4>(raw, W, scale, T, ch0, run); conv_store_t<5>(raw, W, scale, T, ch0, run); conv_store_t<6>(raw, W, scale, T, ch0, run); conv_store_t<7>(raw, W, scale, T, ch0, run);
}
__device__ __forceinline__ void conv_item_n(const u32x4 (&raw)[11], const ConvW& W, bf16* N, int run, int colel) {
    float p0[8], p1[8], p2[8]; unpack8(raw[0], p0); unpack8(raw[1], p1); unpack8(raw[2], p2);
#pragma unroll
    for (int t = 0; t < 8; ++t) { float x[8]; unpack8(raw[3 + t], x); float o[8];
#pragma unroll
        for (int j = 0; j < 8; ++j) { const float v = W.bs[j] + W.w0[j] * p0[j] + W.w1[j] * p1[j] + W.w2[j] * p2[j] + W.w3[j] * x[j]; o[j] = v * sigmoid_f(v); }
        u32x4 w; w.x = pkbf(o[0], o[1]); w.y = pkbf(o[2], o[3]); w.z = pkbf(o[4], o[5]); w.w = pkbf(o[6], o[7]);
        *(u32x4*)(N + (8 * run + t) * LDX + colel) = w;
#pragma unroll
        for (int j = 0; j < 8; ++j) { p0[j] = p1[j]; p1[j] = p2[j]; p2[j] = x[j]; } }
}
__device__ __forceinline__ void conv_state_out(const u32x4 (&raw)[11], float* __restrict__ dst  ) {
#pragma unroll
    for (int k = 0; k < 3; ++k) { float x[8]; unpack8(raw[8 + k], x); *(f32x4*)(dst + (size_t)k * CONVD) = (f32x4){x[0], x[1], x[2], x[3]}; *(f32x4*)(dst + (size_t)k * CONVD + 4) = (f32x4){x[4], x[5], x[6], x[7]}; }
}

__device__ __forceinline__ void ssd_acs(const float* DT, const float* alog, int R0, int len, int h0, float* s_dt, float* s_acs, int wave, int lane) {
    if (wave < 4) {
        const int r = wave; const float An = -__expf(alog[h0 + r]);
        const int l0 = 2 * lane;
        const float d0 = (l0 < len) ? DT[(size_t)(R0 + l0) * 32 + h0 + r] : 0.f;
        const float d1 = (l0 + 1 < len) ? DT[(size_t)(R0 + l0 + 1) * 32 + h0 + r] : 0.f;
        const float a0 = d0 * An, a1 = d1 * An, s = a0 + a1;
        float incl = s;
#pragma unroll
        for (int o = 1; o < 64; o <<= 1) { const float t = __shfl_up(incl, o); if (lane >= o) incl += t; }
        const float excl = incl - s;
        s_dt[r * 128 + l0] = d0; s_dt[r * 128 + l0 + 1] = d1;
        s_acs[r * 128 + l0] = excl + a0; s_acs[r * 128 + l0 + 1] = excl + s;
    }
}
#define LFRAG(base, row, ld, ks) (*(const bf16x8*)((base) + (row) * (ld) + 32 * (ks) + 8 * fq))

__device__ __forceinline__ void ssd1_unit(ArgsP a, int li, unsigned char* lds, int slot, int g, int R0, int len, int, int, int) {
    const int tid = ltid(), lane = tid & 63, wave = __builtin_amdgcn_readfirstlane(tid >> 6);
    const float* __restrict__ DT = (const float*)(a->ws + WS_DT);
    bf16* __restrict__ CS = (bf16*)(a->ws + WS_CS); float* __restrict__ CD = (float*)(a->ws + WS_CD);
    bf16* XsT = (bf16*)lds;
    bf16* BT = (bf16*)(lds + 256 * LDX * 2);
    float* s_dt = (float*)(lds + 384 * LDX * 2); float* s_acs = s_dt + 512;
    const int fr = lane & 15, fq = lane >> 4, h0 = g * 4;
    const float* __restrict__ cw = a->in[I_ACONVW] + (size_t)li * 4 * CONVD; const float* __restrict__ cbias = a->in[I_ACONVB] + (size_t)li * CONVD;
    const bf16* __restrict__ ZX = (const bf16*)(a->ws + WS_ZX);
    const bool meta = (slot == 128), chunk0 = (!meta && (slot & 63) == 0);
    const int xcb = tid & 31, xrun = tid >> 5, xc0 = g * 256 + xcb * 8;
    const int bcb = tid & 15, brun = (tid >> 4) & 15, bc0 = 2048 + g * 128 + bcb * 8;
    u32x4 rx[11], rb[11];
    conv_load_run(ZX, R0 + 8 * xrun, xc0, (xrun == 0) ? (meta ? 2 : (chunk0 ? 1 : 0)) : 0, 8 * xrun < len, rx);
    if (tid < 256) conv_load_run(ZX, R0 + 8 * brun, bc0, (brun == 0) ? (meta ? 2 : (chunk0 ? 1 : 0)) : 0, 8 * brun < len, rb);
    ssd_acs(DT, a->in[I_ALOG] + li * NHEADS, R0, len, h0, s_dt, s_acs, wave, lane);
    if (tid < 256) { ConvW W; conv_load_w(cw, cbias, bc0, W); const float one[8] = {1.f, 1.f, 1.f, 1.f, 1.f, 1.f, 1.f, 1.f}; conv_item_t(rb, W, one, BT, bcb * 8, brun); }
    __syncthreads();
    {   ConvW W; conv_load_w(cw, cbias, xc0, W);
        const int r = xcb >> 3; const float tot = s_acs[r * 128 + 127];
        const f32x4 a0 = *(const f32x4*)(s_acs + r * 128 + 8 * xrun), a1 = *(const f32x4*)(s_acs + r * 128 + 8 * xrun + 4), d0 = *(const f32x4*)(s_dt + r * 128 + 8 * xrun), d1 = *(const f32x4*)(s_dt + r * 128 + 8 * xrun + 4);
        float wl[8];
#pragma unroll
        for (int t = 0; t < 4; ++t) { wl[t] = __expf(tot - a0[t]) * d0[t]; wl[4 + t] = __expf(tot - a1[t]) * d1[t]; }
        conv_item_t(rx, W, wl, XsT, xcb * 8, xrun);
    }
    __syncthreads();
    f32x4 acc[2][8];
#pragma unroll
    for (int mi = 0; mi < 2; ++mi)
#pragma unroll
        for (int ni = 0; ni < 8; ++ni) acc[mi][ni] = (f32x4){0.f, 0.f, 0.f, 0.f};
#pragma unroll
    for (int ks = 0; ks < 4; ++ks) {
        const int ra0 = 32 * wave + fr, ra1 = ra0 + 16;
        const bf16x8 a0 = *(const bf16x8*)(XsT + ra0 * LDX + ((32 * ks + 8 * fq) ^ TSW(ra0))), a1 = *(const bf16x8*)(XsT + ra1 * LDX + ((32 * ks + 8 * fq) ^ TSW(ra1)));
#pragma unroll
        for (int ni = 0; ni < 8; ++ni) { const int rb = 16 * ni + fr; const bf16x8 bb = *(const bf16x8*)(BT + rb * LDX + ((32 * ks + 8 * fq) ^ TSW(rb)));
            acc[0][ni] = MFMA16(bb, a0, acc[0][ni]); acc[1][ni] = MFMA16(bb, a1, acc[1][ni]); }
    }
#pragma unroll
    for (int mi = 0; mi < 2; ++mi) { const int hp = 32 * wave + 16 * mi + fr, r = hp >> 6, p = hp & 63;
        bf16* dst = CS + ((size_t)(slot * 32 + h0 + r) * 64 + p) * 128 + 4 * fq;
#pragma unroll
        for (int ni = 0; ni < 8; ++ni) { u32x2 w; w.x = pkbf(acc[mi][ni][0], acc[mi][ni][1]); w.y = pkbf(acc[mi][ni][2], acc[mi][ni][3]); *(u32x2*)(dst + 16 * ni) = w; } }
    if (tid < 4) CD[slot * 32 + h0 + tid] = __expf(s_acs[tid * 128 + 127]);
    __syncthreads();
}

__device__ __forceinline__ void ssd_sample_issue(ArgsP a, int li, int b, int g, f32x4 (&st)[4][4]) {
    const int tid = ltid(), p = tid >> 3, nb = tid & 7;
    const float* __restrict__ sin_ = a->in[I_SSSM] + ((size_t)((li * NSAMP + b) * NHEADS + g * 4) * 64 + p) * 128 + 4 * nb;
#pragma unroll
    for (int r = 0; r < 4; ++r)
#pragma unroll
        for (int kk = 0; kk < 4; ++kk) st[r][kk] = __builtin_nontemporal_load((const f32x4*)(sin_ + (size_t)r * 8192 + 32 * kk));
}
__device__ __forceinline__ void ssd_sample_unit(ArgsP a, int li, unsigned char* lds, int b, int g, f32x4 (&st)[4][4]) {
    const int tid = ltid(), lane = tid & 63, wave = __builtin_amdgcn_readfirstlane(tid >> 6);
    const bf16* __restrict__ ZX = (const bf16*)(a->ws + WS_ZX); const float* __restrict__ DT = (const float*)(a->ws + WS_DT); bf16* __restrict__ YN = (bf16*)(a->ws + WS_YN);
    float* sX = (float*)lds; float* sB = sX + 8 * 256; float* sC = sB + 8 * 128; float* sY = sC + 8 * 128; float* sDt = sY + 8 * 256;
    const int R0 = ROW_S + b * 8, h0 = g * 4;
    const int p = tid >> 3, nb = tid & 7;
    float* __restrict__ sout = a->out + O_SSSM + ((size_t)((li * NSAMP + b) * NHEADS + h0) * 64 + p) * 128 + 4 * nb;
    {
        const float* __restrict__ cw = a->in[I_ACONVW] + (size_t)li * 4 * CONVD; const float* __restrict__ cbias = a->in[I_ACONVB] + (size_t)li * CONVD;
        const int t = tid >> 6, ck = tid & 63;
        const int c0 = (ck < 32) ? g * 256 + ck * 8 : (ck < 48) ? 2048 + g * 128 + (ck - 32) * 8 : 3072 + g * 128 + (ck - 48) * 8;
        float* dst = (ck < 32) ? sX + t * 256 + ck * 8 : (ck < 48) ? sB + t * 128 + (ck - 32) * 8 : sC + t * 128 + (ck - 48) * 8;
        const float* __restrict__ sc = a->in[I_SCONV] + ((size_t)(li * NSAMP + b) * 3) * CONVD + c0;
        float xr[4][8];
#pragma unroll
        for (int k = 0; k < 4; ++k) { const int tt = t - 3 + k;
            if (tt >= 0) unpack8(*(const u32x4*)(ZX + (size_t)(R0 + tt) * ZXW + 2048 + c0), xr[k]); else ld8f(sc + (size_t)(tt + 3) * CONVD, xr[k]); }
        ConvW W; conv_load_w(cw, cbias, c0, W);
        float o[8];
#pragma unroll
        for (int j = 0; j < 8; ++j) { const float v = W.bs[j] + W.w0[j] * xr[0][j] + W.w1[j] * xr[1][j] + W.w2[j] * xr[2][j] + W.w3[j] * xr[3][j]; o[j] = v * sigmoid_f(v); }
        *(f32x4*)dst = (f32x4){o[0], o[1], o[2], o[3]}; *(f32x4*)(dst + 4) = (f32x4){o[4], o[5], o[6], o[7]};
        if (t >= 5) { float* __restrict__ so = a->out + O_SCONV + ((size_t)(li * NSAMP + b) * 3 + (t - 5)) * CONVD + c0;
            *(f32x4*)so = (f32x4){xr[3][0], xr[3][1], xr[3][2], xr[3][3]}; *(f32x4*)(so + 4) = (f32x4){xr[3][4], xr[3][5], xr[3][6], xr[3][7]}; }
    }
    if (tid < 32) sDt[tid] = DT[(size_t)(R0 + (tid >> 2)) * 32 + h0 + (tid & 3)];
    __syncthreads();
    float An[4], Dk[4];
#pragma unroll
    for (int r = 0; r < 4; ++r) { An[r] = -__expf(a->in[I_ALOG][li * NHEADS + h0 + r]); Dk[r] = a->in[I_ADSKIP][li * NHEADS + h0 + r]; }
    float part[8][4];
#pragma unroll
    for (int t = 0; t < 8; ++t) {
        f32x4 bv[4], cv[4];
#pragma unroll
        for (int kk = 0; kk < 4; ++kk) { bv[kk] = *(const f32x4*)(sB + t * 128 + 32 * kk + 4 * nb); cv[kk] = *(const f32x4*)(sC + t * 128 + 32 * kk + 4 * nb); }
#pragma unroll
        for (int r = 0; r < 4; ++r) {
            const float dt = sDt[t * 4 + r], dA = __expf(dt * An[r]), xv = sX[t * 256 + r * 64 + p], coef = dt * xv;
            float pr = 0.f;
#pragma unroll
            for (int kk = 0; kk < 4; ++kk) { st[r][kk] = st[r][kk] * dA + bv[kk] * coef; pr += (cv[kk].x * st[r][kk].x + cv[kk].y * st[r][kk].y) + (cv[kk].z * st[r][kk].z + cv[kk].w * st[r][kk].w); }
            part[t][r] = pr;
        }
    }
#pragma unroll
    for (int r = 0; r < 4; ++r)
#pragma unroll
        for (int kk = 0; kk < 4; ++kk) __builtin_nontemporal_store(st[r][kk], (f32x4*)(sout + (size_t)r * 8192 + 32 * kk));
#pragma unroll
    for (int t = 0; t < 8; ++t)
#pragma unroll
        for (int r = 0; r < 4; ++r) { float v = part[t][r]; v += __shfl_xor(v, 1); v += __shfl_xor(v, 2); v += __shfl_xor(v, 4); part[t][r] = v; }
    if (nb == 0) {
#pragma unroll
        for (int t = 0; t < 8; ++t)
#pragma unroll
            for (int r = 0; r < 4; ++r) sY[t * 256 + r * 64 + p] = part[t][r] + Dk[r] * sX[t * 256 + r * 64 + p];
    }
    __syncthreads();
    {
        const int t = wave, c4 = lane * 4; const size_t row = (size_t)(R0 + t);
        const f32x4 y = *(const f32x4*)(sY + t * 256 + c4);
        const u32x2 zz = *(const u32x2*)(ZX + row * ZXW + g * 256 + c4);
        const float z0 = bflo(zz.x), z1 = bfhi(zz.x), z2 = bflo(zz.y), z3 = bfhi(zz.y);
        const float g0 = y.x * z0 * sigmoid_f(z0), g1 = y.y * z1 * sigmoid_f(z1), g2 = y.z * z2 * sigmoid_f(z2), g3 = y.w * z3 * sigmoid_f(z3);
        const float ss = wave_sum((g0 * g0 + g1 * g1) + (g2 * g2 + g3 * g3));
        const float rs = rsqrtf(ss * (1.f / 256.f) + EPS);
        u32x2 o; o.x = pkbf(g0 * rs, g1 * rs); o.y = pkbf(g2 * rs, g3 * rs);
        *(u32x2*)(YN + row * DINNER + g * 256 + c4) = o;
    }
    __syncthreads();
}

__device__ __forceinline__ void phase_scan(ArgsP a, int li) {
    const bf16* __restrict__ CS = (const bf16*)(a->ws + WS_CS); const float* __restrict__ CD = (const float*)(a->ws + WS_CD); bf16* __restrict__ HSB = (bf16*)(a->ws + WS_HSB);
    const int gt = blockIdx.x * NTHREADS + ltid(), NT = gridDim.x * NTHREADS;
    for (int e = gt; e < 2 * 65536; e += NT) {
        const int b = e >> 16, rem = e & 65535, h = rem >> 11, pn4 = rem & 2047;
        f32x4 hc; { const u32x2 w0 = *(const u32x2*)(CS + ((size_t)(128 * 32 + h) * 2048 + pn4) * 4); hc = (f32x4){bflo(w0.x), bfhi(w0.x), bflo(w0.y), bfhi(w0.y)}; }
#pragma unroll 1
        for (int c0 = 0; c0 < 64; c0 += 16) {
            u32x2 sw[16]; float dd[16];
#pragma unroll
            for (int k = 0; k < 16; ++k) { const int slot = b * 64 + c0 + k; sw[k] = __builtin_nontemporal_load((const u32x2*)(CS + ((size_t)(slot * 32 + h) * 2048 + pn4) * 4)); dd[k] = CD[slot * 32 + h]; }
#pragma unroll
            for (int k = 0; k < 16; ++k) { const int slot = b * 64 + c0 + k; const size_t o = ((size_t)(slot * 32 + h) * 2048 + pn4) * 4;
                const f32x4 sv = (f32x4){bflo(sw[k].x), bfhi(sw[k].x), bflo(sw[k].y), bfhi(sw[k].y)};
                u32x2 w; w.x = pkbf(hc.x, hc.y); w.y = pkbf(hc.z, hc.w); *(u32x2*)(HSB + o) = w;
                hc = hc * dd[k] + sv; }
        }
        __builtin_nontemporal_store(hc, (f32x4*)(a->out + O_PSSM + ((size_t)((li * NPROMPT + b) * NHEADS + h) * 2048 + pn4) * 4));
    }
}

__device__ __forceinline__ void ssd3_head(int r, int hb, const bf16* Cn, const bf16* BH, const bf16* Xt, const float* s_dt, const float* s_acs, const f32x4 (&cb)[8], f32x4 (&acc)[4],
                                          const bf16* __restrict__ ZX, size_t row, int g, float Dk, int l, int wave, int fr, int fq, float& ss) {
    u32x2 zz[4];
#pragma unroll
    for (int ni = 0; ni < 4; ++ni) { const int ch = g * 256 + r * 64 + 16 * ni + 4 * fq; zz[ni] = __builtin_nontemporal_load((const u32x2*)(ZX + row * ZXW + ch)); }
    const float al = s_acs[r * 128 + l];
#pragma unroll
    for (int ni = 0; ni < 4; ++ni) acc[ni] = (f32x4){0.f, 0.f, 0.f, 0.f};
    const bf16* Hs = BH + hb * 64 * LDX;
#pragma unroll
    for (int ks = 0; ks < 4; ++ks) { const bf16x8 af = LFRAG(Cn, l, LDX, ks);
#pragma unroll
        for (int ni = 0; ni < 4; ++ni) { const bf16x8 bb = LFRAG(Hs, 16 * ni + fr, LDX, ks); acc[ni] = MFMA16(bb, af, acc[ni]); } }
    const float e = __expf(al);
#pragma unroll
    for (int ni = 0; ni < 4; ++ni) acc[ni] = acc[ni] * e;
#pragma unroll
    for (int ks = 0; ks < 4; ++ks) if (2 * ks <= wave) {
        unsigned mw[4];
#pragma unroll
        for (int hf = 0; hf < 2; ++hf) { const int ni = 2 * ks + hf, s0 = 16 * ni + 4 * fq;
            const f32x4 av = *(const f32x4*)(s_acs + r * 128 + s0), dv = *(const f32x4*)(s_dt + r * 128 + s0);
            float m[4];
#pragma unroll
            for (int j = 0; j < 4; ++j) m[j] = (s0 + j <= l) ? cb[ni][j] * __expf(al - av[j]) * dv[j] : 0.f;
            mw[2 * hf] = pkbf(m[0], m[1]); mw[2 * hf + 1] = pkbf(m[2], m[3]); }
        const u32x4 afu = (u32x4){mw[0], mw[1], mw[2], mw[3]};
        const bf16x8 af = __builtin_bit_cast(bf16x8, afu);
#pragma unroll
        for (int ni = 0; ni < 4; ++ni) { const int chl = r * 64 + 16 * ni + fr, sw = TSW(chl);
            const u32x2 b0 = *(const u32x2*)(Xt + chl * LDX + ((32 * ks + 4 * fq) ^ sw)), b1 = *(const u32x2*)(Xt + chl * LDX + ((32 * ks + 16 + 4 * fq) ^ sw));
            const u32x4 bu = (u32x4){b0.x, b0.y, b1.x, b1.y};
            acc[ni] = MFMA16(__builtin_bit_cast(bf16x8, bu), af, acc[ni]); }
    }
#pragma unroll
    for (int ni = 0; ni < 4; ++ni) {
        float xv[4];
#pragma unroll
        for (int j = 0; j < 4; ++j) { const int chl = r * 64 + 16 * ni + 4 * fq + j; xv[j] = bf2f(Xt[chl * LDX + (l ^ TSW(chl))]); }
        const float zv[4] = {bflo(zz[ni].x), bfhi(zz[ni].x), bflo(zz[ni].y), bfhi(zz[ni].y)};
#pragma unroll
        for (int j = 0; j < 4; ++j) { const float q = (acc[ni][j] + Dk * xv[j]) * zv[j] * sigmoid_f(zv[j]); acc[ni][j] = q; ss += q * q; } }
}
__device__ __forceinline__ void ssd3_unit(ArgsP a, int li, unsigned char* lds, const bf16* __restrict__ hs, int slot, int g, int R0, int len, int, int, int) {
    const int tid = ltid(), lane = tid & 63, wave = __builtin_amdgcn_readfirstlane(tid >> 6);
    const bf16* __restrict__ ZX = (const bf16*)(a->ws + WS_ZX); const float* __restrict__ DT = (const float*)(a->ws + WS_DT); bf16* __restrict__ YN = (bf16*)(a->ws + WS_YN);
    bf16* Cn = (bf16*)lds; bf16* BH = Cn + 128 * LDX; bf16* Xt = BH + 128 * LDX;
    float* s_dt = (float*)(Xt + 256 * LDX); float* s_acs = s_dt + 512;
    const int fr = lane & 15, fq = lane >> 4, h0 = g * 4;
    {
        const float* __restrict__ cw = a->in[I_ACONVW] + (size_t)li * 4 * CONVD; const float* __restrict__ cbias = a->in[I_ACONVB] + (size_t)li * CONVD;
        const bool meta = (slot == 128), chunk0 = (!meta && (slot & 63) == 0);
        const int half = tid >> 8, ncb = tid & 15, nrun = (tid >> 4) & 15, nc0 = (half ? 2048 : 3072) + g * 128 + ncb * 8;
        const int xcb = tid & 31, xrun = tid >> 5, xc0 = g * 256 + xcb * 8;
        u32x4 rn[11], rx[11];
        conv_load_run(ZX, R0 + 8 * nrun, nc0, (nrun == 0) ? (meta ? 2 : (chunk0 ? 1 : 0)) : 0, 8 * nrun < len, rn);
        conv_load_run(ZX, R0 + 8 * xrun, xc0, (xrun == 0) ? (meta ? 2 : (chunk0 ? 1 : 0)) : 0, 8 * xrun < len, rx);
        ssd_acs(DT, a->in[I_ALOG] + li * NHEADS, R0, len, h0, s_dt, s_acs, wave, lane);
        { ConvW W; conv_load_w(cw, cbias, nc0, W); conv_item_n(rn, W, half ? BH : Cn, nrun, ncb * 8); }
        { ConvW W; conv_load_w(cw, cbias, xc0, W); const float one[8] = {1.f, 1.f, 1.f, 1.f, 1.f, 1.f, 1.f, 1.f}; conv_item_t(rx, W, one, Xt, xcb * 8, xrun); }
        if (!meta && (slot & 63) == 63) {
            float* __restrict__ dst = a->out + O_PCONV + (size_t)((li * NPROMPT + (slot >> 6)) * 3) * CONVD;
            if (nrun == 15) conv_state_out(rn, dst + nc0);
            if (xrun == 15) conv_state_out(rx, dst + xc0);
        }
    }
    __syncthreads();
    u32x2 hv[8];
#pragma unroll
    for (int k = 0; k < 8; ++k) { const int item = tid + NTHREADS * k; hv[k] = (u32x2){0u, 0u}; if (hs) hv[k] = __builtin_nontemporal_load((const u32x2*)(hs + (size_t)item * 4)); }
    const bool active = (16 * wave < len);
    f32x4 cb[8];
#pragma unroll
    for (int ni = 0; ni < 8; ++ni) cb[ni] = (f32x4){0.f, 0.f, 0.f, 0.f};
    if (active) {
#pragma unroll
    for (int ks = 0; ks < 4; ++ks) { const bf16x8 af = LFRAG(Cn, 16 * wave + fr, LDX, ks);
#pragma unroll
        for (int ni = 0; ni < 8; ++ni) { const bf16x8 bb = LFRAG(BH, 16 * ni + fr, LDX, ks); cb[ni] = MFMA16(bb, af, cb[ni]); } }
    }
    __syncthreads();
#pragma unroll
    for (int k = 0; k < 8; ++k) { const int item = tid + NTHREADS * k, hp = item >> 5, n4 = item & 31; *(u32x2*)(BH + hp * LDX + n4 * 4) = hv[k]; }
#pragma unroll
    for (int k = 0; k < 8; ++k) { const int item = tid + NTHREADS * k; hv[k] = (u32x2){0u, 0u}; if (hs) hv[k] = __builtin_nontemporal_load((const u32x2*)(hs + (size_t)(2 * 8192) + (size_t)item * 4)); }
    __syncthreads();
    const int l = 16 * wave + fr;
    const size_t row = (size_t)(R0 + ((l < len) ? l : 0));
    f32x4 y0[4], y1[4], y2[4], y3[4];
    float ss = 0.f;
    const float* dsk = a->in[I_ADSKIP] + li * NHEADS + h0;
    if (active) {
    ssd3_head(0, 0, Cn, BH, Xt, s_dt, s_acs, cb, y0, ZX, row, g, dsk[0], l, wave, fr, fq, ss);
    ssd3_head(1, 1, Cn, BH, Xt, s_dt, s_acs, cb, y1, ZX, row, g, dsk[1], l, wave, fr, fq, ss);
    }
    __syncthreads();
#pragma unroll
    for (int k = 0; k < 8; ++k) { const int item = tid + NTHREADS * k, hp = item >> 5, n4 = item & 31; *(u32x2*)(BH + hp * LDX + n4 * 4) = hv[k]; }
    __syncthreads();
    if (active) {
    ssd3_head(2, 0, Cn, BH, Xt, s_dt, s_acs, cb, y2, ZX, row, g, dsk[2], l, wave, fr, fq, ss);
    ssd3_head(3, 1, Cn, BH, Xt, s_dt, s_acs, cb, y3, ZX, row, g, dsk[3], l, wave, fr, fq, ss);
    ss += __shfl_xor(ss, 16); ss += __shfl_xor(ss, 32);
    }
    const float rs = rsqrtf(ss * (1.f / 256.f) + EPS);
    if (active && l < len) {
        bf16* yrow = YN + row * DINNER + g * 256 + 4 * fq;
#pragma unroll
        for (int ni = 0; ni < 4; ++ni) {
            u32x2 w;
            w.x = pkbf(y0[ni][0] * rs, y0[ni][1] * rs); w.y = pkbf(y0[ni][2] * rs, y0[ni][3] * rs); *(u32x2*)(yrow + 0 * 64 + 16 * ni) = w;
            w.x = pkbf(y1[ni][0] * rs, y1[ni][1] * rs); w.y = pkbf(y1[ni][2] * rs, y1[ni][3] * rs); *(u32x2*)(yrow + 1 * 64 + 16 * ni) = w;
            w.x = pkbf(y2[ni][0] * rs, y2[ni][1] * rs); w.y = pkbf(y2[ni][2] * rs, y2[ni][3] * rs); *(u32x2*)(yrow + 2 * 64 + 16 * ni) = w;
            w.x = pkbf(y3[ni][0] * rs, y3[ni][1] * rs); w.y = pkbf(y3[ni][2] * rs, y3[ni][3] * rs); *(u32x2*)(yrow + 3 * 64 + 16 * ni) = w;
        }
    }
    __syncthreads();
}
__device__ __forceinline__ void phase_ssd1(ArgsP a, int li, unsigned char* lds, int tid, int wave, int lane) {
    const int c = blockIdx.x;
#pragma unroll 1
    for (int j = 0; j < 4; ++j) {
        const int u = c + 256 * j;
        f32x4 st[4][4];
        ssd_sample_issue(a, li, u >> 3, u & 7, st);
#ifndef PROBE_SSD1
#define PROBE_SSD1 0
#endif
#pragma unroll 1
        for (int rp = 0; rp < (PROBE_SSD1 == 1 ? 2 : 1); ++rp) { const int slot = u >> 3, g = u & 7; ssd1_unit(a, li, lds, slot, g, (slot >> 6) * SEQ + (slot & 63) * 128, 128, tid, wave, lane); }
        ssd_sample_unit(a, li, lds, u >> 3, u & 7, st);
    }
    if (c < 8) ssd1_unit(a, li, lds, 128, c, ROW_M, NMETA, tid, wave, lane);
    else if (c < 16) ssd3_unit(a, li, lds, nullptr, 128, c - 8, ROW_M, NMETA, tid, wave, lane);
}
__device__ __forceinline__ void phase_ssd3(ArgsP a, int li, unsigned char* lds, int tid, int wave, int lane) {
    const bf16* HSB = (const bf16*)(a->ws + WS_HSB);
#ifdef PROBE_STAGGER
    if (blockIdx.x & 1) { const unsigned long long t0 = __builtin_amdgcn_s_memrealtime(); while (__builtin_amdgcn_s_memrealtime() - t0 < PROBE_STAGGER) __builtin_amdgcn_s_sleep(8); }
#endif
#pragma unroll 1
    for (int u = blockIdx.x; u < 1024; u += gridDim.x) { const int slot = u >> 3, g = u & 7; ssd3_unit(a, li, lds, HSB + (size_t)(slot * 32 + g * 4) * 8192, slot, g, (slot >> 6) * SEQ + (slot & 63) * 128, 128, tid, wave, lane); }
}

constexpr int KS_LD = 72, VT_LD = 264, P_LD = 232, NKEYS = 208;
__device__ __forceinline__ void attn_prompt_unit(ArgsP a, int lj, unsigned char* lds, int b, int kvh, int qb, int, int, int) {
    const int tid = ltid(), lane = tid & 63, wave = __builtin_amdgcn_readfirstlane(tid >> 6);
    const bf16* __restrict__ Q = (const bf16*)(a->ws + WS_Q); const bf16* __restrict__ KV = (const bf16*)(a->ws + WS_KV); bf16* __restrict__ AO = (bf16*)(a->ws + WS_AO);
    bf16* Ks = (bf16*)lds; bf16* Vt = Ks + NKEYS * KS_LD; bf16* Pw = Vt + 64 * VT_LD + wave * 16 * P_LD;
    const int fr = lane & 15, fq = lane >> 4, t0 = qb * 64, Rb = b * SEQ;
    const int r = wave >> 1, th = (wave & 1) * 32, qh = kvh * 4 + r;
    bf16x8 q0[2], q1[2];
#pragma unroll
    for (int ks = 0; ks < 2; ++ks) { q0[ks] = *(const bf16x8*)(Q + (size_t)(Rb + t0 + th + fr) * DM + qh * 64 + 32 * ks + 8 * fq); q1[ks] = *(const bf16x8*)(Q + (size_t)(Rb + t0 + th + 16 + fr) * DM + qh * 64 + 32 * ks + 8 * fq); }
    {
        u32x4 kv[4];
#pragma unroll
        for (int k = 0; k < 4; ++k) { const int it = tid + NTHREADS * k, key = it >> 3, ch = it & 7; kv[k] = (u32x4){0u, 0u, 0u, 0u};
            if (it < NKEYS * 8) { int row; if (key < 16) row = ROW_M + key; else { int s = t0 - 128 + key - 16; if (s < 0) s = 0; row = Rb + s; }
                kv[k] = *(const u32x4*)(KV + (size_t)row * KVW + kvh * 64 + ch * 8); } }
        u32x4 v0[2], v1[2];
#pragma unroll
        for (int k = 0; k < 2; ++k) { const int it = tid + NTHREADS * k, dbl = it & 7, kp = it >> 3; v0[k] = (u32x4){0u, 0u, 0u, 0u}; v1[k] = v0[k];
            if (it < (NKEYS / 2) * 8) { const int k0 = 2 * kp, k1 = k0 + 1; int s0 = t0 - 128 + k0 - 16, s1 = t0 - 128 + k1 - 16; if (s0 < 0) s0 = 0; if (s1 < 0) s1 = 0;
                const int r0 = (k0 < 16) ? ROW_M + k0 : Rb + s0, r1 = (k1 < 16) ? ROW_M + k1 : Rb + s1;
                v0[k] = *(const u32x4*)(KV + (size_t)r0 * KVW + 256 + kvh * 64 + dbl * 8); v1[k] = *(const u32x4*)(KV + (size_t)r1 * KVW + 256 + kvh * 64 + dbl * 8); } }
#pragma unroll
        for (int k = 0; k < 4; ++k) { const int it = tid + NTHREADS * k, key = it >> 3, ch = it & 7; if (it < NKEYS * 8) *(u32x4*)(Ks + key * KS_LD + ch * 8) = kv[k]; }
#pragma unroll
        for (int k = 0; k < 2; ++k) { const int it = tid + NTHREADS * k, dbl = it & 7, kp = it >> 3;
            if (it < (NKEYS / 2) * 8) { const int col = (2 * kp) ^ (8 * dbl);
                const unsigned a0[4] = {v0[k].x, v0[k].y, v0[k].z, v0[k].w}, a1[4] = {v1[k].x, v1[k].y, v1[k].z, v1[k].w};
#pragma unroll
                for (int j = 0; j < 4; ++j) {
                    *(unsigned*)(Vt + (dbl * 8 + 2 * j) * VT_LD + col) = (a0[j] & 0xffffu) | (a1[j] << 16);
                    *(unsigned*)(Vt + (dbl * 8 + 2 * j + 1) * VT_LD + col) = (a0[j] >> 16) | (a1[j] & 0xffff0000u); } } }
#pragma unroll
        for (int k = 0; k < 3; ++k) { const int idx = tid + NTHREADS * k, row = idx / 24, c = idx - row * 24; *(unsigned*)(Vt + row * VT_LD + ((NKEYS + 2 * c) ^ TSW(row))) = 0u; }
    }
    __syncthreads();
    const float sink = a->in[I_SINKS][lj * NQ + qh];
#pragma unroll 1
    for (int blk = 0; blk < 2; ++blk) {
        const int tq = th + blk * 16 + fr, t = t0 + tq;
        bf16x8 qa2[2];
#pragma unroll
        for (int ks = 0; ks < 2; ++ks) qa2[ks] = (blk == 0) ? q0[ks] : q1[ks];
        f32x4 sc[13];
#pragma unroll
        for (int ni = 0; ni < 13; ++ni) sc[ni] = (f32x4){0.f, 0.f, 0.f, 0.f};
#pragma unroll
        for (int ni = 0; ni < 13; ++ni) {
            const bf16x8 b0 = *(const bf16x8*)(Ks + (16 * ni + fr) * KS_LD + 8 * fq), b1 = *(const bf16x8*)(Ks + (16 * ni + fr) * KS_LD + 32 + 8 * fq);
            sc[ni] = MFMA16(b0, qa2[0], sc[ni]); sc[ni] = MFMA16(b1, qa2[1], sc[ni]);
            }
        int lo = tq + 17; { const int l2 = 144 - t0; if (l2 > lo) lo = l2; }
        const unsigned span = (unsigned)(tq + 144 - lo);
        float mx = -INFINITY;
#pragma unroll
        for (int ni = 0; ni < 13; ++ni)
#pragma unroll
            for (int j = 0; j < 4; ++j) { const int key = 16 * ni + 4 * fq + j; const bool vis = (ni == 0) || ((unsigned)(key - lo) <= span);
                const float v = vis ? sc[ni][j] * 0.125f : -INFINITY; sc[ni][j] = v; mx = fmaxf(mx, v); }
        mx = fmaxf(mx, __shfl_xor(mx, 16)); mx = fmaxf(mx, __shfl_xor(mx, 32)); mx = fmaxf(mx, sink);
        float sum = 0.f;
#pragma unroll
        for (int ni = 0; ni < 13; ++ni)
#pragma unroll
            for (int j = 0; j < 4; ++j) { const float p = __expf(sc[ni][j] - mx); sc[ni][j] = p; sum += p; }
        sum += __shfl_xor(sum, 16); sum += __shfl_xor(sum, 32); sum += __expf(sink - mx);
        const float inv = frcp(sum);
#pragma unroll
        for (int ni = 0; ni < 13; ++ni) { u32x2 w; w.x = pkbf(sc[ni][0] * inv, sc[ni][1] * inv); w.y = pkbf(sc[ni][2] * inv, sc[ni][3] * inv); *(u32x2*)(Pw + fr * P_LD + 16 * ni + 4 * fq) = w; }
        *(u32x2*)(Pw + fr * P_LD + NKEYS + 4 * fq) = (u32x2){0u, 0u};
        asm volatile("s_waitcnt lgkmcnt(0)" ::: "memory");
        f32x4 o[4];
#pragma unroll
        for (int ni = 0; ni < 4; ++ni) o[ni] = (f32x4){0.f, 0.f, 0.f, 0.f};
#pragma unroll
        for (int ks = 0; ks < 7; ++ks) { const bf16x8 af = *(const bf16x8*)(Pw + fr * P_LD + 32 * ks + 8 * fq);
#pragma unroll
            for (int ni = 0; ni < 4; ++ni) { const int vr = 16 * ni + fr; const bf16x8 bb = *(const bf16x8*)(Vt + vr * VT_LD + ((32 * ks + 8 * fq) ^ TSW(vr))); o[ni] = MFMA16(bb, af, o[ni]); }
            }
#pragma unroll
        for (int ni = 0; ni < 4; ++ni) { u32x2 w; w.x = pkbf(o[ni][0], o[ni][1]); w.y = pkbf(o[ni][2], o[ni][3]); *(u32x2*)(AO + (size_t)(Rb + t) * DM + qh * 64 + 16 * ni + 4 * fq) = w; }
        asm volatile("s_waitcnt lgkmcnt(0)" ::: "memory");
    }
    __syncthreads();
}
constexpr int SK_LD = 72, SV_LD = 200, SP_LD = 168, SKEYS = 160;
__device__ __forceinline__ void attn_sample_pair(ArgsP a, int lj, unsigned char* lds, int bp, int kvh, int, int, int) {
    const int tid = ltid(), lane = tid & 63, wave = __builtin_amdgcn_readfirstlane(tid >> 6);
    const bf16* __restrict__ Q = (const bf16*)(a->ws + WS_Q); const bf16* __restrict__ KV = (const bf16*)(a->ws + WS_KV); bf16* __restrict__ AO = (bf16*)(a->ws + WS_AO);
    const float* __restrict__ CK = a->in[I_CK]; const float* __restrict__ CV = a->in[I_CV];
    constexpr int HALF_B = (SKEYS * SK_LD + 64 * SV_LD) * 2;
    const int fr = lane & 15, fq = lane >> 4;
    {
        u32x4 r0[5], r1[5];
#pragma unroll
        for (int k = 0; k < 5; ++k) { const int it = tid + NTHREADS * k, hf = it / (SKEYS * 8), rem = it - hf * (SKEYS * 8), key = rem >> 3, ch = rem & 7, bb = 2 * bp + hf;
            r0[k] = (u32x4){0u, 0u, 0u, 0u}; r1[k] = r0[k];
            if (key < 16) r0[k] = *(const u32x4*)(KV + (size_t)(ROW_M + key) * KVW + kvh * 64 + ch * 8);
            else if (key < 144) { const float* p = CK + ((size_t)(bb * 128 + (key - 16)) * NKV + kvh) * 64 + ch * 8; r0[k] = __builtin_nontemporal_load((const u32x4*)p); r1[k] = __builtin_nontemporal_load((const u32x4*)(p + 4)); }
            else if (key < 152) r0[k] = *(const u32x4*)(KV + (size_t)(ROW_S + bb * 8 + (key - 144)) * KVW + kvh * 64 + ch * 8); }
#pragma unroll
        for (int k = 0; k < 5; ++k) { const int it = tid + NTHREADS * k, hf = it / (SKEYS * 8), rem = it - hf * (SKEYS * 8), key = rem >> 3, ch = rem & 7;
            bf16* Ks = (bf16*)(lds + hf * HALF_B);
            u32x4 w = r0[k];
            if (key >= 16 && key < 144) { w.x = pkbf(__uint_as_float(r0[k].x), __uint_as_float(r0[k].y)); w.y = pkbf(__uint_as_float(r0[k].z), __uint_as_float(r0[k].w)); w.z = pkbf(__uint_as_float(r1[k].x), __uint_as_float(r1[k].y)); w.w = pkbf(__uint_as_float(r1[k].z), __uint_as_float(r1[k].w)); }
            *(u32x4*)(Ks + key * SK_LD + ch * 8) = w; }
    }
    {
        u32x4 x0[3], x1[3], y0[3], y1[3];
#pragma unroll
        for (int k = 0; k < 3; ++k) { const int it = tid + NTHREADS * k, hf = it / (96 * 8), rem = it - hf * (96 * 8), dbl = rem & 7, kp = rem >> 3, bb = 2 * bp + hf, k0 = 2 * kp;
            x0[k] = (u32x4){0u, 0u, 0u, 0u}; x1[k] = x0[k]; y0[k] = x0[k]; y1[k] = x0[k];
            if (k0 < 16) { x0[k] = *(const u32x4*)(KV + (size_t)(ROW_M + k0) * KVW + 256 + kvh * 64 + dbl * 8); y0[k] = *(const u32x4*)(KV + (size_t)(ROW_M + k0 + 1) * KVW + 256 + kvh * 64 + dbl * 8); }
            else if (k0 < 144) { const float* p = CV + ((size_t)(bb * 128 + (k0 - 16)) * NKV + kvh) * 64 + dbl * 8;
                x0[k] = __builtin_nontemporal_load((const u32x4*)p); x1[k] = __builtin_nontemporal_load((const u32x4*)(p + 4)); y0[k] = __builtin_nontemporal_load((const u32x4*)(p + NKV * 64)); y1[k] = __builtin_nontemporal_load((const u32x4*)(p + NKV * 64 + 4)); }
            else if (k0 < 152) { x0[k] = *(const u32x4*)(KV + (size_t)(ROW_S + bb * 8 + (k0 - 144)) * KVW + 256 + kvh * 64 + dbl * 8); y0[k] = *(const u32x4*)(KV + (size_t)(ROW_S + bb * 8 + (k0 - 143)) * KVW + 256 + kvh * 64 + dbl * 8); } }
#pragma unroll
        for (int k = 0; k < 3; ++k) { const int it = tid + NTHREADS * k, hf = it / (96 * 8), rem = it - hf * (96 * 8), dbl = rem & 7, kp = rem >> 3, k0 = 2 * kp;
            bf16* Vt = (bf16*)(lds + hf * HALF_B) + SKEYS * SK_LD;
            unsigned a0[4] = {x0[k].x, x0[k].y, x0[k].z, x0[k].w}, a1[4] = {y0[k].x, y0[k].y, y0[k].z, y0[k].w};
            if (k0 >= 16 && k0 < 144) {
                a0[0] = pkbf(__uint_as_float(x0[k].x), __uint_as_float(x0[k].y)); a0[1] = pkbf(__uint_as_float(x0[k].z), __uint_as_float(x0[k].w)); a0[2] = pkbf(__uint_as_float(x1[k].x), __uint_as_float(x1[k].y)); a0[3] = pkbf(__uint_as_float(x1[k].z), __uint_as_float(x1[k].w));
                a1[0] = pkbf(__uint_as_float(y0[k].x), __uint_as_float(y0[k].y)); a1[1] = pkbf(__uint_as_float(y0[k].z), __uint_as_float(y0[k].w)); a1[2] = pkbf(__uint_as_float(y1[k].x), __uint_as_float(y1[k].y)); a1[3] = pkbf(__uint_as_float(y1[k].z), __uint_as_float(y1[k].w)); }
            const int col = (2 * kp) ^ (8 * dbl);
#pragma unroll
            for (int j = 0; j < 4; ++j) {
                *(unsigned*)(Vt + (dbl * 8 + 2 * j) * SV_LD + col) = (a0[j] & 0xffffu) | (a1[j] << 16);
                *(unsigned*)(Vt + (dbl * 8 + 2 * j + 1) * SV_LD + col) = (a0[j] >> 16) | (a1[j] & 0xffff0000u); } }
    }
    if (lj == 0) {
        u32x4 kx[8], vx[8];
#pragma unroll
        for (int k = 0; k < 8; ++k) { const int it = tid + NTHREADS * k, hf = it >> 11, rem = it & 2047, w = rem >> 4, c4 = (rem & 15) * 4, bb = 2 * bp + hf;
            if (w < 120) { const size_t i = ((size_t)(bb * 128 + w + 8) * NKV + kvh) * 64 + c4; kx[k] = __builtin_nontemporal_load((const u32x4*)(CK + i)); vx[k] = __builtin_nontemporal_load((const u32x4*)(CV + i)); }
            else { const bf16* rp = KV + (size_t)(ROW_S + bb * 8 + (w - 120)) * KVW + kvh * 64 + c4; const u32x2 k2 = *(const u32x2*)rp, v2 = *(const u32x2*)(rp + 256);
                kx[k] = (u32x4){k2.x << 16, k2.x & 0xffff0000u, k2.y << 16, k2.y & 0xffff0000u}; vx[k] = (u32x4){v2.x << 16, v2.x & 0xffff0000u, v2.y << 16, v2.y & 0xffff0000u}; } }
#pragma unroll
        for (int k = 0; k < 8; ++k) { const int it = tid + NTHREADS * k, hf = it >> 11, rem = it & 2047, w = rem >> 4, c4 = (rem & 15) * 4, bb = 2 * bp + hf;
            const size_t o = ((size_t)(bb * 128 + w) * NKV + kvh) * 64 + c4;
            __builtin_nontemporal_store(kx[k], (u32x4*)(a->out + O_SCK + o)); __builtin_nontemporal_store(vx[k], (u32x4*)(a->out + O_SCV + o)); }
    }
    __syncthreads();
    if (wave < 4) {
        const int hf = wave >> 1, rb = wave & 1, bb = 2 * bp + hf;
        const bf16* Ks = (const bf16*)(lds + hf * HALF_B); const bf16* Vt = Ks + SKEYS * SK_LD; bf16* Pw = (bf16*)(lds + 2 * HALF_B) + wave * 16 * SP_LD;
        const int r = 2 * rb + (fr >> 3), t = fr & 7, qh = kvh * 4 + r;
        const size_t qrow = (size_t)(ROW_S + bb * 8 + t);
        bf16x8 qa[2];
        if (lj == 0) {
#pragma unroll
            for (int ks = 0; ks < 2; ++ks) qa[ks] = *(const bf16x8*)(Q + qrow * DM + qh * 64 + 32 * ks + 8 * fq);
        } else {
            const float* __restrict__ SL = (const float*)(a->ws + WS_SLAB) + (size_t)(qrow - ROW_S) * DM + qh * 64 + 8 * fq;
#pragma unroll
            for (int ks = 0; ks < 2; ++ks) { f32x4 x0 = (f32x4){0.f, 0.f, 0.f, 0.f}, x1 = x0;
#pragma unroll
                for (int sl = 0; sl < 4; ++sl) { const float* p = SL + (size_t)sl * (1280 * 1024) + 32 * ks; x0 = x0 + *(const f32x4*)p; x1 = x1 + *(const f32x4*)(p + 4); }
                const u32x4 w = (u32x4){pkbf(x0.x, x0.y), pkbf(x0.z, x0.w), pkbf(x1.x, x1.y), pkbf(x1.z, x1.w)}; qa[ks] = __builtin_bit_cast(bf16x8, w); }
        }
        const float sink = a->in[I_SINKS][lj * NQ + qh];
        f32x4 sc[10];
#pragma unroll
        for (int ni = 0; ni < 10; ++ni) sc[ni] = (f32x4){0.f, 0.f, 0.f, 0.f};
#pragma unroll
        for (int ni = 0; ni < 10; ++ni) {
            const bf16x8 b0 = *(const bf16x8*)(Ks + (16 * ni + fr) * SK_LD + 8 * fq), b1 = *(const bf16x8*)(Ks + (16 * ni + fr) * SK_LD + 32 + 8 * fq);
            sc[ni] = MFMA16(b0, qa[0], sc[ni]); sc[ni] = MFMA16(b1, qa[1], sc[ni]); }
        float mx = -INFINITY;
#pragma unroll
        for (int ni = 0; ni < 10; ++ni)
#pragma unroll
            for (int j = 0; j < 4; ++j) { const int key = 16 * ni + 4 * fq + j;
                const bool vis = (ni == 0) || ((key < 144) ? (key - 16 > t) : (key - 144 <= t));
                const float v = vis ? sc[ni][j] * 0.125f : -INFINITY; sc[ni][j] = v; mx = fmaxf(mx, v); }
        mx = fmaxf(mx, __shfl_xor(mx, 16)); mx = fmaxf(mx, __shfl_xor(mx, 32)); mx = fmaxf(mx, sink);
        float sum = 0.f;
#pragma unroll
        for (int ni = 0; ni < 10; ++ni)
#pragma unroll
            for (int j = 0; j < 4; ++j) { const float p = __expf(sc[ni][j] - mx); sc[ni][j] = p; sum += p; }
        sum += __shfl_xor(sum, 16); sum += __shfl_xor(sum, 32); sum += __expf(sink - mx);
        const float inv = frcp(sum);
#pragma unroll
        for (int ni = 0; ni < 10; ++ni) { u32x2 w; w.x = pkbf(sc[ni][0] * inv, sc[ni][1] * inv); w.y = pkbf(sc[ni][2] * inv, sc[ni][3] * inv); *(u32x2*)(Pw + fr * SP_LD + 16 * ni + 4 * fq) = w; }
        asm volatile("s_waitcnt lgkmcnt(0)" ::: "memory");
        f32x4 o[4];
#pragma unroll
        for (int ni = 0; ni < 4; ++ni) o[ni] = (f32x4){0.f, 0.f, 0.f, 0.f};
#pragma unroll
        for (int ks = 0; ks < 5; ++ks) { const bf16x8 af = *(const bf16x8*)(Pw + fr * SP_LD + 32 * ks + 8 * fq);
#pragma unroll
            for (int ni = 0; ni < 4; ++ni) { const int vr = 16 * ni + fr; const bf16x8 bb2 = *(const bf16x8*)(Vt + vr * SV_LD + ((32 * ks + 8 * fq) ^ TSW(vr))); o[ni] = MFMA16(bb2, af, o[ni]); } }
#pragma unroll
        for (int ni = 0; ni < 4; ++ni) { u32x2 w; w.x = pkbf(o[ni][0], o[ni][1]); w.y = pkbf(o[ni][2], o[ni][3]); *(u32x2*)(AO + qrow * DM + qh * 64 + 16 * ni + 4 * fq) = w; }
    }
    __syncthreads();
}
__device__ __forceinline__ void phase_attn(ArgsP a, int lj, unsigned char* lds, int tid, int wave, int lane) {
    if (lj == 0) {
        const bf16* KV = (const bf16*)(a->ws + WS_KV);
        const int gt = blockIdx.x * NTHREADS + tid, NT = gridDim.x * NTHREADS;
        for (int e = gt; e < 2 * 128 * 512; e += NT) { const int b = e >> 16, w = (e >> 9) & 127, c = e & 511;
            const float v = bf2f(KV[(size_t)(b * SEQ + SEQ - 128 + w) * KVW + c]);
            if (c < 256) a->out[O_PCK + (size_t)(b * 128 + w) * 256 + c] = v; else a->out[O_PCV + (size_t)(b * 128 + w) * 256 + (c - 256)] = v; }
    }
    const int xg = blockIdx.x & 7, xi = blockIdx.x >> 3;
#pragma unroll 1
    for (int j = 0; j < 4; ++j) { const int u = 128 * xg + 4 * xi + j, qb = u & 127, kvh = (u >> 7) & 3, b = u >> 9; attn_prompt_unit(a, lj, lds, b, kvh, qb, tid, wave, lane); }
    { const int su = blockIdx.x; attn_sample_pair(a, lj, lds, su >> 2, su & 3, tid, wave, lane); }
}

constexpr int PH_B = 9 * 2, PH_F = PH_B + 7 * 2, NPHASES = PH_F + 1;
template <class Epi> __device__ __forceinline__ void run_gemm(LAS unsigned char* lds, const bf16* A, const bf16* Bt, int N, int K, const Epi& E) {
    pg8::Gemm g{A, Bt, MP, N, K}; pg8::StaticOrder S; S.init(MP, N, K, (int)gridDim.x, (int)blockIdx.x);
    pg8::gemm_phase<Epi, pg8::StaticOrder, true, true>(lds, g, S, E);
}
template <class Epi> __device__ __forceinline__ void run_gemm_res(LAS unsigned char* lds, const bf16* A, const bf16* Bt, int K, int S_, const Epi& E) {
    pg8::Gemm g{A, Bt, MP, 1024, K}; pg8::ResOrder S; S.init(K, S_, (int)gridDim.x, (int)blockIdx.x);
    pg8::gemm_phase<Epi, pg8::ResOrder, true, true>(lds, g, S, E);
}

__global__ void __launch_bounds__(NTHREADS, 2) yoco_fwd(Args args) {
    extern __shared__ __attribute__((aligned(16))) unsigned char lds[];
    LAS unsigned char* ldsl = (LAS unsigned char*)lds;
    const int tid0 = threadIdx.x;
    for (int u = tid0; u < (LDS_BYTES - LDSCTL_OFF) / 4; u += NTHREADS) ((LAS unsigned*)(ldsl + LDSCTL_OFF))[u] = 0u;
    __syncthreads();
    const int lo = args.ph_lo, hi = args.ph_hi;
    if (hi - lo > 1) (void)xcd_barrier_post((unsigned*)(args.ws + WS_CTL) + CW_BAR, (volatile LAS unsigned*)(ldsl + MISC_OFF) + 8);
    int rep = 0;
#pragma unroll 1
    for (int p = lo; p < hi;) {
        ArgsP la = (ArgsP)__builtin_amdgcn_kernarg_segment_ptr(); asm volatile("" : "+s"(la));
        unsigned char* ws = la->ws;
        const int tid = ltid();
        const int lane = tid & 63, wave = __builtin_amdgcn_readfirstlane(tid >> 6);
        bf16* HN = (bf16*)(ws + WS_HN); float* H = (float*)(ws + WS_H);
        int kind, li = 0, lj = 0, layer = 0;
        int nslab = 8;
        if (p == 0) kind = 0;
        else if (p < PH_B) { li = p / 9; layer = li; const int sub = p % 9;
            kind = (sub == 0) ? 1 : (sub == 1) ? 3 : (sub == 2) ? 5 : (sub == 3) ? 6 : (sub == 4) ? 7 : (sub == 5) ? 8 : (sub == 6) ? 1 : (sub == 7) ? 9 : 10; }
        else if (p < PH_F) { lj = (p - PH_B) / 7; layer = 2 + lj; const int sub = (p - PH_B) % 7;
            kind = (sub == 0) ? 1 : (sub == 1) ? 11 : (sub == 2) ? 12 : (sub == 3) ? 13 : (sub == 4) ? 1 : (sub == 5) ? 9 : 10; if (sub == 4) nslab = 4; }
        else kind = 14;
#ifndef KMASK
#define KMASK 0xffff
#endif
#define KON(k) ((KMASK >> (k)) & 1)
#ifndef REP_MASK
#define REP_MASK 0
#endif
        if (KON(0) && kind == 0) { phase_prologue(la, ldsl, wave, lane); phase_norm(la, 1, 0, wave, lane); }
        else if (KON(1) && kind == 1) phase_norm(la, 0, nslab, wave, lane);
        else if (KON(3) && kind == 3) { pg8::EpiInProj E{(bf16*)(ws + WS_ZX), (float*)(ws + WS_DT), la->in[I_ADTB] + li * NHEADS}; run_gemm(ldsl, HN, (const bf16*)(ws + WS_WIN + li * SZ_WIN), INPROJ_P, 1024, E); }
        else if (KON(5) && kind == 5) phase_ssd1(la, li, lds, tid, wave, lane);
        else if (KON(6) && kind == 6) phase_scan(la, li);
        else if (KON(7) && kind == 7) phase_ssd3(la, li, lds, tid, wave, lane);
        else if (KON(8) && (kind == 8 || kind == 10 || kind == 13)) {
            const bf16* A; const bf16* Bt; int K;
            if (kind == 8) { A = (const bf16*)(ws + WS_YN); Bt = (const bf16*)(ws + WS_WOUT + li * SZ_WOUT); K = 2048; }
            else if (kind == 10) { A = (const bf16*)(ws + WS_U); Bt = (const bf16*)(ws + WS_WDN + layer * SZ_WDN); K = 4096; }
            else { A = (const bf16*)(ws + WS_AO); Bt = (const bf16*)(ws + WS_WO + lj * SZ_WO); K = 1024; }
            pg8::EpiRes E{(kind == 8 && li == 0) ? la->in[I_XP] : nullptr, (bf16*)H, (float*)(ws + WS_SLAB)}; run_gemm_res(ldsl, A, Bt, K, K == 1024 ? 4 : 8, E); }
        else if (KON(9) && kind == 9) { pg8::EpiBf<1> E{(bf16*)(ws + WS_U), 4096, 1 << 20, nullptr, 0}; run_gemm(ldsl, HN, (const bf16*)(ws + WS_WUP + layer * SZ_WUP), 4096, 1024, E); }
        else if (KON(11) && kind == 11) { pg8::EpiBf<0> E{(bf16*)(ws + WS_Q), 1024, 4, (bf16*)(ws + WS_KV), KVW};
            if (lj == 0) run_gemm(ldsl, HN, (const bf16*)(ws + WS_WQKV0), 1536, 1024, E);
            else { pg8::EpiQSplit E2{(bf16*)(ws + WS_Q), (float*)(ws + WS_SLAB)}; run_gemm_res(ldsl, HN, (const bf16*)(ws + WS_WQ1), 1024, 4, E2); } }
        else if (KON(12) && kind == 12) phase_attn(la, lj, lds, tid, wave, lane);
        else if (KON(14) && kind == 14) phase_final(la, wave, lane);
        bool again = false;
        if (REP_MASK != 0) { if (rep == 0 && ((REP_MASK >> kind) & 1)) { rep = 1; again = true; } else rep = 0; }
        if (p + 1 < hi || again) { XcdBarrier bar; bar.bar = (unsigned*)(ws + WS_CTL) + CW_BAR; bar.x = xb_xcc_id(); bar.st = (volatile LAS unsigned*)(ldsl + MISC_OFF) + 8; xcd_barrier(bar); }
        else { asm volatile("s_waitcnt vmcnt(0)" ::: "memory"); __syncthreads(); }
        if (!again) ++p;
    }
}

#ifndef MK_PER_PHASE
#define MK_PER_PHASE 0
#endif
extern "C" void kernel_launch(void* const* d_in, const int* in_sizes, int n_in, void* d_out, int out_size, void* d_ws, size_t ws_size, hipStream_t stream) {
    static int grid = 0;
    if (grid == 0) {
        if (n_in != 26 || (size_t)out_size != O_END || ws_size < WS_END) { fprintf(stderr, "kernel_launch: unexpected problem (n_in %d, out %d vs %zu, ws %zu vs %zu); nothing launched\n", n_in, out_size, (size_t)O_END, ws_size, (size_t)WS_END); grid = -1; return; }
        int dev = 0, cus = 0, per_cu = 0;
        if (hipGetDevice(&dev) != hipSuccess || hipDeviceGetAttribute(&cus, hipDeviceAttributeMultiprocessorCount, dev) != hipSuccess) { grid = -1; return; }
        if (hipFuncSetAttribute((const void*)yoco_fwd, hipFuncAttributeMaxDynamicSharedMemorySize, LDS_BYTES) != hipSuccess) { fprintf(stderr, "kernel_launch: hipFuncSetAttribute failed\n"); grid = -1; return; }
        if (hipOccupancyMaxActiveBlocksPerMultiprocessor(&per_cu, (const void*)yoco_fwd, NTHREADS, LDS_BYTES) != hipSuccess || per_cu < 1) { fprintf(stderr, "kernel_launch: occupancy query says %d\n", per_cu); per_cu = 1; }
        (void)hipGetLastError();
        if (cus != 256) { fprintf(stderr, "kernel_launch: built for a 256-CU device (got %d); nothing launched\n", cus); grid = -1; return; }
        grid = cus;
    }
    if (grid < 0) return;
    if (hipMemsetAsync((char*)d_ws + WS_CTL, 0, CTL_ZERO_BYTES, stream) != hipSuccess) { fprintf(stderr, "kernel_launch: memset failed\n"); return; }
    Args a{};
    for (int i = 0; i < 26; ++i) a.in[i] = (const float*)d_in[i];
    a.out = (float*)d_out; a.ws = (unsigned char*)d_ws;
#if MK_PER_PHASE
    for (int p = 0; p < NPHASES; ++p) { a.ph_lo = p; a.ph_hi = p + 1; hipLaunchKernelGGL(yoco_fwd, dim3(grid), dim3(NTHREADS), LDS_BYTES, stream, a); }
#else
    a.ph_lo = 0; a.ph_hi = NPHASES;
    void* kargs[] = {&a};
    hipError_t e = hipLaunchCooperativeKernel((const void*)yoco_fwd, dim3(grid), dim3(NTHREADS), kargs, LDS_BYTES, stream);
    if (e != hipSuccess) fprintf(stderr, "kernel_launch: cooperative launch failed: %s (grid %d)\n", hipGetErrorString(e), grid);
#endif
}
```

```cpp
#include <hip/hip_runtime.h>
#include <cstdio>
#include <cstdint>
#include <cmath>
namespace pg8 {
#define PG8_LAS __attribute__((address_space(3)))
typedef unsigned short bf16_t;
typedef short bf16x8 __attribute__((ext_vector_type(8)));
typedef float f32x4 __attribute__((ext_vector_type(4)));
typedef unsigned u32x4 __attribute__((ext_vector_type(4)));
constexpr int BM = 256, BK = 64, HALF = 128, HTB = HALF * BK * 2  , STAGE_BYTES = 8 * HTB, NXCD = 8, WGM = 8;

__host__ __device__ __forceinline__ int lds_byte(int r, int c) { const int st = (r >> 4) * 2 + (c >> 5), rr = r & 15, cc = c & 31, ob = rr * 64 + cc * 2; return st * 1024 + (ob ^ (((ob >> 9) & 1) << 5)); }
__host__ __device__ __forceinline__ void stage_rc(int b, int& R, int& C) { const int st = b / 1024, sb = b % 1024, swz = sb ^ (((sb >> 9) & 1) << 5); R = (st >> 1) * 16 + swz / 64; C = (st & 1) * 32 + (swz % 64) / 2; }
__host__ __device__ __forceinline__ int perm32(int rho) { const int n = rho >> 4, i = rho & 15; return 8 * (i >> 2) + 4 * n + (i & 3); }

struct Unit { int pm, pn, k0, nt, aux; };
struct Gemm { const bf16_t* A; const bf16_t* Bt; int M, N, K; };

struct StaticOrder {
    int nM, nN, nwg, G, c, nt0;
    __host__ __device__ void init(int M, int N, int K, int G_, int c_) { nM = M / BM; nN = N / BM; nwg = nM * nN; G = G_; c = c_; nt0 = K / BK; }
    __host__ __device__ bool next(int i, Unit& u) const {
        const long L = (long)i * G + c; if (L >= nwg) return false;
        int wgid = (int)L; { const int q = nwg / NXCD, r = nwg % NXCD, xcd = wgid % NXCD, off = wgid / NXCD; wgid = (xcd < r ? xcd * (q + 1) : r * (q + 1) + (xcd - r) * q) + off; }
        const int nig = WGM * nN, gid = wgid / nig, fm = gid * WGM, gsz = (nM - fm) < WGM ? (nM - fm) : WGM;
        u.pm = fm + ((wgid % nig) % gsz); u.pn = (wgid % nig) / gsz; u.k0 = 0; u.nt = nt0; u.aux = -1; return true;
    }
    __device__ __forceinline__ void a_ready(const Unit&) const {}
    __device__ __forceinline__ void done(const Unit&) const {}
};
struct ResOrder {
    StaticOrder so; int S, K, c;
    __host__ __device__ void init(int K_, int S_, int G_, int c_) { so.init(64 * BM, 1024, K_, G_, c_); S = S_; K = K_; c = c_; }
    __host__ __device__ bool next(int i, Unit& u) const {
        if (i == 0) return so.next(0, u);
        if (i == 1 && c < 20 * S) { const int t = c / S, sl = c - t * S; u.pm = 64 + (t >> 2); u.pn = t & 3; u.k0 = sl * (K / S); u.nt = K / S / BK; u.aux = sl; return true; }
        return false;
    }
    __device__ __forceinline__ void a_ready(const Unit&) const {}
    __device__ __forceinline__ void done(const Unit&) const {}
};

typedef float f32x2_cv0 __attribute__((ext_vector_type(2))); typedef __bf16 bf16x2_cv0 __attribute__((ext_vector_type(2)));
__device__ __forceinline__ unsigned cvt_pk_bf16(float lo, float hi) { const f32x2_cv0 v = {lo, hi}; const bf16x2_cv0 b = __builtin_convertvector(v, bf16x2_cv0); return __builtin_bit_cast(unsigned, b); }
typedef float f32x2 __attribute__((ext_vector_type(2)));
typedef unsigned u32x2 __attribute__((ext_vector_type(2)));
__device__ __forceinline__ float softplus_f(float x) { const float y = __expf(-fabsf(x)); const float l = (y < 0.03125f) ? y * (1.f - y * (0.5f - y * (1.f / 3.f - 0.25f * y))) : __logf(1.f + y); return fmaxf(x, 0.f) + l; }
struct EpiInProj {
    static constexpr bool PERM = true, AFTER_DRAIN = false;
    bf16_t* ZX; float* DT; const float* dt_bias;
    __device__ __forceinline__ void operator()(const f32x4 (&acc)[2][2][4][2], const Unit& u, int wr, int wc, int fr, int fq) const {
        const int row0 = u.pm * BM + wr * 64 + fr;
        if (u.pn < 24) {
            const int col0 = u.pn * BM + wc * 32 + 8 * fq;
#pragma unroll
            for (int ai = 0; ai < 2; ++ai)
#pragma unroll
                for (int m = 0; m < 4; ++m) { bf16_t* rowp = ZX + (size_t)(row0 + ai * HALF + m * 16) * 6144 + col0;
#pragma unroll
                    for (int bj = 0; bj < 2; ++bj) { const f32x4 v0 = acc[ai][bj][m][0], v1 = acc[ai][bj][m][1];
                        u32x4 w; w.x = cvt_pk_bf16(v0[0], v0[1]); w.y = cvt_pk_bf16(v0[2], v0[3]); w.z = cvt_pk_bf16(v1[0], v1[1]); w.w = cvt_pk_bf16(v1[2], v1[3]);
                        *(u32x4*)(rowp + bj * HALF) = w; } }
        } else if (wc == 0) {
            const int c0 = 8 * fq;
            const f32x4 b0 = *(const f32x4*)(dt_bias + c0), b1 = *(const f32x4*)(dt_bias + c0 + 4);
#pragma unroll
            for (int ai = 0; ai < 2; ++ai)
#pragma unroll
                for (int m = 0; m < 4; ++m) { float* rowp = DT + (size_t)(row0 + ai * HALF + m * 16) * 32 + c0;
                    const f32x4 v0 = acc[ai][0][m][0] + b0, v1 = acc[ai][0][m][1] + b1;
                    f32x4 o0, o1;
#pragma unroll
                    for (int j = 0; j < 4; ++j) { o0[j] = softplus_f(v0[j]); o1[j] = softplus_f(v1[j]); }
                    *(f32x4*)(rowp) = o0; *(f32x4*)(rowp + 4) = o1; }
        }
    }
};
struct EpiRes {
    static constexpr bool PERM = true, AFTER_DRAIN = false;
    const float* X; bf16_t* H; float* SLAB;
    __device__ __forceinline__ void operator()(const f32x4 (&acc)[2][2][4][2], const Unit& u, int wr, int wc, int fr, int fq) const {
        const int row0 = u.pm * BM + wr * 64 + fr, col0 = u.pn * BM + wc * 32 + 8 * fq;
        if (u.aux >= 0) {
            bf16_t* base = (bf16_t*)SLAB + (size_t)u.aux * (1280 * 1024) + (size_t)(row0 - 16384) * 1024 + col0;
#pragma unroll
            for (int ai = 0; ai < 2; ++ai)
#pragma unroll
                for (int m = 0; m < 4; ++m) { bf16_t* rowp = base + (size_t)(ai * HALF + m * 16) * 1024;
#pragma unroll
                    for (int bj = 0; bj < 2; ++bj) { const f32x4 v0 = acc[ai][bj][m][0], v1 = acc[ai][bj][m][1];
                        u32x4 w; w.x = cvt_pk_bf16(v0[0], v0[1]); w.y = cvt_pk_bf16(v0[2], v0[3]); w.z = cvt_pk_bf16(v1[0], v1[1]); w.w = cvt_pk_bf16(v1[2], v1[3]);
                        *(u32x4*)(rowp + bj * HALF) = w; } }
            return;
        }
#pragma unroll
        for (int ai = 0; ai < 2; ++ai) {
            f32x4 r0[4][2], r1[4][2];
            if (X) {
#pragma unroll
                for (int m = 0; m < 4; ++m)
#pragma unroll
                    for (int bj = 0; bj < 2; ++bj) { const float* p = X + (size_t)(row0 + ai * HALF + m * 16) * 1024 + col0 + bj * HALF; r0[m][bj] = *(const f32x4*)p; r1[m][bj] = *(const f32x4*)(p + 4); }
            } else {
                u32x4 hb[4][2];
#pragma unroll
                for (int m = 0; m < 4; ++m)
#pragma unroll
                    for (int bj = 0; bj < 2; ++bj) hb[m][bj] = *(const u32x4*)(H + (size_t)(row0 + ai * HALF + m * 16) * 1024 + col0 + bj * HALF);
#pragma unroll
                for (int m = 0; m < 4; ++m)
#pragma unroll
                    for (int bj = 0; bj < 2; ++bj) { const u32x4 w = hb[m][bj];
                        r0[m][bj] = (f32x4){__uint_as_float(w.x << 16), __uint_as_float(w.x & 0xffff0000u), __uint_as_float(w.y << 16), __uint_as_float(w.y & 0xffff0000u)};
                        r1[m][bj] = (f32x4){__uint_as_float(w.z << 16), __uint_as_float(w.z & 0xffff0000u), __uint_as_float(w.w << 16), __uint_as_float(w.w & 0xffff0000u)}; }
            }
#pragma unroll
            for (int m = 0; m < 4; ++m)
#pragma unroll
                for (int bj = 0; bj < 2; ++bj) { const f32x4 v0 = r0[m][bj] + acc[ai][bj][m][0], v1 = r1[m][bj] + acc[ai][bj][m][1];
                    u32x4 w; w.x = cvt_pk_bf16(v0[0], v0[1]); w.y = cvt_pk_bf16(v0[2], v0[3]); w.z = cvt_pk_bf16(v1[0], v1[1]); w.w = cvt_pk_bf16(v1[2], v1[3]);
                    *(u32x4*)(H + (size_t)(row0 + ai * HALF + m * 16) * 1024 + col0 + bj * HALF) = w; }
        }
    }
};
template <int ACT> struct EpiBf {
    static constexpr bool PERM = true, AFTER_DRAIN = false;
    bf16_t* O0; int ldc0; int nsplit; bf16_t* O1; int ldc1;
    __device__ __forceinline__ void operator()(const f32x4 (&acc)[2][2][4][2], const Unit& u, int wr, int wc, int fr, int fq) const {
        const int row0 = u.pm * BM + wr * 64 + fr;
        bf16_t* base; int ldc, colt;
        if (u.pn < nsplit) { base = O0; ldc = ldc0; colt = u.pn * BM; } else { base = O1; ldc = ldc1; colt = (u.pn - nsplit) * BM; }
        const int col0 = colt + wc * 32 + 8 * fq;
#pragma unroll
        for (int ai = 0; ai < 2; ++ai)
#pragma unroll
            for (int m = 0; m < 4; ++m) { bf16_t* rowp = base + (size_t)(row0 + ai * HALF + m * 16) * ldc + col0;
#pragma unroll
                for (int bj = 0; bj < 2; ++bj) { f32x4 v0 = acc[ai][bj][m][0], v1 = acc[ai][bj][m][1];
                    if (ACT == 1) {
#pragma unroll
                        for (int j = 0; j < 4; ++j) { const float a = fmaxf(v0[j], 0.f), b = fmaxf(v1[j], 0.f); v0[j] = a * a; v1[j] = b * b; } }
                    u32x4 w; w.x = cvt_pk_bf16(v0[0], v0[1]); w.y = cvt_pk_bf16(v0[2], v0[3]); w.z = cvt_pk_bf16(v1[0], v1[1]); w.w = cvt_pk_bf16(v1[2], v1[3]);
                    *(u32x4*)(rowp + bj * HALF) = w; } }
    }
};
struct EpiQSplit {
    static constexpr bool PERM = true, AFTER_DRAIN = false;
    bf16_t* Q; float* SLAB;
    __device__ __forceinline__ void operator()(const f32x4 (&acc)[2][2][4][2], const Unit& u, int wr, int wc, int fr, int fq) const {
        const int row0 = u.pm * BM + wr * 64 + fr, col0 = u.pn * BM + wc * 32 + 8 * fq;
        if (u.aux >= 0) {
            float* base = SLAB + (size_t)u.aux * (1280 * 1024) + (size_t)(row0 - 16384) * 1024 + col0;
#pragma unroll
            for (int ai = 0; ai < 2; ++ai)
#pragma unroll
                for (int m = 0; m < 4; ++m) { float* rowp = base + (size_t)(ai * HALF + m * 16) * 1024;
#pragma unroll
                    for (int bj = 0; bj < 2; ++bj) { *(f32x4*)(rowp + bj * HALF) = acc[ai][bj][m][0]; *(f32x4*)(rowp + bj * HALF + 4) = acc[ai][bj][m][1]; } }
            return;
        }
#pragma unroll
        for (int ai = 0; ai < 2; ++ai)
#pragma unroll
            for (int m = 0; m < 4; ++m) { bf16_t* rowp = Q + (size_t)(row0 + ai * HALF + m * 16) * 1024 + col0;
#pragma unroll
                for (int bj = 0; bj < 2; ++bj) { const f32x4 v0 = acc[ai][bj][m][0], v1 = acc[ai][bj][m][1];
                    u32x4 w; w.x = cvt_pk_bf16(v0[0], v0[1]); w.y = cvt_pk_bf16(v0[2], v0[3]); w.z = cvt_pk_bf16(v1[0], v1[1]); w.w = cvt_pk_bf16(v1[2], v1[3]);
                    *(u32x4*)(rowp + bj * HALF) = w; } }
    }
};

template <class Epi, class Sched, bool ALIGN_EPI = false, bool SP2 = false>
__device__ __forceinline__ void gemm_phase(PG8_LAS unsigned char* lds, const Gemm g, const Sched& S, const Epi& E) {
    int tid_l = threadIdx.x; asm volatile("" : "+v"(tid_l));
    const int tid = tid_l, wid = __builtin_amdgcn_readfirstlane(tid >> 6), lane = tid & 63, wr = wid >> 2, wc = wid & 3, fr = lane & 15, fq = lane >> 4;
    const int K = g.K;
    unsigned voffA[2], voffB[2];
#pragma unroll
    for (int i = 0; i < 2; ++i) { int R, C; stage_rc(tid * 16 + i * 8192, R, C); const int Rb = Epi::PERM ? ((R & ~31) + perm32(R & 31)) : R;
        voffA[i] = (unsigned)(R * K + C) * 2u; voffB[i] = (unsigned)(Rb * K + C) * 2u; }
    const size_t kstep = (size_t)(BK * 2);
    const size_t hstep = (size_t)HALF * K * 2;
    const size_t tstep = 2 * hstep;
    const unsigned ldsw = (unsigned)wid * 1024u;
    const int aoff = lds_byte(wr * 64 + fr, fq * 8), boff = lds_byte(wc * 32 + fr, fq * 8);
#define PG8_SA(b, h) (((b) * 2 + (h)) * HTB)
#define PG8_SB(b, h) ((4 + (b) * 2 + (h)) * HTB)
#define PG8_STAGE(bufoff, gbase, voff) do { _Pragma("unroll") for (int _i = 0; _i < 2; ++_i) \
        __builtin_amdgcn_global_load_lds((const unsigned*)((const char*)(gbase) + (voff)[_i]), (PG8_LAS unsigned*)(lds + (bufoff) + ldsw + _i * 8192), 16, 0, 0); } while (0)
#define PG8_LDA(dst, b, h) do { _Pragma("unroll") for (int m = 0; m < 4; ++m) _Pragma("unroll") for (int k = 0; k < 2; ++k) dst[m][k] = *(const PG8_LAS bf16x8*)(lds + PG8_SA(b, h) + aoff + m * 2048 + k * 1024); } while (0)
#define PG8_LDB(dst, b, h) do { _Pragma("unroll") for (int n = 0; n < 2; ++n) _Pragma("unroll") for (int k = 0; k < 2; ++k) dst[n][k] = *(const PG8_LAS bf16x8*)(lds + PG8_SB(b, h) + boff + n * 2048 + k * 1024); } while (0)
#define PG8_MMA(ai, bj, At, Bt) do { __builtin_amdgcn_s_setprio(1); _Pragma("unroll") for (int m = 0; m < 4; ++m) _Pragma("unroll") for (int n = 0; n < 2; ++n) _Pragma("unroll") for (int k = 0; k < 2; ++k) \
        acc[ai][bj][m][n] = __builtin_amdgcn_mfma_f32_16x16x32_bf16(Bt[n][k], At[m][k], acc[ai][bj][m][n], 0, 0, 0); __builtin_amdgcn_s_setprio(0); } while (0)
#define PG8_WAIT_V(n) asm volatile("s_waitcnt vmcnt(" #n ")" ::: "memory")
#define PG8_WAIT_L(n) asm volatile("s_waitcnt lgkmcnt(" #n ")" ::: "memory")
#define PG8_BAR __builtin_amdgcn_s_barrier()
#define PG8_SCHED __builtin_amdgcn_sched_barrier(0)
    Unit cur, nxt; int ui = 0;
    if (!S.next(0, cur)) return;
    f32x4 acc[2][2][4][2];
#pragma unroll
    for (int a = 0; a < 2; ++a)
#pragma unroll
        for (int b = 0; b < 2; ++b)
#pragma unroll
            for (int m = 0; m < 4; ++m)
#pragma unroll
                for (int n = 0; n < 2; ++n) acc[a][b][m][n] = (f32x4){0.f, 0.f, 0.f, 0.f};
    bf16x8 At[4][2], B0[2][2], B1[2][2];
    const char* cA = (const char*)g.A + (size_t)cur.pm * tstep + (size_t)cur.k0 * 2; const char* cB = (const char*)g.Bt + (size_t)cur.pn * tstep + (size_t)cur.k0 * 2;
    S.a_ready(cur);
    if constexpr (SP2) {
        PG8_STAGE(PG8_SB(0, 0), cB, voffB); PG8_STAGE(PG8_SB(0, 1), cB + hstep, voffB); PG8_STAGE(PG8_SA(0, 0), cA, voffA); PG8_STAGE(PG8_SA(0, 1), cA + hstep, voffA);
        if (wr == 1) PG8_BAR;
        PG8_WAIT_V(2); PG8_BAR;
        PG8_STAGE(PG8_SB(1, 0), cB + kstep, voffB); PG8_STAGE(PG8_SA(1, 0), cA + kstep, voffA); PG8_STAGE(PG8_SB(1, 1), cB + hstep + kstep, voffB);
        PG8_WAIT_V(6); PG8_BAR;
    } else {
        PG8_STAGE(PG8_SB(0, 0), cB, voffB); PG8_STAGE(PG8_SA(0, 0), cA, voffA); PG8_STAGE(PG8_SB(0, 1), cB + hstep, voffB); PG8_STAGE(PG8_SA(0, 1), cA + hstep, voffA);
        if (wr == 1) PG8_BAR;
        PG8_WAIT_V(4); PG8_BAR;
        PG8_STAGE(PG8_SB(1, 0), cB + kstep, voffB); PG8_STAGE(PG8_SA(1, 0), cA + kstep, voffA); PG8_STAGE(PG8_SB(1, 1), cB + hstep + kstep, voffB);
        PG8_WAIT_V(6); PG8_BAR;
    }
    for (;;) {
        const bool has_next = S.next(ui + 1, nxt);
        const char* nA = has_next ? (const char*)g.A + (size_t)nxt.pm * tstep + (size_t)nxt.k0 * 2 : cA; const char* nB = has_next ? (const char*)g.Bt + (size_t)nxt.pn * tstep + (size_t)nxt.k0 * 2 : cB;
        const int nt = cur.nt;
        for (int t = 0; t < nt; t += 2) {
            const bool last = (t == nt - 2);
            const char* a1 = cA + (size_t)(t + 1) * kstep;
            const char* a2 = last ? nA : cA + (size_t)(t + 2) * kstep; const char* b2 = last ? nB : cB + (size_t)(t + 2) * kstep;
            const char* a3 = a2 + kstep; const char* b3 = b2 + kstep;
            if (last && has_next) S.a_ready(nxt);
            if constexpr (SP2) {
            PG8_LDB(B0, 0, 0); PG8_LDB(B1, 0, 1); PG8_SCHED; PG8_LDA(At, 0, 0); PG8_STAGE(PG8_SA(1, 1), a1 + hstep, voffA);
            PG8_WAIT_V(8); PG8_WAIT_L(0); PG8_BAR; PG8_MMA(0, 0, At, B0); PG8_MMA(0, 1, At, B1); PG8_BAR; PG8_SCHED;
            PG8_LDA(At, 0, 1); PG8_STAGE(PG8_SB(0, 0), b2, voffB); PG8_STAGE(PG8_SB(0, 1), b2 + hstep, voffB); PG8_STAGE(PG8_SA(0, 0), a2, voffA);
            PG8_WAIT_V(8); PG8_WAIT_L(0); PG8_BAR; PG8_MMA(1, 0, At, B0); PG8_MMA(1, 1, At, B1); PG8_BAR; PG8_SCHED;
            PG8_LDB(B0, 1, 0); PG8_LDB(B1, 1, 1); PG8_SCHED; PG8_LDA(At, 1, 0); PG8_STAGE(PG8_SA(0, 1), a2 + hstep, voffA);
            PG8_WAIT_V(8); PG8_WAIT_L(0); PG8_BAR; PG8_MMA(0, 0, At, B0); PG8_MMA(0, 1, At, B1); PG8_BAR; PG8_SCHED;
            PG8_LDA(At, 1, 1); PG8_STAGE(PG8_SB(1, 0), b3, voffB); PG8_STAGE(PG8_SB(1, 1), b3 + hstep, voffB); PG8_STAGE(PG8_SA(1, 0), a3, voffA);
            PG8_WAIT_V(8); PG8_WAIT_L(0); PG8_BAR; PG8_MMA(1, 0, At, B0); PG8_MMA(1, 1, At, B1); PG8_BAR; PG8_SCHED;
            } else {
            PG8_LDB(B0, 0, 0); PG8_SCHED; PG8_LDA(At, 0, 0); PG8_STAGE(PG8_SA(1, 1), a1 + hstep, voffA);
            PG8_WAIT_L(8); PG8_BAR; PG8_WAIT_L(0); PG8_MMA(0, 0, At, B0); PG8_BAR; PG8_SCHED;
            PG8_LDB(B1, 0, 1); PG8_STAGE(PG8_SB(0, 0), b2, voffB);
            PG8_BAR; PG8_WAIT_L(0); PG8_MMA(0, 1, At, B1); PG8_BAR;
            PG8_LDA(At, 0, 1); PG8_STAGE(PG8_SA(0, 0), a2, voffA);
            PG8_BAR; PG8_WAIT_L(0); PG8_MMA(1, 0, At, B0); PG8_BAR; PG8_SCHED;
            PG8_STAGE(PG8_SB(0, 1), b2 + hstep, voffB);
            PG8_WAIT_V(6); PG8_BAR; PG8_MMA(1, 1, At, B1); PG8_BAR;
            PG8_LDB(B0, 1, 0); PG8_SCHED; PG8_LDA(At, 1, 0); PG8_STAGE(PG8_SA(0, 1), a2 + hstep, voffA);
            PG8_WAIT_L(8); PG8_BAR; PG8_WAIT_L(0); PG8_MMA(0, 0, At, B0); PG8_BAR; PG8_SCHED;
            PG8_LDB(B1, 1, 1); PG8_STAGE(PG8_SB(1, 0), b3, voffB);
            PG8_BAR; PG8_WAIT_L(0); PG8_MMA(0, 1, At, B1); PG8_BAR;
            PG8_LDA(At, 1, 1); PG8_STAGE(PG8_SA(1, 0), a3, voffA);
            PG8_BAR; PG8_WAIT_L(0); PG8_MMA(1, 0, At, B0); PG8_BAR; PG8_SCHED;
            PG8_STAGE(PG8_SB(1, 1), b3 + hstep, voffB);
            PG8_WAIT_V(6); PG8_BAR; PG8_MMA(1, 1, At, B1); PG8_BAR;
            }
        }
        if constexpr (ALIGN_EPI) { if (wr == 0) PG8_BAR; }
        if constexpr (!Epi::AFTER_DRAIN) { E(acc, cur, wr, wc, fr, fq); S.done(cur); }
        if (!has_next) break;
#pragma unroll
        for (int a = 0; a < 2; ++a)
#pragma unroll
            for (int b = 0; b < 2; ++b)
#pragma unroll
                for (int m = 0; m < 4; ++m)
#pragma unroll
                    for (int n = 0; n < 2; ++n) acc[a][b][m][n] = (f32x4){0.f, 0.f, 0.f, 0.f};
        cur = nxt; cA = nA; cB = nB; ++ui;
        if constexpr (ALIGN_EPI) { if (wr == 1) PG8_BAR; }
    }
    PG8_WAIT_V(0);
    if constexpr (!ALIGN_EPI) { if (wr == 0) PG8_BAR; }
    PG8_BAR;
    if constexpr (Epi::AFTER_DRAIN) { E.fused(acc, cur, wr, wc, fr, fq, lds, wid, lane); S.done(cur); }
#undef PG8_SA
#undef PG8_SB
#undef PG8_STAGE
#undef PG8_LDA
#undef PG8_LDB
#undef PG8_MMA
#undef PG8_WAIT_V
#undef PG8_WAIT_L
#undef PG8_BAR
#undef PG8_SCHED
}
}
#define GAS __attribute__((address_space(1)))
#define LAS __attribute__((address_space(3)))
typedef unsigned short bf16;
typedef unsigned v4u __attribute__((ext_vector_type(4)));
typedef float f32x4 __attribute__((ext_vector_type(4)));
typedef short bf16x8 __attribute__((ext_vector_type(8)));
typedef GAS unsigned gu32;
typedef GAS unsigned long long gu64;
#define RLX_AGENT __ATOMIC_RELAXED, __HIP_MEMORY_SCOPE_AGENT
#define LDS_WAIT() asm volatile("s_waitcnt lgkmcnt(0)" ::: "memory")
#define VM_WAIT() asm volatile("s_waitcnt vmcnt(0)" ::: "memory")
__device__ __forceinline__ unsigned long long rt() { return __builtin_amdgcn_s_memrealtime(); }
__device__ __forceinline__ unsigned f2bf(float f) { unsigned u = __builtin_bit_cast(unsigned, f); return (u + 0x7fffu + ((u >> 16) & 1u)) >> 16; }
__device__ __forceinline__ unsigned pk2(float lo, float hi) { return f2bf(lo) | (f2bf(hi) << 16); }

#define XB_TMO      128
#define XB_XCNT(j)  (256  + 64 * (j))
#define XB_XSUB(j)  (1280 + 64 * (j))
#define XB_XGEN(j)  (2304 + 64 * (j))
#define XB_TOP      3328
#define XB_TOPGEN   3392
#define XCD_BAR_WORDS 3456
#define XB_SPIN_CAP (1u << 18)

__device__ __forceinline__ unsigned xb_ld(unsigned* p)              { return __hip_atomic_load(p, __ATOMIC_RELAXED, __HIP_MEMORY_SCOPE_AGENT); }
__device__ __forceinline__ unsigned xb_add(unsigned* p, unsigned v) { return __hip_atomic_fetch_add(p, v, __ATOMIC_RELAXED, __HIP_MEMORY_SCOPE_AGENT); }
__device__ __forceinline__ unsigned xb_xcc_id() { return (unsigned)__builtin_amdgcn_s_getreg((3 << 11) | 20) & 0xFu; }
#define XB_SPIN(cond, bar) do { unsigned _sp = 0; while (cond) { __builtin_amdgcn_s_sleep(1); \
    if ((++_sp & 255u) == 0u) { if (xb_ld(&(bar)[XB_TMO])) break; if (_sp > XB_SPIN_CAP) { atomicAdd(&(bar)[XB_TMO], 1u); break; } } } } while (0)

struct XcdBarrier {
    unsigned* bar; unsigned x;
    volatile LAS unsigned* st;
};

__device__ __forceinline__ XcdBarrier xcd_barrier_post(unsigned* bar, volatile LAS unsigned* st) {
    XcdBarrier b; b.bar = bar; b.x = xb_xcc_id(); b.st = st;
    if (threadIdx.x == 0) (void)xb_add(&bar[XB_XCNT(b.x)], 1u);
    return b;
}
__device__ __forceinline__ void xcd_barrier_complete(unsigned* bar, unsigned x, unsigned& nloc, unsigned& nx) {
    const unsigned G = gridDim.x * gridDim.y * gridDim.z;
    unsigned sum, cnt, mine, sp = 0u;
    for (;;) {
        sum = 0u; cnt = 0u; mine = 0u;
#pragma unroll
        for (unsigned j = 0; j < 16; ++j) { const unsigned c = xb_ld(&bar[XB_XCNT(j)]); sum += c; cnt += (c > 0u) ? 1u : 0u; mine = (j == x) ? c : mine; }
        if (sum == G) break;
        __builtin_amdgcn_s_sleep(1);
        if ((++sp & 255u) == 0u) { if (xb_ld(&bar[XB_TMO])) break; if (sp > XB_SPIN_CAP) { atomicAdd(&bar[XB_TMO], 1u); break; } }
    }
    nloc = mine > 0u ? mine : 1u; nx = cnt > 0u ? cnt : 1u;
}

__device__ __forceinline__ void xcd_barrier(const XcdBarrier& b) {
    asm volatile("s_waitcnt vmcnt(0)" ::: "memory");
    __syncthreads();
    if (threadIdx.x == 0) {
        unsigned* bar = b.bar;
        __builtin_amdgcn_s_waitcnt(0);
        unsigned nloc = b.st[0], nx = b.st[1];
        if (nloc == 0u) { xcd_barrier_complete(bar, b.x, nloc, nx); b.st[0] = nloc; b.st[1] = nx; }
        const unsigned old = xb_add(&bar[XB_XSUB(b.x)], 1u);
        const unsigned gen = old / nloc;
        if (old + 1u == (gen + 1u) * nloc) {
            __builtin_amdgcn_fence(__ATOMIC_RELEASE, "agent");
            asm volatile("s_waitcnt vmcnt(0)" ::: "memory");
            const unsigned og = xb_add(&bar[XB_TOP], 1u);
            const unsigned tg = og / nx;
            if (og + 1u == (tg + 1u) * nx) xb_add(&bar[XB_TOPGEN], 1u);
            else XB_SPIN(xb_ld(&bar[XB_TOPGEN]) == tg, bar);
            __builtin_amdgcn_fence(__ATOMIC_ACQUIRE, "agent");
            xb_add(&bar[XB_XGEN(b.x)], 1u);
            asm volatile("s_waitcnt vmcnt(0)" ::: "memory");
        } else {
            XB_SPIN(xb_ld(&bar[XB_XGEN(b.x)]) == gen, bar);
            __builtin_amdgcn_fence(__ATOMIC_ACQUIRE, "agent");
            asm volatile("s_waitcnt vmcnt(0)" ::: "memory");
        }
    }
    __syncthreads();
}
constexpr int NWAVES = 8, NTHREADS = 512;
constexpr int DM = 1024, SEQ = 8192, NPROMPT = 2, NSAMP = 128, TSAMP = 8, NMETA = 16;
constexpr int ROW_S = NPROMPT * SEQ;
constexpr int ROW_M = ROW_S + NSAMP * TSAMP;
constexpr int NROWS = ROW_M + NMETA;
constexpr int MP = 17664;
constexpr int DINNER = 2048, NHEADS = 32, HD = 64, NGROUPS = 8, DSTATE = 128, CONVD = 4096, INPROJ = 6176, INPROJ_P = 6400, ZXW = 6144;
constexpr int DFF = 4096, NKV = 4, NQ = 16, KVW = 512;
constexpr float EPS = 1e-5f;
constexpr int LDX = 136;

constexpr size_t O_YP = 0, O_YS = O_YP + (size_t)NPROMPT * SEQ * DM, O_PCONV = O_YS + (size_t)NSAMP * TSAMP * DM, O_PSSM = O_PCONV + 2 * 2 * 3 * 4096,
    O_PCK = O_PSSM + (size_t)2 * 2 * 32 * 64 * 128, O_PCV = O_PCK + 2 * 128 * 256, O_SCONV = O_PCV + 2 * 128 * 256, O_SSSM = O_SCONV + (size_t)2 * 128 * 3 * 4096,
    O_SCK = O_SSSM + (size_t)2 * 128 * 32 * 64 * 128, O_SCV = O_SCK + (size_t)128 * 128 * 256, O_END = O_SCV + (size_t)128 * 128 * 256;

constexpr size_t MiB = 1u << 20;
constexpr size_t WS_CTL = 0, CTL_ZERO_BYTES = 1 * MiB;
constexpr size_t SZ_WIN = (size_t)INPROJ_P * 1024 * 2, SZ_WOUT = (size_t)1024 * 2048 * 2, SZ_WUP = (size_t)4096 * 1024 * 2, SZ_WDN = SZ_WUP, SZ_WQKV0 = (size_t)1536 * 1024 * 2, SZ_WQ1 = (size_t)1024 * 1024 * 2, SZ_WO = SZ_WQ1;
constexpr size_t WS_WIN = 1 * MiB, WS_WOUT = WS_WIN + 2 * SZ_WIN, WS_WUP = WS_WOUT + 2 * SZ_WOUT, WS_WDN = WS_WUP + 4 * SZ_WUP, WS_WQKV0 = WS_WDN + 4 * SZ_WDN, WS_WQ1 = WS_WQKV0 + SZ_WQKV0, WS_WO = WS_WQ1 + SZ_WQ1, WS_WEND = WS_WO + 2 * SZ_WO;
constexpr size_t al1m(size_t x) { return (x + MiB - 1) / MiB * MiB; }
constexpr size_t WS_H = al1m(WS_WEND), WS_HN = al1m(WS_H + (size_t)MP * 1024 * 4), WS_ZX = al1m(WS_HN + (size_t)MP * 1024 * 2), WS_DT = al1m(WS_ZX + (size_t)MP * ZXW * 2),
    WS_XC = al1m(WS_DT + (size_t)MP * 32 * 4), WS_YN = al1m(WS_XC + (size_t)MP * 4096 * 2), WS_CS = al1m(WS_YN + (size_t)MP * 2048 * 2), WS_CD = al1m(WS_CS + (size_t)129 * 32 * 8192 * 4), WS_SLAB = al1m(WS_CD + 129 * 32 * 4), WS_HSB = al1m(WS_SLAB + (size_t)8 * 1280 * 1024 * 4), WS_END = al1m(WS_HSB + (size_t)128 * 32 * 8192 * 2);
constexpr size_t WS_U = WS_ZX;
constexpr size_t WS_Q = WS_XC, WS_KV = WS_Q + (size_t)MP * 1024 * 2, WS_AO = WS_KV + (size_t)MP * 512 * 2;
static_assert(WS_AO + (size_t)MP * 1024 * 2 <= WS_YN, "attention overlay");
constexpr int CW_BAR = 4096;

constexpr int RING_BYTES = 131072, LDS_BYTES = 147456, LDSCTL_OFF = LDS_BYTES - 512, MISC_OFF = LDSCTL_OFF + 320;

typedef unsigned u32x2 __attribute__((ext_vector_type(2)));
typedef unsigned u32x4 __attribute__((ext_vector_type(4)));
__device__ __forceinline__ int ltid() { int t = threadIdx.x; asm volatile("" : "+v"(t)); return t; }
__device__ __forceinline__ float bf2f(unsigned short b) { return __uint_as_float((unsigned)b << 16); }
__device__ __forceinline__ float bflo(unsigned w) { return __uint_as_float(w << 16); }
__device__ __forceinline__ float bfhi(unsigned w) { return __uint_as_float(w & 0xffff0000u); }
__device__ __forceinline__ unsigned pkbf(float lo, float hi) { return pg8::cvt_pk_bf16(lo, hi); }
__device__ __forceinline__ float wave_sum(float v) {
#pragma unroll
    for (int o = 1; o < 64; o <<= 1) v += __shfl_xor(v, o);
    return v;
}
__device__ __forceinline__ float frcp(float x) { return __builtin_amdgcn_rcpf(x); }
__device__ __forceinline__ float sigmoid_f(float x) { return frcp(1.f + __expf(-x)); }
#define MFMA16(b, a, c) __builtin_amdgcn_mfma_f32_16x16x32_bf16((b), (a), (c), 0, 0, 0)

struct Args {
    const float* in[26]; float* out; unsigned char* ws; int ph_lo, ph_hi;
};
typedef const __attribute__((address_space(4))) Args* ArgsP;
enum { I_XP = 0, I_XS, I_SCONV, I_SSSM, I_CK, I_CV, I_META, I_ANORM, I_AIN, I_ACONVW, I_ACONVB, I_ADTB, I_ALOG, I_ADSKIP, I_AGATE, I_AOUT, I_KVNORM, I_WKV, I_BNORM, I_WQ, I_SINKS, I_WO, I_MLPNORM, I_WUP, I_WDOWN, I_FNORM };

__device__ __forceinline__ void transpose_item(const float* W, const float* scale, int K, int N, bf16* WT, int row_off, LAS unsigned* scr, int item, int lane) {
    const int nblk = (N + 63) / 64, kb = item / nblk, nb = item % nblk, k0 = 64 * kb, n0 = 64 * nb;
    const bool ok = (n0 + lane < N);
    const float* src = W + (size_t)k0 * N + n0 + (ok ? lane : 0);
    float v[64];
#pragma unroll
    for (int i = 0; i < 64; ++i) v[i] = __builtin_nontemporal_load(src + (size_t)i * N);
    if (!ok) {
#pragma unroll
        for (int i = 0; i < 64; ++i) v[i] = 0.f;
    }
    if (scale) {
#pragma unroll
        for (int i = 0; i < 64; ++i) v[i] *= scale[k0 + i];
    }
#pragma unroll
    for (int i = 0; i < 32; ++i) scr[lane * 33 + i] = pkbf(v[2 * i], v[2 * i + 1]);
    LDS_WAIT(); asm volatile("" ::: "memory");
    const int c = lane & 7;
#pragma unroll
    for (int j = 0; j < 8; ++j) { const int n = (lane >> 3) + 8 * j; const LAS unsigned* sp = scr + n * 33 + 4 * c;
        v4u o; o.x = sp[0]; o.y = sp[1]; o.z = sp[2]; o.w = sp[3];
        if (n0 + n < N) *(GAS v4u*)(WT + (size_t)(row_off + n0 + n) * K + k0 + 8 * c) = o; }
    LDS_WAIT(); asm volatile("" ::: "memory");
}
struct WJob { const float* W; const float* scale; int K, N; bf16* WT; int row_off; int items; };

__device__ __forceinline__ void phase_prologue(ArgsP a, LAS unsigned char* lds, int wave, int lane) {
    LAS unsigned* scr = (LAS unsigned*)(lds + wave * 16384);
    const int gw = blockIdx.x * NWAVES + wave, NGW = gridDim.x * NWAVES;
    unsigned char* ws = a->ws;
    for (int jb = 0; jb < 21; ++jb) {
        WJob J;
        if (jb < 2)       { const int i = jb;      J = WJob{a->in[I_AIN] + (size_t)i * 1024 * INPROJ, a->in[I_ANORM] + i * 1024, 1024, INPROJ, (bf16*)(ws + WS_WIN + i * SZ_WIN), 0, 0}; }
        else if (jb < 4)  { const int i = jb - 2;  J = WJob{a->in[I_AOUT] + (size_t)i * 2048 * 1024, a->in[I_AGATE] + i * 2048, 2048, 1024, (bf16*)(ws + WS_WOUT + i * SZ_WOUT), 0, 0}; }
        else if (jb < 8)  { const int l = jb - 4;  J = WJob{a->in[I_WUP] + (size_t)l * 1024 * 4096, a->in[I_MLPNORM] + l * 1024, 1024, 4096, (bf16*)(ws + WS_WUP + l * SZ_WUP), 0, 0}; }
        else if (jb < 12) { const int l = jb - 8;  J = WJob{a->in[I_WDOWN] + (size_t)l * 4096 * 1024, nullptr, 4096, 1024, (bf16*)(ws + WS_WDN + l * SZ_WDN), 0, 0}; }
        else if (jb == 12) { J = WJob{a->in[I_WQ], a->in[I_BNORM], 1024, 1024, (bf16*)(ws + WS_WQKV0), 0, 0}; }
        else if (jb == 13) { J = WJob{a->in[I_WKV], a->in[I_KVNORM], 1024, 512, (bf16*)(ws + WS_WQKV0), 1024, 0}; }
        else if (jb == 14) { J = WJob{a->in[I_WQ] + (size_t)1024 * 1024, a->in[I_BNORM] + 1024, 1024, 1024, (bf16*)(ws + WS_WQ1), 0, 0}; }
        else if (jb < 17) { const int j = jb - 15; J = WJob{a->in[I_WO] + (size_t)j * 1024 * 1024, nullptr, 1024, 1024, (bf16*)(ws + WS_WO + j * SZ_WO), 0, 0}; }
        else break;
        const int items = (J.K / 64) * ((J.N + 63) / 64);
        for (int it = gw; it < items; it += NGW) transpose_item(J.W, J.scale, J.K, J.N, J.WT, J.row_off, scr, it, lane);
    }
    {
        const int gt = blockIdx.x * NTHREADS + ltid(), NT = gridDim.x * NTHREADS;
        const int per = (INPROJ_P - INPROJ) * 1024 * 2 / 16;
        for (int e = gt; e < 2 * per; e += NT) { const int i = e / per, c = e % per;
            *(v4u*)(ws + WS_WIN + i * SZ_WIN + (size_t)INPROJ * 1024 * 2 + (size_t)c * 16) = (v4u){0u, 0u, 0u, 0u}; }
    }
}

__device__ __forceinline__ void row_ld_bf(const bf16* __restrict__ p, int lane, float (&v)[16]) {
    const u32x4 a0 = *(const u32x4*)(p + 8 * lane), a1 = *(const u32x4*)(p + 512 + 8 * lane);
    v[0] = bflo(a0.x); v[1] = bfhi(a0.x); v[2] = bflo(a0.y); v[3] = bfhi(a0.y); v[4] = bflo(a0.z); v[5] = bfhi(a0.z); v[6] = bflo(a0.w); v[7] = bfhi(a0.w);
    v[8] = bflo(a1.x); v[9] = bfhi(a1.x); v[10] = bflo(a1.y); v[11] = bfhi(a1.y); v[12] = bflo(a1.z); v[13] = bfhi(a1.z); v[14] = bflo(a1.w); v[15] = bfhi(a1.w);
}
__device__ __forceinline__ void row_ld_f32(const float* __restrict__ p, int lane, float (&v)[16], bool nt) {
    f32x4 q[4];
    if (nt) { q[0] = __builtin_nontemporal_load((const f32x4*)(p + 8 * lane)); q[1] = __builtin_nontemporal_load((const f32x4*)(p + 8 * lane + 4)); q[2] = __builtin_nontemporal_load((const f32x4*)(p + 512 + 8 * lane)); q[3] = __builtin_nontemporal_load((const f32x4*)(p + 512 + 8 * lane + 4)); }
    else { q[0] = *(const f32x4*)(p + 8 * lane); q[1] = *(const f32x4*)(p + 8 * lane + 4); q[2] = *(const f32x4*)(p + 512 + 8 * lane); q[3] = *(const f32x4*)(p + 512 + 8 * lane + 4); }
#pragma unroll
    for (int k = 0; k < 4; ++k) { v[4 * k] = q[k].x; v[4 * k + 1] = q[k].y; v[4 * k + 2] = q[k].z; v[4 * k + 3] = q[k].w; }
}
__device__ __forceinline__ void row_st_bf(bf16* __restrict__ p, int lane, const float (&v)[16], float sc) {
    u32x4 a0, a1;
    a0.x = pkbf(v[0] * sc, v[1] * sc); a0.y = pkbf(v[2] * sc, v[3] * sc); a0.z = pkbf(v[4] * sc, v[5] * sc); a0.w = pkbf(v[6] * sc, v[7] * sc);
    a1.x = pkbf(v[8] * sc, v[9] * sc); a1.y = pkbf(v[10] * sc, v[11] * sc); a1.z = pkbf(v[12] * sc, v[13] * sc); a1.w = pkbf(v[14] * sc, v[15] * sc);
    *(u32x4*)(p + 8 * lane) = a0; *(u32x4*)(p + 512 + 8 * lane) = a1;
}
__device__ __forceinline__ float row_rs(const float (&v)[16]) {
    float s = 0.f;
#pragma unroll
    for (int k = 0; k < 16; ++k) s += v[k] * v[k];
    return rsqrtf(wave_sum(s) * (1.f / DM) + EPS);
}
__device__ __forceinline__ void phase_norm(ArgsP a, int from_inputs, int nslab, int wave, int lane) {
    bf16* __restrict__ H = (bf16*)(a->ws + WS_H); bf16* __restrict__ HN = (bf16*)(a->ws + WS_HN); const float* __restrict__ SLAB = (const float*)(a->ws + WS_SLAB);
    const int gw = blockIdx.x * NWAVES + wave, NGW = gridDim.x * NWAVES;
    for (int m = ROW_S + gw; m < MP; m += NGW) {
        if (m >= NROWS) { *(u32x4*)(HN + (size_t)m * DM + 8 * lane) = (u32x4){0u, 0u, 0u, 0u}; *(u32x4*)(HN + (size_t)m * DM + 512 + 8 * lane) = (u32x4){0u, 0u, 0u, 0u}; continue; }
        float v[16];
        if (from_inputs) row_ld_f32((m < ROW_M) ? a->in[I_XS] + (size_t)(m - ROW_S) * DM : a->in[I_META] + (size_t)(m - ROW_M) * DM, lane, v, false);
        else row_ld_bf(H + (size_t)m * DM, lane, v);
        float sv[8][16];
#pragma unroll
        for (int sl = 0; sl < 8; ++sl) { if (sl < nslab) row_ld_bf((const bf16*)SLAB + (size_t)sl * (1280 * 1024) + (size_t)(m - ROW_S) * DM, lane, sv[sl]); else {
#pragma unroll
                for (int k = 0; k < 16; ++k) sv[sl][k] = 0.f; } }
#pragma unroll
        for (int sl = 0; sl < 8; ++sl)
#pragma unroll
            for (int k = 0; k < 16; ++k) v[k] += sv[sl][k];
        if (nslab > 0 || from_inputs) row_st_bf(H + (size_t)m * DM, lane, v, 1.f);
        row_st_bf(HN + (size_t)m * DM, lane, v, row_rs(v));
    }
    for (int m0 = 4 * gw; m0 < ROW_S; m0 += 4 * NGW) {
        float v[4][16];
#pragma unroll
        for (int q = 0; q < 4; ++q) { if (from_inputs) row_ld_f32(a->in[I_XP] + (size_t)(m0 + q) * DM, lane, v[q], false); else row_ld_bf(H + (size_t)(m0 + q) * DM, lane, v[q]); }
#pragma unroll
        for (int q = 0; q < 4; ++q) row_st_bf(HN + (size_t)(m0 + q) * DM, lane, v[q], row_rs(v[q]));
    }
}
__device__ __forceinline__ void phase_final(ArgsP a, int wave, int lane) {
    const bf16* __restrict__ H = (const bf16*)(a->ws + WS_H); const float* __restrict__ fw = a->in[I_FNORM]; const float* __restrict__ SLAB = (const float*)(a->ws + WS_SLAB);
    const int gw = blockIdx.x * NWAVES + wave, NGW = gridDim.x * NWAVES;
    float w[16]; row_ld_f32(fw, lane, w, false);
    for (int m = gw; m < ROW_M; m += NGW) {
        float v[16]; row_ld_bf(H + (size_t)m * DM, lane, v);
        if (m >= ROW_S) {
#pragma unroll 1
            for (int sl = 0; sl < 8; ++sl) { float t[16]; row_ld_bf((const bf16*)SLAB + (size_t)sl * (1280 * 1024) + (size_t)(m - ROW_S) * DM, lane, t);
#pragma unroll
                for (int k = 0; k < 16; ++k) v[k] += t[k]; }
        }
        const float rs = row_rs(v);
        float* o = a->out + O_YP + (size_t)m * DM;
        __builtin_nontemporal_store((f32x4){v[0] * rs * w[0], v[1] * rs * w[1], v[2] * rs * w[2], v[3] * rs * w[3]}, (f32x4*)(o + 8 * lane));
        __builtin_nontemporal_store((f32x4){v[4] * rs * w[4], v[5] * rs * w[5], v[6] * rs * w[6], v[7] * rs * w[7]}, (f32x4*)(o + 8 * lane + 4));
        __builtin_nontemporal_store((f32x4){v[8] * rs * w[8], v[9] * rs * w[9], v[10] * rs * w[10], v[11] * rs * w[11]}, (f32x4*)(o + 512 + 8 * lane));
        __builtin_nontemporal_store((f32x4){v[12] * rs * w[12], v[13] * rs * w[13], v[14] * rs * w[14], v[15] * rs * w[15]}, (f32x4*)(o + 512 + 8 * lane + 4));
    }
}

__device__ __forceinline__ void unpack8(const u32x4 w, float (&f)[8]) { f[0] = bflo(w.x); f[1] = bfhi(w.x); f[2] = bflo(w.y); f[3] = bfhi(w.y); f[4] = bflo(w.z); f[5] = bfhi(w.z); f[6] = bflo(w.w); f[7] = bfhi(w.w); }
__device__ __forceinline__ void ld8f(const float* __restrict__ p, float (&f)[8]) { const f32x4 x0 = *(const f32x4*)p, x1 = *(const f32x4*)(p + 4); f[0]=x0.x;f[1]=x0.y;f[2]=x0.z;f[3]=x0.w;f[4]=x1.x;f[5]=x1.y;f[6]=x1.z;f[7]=x1.w; }
#define TSW(ch) ((((ch) >> 3) & 7) << 3)
struct ConvW { float w0[8], w1[8], w2[8], w3[8], bs[8]; };
__device__ __forceinline__ void conv_load_w(const float* __restrict__ cw, const float* __restrict__ cb, int c0, ConvW& W) { ld8f(cw + c0, W.w0); ld8f(cw + CONVD + c0, W.w1); ld8f(cw + 2 * CONVD + c0, W.w2); ld8f(cw + 3 * CONVD + c0, W.w3); ld8f(cb + c0, W.bs); }
__device__ __forceinline__ void conv_load_run(const bf16* __restrict__ ZX, int Rrow, int c0, int pk, bool valid, u32x4 (&raw)[11]) {
#pragma unroll
    for (int t = 0; t < 8; ++t) { raw[3 + t] = (u32x4){0u, 0u, 0u, 0u}; if (valid) raw[3 + t] = *(const u32x4*)(ZX + (size_t)(Rrow + t) * ZXW + 2048 + c0); }
#pragma unroll
    for (int t = 0; t < 3; ++t) { const int rr = (pk == 1) ? ROW_M + 13 + t : Rrow - 3 + t; raw[t] = (u32x4){0u, 0u, 0u, 0u}; if (valid && pk != 2) raw[t] = *(const u32x4*)(ZX + (size_t)rr * ZXW + 2048 + c0); }
}
template <int J> __device__ __forceinline__ void conv_channel(const u32x4 (&raw)[11], const ConvW& W, float (&o)[8]) {
    float x[11];
#pragma unroll
    for (int i = 0; i < 11; ++i) { const unsigned w = raw[i][J >> 1]; x[i] = (J & 1) ? bfhi(w) : bflo(w); }
#pragma unroll
    for (int t = 0; t < 8; ++t) { const float v = W.bs[J] + W.w0[J] * x[t] + W.w1[J] * x[t + 1] + W.w2[J] * x[t + 2] + W.w3[J] * x[t + 3]; o[t] = v * sigmoid_f(v); }
}
template <int J> __device__ __forceinline__ void conv_store_t(const u32x4 (&raw)[11], const ConvW& W, const float (&scale)[8], bf16* T, int ch0, int run) {
    float o[8]; conv_channel<J>(raw, W, o);
    u32x4 w; w.x = pkbf(o[0] * scale[0], o[1] * scale[1]); w.y = pkbf(o[2] * scale[2], o[3] * scale[3]); w.z = pkbf(o[4] * scale[4], o[5] * scale[5]); w.w = pkbf(o[6] * scale[6], o[7] * scale[7]);
    *(u32x4*)(T + (ch0 + J) * LDX + ((8 * run) ^ TSW(ch0 + J))) = w;
}
__device__ __forceinline__ void conv_item_t(const u32x4 (&raw)[11], const ConvW& W, const float (&scale)[8], bf16* T, int ch0, int run) {
    conv_store_t<0>(raw, W, scale, T, ch0, run); conv_store_t<1>(raw, W, scale, T, ch0, run); conv_store_t<2>(raw, W, scale, T, ch0, run); conv_store_t<3>(raw, W, scale, T, ch0, run);
    conv_store_t<4>(raw, W, scale, T, ch0, run); conv_store_t<5>(raw, W, scale, T, ch0, run); conv_store_t<6>(raw, W, scale, T, ch0, run); conv_store_t<7>(raw, W, scale, T, ch0, run);
}
__device__ __forceinline__ void conv_item_n(const u32x4 (&raw)[11], const ConvW& W, bf16* N, int run, int colel) {
    float p0[8], p1[8], p2[8]; unpack8(raw[0], p0); unpack8(raw[1], p1); unpack8(raw[2], p2);
#pragma unroll
    for (int t = 0; t < 8; ++t) { float x[8]; unpack8(raw[3 + t], x); float o[8];
#pragma unroll
        for (int j = 0; j < 8; ++j) { const float v = W.bs[j] + W.w0[j] * p0[j] + W.w1[j] * p1[j] + W.w2[j] * p2[j] + W.w3[j] * x[j]; o[j] = v * sigmoid_f(v); }
        u32x4 w; w.x = pkbf(o[0], o[1]); w.y = pkbf(o[2], o[3]); w.z = pkbf(o[4], o[5]); w.w = pkbf(o[6], o[7]);
        *(u32x4*)(N + (8 * run + t) * LDX + colel) = w;
#pragma unroll
        for (int j = 0; j < 8; ++j) { p0[j] = p1[j]; p1[j] = p2[j]; p2[j] = x[j]; } }
}
__device__ __forceinline__ void conv_state_out(const u32x4 (&raw)[11], float* __restrict__ dst  ) {
#pragma unroll
    for (int k = 0; k < 3; ++k) { float x[8]; unpack8(raw[8 + k], x); *(f32x4*)(dst + (size_t)k * CONVD) = (f32x4){x[0], x[1], x[2], x[3]}; *(f32x4*)(dst + (size_t)k * CONVD + 4) = (f32x4){x[4], x[5], x[6], x[7]}; }
}

__device__ __forceinline__ void ssd_acs(const float* DT, const float* alog, int R0, int len, int h0, float* s_dt, float* s_acs, int wave, int lane) {
    if (wave < 4) {
        const int r = wave; const float An = -__expf(alog[h0 + r]);
        const int l0 = 2 * lane;
        const float d0 = (l0 < len) ? DT[(size_t)(R0 + l0) * 32 + h0 + r] : 0.f;
        const float d1 = (l0 + 1 < len) ? DT[(size_t)(R0 + l0 + 1) * 32 + h0 + r] : 0.f;
        const float a0 = d0 * An, a1 = d1 * An, s = a0 + a1;
        float incl = s;
#pragma unroll
        for (int o = 1; o < 64; o <<= 1) { const float t = __shfl_up(incl, o); if (lane >= o) incl += t; }
        const float excl = incl - s;
        s_dt[r * 128 + l0] = d0; s_dt[r * 128 + l0 + 1] = d1;
        s_acs[r * 128 + l0] = excl + a0; s_acs[r * 128 + l0 + 1] = excl + s;
    }
}
#define LFRAG(base, row, ld, ks) (*(const bf16x8*)((base) + (row) * (ld) + 32 * (ks) + 8 * fq))

__device__ __forceinline__ void ssd1_unit(ArgsP a, int li, unsigned char* lds, int slot, int g, int R0, int len, int, int, int) {
    const int tid = ltid(), lane = tid & 63, wave = __builtin_amdgcn_readfirstlane(tid >> 6);
    const float* __restrict__ DT = (const float*)(a->ws + WS_DT);
    bf16* __restrict__ CS = (bf16*)(a->ws + WS_CS); float* __restrict__ CD = (float*)(a->ws + WS_CD);
    bf16* XsT = (bf16*)lds;
    bf16* BT = (bf16*)(lds + 256 * LDX * 2);
    float* s_dt = (float*)(lds + 384 * LDX * 2); float* s_acs = s_dt + 512;
    const int fr = lane & 15, fq = lane >> 4, h0 = g * 4;
    const float* __restrict__ cw = a->in[I_ACONVW] + (size_t)li * 4 * CONVD; const float* __restrict__ cbias = a->in[I_ACONVB] + (size_t)li * CONVD;
    const bf16* __restrict__ ZX = (const bf16*)(a->ws + WS_ZX);
    const bool meta = (slot == 128), chunk0 = (!meta && (slot & 63) == 0);
    const int xcb = tid & 31, xrun = tid >> 5, xc0 = g * 256 + xcb * 8;
    const int bcb = tid & 15, brun = (tid >> 4) & 15, bc0 = 2048 + g * 128 + bcb * 8;
    u32x4 rx[11], rb[11];
    conv_load_run(ZX, R0 + 8 * xrun, xc0, (xrun == 0) ? (meta ? 2 : (chunk0 ? 1 : 0)) : 0, 8 * xrun < len, rx);
    if (tid < 256) conv_load_run(ZX, R0 + 8 * brun, bc0, (brun == 0) ? (meta ? 2 : (chunk0 ? 1 : 0)) : 0, 8 * brun < len, rb);
    ssd_acs(DT, a->in[I_ALOG] + li * NHEADS, R0, len, h0, s_dt, s_acs, wave, lane);
    if (tid < 256) { ConvW W; conv_load_w(cw, cbias, bc0, W); const float one[8] = {1.f, 1.f, 1.f, 1.f, 1.f, 1.f, 1.f, 1.f}; conv_item_t(rb, W, one, BT, bcb * 8, brun); }
    __syncthreads();
    {   ConvW W; conv_load_w(cw, cbias, xc0, W);
        const int r = xcb >> 3; const float tot = s_acs[r * 128 + 127];
        const f32x4 a0 = *(const f32x4*)(s_acs + r * 128 + 8 * xrun), a1 = *(const f32x4*)(s_acs + r * 128 + 8 * xrun + 4), d0 = *(const f32x4*)(s_dt + r * 128 + 8 * xrun), d1 = *(const f32x4*)(s_dt + r * 128 + 8 * xrun + 4);
        float wl[8];
#pragma unroll
        for (int t = 0; t < 4; ++t) { wl[t] = __expf(tot - a0[t]) * d0[t]; wl[4 + t] = __expf(tot - a1[t]) * d1[t]; }
        conv_item_t(rx, W, wl, XsT, xcb * 8, xrun);
    }
    __syncthreads();
    f32x4 acc[2][8];
#pragma unroll
    for (int mi = 0; mi < 2; ++mi)
#pragma unroll
        for (int ni = 0; ni < 8; ++ni) acc[mi][ni] = (f32x4){0.f, 0.f, 0.f, 0.f};
#pragma unroll
    for (int ks = 0; ks < 4; ++ks) {
        const int ra0 = 32 * wave + fr, ra1 = ra0 + 16;
        const bf16x8 a0 = *(const bf16x8*)(XsT + ra0 * LDX + ((32 * ks + 8 * fq) ^ TSW(ra0))), a1 = *(const bf16x8*)(XsT + ra1 * LDX + ((32 * ks + 8 * fq) ^ TSW(ra1)));
#pragma unroll
        for (int ni = 0; ni < 8; ++ni) { const int rb = 16 * ni + fr; const bf16x8 bb = *(const bf16x8*)(BT + rb * LDX + ((32 * ks + 8 * fq) ^ TSW(rb)));
            acc[0][ni] = MFMA16(bb, a0, acc[0][ni]); acc[1][ni] = MFMA16(bb, a1, acc[1][ni]); }
    }
#pragma unroll
    for (int mi = 0; mi < 2; ++mi) { const int hp = 32 * wave + 16 * mi + fr, r = hp >> 6, p = hp & 63;
        bf16* dst = CS + ((size_t)(slot * 32 + h0 + r) * 64 + p) * 128 + 4 * fq;
#pragma unroll
        for (int ni = 0; ni < 8; ++ni) { u32x2 w; w.x = pkbf(acc[mi][ni][0], acc[mi][ni][1]); w.y = pkbf(acc[mi][ni][2], acc[mi][ni][3]); *(u32x2*)(dst + 16 * ni) = w; } }
    if (tid < 4) CD[slot * 32 + h0 + tid] = __expf(s_acs[tid * 128 + 127]);
    __syncthreads();
}

__device__ __forceinline__ void ssd_sample_issue(ArgsP a, int li, int b, int g, f32x4 (&st)[4][4]) {
    const int tid = ltid(), p = tid >> 3, nb = tid & 7;
    const float* __restrict__ sin_ = a->in[I_SSSM] + ((size_t)((li * NSAMP + b) * NHEADS + g * 4) * 64 + p) * 128 + 4 * nb;
#pragma unroll
    for (int r = 0; r < 4; ++r)
#pragma unroll
        for (int kk = 0; kk < 4; ++kk) st[r][kk] = __builtin_nontemporal_load((const f32x4*)(sin_ + (size_t)r * 8192 + 32 * kk));
}
__device__ __forceinline__ void ssd_sample_unit(ArgsP a, int li, unsigned char* lds, int b, int g, f32x4 (&st)[4][4]) {
    const int tid = ltid(), lane = tid & 63, wave = __builtin_amdgcn_readfirstlane(tid >> 6);
    const bf16* __restrict__ ZX = (const bf16*)(a->ws + WS_ZX); const float* __restrict__ DT = (const float*)(a->ws + WS_DT); bf16* __restrict__ YN = (bf16*)(a->ws + WS_YN);
    float* sX = (float*)lds; float* sB = sX + 8 * 256; float* sC = sB + 8 * 128; float* sY = sC + 8 * 128; float* sDt = sY + 8 * 256;
    const int R0 = ROW_S + b * 8, h0 = g * 4;
    const int p = tid >> 3, nb = tid & 7;
    float* __restrict__ sout = a->out + O_SSSM + ((size_t)((li * NSAMP + b) * NHEADS + h0) * 64 + p) * 128 + 4 * nb;
    {
        const float* __restrict__ cw = a->in[I_ACONVW] + (size_t)li * 4 * CONVD; const float* __restrict__ cbias = a->in[I_ACONVB] + (size_t)li * CONVD;
        const int t = tid >> 6, ck = tid & 63;
        const int c0 = (ck < 32) ? g * 256 + ck * 8 : (ck < 48) ? 2048 + g * 128 + (ck - 32) * 8 : 3072 + g * 128 + (ck - 48) * 8;
        float* dst = (ck < 32) ? sX + t * 256 + ck * 8 : (ck < 48) ? sB + t * 128 + (ck - 32) * 8 : sC + t * 128 + (ck - 48) * 8;
        const float* __restrict__ sc = a->in[I_SCONV] + ((size_t)(li * NSAMP + b) * 3) * CONVD + c0;
        float xr[4][8];
#pragma unroll
        for (int k = 0; k < 4; ++k) { const int tt = t - 3 + k;
            if (tt >= 0) unpack8(*(const u32x4*)(ZX + (size_t)(R0 + tt) * ZXW + 2048 + c0), xr[k]); else ld8f(sc + (size_t)(tt + 3) * CONVD, xr[k]); }
        ConvW W; conv_load_w(cw, cbias, c0, W);
        float o[8];
#pragma unroll
        for (int j = 0; j < 8; ++j) { const float v = W.bs[j] + W.w0[j] * xr[0][j] + W.w1[j] * xr[1][j] + W.w2[j] * xr[2][j] + W.w3[j] * xr[3][j]; o[j] = v * sigmoid_f(v); }
        *(f32x4*)dst = (f32x4){o[0], o[1], o[2], o[3]}; *(f32x4*)(dst + 4) = (f32x4){o[4], o[5], o[6], o[7]};
        if (t >= 5) { float* __restrict__ so = a->out + O_SCONV + ((size_t)(li * NSAMP + b) * 3 + (t - 5)) * CONVD + c0;
            *(f32x4*)so = (f32x4){xr[3][0], xr[3][1], xr[3][2], xr[3][3]}; *(f32x4*)(so + 4) = (f32x4){xr[3][4], xr[3][5], xr[3][6], xr[3][7]}; }
    }
    if (tid < 32) sDt[tid] = DT[(size_t)(R0 + (tid >> 2)) * 32 + h0 + (tid & 3)];
    __syncthreads();
    float An[4], Dk[4];
#pragma unroll
    for (int r = 0; r < 4; ++r) { An[r] = -__expf(a->in[I_ALOG][li * NHEADS + h0 + r]); Dk[r] = a->in[I_ADSKIP][li * NHEADS + h0 + r]; }
    float part[8][4];
#pragma unroll
    for (int t = 0; t < 8; ++t) {
        f32x4 bv[4], cv[4];
#pragma unroll
        for (int kk = 0; kk < 4; ++kk) { bv[kk] = *(const f32x4*)(sB + t * 128 + 32 * kk + 4 * nb); cv[kk] = *(const f32x4*)(sC + t * 128 + 32 * kk + 4 * nb); }
#pragma unroll
        for (int r = 0; r < 4; ++r) {
            const float dt = sDt[t * 4 + r], dA = __expf(dt * An[r]), xv = sX[t * 256 + r * 64 + p], coef = dt * xv;
            float pr = 0.f;
#pragma unroll
            for (int kk = 0; kk < 4; ++kk) { st[r][kk] = st[r][kk] * dA + bv[kk] * coef; pr += (cv[kk].x * st[r][kk].x + cv[kk].y * st[r][kk].y) + (cv[kk].z * st[r][kk].z + cv[kk].w * st[r][kk].w); }
            part[t][r] = pr;
        }
    }
#pragma unroll
    for (int r = 0; r < 4; ++r)
#pragma unroll
        for (int kk = 0; kk < 4; ++kk) __builtin_nontemporal_store(st[r][kk], (f32x4*)(sout + (size_t)r * 8192 + 32 * kk));
#pragma unroll
    for (int t = 0; t < 8; ++t)
#pragma unroll
        for (int r = 0; r < 4; ++r) { float v = part[t][r]; v += __shfl_xor(v, 1); v += __shfl_xor(v, 2); v += __shfl_xor(v, 4); part[t][r] = v; }
    if (nb == 0) {
#pragma unroll
        for (int t = 0; t < 8; ++t)
#pragma unroll
            for (int r = 0; r < 4; ++r) sY[t * 256 + r * 64 + p] = part[t][r] + Dk[r] * sX[t * 256 + r * 64 + p];
    }
    __syncthreads();
    {
        const int t = wave, c4 = lane * 4; const size_t row = (size_t)(R0 + t);
        const f32x4 y = *(const f32x4*)(sY + t * 256 + c4);
        const u32x2 zz = *(const u32x2*)(ZX + row * ZXW + g * 256 + c4);
        const float z0 = bflo(zz.x), z1 = bfhi(zz.x), z2 = bflo(zz.y), z3 = bfhi(zz.y);
        const float g0 = y.x * z0 * sigmoid_f(z0), g1 = y.y * z1 * sigmoid_f(z1), g2 = y.z * z2 * sigmoid_f(z2), g3 = y.w * z3 * sigmoid_f(z3);
        const float ss = wave_sum((g0 * g0 + g1 * g1) + (g2 * g2 + g3 * g3));
        const float rs = rsqrtf(ss * (1.f / 256.f) + EPS);
        u32x2 o; o.x = pkbf(g0 * rs, g1 * rs); o.y = pkbf(g2 * rs, g3 * rs);
        *(u32x2*)(YN + row * DINNER + g * 256 + c4) = o;
    }
    __syncthreads();
}

__device__ __forceinline__ void phase_scan(ArgsP a, int li) {
    const bf16* __restrict__ CS = (const bf16*)(a->ws + WS_CS); const float* __restrict__ CD = (const float*)(a->ws + WS_CD); bf16* __restrict__ HSB = (bf16*)(a->ws + WS_HSB);
    const int gt = blockIdx.x * NTHREADS + ltid(), NT = gridDim.x * NTHREADS;
    for (int e = gt; e < 2 * 65536; e += NT) {
        const int b = e >> 16, rem = e & 65535, h = rem >> 11, pn4 = rem & 2047;
        f32x4 hc; { const u32x2 w0 = *(const u32x2*)(CS + ((size_t)(128 * 32 + h) * 2048 + pn4) * 4); hc = (f32x4){bflo(w0.x), bfhi(w0.x), bflo(w0.y), bfhi(w0.y)}; }
#pragma unroll 1
        for (int c0 = 0; c0 < 64; c0 += 16) {
            u32x2 sw[16]; float dd[16];
#pragma unroll
            for (int k = 0; k < 16; ++k) { const int slot = b * 64 + c0 + k; sw[k] = __builtin_nontemporal_load((const u32x2*)(CS + ((size_t)(slot * 32 + h) * 2048 + pn4) * 4)); dd[k] = CD[slot * 32 + h]; }
#pragma unroll
            for (int k = 0; k < 16; ++k) { const int slot = b * 64 + c0 + k; const size_t o = ((size_t)(slot * 32 + h) * 2048 + pn4) * 4;
                const f32x4 sv = (f32x4){bflo(sw[k].x), bfhi(sw[k].x), bflo(sw[k].y), bfhi(sw[k].y)};
                u32x2 w; w.x = pkbf(hc.x, hc.y); w.y = pkbf(hc.z, hc.w); *(u32x2*)(HSB + o) = w;
                hc = hc * dd[k] + sv; }
        }
        __builtin_nontemporal_store(hc, (f32x4*)(a->out + O_PSSM + ((size_t)((li * NPROMPT + b) * NHEADS + h) * 2048 + pn4) * 4));
    }
}

__device__ __forceinline__ void ssd3_head(int r, int hb, const bf16* Cn, const bf16* BH, const bf16* Xt, const float* s_dt, const float* s_acs, const f32x4 (&cb)[8], f32x4 (&acc)[4],
                                          const bf16* __restrict__ ZX, size_t row, int g, float Dk, int l, int wave, int fr, int fq, float& ss) {
    u32x2 zz[4];
#pragma unroll
    for (int ni = 0; ni < 4; ++ni) { const int ch = g * 256 + r * 64 + 16 * ni + 4 * fq; zz[ni] = __builtin_nontemporal_load((const u32x2*)(ZX + row * ZXW + ch)); }
    const float al = s_acs[r * 128 + l];
#pragma unroll
    for (int ni = 0; ni < 4; ++ni) acc[ni] = (f32x4){0.f, 0.f, 0.f, 0.f};
    const bf16* Hs = BH + hb * 64 * LDX;
#pragma unroll
    for (int ks = 0; ks < 4; ++ks) { const bf16x8 af = LFRAG(Cn, l, LDX, ks);
#pragma unroll
        for (int ni = 0; ni < 4; ++ni) { const bf16x8 bb = LFRAG(Hs, 16 * ni + fr, LDX, ks); acc[ni] = MFMA16(bb, af, acc[ni]); } }
    const float e = __expf(al);
#pragma unroll
    for (int ni = 0; ni < 4; ++ni) acc[ni] = acc[ni] * e;
#pragma unroll
    for (int ks = 0; ks < 4; ++ks) if (2 * ks <= wave) {
        unsigned mw[4];
#pragma unroll
        for (int hf = 0; hf < 2; ++hf) { const int ni = 2 * ks + hf, s0 = 16 * ni + 4 * fq;
            const f32x4 av = *(const f32x4*)(s_acs + r * 128 + s0), dv = *(const f32x4*)(s_dt + r * 128 + s0);
            float m[4];
#pragma unroll
            for (int j = 0; j < 4; ++j) m[j] = (s0 + j <= l) ? cb[ni][j] * __expf(al - av[j]) * dv[j] : 0.f;
            mw[2 * hf] = pkbf(m[0], m[1]); mw[2 * hf + 1] = pkbf(m[2], m[3]); }
        const u32x4 afu = (u32x4){mw[0], mw[1], mw[2], mw[3]};
        const bf16x8 af = __builtin_bit_cast(bf16x8, afu);
#pragma unroll
        for (int ni = 0; ni < 4; ++ni) { const int chl = r * 64 + 16 * ni + fr, sw = TSW(chl);
            const u32x2 b0 = *(const u32x2*)(Xt + chl * LDX + ((32 * ks + 4 * fq) ^ sw)), b1 = *(const u32x2*)(Xt + chl * LDX + ((32 * ks + 16 + 4 * fq) ^ sw));
            const u32x4 bu = (u32x4){b0.x, b0.y, b1.x, b1.y};
            acc[ni] = MFMA16(__builtin_bit_cast(bf16x8, bu), af, acc[ni]); }
    }
#pragma unroll
    for (int ni = 0; ni < 4; ++ni) {
        float xv[4];
#pragma unroll
        for (int j = 0; j < 4; ++j) { const int chl = r * 64 + 16 * ni + 4 * fq + j; xv[j] = bf2f(Xt[chl * LDX + (l ^ TSW(chl))]); }
        const float zv[4] = {bflo(zz[ni].x), bfhi(zz[ni].x), bflo(zz[ni].y), bfhi(zz[ni].y)};
#pragma unroll
        for (int j = 0; j < 4; ++j) { const float q = (acc[ni][j] + Dk * xv[j]) * zv[j] * sigmoid_f(zv[j]); acc[ni][j] = q; ss += q * q; } }
}
__device__ __forceinline__ void ssd3_unit(ArgsP a, int li, unsigned char* lds, const bf16* __restrict__ hs, int slot, int g, int R0, int len, u32x4 (&rx)[11], int nslot, int nR0) {
    const int tid = ltid(), lane = tid & 63, wave = __builtin_amdgcn_readfirstlane(tid >> 6);
    const bf16* __restrict__ ZX = (const bf16*)(a->ws + WS_ZX); const float* __restrict__ DT = (const float*)(a->ws + WS_DT); bf16* __restrict__ YN = (bf16*)(a->ws + WS_YN);
    bf16* Cn = (bf16*)lds; bf16* BH = Cn + 128 * LDX; bf16* Xt = BH + 128 * LDX;
    float* s_dt = (float*)(Xt + 256 * LDX); float* s_acs = s_dt + 512;
    const int fr = lane & 15, fq = lane >> 4, h0 = g * 4;
    {
        const float* __restrict__ cw = a->in[I_ACONVW] + (size_t)li * 4 * CONVD; const float* __restrict__ cbias = a->in[I_ACONVB] + (size_t)li * CONVD;
        const bool meta = (slot == 128), chunk0 = (!meta && (slot & 63) == 0);
        const int half = tid >> 8, ncb = tid & 15, nrun = (tid >> 4) & 15, nc0 = (half ? 2048 : 3072) + g * 128 + ncb * 8;
        const int xcb = tid & 31, xrun = tid >> 5, xc0 = g * 256 + xcb * 8;
        u32x4 rn[11];
        conv_load_run(ZX, R0 + 8 * nrun, nc0, (nrun == 0) ? (meta ? 2 : (chunk0 ? 1 : 0)) : 0, 8 * nrun < len, rn);
        ssd_acs(DT, a->in[I_ALOG] + li * NHEADS, R0, len, h0, s_dt, s_acs, wave, lane);
        { ConvW W; conv_load_w(cw, cbias, nc0, W); conv_item_n(rn, W, half ? BH : Cn, nrun, ncb * 8); }
        { ConvW W; conv_load_w(cw, cbias, xc0, W); const float one[8] = {1.f, 1.f, 1.f, 1.f, 1.f, 1.f, 1.f, 1.f}; conv_item_t(rx, W, one, Xt, xcb * 8, xrun); }
        if (!meta && (slot & 63) == 63) {
            float* __restrict__ dst = a->out + O_PCONV + (size_t)((li * NPROMPT + (slot >> 6)) * 3) * CONVD;
            if (nrun == 15) conv_state_out(rn, dst + nc0);
            if (xrun == 15) conv_state_out(rx, dst + xc0);
        }
    }
    __syncthreads();
    u32x2 hv[8];
#pragma unroll
    for (int k = 0; k < 8; ++k) { const int item = tid + NTHREADS * k; hv[k] = (u32x2){0u, 0u}; if (hs) hv[k] = __builtin_nontemporal_load((const u32x2*)(hs + (size_t)item * 4)); }
    const bool active = (16 * wave < len);
    f32x4 cb[8];
#pragma unroll
    for (int ni = 0; ni < 8; ++ni) cb[ni] = (f32x4){0.f, 0.f, 0.f, 0.f};
    if (active) {
#pragma unroll
    for (int ks = 0; ks < 4; ++ks) { const bf16x8 af = LFRAG(Cn, 16 * wave + fr, LDX, ks);
#pragma unroll
        for (int ni = 0; ni < 8; ++ni) { const bf16x8 bb = LFRAG(BH, 16 * ni + fr, LDX, ks); cb[ni] = MFMA16(bb, af, cb[ni]); } }
    }
    __syncthreads();
#pragma unroll
    for (int k = 0; k < 8; ++k) { const int item = tid + NTHREADS * k, hp = item >> 5, n4 = item & 31; *(u32x2*)(BH + hp * LDX + n4 * 4) = hv[k]; }
#pragma unroll
    for (int k = 0; k < 8; ++k) { const int item = tid + NTHREADS * k; hv[k] = (u32x2){0u, 0u}; if (hs) hv[k] = __builtin_nontemporal_load((const u32x2*)(hs + (size_t)(2 * 8192) + (size_t)item * 4)); }
    __syncthreads();
    const int l = 16 * wave + fr;
    const size_t row = (size_t)(R0 + ((l < len) ? l : 0));
    f32x4 y0[4], y1[4], y2[4], y3[4];
    float ss = 0.f;
    const float* dsk = a->in[I_ADSKIP] + li * NHEADS + h0;
    if (active) {
    ssd3_head(0, 0, Cn, BH, Xt, s_dt, s_acs, cb, y0, ZX, row, g, dsk[0], l, wave, fr, fq, ss);
    ssd3_head(1, 1, Cn, BH, Xt, s_dt, s_acs, cb, y1, ZX, row, g, dsk[1], l, wave, fr, fq, ss);
    }
    u32x2 p0[4], p1[4];
#pragma unroll
    for (int ni = 0; ni < 4; ++ni) { p0[ni].x = pkbf(y0[ni][0], y0[ni][1]); p0[ni].y = pkbf(y0[ni][2], y0[ni][3]); p1[ni].x = pkbf(y1[ni][0], y1[ni][1]); p1[ni].y = pkbf(y1[ni][2], y1[ni][3]); }
    __syncthreads();
#pragma unroll
    for (int k = 0; k < 8; ++k) { const int item = tid + NTHREADS * k, hp = item >> 5, n4 = item & 31; *(u32x2*)(BH + hp * LDX + n4 * 4) = hv[k]; }
    if (nslot >= 0) { const int xcb = tid & 31, xrun = tid >> 5; conv_load_run(ZX, nR0 + 8 * xrun, g * 256 + xcb * 8, (xrun == 0 && (nslot & 63) == 0) ? 1 : 0, true, rx); }
    __syncthreads();
    if (active) {
    ssd3_head(2, 0, Cn, BH, Xt, s_dt, s_acs, cb, y2, ZX, row, g, dsk[2], l, wave, fr, fq, ss);
    ssd3_head(3, 1, Cn, BH, Xt, s_dt, s_acs, cb, y3, ZX, row, g, dsk[3], l, wave, fr, fq, ss);
    ss += __shfl_xor(ss, 16); ss += __shfl_xor(ss, 32);
    }
    const float rs = rsqrtf(ss * (1.f / 256.f) + EPS);
    if (active && l < len) {
        bf16* yrow = YN + row * DINNER + g * 256 + 4 * fq;
#pragma unroll
        for (int ni = 0; ni < 4; ++ni) {
            u32x2 w;
            w.x = pkbf(bflo(p0[ni].x) * rs, bfhi(p0[ni].x) * rs); w.y = pkbf(bflo(p0[ni].y) * rs, bfhi(p0[ni].y) * rs); *(u32x2*)(yrow + 0 * 64 + 16 * ni) = w;
            w.x = pkbf(bflo(p1[ni].x) * rs, bfhi(p1[ni].x) * rs); w.y = pkbf(bflo(p1[ni].y) * rs, bfhi(p1[ni].y) * rs); *(u32x2*)(yrow + 1 * 64 + 16 * ni) = w;
            w.x = pkbf(y2[ni][0] * rs, y2[ni][1] * rs); w.y = pkbf(y2[ni][2] * rs, y2[ni][3] * rs); *(u32x2*)(yrow + 2 * 64 + 16 * ni) = w;
            w.x = pkbf(y3[ni][0] * rs, y3[ni][1] * rs); w.y = pkbf(y3[ni][2] * rs, y3[ni][3] * rs); *(u32x2*)(yrow + 3 * 64 + 16 * ni) = w;
        }
    }
    __syncthreads();
}
__device__ __forceinline__ void phase_ssd1(ArgsP a, int li, unsigned char* lds, int tid, int wave, int lane) {
    const int c = blockIdx.x;
#pragma unroll 1
    for (int j = 0; j < 4; ++j) {
        const int u = c + 256 * j;
        f32x4 st[4][4];
        ssd_sample_issue(a, li, u >> 3, u & 7, st);
#ifndef PROBE_SSD1
#define PROBE_SSD1 0
#endif
#pragma unroll 1
        for (int rp = 0; rp < (PROBE_SSD1 == 1 ? 2 : 1); ++rp) { const int slot = u >> 3, g = u & 7; ssd1_unit(a, li, lds, slot, g, (slot >> 6) * SEQ + (slot & 63) * 128, 128, tid, wave, lane); }
        ssd_sample_unit(a, li, lds, u >> 3, u & 7, st);
    }
    if (c < 8) ssd1_unit(a, li, lds, 128, c, ROW_M, NMETA, tid, wave, lane);
    else if (c < 16) { u32x4 rx[11]; { const bf16* ZX = (const bf16*)(a->ws + WS_ZX); const int t_ = ltid(), xcb = t_ & 31, xrun = t_ >> 5; conv_load_run(ZX, ROW_M + 8 * xrun, (c - 8) * 256 + xcb * 8, (xrun == 0) ? 2 : 0, 8 * xrun < NMETA, rx); }
        ssd3_unit(a, li, lds, nullptr, 128, c - 8, ROW_M, NMETA, rx, -1, 0); }
}
__device__ __forceinline__ void phase_ssd3(ArgsP a, int li, unsigned char* lds, int tid, int wave, int lane) {
    const bf16* HSB = (const bf16*)(a->ws + WS_HSB);
#ifdef PROBE_STAGGER
    if (blockIdx.x & 1) { const unsigned long long t0 = __builtin_amdgcn_s_memrealtime(); while (__builtin_amdgcn_s_memrealtime() - t0 < PROBE_STAGGER) __builtin_amdgcn_s_sleep(8); }
#endif
    u32x4 rx[11];
    { const bf16* ZX = (const bf16*)(a->ws + WS_ZX); const int u = blockIdx.x, slot = u >> 3, g = u & 7, t_ = ltid(), xcb = t_ & 31, xrun = t_ >> 5;
      conv_load_run(ZX, (slot >> 6) * SEQ + (slot & 63) * 128 + 8 * xrun, g * 256 + xcb * 8, (xrun == 0 && (slot & 63) == 0) ? 1 : 0, true, rx); }
#pragma unroll 1
    for (int u = blockIdx.x; u < 1024; u += 256) { const int slot = u >> 3, g = u & 7, un = u + 256, nslot = (un < 1024) ? (un >> 3) : -1;
        ssd3_unit(a, li, lds, HSB + (size_t)(slot * 32 + g * 4) * 8192, slot, g, (slot >> 6) * SEQ + (slot & 63) * 128, 128, rx, nslot, (nslot >> 6) * SEQ + (nslot & 63) * 128); }
}

constexpr int KS_LD = 72, VT_LD = 264, P_LD = 232, NKEYS = 208;
__device__ __forceinline__ void attn_prompt_unit(ArgsP a, int lj, unsigned char* lds, int b, int kvh, int qb, int, int, int) {
    const int tid = ltid(), lane = tid & 63, wave = __builtin_amdgcn_readfirstlane(tid >> 6);
    const bf16* __restrict__ Q = (const bf16*)(a->ws + WS_Q); const bf16* __restrict__ KV = (const bf16*)(a->ws + WS_KV); bf16* __restrict__ AO = (bf16*)(a->ws + WS_AO);
    bf16* Ks = (bf16*)lds; bf16* Vt = Ks + NKEYS * KS_LD; bf16* Pw = Vt + 64 * VT_LD + wave * 16 * P_LD;
    const int fr = lane & 15, fq = lane >> 4, t0 = qb * 64, Rb = b * SEQ;
    const int r = wave >> 1, th = (wave & 1) * 32, qh = kvh * 4 + r;
    bf16x8 q0[2], q1[2];
#pragma unroll
    for (int ks = 0; ks < 2; ++ks) { q0[ks] = *(const bf16x8*)(Q + (size_t)(Rb + t0 + th + fr) * DM + qh * 64 + 32 * ks + 8 * fq); q1[ks] = *(const bf16x8*)(Q + (size_t)(Rb + t0 + th + 16 + fr) * DM + qh * 64 + 32 * ks + 8 * fq); }
    {
        u32x4 kv[4];
#pragma unroll
        for (int k = 0; k < 4; ++k) { const int it = tid + NTHREADS * k, key = it >> 3, ch = it & 7; kv[k] = (u32x4){0u, 0u, 0u, 0u};
            if (it < NKEYS * 8) { int row; if (key < 16) row = ROW_M + key; else { int s = t0 - 128 + key - 16; if (s < 0) s = 0; row = Rb + s; }
                kv[k] = *(const u32x4*)(KV + (size_t)row * KVW + kvh * 64 + ch * 8); } }
        u32x4 v0[2], v1[2];
#pragma unroll
        for (int k = 0; k < 2; ++k) { const int it = tid + NTHREADS * k, dbl = it & 7, kp = it >> 3; v0[k] = (u32x4){0u, 0u, 0u, 0u}; v1[k] = v0[k];
            if (it < (NKEYS / 2) * 8) { const int k0 = 2 * kp, k1 = k0 + 1; int s0 = t0 - 128 + k0 - 16, s1 = t0 - 128 + k1 - 16; if (s0 < 0) s0 = 0; if (s1 < 0) s1 = 0;
                const int r0 = (k0 < 16) ? ROW_M + k0 : Rb + s0, r1 = (k1 < 16) ? ROW_M + k1 : Rb + s1;
                v0[k] = *(const u32x4*)(KV + (size_t)r0 * KVW + 256 + kvh * 64 + dbl * 8); v1[k] = *(const u32x4*)(KV + (size_t)r1 * KVW + 256 + kvh * 64 + dbl * 8); } }
#pragma unroll
        for (int k = 0; k < 4; ++k) { const int it = tid + NTHREADS * k, key = it >> 3, ch = it & 7; if (it < NKEYS * 8) *(u32x4*)(Ks + key * KS_LD + ch * 8) = kv[k]; }
#pragma unroll
        for (int k = 0; k < 2; ++k) { const int it = tid + NTHREADS * k, dbl = it & 7, kp = it >> 3;
            if (it < (NKEYS / 2) * 8) { const int col = (2 * kp) ^ (8 * dbl);
                const unsigned a0[4] = {v0[k].x, v0[k].y, v0[k].z, v0[k].w}, a1[4] = {v1[k].x, v1[k].y, v1[k].z, v1[k].w};
#pragma unroll
                for (int j = 0; j < 4; ++j) {
                    *(unsigned*)(Vt + (dbl * 8 + 2 * j) * VT_LD + col) = (a0[j] & 0xffffu) | (a1[j] << 16);
                    *(unsigned*)(Vt + (dbl * 8 + 2 * j + 1) * VT_LD + col) = (a0[j] >> 16) | (a1[j] & 0xffff0000u); } } }
#pragma unroll
        for (int k = 0; k < 3; ++k) { const int idx = tid + NTHREADS * k, row = idx / 24, c = idx - row * 24; *(unsigned*)(Vt + row * VT_LD + ((NKEYS + 2 * c) ^ TSW(row))) = 0u; }
    }
    __syncthreads();
    const float sink = a->in[I_SINKS][lj * NQ + qh];
#pragma unroll 1
    for (int blk = 0; blk < 2; ++blk) {
        const int tq = th + blk * 16 + fr, t = t0 + tq;
        bf16x8 qa2[2];
#pragma unroll
        for (int ks = 0; ks < 2; ++ks) qa2[ks] = (blk == 0) ? q0[ks] : q1[ks];
        f32x4 sc[13];
#pragma unroll
        for (int ni = 0; ni < 13; ++ni) sc[ni] = (f32x4){0.f, 0.f, 0.f, 0.f};
#pragma unroll
        for (int ni = 0; ni < 13; ++ni) {
            const bf16x8 b0 = *(const bf16x8*)(Ks + (16 * ni + fr) * KS_LD + 8 * fq), b1 = *(const bf16x8*)(Ks + (16 * ni + fr) * KS_LD + 32 + 8 * fq);
            sc[ni] = MFMA16(b0, qa2[0], sc[ni]); sc[ni] = MFMA16(b1, qa2[1], sc[ni]);
            }
        int lo = tq + 17; { const int l2 = 144 - t0; if (l2 > lo) lo = l2; }
        const unsigned span = (unsigned)(tq + 144 - lo);
        float mx = -INFINITY;
#pragma unroll
        for (int ni = 0; ni < 13; ++ni)
#pragma unroll
            for (int j = 0; j < 4; ++j) { const int key = 16 * ni + 4 * fq + j; const bool vis = (ni == 0) || ((unsigned)(key - lo) <= span);
                const float v = vis ? sc[ni][j] * 0.125f : -INFINITY; sc[ni][j] = v; mx = fmaxf(mx, v); }
        mx = fmaxf(mx, __shfl_xor(mx, 16)); mx = fmaxf(mx, __shfl_xor(mx, 32)); mx = fmaxf(mx, sink);
        float sum = 0.f;
#pragma unroll
        for (int ni = 0; ni < 13; ++ni)
#pragma unroll
            for (int j = 0; j < 4; ++j) { const float p = __expf(sc[ni][j] - mx); sc[ni][j] = p; sum += p; }
        sum += __shfl_xor(sum, 16); sum += __shfl_xor(sum, 32); sum += __expf(sink - mx);
        const float inv = frcp(sum);
#pragma unroll
        for (int ni = 0; ni < 13; ++ni) { u32x2 w; w.x = pkbf(sc[ni][0] * inv, sc[ni][1] * inv); w.y = pkbf(sc[ni][2] * inv, sc[ni][3] * inv); *(u32x2*)(Pw + fr * P_LD + 16 * ni + 4 * fq) = w; }
        *(u32x2*)(Pw + fr * P_LD + NKEYS + 4 * fq) = (u32x2){0u, 0u};
        asm volatile("s_waitcnt lgkmcnt(0)" ::: "memory");
        f32x4 o[4];
#pragma unroll
        for (int ni = 0; ni < 4; ++ni) o[ni] = (f32x4){0.f, 0.f, 0.f, 0.f};
#pragma unroll
        for (int ks = 0; ks < 7; ++ks) { const bf16x8 af = *(const bf16x8*)(Pw + fr * P_LD + 32 * ks + 8 * fq);
#pragma unroll
            for (int ni = 0; ni < 4; ++ni) { const int vr = 16 * ni + fr; const bf16x8 bb = *(const bf16x8*)(Vt + vr * VT_LD + ((32 * ks + 8 * fq) ^ TSW(vr))); o[ni] = MFMA16(bb, af, o[ni]); }
            }
#pragma unroll
        for (int ni = 0; ni < 4; ++ni) { u32x2 w; w.x = pkbf(o[ni][0], o[ni][1]); w.y = pkbf(o[ni][2], o[ni][3]); *(u32x2*)(AO + (size_t)(Rb + t) * DM + qh * 64 + 16 * ni + 4 * fq) = w; }
        asm volatile("s_waitcnt lgkmcnt(0)" ::: "memory");
    }
    __syncthreads();
}
constexpr int SK_LD = 72, SV_LD = 200, SP_LD = 168, SKEYS = 160;
__device__ __forceinline__ void attn_sample_pair(ArgsP a, int lj, unsigned char* lds, int bp, int kvh, int, int, int) {
    const int tid = ltid(), lane = tid & 63, wave = __builtin_amdgcn_readfirstlane(tid >> 6);
    const bf16* __restrict__ Q = (const bf16*)(a->ws + WS_Q); const bf16* __restrict__ KV = (const bf16*)(a->ws + WS_KV); bf16* __restrict__ AO = (bf16*)(a->ws + WS_AO);
    const float* __restrict__ CK = a->in[I_CK]; const float* __restrict__ CV = a->in[I_CV];
    constexpr int HALF_B = (SKEYS * SK_LD + 64 * SV_LD) * 2;
    const int fr = lane & 15, fq = lane >> 4;
    {
        u32x4 r0[5], r1[5];
#pragma unroll
        for (int k = 0; k < 5; ++k) { const int it = tid + NTHREADS * k, hf = it / (SKEYS * 8), rem = it - hf * (SKEYS * 8), key = rem >> 3, ch = rem & 7, bb = 2 * bp + hf;
            r0[k] = (u32x4){0u, 0u, 0u, 0u}; r1[k] = r0[k];
            if (key < 16) r0[k] = *(const u32x4*)(KV + (size_t)(ROW_M + key) * KVW + kvh * 64 + ch * 8);
            else if (key < 144) { const float* p = CK + ((size_t)(bb * 128 + (key - 16)) * NKV + kvh) * 64 + ch * 8; r0[k] = __builtin_nontemporal_load((const u32x4*)p); r1[k] = __builtin_nontemporal_load((const u32x4*)(p + 4)); }
            else if (key < 152) r0[k] = *(const u32x4*)(KV + (size_t)(ROW_S + bb * 8 + (key - 144)) * KVW + kvh * 64 + ch * 8); }
#pragma unroll
        for (int k = 0; k < 5; ++k) { const int it = tid + NTHREADS * k, hf = it / (SKEYS * 8), rem = it - hf * (SKEYS * 8), key = rem >> 3, ch = rem & 7;
            bf16* Ks = (bf16*)(lds + hf * HALF_B);
            u32x4 w = r0[k];
            if (key >= 16 && key < 144) { w.x = pkbf(__uint_as_float(r0[k].x), __uint_as_float(r0[k].y)); w.y = pkbf(__uint_as_float(r0[k].z), __uint_as_float(r0[k].w)); w.z = pkbf(__uint_as_float(r1[k].x), __uint_as_float(r1[k].y)); w.w = pkbf(__uint_as_float(r1[k].z), __uint_as_float(r1[k].w)); }
            *(u32x4*)(Ks + key * SK_LD + ch * 8) = w; }
    }
    {
        u32x4 x0[3], x1[3], y0[3], y1[3];
#pragma unroll
        for (int k = 0; k < 3; ++k) { const int it = tid + NTHREADS * k, hf = it / (96 * 8), rem = it - hf * (96 * 8), dbl = rem & 7, kp = rem >> 3, bb = 2 * bp + hf, k0 = 2 * kp;
            x0[k] = (u32x4){0u, 0u, 0u, 0u}; x1[k] = x0[k]; y0[k] = x0[k]; y1[k] = x0[k];
            if (k0 < 16) { x0[k] = *(const u32x4*)(KV + (size_t)(ROW_M + k0) * KVW + 256 + kvh * 64 + dbl * 8); y0[k] = *(const u32x4*)(KV + (size_t)(ROW_M + k0 + 1) * KVW + 256 + kvh * 64 + dbl * 8); }
            else if (k0 < 144) { const float* p = CV + ((size_t)(bb * 128 + (k0 - 16)) * NKV + kvh) * 64 + dbl * 8;
                x0[k] = __builtin_nontemporal_load((const u32x4*)p); x1[k] = __builtin_nontemporal_load((const u32x4*)(p + 4)); y0[k] = __builtin_nontemporal_load((const u32x4*)(p + NKV * 64)); y1[k] = __builtin_nontemporal_load((const u32x4*)(p + NKV * 64 + 4)); }
            else if (k0 < 152) { x0[k] = *(const u32x4*)(KV + (size_t)(ROW_S + bb * 8 + (k0 - 144)) * KVW + 256 + kvh * 64 + dbl * 8); y0[k] = *(const u32x4*)(KV + (size_t)(ROW_S + bb * 8 + (k0 - 143)) * KVW + 256 + kvh * 64 + dbl * 8); } }
#pragma unroll
        for (int k = 0; k < 3; ++k) { const int it = tid + NTHREADS * k, hf = it / (96 * 8), rem = it - hf * (96 * 8), dbl = rem & 7, kp = rem >> 3, k0 = 2 * kp;
            bf16* Vt = (bf16*)(lds + hf * HALF_B) + SKEYS * SK_LD;
            unsigned a0[4] = {x0[k].x, x0[k].y, x0[k].z, x0[k].w}, a1[4] = {y0[k].x, y0[k].y, y0[k].z, y0[k].w};
            if (k0 >= 16 && k0 < 144) {
                a0[0] = pkbf(__uint_as_float(x0[k].x), __uint_as_float(x0[k].y)); a0[1] = pkbf(__uint_as_float(x0[k].z), __uint_as_float(x0[k].w)); a0[2] = pkbf(__uint_as_float(x1[k].x), __uint_as_float(x1[k].y)); a0[3] = pkbf(__uint_as_float(x1[k].z), __uint_as_float(x1[k].w));
                a1[0] = pkbf(__uint_as_float(y0[k].x), __uint_as_float(y0[k].y)); a1[1] = pkbf(__uint_as_float(y0[k].z), __uint_as_float(y0[k].w)); a1[2] = pkbf(__uint_as_float(y1[k].x), __uint_as_float(y1[k].y)); a1[3] = pkbf(__uint_as_float(y1[k].z), __uint_as_float(y1[k].w)); }
            const int col = (2 * kp) ^ (8 * dbl);
#pragma unroll
            for (int j = 0; j < 4; ++j) {
                *(unsigned*)(Vt + (dbl * 8 + 2 * j) * SV_LD + col) = (a0[j] & 0xffffu) | (a1[j] << 16);
                *(unsigned*)(Vt + (dbl * 8 + 2 * j + 1) * SV_LD + col) = (a0[j] >> 16) | (a1[j] & 0xffff0000u); } }
    }
    if (lj == 0) {
        u32x4 kx[8], vx[8];
#pragma unroll
        for (int k = 0; k < 8; ++k) { const int it = tid + NTHREADS * k, hf = it >> 11, rem = it & 2047, w = rem >> 4, c4 = (rem & 15) * 4, bb = 2 * bp + hf;
            if (w < 120) { const size_t i = ((size_t)(bb * 128 + w + 8) * NKV + kvh) * 64 + c4; kx[k] = __builtin_nontemporal_load((const u32x4*)(CK + i)); vx[k] = __builtin_nontemporal_load((const u32x4*)(CV + i)); }
            else { const bf16* rp = KV + (size_t)(ROW_S + bb * 8 + (w - 120)) * KVW + kvh * 64 + c4; const u32x2 k2 = *(const u32x2*)rp, v2 = *(const u32x2*)(rp + 256);
                kx[k] = (u32x4){k2.x << 16, k2.x & 0xffff0000u, k2.y << 16, k2.y & 0xffff0000u}; vx[k] = (u32x4){v2.x << 16, v2.x & 0xffff0000u, v2.y << 16, v2.y & 0xffff0000u}; } }
#pragma unroll
        for (int k = 0; k < 8; ++k) { const int it = tid + NTHREADS * k, hf = it >> 11, rem = it & 2047, w = rem >> 4, c4 = (rem & 15) * 4, bb = 2 * bp + hf;
            const size_t o = ((size_t)(bb * 128 + w) * NKV + kvh) * 64 + c4;
            __builtin_nontemporal_store(kx[k], (u32x4*)(a->out + O_SCK + o)); __builtin_nontemporal_store(vx[k], (u32x4*)(a->out + O_SCV + o)); }
    }
    __syncthreads();
    if (wave < 4) {
        const int hf = wave >> 1, rb = wave & 1, bb = 2 * bp + hf;
        const bf16* Ks = (const bf16*)(lds + hf * HALF_B); const bf16* Vt = Ks + SKEYS * SK_LD; bf16* Pw = (bf16*)(lds + 2 * HALF_B) + wave * 16 * SP_LD;
        const int r = 2 * rb + (fr >> 3), t = fr & 7, qh = kvh * 4 + r;
        const size_t qrow = (size_t)(ROW_S + bb * 8 + t);
        bf16x8 qa[2];
        if (lj == 0) {
#pragma unroll
            for (int ks = 0; ks < 2; ++ks) qa[ks] = *(const bf16x8*)(Q + qrow * DM + qh * 64 + 32 * ks + 8 * fq);
        } else {
            const float* __restrict__ SL = (const float*)(a->ws + WS_SLAB) + (size_t)(qrow - ROW_S) * DM + qh * 64 + 8 * fq;
#pragma unroll
            for (int ks = 0; ks < 2; ++ks) { f32x4 x0 = (f32x4){0.f, 0.f, 0.f, 0.f}, x1 = x0;
#pragma unroll
                for (int sl = 0; sl < 4; ++sl) { const float* p = SL + (size_t)sl * (1280 * 1024) + 32 * ks; x0 = x0 + *(const f32x4*)p; x1 = x1 + *(const f32x4*)(p + 4); }
                const u32x4 w = (u32x4){pkbf(x0.x, x0.y), pkbf(x0.z, x0.w), pkbf(x1.x, x1.y), pkbf(x1.z, x1.w)}; qa[ks] = __builtin_bit_cast(bf16x8, w); }
        }
        const float sink = a->in[I_SINKS][lj * NQ + qh];
        f32x4 sc[10];
#pragma unroll
        for (int ni = 0; ni < 10; ++ni) sc[ni] = (f32x4){0.f, 0.f, 0.f, 0.f};
#pragma unroll
        for (int ni = 0; ni < 10; ++ni) {
            const bf16x8 b0 = *(const bf16x8*)(Ks + (16 * ni + fr) * SK_LD + 8 * fq), b1 = *(const bf16x8*)(Ks + (16 * ni + fr) * SK_LD + 32 + 8 * fq);
            sc[ni] = MFMA16(b0, qa[0], sc[ni]); sc[ni] = MFMA16(b1, qa[1], sc[ni]); }
        float mx = -INFINITY;
#pragma unroll
        for (int ni = 0; ni < 10; ++ni)
#pragma unroll
            for (int j = 0; j < 4; ++j) { const int key = 16 * ni + 4 * fq + j;
                const bool vis = (ni == 0) || ((key < 144) ? (key - 16 > t) : (key - 144 <= t));
                const float v = vis ? sc[ni][j] * 0.125f : -INFINITY; sc[ni][j] = v; mx = fmaxf(mx, v); }
        mx = fmaxf(mx, __shfl_xor(mx, 16)); mx = fmaxf(mx, __shfl_xor(mx, 32)); mx = fmaxf(mx, sink);
        float sum = 0.f;
#pragma unroll
        for (int ni = 0; ni < 10; ++ni)
#pragma unroll
            for (int j = 0; j < 4; ++j) { const float p = __expf(sc[ni][j] - mx); sc[ni][j] = p; sum += p; }
        sum += __shfl_xor(sum, 16); sum += __shfl_xor(sum, 32); sum += __expf(sink - mx);
        const float inv = frcp(sum);
#pragma unroll
        for (int ni = 0; ni < 10; ++ni) { u32x2 w; w.x = pkbf(sc[ni][0] * inv, sc[ni][1] * inv); w.y = pkbf(sc[ni][2] * inv, sc[ni][3] * inv); *(u32x2*)(Pw + fr * SP_LD + 16 * ni + 4 * fq) = w; }
        asm volatile("s_waitcnt lgkmcnt(0)" ::: "memory");
        f32x4 o[4];
#pragma unroll
        for (int ni = 0; ni < 4; ++ni) o[ni] = (f32x4){0.f, 0.f, 0.f, 0.f};
#pragma unroll
        for (int ks = 0; ks < 5; ++ks) { const bf16x8 af = *(const bf16x8*)(Pw + fr * SP_LD + 32 * ks + 8 * fq);
#pragma unroll
            for (int ni = 0; ni < 4; ++ni) { const int vr = 16 * ni + fr; const bf16x8 bb2 = *(const bf16x8*)(Vt + vr * SV_LD + ((32 * ks + 8 * fq) ^ TSW(vr))); o[ni] = MFMA16(bb2, af, o[ni]); } }
#pragma unroll
        for (int ni = 0; ni < 4; ++ni) { u32x2 w; w.x = pkbf(o[ni][0], o[ni][1]); w.y = pkbf(o[ni][2], o[ni][3]); *(u32x2*)(AO + qrow * DM + qh * 64 + 16 * ni + 4 * fq) = w; }
    }
    __syncthreads();
}
__device__ __forceinline__ void phase_attn(ArgsP a, int lj, unsigned char* lds, int tid, int wave, int lane) {
    if (lj == 0) {
        const bf16* KV = (const bf16*)(a->ws + WS_KV);
        const int gt = blockIdx.x * NTHREADS + tid, NT = gridDim.x * NTHREADS;
        for (int e = gt; e < 2 * 128 * 512; e += NT) { const int b = e >> 16, w = (e >> 9) & 127, c = e & 511;
            const float v = bf2f(KV[(size_t)(b * SEQ + SEQ - 128 + w) * KVW + c]);
            if (c < 256) a->out[O_PCK + (size_t)(b * 128 + w) * 256 + c] = v; else a->out[O_PCV + (size_t)(b * 128 + w) * 256 + (c - 256)] = v; }
    }
    const int xg = blockIdx.x & 7, xi = blockIdx.x >> 3;
#pragma unroll 1
    for (int j = 0; j < 4; ++j) { const int u = 128 * xg + 4 * xi + j, qb = u & 127, kvh = (u >> 7) & 3, b = u >> 9; attn_prompt_unit(a, lj, lds, b, kvh, qb, tid, wave, lane); }
    { const int su = blockIdx.x; attn_sample_pair(a, lj, lds, su >> 2, su & 3, tid, wave, lane); }
}

constexpr int PH_B = 9 * 2, PH_F = PH_B + 7 * 2, NPHASES = PH_F + 1;
template <class Epi> __device__ __forceinline__ void run_gemm(LAS unsigned char* lds, const bf16* A, const bf16* Bt, int N, int K, const Epi& E) {
    pg8::Gemm g{A, Bt, MP, N, K}; pg8::StaticOrder S; S.init(MP, N, K, (int)gridDim.x, (int)blockIdx.x);
    pg8::gemm_phase<Epi, pg8::StaticOrder, true, true>(lds, g, S, E);
}
template <class Epi> __device__ __forceinline__ void run_gemm_res(LAS unsigned char* lds, const bf16* A, const bf16* Bt, int K, int S_, const Epi& E) {
    pg8::Gemm g{A, Bt, MP, 1024, K}; pg8::ResOrder S; S.init(K, S_, (int)gridDim.x, (int)blockIdx.x);
    pg8::gemm_phase<Epi, pg8::ResOrder, true, true>(lds, g, S, E);
}

__global__ void __launch_bounds__(NTHREADS, 2) yoco_fwd(Args args) {
    extern __shared__ __attribute__((aligned(16))) unsigned char lds[];
    LAS unsigned char* ldsl = (LAS unsigned char*)lds;
    const int tid0 = threadIdx.x;
    for (int u = tid0; u < (LDS_BYTES - LDSCTL_OFF) / 4; u += NTHREADS) ((LAS unsigned*)(ldsl + LDSCTL_OFF))[u] = 0u;
    __syncthreads();
    const int lo = args.ph_lo, hi = args.ph_hi;
    if (hi - lo > 1) (void)xcd_barrier_post((unsigned*)(args.ws + WS_CTL) + CW_BAR, (volatile LAS unsigned*)(ldsl + MISC_OFF) + 8);
    int rep = 0;
#pragma unroll 1
    for (int p = lo; p < hi;) {
        ArgsP la = (ArgsP)__builtin_amdgcn_kernarg_segment_ptr(); asm volatile("" : "+s"(la));
        unsigned char* ws = la->ws;
        const int tid = ltid();
        const int lane = tid & 63, wave = __builtin_amdgcn_readfirstlane(tid >> 6);
        bf16* HN = (bf16*)(ws + WS_HN); float* H = (float*)(ws + WS_H);
        int kind, li = 0, lj = 0, layer = 0;
        int nslab = 8;
        if (p == 0) kind = 0;
        else if (p < PH_B) { li = p / 9; layer = li; const int sub = p % 9;
            kind = (sub == 0) ? 1 : (sub == 1) ? 3 : (sub == 2) ? 5 : (sub == 3) ? 6 : (sub == 4) ? 7 : (sub == 5) ? 8 : (sub == 6) ? 1 : (sub == 7) ? 9 : 10; }
        else if (p < PH_F) { lj = (p - PH_B) / 7; layer = 2 + lj; const int sub = (p - PH_B) % 7;
            kind = (sub == 0) ? 1 : (sub == 1) ? 11 : (sub == 2) ? 12 : (sub == 3) ? 13 : (sub == 4) ? 1 : (sub == 5) ? 9 : 10; if (sub == 4) nslab = 4; }
        else kind = 14;
#ifndef KMASK
#define KMASK 0xffff
#endif
#define KON(k) ((KMASK >> (k)) & 1)
#ifndef REP_MASK
#define REP_MASK 0
#endif
        if (KON(0) && kind == 0) { phase_prologue(la, ldsl, wave, lane); phase_norm(la, 1, 0, wave, lane); }
        else if (KON(1) && kind == 1) phase_norm(la, 0, nslab, wave, lane);
        else if (KON(3) && kind == 3) { pg8::EpiInProj E{(bf16*)(ws + WS_ZX), (float*)(ws + WS_DT), la->in[I_ADTB] + li * NHEADS}; run_gemm(ldsl, HN, (const bf16*)(ws + WS_WIN + li * SZ_WIN), INPROJ_P, 1024, E); }
        else if (KON(5) && kind == 5) phase_ssd1(la, li, lds, tid, wave, lane);
        else if (KON(6) && kind == 6) phase_scan(la, li);
        else if (KON(7) && kind == 7) phase_ssd3(la, li, lds, tid, wave, lane);
        else if (KON(8) && (kind == 8 || kind == 10 || kind == 13)) {
            const bf16* A; const bf16* Bt; int K;
            if (kind == 8) { A = (const bf16*)(ws + WS_YN); Bt = (const bf16*)(ws + WS_WOUT + li * SZ_WOUT); K = 2048; }
            else if (kind == 10) { A = (const bf16*)(ws + WS_U); Bt = (const bf16*)(ws + WS_WDN + layer * SZ_WDN); K = 4096; }
            else { A = (const bf16*)(ws + WS_AO); Bt = (const bf16*)(ws + WS_WO + lj * SZ_WO); K = 1024; }
            pg8::EpiRes E{(kind == 8 && li == 0) ? la->in[I_XP] : nullptr, (bf16*)H, (float*)(ws + WS_SLAB)}; run_gemm_res(ldsl, A, Bt, K, K == 1024 ? 4 : 8, E); }
        else if (KON(9) && kind == 9) { pg8::EpiBf<1> E{(bf16*)(ws + WS_U), 4096, 1 << 20, nullptr, 0}; run_gemm(ldsl, HN, (const bf16*)(ws + WS_WUP + layer * SZ_WUP), 4096, 1024, E); }
        else if (KON(11) && kind == 11) { pg8::EpiBf<0> E{(bf16*)(ws + WS_Q), 1024, 4, (bf16*)(ws + WS_KV), KVW};
            if (lj == 0) run_gemm(ldsl, HN, (const bf16*)(ws + WS_WQKV0), 1536, 1024, E);
            else { pg8::EpiQSplit E2{(bf16*)(ws + WS_Q), (float*)(ws + WS_SLAB)}; run_gemm_res(ldsl, HN, (const bf16*)(ws + WS_WQ1), 1024, 4, E2); } }
        else if (KON(12) && kind == 12) phase_attn(la, lj, lds, tid, wave, lane);
        else if (KON(14) && kind == 14) phase_final(la, wave, lane);
        bool again = false;
        if (REP_MASK != 0) { if (rep == 0 && ((REP_MASK >> kind) & 1)) { rep = 1; again = true; } else rep = 0; }
        if (p + 1 < hi || again) { XcdBarrier bar; bar.bar = (unsigned*)(ws + WS_CTL) + CW_BAR; bar.x = xb_xcc_id(); bar.st = (volatile LAS unsigned*)(ldsl + MISC_OFF) + 8; xcd_barrier(bar); }
        else { asm volatile("s_waitcnt vmcnt(0)" ::: "memory"); __syncthreads(); }
        if (!again) ++p;
    }
}

#ifndef MK_PER_PHASE
#define MK_PER_PHASE 0
#endif
extern "C" void kernel_launch(void* const* d_in, const int* in_sizes, int n_in, void* d_out, int out_size, void* d_ws, size_t ws_size, hipStream_t stream) {
    static int grid = 0;
    if (grid == 0) {
        if (n_in != 26 || (size_t)out_size != O_END || ws_size < WS_END) { fprintf(stderr, "kernel_launch: unexpected problem (n_in %d, out %d vs %zu, ws %zu vs %zu); nothing launched\n", n_in, out_size, (size_t)O_END, ws_size, (size_t)WS_END); grid = -1; return; }
        int dev = 0, cus = 0, per_cu = 0;
        if (hipGetDevice(&dev) != hipSuccess || hipDeviceGetAttribute(&cus, hipDeviceAttributeMultiprocessorCount, dev) != hipSuccess) { grid = -1; return; }
        if (hipFuncSetAttribute((const void*)yoco_fwd, hipFuncAttributeMaxDynamicSharedMemorySize, LDS_BYTES) != hipSuccess) { fprintf(stderr, "kernel_launch: hipFuncSetAttribute failed\n"); grid = -1; return; }
        if (hipOccupancyMaxActiveBlocksPerMultiprocessor(&per_cu, (const void*)yoco_fwd, NTHREADS, LDS_BYTES) != hipSuccess || per_cu < 1) { fprintf(stderr, "kernel_launch: occupancy query says %d\n", per_cu); per_cu = 1; }
        (void)hipGetLastError();
        if (cus != 256) { fprintf(stderr, "kernel_launch: built for a 256-CU device (got %d); nothing launched\n", cus); grid = -1; return; }
        grid = cus;
    }
    if (grid < 0) return;
    if (hipMemsetAsync((char*)d_ws + WS_CTL, 0, CTL_ZERO_BYTES, stream) != hipSuccess) { fprintf(stderr, "kernel_launch: memset failed\n"); return; }
    Args a{};
    for (int i = 0; i < 26; ++i) a.in[i] = (const float*)d_in[i];
    a.out = (float*)d_out; a.ws = (unsigned char*)d_ws;
#if MK_PER_PHASE
    for (int p = 0; p < NPHASES; ++p) { a.ph_lo = p; a.ph_hi = p + 1; hipLaunchKernelGGL(yoco_fwd, dim3(grid), dim3(NTHREADS), LDS_BYTES, stream, a); }
#else
    a.ph_lo = 0; a.ph_hi = NPHASES;
    void* kargs[] = {&a};
    hipError_t e = hipLaunchCooperativeKernel((const void*)yoco_fwd, dim3(grid), dim3(NTHREADS), kargs, LDS_BYTES, stream);
    if (e != hipSuccess) fprintf(stderr, "kernel_launch: cooperative launch failed: %s (grid %d)\n", hipGetErrorString(e), grid);
#endif
}
```

```cpp
#include <hip/hip_runtime.h>
#include <cstdio>
#include <cstdint>
#include <cmath>
namespace pg8 {
#define PG8_LAS __attribute__((address_space(3)))
typedef unsigned short bf16_t;
typedef short bf16x8 __attribute__((ext_vector_type(8)));
typedef float f32x4 __attribute__((ext_vector_type(4)));
typedef unsigned u32x4 __attribute__((ext_vector_type(4)));
constexpr int BM = 256, BK = 64, HALF = 128, HTB = HALF * BK * 2  , STAGE_BYTES = 8 * HTB, NXCD = 8, WGM = 8;

__host__ __device__ __forceinline__ int lds_byte(int r, int c) { const int st = (r >> 4) * 2 + (c >> 5), rr = r & 15, cc = c & 31, ob = rr * 64 + cc * 2; return st * 1024 + (ob ^ (((ob >> 9) & 1) << 5)); }
__host__ __device__ __forceinline__ void stage_rc(int b, int& R, int& C) { const int st = b / 1024, sb = b % 1024, swz = sb ^ (((sb >> 9) & 1) << 5); R = (st >> 1) * 16 + swz / 64; C = (st & 1) * 32 + (swz % 64) / 2; }
__host__ __device__ __forceinline__ int perm32(int rho) { const int n = rho >> 4, i = rho & 15; return 8 * (i >> 2) + 4 * n + (i & 3); }

struct Unit { int pm, pn, k0, nt, aux; };
struct Gemm { const bf16_t* A; const bf16_t* Bt; int M, N, K; };

struct StaticOrder {
    int nM, nN, nwg, G, c, nt0; const unsigned* flag; unsigned need;
    __host__ __device__ void init(int M, int N, int K, int G_, int c_) { nM = M / BM; nN = N / BM; nwg = nM * nN; G = G_; c = c_; nt0 = K / BK; }
    __host__ __device__ bool next(int i, Unit& u) const {
        const long L = (long)i * G + c; if (L >= nwg) return false;
        int wgid = (int)L; { const int q = nwg / NXCD, r = nwg % NXCD, xcd = wgid % NXCD, off = wgid / NXCD; wgid = (xcd < r ? xcd * (q + 1) : r * (q + 1) + (xcd - r) * q) + off; }
        const int nig = WGM * nN, gid = wgid / nig, fm = gid * WGM, gsz = (nM - fm) < WGM ? (nM - fm) : WGM;
        u.pm = fm + ((wgid % nig) % gsz); u.pn = (wgid % nig) / gsz; u.k0 = 0; u.nt = nt0; u.aux = -1; return true;
    }
    __device__ __forceinline__ void a_ready(const Unit& u) const {
        if (flag != nullptr && u.pm >= 64) { unsigned sp = 0; while (__hip_atomic_load(flag, __ATOMIC_RELAXED, __HIP_MEMORY_SCOPE_AGENT) < need && ++sp < (1u << 22)) __builtin_amdgcn_s_sleep(2); asm volatile("" ::: "memory"); }
    }
    __device__ __forceinline__ void done(const Unit&) const {}
};
struct LeftOrder {
    int u;
    __host__ __device__ bool next(int i, Unit& un) const { if (i != 0 || u < 0) return false; un.pm = 64 + (u >> 4); un.pn = u & 15; un.k0 = 0; un.nt = 1024 / BK; un.aux = -1; return true; }
    __device__ __forceinline__ void a_ready(const Unit&) const {}
    __device__ __forceinline__ void done(const Unit&) const {}
};
struct ResOrder {
    StaticOrder so; int S, K, c;
    __host__ __device__ void init(int K_, int S_, int G_, int c_) { so.init(64 * BM, 1024, K_, G_, c_); S = S_; K = K_; c = c_; }
    __host__ __device__ bool next(int i, Unit& u) const {
        if (i == 0) return so.next(0, u);
        if (i == 1 && c < 20 * S) { const int t = c / S, sl = c - t * S; u.pm = 64 + (t >> 2); u.pn = t & 3; u.k0 = sl * (K / S); u.nt = K / S / BK; u.aux = sl; return true; }
        return false;
    }
    __device__ __forceinline__ void a_ready(const Unit& u) const { so.a_ready(u); }
    __device__ __forceinline__ void done(const Unit&) const {}
};

typedef float f32x2_cv0 __attribute__((ext_vector_type(2))); typedef __bf16 bf16x2_cv0 __attribute__((ext_vector_type(2)));
__device__ __forceinline__ unsigned cvt_pk_bf16(float lo, float hi) { const f32x2_cv0 v = {lo, hi}; const bf16x2_cv0 b = __builtin_convertvector(v, bf16x2_cv0); return __builtin_bit_cast(unsigned, b); }
typedef float f32x2 __attribute__((ext_vector_type(2)));
typedef unsigned u32x2 __attribute__((ext_vector_type(2)));
__device__ __forceinline__ float rs_of(const f32x4 q) { return __builtin_amdgcn_rsqf((((q.x + q.y) + q.z) + q.w) * (1.f / 1024.f) + 1e-5f); }
__device__ __forceinline__ float softplus_f(float x) { const float y = __expf(-fabsf(x)); const float l = (y < 0.03125f) ? y * (1.f - y * (0.5f - y * (1.f / 3.f - 0.25f * y))) : __logf(1.f + y); return fmaxf(x, 0.f) + l; }
struct EpiInProj {
    static constexpr bool PERM = true, AFTER_DRAIN = false, PRE = true;
    bf16_t* ZX; float* DT; const float* dt_bias; const float* SS;
    __device__ __forceinline__ const float* pre_ptr(const Unit& u) const { return SS + u.pm * (BM * 4); }
    __device__ __forceinline__ void operator()(const f32x4 (&acc)[2][2][4][2], const Unit& u, int wr, int wc, int fr, int fq, const PG8_LAS f32x4* rsl) const {
        const int row0 = u.pm * BM + wr * 64 + fr;
        if (u.pn < 24) {
            const int col0 = u.pn * BM + wc * 32 + 8 * fq;
#pragma unroll
            for (int ai = 0; ai < 2; ++ai)
#pragma unroll
                for (int m = 0; m < 4; ++m) { bf16_t* rowp = ZX + (size_t)(row0 + ai * HALF + m * 16) * 6144 + col0; const float rs = rs_of(rsl[wr * 64 + fr + ai * HALF + m * 16]);
#pragma unroll
                    for (int bj = 0; bj < 2; ++bj) { const f32x4 v0 = acc[ai][bj][m][0] * rs, v1 = acc[ai][bj][m][1] * rs;
                        u32x4 w; w.x = cvt_pk_bf16(v0[0], v0[1]); w.y = cvt_pk_bf16(v0[2], v0[3]); w.z = cvt_pk_bf16(v1[0], v1[1]); w.w = cvt_pk_bf16(v1[2], v1[3]);
                        *(u32x4*)(rowp + bj * HALF) = w; } }
        } else if (wc == 0) {
            const int c0 = 8 * fq;
            const f32x4 b0 = *(const f32x4*)(dt_bias + c0), b1 = *(const f32x4*)(dt_bias + c0 + 4);
#pragma unroll
            for (int ai = 0; ai < 2; ++ai)
#pragma unroll
                for (int m = 0; m < 4; ++m) { float* rowp = DT + (size_t)(row0 + ai * HALF + m * 16) * 32 + c0;
                    const float rs = rs_of(rsl[wr * 64 + fr + ai * HALF + m * 16]);
                    const f32x4 v0 = acc[ai][0][m][0] * rs + b0, v1 = acc[ai][0][m][1] * rs + b1;
                    f32x4 o0, o1;
#pragma unroll
                    for (int j = 0; j < 4; ++j) { o0[j] = softplus_f(v0[j]); o1[j] = softplus_f(v1[j]); }
                    *(f32x4*)(rowp) = o0; *(f32x4*)(rowp + 4) = o1; }
        }
    }
};
struct EpiRes {
    static constexpr bool PERM = true, AFTER_DRAIN = false, PRE = false;
    float* SSO;
    const float* X; bf16_t* H; float* SLAB;
    __device__ __forceinline__ void operator()(const f32x4 (&acc)[2][2][4][2], const Unit& u, int wr, int wc, int fr, int fq, const PG8_LAS f32x4* scr4) const {
        const int row0 = u.pm * BM + wr * 64 + fr, col0 = u.pn * BM + wc * 32 + 8 * fq;
        if (u.aux >= 0) {
            bf16_t* base = (bf16_t*)SLAB + (size_t)u.aux * (1280 * 1024) + (size_t)(row0 - 16384) * 1024 + col0;
#pragma unroll
            for (int ai = 0; ai < 2; ++ai)
#pragma unroll
                for (int m = 0; m < 4; ++m) { bf16_t* rowp = base + (size_t)(ai * HALF + m * 16) * 1024;
#pragma unroll
                    for (int bj = 0; bj < 2; ++bj) { const f32x4 v0 = acc[ai][bj][m][0], v1 = acc[ai][bj][m][1];
                        u32x4 w; w.x = cvt_pk_bf16(v0[0], v0[1]); w.y = cvt_pk_bf16(v0[2], v0[3]); w.z = cvt_pk_bf16(v1[0], v1[1]); w.w = cvt_pk_bf16(v1[2], v1[3]);
                        *(u32x4*)(rowp + bj * HALF) = w; } }
            return;
        }
        PG8_LAS float* scr = (PG8_LAS float*)scr4;
#pragma unroll
        for (int ai = 0; ai < 2; ++ai) {
            f32x4 r0[4][2], r1[4][2];
            if (X) {
#pragma unroll
                for (int m = 0; m < 4; ++m)
#pragma unroll
                    for (int bj = 0; bj < 2; ++bj) { const float* p = X + (size_t)(row0 + ai * HALF + m * 16) * 1024 + col0 + bj * HALF; r0[m][bj] = *(const f32x4*)p; r1[m][bj] = *(const f32x4*)(p + 4); }
            } else {
                u32x4 hb[4][2];
#pragma unroll
                for (int m = 0; m < 4; ++m)
#pragma unroll
                    for (int bj = 0; bj < 2; ++bj) hb[m][bj] = *(const u32x4*)(H + (size_t)(row0 + ai * HALF + m * 16) * 1024 + col0 + bj * HALF);
#pragma unroll
                for (int m = 0; m < 4; ++m)
#pragma unroll
                    for (int bj = 0; bj < 2; ++bj) { const u32x4 w = hb[m][bj];
                        r0[m][bj] = (f32x4){__uint_as_float(w.x << 16), __uint_as_float(w.x & 0xffff0000u), __uint_as_float(w.y << 16), __uint_as_float(w.y & 0xffff0000u)};
                        r1[m][bj] = (f32x4){__uint_as_float(w.z << 16), __uint_as_float(w.z & 0xffff0000u), __uint_as_float(w.w << 16), __uint_as_float(w.w & 0xffff0000u)}; }
            }
            float ssq[4];
#pragma unroll
            for (int m = 0; m < 4; ++m) { ssq[m] = 0.f;
#pragma unroll
                for (int bj = 0; bj < 2; ++bj) { const f32x4 v0 = r0[m][bj] + acc[ai][bj][m][0], v1 = r1[m][bj] + acc[ai][bj][m][1];
                    ssq[m] += v0[0] * v0[0] + v0[1] * v0[1] + v0[2] * v0[2] + v0[3] * v0[3] + v1[0] * v1[0] + v1[1] * v1[1] + v1[2] * v1[2] + v1[3] * v1[3];
                    u32x4 w; w.x = cvt_pk_bf16(v0[0], v0[1]); w.y = cvt_pk_bf16(v0[2], v0[3]); w.z = cvt_pk_bf16(v1[0], v1[1]); w.w = cvt_pk_bf16(v1[2], v1[3]);
                    *(u32x4*)(H + (size_t)(row0 + ai * HALF + m * 16) * 1024 + col0 + bj * HALF) = w; } }
#pragma unroll
            for (int m = 0; m < 4; ++m) { float t = ssq[m]; t += __shfl_xor(t, 16); t += __shfl_xor(t, 32);
                if (fq == 0) scr[(wr * 64 + fr + ai * HALF + m * 16) * 4 + wc] = t; }
        }
        asm volatile("s_waitcnt lgkmcnt(0)" ::: "memory"); __builtin_amdgcn_s_barrier();
        if (wr == 0) { const int r = wc * 64 + fq * 16 + fr; const f32x4 q = scr4[r]; SSO[(size_t)(u.pm * BM + r) * 4 + u.pn] = ((q.x + q.y) + q.z) + q.w; }
    }
};
template <int ACT> struct EpiBf {
    static constexpr bool PERM = true, AFTER_DRAIN = false, PRE = true;
    bf16_t* O0; int ldc0; int nsplit; bf16_t* O1; int ldc1; const float* SS;
    __device__ __forceinline__ const float* pre_ptr(const Unit& u) const { return SS + u.pm * (BM * 4); }
    __device__ __forceinline__ void operator()(const f32x4 (&acc)[2][2][4][2], const Unit& u, int wr, int wc, int fr, int fq, const PG8_LAS f32x4* rsl) const {
        const int row0 = u.pm * BM + wr * 64 + fr;
        bf16_t* base; int ldc, colt;
        if (u.pn < nsplit) { base = O0; ldc = ldc0; colt = u.pn * BM; } else { base = O1; ldc = ldc1; colt = (u.pn - nsplit) * BM; }
        const int col0 = colt + wc * 32 + 8 * fq;
#pragma unroll
        for (int ai = 0; ai < 2; ++ai)
#pragma unroll
            for (int m = 0; m < 4; ++m) { bf16_t* rowp = base + (size_t)(row0 + ai * HALF + m * 16) * ldc + col0; const float rs = rs_of(rsl[wr * 64 + fr + ai * HALF + m * 16]);
#pragma unroll
                for (int bj = 0; bj < 2; ++bj) { f32x4 v0 = acc[ai][bj][m][0] * rs, v1 = acc[ai][bj][m][1] * rs;
                    if (ACT == 1) {
#pragma unroll
                        for (int j = 0; j < 4; ++j) { const float a = fmaxf(v0[j], 0.f), b = fmaxf(v1[j], 0.f); v0[j] = a * a; v1[j] = b * b; } }
                    u32x4 w; w.x = cvt_pk_bf16(v0[0], v0[1]); w.y = cvt_pk_bf16(v0[2], v0[3]); w.z = cvt_pk_bf16(v1[0], v1[1]); w.w = cvt_pk_bf16(v1[2], v1[3]);
                    *(u32x4*)(rowp + bj * HALF) = w; } }
    }
};
struct EpiQSplit {
    static constexpr bool PERM = true, AFTER_DRAIN = false, PRE = true;
    bf16_t* Q; float* SLAB; const float* SS;
    __device__ __forceinline__ const float* pre_ptr(const Unit& u) const { return SS + u.pm * (BM * 4); }
    __device__ __forceinline__ void operator()(const f32x4 (&acc)[2][2][4][2], const Unit& u, int wr, int wc, int fr, int fq, const PG8_LAS f32x4* rsl) const {
        const int row0 = u.pm * BM + wr * 64 + fr, col0 = u.pn * BM + wc * 32 + 8 * fq;
        if (u.aux >= 0) {
            float* base = SLAB + (size_t)u.aux * (1280 * 1024) + (size_t)(row0 - 16384) * 1024 + col0;
#pragma unroll
            for (int ai = 0; ai < 2; ++ai)
#pragma unroll
                for (int m = 0; m < 4; ++m) { float* rowp = base + (size_t)(ai * HALF + m * 16) * 1024; const float rs = rs_of(rsl[wr * 64 + fr + ai * HALF + m * 16]);
#pragma unroll
                    for (int bj = 0; bj < 2; ++bj) { *(f32x4*)(rowp + bj * HALF) = acc[ai][bj][m][0] * rs; *(f32x4*)(rowp + bj * HALF + 4) = acc[ai][bj][m][1] * rs; } }
            return;
        }
#pragma unroll
        for (int ai = 0; ai < 2; ++ai)
#pragma unroll
            for (int m = 0; m < 4; ++m) { bf16_t* rowp = Q + (size_t)(row0 + ai * HALF + m * 16) * 1024 + col0; const float rs = rs_of(rsl[wr * 64 + fr + ai * HALF + m * 16]);
#pragma unroll
                for (int bj = 0; bj < 2; ++bj) { const f32x4 v0 = acc[ai][bj][m][0] * rs, v1 = acc[ai][bj][m][1] * rs;
                    u32x4 w; w.x = cvt_pk_bf16(v0[0], v0[1]); w.y = cvt_pk_bf16(v0[2], v0[3]); w.z = cvt_pk_bf16(v1[0], v1[1]); w.w = cvt_pk_bf16(v1[2], v1[3]);
                    *(u32x4*)(rowp + bj * HALF) = w; } }
    }
};

template <class Epi, class Sched, bool ALIGN_EPI = false, bool SP2 = false>
__device__ __forceinline__ void gemm_phase(PG8_LAS unsigned char* lds, const Gemm g, const Sched& S, const Epi& E) {
    int tid_l = threadIdx.x; asm volatile("" : "+v"(tid_l));
    const int tid = tid_l, wid = __builtin_amdgcn_readfirstlane(tid >> 6), lane = tid & 63, wr = wid >> 2, wc = wid & 3, fr = lane & 15, fq = lane >> 4;
    const int K = g.K;
    unsigned voffA[2], voffB[2];
#pragma unroll
    for (int i = 0; i < 2; ++i) { int R, C; stage_rc(tid * 16 + i * 8192, R, C); const int Rb = Epi::PERM ? ((R & ~31) + perm32(R & 31)) : R;
        voffA[i] = (unsigned)(R * K + C) * 2u; voffB[i] = (unsigned)(Rb * K + C) * 2u; }
    const unsigned voffS = (unsigned)tid * 16u;
    const size_t kstep = (size_t)(BK * 2);
    const size_t hstep = (size_t)HALF * K * 2;
    const size_t tstep = 2 * hstep;
    const unsigned ldsw = (unsigned)wid * 1024u;
    const int aoff = lds_byte(wr * 64 + fr, fq * 8), boff = lds_byte(wc * 32 + fr, fq * 8);
#define PG8_SA(b, h) (((b) * 2 + (h)) * HTB)
#define PG8_SB(b, h) ((4 + (b) * 2 + (h)) * HTB)
#define PG8_STAGE(bufoff, gbase, voff) do { _Pragma("unroll") for (int _i = 0; _i < 2; ++_i) \
        __builtin_amdgcn_global_load_lds((const unsigned*)((const char*)(gbase) + (voff)[_i]), (PG8_LAS unsigned*)(lds + (bufoff) + ldsw + _i * 8192), 16, 0, 0); } while (0)
#define PG8_LDA(dst, b, h) do { _Pragma("unroll") for (int m = 0; m < 4; ++m) _Pragma("unroll") for (int k = 0; k < 2; ++k) dst[m][k] = *(const PG8_LAS bf16x8*)(lds + PG8_SA(b, h) + aoff + m * 2048 + k * 1024); } while (0)
#define PG8_LDB(dst, b, h) do { _Pragma("unroll") for (int n = 0; n < 2; ++n) _Pragma("unroll") for (int k = 0; k < 2; ++k) dst[n][k] = *(const PG8_LAS bf16x8*)(lds + PG8_SB(b, h) + boff + n * 2048 + k * 1024); } while (0)
#define PG8_MMA(ai, bj, At, Bt) do { __builtin_amdgcn_s_setprio(1); _Pragma("unroll") for (int m = 0; m < 4; ++m) _Pragma("unroll") for (int n = 0; n < 2; ++n) _Pragma("unroll") for (int k = 0; k < 2; ++k) \
        acc[ai][bj][m][n] = __builtin_amdgcn_mfma_f32_16x16x32_bf16(Bt[n][k], At[m][k], acc[ai][bj][m][n], 0, 0, 0); __builtin_amdgcn_s_setprio(0); } while (0)
#define PG8_WAIT_V(n) asm volatile("s_waitcnt vmcnt(" #n ")" ::: "memory")
#define PG8_WAIT_L(n) asm volatile("s_waitcnt lgkmcnt(" #n ")" ::: "memory")
#define PG8_BAR __builtin_amdgcn_s_barrier()
#define PG8_SCHED __builtin_amdgcn_sched_barrier(0)
    Unit cur, nxt; int ui = 0;
    if (!S.next(0, cur)) return;
    f32x4 acc[2][2][4][2];
#pragma unroll
    for (int a = 0; a < 2; ++a)
#pragma unroll
        for (int b = 0; b < 2; ++b)
#pragma unroll
            for (int m = 0; m < 4; ++m)
#pragma unroll
                for (int n = 0; n < 2; ++n) acc[a][b][m][n] = (f32x4){0.f, 0.f, 0.f, 0.f};
    bf16x8 At[4][2], B0[2][2], B1[2][2];
    const char* cA = (const char*)g.A + (size_t)cur.pm * tstep + (size_t)cur.k0 * 2; const char* cB = (const char*)g.Bt + (size_t)cur.pn * tstep + (size_t)cur.k0 * 2;
    S.a_ready(cur);
    if constexpr (SP2) {
        PG8_STAGE(PG8_SB(0, 0), cB, voffB); PG8_STAGE(PG8_SB(0, 1), cB + hstep, voffB); PG8_STAGE(PG8_SA(0, 0), cA, voffA); PG8_STAGE(PG8_SA(0, 1), cA + hstep, voffA);
        if (wr == 1) PG8_BAR;
        PG8_WAIT_V(2); PG8_BAR;
        PG8_STAGE(PG8_SB(1, 0), cB + kstep, voffB); PG8_STAGE(PG8_SA(1, 0), cA + kstep, voffA); PG8_STAGE(PG8_SB(1, 1), cB + hstep + kstep, voffB);
        PG8_WAIT_V(6); PG8_BAR;
    } else {
        PG8_STAGE(PG8_SB(0, 0), cB, voffB); PG8_STAGE(PG8_SA(0, 0), cA, voffA); PG8_STAGE(PG8_SB(0, 1), cB + hstep, voffB); PG8_STAGE(PG8_SA(0, 1), cA + hstep, voffA);
        if (wr == 1) PG8_BAR;
        PG8_WAIT_V(4); PG8_BAR;
        PG8_STAGE(PG8_SB(1, 0), cB + kstep, voffB); PG8_STAGE(PG8_SA(1, 0), cA + kstep, voffA); PG8_STAGE(PG8_SB(1, 1), cB + hstep + kstep, voffB);
        PG8_WAIT_V(6); PG8_BAR;
    }
    for (;;) {
        const bool has_next = S.next(ui + 1, nxt);
        const char* nA = has_next ? (const char*)g.A + (size_t)nxt.pm * tstep + (size_t)nxt.k0 * 2 : cA; const char* nB = has_next ? (const char*)g.Bt + (size_t)nxt.pn * tstep + (size_t)nxt.k0 * 2 : cB;
        const int nt = cur.nt;
        for (int t = 0; t < nt; t += 2) {
            const bool last = (t == nt - 2);
            const char* a1 = cA + (size_t)(t + 1) * kstep;
            const char* a2 = last ? nA : cA + (size_t)(t + 2) * kstep; const char* b2 = last ? nB : cB + (size_t)(t + 2) * kstep;
            const char* a3 = a2 + kstep; const char* b3 = b2 + kstep;
            if (last && has_next) S.a_ready(nxt);
            if constexpr (SP2) {
            PG8_LDB(B0, 0, 0); PG8_LDB(B1, 0, 1); PG8_SCHED; PG8_LDA(At, 0, 0); PG8_STAGE(PG8_SA(1, 1), a1 + hstep, voffA);
            PG8_WAIT_V(8); PG8_WAIT_L(0); PG8_BAR;
            if constexpr (Epi::PRE) { if (last && wid < 4) __builtin_amdgcn_global_load_lds((const unsigned*)((const char*)E.pre_ptr(cur) + voffS), (PG8_LAS unsigned*)(lds + 8 * HTB + (ui & 1) * 4096 + wid * 1024), 16, 0, 0); }
            PG8_MMA(0, 0, At, B0); PG8_MMA(0, 1, At, B1); PG8_BAR; PG8_SCHED;
            PG8_LDA(At, 0, 1); PG8_STAGE(PG8_SB(0, 0), b2, voffB); PG8_STAGE(PG8_SB(0, 1), b2 + hstep, voffB); PG8_STAGE(PG8_SA(0, 0), a2, voffA);
            PG8_WAIT_V(8); PG8_WAIT_L(0); PG8_BAR; PG8_MMA(1, 0, At, B0); PG8_MMA(1, 1, At, B1); PG8_BAR; PG8_SCHED;
            PG8_LDB(B0, 1, 0); PG8_LDB(B1, 1, 1); PG8_SCHED; PG8_LDA(At, 1, 0); PG8_STAGE(PG8_SA(0, 1), a2 + hstep, voffA);
            PG8_WAIT_V(8); PG8_WAIT_L(0); PG8_BAR; PG8_MMA(0, 0, At, B0); PG8_MMA(0, 1, At, B1); PG8_BAR; PG8_SCHED;
            PG8_LDA(At, 1, 1); PG8_STAGE(PG8_SB(1, 0), b3, voffB); PG8_STAGE(PG8_SB(1, 1), b3 + hstep, voffB); PG8_STAGE(PG8_SA(1, 0), a3, voffA);
            PG8_WAIT_V(8); PG8_WAIT_L(0); PG8_BAR; PG8_MMA(1, 0, At, B0); PG8_MMA(1, 1, At, B1); PG8_BAR; PG8_SCHED;
            } else {
            PG8_LDB(B0, 0, 0); PG8_SCHED; PG8_LDA(At, 0, 0); PG8_STAGE(PG8_SA(1, 1), a1 + hstep, voffA);
            PG8_WAIT_L(8); PG8_BAR; PG8_WAIT_L(0); PG8_MMA(0, 0, At, B0); PG8_BAR; PG8_SCHED;
            PG8_LDB(B1, 0, 1); PG8_STAGE(PG8_SB(0, 0), b2, voffB);
            PG8_BAR; PG8_WAIT_L(0); PG8_MMA(0, 1, At, B1); PG8_BAR;
            PG8_LDA(At, 0, 1); PG8_STAGE(PG8_SA(0, 0), a2, voffA);
            PG8_BAR; PG8_WAIT_L(0); PG8_MMA(1, 0, At, B0); PG8_BAR; PG8_SCHED;
            PG8_STAGE(PG8_SB(0, 1), b2 + hstep, voffB);
            PG8_WAIT_V(6); PG8_BAR; PG8_MMA(1, 1, At, B1); PG8_BAR;
            PG8_LDB(B0, 1, 0); PG8_SCHED; PG8_LDA(At, 1, 0); PG8_STAGE(PG8_SA(0, 1), a2 + hstep, voffA);
            PG8_WAIT_L(8); PG8_BAR; PG8_WAIT_L(0); PG8_MMA(0, 0, At, B0); PG8_BAR; PG8_SCHED;
            PG8_LDB(B1, 1, 1); PG8_STAGE(PG8_SB(1, 0), b3, voffB);
            PG8_BAR; PG8_WAIT_L(0); PG8_MMA(0, 1, At, B1); PG8_BAR;
            PG8_LDA(At, 1, 1); PG8_STAGE(PG8_SA(1, 0), a3, voffA);
            PG8_BAR; PG8_WAIT_L(0); PG8_MMA(1, 0, At, B0); PG8_BAR; PG8_SCHED;
            PG8_STAGE(PG8_SB(1, 1), b3 + hstep, voffB);
            PG8_WAIT_V(6); PG8_BAR; PG8_MMA(1, 1, At, B1); PG8_BAR;
            }
        }
        if constexpr (ALIGN_EPI) { if (wr == 0) PG8_BAR; }
        if constexpr (!Epi::AFTER_DRAIN) { E(acc, cur, wr, wc, fr, fq, (const PG8_LAS f32x4*)(lds + 8 * HTB + (ui & 1) * 4096)); S.done(cur); }
        if (!has_next) break;
#pragma unroll
        for (int a = 0; a < 2; ++a)
#pragma unroll
            for (int b = 0; b < 2; ++b)
#pragma unroll
                for (int m = 0; m < 4; ++m)
#pragma unroll
                    for (int n = 0; n < 2; ++n) acc[a][b][m][n] = (f32x4){0.f, 0.f, 0.f, 0.f};
        cur = nxt; cA = nA; cB = nB; ++ui;
        if constexpr (ALIGN_EPI) { if (wr == 1) PG8_BAR; }
    }
    PG8_WAIT_V(0);
    if constexpr (!ALIGN_EPI) { if (wr == 0) PG8_BAR; }
    PG8_BAR;
    if constexpr (Epi::AFTER_DRAIN) { E.fused(acc, cur, wr, wc, fr, fq, lds, wid, lane); S.done(cur); }
#undef PG8_SA
#undef PG8_SB
#undef PG8_STAGE
#undef PG8_LDA
#undef PG8_LDB
#undef PG8_MMA
#undef PG8_WAIT_V
#undef PG8_WAIT_L
#undef PG8_BAR
#undef PG8_SCHED
}
}
#define GAS __attribute__((address_space(1)))
#define LAS __attribute__((address_space(3)))
typedef unsigned short bf16;
typedef unsigned v4u __attribute__((ext_vector_type(4)));
typedef float f32x4 __attribute__((ext_vector_type(4)));
typedef short bf16x8 __attribute__((ext_vector_type(8)));
typedef GAS unsigned gu32;
typedef GAS unsigned long long gu64;
#define RLX_AGENT __ATOMIC_RELAXED, __HIP_MEMORY_SCOPE_AGENT
#define LDS_WAIT() asm volatile("s_waitcnt lgkmcnt(0)" ::: "memory")
#define VM_WAIT() asm volatile("s_waitcnt vmcnt(0)" ::: "memory")
__device__ __forceinline__ unsigned long long rt() { return __builtin_amdgcn_s_memrealtime(); }
__device__ __forceinline__ unsigned f2bf(float f) { unsigned u = __builtin_bit_cast(unsigned, f); return (u + 0x7fffu + ((u >> 16) & 1u)) >> 16; }
__device__ __forceinline__ unsigned pk2(float lo, float hi) { return f2bf(lo) | (f2bf(hi) << 16); }

#define XB_TMO      128
#define XB_XCNT(j)  (256  + 64 * (j))
#define XB_XSUB(j)  (1280 + 64 * (j))
#define XB_XGEN(j)  (2304 + 64 * (j))
#define XB_TOP      3328
#define XB_TOPGEN   3392
#define XCD_BAR_WORDS 3456
#define XB_SPIN_CAP (1u << 18)

__device__ __forceinline__ unsigned xb_ld(unsigned* p)              { return __hip_atomic_load(p, __ATOMIC_RELAXED, __HIP_MEMORY_SCOPE_AGENT); }
__device__ __forceinline__ unsigned xb_add(unsigned* p, unsigned v) { return __hip_atomic_fetch_add(p, v, __ATOMIC_RELAXED, __HIP_MEMORY_SCOPE_AGENT); }
__device__ __forceinline__ unsigned xb_xcc_id() { return (unsigned)__builtin_amdgcn_s_getreg((3 << 11) | 20) & 0xFu; }
#define XB_SPIN(cond, bar) do { unsigned _sp = 0; while (cond) { __builtin_amdgcn_s_sleep(1); \
    if ((++_sp & 255u) == 0u) { if (xb_ld(&(bar)[XB_TMO])) break; if (_sp > XB_SPIN_CAP) { atomicAdd(&(bar)[XB_TMO], 1u); break; } } } } while (0)

struct XcdBarrier {
    unsigned* bar; unsigned x;
    volatile LAS unsigned* st;
};

__device__ __forceinline__ XcdBarrier xcd_barrier_post(unsigned* bar, volatile LAS unsigned* st) {
    XcdBarrier b; b.bar = bar; b.x = xb_xcc_id(); b.st = st;
    if (threadIdx.x == 0) (void)xb_add(&bar[XB_XCNT(b.x)], 1u);
    return b;
}
__device__ __forceinline__ void xcd_barrier_complete(unsigned* bar, unsigned x, unsigned& nloc, unsigned& nx) {
    const unsigned G = gridDim.x * gridDim.y * gridDim.z;
    unsigned sum, cnt, mine, sp = 0u;
    for (;;) {
        sum = 0u; cnt = 0u; mine = 0u;
#pragma unroll
        for (unsigned j = 0; j < 16; ++j) { const unsigned c = xb_ld(&bar[XB_XCNT(j)]); sum += c; cnt += (c > 0u) ? 1u : 0u; mine = (j == x) ? c : mine; }
        if (sum == G) break;
        __builtin_amdgcn_s_sleep(1);
        if ((++sp & 255u) == 0u) { if (xb_ld(&bar[XB_TMO])) break; if (sp > XB_SPIN_CAP) { atomicAdd(&bar[XB_TMO], 1u); break; } }
    }
    nloc = mine > 0u ? mine : 1u; nx = cnt > 0u ? cnt : 1u;
}

__device__ __forceinline__ void xcd_barrier(const XcdBarrier& b) {
    asm volatile("s_waitcnt vmcnt(0)" ::: "memory");
    __syncthreads();
    if (threadIdx.x == 0) {
        unsigned* bar = b.bar;
        __builtin_amdgcn_s_waitcnt(0);
        unsigned nloc = b.st[0], nx = b.st[1];
        if (nloc == 0u) { xcd_barrier_complete(bar, b.x, nloc, nx); b.st[0] = nloc; b.st[1] = nx; }
        const unsigned old = xb_add(&bar[XB_XSUB(b.x)], 1u);
        const unsigned gen = old / nloc;
        if (old + 1u == (gen + 1u) * nloc) {
            __builtin_amdgcn_fence(__ATOMIC_RELEASE, "agent");
            asm volatile("s_waitcnt vmcnt(0)" ::: "memory");
            const unsigned og = xb_add(&bar[XB_TOP], 1u);
            const unsigned tg = og / nx;
            if (og + 1u == (tg + 1u) * nx) xb_add(&bar[XB_TOPGEN], 1u);
            else XB_SPIN(xb_ld(&bar[XB_TOPGEN]) == tg, bar);
            __builtin_amdgcn_fence(__ATOMIC_ACQUIRE, "agent");
            xb_add(&bar[XB_XGEN(b.x)], 1u);
            asm volatile("s_waitcnt vmcnt(0)" ::: "memory");
        } else {
            XB_SPIN(xb_ld(&bar[XB_XGEN(b.x)]) == gen, bar);
            __builtin_amdgcn_fence(__ATOMIC_ACQUIRE, "agent");
            asm volatile("s_waitcnt vmcnt(0)" ::: "memory");
        }
    }
    __syncthreads();
}
constexpr int NWAVES = 8, NTHREADS = 512;
constexpr int DM = 1024, SEQ = 8192, NPROMPT = 2, NSAMP = 128, TSAMP = 8, NMETA = 16;
constexpr int ROW_S = NPROMPT * SEQ;
constexpr int ROW_M = ROW_S + NSAMP * TSAMP;
constexpr int NROWS = ROW_M + NMETA;
constexpr int MP = 17664;
constexpr int DINNER = 2048, NHEADS = 32, HD = 64, NGROUPS = 8, DSTATE = 128, CONVD = 4096, INPROJ = 6176, INPROJ_P = 6400, ZXW = 6144;
constexpr int DFF = 4096, NKV = 4, NQ = 16, KVW = 512;
constexpr float EPS = 1e-5f;
constexpr int LDX = 136;

constexpr size_t O_YP = 0, O_YS = O_YP + (size_t)NPROMPT * SEQ * DM, O_PCONV = O_YS + (size_t)NSAMP * TSAMP * DM, O_PSSM = O_PCONV + 2 * 2 * 3 * 4096,
    O_PCK = O_PSSM + (size_t)2 * 2 * 32 * 64 * 128, O_PCV = O_PCK + 2 * 128 * 256, O_SCONV = O_PCV + 2 * 128 * 256, O_SSSM = O_SCONV + (size_t)2 * 128 * 3 * 4096,
    O_SCK = O_SSSM + (size_t)2 * 128 * 32 * 64 * 128, O_SCV = O_SCK + (size_t)128 * 128 * 256, O_END = O_SCV + (size_t)128 * 128 * 256;

constexpr size_t MiB = 1u << 20;
constexpr size_t WS_CTL = 0, CTL_ZERO_BYTES = 1 * MiB;
constexpr size_t SZ_WIN = (size_t)INPROJ_P * 1024 * 2, SZ_WOUT = (size_t)1024 * 2048 * 2, SZ_WUP = (size_t)4096 * 1024 * 2, SZ_WDN = SZ_WUP, SZ_WQKV0 = (size_t)1536 * 1024 * 2, SZ_WQ1 = (size_t)1024 * 1024 * 2, SZ_WO = SZ_WQ1;
constexpr size_t WS_WIN = 1 * MiB, WS_WOUT = WS_WIN + 2 * SZ_WIN, WS_WUP = WS_WOUT + 2 * SZ_WOUT, WS_WDN = WS_WUP + 4 * SZ_WUP, WS_WQKV0 = WS_WDN + 4 * SZ_WDN, WS_WQ1 = WS_WQKV0 + SZ_WQKV0, WS_WO = WS_WQ1 + SZ_WQ1, WS_WEND = WS_WO + 2 * SZ_WO;
constexpr size_t al1m(size_t x) { return (x + MiB - 1) / MiB * MiB; }
constexpr size_t WS_H = al1m(WS_WEND), WS_HN = al1m(WS_H + (size_t)MP * 1024 * 4), WS_ZX = al1m(WS_HN + (size_t)MP * 1024 * 2), WS_DT = al1m(WS_ZX + (size_t)MP * ZXW * 2),
    WS_XC = al1m(WS_DT + (size_t)MP * 32 * 4), WS_YN = al1m(WS_XC + (size_t)MP * 4096 * 2), WS_CS = al1m(WS_YN + (size_t)MP * 2048 * 2), WS_CD = al1m(WS_CS + (size_t)129 * 32 * 8192 * 4), WS_SLAB = al1m(WS_CD + 129 * 32 * 4), WS_HSB = al1m(WS_SLAB + (size_t)8 * 1280 * 1024 * 4), WS_END = al1m(WS_HSB + (size_t)128 * 32 * 8192 * 2);
constexpr size_t WS_U = WS_ZX;
constexpr size_t WS_Q = WS_XC, WS_KV = WS_Q + (size_t)MP * 1024 * 2, WS_AO = WS_KV + (size_t)MP * 512 * 2;
static_assert(WS_AO + (size_t)MP * 1024 * 2 <= WS_YN, "attention overlay");
constexpr int CW_BAR = 4096;
constexpr int CW_FLAG2 = 8192 + 64 * 16, LEFT_CU0 = 176;
constexpr int CW_FLAG = 8192, ROWJOB_WGS = 64;
constexpr size_t WS_SS = WS_HN;

constexpr int RING_BYTES = 131072, LDS_BYTES = 163840, LDSCTL_OFF = LDS_BYTES - 512, MISC_OFF = LDSCTL_OFF + 320;
constexpr int CWT_OFF = 147456;
static_assert(CWT_OFF + 5 * 512 * 4 <= LDSCTL_OFF, "conv weight table");

typedef unsigned u32x2 __attribute__((ext_vector_type(2)));
typedef unsigned u32x4 __attribute__((ext_vector_type(4)));
__device__ __forceinline__ int ltid() { int t = threadIdx.x; asm volatile("" : "+v"(t)); return t; }
__device__ __forceinline__ float bf2f(unsigned short b) { return __uint_as_float((unsigned)b << 16); }
__device__ __forceinline__ float bflo(unsigned w) { return __uint_as_float(w << 16); }
__device__ __forceinline__ float bfhi(unsigned w) { return __uint_as_float(w & 0xffff0000u); }
__device__ __forceinline__ unsigned pkbf(float lo, float hi) { return pg8::cvt_pk_bf16(lo, hi); }
#define dpp_f(v, ctrl) __builtin_bit_cast(float, __builtin_amdgcn_update_dpp(0, __builtin_bit_cast(int, (float)(v)), (ctrl), 0xf, 0xf, true))
__device__ __forceinline__ float wave_sum(float v) {
    v += dpp_f(v, 0xB1); v += dpp_f(v, 0x4E); v += dpp_f(v, 0x141); v += dpp_f(v, 0x140);
    v += __shfl_xor(v, 16); v += __shfl_xor(v, 32);
    return v;
}
__device__ __forceinline__ float frcp(float x) { return __builtin_amdgcn_rcpf(x); }
__device__ __forceinline__ float sigmoid_f(float x) { return frcp(1.f + __expf(-x)); }
#define MFMA16(b, a, c) __builtin_amdgcn_mfma_f32_16x16x32_bf16((b), (a), (c), 0, 0, 0)

struct Args {
    const float* in[26]; float* out; unsigned char* ws; int ph_lo, ph_hi;
};
typedef const __attribute__((address_space(4))) Args* ArgsP;
enum { I_XP = 0, I_XS, I_SCONV, I_SSSM, I_CK, I_CV, I_META, I_ANORM, I_AIN, I_ACONVW, I_ACONVB, I_ADTB, I_ALOG, I_ADSKIP, I_AGATE, I_AOUT, I_KVNORM, I_WKV, I_BNORM, I_WQ, I_SINKS, I_WO, I_MLPNORM, I_WUP, I_WDOWN, I_FNORM };

__device__ __forceinline__ void transpose_item(const float* W, const float* scale, int K, int N, bf16* WT, int row_off, LAS unsigned* scr, int item, int lane) {
    const int nblk = (N + 63) / 64, kb = item / nblk, nb = item % nblk, k0 = 64 * kb, n0 = 64 * nb;
    const bool ok = (n0 + lane < N);
    const float* src = W + (size_t)k0 * N + n0 + (ok ? lane : 0);
    float v[64];
#pragma unroll
    for (int i = 0; i < 64; ++i) v[i] = __builtin_nontemporal_load(src + (size_t)i * N);
    if (!ok) {
#pragma unroll
        for (int i = 0; i < 64; ++i) v[i] = 0.f;
    }
    if (scale) {
#pragma unroll
        for (int i = 0; i < 64; ++i) v[i] *= scale[k0 + i];
    }
#pragma unroll
    for (int i = 0; i < 32; ++i) scr[lane * 33 + i] = pkbf(v[2 * i], v[2 * i + 1]);
    LDS_WAIT(); asm volatile("" ::: "memory");
    const int c = lane & 7;
#pragma unroll
    for (int j = 0; j < 8; ++j) { const int n = (lane >> 3) + 8 * j; const LAS unsigned* sp = scr + n * 33 + 4 * c;
        v4u o; o.x = sp[0]; o.y = sp[1]; o.z = sp[2]; o.w = sp[3];
        if (n0 + n < N) *(GAS v4u*)(WT + (size_t)(row_off + n0 + n) * K + k0 + 8 * c) = o; }
    LDS_WAIT(); asm volatile("" ::: "memory");
}
struct WJob { const float* W; const float* scale; int K, N; bf16* WT; int row_off; int items; };

__device__ __forceinline__ void phase_prologue(ArgsP a, LAS unsigned char* lds, int wave, int lane, unsigned jbmask, int cu0, int cu1) {
    LAS unsigned* scr = (LAS unsigned*)(lds + wave * 16384);
    const int gw = ((int)blockIdx.x - cu0) * NWAVES + wave, NGW = (cu1 - cu0) * NWAVES;
    unsigned char* ws = a->ws;
    int off = 0;
#pragma unroll 1
    for (int jb = 0; jb < 17; ++jb) {
        if (!((jbmask >> jb) & 1u)) continue;
        WJob J;
        if (jb < 2)       { const int i = jb;      J = WJob{a->in[I_AIN] + (size_t)i * 1024 * INPROJ, a->in[I_ANORM] + i * 1024, 1024, INPROJ, (bf16*)(ws + WS_WIN + i * SZ_WIN), 0, 0}; }
        else if (jb < 4)  { const int i = jb - 2;  J = WJob{a->in[I_AOUT] + (size_t)i * 2048 * 1024, a->in[I_AGATE] + i * 2048, 2048, 1024, (bf16*)(ws + WS_WOUT + i * SZ_WOUT), 0, 0}; }
        else if (jb < 8)  { const int l = jb - 4;  J = WJob{a->in[I_WUP] + (size_t)l * 1024 * 4096, a->in[I_MLPNORM] + l * 1024, 1024, 4096, (bf16*)(ws + WS_WUP + l * SZ_WUP), 0, 0}; }
        else if (jb < 12) { const int l = jb - 8;  J = WJob{a->in[I_WDOWN] + (size_t)l * 4096 * 1024, nullptr, 4096, 1024, (bf16*)(ws + WS_WDN + l * SZ_WDN), 0, 0}; }
        else if (jb == 12) { J = WJob{a->in[I_WQ], a->in[I_BNORM], 1024, 1024, (bf16*)(ws + WS_WQKV0), 0, 0}; }
        else if (jb == 13) { J = WJob{a->in[I_WKV], a->in[I_KVNORM], 1024, 512, (bf16*)(ws + WS_WQKV0), 1024, 0}; }
        else if (jb == 14) { J = WJob{a->in[I_WQ] + (size_t)1024 * 1024, a->in[I_BNORM] + 1024, 1024, 1024, (bf16*)(ws + WS_WQ1), 0, 0}; }
        else { const int j = jb - 15; J = WJob{a->in[I_WO] + (size_t)j * 1024 * 1024, nullptr, 1024, 1024, (bf16*)(ws + WS_WO + j * SZ_WO), 0, 0}; }
        const int items = (J.K / 64) * ((J.N + 63) / 64);
        int first = (gw - off) % NGW; if (first < 0) first += NGW;
        for (int it = first; it < items; it += NGW) transpose_item(J.W, J.scale, J.K, J.N, J.WT, J.row_off, scr, it, lane);
        off = (off + items) % NGW;
        if (jb < 2) {
            const int gt = gw * 64 + lane, NT = NGW * 64;
            const int per = (INPROJ_P - INPROJ) * 1024 * 2 / 16;
            unsigned z = 0u; asm volatile("" : "+v"(z));
            for (int e = gt; e < per; e += NT) *(v4u*)(ws + WS_WIN + jb * SZ_WIN + (size_t)INPROJ * 1024 * 2 + (size_t)e * 16) = (v4u){z, z, z, z};
        }
    }
}

__device__ __forceinline__ void row_ld_bf(const bf16* __restrict__ p, int lane, float (&v)[16]) {
    const u32x4 a0 = *(const u32x4*)(p + 8 * lane), a1 = *(const u32x4*)(p + 512 + 8 * lane);
    v[0] = bflo(a0.x); v[1] = bfhi(a0.x); v[2] = bflo(a0.y); v[3] = bfhi(a0.y); v[4] = bflo(a0.z); v[5] = bfhi(a0.z); v[6] = bflo(a0.w); v[7] = bfhi(a0.w);
    v[8] = bflo(a1.x); v[9] = bfhi(a1.x); v[10] = bflo(a1.y); v[11] = bfhi(a1.y); v[12] = bflo(a1.z); v[13] = bfhi(a1.z); v[14] = bflo(a1.w); v[15] = bfhi(a1.w);
}
__device__ __forceinline__ void row_ld_f32(const float* __restrict__ p, int lane, float (&v)[16], bool nt) {
    f32x4 q[4];
    if (nt) { q[0] = __builtin_nontemporal_load((const f32x4*)(p + 8 * lane)); q[1] = __builtin_nontemporal_load((const f32x4*)(p + 8 * lane + 4)); q[2] = __builtin_nontemporal_load((const f32x4*)(p + 512 + 8 * lane)); q[3] = __builtin_nontemporal_load((const f32x4*)(p + 512 + 8 * lane + 4)); }
    else { q[0] = *(const f32x4*)(p + 8 * lane); q[1] = *(const f32x4*)(p + 8 * lane + 4); q[2] = *(const f32x4*)(p + 512 + 8 * lane); q[3] = *(const f32x4*)(p + 512 + 8 * lane + 4); }
#pragma unroll
    for (int k = 0; k < 4; ++k) { v[4 * k] = q[k].x; v[4 * k + 1] = q[k].y; v[4 * k + 2] = q[k].z; v[4 * k + 3] = q[k].w; }
}
__device__ __forceinline__ void row_st_bf(bf16* __restrict__ p, int lane, const float (&v)[16], float sc) {
    u32x4 a0, a1;
    a0.x = pkbf(v[0] * sc, v[1] * sc); a0.y = pkbf(v[2] * sc, v[3] * sc); a0.z = pkbf(v[4] * sc, v[5] * sc); a0.w = pkbf(v[6] * sc, v[7] * sc);
    a1.x = pkbf(v[8] * sc, v[9] * sc); a1.y = pkbf(v[10] * sc, v[11] * sc); a1.z = pkbf(v[12] * sc, v[13] * sc); a1.w = pkbf(v[14] * sc, v[15] * sc);
    *(u32x4*)(p + 8 * lane) = a0; *(u32x4*)(p + 512 + 8 * lane) = a1;
}
__device__ __forceinline__ float row_rs(const float (&v)[16]) {
    float s = 0.f;
#pragma unroll
    for (int k = 0; k < 16; ++k) s += v[k] * v[k];
    return rsqrtf(wave_sum(s) * (1.f / DM) + EPS);
}
__device__ __forceinline__ float row_ss(const float (&v)[16]) {
    float s = 0.f;
#pragma unroll
    for (int k = 0; k < 16; ++k) s += v[k] * v[k];
    return wave_sum(s);
}
__device__ __forceinline__ void phase_rows(ArgsP a, int from_inputs, int nslab, int ver, int jobs, int wave, int lane) {
    bf16* __restrict__ H = (bf16*)(a->ws + WS_H); f32x4* __restrict__ SS = (f32x4*)(a->ws + WS_SS) + (size_t)ver * MP; const float* __restrict__ SLAB = (const float*)(a->ws + WS_SLAB);
    const int gw = ((int)blockIdx.x - ((int)gridDim.x - jobs)) * NWAVES + wave, NGW = jobs * NWAVES;
    for (int m = ROW_S + gw; m < MP; m += NGW) {
        if (m >= NROWS) { unsigned z = 0u; asm volatile("" : "+v"(z));
            if (from_inputs) { *(u32x4*)(H + (size_t)m * DM + 8 * lane) = (u32x4){z, z, z, z}; *(u32x4*)(H + (size_t)m * DM + 512 + 8 * lane) = (u32x4){z, z, z, z}; }
            if (lane == 0) SS[m] = (f32x4){__uint_as_float(z), __uint_as_float(z), __uint_as_float(z), __uint_as_float(z)};
            continue; }
        float v[16];
        if (from_inputs) row_ld_f32((m < ROW_M) ? a->in[I_XS] + (size_t)(m - ROW_S) * DM : a->in[I_META] + (size_t)(m - ROW_M) * DM, lane, v, false);
        else row_ld_bf(H + (size_t)m * DM, lane, v);
        float sv[8][16];
#pragma unroll
        for (int sl = 0; sl < 8; ++sl) { if (sl < nslab) row_ld_bf((const bf16*)SLAB + (size_t)sl * (1280 * 1024) + (size_t)(m - ROW_S) * DM, lane, sv[sl]); else {
#pragma unroll
                for (int k = 0; k < 16; ++k) sv[sl][k] = 0.f; } }
#pragma unroll
        for (int sl = 0; sl < 8; ++sl)
#pragma unroll
            for (int k = 0; k < 16; ++k) v[k] += sv[sl][k];
        row_st_bf(H + (size_t)m * DM, lane, v, 1.f);
        const float ss = row_ss(v);
        if (lane == 0) SS[m] = (f32x4){ss, 0.f, 0.f, 0.f};
    }
    if (!from_inputs) return;
    for (int m0 = 4 * gw; m0 < ROW_S; m0 += 4 * NGW) {
        float v[4][16];
#pragma unroll
        for (int q = 0; q < 4; ++q) row_ld_f32(a->in[I_XP] + (size_t)(m0 + q) * DM, lane, v[q], false);
#pragma unroll
        for (int q = 0; q < 4; ++q) { row_st_bf(H + (size_t)(m0 + q) * DM, lane, v[q], 1.f); const float ss = row_ss(v[q]); if (lane == 0) SS[m0 + q] = (f32x4){ss, 0.f, 0.f, 0.f}; }
    }
}
__device__ __forceinline__ void phase_final(ArgsP a, int wave, int lane) {
    const bf16* __restrict__ H = (const bf16*)(a->ws + WS_H); const float* __restrict__ fw = a->in[I_FNORM]; const float* __restrict__ SLAB = (const float*)(a->ws + WS_SLAB);
    const int gw = blockIdx.x * NWAVES + wave, NGW = gridDim.x * NWAVES;
    float w[16]; row_ld_f32(fw, lane, w, false);
    for (int m = gw; m < ROW_M; m += NGW) {
        float v[16]; row_ld_bf(H + (size_t)m * DM, lane, v);
        if (m >= ROW_S) {
#pragma unroll 1
            for (int sl = 0; sl < 8; ++sl) { float t[16]; row_ld_bf((const bf16*)SLAB + (size_t)sl * (1280 * 1024) + (size_t)(m - ROW_S) * DM, lane, t);
#pragma unroll
                for (int k = 0; k < 16; ++k) v[k] += t[k]; }
        }
        const float rs = row_rs(v);
        float* o = a->out + O_YP + (size_t)m * DM;
        __builtin_nontemporal_store((f32x4){v[0] * rs * w[0], v[1] * rs * w[1], v[2] * rs * w[2], v[3] * rs * w[3]}, (f32x4*)(o + 8 * lane));
        __builtin_nontemporal_store((f32x4){v[4] * rs * w[4], v[5] * rs * w[5], v[6] * rs * w[6], v[7] * rs * w[7]}, (f32x4*)(o + 8 * lane + 4));
        __builtin_nontemporal_store((f32x4){v[8] * rs * w[8], v[9] * rs * w[9], v[10] * rs * w[10], v[11] * rs * w[11]}, (f32x4*)(o + 512 + 8 * lane));
        __builtin_nontemporal_store((f32x4){v[12] * rs * w[12], v[13] * rs * w[13], v[14] * rs * w[14], v[15] * rs * w[15]}, (f32x4*)(o + 512 + 8 * lane + 4));
    }
}

__device__ __forceinline__ void unpack8(const u32x4 w, float (&f)[8]) { f[0] = bflo(w.x); f[1] = bfhi(w.x); f[2] = bflo(w.y); f[3] = bfhi(w.y); f[4] = bflo(w.z); f[5] = bfhi(w.z); f[6] = bflo(w.w); f[7] = bfhi(w.w); }
__device__ __forceinline__ void ld8f(const float* __restrict__ p, float (&f)[8]) { const f32x4 x0 = *(const f32x4*)p, x1 = *(const f32x4*)(p + 4); f[0]=x0.x;f[1]=x0.y;f[2]=x0.z;f[3]=x0.w;f[4]=x1.x;f[5]=x1.y;f[6]=x1.z;f[7]=x1.w; }
#define TSW(ch) ((((ch) >> 3) & 7) << 3)
struct ConvW { float w0[8], w1[8], w2[8], w3[8], bs[8]; };
__device__ __forceinline__ void conv_load_w(const float* __restrict__ cw, const float* __restrict__ cb, int c0, ConvW& W) { ld8f(cw + c0, W.w0); ld8f(cw + CONVD + c0, W.w1); ld8f(cw + 2 * CONVD + c0, W.w2); ld8f(cw + 3 * CONVD + c0, W.w3); ld8f(cb + c0, W.bs); }
__device__ __forceinline__ void conv_load_w_lds(const unsigned char* lds, int chl, ConvW& W) { const float* tab = (const float*)(lds + CWT_OFF) + chl; ld8f(tab, W.w0); ld8f(tab + 512, W.w1); ld8f(tab + 1024, W.w2); ld8f(tab + 1536, W.w3); ld8f(tab + 2048, W.bs); }
__device__ __forceinline__ void conv_fill_table(const float* __restrict__ cw, const float* __restrict__ cb, unsigned char* lds, int g) {
    float* tab = (float*)(lds + CWT_OFF);
    for (int i = ltid(); i < 5 * 512; i += NTHREADS) { const int k = i >> 9, ch = i & 511, cc = (ch < 256) ? g * 256 + ch : (ch < 384) ? 2048 + g * 128 + (ch - 256) : 3072 + g * 128 + (ch - 384); tab[i] = (k < 4) ? cw[(size_t)k * CONVD + cc] : cb[cc]; }
    __syncthreads();
}
__device__ __forceinline__ void conv_load_run(const bf16* __restrict__ ZX, int Rrow, int c0, int pk, bool valid, u32x4 (&raw)[11]) {
#pragma unroll
    for (int t = 0; t < 8; ++t) { raw[3 + t] = (u32x4){0u, 0u, 0u, 0u}; if (valid) raw[3 + t] = *(const u32x4*)(ZX + (size_t)(Rrow + t) * ZXW + 2048 + c0); }
#pragma unroll
    for (int t = 0; t < 3; ++t) { const int rr = (pk == 1) ? ROW_M + 13 + t : Rrow - 3 + t; raw[t] = (u32x4){0u, 0u, 0u, 0u}; if (valid && pk != 2) raw[t] = *(const u32x4*)(ZX + (size_t)rr * ZXW + 2048 + c0); }
}
template <int J> __device__ __forceinline__ void conv_channel(const u32x4 (&raw)[11], const ConvW& W, float (&o)[8]) {
    float x[11];
#pragma unroll
    for (int i = 0; i < 11; ++i) { const unsigned w = raw[i][J >> 1]; x[i] = (J & 1) ? bfhi(w) : bflo(w); }
#pragma unroll
    for (int t = 0; t < 8; ++t) { const float v = W.bs[J] + W.w0[J] * x[t] + W.w1[J] * x[t + 1] + W.w2[J] * x[t + 2] + W.w3[J] * x[t + 3]; o[t] = v * sigmoid_f(v); }
}
template <int J> __device__ __forceinline__ void conv_store_t(const u32x4 (&raw)[11], const ConvW& W, const float (&scale)[8], bf16* T, int ch0, int run) {
    float o[8]; conv_channel<J>(raw, W, o);
    u32x4 w; w.x = pkbf(o[0] * scale[0], o[1] * scale[1]); w.y = pkbf(o[2] * scale[2], o[3] * scale[3]); w.z = pkbf(o[4] * scale[4], o[5] * scale[5]); w.w = pkbf(o[6] * scale[6], o[7] * scale[7]);
    *(u32x4*)(T + (ch0 + J) * LDX + ((8 * run) ^ TSW(ch0 + J))) = w;
}
__device__ __forceinline__ void conv_item_t(const u32x4 (&raw)[11], const ConvW& W, const float (&scale)[8], bf16* T, int ch0, int run) {
    conv_store_t<0>(raw, W, scale, T, ch0, run); conv_store_t<1>(raw, W, scale, T, ch0, run); conv_store_t<2>(raw, W, scale, T, ch0, run); conv_store_t<3>(raw, W, scale, T, ch0, run);
    conv_store_t<4>(raw, W, scale, T, ch0, run); conv_store_t<5>(raw, W, scale, T, ch0, run); conv_store_t<6>(raw, W, scale, T, ch0, run); conv_store_t<7>(raw, W, scale, T, ch0, run);
}
__device__ __forceinline__ void conv_item_n(const u32x4 (&raw)[11], const ConvW& W, bf16* N, int run, int colel) {
    float p0[8], p1[8], p2[8]; unpack8(raw[0], p0); unpack8(raw[1], p1); unpack8(raw[2], p2);
#pragma unroll
    for (int t = 0; t < 8; ++t) { float x[8]; unpack8(raw[3 + t], x); float o[8];
#pragma unroll
        for (int j = 0; j < 8; ++j) { const float v = W.bs[j] + W.w0[j] * p0[j] + W.w1[j] * p1[j] + W.w2[j] * p2[j] + W.w3[j] * x[j]; o[j] = v * sigmoid_f(v); }
        u32x4 w; w.x = pkbf(o[0], o[1]); w.y = pkbf(o[2], o[3]); w.z = pkbf(o[4], o[5]); w.w = pkbf(o[6], o[7]);
        *(u32x4*)(N + (8 * run + t) * LDX + colel) = w;
#pragma unroll
        for (int j = 0; j < 8; ++j) { p0[j] = p1[j]; p1[j] = p2[j]; p2[j] = x[j]; } }
}
__device__ __forceinline__ void conv_state_out(const u32x4 (&raw)[11], float* __restrict__ dst  ) {
#pragma unroll
    for (int k = 0; k < 3; ++k) { float x[8]; unpack8(raw[8 + k], x); *(f32x4*)(dst + (size_t)k * CONVD) = (f32x4){x[0], x[1], x[2], x[3]}; *(f32x4*)(dst + (size_t)k * CONVD + 4) = (f32x4){x[4], x[5], x[6], x[7]}; }
}

__device__ __forceinline__ void ssd_acs(const float* DT, const float* alog, int R0, int len, int h0, float* s_dt, float* s_acs, float* s_dve, int wave, int lane) {
    if (wave < 4) {
        const int r = wave; const float An = -__expf(alog[h0 + r]);
        const int l0 = 2 * lane;
        const float d0 = (l0 < len) ? DT[(size_t)(R0 + l0) * 32 + h0 + r] : 0.f;
        const float d1 = (l0 + 1 < len) ? DT[(size_t)(R0 + l0 + 1) * 32 + h0 + r] : 0.f;
        const float a0 = d0 * An, a1 = d1 * An, s = a0 + a1;
        float incl = s;
#pragma unroll
        for (int o = 1; o < 64; o <<= 1) { const float t = __shfl_up(incl, o); if (lane >= o) incl += t; }
        const float excl = incl - s;
        s_dt[r * 128 + l0] = d0; s_dt[r * 128 + l0 + 1] = d1;
        s_acs[r * 128 + l0] = excl + a0; s_acs[r * 128 + l0 + 1] = excl + s;
        if (s_dve) { const float te = __shfl(excl + s, lane | 7); s_dve[r * 128 + l0] = d0 * __expf(te - (excl + a0)); s_dve[r * 128 + l0 + 1] = d1 * __expf(te - (excl + s)); }
    }
}
#define LFRAG(base, row, ld, ks) (*(const bf16x8*)((base) + (row) * (ld) + 32 * (ks) + 8 * fq))

__device__ __forceinline__ void ssd1_unit(ArgsP a, int li, unsigned char* lds, int slot, int g, int R0, int len, int, int, int) {
    const int tid = ltid(), lane = tid & 63, wave = __builtin_amdgcn_readfirstlane(tid >> 6);
    const float* __restrict__ DT = (const float*)(a->ws + WS_DT);
    bf16* __restrict__ CS = (bf16*)(a->ws + WS_CS); float* __restrict__ CD = (float*)(a->ws + WS_CD);
    bf16* XsT = (bf16*)lds;
    bf16* BT = (bf16*)(lds + 256 * LDX * 2);
    float* s_dt = (float*)(lds + 384 * LDX * 2); float* s_acs = s_dt + 512;
    const int fr = lane & 15, fq = lane >> 4, h0 = g * 4;
    const float* __restrict__ cw = a->in[I_ACONVW] + (size_t)li * 4 * CONVD; const float* __restrict__ cbias = a->in[I_ACONVB] + (size_t)li * CONVD;
    const bf16* __restrict__ ZX = (const bf16*)(a->ws + WS_ZX);
    const bool meta = (slot == 128), chunk0 = (!meta && (slot & 63) == 0);
    const int xcb = tid & 31, xrun = tid >> 5, xc0 = g * 256 + xcb * 8;
    const int bcb = tid & 15, brun = (tid >> 4) & 15, bc0 = 2048 + g * 128 + bcb * 8;
    u32x4 rx[11], rb[11];
    conv_load_run(ZX, R0 + 8 * xrun, xc0, (xrun == 0) ? (meta ? 2 : (chunk0 ? 1 : 0)) : 0, 8 * xrun < len, rx);
    if (tid >= 256) conv_load_run(ZX, R0 + 8 * brun, bc0, (brun == 0) ? (meta ? 2 : (chunk0 ? 1 : 0)) : 0, 8 * brun < len, rb);
    ssd_acs(DT, a->in[I_ALOG] + li * NHEADS, R0, len, h0, s_dt, s_acs, nullptr, wave, lane);
    if (tid >= 256) { ConvW W; conv_load_w_lds(lds, 256 + bcb * 8, W); const float one[8] = {1.f, 1.f, 1.f, 1.f, 1.f, 1.f, 1.f, 1.f}; conv_item_t(rb, W, one, BT, bcb * 8, brun); }
    __syncthreads();
    {   ConvW W; conv_load_w_lds(lds, xcb * 8, W);
        const int r = xcb >> 3; const float tot = s_acs[r * 128 + 127];
        const f32x4 a0 = *(const f32x4*)(s_acs + r * 128 + 8 * xrun), a1 = *(const f32x4*)(s_acs + r * 128 + 8 * xrun + 4), d0 = *(const f32x4*)(s_dt + r * 128 + 8 * xrun), d1 = *(const f32x4*)(s_dt + r * 128 + 8 * xrun + 4);
        float wl[8];
#pragma unroll
        for (int t = 0; t < 4; ++t) { wl[t] = __expf(tot - a0[t]) * d0[t]; wl[4 + t] = __expf(tot - a1[t]) * d1[t]; }
        conv_item_t(rx, W, wl, XsT, xcb * 8, xrun);
    }
    __syncthreads();
    f32x4 acc[2][8];
#pragma unroll
    for (int mi = 0; mi < 2; ++mi)
#pragma unroll
        for (int ni = 0; ni < 8; ++ni) acc[mi][ni] = (f32x4){0.f, 0.f, 0.f, 0.f};
#pragma unroll
    for (int ks = 0; ks < 4; ++ks) {
        const int ra0 = 32 * wave + fr, ra1 = ra0 + 16;
        const bf16x8 a0 = *(const bf16x8*)(XsT + ra0 * LDX + ((32 * ks + 8 * fq) ^ TSW(ra0))), a1 = *(const bf16x8*)(XsT + ra1 * LDX + ((32 * ks + 8 * fq) ^ TSW(ra1)));
#pragma unroll
        for (int ni = 0; ni < 8; ++ni) { const int rb = 16 * ni + fr; const bf16x8 bb = *(const bf16x8*)(BT + rb * LDX + ((32 * ks + 8 * fq) ^ TSW(rb)));
            acc[0][ni] = MFMA16(bb, a0, acc[0][ni]); acc[1][ni] = MFMA16(bb, a1, acc[1][ni]); }
    }
#pragma unroll
    for (int mi = 0; mi < 2; ++mi) { const int hp = 32 * wave + 16 * mi + fr, r = hp >> 6, p = hp & 63;
        bf16* dst = CS + ((size_t)(slot * 32 + h0 + r) * 64 + p) * 128 + 4 * fq;
#pragma unroll
        for (int ni = 0; ni < 8; ++ni) { u32x2 w; w.x = pkbf(acc[mi][ni][0], acc[mi][ni][1]); w.y = pkbf(acc[mi][ni][2], acc[mi][ni][3]); *(u32x2*)(dst + 16 * ni) = w; } }
    if (tid < 4) CD[slot * 32 + h0 + tid] = __expf(s_acs[tid * 128 + 127]);
    __syncthreads();
}

__device__ __forceinline__ void ssd_sample_issue(ArgsP a, int li, int b, int g, f32x4 (&st)[4][4]) {
    const int tid = ltid(), p = tid >> 3, nb = tid & 7;
    const float* __restrict__ sin_ = a->in[I_SSSM] + ((size_t)((li * NSAMP + b) * NHEADS + g * 4) * 64 + p) * 128 + 4 * nb;
#pragma unroll
    for (int r = 0; r < 4; ++r)
#pragma unroll
        for (int kk = 0; kk < 4; ++kk) st[r][kk] = __builtin_nontemporal_load((const f32x4*)(sin_ + (size_t)r * 8192 + 32 * kk));
}
__device__ __forceinline__ void ssd_sample_unit(ArgsP a, int li, unsigned char* lds, int b, int g, f32x4 (&st)[4][4]) {
    const int tid = ltid(), lane = tid & 63, wave = __builtin_amdgcn_readfirstlane(tid >> 6);
    const bf16* __restrict__ ZX = (const bf16*)(a->ws + WS_ZX); const float* __restrict__ DT = (const float*)(a->ws + WS_DT); bf16* __restrict__ YN = (bf16*)(a->ws + WS_YN);
    float* sX = (float*)lds; float* sB = sX + 8 * 256; float* sC = sB + 8 * 128; float* sY = sC + 8 * 128; float* sDt = sY + 8 * 256;
    const int R0 = ROW_S + b * 8, h0 = g * 4;
    const int p = tid >> 3, nb = tid & 7;
    float* __restrict__ sout = a->out + O_SSSM + ((size_t)((li * NSAMP + b) * NHEADS + h0) * 64 + p) * 128 + 4 * nb;
    {
        const float* __restrict__ cw = a->in[I_ACONVW] + (size_t)li * 4 * CONVD; const float* __restrict__ cbias = a->in[I_ACONVB] + (size_t)li * CONVD;
        const int t = tid >> 6, ck = tid & 63;
        const int c0 = (ck < 32) ? g * 256 + ck * 8 : (ck < 48) ? 2048 + g * 128 + (ck - 32) * 8 : 3072 + g * 128 + (ck - 48) * 8;
        float* dst = (ck < 32) ? sX + t * 256 + ck * 8 : (ck < 48) ? sB + t * 128 + (ck - 32) * 8 : sC + t * 128 + (ck - 48) * 8;
        const float* __restrict__ sc = a->in[I_SCONV] + ((size_t)(li * NSAMP + b) * 3) * CONVD + c0;
        float xr[4][8];
#pragma unroll
        for (int k = 0; k < 4; ++k) { const int tt = t - 3 + k;
            if (tt >= 0) unpack8(*(const u32x4*)(ZX + (size_t)(R0 + tt) * ZXW + 2048 + c0), xr[k]); else ld8f(sc + (size_t)(tt + 3) * CONVD, xr[k]); }
        ConvW W; conv_load_w_lds(lds, (ck < 32) ? ck * 8 : (ck < 48) ? 256 + (ck - 32) * 8 : 384 + (ck - 48) * 8, W);
        float o[8];
#pragma unroll
        for (int j = 0; j < 8; ++j) { const float v = W.bs[j] + W.w0[j] * xr[0][j] + W.w1[j] * xr[1][j] + W.w2[j] * xr[2][j] + W.w3[j] * xr[3][j]; o[j] = v * sigmoid_f(v); }
        *(f32x4*)dst = (f32x4){o[0], o[1], o[2], o[3]}; *(f32x4*)(dst + 4) = (f32x4){o[4], o[5], o[6], o[7]};
        if (t >= 5) { float* __restrict__ so = a->out + O_SCONV + ((size_t)(li * NSAMP + b) * 3 + (t - 5)) * CONVD + c0;
            *(f32x4*)so = (f32x4){xr[3][0], xr[3][1], xr[3][2], xr[3][3]}; *(f32x4*)(so + 4) = (f32x4){xr[3][4], xr[3][5], xr[3][6], xr[3][7]}; }
    }
    if (tid < 32) { const float d = DT[(size_t)(R0 + (tid >> 2)) * 32 + h0 + (tid & 3)]; sDt[tid] = d; sDt[32 + tid] = __expf(-d * __expf(a->in[I_ALOG][li * NHEADS + h0 + (tid & 3)])); }
    __syncthreads();
    float Dk[4];
#pragma unroll
    for (int r = 0; r < 4; ++r) Dk[r] = a->in[I_ADSKIP][li * NHEADS + h0 + r];
    float part[8][4];
#pragma unroll
    for (int t = 0; t < 8; ++t) {
        f32x4 bv[4], cv[4];
#pragma unroll
        for (int kk = 0; kk < 4; ++kk) { bv[kk] = *(const f32x4*)(sB + t * 128 + 32 * kk + 4 * nb); cv[kk] = *(const f32x4*)(sC + t * 128 + 32 * kk + 4 * nb); }
#pragma unroll
        for (int r = 0; r < 4; ++r) {
            const float dt = sDt[t * 4 + r], dA = sDt[32 + t * 4 + r], xv = sX[t * 256 + r * 64 + p], coef = dt * xv;
            f32x4 pv = (f32x4){0.f, 0.f, 0.f, 0.f};
#pragma unroll
            for (int kk = 0; kk < 4; ++kk) { st[r][kk] = st[r][kk] * dA + bv[kk] * coef; pv = pv + cv[kk] * st[r][kk]; }
            part[t][r] = (pv.x + pv.y) + (pv.z + pv.w);
        }
    }
#pragma unroll
    for (int r = 0; r < 4; ++r)
#pragma unroll
        for (int kk = 0; kk < 4; ++kk) __builtin_nontemporal_store(st[r][kk], (f32x4*)(sout + (size_t)r * 8192 + 32 * kk));
#pragma unroll
    for (int t = 0; t < 8; ++t)
#pragma unroll
        for (int r = 0; r < 4; ++r) { float v = part[t][r]; v += dpp_f(v, 0xB1); v += dpp_f(v, 0x4E); v += dpp_f(v, 0x141); part[t][r] = v; }
    if (nb == 0) {
#pragma unroll
        for (int t = 0; t < 8; ++t)
#pragma unroll
            for (int r = 0; r < 4; ++r) sY[t * 256 + r * 64 + p] = part[t][r] + Dk[r] * sX[t * 256 + r * 64 + p];
    }
    __syncthreads();
    {
        const int t = wave, c4 = lane * 4; const size_t row = (size_t)(R0 + t);
        const f32x4 y = *(const f32x4*)(sY + t * 256 + c4);
        const u32x2 zz = *(const u32x2*)(ZX + row * ZXW + g * 256 + c4);
        const float z0 = bflo(zz.x), z1 = bfhi(zz.x), z2 = bflo(zz.y), z3 = bfhi(zz.y);
        const float g0 = y.x * z0 * sigmoid_f(z0), g1 = y.y * z1 * sigmoid_f(z1), g2 = y.z * z2 * sigmoid_f(z2), g3 = y.w * z3 * sigmoid_f(z3);
        const float ss = wave_sum((g0 * g0 + g1 * g1) + (g2 * g2 + g3 * g3));
        const float rs = rsqrtf(ss * (1.f / 256.f) + EPS);
        u32x2 o; o.x = pkbf(g0 * rs, g1 * rs); o.y = pkbf(g2 * rs, g3 * rs);
        *(u32x2*)(YN + row * DINNER + g * 256 + c4) = o;
    }
    __syncthreads();
}

__device__ __forceinline__ void phase_scan(ArgsP a, int li) {
    const bf16* __restrict__ CS = (const bf16*)(a->ws + WS_CS); const float* __restrict__ CD = (const float*)(a->ws + WS_CD); bf16* __restrict__ HSB = (bf16*)(a->ws + WS_HSB);
    const int gt = blockIdx.x * NTHREADS + ltid(), NT = gridDim.x * NTHREADS;
    for (int e = gt; e < 2 * 65536; e += NT) {
        const int b = e >> 16, rem = e & 65535, h = rem >> 11, pn4 = rem & 2047;
        f32x4 hc; { const u32x2 w0 = *(const u32x2*)(CS + ((size_t)(128 * 32 + h) * 2048 + pn4) * 4); hc = (f32x4){bflo(w0.x), bfhi(w0.x), bflo(w0.y), bfhi(w0.y)}; }
#pragma unroll 1
        for (int c0 = 0; c0 < 64; c0 += 16) {
            u32x2 sw[16]; float dd[16];
#pragma unroll
            for (int k = 0; k < 16; ++k) { const int slot = b * 64 + c0 + k; sw[k] = __builtin_nontemporal_load((const u32x2*)(CS + ((size_t)(slot * 32 + h) * 2048 + pn4) * 4)); dd[k] = CD[slot * 32 + h]; }
#pragma unroll
            for (int k = 0; k < 16; ++k) { const int slot = b * 64 + c0 + k; const size_t o = ((size_t)(slot * 32 + h) * 2048 + pn4) * 4;
                const f32x4 sv = (f32x4){bflo(sw[k].x), bfhi(sw[k].x), bflo(sw[k].y), bfhi(sw[k].y)};
                u32x2 w; w.x = pkbf(hc.x, hc.y); w.y = pkbf(hc.z, hc.w); *(u32x2*)(HSB + o) = w;
                hc = hc * dd[k] + sv; }
        }
        __builtin_nontemporal_store(hc, (f32x4*)(a->out + O_PSSM + ((size_t)((li * NPROMPT + b) * NHEADS + h) * 2048 + pn4) * 4));
    }
}

__device__ __forceinline__ void ssd3_head(int r, int hb, const bf16* Cn, const bf16* BH, const bf16* xb, const bf16* xd, const float* s_dt, const float* s_acs, const float* s_dve, const f32x4 (&cb)[8], const f32x4 cbd, f32x4 (&acc)[4],
                                          const bf16* __restrict__ ZX, size_t row, int g, float Dk, int l, int wave, int fr, int fq, float& ss) {
    u32x2 zz[4];
#pragma unroll
    for (int ni = 0; ni < 4; ++ni) { const int ch = g * 256 + r * 64 + 16 * ni + 4 * fq; zz[ni] = __builtin_nontemporal_load((const u32x2*)(ZX + row * ZXW + ch)); }
    const float al = s_acs[r * 128 + l];
#pragma unroll
    for (int ni = 0; ni < 4; ++ni) acc[ni] = (f32x4){0.f, 0.f, 0.f, 0.f};
    const bf16* Hs = BH + hb * 64 * LDX;
#pragma unroll
    for (int ks = 0; ks < 4; ++ks) { const bf16x8 af = LFRAG(Cn, l, LDX, ks);
#pragma unroll
        for (int ni = 0; ni < 4; ++ni) { const bf16x8 bb = LFRAG(Hs, 16 * ni + fr, LDX, ks); acc[ni] = MFMA16(bb, af, acc[ni]); } }
    const float e = __expf(al);
#pragma unroll
    for (int ni = 0; ni < 4; ++ni) acc[ni] = acc[ni] * e;
    float md[4];
    { const f32x4 av = *(const f32x4*)(s_acs + r * 128 + 16 * wave + 4 * fq), dv = *(const f32x4*)(s_dt + r * 128 + 16 * wave + 4 * fq);
#pragma unroll
        for (int j = 0; j < 4; ++j) md[j] = (4 * fq + j <= fr) ? cbd[j] * __expf(al - av[j]) * dv[j] : 0.f; }
#pragma unroll
    for (int ks = 0; ks < 4; ++ks) if (2 * ks <= wave) {
        unsigned mw[4];
#pragma unroll
        for (int hf = 0; hf < 2; ++hf) { const int ni = 2 * ks + hf, s0 = 16 * ni + 4 * fq;
            const float ex = __expf(fminf(al - s_acs[r * 128 + 16 * ni + 15], 0.f)), rowf = (ni < wave) ? ex : 0.f;
            const f32x4 dv = *(const f32x4*)(s_dve + r * 128 + s0);
            float m[4];
#pragma unroll
            for (int j = 0; j < 4; ++j) { const float t = cb[ni][j] * (rowf * dv[j]); m[j] = (ni == wave) ? md[j] : t; }
            mw[2 * hf] = pkbf(m[0], m[1]); mw[2 * hf + 1] = pkbf(m[2], m[3]); }
        const u32x4 afu = (u32x4){mw[0], mw[1], mw[2], mw[3]};
        const bf16x8 af = __builtin_bit_cast(bf16x8, afu);
#pragma unroll
        for (int ni = 0; ni < 4; ++ni) { const bf16* xp = xb + (r * 64 + 16 * ni) * LDX;
            const u32x2 b0 = *(const u32x2*)(xp + ((32 * ks) ^ (16 * ni))), b1 = *(const u32x2*)(xp + ((32 * ks + 16) ^ (16 * ni)));
            const u32x4 bu = (u32x4){b0.x, b0.y, b1.x, b1.y};
            acc[ni] = MFMA16(__builtin_bit_cast(bf16x8, bu), af, acc[ni]); }
    }
#pragma unroll
    for (int ni = 0; ni < 4; ++ni) {
        const bf16* xp = xd + (r * 64 + 16 * ni) * LDX + 16 * (wave ^ ni);
        float xv[4];
#pragma unroll
        for (int j = 0; j < 4; ++j) xv[j] = bf2f(xp[j * LDX]);
        const float zv[4] = {bflo(zz[ni].x), bfhi(zz[ni].x), bflo(zz[ni].y), bfhi(zz[ni].y)};
#pragma unroll
        for (int j = 0; j < 4; ++j) { const float q = (acc[ni][j] + Dk * xv[j]) * zv[j] * sigmoid_f(zv[j]); acc[ni][j] = q; ss += q * q; } }
}
__device__ __forceinline__ void ssd3_unit(ArgsP a, int li, unsigned char* lds, const bf16* __restrict__ hs, int slot, int g, int R0, int len, u32x4 (&rx)[11], int nslot, int nR0) {
    const int tid = ltid(), lane = tid & 63, wave = __builtin_amdgcn_readfirstlane(tid >> 6);
    const bf16* __restrict__ ZX = (const bf16*)(a->ws + WS_ZX); const float* __restrict__ DT = (const float*)(a->ws + WS_DT); bf16* __restrict__ YN = (bf16*)(a->ws + WS_YN);
    bf16* Cn = (bf16*)lds; bf16* BH = Cn + 128 * LDX; bf16* Xt = BH + 128 * LDX;
    float* s_dt = (float*)(Xt + 256 * LDX); float* s_acs = s_dt + 512; float* s_dve = s_acs + 512;
    const int fr = lane & 15, fq = lane >> 4, h0 = g * 4;
    {
        const float* __restrict__ cw = a->in[I_ACONVW] + (size_t)li * 4 * CONVD; const float* __restrict__ cbias = a->in[I_ACONVB] + (size_t)li * CONVD;
        const bool meta = (slot == 128), chunk0 = (!meta && (slot & 63) == 0);
        const int half = tid >> 8, ncb = tid & 15, nrun = (tid >> 4) & 15, nc0 = (half ? 2048 : 3072) + g * 128 + ncb * 8;
        const int xcb = tid & 31, xrun = tid >> 5, xc0 = g * 256 + xcb * 8;
        u32x4 rn[11];
        conv_load_run(ZX, R0 + 8 * nrun, nc0, (nrun == 0) ? (meta ? 2 : (chunk0 ? 1 : 0)) : 0, 8 * nrun < len, rn);
        ssd_acs(DT, a->in[I_ALOG] + li * NHEADS, R0, len, h0, s_dt, s_acs, s_dve, wave, lane);
        { ConvW W; conv_load_w_lds(lds, (half ? 256 : 384) + ncb * 8, W); conv_item_n(rn, W, half ? BH : Cn, nrun, ncb * 8); }
        { ConvW W; conv_load_w_lds(lds, xcb * 8, W); const float one[8] = {1.f, 1.f, 1.f, 1.f, 1.f, 1.f, 1.f, 1.f}; conv_item_t(rx, W, one, Xt, xcb * 8, xrun); }
        if (!meta && (slot & 63) == 63) {
            float* __restrict__ dst = a->out + O_PCONV + (size_t)((li * NPROMPT + (slot >> 6)) * 3) * CONVD;
            if (nrun == 15) conv_state_out(rn, dst + nc0);
            if (xrun == 15) conv_state_out(rx, dst + xc0);
        }
    }
    __syncthreads();
    u32x2 hv[8];
#pragma unroll
    for (int k = 0; k < 8; ++k) { const int item = tid + NTHREADS * k; hv[k] = (u32x2){0u, 0u}; if (hs) hv[k] = __builtin_nontemporal_load((const u32x2*)(hs + (size_t)item * 4)); }
    const bool active = (16 * wave < len);
    f32x4 cb[8];
#pragma unroll
    for (int ni = 0; ni < 8; ++ni) cb[ni] = (f32x4){0.f, 0.f, 0.f, 0.f};
    if (active) {
#pragma unroll
    for (int ks = 0; ks < 4; ++ks) { const bf16x8 af = LFRAG(Cn, 16 * wave + fr, LDX, ks);
#pragma unroll
        for (int ni = 0; ni < 8; ++ni) { const bf16x8 bb = LFRAG(BH, 16 * ni + fr, LDX, ks); cb[ni] = MFMA16(bb, af, cb[ni]); } }
    }
    __syncthreads();
#pragma unroll
    for (int k = 0; k < 8; ++k) { const int item = tid + NTHREADS * k, hp = item >> 5, n4 = item & 31; *(u32x2*)(BH + hp * LDX + n4 * 4) = hv[k]; }
#pragma unroll
    for (int k = 0; k < 8; ++k) { const int item = tid + NTHREADS * k; hv[k] = (u32x2){0u, 0u}; if (hs) hv[k] = __builtin_nontemporal_load((const u32x2*)(hs + (size_t)(2 * 8192) + (size_t)item * 4)); }
    __syncthreads();
    const int l = 16 * wave + fr;
    const size_t row = (size_t)(R0 + ((l < len) ? l : 0));
    f32x4 y0[4], y1[4], y2[4], y3[4];
    float ss = 0.f;
    const float* dsk = a->in[I_ADSKIP] + li * NHEADS + h0;
    f32x4 cbd = cb[0];
#pragma unroll
    for (int ni = 1; ni < 8; ++ni) cbd = (ni == wave) ? cb[ni] : cbd;
    const bf16* xb = Xt + fr * LDX + ((4 * fq) ^ (8 * (fr >> 3))); const bf16* xd = Xt + (4 * fq) * LDX + (fr ^ (8 * (fq >> 1)));
    if (active) {
    ssd3_head(0, 0, Cn, BH, xb, xd, s_dt, s_acs, s_dve, cb, cbd, y0, ZX, row, g, dsk[0], l, wave, fr, fq, ss);
    ssd3_head(1, 1, Cn, BH, xb, xd, s_dt, s_acs, s_dve, cb, cbd, y1, ZX, row, g, dsk[1], l, wave, fr, fq, ss);
    }
    u32x2 p0[4], p1[4];
#pragma unroll
    for (int ni = 0; ni < 4; ++ni) { p0[ni].x = pkbf(y0[ni][0], y0[ni][1]); p0[ni].y = pkbf(y0[ni][2], y0[ni][3]); p1[ni].x = pkbf(y1[ni][0], y1[ni][1]); p1[ni].y = pkbf(y1[ni][2], y1[ni][3]); }
    __syncthreads();
#pragma unroll
    for (int k = 0; k < 8; ++k) { const int item = tid + NTHREADS * k, hp = item >> 5, n4 = item & 31; *(u32x2*)(BH + hp * LDX + n4 * 4) = hv[k]; }
    if (nslot >= 0) { const int xcb = tid & 31, xrun = tid >> 5; conv_load_run(ZX, nR0 + 8 * xrun, g * 256 + xcb * 8, (xrun == 0 && (nslot & 63) == 0) ? 1 : 0, true, rx); }
    __syncthreads();
    if (active) {
    ssd3_head(2, 0, Cn, BH, xb, xd, s_dt, s_acs, s_dve, cb, cbd, y2, ZX, row, g, dsk[2], l, wave, fr, fq, ss);
    ssd3_head(3, 1, Cn, BH, xb, xd, s_dt, s_acs, s_dve, cb, cbd, y3, ZX, row, g, dsk[3], l, wave, fr, fq, ss);
    ss += __shfl_xor(ss, 16); ss += __shfl_xor(ss, 32);
    }
    const float rs = rsqrtf(ss * (1.f / 256.f) + EPS);
    if (active && l < len) {
        bf16* yrow = YN + row * DINNER + g * 256 + 4 * fq;
#pragma unroll
        for (int ni = 0; ni < 4; ++ni) {
            u32x2 w;
            w.x = pkbf(bflo(p0[ni].x) * rs, bfhi(p0[ni].x) * rs); w.y = pkbf(bflo(p0[ni].y) * rs, bfhi(p0[ni].y) * rs); *(u32x2*)(yrow + 0 * 64 + 16 * ni) = w;
            w.x = pkbf(bflo(p1[ni].x) * rs, bfhi(p1[ni].x) * rs); w.y = pkbf(bflo(p1[ni].y) * rs, bfhi(p1[ni].y) * rs); *(u32x2*)(yrow + 1 * 64 + 16 * ni) = w;
            w.x = pkbf(y2[ni][0] * rs, y2[ni][1] * rs); w.y = pkbf(y2[ni][2] * rs, y2[ni][3] * rs); *(u32x2*)(yrow + 2 * 64 + 16 * ni) = w;
            w.x = pkbf(y3[ni][0] * rs, y3[ni][1] * rs); w.y = pkbf(y3[ni][2] * rs, y3[ni][3] * rs); *(u32x2*)(yrow + 3 * 64 + 16 * ni) = w;
        }
    }
    __syncthreads();
}
__device__ __forceinline__ void phase_ssd1(ArgsP a, int li, unsigned char* lds, int tid, int wave, int lane) {
    const int c = blockIdx.x;
    conv_fill_table(a->in[I_ACONVW] + (size_t)li * 4 * CONVD, a->in[I_ACONVB] + (size_t)li * CONVD, lds, c & 7);
#pragma unroll 1
    for (int j = 0; j < 4; ++j) {
        const int u = c + 256 * j;
        f32x4 st[4][4];
        ssd_sample_issue(a, li, u >> 3, u & 7, st);
#ifndef PROBE_SSD1
#define PROBE_SSD1 0
#endif
#pragma unroll 1
        for (int rp = 0; rp < (PROBE_SSD1 == 1 ? 2 : 1); ++rp) { const int slot = u >> 3, g = u & 7; ssd1_unit(a, li, lds, slot, g, (slot >> 6) * SEQ + (slot & 63) * 128, 128, tid, wave, lane); }
        ssd_sample_unit(a, li, lds, u >> 3, u & 7, st);
    }
    if (c < 8) ssd1_unit(a, li, lds, 128, c, ROW_M, NMETA, tid, wave, lane);
    else if (c < 16) { u32x4 rx[11]; { const bf16* ZX = (const bf16*)(a->ws + WS_ZX); const int t_ = ltid(), xcb = t_ & 31, xrun = t_ >> 5; conv_load_run(ZX, ROW_M + 8 * xrun, (c - 8) * 256 + xcb * 8, (xrun == 0) ? 2 : 0, 8 * xrun < NMETA, rx); }
        ssd3_unit(a, li, lds, nullptr, 128, c - 8, ROW_M, NMETA, rx, -1, 0); }
}
__device__ __forceinline__ void phase_ssd3(ArgsP a, int li, unsigned char* lds, int tid, int wave, int lane) {
    const bf16* HSB = (const bf16*)(a->ws + WS_HSB);
#ifdef PROBE_STAGGER
    if (blockIdx.x & 1) { const unsigned long long t0 = __builtin_amdgcn_s_memrealtime(); while (__builtin_amdgcn_s_memrealtime() - t0 < PROBE_STAGGER) __builtin_amdgcn_s_sleep(8); }
#endif
    u32x4 rx[11];
    conv_fill_table(a->in[I_ACONVW] + (size_t)li * 4 * CONVD, a->in[I_ACONVB] + (size_t)li * CONVD, lds, (int)blockIdx.x & 7);
    { const bf16* ZX = (const bf16*)(a->ws + WS_ZX); const int u = blockIdx.x, slot = u >> 3, g = u & 7, t_ = ltid(), xcb = t_ & 31, xrun = t_ >> 5;
      conv_load_run(ZX, (slot >> 6) * SEQ + (slot & 63) * 128 + 8 * xrun, g * 256 + xcb * 8, (xrun == 0 && (slot & 63) == 0) ? 1 : 0, true, rx); }
#pragma unroll 1
    for (int u = blockIdx.x; u < 1024; u += 256) { const int slot = u >> 3, g = u & 7, un = u + 256, nslot = (un < 1024) ? (un >> 3) : -1;
        ssd3_unit(a, li, lds, HSB + (size_t)(slot * 32 + g * 4) * 8192, slot, g, (slot >> 6) * SEQ + (slot & 63) * 128, 128, rx, nslot, (nslot >> 6) * SEQ + (nslot & 63) * 128); }
}

constexpr int KS_LD = 72, VT_LD = 264, P_LD = 232, NKEYS = 208;
__device__ __forceinline__ void attn_prompt_unit(ArgsP a, int lj, unsigned char* lds, int b, int kvh, int qb, int, int, int) {
    const int tid = ltid(), lane = tid & 63, wave = __builtin_amdgcn_readfirstlane(tid >> 6);
    const bf16* __restrict__ Q = (const bf16*)(a->ws + WS_Q); const bf16* __restrict__ KV = (const bf16*)(a->ws + WS_KV); bf16* __restrict__ AO = (bf16*)(a->ws + WS_AO);
    bf16* Ks = (bf16*)lds; bf16* Vt = Ks + NKEYS * KS_LD; bf16* Pw = Vt + 64 * VT_LD + wave * 16 * P_LD;
    const int fr = lane & 15, fq = lane >> 4, t0 = qb * 64, Rb = b * SEQ;
    const int r = wave >> 1, th = (wave & 1) * 32, qh = kvh * 4 + r;
    bf16x8 q0[2], q1[2];
#pragma unroll
    for (int ks = 0; ks < 2; ++ks) { q0[ks] = *(const bf16x8*)(Q + (size_t)(Rb + t0 + th + fr) * DM + qh * 64 + 32 * ks + 8 * fq); q1[ks] = *(const bf16x8*)(Q + (size_t)(Rb + t0 + th + 16 + fr) * DM + qh * 64 + 32 * ks + 8 * fq); }
    {
        u32x4 kv[4];
#pragma unroll
        for (int k = 0; k < 4; ++k) { const int it = tid + NTHREADS * k, key = it >> 3, ch = it & 7; kv[k] = (u32x4){0u, 0u, 0u, 0u};
            if (it < NKEYS * 8) { int row; if (key < 16) row = ROW_M + key; else { int s = t0 - 128 + key - 16; if (s < 0) s = 0; row = Rb + s; }
                kv[k] = *(const u32x4*)(KV + (size_t)row * KVW + kvh * 64 + ch * 8); } }
        u32x4 v0[2], v1[2];
#pragma unroll
        for (int k = 0; k < 2; ++k) { const int it = tid + NTHREADS * k, dbl = it & 7, kp = it >> 3; v0[k] = (u32x4){0u, 0u, 0u, 0u}; v1[k] = v0[k];
            if (it < (NKEYS / 2) * 8) { const int k0 = 2 * kp, k1 = k0 + 1; int s0 = t0 - 128 + k0 - 16, s1 = t0 - 128 + k1 - 16; if (s0 < 0) s0 = 0; if (s1 < 0) s1 = 0;
                const int r0 = (k0 < 16) ? ROW_M + k0 : Rb + s0, r1 = (k1 < 16) ? ROW_M + k1 : Rb + s1;
                v0[k] = *(const u32x4*)(KV + (size_t)r0 * KVW + 256 + kvh * 64 + dbl * 8); v1[k] = *(const u32x4*)(KV + (size_t)r1 * KVW + 256 + kvh * 64 + dbl * 8); } }
#pragma unroll
        for (int k = 0; k < 4; ++k) { const int it = tid + NTHREADS * k, key = it >> 3, ch = it & 7; if (it < NKEYS * 8) *(u32x4*)(Ks + key * KS_LD + ch * 8) = kv[k]; }
#pragma unroll
        for (int k = 0; k < 2; ++k) { const int it = tid + NTHREADS * k, dbl = it & 7, kp = it >> 3;
            if (it < (NKEYS / 2) * 8) { const int col = (2 * kp) ^ (8 * dbl);
                const unsigned a0[4] = {v0[k].x, v0[k].y, v0[k].z, v0[k].w}, a1[4] = {v1[k].x, v1[k].y, v1[k].z, v1[k].w};
#pragma unroll
                for (int j = 0; j < 4; ++j) {
                    *(unsigned*)(Vt + (dbl * 8 + 2 * j) * VT_LD + col) = (a0[j] & 0xffffu) | (a1[j] << 16);
                    *(unsigned*)(Vt + (dbl * 8 + 2 * j + 1) * VT_LD + col) = (a0[j] >> 16) | (a1[j] & 0xffff0000u); } } }
#pragma unroll
        for (int k = 0; k < 3; ++k) { const int idx = tid + NTHREADS * k, row = idx / 24, c = idx - row * 24; *(unsigned*)(Vt + row * VT_LD + ((NKEYS + 2 * c) ^ TSW(row))) = 0u; }
    }
    __syncthreads();
    const float sink = a->in[I_SINKS][lj * NQ + qh];
#pragma unroll 1
    for (int blk = 0; blk < 2; ++blk) {
        const int tq = th + blk * 16 + fr, t = t0 + tq;
        bf16x8 qa2[2];
#pragma unroll
        for (int ks = 0; ks < 2; ++ks) qa2[ks] = (blk == 0) ? q0[ks] : q1[ks];
        f32x4 sc[13];
#pragma unroll
        for (int ni = 0; ni < 13; ++ni) sc[ni] = (f32x4){0.f, 0.f, 0.f, 0.f};
#pragma unroll
        for (int ni = 0; ni < 13; ++ni) {
            const bf16x8 b0 = *(const bf16x8*)(Ks + (16 * ni + fr) * KS_LD + 8 * fq), b1 = *(const bf16x8*)(Ks + (16 * ni + fr) * KS_LD + 32 + 8 * fq);
            sc[ni] = MFMA16(b0, qa2[0], sc[ni]); sc[ni] = MFMA16(b1, qa2[1], sc[ni]);
            }
        int lo = tq + 17; { const int l2 = 144 - t0; if (l2 > lo) lo = l2; }
        const unsigned span = (unsigned)(tq + 144 - lo);
        float mx = -INFINITY;
#pragma unroll
        for (int ni = 0; ni < 13; ++ni)
#pragma unroll
            for (int j = 0; j < 4; ++j) { const int key = 16 * ni + 4 * fq + j; const bool vis = (ni == 0) || ((unsigned)(key - lo) <= span);
                const float v = vis ? sc[ni][j] * 0.125f : -INFINITY; sc[ni][j] = v; mx = fmaxf(mx, v); }
        mx = fmaxf(mx, __shfl_xor(mx, 16)); mx = fmaxf(mx, __shfl_xor(mx, 32)); mx = fmaxf(mx, sink);
        float sum = 0.f;
#pragma unroll
        for (int ni = 0; ni < 13; ++ni)
#pragma unroll
            for (int j = 0; j < 4; ++j) { const float p = __expf(sc[ni][j] - mx); sc[ni][j] = p; sum += p; }
        sum += __shfl_xor(sum, 16); sum += __shfl_xor(sum, 32); sum += __expf(sink - mx);
        const float inv = frcp(sum);
#pragma unroll
        for (int ni = 0; ni < 13; ++ni) { u32x2 w; w.x = pkbf(sc[ni][0] * inv, sc[ni][1] * inv); w.y = pkbf(sc[ni][2] * inv, sc[ni][3] * inv); *(u32x2*)(Pw + fr * P_LD + 16 * ni + 4 * fq) = w; }
        *(u32x2*)(Pw + fr * P_LD + NKEYS + 4 * fq) = (u32x2){0u, 0u};
        asm volatile("s_waitcnt lgkmcnt(0)" ::: "memory");
        f32x4 o[4];
#pragma unroll
        for (int ni = 0; ni < 4; ++ni) o[ni] = (f32x4){0.f, 0.f, 0.f, 0.f};
#pragma unroll
        for (int ks = 0; ks < 7; ++ks) { const bf16x8 af = *(const bf16x8*)(Pw + fr * P_LD + 32 * ks + 8 * fq);
#pragma unroll
            for (int ni = 0; ni < 4; ++ni) { const int vr = 16 * ni + fr; const bf16x8 bb = *(const bf16x8*)(Vt + vr * VT_LD + ((32 * ks + 8 * fq) ^ TSW(vr))); o[ni] = MFMA16(bb, af, o[ni]); }
            }
#pragma unroll
        for (int ni = 0; ni < 4; ++ni) { u32x2 w; w.x = pkbf(o[ni][0], o[ni][1]); w.y = pkbf(o[ni][2], o[ni][3]); *(u32x2*)(AO + (size_t)(Rb + t) * DM + qh * 64 + 16 * ni + 4 * fq) = w; }
        asm volatile("s_waitcnt lgkmcnt(0)" ::: "memory");
    }
    __syncthreads();
}
constexpr int SK_LD = 72, SV_LD = 200, SP_LD = 168, SKEYS = 160;
__device__ __forceinline__ void attn_sample_pair(ArgsP a, int lj, unsigned char* lds, int bp, int kvh, int, int, int) {
    const int tid = ltid(), lane = tid & 63, wave = __builtin_amdgcn_readfirstlane(tid >> 6);
    const bf16* __restrict__ Q = (const bf16*)(a->ws + WS_Q); const bf16* __restrict__ KV = (const bf16*)(a->ws + WS_KV); bf16* __restrict__ AO = (bf16*)(a->ws + WS_AO);
    const float* __restrict__ CK = a->in[I_CK]; const float* __restrict__ CV = a->in[I_CV];
    constexpr int HALF_B = (SKEYS * SK_LD + 64 * SV_LD) * 2;
    const int fr = lane & 15, fq = lane >> 4;
    {
        u32x4 r0[5], r1[5];
#pragma unroll
        for (int k = 0; k < 5; ++k) { const int it = tid + NTHREADS * k, hf = it / (SKEYS * 8), rem = it - hf * (SKEYS * 8), key = rem >> 3, ch = rem & 7, bb = 2 * bp + hf;
            r0[k] = (u32x4){0u, 0u, 0u, 0u}; r1[k] = r0[k];
            if (key < 16) r0[k] = *(const u32x4*)(KV + (size_t)(ROW_M + key) * KVW + kvh * 64 + ch * 8);
            else if (key < 144) { const float* p = CK + ((size_t)(bb * 128 + (key - 16)) * NKV + kvh) * 64 + ch * 8; r0[k] = __builtin_nontemporal_load((const u32x4*)p); r1[k] = __builtin_nontemporal_load((const u32x4*)(p + 4)); }
            else if (key < 152) r0[k] = *(const u32x4*)(KV + (size_t)(ROW_S + bb * 8 + (key - 144)) * KVW + kvh * 64 + ch * 8); }
#pragma unroll
        for (int k = 0; k < 5; ++k) { const int it = tid + NTHREADS * k, hf = it / (SKEYS * 8), rem = it - hf * (SKEYS * 8), key = rem >> 3, ch = rem & 7;
            bf16* Ks = (bf16*)(lds + hf * HALF_B);
            u32x4 w = r0[k];
            if (key >= 16 && key < 144) { w.x = pkbf(__uint_as_float(r0[k].x), __uint_as_float(r0[k].y)); w.y = pkbf(__uint_as_float(r0[k].z), __uint_as_float(r0[k].w)); w.z = pkbf(__uint_as_float(r1[k].x), __uint_as_float(r1[k].y)); w.w = pkbf(__uint_as_float(r1[k].z), __uint_as_float(r1[k].w)); }
            *(u32x4*)(Ks + key * SK_LD + ch * 8) = w; }
    }
    {
        u32x4 x0[3], x1[3], y0[3], y1[3];
#pragma unroll
        for (int k = 0; k < 3; ++k) { const int it = tid + NTHREADS * k, hf = it / (96 * 8), rem = it - hf * (96 * 8), dbl = rem & 7, kp = rem >> 3, bb = 2 * bp + hf, k0 = 2 * kp;
            x0[k] = (u32x4){0u, 0u, 0u, 0u}; x1[k] = x0[k]; y0[k] = x0[k]; y1[k] = x0[k];
            if (k0 < 16) { x0[k] = *(const u32x4*)(KV + (size_t)(ROW_M + k0) * KVW + 256 + kvh * 64 + dbl * 8); y0[k] = *(const u32x4*)(KV + (size_t)(ROW_M + k0 + 1) * KVW + 256 + kvh * 64 + dbl * 8); }
            else if (k0 < 144) { const float* p = CV + ((size_t)(bb * 128 + (k0 - 16)) * NKV + kvh) * 64 + dbl * 8;
                x0[k] = __builtin_nontemporal_load((const u32x4*)p); x1[k] = __builtin_nontemporal_load((const u32x4*)(p + 4)); y0[k] = __builtin_nontemporal_load((const u32x4*)(p + NKV * 64)); y1[k] = __builtin_nontemporal_load((const u32x4*)(p + NKV * 64 + 4)); }
            else if (k0 < 152) { x0[k] = *(const u32x4*)(KV + (size_t)(ROW_S + bb * 8 + (k0 - 144)) * KVW + 256 + kvh * 64 + dbl * 8); y0[k] = *(const u32x4*)(KV + (size_t)(ROW_S + bb * 8 + (k0 - 143)) * KVW + 256 + kvh * 64 + dbl * 8); } }
#pragma unroll
        for (int k = 0; k < 3; ++k) { const int it = tid + NTHREADS * k, hf = it / (96 * 8), rem = it - hf * (96 * 8), dbl = rem & 7, kp = rem >> 3, k0 = 2 * kp;
            bf16* Vt = (bf16*)(lds + hf * HALF_B) + SKEYS * SK_LD;
            unsigned a0[4] = {x0[k].x, x0[k].y, x0[k].z, x0[k].w}, a1[4] = {y0[k].x, y0[k].y, y0[k].z, y0[k].w};
            if (k0 >= 16 && k0 < 144) {
                a0[0] = pkbf(__uint_as_float(x0[k].x), __uint_as_float(x0[k].y)); a0[1] = pkbf(__uint_as_float(x0[k].z), __uint_as_float(x0[k].w)); a0[2] = pkbf(__uint_as_float(x1[k].x), __uint_as_float(x1[k].y)); a0[3] = pkbf(__uint_as_float(x1[k].z), __uint_as_float(x1[k].w));
                a1[0] = pkbf(__uint_as_float(y0[k].x), __uint_as_float(y0[k].y)); a1[1] = pkbf(__uint_as_float(y0[k].z), __uint_as_float(y0[k].w)); a1[2] = pkbf(__uint_as_float(y1[k].x), __uint_as_float(y1[k].y)); a1[3] = pkbf(__uint_as_float(y1[k].z), __uint_as_float(y1[k].w)); }
            const int col = (2 * kp) ^ (8 * dbl);
#pragma unroll
            for (int j = 0; j < 4; ++j) {
                *(unsigned*)(Vt + (dbl * 8 + 2 * j) * SV_LD + col) = (a0[j] & 0xffffu) | (a1[j] << 16);
                *(unsigned*)(Vt + (dbl * 8 + 2 * j + 1) * SV_LD + col) = (a0[j] >> 16) | (a1[j] & 0xffff0000u); } }
    }
    __syncthreads();
    if (wave < 4) {
        const int hf = wave >> 1, rb = wave & 1, bb = 2 * bp + hf;
        const bf16* Ks = (const bf16*)(lds + hf * HALF_B); const bf16* Vt = Ks + SKEYS * SK_LD; bf16* Pw = (bf16*)(lds + 2 * HALF_B) + wave * 16 * SP_LD;
        const int r = 2 * rb + (fr >> 3), t = fr & 7, qh = kvh * 4 + r;
        const size_t qrow = (size_t)(ROW_S + bb * 8 + t);
        bf16x8 qa[2];
        if (lj == 0) {
#pragma unroll
            for (int ks = 0; ks < 2; ++ks) qa[ks] = *(const bf16x8*)(Q + qrow * DM + qh * 64 + 32 * ks + 8 * fq);
        } else {
            const float* __restrict__ SL = (const float*)(a->ws + WS_SLAB) + (size_t)(qrow - ROW_S) * DM + qh * 64 + 8 * fq;
#pragma unroll
            for (int ks = 0; ks < 2; ++ks) { f32x4 x0 = (f32x4){0.f, 0.f, 0.f, 0.f}, x1 = x0;
#pragma unroll
                for (int sl = 0; sl < 4; ++sl) { const float* p = SL + (size_t)sl * (1280 * 1024) + 32 * ks; x0 = x0 + *(const f32x4*)p; x1 = x1 + *(const f32x4*)(p + 4); }
                const u32x4 w = (u32x4){pkbf(x0.x, x0.y), pkbf(x0.z, x0.w), pkbf(x1.x, x1.y), pkbf(x1.z, x1.w)}; qa[ks] = __builtin_bit_cast(bf16x8, w); }
        }
        const float sink = a->in[I_SINKS][lj * NQ + qh];
        f32x4 sc[10];
#pragma unroll
        for (int ni = 0; ni < 10; ++ni) sc[ni] = (f32x4){0.f, 0.f, 0.f, 0.f};
#pragma unroll
        for (int ni = 0; ni < 10; ++ni) {
            const bf16x8 b0 = *(const bf16x8*)(Ks + (16 * ni + fr) * SK_LD + 8 * fq), b1 = *(const bf16x8*)(Ks + (16 * ni + fr) * SK_LD + 32 + 8 * fq);
            sc[ni] = MFMA16(b0, qa[0], sc[ni]); sc[ni] = MFMA16(b1, qa[1], sc[ni]); }
        float mx = -INFINITY;
#pragma unroll
        for (int ni = 0; ni < 10; ++ni)
#pragma unroll
            for (int j = 0; j < 4; ++j) { const int key = 16 * ni + 4 * fq + j;
                const bool vis = (ni == 0) || ((key < 144) ? (key - 16 > t) : (key - 144 <= t));
                const float v = vis ? sc[ni][j] * 0.125f : -INFINITY; sc[ni][j] = v; mx = fmaxf(mx, v); }
        mx = fmaxf(mx, __shfl_xor(mx, 16)); mx = fmaxf(mx, __shfl_xor(mx, 32)); mx = fmaxf(mx, sink);
        float sum = 0.f;
#pragma unroll
        for (int ni = 0; ni < 10; ++ni)
#pragma unroll
            for (int j = 0; j < 4; ++j) { const float p = __expf(sc[ni][j] - mx); sc[ni][j] = p; sum += p; }
        sum += __shfl_xor(sum, 16); sum += __shfl_xor(sum, 32); sum += __expf(sink - mx);
        const float inv = frcp(sum);
#pragma unroll
        for (int ni = 0; ni < 10; ++ni) { u32x2 w; w.x = pkbf(sc[ni][0] * inv, sc[ni][1] * inv); w.y = pkbf(sc[ni][2] * inv, sc[ni][3] * inv); *(u32x2*)(Pw + fr * SP_LD + 16 * ni + 4 * fq) = w; }
        asm volatile("s_waitcnt lgkmcnt(0)" ::: "memory");
        f32x4 o[4];
#pragma unroll
        for (int ni = 0; ni < 4; ++ni) o[ni] = (f32x4){0.f, 0.f, 0.f, 0.f};
#pragma unroll
        for (int ks = 0; ks < 5; ++ks) { const bf16x8 af = *(const bf16x8*)(Pw + fr * SP_LD + 32 * ks + 8 * fq);
#pragma unroll
            for (int ni = 0; ni < 4; ++ni) { const int vr = 16 * ni + fr; const bf16x8 bb2 = *(const bf16x8*)(Vt + vr * SV_LD + ((32 * ks + 8 * fq) ^ TSW(vr))); o[ni] = MFMA16(bb2, af, o[ni]); } }
#pragma unroll
        for (int ni = 0; ni < 4; ++ni) { u32x2 w; w.x = pkbf(o[ni][0], o[ni][1]); w.y = pkbf(o[ni][2], o[ni][3]); *(u32x2*)(AO + qrow * DM + qh * 64 + 16 * ni + 4 * fq) = w; }
    }
    __syncthreads();
}
__device__ __forceinline__ void cache_copy_job(ArgsP a, int cu0) {
    const bf16* __restrict__ KV = (const bf16*)(a->ws + WS_KV); const float* __restrict__ CK = a->in[I_CK]; const float* __restrict__ CV = a->in[I_CV];
    const int gt = ((int)blockIdx.x - cu0) * NTHREADS + ltid(), NT = ((int)gridDim.x - cu0) * NTHREADS;
    constexpr int ITEMS = NSAMP * 128 * 64;
#pragma unroll 1
    for (int it0 = gt; it0 < ITEMS; it0 += 4 * NT) {
        u32x4 kx[4], vx[4];
#pragma unroll
        for (int k = 0; k < 4; ++k) { const int it = it0 + k * NT; kx[k] = (u32x4){0u, 0u, 0u, 0u}; vx[k] = kx[k];
            if (it < ITEMS) { const int b = it >> 13, w = (it >> 6) & 127, c4 = (it & 63) * 4;
                if (w < 120) { const size_t i = (size_t)(b * 128 + w + 8) * 256 + c4; kx[k] = __builtin_nontemporal_load((const u32x4*)(CK + i)); vx[k] = __builtin_nontemporal_load((const u32x4*)(CV + i)); }
                else { const bf16* rp = KV + (size_t)(ROW_S + b * 8 + (w - 120)) * KVW + c4; const u32x2 k2 = *(const u32x2*)rp, v2 = *(const u32x2*)(rp + 256);
                    kx[k] = (u32x4){k2.x << 16, k2.x & 0xffff0000u, k2.y << 16, k2.y & 0xffff0000u}; vx[k] = (u32x4){v2.x << 16, v2.x & 0xffff0000u, v2.y << 16, v2.y & 0xffff0000u}; } } }
#pragma unroll
        for (int k = 0; k < 4; ++k) { const int it = it0 + k * NT;
            if (it < ITEMS) { const size_t o = (size_t)it * 4; __builtin_nontemporal_store(kx[k], (u32x4*)(a->out + O_SCK + o)); __builtin_nontemporal_store(vx[k], (u32x4*)(a->out + O_SCV + o)); } }
    }
}
__device__ __forceinline__ void phase_attn(ArgsP a, int lj, unsigned char* lds, int tid, int wave, int lane) {
    if (lj == 0) {
        const bf16* KV = (const bf16*)(a->ws + WS_KV);
        const int gt = blockIdx.x * NTHREADS + tid, NT = gridDim.x * NTHREADS;
        for (int e = gt; e < 2 * 128 * 512; e += NT) { const int b = e >> 16, w = (e >> 9) & 127, c = e & 511;
            const float v = bf2f(KV[(size_t)(b * SEQ + SEQ - 128 + w) * KVW + c]);
            if (c < 256) a->out[O_PCK + (size_t)(b * 128 + w) * 256 + c] = v; else a->out[O_PCV + (size_t)(b * 128 + w) * 256 + (c - 256)] = v; }
    }
    const int xg = blockIdx.x & 7, xi = blockIdx.x >> 3;
#pragma unroll 1
    for (int j = 0; j < 4; ++j) { const int u = 128 * xg + 4 * xi + j, qb = u & 127, kvh = (u >> 7) & 3, b = u >> 9; attn_prompt_unit(a, lj, lds, b, kvh, qb, tid, wave, lane); }
    { const int su = blockIdx.x; attn_sample_pair(a, lj, lds, su >> 2, su & 3, tid, wave, lane); }
}

constexpr int PH_A = 1, PH_B = PH_A + 7 * 2, PH_F = PH_B + 5 * 2, NPHASES = PH_F + 1;
template <class Epi> __device__ __forceinline__ void run_gemm(LAS unsigned char* lds, const bf16* A, const bf16* Bt, int M, int N, int K, const Epi& E, unsigned* flag) {
    pg8::Gemm g{A, Bt, MP, N, K}; pg8::StaticOrder S; S.init(M, N, K, (int)gridDim.x, (int)blockIdx.x); S.flag = flag; S.need = ROWJOB_WGS;
    pg8::gemm_phase<Epi, pg8::StaticOrder, true, true>(lds, g, S, E);
}
template <class Epi> __device__ __forceinline__ void run_gemm_res(LAS unsigned char* lds, const bf16* A, const bf16* Bt, int K, int S_, const Epi& E, unsigned* flag, unsigned need) {
    pg8::Gemm g{A, Bt, MP, 1024, K}; pg8::ResOrder S; S.init(K, S_, (int)gridDim.x, (int)blockIdx.x); S.so.flag = flag; S.so.need = need;
    pg8::gemm_phase<Epi, pg8::ResOrder, true, true>(lds, g, S, E);
}

template <class Epi> __device__ __forceinline__ void run_gemm_left(LAS unsigned char* lds, const bf16* A, const bf16* Bt, int u, const Epi& E) {
    pg8::Gemm g{A, Bt, MP, 4096, 1024}; pg8::LeftOrder S; S.u = u;
    pg8::gemm_phase<Epi, pg8::LeftOrder, true, true>(lds, g, S, E);
}

__global__ void __launch_bounds__(NTHREADS, 2) yoco_fwd(Args args) {
    extern __shared__ __attribute__((aligned(16))) unsigned char lds[];
    LAS unsigned char* ldsl = (LAS unsigned char*)lds;
    const int tid0 = threadIdx.x;
    for (int u = tid0; u < (LDS_BYTES - LDSCTL_OFF) / 4; u += NTHREADS) ((LAS unsigned*)(ldsl + LDSCTL_OFF))[u] = 0u;
    __syncthreads();
    const int lo = args.ph_lo, hi = args.ph_hi;
    if (hi - lo > 1) (void)xcd_barrier_post((unsigned*)(args.ws + WS_CTL) + CW_BAR, (volatile LAS unsigned*)(ldsl + MISC_OFF) + 8);
    int rep = 0;
#pragma unroll 1
    for (int p = lo; p < hi;) {
        ArgsP la = (ArgsP)__builtin_amdgcn_kernarg_segment_ptr(); asm volatile("" : "+s"(la));
        unsigned char* ws = la->ws;
        const int tid = ltid();
        const int lane = tid & 63, wave = __builtin_amdgcn_readfirstlane(tid >> 6);
        float* H = (float*)(ws + WS_H);
        int kind, li = 0, lj = 0, layer = 0;
        int nslab = 8;
        int ver = 0;
        if (p == 0) kind = 0;
        else if (p < PH_B) { li = (p - PH_A) / 7; layer = li; const int sub = (p - PH_A) % 7;
            kind = (sub == 0) ? 3 : (sub == 1) ? 5 : (sub == 2) ? 6 : (sub == 3) ? 7 : (sub == 4) ? 8 : (sub == 5) ? 9 : 10; ver = 2 * li + (sub >= 5 ? 1 : 0); }
        else if (p < PH_F) { lj = (p - PH_B) / 5; layer = 2 + lj; const int sub = (p - PH_B) % 5;
            kind = (sub == 0) ? 11 : (sub == 1) ? 12 : (sub == 2) ? 13 : (sub == 3) ? 9 : 10; if (sub == 3) nslab = 4; ver = 4 + 2 * lj + (sub >= 3 ? 1 : 0); }
        else kind = 14;
#ifndef KMASK
#define KMASK 0xffff
#endif
#define KON(k) ((KMASK >> (k)) & 1)
#ifndef REP_MASK
#define REP_MASK 0
#endif
        const int verS = __builtin_amdgcn_readfirstlane(ver);
#define SSV(v) ((float*)(ws + WS_SS) + (v) * (MP * 4))
        unsigned* flagp = (unsigned*)(ws + WS_CTL) + CW_FLAG + 64 * verS;
        if ((kind == 3 || kind == 11) && verS > 0) {
            if (rep == 0 && (int)blockIdx.x >= (int)gridDim.x - ROWJOB_WGS) {
                phase_rows(la, 0, nslab, verS, ROWJOB_WGS, wave, lane);
                asm volatile("s_waitcnt vmcnt(0)" ::: "memory"); __syncthreads();
                if (tid == 0) { __builtin_amdgcn_fence(__ATOMIC_RELEASE, "agent"); asm volatile("s_waitcnt vmcnt(0)" ::: "memory"); (void)xb_add(flagp, 1u); }
            }
        } else { flagp = nullptr;
            if (kind == 9 && rep == 0) phase_rows(la, 0, nslab, verS, (int)gridDim.x, wave, lane);
        }
        {
            constexpr int SLACK_IN = (69 * 25) % 256;
            unsigned cmask = 0u; int ccu0 = 0, ccu1 = 0;
            if (p == PH_A) { cmask = (1u << 2) | (1u << 4) | (1u << 8); ccu0 = SLACK_IN; ccu1 = (int)gridDim.x; }
            else if (p == PH_A + 6) { cmask = (1u << 1) | (1u << 3) | (1u << 5) | (1u << 9); ccu0 = 0; ccu1 = 160; }
            else if (p == PH_A + 7) { cmask = (1u << 6) | (1u << 10); ccu0 = SLACK_IN; ccu1 = (int)gridDim.x; }
            else if (p == PH_A + 13) { cmask = (0x1fu << 12) | (1u << 7) | (1u << 11); ccu0 = 0; ccu1 = 160; }
            if (KON(0) && cmask != 0u && (int)blockIdx.x >= ccu0 && (int)blockIdx.x < ccu1) { phase_prologue(la, ldsl, wave, lane, cmask, ccu0, ccu1); __syncthreads(); }
        }
        if (KON(0) && kind == 0) { phase_prologue(la, ldsl, wave, lane, 1u, 0, (int)gridDim.x); phase_rows(la, 1, 0, 0, (int)gridDim.x, wave, lane); }
        else if (KON(3) && kind == 3) { pg8::EpiInProj E{(bf16*)(ws + WS_ZX), (float*)(ws + WS_DT), la->in[I_ADTB] + li * NHEADS, SSV(verS)}; run_gemm(ldsl, (const bf16*)H, (const bf16*)(ws + WS_WIN + li * SZ_WIN), MP, INPROJ_P, 1024, E, flagp); }
        else if (KON(5) && kind == 5) phase_ssd1(la, li, lds, tid, wave, lane);
        else if (KON(6) && kind == 6) phase_scan(la, li);
        else if (KON(7) && kind == 7) phase_ssd3(la, li, lds, tid, wave, lane);
        else if (KON(8) && (kind == 8 || kind == 10 || kind == 13)) {
            const bf16* A; const bf16* Bt; int K;
            if (kind == 8) { A = (const bf16*)(ws + WS_YN); Bt = (const bf16*)(ws + WS_WOUT + li * SZ_WOUT); K = 2048; }
            else if (kind == 10) { A = (const bf16*)(ws + WS_U); Bt = (const bf16*)(ws + WS_WDN + layer * SZ_WDN); K = 4096; }
            else { A = (const bf16*)(ws + WS_AO); Bt = (const bf16*)(ws + WS_WO + lj * SZ_WO); K = 1024; }
            unsigned* flag2 = nullptr;
            if (kind == 13 && lj == 0 && (int)blockIdx.x >= 80) cache_copy_job(la, 80);
            if (kind == 10) {
                flag2 = (unsigned*)(ws + WS_CTL) + CW_FLAG2 + 64 * layer;
                if ((int)blockIdx.x >= LEFT_CU0) {
                    pg8::EpiBf<1> EU{(bf16*)(ws + WS_U), 4096, 1 << 20, nullptr, 0, SSV(verS)}; run_gemm_left(ldsl, (const bf16*)H, (const bf16*)(ws + WS_WUP + layer * SZ_WUP), (int)blockIdx.x - LEFT_CU0, EU);
                    asm volatile("s_waitcnt vmcnt(0)" ::: "memory"); __syncthreads();
                    if (tid == 0) { __builtin_amdgcn_fence(__ATOMIC_RELEASE, "agent"); asm volatile("s_waitcnt vmcnt(0)" ::: "memory"); (void)xb_add(flag2, 1u); }
                }
            }
            pg8::EpiRes E{SSV(verS + 1), nullptr, (bf16*)H, (float*)(ws + WS_SLAB)}; run_gemm_res(ldsl, A, Bt, K, K == 1024 ? 4 : 8, E, flag2, 80u); }
        else if (KON(9) && kind == 9) { pg8::EpiBf<1> E{(bf16*)(ws + WS_U), 4096, 1 << 20, nullptr, 0, SSV(verS)}; run_gemm(ldsl, (const bf16*)H, (const bf16*)(ws + WS_WUP + layer * SZ_WUP), 64 * pg8::BM, 4096, 1024, E, nullptr); }
        else if (KON(11) && kind == 11) { pg8::EpiBf<0> E{(bf16*)(ws + WS_Q), 1024, 4, (bf16*)(ws + WS_KV), KVW, SSV(verS)};
            if (lj == 0) run_gemm(ldsl, (const bf16*)H, (const bf16*)(ws + WS_WQKV0), MP, 1536, 1024, E, flagp);
            else { pg8::EpiQSplit E2{(bf16*)(ws + WS_Q), (float*)(ws + WS_SLAB), SSV(verS)}; run_gemm_res(ldsl, (const bf16*)H, (const bf16*)(ws + WS_WQ1), 1024, 4, E2, flagp, (unsigned)ROWJOB_WGS); } }
        else if (KON(12) && kind == 12) phase_attn(la, lj, lds, tid, wave, lane);
        else if (KON(14) && kind == 14) phase_final(la, wave, lane);
        bool again = false;
        if (REP_MASK != 0) { if (rep == 0 && ((REP_MASK >> kind) & 1)) { rep = 1; again = true; } else rep = 0; }
        if (p + 1 < hi || again) { XcdBarrier bar; bar.bar = (unsigned*)(ws + WS_CTL) + CW_BAR; bar.x = xb_xcc_id(); bar.st = (volatile LAS unsigned*)(ldsl + MISC_OFF) + 8; xcd_barrier(bar); }
        else { asm volatile("s_waitcnt vmcnt(0)" ::: "memory"); __syncthreads(); }
        if (!again) ++p;
    }
}

#ifndef MK_PER_PHASE
#define MK_PER_PHASE 0
#endif
extern "C" void kernel_launch(void* const* d_in, const int* in_sizes, int n_in, void* d_out, int out_size, void* d_ws, size_t ws_size, hipStream_t stream) {
    static int grid = 0;
    if (grid == 0) {
        if (n_in != 26 || (size_t)out_size != O_END || ws_size < WS_END) { fprintf(stderr, "kernel_launch: unexpected problem (n_in %d, out %d vs %zu, ws %zu vs %zu); nothing launched\n", n_in, out_size, (size_t)O_END, ws_size, (size_t)WS_END); grid = -1; return; }
        int dev = 0, cus = 0, per_cu = 0;
        if (hipGetDevice(&dev) != hipSuccess || hipDeviceGetAttribute(&cus, hipDeviceAttributeMultiprocessorCount, dev) != hipSuccess) { grid = -1; return; }
        if (hipFuncSetAttribute((const void*)yoco_fwd, hipFuncAttributeMaxDynamicSharedMemorySize, LDS_BYTES) != hipSuccess) { fprintf(stderr, "kernel_launch: hipFuncSetAttribute failed\n"); grid = -1; return; }
        if (hipOccupancyMaxActiveBlocksPerMultiprocessor(&per_cu, (const void*)yoco_fwd, NTHREADS, LDS_BYTES) != hipSuccess || per_cu < 1) { fprintf(stderr, "kernel_launch: occupancy query says %d\n", per_cu); per_cu = 1; }
        (void)hipGetLastError();
        if (cus != 256) { fprintf(stderr, "kernel_launch: built for a 256-CU device (got %d); nothing launched\n", cus); grid = -1; return; }
        grid = cus;
    }
    if (grid < 0) return;
    if (hipMemsetAsync((char*)d_ws + WS_CTL, 0, CTL_ZERO_BYTES, stream) != hipSuccess) { fprintf(stderr, "kernel_launch: memset failed\n"); return; }
    Args a{};
    for (int i = 0; i < 26; ++i) a.in[i] = (const float*)d_in[i];
    a.out = (float*)d_out; a.ws = (unsigned char*)d_ws;
#if MK_PER_PHASE
    for (int p = 0; p < NPHASES; ++p) { a.ph_lo = p; a.ph_hi = p + 1; hipLaunchKernelGGL(yoco_fwd, dim3(grid), dim3(NTHREADS), LDS_BYTES, stream, a); }
#else
    a.ph_lo = 0; a.ph_hi = NPHASES;
    void* kargs[] = {&a};
    hipError_t e = hipLaunchCooperativeKernel((const void*)yoco_fwd, dim3(grid), dim3(NTHREADS), kargs, LDS_BYTES, stream);
    if (e != hipSuccess) fprintf(stderr, "kernel_launch: cooperative launch failed: %s (grid %d)\n", hipGetErrorString(e), grid);
#endif
}
```

```cpp
#include <hip/hip_runtime.h>
#include <cstdio>
#include <cstdint>
#include <cmath>
#include <type_traits>
namespace pg8 {
#define PG8_LAS __attribute__((address_space(3)))
typedef unsigned short bf16_t;
typedef short bf16x8 __attribute__((ext_vector_type(8)));
typedef float f32x4 __attribute__((ext_vector_type(4)));
typedef unsigned u32x4 __attribute__((ext_vector_type(4)));
constexpr int BM = 256, BK = 64, HALF = 128, HTB = HALF * BK * 2  , STAGE_BYTES = 8 * HTB, NXCD = 8, WGM = 8;

__host__ __device__ __forceinline__ int lds_byte(int r, int c) { const int st = (r >> 4) * 2 + (c >> 5), rr = r & 15, cc = c & 31, ob = rr * 64 + cc * 2; return st * 1024 + (ob ^ (((ob >> 9) & 1) << 5)); }
__host__ __device__ __forceinline__ void stage_rc(int b, int& R, int& C) { const int st = b / 1024, sb = b % 1024, swz = sb ^ (((sb >> 9) & 1) << 5); R = (st >> 1) * 16 + swz / 64; C = (st & 1) * 32 + (swz % 64) / 2; }
__host__ __device__ __forceinline__ int perm32(int rho) { const int n = rho >> 4, i = rho & 15; return 8 * (i >> 2) + 4 * n + (i & 3); }

struct Unit { int pm, pn, k0, nt, aux; };
struct Gemm { const bf16_t* A; const bf16_t* Bt; int M, N, K; };

struct StaticOrder {
    int nM, nN, nwg, G, c, nt0; const unsigned* flag; unsigned need;
    __host__ __device__ void init(int M, int N, int K, int G_, int c_) { nM = M / BM; nN = N / BM; nwg = nM * nN; G = G_; c = c_; nt0 = K / BK; }
    __host__ __device__ bool next(int i, Unit& u) const {
        const long L = (long)i * G + c; if (L >= nwg) return false;
        int wgid = (int)L; { const int q = nwg / NXCD, r = nwg % NXCD, xcd = wgid % NXCD, off = wgid / NXCD; wgid = (xcd < r ? xcd * (q + 1) : r * (q + 1) + (xcd - r) * q) + off; }
        const int nig = WGM * nN, gid = wgid / nig, fm = gid * WGM, gsz = (nM - fm) < WGM ? (nM - fm) : WGM;
        u.pm = fm + ((wgid % nig) % gsz); u.pn = (wgid % nig) / gsz; u.k0 = 0; u.nt = nt0; u.aux = -1; return true;
    }
    __device__ __forceinline__ void a_ready(const Unit& u) const {
        if (flag != nullptr && u.pm >= 64) { unsigned sp = 0; while (__hip_atomic_load(flag, __ATOMIC_RELAXED, __HIP_MEMORY_SCOPE_AGENT) < need && ++sp < (1u << 22)) __builtin_amdgcn_s_sleep(2); asm volatile("" ::: "memory"); }
    }
    __device__ __forceinline__ void done(const Unit&) const {}
};
struct LeftOrder {
    int u;
    __host__ __device__ bool next(int i, Unit& un) const { if (i != 0 || u < 0) return false; un.pm = 64 + (u >> 4); un.pn = u & 15; un.k0 = 0; un.nt = 1024 / BK; un.aux = -1; return true; }
    __device__ __forceinline__ void a_ready(const Unit&) const {}
    __device__ __forceinline__ void done(const Unit&) const {}
};
struct ResOrder {
    StaticOrder so; int S, K, c;
    __host__ __device__ void init(int K_, int S_, int G_, int c_) { so.init(64 * BM, 1024, K_, G_, c_); S = S_; K = K_; c = c_; }
    __host__ __device__ bool next(int i, Unit& u) const {
        if (i == 0) return so.next(0, u);
        if (i == 1 && c < 20 * S) { const int t = c / S, sl = c - t * S; u.pm = 64 + (t >> 2); u.pn = t & 3; u.k0 = sl * (K / S); u.nt = K / S / BK; u.aux = sl; return true; }
        return false;
    }
    __device__ __forceinline__ void a_ready(const Unit& u) const { so.a_ready(u); }
    __device__ __forceinline__ void done(const Unit&) const {}
};

typedef float f32x2_cv0 __attribute__((ext_vector_type(2))); typedef __bf16 bf16x2_cv0 __attribute__((ext_vector_type(2)));
__device__ __forceinline__ unsigned cvt_pk_bf16(float lo, float hi) { const f32x2_cv0 v = {lo, hi}; const bf16x2_cv0 b = __builtin_convertvector(v, bf16x2_cv0); return __builtin_bit_cast(unsigned, b); }
typedef float f32x2 __attribute__((ext_vector_type(2)));
typedef unsigned u32x2 __attribute__((ext_vector_type(2)));
__device__ __forceinline__ float rs_of(const f32x4 q) { return __builtin_amdgcn_rsqf((((q.x + q.y) + q.z) + q.w) * (1.f / 1024.f) + 1e-5f); }
__device__ __forceinline__ float softplus_f(float x) { const float y = __expf(-fabsf(x)); const float l = (y < 0.03125f) ? y * (1.f - y * (0.5f - y * (1.f / 3.f - 0.25f * y))) : __logf(1.f + y); return fmaxf(x, 0.f) + l; }
struct EpiInProj {
    static constexpr bool PERM = true, AFTER_DRAIN = false, PRE = true;
    bf16_t* ZX; float* DT; const float* dt_bias; const float* SS;
    __device__ __forceinline__ const float* pre_ptr(const Unit& u) const { return SS + u.pm * (BM * 4); }
    __device__ __forceinline__ void operator()(const f32x4 (&acc)[2][2][4][2], const Unit& u, int wr, int wc, int fr, int fq, const PG8_LAS f32x4* rsl) const {
        const int row0 = u.pm * BM + wr * 64 + fr;
        if (u.pn < 24) {
            const int col0 = u.pn * BM + wc * 32 + 8 * fq;
#pragma unroll
            for (int ai = 0; ai < 2; ++ai)
#pragma unroll
                for (int m = 0; m < 4; ++m) { bf16_t* rowp = ZX + (size_t)(row0 + ai * HALF + m * 16) * 6144 + col0; const float rs = rs_of(rsl[wr * 64 + fr + ai * HALF + m * 16]);
#pragma unroll
                    for (int bj = 0; bj < 2; ++bj) { const f32x4 v0 = acc[ai][bj][m][0] * rs, v1 = acc[ai][bj][m][1] * rs;
                        u32x4 w; w.x = cvt_pk_bf16(v0[0], v0[1]); w.y = cvt_pk_bf16(v0[2], v0[3]); w.z = cvt_pk_bf16(v1[0], v1[1]); w.w = cvt_pk_bf16(v1[2], v1[3]);
                        *(u32x4*)(rowp + bj * HALF) = w; } }
        } else if (wc == 0) {
            const int c0 = 8 * fq;
            const f32x4 b0 = *(const f32x4*)(dt_bias + c0), b1 = *(const f32x4*)(dt_bias + c0 + 4);
#pragma unroll
            for (int ai = 0; ai < 2; ++ai)
#pragma unroll
                for (int m = 0; m < 4; ++m) { float* rowp = DT + (size_t)(row0 + ai * HALF + m * 16) * 32 + c0;
                    const float rs = rs_of(rsl[wr * 64 + fr + ai * HALF + m * 16]);
                    const f32x4 v0 = acc[ai][0][m][0] * rs + b0, v1 = acc[ai][0][m][1] * rs + b1;
                    f32x4 o0, o1;
#pragma unroll
                    for (int j = 0; j < 4; ++j) { o0[j] = softplus_f(v0[j]); o1[j] = softplus_f(v1[j]); }
                    *(f32x4*)(rowp) = o0; *(f32x4*)(rowp + 4) = o1; }
        }
    }
};
struct EpiRes {
    static constexpr bool PERM = true, AFTER_DRAIN = false, PRE = false;
    float* SSO;
    const float* X; bf16_t* H; float* SLAB;
    __device__ __forceinline__ void operator()(const f32x4 (&acc)[2][2][4][2], const Unit& u, int wr, int wc, int fr, int fq, const PG8_LAS f32x4* scr4) const {
        const int row0 = u.pm * BM + wr * 64 + fr, col0 = u.pn * BM + wc * 32 + 8 * fq;
        if (u.aux >= 0) {
            bf16_t* base = (bf16_t*)SLAB + (size_t)u.aux * (1280 * 1024) + (size_t)(row0 - 16384) * 1024 + col0;
#pragma unroll
            for (int ai = 0; ai < 2; ++ai)
#pragma unroll
                for (int m = 0; m < 4; ++m) { bf16_t* rowp = base + (size_t)(ai * HALF + m * 16) * 1024;
#pragma unroll
                    for (int bj = 0; bj < 2; ++bj) { const f32x4 v0 = acc[ai][bj][m][0], v1 = acc[ai][bj][m][1];
                        u32x4 w; w.x = cvt_pk_bf16(v0[0], v0[1]); w.y = cvt_pk_bf16(v0[2], v0[3]); w.z = cvt_pk_bf16(v1[0], v1[1]); w.w = cvt_pk_bf16(v1[2], v1[3]);
                        *(u32x4*)(rowp + bj * HALF) = w; } }
            return;
        }
        PG8_LAS float* scr = (PG8_LAS float*)scr4;
#pragma unroll
        for (int ai = 0; ai < 2; ++ai) {
            f32x4 r0[4][2], r1[4][2];
            if (X) {
#pragma unroll
                for (int m = 0; m < 4; ++m)
#pragma unroll
                    for (int bj = 0; bj < 2; ++bj) { const float* p = X + (size_t)(row0 + ai * HALF + m * 16) * 1024 + col0 + bj * HALF; r0[m][bj] = *(const f32x4*)p; r1[m][bj] = *(const f32x4*)(p + 4); }
            } else {
                u32x4 hb[4][2];
#pragma unroll
                for (int m = 0; m < 4; ++m)
#pragma unroll
                    for (int bj = 0; bj < 2; ++bj) hb[m][bj] = *(const u32x4*)(H + (size_t)(row0 + ai * HALF + m * 16) * 1024 + col0 + bj * HALF);
#pragma unroll
                for (int m = 0; m < 4; ++m)
#pragma unroll
                    for (int bj = 0; bj < 2; ++bj) { const u32x4 w = hb[m][bj];
                        r0[m][bj] = (f32x4){__uint_as_float(w.x << 16), __uint_as_float(w.x & 0xffff0000u), __uint_as_float(w.y << 16), __uint_as_float(w.y & 0xffff0000u)};
                        r1[m][bj] = (f32x4){__uint_as_float(w.z << 16), __uint_as_float(w.z & 0xffff0000u), __uint_as_float(w.w << 16), __uint_as_float(w.w & 0xffff0000u)}; }
            }
            float ssq[4];
#pragma unroll
            for (int m = 0; m < 4; ++m) { ssq[m] = 0.f;
#pragma unroll
                for (int bj = 0; bj < 2; ++bj) { const f32x4 v0 = r0[m][bj] + acc[ai][bj][m][0], v1 = r1[m][bj] + acc[ai][bj][m][1];
                    ssq[m] += v0[0] * v0[0] + v0[1] * v0[1] + v0[2] * v0[2] + v0[3] * v0[3] + v1[0] * v1[0] + v1[1] * v1[1] + v1[2] * v1[2] + v1[3] * v1[3];
                    u32x4 w; w.x = cvt_pk_bf16(v0[0], v0[1]); w.y = cvt_pk_bf16(v0[2], v0[3]); w.z = cvt_pk_bf16(v1[0], v1[1]); w.w = cvt_pk_bf16(v1[2], v1[3]);
                    *(u32x4*)(H + (size_t)(row0 + ai * HALF + m * 16) * 1024 + col0 + bj * HALF) = w; } }
#pragma unroll
            for (int m = 0; m < 4; ++m) { float t = ssq[m]; t += __shfl_xor(t, 16); t += __shfl_xor(t, 32);
                if (fq == 0) scr[(wr * 64 + fr + ai * HALF + m * 16) * 4 + wc] = t; }
        }
        asm volatile("s_waitcnt lgkmcnt(0)" ::: "memory"); __builtin_amdgcn_s_barrier();
        if (wr == 0) { const int r = wc * 64 + fq * 16 + fr; const f32x4 q = scr4[r]; SSO[(size_t)(u.pm * BM + r) * 4 + u.pn] = ((q.x + q.y) + q.z) + q.w; }
    }
};
template <int ACT> struct EpiBf {
    static constexpr bool PERM = true, AFTER_DRAIN = false, PRE = true;
    bf16_t* O0; int ldc0; int nsplit; bf16_t* O1; int ldc1; const float* SS;
    __device__ __forceinline__ const float* pre_ptr(const Unit& u) const { return SS + u.pm * (BM * 4); }
    __device__ __forceinline__ void operator()(const f32x4 (&acc)[2][2][4][2], const Unit& u, int wr, int wc, int fr, int fq, const PG8_LAS f32x4* rsl) const {
        const int row0 = u.pm * BM + wr * 64 + fr;
        bf16_t* base; int ldc, colt;
        if (u.pn < nsplit) { base = O0; ldc = ldc0; colt = u.pn * BM; } else { base = O1; ldc = ldc1; colt = (u.pn - nsplit) * BM; }
        const int col0 = colt + wc * 32 + 8 * fq;
#pragma unroll
        for (int ai = 0; ai < 2; ++ai)
#pragma unroll
            for (int m = 0; m < 4; ++m) { bf16_t* rowp = base + (size_t)(row0 + ai * HALF + m * 16) * ldc + col0; const float rs = rs_of(rsl[wr * 64 + fr + ai * HALF + m * 16]);
#pragma unroll
                for (int bj = 0; bj < 2; ++bj) { f32x4 v0 = acc[ai][bj][m][0] * rs, v1 = acc[ai][bj][m][1] * rs;
                    if (ACT == 1) {
#pragma unroll
                        for (int j = 0; j < 4; ++j) { const float a = fmaxf(v0[j], 0.f), b = fmaxf(v1[j], 0.f); v0[j] = a * a; v1[j] = b * b; } }
                    u32x4 w; w.x = cvt_pk_bf16(v0[0], v0[1]); w.y = cvt_pk_bf16(v0[2], v0[3]); w.z = cvt_pk_bf16(v1[0], v1[1]); w.w = cvt_pk_bf16(v1[2], v1[3]);
                    *(u32x4*)(rowp + bj * HALF) = w; } }
    }
};
struct EpiQSplit {
    static constexpr bool PERM = true, AFTER_DRAIN = false, PRE = true;
    bf16_t* Q; float* SLAB; const float* SS;
    __device__ __forceinline__ const float* pre_ptr(const Unit& u) const { return SS + u.pm * (BM * 4); }
    __device__ __forceinline__ void operator()(const f32x4 (&acc)[2][2][4][2], const Unit& u, int wr, int wc, int fr, int fq, const PG8_LAS f32x4* rsl) const {
        const int row0 = u.pm * BM + wr * 64 + fr, col0 = u.pn * BM + wc * 32 + 8 * fq;
        if (u.aux >= 0) {
            float* base = SLAB + (size_t)u.aux * (1280 * 1024) + (size_t)(row0 - 16384) * 1024 + col0;
#pragma unroll
            for (int ai = 0; ai < 2; ++ai)
#pragma unroll
                for (int m = 0; m < 4; ++m) { float* rowp = base + (size_t)(ai * HALF + m * 16) * 1024; const float rs = rs_of(rsl[wr * 64 + fr + ai * HALF + m * 16]);
#pragma unroll
                    for (int bj = 0; bj < 2; ++bj) { *(f32x4*)(rowp + bj * HALF) = acc[ai][bj][m][0] * rs; *(f32x4*)(rowp + bj * HALF + 4) = acc[ai][bj][m][1] * rs; } }
            return;
        }
#pragma unroll
        for (int ai = 0; ai < 2; ++ai)
#pragma unroll
            for (int m = 0; m < 4; ++m) { bf16_t* rowp = Q + (size_t)(row0 + ai * HALF + m * 16) * 1024 + col0; const float rs = rs_of(rsl[wr * 64 + fr + ai * HALF + m * 16]);
#pragma unroll
                for (int bj = 0; bj < 2; ++bj) { const f32x4 v0 = acc[ai][bj][m][0] * rs, v1 = acc[ai][bj][m][1] * rs;
                    u32x4 w; w.x = cvt_pk_bf16(v0[0], v0[1]); w.y = cvt_pk_bf16(v0[2], v0[3]); w.z = cvt_pk_bf16(v1[0], v1[1]); w.w = cvt_pk_bf16(v1[2], v1[3]);
                    *(u32x4*)(rowp + bj * HALF) = w; } }
    }
};

template <class Epi, class Sched, bool ALIGN_EPI = false, bool SP2 = false>
__device__ __forceinline__ void gemm_phase(PG8_LAS unsigned char* lds, const Gemm g, const Sched& S, const Epi& E) {
    int tid_l = threadIdx.x; asm volatile("" : "+v"(tid_l));
    const int tid = tid_l, wid = __builtin_amdgcn_readfirstlane(tid >> 6), lane = tid & 63, wr = wid >> 2, wc = wid & 3, fr = lane & 15, fq = lane >> 4;
    const int K = g.K;
    unsigned voffA[2], voffB[2];
#pragma unroll
    for (int i = 0; i < 2; ++i) { int R, C; stage_rc(tid * 16 + i * 8192, R, C); const int Rb = Epi::PERM ? ((R & ~31) + perm32(R & 31)) : R;
        voffA[i] = (unsigned)(R * K + C) * 2u; voffB[i] = (unsigned)(Rb * K + C) * 2u; }
    const unsigned voffS = (unsigned)tid * 16u;
    const size_t kstep = (size_t)(BK * 2);
    const size_t hstep = (size_t)HALF * K * 2;
    const size_t tstep = 2 * hstep;
    const unsigned ldsw = (unsigned)wid * 1024u;
    const int aoff = lds_byte(wr * 64 + fr, fq * 8), boff = lds_byte(wc * 32 + fr, fq * 8);
#define PG8_SA(b, h) (((b) * 2 + (h)) * HTB)
#define PG8_SB(b, h) ((4 + (b) * 2 + (h)) * HTB)
#define PG8_STAGE(bufoff, gbase, voff) do { _Pragma("unroll") for (int _i = 0; _i < 2; ++_i) \
        __builtin_amdgcn_global_load_lds((const unsigned*)((const char*)(gbase) + (voff)[_i]), (PG8_LAS unsigned*)(lds + (bufoff) + ldsw + _i * 8192), 16, 0, 0); } while (0)
#define PG8_LDA(dst, b, h) do { _Pragma("unroll") for (int m = 0; m < 4; ++m) _Pragma("unroll") for (int k = 0; k < 2; ++k) dst[m][k] = *(const PG8_LAS bf16x8*)(lds + PG8_SA(b, h) + aoff + m * 2048 + k * 1024); } while (0)
#define PG8_LDB(dst, b, h) do { _Pragma("unroll") for (int n = 0; n < 2; ++n) _Pragma("unroll") for (int k = 0; k < 2; ++k) dst[n][k] = *(const PG8_LAS bf16x8*)(lds + PG8_SB(b, h) + boff + n * 2048 + k * 1024); } while (0)
#define PG8_MMA(ai, bj, At, Bt) do { __builtin_amdgcn_s_setprio(1); _Pragma("unroll") for (int m = 0; m < 4; ++m) _Pragma("unroll") for (int n = 0; n < 2; ++n) _Pragma("unroll") for (int k = 0; k < 2; ++k) \
        acc[ai][bj][m][n] = __builtin_amdgcn_mfma_f32_16x16x32_bf16(Bt[n][k], At[m][k], acc[ai][bj][m][n], 0, 0, 0); __builtin_amdgcn_s_setprio(0); } while (0)
#define PG8_WAIT_V(n) asm volatile("s_waitcnt vmcnt(" #n ")" ::: "memory")
#define PG8_WAIT_L(n) asm volatile("s_waitcnt lgkmcnt(" #n ")" ::: "memory")
#define PG8_BAR __builtin_amdgcn_s_barrier()
#define PG8_SCHED __builtin_amdgcn_sched_barrier(0)
    Unit cur, nxt; int ui = 0;
    if (!S.next(0, cur)) return;
    f32x4 acc[2][2][4][2];
#pragma unroll
    for (int a = 0; a < 2; ++a)
#pragma unroll
        for (int b = 0; b < 2; ++b)
#pragma unroll
            for (int m = 0; m < 4; ++m)
#pragma unroll
                for (int n = 0; n < 2; ++n) acc[a][b][m][n] = (f32x4){0.f, 0.f, 0.f, 0.f};
    bf16x8 At[4][2], B0[2][2], B1[2][2];
    const char* cA = (const char*)g.A + (size_t)cur.pm * tstep + (size_t)cur.k0 * 2; const char* cB = (const char*)g.Bt + (size_t)cur.pn * tstep + (size_t)cur.k0 * 2;
    S.a_ready(cur);
    if constexpr (SP2) {
        PG8_STAGE(PG8_SB(0, 0), cB, voffB); PG8_STAGE(PG8_SB(0, 1), cB + hstep, voffB); PG8_STAGE(PG8_SA(0, 0), cA, voffA); PG8_STAGE(PG8_SA(0, 1), cA + hstep, voffA);
        if (wr == 1) PG8_BAR;
        PG8_WAIT_V(2); PG8_BAR;
        PG8_STAGE(PG8_SB(1, 0), cB + kstep, voffB); PG8_STAGE(PG8_SA(1, 0), cA + kstep, voffA); PG8_STAGE(PG8_SB(1, 1), cB + hstep + kstep, voffB);
        PG8_WAIT_V(6); PG8_BAR;
    } else {
        PG8_STAGE(PG8_SB(0, 0), cB, voffB); PG8_STAGE(PG8_SA(0, 0), cA, voffA); PG8_STAGE(PG8_SB(0, 1), cB + hstep, voffB); PG8_STAGE(PG8_SA(0, 1), cA + hstep, voffA);
        if (wr == 1) PG8_BAR;
        PG8_WAIT_V(4); PG8_BAR;
        PG8_STAGE(PG8_SB(1, 0), cB + kstep, voffB); PG8_STAGE(PG8_SA(1, 0), cA + kstep, voffA); PG8_STAGE(PG8_SB(1, 1), cB + hstep + kstep, voffB);
        PG8_WAIT_V(6); PG8_BAR;
    }
    for (;;) {
        const bool has_next = S.next(ui + 1, nxt);
        const char* nA = has_next ? (const char*)g.A + (size_t)nxt.pm * tstep + (size_t)nxt.k0 * 2 : cA; const char* nB = has_next ? (const char*)g.Bt + (size_t)nxt.pn * tstep + (size_t)nxt.k0 * 2 : cB;
        const int nt = cur.nt;
        for (int t = 0; t < nt; t += 2) {
            const bool last = (t == nt - 2);
            const char* a1 = cA + (size_t)(t + 1) * kstep;
            const char* a2 = last ? nA : cA + (size_t)(t + 2) * kstep; const char* b2 = last ? nB : cB + (size_t)(t + 2) * kstep;
            const char* a3 = a2 + kstep; const char* b3 = b2 + kstep;
            if (last && has_next) S.a_ready(nxt);
            if constexpr (SP2) {
            PG8_LDB(B0, 0, 0); PG8_LDB(B1, 0, 1); PG8_SCHED; PG8_LDA(At, 0, 0); PG8_STAGE(PG8_SA(1, 1), a1 + hstep, voffA);
            PG8_WAIT_V(8); PG8_WAIT_L(0); PG8_BAR;
            if constexpr (Epi::PRE) { if (last && wid < 4) __builtin_amdgcn_global_load_lds((const unsigned*)((const char*)E.pre_ptr(cur) + voffS), (PG8_LAS unsigned*)(lds + 8 * HTB + (ui & 1) * 4096 + wid * 1024), 16, 0, 0); }
            PG8_MMA(0, 0, At, B0); PG8_MMA(0, 1, At, B1); PG8_BAR; PG8_SCHED;
            PG8_LDA(At, 0, 1); PG8_STAGE(PG8_SB(0, 0), b2, voffB); PG8_STAGE(PG8_SB(0, 1), b2 + hstep, voffB); PG8_STAGE(PG8_SA(0, 0), a2, voffA);
            PG8_WAIT_V(8); PG8_WAIT_L(0); PG8_BAR; PG8_MMA(1, 0, At, B0); PG8_MMA(1, 1, At, B1); PG8_BAR; PG8_SCHED;
            PG8_LDB(B0, 1, 0); PG8_LDB(B1, 1, 1); PG8_SCHED; PG8_LDA(At, 1, 0); PG8_STAGE(PG8_SA(0, 1), a2 + hstep, voffA);
            PG8_WAIT_V(8); PG8_WAIT_L(0); PG8_BAR; PG8_MMA(0, 0, At, B0); PG8_MMA(0, 1, At, B1); PG8_BAR; PG8_SCHED;
            PG8_LDA(At, 1, 1); PG8_STAGE(PG8_SB(1, 0), b3, voffB); PG8_STAGE(PG8_SB(1, 1), b3 + hstep, voffB); PG8_STAGE(PG8_SA(1, 0), a3, voffA);
            PG8_WAIT_V(8); PG8_WAIT_L(0); PG8_BAR; PG8_MMA(1, 0, At, B0); PG8_MMA(1, 1, At, B1); PG8_BAR; PG8_SCHED;
            } else {
            PG8_LDB(B0, 0, 0); PG8_SCHED; PG8_LDA(At, 0, 0); PG8_STAGE(PG8_SA(1, 1), a1 + hstep, voffA);
            PG8_WAIT_L(8); PG8_BAR; PG8_WAIT_L(0); PG8_MMA(0, 0, At, B0); PG8_BAR; PG8_SCHED;
            PG8_LDB(B1, 0, 1); PG8_STAGE(PG8_SB(0, 0), b2, voffB);
            PG8_BAR; PG8_WAIT_L(0); PG8_MMA(0, 1, At, B1); PG8_BAR;
            PG8_LDA(At, 0, 1); PG8_STAGE(PG8_SA(0, 0), a2, voffA);
            PG8_BAR; PG8_WAIT_L(0); PG8_MMA(1, 0, At, B0); PG8_BAR; PG8_SCHED;
            PG8_STAGE(PG8_SB(0, 1), b2 + hstep, voffB);
            PG8_WAIT_V(6); PG8_BAR; PG8_MMA(1, 1, At, B1); PG8_BAR;
            PG8_LDB(B0, 1, 0); PG8_SCHED; PG8_LDA(At, 1, 0); PG8_STAGE(PG8_SA(0, 1), a2 + hstep, voffA);
            PG8_WAIT_L(8); PG8_BAR; PG8_WAIT_L(0); PG8_MMA(0, 0, At, B0); PG8_BAR; PG8_SCHED;
            PG8_LDB(B1, 1, 1); PG8_STAGE(PG8_SB(1, 0), b3, voffB);
            PG8_BAR; PG8_WAIT_L(0); PG8_MMA(0, 1, At, B1); PG8_BAR;
            PG8_LDA(At, 1, 1); PG8_STAGE(PG8_SA(1, 0), a3, voffA);
            PG8_BAR; PG8_WAIT_L(0); PG8_MMA(1, 0, At, B0); PG8_BAR; PG8_SCHED;
            PG8_STAGE(PG8_SB(1, 1), b3 + hstep, voffB);
            PG8_WAIT_V(6); PG8_BAR; PG8_MMA(1, 1, At, B1); PG8_BAR;
            }
        }
        if constexpr (ALIGN_EPI) { if (wr == 0) PG8_BAR; }
        if constexpr (!Epi::AFTER_DRAIN) { E(acc, cur, wr, wc, fr, fq, (const PG8_LAS f32x4*)(lds + 8 * HTB + (ui & 1) * 4096)); S.done(cur); }
        if (!has_next) break;
#pragma unroll
        for (int a = 0; a < 2; ++a)
#pragma unroll
            for (int b = 0; b < 2; ++b)
#pragma unroll
                for (int m = 0; m < 4; ++m)
#pragma unroll
                    for (int n = 0; n < 2; ++n) acc[a][b][m][n] = (f32x4){0.f, 0.f, 0.f, 0.f};
        cur = nxt; cA = nA; cB = nB; ++ui;
        if constexpr (ALIGN_EPI) { if (wr == 1) PG8_BAR; }
    }
    PG8_WAIT_V(0);
    if constexpr (!ALIGN_EPI) { if (wr == 0) PG8_BAR; }
    PG8_BAR;
    if constexpr (Epi::AFTER_DRAIN) { E.fused(acc, cur, wr, wc, fr, fq, lds, wid, lane); S.done(cur); }
#undef PG8_SA
#undef PG8_SB
#undef PG8_STAGE
#undef PG8_LDA
#undef PG8_LDB
#undef PG8_MMA
#undef PG8_WAIT_V
#undef PG8_WAIT_L
#undef PG8_BAR
#undef PG8_SCHED
}
}
#define GAS __attribute__((address_space(1)))
#define LAS __attribute__((address_space(3)))
typedef unsigned short bf16;
typedef unsigned v4u __attribute__((ext_vector_type(4)));
typedef float f32x4 __attribute__((ext_vector_type(4)));
typedef short bf16x8 __attribute__((ext_vector_type(8)));
typedef GAS unsigned gu32;
typedef GAS unsigned long long gu64;
#define RLX_AGENT __ATOMIC_RELAXED, __HIP_MEMORY_SCOPE_AGENT
#define LDS_WAIT() asm volatile("s_waitcnt lgkmcnt(0)" ::: "memory")
#define VM_WAIT() asm volatile("s_waitcnt vmcnt(0)" ::: "memory")
__device__ __forceinline__ unsigned long long rt() { return __builtin_amdgcn_s_memrealtime(); }
__device__ __forceinline__ unsigned f2bf(float f) { unsigned u = __builtin_bit_cast(unsigned, f); return (u + 0x7fffu + ((u >> 16) & 1u)) >> 16; }
__device__ __forceinline__ unsigned pk2(float lo, float hi) { return f2bf(lo) | (f2bf(hi) << 16); }

#define XB_TMO      128
#define XB_XCNT(j)  (256  + 64 * (j))
#define XB_XSUB(j)  (1280 + 64 * (j))
#define XB_XGEN(j)  (2304 + 64 * (j))
#define XB_TOP      3328
#define XB_TOPGEN   3392
#define XCD_BAR_WORDS 3456
#define XB_SPIN_CAP (1u << 18)

__device__ __forceinline__ unsigned xb_ld(unsigned* p)              { return __hip_atomic_load(p, __ATOMIC_RELAXED, __HIP_MEMORY_SCOPE_AGENT); }
__device__ __forceinline__ unsigned xb_add(unsigned* p, unsigned v) { return __hip_atomic_fetch_add(p, v, __ATOMIC_RELAXED, __HIP_MEMORY_SCOPE_AGENT); }
__device__ __forceinline__ unsigned xb_xcc_id() { return (unsigned)__builtin_amdgcn_s_getreg((3 << 11) | 20) & 0xFu; }
#define XB_SPIN(cond, bar) do { unsigned _sp = 0; while (cond) { __builtin_amdgcn_s_sleep(1); \
    if ((++_sp & 255u) == 0u) { if (xb_ld(&(bar)[XB_TMO])) break; if (_sp > XB_SPIN_CAP) { atomicAdd(&(bar)[XB_TMO], 1u); break; } } } } while (0)

struct XcdBarrier {
    unsigned* bar; unsigned x;
    volatile LAS unsigned* st;
};

__device__ __forceinline__ XcdBarrier xcd_barrier_post(unsigned* bar, volatile LAS unsigned* st) {
    XcdBarrier b; b.bar = bar; b.x = xb_xcc_id(); b.st = st;
    if (threadIdx.x == 0) (void)xb_add(&bar[XB_XCNT(b.x)], 1u);
    return b;
}
__device__ __forceinline__ void xcd_barrier_complete(unsigned* bar, unsigned x, unsigned& nloc, unsigned& nx) {
    const unsigned G = gridDim.x * gridDim.y * gridDim.z;
    unsigned sum, cnt, mine, sp = 0u;
    for (;;) {
        sum = 0u; cnt = 0u; mine = 0u;
#pragma unroll
        for (unsigned j = 0; j < 16; ++j) { const unsigned c = xb_ld(&bar[XB_XCNT(j)]); sum += c; cnt += (c > 0u) ? 1u : 0u; mine = (j == x) ? c : mine; }
        if (sum == G) break;
        __builtin_amdgcn_s_sleep(1);
        if ((++sp & 255u) == 0u) { if (xb_ld(&bar[XB_TMO])) break; if (sp > XB_SPIN_CAP) { atomicAdd(&bar[XB_TMO], 1u); break; } }
    }
    nloc = mine > 0u ? mine : 1u; nx = cnt > 0u ? cnt : 1u;
}

__device__ __forceinline__ void xcd_barrier(const XcdBarrier& b) {
    asm volatile("s_waitcnt vmcnt(0)" ::: "memory");
    __syncthreads();
    if (threadIdx.x == 0) {
        unsigned* bar = b.bar;
        __builtin_amdgcn_s_waitcnt(0);
        unsigned nloc = b.st[0], nx = b.st[1];
        if (nloc == 0u) { xcd_barrier_complete(bar, b.x, nloc, nx); b.st[0] = nloc; b.st[1] = nx; }
        const unsigned old = xb_add(&bar[XB_XSUB(b.x)], 1u);
        const unsigned gen = old / nloc;
        if (old + 1u == (gen + 1u) * nloc) {
            __builtin_amdgcn_fence(__ATOMIC_RELEASE, "agent");
            asm volatile("s_waitcnt vmcnt(0)" ::: "memory");
            const unsigned og = xb_add(&bar[XB_TOP], 1u);
            const unsigned tg = og / nx;
            if (og + 1u == (tg + 1u) * nx) xb_add(&bar[XB_TOPGEN], 1u);
            else XB_SPIN(xb_ld(&bar[XB_TOPGEN]) == tg, bar);
            __builtin_amdgcn_fence(__ATOMIC_ACQUIRE, "agent");
            xb_add(&bar[XB_XGEN(b.x)], 1u);
            asm volatile("s_waitcnt vmcnt(0)" ::: "memory");
        } else {
            XB_SPIN(xb_ld(&bar[XB_XGEN(b.x)]) == gen, bar);
            __builtin_amdgcn_fence(__ATOMIC_ACQUIRE, "agent");
            asm volatile("s_waitcnt vmcnt(0)" ::: "memory");
        }
    }
    __syncthreads();
}
constexpr int NWAVES = 8, NTHREADS = 512;
constexpr int DM = 1024, SEQ = 8192, NPROMPT = 2, NSAMP = 128, TSAMP = 8, NMETA = 16;
constexpr int ROW_S = NPROMPT * SEQ;
constexpr int ROW_M = ROW_S + NSAMP * TSAMP;
constexpr int NROWS = ROW_M + NMETA;
constexpr int MP = 17664;
constexpr int DINNER = 2048, NHEADS = 32, HD = 64, NGROUPS = 8, DSTATE = 128, CONVD = 4096, INPROJ = 6176, INPROJ_P = 6400, ZXW = 6144;
constexpr int DFF = 4096, NKV = 4, NQ = 16, KVW = 512;
constexpr float EPS = 1e-5f;
constexpr int LDX = 136;

constexpr size_t O_YP = 0, O_YS = O_YP + (size_t)NPROMPT * SEQ * DM, O_PCONV = O_YS + (size_t)NSAMP * TSAMP * DM, O_PSSM = O_PCONV + 2 * 2 * 3 * 4096,
    O_PCK = O_PSSM + (size_t)2 * 2 * 32 * 64 * 128, O_PCV = O_PCK + 2 * 128 * 256, O_SCONV = O_PCV + 2 * 128 * 256, O_SSSM = O_SCONV + (size_t)2 * 128 * 3 * 4096,
    O_SCK = O_SSSM + (size_t)2 * 128 * 32 * 64 * 128, O_SCV = O_SCK + (size_t)128 * 128 * 256, O_END = O_SCV + (size_t)128 * 128 * 256;

constexpr size_t MiB = 1u << 20;
constexpr size_t WS_CTL = 0, CTL_ZERO_BYTES = 64 * 1024;
constexpr size_t SZ_WIN = (size_t)INPROJ_P * 1024 * 2, SZ_WOUT = (size_t)1024 * 2048 * 2, SZ_WUP = (size_t)4096 * 1024 * 2, SZ_WDN = SZ_WUP, SZ_WQKV0 = (size_t)1536 * 1024 * 2, SZ_WQ1 = (size_t)1024 * 1024 * 2, SZ_WO = SZ_WQ1;
constexpr size_t WS_WIN = 1 * MiB, WS_WOUT = WS_WIN + 2 * SZ_WIN, WS_WUP = WS_WOUT + 2 * SZ_WOUT, WS_WDN = WS_WUP + 4 * SZ_WUP, WS_WQKV0 = WS_WDN + 4 * SZ_WDN, WS_WQ1 = WS_WQKV0 + SZ_WQKV0, WS_WO = WS_WQ1 + SZ_WQ1, WS_WEND = WS_WO + 2 * SZ_WO;
constexpr size_t al1m(size_t x) { return (x + MiB - 1) / MiB * MiB; }
constexpr size_t WS_H = al1m(WS_WEND), WS_HN = al1m(WS_H + (size_t)MP * 1024 * 4), WS_ZX = al1m(WS_HN + (size_t)MP * 1024 * 2), WS_DT = al1m(WS_ZX + (size_t)MP * ZXW * 2),
    WS_XC = al1m(WS_DT + (size_t)MP * 32 * 4), WS_YN = al1m(WS_XC + (size_t)MP * 4096 * 2), WS_CS = al1m(WS_YN + (size_t)MP * 2048 * 2), WS_CD = al1m(WS_CS + (size_t)129 * 32 * 8192 * 4), WS_SLAB = al1m(WS_CD + 129 * 32 * 4), WS_HSB = al1m(WS_SLAB + (size_t)8 * 1280 * 1024 * 4), WS_END = al1m(WS_HSB + (size_t)128 * 32 * 8192 * 2);
constexpr size_t WS_U = WS_ZX;
constexpr size_t WS_Q = WS_XC, WS_KV = WS_Q + (size_t)MP * 1024 * 2, WS_AO = WS_KV + (size_t)MP * 512 * 2;
static_assert(WS_AO + (size_t)MP * 1024 * 2 <= WS_YN, "attention overlay");
constexpr int CW_BAR = 4096;
static_assert((8192 + 64 * 16 + 64 * 4) * 4 <= 64 * 1024, "control words inside the zeroed part");
constexpr int CW_FLAG2 = 8192 + 64 * 16, LEFT_CU0 = 176;
constexpr int CW_FLAG = 8192, ROWJOB_WGS = 64;
constexpr size_t WS_SS = WS_HN;

constexpr int RING_BYTES = 131072, LDS_BYTES = 163840, LDSCTL_OFF = LDS_BYTES - 512, MISC_OFF = LDSCTL_OFF + 320;
constexpr int CWT_OFF = 147456;
static_assert(CWT_OFF + 5 * 512 * 4 <= LDSCTL_OFF, "conv weight table");

typedef unsigned u32x2 __attribute__((ext_vector_type(2)));
typedef unsigned u32x4 __attribute__((ext_vector_type(4)));
__device__ __forceinline__ int ltid() { int t = threadIdx.x; asm volatile("" : "+v"(t)); return t; }
__device__ __forceinline__ float bf2f(unsigned short b) { return __uint_as_float((unsigned)b << 16); }
__device__ __forceinline__ float bflo(unsigned w) { return __uint_as_float(w << 16); }
__device__ __forceinline__ float bfhi(unsigned w) { return __uint_as_float(w & 0xffff0000u); }
__device__ __forceinline__ unsigned pkbf(float lo, float hi) { return pg8::cvt_pk_bf16(lo, hi); }
#define dpp_f(v, ctrl) __builtin_bit_cast(float, __builtin_amdgcn_update_dpp(0, __builtin_bit_cast(int, (float)(v)), (ctrl), 0xf, 0xf, true))
__device__ __forceinline__ float wave_sum(float v) {
    v += dpp_f(v, 0xB1); v += dpp_f(v, 0x4E); v += dpp_f(v, 0x141); v += dpp_f(v, 0x140);
    v += __shfl_xor(v, 16); v += __shfl_xor(v, 32);
    return v;
}
__device__ __forceinline__ float frcp(float x) { return __builtin_amdgcn_rcpf(x); }
__device__ __forceinline__ float sigmoid_f(float x) { return frcp(1.f + __expf(-x)); }
#define MFMA16(b, a, c) __builtin_amdgcn_mfma_f32_16x16x32_bf16((b), (a), (c), 0, 0, 0)

struct Args {
    const float* in[26]; float* out; unsigned char* ws; int ph_lo, ph_hi;
};
typedef const __attribute__((address_space(4))) Args* ArgsP;
enum { I_XP = 0, I_XS, I_SCONV, I_SSSM, I_CK, I_CV, I_META, I_ANORM, I_AIN, I_ACONVW, I_ACONVB, I_ADTB, I_ALOG, I_ADSKIP, I_AGATE, I_AOUT, I_KVNORM, I_WKV, I_BNORM, I_WQ, I_SINKS, I_WO, I_MLPNORM, I_WUP, I_WDOWN, I_FNORM };

__device__ __forceinline__ void transpose_item(const float* W, const float* scale, int K, int N, bf16* WT, int row_off, LAS unsigned* scr, int item, int lane) {
    const int nblk = (N + 63) / 64, kb = item / nblk, nb = item % nblk, k0 = 64 * kb, n0 = 64 * nb;
    const bool ok = (n0 + lane < N);
    const float* src = W + (size_t)k0 * N + n0 + (ok ? lane : 0);
    float v[64];
#pragma unroll
    for (int i = 0; i < 64; ++i) v[i] = __builtin_nontemporal_load(src + (size_t)i * N);
    if (!ok) {
#pragma unroll
        for (int i = 0; i < 64; ++i) v[i] = 0.f;
    }
    if (scale) {
#pragma unroll
        for (int i = 0; i < 64; ++i) v[i] *= scale[k0 + i];
    }
#pragma unroll
    for (int i = 0; i < 32; ++i) scr[lane * 33 + i] = pkbf(v[2 * i], v[2 * i + 1]);
    LDS_WAIT(); asm volatile("" ::: "memory");
    const int c = lane & 7;
#pragma unroll
    for (int j = 0; j < 8; ++j) { const int n = (lane >> 3) + 8 * j; const LAS unsigned* sp = scr + n * 33 + 4 * c;
        v4u o; o.x = sp[0]; o.y = sp[1]; o.z = sp[2]; o.w = sp[3];
        if (n0 + n < N) *(GAS v4u*)(WT + (size_t)(row_off + n0 + n) * K + k0 + 8 * c) = o; }
    LDS_WAIT(); asm volatile("" ::: "memory");
}
struct WJob { const float* W; const float* scale; int K, N; bf16* WT; int row_off; int items; };

__device__ __forceinline__ void phase_prologue(ArgsP a, LAS unsigned char* lds, int wave, int lane, unsigned jbmask, int cu0, int cu1) {
    LAS unsigned* scr = (LAS unsigned*)(lds + wave * 16384);
    const int gw = ((int)blockIdx.x - cu0) * NWAVES + wave, NGW = (cu1 - cu0) * NWAVES;
    unsigned char* ws = a->ws;
    int off = 0;
#pragma unroll 1
    for (int jb = 0; jb < 17; ++jb) {
        if (!((jbmask >> jb) & 1u)) continue;
        WJob J;
        if (jb < 2)       { const int i = jb;      J = WJob{a->in[I_AIN] + (size_t)i * 1024 * INPROJ, a->in[I_ANORM] + i * 1024, 1024, INPROJ, (bf16*)(ws + WS_WIN + i * SZ_WIN), 0, 0}; }
        else if (jb < 4)  { const int i = jb - 2;  J = WJob{a->in[I_AOUT] + (size_t)i * 2048 * 1024, a->in[I_AGATE] + i * 2048, 2048, 1024, (bf16*)(ws + WS_WOUT + i * SZ_WOUT), 0, 0}; }
        else if (jb < 8)  { const int l = jb - 4;  J = WJob{a->in[I_WUP] + (size_t)l * 1024 * 4096, a->in[I_MLPNORM] + l * 1024, 1024, 4096, (bf16*)(ws + WS_WUP + l * SZ_WUP), 0, 0}; }
        else if (jb < 12) { const int l = jb - 8;  J = WJob{a->in[I_WDOWN] + (size_t)l * 4096 * 1024, nullptr, 4096, 1024, (bf16*)(ws + WS_WDN + l * SZ_WDN), 0, 0}; }
        else if (jb == 12) { J = WJob{a->in[I_WQ], a->in[I_BNORM], 1024, 1024, (bf16*)(ws + WS_WQKV0), 0, 0}; }
        else if (jb == 13) { J = WJob{a->in[I_WKV], a->in[I_KVNORM], 1024, 512, (bf16*)(ws + WS_WQKV0), 1024, 0}; }
        else if (jb == 14) { J = WJob{a->in[I_WQ] + (size_t)1024 * 1024, a->in[I_BNORM] + 1024, 1024, 1024, (bf16*)(ws + WS_WQ1), 0, 0}; }
        else { const int j = jb - 15; J = WJob{a->in[I_WO] + (size_t)j * 1024 * 1024, nullptr, 1024, 1024, (bf16*)(ws + WS_WO + j * SZ_WO), 0, 0}; }
        const int items = (J.K / 64) * ((J.N + 63) / 64);
        int first = (gw - off) % NGW; if (first < 0) first += NGW;
        for (int it = first; it < items; it += NGW) transpose_item(J.W, J.scale, J.K, J.N, J.WT, J.row_off, scr, it, lane);
        off = (off + items) % NGW;
        if (jb < 2) {
            const int gt = gw * 64 + lane, NT = NGW * 64;
            const int per = (INPROJ_P - INPROJ) * 1024 * 2 / 16;
            unsigned z = 0u; asm volatile("" : "+v"(z));
            for (int e = gt; e < per; e += NT) *(v4u*)(ws + WS_WIN + jb * SZ_WIN + (size_t)INPROJ * 1024 * 2 + (size_t)e * 16) = (v4u){z, z, z, z};
        }
    }
}

__device__ __forceinline__ void row_ld_bf(const bf16* __restrict__ p, int lane, float (&v)[16]) {
    const u32x4 a0 = *(const u32x4*)(p + 8 * lane), a1 = *(const u32x4*)(p + 512 + 8 * lane);
    v[0] = bflo(a0.x); v[1] = bfhi(a0.x); v[2] = bflo(a0.y); v[3] = bfhi(a0.y); v[4] = bflo(a0.z); v[5] = bfhi(a0.z); v[6] = bflo(a0.w); v[7] = bfhi(a0.w);
    v[8] = bflo(a1.x); v[9] = bfhi(a1.x); v[10] = bflo(a1.y); v[11] = bfhi(a1.y); v[12] = bflo(a1.z); v[13] = bfhi(a1.z); v[14] = bflo(a1.w); v[15] = bfhi(a1.w);
}
__device__ __forceinline__ void row_ld_f32(const float* __restrict__ p, int lane, float (&v)[16], bool nt) {
    f32x4 q[4];
    if (nt) { q[0] = __builtin_nontemporal_load((const f32x4*)(p + 8 * lane)); q[1] = __builtin_nontemporal_load((const f32x4*)(p + 8 * lane + 4)); q[2] = __builtin_nontemporal_load((const f32x4*)(p + 512 + 8 * lane)); q[3] = __builtin_nontemporal_load((const f32x4*)(p + 512 + 8 * lane + 4)); }
    else { q[0] = *(const f32x4*)(p + 8 * lane); q[1] = *(const f32x4*)(p + 8 * lane + 4); q[2] = *(const f32x4*)(p + 512 + 8 * lane); q[3] = *(const f32x4*)(p + 512 + 8 * lane + 4); }
#pragma unroll
    for (int k = 0; k < 4; ++k) { v[4 * k] = q[k].x; v[4 * k + 1] = q[k].y; v[4 * k + 2] = q[k].z; v[4 * k + 3] = q[k].w; }
}
__device__ __forceinline__ void row_st_bf(bf16* __restrict__ p, int lane, const float (&v)[16], float sc) {
    u32x4 a0, a1;
    a0.x = pkbf(v[0] * sc, v[1] * sc); a0.y = pkbf(v[2] * sc, v[3] * sc); a0.z = pkbf(v[4] * sc, v[5] * sc); a0.w = pkbf(v[6] * sc, v[7] * sc);
    a1.x = pkbf(v[8] * sc, v[9] * sc); a1.y = pkbf(v[10] * sc, v[11] * sc); a1.z = pkbf(v[12] * sc, v[13] * sc); a1.w = pkbf(v[14] * sc, v[15] * sc);
    *(u32x4*)(p + 8 * lane) = a0; *(u32x4*)(p + 512 + 8 * lane) = a1;
}
__device__ __forceinline__ float row_rs(const float (&v)[16]) {
    float s = 0.f;
#pragma unroll
    for (int k = 0; k < 16; ++k) s += v[k] * v[k];
    return rsqrtf(wave_sum(s) * (1.f / DM) + EPS);
}
__device__ __forceinline__ float row_ss(const float (&v)[16]) {
    float s = 0.f;
#pragma unroll
    for (int k = 0; k < 16; ++k) s += v[k] * v[k];
    return wave_sum(s);
}
__device__ __forceinline__ void phase_rows(ArgsP a, int from_inputs, int nslab, int ver, int jobs, int wave, int lane) {
    bf16* __restrict__ H = (bf16*)(a->ws + WS_H); f32x4* __restrict__ SS = (f32x4*)(a->ws + WS_SS) + (size_t)ver * MP; const float* __restrict__ SLAB = (const float*)(a->ws + WS_SLAB);
    const int gw = ((int)blockIdx.x - ((int)gridDim.x - jobs)) * NWAVES + wave, NGW = jobs * NWAVES;
    for (int m = ROW_S + gw; m < MP; m += NGW) {
        if (m >= NROWS) { unsigned z = 0u; asm volatile("" : "+v"(z));
            if (from_inputs) { *(u32x4*)(H + (size_t)m * DM + 8 * lane) = (u32x4){z, z, z, z}; *(u32x4*)(H + (size_t)m * DM + 512 + 8 * lane) = (u32x4){z, z, z, z}; }
            if (lane == 0) SS[m] = (f32x4){__uint_as_float(z), __uint_as_float(z), __uint_as_float(z), __uint_as_float(z)};
            continue; }
        float v[16];
        if (from_inputs) row_ld_f32((m < ROW_M) ? a->in[I_XS] + (size_t)(m - ROW_S) * DM : a->in[I_META] + (size_t)(m - ROW_M) * DM, lane, v, false);
        else row_ld_bf(H + (size_t)m * DM, lane, v);
        float sv[8][16];
#pragma unroll
        for (int sl = 0; sl < 8; ++sl) { if (sl < nslab) row_ld_bf((const bf16*)SLAB + (size_t)sl * (1280 * 1024) + (size_t)(m - ROW_S) * DM, lane, sv[sl]); else {
#pragma unroll
                for (int k = 0; k < 16; ++k) sv[sl][k] = 0.f; } }
#pragma unroll
        for (int sl = 0; sl < 8; ++sl)
#pragma unroll
            for (int k = 0; k < 16; ++k) v[k] += sv[sl][k];
        row_st_bf(H + (size_t)m * DM, lane, v, 1.f);
        const float ss = row_ss(v);
        if (lane == 0) SS[m] = (f32x4){ss, 0.f, 0.f, 0.f};
    }
    if (!from_inputs) return;
    for (int m0 = 4 * gw; m0 < ROW_S; m0 += 4 * NGW) {
        float v[4][16];
#pragma unroll
        for (int q = 0; q < 4; ++q) row_ld_f32(a->in[I_XP] + (size_t)(m0 + q) * DM, lane, v[q], false);
#pragma unroll
        for (int q = 0; q < 4; ++q) { row_st_bf(H + (size_t)(m0 + q) * DM, lane, v[q], 1.f); const float ss = row_ss(v[q]); if (lane == 0) SS[m0 + q] = (f32x4){ss, 0.f, 0.f, 0.f}; }
    }
}
__device__ __forceinline__ void phase_final(ArgsP a, int wave, int lane) {
    const bf16* __restrict__ H = (const bf16*)(a->ws + WS_H); const float* __restrict__ fw = a->in[I_FNORM]; const float* __restrict__ SLAB = (const float*)(a->ws + WS_SLAB);
    const int gw = blockIdx.x * NWAVES + wave, NGW = gridDim.x * NWAVES;
    float w[16]; row_ld_f32(fw, lane, w, false);
    for (int m = gw; m < ROW_M; m += NGW) {
        float v[16]; row_ld_bf(H + (size_t)m * DM, lane, v);
        if (m >= ROW_S) {
#pragma unroll 1
            for (int sl = 0; sl < 8; ++sl) { float t[16]; row_ld_bf((const bf16*)SLAB + (size_t)sl * (1280 * 1024) + (size_t)(m - ROW_S) * DM, lane, t);
#pragma unroll
                for (int k = 0; k < 16; ++k) v[k] += t[k]; }
        }
        const float rs = row_rs(v);
        float* o = a->out + O_YP + (size_t)m * DM;
        __builtin_nontemporal_store((f32x4){v[0] * rs * w[0], v[1] * rs * w[1], v[2] * rs * w[2], v[3] * rs * w[3]}, (f32x4*)(o + 8 * lane));
        __builtin_nontemporal_store((f32x4){v[4] * rs * w[4], v[5] * rs * w[5], v[6] * rs * w[6], v[7] * rs * w[7]}, (f32x4*)(o + 8 * lane + 4));
        __builtin_nontemporal_store((f32x4){v[8] * rs * w[8], v[9] * rs * w[9], v[10] * rs * w[10], v[11] * rs * w[11]}, (f32x4*)(o + 512 + 8 * lane));
        __builtin_nontemporal_store((f32x4){v[12] * rs * w[12], v[13] * rs * w[13], v[14] * rs * w[14], v[15] * rs * w[15]}, (f32x4*)(o + 512 + 8 * lane + 4));
    }
}

__device__ __forceinline__ void unpack8(const u32x4 w, float (&f)[8]) { f[0] = bflo(w.x); f[1] = bfhi(w.x); f[2] = bflo(w.y); f[3] = bfhi(w.y); f[4] = bflo(w.z); f[5] = bfhi(w.z); f[6] = bflo(w.w); f[7] = bfhi(w.w); }
__device__ __forceinline__ void ld8f(const float* __restrict__ p, float (&f)[8]) { const f32x4 x0 = *(const f32x4*)p, x1 = *(const f32x4*)(p + 4); f[0]=x0.x;f[1]=x0.y;f[2]=x0.z;f[3]=x0.w;f[4]=x1.x;f[5]=x1.y;f[6]=x1.z;f[7]=x1.w; }
#define TSW(ch) ((((ch) >> 3) & 7) << 3)
struct ConvW { float w0[8], w1[8], w2[8], w3[8], bs[8]; };
__device__ __forceinline__ void conv_load_w(const float* __restrict__ cw, const float* __restrict__ cb, int c0, ConvW& W) { ld8f(cw + c0, W.w0); ld8f(cw + CONVD + c0, W.w1); ld8f(cw + 2 * CONVD + c0, W.w2); ld8f(cw + 3 * CONVD + c0, W.w3); ld8f(cb + c0, W.bs); }
__device__ __forceinline__ void conv_load_w_lds(const unsigned char* lds, int chl, ConvW& W) { const float* tab = (const float*)(lds + CWT_OFF) + chl; ld8f(tab, W.w0); ld8f(tab + 512, W.w1); ld8f(tab + 1024, W.w2); ld8f(tab + 1536, W.w3); ld8f(tab + 2048, W.bs); }
__device__ __forceinline__ void conv_fill_table(const float* __restrict__ cw, const float* __restrict__ cb, unsigned char* lds, int g) {
    float* tab = (float*)(lds + CWT_OFF);
    for (int i = ltid(); i < 5 * 512; i += NTHREADS) { const int k = i >> 9, ch = i & 511, cc = (ch < 256) ? g * 256 + ch : (ch < 384) ? 2048 + g * 128 + (ch - 256) : 3072 + g * 128 + (ch - 384); tab[i] = (k < 4) ? cw[(size_t)k * CONVD + cc] : cb[cc]; }
    __syncthreads();
}
__device__ __forceinline__ void conv_load_run(const bf16* __restrict__ ZX, int Rrow, int c0, int pk, bool valid, u32x4 (&raw)[11]) {
#pragma unroll
    for (int t = 0; t < 8; ++t) { raw[3 + t] = (u32x4){0u, 0u, 0u, 0u}; if (valid) raw[3 + t] = *(const u32x4*)(ZX + (size_t)(Rrow + t) * ZXW + 2048 + c0); }
#pragma unroll
    for (int t = 0; t < 3; ++t) { const int rr = (pk == 1) ? ROW_M + 13 + t : Rrow - 3 + t; raw[t] = (u32x4){0u, 0u, 0u, 0u}; if (valid && pk != 2) raw[t] = *(const u32x4*)(ZX + (size_t)rr * ZXW + 2048 + c0); }
}
template <int J> __device__ __forceinline__ void conv_channel(const u32x4 (&raw)[11], const ConvW& W, float (&o)[8]) {
    float x[11];
#pragma unroll
    for (int i = 0; i < 11; ++i) { const unsigned w = raw[i][J >> 1]; x[i] = (J & 1) ? bfhi(w) : bflo(w); }
#pragma unroll
    for (int t = 0; t < 8; ++t) { const float v = W.bs[J] + W.w0[J] * x[t] + W.w1[J] * x[t + 1] + W.w2[J] * x[t + 2] + W.w3[J] * x[t + 3]; o[t] = v * sigmoid_f(v); }
}
template <int J> __device__ __forceinline__ void conv_store_t(const u32x4 (&raw)[11], const ConvW& W, const float (&scale)[8], bf16* T, int ch0, int run) {
    float o[8]; conv_channel<J>(raw, W, o);
    u32x4 w; w.x = pkbf(o[0] * scale[0], o[1] * scale[1]); w.y = pkbf(o[2] * scale[2], o[3] * scale[3]); w.z = pkbf(o[4] * scale[4], o[5] * scale[5]); w.w = pkbf(o[6] * scale[6], o[7] * scale[7]);
    *(u32x4*)(T + (ch0 + J) * LDX + ((8 * run) ^ TSW(ch0 + J))) = w;
}
__device__ __forceinline__ void conv_item_t(const u32x4 (&raw)[11], const ConvW& W, const float (&scale)[8], bf16* T, int ch0, int run) {
    conv_store_t<0>(raw, W, scale, T, ch0, run); conv_store_t<1>(raw, W, scale, T, ch0, run); conv_store_t<2>(raw, W, scale, T, ch0, run); conv_store_t<3>(raw, W, scale, T, ch0, run);
    conv_store_t<4>(raw, W, scale, T, ch0, run); conv_store_t<5>(raw, W, scale, T, ch0, run); conv_store_t<6>(raw, W, scale, T, ch0, run); conv_store_t<7>(raw, W, scale, T, ch0, run);
}
__device__ __forceinline__ void conv_item_n(const u32x4 (&raw)[11], const ConvW& W, bf16* N, int run, int colel) {
    float p0[8], p1[8], p2[8]; unpack8(raw[0], p0); unpack8(raw[1], p1); unpack8(raw[2], p2);
#pragma unroll
    for (int t = 0; t < 8; ++t) { float x[8]; unpack8(raw[3 + t], x); float o[8];
#pragma unroll
        for (int j = 0; j < 8; ++j) { const float v = W.bs[j] + W.w0[j] * p0[j] + W.w1[j] * p1[j] + W.w2[j] * p2[j] + W.w3[j] * x[j]; o[j] = v * sigmoid_f(v); }
        u32x4 w; w.x = pkbf(o[0], o[1]); w.y = pkbf(o[2], o[3]); w.z = pkbf(o[4], o[5]); w.w = pkbf(o[6], o[7]);
        *(u32x4*)(N + (8 * run + t) * LDX + colel) = w;
#pragma unroll
        for (int j = 0; j < 8; ++j) { p0[j] = p1[j]; p1[j] = p2[j]; p2[j] = x[j]; } }
}
__device__ __forceinline__ void conv_state_out(const u32x4 (&raw)[11], float* __restrict__ dst  ) {
#pragma unroll
    for (int k = 0; k < 3; ++k) { float x[8]; unpack8(raw[8 + k], x); *(f32x4*)(dst + (size_t)k * CONVD) = (f32x4){x[0], x[1], x[2], x[3]}; *(f32x4*)(dst + (size_t)k * CONVD + 4) = (f32x4){x[4], x[5], x[6], x[7]}; }
}

__device__ __forceinline__ void ssd_acs_load(const float* DT, const float* alog, int R0, int len, int h0, int wave, int lane, float& d0, float& d1, float& al) {
    d0 = 0.f; d1 = 0.f; al = 0.f;
    if (wave < 4) { const int r = wave, l0 = 2 * lane; al = alog[h0 + r];
        if (l0 < len) d0 = DT[(size_t)(R0 + l0) * 32 + h0 + r];
        if (l0 + 1 < len) d1 = DT[(size_t)(R0 + l0 + 1) * 32 + h0 + r]; }
}
__device__ __forceinline__ void ssd_acs_fin(float al, float d0, float d1, float* s_dt, float* s_acs, float* s_dve, int wave, int lane) {
    if (wave < 4) {
        const int r = wave; const float An = -__expf(al);
        const int l0 = 2 * lane;
        const float a0 = d0 * An, a1 = d1 * An, s = a0 + a1;
        float incl = s;
#pragma unroll
        for (int o = 1; o < 64; o <<= 1) { const float t = __shfl_up(incl, o); if (lane >= o) incl += t; }
        const float excl = incl - s;
        s_acs[r * 128 + l0] = excl + a0; s_acs[r * 128 + l0 + 1] = excl + s;
        if (!s_dve) {
            const float tot = __shfl(excl + s, 63); s_dt[r * 128 + l0] = d0 * __expf(tot - (excl + a0)); s_dt[r * 128 + l0 + 1] = d1 * __expf(tot - (excl + s)); }
        else { s_dt[r * 128 + l0] = d0; s_dt[r * 128 + l0 + 1] = d1; }
        if (s_dve) { const float te = __shfl(excl + s, lane | 7); s_dve[r * 128 + l0] = d0 * __expf(te - (excl + a0)); s_dve[r * 128 + l0 + 1] = d1 * __expf(te - (excl + s));
            if ((lane & 7) == 7) s_dve[512 + r * 8 + (lane >> 3)] = excl + s; }
    }
}
__device__ __forceinline__ void ssd_acs(const float* DT, const float* alog, int R0, int len, int h0, float* s_dt, float* s_acs, float* s_dve, int wave, int lane) {
    float d0, d1, al; ssd_acs_load(DT, alog, R0, len, h0, wave, lane, d0, d1, al); ssd_acs_fin(al, d0, d1, s_dt, s_acs, s_dve, wave, lane);
}
#define LFRAG(base, row, ld, ks) (*(const bf16x8*)((base) + (row) * (ld) + 32 * (ks) + 8 * fq))

__device__ __forceinline__ void ssd_sample_issue(ArgsP a, int li, int b, int g, f32x4 (&st)[4][4]);
template <bool WITH_ST> __device__ __forceinline__ void ssd1_unit_t(ArgsP a, int li, unsigned char* lds, int slot, int g, int R0, int len, int sb, int sg, f32x4 (&st)[4][4]) {
    const int tid = ltid(), lane = tid & 63, wave = __builtin_amdgcn_readfirstlane(tid >> 6);
    const float* __restrict__ DT = (const float*)(a->ws + WS_DT);
    bf16* __restrict__ CS = (bf16*)(a->ws + WS_CS); float* __restrict__ CD = (float*)(a->ws + WS_CD);
    bf16* XsT = (bf16*)lds;
    bf16* BT = (bf16*)(lds + 256 * LDX * 2);
    float* s_dt = (float*)(lds + 384 * LDX * 2); float* s_acs = s_dt + 512;
    const int fr = lane & 15, fq = lane >> 4, h0 = g * 4;
    const float* __restrict__ cw = a->in[I_ACONVW] + (size_t)li * 4 * CONVD; const float* __restrict__ cbias = a->in[I_ACONVB] + (size_t)li * CONVD;
    const bf16* __restrict__ ZX = (const bf16*)(a->ws + WS_ZX);
    const bool meta = (slot == 128), chunk0 = (!meta && (slot & 63) == 0);
    const int xcb = tid & 31, xrun = tid >> 5, xc0 = g * 256 + xcb * 8;
    const int bcb = tid & 15, brun = (tid >> 4) & 15, bc0 = 2048 + g * 128 + bcb * 8;
    u32x4 rx[11], rb[11];
    conv_load_run(ZX, R0 + 8 * xrun, xc0, (xrun == 0) ? (meta ? 2 : (chunk0 ? 1 : 0)) : 0, 8 * xrun < len, rx);
    if (tid >= 256) conv_load_run(ZX, R0 + 8 * brun, bc0, (brun == 0) ? (meta ? 2 : (chunk0 ? 1 : 0)) : 0, 8 * brun < len, rb);
    { float d0, d1, al; ssd_acs_load(DT, a->in[I_ALOG] + li * NHEADS, R0, len, h0, wave, lane, d0, d1, al);
      if constexpr (WITH_ST) ssd_sample_issue(a, li, sb, sg, st);
      ssd_acs_fin(al, d0, d1, s_dt, s_acs, nullptr, wave, lane); }
    if (tid >= 256) { ConvW W; conv_load_w_lds(lds, 256 + bcb * 8, W); const float one[8] = {1.f, 1.f, 1.f, 1.f, 1.f, 1.f, 1.f, 1.f}; conv_item_t(rb, W, one, BT, bcb * 8, brun); }
    __syncthreads();
    {   ConvW W; conv_load_w_lds(lds, xcb * 8, W);
        const int r = xcb >> 3;
        const f32x4 w0 = *(const f32x4*)(s_dt + r * 128 + 8 * xrun), w1 = *(const f32x4*)(s_dt + r * 128 + 8 * xrun + 4);
        float wl[8];
#pragma unroll
        for (int t = 0; t < 4; ++t) { wl[t] = w0[t]; wl[4 + t] = w1[t]; }
        conv_item_t(rx, W, wl, XsT, xcb * 8, xrun);
    }
    __syncthreads();
    f32x4 acc[2][8];
#pragma unroll
    for (int mi = 0; mi < 2; ++mi)
#pragma unroll
        for (int ni = 0; ni < 8; ++ni) acc[mi][ni] = (f32x4){0.f, 0.f, 0.f, 0.f};
#pragma unroll
    for (int ks = 0; ks < 4; ++ks) {
        const int ra0 = 32 * wave + fr, ra1 = ra0 + 16;
        const bf16x8 a0 = *(const bf16x8*)(XsT + ra0 * LDX + ((32 * ks + 8 * fq) ^ TSW(ra0))), a1 = *(const bf16x8*)(XsT + ra1 * LDX + ((32 * ks + 8 * fq) ^ TSW(ra1)));
#pragma unroll
        for (int ni = 0; ni < 8; ++ni) { const int rb = 16 * ni + fr; const bf16x8 bb = *(const bf16x8*)(BT + rb * LDX + ((32 * ks + 8 * fq) ^ TSW(rb)));
            acc[0][ni] = MFMA16(bb, a0, acc[0][ni]); acc[1][ni] = MFMA16(bb, a1, acc[1][ni]); }
    }
#pragma unroll
    for (int mi = 0; mi < 2; ++mi) { const int hp = 32 * wave + 16 * mi + fr, r = hp >> 6, p = hp & 63;
        bf16* dst = CS + ((size_t)(slot * 32 + h0 + r) * 64 + p) * 128 + 4 * fq;
#pragma unroll
        for (int ni = 0; ni < 8; ++ni) { u32x2 w; w.x = pkbf(acc[mi][ni][0], acc[mi][ni][1]); w.y = pkbf(acc[mi][ni][2], acc[mi][ni][3]); *(u32x2*)(dst + 16 * ni) = w; } }
    if (tid < 4) CD[slot * 32 + h0 + tid] = __expf(s_acs[tid * 128 + 127]);
    __syncthreads();
}

__device__ __forceinline__ void ssd_sample_issue(ArgsP a, int li, int b, int g, f32x4 (&st)[4][4]) {
    const int tid = ltid(), p = tid >> 3, nb = tid & 7;
    const float* __restrict__ sin_ = a->in[I_SSSM] + ((size_t)((li * NSAMP + b) * NHEADS + g * 4) * 64 + p) * 128 + 4 * nb;
#pragma unroll
    for (int r = 0; r < 4; ++r)
#pragma unroll
        for (int kk = 0; kk < 4; ++kk) st[r][kk] = __builtin_nontemporal_load((const f32x4*)(sin_ + (size_t)r * 8192 + 32 * kk));
}
__device__ __forceinline__ void ssd_sample_unit(ArgsP a, int li, unsigned char* lds, int b, int g, f32x4 (&st)[4][4]) {
    const int tid = ltid(), lane = tid & 63, wave = __builtin_amdgcn_readfirstlane(tid >> 6);
    const bf16* __restrict__ ZX = (const bf16*)(a->ws + WS_ZX); const float* __restrict__ DT = (const float*)(a->ws + WS_DT); bf16* __restrict__ YN = (bf16*)(a->ws + WS_YN);
    float* sX = (float*)lds; float* sB = sX + 8 * 256; float* sC = sB + 8 * 128; float* sY = sC + 8 * 128; float* sDt = sY + 8 * 256;
    const int R0 = ROW_S + b * 8, h0 = g * 4;
    const int p = tid >> 3, nb = tid & 7;
    float* __restrict__ sout = a->out + O_SSSM + ((size_t)((li * NSAMP + b) * NHEADS + h0) * 64 + p) * 128 + 4 * nb;
    const u32x2 zz_early = *(const u32x2*)(ZX + (size_t)(R0 + wave) * ZXW + g * 256 + lane * 4);
    {
        const float* __restrict__ cw = a->in[I_ACONVW] + (size_t)li * 4 * CONVD; const float* __restrict__ cbias = a->in[I_ACONVB] + (size_t)li * CONVD;
        const int t = tid >> 6, ck = tid & 63;
        const int c0 = (ck < 32) ? g * 256 + ck * 8 : (ck < 48) ? 2048 + g * 128 + (ck - 32) * 8 : 3072 + g * 128 + (ck - 48) * 8;
        float* dst = (ck < 32) ? sX + t * 256 + ck * 8 : (ck < 48) ? sB + t * 128 + (ck - 32) * 8 : sC + t * 128 + (ck - 48) * 8;
        const float* __restrict__ sc = a->in[I_SCONV] + ((size_t)(li * NSAMP + b) * 3) * CONVD + c0;
        float xr[4][8];
#pragma unroll
        for (int k = 0; k < 4; ++k) { const int tt = t - 3 + k;
            if (tt >= 0) unpack8(*(const u32x4*)(ZX + (size_t)(R0 + tt) * ZXW + 2048 + c0), xr[k]); else ld8f(sc + (size_t)(tt + 3) * CONVD, xr[k]); }
        ConvW W; conv_load_w_lds(lds, (ck < 32) ? ck * 8 : (ck < 48) ? 256 + (ck - 32) * 8 : 384 + (ck - 48) * 8, W);
        float o[8];
#pragma unroll
        for (int j = 0; j < 8; ++j) { const float v = W.bs[j] + W.w0[j] * xr[0][j] + W.w1[j] * xr[1][j] + W.w2[j] * xr[2][j] + W.w3[j] * xr[3][j]; o[j] = v * sigmoid_f(v); }
        if (ck < 32) {
            float* xd_ = sX + t * 256 + ((ck & 7) * 8) * 4 + (ck >> 3);
#pragma unroll
            for (int j = 0; j < 8; ++j) xd_[j * 4] = o[j];
        } else { *(f32x4*)dst = (f32x4){o[0], o[1], o[2], o[3]}; *(f32x4*)(dst + 4) = (f32x4){o[4], o[5], o[6], o[7]}; }
        if (t >= 5) { float* __restrict__ so = a->out + O_SCONV + ((size_t)(li * NSAMP + b) * 3 + (t - 5)) * CONVD + c0;
            *(f32x4*)so = (f32x4){xr[3][0], xr[3][1], xr[3][2], xr[3][3]}; *(f32x4*)(so + 4) = (f32x4){xr[3][4], xr[3][5], xr[3][6], xr[3][7]}; }
    }
    if (tid < 32) { const float d = DT[(size_t)(R0 + (tid >> 2)) * 32 + h0 + (tid & 3)]; sDt[tid] = d; sDt[32 + tid] = __expf(-d * __expf(a->in[I_ALOG][li * NHEADS + h0 + (tid & 3)])); }
    __syncthreads();
    float Dk[4];
#pragma unroll
    for (int r = 0; r < 4; ++r) Dk[r] = a->in[I_ADSKIP][li * NHEADS + h0 + r];
#pragma unroll
    for (int t = 0; t < 8; ++t) {
        f32x4 bv[4], cv[4];
#pragma unroll
        for (int kk = 0; kk < 4; ++kk) { bv[kk] = *(const f32x4*)(sB + t * 128 + 32 * kk + 4 * nb); cv[kk] = *(const f32x4*)(sC + t * 128 + 32 * kk + 4 * nb); }
        const f32x4 dt4 = *(const f32x4*)(sDt + t * 4), dA4 = *(const f32x4*)(sDt + 32 + t * 4), x4 = *(const f32x4*)(sX + t * 256 + p * 4);
#pragma unroll
        for (int r = 0; r < 4; ++r) {
            const float dt = dt4[r], dA = dA4[r], xv = x4[r], coef = dt * xv;
            f32x4 pv = (f32x4){0.f, 0.f, 0.f, 0.f};
#pragma unroll
            for (int kk = 0; kk < 4; ++kk) { st[r][kk] = st[r][kk] * dA + bv[kk] * coef; pv = pv + cv[kk] * st[r][kk]; }
            float v = (pv.x + pv.y) + (pv.z + pv.w);
            v += dpp_f(v, 0xB1); v += dpp_f(v, 0x4E); v += dpp_f(v, 0x141);
            if (nb == 0) sY[t * 256 + r * 64 + p] = v + Dk[r] * xv;
        }
    }
#pragma unroll
    for (int r = 0; r < 4; ++r)
#pragma unroll
        for (int kk = 0; kk < 4; ++kk) __builtin_nontemporal_store(st[r][kk], (f32x4*)(sout + (size_t)r * 8192 + 32 * kk));
    __syncthreads();
    {
        const int t = wave, c4 = lane * 4; const size_t row = (size_t)(R0 + t);
        const f32x4 y = *(const f32x4*)(sY + t * 256 + c4);
        const u32x2 zz = zz_early;
        const float z0 = bflo(zz.x), z1 = bfhi(zz.x), z2 = bflo(zz.y), z3 = bfhi(zz.y);
        const float g0 = y.x * z0 * sigmoid_f(z0), g1 = y.y * z1 * sigmoid_f(z1), g2 = y.z * z2 * sigmoid_f(z2), g3 = y.w * z3 * sigmoid_f(z3);
        const float ss = wave_sum((g0 * g0 + g1 * g1) + (g2 * g2 + g3 * g3));
        const float rs = rsqrtf(ss * (1.f / 256.f) + EPS);
        u32x2 o; o.x = pkbf(g0 * rs, g1 * rs); o.y = pkbf(g2 * rs, g3 * rs);
        *(u32x2*)(YN + row * DINNER + g * 256 + c4) = o;
    }
    __syncthreads();
}

__device__ __forceinline__ void phase_scan(ArgsP a, int li) {
    const bf16* __restrict__ CS = (const bf16*)(a->ws + WS_CS); const float* __restrict__ CD = (const float*)(a->ws + WS_CD); bf16* __restrict__ HSB = (bf16*)(a->ws + WS_HSB);
    const int gt = blockIdx.x * NTHREADS + ltid(), NT = gridDim.x * NTHREADS;
    for (int e = gt; e < 2 * 65536; e += NT) {
        const int b = e >> 16, rem = e & 65535, h = rem >> 11, pn4 = rem & 2047;
        f32x4 hc; { const u32x2 w0 = *(const u32x2*)(CS + ((size_t)(128 * 32 + h) * 2048 + pn4) * 4); hc = (f32x4){bflo(w0.x), bfhi(w0.x), bflo(w0.y), bfhi(w0.y)}; }
#pragma unroll 1
        for (int c0 = 0; c0 < 64; c0 += 16) {
            u32x2 sw[16]; float dd[16];
#pragma unroll
            for (int k = 0; k < 16; ++k) { const int slot = b * 64 + c0 + k; sw[k] = __builtin_nontemporal_load((const u32x2*)(CS + ((size_t)(slot * 32 + h) * 2048 + pn4) * 4)); dd[k] = CD[slot * 32 + h]; }
#pragma unroll
            for (int k = 0; k < 16; ++k) { const int slot = b * 64 + c0 + k; const size_t o = ((size_t)(slot * 32 + h) * 2048 + pn4) * 4;
                const f32x4 sv = (f32x4){bflo(sw[k].x), bfhi(sw[k].x), bflo(sw[k].y), bfhi(sw[k].y)};
                u32x2 w; w.x = pkbf(hc.x, hc.y); w.y = pkbf(hc.z, hc.w); *(u32x2*)(HSB + o) = w;
                hc = hc * dd[k] + sv; }
        }
        __builtin_nontemporal_store(hc, (f32x4*)(a->out + O_PSSM + ((size_t)((li * NPROMPT + b) * NHEADS + h) * 2048 + pn4) * 4));
    }
}

template <bool HI> __device__ __forceinline__ void ssd3_head_t(int r, int hb, const bf16* Cn, const bf16* BH, const bf16* xb, const bf16* xd, const float* s_dt, const float* s_acs, const float* s_dve, const f32x4 (&cb)[8], const f32x4 cbd, const bf16x8 (&cf)[4], f32x4 (&acc)[4],
                                          const bf16* __restrict__ ZX, size_t row, int g, float Dk, int l, int wave, int fr, int fq, float& ss) {
    u32x2 zz[4];
#pragma unroll
    for (int ni = 0; ni < 4; ++ni) { const int ch = g * 256 + r * 64 + 16 * ni + 4 * fq; zz[ni] = __builtin_nontemporal_load((const u32x2*)(ZX + row * ZXW + ch)); }
    const float al = s_acs[r * 128 + l];
#pragma unroll
    for (int ni = 0; ni < 4; ++ni) acc[ni] = (f32x4){0.f, 0.f, 0.f, 0.f};
    const bf16* Hs = BH + hb * 64 * LDX;
#pragma unroll
    for (int ks = 0; ks < 4; ++ks) { const bf16x8 af = cf[ks];
#pragma unroll
        for (int ni = 0; ni < 4; ++ni) { const bf16x8 bb = LFRAG(Hs, 16 * ni + fr, LDX, ks); acc[ni] = MFMA16(bb, af, acc[ni]); } }
    const float e = __expf(al);
#pragma unroll
    for (int ni = 0; ni < 4; ++ni) acc[ni] = acc[ni] * e;
    const f32x4 te0 = *(const f32x4*)(s_dve + 512 + r * 8), te1 = *(const f32x4*)(s_dve + 512 + r * 8 + 4);
    float md[4];
    { const f32x4 av = *(const f32x4*)(s_acs + r * 128 + 16 * wave + 4 * fq), dv = *(const f32x4*)(s_dt + r * 128 + 16 * wave + 4 * fq);
#pragma unroll
        for (int j = 0; j < 4; ++j) md[j] = ((4 * fq + j <= fr) ? cbd[j] * __expf(al - av[j]) * dv[j] : 0.f) + ((4 * fq + j == fr) ? Dk : 0.f); }
#pragma unroll
    for (int ks = 0; ks < 4; ++ks) if (HI ? (ks < 3 || wave >= 6) : (ks == 0 || (ks == 1 && wave >= 2))) {
        unsigned mw[4];
#pragma unroll
        for (int hf = 0; hf < 2; ++hf) { const int ni = 2 * ks + hf, s0 = 16 * ni + 4 * fq;
            const float ex = __expf(fminf(al - ((ni < 4) ? te0[ni & 3] : te1[ni & 3]), 0.f)), rowf = (HI && ni < 4) ? ex : ((ni < wave) ? ex : 0.f);
            const f32x4 dv = *(const f32x4*)(s_dve + r * 128 + s0);
            float m[4];
#pragma unroll
            for (int j = 0; j < 4; ++j) { const float t = cb[ni][j] * (rowf * dv[j]); m[j] = (HI && ni < 4) ? t : ((ni == wave) ? md[j] : t); }
            mw[2 * hf] = pkbf(m[0], m[1]); mw[2 * hf + 1] = pkbf(m[2], m[3]); }
        const u32x4 afu = (u32x4){mw[0], mw[1], mw[2], mw[3]};
        const bf16x8 af = __builtin_bit_cast(bf16x8, afu);
#pragma unroll
        for (int ni = 0; ni < 4; ++ni) { const bf16* xp = xb + (r * 64 + 16 * ni) * LDX;
            const u32x2 b0 = *(const u32x2*)(xp + ((32 * ks) ^ (16 * ni))), b1 = *(const u32x2*)(xp + ((32 * ks + 16) ^ (16 * ni)));
            const u32x4 bu = (u32x4){b0.x, b0.y, b1.x, b1.y};
            acc[ni] = MFMA16(__builtin_bit_cast(bf16x8, bu), af, acc[ni]); }
    }
#pragma unroll
    for (int ni = 0; ni < 4; ++ni) {
        const float zv[4] = {bflo(zz[ni].x), bfhi(zz[ni].x), bflo(zz[ni].y), bfhi(zz[ni].y)};
#pragma unroll
        for (int j = 0; j < 4; ++j) { const float q = acc[ni][j] * zv[j] * sigmoid_f(zv[j]); acc[ni][j] = q; ss += q * q; } }
}
__device__ __forceinline__ void ssd3_unit(ArgsP a, int li, unsigned char* lds, const bf16* __restrict__ hs, int slot, int g, int R0, int len, u32x4 (&rx)[11], int nslot, int nR0) {
    const int tid = ltid(), lane = tid & 63, wave = __builtin_amdgcn_readfirstlane(tid >> 6);
    const bf16* __restrict__ ZX = (const bf16*)(a->ws + WS_ZX); const float* __restrict__ DT = (const float*)(a->ws + WS_DT); bf16* __restrict__ YN = (bf16*)(a->ws + WS_YN);
    bf16* Cn = (bf16*)lds; bf16* BH = Cn + 128 * LDX; bf16* Xt = BH + 128 * LDX;
    float* s_dt = (float*)(Xt + 256 * LDX); float* s_acs = s_dt + 512; float* s_dve = s_acs + 512;
    const int fr = lane & 15, fq = lane >> 4, h0 = g * 4;
    {
        const float* __restrict__ cw = a->in[I_ACONVW] + (size_t)li * 4 * CONVD; const float* __restrict__ cbias = a->in[I_ACONVB] + (size_t)li * CONVD;
        const bool meta = (slot == 128), chunk0 = (!meta && (slot & 63) == 0);
        const int half = tid >> 8, ncb = tid & 15, nrun = (tid >> 4) & 15, nc0 = (half ? 2048 : 3072) + g * 128 + ncb * 8;
        const int xcb = tid & 31, xrun = tid >> 5, xc0 = g * 256 + xcb * 8;
        u32x4 rn[11];
        conv_load_run(ZX, R0 + 8 * nrun, nc0, (nrun == 0) ? (meta ? 2 : (chunk0 ? 1 : 0)) : 0, 8 * nrun < len, rn);
        ssd_acs(DT, a->in[I_ALOG] + li * NHEADS, R0, len, h0, s_dt, s_acs, s_dve, wave, lane);
        { ConvW W; conv_load_w_lds(lds, (half ? 256 : 384) + ncb * 8, W); conv_item_n(rn, W, half ? BH : Cn, nrun, ncb * 8); }
        { ConvW W; conv_load_w_lds(lds, xcb * 8, W); const float one[8] = {1.f, 1.f, 1.f, 1.f, 1.f, 1.f, 1.f, 1.f}; conv_item_t(rx, W, one, Xt, xcb * 8, xrun); }
        if (!meta && (slot & 63) == 63) {
            float* __restrict__ dst = a->out + O_PCONV + (size_t)((li * NPROMPT + (slot >> 6)) * 3) * CONVD;
            if (nrun == 15) conv_state_out(rn, dst + nc0);
            if (xrun == 15) conv_state_out(rx, dst + xc0);
        }
    }
    __syncthreads();
    u32x2 hv[8];
#pragma unroll
    for (int k = 0; k < 8; ++k) { const int item = tid + NTHREADS * k; hv[k] = (u32x2){0u, 0u}; if (hs) hv[k] = __builtin_nontemporal_load((const u32x2*)(hs + (size_t)item * 4)); }
    const bool active = (16 * wave < len);
    bf16x8 cf[4];
#pragma unroll
    for (int ks = 0; ks < 4; ++ks) cf[ks] = LFRAG(Cn, 16 * wave + fr, LDX, ks);
    f32x4 cb[8];
#pragma unroll
    for (int ni = 0; ni < 8; ++ni) cb[ni] = (f32x4){0.f, 0.f, 0.f, 0.f};
    if (active) {
#pragma unroll
    for (int ks = 0; ks < 4; ++ks) { const bf16x8 af = cf[ks];
#pragma unroll
        for (int ni = 0; ni < 8; ++ni) { const bf16x8 bb = LFRAG(BH, 16 * ni + fr, LDX, ks); cb[ni] = MFMA16(bb, af, cb[ni]); } }
    }
    __syncthreads();
#pragma unroll
    for (int k = 0; k < 8; ++k) { const int item = tid + NTHREADS * k, hp = item >> 5, n4 = item & 31; *(u32x2*)(BH + hp * LDX + n4 * 4) = hv[k]; }
#pragma unroll
    for (int k = 0; k < 8; ++k) { const int item = tid + NTHREADS * k; hv[k] = (u32x2){0u, 0u}; if (hs) hv[k] = __builtin_nontemporal_load((const u32x2*)(hs + (size_t)(2 * 8192) + (size_t)item * 4)); }
    __syncthreads();
    const int l = 16 * wave + fr;
    const size_t row = (size_t)(R0 + ((l < len) ? l : 0));
    f32x4 y0[4], y1[4], y2[4], y3[4];
    float ss = 0.f;
    const float* dsk = a->in[I_ADSKIP] + li * NHEADS + h0;
    f32x4 cbd = cb[0];
#pragma unroll
    for (int ni = 1; ni < 8; ++ni) cbd = (ni == wave) ? cb[ni] : cbd;
    const bf16* xb = Xt + fr * LDX + ((4 * fq) ^ (8 * (fr >> 3))); const bf16* xd = Xt + (4 * fq) * LDX + (fr ^ (8 * (fq >> 1)));
    if (active) {
    if (wave >= 4) ssd3_head_t<true>(0, 0, Cn, BH, xb, xd, s_dt, s_acs, s_dve, cb, cbd, cf, y0, ZX, row, g, dsk[0], l, wave, fr, fq, ss); else ssd3_head_t<false>(0, 0, Cn, BH, xb, xd, s_dt, s_acs, s_dve, cb, cbd, cf, y0, ZX, row, g, dsk[0], l, wave, fr, fq, ss);
    if (wave >= 4) ssd3_head_t<true>(1, 1, Cn, BH, xb, xd, s_dt, s_acs, s_dve, cb, cbd, cf, y1, ZX, row, g, dsk[1], l, wave, fr, fq, ss); else ssd3_head_t<false>(1, 1, Cn, BH, xb, xd, s_dt, s_acs, s_dve, cb, cbd, cf, y1, ZX, row, g, dsk[1], l, wave, fr, fq, ss);
    }
    u32x2 p0[4], p1[4];
#pragma unroll
    for (int ni = 0; ni < 4; ++ni) { p0[ni].x = pkbf(y0[ni][0], y0[ni][1]); p0[ni].y = pkbf(y0[ni][2], y0[ni][3]); p1[ni].x = pkbf(y1[ni][0], y1[ni][1]); p1[ni].y = pkbf(y1[ni][2], y1[ni][3]); }
    __syncthreads();
#pragma unroll
    for (int k = 0; k < 8; ++k) { const int item = tid + NTHREADS * k, hp = item >> 5, n4 = item & 31; *(u32x2*)(BH + hp * LDX + n4 * 4) = hv[k]; }
    if (nslot >= 0) { const int xcb = tid & 31, xrun = tid >> 5; conv_load_run(ZX, nR0 + 8 * xrun, g * 256 + xcb * 8, (xrun == 0 && (nslot & 63) == 0) ? 1 : 0, true, rx); }
    __syncthreads();
    if (active) {
    if (wave >= 4) ssd3_head_t<true>(2, 0, Cn, BH, xb, xd, s_dt, s_acs, s_dve, cb, cbd, cf, y2, ZX, row, g, dsk[2], l, wave, fr, fq, ss); else ssd3_head_t<false>(2, 0, Cn, BH, xb, xd, s_dt, s_acs, s_dve, cb, cbd, cf, y2, ZX, row, g, dsk[2], l, wave, fr, fq, ss);
    if (wave >= 4) ssd3_head_t<true>(3, 1, Cn, BH, xb, xd, s_dt, s_acs, s_dve, cb, cbd, cf, y3, ZX, row, g, dsk[3], l, wave, fr, fq, ss); else ssd3_head_t<false>(3, 1, Cn, BH, xb, xd, s_dt, s_acs, s_dve, cb, cbd, cf, y3, ZX, row, g, dsk[3], l, wave, fr, fq, ss);
    ss += __shfl_xor(ss, 16); ss += __shfl_xor(ss, 32);
    }
    const float rs = rsqrtf(ss * (1.f / 256.f) + EPS);
    if (active && l < len) {
        bf16* yrow = YN + row * DINNER + g * 256 + 4 * fq;
#pragma unroll
        for (int ni = 0; ni < 4; ++ni) {
            u32x2 w;
            w.x = pkbf(bflo(p0[ni].x) * rs, bfhi(p0[ni].x) * rs); w.y = pkbf(bflo(p0[ni].y) * rs, bfhi(p0[ni].y) * rs); *(u32x2*)(yrow + 0 * 64 + 16 * ni) = w;
            w.x = pkbf(bflo(p1[ni].x) * rs, bfhi(p1[ni].x) * rs); w.y = pkbf(bflo(p1[ni].y) * rs, bfhi(p1[ni].y) * rs); *(u32x2*)(yrow + 1 * 64 + 16 * ni) = w;
            w.x = pkbf(y2[ni][0] * rs, y2[ni][1] * rs); w.y = pkbf(y2[ni][2] * rs, y2[ni][3] * rs); *(u32x2*)(yrow + 2 * 64 + 16 * ni) = w;
            w.x = pkbf(y3[ni][0] * rs, y3[ni][1] * rs); w.y = pkbf(y3[ni][2] * rs, y3[ni][3] * rs); *(u32x2*)(yrow + 3 * 64 + 16 * ni) = w;
        }
    }
    __syncthreads();
}
__device__ __forceinline__ void phase_ssd1(ArgsP a, int li, unsigned char* lds, int tid, int wave, int lane) {
    const int c = blockIdx.x;
    conv_fill_table(a->in[I_ACONVW] + (size_t)li * 4 * CONVD, a->in[I_ACONVB] + (size_t)li * CONVD, lds, c & 7);
#pragma unroll 1
    for (int j = 0; j < 4; ++j) {
        const int u = c + 256 * j, slot = u >> 3, g = u & 7;
        f32x4 st[4][4];
        ssd1_unit_t<true>(a, li, lds, slot, g, (slot >> 6) * SEQ + (slot & 63) * 128, 128, u >> 3, u & 7, st);
        ssd_sample_unit(a, li, lds, u >> 3, u & 7, st);
    }
    if (c < 8) { f32x4 none[4][4]; ssd1_unit_t<false>(a, li, lds, 128, c, ROW_M, NMETA, 0, 0, none); }
    else if (c < 16) { u32x4 rx[11]; { const bf16* ZX = (const bf16*)(a->ws + WS_ZX); const int t_ = ltid(), xcb = t_ & 31, xrun = t_ >> 5; conv_load_run(ZX, ROW_M + 8 * xrun, (c - 8) * 256 + xcb * 8, (xrun == 0) ? 2 : 0, 8 * xrun < NMETA, rx); }
        ssd3_unit(a, li, lds, nullptr, 128, c - 8, ROW_M, NMETA, rx, -1, 0); }
}
__device__ __forceinline__ void phase_ssd3(ArgsP a, int li, unsigned char* lds, int tid, int wave, int lane) {
    const bf16* HSB = (const bf16*)(a->ws + WS_HSB);
#ifdef PROBE_STAGGER
    if (blockIdx.x & 1) { const unsigned long long t0 = __builtin_amdgcn_s_memrealtime(); while (__builtin_amdgcn_s_memrealtime() - t0 < PROBE_STAGGER) __builtin_amdgcn_s_sleep(8); }
#endif
    u32x4 rx[11];
    conv_fill_table(a->in[I_ACONVW] + (size_t)li * 4 * CONVD, a->in[I_ACONVB] + (size_t)li * CONVD, lds, (int)blockIdx.x & 7);
    { const bf16* ZX = (const bf16*)(a->ws + WS_ZX); const int u = blockIdx.x, slot = u >> 3, g = u & 7, t_ = ltid(), xcb = t_ & 31, xrun = t_ >> 5;
      conv_load_run(ZX, (slot >> 6) * SEQ + (slot & 63) * 128 + 8 * xrun, g * 256 + xcb * 8, (xrun == 0 && (slot & 63) == 0) ? 1 : 0, true, rx); }
#pragma unroll 1
    for (int u = blockIdx.x; u < 1024; u += 256) { const int slot = u >> 3, g = u & 7, un = u + 256, nslot = (un < 1024) ? (un >> 3) : -1;
        ssd3_unit(a, li, lds, HSB + (size_t)(slot * 32 + g * 4) * 8192, slot, g, (slot >> 6) * SEQ + (slot & 63) * 128, 128, rx, nslot, (nslot >> 6) * SEQ + (nslot & 63) * 128); }
}

constexpr int KS_LD = 72, VT_LD = 264, P_LD = 232, NKEYS = 208;
constexpr float SM_C = 0.125f * 1.4426950408889634f;
__device__ __forceinline__ void attn_prompt_unit(ArgsP a, int lj, unsigned char* lds, int b, int kvh, int qb, int, int, int) {
    const int tid = ltid(), lane = tid & 63, wave = __builtin_amdgcn_readfirstlane(tid >> 6);
    const bf16* __restrict__ Q = (const bf16*)(a->ws + WS_Q); const bf16* __restrict__ KV = (const bf16*)(a->ws + WS_KV); bf16* __restrict__ AO = (bf16*)(a->ws + WS_AO);
    bf16* Ks = (bf16*)lds; bf16* Vt = Ks + NKEYS * KS_LD; bf16* Pw = Vt + 64 * VT_LD + wave * 16 * P_LD;
    const int fr = lane & 15, fq = lane >> 4, t0 = qb * 64, Rb = b * SEQ;
    const int r = wave >> 1, th = (wave & 1) * 32, qh = kvh * 4 + r;
    bf16x8 q0[2], q1[2];
#pragma unroll
    for (int ks = 0; ks < 2; ++ks) { q0[ks] = *(const bf16x8*)(Q + (size_t)(Rb + t0 + th + fr) * DM + qh * 64 + 32 * ks + 8 * fq); q1[ks] = *(const bf16x8*)(Q + (size_t)(Rb + t0 + th + 16 + fr) * DM + qh * 64 + 32 * ks + 8 * fq); }
    {
        u32x4 kv[4];
#pragma unroll
        for (int k = 0; k < 4; ++k) { const int it = tid + NTHREADS * k, key = it >> 3, ch = it & 7; kv[k] = (u32x4){0u, 0u, 0u, 0u};
            if (it < NKEYS * 8) { int row; if (key < 16) row = ROW_M + key; else { int s = t0 - 128 + key - 16; if (s < 0) s = 0; row = Rb + s; }
                kv[k] = *(const u32x4*)(KV + (size_t)row * KVW + kvh * 64 + ch * 8); } }
        u32x4 v0[2], v1[2];
#pragma unroll
        for (int k = 0; k < 2; ++k) { const int it = tid + NTHREADS * k, dbl = it & 7, kp = it >> 3; v0[k] = (u32x4){0u, 0u, 0u, 0u}; v1[k] = v0[k];
            if (it < (NKEYS / 2) * 8) { const int k0 = 2 * kp, k1 = k0 + 1; int s0 = t0 - 128 + k0 - 16, s1 = t0 - 128 + k1 - 16; if (s0 < 0) s0 = 0; if (s1 < 0) s1 = 0;
                const int r0 = (k0 < 16) ? ROW_M + k0 : Rb + s0, r1 = (k1 < 16) ? ROW_M + k1 : Rb + s1;
                v0[k] = *(const u32x4*)(KV + (size_t)r0 * KVW + 256 + kvh * 64 + dbl * 8); v1[k] = *(const u32x4*)(KV + (size_t)r1 * KVW + 256 + kvh * 64 + dbl * 8); } }
#pragma unroll
        for (int k = 0; k < 4; ++k) { const int it = tid + NTHREADS * k, key = it >> 3, ch = it & 7; if (it < NKEYS * 8) *(u32x4*)(Ks + key * KS_LD + ch * 8) = kv[k]; }
#pragma unroll
        for (int k = 0; k < 2; ++k) { const int it = tid + NTHREADS * k, dbl = it & 7, kp = it >> 3;
            if (it < (NKEYS / 2) * 8) { const int col = (2 * kp) ^ (8 * dbl);
                const unsigned a0[4] = {v0[k].x, v0[k].y, v0[k].z, v0[k].w}, a1[4] = {v1[k].x, v1[k].y, v1[k].z, v1[k].w};
#pragma unroll
                for (int j = 0; j < 4; ++j) {
                    *(unsigned*)(Vt + (dbl * 8 + 2 * j) * VT_LD + col) = (a0[j] & 0xffffu) | (a1[j] << 16);
                    *(unsigned*)(Vt + (dbl * 8 + 2 * j + 1) * VT_LD + col) = (a0[j] >> 16) | (a1[j] & 0xffff0000u); } } }
#pragma unroll
        for (int k = 0; k < 3; ++k) { const int idx = tid + NTHREADS * k, row = idx / 24, c = idx - row * 24; *(unsigned*)(Vt + row * VT_LD + ((NKEYS + 2 * c) ^ TSW(row))) = 0u; }
    }
    __syncthreads();
    const float sink8 = a->in[I_SINKS][lj * NQ + qh] * 8.f;
    auto compute = [&](auto thc) {
        constexpr int TH = decltype(thc)::value;
        auto needA = [](int ni) constexpr { return ni == 0 || (ni >= TH / 16 + 1 && ni <= TH / 16 + 9); };
        auto needB = [](int ni) constexpr { return ni == 0 || (ni >= TH / 16 + 2 && ni <= TH / 16 + 10); };
        constexpr int NSTEP = (TH == 0) ? 6 : 7;
        f32x4 sA[13], sB[13];
#pragma unroll
        for (int ni = 0; ni < 13; ++ni) { sA[ni] = (f32x4){0.f, 0.f, 0.f, 0.f}; sB[ni] = (f32x4){0.f, 0.f, 0.f, 0.f}; }
#pragma unroll
        for (int ni = 0; ni < 13; ++ni) if (needA(ni) || needB(ni)) {
            const bf16x8 b0 = *(const bf16x8*)(Ks + (16 * ni + fr) * KS_LD + 8 * fq), b1 = *(const bf16x8*)(Ks + (16 * ni + fr) * KS_LD + 32 + 8 * fq);
            if (needA(ni)) { sA[ni] = MFMA16(b0, q0[0], sA[ni]); sA[ni] = MFMA16(b1, q0[1], sA[ni]); }
            if (needB(ni)) { sB[ni] = MFMA16(b0, q1[0], sB[ni]); sB[ni] = MFMA16(b1, q1[1], sB[ni]); }
        }
        float invA, invB;
        {
            const int tq = TH + fr;
            int lo = tq + 17; { const int l2 = 144 - t0; if (l2 > lo) lo = l2; }
            const unsigned span = (unsigned)(tq + 144 - lo);
            float mx = -INFINITY;
#pragma unroll
            for (int ni = 0; ni < 13; ++ni) if (needA(ni))
#pragma unroll
                for (int j = 0; j < 4; ++j) { const int key = 16 * ni + 4 * fq + j; const bool vis = (ni == 0) || ((unsigned)(key - lo) <= span);
                    const float v = vis ? sA[ni][j] : -INFINITY; sA[ni][j] = v; mx = fmaxf(mx, v); }
            mx = fmaxf(mx, __shfl_xor(mx, 16)); mx = fmaxf(mx, __shfl_xor(mx, 32)); mx = fmaxf(mx, sink8);
            float sum = 0.f;
#pragma unroll
            for (int ni = 0; ni < 13; ++ni) if (needA(ni))
#pragma unroll
                for (int j = 0; j < 4; ++j) { const float p = __builtin_amdgcn_exp2f((sA[ni][j] - mx) * SM_C); sA[ni][j] = p; sum += p; }
            sum += __shfl_xor(sum, 16); sum += __shfl_xor(sum, 32); sum += __builtin_amdgcn_exp2f((sink8 - mx) * SM_C);
            invA = frcp(sum);
        }
        {
            const int tq = TH + 16 + fr;
            int lo = tq + 17; { const int l2 = 144 - t0; if (l2 > lo) lo = l2; }
            const unsigned span = (unsigned)(tq + 144 - lo);
            float mx = -INFINITY;
#pragma unroll
            for (int ni = 0; ni < 13; ++ni) if (needB(ni))
#pragma unroll
                for (int j = 0; j < 4; ++j) { const int key = 16 * ni + 4 * fq + j; const bool vis = (ni == 0) || ((unsigned)(key - lo) <= span);
                    const float v = vis ? sB[ni][j] : -INFINITY; sB[ni][j] = v; mx = fmaxf(mx, v); }
            mx = fmaxf(mx, __shfl_xor(mx, 16)); mx = fmaxf(mx, __shfl_xor(mx, 32)); mx = fmaxf(mx, sink8);
            float sum = 0.f;
#pragma unroll
            for (int ni = 0; ni < 13; ++ni) if (needB(ni))
#pragma unroll
                for (int j = 0; j < 4; ++j) { const float p = __builtin_amdgcn_exp2f((sB[ni][j] - mx) * SM_C); sB[ni][j] = p; sum += p; }
            sum += __shfl_xor(sum, 16); sum += __shfl_xor(sum, 32); sum += __builtin_amdgcn_exp2f((sink8 - mx) * SM_C);
            invB = frcp(sum);
        }
        f32x4 oA[4], oB[4];
#pragma unroll
        for (int ni = 0; ni < 4; ++ni) { oA[ni] = (f32x4){0.f, 0.f, 0.f, 0.f}; oB[ni] = (f32x4){0.f, 0.f, 0.f, 0.f}; }
        const bf16* vb = Vt + fr * VT_LD + ((4 * fq) ^ (8 * (fr >> 3)));
        u32x2 vn0[4], vn1[4];
#pragma unroll
        for (int ni = 0; ni < 4; ++ni) { const bf16* vp = vb + (16 * ni) * VT_LD; vn0[ni] = *(const u32x2*)(vp + ((0) ^ (16 * ni))); vn1[ni] = *(const u32x2*)(vp + ((16) ^ (16 * ni))); }
#pragma unroll
        for (int ks = 0; ks < NSTEP; ++ks) {
            u32x2 v0[4], v1[4];
#pragma unroll
            for (int ni = 0; ni < 4; ++ni) { v0[ni] = vn0[ni]; v1[ni] = vn1[ni]; }
            if (ks + 1 < NSTEP) {
#pragma unroll
                for (int ni = 0; ni < 4; ++ni) { const bf16* vp = vb + (16 * ni) * VT_LD; vn0[ni] = *(const u32x2*)(vp + ((32 * (ks + 1)) ^ (16 * ni))); vn1[ni] = *(const u32x2*)(vp + ((32 * (ks + 1) + 16) ^ (16 * ni))); }
            }
            const int n0 = 2 * ks, n1 = (2 * ks + 1 < 13) ? 2 * ks + 1 : 0; const bool has1 = (2 * ks + 1 < 13);
            u32x4 pa = (u32x4){0u, 0u, 0u, 0u}, pb = (u32x4){0u, 0u, 0u, 0u};
            if (needA(n0)) { pa.x = pkbf(sA[n0][0] * invA, sA[n0][1] * invA); pa.y = pkbf(sA[n0][2] * invA, sA[n0][3] * invA); }
            if (needB(n0)) { pb.x = pkbf(sB[n0][0] * invB, sB[n0][1] * invB); pb.y = pkbf(sB[n0][2] * invB, sB[n0][3] * invB); }
            if (has1 && needA(n1)) { pa.z = pkbf(sA[n1][0] * invA, sA[n1][1] * invA); pa.w = pkbf(sA[n1][2] * invA, sA[n1][3] * invA); }
            if (has1 && needB(n1)) { pb.z = pkbf(sB[n1][0] * invB, sB[n1][1] * invB); pb.w = pkbf(sB[n1][2] * invB, sB[n1][3] * invB); }
            const bf16x8 afA = __builtin_bit_cast(bf16x8, pa), afB = __builtin_bit_cast(bf16x8, pb);
#pragma unroll
            for (int ni = 0; ni < 4; ++ni) { const u32x4 bu = (u32x4){v0[ni].x, v0[ni].y, v1[ni].x, v1[ni].y}; const bf16x8 bb = __builtin_bit_cast(bf16x8, bu); oA[ni] = MFMA16(bb, afA, oA[ni]); oB[ni] = MFMA16(bb, afB, oB[ni]); }
            __builtin_amdgcn_sched_barrier(0);
        }
#pragma unroll
        for (int ni = 0; ni < 4; ++ni) { u32x2 w; w.x = pkbf(oA[ni][0], oA[ni][1]); w.y = pkbf(oA[ni][2], oA[ni][3]); *(u32x2*)(AO + (size_t)(Rb + t0 + TH + fr) * DM + qh * 64 + 16 * ni + 4 * fq) = w;
            w.x = pkbf(oB[ni][0], oB[ni][1]); w.y = pkbf(oB[ni][2], oB[ni][3]); *(u32x2*)(AO + (size_t)(Rb + t0 + TH + 16 + fr) * DM + qh * 64 + 16 * ni + 4 * fq) = w; }
    };
    if (th == 0) compute(std::integral_constant<int, 0>{}); else compute(std::integral_constant<int, 32>{});
    __syncthreads();
}
constexpr int SK_LD = 72, SV_LD = 200, SP_LD = 168, SKEYS = 160;
__device__ __forceinline__ void attn_sample_pair(ArgsP a, int lj, unsigned char* lds, int bp, int kvh, int, int, int) {
    const int tid = ltid(), lane = tid & 63, wave = __builtin_amdgcn_readfirstlane(tid >> 6);
    const bf16* __restrict__ Q = (const bf16*)(a->ws + WS_Q); const bf16* __restrict__ KV = (const bf16*)(a->ws + WS_KV); bf16* __restrict__ AO = (bf16*)(a->ws + WS_AO);
    const float* __restrict__ CK = a->in[I_CK]; const float* __restrict__ CV = a->in[I_CV];
    constexpr int HALF_B = (SKEYS * SK_LD + 64 * SV_LD) * 2;
    const int fr = lane & 15, fq = lane >> 4;
    {
        u32x4 r0[5], r1[5];
#pragma unroll
        for (int k = 0; k < 5; ++k) { const int it = tid + NTHREADS * k, hf = it / (SKEYS * 8), rem = it - hf * (SKEYS * 8), key = rem >> 3, ch = rem & 7, bb = 2 * bp + hf;
            r0[k] = (u32x4){0u, 0u, 0u, 0u}; r1[k] = r0[k];
            if (key < 16) r0[k] = *(const u32x4*)(KV + (size_t)(ROW_M + key) * KVW + kvh * 64 + ch * 8);
            else if (key < 144) { const float* p = CK + ((size_t)(bb * 128 + (key - 16)) * NKV + kvh) * 64 + ch * 8; r0[k] = __builtin_nontemporal_load((const u32x4*)p); r1[k] = __builtin_nontemporal_load((const u32x4*)(p + 4)); }
            else if (key < 152) r0[k] = *(const u32x4*)(KV + (size_t)(ROW_S + bb * 8 + (key - 144)) * KVW + kvh * 64 + ch * 8); }
        u32x4 x0[3], x1[3], y0[3], y1[3];
#pragma unroll
        for (int k = 0; k < 3; ++k) { const int it = tid + NTHREADS * k, hf = it / (96 * 8), rem = it - hf * (96 * 8), dbl = rem & 7, kp = rem >> 3, bb = 2 * bp + hf, k0 = 2 * kp;
            x0[k] = (u32x4){0u, 0u, 0u, 0u}; x1[k] = x0[k]; y0[k] = x0[k]; y1[k] = x0[k];
            if (k0 < 16) { x0[k] = *(const u32x4*)(KV + (size_t)(ROW_M + k0) * KVW + 256 + kvh * 64 + dbl * 8); y0[k] = *(const u32x4*)(KV + (size_t)(ROW_M + k0 + 1) * KVW + 256 + kvh * 64 + dbl * 8); }
            else if (k0 < 144) { const float* p = CV + ((size_t)(bb * 128 + (k0 - 16)) * NKV + kvh) * 64 + dbl * 8;
                x0[k] = __builtin_nontemporal_load((const u32x4*)p); x1[k] = __builtin_nontemporal_load((const u32x4*)(p + 4)); y0[k] = __builtin_nontemporal_load((const u32x4*)(p + NKV * 64)); y1[k] = __builtin_nontemporal_load((const u32x4*)(p + NKV * 64 + 4)); }
            else if (k0 < 152) { x0[k] = *(const u32x4*)(KV + (size_t)(ROW_S + bb * 8 + (k0 - 144)) * KVW + 256 + kvh * 64 + dbl * 8); y0[k] = *(const u32x4*)(KV + (size_t)(ROW_S + bb * 8 + (k0 - 143)) * KVW + 256 + kvh * 64 + dbl * 8); } }
#pragma unroll
        for (int k = 0; k < 5; ++k) { const int it = tid + NTHREADS * k, hf = it / (SKEYS * 8), rem = it - hf * (SKEYS * 8), key = rem >> 3, ch = rem & 7;
            bf16* Ks = (bf16*)(lds + hf * HALF_B);
            u32x4 w = r0[k];
            if (key >= 16 && key < 144) { w.x = pkbf(__uint_as_float(r0[k].x), __uint_as_float(r0[k].y)); w.y = pkbf(__uint_as_float(r0[k].z), __uint_as_float(r0[k].w)); w.z = pkbf(__uint_as_float(r1[k].x), __uint_as_float(r1[k].y)); w.w = pkbf(__uint_as_float(r1[k].z), __uint_as_float(r1[k].w)); }
            *(u32x4*)(Ks + key * SK_LD + ch * 8) = w; }
#pragma unroll
        for (int k = 0; k < 3; ++k) { const int it = tid + NTHREADS * k, hf = it / (96 * 8), rem = it - hf * (96 * 8), dbl = rem & 7, kp = rem >> 3, k0 = 2 * kp;
            bf16* Vt = (bf16*)(lds + hf * HALF_B) + SKEYS * SK_LD;
            unsigned a0[4] = {x0[k].x, x0[k].y, x0[k].z, x0[k].w}, a1[4] = {y0[k].x, y0[k].y, y0[k].z, y0[k].w};
            if (k0 >= 16 && k0 < 144) {
                a0[0] = pkbf(__uint_as_float(x0[k].x), __uint_as_float(x0[k].y)); a0[1] = pkbf(__uint_as_float(x0[k].z), __uint_as_float(x0[k].w)); a0[2] = pkbf(__uint_as_float(x1[k].x), __uint_as_float(x1[k].y)); a0[3] = pkbf(__uint_as_float(x1[k].z), __uint_as_float(x1[k].w));
                a1[0] = pkbf(__uint_as_float(y0[k].x), __uint_as_float(y0[k].y)); a1[1] = pkbf(__uint_as_float(y0[k].z), __uint_as_float(y0[k].w)); a1[2] = pkbf(__uint_as_float(y1[k].x), __uint_as_float(y1[k].y)); a1[3] = pkbf(__uint_as_float(y1[k].z), __uint_as_float(y1[k].w)); }
            const int col = (2 * kp) ^ (8 * dbl);
#pragma unroll
            for (int j = 0; j < 4; ++j) {
                *(unsigned*)(Vt + (dbl * 8 + 2 * j) * SV_LD + col) = (a0[j] & 0xffffu) | (a1[j] << 16);
                *(unsigned*)(Vt + (dbl * 8 + 2 * j + 1) * SV_LD + col) = (a0[j] >> 16) | (a1[j] & 0xffff0000u); } }
    }
    __syncthreads();
    if (wave < 4) {
        const int hf = wave >> 1, rb = wave & 1, bb = 2 * bp + hf;
        const bf16* Ks = (const bf16*)(lds + hf * HALF_B); const bf16* Vt = Ks + SKEYS * SK_LD; bf16* Pw = (bf16*)(lds + 2 * HALF_B) + wave * 16 * SP_LD;
        const int r = 2 * rb + (fr >> 3), t = fr & 7, qh = kvh * 4 + r;
        const size_t qrow = (size_t)(ROW_S + bb * 8 + t);
        bf16x8 qa[2];
        if (lj == 0) {
#pragma unroll
            for (int ks = 0; ks < 2; ++ks) qa[ks] = *(const bf16x8*)(Q + qrow * DM + qh * 64 + 32 * ks + 8 * fq);
        } else {
            const float* __restrict__ SL = (const float*)(a->ws + WS_SLAB) + (size_t)(qrow - ROW_S) * DM + qh * 64 + 8 * fq;
#pragma unroll
            for (int ks = 0; ks < 2; ++ks) { f32x4 x0 = (f32x4){0.f, 0.f, 0.f, 0.f}, x1 = x0;
#pragma unroll
                for (int sl = 0; sl < 4; ++sl) { const float* p = SL + (size_t)sl * (1280 * 1024) + 32 * ks; x0 = x0 + *(const f32x4*)p; x1 = x1 + *(const f32x4*)(p + 4); }
                const u32x4 w = (u32x4){pkbf(x0.x, x0.y), pkbf(x0.z, x0.w), pkbf(x1.x, x1.y), pkbf(x1.z, x1.w)}; qa[ks] = __builtin_bit_cast(bf16x8, w); }
        }
        const float sink8 = a->in[I_SINKS][lj * NQ + qh] * 8.f;
        f32x4 sc[10];
#pragma unroll
        for (int ni = 0; ni < 10; ++ni) sc[ni] = (f32x4){0.f, 0.f, 0.f, 0.f};
#pragma unroll
        for (int ni = 0; ni < 10; ++ni) {
            const bf16x8 b0 = *(const bf16x8*)(Ks + (16 * ni + fr) * SK_LD + 8 * fq), b1 = *(const bf16x8*)(Ks + (16 * ni + fr) * SK_LD + 32 + 8 * fq);
            sc[ni] = MFMA16(b0, qa[0], sc[ni]); sc[ni] = MFMA16(b1, qa[1], sc[ni]); }
        float mx = -INFINITY;
#pragma unroll
        for (int ni = 0; ni < 10; ++ni)
#pragma unroll
            for (int j = 0; j < 4; ++j) { const int key = 16 * ni + 4 * fq + j;
                const bool vis = (ni == 0) || ((key < 144) ? (key - 16 > t) : (key - 144 <= t));
                const float v = vis ? sc[ni][j] : -INFINITY; sc[ni][j] = v; mx = fmaxf(mx, v); }
        mx = fmaxf(mx, __shfl_xor(mx, 16)); mx = fmaxf(mx, __shfl_xor(mx, 32)); mx = fmaxf(mx, sink8);
        float sum = 0.f;
#pragma unroll
        for (int ni = 0; ni < 10; ++ni)
#pragma unroll
            for (int j = 0; j < 4; ++j) { const float p = __builtin_amdgcn_exp2f((sc[ni][j] - mx) * SM_C); sc[ni][j] = p; sum += p; }
        sum += __shfl_xor(sum, 16); sum += __shfl_xor(sum, 32); sum += __builtin_amdgcn_exp2f((sink8 - mx) * SM_C);
        const float inv = frcp(sum);
        f32x4 o[4];
#pragma unroll
        for (int ni = 0; ni < 4; ++ni) o[ni] = (f32x4){0.f, 0.f, 0.f, 0.f};
        const bf16* vb = Vt + fr * SV_LD + ((4 * fq) ^ (8 * (fr >> 3)));
        u32x2 vn0[4], vn1[4];
#pragma unroll
        for (int ni = 0; ni < 4; ++ni) { const bf16* vp = vb + (16 * ni) * SV_LD; vn0[ni] = *(const u32x2*)(vp + ((0) ^ (16 * ni))); vn1[ni] = *(const u32x2*)(vp + ((16) ^ (16 * ni))); }
#pragma unroll
        for (int ks = 0; ks < 5; ++ks) {
            u32x2 v0[4], v1[4];
#pragma unroll
            for (int ni = 0; ni < 4; ++ni) { v0[ni] = vn0[ni]; v1[ni] = vn1[ni]; }
            if (ks + 1 < 5) {
#pragma unroll
                for (int ni = 0; ni < 4; ++ni) { const bf16* vp = vb + (16 * ni) * SV_LD; vn0[ni] = *(const u32x2*)(vp + ((32 * (ks + 1)) ^ (16 * ni))); vn1[ni] = *(const u32x2*)(vp + ((32 * (ks + 1) + 16) ^ (16 * ni))); }
            }
            u32x4 pu; pu.x = pkbf(sc[2 * ks][0] * inv, sc[2 * ks][1] * inv); pu.y = pkbf(sc[2 * ks][2] * inv, sc[2 * ks][3] * inv); pu.z = pkbf(sc[2 * ks + 1][0] * inv, sc[2 * ks + 1][1] * inv); pu.w = pkbf(sc[2 * ks + 1][2] * inv, sc[2 * ks + 1][3] * inv);
            const bf16x8 af = __builtin_bit_cast(bf16x8, pu);
#pragma unroll
            for (int ni = 0; ni < 4; ++ni) { const u32x4 bu = (u32x4){v0[ni].x, v0[ni].y, v1[ni].x, v1[ni].y}; o[ni] = MFMA16(__builtin_bit_cast(bf16x8, bu), af, o[ni]); }
            __builtin_amdgcn_sched_barrier(0);
        }
#pragma unroll
        for (int ni = 0; ni < 4; ++ni) { u32x2 w; w.x = pkbf(o[ni][0], o[ni][1]); w.y = pkbf(o[ni][2], o[ni][3]); *(u32x2*)(AO + qrow * DM + qh * 64 + 16 * ni + 4 * fq) = w; }
    }
    __syncthreads();
}
__device__ __forceinline__ void cache_copy_job(ArgsP a, int cu0) {
    const bf16* __restrict__ KV = (const bf16*)(a->ws + WS_KV); const float* __restrict__ CK = a->in[I_CK]; const float* __restrict__ CV = a->in[I_CV];
    const int gt = ((int)blockIdx.x - cu0) * NTHREADS + ltid(), NT = ((int)gridDim.x - cu0) * NTHREADS;
    constexpr int ITEMS = NSAMP * 128 * 64;
#pragma unroll 1
    for (int it0 = gt; it0 < ITEMS; it0 += 4 * NT) {
        u32x4 kx[4], vx[4];
#pragma unroll
        for (int k = 0; k < 4; ++k) { const int it = it0 + k * NT; kx[k] = (u32x4){0u, 0u, 0u, 0u}; vx[k] = kx[k];
            if (it < ITEMS) { const int b = it >> 13, w = (it >> 6) & 127, c4 = (it & 63) * 4;
                if (w < 120) { const size_t i = (size_t)(b * 128 + w + 8) * 256 + c4; kx[k] = __builtin_nontemporal_load((const u32x4*)(CK + i)); vx[k] = __builtin_nontemporal_load((const u32x4*)(CV + i)); }
                else { const bf16* rp = KV + (size_t)(ROW_S + b * 8 + (w - 120)) * KVW + c4; const u32x2 k2 = *(const u32x2*)rp, v2 = *(const u32x2*)(rp + 256);
                    kx[k] = (u32x4){k2.x << 16, k2.x & 0xffff0000u, k2.y << 16, k2.y & 0xffff0000u}; vx[k] = (u32x4){v2.x << 16, v2.x & 0xffff0000u, v2.y << 16, v2.y & 0xffff0000u}; } } }
#pragma unroll
        for (int k = 0; k < 4; ++k) { const int it = it0 + k * NT;
            if (it < ITEMS) { const size_t o = (size_t)it * 4; __builtin_nontemporal_store(kx[k], (u32x4*)(a->out + O_SCK + o)); __builtin_nontemporal_store(vx[k], (u32x4*)(a->out + O_SCV + o)); } }
    }
}
__device__ __forceinline__ void phase_attn(ArgsP a, int lj, unsigned char* lds, int tid, int wave, int lane) {
    if (lj == 0) {
        const bf16* KV = (const bf16*)(a->ws + WS_KV);
        const int gt = blockIdx.x * NTHREADS + tid, NT = gridDim.x * NTHREADS;
        for (int e = gt; e < 2 * 128 * 512; e += NT) { const int b = e >> 16, w = (e >> 9) & 127, c = e & 511;
            const float v = bf2f(KV[(size_t)(b * SEQ + SEQ - 128 + w) * KVW + c]);
            if (c < 256) a->out[O_PCK + (size_t)(b * 128 + w) * 256 + c] = v; else a->out[O_PCV + (size_t)(b * 128 + w) * 256 + (c - 256)] = v; }
    }
    const int xg = blockIdx.x & 7, xi = blockIdx.x >> 3;
#pragma unroll 1
    for (int j = 0; j < 4; ++j) { const int u = 128 * xg + 4 * xi + j, qb = u & 127, kvh = (u >> 7) & 3, b = u >> 9; attn_prompt_unit(a, lj, lds, b, kvh, qb, tid, wave, lane); }
    { const int su = blockIdx.x; attn_sample_pair(a, lj, lds, su >> 2, su & 3, tid, wave, lane); }
}

constexpr int PH_A = 1, PH_B = PH_A + 7 * 2, PH_F = PH_B + 5 * 2, NPHASES = PH_F + 1;
template <class Epi> __device__ __forceinline__ void run_gemm(LAS unsigned char* lds, const bf16* A, const bf16* Bt, int M, int N, int K, const Epi& E, unsigned* flag) {
    pg8::Gemm g{A, Bt, MP, N, K}; pg8::StaticOrder S; S.init(M, N, K, (int)gridDim.x, (int)blockIdx.x); S.flag = flag; S.need = ROWJOB_WGS;
    pg8::gemm_phase<Epi, pg8::StaticOrder, true, true>(lds, g, S, E);
}
template <class Epi> __device__ __forceinline__ void run_gemm_res(LAS unsigned char* lds, const bf16* A, const bf16* Bt, int K, int S_, const Epi& E, unsigned* flag, unsigned need) {
    pg8::Gemm g{A, Bt, MP, 1024, K}; pg8::ResOrder S; S.init(K, S_, (int)gridDim.x, (int)blockIdx.x); S.so.flag = flag; S.so.need = need;
    pg8::gemm_phase<Epi, pg8::ResOrder, true, true>(lds, g, S, E);
}

template <class Epi> __device__ __forceinline__ void run_gemm_left(LAS unsigned char* lds, const bf16* A, const bf16* Bt, int u, const Epi& E) {
    pg8::Gemm g{A, Bt, MP, 4096, 1024}; pg8::LeftOrder S; S.u = u;
    pg8::gemm_phase<Epi, pg8::LeftOrder, true, true>(lds, g, S, E);
}

__global__ void __launch_bounds__(NTHREADS, 2) yoco_fwd(Args args) {
    extern __shared__ __attribute__((aligned(16))) unsigned char lds[];
    LAS unsigned char* ldsl = (LAS unsigned char*)lds;
    const int tid0 = threadIdx.x;
    for (int u = tid0; u < (LDS_BYTES - LDSCTL_OFF) / 4; u += NTHREADS) ((LAS unsigned*)(ldsl + LDSCTL_OFF))[u] = 0u;
    __syncthreads();
    const int lo = args.ph_lo, hi = args.ph_hi;
    if (hi - lo > 1) (void)xcd_barrier_post((unsigned*)(args.ws + WS_CTL) + CW_BAR, (volatile LAS unsigned*)(ldsl + MISC_OFF) + 8);
    int rep = 0;
#pragma unroll 1
    for (int p = lo; p < hi;) {
        ArgsP la = (ArgsP)__builtin_amdgcn_kernarg_segment_ptr(); asm volatile("" : "+s"(la));
        unsigned char* ws = la->ws;
#define TID_ ltid()
#define LANE_ (ltid() & 63)
#define WAVE_ __builtin_amdgcn_readfirstlane(ltid() >> 6)
        float* H = (float*)(ws + WS_H);
        int kind, li = 0, lj = 0, layer = 0;
        int nslab = 8;
        int ver = 0;
        if (p == 0) kind = 0;
        else if (p < PH_B) { li = (p - PH_A) / 7; layer = li; const int sub = (p - PH_A) % 7;
            kind = (sub == 0) ? 3 : (sub == 1) ? 5 : (sub == 2) ? 6 : (sub == 3) ? 7 : (sub == 4) ? 8 : (sub == 5) ? 9 : 10; ver = 2 * li + (sub >= 5 ? 1 : 0); }
        else if (p < PH_F) { lj = (p - PH_B) / 5; layer = 2 + lj; const int sub = (p - PH_B) % 5;
            kind = (sub == 0) ? 11 : (sub == 1) ? 12 : (sub == 2) ? 13 : (sub == 3) ? 9 : 10; if (sub == 3) nslab = 4; ver = 4 + 2 * lj + (sub >= 3 ? 1 : 0); }
        else kind = 14;
#ifndef KMASK
#define KMASK 0xffff
#endif
#define KON(k) ((KMASK >> (k)) & 1)
#ifndef REP_MASK
#define REP_MASK 0
#endif
        const int verS = __builtin_amdgcn_readfirstlane(ver);
#define SSV(v) ((float*)(ws + WS_SS) + (v) * (MP * 4))
        unsigned* flagp = (unsigned*)(ws + WS_CTL) + CW_FLAG + 64 * verS;
        if ((kind == 3 || kind == 11) && verS > 0) {
            if (rep == 0 && (int)blockIdx.x >= (int)gridDim.x - ROWJOB_WGS) {
                phase_rows(la, 0, nslab, verS, ROWJOB_WGS, WAVE_, LANE_);
                asm volatile("s_waitcnt vmcnt(0)" ::: "memory"); __syncthreads();
                if (TID_ == 0) { __builtin_amdgcn_fence(__ATOMIC_RELEASE, "agent"); asm volatile("s_waitcnt vmcnt(0)" ::: "memory"); (void)xb_add(flagp, 1u); }
            }
        } else { flagp = nullptr;
            if (kind == 9 && rep == 0) phase_rows(la, 0, nslab, verS, (int)gridDim.x, WAVE_, LANE_);
        }
        {
            constexpr int SLACK_IN = (69 * 25) % 256;
            unsigned cmask = 0u; int ccu0 = 0, ccu1 = 0;
            if (p == PH_A) { cmask = (1u << 2) | (1u << 4) | (1u << 8); ccu0 = SLACK_IN; ccu1 = (int)gridDim.x; }
            else if (p == PH_A + 6) { cmask = (1u << 1) | (1u << 3) | (1u << 5) | (1u << 9); ccu0 = 0; ccu1 = 160; }
            else if (p == PH_A + 7) { cmask = (1u << 6) | (1u << 10); ccu0 = SLACK_IN; ccu1 = (int)gridDim.x; }
            else if (p == PH_A + 13) { cmask = (0x1fu << 12) | (1u << 7) | (1u << 11); ccu0 = 0; ccu1 = 160; }
            if (KON(0) && cmask != 0u && (int)blockIdx.x >= ccu0 && (int)blockIdx.x < ccu1) { phase_prologue(la, ldsl, WAVE_, LANE_, cmask, ccu0, ccu1); __syncthreads(); }
        }
        if (KON(0) && kind == 0) { phase_prologue(la, ldsl, WAVE_, LANE_, 1u, 0, (int)gridDim.x); phase_rows(la, 1, 0, 0, (int)gridDim.x, WAVE_, LANE_); }
        else if (KON(3) && kind == 3) { pg8::EpiInProj E{(bf16*)(ws + WS_ZX), (float*)(ws + WS_DT), la->in[I_ADTB] + li * NHEADS, SSV(verS)}; run_gemm(ldsl, (const bf16*)H, (const bf16*)(ws + WS_WIN + li * SZ_WIN), MP, INPROJ_P, 1024, E, flagp); }
        else if (KON(5) && kind == 5) phase_ssd1(la, li, lds, TID_, WAVE_, LANE_);
        else if (KON(6) && kind == 6) phase_scan(la, li);
        else if (KON(7) && kind == 7) phase_ssd3(la, li, lds, TID_, WAVE_, LANE_);
        else if (KON(8) && (kind == 8 || kind == 10 || kind == 13)) {
            const bf16* A; const bf16* Bt; int K;
            if (kind == 8) { A = (const bf16*)(ws + WS_YN); Bt = (const bf16*)(ws + WS_WOUT + li * SZ_WOUT); K = 2048; }
            else if (kind == 10) { A = (const bf16*)(ws + WS_U); Bt = (const bf16*)(ws + WS_WDN + layer * SZ_WDN); K = 4096; }
            else { A = (const bf16*)(ws + WS_AO); Bt = (const bf16*)(ws + WS_WO + lj * SZ_WO); K = 1024; }
            unsigned* flag2 = nullptr;
            if (kind == 13 && lj == 0 && (int)blockIdx.x >= 80) cache_copy_job(la, 80);
            if (kind == 10) {
                flag2 = (unsigned*)(ws + WS_CTL) + CW_FLAG2 + 64 * layer;
                if ((int)blockIdx.x >= LEFT_CU0) {
                    pg8::EpiBf<1> EU{(bf16*)(ws + WS_U), 4096, 1 << 20, nullptr, 0, SSV(verS)}; run_gemm_left(ldsl, (const bf16*)H, (const bf16*)(ws + WS_WUP + layer * SZ_WUP), (int)blockIdx.x - LEFT_CU0, EU);
                    asm volatile("s_waitcnt vmcnt(0)" ::: "memory"); __syncthreads();
                    if (TID_ == 0) { __builtin_amdgcn_fence(__ATOMIC_RELEASE, "agent"); asm volatile("s_waitcnt vmcnt(0)" ::: "memory"); (void)xb_add(flag2, 1u); }
                }
            }
            pg8::EpiRes E{SSV(verS + 1), nullptr, (bf16*)H, (float*)(ws + WS_SLAB)}; run_gemm_res(ldsl, A, Bt, K, K == 1024 ? 4 : 8, E, flag2, 80u); }
        else if (KON(9) && kind == 9) { pg8::EpiBf<1> E{(bf16*)(ws + WS_U), 4096, 1 << 20, nullptr, 0, SSV(verS)}; run_gemm(ldsl, (const bf16*)H, (const bf16*)(ws + WS_WUP + layer * SZ_WUP), 64 * pg8::BM, 4096, 1024, E, nullptr); }
        else if (KON(11) && kind == 11) { pg8::EpiBf<0> E{(bf16*)(ws + WS_Q), 1024, 4, (bf16*)(ws + WS_KV), KVW, SSV(verS)};
            if (lj == 0) run_gemm(ldsl, (const bf16*)H, (const bf16*)(ws + WS_WQKV0), MP, 1536, 1024, E, flagp);
            else { pg8::EpiQSplit E2{(bf16*)(ws + WS_Q), (float*)(ws + WS_SLAB), SSV(verS)}; run_gemm_res(ldsl, (const bf16*)H, (const bf16*)(ws + WS_WQ1), 1024, 4, E2, flagp, (unsigned)ROWJOB_WGS); } }
        else if (KON(12) && kind == 12) phase_attn(la, lj, lds, TID_, WAVE_, LANE_);
        else if (KON(14) && kind == 14) phase_final(la, WAVE_, LANE_);
        bool again = false;
#ifndef REP_N
#define REP_N 2
#endif
        if (REP_MASK != 0) { if (rep < REP_N - 1 && ((REP_MASK >> kind) & 1)) { ++rep; again = true; } else rep = 0; }
        if (p + 1 < hi || again) { XcdBarrier bar; bar.bar = (unsigned*)(ws + WS_CTL) + CW_BAR; bar.x = xb_xcc_id(); bar.st = (volatile LAS unsigned*)(ldsl + MISC_OFF) + 8; xcd_barrier(bar); }
        else { asm volatile("s_waitcnt vmcnt(0)" ::: "memory"); __syncthreads(); }
        if (!again) ++p;
    }
}

#ifndef MK_PER_PHASE
#define MK_PER_PHASE 0
#endif
extern "C" void kernel_launch(void* const* d_in, const int* in_sizes, int n_in, void* d_out, int out_size, void* d_ws, size_t ws_size, hipStream_t stream) {
    static int grid = 0;
    if (grid == 0) {
        if (n_in != 26 || (size_t)out_size != O_END || ws_size < WS_END) { fprintf(stderr, "kernel_launch: unexpected problem (n_in %d, out %d vs %zu, ws %zu vs %zu); nothing launched\n", n_in, out_size, (size_t)O_END, ws_size, (size_t)WS_END); grid = -1; return; }
        int dev = 0, cus = 0, per_cu = 0;
        if (hipGetDevice(&dev) != hipSuccess || hipDeviceGetAttribute(&cus, hipDeviceAttributeMultiprocessorCount, dev) != hipSuccess) { grid = -1; return; }
        if (hipFuncSetAttribute((const void*)yoco_fwd, hipFuncAttributeMaxDynamicSharedMemorySize, LDS_BYTES) != hipSuccess) { fprintf(stderr, "kernel_launch: hipFuncSetAttribute failed\n"); grid = -1; return; }
        if (hipOccupancyMaxActiveBlocksPerMultiprocessor(&per_cu, (const void*)yoco_fwd, NTHREADS, LDS_BYTES) != hipSuccess || per_cu < 1) { fprintf(stderr, "kernel_launch: occupancy query says %d\n", per_cu); per_cu = 1; }
        (void)hipGetLastError();
        if (cus != 256) { fprintf(stderr, "kernel_launch: built for a 256-CU device (got %d); nothing launched\n", cus); grid = -1; return; }
        grid = cus;
    }
    if (grid < 0) return;
    if (hipMemsetAsync((char*)d_ws + WS_CTL, 0, CTL_ZERO_BYTES, stream) != hipSuccess) { fprintf(stderr, "kernel_launch: memset failed\n"); return; }
    Args a{};
    for (int i = 0; i < 26; ++i) a.in[i] = (const float*)d_in[i];
    a.out = (float*)d_out; a.ws = (unsigned char*)d_ws;
#if MK_PER_PHASE
    for (int p = 0; p < NPHASES; ++p) { a.ph_lo = p; a.ph_hi = p + 1; hipLaunchKernelGGL(yoco_fwd, dim3(grid), dim3(NTHREADS), LDS_BYTES, stream, a); }
#else
    a.ph_lo = 0; a.ph_hi = NPHASES;
    void* kargs[] = {&a};
    hipError_t e = hipLaunchCooperativeKernel((const void*)yoco_fwd, dim3(grid), dim3(NTHREADS), kargs, LDS_BYTES, stream);
    if (e != hipSuccess) fprintf(stderr, "kernel_launch: cooperative launch failed: %s (grid %d)\n", hipGetErrorString(e), grid);
#endif
}
```
